# Optimizing an MI355X kernel written in HIP

```python
import math
import jax, jax.numpy as jnp
from jax import lax
import numpy as np

D_MODEL = 1024
BATCH = 8
SEQ = 2048
DEPTH = 1

PLE_DIM = 256
GLA_HEADS = 4
GLA_DK = 128
GLA_DV = 256
GLA_RANK = 16
GLA_TAU = 16.0
GLA_CHUNK = 64
GLA_QK = GLA_HEADS * GLA_DK
GLA_V = GLA_HEADS * GLA_DV
MOBA_HEADS = 8
MOBA_HD = 128
MOBA_BLOCK = 256
MOBA_TOPK = 3
MOBA_QCHUNK = 128
MOBA_W = MOBA_HEADS * MOBA_HD
REL_BUCKETS = 32
REL_MAX_DIST = 4096
N_EXPERTS = 32
TOP_K = 4
D_FF = 1024
SWIGLU_LIMIT = 7.0
SWIGLU_ALPHA = 1.702
MOE_BLOCK = 512
EPS = 1e-6
SPLIT_SIZES = (GLA_QK, GLA_QK, GLA_V, GLA_V, GLA_RANK, MOBA_W, MOBA_W, MOBA_W, D_MODEL, D_MODEL)
D_IN = sum(SPLIT_SIZES)

kernel_name = 'hybrid_gla_moba_moe_block'


def rmsnorm(x, g):
    xf = x.astype(jnp.float32)
    y = xf * lax.rsqrt(jnp.mean(xf * xf, axis=-1, keepdims=True) + EPS)
    return (y * g.astype(jnp.float32)).astype(x.dtype)


def rel_bucket(n):
    n = jnp.maximum(n, 0)
    max_exact = REL_BUCKETS // 2
    nf = jnp.maximum(n, 1).astype(jnp.float32)
    large = max_exact + (jnp.log(nf / max_exact) / math.log(REL_MAX_DIST / max_exact)
                         * (REL_BUCKETS - max_exact)).astype(jnp.int32)
    large = jnp.minimum(large, REL_BUCKETS - 1)
    return jnp.where(n < max_exact, n, large)


def gla_mixer(q, k, v, g):
    B, S, H, DK = q.shape
    DV = v.shape[-1]
    L = GLA_CHUNK
    n = S // L

    def chunks(t):
        return t.astype(jnp.float32).reshape(B, n, L, H, t.shape[-1]).transpose(1, 0, 3, 2, 4)

    qc = chunks(q) * (DK ** -0.5)
    kc, vc, gc = chunks(k), chunks(v), chunks(g)
    causal = jnp.tril(jnp.ones((L, L), dtype=bool))[None, None, :, :, None]

    def step(state, inp):
        qi, ki, vi, gi = inp
        G = jnp.cumsum(gi, axis=2)
        inter = jnp.einsum('bhld,bhde->bhle', qi * jnp.exp(G), state)
        diff = G[:, :, :, None, :] - G[:, :, None, :, :]
        decay = jnp.exp(jnp.where(causal, diff, -jnp.inf))
        A = jnp.einsum('bhtd,bhsd,bhtsd->bhts', qi, ki, decay)
        intra = jnp.einsum('bhts,bhse->bhte', A, vi)
        G_last = G[:, :, -1:, :]
        new_state = (jnp.exp(G_last[:, :, 0, :, None]) * state
                     + jnp.einsum('bhld,bhle->bhde', ki * jnp.exp(G_last - G), vi))
        return new_state, inter + intra

    state0 = jnp.zeros((B, H, DK, DV), jnp.float32)
    _, out = lax.scan(step, state0, (qc, kc, vc, gc))
    return out.transpose(1, 0, 3, 2, 4).reshape(B, S, H, DV).astype(v.dtype)


def moba_mixer(q, k, v, rel_table):
    B, S, H, HD = q.shape
    BLK, QC = MOBA_BLOCK, MOBA_QCHUNK
    s_pad = -(-S // BLK) * BLK
    pad = ((0, 0), (0, s_pad - S), (0, 0), (0, 0))
    q, k, v = jnp.pad(q, pad), jnp.pad(k, pad), jnp.pad(v, pad)
    nb = s_pad // BLK
    nc = s_pad // QC
    kk = min(MOBA_TOPK, nb)
    qh = (q * (HD ** -0.5)).transpose(0, 2, 1, 3)
    kb = k.transpose(0, 2, 1, 3).reshape(B, H, nb, BLK, HD)
    vb = v.transpose(0, 2, 1, 3).reshape(B, H, nb, BLK, HD)
    kmean = jnp.mean(kb.astype(jnp.float32), axis=3)
    pos = jnp.arange(s_pad)
    qblk = pos // BLK
    score = jnp.einsum('bhsd,bhnd->bhsn', qh.astype(jnp.float32), kmean)
    past = jnp.arange(nb)[None, :] < qblk[:, None]
    score = jnp.where(past, score, -jnp.inf)
    _, sel = lax.top_k(score, kk)
    rel_t = rel_table.astype(jnp.float32).T
    hix = jnp.arange(H)[:, None]
    blk_off = jnp.arange(BLK)

    def attend(args):
        qq, ss, bi, ci = args
        qpos = ci * QC + jnp.arange(QC)
        qb = qpos // BLK
        kbb, vbb = kb[bi], vb[bi]
        ob = (ci * QC) // BLK
        k_own = lax.dynamic_index_in_dim(kbb, ob, axis=1, keepdims=False)
        v_own = lax.dynamic_index_in_dim(vbb, ob, axis=1, keepdims=False)
        dist = qpos[:, None] - (ob * BLK + blk_off)[None, :]
        lg = jnp.einsum('hqd,hkd->hqk', qq, k_own).astype(jnp.float32) + rel_t[:, rel_bucket(dist)]
        logits = [jnp.where(dist[None] >= 0, lg, -jnp.inf)]
        for s in range(kk):
            idx = ss[:, :, s]
            kg = kbb[hix, idx]
            kpos_s = idx[:, :, None] * BLK + blk_off
            bias = rel_t[hix[:, :, None], rel_bucket(qpos[None, :, None] - kpos_s)]
            lg = jnp.einsum('hqd,hqkd->hqk', qq, kg).astype(jnp.float32) + bias
            logits.append(jnp.where((s < qb)[None, :, None], lg, -jnp.inf))
        probs = jax.nn.softmax(jnp.concatenate(logits, axis=-1), axis=-1).astype(v.dtype)
        out = jnp.einsum('hqk,hkd->hqd', probs[..., :BLK], v_own)
        for s in range(kk):
            vg = vbb[hix, ss[:, :, s]]
            out = out + jnp.einsum('hqk,hqkd->hqd', probs[..., (s + 1) * BLK:(s + 2) * BLK], vg)
        return out

    qx = qh.reshape(B, H, nc, QC, HD).transpose(0, 2, 1, 3, 4).reshape(B * nc, H, QC, HD)
    sx = sel.reshape(B, H, nc, QC, kk).transpose(0, 2, 1, 3, 4).reshape(B * nc, H, QC, kk)
    bx = jnp.repeat(jnp.arange(B), nc)
    cx = jnp.tile(jnp.arange(nc), B)
    out = lax.map(attend, (qx, sx, bx, cx))
    out = out.reshape(B, nc, H, QC, HD).transpose(0, 1, 3, 2, 4).reshape(B, s_pad, H * HD)
    return out[:, :S]


def moe_ffn(h, w_router, b_router, w_gate, b_gate, w_up, b_up, w_down, b_down):
    B, S, D = h.shape
    T = B * S
    M = MOE_BLOCK
    hf = h.reshape(T, D)
    logits = (hf @ w_router + b_router).astype(jnp.float32)
    top_v, top_i = lax.top_k(logits, TOP_K)
    wts = jax.nn.softmax(top_v, axis=-1)
    A = T * TOP_K
    e_flat = top_i.reshape(A)
    order = jnp.argsort(e_flat)
    e_sorted = e_flat[order]
    counts = jnp.bincount(e_flat, length=N_EXPERTS)
    padded = (counts + M - 1) // M * M
    pad_end = jnp.cumsum(padded)
    pad_start = pad_end - padded
    start = jnp.cumsum(counts) - counts
    dest_sorted = pad_start[e_sorted] + (jnp.arange(A) - start[e_sorted])
    n_pad = (-(-A // M)) * M + N_EXPERTS * M
    n_blk = n_pad // M
    row_tok = jnp.full((n_pad,), T, jnp.int32).at[dest_sorted].set(order // TOP_K)
    blk_exp = jnp.minimum(jnp.searchsorted(pad_end, jnp.arange(n_blk) * M, side='right'), N_EXPERTS - 1)
    x_rows = jnp.concatenate([hf, jnp.zeros((1, D), hf.dtype)], axis=0)[row_tok].reshape(n_blk, M, D)

    def expert_block(args):
        xb, e = args
        gate = xb @ w_gate[e] + b_gate[e]
        up = xb @ w_up[e] + b_up[e]
        gate = jnp.minimum(gate, SWIGLU_LIMIT)
        up = jnp.clip(up, -SWIGLU_LIMIT, SWIGLU_LIMIT)
        glu = gate * jax.nn.sigmoid(gate * SWIGLU_ALPHA)
        return ((up + 1.0) * glu) @ w_down[e] + b_down[e]

    y_rows = lax.map(expert_block, (x_rows, blk_exp)).reshape(n_pad, D)
    dest = jnp.zeros((A,), jnp.int32).at[order].set(dest_sorted).reshape(T, TOP_K)
    y = jnp.einsum('tk,tkd->td', wts.astype(h.dtype), y_rows[dest])
    return y.reshape(B, S, D)


def setup_inputs(seed: int = 0) -> dict:
    key = jax.random.key(seed)
    ks = jax.random.split(key, 32)
    f32 = jnp.float32
    L = DEPTH

    def nrm(k, shape, scale):
        return jax.random.normal(k, shape, f32) * scale

    def gain(k, shape):
        return 1.0 + 0.05 * jax.random.normal(k, shape, f32)

    return {
        'x': nrm(ks[0], (BATCH, SEQ, D_MODEL), 1.0),
        'p': nrm(ks[1], (DEPTH, BATCH, SEQ, PLE_DIM), 1.0),
        'rel_bias': nrm(ks[2], (REL_BUCKETS, MOBA_HEADS), 0.5),
        'g_mix': gain(ks[3], (L, D_MODEL)),
        'w_in': nrm(ks[4], (L, D_MODEL, D_IN), D_MODEL ** -0.5),
        'w_a2': nrm(ks[5], (L, GLA_RANK, GLA_QK), GLA_RANK ** -0.5),
        'b_a2': nrm(ks[6], (L, GLA_QK), 0.1),
        'g_gla_out': gain(ks[7], (L, GLA_DV)),
        'w_up_gla': nrm(ks[8], (L, GLA_V, D_MODEL), GLA_V ** -0.5),
        'w_up_moba': nrm(ks[9], (L, MOBA_W, D_MODEL), MOBA_W ** -0.5),
        'w_o': nrm(ks[10], (L, D_MODEL, D_MODEL), D_MODEL ** -0.5),
        'g_ffn': gain(ks[11], (L, D_MODEL)),
        'w_router': nrm(ks[12], (L, D_MODEL, N_EXPERTS), D_MODEL ** -0.5),
        'b_router': nrm(ks[13], (L, N_EXPERTS), 0.01),
        'w_e_gate': nrm(ks[14], (L, N_EXPERTS, D_MODEL, D_FF), D_MODEL ** -0.5),
        'b_e_gate': nrm(ks[15], (L, N_EXPERTS, D_FF), 0.02),
        'w_e_up': nrm(ks[16], (L, N_EXPERTS, D_MODEL, D_FF), D_MODEL ** -0.5),
        'b_e_up': nrm(ks[17], (L, N_EXPERTS, D_FF), 0.02),
        'w_e_down': nrm(ks[18], (L, N_EXPERTS, D_FF, D_MODEL), D_FF ** -0.5),
        'b_e_down': nrm(ks[19], (L, N_EXPERTS, D_MODEL), 0.02),
        'g_ple_gate': gain(ks[20], (L, D_MODEL)),
        'w_ple_gate': nrm(ks[21], (L, D_MODEL, D_MODEL), D_MODEL ** -0.5),
        'w_ple_proj': nrm(ks[22], (L, PLE_DIM, D_MODEL), PLE_DIM ** -0.5),
        'g_ple_proj': gain(ks[23], (L, D_MODEL)),
        'g_final': gain(ks[24], (D_MODEL,)),
    }


def reference(x, p, rel_bias, g_mix, w_in, w_a2, b_a2, g_gla_out, w_up_gla, w_up_moba, w_o,
              g_ffn, w_router, b_router, w_e_gate, b_e_gate, w_e_up, b_e_up, w_e_down, b_e_down,
              g_ple_gate, w_ple_gate, w_ple_proj, g_ple_proj, g_final):
    B, S, D = x.shape
    points = []
    acc = 0
    for sz in SPLIT_SIZES[:-1]:
        acc += sz
        points.append(acc)
    for i in range(DEPTH):
        h = rmsnorm(x, g_mix[i])
        proj = h @ w_in[i]
        qa, ka, va, ra, a_low, qb, kb, vb, gate_a, gate_b = jnp.split(proj, points, axis=-1)
        a_logit = (a_low @ w_a2[i] + b_a2[i]).astype(jnp.float32)
        g_log = (jax.nn.log_sigmoid(a_logit) / GLA_TAU).reshape(B, S, GLA_HEADS, GLA_DK)
        o_a = gla_mixer(qa.reshape(B, S, GLA_HEADS, GLA_DK), ka.reshape(B, S, GLA_HEADS, GLA_DK),
                        va.reshape(B, S, GLA_HEADS, GLA_DV), g_log)
        o_a = rmsnorm(o_a, g_gla_out[i]).reshape(B, S, GLA_V) * jax.nn.silu(ra)
        u_a = o_a @ w_up_gla[i]
        o_b = moba_mixer(qb.reshape(B, S, MOBA_HEADS, MOBA_HD), kb.reshape(B, S, MOBA_HEADS, MOBA_HD),
                         vb.reshape(B, S, MOBA_HEADS, MOBA_HD), rel_bias)
        u_b = o_b @ w_up_moba[i]
        y = jax.nn.sigmoid(gate_a) * u_a + jax.nn.sigmoid(gate_b) * u_b
        x = x + y @ w_o[i]
        h2 = rmsnorm(x, g_ffn[i])
        x = x + moe_ffn(h2, w_router[i], b_router[i], w_e_gate[i], b_e_gate[i], w_e_up[i], b_e_up[i],
                        w_e_down[i], b_e_down[i])
        pg = jax.nn.sigmoid(rmsnorm(x, g_ple_gate[i]) @ w_ple_gate[i])
        x = x + pg * rmsnorm(p[i] @ w_ple_proj[i], g_ple_proj[i])
    return rmsnorm(x, g_final)
```

```cpp
#include <hip/hip_runtime.h>
#include <cstdio>
#include <cstdint>

#define LAS __attribute__((address_space(3)))
#define GAS __attribute__((address_space(1)))
typedef unsigned short bf16_t;
typedef short bf16x8 __attribute__((ext_vector_type(8)));
typedef short s16x4 __attribute__((ext_vector_type(4)));
typedef float f32x2 __attribute__((ext_vector_type(2)));
typedef float f32x4 __attribute__((ext_vector_type(4)));
typedef float f32x16 __attribute__((ext_vector_type(16)));
typedef unsigned u32x2 __attribute__((ext_vector_type(2)));
typedef unsigned u32x4 __attribute__((ext_vector_type(4)));
typedef GAS unsigned gu32;
#define RLX_AGENT __ATOMIC_RELAXED, __HIP_MEMORY_SCOPE_AGENT
#define LDS_WAIT() asm volatile("s_waitcnt lgkmcnt(0)" ::: "memory")
#define VM_WAIT() asm volatile("s_waitcnt vmcnt(0)" ::: "memory")

#ifndef MK_PER_PHASE
#define MK_PER_PHASE 0
#endif

constexpr int NB = 8, SEQ = 2048, T = NB * SEQ, D = 1024;
constexpr int NPROJ = 8192;
constexpr int C_QA = 0, C_KA = 512, C_VA = 1024, C_RA = 2048, C_QB = 3072, C_KB = 4096, C_VB = 5120, C_GA = 6144, C_GB = 7168;
constexpr int SRC_ALOW = 3072, D_IN = 8208;
constexpr int NE = 32, FF = 1024, MAXTILES = 288, MAXROWS = MAXTILES * 256;
constexpr float EPS = 1e-6f;
constexpr int NWAVES = 8, NTHREADS = 512;
constexpr int NPHASES = 13;

constexpr size_t MiB = 1u << 20;
constexpr size_t WS_CTL = 0, CTL_ZERO_BYTES = 1 * MiB;
constexpr size_t WS_SMALL = 1 * MiB;
constexpr size_t WS_KMP   = WS_SMALL;
constexpr size_t WS_DEC   = WS_KMP + 512 * 1024;
constexpr size_t WS_TOPE  = WS_DEC + 512 * 1024;
constexpr size_t WS_WTS   = WS_TOPE + 256 * 1024;
constexpr size_t WS_SLOT  = WS_WTS + 256 * 1024;
constexpr size_t WS_DEST  = WS_SLOT + 256 * 1024;
constexpr size_t WS_ROWTOK = WS_DEST + 256 * 1024;
constexpr size_t WS_RSTDS = WS_ROWTOK + 320 * 1024;
constexpr size_t WS_RSTD  = WS_RSTDS + 320 * 1024;
constexpr size_t WS_TILEE = WS_RSTD + 64 * 1024;
constexpr size_t WS_WALT  = WS_TILEE + 4 * 1024;
constexpr size_t WS_WRF   = WS_WALT + 32 * 1024;
static_assert(WS_WRF + 128 * 1024 <= 6 * MiB, "small map");
constexpr size_t WS_WO = 6 * MiB, WS_WPG = 8 * MiB, WS_WPP = 10 * MiB, WS_WUP = 12 * MiB, WS_WIN = 16 * MiB;
constexpr size_t WS_PB = 34 * MiB;
constexpr size_t WS_H  = 42 * MiB;
constexpr size_t WS_PROJ = 74 * MiB;
constexpr size_t WS_QG = 362 * MiB, WS_KG = 378 * MiB, WS_KDT = 394 * MiB;
constexpr size_t WS_OAB = 410 * MiB;
constexpr size_t WS_Y = 474 * MiB;
constexpr size_t WS_W2T = 74 * MiB;
constexpr size_t WS_HMID = 138 * MiB;
constexpr size_t WS_W1T = 282 * MiB;
constexpr size_t WS_YROWS = 282 * MiB;
constexpr size_t WS_PGATE = 74 * MiB, WS_PPROJ = 106 * MiB;
constexpr size_t WS_END = 506 * MiB;

constexpr int CW_BAR = 4096;
constexpr int CW_COUNTS = 16384;
constexpr int CW_QUEUE = 16384 + 64;

constexpr int RING_BYTES = 131072;
constexpr int LDSCTL_OFF = RING_BYTES, MISC_OFF = LDSCTL_OFF + 320;
constexpr int LDS_BYTES = 147456;

typedef __bf16 bf16v2_t __attribute__((ext_vector_type(2)));
__device__ __forceinline__ unsigned cvt_pk_bf16(float lo, float hi) { const f32x2 v = {lo, hi}; return __builtin_bit_cast(unsigned, __builtin_convertvector(v, bf16v2_t)); }
__device__ __forceinline__ float bf2f(unsigned short s) { return __uint_as_float(((unsigned)s) << 16); }
__device__ __forceinline__ float bflo(unsigned w) { return __uint_as_float(w << 16); }
__device__ __forceinline__ float bfhi(unsigned w) { return __uint_as_float(w & 0xffff0000u); }
__device__ __forceinline__ float fsigmoid(float x) { return __builtin_amdgcn_rcpf(1.0f + __builtin_amdgcn_exp2f(-1.4426950408889634f * x)); }
__device__ __forceinline__ float wave_sum(float v) {
#pragma unroll
    for (int o = 1; o < 64; o <<= 1) v += __shfl_xor(v, o);
    return v;
}
__device__ __forceinline__ bf16x8 pack8(f32x4 a, f32x4 b) {
    u32x4 w = {cvt_pk_bf16(a[0], a[1]), cvt_pk_bf16(a[2], a[3]), cvt_pk_bf16(b[0], b[1]), cvt_pk_bf16(b[2], b[3])};
    return __builtin_bit_cast(bf16x8, w);
}

#define XB_TMO      128
#define XB_XCNT(j)  (256  + 64 * (j))
#define XB_XSUB(j)  (1280 + 64 * (j))
#define XB_XGEN(j)  (2304 + 64 * (j))
#define XB_TOP      3328
#define XB_TOPGEN   3392
#define XCD_BAR_WORDS 3456
#define XB_SPIN_CAP (1u << 18)

__device__ __forceinline__ unsigned xb_ld(unsigned* p)              { return __hip_atomic_load(p, __ATOMIC_RELAXED, __HIP_MEMORY_SCOPE_AGENT); }
__device__ __forceinline__ unsigned xb_add(unsigned* p, unsigned v) { return __hip_atomic_fetch_add(p, v, __ATOMIC_RELAXED, __HIP_MEMORY_SCOPE_AGENT); }
__device__ __forceinline__ unsigned xb_xcc_id() { return (unsigned)__builtin_amdgcn_s_getreg((3 << 11) | 20) & 0xFu; }
#define XB_SPIN(cond, bar) do { unsigned _sp = 0; while (cond) { __builtin_amdgcn_s_sleep(1); \
    if ((++_sp & 255u) == 0u) { if (xb_ld(&(bar)[XB_TMO])) break; if (_sp > XB_SPIN_CAP) { atomicAdd(&(bar)[XB_TMO], 1u); break; } } } } while (0)

struct XcdBarrier { unsigned* bar; unsigned x; volatile LAS unsigned* st; };

__device__ __forceinline__ XcdBarrier xcd_barrier_post(unsigned* bar, volatile LAS unsigned* st) {
    XcdBarrier b; b.bar = bar; b.x = xb_xcc_id(); b.st = st;
    if (threadIdx.x == 0) (void)xb_add(&bar[XB_XCNT(b.x)], 1u);
    return b;
}
__device__ __forceinline__ void xcd_barrier_complete(unsigned* bar, unsigned x, unsigned& nloc, unsigned& nx) {
    const unsigned G = gridDim.x * gridDim.y * gridDim.z;
    unsigned sum, cnt, mine, sp = 0u;
    for (;;) {
        sum = 0u; cnt = 0u; mine = 0u;
#pragma unroll
        for (unsigned j = 0; j < 16; ++j) { const unsigned c = xb_ld(&bar[XB_XCNT(j)]); sum += c; cnt += (c > 0u) ? 1u : 0u; mine = (j == x) ? c : mine; }
        if (sum == G) break;
        __builtin_amdgcn_s_sleep(1);
        if ((++sp & 255u) == 0u) { if (xb_ld(&bar[XB_TMO])) break; if (sp > XB_SPIN_CAP) { atomicAdd(&bar[XB_TMO], 1u); break; } }
    }
    nloc = mine > 0u ? mine : 1u; nx = cnt > 0u ? cnt : 1u;
}
__device__ __forceinline__ void xcd_barrier(const XcdBarrier& b) {
    asm volatile("s_waitcnt vmcnt(0)" ::: "memory");
    __syncthreads();
    if (threadIdx.x == 0) {
        unsigned* bar = b.bar;
        __builtin_amdgcn_s_waitcnt(0);
        unsigned nloc = b.st[0], nx = b.st[1];
        if (nloc == 0u) { xcd_barrier_complete(bar, b.x, nloc, nx); b.st[0] = nloc; b.st[1] = nx; }
        const unsigned old = xb_add(&bar[XB_XSUB(b.x)], 1u);
        const unsigned gen = old / nloc;
        if (old + 1u == (gen + 1u) * nloc) {
            __builtin_amdgcn_fence(__ATOMIC_RELEASE, "agent");
            asm volatile("s_waitcnt vmcnt(0)" ::: "memory");
            const unsigned og = xb_add(&bar[XB_TOP], 1u);
            const unsigned tg = og / nx;
            if (og + 1u == (tg + 1u) * nx) xb_add(&bar[XB_TOPGEN], 1u);
            else XB_SPIN(xb_ld(&bar[XB_TOPGEN]) == tg, bar);
            __builtin_amdgcn_fence(__ATOMIC_ACQUIRE, "agent");
            xb_add(&bar[XB_XGEN(b.x)], 1u);
            asm volatile("s_waitcnt vmcnt(0)" ::: "memory");
        } else {
            XB_SPIN(xb_ld(&bar[XB_XGEN(b.x)]) == gen, bar);
            __builtin_amdgcn_fence(__ATOMIC_ACQUIRE, "agent");
            asm volatile("s_waitcnt vmcnt(0)" ::: "memory");
        }
    }
    __syncthreads();
}
namespace pg8 {
constexpr int BM = 256, BK = 64, HALF = 128, HTB = HALF * BK * 2, STAGE_BYTES = 8 * HTB, NXCD = 8, WGM = 8;

__host__ __device__ __forceinline__ int lds_byte(int r, int c) { const int st = (r >> 4) * 2 + (c >> 5), rr = r & 15, cc = c & 31, ob = rr * 64 + cc * 2; return st * 1024 + (ob ^ (((ob >> 9) & 1) << 5)); }
__host__ __device__ __forceinline__ void stage_rc(int b, int& R, int& C) { const int st = b / 1024, sb = b % 1024, swz = sb ^ (((sb >> 9) & 1) << 5); R = (st >> 1) * 16 + swz / 64; C = (st & 1) * 32 + (swz % 64) / 2; }
__host__ __device__ __forceinline__ int perm32(int rho) { const int n = rho >> 4, i = rho & 15; return 8 * (i >> 2) + 4 * n + (i & 3); }

struct Unit { int pm, pn, e; };

struct TileOrder {
    int nM, nN, nwg, G, c;
    __device__ __forceinline__ void init(int nM_, int nN_, int G_, int c_) { nM = nM_; nN = nN_; nwg = nM * nN; G = G_; c = c_; }
    __device__ __forceinline__ bool next(int i, int& pm, int& pn) const {
        const long L = (long)i * G + c; if (L >= nwg) return false;
        int wgid = (int)L; { const int q = nwg / NXCD, r = nwg % NXCD, xcd = wgid % NXCD, off = wgid / NXCD; wgid = (xcd < r ? xcd * (q + 1) : r * (q + 1) + (xcd - r) * q) + off; }
        const int nig = WGM * nN, gid = wgid / nig, fm = gid * WGM, gsz = (nM - fm) < WGM ? (nM - fm) : WGM;
        pm = fm + ((wgid % nig) % gsz); pn = (wgid % nig) / gsz; return true;
    }
};
struct DenseSched {
    TileOrder o; const char* Bt; int K;
    __device__ __forceinline__ bool next(int i, Unit& u) const { u.e = 0; return o.next(i, u.pm, u.pn); }
    __device__ __forceinline__ unsigned a_row(const Unit& u, int r) const { return (unsigned)(u.pm * BM + r); }
    __device__ __forceinline__ unsigned a_koff(const Unit&) const { return 0u; }
    __device__ __forceinline__ const char* b_base(const Unit& u) const { return Bt + (size_t)u.pn * BM * K * 2; }
};
struct ChainSched {
    TileOrder o; const char* Bt; int K;
    __device__ __forceinline__ bool next(int i, Unit& u) const { if (!o.next(i >> 1, u.pm, u.pn)) return false; u.e = i & 1; return true; }
    __device__ __forceinline__ unsigned a_row(const Unit& u, int r) const { return (unsigned)(u.pm * BM + r); }
    __device__ __forceinline__ unsigned a_koff(const Unit& u) const { return (unsigned)(u.e * K * 2); }
    __device__ __forceinline__ const char* b_base(const Unit& u) const { return Bt + (size_t)u.pn * BM * (2 * K) * 2 + (size_t)u.e * K * 2; }
};
template <bool GATHER> struct MoeSched {
    TileOrder o; const char* Bt; int K; int rows_per_e; const int* tile_e; const int* row_tok;
    __device__ __forceinline__ bool next(int i, Unit& u) const { if (!o.next(i, u.pm, u.pn)) return false; u.e = __builtin_amdgcn_readfirstlane(tile_e[u.pm]); return true; }
    __device__ __forceinline__ unsigned a_row(const Unit& u, int r) const { if (GATHER) return (unsigned)row_tok[u.pm * BM + r]; else return (unsigned)(u.pm * BM + r); }
    __device__ __forceinline__ unsigned a_koff(const Unit&) const { return 0u; }
    __device__ __forceinline__ const char* b_base(const Unit& u) const { return Bt + ((size_t)u.e * rows_per_e + (size_t)u.pn * BM) * K * 2; }
};

template <class Epi, class Sched>
__device__ __forceinline__ void gemm_phase(LAS unsigned char* lds, const char* gA, int K_, int lda, int ldb, const Sched& S, const Epi& E) {
    int K = K_; asm volatile("" : "+s"(K));
    int tid = threadIdx.x; asm volatile("" : "+v"(tid));     const int wid = __builtin_amdgcn_readfirstlane(tid >> 6), lane = tid & 63, wr = wid >> 2, wc = wid & 3, fr = lane & 15, fq = lane >> 4;
    const int nt = K / BK;
    unsigned voffB[2];
#pragma unroll
    for (int i = 0; i < 2; ++i) { int R, C; stage_rc(tid * 16 + i * 8192, R, C); const int Rb = Epi::PERM ? ((R & ~31) + perm32(R & 31)) : R; voffB[i] = (unsigned)(Rb * ldb + C) * 2u; }
    const unsigned kstep = (unsigned)(BK * 2);
    const size_t hstepB = (size_t)HALF * ldb * 2;
    const unsigned ldab = (unsigned)lda * 2u;
    const unsigned ldsw = (unsigned)wid * 1024u;
    const int aoff = lds_byte(wr * 64 + fr, fq * 8), boff = lds_byte(wc * 32 + fr, fq * 8);
#define PG8_SA(b, h) (((b) * 2 + (h)) * HTB)
#define PG8_SB(b, h) ((4 + (b) * 2 + (h)) * HTB)
#define PG8_STAGE_B(bufoff, gbase) do { _Pragma("unroll") for (int _i = 0; _i < 2; ++_i) \
        __builtin_amdgcn_global_load_lds((const unsigned*)((const char*)(gbase) + voffB[_i]), (LAS unsigned*)(lds + (bufoff) + ldsw + _i * 8192), 16, 0, 0); } while (0)
#define PG8_STAGE_A(bufoff, o0, o1, kb) do { \
        __builtin_amdgcn_global_load_lds((const unsigned*)(gA + (size_t)(o0) + (kb)), (LAS unsigned*)(lds + (bufoff) + ldsw), 16, 0, 0); \
        __builtin_amdgcn_global_load_lds((const unsigned*)(gA + (size_t)(o1) + (kb)), (LAS unsigned*)(lds + (bufoff) + ldsw + 8192), 16, 0, 0); } while (0)
#define PG8_LDA(dst, b, h) do { _Pragma("unroll") for (int m = 0; m < 4; ++m) _Pragma("unroll") for (int k = 0; k < 2; ++k) dst[m][k] = *(const LAS bf16x8*)(lds + PG8_SA(b, h) + aoff + m * 2048 + k * 1024); } while (0)
#define PG8_LDB(dst, b, h) do { _Pragma("unroll") for (int n = 0; n < 2; ++n) _Pragma("unroll") for (int k = 0; k < 2; ++k) dst[n][k] = *(const LAS bf16x8*)(lds + PG8_SB(b, h) + boff + n * 2048 + k * 1024); } while (0)
#define PG8_MMA(ai, bj, At, Bt) do { __builtin_amdgcn_s_setprio(1); _Pragma("unroll") for (int m = 0; m < 4; ++m) _Pragma("unroll") for (int n = 0; n < 2; ++n) _Pragma("unroll") for (int k = 0; k < 2; ++k) \
        acc[ai][bj][m][n] = __builtin_amdgcn_mfma_f32_16x16x32_bf16(Bt[n][k], At[m][k], acc[ai][bj][m][n], 0, 0, 0); __builtin_amdgcn_s_setprio(0); } while (0)
#define PG8_WAIT_V(n) asm volatile("s_waitcnt vmcnt(" #n ")" ::: "memory")
#define PG8_WAIT_L(n) asm volatile("s_waitcnt lgkmcnt(" #n ")" ::: "memory")
#define PG8_BAR __builtin_amdgcn_s_barrier()
#define PG8_SCHED __builtin_amdgcn_sched_barrier(0)
#define PG8_AOFFS(dst, u) do { _Pragma("unroll") for (int _h = 0; _h < 2; ++_h) _Pragma("unroll") for (int _i = 0; _i < 2; ++_i) { int R_, C_; stage_rc(tid * 16 + _i * 8192, R_, C_); \
        dst[_h][_i] = S.a_row(u, _h * HALF + R_) * ldab + (unsigned)C_ * 2u + S.a_koff(u); } } while (0)
    Unit cur, nxt; int ui = 0;
    if (!S.next(0, cur)) return;
    f32x4 acc[2][2][4][2];
#pragma unroll
    for (int a = 0; a < 2; ++a)
#pragma unroll
        for (int b = 0; b < 2; ++b)
#pragma unroll
            for (int m = 0; m < 4; ++m)
#pragma unroll
                for (int n = 0; n < 2; ++n) acc[a][b][m][n] = (f32x4){0.f, 0.f, 0.f, 0.f};
    bf16x8 At[4][2], B0[2][2], B1[2][2];
    unsigned oc[2][2], on[2][2];
    PG8_AOFFS(oc, cur);
    const char* cB = S.b_base(cur);
    PG8_STAGE_B(PG8_SB(0, 0), cB); PG8_STAGE_B(PG8_SB(0, 1), cB + hstepB); PG8_STAGE_A(PG8_SA(0, 0), oc[0][0], oc[0][1], 0u); PG8_STAGE_A(PG8_SA(0, 1), oc[1][0], oc[1][1], 0u);
    if (wr == 1) PG8_BAR;
    PG8_WAIT_V(2); PG8_BAR;
    PG8_STAGE_B(PG8_SB(1, 0), cB + kstep); PG8_STAGE_A(PG8_SA(1, 0), oc[0][0], oc[0][1], kstep); PG8_STAGE_B(PG8_SB(1, 1), cB + hstepB + kstep);
    PG8_WAIT_V(6); PG8_BAR;
    for (;;) {
        const bool has_next = S.next(ui + 1, nxt);
        const char* nB = has_next ? S.b_base(nxt) : cB;
        if (has_next) { PG8_AOFFS(on, nxt); }
        else {
#pragma unroll
            for (int h = 0; h < 2; ++h)
#pragma unroll
                for (int i = 0; i < 2; ++i) on[h][i] = oc[h][i];
        }
        for (int t = 0; t < nt; t += 2) {
            const bool last = (t == nt - 2);
            const unsigned k1 = (unsigned)(t + 1) * kstep;
            const unsigned k2 = last ? 0u : (unsigned)(t + 2) * kstep, k3 = k2 + kstep;
            const char* b2 = last ? nB : cB + (size_t)(t + 2) * kstep; const char* b3 = b2 + kstep;
            const unsigned o200 = last ? on[0][0] : oc[0][0], o201 = last ? on[0][1] : oc[0][1], o210 = last ? on[1][0] : oc[1][0], o211 = last ? on[1][1] : oc[1][1];
            PG8_LDB(B0, 0, 0); PG8_LDB(B1, 0, 1); PG8_SCHED; PG8_LDA(At, 0, 0); PG8_STAGE_A(PG8_SA(1, 1), oc[1][0], oc[1][1], k1);
            PG8_WAIT_V(8); PG8_WAIT_L(0); PG8_BAR; PG8_MMA(0, 0, At, B0); PG8_MMA(0, 1, At, B1); PG8_BAR; PG8_SCHED;
            PG8_LDA(At, 0, 1); PG8_STAGE_B(PG8_SB(0, 0), b2); PG8_STAGE_B(PG8_SB(0, 1), b2 + hstepB); PG8_STAGE_A(PG8_SA(0, 0), o200, o201, k2);
            PG8_WAIT_V(8); PG8_WAIT_L(0); PG8_BAR; PG8_MMA(1, 0, At, B0); PG8_MMA(1, 1, At, B1); PG8_BAR; PG8_SCHED;
            PG8_LDB(B0, 1, 0); PG8_LDB(B1, 1, 1); PG8_SCHED; PG8_LDA(At, 1, 0); PG8_STAGE_A(PG8_SA(0, 1), o210, o211, k2);
            PG8_WAIT_V(8); PG8_WAIT_L(0); PG8_BAR; PG8_MMA(0, 0, At, B0); PG8_MMA(0, 1, At, B1); PG8_BAR; PG8_SCHED;
            PG8_LDA(At, 1, 1); PG8_STAGE_B(PG8_SB(1, 0), b3); PG8_STAGE_B(PG8_SB(1, 1), b3 + hstepB); PG8_STAGE_A(PG8_SA(1, 0), o200, o201, k3);
            PG8_WAIT_V(8); PG8_WAIT_L(0); PG8_BAR; PG8_MMA(1, 0, At, B0); PG8_MMA(1, 1, At, B1); PG8_BAR; PG8_SCHED;
        }
        if (wr == 0) PG8_BAR;
        bool carry = false;
        if constexpr (Epi::MIDK) { if (cur.e == 0) { E.mid(acc, cur, wr, wc, fr, fq); carry = true; } else E(acc, cur, wr, wc, fr, fq); } else E(acc, cur, wr, wc, fr, fq);
        if (!has_next) break;
        if (!carry)
#pragma unroll
        for (int a = 0; a < 2; ++a)
#pragma unroll
            for (int b = 0; b < 2; ++b)
#pragma unroll
                for (int m = 0; m < 4; ++m)
#pragma unroll
                    for (int n = 0; n < 2; ++n) acc[a][b][m][n] = (f32x4){0.f, 0.f, 0.f, 0.f};
        cur = nxt; cB = nB; ++ui;
#pragma unroll
        for (int h = 0; h < 2; ++h)
#pragma unroll
            for (int i = 0; i < 2; ++i) oc[h][i] = on[h][i];
        if (wr == 1) PG8_BAR;
    }
    PG8_WAIT_V(0);
    PG8_BAR;
#undef PG8_SA
#undef PG8_SB
#undef PG8_STAGE_A
#undef PG8_STAGE_B
#undef PG8_LDA
#undef PG8_LDB
#undef PG8_MMA
#undef PG8_WAIT_V
#undef PG8_WAIT_L
#undef PG8_BAR
#undef PG8_SCHED
#undef PG8_AOFFS
}

struct EpiProj {
    static constexpr bool PERM = true, MIDK = false;
    bf16_t* O; float* kmp;
    __device__ __forceinline__ void operator()(const f32x4 (&acc)[2][2][4][2], const Unit& u, int wr, int wc, int fr, int fq) const {
        const int row0 = u.pm * BM + wr * 64 + fr; const int col0 = u.pn * BM + wc * 32 + 8 * fq;
#pragma unroll
        for (int ai = 0; ai < 2; ++ai)
#pragma unroll
            for (int m = 0; m < 4; ++m) { bf16_t* rowp = O + (size_t)(row0 + ai * HALF + m * 16) * NPROJ + col0;
#pragma unroll
                for (int bj = 0; bj < 2; ++bj) { const f32x4 v0 = acc[ai][bj][m][0], v1 = acc[ai][bj][m][1];
                    u32x4 w; w.x = cvt_pk_bf16(v0[0], v0[1]); w.y = cvt_pk_bf16(v0[2], v0[3]); w.z = cvt_pk_bf16(v1[0], v1[1]); w.w = cvt_pk_bf16(v1[2], v1[3]);
                    *(u32x4*)(rowp + bj * HALF) = w; } }
        if (u.pn >= C_KB / BM && u.pn < C_VB / BM) {
#pragma unroll
            for (int bj = 0; bj < 2; ++bj)
#pragma unroll
                for (int n = 0; n < 2; ++n) { f32x4 s = (f32x4){0.f, 0.f, 0.f, 0.f};
#pragma unroll
                    for (int ai = 0; ai < 2; ++ai)
#pragma unroll
                        for (int m = 0; m < 4; ++m) s += acc[ai][bj][m][n];
#pragma unroll
                    for (int o = 1; o < 16; o <<= 1) { s[0] += __shfl_xor(s[0], o); s[1] += __shfl_xor(s[1], o); s[2] += __shfl_xor(s[2], o); s[3] += __shfl_xor(s[3], o); }
                    if (fr == 0) *(f32x4*)(kmp + ((size_t)wr * 64 + u.pm) * 1024 + (u.pn - C_KB / BM) * BM + bj * HALF + wc * 32 + 8 * fq + 4 * n) = s; }
        }
    }
};
struct EpiMerge {
    static constexpr bool PERM = true, MIDK = true;
    const bf16_t* proj; bf16_t* Y;
    __device__ __forceinline__ void mid(f32x4 (&acc)[2][2][4][2], const Unit& u, int wr, int wc, int fr, int fq) const {
        const int row0 = u.pm * BM + wr * 64 + fr; const int col0 = u.pn * BM + wc * 32 + 8 * fq;
#pragma unroll
        for (int ai = 0; ai < 2; ++ai)
#pragma unroll
            for (int m = 0; m < 4; ++m) { const bf16_t* rowp = proj + (size_t)(row0 + ai * HALF + m * 16) * NPROJ + col0;
#pragma unroll
                for (int bj = 0; bj < 2; ++bj) { const u32x4 ga = *(const u32x4*)(rowp + C_GA + bj * HALF), gb = *(const u32x4*)(rowp + C_GB + bj * HALF);
#pragma unroll
                    for (int j = 0; j < 4; ++j) { const float a0 = bflo(ga[j]), a1 = bfhi(ga[j]), b0 = bflo(gb[j]), b1 = bfhi(gb[j]);
                        const float r0 = (1.0f + __builtin_amdgcn_exp2f(-1.4426950408889634f * b0)) * __builtin_amdgcn_rcpf(1.0f + __builtin_amdgcn_exp2f(-1.4426950408889634f * a0));
                        const float r1 = (1.0f + __builtin_amdgcn_exp2f(-1.4426950408889634f * b1)) * __builtin_amdgcn_rcpf(1.0f + __builtin_amdgcn_exp2f(-1.4426950408889634f * a1));
                        acc[ai][bj][m][j >> 1][(j & 1) * 2] *= r0; acc[ai][bj][m][j >> 1][(j & 1) * 2 + 1] *= r1; } }
                asm volatile("" : "+v"(acc[ai][0][m][0]), "+v"(acc[ai][0][m][1]), "+v"(acc[ai][1][m][0]), "+v"(acc[ai][1][m][1]));
                asm volatile("" ::: "memory"); }
    }
    __device__ __forceinline__ void operator()(const f32x4 (&acc)[2][2][4][2], const Unit& u, int wr, int wc, int fr, int fq) const {
        const int row0 = u.pm * BM + wr * 64 + fr; const int col0 = u.pn * BM + wc * 32 + 8 * fq;
#pragma unroll
        for (int ai = 0; ai < 2; ++ai)
#pragma unroll
            for (int m = 0; m < 4; ++m) { const size_t r = (size_t)(row0 + ai * HALF + m * 16);
#pragma unroll
                for (int bj = 0; bj < 2; ++bj) { const u32x4 gb = *(const u32x4*)(proj + r * NPROJ + C_GB + col0 + bj * HALF);
                    const f32x4 v0 = acc[ai][bj][m][0], v1 = acc[ai][bj][m][1];
                    u32x4 w; w.x = cvt_pk_bf16(v0[0] * fsigmoid(bflo(gb[0])), v0[1] * fsigmoid(bfhi(gb[0]))); w.y = cvt_pk_bf16(v0[2] * fsigmoid(bflo(gb[1])), v0[3] * fsigmoid(bfhi(gb[1])));
                    w.z = cvt_pk_bf16(v1[0] * fsigmoid(bflo(gb[2])), v1[1] * fsigmoid(bfhi(gb[2]))); w.w = cvt_pk_bf16(v1[2] * fsigmoid(bflo(gb[3])), v1[3] * fsigmoid(bfhi(gb[3])));
                    *(u32x4*)(Y + r * D + col0 + bj * HALF) = w; }
                asm volatile("" ::: "memory"); }
    }
};
struct EpiResF32 {
    static constexpr bool PERM = false, MIDK = false;
    const float* base; float* out;
    __device__ __forceinline__ void operator()(const f32x4 (&acc)[2][2][4][2], const Unit& u, int wr, int wc, int fr, int fq) const {
        const int row0 = u.pm * BM + wr * 64 + fr, col0 = u.pn * BM + wc * 32 + 4 * fq;
#pragma unroll
        for (int ai = 0; ai < 2; ++ai)
#pragma unroll
            for (int m = 0; m < 4; ++m) { const size_t off = (size_t)(row0 + ai * HALF + m * 16) * D + col0;
#pragma unroll
                for (int bj = 0; bj < 2; ++bj)
#pragma unroll
                    for (int n = 0; n < 2; ++n) *(f32x4*)(out + off + bj * HALF + n * 16) = *(const f32x4*)(base + off + bj * HALF + n * 16) + acc[ai][bj][m][n];
                asm volatile("" ::: "memory"); }
    }
};
struct EpiGlu {
    static constexpr bool PERM = true, MIDK = false;
    bf16_t* H; const float* rstd_s; const float* bg; const float* bu;
    __device__ __forceinline__ void operator()(const f32x4 (&acc)[2][2][4][2], const Unit& u, int wr, int wc, int fr, int fq) const {
        const int row0 = u.pm * BM + wr * 64 + fr; const int colo = u.pn * HALF + wc * 32 + 8 * fq;
        f32x4 g4[2], u4[2];
#pragma unroll
        for (int n = 0; n < 2; ++n) { g4[n] = *(const f32x4*)(bg + (size_t)u.e * FF + colo + 4 * n); u4[n] = *(const f32x4*)(bu + (size_t)u.e * FF + colo + 4 * n); }
#pragma unroll
        for (int ai = 0; ai < 2; ++ai)
#pragma unroll
            for (int m = 0; m < 4; ++m) { const int r = row0 + ai * HALF + m * 16; const float rs = rstd_s[r];
                float o[8];
#pragma unroll
                for (int n = 0; n < 2; ++n)
#pragma unroll
                    for (int j = 0; j < 4; ++j) { float g = acc[ai][0][m][n][j] * rs + g4[n][j], up = acc[ai][1][m][n][j] * rs + u4[n][j];
                        g = fminf(g, 7.0f); up = fminf(fmaxf(up, -7.0f), 7.0f);
                        const float glu = g * fsigmoid(1.702f * g); o[n * 4 + j] = (up + 1.0f) * glu; }
                u32x4 w; w.x = cvt_pk_bf16(o[0], o[1]); w.y = cvt_pk_bf16(o[2], o[3]); w.z = cvt_pk_bf16(o[4], o[5]); w.w = cvt_pk_bf16(o[6], o[7]);
                *(u32x4*)(H + (size_t)r * FF + colo) = w; asm volatile("" ::: "memory"); }
    }
};
template <int ACT, bool HASBIAS> struct EpiBf16 {
    static constexpr bool PERM = true, MIDK = false;
    bf16_t* O; int ldc; const float* bias; int bias_stride;
    __device__ __forceinline__ void operator()(const f32x4 (&acc)[2][2][4][2], const Unit& u, int wr, int wc, int fr, int fq) const {
        const int row0 = u.pm * BM + wr * 64 + fr; const int col0 = u.pn * BM + wc * 32 + 8 * fq;
        f32x4 bv[2][2];
#pragma unroll
        for (int bj = 0; bj < 2; ++bj)
#pragma unroll
            for (int n = 0; n < 2; ++n) bv[bj][n] = HASBIAS ? *(const f32x4*)(bias + (size_t)u.e * bias_stride + col0 + bj * HALF + 4 * n) : (f32x4){0.f, 0.f, 0.f, 0.f};
#pragma unroll
        for (int ai = 0; ai < 2; ++ai)
#pragma unroll
            for (int m = 0; m < 4; ++m) { bf16_t* rowp = O + (size_t)(row0 + ai * HALF + m * 16) * ldc + col0;
#pragma unroll
                for (int bj = 0; bj < 2; ++bj) { f32x4 v0 = acc[ai][bj][m][0] + bv[bj][0], v1 = acc[ai][bj][m][1] + bv[bj][1];
                    if (ACT == 1) {
#pragma unroll
                        for (int j = 0; j < 4; ++j) { v0[j] = fsigmoid(v0[j]); v1[j] = fsigmoid(v1[j]); } }
                    u32x4 w; w.x = cvt_pk_bf16(v0[0], v0[1]); w.y = cvt_pk_bf16(v0[2], v0[3]); w.z = cvt_pk_bf16(v1[0], v1[1]); w.w = cvt_pk_bf16(v1[2], v1[3]);
                    *(u32x4*)(rowp + bj * HALF) = w; }
                asm volatile("" ::: "memory"); }
    }
};
}
__device__ __forceinline__ void transpose_item(const float* __restrict__ W, int ldw, int k0, int n_src0, bf16_t* __restrict__ WT, int ldo, int n_dst0, int k_off, LAS float* scr, int lane) {
#pragma unroll 8
    for (int i = 0; i < 32; ++i) { const int kk = 2 * i + (lane >> 5); scr[kk * 33 + (lane & 31)] = W[(size_t)(k0 + kk) * ldw + n_src0 + (lane & 31)]; }
    LDS_WAIT(); asm volatile("" ::: "memory");
    const int c = lane & 7;
#pragma unroll
    for (int j = 0; j < 4; ++j) { const int n = (lane >> 3) + 8 * j; const LAS float* s = scr + (8 * c) * 33 + n;
        u32x4 o; o.x = cvt_pk_bf16(s[0 * 33], s[1 * 33]); o.y = cvt_pk_bf16(s[2 * 33], s[3 * 33]); o.z = cvt_pk_bf16(s[4 * 33], s[5 * 33]); o.w = cvt_pk_bf16(s[6 * 33], s[7 * 33]);
        *(u32x4*)(WT + (size_t)(n_dst0 + n) * ldo + k_off + k0 + 8 * c) = o; }
    LDS_WAIT(); asm volatile("" ::: "memory");
}
__device__ __forceinline__ void transpose_mat_item(const float* W, int ldw, int N, int n_src_base, bf16_t* WT, int ldo, int n_dst_base, int k_off, LAS float* scr, int item, int lane) {
    const int nblk = N / 32, kb = item / nblk, nb = item % nblk;
    transpose_item(W, ldw, 64 * kb, n_src_base + 32 * nb, WT, ldo, n_dst_base + 32 * nb, k_off, scr, lane);
}

struct P {
    const float* in[25]; float* out; unsigned char* ws;
};

__device__ __forceinline__ void p0_prologue(const P& a, LAS unsigned char* lds, int vcu, int G, int wave, int lane) {
    LAS float* scr = (LAS float*)(lds + wave * 16384);
    const int gw = vcu * NWAVES + wave, NGW = G * NWAVES;
    unsigned char* ws = a.ws;
    bf16_t* WinT = (bf16_t*)(ws + WS_WIN); bf16_t* WupT = (bf16_t*)(ws + WS_WUP); bf16_t* WoT = (bf16_t*)(ws + WS_WO); bf16_t* WpgT = (bf16_t*)(ws + WS_WPG); bf16_t* WppT = (bf16_t*)(ws + WS_WPP);
    constexpr int I_A = 16 * 96, I_B = 16 * 160, I_S = 16 * 32, I_P = 4 * 32;
    constexpr int NITEMS = I_A + I_B + 4 * I_S + I_P;
#ifndef P0_PARTS
#define P0_PARTS 63
#endif
    if (P0_PARTS & 1)
    for (int it = gw; it < NITEMS; it += NGW) {
        int r = it;
        if (r < I_A) { transpose_mat_item(a.in[4], D_IN, 3072, 0, WinT, D, 0, 0, scr, r, lane); continue; } r -= I_A;
        if (r < I_B) { transpose_mat_item(a.in[4], D_IN, 5120, 3088, WinT, D, 3072, 0, scr, r, lane); continue; } r -= I_B;
        if (r < I_S) { transpose_mat_item(a.in[8], D, D, 0, WupT, 2048, 0, 0, scr, r, lane); continue; } r -= I_S;
        if (r < I_S) { transpose_mat_item(a.in[9], D, D, 0, WupT, 2048, 0, 1024, scr, r, lane); continue; } r -= I_S;
        if (r < I_S) { transpose_mat_item(a.in[10], D, D, 0, WoT, D, 0, 0, scr, r, lane); continue; } r -= I_S;
        if (r < I_S) { transpose_mat_item(a.in[21], D, D, 0, WpgT, D, 0, 0, scr, r, lane); continue; } r -= I_S;
        transpose_mat_item(a.in[22], D, D, 0, WppT, 256, 0, 0, scr, r, lane);
    }
    if (P0_PARTS & 2) {
        const float* x = a.in[0]; const float* g = a.in[3]; bf16_t* H = (bf16_t*)(ws + WS_H);
        f32x4 gv[4];
#pragma unroll
        for (int j = 0; j < 4; ++j) gv[j] = *((const f32x4*)g + lane + 64 * j);
        for (int m = gw; m < T; m += NGW) {
            const f32x4* xr = (const f32x4*)(x + (size_t)m * D) + lane; f32x4 v[4]; float s = 0.f;
#pragma unroll
            for (int j = 0; j < 4; ++j) { v[j] = xr[64 * j]; s += (v[j].x * v[j].x + v[j].y * v[j].y) + (v[j].z * v[j].z + v[j].w * v[j].w); }
            const float rstd = 1.0f / sqrtf(wave_sum(s) * (1.0f / D) + EPS);
            u32x2* o8 = (u32x2*)(H + (size_t)m * D) + lane;
#pragma unroll
            for (int j = 0; j < 4; ++j) { u32x2 w; w.x = cvt_pk_bf16(v[j].x * rstd * gv[j].x, v[j].y * rstd * gv[j].y); w.y = cvt_pk_bf16(v[j].z * rstd * gv[j].z, v[j].w * rstd * gv[j].w); o8[64 * j] = w; }
        }
    }
    if (P0_PARTS & 4) {
        const f32x4* p4 = (const f32x4*)a.in[1]; u32x2* pb = (u32x2*)(ws + WS_PB);
        const size_t n4 = (size_t)T * 256 / 4;
        for (size_t i = (size_t)gw * 64 + lane; i < n4; i += (size_t)NGW * 64) { const f32x4 v = p4[i]; u32x2 w; w.x = cvt_pk_bf16(v.x, v.y); w.y = cvt_pk_bf16(v.z, v.w); pb[i] = w; }
    }
    if (P0_PARTS & 8) {
        const int gt = (vcu * NWAVES + wave) * 64 + lane;
        if ((P0_PARTS & 16) && gt < 16 * 1024) { const int n = gt >> 10, k = gt & 1023; ((bf16_t*)(ws + WS_WALT))[n * 1024 + k] = (bf16_t)(cvt_pk_bf16(a.in[4][(size_t)k * D_IN + SRC_ALOW + n], 0.f) & 0xffffu); }
        if ((P0_PARTS & 32) && gt < 4096) { const int s = gt >> 6, l = gt & 63, e = l & 31, hh = l >> 5; const float* wr = a.in[12];
            float v[8], lo[8];
#pragma unroll
            for (int j = 0; j < 8; ++j) { v[j] = wr[(size_t)(16 * s + 8 * hh + j) * NE + e]; }
            u32x4 whi; whi.x = cvt_pk_bf16(v[0], v[1]); whi.y = cvt_pk_bf16(v[2], v[3]); whi.z = cvt_pk_bf16(v[4], v[5]); whi.w = cvt_pk_bf16(v[6], v[7]);
#pragma unroll
            for (int j = 0; j < 4; ++j) { lo[2 * j] = v[2 * j] - bflo(whi[j]); lo[2 * j + 1] = v[2 * j + 1] - bfhi(whi[j]); }
            u32x4 wlo; wlo.x = cvt_pk_bf16(lo[0], lo[1]); wlo.y = cvt_pk_bf16(lo[2], lo[3]); wlo.z = cvt_pk_bf16(lo[4], lo[5]); wlo.w = cvt_pk_bf16(lo[6], lo[7]);
            u32x4* f = (u32x4*)(ws + WS_WRF); f[gt] = whi; f[4096 + gt] = wlo; }
    }
}

__device__ __forceinline__ void expert_convert(const P& a, LAS unsigned char* lds, int vcu, int G, int wave, int lane) {
    LAS float* scr = (LAS float*)(lds + wave * 16384);
    const int gw = vcu * NWAVES + wave, NGW = G * NWAVES;
    bf16_t* W1T = (bf16_t*)(a.ws + WS_W1T); bf16_t* W2T = (bf16_t*)(a.ws + WS_W2T);
    constexpr int IPM = 16 * 32;
    for (int it = gw; it < NE * 3 * IPM; it += NGW) {
        const int e = it / (3 * IPM), r0 = it % (3 * IPM), which = r0 / IPM, r = r0 % IPM, kb = r / 32, nb = r % 32;
        if (which < 2) { const float* W = a.in[which == 0 ? 14 : 16] + (size_t)e * D * FF; const int n0 = 32 * nb;
            transpose_item(W, FF, 64 * kb, n0, W1T + (size_t)e * 2048 * D, D, (n0 >> 7) * 256 + (n0 & 127) + which * 128, 0, scr, lane); }
        else { const float* W = a.in[18] + (size_t)e * FF * D; transpose_item(W, D, 64 * kb, 32 * nb, W2T + (size_t)e * D * FF, FF, 32 * nb, 0, scr, lane); }
    }
}

__device__ __forceinline__ float logsigmoidf_(float x) { return fminf(x, 0.0f) - log1pf(expf(-fabsf(x))); }
__device__ __forceinline__ void gla_prep_unit(const P& a, LAS unsigned char* lds, int unit) {
    int tid = threadIdx.x; asm volatile("" : "+v"(tid));     const int wave = __builtin_amdgcn_readfirstlane(tid >> 6), lane = tid & 63;
    const int b = unit >> 5, chunk = unit & 31, tok0 = b * SEQ + chunk * 64;
    const bf16_t* H = (const bf16_t*)(a.ws + WS_H); const bf16_t* WalT = (const bf16_t*)(a.ws + WS_WALT); const bf16_t* proj = (const bf16_t*)(a.ws + WS_PROJ);
    LAS float* part = (LAS float*)lds;
    LAS float* alow = (LAS float*)(lds + 8192);
    LAS float* seg = (LAS float*)(lds + 12288);
    {
        const int rg = wave & 3, kh = wave >> 2, r = lane & 15, q = lane >> 4;
        f32x4 acc = (f32x4){0.f, 0.f, 0.f, 0.f};
        const bf16_t* ap = H + (size_t)(tok0 + 16 * rg + r) * D + 512 * kh + 8 * q; const bf16_t* bp = WalT + (size_t)r * D + 512 * kh + 8 * q;
#pragma unroll 4
        for (int s = 0; s < 16; ++s) { const bf16x8 av = *(const bf16x8*)(ap + 32 * s), bv = *(const bf16x8*)(bp + 32 * s); acc = __builtin_amdgcn_mfma_f32_16x16x32_bf16(bv, av, acc, 0, 0, 0); }
        *(LAS f32x4*)(part + (kh * 64 + 16 * rg + r) * 16 + 4 * q) = acc;
    }
    __syncthreads();
    if (tid < 256) { *(LAS f32x4*)(alow + tid * 4) = *(LAS f32x4*)(part + tid * 4) + *(LAS f32x4*)(part + 1024 + tid * 4); }
    __syncthreads();
    const int dp = tid & 63, tq = wave;
    const float* w_a2 = a.in[5]; const float* b_a2 = a.in[6];
    for (int h = 0; h < 4; ++h) {
        const int dcol = h * 128 + 2 * dp;
        f32x2 w2[16];
#pragma unroll
        for (int r = 0; r < 16; ++r) w2[r] = *(const f32x2*)(w_a2 + r * 512 + dcol);
        const f32x2 b2 = *(const f32x2*)(b_a2 + dcol);
        unsigned qv[8], kv[8];
#pragma unroll
        for (int i = 0; i < 8; ++i) { const bf16_t* rp = proj + (size_t)(tok0 + 8 * tq + i) * NPROJ + dcol; qv[i] = *(const unsigned*)(rp + C_QA); kv[i] = *(const unsigned*)(rp + C_KA); }
        float G0[8], G1[8]; float r0 = 0.f, r1 = 0.f;
#pragma unroll
        for (int i = 0; i < 8; ++i) { const LAS f32x4* al4 = (const LAS f32x4*)(alow + (8 * tq + i) * 16); float x0 = b2.x, x1 = b2.y;
#pragma unroll
            for (int r4 = 0; r4 < 4; ++r4) { const f32x4 al = al4[r4];
#pragma unroll
                for (int j = 0; j < 4; ++j) { x0 += al[j] * w2[4 * r4 + j].x; x1 += al[j] * w2[4 * r4 + j].y; } }
            r0 += logsigmoidf_(x0) * (1.0f / 16.0f); r1 += logsigmoidf_(x1) * (1.0f / 16.0f); G0[i] = r0; G1[i] = r1; }
        *(LAS f32x2*)(seg + tq * 128 + 2 * dp) = (f32x2){r0, r1};
        __syncthreads();
        float off0 = 0.f, off1 = 0.f, tot0 = 0.f, tot1 = 0.f;
#pragma unroll
        for (int q = 0; q < 8; ++q) { const f32x2 s = *(LAS f32x2*)(seg + q * 128 + 2 * dp); tot0 += s.x; tot1 += s.y; if (q < tq) { off0 += s.x; off1 += s.y; } }
        const size_t tile = (size_t)((b * 4 + h) * 32 + chunk);
        bf16_t* Qg = (bf16_t*)(a.ws + WS_QG) + tile * 8192; bf16_t* Kg = (bf16_t*)(a.ws + WS_KG) + tile * 8192; bf16_t* KdT = (bf16_t*)(a.ws + WS_KDT) + tile * 8192;
        float kd0[8], kd1[8];
#pragma unroll
        for (int i = 0; i < 8; ++i) { const float g0 = G0[i] + off0, g1 = G1[i] + off1; const float q0 = bflo(qv[i]), q1 = bfhi(qv[i]), k0 = bflo(kv[i]), k1 = bfhi(kv[i]);
            const float e0 = expf(g0), e1 = expf(g1);
            *(unsigned*)(Qg + (8 * tq + i) * 128 + 2 * dp) = cvt_pk_bf16(q0 * e0 * 0.08838834764831845f, q1 * e1 * 0.08838834764831845f);
            *(unsigned*)(Kg + (8 * tq + i) * 128 + 2 * dp) = cvt_pk_bf16(k0 * expf(-g0), k1 * expf(-g1));
            kd0[i] = k0 * expf(tot0 - g0); kd1[i] = k1 * expf(tot1 - g1); }
        u32x4 w0, w1; w0.x = cvt_pk_bf16(kd0[0], kd0[1]); w0.y = cvt_pk_bf16(kd0[2], kd0[3]); w0.z = cvt_pk_bf16(kd0[4], kd0[5]); w0.w = cvt_pk_bf16(kd0[6], kd0[7]);
        w1.x = cvt_pk_bf16(kd1[0], kd1[1]); w1.y = cvt_pk_bf16(kd1[2], kd1[3]); w1.z = cvt_pk_bf16(kd1[4], kd1[5]); w1.w = cvt_pk_bf16(kd1[6], kd1[7]);
        *(u32x4*)(KdT + (2 * dp) * 64 + 8 * tq) = w0; *(u32x4*)(KdT + (2 * dp + 1) * 64 + 8 * tq) = w1;
        if (tq == 0) *(f32x2*)((float*)(a.ws + WS_DEC) + tile * 128 + 2 * dp) = (f32x2){expf(tot0), expf(tot1)};
        __syncthreads();
    }
}

constexpr int GL_QG = 0, GL_KG = 17408, GL_KDT = 34816, GL_VT = 53248, GL_AM = 90112, GL_DEC = 99328, GL_OST = 0;
constexpr int GL_QS = 272, GL_TS = 144, GL_OS = 528;
__device__ __forceinline__ int crow(int r, int hi) { return (r & 3) + 8 * (r >> 2) + 4 * hi; }
__device__ __forceinline__ bf16x8 pack_step(const f32x16& x, int s) {
    u32x4 p; p.x = cvt_pk_bf16(x[8 * s + 0], x[8 * s + 1]); p.y = cvt_pk_bf16(x[8 * s + 2], x[8 * s + 3]); p.z = cvt_pk_bf16(x[8 * s + 4], x[8 * s + 5]); p.w = cvt_pk_bf16(x[8 * s + 6], x[8 * s + 7]);
    return __builtin_bit_cast(bf16x8, p);
}
__device__ __forceinline__ void gla_scan_unit(const P& a, LAS unsigned char* lds, int unit) {
    int tid = threadIdx.x; asm volatile("" : "+v"(tid));     const int w = __builtin_amdgcn_readfirstlane(tid >> 6), lane = tid & 63, c32 = lane & 31, hi = lane >> 5;
    const int b = unit >> 2, h = unit & 3;
    const bf16_t* proj = (const bf16_t*)(a.ws + WS_PROJ); bf16_t* oab = (bf16_t*)(a.ws + WS_OAB);
    const float* ggo = a.in[7];
    f32x16 S[4];
#pragma unroll
    for (int i = 0; i < 4; ++i)
#pragma unroll
        for (int r = 0; r < 16; ++r) S[i][r] = 0.f;
    u32x4 sq[2], sk[2], sd[2]; unsigned sv[16]; float sdec = 0.f;
    const int ep = tid & 127, sq4 = tid >> 7;
#define GL_LOAD(chunk_) do { const size_t tile_ = (size_t)((b * 4 + h) * 32 + (chunk_)); \
        const u32x4* q_ = (const u32x4*)((const bf16_t*)(a.ws + WS_QG) + tile_ * 8192); const u32x4* k_ = (const u32x4*)((const bf16_t*)(a.ws + WS_KG) + tile_ * 8192); const u32x4* d_ = (const u32x4*)((const bf16_t*)(a.ws + WS_KDT) + tile_ * 8192); \
        sq[0] = q_[tid]; sq[1] = q_[tid + 512]; sk[0] = k_[tid]; sk[1] = k_[tid + 512]; sd[0] = d_[tid]; sd[1] = d_[tid + 512]; \
        const bf16_t* v_ = proj + (size_t)(b * SEQ + (chunk_) * 64 + 16 * sq4) * NPROJ + C_VA + h * 256 + 2 * ep; \
        _Pragma("unroll") for (int i_ = 0; i_ < 16; ++i_) sv[i_] = *(const unsigned*)(v_ + (size_t)i_ * NPROJ); \
        if (tid < 128) sdec = ((const float*)(a.ws + WS_DEC))[tile_ * 128 + tid]; } while (0)
    GL_LOAD(0);
    for (int chunk = 0; chunk < 32; ++chunk) {
#pragma unroll
        for (int i = 0; i < 2; ++i) { const int p = tid + 512 * i;
            *(LAS u32x4*)(lds + GL_QG + (p >> 4) * GL_QS + (p & 15) * 16) = sq[i]; *(LAS u32x4*)(lds + GL_KG + (p >> 4) * GL_QS + (p & 15) * 16) = sk[i];
            *(LAS u32x4*)(lds + GL_KDT + (p >> 3) * GL_TS + (p & 7) * 16) = sd[i]; }
        {   u32x4 lo0, lo1, hi0, hi1;
#pragma unroll
            for (int j = 0; j < 4; ++j) { lo0[j] = (sv[2 * j] & 0xffffu) | (sv[2 * j + 1] << 16); lo1[j] = (sv[8 + 2 * j] & 0xffffu) | (sv[8 + 2 * j + 1] << 16);
                hi0[j] = (sv[2 * j] >> 16) | (sv[2 * j + 1] & 0xffff0000u); hi1[j] = (sv[8 + 2 * j] >> 16) | (sv[8 + 2 * j + 1] & 0xffff0000u); }
            LAS unsigned char* v0 = lds + GL_VT + (2 * ep) * GL_TS + sq4 * 32;
            *(LAS u32x4*)(v0) = lo0; *(LAS u32x4*)(v0 + 16) = lo1; *(LAS u32x4*)(v0 + GL_TS) = hi0; *(LAS u32x4*)(v0 + GL_TS + 16) = hi1; }
        if (tid < 128) *(LAS float*)(lds + GL_DEC + tid * 4) = sdec;
        __syncthreads();
        if (chunk + 1 < 32) GL_LOAD(chunk + 1);
        if (w < 3) {
            const int ti = (w + 1) >> 1, si = w >> 1;
            f32x16 A;
#pragma unroll
            for (int r = 0; r < 16; ++r) A[r] = 0.f;
#pragma unroll
            for (int s = 0; s < 8; ++s) { const bf16x8 av = *(const LAS bf16x8*)(lds + GL_QG + (32 * ti + c32) * GL_QS + (16 * s + 8 * hi) * 2), bv = *(const LAS bf16x8*)(lds + GL_KG + (32 * si + c32) * GL_QS + (16 * s + 8 * hi) * 2);
                A = __builtin_amdgcn_mfma_f32_32x32x16_bf16(av, bv, A, 0, 0, 0); }
            const int sidx = 32 * si + c32;
#pragma unroll
            for (int r = 0; r < 16; ++r) { const int t = 32 * ti + crow(r, hi); const float v = (sidx <= t) ? A[r] : 0.f;
                *(LAS bf16_t*)(lds + GL_AM + t * GL_TS + sidx * 2) = (bf16_t)(cvt_pk_bf16(v, 0.f) & 0xffffu); }
        }
        __syncthreads();
        f32x16 o[2];
        {
            bf16x8 vt[4];
#pragma unroll
            for (int ks = 0; ks < 4; ++ks) vt[ks] = *(const LAS bf16x8*)(lds + GL_VT + (32 * w + c32) * GL_TS + (16 * ks + 8 * hi) * 2);
#pragma unroll
            for (int ti = 0; ti < 2; ++ti) {
#pragma unroll
                for (int r = 0; r < 16; ++r) o[ti][r] = 0.f;
#pragma unroll
                for (int tile = 0; tile < 4; ++tile)
#pragma unroll
                    for (int s = 0; s < 2; ++s) { const LAS unsigned char* qp = lds + GL_QG + (32 * ti + c32) * GL_QS + (32 * tile + 16 * s + 4 * hi) * 2;
                        const s16x4 lo = *(const LAS s16x4*)qp, hh = *(const LAS s16x4*)(qp + 16);
                        const bf16x8 aop = __builtin_shufflevector(lo, hh, 0, 1, 2, 3, 4, 5, 6, 7);
                        o[ti] = __builtin_amdgcn_mfma_f32_32x32x16_bf16(aop, pack_step(S[tile], s), o[ti], 0, 0, 0); }
#pragma unroll
                for (int ks = 0; ks < 4; ++ks) { if (ti == 0 && ks >= 2) continue;
                    const bf16x8 av = *(const LAS bf16x8*)(lds + GL_AM + (32 * ti + c32) * GL_TS + (16 * ks + 8 * hi) * 2);
                    o[ti] = __builtin_amdgcn_mfma_f32_32x32x16_bf16(av, vt[ks], o[ti], 0, 0, 0); }
            }
#pragma unroll
            for (int tile = 0; tile < 4; ++tile) {
#pragma unroll
                for (int g = 0; g < 4; ++g) { const f32x4 dv = *(const LAS f32x4*)(lds + GL_DEC + (32 * tile + 8 * g + 4 * hi) * 4);
#pragma unroll
                    for (int j = 0; j < 4; ++j) S[tile][4 * g + j] *= dv[j]; }
#pragma unroll
                for (int ks = 0; ks < 4; ++ks) { const bf16x8 av = *(const LAS bf16x8*)(lds + GL_KDT + (32 * tile + c32) * GL_TS + (16 * ks + 8 * hi) * 2);
                    S[tile] = __builtin_amdgcn_mfma_f32_32x32x16_bf16(av, vt[ks], S[tile], 0, 0, 0); }
            }
        }
        __syncthreads();
#pragma unroll
        for (int ti = 0; ti < 2; ++ti)
#pragma unroll
            for (int r = 0; r < 16; ++r) *(LAS bf16_t*)(lds + GL_OST + (32 * ti + crow(r, hi)) * GL_OS + (32 * w + c32) * 2) = (bf16_t)(cvt_pk_bf16(o[ti][r], 0.f) & 0xffffu);
        __syncthreads();
        {
            const int t = tid >> 3, sg = tid & 7; const size_t tok = (size_t)(b * SEQ + chunk * 64 + t);
            u32x4 ov[4]; float ss = 0.f;
#pragma unroll
            for (int j = 0; j < 4; ++j) { ov[j] = *(const LAS u32x4*)(lds + GL_OST + t * GL_OS + sg * 64 + j * 16);
#pragma unroll
                for (int i = 0; i < 4; ++i) { const float x0 = bflo(ov[j][i]), x1 = bfhi(ov[j][i]); ss += x0 * x0 + x1 * x1; } }
            ss += __shfl_xor(ss, 1); ss += __shfl_xor(ss, 2); ss += __shfl_xor(ss, 4);
            const float rstd = 1.0f / sqrtf(ss * (1.0f / 256.0f) + EPS);
            const bf16_t* rap = proj + tok * NPROJ + C_RA + h * 256 + sg * 32; bf16_t* op = oab + tok * 2048 + h * 256 + sg * 32; const float* gp = ggo + sg * 32;
#pragma unroll
            for (int j = 0; j < 4; ++j) { const u32x4 ra = *(const u32x4*)(rap + 8 * j); const f32x4 g0 = *(const f32x4*)(gp + 8 * j), g1 = *(const f32x4*)(gp + 8 * j + 4); u32x4 wv;
#pragma unroll
                for (int i = 0; i < 4; ++i) { const float r0 = bflo(ra[i]), r1 = bfhi(ra[i]); const float ga = (i < 2) ? g0[2 * i] : g1[2 * i - 4], gb = (i < 2) ? g0[2 * i + 1] : g1[2 * i - 3];
                    wv[i] = cvt_pk_bf16(bflo(ov[j][i]) * rstd * ga * (r0 * fsigmoid(r0)), bfhi(ov[j][i]) * rstd * gb * (r1 * fsigmoid(r1))); }
                *(u32x4*)(op + 8 * j) = wv; }
        }
        __syncthreads();
    }
#undef GL_LOAD
}
namespace moba {
constexpr int HD = 128;
constexpr float SCALE = 0.08838834764831845f;
constexpr float THR = 8.f;
constexpr int NW = 8, QBLK = 32, KVBLK = 64, QB = NW * QBLK;
constexpr int SHM_V = KVBLK * HD * 2, SHM_K = KVBLK * HD * 2;
constexpr int OFF_WS = 2 * SHM_V + 2 * SHM_K;
constexpr int OFF_RTAB = OFF_WS + NW * 64 * 4;
constexpr int OFF_KM = OFF_RTAB + 2304 * 4;
constexpr int OFF_MISC = OFF_KM + 8 * 128 * 4;
constexpr int OFF_SEL = OFF_MISC + 64;
constexpr int LDS_BYTES = OFF_SEL + 2048;
constexpr int LDP = NPROJ, LDO = 2048;

#define KSWZ(row, colB) ((row) * 256 + ((colB) ^ (((row) & 7) << 4)))
#define SBAR() __builtin_amdgcn_sched_barrier(0)
__device__ __forceinline__ int v_st(int k, int c) { const int kk = (k & ~0xC) | ((k & 4) << 1) | ((k & 8) >> 1); return ((kk >> 3) * 4 + (c >> 5)) * 512 + ((kk & 7) * 32 + (c & 31)) * 2; }
__device__ __forceinline__ int v_rd_base(int lane) { return ((lane & 3) << 3) | (((lane >> 2) & 3) << 6) | (((lane >> 4) & 1) << 5) | (((lane >> 5) & 1) << 8); }
constexpr int v_rd_off(int d0, int ks, int half) { return d0 * 512 + ks * 4096 + half * 2048; }
__device__ __forceinline__ int crow(int r, int hi) { return (r & 3) + 8 * (r >> 2) + 4 * hi; }
__device__ __forceinline__ unsigned cvtpk(float lo, float hi) { unsigned r; asm volatile("v_cvt_pk_bf16_f32 %0, %1, %2" : "=v"(r) : "v"(lo), "v"(hi)); return r; }

__device__ __forceinline__ void mask_tile(f32x16& p0, f32x16& p1, int dq) {
    const float NEG = -__builtin_inff();
#pragma unroll
    for (int r = 0; r < 16; ++r) {
        const int c = (r & 3) + 8 * (r >> 2);
        if (dq - c < 0) p0[r] = NEG;
        if (dq - c - 32 < 0) p1[r] = NEG;
    }
}
__device__ __forceinline__ void bias_tile(f32x16& p0, f32x16& p1, const LAS float* rt) {
#pragma unroll
    for (int r = 0; r < 16; ++r) { const int c = (r & 3) + 8 * (r >> 2); p0[r] += rt[c]; p1[r] += rt[c + 32]; }
}
__device__ __forceinline__ void kill_tile(f32x16& p0, f32x16& p1) {
    const float NEG = -__builtin_inff();
#pragma unroll
    for (int r = 0; r < 16; ++r) { p0[r] = NEG; p1[r] = NEG; }
}
__device__ __forceinline__ void partialSM(f32x16& p0, f32x16& p1, float& m_reg, float& mn, float& alpha) {
    float pmax = p0[0];
#pragma unroll
    for (int r = 1; r < 16; ++r) pmax = fmaxf(pmax, p0[r]);
#pragma unroll
    for (int r = 0; r < 16; ++r) pmax = fmaxf(pmax, p1[r]);
    { auto rr = __builtin_amdgcn_permlane32_swap(__float_as_uint(pmax), __float_as_uint(pmax), false, false);
      pmax = fmaxf(__uint_as_float(rr[0]), __uint_as_float(rr[1])); }
    constexpr float C2 = 1.4426950408889634f * SCALE;
    if (__builtin_expect(__all((pmax - m_reg) * SCALE <= THR), 1)) { mn = m_reg; alpha = 1.f; }
    else { mn = fmaxf(m_reg, pmax); alpha = __builtin_amdgcn_exp2f((m_reg - mn) * C2); m_reg = mn; }
    const float mnL = -mn * C2;
#pragma unroll
    for (int r = 0; r < 16; ++r) p0[r] = fmaf(p0[r], C2, mnL);
#pragma unroll
    for (int r = 0; r < 16; ++r) p1[r] = fmaf(p1[r], C2, mnL);
#pragma unroll
    for (int r = 0; r < 16; ++r) p0[r] = __builtin_amdgcn_exp2f(p0[r]);
}
__device__ __forceinline__ void finishSM(f32x16& p0, f32x16& p1, float alpha, float& l_reg, bf16x8& pa0, bf16x8& pa1, bf16x8& pa2, bf16x8& pa3) {
#pragma unroll
    for (int r = 0; r < 16; ++r) p1[r] = __builtin_amdgcn_exp2f(p1[r]);
    float ps = 0;
#pragma unroll
    for (int r = 0; r < 16; ++r) ps += p0[r];
#pragma unroll
    for (int r = 0; r < 16; ++r) ps += p1[r];
    { auto rr = __builtin_amdgcn_permlane32_swap(__float_as_uint(ps), __float_as_uint(ps), false, false);
      ps = __uint_as_float(rr[0]) + __uint_as_float(rr[1]); }
    l_reg = l_reg * alpha + ps;
#define PK4(P, B_, OUT) do { unsigned a0 = cvtpk(P[B_+0], P[B_+1]), a1 = cvtpk(P[B_+2], P[B_+3]);                          \
        unsigned b0 = cvtpk(P[B_+4], P[B_+5]), b1 = cvtpk(P[B_+6], P[B_+7]);                                             \
        auto r0 = __builtin_amdgcn_permlane32_swap(a0, b0, false, false); auto r1 = __builtin_amdgcn_permlane32_swap(a1, b1, false, false); \
        u32x4 w = {r0[0], r1[0], r0[1], r1[1]}; OUT = __builtin_bit_cast(bf16x8, w); } while (0)
    PK4(p0, 0, pa0); PK4(p0, 8, pa1); PK4(p1, 0, pa2); PK4(p1, 8, pa3);
#undef PK4
}
template <int KB>
__device__ __forceinline__ void qkt(f32x16& p0, f32x16& p1, const char* K_lds, int r32, int hi, const bf16x8* qr) {
#pragma unroll
    for (int r = 0; r < 16; ++r) { p0[r] = 0.f; p1[r] = 0.f; }
    const char* kb[4];
#pragma unroll
    for (int dd = 0; dd < 4; ++dd) kb[dd] = K_lds + KB * SHM_K + KSWZ(r32, (dd * 16 + hi * 8) * 2);
#pragma unroll
    for (int d0 = 0; d0 < 8; ++d0) { const char* a = kb[d0 & 3] + (d0 >> 2) * 128;
        bf16x8 b0 = *reinterpret_cast<const bf16x8*>(a);
        bf16x8 b1 = *reinterpret_cast<const bf16x8*>(a + 32 * 256);
        p0 = __builtin_amdgcn_mfma_f32_32x32x16_bf16(b0, qr[d0], p0, 0, 0, 0);
        p1 = __builtin_amdgcn_mfma_f32_32x32x16_bf16(b1, qr[d0], p1, 0, 0, 0); }
}
template <int VB>
__device__ __forceinline__ void pv_tile(f32x16* o, int vb0, bf16x8 pa0, bf16x8 pa1, bf16x8 pa2, bf16x8 pa3) {
#define TRRD(dst, off) asm volatile("ds_read_b64_tr_b16 %0, %1 offset:%2" : "=&v"(dst) : "v"(vb0), "i"(off) : "memory")
#define PV_D0(d0) do { s16x4 l0, l1, l2, l3, h0, h1, h2, h3; constexpr int b_ = VB * SHM_V + v_rd_off(d0, 0, 0);   \
        TRRD(l0, b_); TRRD(h0, b_ + 2048); TRRD(l1, b_ + 4096); TRRD(h1, b_ + 6144); TRRD(l2, b_ + 8192); TRRD(h2, b_ + 10240); TRRD(l3, b_ + 12288); TRRD(h3, b_ + 14336); \
        asm volatile("s_waitcnt lgkmcnt(0)" ::: "memory"); SBAR();   \
        o[d0] = __builtin_amdgcn_mfma_f32_32x32x16_bf16(pa0, (bf16x8){l0[0], l0[1], l0[2], l0[3], h0[0], h0[1], h0[2], h0[3]}, o[d0], 0, 0, 0);   \
        o[d0] = __builtin_amdgcn_mfma_f32_32x32x16_bf16(pa1, (bf16x8){l1[0], l1[1], l1[2], l1[3], h1[0], h1[1], h1[2], h1[3]}, o[d0], 0, 0, 0);   \
        o[d0] = __builtin_amdgcn_mfma_f32_32x32x16_bf16(pa2, (bf16x8){l2[0], l2[1], l2[2], l2[3], h2[0], h2[1], h2[2], h2[3]}, o[d0], 0, 0, 0);   \
        o[d0] = __builtin_amdgcn_mfma_f32_32x32x16_bf16(pa3, (bf16x8){l3[0], l3[1], l3[2], l3[3], h3[0], h3[1], h3[2], h3[3]}, o[d0], 0, 0, 0); } while (0)
    PV_D0(0); PV_D0(1); PV_D0(2); PV_D0(3);
#undef PV_D0
#undef TRRD
}

struct BlockRef { const bf16_t* Q; const bf16_t* K; const bf16_t* V; bf16_t* O; int qb; int b, h; };
struct Seam { bf16x8 qr[8]; bf16x8 st_v0, st_v1, st_k0, st_k1; };
#define VMW() asm volatile("s_waitcnt vmcnt(0)" ::: "memory")
#define VMWN(n) asm volatile("s_waitcnt vmcnt(%0)" :: "i"(n) : "memory")
#define LD8(p) (*reinterpret_cast<const bf16x8*>(p))
#define SLOAD_H(Kp, Vp, k0) do { const char* kb__ = (const char*)(Kp) + (size_t)(k0) * (LDP * 2); \
        S.st_v0 = LD8(kb__ + 2048 + kvoff); S.st_v1 = LD8(kb__ + (32 * LDP * 2 + 2048) + kvoff); S.st_k0 = LD8(kb__ + kvoff); S.st_k1 = LD8(kb__ + 32 * LDP * 2 + kvoff); } while (0)
#define SWRITE_HK(bf) do { *(bf16x8*)(K_lds + (bf) * SHM_K + kws) = S.st_k0; *(bf16x8*)(K_lds + (bf) * SHM_K + kws + 32 * 256) = S.st_k1; } while (0)
#define SWRITE_HV(bf) do { *(bf16x8*)(V_lds + (bf) * SHM_V + vst0) = S.st_v0; *(bf16x8*)(V_lds + (bf) * SHM_V + vst1) = S.st_v1; } while (0)
#define SWRITE_H(bf) do { SWRITE_HV(bf); SWRITE_HK(bf); } while (0)

__device__ __forceinline__ void prime(const BlockRef& cur, char* lds, Seam& S) {
    int tid = threadIdx.x; asm volatile("" : "+v"(tid));     const int wid = __builtin_amdgcn_readfirstlane(tid >> 6), lane = tid & 63, r32 = lane & 31, hi = lane >> 5;
    const int sr = tid >> 4, sc = (tid & 15) * 8, kws = KSWZ(sr, sc * 2); char* K_lds = lds + 2 * SHM_V;
    const unsigned kvoff = (unsigned)(sr * LDP + sc) * 2u, qvoff = (unsigned)(r32 * LDP + hi * 8) * 2u;
    { const char* qb__ = (const char*)cur.Q + (size_t)(wid * QBLK) * (LDP * 2);
#pragma unroll
    for (int d0 = 0; d0 < 8; ++d0) S.qr[d0] = LD8(qb__ + qvoff + d0 * 32); }
    SLOAD_H(cur.K, cur.V, 0); VMW(); SWRITE_HK(0);
    __syncthreads();
}
__device__ __forceinline__ int rel_bucket(int n) {
    if (n < 16) return n;
    const float nf = (float)n;
    int large = 16 + (int)(logf(nf / 16.0f) / 5.545177444479562f * 16.0f);
    return large < 31 ? large : 31;
}
__device__ __forceinline__ void block(const BlockRef& cur, const BlockRef& nxt, const float* rel_bias, const float* kmp, char* lds, Seam& S) {
    int tid = threadIdx.x; asm volatile("" : "+v"(tid));     const int wid = __builtin_amdgcn_readfirstlane(tid >> 6), lane = tid & 63, r32 = lane & 31, hi = lane >> 5;
    const int qb = cur.qb, NT = 4 * (qb + 1);
    const int qlo = qb * QB + wid * QBLK, qrow = qlo + r32;
    char* V_lds = lds; char* K_lds = lds + 2 * SHM_V;
    float* ws = (float*)(lds + OFF_WS) + wid * 64; float* li_l = ws, * al_l = ws + 32;
    LAS float* rtab = (LAS float*)(LAS char*)(uintptr_t)(unsigned)(uintptr_t)(lds + OFF_RTAB);
    float* kmL = (float*)(lds + OFF_KM);
    for (int i = tid; i < 2304; i += NW * 64) { const int dist = 2047 - i; rtab[i] = dist >= 0 ? rel_bias[rel_bucket(dist) * 8 + cur.h] * (1.0f / SCALE) : 0.f; }
    for (int i = tid; i < qb * 128; i += NW * 64) { const int j = i >> 7, dd = i & 127; const size_t o = ((size_t)(cur.b * 8 + j)) * 1024 + cur.h * 128 + dd;
        kmL[i] = (kmp[o] + kmp[o + 64 * 1024]) * (1.0f / 256.0f); }
    __syncthreads();
    unsigned selmask = 0;
    {
        float sc7[7];
#pragma unroll
        for (int j = 0; j < 7; ++j) { sc7[j] = -__builtin_inff();
            if (j < qb) { float acc = 0.f;
#pragma unroll
                for (int d0 = 0; d0 < 8; ++d0) { const u32x4 q4 = __builtin_bit_cast(u32x4, S.qr[d0]); const f32x4 k0 = *(const f32x4*)(kmL + j * 128 + d0 * 16 + hi * 8), k1 = *(const f32x4*)(kmL + j * 128 + d0 * 16 + hi * 8 + 4);
                    acc += bflo(q4[0]) * k0[0] + bfhi(q4[0]) * k0[1] + bflo(q4[1]) * k0[2] + bfhi(q4[1]) * k0[3] + bflo(q4[2]) * k1[0] + bfhi(q4[2]) * k1[1] + bflo(q4[3]) * k1[2] + bfhi(q4[3]) * k1[3]; }
                acc += __shfl_xor(acc, 32); sc7[j] = acc; } }
#pragma unroll
        for (int j = 0; j < 7; ++j) { int rank = 0;
#pragma unroll
            for (int i = 0; i < 7; ++i) { if (i != j) rank += (sc7[i] > sc7[j] || (sc7[i] == sc7[j] && i < j)) ? 1 : 0; }
            if (j < qb && (qb <= 3 || rank < 3)) selmask |= 1u << j; }
    }
    LAS unsigned* selp = (LAS unsigned*)(LAS char*)(uintptr_t)(unsigned)(uintptr_t)(lds + OFF_SEL) + tid;
    *selp = selmask;
    float m_reg = -1e30f, l_reg = 0; f32x16 o[4];
#pragma unroll
    for (int d = 0; d < 4; ++d)
#pragma unroll
        for (int r = 0; r < 16; ++r) o[d][r] = 0.f;
    const int sr = tid >> 4, sc = (tid & 15) * 8, vst0 = v_st(sr, sc), vst1 = v_st(32 + sr, sc), kws = KSWZ(sr, sc * 2);
    const unsigned kvoff = (unsigned)(sr * LDP + sc) * 2u;
    const int vb0 = (int)(uintptr_t)V_lds + v_rd_base(lane);
    const bf16_t* Kh = cur.K; const bf16_t* Vh = cur.V;
#define RESC(a) do { if (__any((a) < 1.f)) { if (hi == 0) al_l[r32] = (a); asm volatile("s_waitcnt lgkmcnt(0)" ::: "memory");              \
                     for (int d_ = 0; d_ < 4; ++d_) for (int r = 0; r < 16; ++r) o[d_][r] *= al_l[crow(r, hi)]; } } while (0)
#define KBASE(t) ((t) * KVBLK)
#define MASKT(P0_, P1_, t) do { const int kb_ = KBASE(t); bias_tile(P0_, P1_, rtab + (kb_ + 4 * hi - qrow + 2047)); \
        if (((t) >> 2) != qb) { if (!((*selp >> ((t) >> 2)) & 1u)) kill_tile(P0_, P1_); } \
        else if (kb_ + KVBLK - 1 > qlo) mask_tile(P0_, P1_, qrow - 4 * hi - kb_); } while (0)
    constexpr int NQL = 8;
#define SEAM_K0() do { VMWN(NQL); SWRITE_HK(0); SBAR(); } while (0)
    f32x16 pA0, pA1, pB0, pB1; float mnA, mnB, alA, alB; bf16x8 pa0, pa1, pa2, pa3;
    SWRITE_HV(0); SBAR();
    if (NT > 1) { SLOAD_H(Kh, Vh, KBASE(1)); }
    SBAR(); qkt<0>(pA0, pA1, K_lds, r32, hi, S.qr);
    MASKT(pA0, pA1, 0); partialSM(pA0, pA1, m_reg, mnA, alA);
    if (NT > 1) { VMW(); SWRITE_H(1); }
    __syncthreads();
#define HALF_STEP(PX0, PX1, mnX, alX, PY0, PY1, alY, t, KB, VB, SB) do {                                                      \
        SBAR(); qkt<KB>(PX0, PX1, K_lds, r32, hi, S.qr);                                             \
        finishSM(PY0, PY1, alY, l_reg, pa0, pa1, pa2, pa3); SBAR();                                                           \
        if ((t) + 1 < NT) { SLOAD_H(Kh, Vh, KBASE((t) + 1)); SBAR(); }                                               \
        pv_tile<VB>(o, vb0, pa0, pa1, pa2, pa3); MASKT(PX0, PX1, (t)); partialSM(PX0, PX1, m_reg, mnX, alX);                                        \
        __syncthreads();                                                                                                      \
        if ((t) + 1 < NT) { VMW(); SWRITE_H(SB); }                                                                          \
        RESC(alX); __syncthreads(); } while (0)
    for (int t = 1; t + 1 < NT; t += 2) {
        HALF_STEP(pB0, pB1, mnB, alB, pA0, pA1, alA, t, 1, 0, 0);
        HALF_STEP(pA0, pA1, mnA, alA, pB0, pB1, alB, t + 1, 0, 1, 1);
    }
    { SBAR(); qkt<1>(pB0, pB1, K_lds, r32, hi, S.qr); SBAR(); }
    SLOAD_H(nxt.K, nxt.V, 0); SBAR();
    { const char* qb__ = (const char*)nxt.Q + (size_t)(wid * QBLK) * (LDP * 2); int l_ = lane; asm volatile("" : "+v"(l_));
      const unsigned qvoff = (unsigned)((l_ & 31) * LDP + (l_ >> 5) * 8) * 2u;
#pragma unroll
    for (int d0 = 0; d0 < 8; ++d0) S.qr[d0] = LD8(qb__ + qvoff + d0 * 32); }
    SBAR();
    finishSM(pA0, pA1, alA, l_reg, pa0, pa1, pa2, pa3); SBAR();
    pv_tile<0>(o, vb0, pa0, pa1, pa2, pa3);
    { MASKT(pB0, pB1, NT - 1); partialSM(pB0, pB1, m_reg, mnB, alB); __syncthreads(); RESC(alB);
      finishSM(pB0, pB1, alB, l_reg, pa0, pa1, pa2, pa3); SBAR(); pv_tile<1>(o, vb0, pa0, pa1, pa2, pa3); }
    SBAR(); SEAM_K0();
    if (hi == 0) li_l[r32] = l_reg; asm volatile("s_waitcnt lgkmcnt(0)" ::: "memory");
    float rli[16];
#pragma unroll
    for (int r = 0; r < 16; ++r) rli[r] = __builtin_amdgcn_rcpf(li_l[crow(r, hi)]);
    char* Ow = (char*)cur.O + (size_t)(wid * QBLK) * (LDO * 2); const unsigned ovoff = (unsigned)(4 * hi * LDO + r32) * 2u;
#pragma unroll
    for (int r = 0; r < 16; ++r) { const int orow0 = (r & 3) + 8 * (r >> 2);
#pragma unroll
        for (int d0 = 0; d0 < 4; ++d0) { const float v = o[d0][r] * rli[r];
            const float vn = __shfl_xor(v, 1);
            if ((r32 & 1) == 0) *(unsigned*)(Ow + (size_t)(orow0 * LDO * 2 + d0 * 64) + ovoff) = cvtpk(v, vn); } }
    __syncthreads();
#undef RESC
#undef KBASE
#undef MASKT
#undef SEAM_K0
#undef HALF_STEP
}
#undef ROWP
#undef VMW
#undef VMWN
#undef LD8
#undef SLOAD_H
#undef SWRITE_HK
#undef SWRITE_HV
#undef SWRITE_H

__device__ __forceinline__ BlockRef make_ref(const P& a, int item) {
    const int qb = 7 - (item >> 6), bh = item & 63, b = bh >> 3, h = bh & 7;
    const bf16_t* proj = (const bf16_t*)(a.ws + WS_PROJ);
    BlockRef r; r.b = b; r.h = h; r.qb = qb;
    r.Q = proj + (size_t)(b * SEQ + qb * QB) * LDP + C_QB + h * HD;
    r.K = proj + (size_t)(b * SEQ) * LDP + C_KB + h * HD;
    r.V = proj + (size_t)(b * SEQ) * LDP + C_VB + h * HD;
    r.O = (bf16_t*)(a.ws + WS_OAB) + (size_t)(b * SEQ + qb * QB) * LDO + 1024 + h * HD;
    return r;
}
}
__device__ __forceinline__ void router_unit(const P& a, LAS unsigned char* lds, int unit) {
    int tid = threadIdx.x; asm volatile("" : "+v"(tid));     const int wave = __builtin_amdgcn_readfirstlane(tid >> 6), lane = tid & 63, c32 = lane & 31, hi = lane >> 5;
    const float* x1 = a.out; const float* g = a.in[11]; const float* br = a.in[13];
    bf16_t* A2 = (bf16_t*)(a.ws + WS_H); const u32x4* frag = (const u32x4*)(a.ws + WS_WRF);
    LAS float* Lw = (LAS float*)(lds + wave * 4352);
    LAS unsigned* hist = (LAS unsigned*)(lds + 8 * 4352);
    LAS unsigned* base = hist + 32;
    if (tid < 32) hist[tid] = 0u;
    __syncthreads();
    const int tok = unit * 256 + wave * 32 + c32;
    f32x16 L;
#pragma unroll
    for (int r = 0; r < 16; ++r) L[r] = 0.f;
    float ss = 0.f;
    const float* xr = x1 + (size_t)tok * D + 8 * hi; bf16_t* ar = A2 + (size_t)tok * D + 8 * hi; const float* gr = g + 8 * hi;
#pragma unroll 2
    for (int s = 0; s < 64; ++s) {
        const f32x4 xa = *(const f32x4*)(xr + 16 * s), xb = *(const f32x4*)(xr + 16 * s + 4), ga = *(const f32x4*)(gr + 16 * s), gb = *(const f32x4*)(gr + 16 * s + 4);
        ss += (xa.x * xa.x + xa.y * xa.y) + (xa.z * xa.z + xa.w * xa.w) + (xb.x * xb.x + xb.y * xb.y) + (xb.z * xb.z + xb.w * xb.w);
        const f32x4 va = xa * ga, vb = xb * gb;
        u32x4 wh; wh.x = cvt_pk_bf16(va.x, va.y); wh.y = cvt_pk_bf16(va.z, va.w); wh.z = cvt_pk_bf16(vb.x, vb.y); wh.w = cvt_pk_bf16(vb.z, vb.w);
        *(u32x4*)(ar + 16 * s) = wh;
        u32x4 wl; wl.x = cvt_pk_bf16(va.x - bflo(wh.x), va.y - bfhi(wh.x)); wl.y = cvt_pk_bf16(va.z - bflo(wh.y), va.w - bfhi(wh.y));
        wl.z = cvt_pk_bf16(vb.x - bflo(wh.z), vb.y - bfhi(wh.z)); wl.w = cvt_pk_bf16(vb.z - bflo(wh.w), vb.w - bfhi(wh.w));
        const bf16x8 ah = __builtin_bit_cast(bf16x8, wh), al = __builtin_bit_cast(bf16x8, wl);
        const bf16x8 bh = __builtin_bit_cast(bf16x8, frag[s * 64 + lane]), bl = __builtin_bit_cast(bf16x8, frag[4096 + s * 64 + lane]);
        L = __builtin_amdgcn_mfma_f32_32x32x16_bf16(ah, bh, L, 0, 0, 0);
        L = __builtin_amdgcn_mfma_f32_32x32x16_bf16(ah, bl, L, 0, 0, 0);
        L = __builtin_amdgcn_mfma_f32_32x32x16_bf16(al, bh, L, 0, 0, 0);
    }
    ss += __shfl_xor(ss, 32);
    const float rstd = 1.0f / sqrtf(ss * (1.0f / D) + EPS);
#pragma unroll
    for (int r = 0; r < 16; ++r) Lw[((r & 3) + 8 * (r >> 2) + 4 * hi) * 33 + c32] = L[r];
    LDS_WAIT(); asm volatile("" ::: "memory");
    int e4[4] = {0, 0, 0, 0}; float w4[4] = {0.f, 0.f, 0.f, 0.f}; unsigned loc[4] = {0u, 0u, 0u, 0u};
    if (hi == 0) {
        float lg[32];
#pragma unroll
        for (int e = 0; e < 32; ++e) lg[e] = Lw[c32 * 33 + e] * rstd + br[e];
        unsigned used = 0u; float v4[4];
#pragma unroll
        for (int p = 0; p < 4; ++p) { float best = -__builtin_inff(); int bi = 0;
#pragma unroll
            for (int e = 0; e < 32; ++e) { const bool take = !((used >> e) & 1u) && lg[e] > best; best = take ? lg[e] : best; bi = take ? e : bi; }
            used |= 1u << bi; e4[p] = bi; v4[p] = best; }
        float sum = 0.f;
#pragma unroll
        for (int p = 0; p < 4; ++p) { w4[p] = expf(v4[p] - v4[0]); sum += w4[p]; }
        const float inv = 1.0f / sum;
#pragma unroll
        for (int p = 0; p < 4; ++p) { w4[p] *= inv; loc[p] = __hip_atomic_fetch_add(hist + e4[p], 1u, __ATOMIC_RELAXED, __HIP_MEMORY_SCOPE_WORKGROUP); }
    }
    __syncthreads();
    if (tid < 32) base[tid] = __hip_atomic_fetch_add((unsigned*)(a.ws + WS_CTL) + CW_COUNTS + tid, hist[tid], RLX_AGENT);
    __syncthreads();
    if (hi == 0) {
        int* tope = (int*)(a.ws + WS_TOPE) + (size_t)tok * 4; float* wts = (float*)(a.ws + WS_WTS) + (size_t)tok * 4; int* slot = (int*)(a.ws + WS_SLOT) + (size_t)tok * 4;
#pragma unroll
        for (int p = 0; p < 4; ++p) { tope[p] = e4[p]; wts[p] = w4[p]; slot[p] = (int)(base[e4[p]] + loc[p]); }
        ((float*)(a.ws + WS_RSTD))[tok] = rstd;
    }
    __syncthreads();
}

__device__ __forceinline__ void moe_index(const P& a, LAS unsigned char* lds, int vcu, int G) {
    const int tid = threadIdx.x;
    LAS int* pstart = (LAS int*)lds;
    LAS int* cnt = pstart + 64;
    const unsigned* counts = (const unsigned*)(a.ws + WS_CTL) + CW_COUNTS;
    if (tid == 0) { int acc = 0; for (int e = 0; e < NE; ++e) { const int c = (int)counts[e]; cnt[e] = c; pstart[e] = acc; acc += ((c + 255) >> 8) << 8; } pstart[NE] = acc; }
    __syncthreads();
    int* rowtok = (int*)(a.ws + WS_ROWTOK); float* rstds = (float*)(a.ws + WS_RSTDS); int* dest = (int*)(a.ws + WS_DEST);
    const int* tope = (const int*)(a.ws + WS_TOPE); const int* slot = (const int*)(a.ws + WS_SLOT); const float* rstd = (const float*)(a.ws + WS_RSTD);
    const int gt = vcu * NTHREADS + tid, NGT = G * NTHREADS;
    for (int i = gt; i < T * 4; i += NGT) { const int e = tope[i], d = pstart[e] + slot[i]; dest[i] = d; rowtok[d] = i >> 2; rstds[d] = rstd[i >> 2]; }
    for (int i = gt; i < NE * 256; i += NGT) { const int e = i >> 8, r = pstart[e] + cnt[e] + (i & 255); if (r < pstart[e + 1]) { rowtok[r] = 0; rstds[r] = 0.f; } }
    if (vcu == 0) { int* tile_e = (int*)(a.ws + WS_TILEE);
        for (int t = tid; t < MAXTILES; t += NTHREADS) { int e = NE - 1; for (int q = 0; q < NE; ++q) { if (t * 256 >= pstart[q] && t * 256 < pstart[q + 1]) e = q; } tile_e[t] = e; }
        if (tid == 0) tile_e[MAXTILES] = pstart[NE] >> 8; }
    __syncthreads();
}

__device__ __forceinline__ void combine_rows(const P& a, int vcu, int G, int wave, int lane) {
    const int gw = vcu * NWAVES + wave, NGW = G * NWAVES;
    float* X = a.out; const bf16_t* Y = (const bf16_t*)(a.ws + WS_YROWS); bf16_t* A3 = (bf16_t*)(a.ws + WS_H);
    const int* dest = (const int*)(a.ws + WS_DEST); const float* wts = (const float*)(a.ws + WS_WTS); const float* g = a.in[20];
    f32x4 gv[4];
#pragma unroll
    for (int j = 0; j < 4; ++j) gv[j] = *((const f32x4*)g + lane + 64 * j);
    for (int m = gw; m < T; m += NGW) {
        f32x4* xr = (f32x4*)(X + (size_t)m * D) + lane; f32x4 v[4];
#pragma unroll
        for (int j = 0; j < 4; ++j) v[j] = xr[64 * j];
#pragma unroll
        for (int k = 0; k < 4; ++k) { const int d = __builtin_amdgcn_readfirstlane(dest[m * 4 + k]); const float w = __uint_as_float(__builtin_amdgcn_readfirstlane(__float_as_uint(wts[m * 4 + k])));
            const u32x2* yr = (const u32x2*)(Y + (size_t)d * D) + lane;
#pragma unroll
            for (int j = 0; j < 4; ++j) { const u32x2 y = yr[64 * j]; v[j].x += w * bflo(y.x); v[j].y += w * bfhi(y.x); v[j].z += w * bflo(y.y); v[j].w += w * bfhi(y.y); } }
        float s = 0.f;
#pragma unroll
        for (int j = 0; j < 4; ++j) s += (v[j].x * v[j].x + v[j].y * v[j].y) + (v[j].z * v[j].z + v[j].w * v[j].w);
        const float rstd = 1.0f / sqrtf(wave_sum(s) * (1.0f / D) + EPS);
        u32x2* o8 = (u32x2*)(A3 + (size_t)m * D) + lane;
#pragma unroll
        for (int j = 0; j < 4; ++j) { xr[64 * j] = v[j]; u32x2 w; w.x = cvt_pk_bf16(v[j].x * rstd * gv[j].x, v[j].y * rstd * gv[j].y); w.y = cvt_pk_bf16(v[j].z * rstd * gv[j].z, v[j].w * rstd * gv[j].w); o8[64 * j] = w; }
    }
}
__device__ __forceinline__ void final_rows(const P& a, int vcu, int G, int wave, int lane) {
    const int gw = vcu * NWAVES + wave, NGW = G * NWAVES;
    float* X = a.out; const bf16_t* PG = (const bf16_t*)(a.ws + WS_PGATE); const bf16_t* PP = (const bf16_t*)(a.ws + WS_PPROJ);
    f32x4 gp[4], gf[4];
#pragma unroll
    for (int j = 0; j < 4; ++j) { gp[j] = *((const f32x4*)a.in[23] + lane + 64 * j); gf[j] = *((const f32x4*)a.in[24] + lane + 64 * j); }
    for (int m = gw; m < T; m += NGW) {
        f32x4* xr = (f32x4*)(X + (size_t)m * D) + lane; const u32x2* pgr = (const u32x2*)(PG + (size_t)m * D) + lane; const u32x2* ppr = (const u32x2*)(PP + (size_t)m * D) + lane;
        f32x4 v[4], pp[4], pg[4]; float sp = 0.f;
#pragma unroll
        for (int j = 0; j < 4; ++j) { v[j] = xr[64 * j]; const u32x2 q = ppr[64 * j], gq = pgr[64 * j];
            pp[j] = (f32x4){bflo(q.x), bfhi(q.x), bflo(q.y), bfhi(q.y)}; pg[j] = (f32x4){bflo(gq.x), bfhi(gq.x), bflo(gq.y), bfhi(gq.y)};
            sp += (pp[j].x * pp[j].x + pp[j].y * pp[j].y) + (pp[j].z * pp[j].z + pp[j].w * pp[j].w); }
        const float rp = 1.0f / sqrtf(wave_sum(sp) * (1.0f / D) + EPS); float s = 0.f;
#pragma unroll
        for (int j = 0; j < 4; ++j) { v[j] = v[j] + pg[j] * (pp[j] * rp * gp[j]); s += (v[j].x * v[j].x + v[j].y * v[j].y) + (v[j].z * v[j].z + v[j].w * v[j].w); }
        const float rstd = 1.0f / sqrtf(wave_sum(s) * (1.0f / D) + EPS);
#pragma unroll
        for (int j = 0; j < 4; ++j) xr[64 * j] = v[j] * rstd * gf[j];
    }
}
struct Args { P p; };
template <int PH_LO, int PH_HI>
__global__ void __launch_bounds__(NTHREADS, 2) hybrid_fwd(Args args) {
    extern __shared__ __attribute__((aligned(16))) unsigned char lds_raw[];
    LAS unsigned char* lds = (LAS unsigned char*)lds_raw;
    const P& a = args.p;
    const int tid = threadIdx.x, lane = tid & 63, wave = __builtin_amdgcn_readfirstlane(tid >> 6);
    const int G = gridDim.x; const int bx = blockIdx.x; const int vcu = (G % 8 == 0) ? (bx % 8) * (G / 8) + bx / 8 : bx;
    unsigned* ctl = (unsigned*)(a.ws + WS_CTL);
    for (int u = tid; u < (LDS_BYTES - LDSCTL_OFF) / 4; u += NTHREADS) ((LAS unsigned*)(lds + LDSCTL_OFF))[u] = 0u;
    __syncthreads();
#if MK_PER_PHASE
#define GRID_BAR() do { } while (0)
#else
    XcdBarrier bar = xcd_barrier_post(ctl + CW_BAR, (volatile LAS unsigned*)(lds + MISC_OFF + 32));
#define GRID_BAR() xcd_barrier(bar)
#endif
    constexpr int lo = PH_LO, hi = PH_HI;
#define IN(k) (lo <= (k) && (k) < hi)
#define SEAM(k) do { if constexpr (IN(k) && IN((k) + 1)) GRID_BAR(); } while (0)
    unsigned char* ws = a.ws;

    if constexpr (IN(0)) { p0_prologue(a, lds, vcu, G, wave, lane); }
    SEAM(0);
    if constexpr (IN(1)) {
        pg8::DenseSched S; S.o.init(T / 256, NPROJ / 256, G, bx); S.Bt = (const char*)(ws + WS_WIN); S.K = D;
        pg8::EpiProj E{(bf16_t*)(ws + WS_PROJ), (float*)(ws + WS_KMP)};
        pg8::gemm_phase(lds, (const char*)(ws + WS_H), D, D, D, S, E);
    }
    SEAM(1);
    if constexpr (IN(2)) { for (int u = vcu; u < NB * 32; u += G) gla_prep_unit(a, lds, u); }
    SEAM(2);
    if constexpr (IN(3)) {
#ifndef NO_GLA
        for (int u = vcu; u < NB * 4; u += G) gla_scan_unit(a, lds, u);
        __syncthreads();
#endif
#ifndef NO_MOBA
        for (int c = bx; c < 256; c += G) {
            moba::Seam S;
            moba::BlockRef cur = moba::make_ref(a, c); const moba::BlockRef second = moba::make_ref(a, 511 - c);
            moba::prime(cur, (char*)lds_raw, S);
            for (int pass = 0; pass < 2; ++pass) {
                moba::block(cur, second, a.in[2], (const float*)(ws + WS_KMP), (char*)lds_raw, S);
                cur = second;
            }
        }
#endif
    }
    SEAM(3);
    if constexpr (IN(4)) {
        pg8::ChainSched S; S.o.init(T / 256, D / 256, G, bx); S.Bt = (const char*)(ws + WS_WUP); S.K = 1024;
        pg8::EpiMerge E{(const bf16_t*)(ws + WS_PROJ), (bf16_t*)(ws + WS_Y)};
        pg8::gemm_phase(lds, (const char*)(ws + WS_OAB), 1024, 2048, 2048, S, E);
    }
    SEAM(4);
    if constexpr (IN(5)) {
        pg8::DenseSched S; S.o.init(T / 256, D / 256, G, bx); S.Bt = (const char*)(ws + WS_WO); S.K = D;
        pg8::EpiResF32 E{a.in[0], a.out};
        pg8::gemm_phase(lds, (const char*)(ws + WS_Y), D, D, D, S, E);
        __syncthreads();
        expert_convert(a, lds, vcu, G, wave, lane);
    }
    SEAM(5);
    if constexpr (IN(6)) { for (int u = vcu; u < T / 256; u += G) router_unit(a, lds, u); }
    SEAM(6);
    if constexpr (IN(7)) { moe_index(a, lds, vcu, G); }
    SEAM(7);
    if constexpr (IN(8)) {
        const int* tile_e = (const int*)(ws + WS_TILEE); const int ntile = __builtin_amdgcn_readfirstlane(tile_e[MAXTILES]);
        pg8::MoeSched<true> S; S.o.init(ntile, 8, G, bx); S.Bt = (const char*)(ws + WS_W1T); S.K = D; S.rows_per_e = 2048; S.tile_e = tile_e; S.row_tok = (const int*)(ws + WS_ROWTOK);
        pg8::EpiGlu E{(bf16_t*)(ws + WS_HMID), (const float*)(ws + WS_RSTDS), a.in[15], a.in[17]};
        pg8::gemm_phase(lds, (const char*)(ws + WS_H), D, D, D, S, E);
    }
    SEAM(8);
    if constexpr (IN(9)) {
        const int* tile_e = (const int*)(ws + WS_TILEE); const int ntile = __builtin_amdgcn_readfirstlane(tile_e[MAXTILES]);
        pg8::MoeSched<false> S; S.o.init(ntile, 4, G, bx); S.Bt = (const char*)(ws + WS_W2T); S.K = FF; S.rows_per_e = 1024; S.tile_e = tile_e; S.row_tok = nullptr;
        pg8::EpiBf16<0, true> E{(bf16_t*)(ws + WS_YROWS), D, a.in[19], D};
        pg8::gemm_phase(lds, (const char*)(ws + WS_HMID), FF, FF, FF, S, E);
    }
    SEAM(9);
    if constexpr (IN(10)) { combine_rows(a, vcu, G, wave, lane); }
    SEAM(10);
    if constexpr (IN(11)) {
        { pg8::DenseSched S; S.o.init(T / 256, D / 256, G, bx); S.Bt = (const char*)(ws + WS_WPG); S.K = D;
          pg8::EpiBf16<1, false> E{(bf16_t*)(ws + WS_PGATE), D, nullptr, 0};
          pg8::gemm_phase(lds, (const char*)(ws + WS_H), D, D, D, S, E); }
        __syncthreads();
        { pg8::DenseSched S; S.o.init(T / 256, D / 256, G, bx); S.Bt = (const char*)(ws + WS_WPP); S.K = 256;
          pg8::EpiBf16<0, false> E{(bf16_t*)(ws + WS_PPROJ), D, nullptr, 0};
          pg8::gemm_phase(lds, (const char*)(ws + WS_PB), 256, 256, 256, S, E); }
    }
    SEAM(11);
    if constexpr (IN(12)) { final_rows(a, vcu, G, wave, lane); }
#undef IN
#undef SEAM
#undef GRID_BAR
}

template <int LO, int HI> static void launch_range(const Args& a, int grid, hipStream_t stream) {
    static bool attr = false;
    if (!attr) { attr = true; if (hipFuncSetAttribute((const void*)hybrid_fwd<LO, HI>, hipFuncAttributeMaxDynamicSharedMemorySize, LDS_BYTES) != hipSuccess) fprintf(stderr, "kernel_launch: hipFuncSetAttribute failed\n"); }
    hipLaunchKernelGGL((hybrid_fwd<LO, HI>), dim3(grid), dim3(NTHREADS), LDS_BYTES, stream, a);
}
extern "C" void kernel_launch(void* const* d_in, const int* in_sizes, int n_in, void* d_out, int out_size, void* d_ws, size_t ws_size, hipStream_t stream) {
    static int grid = 0;
    if (grid == 0) {
        static const int expect[25] = {T * D, T * 256, 256, 1024, 1024 * D_IN, 16 * 512, 512, 256, 1048576, 1048576, 1048576, 1024, 32768, 32, 33554432, 32768, 33554432, 32768, 33554432, 32768, 1024, 1048576, 262144, 1024, 1024};
        bool okk = (n_in == 25);
        for (int i = 0; okk && i < 25; ++i) if (in_sizes[i] != expect[i]) { fprintf(stderr, "kernel_launch: input %d has %d elements, expected %d\n", i, in_sizes[i], expect[i]); okk = false; }
        if (!okk || out_size != T * D || ws_size < WS_END) { fprintf(stderr, "kernel_launch: unexpected shapes (n_in %d, in0 %d, out %d, ws %zu); nothing launched\n", n_in, n_in > 0 ? in_sizes[0] : -1, out_size, ws_size); grid = -1; return; }
        int dev = 0, cus = 0;
        if (hipGetDevice(&dev) != hipSuccess || hipDeviceGetAttribute(&cus, hipDeviceAttributeMultiprocessorCount, dev) != hipSuccess) { grid = -1; return; }
        grid = cus;
    }
    if (grid < 0) return;
    (void)hipMemsetAsync((char*)d_ws + WS_CTL, 0, CTL_ZERO_BYTES, stream);
    Args a{};
    for (int i = 0; i < 25; ++i) a.p.in[i] = (const float*)d_in[i];
    a.p.out = (float*)d_out; a.p.ws = (unsigned char*)d_ws;
#if MK_PER_PHASE
#ifndef MK_LAST
#define MK_LAST 12
#endif
#define LR(k) do { if ((k) <= MK_LAST) launch_range<(k), (k) + 1>(a, grid, stream); } while (0)
    LR(0); LR(1); LR(2); LR(3); LR(4); LR(5); LR(6); LR(7); LR(8); LR(9); LR(10); LR(11); LR(12);
#undef LR
#else
    launch_range<0, NPHASES>(a, grid, stream);
#endif
}
```

```cpp
#define MK_PER_PHASE 0
#include <hip/hip_runtime.h>
#include <cstdio>
#include <cstdint>

#define LAS __attribute__((address_space(3)))
#define GAS __attribute__((address_space(1)))
typedef unsigned short bf16_t;
typedef short bf16x8 __attribute__((ext_vector_type(8)));
typedef short s16x4 __attribute__((ext_vector_type(4)));
typedef float f32x2 __attribute__((ext_vector_type(2)));
typedef float f32x4 __attribute__((ext_vector_type(4)));
typedef float f32x16 __attribute__((ext_vector_type(16)));
typedef unsigned u32x2 __attribute__((ext_vector_type(2)));
typedef unsigned u32x4 __attribute__((ext_vector_type(4)));
typedef int i32x4 __attribute__((ext_vector_type(4)));
typedef int i32x8 __attribute__((ext_vector_type(8)));
typedef GAS unsigned gu32;
#define RLX_AGENT __ATOMIC_RELAXED, __HIP_MEMORY_SCOPE_AGENT
#define LDS_WAIT() asm volatile("s_waitcnt lgkmcnt(0)" ::: "memory")
#define VM_WAIT() asm volatile("s_waitcnt vmcnt(0)" ::: "memory")

#ifndef MK_PER_PHASE
#define MK_PER_PHASE 0
#endif

constexpr int NB = 8, SEQ = 2048, T = NB * SEQ, D = 1024;
constexpr int NPROJ = 8192;
constexpr int C_QA = 0, C_KA = 512, C_VA = 1024, C_RA = 2048, C_QB = 3072, C_KB = 4096, C_VB = 5120, C_GA = 6144, C_GB = 7168;
constexpr int SRC_ALOW = 3072, D_IN = 8208;
constexpr int NE = 32, FF = 1024, MAXTILES = 288, MAXROWS = MAXTILES * 256;
constexpr float EPS = 1e-6f;
constexpr int NWAVES = 8, NTHREADS = 512;
constexpr int NPHASES = 14;

constexpr size_t MiB = 1u << 20;
constexpr size_t WS_CTL = 0, CTL_ZERO_BYTES = 1 * MiB;
constexpr size_t WS_SMALL = 1 * MiB;
constexpr size_t WS_KMP   = WS_SMALL;
constexpr size_t WS_DEC   = WS_KMP + 512 * 1024;
constexpr size_t WS_TOPE  = WS_DEC + 512 * 1024;
constexpr size_t WS_WTS   = WS_TOPE + 256 * 1024;
constexpr size_t WS_SLOT  = WS_WTS + 256 * 1024;
constexpr size_t WS_DEST  = WS_SLOT + 256 * 1024;
constexpr size_t WS_ROWTOK = WS_DEST + 256 * 1024;
constexpr size_t WS_RSTDS = WS_ROWTOK + 320 * 1024;
constexpr size_t WS_RSTD  = WS_RSTDS + 320 * 1024;
constexpr size_t WS_TILEE = WS_RSTD + 64 * 1024;
constexpr size_t WS_WALT  = WS_TILEE + 4 * 1024;
constexpr size_t WS_WRF   = WS_WALT + 32 * 1024;
static_assert(WS_WRF + 128 * 1024 <= 6 * MiB, "small map");
constexpr size_t WS_WO = 6 * MiB, WS_WPG = 8 * MiB, WS_WPP = 10 * MiB, WS_WUP = 12 * MiB, WS_WIN = 16 * MiB;
constexpr size_t WS_PB = 34 * MiB;
constexpr size_t WS_H  = 42 * MiB;
constexpr size_t WS_PROJ = 74 * MiB;
constexpr size_t WS_QG = 362 * MiB, WS_KG = 378 * MiB, WS_KDT = 394 * MiB;
constexpr size_t WS_OAB = 410 * MiB;
constexpr size_t WS_Y = 474 * MiB;
constexpr size_t WS_W2T = 74 * MiB;
constexpr size_t WS_HMID = 138 * MiB;
constexpr size_t WS_W1T = 282 * MiB;
constexpr size_t WS_YROWS = 282 * MiB;
constexpr size_t WS_PGATE = 74 * MiB, WS_PPROJ = 106 * MiB;
constexpr size_t WS_END = 506 * MiB;

constexpr int CW_BAR = 4096;
constexpr int CW_COUNTS = 16384;
constexpr int CW_QUEUE = 16384 + 64;

constexpr int RING_BYTES = 131072;
constexpr int LDSCTL_OFF = RING_BYTES, MISC_OFF = LDSCTL_OFF + 320;
constexpr int LDS_BYTES = 147456;

typedef __bf16 bf16v2_t __attribute__((ext_vector_type(2)));
__device__ __forceinline__ unsigned cvt_pk_bf16(float lo, float hi) { const f32x2 v = {lo, hi}; return __builtin_bit_cast(unsigned, __builtin_convertvector(v, bf16v2_t)); }
__device__ __forceinline__ unsigned pk4_fp8(float a, float b, float c, float d) { int w = 0; w = __builtin_amdgcn_cvt_pk_fp8_f32(a, b, w, false); w = __builtin_amdgcn_cvt_pk_fp8_f32(c, d, w, true); return (unsigned)w; }
__device__ __forceinline__ float bf2f(unsigned short s) { return __uint_as_float(((unsigned)s) << 16); }
__device__ __forceinline__ float bflo(unsigned w) { return __uint_as_float(w << 16); }
__device__ __forceinline__ float bfhi(unsigned w) { return __uint_as_float(w & 0xffff0000u); }
__device__ __forceinline__ float fsigmoid(float x) { return __builtin_amdgcn_rcpf(1.0f + __builtin_amdgcn_exp2f(-1.4426950408889634f * x)); }
__device__ __forceinline__ float wave_sum(float v) {
#pragma unroll
    for (int o = 1; o < 64; o <<= 1) v += __shfl_xor(v, o);
    return v;
}
__device__ __forceinline__ bf16x8 pack8(f32x4 a, f32x4 b) {
    u32x4 w = {cvt_pk_bf16(a[0], a[1]), cvt_pk_bf16(a[2], a[3]), cvt_pk_bf16(b[0], b[1]), cvt_pk_bf16(b[2], b[3])};
    return __builtin_bit_cast(bf16x8, w);
}

#define XB_TMO      128
#define XB_XCNT(j)  (256  + 64 * (j))
#define XB_XSUB(j)  (1280 + 64 * (j))
#define XB_XGEN(j)  (2304 + 64 * (j))
#define XB_TOP      3328
#define XB_TOPGEN   3392
#define XCD_BAR_WORDS 3456
#define XB_SPIN_CAP (1u << 18)

__device__ __forceinline__ unsigned xb_ld(unsigned* p)              { return __hip_atomic_load(p, __ATOMIC_RELAXED, __HIP_MEMORY_SCOPE_AGENT); }
__device__ __forceinline__ unsigned xb_add(unsigned* p, unsigned v) { return __hip_atomic_fetch_add(p, v, __ATOMIC_RELAXED, __HIP_MEMORY_SCOPE_AGENT); }
__device__ __forceinline__ unsigned xb_xcc_id() { return (unsigned)__builtin_amdgcn_s_getreg((3 << 11) | 20) & 0xFu; }
#define XB_SPIN(cond, bar) do { unsigned _sp = 0; while (cond) { __builtin_amdgcn_s_sleep(1); \
    if ((++_sp & 255u) == 0u) { if (xb_ld(&(bar)[XB_TMO])) break; if (_sp > XB_SPIN_CAP) { atomicAdd(&(bar)[XB_TMO], 1u); break; } } } } while (0)

struct XcdBarrier { unsigned* bar; unsigned x; volatile LAS unsigned* st; };

__device__ __forceinline__ XcdBarrier xcd_barrier_post(unsigned* bar, volatile LAS unsigned* st) {
    XcdBarrier b; b.bar = bar; b.x = xb_xcc_id(); b.st = st;
    if (threadIdx.x == 0) (void)xb_add(&bar[XB_XCNT(b.x)], 1u);
    return b;
}
__device__ __forceinline__ void xcd_barrier_complete(unsigned* bar, unsigned x, unsigned& nloc, unsigned& nx) {
    const unsigned G = gridDim.x * gridDim.y * gridDim.z;
    unsigned sum, cnt, mine, sp = 0u;
    for (;;) {
        sum = 0u; cnt = 0u; mine = 0u;
#pragma unroll
        for (unsigned j = 0; j < 16; ++j) { const unsigned c = xb_ld(&bar[XB_XCNT(j)]); sum += c; cnt += (c > 0u) ? 1u : 0u; mine = (j == x) ? c : mine; }
        if (sum == G) break;
        __builtin_amdgcn_s_sleep(1);
        if ((++sp & 255u) == 0u) { if (xb_ld(&bar[XB_TMO])) break; if (sp > XB_SPIN_CAP) { atomicAdd(&bar[XB_TMO], 1u); break; } }
    }
    nloc = mine > 0u ? mine : 1u; nx = cnt > 0u ? cnt : 1u;
}
__device__ __forceinline__ void xcd_barrier(const XcdBarrier& b) {
    asm volatile("s_waitcnt vmcnt(0)" ::: "memory");
    __syncthreads();
    if (threadIdx.x == 0) {
        unsigned* bar = b.bar;
        __builtin_amdgcn_s_waitcnt(0);
        unsigned nloc = b.st[0], nx = b.st[1];
        if (nloc == 0u) { xcd_barrier_complete(bar, b.x, nloc, nx); b.st[0] = nloc; b.st[1] = nx; }
        const unsigned old = xb_add(&bar[XB_XSUB(b.x)], 1u);
        const unsigned gen = old / nloc;
        if (old + 1u == (gen + 1u) * nloc) {
            __builtin_amdgcn_fence(__ATOMIC_RELEASE, "agent");
            asm volatile("s_waitcnt vmcnt(0)" ::: "memory");
            const unsigned og = xb_add(&bar[XB_TOP], 1u);
            const unsigned tg = og / nx;
            if (og + 1u == (tg + 1u) * nx) xb_add(&bar[XB_TOPGEN], 1u);
            else XB_SPIN(xb_ld(&bar[XB_TOPGEN]) == tg, bar);
            __builtin_amdgcn_fence(__ATOMIC_ACQUIRE, "agent");
            xb_add(&bar[XB_XGEN(b.x)], 1u);
            asm volatile("s_waitcnt vmcnt(0)" ::: "memory");
        } else {
            XB_SPIN(xb_ld(&bar[XB_XGEN(b.x)]) == gen, bar);
            __builtin_amdgcn_fence(__ATOMIC_ACQUIRE, "agent");
            asm volatile("s_waitcnt vmcnt(0)" ::: "memory");
        }
    }
    __syncthreads();
}
namespace pg8 {
constexpr int BM = 256, BK = 64, HALF = 128, HTB = HALF * BK * 2, STAGE_BYTES = 8 * HTB, NXCD = 8, WGM = 8;

__host__ __device__ __forceinline__ int lds_byte(int r, int c) { const int st = (r >> 4) * 2 + (c >> 5), rr = r & 15, cc = c & 31, ob = rr * 64 + cc * 2; return st * 1024 + (ob ^ (((ob >> 9) & 1) << 5)); }
__host__ __device__ __forceinline__ void stage_rc(int b, int& R, int& C) { const int st = b / 1024, sb = b % 1024, swz = sb ^ (((sb >> 9) & 1) << 5); R = (st >> 1) * 16 + swz / 64; C = (st & 1) * 32 + (swz % 64) / 2; }
__host__ __device__ __forceinline__ int perm32(int rho) { const int n = rho >> 4, i = rho & 15; return 8 * (i >> 2) + 4 * n + (i & 3); }

struct Unit { int pm, pn, e; };

struct TileOrder {
    int nM, nN, nwg, G, c;
    __device__ __forceinline__ void init(int nM_, int nN_, int G_, int c_) { nM = nM_; nN = nN_; nwg = nM * nN; G = G_; c = c_; }
    __device__ __forceinline__ bool next(int i, int& pm, int& pn) const {
        const long L = (long)i * G + c; if (L >= nwg) return false;
        int wgid = (int)L; { const int q = nwg / NXCD, r = nwg % NXCD, xcd = wgid % NXCD, off = wgid / NXCD; wgid = (xcd < r ? xcd * (q + 1) : r * (q + 1) + (xcd - r) * q) + off; }
        const int nig = WGM * nN, gid = wgid / nig, fm = gid * WGM, gsz = (nM - fm) < WGM ? (nM - fm) : WGM;
        pm = fm + ((wgid % nig) % gsz); pn = (wgid % nig) / gsz; return true;
    }
};
struct DenseSched {
    TileOrder o; const char* Bt; int K;
    __device__ __forceinline__ bool next(int i, Unit& u) const { u.e = 0; return o.next(i, u.pm, u.pn); }
    __device__ __forceinline__ unsigned a_row(const Unit& u, int r) const { return (unsigned)(u.pm * BM + r); }
    __device__ __forceinline__ unsigned a_koff(const Unit&) const { return 0u; }
    __device__ __forceinline__ const char* b_base(const Unit& u) const { return Bt + (size_t)u.pn * BM * K * 2; }
};
struct ChainSched {
    TileOrder o; const char* Bt; int K;
    __device__ __forceinline__ bool next(int i, Unit& u) const { if (!o.next(i >> 1, u.pm, u.pn)) return false; u.e = i & 1; return true; }
    __device__ __forceinline__ unsigned a_row(const Unit& u, int r) const { return (unsigned)(u.pm * BM + r); }
    __device__ __forceinline__ unsigned a_koff(const Unit& u) const { return (unsigned)(u.e * K * 2); }
    __device__ __forceinline__ const char* b_base(const Unit& u) const { return Bt + (size_t)u.pn * BM * (2 * K) * 2 + (size_t)u.e * K * 2; }
};
template <bool GATHER> struct MoeSched {
    TileOrder o; const char* Bt; int K; int rows_per_e; const int* tile_e; const int* row_tok; int es;
    __device__ __forceinline__ bool next(int i, Unit& u) const { if (!o.next(i, u.pm, u.pn)) return false; u.e = __builtin_amdgcn_readfirstlane(tile_e[u.pm]); return true; }
    __device__ __forceinline__ unsigned a_row(const Unit& u, int r) const { if (GATHER) return (unsigned)row_tok[u.pm * BM + r]; else return (unsigned)(u.pm * BM + r); }
    __device__ __forceinline__ unsigned a_koff(const Unit&) const { return 0u; }
    __device__ __forceinline__ const char* b_base(const Unit& u) const { return Bt + ((size_t)u.e * rows_per_e + (size_t)u.pn * BM) * K * es; }
};

template <class Epi, class Sched>
__device__ __forceinline__ void gemm_phase(LAS unsigned char* lds, const char* gA, int K_, int lda, int ldb, const Sched& S, const Epi& E) {
    int K = K_; asm volatile("" : "+s"(K));
    int tid = threadIdx.x; asm volatile("" : "+v"(tid));     const int wid = __builtin_amdgcn_readfirstlane(tid >> 6), lane = tid & 63, wr = wid >> 2, wc = wid & 3, fr = lane & 15, fq = lane >> 4;
    constexpr int ES = Epi::F8 ? 1 : 2;
    const int nt = K * ES / 128;
    unsigned voffB[2];
#pragma unroll
    for (int i = 0; i < 2; ++i) { int R, C; stage_rc(tid * 16 + i * 8192, R, C); const int Rb = Epi::PERM ? ((R & ~31) + perm32(R & 31)) : R; voffB[i] = (unsigned)(Rb * ldb * ES + C * 2); }
    const unsigned kstep = (unsigned)(BK * 2);
    const size_t hstepB = (size_t)HALF * ldb * ES;
    const unsigned ldab = (unsigned)lda * ES;
    const unsigned ldsw = (unsigned)wid * 1024u;
    const int aoff = lds_byte(wr * 64 + fr, fq * 8), boff = lds_byte(wc * 32 + fr, fq * 8);
#define PG8_SA(b, h) (((b) * 2 + (h)) * HTB)
#define PG8_SB(b, h) ((4 + (b) * 2 + (h)) * HTB)
#define PG8_STAGE_B(bufoff, gbase) do { _Pragma("unroll") for (int _i = 0; _i < 2; ++_i) \
        __builtin_amdgcn_global_load_lds((const unsigned*)((const char*)(gbase) + voffB[_i]), (LAS unsigned*)(lds + (bufoff) + ldsw + _i * 8192), 16, 0, 0); } while (0)
#define PG8_STAGE_A(bufoff, o0, o1, kb) do { \
        const char* gk_ = gA + (kb);      \
        __builtin_amdgcn_global_load_lds((const unsigned*)(gk_ + (o0)), (LAS unsigned*)(lds + (bufoff) + ldsw), 16, 0, 0); \
        __builtin_amdgcn_global_load_lds((const unsigned*)(gk_ + (o1)), (LAS unsigned*)(lds + (bufoff) + ldsw + 8192), 16, 0, 0); } while (0)
#define PG8_LDA(dst, b, h) do { _Pragma("unroll") for (int m = 0; m < 4; ++m) _Pragma("unroll") for (int k = 0; k < 2; ++k) dst[m][k] = *(const LAS bf16x8*)(lds + PG8_SA(b, h) + aoff + m * 2048 + k * 1024); } while (0)
#define PG8_LDB(dst, b, h) do { _Pragma("unroll") for (int n = 0; n < 2; ++n) _Pragma("unroll") for (int k = 0; k < 2; ++k) dst[n][k] = *(const LAS bf16x8*)(lds + PG8_SB(b, h) + boff + n * 2048 + k * 1024); } while (0)
#define PG8_MMA(ai, bj, At, Bt) do { __builtin_amdgcn_s_setprio(1); \
        if constexpr (Epi::F8) { _Pragma("unroll") for (int m = 0; m < 4; ++m) _Pragma("unroll") for (int n = 0; n < 2; ++n) { \
            const i32x8 a8_ = __builtin_shufflevector(__builtin_bit_cast(i32x4, At[m][0]), __builtin_bit_cast(i32x4, At[m][1]), 0, 1, 2, 3, 4, 5, 6, 7); \
            const i32x8 b8_ = __builtin_shufflevector(__builtin_bit_cast(i32x4, Bt[n][0]), __builtin_bit_cast(i32x4, Bt[n][1]), 0, 1, 2, 3, 4, 5, 6, 7); \
            acc[ai][bj][m][n] = __builtin_amdgcn_mfma_scale_f32_16x16x128_f8f6f4(b8_, a8_, acc[ai][bj][m][n], 0, 0, 0, 0x7F7F7F7F, 0, 0x7F7F7F7F); } } \
        else { _Pragma("unroll") for (int m = 0; m < 4; ++m) _Pragma("unroll") for (int n = 0; n < 2; ++n) _Pragma("unroll") for (int k = 0; k < 2; ++k) \
            acc[ai][bj][m][n] = __builtin_amdgcn_mfma_f32_16x16x32_bf16(Bt[n][k], At[m][k], acc[ai][bj][m][n], 0, 0, 0); } \
        __builtin_amdgcn_s_setprio(0); } while (0)
#define PG8_WAIT_V(n) asm volatile("s_waitcnt vmcnt(" #n ")" ::: "memory")
#define PG8_WAIT_L(n) asm volatile("s_waitcnt lgkmcnt(" #n ")" ::: "memory")
#define PG8_BAR __builtin_amdgcn_s_barrier()
#define PG8_SCHED __builtin_amdgcn_sched_barrier(0)
#define PG8_AOFFS(dst, u) do { _Pragma("unroll") for (int _h = 0; _h < 2; ++_h) _Pragma("unroll") for (int _i = 0; _i < 2; ++_i) { int R_, C_; stage_rc(tid * 16 + _i * 8192, R_, C_); \
        dst[_h][_i] = S.a_row(u, _h * HALF + R_) * ldab + (unsigned)C_ * 2u + S.a_koff(u); } } while (0)
    Unit cur, nxt; int ui = 0;
    if (!S.next(0, cur)) return;
    f32x4 acc[2][2][4][2];
#pragma unroll
    for (int a = 0; a < 2; ++a)
#pragma unroll
        for (int b = 0; b < 2; ++b)
#pragma unroll
            for (int m = 0; m < 4; ++m)
#pragma unroll
                for (int n = 0; n < 2; ++n) acc[a][b][m][n] = (f32x4){0.f, 0.f, 0.f, 0.f};
    bf16x8 At[4][2], B0[2][2], B1[2][2];
    unsigned oc[2][2];
    LAS u32x4* nslot = (LAS u32x4*)(lds + LDSCTL_OFF + 2048) + tid;
    PG8_AOFFS(oc, cur);
    const char* cB = S.b_base(cur);
    PG8_STAGE_B(PG8_SB(0, 0), cB); PG8_STAGE_B(PG8_SB(0, 1), cB + hstepB); PG8_STAGE_A(PG8_SA(0, 0), oc[0][0], oc[0][1], 0u); PG8_STAGE_A(PG8_SA(0, 1), oc[1][0], oc[1][1], 0u);
    if (wr == 1) PG8_BAR;
    PG8_WAIT_V(2); PG8_BAR;
    PG8_STAGE_B(PG8_SB(1, 0), cB + kstep); PG8_STAGE_A(PG8_SA(1, 0), oc[0][0], oc[0][1], kstep); PG8_STAGE_B(PG8_SB(1, 1), cB + hstepB + kstep);
    PG8_WAIT_V(6); PG8_BAR;
    for (;;) {
        const bool has_next = S.next(ui + 1, nxt);
        const char* nB = has_next ? S.b_base(nxt) : cB;
        if (has_next) { unsigned on[2][2]; PG8_AOFFS(on, nxt); *nslot = (u32x4){on[0][0], on[0][1], on[1][0], on[1][1]}; }
        for (int t = 0; t < nt; t += 2) {
            const bool last = (t == nt - 2);
            const unsigned k1 = (unsigned)(t + 1) * kstep;
            const unsigned k2 = last ? 0u : (unsigned)(t + 2) * kstep, k3 = k2 + kstep;
            const char* b2 = last ? nB : cB + (size_t)(t + 2) * kstep; const char* b3 = b2 + kstep;
            PG8_LDB(B0, 0, 0); PG8_LDB(B1, 0, 1); PG8_SCHED; PG8_LDA(At, 0, 0); PG8_STAGE_A(PG8_SA(1, 1), oc[1][0], oc[1][1], k1);
            PG8_WAIT_V(8); PG8_WAIT_L(0); PG8_BAR; PG8_MMA(0, 0, At, B0); PG8_MMA(0, 1, At, B1); PG8_BAR; PG8_SCHED;
            if (last && has_next) { const u32x4 o_ = *nslot; oc[0][0] = o_.x; oc[0][1] = o_.y; oc[1][0] = o_.z; oc[1][1] = o_.w; }
            PG8_LDA(At, 0, 1); PG8_STAGE_B(PG8_SB(0, 0), b2); PG8_STAGE_B(PG8_SB(0, 1), b2 + hstepB); PG8_STAGE_A(PG8_SA(0, 0), oc[0][0], oc[0][1], k2);
            PG8_WAIT_V(8); PG8_WAIT_L(0); PG8_BAR; PG8_MMA(1, 0, At, B0); PG8_MMA(1, 1, At, B1); PG8_BAR; PG8_SCHED;
            PG8_LDB(B0, 1, 0); PG8_LDB(B1, 1, 1); PG8_SCHED; PG8_LDA(At, 1, 0); PG8_STAGE_A(PG8_SA(0, 1), oc[1][0], oc[1][1], k2);
            PG8_WAIT_V(8); PG8_WAIT_L(0); PG8_BAR; PG8_MMA(0, 0, At, B0); PG8_MMA(0, 1, At, B1); PG8_BAR; PG8_SCHED;
            PG8_LDA(At, 1, 1); PG8_STAGE_B(PG8_SB(1, 0), b3); PG8_STAGE_B(PG8_SB(1, 1), b3 + hstepB); PG8_STAGE_A(PG8_SA(1, 0), oc[0][0], oc[0][1], k3);
            PG8_WAIT_V(8); PG8_WAIT_L(0); PG8_BAR; PG8_MMA(1, 0, At, B0); PG8_MMA(1, 1, At, B1); PG8_BAR; PG8_SCHED;
        }
        if (wr == 0) PG8_BAR;
        bool carry = false;
        if constexpr (Epi::MIDK) { if (cur.e == 0) { E.mid(acc, cur, wr, wc, fr, fq); carry = true; } else E(acc, cur, wr, wc, fr, fq); } else E(acc, cur, wr, wc, fr, fq);
        if (!has_next) break;
        if (!carry)
#pragma unroll
        for (int a = 0; a < 2; ++a)
#pragma unroll
            for (int b = 0; b < 2; ++b)
#pragma unroll
                for (int m = 0; m < 4; ++m)
#pragma unroll
                    for (int n = 0; n < 2; ++n) acc[a][b][m][n] = (f32x4){0.f, 0.f, 0.f, 0.f};
        cur = nxt; cB = nB; ++ui;
        if (wr == 1) PG8_BAR;
    }
    PG8_WAIT_V(0);
    PG8_BAR;
#undef PG8_SA
#undef PG8_SB
#undef PG8_STAGE_A
#undef PG8_STAGE_B
#undef PG8_LDA
#undef PG8_LDB
#undef PG8_MMA
#undef PG8_WAIT_V
#undef PG8_WAIT_L
#undef PG8_BAR
#undef PG8_SCHED
#undef PG8_AOFFS
}

struct EpiProj {
    static constexpr bool PERM = true, MIDK = false, F8 = false;
    bf16_t* O; float* kmp;
    __device__ __forceinline__ void operator()(const f32x4 (&acc)[2][2][4][2], const Unit& u, int wr, int wc, int fr, int fq) const {
        const int row0 = u.pm * BM + wr * 64 + fr; const int col0 = u.pn * BM + wc * 32 + 8 * fq;
#pragma unroll
        for (int ai = 0; ai < 2; ++ai)
#pragma unroll
            for (int m = 0; m < 4; ++m) { bf16_t* rowp = O + (size_t)(row0 + ai * HALF + m * 16) * NPROJ + col0;
#pragma unroll
                for (int bj = 0; bj < 2; ++bj) { const f32x4 v0 = acc[ai][bj][m][0], v1 = acc[ai][bj][m][1];
                    u32x4 w; w.x = cvt_pk_bf16(v0[0], v0[1]); w.y = cvt_pk_bf16(v0[2], v0[3]); w.z = cvt_pk_bf16(v1[0], v1[1]); w.w = cvt_pk_bf16(v1[2], v1[3]);
                    *(u32x4*)(rowp + bj * HALF) = w; } }
        if (u.pn >= C_KB / BM && u.pn < C_VB / BM) {
#pragma unroll
            for (int bj = 0; bj < 2; ++bj)
#pragma unroll
                for (int n = 0; n < 2; ++n) { f32x4 s = (f32x4){0.f, 0.f, 0.f, 0.f};
#pragma unroll
                    for (int ai = 0; ai < 2; ++ai)
#pragma unroll
                        for (int m = 0; m < 4; ++m) s += acc[ai][bj][m][n];
#pragma unroll
                    for (int o = 1; o < 16; o <<= 1) { s[0] += __shfl_xor(s[0], o); s[1] += __shfl_xor(s[1], o); s[2] += __shfl_xor(s[2], o); s[3] += __shfl_xor(s[3], o); }
                    if (fr == 0) *(f32x4*)(kmp + ((size_t)wr * 64 + u.pm) * 1024 + (u.pn - C_KB / BM) * BM + bj * HALF + wc * 32 + 8 * fq + 4 * n) = s; }
        }
    }
};
struct EpiMerge {
    static constexpr bool PERM = true, MIDK = true, F8 = false;
    const bf16_t* proj; bf16_t* Y;
    __device__ __forceinline__ void mid(f32x4 (&acc)[2][2][4][2], const Unit& u, int wr, int wc, int fr, int fq) const {
        const int row0 = u.pm * BM + wr * 64 + fr; const int col0 = u.pn * BM + wc * 32 + 8 * fq;
#pragma unroll
        for (int ai = 0; ai < 2; ++ai)
#pragma unroll
            for (int m = 0; m < 4; ++m) { const bf16_t* rowp = proj + (size_t)(row0 + ai * HALF + m * 16) * NPROJ + col0;
#pragma unroll
                for (int bj = 0; bj < 2; ++bj) { const u32x4 ga = *(const u32x4*)(rowp + C_GA + bj * HALF), gb = *(const u32x4*)(rowp + C_GB + bj * HALF);
#pragma unroll
                    for (int j = 0; j < 4; ++j) { const float a0 = bflo(ga[j]), a1 = bfhi(ga[j]), b0 = bflo(gb[j]), b1 = bfhi(gb[j]);
                        const float r0 = (1.0f + __builtin_amdgcn_exp2f(-1.4426950408889634f * b0)) * __builtin_amdgcn_rcpf(1.0f + __builtin_amdgcn_exp2f(-1.4426950408889634f * a0));
                        const float r1 = (1.0f + __builtin_amdgcn_exp2f(-1.4426950408889634f * b1)) * __builtin_amdgcn_rcpf(1.0f + __builtin_amdgcn_exp2f(-1.4426950408889634f * a1));
                        acc[ai][bj][m][j >> 1][(j & 1) * 2] *= r0; acc[ai][bj][m][j >> 1][(j & 1) * 2 + 1] *= r1; } }
                asm volatile("" : "+v"(acc[ai][0][m][0]), "+v"(acc[ai][0][m][1]), "+v"(acc[ai][1][m][0]), "+v"(acc[ai][1][m][1]));
                asm volatile("" ::: "memory"); }
    }
    __device__ __forceinline__ void operator()(const f32x4 (&acc)[2][2][4][2], const Unit& u, int wr, int wc, int fr, int fq) const {
        const int row0 = u.pm * BM + wr * 64 + fr; const int col0 = u.pn * BM + wc * 32 + 8 * fq;
#pragma unroll
        for (int ai = 0; ai < 2; ++ai)
#pragma unroll
            for (int m = 0; m < 4; ++m) { const size_t r = (size_t)(row0 + ai * HALF + m * 16);
#pragma unroll
                for (int bj = 0; bj < 2; ++bj) { const u32x4 gb = *(const u32x4*)(proj + r * NPROJ + C_GB + col0 + bj * HALF);
                    const f32x4 v0 = acc[ai][bj][m][0], v1 = acc[ai][bj][m][1];
                    u32x4 w; w.x = cvt_pk_bf16(v0[0] * fsigmoid(bflo(gb[0])), v0[1] * fsigmoid(bfhi(gb[0]))); w.y = cvt_pk_bf16(v0[2] * fsigmoid(bflo(gb[1])), v0[3] * fsigmoid(bfhi(gb[1])));
                    w.z = cvt_pk_bf16(v1[0] * fsigmoid(bflo(gb[2])), v1[1] * fsigmoid(bfhi(gb[2]))); w.w = cvt_pk_bf16(v1[2] * fsigmoid(bflo(gb[3])), v1[3] * fsigmoid(bfhi(gb[3])));
                    *(u32x4*)(Y + r * D + col0 + bj * HALF) = w; }
                asm volatile("" ::: "memory"); }
    }
};
struct EpiResF32 {
    static constexpr bool PERM = false, MIDK = false, F8 = false;
    const float* base; float* out;
    __device__ __forceinline__ void operator()(const f32x4 (&acc)[2][2][4][2], const Unit& u, int wr, int wc, int fr, int fq) const {
        const int row0 = u.pm * BM + wr * 64 + fr, col0 = u.pn * BM + wc * 32 + 4 * fq;
#pragma unroll
        for (int ai = 0; ai < 2; ++ai)
#pragma unroll
            for (int m = 0; m < 4; ++m) { const size_t off = (size_t)(row0 + ai * HALF + m * 16) * D + col0;
#pragma unroll
                for (int bj = 0; bj < 2; ++bj)
#pragma unroll
                    for (int n = 0; n < 2; ++n) *(f32x4*)(out + off + bj * HALF + n * 16) = *(const f32x4*)(base + off + bj * HALF + n * 16) + acc[ai][bj][m][n];
                asm volatile("" ::: "memory"); }
    }
};
struct EpiGlu {
    static constexpr bool PERM = true, MIDK = false, F8 = true;
    unsigned char* H; const float* rstd_s; const float* bg; const float* bu;
    __device__ __forceinline__ void operator()(const f32x4 (&acc)[2][2][4][2], const Unit& u, int wr, int wc, int fr, int fq) const {
        const int row0 = u.pm * BM + wr * 64 + fr; const int colo = u.pn * HALF + wc * 32 + 8 * fq;
        f32x4 g4[2], u4[2];
#pragma unroll
        for (int n = 0; n < 2; ++n) { g4[n] = *(const f32x4*)(bg + (size_t)u.e * FF + colo + 4 * n); u4[n] = *(const f32x4*)(bu + (size_t)u.e * FF + colo + 4 * n); }
#pragma unroll
        for (int ai = 0; ai < 2; ++ai)
#pragma unroll
            for (int m = 0; m < 4; ++m) { const int r = row0 + ai * HALF + m * 16; const float rs = rstd_s[r] * (1.0f / 32.0f);
                float o[8];
#pragma unroll
                for (int n = 0; n < 2; ++n)
#pragma unroll
                    for (int j = 0; j < 4; ++j) { float g = acc[ai][0][m][n][j] * rs + g4[n][j], up = acc[ai][1][m][n][j] * rs + u4[n][j];
                        g = fminf(g, 7.0f); up = fminf(fmaxf(up, -7.0f), 7.0f);
                        const float glu = g * fsigmoid(1.702f * g); o[n * 4 + j] = (up + 1.0f) * glu; }
                u32x2 w; w.x = pk4_fp8(o[0], o[1], o[2], o[3]); w.y = pk4_fp8(o[4], o[5], o[6], o[7]);
                *(u32x2*)(H + (size_t)r * FF + colo) = w; asm volatile("" ::: "memory"); }
    }
};
template <int ACT, bool HASBIAS, bool F8_ = false> struct EpiBf16 {
    static constexpr bool PERM = true, MIDK = false, F8 = F8_;
    bf16_t* O; int ldc; const float* bias; int bias_stride; float scale;
    __device__ __forceinline__ void operator()(const f32x4 (&acc)[2][2][4][2], const Unit& u, int wr, int wc, int fr, int fq) const {
        const int row0 = u.pm * BM + wr * 64 + fr; const int col0 = u.pn * BM + wc * 32 + 8 * fq;
        f32x4 bv[2][2];
#pragma unroll
        for (int bj = 0; bj < 2; ++bj)
#pragma unroll
            for (int n = 0; n < 2; ++n) bv[bj][n] = HASBIAS ? *(const f32x4*)(bias + (size_t)u.e * bias_stride + col0 + bj * HALF + 4 * n) : (f32x4){0.f, 0.f, 0.f, 0.f};
#pragma unroll
        for (int ai = 0; ai < 2; ++ai)
#pragma unroll
            for (int m = 0; m < 4; ++m) { bf16_t* rowp = O + (size_t)(row0 + ai * HALF + m * 16) * ldc + col0;
#pragma unroll
                for (int bj = 0; bj < 2; ++bj) { f32x4 v0 = acc[ai][bj][m][0] * scale + bv[bj][0], v1 = acc[ai][bj][m][1] * scale + bv[bj][1];
                    if (ACT == 1) {
#pragma unroll
                        for (int j = 0; j < 4; ++j) { v0[j] = fsigmoid(v0[j]); v1[j] = fsigmoid(v1[j]); } }
                    u32x4 w; w.x = cvt_pk_bf16(v0[0], v0[1]); w.y = cvt_pk_bf16(v0[2], v0[3]); w.z = cvt_pk_bf16(v1[0], v1[1]); w.w = cvt_pk_bf16(v1[2], v1[3]);
                    *(u32x4*)(rowp + bj * HALF) = w; }
                asm volatile("" ::: "memory"); }
    }
};
}
__device__ __forceinline__ void transpose_item(const float* __restrict__ W, int ldw, int k0, int n_src0, bf16_t* __restrict__ WT, int ldo, int n_dst0, int k_off, LAS float* scr, int lane) {
#pragma unroll 8
    for (int i = 0; i < 32; ++i) { const int kk = 2 * i + (lane >> 5); scr[kk * 33 + (lane & 31)] = W[(size_t)(k0 + kk) * ldw + n_src0 + (lane & 31)]; }
    LDS_WAIT(); asm volatile("" ::: "memory");
    const int c = lane & 7;
#pragma unroll
    for (int j = 0; j < 4; ++j) { const int n = (lane >> 3) + 8 * j; const LAS float* s = scr + (8 * c) * 33 + n;
        u32x4 o; o.x = cvt_pk_bf16(s[0 * 33], s[1 * 33]); o.y = cvt_pk_bf16(s[2 * 33], s[3 * 33]); o.z = cvt_pk_bf16(s[4 * 33], s[5 * 33]); o.w = cvt_pk_bf16(s[6 * 33], s[7 * 33]);
        *(u32x4*)(WT + (size_t)(n_dst0 + n) * ldo + k_off + k0 + 8 * c) = o; }
    LDS_WAIT(); asm volatile("" ::: "memory");
}
__device__ __forceinline__ void transpose_item_f8(const float* __restrict__ W, int ldw, int k0, int n_src0, unsigned char* __restrict__ WT, int ldo, int n_dst0, float sc, LAS float* scr, int lane) {
#pragma unroll 8
    for (int i = 0; i < 32; ++i) { const int kk = 2 * i + (lane >> 5); scr[kk * 33 + (lane & 31)] = W[(size_t)(k0 + kk) * ldw + n_src0 + (lane & 31)]; }
    LDS_WAIT(); asm volatile("" ::: "memory");
    const int c = lane & 7;
#pragma unroll
    for (int j = 0; j < 4; ++j) { const int n = (lane >> 3) + 8 * j; const LAS float* s = scr + (8 * c) * 33 + n;
        u32x2 o; o.x = pk4_fp8(s[0 * 33] * sc, s[1 * 33] * sc, s[2 * 33] * sc, s[3 * 33] * sc); o.y = pk4_fp8(s[4 * 33] * sc, s[5 * 33] * sc, s[6 * 33] * sc, s[7 * 33] * sc);
        *(u32x2*)(WT + (size_t)(n_dst0 + n) * ldo + k0 + 8 * c) = o; }
    LDS_WAIT(); asm volatile("" ::: "memory");
}
__device__ __forceinline__ void transpose_mat_item(const float* W, int ldw, int N, int n_src_base, bf16_t* WT, int ldo, int n_dst_base, int k_off, LAS float* scr, int item, int lane) {
    const int nblk = N / 32, kb = item / nblk, nb = item % nblk;
    transpose_item(W, ldw, 64 * kb, n_src_base + 32 * nb, WT, ldo, n_dst_base + 32 * nb, k_off, scr, lane);
}

struct P {
    const float* in[25]; float* out; unsigned char* ws;
};

__device__ __forceinline__ void p0_prologue(const P& a, LAS unsigned char* lds, int vcu, int G, int wave, int lane) {
    LAS float* scr = (LAS float*)(lds + wave * 16384);
    const int gw = vcu * NWAVES + wave, NGW = G * NWAVES;
    unsigned char* ws = a.ws;
    bf16_t* WinT = (bf16_t*)(ws + WS_WIN); bf16_t* WupT = (bf16_t*)(ws + WS_WUP); bf16_t* WoT = (bf16_t*)(ws + WS_WO); bf16_t* WpgT = (bf16_t*)(ws + WS_WPG); bf16_t* WppT = (bf16_t*)(ws + WS_WPP);
    constexpr int I_A = 16 * 96, I_B = 16 * 160, I_S = 16 * 32, I_P = 4 * 32;
    constexpr int NITEMS = I_A + I_B + 4 * I_S + I_P;
#ifndef P0_PARTS
#define P0_PARTS 63
#endif
    if (P0_PARTS & 1)
    for (int it = gw; it < NITEMS; it += NGW) {
        int r = it;
        if (r < I_A) { transpose_mat_item(a.in[4], D_IN, 3072, 0, WinT, D, 0, 0, scr, r, lane); continue; } r -= I_A;
        if (r < I_B) { transpose_mat_item(a.in[4], D_IN, 5120, 3088, WinT, D, 3072, 0, scr, r, lane); continue; } r -= I_B;
        if (r < I_S) { transpose_mat_item(a.in[8], D, D, 0, WupT, 2048, 0, 0, scr, r, lane); continue; } r -= I_S;
        if (r < I_S) { transpose_mat_item(a.in[9], D, D, 0, WupT, 2048, 0, 1024, scr, r, lane); continue; } r -= I_S;
        if (r < I_S) { transpose_mat_item(a.in[10], D, D, 0, WoT, D, 0, 0, scr, r, lane); continue; } r -= I_S;
        if (r < I_S) { transpose_mat_item(a.in[21], D, D, 0, WpgT, D, 0, 0, scr, r, lane); continue; } r -= I_S;
        transpose_mat_item(a.in[22], D, D, 0, WppT, 256, 0, 0, scr, r, lane);
    }
    if (P0_PARTS & 2) {
        const float* x = a.in[0]; const float* g = a.in[3]; bf16_t* H = (bf16_t*)(ws + WS_H);
        f32x4 gv[4];
#pragma unroll
        for (int j = 0; j < 4; ++j) gv[j] = *((const f32x4*)g + lane + 64 * j);
        for (int m = gw; m < T; m += NGW) {
            const f32x4* xr = (const f32x4*)(x + (size_t)m * D) + lane; f32x4 v[4]; float s = 0.f;
#pragma unroll
            for (int j = 0; j < 4; ++j) { v[j] = xr[64 * j]; s += (v[j].x * v[j].x + v[j].y * v[j].y) + (v[j].z * v[j].z + v[j].w * v[j].w); }
            const float rstd = 1.0f / sqrtf(wave_sum(s) * (1.0f / D) + EPS);
            u32x2* o8 = (u32x2*)(H + (size_t)m * D) + lane;
#pragma unroll
            for (int j = 0; j < 4; ++j) { u32x2 w; w.x = cvt_pk_bf16(v[j].x * rstd * gv[j].x, v[j].y * rstd * gv[j].y); w.y = cvt_pk_bf16(v[j].z * rstd * gv[j].z, v[j].w * rstd * gv[j].w); o8[64 * j] = w; }
        }
    }
    if (P0_PARTS & 4) {
        const f32x4* p4 = (const f32x4*)a.in[1]; u32x2* pb = (u32x2*)(ws + WS_PB);
        const size_t n4 = (size_t)T * 256 / 4;
        for (size_t i = (size_t)gw * 64 + lane; i < n4; i += (size_t)NGW * 64) { const f32x4 v = p4[i]; u32x2 w; w.x = cvt_pk_bf16(v.x, v.y); w.y = cvt_pk_bf16(v.z, v.w); pb[i] = w; }
    }
    if (P0_PARTS & 8) {
        const int gt = (vcu * NWAVES + wave) * 64 + lane;
        if ((P0_PARTS & 16) && gt < 16 * 1024) { const int n = gt >> 10, k = gt & 1023; ((bf16_t*)(ws + WS_WALT))[n * 1024 + k] = (bf16_t)(cvt_pk_bf16(a.in[4][(size_t)k * D_IN + SRC_ALOW + n], 0.f) & 0xffffu); }
        if ((P0_PARTS & 32) && gt < 4096) { const int s = gt >> 6, l = gt & 63, e = l & 31, hh = l >> 5; const float* wr = a.in[12];
            float v[8], lo[8];
#pragma unroll
            for (int j = 0; j < 8; ++j) { v[j] = wr[(size_t)(16 * s + 8 * hh + j) * NE + e]; }
            u32x4 whi; whi.x = cvt_pk_bf16(v[0], v[1]); whi.y = cvt_pk_bf16(v[2], v[3]); whi.z = cvt_pk_bf16(v[4], v[5]); whi.w = cvt_pk_bf16(v[6], v[7]);
#pragma unroll
            for (int j = 0; j < 4; ++j) { lo[2 * j] = v[2 * j] - bflo(whi[j]); lo[2 * j + 1] = v[2 * j + 1] - bfhi(whi[j]); }
            u32x4 wlo; wlo.x = cvt_pk_bf16(lo[0], lo[1]); wlo.y = cvt_pk_bf16(lo[2], lo[3]); wlo.z = cvt_pk_bf16(lo[4], lo[5]); wlo.w = cvt_pk_bf16(lo[6], lo[7]);
            u32x4* f = (u32x4*)(ws + WS_WRF); f[gt] = whi; f[4096 + gt] = wlo; }
    }
}

__device__ __forceinline__ void expert_convert(const P& a, LAS unsigned char* lds, int vcu, int G, int wave, int lane) {
    LAS float* scr = (LAS float*)(lds + wave * 16384);
    const int gw = vcu * NWAVES + wave, NGW = G * NWAVES;
    unsigned char* W1T = a.ws + WS_W1T; unsigned char* W2T = a.ws + WS_W2T;
    constexpr int IPM = 16 * 32;
    for (int it = gw; it < NE * 3 * IPM; it += NGW) {
        const int e = it / (3 * IPM), r0 = it % (3 * IPM), which = r0 / IPM, r = r0 % IPM, kb = r / 32, nb = r % 32;
        if (which < 2) { const float* W = a.in[which == 0 ? 14 : 16] + (size_t)e * D * FF; const int n0 = 32 * nb;
            transpose_item_f8(W, FF, 64 * kb, n0, W1T + (size_t)e * 2048 * D, D, (n0 >> 7) * 256 + (n0 & 127) + which * 128, 32.0f, scr, lane); }
        else { const float* W = a.in[18] + (size_t)e * FF * D; transpose_item_f8(W, D, 64 * kb, 32 * nb, W2T + (size_t)e * D * FF, FF, 32 * nb, 32.0f, scr, lane); }
    }
}

__device__ __forceinline__ float logsigmoidf_(float x) { return fminf(x, 0.0f) - log1pf(expf(-fabsf(x))); }
__device__ __forceinline__ void gla_prep_unit(const P& a, LAS unsigned char* lds, int unit) {
    int tid = threadIdx.x; asm volatile("" : "+v"(tid));     const int wave = __builtin_amdgcn_readfirstlane(tid >> 6), lane = tid & 63;
    const int b = unit >> 5, chunk = unit & 31, tok0 = b * SEQ + chunk * 64;
    const bf16_t* H = (const bf16_t*)(a.ws + WS_H); const bf16_t* WalT = (const bf16_t*)(a.ws + WS_WALT); const bf16_t* proj = (const bf16_t*)(a.ws + WS_PROJ);
    LAS float* part = (LAS float*)lds;
    LAS float* alow = (LAS float*)(lds + 8192);
    LAS float* seg = (LAS float*)(lds + 12288);
    {
        const int rg = wave & 3, kh = wave >> 2, r = lane & 15, q = lane >> 4;
        f32x4 acc = (f32x4){0.f, 0.f, 0.f, 0.f};
        const bf16_t* ap = H + (size_t)(tok0 + 16 * rg + r) * D + 512 * kh + 8 * q; const bf16_t* bp = WalT + (size_t)r * D + 512 * kh + 8 * q;
#pragma unroll 4
        for (int s = 0; s < 16; ++s) { const bf16x8 av = *(const bf16x8*)(ap + 32 * s), bv = *(const bf16x8*)(bp + 32 * s); acc = __builtin_amdgcn_mfma_f32_16x16x32_bf16(bv, av, acc, 0, 0, 0); }
        *(LAS f32x4*)(part + (kh * 64 + 16 * rg + r) * 16 + 4 * q) = acc;
    }
    __syncthreads();
    if (tid < 256) { *(LAS f32x4*)(alow + tid * 4) = *(LAS f32x4*)(part + tid * 4) + *(LAS f32x4*)(part + 1024 + tid * 4); }
    __syncthreads();
    const int dp = tid & 63, tq = wave;
    const float* w_a2 = a.in[5]; const float* b_a2 = a.in[6];
    for (int h = 0; h < 4; ++h) {
        const int dcol = h * 128 + 2 * dp;
        f32x2 w2[16];
#pragma unroll
        for (int r = 0; r < 16; ++r) w2[r] = *(const f32x2*)(w_a2 + r * 512 + dcol);
        const f32x2 b2 = *(const f32x2*)(b_a2 + dcol);
        unsigned qv[8], kv[8];
#pragma unroll
        for (int i = 0; i < 8; ++i) { const bf16_t* rp = proj + (size_t)(tok0 + 8 * tq + i) * NPROJ + dcol; qv[i] = *(const unsigned*)(rp + C_QA); kv[i] = *(const unsigned*)(rp + C_KA); }
        float G0[8], G1[8]; float r0 = 0.f, r1 = 0.f;
#pragma unroll
        for (int i = 0; i < 8; ++i) { const LAS f32x4* al4 = (const LAS f32x4*)(alow + (8 * tq + i) * 16); float x0 = b2.x, x1 = b2.y;
#pragma unroll
            for (int r4 = 0; r4 < 4; ++r4) { const f32x4 al = al4[r4];
#pragma unroll
                for (int j = 0; j < 4; ++j) { x0 += al[j] * w2[4 * r4 + j].x; x1 += al[j] * w2[4 * r4 + j].y; } }
            r0 += logsigmoidf_(x0) * (1.0f / 16.0f); r1 += logsigmoidf_(x1) * (1.0f / 16.0f); G0[i] = r0; G1[i] = r1; }
        *(LAS f32x2*)(seg + tq * 128 + 2 * dp) = (f32x2){r0, r1};
        __syncthreads();
        float off0 = 0.f, off1 = 0.f, tot0 = 0.f, tot1 = 0.f;
#pragma unroll
        for (int q = 0; q < 8; ++q) { const f32x2 s = *(LAS f32x2*)(seg + q * 128 + 2 * dp); tot0 += s.x; tot1 += s.y; if (q < tq) { off0 += s.x; off1 += s.y; } }
        const size_t tile = (size_t)((b * 4 + h) * 32 + chunk);
        bf16_t* Qg = (bf16_t*)(a.ws + WS_QG) + tile * 8192; bf16_t* Kg = (bf16_t*)(a.ws + WS_KG) + tile * 8192; bf16_t* KdT = (bf16_t*)(a.ws + WS_KDT) + tile * 8192;
        float kd0[8], kd1[8];
#pragma unroll
        for (int i = 0; i < 8; ++i) { const float g0 = G0[i] + off0, g1 = G1[i] + off1; const float q0 = bflo(qv[i]), q1 = bfhi(qv[i]), k0 = bflo(kv[i]), k1 = bfhi(kv[i]);
            const float e0 = expf(g0), e1 = expf(g1);
            *(unsigned*)(Qg + (8 * tq + i) * 128 + 2 * dp) = cvt_pk_bf16(q0 * e0 * 0.08838834764831845f, q1 * e1 * 0.08838834764831845f);
            *(unsigned*)(Kg + (8 * tq + i) * 128 + 2 * dp) = cvt_pk_bf16(k0 * expf(-g0), k1 * expf(-g1));
            kd0[i] = k0 * expf(tot0 - g0); kd1[i] = k1 * expf(tot1 - g1); }
        u32x4 w0, w1; w0.x = cvt_pk_bf16(kd0[0], kd0[1]); w0.y = cvt_pk_bf16(kd0[2], kd0[3]); w0.z = cvt_pk_bf16(kd0[4], kd0[5]); w0.w = cvt_pk_bf16(kd0[6], kd0[7]);
        w1.x = cvt_pk_bf16(kd1[0], kd1[1]); w1.y = cvt_pk_bf16(kd1[2], kd1[3]); w1.z = cvt_pk_bf16(kd1[4], kd1[5]); w1.w = cvt_pk_bf16(kd1[6], kd1[7]);
        *(u32x4*)(KdT + (2 * dp) * 64 + 8 * tq) = w0; *(u32x4*)(KdT + (2 * dp + 1) * 64 + 8 * tq) = w1;
        if (tq == 0) *(f32x2*)((float*)(a.ws + WS_DEC) + tile * 128 + 2 * dp) = (f32x2){expf(tot0), expf(tot1)};
        __syncthreads();
    }
}

constexpr int GL_QG = 0, GL_KG = 17408, GL_KDT = 34816, GL_VT = 53248, GL_AM = 90112, GL_DEC = 99328, GL_OST = 0;
constexpr int GL_QS = 272, GL_TS = 144, GL_OS = 528;
__device__ __forceinline__ int crow(int r, int hi) { return (r & 3) + 8 * (r >> 2) + 4 * hi; }
__device__ __forceinline__ bf16x8 pack_step(const f32x16& x, int s) {
    u32x4 p; p.x = cvt_pk_bf16(x[8 * s + 0], x[8 * s + 1]); p.y = cvt_pk_bf16(x[8 * s + 2], x[8 * s + 3]); p.z = cvt_pk_bf16(x[8 * s + 4], x[8 * s + 5]); p.w = cvt_pk_bf16(x[8 * s + 6], x[8 * s + 7]);
    return __builtin_bit_cast(bf16x8, p);
}
__device__ __forceinline__ void gla_scan_unit(const P& a, LAS unsigned char* lds, int unit) {
    int tid = threadIdx.x; asm volatile("" : "+v"(tid));     const int w = __builtin_amdgcn_readfirstlane(tid >> 6), lane = tid & 63, c32 = lane & 31, hi = lane >> 5;
    const int b = unit >> 2, h = unit & 3;
    const bf16_t* proj = (const bf16_t*)(a.ws + WS_PROJ); bf16_t* oab = (bf16_t*)(a.ws + WS_OAB);
    const float* ggo = a.in[7];
    f32x16 S[4];
#pragma unroll
    for (int i = 0; i < 4; ++i)
#pragma unroll
        for (int r = 0; r < 16; ++r) S[i][r] = 0.f;
    u32x4 sq[2], sk[2], sd[2]; unsigned sv[16]; float sdec = 0.f;
    const int ep = tid & 127, sq4 = tid >> 7;
#define GL_LOAD(chunk_) do { const size_t tile_ = (size_t)((b * 4 + h) * 32 + (chunk_)); \
        const u32x4* q_ = (const u32x4*)((const bf16_t*)(a.ws + WS_QG) + tile_ * 8192); const u32x4* k_ = (const u32x4*)((const bf16_t*)(a.ws + WS_KG) + tile_ * 8192); const u32x4* d_ = (const u32x4*)((const bf16_t*)(a.ws + WS_KDT) + tile_ * 8192); \
        sq[0] = q_[tid]; sq[1] = q_[tid + 512]; sk[0] = k_[tid]; sk[1] = k_[tid + 512]; sd[0] = d_[tid]; sd[1] = d_[tid + 512]; \
        const bf16_t* v_ = proj + (size_t)(b * SEQ + (chunk_) * 64 + 16 * sq4) * NPROJ + C_VA + h * 256 + 2 * ep; \
        _Pragma("unroll") for (int i_ = 0; i_ < 16; ++i_) sv[i_] = *(const unsigned*)(v_ + (size_t)i_ * NPROJ); \
        if (tid < 128) sdec = ((const float*)(a.ws + WS_DEC))[tile_ * 128 + tid]; } while (0)
    GL_LOAD(0);
    for (int chunk = 0; chunk < 32; ++chunk) {
#pragma unroll
        for (int i = 0; i < 2; ++i) { const int p = tid + 512 * i;
            *(LAS u32x4*)(lds + GL_QG + (p >> 4) * GL_QS + (p & 15) * 16) = sq[i]; *(LAS u32x4*)(lds + GL_KG + (p >> 4) * GL_QS + (p & 15) * 16) = sk[i];
            *(LAS u32x4*)(lds + GL_KDT + (p >> 3) * GL_TS + (p & 7) * 16) = sd[i]; }
        {   u32x4 lo0, lo1, hi0, hi1;
#pragma unroll
            for (int j = 0; j < 4; ++j) { lo0[j] = (sv[2 * j] & 0xffffu) | (sv[2 * j + 1] << 16); lo1[j] = (sv[8 + 2 * j] & 0xffffu) | (sv[8 + 2 * j + 1] << 16);
                hi0[j] = (sv[2 * j] >> 16) | (sv[2 * j + 1] & 0xffff0000u); hi1[j] = (sv[8 + 2 * j] >> 16) | (sv[8 + 2 * j + 1] & 0xffff0000u); }
            LAS unsigned char* v0 = lds + GL_VT + (2 * ep) * GL_TS + sq4 * 32;
            *(LAS u32x4*)(v0) = lo0; *(LAS u32x4*)(v0 + 16) = lo1; *(LAS u32x4*)(v0 + GL_TS) = hi0; *(LAS u32x4*)(v0 + GL_TS + 16) = hi1; }
        if (tid < 128) *(LAS float*)(lds + GL_DEC + tid * 4) = sdec;
        __syncthreads();
        if (chunk + 1 < 32) GL_LOAD(chunk + 1);
        if (w < 3) {
            const int ti = (w + 1) >> 1, si = w >> 1;
            f32x16 A;
#pragma unroll
            for (int r = 0; r < 16; ++r) A[r] = 0.f;
#pragma unroll
            for (int s = 0; s < 8; ++s) { const bf16x8 av = *(const LAS bf16x8*)(lds + GL_QG + (32 * ti + c32) * GL_QS + (16 * s + 8 * hi) * 2), bv = *(const LAS bf16x8*)(lds + GL_KG + (32 * si + c32) * GL_QS + (16 * s + 8 * hi) * 2);
                A = __builtin_amdgcn_mfma_f32_32x32x16_bf16(av, bv, A, 0, 0, 0); }
            const int sidx = 32 * si + c32;
#pragma unroll
            for (int r = 0; r < 16; ++r) { const int t = 32 * ti + crow(r, hi); const float v = (sidx <= t) ? A[r] : 0.f;
                *(LAS bf16_t*)(lds + GL_AM + t * GL_TS + sidx * 2) = (bf16_t)(cvt_pk_bf16(v, 0.f) & 0xffffu); }
        }
        __syncthreads();
        f32x16 o[2];
        {
            bf16x8 vt[4];
#pragma unroll
            for (int ks = 0; ks < 4; ++ks) vt[ks] = *(const LAS bf16x8*)(lds + GL_VT + (32 * w + c32) * GL_TS + (16 * ks + 8 * hi) * 2);
#pragma unroll
            for (int ti = 0; ti < 2; ++ti) {
#pragma unroll
                for (int r = 0; r < 16; ++r) o[ti][r] = 0.f;
#pragma unroll
                for (int tile = 0; tile < 4; ++tile)
#pragma unroll
                    for (int s = 0; s < 2; ++s) { const LAS unsigned char* qp = lds + GL_QG + (32 * ti + c32) * GL_QS + (32 * tile + 16 * s + 4 * hi) * 2;
                        const s16x4 lo = *(const LAS s16x4*)qp, hh = *(const LAS s16x4*)(qp + 16);
                        const bf16x8 aop = __builtin_shufflevector(lo, hh, 0, 1, 2, 3, 4, 5, 6, 7);
                        o[ti] = __builtin_amdgcn_mfma_f32_32x32x16_bf16(aop, pack_step(S[tile], s), o[ti], 0, 0, 0); }
#pragma unroll
                for (int ks = 0; ks < 4; ++ks) { if (ti == 0 && ks >= 2) continue;
                    const bf16x8 av = *(const LAS bf16x8*)(lds + GL_AM + (32 * ti + c32) * GL_TS + (16 * ks + 8 * hi) * 2);
                    o[ti] = __builtin_amdgcn_mfma_f32_32x32x16_bf16(av, vt[ks], o[ti], 0, 0, 0); }
            }
#pragma unroll
            for (int tile = 0; tile < 4; ++tile) {
#pragma unroll
                for (int g = 0; g < 4; ++g) { const f32x4 dv = *(const LAS f32x4*)(lds + GL_DEC + (32 * tile + 8 * g + 4 * hi) * 4);
#pragma unroll
                    for (int j = 0; j < 4; ++j) S[tile][4 * g + j] *= dv[j]; }
#pragma unroll
                for (int ks = 0; ks < 4; ++ks) { const bf16x8 av = *(const LAS bf16x8*)(lds + GL_KDT + (32 * tile + c32) * GL_TS + (16 * ks + 8 * hi) * 2);
                    S[tile] = __builtin_amdgcn_mfma_f32_32x32x16_bf16(av, vt[ks], S[tile], 0, 0, 0); }
            }
        }
        __syncthreads();
#pragma unroll
        for (int ti = 0; ti < 2; ++ti)
#pragma unroll
            for (int r = 0; r < 16; ++r) *(LAS bf16_t*)(lds + GL_OST + (32 * ti + crow(r, hi)) * GL_OS + (32 * w + c32) * 2) = (bf16_t)(cvt_pk_bf16(o[ti][r], 0.f) & 0xffffu);
        __syncthreads();
        {
            const int t = tid >> 3, sg = tid & 7; const size_t tok = (size_t)(b * SEQ + chunk * 64 + t);
            u32x4 ov[4]; float ss = 0.f;
#pragma unroll
            for (int j = 0; j < 4; ++j) { ov[j] = *(const LAS u32x4*)(lds + GL_OST + t * GL_OS + sg * 64 + j * 16);
#pragma unroll
                for (int i = 0; i < 4; ++i) { const float x0 = bflo(ov[j][i]), x1 = bfhi(ov[j][i]); ss += x0 * x0 + x1 * x1; } }
            ss += __shfl_xor(ss, 1); ss += __shfl_xor(ss, 2); ss += __shfl_xor(ss, 4);
            const float rstd = 1.0f / sqrtf(ss * (1.0f / 256.0f) + EPS);
            const bf16_t* rap = proj + tok * NPROJ + C_RA + h * 256 + sg * 32; bf16_t* op = oab + tok * 2048 + h * 256 + sg * 32; const float* gp = ggo + sg * 32;
#pragma unroll
            for (int j = 0; j < 4; ++j) { const u32x4 ra = *(const u32x4*)(rap + 8 * j); const f32x4 g0 = *(const f32x4*)(gp + 8 * j), g1 = *(const f32x4*)(gp + 8 * j + 4); u32x4 wv;
#pragma unroll
                for (int i = 0; i < 4; ++i) { const float r0 = bflo(ra[i]), r1 = bfhi(ra[i]); const float ga = (i < 2) ? g0[2 * i] : g1[2 * i - 4], gb = (i < 2) ? g0[2 * i + 1] : g1[2 * i - 3];
                    wv[i] = cvt_pk_bf16(bflo(ov[j][i]) * rstd * ga * (r0 * fsigmoid(r0)), bfhi(ov[j][i]) * rstd * gb * (r1 * fsigmoid(r1))); }
                *(u32x4*)(op + 8 * j) = wv; }
        }
        __syncthreads();
    }
#undef GL_LOAD
}
namespace moba {
constexpr int HD = 128;
constexpr float SCALE = 0.08838834764831845f;
constexpr float THR = 8.f;
constexpr int NW = 8, QBLK = 32, KVBLK = 64, QB = NW * QBLK;
constexpr int SHM_V = KVBLK * HD * 2, SHM_K = KVBLK * HD * 2;
constexpr int OFF_WS = 2 * SHM_V + 2 * SHM_K;
constexpr int OFF_RTAB = OFF_WS + NW * 64 * 4;
constexpr int OFF_KM = OFF_RTAB + 2304 * 4;
constexpr int OFF_MISC = OFF_KM + 8 * 128 * 4;
constexpr int OFF_SEL = OFF_MISC + 64;
constexpr int LDS_BYTES = OFF_SEL + 2048;
constexpr int LDP = NPROJ, LDO = 2048;

#define KSWZ(row, colB) ((row) * 256 + ((colB) ^ (((row) & 7) << 4)))
#define SBAR() __builtin_amdgcn_sched_barrier(0)
__device__ __forceinline__ int v_st(int k, int c) { const int kk = (k & ~0xC) | ((k & 4) << 1) | ((k & 8) >> 1); return ((kk >> 3) * 4 + (c >> 5)) * 512 + ((kk & 7) * 32 + (c & 31)) * 2; }
__device__ __forceinline__ int v_rd_base(int lane) { return ((lane & 3) << 3) | (((lane >> 2) & 3) << 6) | (((lane >> 4) & 1) << 5) | (((lane >> 5) & 1) << 8); }
constexpr int v_rd_off(int d0, int ks, int half) { return d0 * 512 + ks * 4096 + half * 2048; }
__device__ __forceinline__ int crow(int r, int hi) { return (r & 3) + 8 * (r >> 2) + 4 * hi; }
__device__ __forceinline__ unsigned cvtpk(float lo, float hi) { unsigned r; asm volatile("v_cvt_pk_bf16_f32 %0, %1, %2" : "=v"(r) : "v"(lo), "v"(hi)); return r; }

__device__ __forceinline__ void mask_tile(f32x16& p0, f32x16& p1, int dq) {
    const float NEG = -__builtin_inff();
#pragma unroll
    for (int r = 0; r < 16; ++r) {
        const int c = (r & 3) + 8 * (r >> 2);
        if (dq - c < 0) p0[r] = NEG;
        if (dq - c - 32 < 0) p1[r] = NEG;
    }
}
__device__ __forceinline__ void bias_tile(f32x16& p0, f32x16& p1, const LAS float* rt) {
#pragma unroll
    for (int r = 0; r < 16; ++r) { const int c = (r & 3) + 8 * (r >> 2); p0[r] += rt[c]; p1[r] += rt[c + 32]; }
}
__device__ __forceinline__ void kill_tile(f32x16& p0, f32x16& p1) {
    const float NEG = -__builtin_inff();
#pragma unroll
    for (int r = 0; r < 16; ++r) { p0[r] = NEG; p1[r] = NEG; }
}
__device__ __forceinline__ void partialSM(f32x16& p0, f32x16& p1, float& m_reg, float& mn, float& alpha) {
    float pmax = p0[0];
#pragma unroll
    for (int r = 1; r < 16; ++r) pmax = fmaxf(pmax, p0[r]);
#pragma unroll
    for (int r = 0; r < 16; ++r) pmax = fmaxf(pmax, p1[r]);
    { auto rr = __builtin_amdgcn_permlane32_swap(__float_as_uint(pmax), __float_as_uint(pmax), false, false);
      pmax = fmaxf(__uint_as_float(rr[0]), __uint_as_float(rr[1])); }
    constexpr float C2 = 1.4426950408889634f * SCALE;
    if (__builtin_expect(__all((pmax - m_reg) * SCALE <= THR), 1)) { mn = m_reg; alpha = 1.f; }
    else { mn = fmaxf(m_reg, pmax); alpha = __builtin_amdgcn_exp2f((m_reg - mn) * C2); m_reg = mn; }
    const float mnL = -mn * C2;
#pragma unroll
    for (int r = 0; r < 16; ++r) p0[r] = fmaf(p0[r], C2, mnL);
#pragma unroll
    for (int r = 0; r < 16; ++r) p1[r] = fmaf(p1[r], C2, mnL);
#pragma unroll
    for (int r = 0; r < 16; ++r) p0[r] = __builtin_amdgcn_exp2f(p0[r]);
}
__device__ __forceinline__ void finishSM(f32x16& p0, f32x16& p1, float alpha, float& l_reg, bf16x8& pa0, bf16x8& pa1, bf16x8& pa2, bf16x8& pa3) {
#pragma unroll
    for (int r = 0; r < 16; ++r) p1[r] = __builtin_amdgcn_exp2f(p1[r]);
    float ps = 0;
#pragma unroll
    for (int r = 0; r < 16; ++r) ps += p0[r];
#pragma unroll
    for (int r = 0; r < 16; ++r) ps += p1[r];
    { auto rr = __builtin_amdgcn_permlane32_swap(__float_as_uint(ps), __float_as_uint(ps), false, false);
      ps = __uint_as_float(rr[0]) + __uint_as_float(rr[1]); }
    l_reg = l_reg * alpha + ps;
#define PK4(P, B_, OUT) do { unsigned a0 = cvtpk(P[B_+0], P[B_+1]), a1 = cvtpk(P[B_+2], P[B_+3]);                          \
        unsigned b0 = cvtpk(P[B_+4], P[B_+5]), b1 = cvtpk(P[B_+6], P[B_+7]);                                             \
        auto r0 = __builtin_amdgcn_permlane32_swap(a0, b0, false, false); auto r1 = __builtin_amdgcn_permlane32_swap(a1, b1, false, false); \
        u32x4 w = {r0[0], r1[0], r0[1], r1[1]}; OUT = __builtin_bit_cast(bf16x8, w); } while (0)
    PK4(p0, 0, pa0); PK4(p0, 8, pa1); PK4(p1, 0, pa2); PK4(p1, 8, pa3);
#undef PK4
}
template <int KB>
__device__ __forceinline__ void qkt(f32x16& p0, f32x16& p1, const char* K_lds, int r32, int hi, const bf16x8* qr) {
#pragma unroll
    for (int r = 0; r < 16; ++r) { p0[r] = 0.f; p1[r] = 0.f; }
    const char* kb[4];
#pragma unroll
    for (int dd = 0; dd < 4; ++dd) kb[dd] = K_lds + KB * SHM_K + KSWZ(r32, (dd * 16 + hi * 8) * 2);
#pragma unroll
    for (int d0 = 0; d0 < 8; ++d0) { const char* a = kb[d0 & 3] + (d0 >> 2) * 128;
        bf16x8 b0 = *reinterpret_cast<const bf16x8*>(a);
        bf16x8 b1 = *reinterpret_cast<const bf16x8*>(a + 32 * 256);
        p0 = __builtin_amdgcn_mfma_f32_32x32x16_bf16(b0, qr[d0], p0, 0, 0, 0);
        p1 = __builtin_amdgcn_mfma_f32_32x32x16_bf16(b1, qr[d0], p1, 0, 0, 0); }
}
template <int VB>
__device__ __forceinline__ void pv_tile(f32x16* o, int vb0, bf16x8 pa0, bf16x8 pa1, bf16x8 pa2, bf16x8 pa3) {
#define TRRD(dst, off) asm volatile("ds_read_b64_tr_b16 %0, %1 offset:%2" : "=&v"(dst) : "v"(vb0), "i"(off) : "memory")
#define PV_D0(d0) do { s16x4 l0, l1, l2, l3, h0, h1, h2, h3; constexpr int b_ = VB * SHM_V + v_rd_off(d0, 0, 0);   \
        TRRD(l0, b_); TRRD(h0, b_ + 2048); TRRD(l1, b_ + 4096); TRRD(h1, b_ + 6144); TRRD(l2, b_ + 8192); TRRD(h2, b_ + 10240); TRRD(l3, b_ + 12288); TRRD(h3, b_ + 14336); \
        asm volatile("s_waitcnt lgkmcnt(0)" ::: "memory"); SBAR();   \
        o[d0] = __builtin_amdgcn_mfma_f32_32x32x16_bf16(pa0, (bf16x8){l0[0], l0[1], l0[2], l0[3], h0[0], h0[1], h0[2], h0[3]}, o[d0], 0, 0, 0);   \
        o[d0] = __builtin_amdgcn_mfma_f32_32x32x16_bf16(pa1, (bf16x8){l1[0], l1[1], l1[2], l1[3], h1[0], h1[1], h1[2], h1[3]}, o[d0], 0, 0, 0);   \
        o[d0] = __builtin_amdgcn_mfma_f32_32x32x16_bf16(pa2, (bf16x8){l2[0], l2[1], l2[2], l2[3], h2[0], h2[1], h2[2], h2[3]}, o[d0], 0, 0, 0);   \
        o[d0] = __builtin_amdgcn_mfma_f32_32x32x16_bf16(pa3, (bf16x8){l3[0], l3[1], l3[2], l3[3], h3[0], h3[1], h3[2], h3[3]}, o[d0], 0, 0, 0); } while (0)
    PV_D0(0); PV_D0(1); PV_D0(2); PV_D0(3);
#undef PV_D0
#undef TRRD
}

struct BlockRef { const bf16_t* Q; const bf16_t* K; const bf16_t* V; bf16_t* O; int qb; int b, h; };
struct Seam { bf16x8 qr[8]; bf16x8 st_v0, st_v1, st_k0, st_k1; };
#define VMW() asm volatile("s_waitcnt vmcnt(0)" ::: "memory")
#define VMWN(n) asm volatile("s_waitcnt vmcnt(%0)" :: "i"(n) : "memory")
#define LD8(p) (*reinterpret_cast<const bf16x8*>(p))
#define SLOAD_H(Kp, Vp, k0) do { const char* kb__ = (const char*)(Kp) + (size_t)(k0) * (LDP * 2); \
        S.st_v0 = LD8(kb__ + 2048 + kvoff); S.st_v1 = LD8(kb__ + (32 * LDP * 2 + 2048) + kvoff); S.st_k0 = LD8(kb__ + kvoff); S.st_k1 = LD8(kb__ + 32 * LDP * 2 + kvoff); } while (0)
#define SWRITE_HK(bf) do { *(bf16x8*)(K_lds + (bf) * SHM_K + kws) = S.st_k0; *(bf16x8*)(K_lds + (bf) * SHM_K + kws + 32 * 256) = S.st_k1; } while (0)
#define SWRITE_HV(bf) do { *(bf16x8*)(V_lds + (bf) * SHM_V + vst0) = S.st_v0; *(bf16x8*)(V_lds + (bf) * SHM_V + vst1) = S.st_v1; } while (0)
#define SWRITE_H(bf) do { SWRITE_HV(bf); SWRITE_HK(bf); } while (0)

__device__ __forceinline__ void prime(const BlockRef& cur, char* lds, Seam& S) {
    int tid = threadIdx.x; asm volatile("" : "+v"(tid));     const int wid = __builtin_amdgcn_readfirstlane(tid >> 6), lane = tid & 63, r32 = lane & 31, hi = lane >> 5;
    const int sr = tid >> 4, sc = (tid & 15) * 8, kws = KSWZ(sr, sc * 2); char* K_lds = lds + 2 * SHM_V;
    const unsigned kvoff = (unsigned)(sr * LDP + sc) * 2u, qvoff = (unsigned)(r32 * LDP + hi * 8) * 2u;
    { const char* qb__ = (const char*)cur.Q + (size_t)(wid * QBLK) * (LDP * 2);
#pragma unroll
    for (int d0 = 0; d0 < 8; ++d0) S.qr[d0] = LD8(qb__ + qvoff + d0 * 32); }
    SLOAD_H(cur.K, cur.V, 0); VMW(); SWRITE_HK(0);
    __syncthreads();
}
__device__ __forceinline__ int rel_bucket(int n) {
    if (n < 16) return n;
    const float nf = (float)n;
    int large = 16 + (int)(logf(nf / 16.0f) / 5.545177444479562f * 16.0f);
    return large < 31 ? large : 31;
}
__device__ __forceinline__ void block(const BlockRef& cur, const BlockRef& nxt, const float* rel_bias, const float* kmp, char* lds, Seam& S) {
    int tid = threadIdx.x; asm volatile("" : "+v"(tid));     const int wid = __builtin_amdgcn_readfirstlane(tid >> 6), lane = tid & 63, r32 = lane & 31, hi = lane >> 5;
    const int qb = cur.qb, NT = 4 * (qb + 1);
    const int qlo = qb * QB + wid * QBLK, qrow = qlo + r32;
    char* V_lds = lds; char* K_lds = lds + 2 * SHM_V;
    float* ws = (float*)(lds + OFF_WS) + wid * 64; float* li_l = ws, * al_l = ws + 32;
    LAS float* rtab = (LAS float*)(LAS char*)(uintptr_t)(unsigned)(uintptr_t)(lds + OFF_RTAB);
    float* kmL = (float*)(lds + OFF_KM);
    for (int i = tid; i < 2304; i += NW * 64) { const int dist = 2047 - i; rtab[i] = dist >= 0 ? rel_bias[rel_bucket(dist) * 8 + cur.h] * (1.0f / SCALE) : 0.f; }
    for (int i = tid; i < qb * 128; i += NW * 64) { const int j = i >> 7, dd = i & 127; const size_t o = ((size_t)(cur.b * 8 + j)) * 1024 + cur.h * 128 + dd;
        kmL[i] = (kmp[o] + kmp[o + 64 * 1024]) * (1.0f / 256.0f); }
    __syncthreads();
    unsigned selmask = 0;
    {
        float sc7[7];
#pragma unroll
        for (int j = 0; j < 7; ++j) { sc7[j] = -__builtin_inff();
            if (j < qb) { float acc = 0.f;
#pragma unroll
                for (int d0 = 0; d0 < 8; ++d0) { const u32x4 q4 = __builtin_bit_cast(u32x4, S.qr[d0]); const f32x4 k0 = *(const f32x4*)(kmL + j * 128 + d0 * 16 + hi * 8), k1 = *(const f32x4*)(kmL + j * 128 + d0 * 16 + hi * 8 + 4);
                    acc += bflo(q4[0]) * k0[0] + bfhi(q4[0]) * k0[1] + bflo(q4[1]) * k0[2] + bfhi(q4[1]) * k0[3] + bflo(q4[2]) * k1[0] + bfhi(q4[2]) * k1[1] + bflo(q4[3]) * k1[2] + bfhi(q4[3]) * k1[3]; }
                acc += __shfl_xor(acc, 32); sc7[j] = acc; } }
#pragma unroll
        for (int j = 0; j < 7; ++j) { int rank = 0;
#pragma unroll
            for (int i = 0; i < 7; ++i) { if (i != j) rank += (sc7[i] > sc7[j] || (sc7[i] == sc7[j] && i < j)) ? 1 : 0; }
            if (j < qb && (qb <= 3 || rank < 3)) selmask |= 1u << j; }
    }
    LAS unsigned* selp = (LAS unsigned*)(LAS char*)(uintptr_t)(unsigned)(uintptr_t)(lds + OFF_SEL) + tid;
    *selp = selmask;
    float m_reg = -1e30f, l_reg = 0; f32x16 o[4];
#pragma unroll
    for (int d = 0; d < 4; ++d)
#pragma unroll
        for (int r = 0; r < 16; ++r) o[d][r] = 0.f;
    const int sr = tid >> 4, sc = (tid & 15) * 8, vst0 = v_st(sr, sc), vst1 = v_st(32 + sr, sc), kws = KSWZ(sr, sc * 2);
    const unsigned kvoff = (unsigned)(sr * LDP + sc) * 2u;
    const int vb0 = (int)(uintptr_t)V_lds + v_rd_base(lane);
    const bf16_t* Kh = cur.K; const bf16_t* Vh = cur.V;
#define RESC(a) do { if (__any((a) < 1.f)) { if (hi == 0) al_l[r32] = (a); asm volatile("s_waitcnt lgkmcnt(0)" ::: "memory");              \
                     for (int d_ = 0; d_ < 4; ++d_) for (int r = 0; r < 16; ++r) o[d_][r] *= al_l[crow(r, hi)]; } } while (0)
#define KBASE(t) ((t) * KVBLK)
#define MASKT(P0_, P1_, t) do { const int kb_ = KBASE(t); bias_tile(P0_, P1_, rtab + (kb_ + 4 * hi - qrow + 2047)); \
        if (((t) >> 2) != qb) { if (!((*selp >> ((t) >> 2)) & 1u)) kill_tile(P0_, P1_); } \
        else if (kb_ + KVBLK - 1 > qlo) mask_tile(P0_, P1_, qrow - 4 * hi - kb_); } while (0)
    constexpr int NQL = 8;
#define SEAM_K0() do { VMWN(NQL); SWRITE_HK(0); SBAR(); } while (0)
    f32x16 pA0, pA1, pB0, pB1; float mnA, mnB, alA, alB; bf16x8 pa0, pa1, pa2, pa3;
    SWRITE_HV(0); SBAR();
    if (NT > 1) { SLOAD_H(Kh, Vh, KBASE(1)); }
    SBAR(); qkt<0>(pA0, pA1, K_lds, r32, hi, S.qr);
    MASKT(pA0, pA1, 0); partialSM(pA0, pA1, m_reg, mnA, alA);
    if (NT > 1) { VMW(); SWRITE_H(1); }
    __syncthreads();
#define HALF_STEP(PX0, PX1, mnX, alX, PY0, PY1, alY, t, KB, VB, SB) do {                                                      \
        SBAR(); qkt<KB>(PX0, PX1, K_lds, r32, hi, S.qr);                                             \
        finishSM(PY0, PY1, alY, l_reg, pa0, pa1, pa2, pa3); SBAR();                                                           \
        if ((t) + 1 < NT) { SLOAD_H(Kh, Vh, KBASE((t) + 1)); SBAR(); }                                               \
        pv_tile<VB>(o, vb0, pa0, pa1, pa2, pa3); MASKT(PX0, PX1, (t)); partialSM(PX0, PX1, m_reg, mnX, alX);                                        \
        __syncthreads();                                                                                                      \
        if ((t) + 1 < NT) { VMW(); SWRITE_H(SB); }                                                                          \
        RESC(alX); __syncthreads(); } while (0)
    for (int t = 1; t + 1 < NT; t += 2) {
        HALF_STEP(pB0, pB1, mnB, alB, pA0, pA1, alA, t, 1, 0, 0);
        HALF_STEP(pA0, pA1, mnA, alA, pB0, pB1, alB, t + 1, 0, 1, 1);
    }
    { SBAR(); qkt<1>(pB0, pB1, K_lds, r32, hi, S.qr); SBAR(); }
    SLOAD_H(nxt.K, nxt.V, 0); SBAR();
    { const char* qb__ = (const char*)nxt.Q + (size_t)(wid * QBLK) * (LDP * 2); int l_ = lane; asm volatile("" : "+v"(l_));
      const unsigned qvoff = (unsigned)((l_ & 31) * LDP + (l_ >> 5) * 8) * 2u;
#pragma unroll
    for (int d0 = 0; d0 < 8; ++d0) S.qr[d0] = LD8(qb__ + qvoff + d0 * 32); }
    SBAR();
    finishSM(pA0, pA1, alA, l_reg, pa0, pa1, pa2, pa3); SBAR();
    pv_tile<0>(o, vb0, pa0, pa1, pa2, pa3);
    { MASKT(pB0, pB1, NT - 1); partialSM(pB0, pB1, m_reg, mnB, alB); __syncthreads(); RESC(alB);
      finishSM(pB0, pB1, alB, l_reg, pa0, pa1, pa2, pa3); SBAR(); pv_tile<1>(o, vb0, pa0, pa1, pa2, pa3); }
    SBAR(); SEAM_K0();
    if (hi == 0) li_l[r32] = l_reg; asm volatile("s_waitcnt lgkmcnt(0)" ::: "memory");
    float rli[16];
#pragma unroll
    for (int r = 0; r < 16; ++r) rli[r] = __builtin_amdgcn_rcpf(li_l[crow(r, hi)]);
    char* Ow = (char*)cur.O + (size_t)(wid * QBLK) * (LDO * 2); const unsigned ovoff = (unsigned)(4 * hi * LDO + r32) * 2u;
#pragma unroll
    for (int r = 0; r < 16; ++r) { const int orow0 = (r & 3) + 8 * (r >> 2);
#pragma unroll
        for (int d0 = 0; d0 < 4; ++d0) { const float v = o[d0][r] * rli[r];
            const float vn = __shfl_xor(v, 1);
            if ((r32 & 1) == 0) *(unsigned*)(Ow + (size_t)(orow0 * LDO * 2 + d0 * 64) + ovoff) = cvtpk(v, vn); } }
    __syncthreads();
#undef RESC
#undef KBASE
#undef MASKT
#undef SEAM_K0
#undef HALF_STEP
}
#undef ROWP
#undef VMW
#undef VMWN
#undef LD8
#undef SLOAD_H
#undef SWRITE_HK
#undef SWRITE_HV
#undef SWRITE_H

__device__ __forceinline__ BlockRef make_ref(const P& a, int item) {
    const int qb = 7 - (item >> 6), bh = item & 63, b = bh >> 3, h = bh & 7;
    const bf16_t* proj = (const bf16_t*)(a.ws + WS_PROJ);
    BlockRef r; r.b = b; r.h = h; r.qb = qb;
    r.Q = proj + (size_t)(b * SEQ + qb * QB) * LDP + C_QB + h * HD;
    r.K = proj + (size_t)(b * SEQ) * LDP + C_KB + h * HD;
    r.V = proj + (size_t)(b * SEQ) * LDP + C_VB + h * HD;
    r.O = (bf16_t*)(a.ws + WS_OAB) + (size_t)(b * SEQ + qb * QB) * LDO + 1024 + h * HD;
    return r;
}
}
__device__ __forceinline__ void router_unit(const P& a, LAS unsigned char* lds, int unit) {
    int tid = threadIdx.x; asm volatile("" : "+v"(tid));     const int wave = __builtin_amdgcn_readfirstlane(tid >> 6), lane = tid & 63, c32 = lane & 31, hi = lane >> 5;
    const float* x1 = a.out; const float* g = a.in[11]; const float* br = a.in[13];
    unsigned char* A2 = a.ws + WS_H; const u32x4* frag = (const u32x4*)(a.ws + WS_WRF);
    LAS float* Lw = (LAS float*)(lds + wave * 4352);
    LAS unsigned* hist = (LAS unsigned*)(lds + 8 * 4352);
    LAS unsigned* base = hist + 32;
    if (tid < 32) hist[tid] = 0u;
    __syncthreads();
    const int tok = unit * 256 + wave * 32 + c32;
    f32x16 L;
#pragma unroll
    for (int r = 0; r < 16; ++r) L[r] = 0.f;
    float ss = 0.f;
    const float* xr = x1 + (size_t)tok * D + 8 * hi; unsigned char* ar = A2 + (size_t)tok * D + 8 * hi; const float* gr = g + 8 * hi;
#pragma unroll 2
    for (int s = 0; s < 64; ++s) {
        const f32x4 xa = *(const f32x4*)(xr + 16 * s), xb = *(const f32x4*)(xr + 16 * s + 4), ga = *(const f32x4*)(gr + 16 * s), gb = *(const f32x4*)(gr + 16 * s + 4);
        ss += (xa.x * xa.x + xa.y * xa.y) + (xa.z * xa.z + xa.w * xa.w) + (xb.x * xb.x + xb.y * xb.y) + (xb.z * xb.z + xb.w * xb.w);
        const f32x4 va = xa * ga, vb = xb * gb;
        u32x4 wh; wh.x = cvt_pk_bf16(va.x, va.y); wh.y = cvt_pk_bf16(va.z, va.w); wh.z = cvt_pk_bf16(vb.x, vb.y); wh.w = cvt_pk_bf16(vb.z, vb.w);
        { u32x2 w8; w8.x = pk4_fp8(va.x, va.y, va.z, va.w); w8.y = pk4_fp8(vb.x, vb.y, vb.z, vb.w); *(u32x2*)(ar + 16 * s) = w8; }
        u32x4 wl; wl.x = cvt_pk_bf16(va.x - bflo(wh.x), va.y - bfhi(wh.x)); wl.y = cvt_pk_bf16(va.z - bflo(wh.y), va.w - bfhi(wh.y));
        wl.z = cvt_pk_bf16(vb.x - bflo(wh.z), vb.y - bfhi(wh.z)); wl.w = cvt_pk_bf16(vb.z - bflo(wh.w), vb.w - bfhi(wh.w));
        const bf16x8 ah = __builtin_bit_cast(bf16x8, wh), al = __builtin_bit_cast(bf16x8, wl);
        const bf16x8 bh = __builtin_bit_cast(bf16x8, frag[s * 64 + lane]), bl = __builtin_bit_cast(bf16x8, frag[4096 + s * 64 + lane]);
        L = __builtin_amdgcn_mfma_f32_32x32x16_bf16(ah, bh, L, 0, 0, 0);
        L = __builtin_amdgcn_mfma_f32_32x32x16_bf16(ah, bl, L, 0, 0, 0);
        L = __builtin_amdgcn_mfma_f32_32x32x16_bf16(al, bh, L, 0, 0, 0);
    }
    ss += __shfl_xor(ss, 32);
    const float rstd = 1.0f / sqrtf(ss * (1.0f / D) + EPS);
#pragma unroll
    for (int r = 0; r < 16; ++r) Lw[((r & 3) + 8 * (r >> 2) + 4 * hi) * 33 + c32] = L[r];
    LDS_WAIT(); asm volatile("" ::: "memory");
    int e4[4] = {0, 0, 0, 0}; float w4[4] = {0.f, 0.f, 0.f, 0.f}; unsigned loc[4] = {0u, 0u, 0u, 0u};
    if (hi == 0) {
        float lg[32];
#pragma unroll
        for (int e = 0; e < 32; ++e) lg[e] = Lw[c32 * 33 + e] * rstd + br[e];
        unsigned used = 0u; float v4[4];
#pragma unroll
        for (int p = 0; p < 4; ++p) { float best = -__builtin_inff(); int bi = 0;
#pragma unroll
            for (int e = 0; e < 32; ++e) { const bool take = !((used >> e) & 1u) && lg[e] > best; best = take ? lg[e] : best; bi = take ? e : bi; }
            used |= 1u << bi; e4[p] = bi; v4[p] = best; }
        float sum = 0.f;
#pragma unroll
        for (int p = 0; p < 4; ++p) { w4[p] = expf(v4[p] - v4[0]); sum += w4[p]; }
        const float inv = 1.0f / sum;
#pragma unroll
        for (int p = 0; p < 4; ++p) { w4[p] *= inv; loc[p] = __hip_atomic_fetch_add(hist + e4[p], 1u, __ATOMIC_RELAXED, __HIP_MEMORY_SCOPE_WORKGROUP); }
    }
    __syncthreads();
    if (tid < 32) base[tid] = __hip_atomic_fetch_add((unsigned*)(a.ws + WS_CTL) + CW_COUNTS + tid, hist[tid], RLX_AGENT);
    __syncthreads();
    if (hi == 0) {
        int* tope = (int*)(a.ws + WS_TOPE) + (size_t)tok * 4; float* wts = (float*)(a.ws + WS_WTS) + (size_t)tok * 4; int* slot = (int*)(a.ws + WS_SLOT) + (size_t)tok * 4;
#pragma unroll
        for (int p = 0; p < 4; ++p) { tope[p] = e4[p]; wts[p] = w4[p]; slot[p] = (int)(base[e4[p]] + loc[p]); }
        ((float*)(a.ws + WS_RSTD))[tok] = rstd;
    }
    __syncthreads();
}

__device__ __forceinline__ void moe_index(const P& a, LAS unsigned char* lds, int vcu, int G) {
    const int tid = threadIdx.x;
    LAS int* pstart = (LAS int*)lds;
    LAS int* cnt = pstart + 64;
    const unsigned* counts = (const unsigned*)(a.ws + WS_CTL) + CW_COUNTS;
    if (tid == 0) { int acc = 0; for (int e = 0; e < NE; ++e) { const int c = (int)counts[e]; cnt[e] = c; pstart[e] = acc; acc += ((c + 255) >> 8) << 8; } pstart[NE] = acc; }
    __syncthreads();
    int* rowtok = (int*)(a.ws + WS_ROWTOK); float* rstds = (float*)(a.ws + WS_RSTDS); int* dest = (int*)(a.ws + WS_DEST);
    const int* tope = (const int*)(a.ws + WS_TOPE); const int* slot = (const int*)(a.ws + WS_SLOT); const float* rstd = (const float*)(a.ws + WS_RSTD);
    const int gt = vcu * NTHREADS + tid, NGT = G * NTHREADS;
    for (int i = gt; i < T * 4; i += NGT) { const int e = tope[i], d = pstart[e] + slot[i]; dest[i] = d; rowtok[d] = i >> 2; rstds[d] = rstd[i >> 2]; }
    for (int i = gt; i < NE * 256; i += NGT) { const int e = i >> 8, r = pstart[e] + cnt[e] + (i & 255); if (r < pstart[e + 1]) { rowtok[r] = 0; rstds[r] = 0.f; } }
    if (vcu == 0) { int* tile_e = (int*)(a.ws + WS_TILEE);
        for (int t = tid; t < MAXTILES; t += NTHREADS) { int e = NE - 1; for (int q = 0; q < NE; ++q) { if (t * 256 >= pstart[q] && t * 256 < pstart[q + 1]) e = q; } tile_e[t] = e; }
        if (tid == 0) tile_e[MAXTILES] = pstart[NE] >> 8; }
    __syncthreads();
}

__device__ __forceinline__ void combine_rows(const P& a, int vcu, int G, int wave, int lane) {
    const int gw = vcu * NWAVES + wave, NGW = G * NWAVES;
    float* X = a.out; const bf16_t* Y = (const bf16_t*)(a.ws + WS_YROWS); bf16_t* A3 = (bf16_t*)(a.ws + WS_H);
    const int* dest = (const int*)(a.ws + WS_DEST); const float* wts = (const float*)(a.ws + WS_WTS); const float* g = a.in[20];
    f32x4 gv[4];
#pragma unroll
    for (int j = 0; j < 4; ++j) gv[j] = *((const f32x4*)g + lane + 64 * j);
    for (int m = gw; m < T; m += NGW) {
        f32x4* xr = (f32x4*)(X + (size_t)m * D) + lane; f32x4 v[4];
#pragma unroll
        for (int j = 0; j < 4; ++j) v[j] = xr[64 * j];
#pragma unroll
        for (int k = 0; k < 4; ++k) { const int d = __builtin_amdgcn_readfirstlane(dest[m * 4 + k]); const float w = __uint_as_float(__builtin_amdgcn_readfirstlane(__float_as_uint(wts[m * 4 + k])));
            const u32x2* yr = (const u32x2*)(Y + (size_t)d * D) + lane;
#pragma unroll
            for (int j = 0; j < 4; ++j) { const u32x2 y = yr[64 * j]; v[j].x += w * bflo(y.x); v[j].y += w * bfhi(y.x); v[j].z += w * bflo(y.y); v[j].w += w * bfhi(y.y); } }
        float s = 0.f;
#pragma unroll
        for (int j = 0; j < 4; ++j) s += (v[j].x * v[j].x + v[j].y * v[j].y) + (v[j].z * v[j].z + v[j].w * v[j].w);
        const float rstd = 1.0f / sqrtf(wave_sum(s) * (1.0f / D) + EPS);
        u32x2* o8 = (u32x2*)(A3 + (size_t)m * D) + lane;
#pragma unroll
        for (int j = 0; j < 4; ++j) { xr[64 * j] = v[j]; u32x2 w; w.x = cvt_pk_bf16(v[j].x * rstd * gv[j].x, v[j].y * rstd * gv[j].y); w.y = cvt_pk_bf16(v[j].z * rstd * gv[j].z, v[j].w * rstd * gv[j].w); o8[64 * j] = w; }
    }
}
__device__ __forceinline__ void final_rows(const P& a, int vcu, int G, int wave, int lane) {
    const int gw = vcu * NWAVES + wave, NGW = G * NWAVES;
    float* X = a.out; const bf16_t* PG = (const bf16_t*)(a.ws + WS_PGATE); const bf16_t* PP = (const bf16_t*)(a.ws + WS_PPROJ);
    f32x4 gp[4], gf[4];
#pragma unroll
    for (int j = 0; j < 4; ++j) { gp[j] = *((const f32x4*)a.in[23] + lane + 64 * j); gf[j] = *((const f32x4*)a.in[24] + lane + 64 * j); }
    for (int m = gw; m < T; m += NGW) {
        f32x4* xr = (f32x4*)(X + (size_t)m * D) + lane; const u32x2* pgr = (const u32x2*)(PG + (size_t)m * D) + lane; const u32x2* ppr = (const u32x2*)(PP + (size_t)m * D) + lane;
        f32x4 v[4], pp[4], pg[4]; float sp = 0.f;
#pragma unroll
        for (int j = 0; j < 4; ++j) { v[j] = xr[64 * j]; const u32x2 q = ppr[64 * j], gq = pgr[64 * j];
            pp[j] = (f32x4){bflo(q.x), bfhi(q.x), bflo(q.y), bfhi(q.y)}; pg[j] = (f32x4){bflo(gq.x), bfhi(gq.x), bflo(gq.y), bfhi(gq.y)};
            sp += (pp[j].x * pp[j].x + pp[j].y * pp[j].y) + (pp[j].z * pp[j].z + pp[j].w * pp[j].w); }
        const float rp = 1.0f / sqrtf(wave_sum(sp) * (1.0f / D) + EPS); float s = 0.f;
#pragma unroll
        for (int j = 0; j < 4; ++j) { v[j] = v[j] + pg[j] * (pp[j] * rp * gp[j]); s += (v[j].x * v[j].x + v[j].y * v[j].y) + (v[j].z * v[j].z + v[j].w * v[j].w); }
        const float rstd = 1.0f / sqrtf(wave_sum(s) * (1.0f / D) + EPS);
#pragma unroll
        for (int j = 0; j < 4; ++j) xr[64 * j] = v[j] * rstd * gf[j];
    }
}
struct Args { P p; };
template <int PH_LO, int PH_HI>
__global__ void __launch_bounds__(NTHREADS, 2) hybrid_fwd(Args args) {
    extern __shared__ __attribute__((aligned(16))) unsigned char lds_raw[];
    LAS unsigned char* lds = (LAS unsigned char*)lds_raw;
    const P& a = args.p;
    const int tid = threadIdx.x, lane = tid & 63, wave = __builtin_amdgcn_readfirstlane(tid >> 6);
    const int G = gridDim.x; const int bx = blockIdx.x; const int vcu = (G % 8 == 0) ? (bx % 8) * (G / 8) + bx / 8 : bx;
    unsigned* ctl = (unsigned*)(a.ws + WS_CTL);
    for (int u = tid; u < (LDS_BYTES - LDSCTL_OFF) / 4; u += NTHREADS) ((LAS unsigned*)(lds + LDSCTL_OFF))[u] = 0u;
    __syncthreads();
#if MK_PER_PHASE
#define GRID_BAR() do { } while (0)
#else
    XcdBarrier bar = xcd_barrier_post(ctl + CW_BAR, (volatile LAS unsigned*)(lds + MISC_OFF + 32));
#define GRID_BAR() xcd_barrier(bar)
#endif
    constexpr int lo = PH_LO, hi = PH_HI;
#define IN(k) (lo <= (k) && (k) < hi)
#define SEAM(k) do { if constexpr (IN(k) && IN((k) + 1)) GRID_BAR(); } while (0)
    unsigned char* ws = a.ws;

    if constexpr (IN(0)) { p0_prologue(a, lds, vcu, G, wave, lane); }
    SEAM(0);
    if constexpr (IN(1)) {
        pg8::DenseSched S; S.o.init(T / 256, NPROJ / 256, G, bx); S.Bt = (const char*)(ws + WS_WIN); S.K = D;
        pg8::EpiProj E{(bf16_t*)(ws + WS_PROJ), (float*)(ws + WS_KMP)};
        pg8::gemm_phase(lds, (const char*)(ws + WS_H), D, D, D, S, E);
    }
    SEAM(1);
    if constexpr (IN(2)) { for (int u = vcu; u < NB * 32; u += G) gla_prep_unit(a, lds, u); }
    SEAM(2);
    if constexpr (IN(3)) {
        for (int u = vcu; u < NB * 4; u += G) gla_scan_unit(a, lds, u);
        __syncthreads();
    }
    if constexpr (IN(4)) {
        for (int c = bx; c < 256; c += G) {
            moba::Seam S;
            moba::BlockRef cur = moba::make_ref(a, c); const moba::BlockRef second = moba::make_ref(a, 511 - c);
            moba::prime(cur, (char*)lds_raw, S);
            for (int pass = 0; pass < 2; ++pass) {
                moba::block(cur, second, a.in[2], (const float*)(ws + WS_KMP), (char*)lds_raw, S);
                cur = second;
            }
        }
    }
    SEAM(4);
    if constexpr (IN(5)) {
        pg8::ChainSched S; S.o.init(T / 256, D / 256, G, bx); S.Bt = (const char*)(ws + WS_WUP); S.K = 1024;
        pg8::EpiMerge E{(const bf16_t*)(ws + WS_PROJ), (bf16_t*)(ws + WS_Y)};
        pg8::gemm_phase(lds, (const char*)(ws + WS_OAB), 1024, 2048, 2048, S, E);
    }
    SEAM(5);
    if constexpr (IN(6)) {
        pg8::DenseSched S; S.o.init(T / 256, D / 256, G, bx); S.Bt = (const char*)(ws + WS_WO); S.K = D;
        pg8::EpiResF32 E{a.in[0], a.out};
        pg8::gemm_phase(lds, (const char*)(ws + WS_Y), D, D, D, S, E);
        __syncthreads();
        expert_convert(a, lds, vcu, G, wave, lane);
    }
    SEAM(6);
    if constexpr (IN(7)) { for (int u = vcu; u < T / 256; u += G) router_unit(a, lds, u); }
    SEAM(7);
    if constexpr (IN(8)) { moe_index(a, lds, vcu, G); }
    SEAM(8);
    if constexpr (IN(9)) {
        const int* tile_e = (const int*)(ws + WS_TILEE); const int ntile = __builtin_amdgcn_readfirstlane(tile_e[MAXTILES]);
        pg8::MoeSched<true> S; S.o.init(ntile, 8, G, bx); S.Bt = (const char*)(ws + WS_W1T); S.K = D; S.rows_per_e = 2048; S.tile_e = tile_e; S.row_tok = (const int*)(ws + WS_ROWTOK); S.es = 1;
        pg8::EpiGlu E{(unsigned char*)(ws + WS_HMID), (const float*)(ws + WS_RSTDS), a.in[15], a.in[17]};
        pg8::gemm_phase(lds, (const char*)(ws + WS_H), D, D, D, S, E);
    }
    SEAM(9);
    if constexpr (IN(10)) {
        const int* tile_e = (const int*)(ws + WS_TILEE); const int ntile = __builtin_amdgcn_readfirstlane(tile_e[MAXTILES]);
        pg8::MoeSched<false> S; S.o.init(ntile, 4, G, bx); S.Bt = (const char*)(ws + WS_W2T); S.K = FF; S.rows_per_e = 1024; S.tile_e = tile_e; S.row_tok = nullptr; S.es = 1;
        pg8::EpiBf16<0, true, true> E{(bf16_t*)(ws + WS_YROWS), D, a.in[19], D, 1.0f / 32.0f};
        pg8::gemm_phase(lds, (const char*)(ws + WS_HMID), FF, FF, FF, S, E);
    }
    SEAM(10);
    if constexpr (IN(11)) { combine_rows(a, vcu, G, wave, lane); }
    SEAM(11);
    if constexpr (IN(12)) {
        { pg8::DenseSched S; S.o.init(T / 256, D / 256, G, bx); S.Bt = (const char*)(ws + WS_WPG); S.K = D;
          pg8::EpiBf16<1, false> E{(bf16_t*)(ws + WS_PGATE), D, nullptr, 0, 1.0f};
          pg8::gemm_phase(lds, (const char*)(ws + WS_H), D, D, D, S, E); }
        __syncthreads();
        { pg8::DenseSched S; S.o.init(T / 256, D / 256, G, bx); S.Bt = (const char*)(ws + WS_WPP); S.K = 256;
          pg8::EpiBf16<0, false> E{(bf16_t*)(ws + WS_PPROJ), D, nullptr, 0, 1.0f};
          pg8::gemm_phase(lds, (const char*)(ws + WS_PB), 256, 256, 256, S, E); }
    }
    SEAM(12);
    if constexpr (IN(13)) { final_rows(a, vcu, G, wave, lane); }
#undef IN
#undef SEAM
#undef GRID_BAR
}

template <int LO, int HI> static void launch_range(const Args& a, int grid, hipStream_t stream) {
    static bool attr = false;
    if (!attr) { attr = true; if (hipFuncSetAttribute((const void*)hybrid_fwd<LO, HI>, hipFuncAttributeMaxDynamicSharedMemorySize, LDS_BYTES) != hipSuccess) fprintf(stderr, "kernel_launch: hipFuncSetAttribute failed\n"); }
    hipLaunchKernelGGL((hybrid_fwd<LO, HI>), dim3(grid), dim3(NTHREADS), LDS_BYTES, stream, a);
}
extern "C" void kernel_launch(void* const* d_in, const int* in_sizes, int n_in, void* d_out, int out_size, void* d_ws, size_t ws_size, hipStream_t stream) {
    static int grid = 0;
    if (grid == 0) {
        static const int expect[25] = {T * D, T * 256, 256, 1024, 1024 * D_IN, 16 * 512, 512, 256, 1048576, 1048576, 1048576, 1024, 32768, 32, 33554432, 32768, 33554432, 32768, 33554432, 32768, 1024, 1048576, 262144, 1024, 1024};
        bool okk = (n_in == 25);
        for (int i = 0; okk && i < 25; ++i) if (in_sizes[i] != expect[i]) { fprintf(stderr, "kernel_launch: input %d has %d elements, expected %d\n", i, in_sizes[i], expect[i]); okk = false; }
        if (!okk || out_size != T * D || ws_size < WS_END) { fprintf(stderr, "kernel_launch: unexpected shapes (n_in %d, in0 %d, out %d, ws %zu); nothing launched\n", n_in, n_in > 0 ? in_sizes[0] : -1, out_size, ws_size); grid = -1; return; }
        int dev = 0, cus = 0;
        if (hipGetDevice(&dev) != hipSuccess || hipDeviceGetAttribute(&cus, hipDeviceAttributeMultiprocessorCount, dev) != hipSuccess) { grid = -1; return; }
        grid = cus;
    }
    if (grid < 0) return;
    (void)hipMemsetAsync((char*)d_ws + WS_CTL, 0, CTL_ZERO_BYTES, stream);
    Args a{};
    for (int i = 0; i < 25; ++i) a.p.in[i] = (const float*)d_in[i];
    a.p.out = (float*)d_out; a.p.ws = (unsigned char*)d_ws;
#if MK_PER_PHASE
#ifndef MK_LAST
#define MK_LAST 13
#endif
#ifndef MK_REPEAT
#define MK_REPEAT 0
#endif
#define LR(k) do { if ((k) <= MK_LAST) for (int r_ = 0; r_ < 1 + ((MK_REPEAT >> (k)) & 1); ++r_) launch_range<(k), (k) + 1>(a, grid, stream); } while (0)
    LR(0); LR(1); LR(2); LR(3); LR(4); LR(5); LR(6); LR(7); LR(8); LR(9); LR(10); LR(11); LR(12); LR(13);
#undef LR
#else
    launch_range<0, NPHASES>(a, grid, stream);
#endif
}
```

```cpp
#define MK_PER_PHASE 0
#include <hip/hip_runtime.h>
#include <cstdio>
#include <cstdint>

#define LAS __attribute__((address_space(3)))
#define GAS __attribute__((address_space(1)))
typedef unsigned short bf16_t;
typedef short bf16x8 __attribute__((ext_vector_type(8)));
typedef short s16x4 __attribute__((ext_vector_type(4)));
typedef float f32x2 __attribute__((ext_vector_type(2)));
typedef float f32x4 __attribute__((ext_vector_type(4)));
typedef float f32x16 __attribute__((ext_vector_type(16)));
typedef unsigned u32x2 __attribute__((ext_vector_type(2)));
typedef unsigned u32x4 __attribute__((ext_vector_type(4)));
typedef int i32x4 __attribute__((ext_vector_type(4)));
typedef int i32x8 __attribute__((ext_vector_type(8)));
typedef GAS unsigned gu32;
#define RLX_AGENT __ATOMIC_RELAXED, __HIP_MEMORY_SCOPE_AGENT
#define LDS_WAIT() asm volatile("s_waitcnt lgkmcnt(0)" ::: "memory")
#define VM_WAIT() asm volatile("s_waitcnt vmcnt(0)" ::: "memory")

#ifndef MK_PER_PHASE
#define MK_PER_PHASE 0
#endif

constexpr int NB = 8, SEQ = 2048, T = NB * SEQ, D = 1024;
constexpr int NPROJ = 8192;
constexpr int C_QA = 0, C_KA = 512, C_VA = 1024, C_RA = 2048, C_QB = 3072, C_KB = 4096, C_VB = 5120, C_GA = 6144, C_GB = 7168;
constexpr int SRC_ALOW = 3072, D_IN = 8208;
constexpr int NE = 32, FF = 1024, MAXTILES = 288, MAXROWS = MAXTILES * 256;
constexpr float EPS = 1e-6f;
constexpr int NWAVES = 8, NTHREADS = 512;
constexpr int NPHASES = 15;

constexpr size_t MiB = 1u << 20;
constexpr size_t WS_CTL = 0, CTL_ZERO_BYTES = 1 * MiB;
constexpr size_t WS_SMALL = 1 * MiB;
constexpr size_t WS_KMP   = WS_SMALL;
constexpr size_t WS_DEC   = WS_KMP + 512 * 1024;
constexpr size_t WS_TOPE  = WS_DEC + 512 * 1024;
constexpr size_t WS_WTS   = WS_TOPE + 256 * 1024;
constexpr size_t WS_SLOT  = WS_WTS + 256 * 1024;
constexpr size_t WS_DEST  = WS_SLOT + 256 * 1024;
constexpr size_t WS_ROWTOK = WS_DEST + 256 * 1024;
constexpr size_t WS_RSTDS = WS_ROWTOK + 320 * 1024;
constexpr size_t WS_RSTD  = WS_RSTDS + 320 * 1024;
constexpr size_t WS_TILEE = WS_RSTD + 64 * 1024;
constexpr size_t WS_WALT  = WS_TILEE + 4 * 1024;
constexpr size_t WS_WRF   = WS_WALT + 32 * 1024;
static_assert(WS_WRF + 128 * 1024 <= 6 * MiB, "small map");
constexpr size_t WS_WO = 6 * MiB, WS_WPG = 8 * MiB, WS_WPP = 10 * MiB, WS_WUP = 12 * MiB, WS_WIN = 16 * MiB;
constexpr size_t WS_PB = 34 * MiB;
constexpr size_t WS_H  = 42 * MiB;
constexpr size_t WS_PROJ = 74 * MiB;
constexpr size_t WS_QG = 330 * MiB, WS_KG = 346 * MiB;
constexpr size_t WS_SLOC = 426 * MiB;
constexpr size_t WS_OAB = 362 * MiB;
constexpr size_t WS_H8 = 410 * MiB;
constexpr size_t WS_Y = 330 * MiB;
constexpr size_t WS_W2T = 74 * MiB;
constexpr size_t WS_HMID = 138 * MiB;
constexpr size_t WS_W1T = 426 * MiB;
constexpr size_t WS_YROWS = 282 * MiB;
constexpr size_t WS_PGATE = 74 * MiB, WS_PPROJ = 106 * MiB;
constexpr size_t WS_END = 506 * MiB;

constexpr int CW_BAR = 4096;
constexpr int CW_COUNTS = 16384;
constexpr int CW_QUEUE = 16384 + 64;

constexpr int RING_BYTES = 131072;
constexpr int LDSCTL_OFF = RING_BYTES, MISC_OFF = LDSCTL_OFF + 320;
constexpr int LDS_BYTES = 147456;

typedef __bf16 bf16v2_t __attribute__((ext_vector_type(2)));
__device__ __forceinline__ unsigned cvt_pk_bf16(float lo, float hi) { const f32x2 v = {lo, hi}; return __builtin_bit_cast(unsigned, __builtin_convertvector(v, bf16v2_t)); }
__device__ __forceinline__ unsigned pk4_fp8(float a, float b, float c, float d) { int w = 0; w = __builtin_amdgcn_cvt_pk_fp8_f32(a, b, w, false); w = __builtin_amdgcn_cvt_pk_fp8_f32(c, d, w, true); return (unsigned)w; }
__device__ __forceinline__ float bf2f(unsigned short s) { return __uint_as_float(((unsigned)s) << 16); }
__device__ __forceinline__ float bflo(unsigned w) { return __uint_as_float(w << 16); }
__device__ __forceinline__ float bfhi(unsigned w) { return __uint_as_float(w & 0xffff0000u); }
__device__ __forceinline__ float fsigmoid(float x) { return __builtin_amdgcn_rcpf(1.0f + __builtin_amdgcn_exp2f(-1.4426950408889634f * x)); }
__device__ __forceinline__ float wave_sum(float v) {
#pragma unroll
    for (int o = 1; o < 64; o <<= 1) v += __shfl_xor(v, o);
    return v;
}
__device__ __forceinline__ bf16x8 pack8(f32x4 a, f32x4 b) {
    u32x4 w = {cvt_pk_bf16(a[0], a[1]), cvt_pk_bf16(a[2], a[3]), cvt_pk_bf16(b[0], b[1]), cvt_pk_bf16(b[2], b[3])};
    return __builtin_bit_cast(bf16x8, w);
}

#define XB_TMO      128
#define XB_XCNT(j)  (256  + 64 * (j))
#define XB_XSUB(j)  (1280 + 64 * (j))
#define XB_XGEN(j)  (2304 + 64 * (j))
#define XB_TOP      3328
#define XB_TOPGEN   3392
#define XCD_BAR_WORDS 3456
#define XB_SPIN_CAP (1u << 18)

__device__ __forceinline__ unsigned xb_ld(unsigned* p)              { return __hip_atomic_load(p, __ATOMIC_RELAXED, __HIP_MEMORY_SCOPE_AGENT); }
__device__ __forceinline__ unsigned xb_add(unsigned* p, unsigned v) { return __hip_atomic_fetch_add(p, v, __ATOMIC_RELAXED, __HIP_MEMORY_SCOPE_AGENT); }
__device__ __forceinline__ unsigned xb_xcc_id() { return (unsigned)__builtin_amdgcn_s_getreg((3 << 11) | 20) & 0xFu; }
#define XB_SPIN(cond, bar) do { unsigned _sp = 0; while (cond) { __builtin_amdgcn_s_sleep(1); \
    if ((++_sp & 255u) == 0u) { if (xb_ld(&(bar)[XB_TMO])) break; if (_sp > XB_SPIN_CAP) { atomicAdd(&(bar)[XB_TMO], 1u); break; } } } } while (0)

struct XcdBarrier { unsigned* bar; unsigned x; volatile LAS unsigned* st; };

__device__ __forceinline__ XcdBarrier xcd_barrier_post(unsigned* bar, volatile LAS unsigned* st) {
    XcdBarrier b; b.bar = bar; b.x = xb_xcc_id(); b.st = st;
    if (threadIdx.x == 0) (void)xb_add(&bar[XB_XCNT(b.x)], 1u);
    return b;
}
__device__ __forceinline__ void xcd_barrier_complete(unsigned* bar, unsigned x, unsigned& nloc, unsigned& nx) {
    const unsigned G = gridDim.x * gridDim.y * gridDim.z;
    unsigned sum, cnt, mine, sp = 0u;
    for (;;) {
        sum = 0u; cnt = 0u; mine = 0u;
#pragma unroll
        for (unsigned j = 0; j < 16; ++j) { const unsigned c = xb_ld(&bar[XB_XCNT(j)]); sum += c; cnt += (c > 0u) ? 1u : 0u; mine = (j == x) ? c : mine; }
        if (sum == G) break;
        __builtin_amdgcn_s_sleep(1);
        if ((++sp & 255u) == 0u) { if (xb_ld(&bar[XB_TMO])) break; if (sp > XB_SPIN_CAP) { atomicAdd(&bar[XB_TMO], 1u); break; } }
    }
    nloc = mine > 0u ? mine : 1u; nx = cnt > 0u ? cnt : 1u;
}
__device__ __forceinline__ void xcd_barrier(const XcdBarrier& b) {
    asm volatile("s_waitcnt vmcnt(0)" ::: "memory");
    __syncthreads();
    if (threadIdx.x == 0) {
        unsigned* bar = b.bar;
        __builtin_amdgcn_s_waitcnt(0);
        unsigned nloc = b.st[0], nx = b.st[1];
        if (nloc == 0u) { xcd_barrier_complete(bar, b.x, nloc, nx); b.st[0] = nloc; b.st[1] = nx; }
        const unsigned old = xb_add(&bar[XB_XSUB(b.x)], 1u);
        const unsigned gen = old / nloc;
        if (old + 1u == (gen + 1u) * nloc) {
            __builtin_amdgcn_fence(__ATOMIC_RELEASE, "agent");
            asm volatile("s_waitcnt vmcnt(0)" ::: "memory");
            const unsigned og = xb_add(&bar[XB_TOP], 1u);
            const unsigned tg = og / nx;
            if (og + 1u == (tg + 1u) * nx) xb_add(&bar[XB_TOPGEN], 1u);
            else XB_SPIN(xb_ld(&bar[XB_TOPGEN]) == tg, bar);
            __builtin_amdgcn_fence(__ATOMIC_ACQUIRE, "agent");
            xb_add(&bar[XB_XGEN(b.x)], 1u);
            asm volatile("s_waitcnt vmcnt(0)" ::: "memory");
        } else {
            XB_SPIN(xb_ld(&bar[XB_XGEN(b.x)]) == gen, bar);
            __builtin_amdgcn_fence(__ATOMIC_ACQUIRE, "agent");
            asm volatile("s_waitcnt vmcnt(0)" ::: "memory");
        }
    }
    __syncthreads();
}
namespace pg8 {
constexpr int BM = 256, BK = 64, HALF = 128, HTB = HALF * BK * 2, STAGE_BYTES = 8 * HTB, NXCD = 8, WGM = 8;

__host__ __device__ __forceinline__ int lds_byte(int r, int c) { const int st = (r >> 4) * 2 + (c >> 5), rr = r & 15, cc = c & 31, ob = rr * 64 + cc * 2; return st * 1024 + (ob ^ (((ob >> 9) & 1) << 5)); }
__host__ __device__ __forceinline__ void stage_rc(int b, int& R, int& C) { const int st = b / 1024, sb = b % 1024, swz = sb ^ (((sb >> 9) & 1) << 5); R = (st >> 1) * 16 + swz / 64; C = (st & 1) * 32 + (swz % 64) / 2; }
__host__ __device__ __forceinline__ int perm32(int rho) { const int n = rho >> 4, i = rho & 15; return 8 * (i >> 2) + 4 * n + (i & 3); }

struct Unit { int pm, pn, e; };

struct TileOrder {
    int nM, nN, nwg, G, c;
    __device__ __forceinline__ void init(int nM_, int nN_, int G_, int c_) { nM = nM_; nN = nN_; nwg = nM * nN; G = G_; c = c_; }
    __device__ __forceinline__ bool next(int i, int& pm, int& pn) const {
        const long L = (long)i * G + c; if (L >= nwg) return false;
        int wgid = (int)L; { const int q = nwg / NXCD, r = nwg % NXCD, xcd = wgid % NXCD, off = wgid / NXCD; wgid = (xcd < r ? xcd * (q + 1) : r * (q + 1) + (xcd - r) * q) + off; }
        const int nig = WGM * nN, gid = wgid / nig, fm = gid * WGM, gsz = (nM - fm) < WGM ? (nM - fm) : WGM;
        pm = fm + ((wgid % nig) % gsz); pn = (wgid % nig) / gsz; return true;
    }
};
struct DenseSched {
    TileOrder o; const char* Bt; int K; int es = 2;
    __device__ __forceinline__ bool next(int i, Unit& u) const { u.e = 0; return o.next(i, u.pm, u.pn); }
    __device__ __forceinline__ unsigned a_row(const Unit& u, int r) const { return (unsigned)(u.pm * BM + r); }
    __device__ __forceinline__ unsigned a_koff(const Unit&) const { return 0u; }
    __device__ __forceinline__ const char* b_base(const Unit& u) const { return Bt + (size_t)u.pn * BM * K * es; }
};
struct ChainSched {
    TileOrder o; const char* Bt; int K;
    __device__ __forceinline__ bool next(int i, Unit& u) const { if (!o.next(i >> 1, u.pm, u.pn)) return false; u.e = i & 1; return true; }
    __device__ __forceinline__ unsigned a_row(const Unit& u, int r) const { return (unsigned)(u.pm * BM + r); }
    __device__ __forceinline__ unsigned a_koff(const Unit& u) const { return (unsigned)(u.e * K * 2); }
    __device__ __forceinline__ const char* b_base(const Unit& u) const { return Bt + (size_t)u.pn * BM * (2 * K) * 2 + (size_t)u.e * K * 2; }
};
template <bool GATHER> struct MoeSched {
    TileOrder o; const char* Bt; int K; int rows_per_e; const int* tile_e; const int* row_tok; int es;
    __device__ __forceinline__ bool next(int i, Unit& u) const { if (!o.next(i, u.pm, u.pn)) return false; u.e = __builtin_amdgcn_readfirstlane(tile_e[u.pm]); return true; }
    __device__ __forceinline__ unsigned a_row(const Unit& u, int r) const { if (GATHER) return (unsigned)row_tok[u.pm * BM + r]; else return (unsigned)(u.pm * BM + r); }
    __device__ __forceinline__ unsigned a_koff(const Unit&) const { return 0u; }
    __device__ __forceinline__ const char* b_base(const Unit& u) const { return Bt + ((size_t)u.e * rows_per_e + (size_t)u.pn * BM) * K * es; }
};

template <class Epi, class Sched>
__device__ __forceinline__ void gemm_phase(LAS unsigned char* lds, const char* gA, int K_, int lda, int ldb, const Sched& S, const Epi& E) {
    int K = K_; asm volatile("" : "+s"(K));
    int tid = threadIdx.x; asm volatile("" : "+v"(tid));     const int wid = __builtin_amdgcn_readfirstlane(tid >> 6), lane = tid & 63, wr = wid >> 2, wc = wid & 3, fr = lane & 15, fq = lane >> 4;
    constexpr int ES = Epi::F8 ? 1 : 2;
    const int nt = K * ES / 128;
    unsigned voffB[2];
#pragma unroll
    for (int i = 0; i < 2; ++i) { int R, C; stage_rc(tid * 16 + i * 8192, R, C); const int Rb = Epi::PERM ? ((R & ~31) + perm32(R & 31)) : R; voffB[i] = (unsigned)(Rb * ldb * ES + C * 2); }
    const unsigned kstep = (unsigned)(BK * 2);
    const size_t hstepB = (size_t)HALF * ldb * ES;
    const unsigned ldab = (unsigned)lda * ES;
    const unsigned ldsw = (unsigned)wid * 1024u;
    const int aoff = lds_byte(wr * 64 + fr, fq * 8), boff = lds_byte(wc * 32 + fr, fq * 8);
#define PG8_SA(b, h) (((b) * 2 + (h)) * HTB)
#define PG8_SB(b, h) ((4 + (b) * 2 + (h)) * HTB)
#define PG8_STAGE_B(bufoff, gbase) do { _Pragma("unroll") for (int _i = 0; _i < 2; ++_i) \
        __builtin_amdgcn_global_load_lds((const unsigned*)((const char*)(gbase) + voffB[_i]), (LAS unsigned*)(lds + (bufoff) + ldsw + _i * 8192), 16, 0, 0); } while (0)
#define PG8_STAGE_A(bufoff, o0, o1, kb) do { \
        const char* gk_ = gA + (kb);      \
        __builtin_amdgcn_global_load_lds((const unsigned*)(gk_ + (o0)), (LAS unsigned*)(lds + (bufoff) + ldsw), 16, 0, 0); \
        __builtin_amdgcn_global_load_lds((const unsigned*)(gk_ + (o1)), (LAS unsigned*)(lds + (bufoff) + ldsw + 8192), 16, 0, 0); } while (0)
#define PG8_LDA(dst, b, h) do { _Pragma("unroll") for (int m = 0; m < 4; ++m) _Pragma("unroll") for (int k = 0; k < 2; ++k) dst[m][k] = *(const LAS bf16x8*)(lds + PG8_SA(b, h) + aoff + m * 2048 + k * 1024); } while (0)
#define PG8_LDB(dst, b, h) do { _Pragma("unroll") for (int n = 0; n < 2; ++n) _Pragma("unroll") for (int k = 0; k < 2; ++k) dst[n][k] = *(const LAS bf16x8*)(lds + PG8_SB(b, h) + boff + n * 2048 + k * 1024); } while (0)
#define PG8_MMA(ai, bj, At, Bt) do { __builtin_amdgcn_s_setprio(1); \
        if constexpr (Epi::F8) { _Pragma("unroll") for (int m = 0; m < 4; ++m) _Pragma("unroll") for (int n = 0; n < 2; ++n) { \
            const i32x8 a8_ = __builtin_shufflevector(__builtin_bit_cast(i32x4, At[m][0]), __builtin_bit_cast(i32x4, At[m][1]), 0, 1, 2, 3, 4, 5, 6, 7); \
            const i32x8 b8_ = __builtin_shufflevector(__builtin_bit_cast(i32x4, Bt[n][0]), __builtin_bit_cast(i32x4, Bt[n][1]), 0, 1, 2, 3, 4, 5, 6, 7); \
            acc[ai][bj][m][n] = __builtin_amdgcn_mfma_scale_f32_16x16x128_f8f6f4(b8_, a8_, acc[ai][bj][m][n], 0, 0, 0, 0x7F7F7F7F, 0, 0x7F7F7F7F); } } \
        else { _Pragma("unroll") for (int m = 0; m < 4; ++m) _Pragma("unroll") for (int n = 0; n < 2; ++n) _Pragma("unroll") for (int k = 0; k < 2; ++k) \
            acc[ai][bj][m][n] = __builtin_amdgcn_mfma_f32_16x16x32_bf16(Bt[n][k], At[m][k], acc[ai][bj][m][n], 0, 0, 0); } \
        __builtin_amdgcn_s_setprio(0); } while (0)
#define PG8_WAIT_V(n) asm volatile("s_waitcnt vmcnt(" #n ")" ::: "memory")
#define PG8_WAIT_L(n) asm volatile("s_waitcnt lgkmcnt(" #n ")" ::: "memory")
#define PG8_BAR __builtin_amdgcn_s_barrier()
#define PG8_SCHED __builtin_amdgcn_sched_barrier(0)
#define PG8_AOFFS(dst, u) do { _Pragma("unroll") for (int _h = 0; _h < 2; ++_h) _Pragma("unroll") for (int _i = 0; _i < 2; ++_i) { int R_, C_; stage_rc(tid * 16 + _i * 8192, R_, C_); \
        dst[_h][_i] = S.a_row(u, _h * HALF + R_) * ldab + (unsigned)C_ * 2u + S.a_koff(u); } } while (0)
    Unit cur, nxt; int ui = 0;
    if (!S.next(0, cur)) return;
    f32x4 acc[2][2][4][2];
#pragma unroll
    for (int a = 0; a < 2; ++a)
#pragma unroll
        for (int b = 0; b < 2; ++b)
#pragma unroll
            for (int m = 0; m < 4; ++m)
#pragma unroll
                for (int n = 0; n < 2; ++n) acc[a][b][m][n] = (f32x4){0.f, 0.f, 0.f, 0.f};
    bf16x8 At[4][2], B0[2][2], B1[2][2];
    unsigned oc[2][2];
    LAS u32x4* nslot = (LAS u32x4*)(lds + LDSCTL_OFF + 2048) + tid;
    PG8_AOFFS(oc, cur);
    const char* cB = S.b_base(cur);
    PG8_STAGE_B(PG8_SB(0, 0), cB); PG8_STAGE_B(PG8_SB(0, 1), cB + hstepB); PG8_STAGE_A(PG8_SA(0, 0), oc[0][0], oc[0][1], 0u); PG8_STAGE_A(PG8_SA(0, 1), oc[1][0], oc[1][1], 0u);
    if (wr == 1) PG8_BAR;
    PG8_WAIT_V(2); PG8_BAR;
    PG8_STAGE_B(PG8_SB(1, 0), cB + kstep); PG8_STAGE_A(PG8_SA(1, 0), oc[0][0], oc[0][1], kstep); PG8_STAGE_B(PG8_SB(1, 1), cB + hstepB + kstep);
    PG8_WAIT_V(6); PG8_BAR;
    for (;;) {
        const bool has_next = S.next(ui + 1, nxt);
        const char* nB = has_next ? S.b_base(nxt) : cB;
        if (has_next) { unsigned on[2][2]; PG8_AOFFS(on, nxt); *nslot = (u32x4){on[0][0], on[0][1], on[1][0], on[1][1]}; }
        for (int t = 0; t < nt; t += 2) {
            const bool last = (t == nt - 2);
            const unsigned k1 = (unsigned)(t + 1) * kstep;
            const unsigned k2 = last ? 0u : (unsigned)(t + 2) * kstep, k3 = k2 + kstep;
            const char* b2 = last ? nB : cB + (size_t)(t + 2) * kstep; const char* b3 = b2 + kstep;
            PG8_LDB(B0, 0, 0); PG8_LDB(B1, 0, 1); PG8_SCHED; PG8_LDA(At, 0, 0); PG8_STAGE_A(PG8_SA(1, 1), oc[1][0], oc[1][1], k1);
            PG8_WAIT_V(8); PG8_WAIT_L(0); PG8_BAR; PG8_MMA(0, 0, At, B0); PG8_MMA(0, 1, At, B1); PG8_BAR; PG8_SCHED;
            if (last && has_next) { const u32x4 o_ = *nslot; oc[0][0] = o_.x; oc[0][1] = o_.y; oc[1][0] = o_.z; oc[1][1] = o_.w; }
            PG8_LDA(At, 0, 1); PG8_STAGE_B(PG8_SB(0, 0), b2); PG8_STAGE_B(PG8_SB(0, 1), b2 + hstepB); PG8_STAGE_A(PG8_SA(0, 0), oc[0][0], oc[0][1], k2);
            PG8_WAIT_V(8); PG8_WAIT_L(0); PG8_BAR; PG8_MMA(1, 0, At, B0); PG8_MMA(1, 1, At, B1); PG8_BAR; PG8_SCHED;
            PG8_LDB(B0, 1, 0); PG8_LDB(B1, 1, 1); PG8_SCHED; PG8_LDA(At, 1, 0); PG8_STAGE_A(PG8_SA(0, 1), oc[1][0], oc[1][1], k2);
            PG8_WAIT_V(8); PG8_WAIT_L(0); PG8_BAR; PG8_MMA(0, 0, At, B0); PG8_MMA(0, 1, At, B1); PG8_BAR; PG8_SCHED;
            PG8_LDA(At, 1, 1); PG8_STAGE_B(PG8_SB(1, 0), b3); PG8_STAGE_B(PG8_SB(1, 1), b3 + hstepB); PG8_STAGE_A(PG8_SA(1, 0), oc[0][0], oc[0][1], k3);
            PG8_WAIT_V(8); PG8_WAIT_L(0); PG8_BAR; PG8_MMA(1, 0, At, B0); PG8_MMA(1, 1, At, B1); PG8_BAR; PG8_SCHED;
        }
        if (wr == 0) PG8_BAR;
        bool carry = false;
        if constexpr (Epi::MIDK) { if (cur.e == 0) { E.mid(acc, cur, wr, wc, fr, fq); carry = true; } else E(acc, cur, wr, wc, fr, fq); } else E(acc, cur, wr, wc, fr, fq);
        if (!has_next) break;
        if (!carry)
#pragma unroll
        for (int a = 0; a < 2; ++a)
#pragma unroll
            for (int b = 0; b < 2; ++b)
#pragma unroll
                for (int m = 0; m < 4; ++m)
#pragma unroll
                    for (int n = 0; n < 2; ++n) acc[a][b][m][n] = (f32x4){0.f, 0.f, 0.f, 0.f};
        cur = nxt; cB = nB; ++ui;
        if (wr == 1) PG8_BAR;
    }
    PG8_WAIT_V(0);
    PG8_BAR;
#undef PG8_SA
#undef PG8_SB
#undef PG8_STAGE_A
#undef PG8_STAGE_B
#undef PG8_LDA
#undef PG8_LDB
#undef PG8_MMA
#undef PG8_WAIT_V
#undef PG8_WAIT_L
#undef PG8_BAR
#undef PG8_SCHED
#undef PG8_AOFFS
}

struct EpiProj {
    static constexpr bool PERM = true, MIDK = false, F8 = false;
    bf16_t* O; float* kmp;
    __device__ __forceinline__ void operator()(const f32x4 (&acc)[2][2][4][2], const Unit& u, int wr, int wc, int fr, int fq) const {
        const int row0 = u.pm * BM + wr * 64 + fr; const int col0 = u.pn * BM + wc * 32 + 8 * fq;
#pragma unroll
        for (int ai = 0; ai < 2; ++ai)
#pragma unroll
            for (int m = 0; m < 4; ++m) { bf16_t* rowp = O + (size_t)(row0 + ai * HALF + m * 16) * NPROJ + col0;
#pragma unroll
                for (int bj = 0; bj < 2; ++bj) { const f32x4 v0 = acc[ai][bj][m][0], v1 = acc[ai][bj][m][1];
                    u32x4 w; w.x = cvt_pk_bf16(v0[0], v0[1]); w.y = cvt_pk_bf16(v0[2], v0[3]); w.z = cvt_pk_bf16(v1[0], v1[1]); w.w = cvt_pk_bf16(v1[2], v1[3]);
                    *(u32x4*)(rowp + bj * HALF) = w; } }
        if (u.pn >= C_KB / BM && u.pn < C_VB / BM) {
#pragma unroll
            for (int bj = 0; bj < 2; ++bj)
#pragma unroll
                for (int n = 0; n < 2; ++n) { f32x4 s = (f32x4){0.f, 0.f, 0.f, 0.f};
#pragma unroll
                    for (int ai = 0; ai < 2; ++ai)
#pragma unroll
                        for (int m = 0; m < 4; ++m) s += acc[ai][bj][m][n];
#pragma unroll
                    for (int o = 1; o < 16; o <<= 1) { s[0] += __shfl_xor(s[0], o); s[1] += __shfl_xor(s[1], o); s[2] += __shfl_xor(s[2], o); s[3] += __shfl_xor(s[3], o); }
                    if (fr == 0) *(f32x4*)(kmp + ((size_t)wr * 64 + u.pm) * 1024 + (u.pn - C_KB / BM) * BM + bj * HALF + wc * 32 + 8 * fq + 4 * n) = s; }
        }
    }
};
struct EpiMerge {
    static constexpr bool PERM = true, MIDK = true, F8 = false;
    const bf16_t* proj; bf16_t* Y;
    __device__ __forceinline__ void mid(f32x4 (&acc)[2][2][4][2], const Unit& u, int wr, int wc, int fr, int fq) const {
        const int row0 = u.pm * BM + wr * 64 + fr; const int col0 = u.pn * BM + wc * 32 + 8 * fq;
#pragma unroll
        for (int ai = 0; ai < 2; ++ai)
#pragma unroll
            for (int m = 0; m < 4; ++m) { const bf16_t* rowp = proj + (size_t)(row0 + ai * HALF + m * 16) * NPROJ + col0;
#pragma unroll
                for (int bj = 0; bj < 2; ++bj) { const u32x4 ga = *(const u32x4*)(rowp + C_GA + bj * HALF), gb = *(const u32x4*)(rowp + C_GB + bj * HALF);
#pragma unroll
                    for (int j = 0; j < 4; ++j) { const float a0 = bflo(ga[j]), a1 = bfhi(ga[j]), b0 = bflo(gb[j]), b1 = bfhi(gb[j]);
                        const float r0 = (1.0f + __builtin_amdgcn_exp2f(-1.4426950408889634f * b0)) * __builtin_amdgcn_rcpf(1.0f + __builtin_amdgcn_exp2f(-1.4426950408889634f * a0));
                        const float r1 = (1.0f + __builtin_amdgcn_exp2f(-1.4426950408889634f * b1)) * __builtin_amdgcn_rcpf(1.0f + __builtin_amdgcn_exp2f(-1.4426950408889634f * a1));
                        acc[ai][bj][m][j >> 1][(j & 1) * 2] *= r0; acc[ai][bj][m][j >> 1][(j & 1) * 2 + 1] *= r1; } }
                asm volatile("" : "+v"(acc[ai][0][m][0]), "+v"(acc[ai][0][m][1]), "+v"(acc[ai][1][m][0]), "+v"(acc[ai][1][m][1]));
                asm volatile("" ::: "memory"); }
    }
    __device__ __forceinline__ void operator()(const f32x4 (&acc)[2][2][4][2], const Unit& u, int wr, int wc, int fr, int fq) const {
        const int row0 = u.pm * BM + wr * 64 + fr; const int col0 = u.pn * BM + wc * 32 + 8 * fq;
#pragma unroll
        for (int ai = 0; ai < 2; ++ai)
#pragma unroll
            for (int m = 0; m < 4; ++m) { const size_t r = (size_t)(row0 + ai * HALF + m * 16);
#pragma unroll
                for (int bj = 0; bj < 2; ++bj) { const u32x4 gb = *(const u32x4*)(proj + r * NPROJ + C_GB + col0 + bj * HALF);
                    const f32x4 v0 = acc[ai][bj][m][0], v1 = acc[ai][bj][m][1];
                    u32x4 w; w.x = cvt_pk_bf16(v0[0] * fsigmoid(bflo(gb[0])), v0[1] * fsigmoid(bfhi(gb[0]))); w.y = cvt_pk_bf16(v0[2] * fsigmoid(bflo(gb[1])), v0[3] * fsigmoid(bfhi(gb[1])));
                    w.z = cvt_pk_bf16(v1[0] * fsigmoid(bflo(gb[2])), v1[1] * fsigmoid(bfhi(gb[2]))); w.w = cvt_pk_bf16(v1[2] * fsigmoid(bflo(gb[3])), v1[3] * fsigmoid(bfhi(gb[3])));
                    *(u32x4*)(Y + r * D + col0 + bj * HALF) = w; }
                asm volatile("" ::: "memory"); }
    }
};
struct EpiResF32 {
    static constexpr bool PERM = false, MIDK = false, F8 = false;
    const float* base; float* out;
    __device__ __forceinline__ void operator()(const f32x4 (&acc)[2][2][4][2], const Unit& u, int wr, int wc, int fr, int fq) const {
        const int row0 = u.pm * BM + wr * 64 + fr, col0 = u.pn * BM + wc * 32 + 4 * fq;
#pragma unroll
        for (int ai = 0; ai < 2; ++ai)
#pragma unroll
            for (int m = 0; m < 4; ++m) { const size_t off = (size_t)(row0 + ai * HALF + m * 16) * D + col0;
#pragma unroll
                for (int bj = 0; bj < 2; ++bj)
#pragma unroll
                    for (int n = 0; n < 2; ++n) *(f32x4*)(out + off + bj * HALF + n * 16) = *(const f32x4*)(base + off + bj * HALF + n * 16) + acc[ai][bj][m][n];
                asm volatile("" ::: "memory"); }
    }
};
struct EpiGlu {
    static constexpr bool PERM = true, MIDK = false, F8 = true;
    unsigned char* H; const float* rstd_s; const float* bg; const float* bu;
    __device__ __forceinline__ void operator()(const f32x4 (&acc)[2][2][4][2], const Unit& u, int wr, int wc, int fr, int fq) const {
        const int row0 = u.pm * BM + wr * 64 + fr; const int colo = u.pn * HALF + wc * 32 + 8 * fq;
        f32x4 g4[2], u4[2];
#pragma unroll
        for (int n = 0; n < 2; ++n) { g4[n] = *(const f32x4*)(bg + (size_t)u.e * FF + colo + 4 * n); u4[n] = *(const f32x4*)(bu + (size_t)u.e * FF + colo + 4 * n); }
#pragma unroll
        for (int ai = 0; ai < 2; ++ai)
#pragma unroll
            for (int m = 0; m < 4; ++m) { const int r = row0 + ai * HALF + m * 16; const float rs = rstd_s[r] * (1.0f / 32.0f);
                float o[8];
#pragma unroll
                for (int n = 0; n < 2; ++n)
#pragma unroll
                    for (int j = 0; j < 4; ++j) { float g = acc[ai][0][m][n][j] * rs + g4[n][j], up = acc[ai][1][m][n][j] * rs + u4[n][j];
                        g = fminf(g, 7.0f); up = fminf(fmaxf(up, -7.0f), 7.0f);
                        const float glu = g * fsigmoid(1.702f * g); o[n * 4 + j] = (up + 1.0f) * glu; }
                u32x2 w; w.x = pk4_fp8(o[0], o[1], o[2], o[3]); w.y = pk4_fp8(o[4], o[5], o[6], o[7]);
                *(u32x2*)(H + (size_t)r * FF + colo) = w; asm volatile("" ::: "memory"); }
    }
};
template <int ACT, bool HASBIAS, bool F8_ = false> struct EpiBf16 {
    static constexpr bool PERM = true, MIDK = false, F8 = F8_;
    bf16_t* O; int ldc; const float* bias; int bias_stride; float scale;
    __device__ __forceinline__ void operator()(const f32x4 (&acc)[2][2][4][2], const Unit& u, int wr, int wc, int fr, int fq) const {
        const int row0 = u.pm * BM + wr * 64 + fr; const int col0 = u.pn * BM + wc * 32 + 8 * fq;
        f32x4 bv[2][2];
#pragma unroll
        for (int bj = 0; bj < 2; ++bj)
#pragma unroll
            for (int n = 0; n < 2; ++n) bv[bj][n] = HASBIAS ? *(const f32x4*)(bias + (size_t)u.e * bias_stride + col0 + bj * HALF + 4 * n) : (f32x4){0.f, 0.f, 0.f, 0.f};
#pragma unroll
        for (int ai = 0; ai < 2; ++ai)
#pragma unroll
            for (int m = 0; m < 4; ++m) { bf16_t* rowp = O + (size_t)(row0 + ai * HALF + m * 16) * ldc + col0;
#pragma unroll
                for (int bj = 0; bj < 2; ++bj) { f32x4 v0 = acc[ai][bj][m][0] * scale + bv[bj][0], v1 = acc[ai][bj][m][1] * scale + bv[bj][1];
                    if (ACT == 1) {
#pragma unroll
                        for (int j = 0; j < 4; ++j) { v0[j] = fsigmoid(v0[j]); v1[j] = fsigmoid(v1[j]); } }
                    u32x4 w; w.x = cvt_pk_bf16(v0[0], v0[1]); w.y = cvt_pk_bf16(v0[2], v0[3]); w.z = cvt_pk_bf16(v1[0], v1[1]); w.w = cvt_pk_bf16(v1[2], v1[3]);
                    *(u32x4*)(rowp + bj * HALF) = w; }
                asm volatile("" ::: "memory"); }
    }
};
}
__device__ __forceinline__ void transpose_item(const float* __restrict__ W, int ldw, int k0, int n_src0, bf16_t* __restrict__ WT, int ldo, int n_dst0, int k_off, LAS float* scr, int lane) {
#pragma unroll 8
    for (int i = 0; i < 32; ++i) { const int kk = 2 * i + (lane >> 5); scr[kk * 33 + (lane & 31)] = W[(size_t)(k0 + kk) * ldw + n_src0 + (lane & 31)]; }
    LDS_WAIT(); asm volatile("" ::: "memory");
    const int c = lane & 7;
#pragma unroll
    for (int j = 0; j < 4; ++j) { const int n = (lane >> 3) + 8 * j; const LAS float* s = scr + (8 * c) * 33 + n;
        u32x4 o; o.x = cvt_pk_bf16(s[0 * 33], s[1 * 33]); o.y = cvt_pk_bf16(s[2 * 33], s[3 * 33]); o.z = cvt_pk_bf16(s[4 * 33], s[5 * 33]); o.w = cvt_pk_bf16(s[6 * 33], s[7 * 33]);
        *(u32x4*)(WT + (size_t)(n_dst0 + n) * ldo + k_off + k0 + 8 * c) = o; }
    LDS_WAIT(); asm volatile("" ::: "memory");
}
__device__ __forceinline__ void transpose_item_f8(const float* __restrict__ W, int ldw, int k0, int n_src0, unsigned char* __restrict__ WT, int ldo, int n_dst0, float sc, LAS float* scr, int lane) {
#pragma unroll 8
    for (int i = 0; i < 32; ++i) { const int kk = 2 * i + (lane >> 5); scr[kk * 33 + (lane & 31)] = W[(size_t)(k0 + kk) * ldw + n_src0 + (lane & 31)]; }
    LDS_WAIT(); asm volatile("" ::: "memory");
    const int c = lane & 7;
#pragma unroll
    for (int j = 0; j < 4; ++j) { const int n = (lane >> 3) + 8 * j; const LAS float* s = scr + (8 * c) * 33 + n;
        u32x2 o; o.x = pk4_fp8(s[0 * 33] * sc, s[1 * 33] * sc, s[2 * 33] * sc, s[3 * 33] * sc); o.y = pk4_fp8(s[4 * 33] * sc, s[5 * 33] * sc, s[6 * 33] * sc, s[7 * 33] * sc);
        *(u32x2*)(WT + (size_t)(n_dst0 + n) * ldo + k0 + 8 * c) = o; }
    LDS_WAIT(); asm volatile("" ::: "memory");
}
__device__ __forceinline__ void transpose_mat_item(const float* W, int ldw, int N, int n_src_base, bf16_t* WT, int ldo, int n_dst_base, int k_off, LAS float* scr, int item, int lane) {
    const int nblk = N / 32, kb = item / nblk, nb = item % nblk;
    transpose_item(W, ldw, 64 * kb, n_src_base + 32 * nb, WT, ldo, n_dst_base + 32 * nb, k_off, scr, lane);
}

struct P {
    const float* in[25]; float* out; unsigned char* ws;
};

__device__ __forceinline__ void p0_prologue(const P& a, LAS unsigned char* lds, int vcu, int G, int wave, int lane) {
    LAS float* scr = (LAS float*)(lds + wave * 16384);
    const int gw = vcu * NWAVES + wave, NGW = G * NWAVES;
    unsigned char* ws = a.ws;
    bf16_t* WinT = (bf16_t*)(ws + WS_WIN); bf16_t* WupT = (bf16_t*)(ws + WS_WUP); bf16_t* WoT = (bf16_t*)(ws + WS_WO); bf16_t* WpgT = (bf16_t*)(ws + WS_WPG); bf16_t* WppT = (bf16_t*)(ws + WS_WPP);
    constexpr int I_A = 16 * 96, I_B = 16 * 160, I_S = 16 * 32, I_P = 4 * 32;
    constexpr int NITEMS = I_A + I_B + 4 * I_S + I_P;
#ifndef P0_PARTS
#define P0_PARTS 63
#endif
    if (P0_PARTS & 1)
    for (int it = gw; it < NITEMS; it += NGW) {
        int r = it;
        if (r < I_A) { transpose_mat_item(a.in[4], D_IN, 3072, 0, WinT, D, 0, 0, scr, r, lane); continue; } r -= I_A;
        if (r < I_B) { transpose_mat_item(a.in[4], D_IN, 5120, 3088, WinT, D, 3072, 0, scr, r, lane); continue; } r -= I_B;
        if (r < I_S) { transpose_mat_item(a.in[8], D, D, 0, WupT, 2048, 0, 0, scr, r, lane); continue; } r -= I_S;
        if (r < I_S) { transpose_mat_item(a.in[9], D, D, 0, WupT, 2048, 0, 1024, scr, r, lane); continue; } r -= I_S;
        if (r < I_S) { transpose_mat_item(a.in[10], D, D, 0, WoT, D, 0, 0, scr, r, lane); continue; } r -= I_S;
        if (r < I_S) { transpose_mat_item(a.in[21], D, D, 0, WpgT, D, 0, 0, scr, r, lane); continue; } r -= I_S;
        transpose_mat_item(a.in[22], D, D, 0, WppT, 256, 0, 0, scr, r, lane);
    }
    if (P0_PARTS & 2) {
        const float* x = a.in[0]; const float* g = a.in[3]; bf16_t* H = (bf16_t*)(ws + WS_H);
        f32x4 gv[4];
#pragma unroll
        for (int j = 0; j < 4; ++j) gv[j] = *((const f32x4*)g + lane + 64 * j);
        for (int m = gw; m < T; m += NGW) {
            const f32x4* xr = (const f32x4*)(x + (size_t)m * D) + lane; f32x4 v[4]; float s = 0.f;
#pragma unroll
            for (int j = 0; j < 4; ++j) { v[j] = xr[64 * j]; s += (v[j].x * v[j].x + v[j].y * v[j].y) + (v[j].z * v[j].z + v[j].w * v[j].w); }
            const float rstd = 1.0f / sqrtf(wave_sum(s) * (1.0f / D) + EPS);
            u32x2* o8 = (u32x2*)(H + (size_t)m * D) + lane;
#pragma unroll
            for (int j = 0; j < 4; ++j) { const f32x4 y = v[j] * rstd * gv[j]; u32x2 w; w.x = cvt_pk_bf16(y.x, y.y); w.y = cvt_pk_bf16(y.z, y.w); o8[64 * j] = w; }
        }
    }
    if (P0_PARTS & 4) {
        const f32x4* p4 = (const f32x4*)a.in[1]; u32x2* pb = (u32x2*)(ws + WS_PB);
        const size_t n4 = (size_t)T * 256 / 4;
        for (size_t i = (size_t)gw * 64 + lane; i < n4; i += (size_t)NGW * 64) { const f32x4 v = p4[i]; u32x2 w; w.x = cvt_pk_bf16(v.x, v.y); w.y = cvt_pk_bf16(v.z, v.w); pb[i] = w; }
    }
    if (P0_PARTS & 8) {
        const int gt = (vcu * NWAVES + wave) * 64 + lane;
        if ((P0_PARTS & 16) && gt < 16 * 1024) { const int n = gt >> 10, k = gt & 1023; ((bf16_t*)(ws + WS_WALT))[n * 1024 + k] = (bf16_t)(cvt_pk_bf16(a.in[4][(size_t)k * D_IN + SRC_ALOW + n], 0.f) & 0xffffu); }
        if ((P0_PARTS & 32) && gt < 4096) { const int s = gt >> 6, l = gt & 63, e = l & 31, hh = l >> 5; const float* wr = a.in[12];
            float v[8], lo[8];
#pragma unroll
            for (int j = 0; j < 8; ++j) { v[j] = wr[(size_t)(16 * s + 8 * hh + j) * NE + e]; }
            u32x4 whi; whi.x = cvt_pk_bf16(v[0], v[1]); whi.y = cvt_pk_bf16(v[2], v[3]); whi.z = cvt_pk_bf16(v[4], v[5]); whi.w = cvt_pk_bf16(v[6], v[7]);
#pragma unroll
            for (int j = 0; j < 4; ++j) { lo[2 * j] = v[2 * j] - bflo(whi[j]); lo[2 * j + 1] = v[2 * j + 1] - bfhi(whi[j]); }
            u32x4 wlo; wlo.x = cvt_pk_bf16(lo[0], lo[1]); wlo.y = cvt_pk_bf16(lo[2], lo[3]); wlo.z = cvt_pk_bf16(lo[4], lo[5]); wlo.w = cvt_pk_bf16(lo[6], lo[7]);
            u32x4* f = (u32x4*)(ws + WS_WRF); f[gt] = whi; f[4096 + gt] = wlo; }
    }
}

__device__ __forceinline__ void expert_convert(const P& a, LAS unsigned char* lds, int vcu, int G, int wave, int lane) {
    LAS float* scr = (LAS float*)(lds + wave * 16384);
    const int gw = vcu * NWAVES + wave, NGW = G * NWAVES;
    unsigned char* W1T = a.ws + WS_W1T; unsigned char* W2T = a.ws + WS_W2T;
    constexpr int IPM = 16 * 32;
    for (int it = gw; it < NE * 3 * IPM; it += NGW) {
        const int e = it / (3 * IPM), r0 = it % (3 * IPM), which = r0 / IPM, r = r0 % IPM, kb = r / 32, nb = r % 32;
        if (which < 2) { const float* W = a.in[which == 0 ? 14 : 16] + (size_t)e * D * FF; const int n0 = 32 * nb;
            transpose_item_f8(W, FF, 64 * kb, n0, W1T + (size_t)e * 2048 * D, D, (n0 >> 7) * 256 + (n0 & 127) + which * 128, 32.0f, scr, lane); }
        else { const float* W = a.in[18] + (size_t)e * FF * D; transpose_item_f8(W, D, 64 * kb, 32 * nb, W2T + (size_t)e * D * FF, FF, 32 * nb, 32.0f, scr, lane); }
    }
}

__device__ __forceinline__ float logsigmoidf_(float x) { return fminf(x, 0.0f) - log1pf(expf(-fabsf(x))); }
__device__ __forceinline__ void gla_prep_unit(const P& a, LAS unsigned char* lds, int unit) {
    int tid = threadIdx.x; asm volatile("" : "+v"(tid));     const int wave = __builtin_amdgcn_readfirstlane(tid >> 6), lane = tid & 63;
    const int b = unit >> 5, chunk = unit & 31, tok0 = b * SEQ + chunk * 64;
    const bf16_t* H = (const bf16_t*)(a.ws + WS_H); const bf16_t* WalT = (const bf16_t*)(a.ws + WS_WALT); const bf16_t* proj = (const bf16_t*)(a.ws + WS_PROJ);
    LAS float* part = (LAS float*)lds;
    LAS float* alow = (LAS float*)(lds + 8192);
    LAS float* seg = (LAS float*)(lds + 12288);
    constexpr int GP_KDT = 16384, GP_VT = 34816;
    {
        const int rg = wave & 3, kh = wave >> 2, r = lane & 15, q = lane >> 4;
        f32x4 acc = (f32x4){0.f, 0.f, 0.f, 0.f};
        const bf16_t* ap = H + (size_t)(tok0 + 16 * rg + r) * D + 512 * kh + 8 * q; const bf16_t* bp = WalT + (size_t)r * D + 512 * kh + 8 * q;
#pragma unroll 4
        for (int s = 0; s < 16; ++s) { const bf16x8 av = *(const bf16x8*)(ap + 32 * s), bv = *(const bf16x8*)(bp + 32 * s); acc = __builtin_amdgcn_mfma_f32_16x16x32_bf16(bv, av, acc, 0, 0, 0); }
        *(LAS f32x4*)(part + (kh * 64 + 16 * rg + r) * 16 + 4 * q) = acc;
    }
    __syncthreads();
    if (tid < 256) { *(LAS f32x4*)(alow + tid * 4) = *(LAS f32x4*)(part + tid * 4) + *(LAS f32x4*)(part + 1024 + tid * 4); }
    __syncthreads();
    const int dp = tid & 63, tq = wave;
    const float* w_a2 = a.in[5]; const float* b_a2 = a.in[6];
    for (int h = 0; h < 4; ++h) {
        const int dcol = h * 128 + 2 * dp;
        f32x2 w2[16];
#pragma unroll
        for (int r = 0; r < 16; ++r) w2[r] = *(const f32x2*)(w_a2 + r * 512 + dcol);
        const f32x2 b2 = *(const f32x2*)(b_a2 + dcol);
        unsigned qv[8], kv[8];
#pragma unroll
        for (int i = 0; i < 8; ++i) { const bf16_t* rp = proj + (size_t)(tok0 + 8 * tq + i) * NPROJ + dcol; qv[i] = *(const unsigned*)(rp + C_QA); kv[i] = *(const unsigned*)(rp + C_KA); }
        float G0[8], G1[8]; float r0 = 0.f, r1 = 0.f;
#pragma unroll
        for (int i = 0; i < 8; ++i) { const LAS f32x4* al4 = (const LAS f32x4*)(alow + (8 * tq + i) * 16); float x0 = b2.x, x1 = b2.y;
#pragma unroll
            for (int r4 = 0; r4 < 4; ++r4) { const f32x4 al = al4[r4];
#pragma unroll
                for (int j = 0; j < 4; ++j) { x0 += al[j] * w2[4 * r4 + j].x; x1 += al[j] * w2[4 * r4 + j].y; } }
            r0 += logsigmoidf_(x0) * (1.0f / 16.0f); r1 += logsigmoidf_(x1) * (1.0f / 16.0f); G0[i] = r0; G1[i] = r1; }
        *(LAS f32x2*)(seg + tq * 128 + 2 * dp) = (f32x2){r0, r1};
        __syncthreads();
        float off0 = 0.f, off1 = 0.f, tot0 = 0.f, tot1 = 0.f;
#pragma unroll
        for (int q = 0; q < 8; ++q) { const f32x2 s = *(LAS f32x2*)(seg + q * 128 + 2 * dp); tot0 += s.x; tot1 += s.y; if (q < tq) { off0 += s.x; off1 += s.y; } }
        const size_t tile = (size_t)((b * 4 + h) * 32 + chunk);
        bf16_t* Qg = (bf16_t*)(a.ws + WS_QG) + tile * 8192; bf16_t* Kg = (bf16_t*)(a.ws + WS_KG) + tile * 8192;
        float kd0[8], kd1[8];
#pragma unroll
        for (int i = 0; i < 8; ++i) { const float g0 = G0[i] + off0, g1 = G1[i] + off1; const float q0 = bflo(qv[i]), q1 = bfhi(qv[i]), k0 = bflo(kv[i]), k1 = bfhi(kv[i]);
            const float e0 = expf(g0), e1 = expf(g1);
            *(unsigned*)(Qg + (8 * tq + i) * 128 + 2 * dp) = cvt_pk_bf16(q0 * e0 * 0.08838834764831845f, q1 * e1 * 0.08838834764831845f);
            *(unsigned*)(Kg + (8 * tq + i) * 128 + 2 * dp) = cvt_pk_bf16(k0 * expf(-g0), k1 * expf(-g1));
            kd0[i] = k0 * expf(tot0 - g0); kd1[i] = k1 * expf(tot1 - g1); }
        u32x4 w0, w1; w0.x = cvt_pk_bf16(kd0[0], kd0[1]); w0.y = cvt_pk_bf16(kd0[2], kd0[3]); w0.z = cvt_pk_bf16(kd0[4], kd0[5]); w0.w = cvt_pk_bf16(kd0[6], kd0[7]);
        w1.x = cvt_pk_bf16(kd1[0], kd1[1]); w1.y = cvt_pk_bf16(kd1[2], kd1[3]); w1.z = cvt_pk_bf16(kd1[4], kd1[5]); w1.w = cvt_pk_bf16(kd1[6], kd1[7]);
        *(LAS u32x4*)(lds + GP_KDT + (2 * dp) * 144 + 16 * tq) = w0; *(LAS u32x4*)(lds + GP_KDT + (2 * dp + 1) * 144 + 16 * tq) = w1;
        if (tq == 0) *(f32x2*)((float*)(a.ws + WS_DEC) + tile * 128 + 2 * dp) = (f32x2){expf(tot0), expf(tot1)};
        {
            const int ep = tid & 127, sq4 = tid >> 7; unsigned sv[16];
            const bf16_t* v_ = proj + (size_t)(tok0 + 16 * sq4) * NPROJ + C_VA + h * 256 + 2 * ep;
#pragma unroll
            for (int i = 0; i < 16; ++i) sv[i] = *(const unsigned*)(v_ + (size_t)i * NPROJ);
            u32x4 lo0, lo1, hi0, hi1;
#pragma unroll
            for (int j = 0; j < 4; ++j) { lo0[j] = (sv[2 * j] & 0xffffu) | (sv[2 * j + 1] << 16); lo1[j] = (sv[8 + 2 * j] & 0xffffu) | (sv[8 + 2 * j + 1] << 16);
                hi0[j] = (sv[2 * j] >> 16) | (sv[2 * j + 1] & 0xffff0000u); hi1[j] = (sv[8 + 2 * j] >> 16) | (sv[8 + 2 * j + 1] & 0xffff0000u); }
            LAS unsigned char* v0 = lds + GP_VT + (2 * ep) * 144 + sq4 * 32;
            *(LAS u32x4*)(v0) = lo0; *(LAS u32x4*)(v0 + 16) = lo1; *(LAS u32x4*)(v0 + 144) = hi0; *(LAS u32x4*)(v0 + 144 + 16) = hi1;
        }
        __syncthreads();
        {
            const int c32 = lane & 31, hi = lane >> 5;
            bf16x8 vt[4];
#pragma unroll
            for (int ks = 0; ks < 4; ++ks) vt[ks] = *(const LAS bf16x8*)(lds + GP_VT + (32 * wave + c32) * 144 + (16 * ks + 8 * hi) * 2);
            u32x2* sl = (u32x2*)(a.ws + WS_SLOC) + tile * 8192;
#pragma unroll
            for (int tl = 0; tl < 4; ++tl) { f32x16 acc;
#pragma unroll
                for (int r = 0; r < 16; ++r) acc[r] = 0.f;
#pragma unroll
                for (int ks = 0; ks < 4; ++ks) { const bf16x8 av = *(const LAS bf16x8*)(lds + GP_KDT + (32 * tl + c32) * 144 + (16 * ks + 8 * hi) * 2); acc = __builtin_amdgcn_mfma_f32_32x32x16_bf16(av, vt[ks], acc, 0, 0, 0); }
#pragma unroll
                for (int g = 0; g < 4; ++g) { u32x2 w; w.x = cvt_pk_bf16(acc[4 * g], acc[4 * g + 1]); w.y = cvt_pk_bf16(acc[4 * g + 2], acc[4 * g + 3]); sl[((tl * 4 + g) * 2 + hi) * 256 + 32 * wave + c32] = w; } }
        }
        __syncthreads();
    }
}

__device__ __forceinline__ void gla_combine_unit(const P& a, int unit) {
    const int tid = threadIdx.x, bh = unit >> 4, i8 = (unit & 15) * 512 + tid;
    const int d0 = 32 * (i8 >> 11) + 8 * ((i8 >> 9) & 3) + 4 * ((i8 >> 8) & 1);
    u32x2* sl = (u32x2*)(a.ws + WS_SLOC) + (size_t)bh * 32 * 8192 + i8; const f32x4* dc = (const f32x4*)((const float*)(a.ws + WS_DEC) + (size_t)bh * 32 * 128 + d0);
    f32x4 s = (f32x4){0.f, 0.f, 0.f, 0.f};
    for (int cb = 0; cb < 32; cb += 8) {
        u32x2 loc[8]; f32x4 dv[8];
#pragma unroll
        for (int i = 0; i < 8; ++i) { loc[i] = sl[(size_t)(cb + i) * 8192]; dv[i] = dc[(cb + i) * 32]; }
#pragma unroll
        for (int i = 0; i < 8; ++i) { if (cb + i < 31) { s.x = dv[i].x * s.x + bflo(loc[i].x); s.y = dv[i].y * s.y + bfhi(loc[i].x); s.z = dv[i].z * s.z + bflo(loc[i].y); s.w = dv[i].w * s.w + bfhi(loc[i].y);
            u32x2 w; w.x = cvt_pk_bf16(s.x, s.y); w.y = cvt_pk_bf16(s.z, s.w); sl[(size_t)(cb + i) * 8192] = w; } }
    }
}

constexpr int GL_QG = 0, GL_KG = 17408, GL_VT = 53248, GL_AM = 90112, GL_OST = 0;
constexpr int GL_QS = 272, GL_TS = 144, GL_OS = 528;
__device__ __forceinline__ int crow(int r, int hi) { return (r & 3) + 8 * (r >> 2) + 4 * hi; }
__device__ __forceinline__ void gla_out_unit(const P& a, LAS unsigned char* lds, int unit) {
    int tid = threadIdx.x; asm volatile("" : "+v"(tid)); const int w = __builtin_amdgcn_readfirstlane(tid >> 6), lane = tid & 63, c32 = lane & 31, hi = lane >> 5;
    const int bh = unit >> 5, chunk = unit & 31, b = bh >> 2, h = bh & 3;
    const bf16_t* proj = (const bf16_t*)(a.ws + WS_PROJ); bf16_t* oab = (bf16_t*)(a.ws + WS_OAB); const float* ggo = a.in[7];
    const size_t tile = (size_t)bh * 32 + chunk;
    {
        const u32x4* q_ = (const u32x4*)((const bf16_t*)(a.ws + WS_QG) + tile * 8192); const u32x4* k_ = (const u32x4*)((const bf16_t*)(a.ws + WS_KG) + tile * 8192);
        u32x4 sq[2], sk[2]; unsigned sv[16];
        sq[0] = q_[tid]; sq[1] = q_[tid + 512]; sk[0] = k_[tid]; sk[1] = k_[tid + 512];
        const int ep = tid & 127, sq4 = tid >> 7;
        const bf16_t* v_ = proj + (size_t)(b * SEQ + chunk * 64 + 16 * sq4) * NPROJ + C_VA + h * 256 + 2 * ep;
#pragma unroll
        for (int i = 0; i < 16; ++i) sv[i] = *(const unsigned*)(v_ + (size_t)i * NPROJ);
#pragma unroll
        for (int i = 0; i < 2; ++i) { const int p = tid + 512 * i;
            *(LAS u32x4*)(lds + GL_QG + (p >> 4) * GL_QS + (p & 15) * 16) = sq[i]; *(LAS u32x4*)(lds + GL_KG + (p >> 4) * GL_QS + (p & 15) * 16) = sk[i]; }
        u32x4 lo0, lo1, hi0, hi1;
#pragma unroll
        for (int j = 0; j < 4; ++j) { lo0[j] = (sv[2 * j] & 0xffffu) | (sv[2 * j + 1] << 16); lo1[j] = (sv[8 + 2 * j] & 0xffffu) | (sv[8 + 2 * j + 1] << 16);
            hi0[j] = (sv[2 * j] >> 16) | (sv[2 * j + 1] & 0xffff0000u); hi1[j] = (sv[8 + 2 * j] >> 16) | (sv[8 + 2 * j + 1] & 0xffff0000u); }
        LAS unsigned char* v0 = lds + GL_VT + (2 * ep) * GL_TS + sq4 * 32;
        *(LAS u32x4*)(v0) = lo0; *(LAS u32x4*)(v0 + 16) = lo1; *(LAS u32x4*)(v0 + GL_TS) = hi0; *(LAS u32x4*)(v0 + GL_TS + 16) = hi1;
    }
    u32x2 sf[4][2][2];
    if (chunk > 0) { const u32x2* sl = (const u32x2*)(a.ws + WS_SLOC) + (tile - 1) * 8192;
#pragma unroll
        for (int tl = 0; tl < 4; ++tl)
#pragma unroll
            for (int s = 0; s < 2; ++s)
#pragma unroll
                for (int q = 0; q < 2; ++q) sf[tl][s][q] = sl[((tl * 4 + 2 * s + q) * 2 + hi) * 256 + 32 * w + c32]; }
    __syncthreads();
    if (w < 3) {
        const int ti = (w + 1) >> 1, si = w >> 1;
        f32x16 A;
#pragma unroll
        for (int r = 0; r < 16; ++r) A[r] = 0.f;
#pragma unroll
        for (int s = 0; s < 8; ++s) { const bf16x8 av = *(const LAS bf16x8*)(lds + GL_QG + (32 * ti + c32) * GL_QS + (16 * s + 8 * hi) * 2), bv = *(const LAS bf16x8*)(lds + GL_KG + (32 * si + c32) * GL_QS + (16 * s + 8 * hi) * 2);
            A = __builtin_amdgcn_mfma_f32_32x32x16_bf16(av, bv, A, 0, 0, 0); }
        const int sidx = 32 * si + c32;
#pragma unroll
        for (int r = 0; r < 16; ++r) { const int t = 32 * ti + crow(r, hi); const float v = (sidx <= t) ? A[r] : 0.f;
            *(LAS bf16_t*)(lds + GL_AM + t * GL_TS + sidx * 2) = (bf16_t)(cvt_pk_bf16(v, 0.f) & 0xffffu); }
    }
    __syncthreads();
    f32x16 o[2];
    {
        bf16x8 vt[4];
#pragma unroll
        for (int ks = 0; ks < 4; ++ks) vt[ks] = *(const LAS bf16x8*)(lds + GL_VT + (32 * w + c32) * GL_TS + (16 * ks + 8 * hi) * 2);
#pragma unroll
        for (int ti = 0; ti < 2; ++ti) {
#pragma unroll
            for (int r = 0; r < 16; ++r) o[ti][r] = 0.f;
            if (chunk > 0) {
#pragma unroll
                for (int tl = 0; tl < 4; ++tl)
#pragma unroll
                    for (int s = 0; s < 2; ++s) { const LAS unsigned char* qp = lds + GL_QG + (32 * ti + c32) * GL_QS + (32 * tl + 16 * s + 4 * hi) * 2;
                        const s16x4 lo = *(const LAS s16x4*)qp, hh = *(const LAS s16x4*)(qp + 16);
                        const bf16x8 aop = __builtin_shufflevector(lo, hh, 0, 1, 2, 3, 4, 5, 6, 7);
                        const u32x4 bw = {sf[tl][s][0].x, sf[tl][s][0].y, sf[tl][s][1].x, sf[tl][s][1].y};
                        o[ti] = __builtin_amdgcn_mfma_f32_32x32x16_bf16(aop, __builtin_bit_cast(bf16x8, bw), o[ti], 0, 0, 0); }
            }
#pragma unroll
            for (int ks = 0; ks < 4; ++ks) { if (ti == 0 && ks >= 2) continue;
                const bf16x8 av = *(const LAS bf16x8*)(lds + GL_AM + (32 * ti + c32) * GL_TS + (16 * ks + 8 * hi) * 2);
                o[ti] = __builtin_amdgcn_mfma_f32_32x32x16_bf16(av, vt[ks], o[ti], 0, 0, 0); }
        }
    }
    __syncthreads();
#pragma unroll
    for (int ti = 0; ti < 2; ++ti)
#pragma unroll
        for (int r = 0; r < 16; ++r) *(LAS bf16_t*)(lds + GL_OST + (32 * ti + crow(r, hi)) * GL_OS + (32 * w + c32) * 2) = (bf16_t)(cvt_pk_bf16(o[ti][r], 0.f) & 0xffffu);
    __syncthreads();
    {
        const int t = tid >> 3, sg = tid & 7; const size_t tok = (size_t)(b * SEQ + chunk * 64 + t);
        u32x4 ov[4]; float ss = 0.f;
#pragma unroll
        for (int j = 0; j < 4; ++j) { ov[j] = *(const LAS u32x4*)(lds + GL_OST + t * GL_OS + sg * 64 + j * 16);
#pragma unroll
            for (int i = 0; i < 4; ++i) { const float x0 = bflo(ov[j][i]), x1 = bfhi(ov[j][i]); ss += x0 * x0 + x1 * x1; } }
        ss += __shfl_xor(ss, 1); ss += __shfl_xor(ss, 2); ss += __shfl_xor(ss, 4);
        const float rstd = 1.0f / sqrtf(ss * (1.0f / 256.0f) + EPS);
        const bf16_t* rap = proj + tok * NPROJ + C_RA + h * 256 + sg * 32; bf16_t* op = oab + tok * 2048 + h * 256 + sg * 32; const float* gp = ggo + sg * 32;
#pragma unroll
        for (int j = 0; j < 4; ++j) { const u32x4 ra = *(const u32x4*)(rap + 8 * j); const f32x4 g0 = *(const f32x4*)(gp + 8 * j), g1 = *(const f32x4*)(gp + 8 * j + 4); u32x4 wv;
#pragma unroll
            for (int i = 0; i < 4; ++i) { const float r0 = bflo(ra[i]), r1 = bfhi(ra[i]); const float ga = (i < 2) ? g0[2 * i] : g1[2 * i - 4], gb = (i < 2) ? g0[2 * i + 1] : g1[2 * i - 3];
                wv[i] = cvt_pk_bf16(bflo(ov[j][i]) * rstd * ga * (r0 * fsigmoid(r0)), bfhi(ov[j][i]) * rstd * gb * (r1 * fsigmoid(r1))); }
            *(u32x4*)(op + 8 * j) = wv; }
    }
    __syncthreads();
}
namespace moba {
constexpr int HD = 128;
constexpr float SCALE = 0.08838834764831845f;
constexpr float THR = 8.f;
constexpr int NW = 8, QBLK = 32, KVBLK = 64, QB = NW * QBLK;
constexpr int SHM_V = KVBLK * HD * 2, SHM_K = KVBLK * HD * 2;
constexpr int OFF_WS = 2 * SHM_V + 2 * SHM_K;
constexpr int OFF_RTAB = OFF_WS + NW * 64 * 4;
constexpr int OFF_KM = OFF_RTAB + 2304 * 4;
constexpr int OFF_MISC = OFF_KM + 8 * 128 * 4;
constexpr int OFF_SEL = OFF_MISC + 64;
constexpr int LDS_BYTES = OFF_SEL + 2048;
constexpr int LDP = NPROJ, LDO = 2048;

#define KSWZ(row, colB) ((row) * 256 + ((colB) ^ (((row) & 7) << 4)))
#define SBAR() __builtin_amdgcn_sched_barrier(0)
__device__ __forceinline__ int v_st(int k, int c) { const int kk = (k & ~0xC) | ((k & 4) << 1) | ((k & 8) >> 1); return ((kk >> 3) * 4 + (c >> 5)) * 512 + ((kk & 7) * 32 + (c & 31)) * 2; }
__device__ __forceinline__ int v_rd_base(int lane) { return ((lane & 3) << 3) | (((lane >> 2) & 3) << 6) | (((lane >> 4) & 1) << 5) | (((lane >> 5) & 1) << 8); }
constexpr int v_rd_off(int d0, int ks, int half) { return d0 * 512 + ks * 4096 + half * 2048; }
__device__ __forceinline__ int crow(int r, int hi) { return (r & 3) + 8 * (r >> 2) + 4 * hi; }
__device__ __forceinline__ unsigned cvtpk(float lo, float hi) { unsigned r; asm volatile("v_cvt_pk_bf16_f32 %0, %1, %2" : "=v"(r) : "v"(lo), "v"(hi)); return r; }

__device__ __forceinline__ void mask_tile(f32x16& p0, f32x16& p1, int dq) {
    const float NEG = -__builtin_inff();
#pragma unroll
    for (int r = 0; r < 16; ++r) {
        const int c = (r & 3) + 8 * (r >> 2);
        if (dq - c < 0) p0[r] = NEG;
        if (dq - c - 32 < 0) p1[r] = NEG;
    }
}
__device__ __forceinline__ void bias_tile(f32x16& p0, f32x16& p1, const LAS float* rt) {
#pragma unroll
    for (int r = 0; r < 16; ++r) { const int c = (r & 3) + 8 * (r >> 2); p0[r] += rt[c]; p1[r] += rt[c + 32]; }
}
__device__ __forceinline__ void kill_tile(f32x16& p0, f32x16& p1) {
    const float NEG = -__builtin_inff();
#pragma unroll
    for (int r = 0; r < 16; ++r) { p0[r] = NEG; p1[r] = NEG; }
}
__device__ __forceinline__ void partialSM(f32x16& p0, f32x16& p1, float& m_reg, float& mn, float& alpha) {
    float pmax = p0[0];
#pragma unroll
    for (int r = 1; r < 16; ++r) pmax = fmaxf(pmax, p0[r]);
#pragma unroll
    for (int r = 0; r < 16; ++r) pmax = fmaxf(pmax, p1[r]);
    { auto rr = __builtin_amdgcn_permlane32_swap(__float_as_uint(pmax), __float_as_uint(pmax), false, false);
      pmax = fmaxf(__uint_as_float(rr[0]), __uint_as_float(rr[1])); }
    constexpr float C2 = 1.4426950408889634f * SCALE;
    if (__builtin_expect(__all((pmax - m_reg) * SCALE <= THR), 1)) { mn = m_reg; alpha = 1.f; }
    else { mn = fmaxf(m_reg, pmax); alpha = __builtin_amdgcn_exp2f((m_reg - mn) * C2); m_reg = mn; }
    const float mnL = -mn * C2;
#pragma unroll
    for (int r = 0; r < 16; ++r) p0[r] = fmaf(p0[r], C2, mnL);
#pragma unroll
    for (int r = 0; r < 16; ++r) p1[r] = fmaf(p1[r], C2, mnL);
#pragma unroll
    for (int r = 0; r < 16; ++r) p0[r] = __builtin_amdgcn_exp2f(p0[r]);
}
__device__ __forceinline__ void finishSM(f32x16& p0, f32x16& p1, float alpha, float& l_reg, bf16x8& pa0, bf16x8& pa1, bf16x8& pa2, bf16x8& pa3) {
#pragma unroll
    for (int r = 0; r < 16; ++r) p1[r] = __builtin_amdgcn_exp2f(p1[r]);
    float ps = 0;
#pragma unroll
    for (int r = 0; r < 16; ++r) ps += p0[r];
#pragma unroll
    for (int r = 0; r < 16; ++r) ps += p1[r];
    { auto rr = __builtin_amdgcn_permlane32_swap(__float_as_uint(ps), __float_as_uint(ps), false, false);
      ps = __uint_as_float(rr[0]) + __uint_as_float(rr[1]); }
    l_reg = l_reg * alpha + ps;
#define PK4(P, B_, OUT) do { unsigned a0 = cvtpk(P[B_+0], P[B_+1]), a1 = cvtpk(P[B_+2], P[B_+3]);                          \
        unsigned b0 = cvtpk(P[B_+4], P[B_+5]), b1 = cvtpk(P[B_+6], P[B_+7]);                                             \
        auto r0 = __builtin_amdgcn_permlane32_swap(a0, b0, false, false); auto r1 = __builtin_amdgcn_permlane32_swap(a1, b1, false, false); \
        u32x4 w = {r0[0], r1[0], r0[1], r1[1]}; OUT = __builtin_bit_cast(bf16x8, w); } while (0)
    PK4(p0, 0, pa0); PK4(p0, 8, pa1); PK4(p1, 0, pa2); PK4(p1, 8, pa3);
#undef PK4
}
template <int KB>
__device__ __forceinline__ void qkt(f32x16& p0, f32x16& p1, const char* K_lds, int r32, int hi, const bf16x8* qr) {
#pragma unroll
    for (int r = 0; r < 16; ++r) { p0[r] = 0.f; p1[r] = 0.f; }
    const char* kb[4];
#pragma unroll
    for (int dd = 0; dd < 4; ++dd) kb[dd] = K_lds + KB * SHM_K + KSWZ(r32, (dd * 16 + hi * 8) * 2);
#pragma unroll
    for (int d0 = 0; d0 < 8; ++d0) { const char* a = kb[d0 & 3] + (d0 >> 2) * 128;
        bf16x8 b0 = *reinterpret_cast<const bf16x8*>(a);
        bf16x8 b1 = *reinterpret_cast<const bf16x8*>(a + 32 * 256);
        p0 = __builtin_amdgcn_mfma_f32_32x32x16_bf16(b0, qr[d0], p0, 0, 0, 0);
        p1 = __builtin_amdgcn_mfma_f32_32x32x16_bf16(b1, qr[d0], p1, 0, 0, 0); }
}
template <int VB>
__device__ __forceinline__ void pv_tile(f32x16* o, int vb0, bf16x8 pa0, bf16x8 pa1, bf16x8 pa2, bf16x8 pa3) {
#define TRRD(dst, off) asm volatile("ds_read_b64_tr_b16 %0, %1 offset:%2" : "=&v"(dst) : "v"(vb0), "i"(off) : "memory")
#define PV_D0(d0) do { s16x4 l0, l1, l2, l3, h0, h1, h2, h3; constexpr int b_ = VB * SHM_V + v_rd_off(d0, 0, 0);   \
        TRRD(l0, b_); TRRD(h0, b_ + 2048); TRRD(l1, b_ + 4096); TRRD(h1, b_ + 6144); TRRD(l2, b_ + 8192); TRRD(h2, b_ + 10240); TRRD(l3, b_ + 12288); TRRD(h3, b_ + 14336); \
        asm volatile("s_waitcnt lgkmcnt(0)" ::: "memory"); SBAR();   \
        o[d0] = __builtin_amdgcn_mfma_f32_32x32x16_bf16(pa0, (bf16x8){l0[0], l0[1], l0[2], l0[3], h0[0], h0[1], h0[2], h0[3]}, o[d0], 0, 0, 0);   \
        o[d0] = __builtin_amdgcn_mfma_f32_32x32x16_bf16(pa1, (bf16x8){l1[0], l1[1], l1[2], l1[3], h1[0], h1[1], h1[2], h1[3]}, o[d0], 0, 0, 0);   \
        o[d0] = __builtin_amdgcn_mfma_f32_32x32x16_bf16(pa2, (bf16x8){l2[0], l2[1], l2[2], l2[3], h2[0], h2[1], h2[2], h2[3]}, o[d0], 0, 0, 0);   \
        o[d0] = __builtin_amdgcn_mfma_f32_32x32x16_bf16(pa3, (bf16x8){l3[0], l3[1], l3[2], l3[3], h3[0], h3[1], h3[2], h3[3]}, o[d0], 0, 0, 0); } while (0)
    PV_D0(0); PV_D0(1); PV_D0(2); PV_D0(3);
#undef PV_D0
#undef TRRD
}

struct BlockRef { const bf16_t* Q; const bf16_t* K; const bf16_t* V; bf16_t* O; int qb; int b, h; };
struct Seam { bf16x8 qr[8]; bf16x8 st_v0, st_v1, st_k0, st_k1; };
#define VMW() asm volatile("s_waitcnt vmcnt(0)" ::: "memory")
#define VMWN(n) asm volatile("s_waitcnt vmcnt(%0)" :: "i"(n) : "memory")
#define LD8(p) (*reinterpret_cast<const bf16x8*>(p))
#define SLOAD_H(Kp, Vp, k0) do { const char* kb__ = (const char*)(Kp) + (size_t)(k0) * (LDP * 2); \
        S.st_v0 = LD8(kb__ + 2048 + kvoff); S.st_v1 = LD8(kb__ + (32 * LDP * 2 + 2048) + kvoff); S.st_k0 = LD8(kb__ + kvoff); S.st_k1 = LD8(kb__ + 32 * LDP * 2 + kvoff); } while (0)
#define SWRITE_HK(bf) do { *(bf16x8*)(K_lds + (bf) * SHM_K + kws) = S.st_k0; *(bf16x8*)(K_lds + (bf) * SHM_K + kws + 32 * 256) = S.st_k1; } while (0)
#define SWRITE_HV(bf) do { *(bf16x8*)(V_lds + (bf) * SHM_V + vst0) = S.st_v0; *(bf16x8*)(V_lds + (bf) * SHM_V + vst1) = S.st_v1; } while (0)
#define SWRITE_H(bf) do { SWRITE_HV(bf); SWRITE_HK(bf); } while (0)

__device__ __forceinline__ void prime(const BlockRef& cur, char* lds, Seam& S) {
    int tid = threadIdx.x; asm volatile("" : "+v"(tid));     const int wid = __builtin_amdgcn_readfirstlane(tid >> 6), lane = tid & 63, r32 = lane & 31, hi = lane >> 5;
    const int sr = tid >> 4, sc = (tid & 15) * 8, kws = KSWZ(sr, sc * 2); char* K_lds = lds + 2 * SHM_V;
    const unsigned kvoff = (unsigned)(sr * LDP + sc) * 2u, qvoff = (unsigned)(r32 * LDP + hi * 8) * 2u;
    { const char* qb__ = (const char*)cur.Q + (size_t)(wid * QBLK) * (LDP * 2);
#pragma unroll
    for (int d0 = 0; d0 < 8; ++d0) S.qr[d0] = LD8(qb__ + qvoff + d0 * 32); }
    SLOAD_H(cur.K, cur.V, 0); VMW(); SWRITE_HK(0);
    __syncthreads();
}
__device__ __forceinline__ int rel_bucket(int n) {
    if (n < 16) return n;
    const float nf = (float)n;
    int large = 16 + (int)(logf(nf / 16.0f) / 5.545177444479562f * 16.0f);
    return large < 31 ? large : 31;
}
__device__ __forceinline__ void block(const BlockRef& cur, const BlockRef& nxt, const float* rel_bias, const float* kmp, char* lds, Seam& S) {
    int tid = threadIdx.x; asm volatile("" : "+v"(tid));     const int wid = __builtin_amdgcn_readfirstlane(tid >> 6), lane = tid & 63, r32 = lane & 31, hi = lane >> 5;
    const int qb = cur.qb, NT = 4 * (qb + 1);
    const int qlo = qb * QB + wid * QBLK, qrow = qlo + r32;
    char* V_lds = lds; char* K_lds = lds + 2 * SHM_V;
    float* ws = (float*)(lds + OFF_WS) + wid * 64; float* li_l = ws, * al_l = ws + 32;
    LAS float* rtab = (LAS float*)(LAS char*)(uintptr_t)(unsigned)(uintptr_t)(lds + OFF_RTAB);
    float* kmL = (float*)(lds + OFF_KM);
    for (int i = tid; i < 2304; i += NW * 64) { const int dist = 2047 - i; rtab[i] = dist >= 0 ? rel_bias[rel_bucket(dist) * 8 + cur.h] * (1.0f / SCALE) : 0.f; }
    for (int i = tid; i < qb * 128; i += NW * 64) { const int j = i >> 7, dd = i & 127; const size_t o = ((size_t)(cur.b * 8 + j)) * 1024 + cur.h * 128 + dd;
        kmL[i] = (kmp[o] + kmp[o + 64 * 1024]) * (1.0f / 256.0f); }
    __syncthreads();
    unsigned selmask = 0;
    {
        float sc7[7];
#pragma unroll
        for (int j = 0; j < 7; ++j) { sc7[j] = -__builtin_inff();
            if (j < qb) { float acc = 0.f;
#pragma unroll
                for (int d0 = 0; d0 < 8; ++d0) { const u32x4 q4 = __builtin_bit_cast(u32x4, S.qr[d0]); const f32x4 k0 = *(const f32x4*)(kmL + j * 128 + d0 * 16 + hi * 8), k1 = *(const f32x4*)(kmL + j * 128 + d0 * 16 + hi * 8 + 4);
                    acc += bflo(q4[0]) * k0[0] + bfhi(q4[0]) * k0[1] + bflo(q4[1]) * k0[2] + bfhi(q4[1]) * k0[3] + bflo(q4[2]) * k1[0] + bfhi(q4[2]) * k1[1] + bflo(q4[3]) * k1[2] + bfhi(q4[3]) * k1[3]; }
                acc += __shfl_xor(acc, 32); sc7[j] = acc; } }
#pragma unroll
        for (int j = 0; j < 7; ++j) { int rank = 0;
#pragma unroll
            for (int i = 0; i < 7; ++i) { if (i != j) rank += (sc7[i] > sc7[j] || (sc7[i] == sc7[j] && i < j)) ? 1 : 0; }
            if (j < qb && (qb <= 3 || rank < 3)) selmask |= 1u << j; }
    }
    LAS unsigned* selp = (LAS unsigned*)(LAS char*)(uintptr_t)(unsigned)(uintptr_t)(lds + OFF_SEL) + tid;
    *selp = selmask;
    float m_reg = -1e30f, l_reg = 0; f32x16 o[4];
#pragma unroll
    for (int d = 0; d < 4; ++d)
#pragma unroll
        for (int r = 0; r < 16; ++r) o[d][r] = 0.f;
    const int sr = tid >> 4, sc = (tid & 15) * 8, vst0 = v_st(sr, sc), vst1 = v_st(32 + sr, sc), kws = KSWZ(sr, sc * 2);
    const unsigned kvoff = (unsigned)(sr * LDP + sc) * 2u;
    const int vb0 = (int)(uintptr_t)V_lds + v_rd_base(lane);
    const bf16_t* Kh = cur.K; const bf16_t* Vh = cur.V;
#define RESC(a) do { if (__any((a) < 1.f)) { if (hi == 0) al_l[r32] = (a); asm volatile("s_waitcnt lgkmcnt(0)" ::: "memory");              \
                     for (int d_ = 0; d_ < 4; ++d_) for (int r = 0; r < 16; ++r) o[d_][r] *= al_l[crow(r, hi)]; } } while (0)
#define KBASE(t) ((t) * KVBLK)
#define MASKT(P0_, P1_, t) do { const int kb_ = KBASE(t); bias_tile(P0_, P1_, rtab + (kb_ + 4 * hi - qrow + 2047)); \
        if (((t) >> 2) != qb) { if (!((*selp >> ((t) >> 2)) & 1u)) kill_tile(P0_, P1_); } \
        else if (kb_ + KVBLK - 1 > qlo) mask_tile(P0_, P1_, qrow - 4 * hi - kb_); } while (0)
    constexpr int NQL = 8;
#define SEAM_K0() do { VMWN(NQL); SWRITE_HK(0); SBAR(); } while (0)
    f32x16 pA0, pA1, pB0, pB1; float mnA, mnB, alA, alB; bf16x8 pa0, pa1, pa2, pa3;
    SWRITE_HV(0); SBAR();
    if (NT > 1) { SLOAD_H(Kh, Vh, KBASE(1)); }
    SBAR(); qkt<0>(pA0, pA1, K_lds, r32, hi, S.qr);
    MASKT(pA0, pA1, 0); partialSM(pA0, pA1, m_reg, mnA, alA);
    if (NT > 1) { VMW(); SWRITE_H(1); }
    __syncthreads();
#define HALF_STEP(PX0, PX1, mnX, alX, PY0, PY1, alY, t, KB, VB, SB) do {                                                      \
        SBAR(); qkt<KB>(PX0, PX1, K_lds, r32, hi, S.qr);                                             \
        finishSM(PY0, PY1, alY, l_reg, pa0, pa1, pa2, pa3); SBAR();                                                           \
        if ((t) + 1 < NT) { SLOAD_H(Kh, Vh, KBASE((t) + 1)); SBAR(); }                                               \
        pv_tile<VB>(o, vb0, pa0, pa1, pa2, pa3); MASKT(PX0, PX1, (t)); partialSM(PX0, PX1, m_reg, mnX, alX);                                        \
        __syncthreads();                                                                                                      \
        if ((t) + 1 < NT) { VMW(); SWRITE_H(SB); }                                                                          \
        RESC(alX); __syncthreads(); } while (0)
    for (int t = 1; t + 1 < NT; t += 2) {
        HALF_STEP(pB0, pB1, mnB, alB, pA0, pA1, alA, t, 1, 0, 0);
        HALF_STEP(pA0, pA1, mnA, alA, pB0, pB1, alB, t + 1, 0, 1, 1);
    }
    { SBAR(); qkt<1>(pB0, pB1, K_lds, r32, hi, S.qr); SBAR(); }
    SLOAD_H(nxt.K, nxt.V, 0); SBAR();
    { const char* qb__ = (const char*)nxt.Q + (size_t)(wid * QBLK) * (LDP * 2); int l_ = lane; asm volatile("" : "+v"(l_));
      const unsigned qvoff = (unsigned)((l_ & 31) * LDP + (l_ >> 5) * 8) * 2u;
#pragma unroll
    for (int d0 = 0; d0 < 8; ++d0) S.qr[d0] = LD8(qb__ + qvoff + d0 * 32); }
    SBAR();
    finishSM(pA0, pA1, alA, l_reg, pa0, pa1, pa2, pa3); SBAR();
    pv_tile<0>(o, vb0, pa0, pa1, pa2, pa3);
    { MASKT(pB0, pB1, NT - 1); partialSM(pB0, pB1, m_reg, mnB, alB); __syncthreads(); RESC(alB);
      finishSM(pB0, pB1, alB, l_reg, pa0, pa1, pa2, pa3); SBAR(); pv_tile<1>(o, vb0, pa0, pa1, pa2, pa3); }
    SBAR(); SEAM_K0();
    if (hi == 0) li_l[r32] = l_reg; asm volatile("s_waitcnt lgkmcnt(0)" ::: "memory");
    float rli[16];
#pragma unroll
    for (int r = 0; r < 16; ++r) rli[r] = __builtin_amdgcn_rcpf(li_l[crow(r, hi)]);
    char* Ow = (char*)cur.O + (size_t)(wid * QBLK) * (LDO * 2); const unsigned ovoff = (unsigned)(4 * hi * LDO + r32) * 2u;
#pragma unroll
    for (int r = 0; r < 16; ++r) { const int orow0 = (r & 3) + 8 * (r >> 2);
#pragma unroll
        for (int d0 = 0; d0 < 4; ++d0) { const float v = o[d0][r] * rli[r];
            const float vn = __shfl_xor(v, 1);
            if ((r32 & 1) == 0) *(unsigned*)(Ow + (size_t)(orow0 * LDO * 2 + d0 * 64) + ovoff) = cvtpk(v, vn); } }
    __syncthreads();
#undef RESC
#undef KBASE
#undef MASKT
#undef SEAM_K0
#undef HALF_STEP
}
#undef ROWP
#undef VMW
#undef VMWN
#undef LD8
#undef SLOAD_H
#undef SWRITE_HK
#undef SWRITE_HV
#undef SWRITE_H

__device__ __forceinline__ BlockRef make_ref(const P& a, int item) {
    const int qb = 7 - (item >> 6), bh = item & 63, b = bh >> 3, h = bh & 7;
    const bf16_t* proj = (const bf16_t*)(a.ws + WS_PROJ);
    BlockRef r; r.b = b; r.h = h; r.qb = qb;
    r.Q = proj + (size_t)(b * SEQ + qb * QB) * LDP + C_QB + h * HD;
    r.K = proj + (size_t)(b * SEQ) * LDP + C_KB + h * HD;
    r.V = proj + (size_t)(b * SEQ) * LDP + C_VB + h * HD;
    r.O = (bf16_t*)(a.ws + WS_OAB) + (size_t)(b * SEQ + qb * QB) * LDO + 1024 + h * HD;
    return r;
}
}
__device__ __forceinline__ void router_unit(const P& a, LAS unsigned char* lds, int unit) {
    int tid = threadIdx.x; asm volatile("" : "+v"(tid));     const int wave = __builtin_amdgcn_readfirstlane(tid >> 6), lane = tid & 63, c32 = lane & 31, hi = lane >> 5;
    const float* x1 = a.out; const float* g = a.in[11]; const float* br = a.in[13];
    unsigned char* A2 = a.ws + WS_H; const u32x4* frag = (const u32x4*)(a.ws + WS_WRF);
    LAS float* Lw = (LAS float*)(lds + wave * 4352);
    LAS unsigned* hist = (LAS unsigned*)(lds + 8 * 4352);
    LAS unsigned* base = hist + 32;
    if (tid < 32) hist[tid] = 0u;
    __syncthreads();
    const int tok = unit * 256 + wave * 32 + c32;
    f32x16 L;
#pragma unroll
    for (int r = 0; r < 16; ++r) L[r] = 0.f;
    float ss = 0.f;
    const float* xr = x1 + (size_t)tok * D + 8 * hi; unsigned char* ar = A2 + (size_t)tok * D + 8 * hi; const float* gr = g + 8 * hi;
#pragma unroll 2
    for (int s = 0; s < 64; ++s) {
        const f32x4 xa = *(const f32x4*)(xr + 16 * s), xb = *(const f32x4*)(xr + 16 * s + 4), ga = *(const f32x4*)(gr + 16 * s), gb = *(const f32x4*)(gr + 16 * s + 4);
        ss += (xa.x * xa.x + xa.y * xa.y) + (xa.z * xa.z + xa.w * xa.w) + (xb.x * xb.x + xb.y * xb.y) + (xb.z * xb.z + xb.w * xb.w);
        const f32x4 va = xa * ga, vb = xb * gb;
        u32x4 wh; wh.x = cvt_pk_bf16(va.x, va.y); wh.y = cvt_pk_bf16(va.z, va.w); wh.z = cvt_pk_bf16(vb.x, vb.y); wh.w = cvt_pk_bf16(vb.z, vb.w);
        { u32x2 w8; w8.x = pk4_fp8(va.x, va.y, va.z, va.w); w8.y = pk4_fp8(vb.x, vb.y, vb.z, vb.w); *(u32x2*)(ar + 16 * s) = w8; }
        u32x4 wl; wl.x = cvt_pk_bf16(va.x - bflo(wh.x), va.y - bfhi(wh.x)); wl.y = cvt_pk_bf16(va.z - bflo(wh.y), va.w - bfhi(wh.y));
        wl.z = cvt_pk_bf16(vb.x - bflo(wh.z), vb.y - bfhi(wh.z)); wl.w = cvt_pk_bf16(vb.z - bflo(wh.w), vb.w - bfhi(wh.w));
        const bf16x8 ah = __builtin_bit_cast(bf16x8, wh), al = __builtin_bit_cast(bf16x8, wl);
        const bf16x8 bh = __builtin_bit_cast(bf16x8, frag[s * 64 + lane]), bl = __builtin_bit_cast(bf16x8, frag[4096 + s * 64 + lane]);
        L = __builtin_amdgcn_mfma_f32_32x32x16_bf16(ah, bh, L, 0, 0, 0);
        L = __builtin_amdgcn_mfma_f32_32x32x16_bf16(ah, bl, L, 0, 0, 0);
        L = __builtin_amdgcn_mfma_f32_32x32x16_bf16(al, bh, L, 0, 0, 0);
    }
    ss += __shfl_xor(ss, 32);
    const float rstd = 1.0f / sqrtf(ss * (1.0f / D) + EPS);
#pragma unroll
    for (int r = 0; r < 16; ++r) Lw[((r & 3) + 8 * (r >> 2) + 4 * hi) * 33 + c32] = L[r];
    LDS_WAIT(); asm volatile("" ::: "memory");
    int e4[4] = {0, 0, 0, 0}; float w4[4] = {0.f, 0.f, 0.f, 0.f}; unsigned loc[4] = {0u, 0u, 0u, 0u};
    if (hi == 0) {
        float lg[32];
#pragma unroll
        for (int e = 0; e < 32; ++e) lg[e] = Lw[c32 * 33 + e] * rstd + br[e];
        unsigned used = 0u; float v4[4];
#pragma unroll
        for (int p = 0; p < 4; ++p) { float best = -__builtin_inff(); int bi = 0;
#pragma unroll
            for (int e = 0; e < 32; ++e) { const bool take = !((used >> e) & 1u) && lg[e] > best; best = take ? lg[e] : best; bi = take ? e : bi; }
            used |= 1u << bi; e4[p] = bi; v4[p] = best; }
        float sum = 0.f;
#pragma unroll
        for (int p = 0; p < 4; ++p) { w4[p] = expf(v4[p] - v4[0]); sum += w4[p]; }
        const float inv = 1.0f / sum;
#pragma unroll
        for (int p = 0; p < 4; ++p) { w4[p] *= inv; loc[p] = __hip_atomic_fetch_add(hist + e4[p], 1u, __ATOMIC_RELAXED, __HIP_MEMORY_SCOPE_WORKGROUP); }
    }
    __syncthreads();
    if (tid < 32) base[tid] = __hip_atomic_fetch_add((unsigned*)(a.ws + WS_CTL) + CW_COUNTS + tid, hist[tid], RLX_AGENT);
    __syncthreads();
    if (hi == 0) {
        int* tope = (int*)(a.ws + WS_TOPE) + (size_t)tok * 4; float* wts = (float*)(a.ws + WS_WTS) + (size_t)tok * 4; int* slot = (int*)(a.ws + WS_SLOT) + (size_t)tok * 4;
#pragma unroll
        for (int p = 0; p < 4; ++p) { tope[p] = e4[p]; wts[p] = w4[p]; slot[p] = (int)(base[e4[p]] + loc[p]); }
        ((float*)(a.ws + WS_RSTD))[tok] = rstd;
    }
    __syncthreads();
}

__device__ __forceinline__ void moe_index(const P& a, LAS unsigned char* lds, int vcu, int G) {
    const int tid = threadIdx.x;
    LAS int* pstart = (LAS int*)lds;
    LAS int* cnt = pstart + 64;
    const unsigned* counts = (const unsigned*)(a.ws + WS_CTL) + CW_COUNTS;
    if (tid == 0) { int acc = 0; for (int e = 0; e < NE; ++e) { const int c = (int)counts[e]; cnt[e] = c; pstart[e] = acc; acc += ((c + 255) >> 8) << 8; } pstart[NE] = acc; }
    __syncthreads();
    int* rowtok = (int*)(a.ws + WS_ROWTOK); float* rstds = (float*)(a.ws + WS_RSTDS); int* dest = (int*)(a.ws + WS_DEST);
    const int* tope = (const int*)(a.ws + WS_TOPE); const int* slot = (const int*)(a.ws + WS_SLOT); const float* rstd = (const float*)(a.ws + WS_RSTD);
    const int gt = vcu * NTHREADS + tid, NGT = G * NTHREADS;
    for (int i = gt; i < T * 4; i += NGT) { const int e = tope[i], d = pstart[e] + slot[i]; dest[i] = d; rowtok[d] = i >> 2; rstds[d] = rstd[i >> 2]; }
    for (int i = gt; i < NE * 256; i += NGT) { const int e = i >> 8, r = pstart[e] + cnt[e] + (i & 255); if (r < pstart[e + 1]) { rowtok[r] = 0; rstds[r] = 0.f; } }
    if (vcu == 0) { int* tile_e = (int*)(a.ws + WS_TILEE);
        for (int t = tid; t < MAXTILES; t += NTHREADS) { int e = NE - 1; for (int q = 0; q < NE; ++q) { if (t * 256 >= pstart[q] && t * 256 < pstart[q + 1]) e = q; } tile_e[t] = e; }
        if (tid == 0) tile_e[MAXTILES] = pstart[NE] >> 8; }
    __syncthreads();
}

__device__ __forceinline__ void combine_rows(const P& a, int vcu, int G, int wave, int lane) {
    const int gw = vcu * NWAVES + wave, NGW = G * NWAVES;
    float* X = a.out; const bf16_t* Y = (const bf16_t*)(a.ws + WS_YROWS); bf16_t* A3 = (bf16_t*)(a.ws + WS_H);
    const int* dest = (const int*)(a.ws + WS_DEST); const float* wts = (const float*)(a.ws + WS_WTS); const float* g = a.in[20];
    f32x4 gv[4];
#pragma unroll
    for (int j = 0; j < 4; ++j) gv[j] = *((const f32x4*)g + lane + 64 * j);
    for (int m = gw; m < T; m += NGW) {
        f32x4* xr = (f32x4*)(X + (size_t)m * D) + lane; f32x4 v[4];
#pragma unroll
        for (int j = 0; j < 4; ++j) v[j] = xr[64 * j];
#pragma unroll
        for (int k = 0; k < 4; ++k) { const int d = __builtin_amdgcn_readfirstlane(dest[m * 4 + k]); const float w = __uint_as_float(__builtin_amdgcn_readfirstlane(__float_as_uint(wts[m * 4 + k])));
            const u32x2* yr = (const u32x2*)(Y + (size_t)d * D) + lane;
#pragma unroll
            for (int j = 0; j < 4; ++j) { const u32x2 y = yr[64 * j]; v[j].x += w * bflo(y.x); v[j].y += w * bfhi(y.x); v[j].z += w * bflo(y.y); v[j].w += w * bfhi(y.y); } }
        float s = 0.f;
#pragma unroll
        for (int j = 0; j < 4; ++j) s += (v[j].x * v[j].x + v[j].y * v[j].y) + (v[j].z * v[j].z + v[j].w * v[j].w);
        const float rstd = 1.0f / sqrtf(wave_sum(s) * (1.0f / D) + EPS);
        u32x2* o8 = (u32x2*)(A3 + (size_t)m * D) + lane;
#pragma unroll
        for (int j = 0; j < 4; ++j) { xr[64 * j] = v[j]; u32x2 w; w.x = cvt_pk_bf16(v[j].x * rstd * gv[j].x, v[j].y * rstd * gv[j].y); w.y = cvt_pk_bf16(v[j].z * rstd * gv[j].z, v[j].w * rstd * gv[j].w); o8[64 * j] = w; }
    }
}
__device__ __forceinline__ void final_rows(const P& a, int vcu, int G, int wave, int lane) {
    const int gw = vcu * NWAVES + wave, NGW = G * NWAVES;
    float* X = a.out; const bf16_t* PG = (const bf16_t*)(a.ws + WS_PGATE); const bf16_t* PP = (const bf16_t*)(a.ws + WS_PPROJ);
    f32x4 gp[4], gf[4];
#pragma unroll
    for (int j = 0; j < 4; ++j) { gp[j] = *((const f32x4*)a.in[23] + lane + 64 * j); gf[j] = *((const f32x4*)a.in[24] + lane + 64 * j); }
    for (int m = gw; m < T; m += NGW) {
        f32x4* xr = (f32x4*)(X + (size_t)m * D) + lane; const u32x2* pgr = (const u32x2*)(PG + (size_t)m * D) + lane; const u32x2* ppr = (const u32x2*)(PP + (size_t)m * D) + lane;
        f32x4 v[4], pp[4], pg[4]; float sp = 0.f;
#pragma unroll
        for (int j = 0; j < 4; ++j) { v[j] = xr[64 * j]; const u32x2 q = ppr[64 * j], gq = pgr[64 * j];
            pp[j] = (f32x4){bflo(q.x), bfhi(q.x), bflo(q.y), bfhi(q.y)}; pg[j] = (f32x4){bflo(gq.x), bfhi(gq.x), bflo(gq.y), bfhi(gq.y)};
            sp += (pp[j].x * pp[j].x + pp[j].y * pp[j].y) + (pp[j].z * pp[j].z + pp[j].w * pp[j].w); }
        const float rp = 1.0f / sqrtf(wave_sum(sp) * (1.0f / D) + EPS); float s = 0.f;
#pragma unroll
        for (int j = 0; j < 4; ++j) { v[j] = v[j] + pg[j] * (pp[j] * rp * gp[j]); s += (v[j].x * v[j].x + v[j].y * v[j].y) + (v[j].z * v[j].z + v[j].w * v[j].w); }
        const float rstd = 1.0f / sqrtf(wave_sum(s) * (1.0f / D) + EPS);
#pragma unroll
        for (int j = 0; j < 4; ++j) xr[64 * j] = v[j] * rstd * gf[j];
    }
}
struct Args { P p; };
template <int PH_LO, int PH_HI>
__global__ void __launch_bounds__(NTHREADS, 2) hybrid_fwd(Args args) {
    extern __shared__ __attribute__((aligned(16))) unsigned char lds_raw[];
    LAS unsigned char* lds = (LAS unsigned char*)lds_raw;
    const P& a = args.p;
    const int tid = threadIdx.x, lane = tid & 63, wave = __builtin_amdgcn_readfirstlane(tid >> 6);
    const int G = gridDim.x; const int bx = blockIdx.x; const int vcu = (G % 8 == 0) ? (bx % 8) * (G / 8) + bx / 8 : bx;
    unsigned* ctl = (unsigned*)(a.ws + WS_CTL);
    for (int u = tid; u < (LDS_BYTES - LDSCTL_OFF) / 4; u += NTHREADS) ((LAS unsigned*)(lds + LDSCTL_OFF))[u] = 0u;
    __syncthreads();
#if MK_PER_PHASE
#define GRID_BAR() do { } while (0)
#else
    XcdBarrier bar = xcd_barrier_post(ctl + CW_BAR, (volatile LAS unsigned*)(lds + MISC_OFF + 32));
#define GRID_BAR() xcd_barrier(bar)
#endif
    constexpr int lo = PH_LO, hi = PH_HI;
#define IN(k) (lo <= (k) && (k) < hi)
#define SEAM(k) do { if constexpr (IN(k) && IN((k) + 1)) GRID_BAR(); } while (0)
    unsigned char* ws = a.ws;

    if constexpr (IN(0)) { p0_prologue(a, lds, vcu, G, wave, lane); }
    SEAM(0);
    if constexpr (IN(1)) {
        pg8::DenseSched S; S.o.init(T / 256, NPROJ / 256, G, bx); S.Bt = (const char*)(ws + WS_WIN); S.K = D;
        pg8::EpiProj E{(bf16_t*)(ws + WS_PROJ), (float*)(ws + WS_KMP)};
        pg8::gemm_phase(lds, (const char*)(ws + WS_H), D, D, D, S, E);
    }
    SEAM(1);
    if constexpr (IN(2)) { for (int u = vcu; u < NB * 32; u += G) gla_prep_unit(a, lds, u); }
    SEAM(2);
    if constexpr (IN(3)) { for (int u = vcu; u < 512; u += G) gla_combine_unit(a, u); }
    SEAM(3);
    if constexpr (IN(4)) {
        for (int u = vcu; u < 1024; u += G) gla_out_unit(a, lds, u);
        __syncthreads();
    }
    if constexpr (IN(5)) {
        for (int c = bx; c < 256; c += G) {
            moba::Seam S;
            moba::BlockRef cur = moba::make_ref(a, c); const moba::BlockRef second = moba::make_ref(a, 511 - c);
            moba::prime(cur, (char*)lds_raw, S);
            for (int pass = 0; pass < 2; ++pass) {
                moba::block(cur, second, a.in[2], (const float*)(ws + WS_KMP), (char*)lds_raw, S);
                cur = second;
            }
        }
    }
    SEAM(5);
    if constexpr (IN(6)) {
        pg8::ChainSched S; S.o.init(T / 256, D / 256, G, bx); S.Bt = (const char*)(ws + WS_WUP); S.K = 1024;
        pg8::EpiMerge E{(const bf16_t*)(ws + WS_PROJ), (bf16_t*)(ws + WS_Y)};
        pg8::gemm_phase(lds, (const char*)(ws + WS_OAB), 1024, 2048, 2048, S, E);
    }
    SEAM(6);
    if constexpr (IN(7)) {
        pg8::DenseSched S; S.o.init(T / 256, D / 256, G, bx); S.Bt = (const char*)(ws + WS_WO); S.K = D;
        pg8::EpiResF32 E{a.in[0], a.out};
        pg8::gemm_phase(lds, (const char*)(ws + WS_Y), D, D, D, S, E);
        __syncthreads();
        expert_convert(a, lds, vcu, G, wave, lane);
    }
    SEAM(7);
    if constexpr (IN(8)) { for (int u = vcu; u < T / 256; u += G) router_unit(a, lds, u); }
    SEAM(8);
    if constexpr (IN(9)) { moe_index(a, lds, vcu, G); }
    SEAM(9);
    if constexpr (IN(10)) {
        const int* tile_e = (const int*)(ws + WS_TILEE); const int ntile = __builtin_amdgcn_readfirstlane(tile_e[MAXTILES]);
        pg8::MoeSched<true> S; S.o.init(ntile, 8, G, bx); S.Bt = (const char*)(ws + WS_W1T); S.K = D; S.rows_per_e = 2048; S.tile_e = tile_e; S.row_tok = (const int*)(ws + WS_ROWTOK); S.es = 1;
        pg8::EpiGlu E{(unsigned char*)(ws + WS_HMID), (const float*)(ws + WS_RSTDS), a.in[15], a.in[17]};
        pg8::gemm_phase(lds, (const char*)(ws + WS_H), D, D, D, S, E);
    }
    SEAM(10);
    if constexpr (IN(11)) {
        const int* tile_e = (const int*)(ws + WS_TILEE); const int ntile = __builtin_amdgcn_readfirstlane(tile_e[MAXTILES]);
        pg8::MoeSched<false> S; S.o.init(ntile, 4, G, bx); S.Bt = (const char*)(ws + WS_W2T); S.K = FF; S.rows_per_e = 1024; S.tile_e = tile_e; S.row_tok = nullptr; S.es = 1;
        pg8::EpiBf16<0, true, true> E{(bf16_t*)(ws + WS_YROWS), D, a.in[19], D, 1.0f / 32.0f};
        pg8::gemm_phase(lds, (const char*)(ws + WS_HMID), FF, FF, FF, S, E);
    }
    SEAM(11);
    if constexpr (IN(12)) { combine_rows(a, vcu, G, wave, lane); }
    SEAM(12);
    if constexpr (IN(13)) {
        { pg8::DenseSched S; S.o.init(T / 256, D / 256, G, bx); S.Bt = (const char*)(ws + WS_WPG); S.K = D;
          pg8::EpiBf16<1, false> E{(bf16_t*)(ws + WS_PGATE), D, nullptr, 0, 1.0f};
          pg8::gemm_phase(lds, (const char*)(ws + WS_H), D, D, D, S, E); }
        __syncthreads();
        { pg8::DenseSched S; S.o.init(T / 256, D / 256, G, bx); S.Bt = (const char*)(ws + WS_WPP); S.K = 256;
          pg8::EpiBf16<0, false> E{(bf16_t*)(ws + WS_PPROJ), D, nullptr, 0, 1.0f};
          pg8::gemm_phase(lds, (const char*)(ws + WS_PB), 256, 256, 256, S, E); }
    }
    SEAM(13);
    if constexpr (IN(14)) { final_rows(a, vcu, G, wave, lane); }
#undef IN
#undef SEAM
#undef GRID_BAR
}

template <int LO, int HI> static void launch_range(const Args& a, int grid, hipStream_t stream) {
    static bool attr = false;
    if (!attr) { attr = true; if (hipFuncSetAttribute((const void*)hybrid_fwd<LO, HI>, hipFuncAttributeMaxDynamicSharedMemorySize, LDS_BYTES) != hipSuccess) fprintf(stderr, "kernel_launch: hipFuncSetAttribute failed\n"); }
    hipLaunchKernelGGL((hybrid_fwd<LO, HI>), dim3(grid), dim3(NTHREADS), LDS_BYTES, stream, a);
}
extern "C" void kernel_launch(void* const* d_in, const int* in_sizes, int n_in, void* d_out, int out_size, void* d_ws, size_t ws_size, hipStream_t stream) {
    static int grid = 0;
    if (grid == 0) {
        static const int expect[25] = {T * D, T * 256, 256, 1024, 1024 * D_IN, 16 * 512, 512, 256, 1048576, 1048576, 1048576, 1024, 32768, 32, 33554432, 32768, 33554432, 32768, 33554432, 32768, 1024, 1048576, 262144, 1024, 1024};
        bool okk = (n_in == 25);
        for (int i = 0; okk && i < 25; ++i) if (in_sizes[i] != expect[i]) { fprintf(stderr, "kernel_launch: input %d has %d elements, expected %d\n", i, in_sizes[i], expect[i]); okk = false; }
        if (!okk || out_size != T * D || ws_size < WS_END) { fprintf(stderr, "kernel_launch: unexpected shapes (n_in %d, in0 %d, out %d, ws %zu); nothing launched\n", n_in, n_in > 0 ? in_sizes[0] : -1, out_size, ws_size); grid = -1; return; }
        int dev = 0, cus = 0;
        if (hipGetDevice(&dev) != hipSuccess || hipDeviceGetAttribute(&cus, hipDeviceAttributeMultiprocessorCount, dev) != hipSuccess) { grid = -1; return; }
        grid = cus;
    }
    if (grid < 0) return;
    (void)hipMemsetAsync((char*)d_ws + WS_CTL, 0, CTL_ZERO_BYTES, stream);
    Args a{};
    for (int i = 0; i < 25; ++i) a.p.in[i] = (const float*)d_in[i];
    a.p.out = (float*)d_out; a.p.ws = (unsigned char*)d_ws;
#if MK_PER_PHASE
#ifndef MK_LAST
#define MK_LAST 14
#endif
#ifndef MK_REPEAT
#define MK_REPEAT 0
#endif
#define LR(k) do { if ((k) <= MK_LAST) for (int r_ = 0; r_ < 1 + ((MK_REPEAT >> (k)) & 1); ++r_) launch_range<(k), (k) + 1>(a, grid, stream); } while (0)
    LR(0); LR(1); LR(2); LR(3); LR(4); LR(5); LR(6); LR(7); LR(8); LR(9); LR(10); LR(11); LR(12); LR(13); LR(14);
#undef LR
#else
    launch_range<0, NPHASES>(a, grid, stream);
#endif
}
```

```cpp
#define MK_PER_PHASE 0
#define MK_REPEAT 0
#include <hip/hip_runtime.h>
#include <cstdio>
#include <cstdint>

#define LAS __attribute__((address_space(3)))
#define GAS __attribute__((address_space(1)))
typedef unsigned short bf16_t;
typedef short bf16x8 __attribute__((ext_vector_type(8)));
typedef short s16x4 __attribute__((ext_vector_type(4)));
typedef float f32x2 __attribute__((ext_vector_type(2)));
typedef float f32x4 __attribute__((ext_vector_type(4)));
typedef float f32x16 __attribute__((ext_vector_type(16)));
typedef unsigned u32x2 __attribute__((ext_vector_type(2)));
typedef unsigned u32x4 __attribute__((ext_vector_type(4)));
typedef int i32x4 __attribute__((ext_vector_type(4)));
typedef int i32x8 __attribute__((ext_vector_type(8)));
typedef GAS unsigned gu32;
#define RLX_AGENT __ATOMIC_RELAXED, __HIP_MEMORY_SCOPE_AGENT
#define LDS_WAIT() asm volatile("s_waitcnt lgkmcnt(0)" ::: "memory")
#define VM_WAIT() asm volatile("s_waitcnt vmcnt(0)" ::: "memory")

#ifndef MK_PER_PHASE
#define MK_PER_PHASE 0
#endif

constexpr int NB = 8, SEQ = 2048, T = NB * SEQ, D = 1024;
constexpr int NPROJ = 8192;
constexpr int C_QA = 0, C_KA = 512, C_VA = 1024, C_RA = 2048, C_QB = 3072, C_KB = 4096, C_VB = 5120, C_GA = 6144, C_GB = 7168;
constexpr int SRC_ALOW = 3072, D_IN = 8208;
constexpr int NE = 32, FF = 1024, MAXTILES = 288, MAXROWS = MAXTILES * 256;
constexpr float EPS = 1e-6f;
constexpr int NWAVES = 8, NTHREADS = 512;
constexpr int NPHASES = 15;

constexpr size_t MiB = 1u << 20;
constexpr size_t WS_CTL = 0, CTL_ZERO_BYTES = 1 * MiB;
constexpr size_t WS_SMALL = 1 * MiB;
constexpr size_t WS_KMP   = WS_SMALL;
constexpr size_t WS_DEC   = WS_KMP + 512 * 1024;
constexpr size_t WS_TOPE  = WS_DEC + 512 * 1024;
constexpr size_t WS_WTS   = WS_TOPE + 256 * 1024;
constexpr size_t WS_SLOT  = WS_WTS + 256 * 1024;
constexpr size_t WS_DEST  = WS_SLOT + 256 * 1024;
constexpr size_t WS_ROWTOK = WS_DEST + 256 * 1024;
constexpr size_t WS_RSTDS = WS_ROWTOK + 320 * 1024;
constexpr size_t WS_RSTD  = WS_RSTDS + 320 * 1024;
constexpr size_t WS_TILEE = WS_RSTD + 64 * 1024;
constexpr size_t WS_WALT  = WS_TILEE + 4 * 1024;
constexpr size_t WS_WRF   = WS_WALT + 32 * 1024;
static_assert(WS_WRF + 128 * 1024 <= 6 * MiB, "small map");
constexpr size_t WS_WO = 6 * MiB, WS_WPG = 8 * MiB, WS_WPP = 10 * MiB, WS_WUP = 12 * MiB, WS_WIN = 16 * MiB;
constexpr size_t WS_PB = 34 * MiB;
constexpr size_t WS_H  = 42 * MiB;
constexpr size_t WS_PROJ = 74 * MiB;
constexpr size_t WS_QG = 330 * MiB, WS_KG = 346 * MiB;
constexpr size_t WS_SLOC = 426 * MiB;
constexpr size_t WS_OAB = 362 * MiB;
constexpr size_t WS_H8 = 426 * MiB;
constexpr size_t WS_WIN8 = 442 * MiB;
constexpr size_t WS_Y = 330 * MiB;
constexpr size_t WS_W2T = 74 * MiB;
constexpr size_t WS_HMID = 138 * MiB;
constexpr size_t WS_W1T = 426 * MiB;
constexpr size_t WS_YROWS = 282 * MiB;
constexpr size_t WS_PGATE = 74 * MiB, WS_PPROJ = 106 * MiB;
constexpr size_t WS_END = 506 * MiB;

constexpr int CW_BAR = 4096;
constexpr int CW_COUNTS = 16384;
constexpr int CW_QUEUE = 16384 + 64;

constexpr int RING_BYTES = 131072;
constexpr int LDSCTL_OFF = RING_BYTES, MISC_OFF = LDSCTL_OFF + 320;
constexpr int LDS_BYTES = 147456;

typedef __bf16 bf16v2_t __attribute__((ext_vector_type(2)));
__device__ __forceinline__ unsigned cvt_pk_bf16(float lo, float hi) { const f32x2 v = {lo, hi}; return __builtin_bit_cast(unsigned, __builtin_convertvector(v, bf16v2_t)); }
__device__ __forceinline__ unsigned pk4_fp8(float a, float b, float c, float d) { int w = 0; w = __builtin_amdgcn_cvt_pk_fp8_f32(a, b, w, false); w = __builtin_amdgcn_cvt_pk_fp8_f32(c, d, w, true); return (unsigned)w; }
__device__ __forceinline__ float bf2f(unsigned short s) { return __uint_as_float(((unsigned)s) << 16); }
__device__ __forceinline__ float bflo(unsigned w) { return __uint_as_float(w << 16); }
__device__ __forceinline__ float bfhi(unsigned w) { return __uint_as_float(w & 0xffff0000u); }
__device__ __forceinline__ float fsigmoid(float x) { return __builtin_amdgcn_rcpf(1.0f + __builtin_amdgcn_exp2f(-1.4426950408889634f * x)); }
__device__ __forceinline__ float wave_sum(float v) {
#pragma unroll
    for (int o = 1; o < 64; o <<= 1) v += __shfl_xor(v, o);
    return v;
}
__device__ __forceinline__ bf16x8 pack8(f32x4 a, f32x4 b) {
    u32x4 w = {cvt_pk_bf16(a[0], a[1]), cvt_pk_bf16(a[2], a[3]), cvt_pk_bf16(b[0], b[1]), cvt_pk_bf16(b[2], b[3])};
    return __builtin_bit_cast(bf16x8, w);
}

#define XB_TMO      128
#define XB_XCNT(j)  (256  + 64 * (j))
#define XB_XSUB(j)  (1280 + 64 * (j))
#define XB_XGEN(j)  (2304 + 64 * (j))
#define XB_TOP      3328
#define XB_TOPGEN   3392
#define XCD_BAR_WORDS 3456
#define XB_SPIN_CAP (1u << 18)

__device__ __forceinline__ unsigned xb_ld(unsigned* p)              { return __hip_atomic_load(p, __ATOMIC_RELAXED, __HIP_MEMORY_SCOPE_AGENT); }
__device__ __forceinline__ unsigned xb_add(unsigned* p, unsigned v) { return __hip_atomic_fetch_add(p, v, __ATOMIC_RELAXED, __HIP_MEMORY_SCOPE_AGENT); }
__device__ __forceinline__ unsigned xb_xcc_id() { return (unsigned)__builtin_amdgcn_s_getreg((3 << 11) | 20) & 0xFu; }
#define XB_SPIN(cond, bar) do { unsigned _sp = 0; while (cond) { __builtin_amdgcn_s_sleep(1); \
    if ((++_sp & 255u) == 0u) { if (xb_ld(&(bar)[XB_TMO])) break; if (_sp > XB_SPIN_CAP) { atomicAdd(&(bar)[XB_TMO], 1u); break; } } } } while (0)

struct XcdBarrier { unsigned* bar; unsigned x; volatile LAS unsigned* st; };

__device__ __forceinline__ XcdBarrier xcd_barrier_post(unsigned* bar, volatile LAS unsigned* st) {
    XcdBarrier b; b.bar = bar; b.x = xb_xcc_id(); b.st = st;
    if (threadIdx.x == 0) (void)xb_add(&bar[XB_XCNT(b.x)], 1u);
    return b;
}
__device__ __forceinline__ void xcd_barrier_complete(unsigned* bar, unsigned x, unsigned& nloc, unsigned& nx) {
    const unsigned G = gridDim.x * gridDim.y * gridDim.z;
    unsigned sum, cnt, mine, sp = 0u;
    for (;;) {
        sum = 0u; cnt = 0u; mine = 0u;
#pragma unroll
        for (unsigned j = 0; j < 16; ++j) { const unsigned c = xb_ld(&bar[XB_XCNT(j)]); sum += c; cnt += (c > 0u) ? 1u : 0u; mine = (j == x) ? c : mine; }
        if (sum == G) break;
        __builtin_amdgcn_s_sleep(1);
        if ((++sp & 255u) == 0u) { if (xb_ld(&bar[XB_TMO])) break; if (sp > XB_SPIN_CAP) { atomicAdd(&bar[XB_TMO], 1u); break; } }
    }
    nloc = mine > 0u ? mine : 1u; nx = cnt > 0u ? cnt : 1u;
}
__device__ __forceinline__ void xcd_barrier(const XcdBarrier& b) {
    asm volatile("s_waitcnt vmcnt(0)" ::: "memory");
    __syncthreads();
    if (threadIdx.x == 0) {
        unsigned* bar = b.bar;
        __builtin_amdgcn_s_waitcnt(0);
        unsigned nloc = b.st[0], nx = b.st[1];
        if (nloc == 0u) { xcd_barrier_complete(bar, b.x, nloc, nx); b.st[0] = nloc; b.st[1] = nx; }
        const unsigned old = xb_add(&bar[XB_XSUB(b.x)], 1u);
        const unsigned gen = old / nloc;
        if (old + 1u == (gen + 1u) * nloc) {
            __builtin_amdgcn_fence(__ATOMIC_RELEASE, "agent");
            asm volatile("s_waitcnt vmcnt(0)" ::: "memory");
            const unsigned og = xb_add(&bar[XB_TOP], 1u);
            const unsigned tg = og / nx;
            if (og + 1u == (tg + 1u) * nx) xb_add(&bar[XB_TOPGEN], 1u);
            else XB_SPIN(xb_ld(&bar[XB_TOPGEN]) == tg, bar);
            __builtin_amdgcn_fence(__ATOMIC_ACQUIRE, "agent");
            xb_add(&bar[XB_XGEN(b.x)], 1u);
            asm volatile("s_waitcnt vmcnt(0)" ::: "memory");
        } else {
            XB_SPIN(xb_ld(&bar[XB_XGEN(b.x)]) == gen, bar);
            __builtin_amdgcn_fence(__ATOMIC_ACQUIRE, "agent");
            asm volatile("s_waitcnt vmcnt(0)" ::: "memory");
        }
    }
    __syncthreads();
}
namespace pg8 {
constexpr int BM = 256, BK = 64, HALF = 128, HTB = HALF * BK * 2, STAGE_BYTES = 8 * HTB, NXCD = 8, WGM = 8;

__host__ __device__ __forceinline__ int lds_byte(int r, int c) { const int st = (r >> 4) * 2 + (c >> 5), rr = r & 15, cc = c & 31, ob = rr * 64 + cc * 2; return st * 1024 + (ob ^ (((ob >> 9) & 1) << 5)); }
__host__ __device__ __forceinline__ void stage_rc(int b, int& R, int& C) { const int st = b / 1024, sb = b % 1024, swz = sb ^ (((sb >> 9) & 1) << 5); R = (st >> 1) * 16 + swz / 64; C = (st & 1) * 32 + (swz % 64) / 2; }
__host__ __device__ __forceinline__ int perm32(int rho) { const int n = rho >> 4, i = rho & 15; return 8 * (i >> 2) + 4 * n + (i & 3); }

struct Unit { int pm, pn, e; };

struct TileOrder {
    int nM, nN, nwg, G, c;
    __device__ __forceinline__ void init(int nM_, int nN_, int G_, int c_) { nM = nM_; nN = nN_; nwg = nM * nN; G = G_; c = c_; }
    __device__ __forceinline__ bool next(int i, int& pm, int& pn) const {
        const long L = (long)i * G + c; if (L >= nwg) return false;
        int wgid = (int)L; { const int q = nwg / NXCD, r = nwg % NXCD, xcd = wgid % NXCD, off = wgid / NXCD; wgid = (xcd < r ? xcd * (q + 1) : r * (q + 1) + (xcd - r) * q) + off; }
        const int nig = WGM * nN, gid = wgid / nig, fm = gid * WGM, gsz = (nM - fm) < WGM ? (nM - fm) : WGM;
        pm = fm + ((wgid % nig) % gsz); pn = (wgid % nig) / gsz; return true;
    }
};
struct DenseSched {
    TileOrder o; const char* Bt; int K; int es = 2; int gap_at = 1 << 30, gap_by = 0, pn0 = 0; bool bt_out = true;
    __device__ __forceinline__ bool next(int i, Unit& u) const { int p; if (!o.next(i, u.pm, p)) return false; u.e = p; u.pn = p + (p >= gap_at ? gap_by : 0) + pn0; return true; }
    __device__ __forceinline__ unsigned a_row(const Unit& u, int r) const { return (unsigned)(u.pm * BM + r); }
    __device__ __forceinline__ unsigned a_koff(const Unit&) const { return 0u; }
    __device__ __forceinline__ const char* b_base(const Unit& u) const { return Bt + (size_t)(bt_out ? u.pn : u.e) * BM * K * es; }
};
struct ChainSched {
    TileOrder o; const char* Bt; int K;
    __device__ __forceinline__ bool next(int i, Unit& u) const { if (!o.next(i >> 1, u.pm, u.pn)) return false; u.e = i & 1; return true; }
    __device__ __forceinline__ unsigned a_row(const Unit& u, int r) const { return (unsigned)(u.pm * BM + r); }
    __device__ __forceinline__ unsigned a_koff(const Unit& u) const { return (unsigned)(u.e * K * 2); }
    __device__ __forceinline__ const char* b_base(const Unit& u) const { return Bt + (size_t)u.pn * BM * (2 * K) * 2 + (size_t)u.e * K * 2; }
};
template <bool GATHER> struct MoeSched {
    TileOrder o; const char* Bt; int K; int rows_per_e; const int* tile_e; const int* row_tok; int es;
    __device__ __forceinline__ bool next(int i, Unit& u) const { if (!o.next(i, u.pm, u.pn)) return false; u.e = __builtin_amdgcn_readfirstlane(tile_e[u.pm]); return true; }
    __device__ __forceinline__ unsigned a_row(const Unit& u, int r) const { if (GATHER) return (unsigned)row_tok[u.pm * BM + r]; else return (unsigned)(u.pm * BM + r); }
    __device__ __forceinline__ unsigned a_koff(const Unit&) const { return 0u; }
    __device__ __forceinline__ const char* b_base(const Unit& u) const { return Bt + ((size_t)u.e * rows_per_e + (size_t)u.pn * BM) * K * es; }
};

template <class Epi, class Sched>
__device__ __forceinline__ void gemm_phase(LAS unsigned char* lds, const char* gA, int K_, int lda, int ldb, const Sched& S, const Epi& E) {
    int K = K_; asm volatile("" : "+s"(K));
    int tid = threadIdx.x; asm volatile("" : "+v"(tid));     const int wid = __builtin_amdgcn_readfirstlane(tid >> 6), lane = tid & 63, wr = wid >> 2, wc = wid & 3, fr = lane & 15, fq = lane >> 4;
    constexpr int ES = Epi::F8 ? 1 : 2;
    const int nt = K * ES / 128;
    unsigned voffB[2];
#pragma unroll
    for (int i = 0; i < 2; ++i) { int R, C; stage_rc(tid * 16 + i * 8192, R, C); const int Rb = Epi::PERM ? ((R & ~31) + perm32(R & 31)) : R; voffB[i] = (unsigned)(Rb * ldb * ES + C * 2); }
    const unsigned kstep = (unsigned)(BK * 2);
    const size_t hstepB = (size_t)HALF * ldb * ES;
    const unsigned ldab = (unsigned)lda * ES;
    const unsigned ldsw = (unsigned)wid * 1024u;
    const int aoff = lds_byte(wr * 64 + fr, fq * 8), boff = lds_byte(wc * 32 + fr, fq * 8);
#define PG8_SA(b, h) (((b) * 2 + (h)) * HTB)
#define PG8_SB(b, h) ((4 + (b) * 2 + (h)) * HTB)
#define PG8_STAGE_B(bufoff, gbase) do { _Pragma("unroll") for (int _i = 0; _i < 2; ++_i) \
        __builtin_amdgcn_global_load_lds((const unsigned*)((const char*)(gbase) + voffB[_i]), (LAS unsigned*)(lds + (bufoff) + ldsw + _i * 8192), 16, 0, 0); } while (0)
#define PG8_STAGE_A(bufoff, o0, o1, kb) do { \
        const char* gk_ = gA + (kb);      \
        __builtin_amdgcn_global_load_lds((const unsigned*)(gk_ + (o0)), (LAS unsigned*)(lds + (bufoff) + ldsw), 16, 0, 0); \
        __builtin_amdgcn_global_load_lds((const unsigned*)(gk_ + (o1)), (LAS unsigned*)(lds + (bufoff) + ldsw + 8192), 16, 0, 0); } while (0)
#define PG8_LDA(dst, b, h) do { _Pragma("unroll") for (int m = 0; m < 4; ++m) _Pragma("unroll") for (int k = 0; k < 2; ++k) dst[m][k] = *(const LAS bf16x8*)(lds + PG8_SA(b, h) + aoff + m * 2048 + k * 1024); } while (0)
#define PG8_LDB(dst, b, h) do { _Pragma("unroll") for (int n = 0; n < 2; ++n) _Pragma("unroll") for (int k = 0; k < 2; ++k) dst[n][k] = *(const LAS bf16x8*)(lds + PG8_SB(b, h) + boff + n * 2048 + k * 1024); } while (0)
#define PG8_MMA(ai, bj, At, Bt) do { __builtin_amdgcn_s_setprio(1); \
        if constexpr (Epi::F8) { _Pragma("unroll") for (int m = 0; m < 4; ++m) _Pragma("unroll") for (int n = 0; n < 2; ++n) { \
            const i32x8 a8_ = __builtin_shufflevector(__builtin_bit_cast(i32x4, At[m][0]), __builtin_bit_cast(i32x4, At[m][1]), 0, 1, 2, 3, 4, 5, 6, 7); \
            const i32x8 b8_ = __builtin_shufflevector(__builtin_bit_cast(i32x4, Bt[n][0]), __builtin_bit_cast(i32x4, Bt[n][1]), 0, 1, 2, 3, 4, 5, 6, 7); \
            acc[ai][bj][m][n] = __builtin_amdgcn_mfma_scale_f32_16x16x128_f8f6f4(b8_, a8_, acc[ai][bj][m][n], 0, 0, 0, 0x7F7F7F7F, 0, 0x7F7F7F7F); } } \
        else { _Pragma("unroll") for (int m = 0; m < 4; ++m) _Pragma("unroll") for (int n = 0; n < 2; ++n) _Pragma("unroll") for (int k = 0; k < 2; ++k) \
            acc[ai][bj][m][n] = __builtin_amdgcn_mfma_f32_16x16x32_bf16(Bt[n][k], At[m][k], acc[ai][bj][m][n], 0, 0, 0); } \
        __builtin_amdgcn_s_setprio(0); } while (0)
#define PG8_WAIT_V(n) asm volatile("s_waitcnt vmcnt(" #n ")" ::: "memory")
#define PG8_WAIT_L(n) asm volatile("s_waitcnt lgkmcnt(" #n ")" ::: "memory")
#define PG8_BAR __builtin_amdgcn_s_barrier()
#define PG8_SCHED __builtin_amdgcn_sched_barrier(0)
#define PG8_AOFFS(dst, u) do { _Pragma("unroll") for (int _h = 0; _h < 2; ++_h) _Pragma("unroll") for (int _i = 0; _i < 2; ++_i) { int R_, C_; stage_rc(tid * 16 + _i * 8192, R_, C_); \
        dst[_h][_i] = S.a_row(u, _h * HALF + R_) * ldab + (unsigned)C_ * 2u + S.a_koff(u); } } while (0)
    Unit cur, nxt; int ui = 0;
    if (!S.next(0, cur)) return;
    f32x4 acc[2][2][4][2];
#pragma unroll
    for (int a = 0; a < 2; ++a)
#pragma unroll
        for (int b = 0; b < 2; ++b)
#pragma unroll
            for (int m = 0; m < 4; ++m)
#pragma unroll
                for (int n = 0; n < 2; ++n) acc[a][b][m][n] = (f32x4){0.f, 0.f, 0.f, 0.f};
    bf16x8 At[4][2], B0[2][2], B1[2][2];
    unsigned oc[2][2];
    LAS u32x4* nslot = (LAS u32x4*)(lds + LDSCTL_OFF + 2048) + tid;
    PG8_AOFFS(oc, cur);
    const char* cB = S.b_base(cur);
    PG8_STAGE_B(PG8_SB(0, 0), cB); PG8_STAGE_B(PG8_SB(0, 1), cB + hstepB); PG8_STAGE_A(PG8_SA(0, 0), oc[0][0], oc[0][1], 0u); PG8_STAGE_A(PG8_SA(0, 1), oc[1][0], oc[1][1], 0u);
    if (wr == 1) PG8_BAR;
    PG8_WAIT_V(2); PG8_BAR;
    PG8_STAGE_B(PG8_SB(1, 0), cB + kstep); PG8_STAGE_A(PG8_SA(1, 0), oc[0][0], oc[0][1], kstep); PG8_STAGE_B(PG8_SB(1, 1), cB + hstepB + kstep);
    PG8_WAIT_V(6); PG8_BAR;
    for (;;) {
        const bool has_next = S.next(ui + 1, nxt);
        const char* nB = has_next ? S.b_base(nxt) : cB;
        if (has_next) { unsigned on[2][2]; PG8_AOFFS(on, nxt); *nslot = (u32x4){on[0][0], on[0][1], on[1][0], on[1][1]}; }
        for (int t = 0; t < nt; t += 2) {
            const bool last = (t == nt - 2);
            const unsigned k1 = (unsigned)(t + 1) * kstep;
            const unsigned k2 = last ? 0u : (unsigned)(t + 2) * kstep, k3 = k2 + kstep;
            const char* b2 = last ? nB : cB + (size_t)(t + 2) * kstep; const char* b3 = b2 + kstep;
            PG8_LDB(B0, 0, 0); PG8_LDB(B1, 0, 1); PG8_SCHED; PG8_LDA(At, 0, 0); PG8_STAGE_A(PG8_SA(1, 1), oc[1][0], oc[1][1], k1);
            PG8_WAIT_V(8); PG8_WAIT_L(0); PG8_BAR; PG8_MMA(0, 0, At, B0); PG8_MMA(0, 1, At, B1); PG8_BAR; PG8_SCHED;
            if (last && has_next) { const u32x4 o_ = *nslot; oc[0][0] = o_.x; oc[0][1] = o_.y; oc[1][0] = o_.z; oc[1][1] = o_.w; }
            PG8_LDA(At, 0, 1); PG8_STAGE_B(PG8_SB(0, 0), b2); PG8_STAGE_B(PG8_SB(0, 1), b2 + hstepB); PG8_STAGE_A(PG8_SA(0, 0), oc[0][0], oc[0][1], k2);
            PG8_WAIT_V(8); PG8_WAIT_L(0); PG8_BAR; PG8_MMA(1, 0, At, B0); PG8_MMA(1, 1, At, B1); PG8_BAR; PG8_SCHED;
            PG8_LDB(B0, 1, 0); PG8_LDB(B1, 1, 1); PG8_SCHED; PG8_LDA(At, 1, 0); PG8_STAGE_A(PG8_SA(0, 1), oc[1][0], oc[1][1], k2);
            PG8_WAIT_V(8); PG8_WAIT_L(0); PG8_BAR; PG8_MMA(0, 0, At, B0); PG8_MMA(0, 1, At, B1); PG8_BAR; PG8_SCHED;
            PG8_LDA(At, 1, 1); PG8_STAGE_B(PG8_SB(1, 0), b3); PG8_STAGE_B(PG8_SB(1, 1), b3 + hstepB); PG8_STAGE_A(PG8_SA(1, 0), oc[0][0], oc[0][1], k3);
            PG8_WAIT_V(8); PG8_WAIT_L(0); PG8_BAR; PG8_MMA(1, 0, At, B0); PG8_MMA(1, 1, At, B1); PG8_BAR; PG8_SCHED;
        }
        if (wr == 0) PG8_BAR;
        bool carry = false;
        if constexpr (Epi::MIDK) { if (cur.e == 0) { E.mid(acc, cur, wr, wc, fr, fq); carry = true; } else E(acc, cur, wr, wc, fr, fq); } else E(acc, cur, wr, wc, fr, fq);
        if (!has_next) break;
        if (!carry)
#pragma unroll
        for (int a = 0; a < 2; ++a)
#pragma unroll
            for (int b = 0; b < 2; ++b)
#pragma unroll
                for (int m = 0; m < 4; ++m)
#pragma unroll
                    for (int n = 0; n < 2; ++n) acc[a][b][m][n] = (f32x4){0.f, 0.f, 0.f, 0.f};
        cur = nxt; cB = nB; ++ui;
        if (wr == 1) PG8_BAR;
    }
    PG8_WAIT_V(0);
    PG8_BAR;
#undef PG8_SA
#undef PG8_SB
#undef PG8_STAGE_A
#undef PG8_STAGE_B
#undef PG8_LDA
#undef PG8_LDB
#undef PG8_MMA
#undef PG8_WAIT_V
#undef PG8_WAIT_L
#undef PG8_BAR
#undef PG8_SCHED
#undef PG8_AOFFS
}

template <bool F8_> struct EpiProj {
    static constexpr bool PERM = true, MIDK = false, F8 = F8_;
    bf16_t* O; float* kmp;
    __device__ __forceinline__ void operator()(const f32x4 (&acc)[2][2][4][2], const Unit& u, int wr, int wc, int fr, int fq) const {
        const int row0 = u.pm * BM + wr * 64 + fr; const int col0 = u.pn * BM + wc * 32 + 8 * fq;
#pragma unroll
        for (int ai = 0; ai < 2; ++ai)
#pragma unroll
            for (int m = 0; m < 4; ++m) { bf16_t* rowp = O + (size_t)(row0 + ai * HALF + m * 16) * NPROJ + col0;
#pragma unroll
                for (int bj = 0; bj < 2; ++bj) { const float sc = F8 ? (1.0f / 32.0f) : 1.0f; const f32x4 v0 = acc[ai][bj][m][0] * sc, v1 = acc[ai][bj][m][1] * sc;
                    u32x4 w; w.x = cvt_pk_bf16(v0[0], v0[1]); w.y = cvt_pk_bf16(v0[2], v0[3]); w.z = cvt_pk_bf16(v1[0], v1[1]); w.w = cvt_pk_bf16(v1[2], v1[3]);
                    *(u32x4*)(rowp + bj * HALF) = w; } }
        if (u.pn >= C_KB / BM && u.pn < C_VB / BM) {
#pragma unroll
            for (int bj = 0; bj < 2; ++bj)
#pragma unroll
                for (int n = 0; n < 2; ++n) { f32x4 s = (f32x4){0.f, 0.f, 0.f, 0.f};
#pragma unroll
                    for (int ai = 0; ai < 2; ++ai)
#pragma unroll
                        for (int m = 0; m < 4; ++m) s += acc[ai][bj][m][n];
#pragma unroll
                    for (int o = 1; o < 16; o <<= 1) { s[0] += __shfl_xor(s[0], o); s[1] += __shfl_xor(s[1], o); s[2] += __shfl_xor(s[2], o); s[3] += __shfl_xor(s[3], o); }
                    if (fr == 0) *(f32x4*)(kmp + ((size_t)wr * 64 + u.pm) * 1024 + (u.pn - C_KB / BM) * BM + bj * HALF + wc * 32 + 8 * fq + 4 * n) = s * (F8 ? (1.0f / 32.0f) : 1.0f); }
        }
    }
};
struct EpiMerge {
    static constexpr bool PERM = true, MIDK = true, F8 = false;
    const bf16_t* proj; bf16_t* Y;
    __device__ __forceinline__ void mid(f32x4 (&acc)[2][2][4][2], const Unit& u, int wr, int wc, int fr, int fq) const {
        const int row0 = u.pm * BM + wr * 64 + fr; const int col0 = u.pn * BM + wc * 32 + 8 * fq;
#pragma unroll
        for (int ai = 0; ai < 2; ++ai)
#pragma unroll
            for (int m = 0; m < 4; ++m) { const bf16_t* rowp = proj + (size_t)(row0 + ai * HALF + m * 16) * NPROJ + col0;
#pragma unroll
                for (int bj = 0; bj < 2; ++bj) { const u32x4 ga = *(const u32x4*)(rowp + C_GA + bj * HALF), gb = *(const u32x4*)(rowp + C_GB + bj * HALF);
#pragma unroll
                    for (int j = 0; j < 4; ++j) { const float a0 = bflo(ga[j]), a1 = bfhi(ga[j]), b0 = bflo(gb[j]), b1 = bfhi(gb[j]);
                        const float r0 = (1.0f + __builtin_amdgcn_exp2f(-1.4426950408889634f * b0)) * __builtin_amdgcn_rcpf(1.0f + __builtin_amdgcn_exp2f(-1.4426950408889634f * a0));
                        const float r1 = (1.0f + __builtin_amdgcn_exp2f(-1.4426950408889634f * b1)) * __builtin_amdgcn_rcpf(1.0f + __builtin_amdgcn_exp2f(-1.4426950408889634f * a1));
                        acc[ai][bj][m][j >> 1][(j & 1) * 2] *= r0; acc[ai][bj][m][j >> 1][(j & 1) * 2 + 1] *= r1; } }
                asm volatile("" : "+v"(acc[ai][0][m][0]), "+v"(acc[ai][0][m][1]), "+v"(acc[ai][1][m][0]), "+v"(acc[ai][1][m][1]));
                asm volatile("" ::: "memory"); }
    }
    __device__ __forceinline__ void operator()(const f32x4 (&acc)[2][2][4][2], const Unit& u, int wr, int wc, int fr, int fq) const {
        const int row0 = u.pm * BM + wr * 64 + fr; const int col0 = u.pn * BM + wc * 32 + 8 * fq;
#pragma unroll
        for (int ai = 0; ai < 2; ++ai)
#pragma unroll
            for (int m = 0; m < 4; ++m) { const size_t r = (size_t)(row0 + ai * HALF + m * 16);
#pragma unroll
                for (int bj = 0; bj < 2; ++bj) { const u32x4 gb = *(const u32x4*)(proj + r * NPROJ + C_GB + col0 + bj * HALF);
                    const f32x4 v0 = acc[ai][bj][m][0], v1 = acc[ai][bj][m][1];
                    u32x4 w; w.x = cvt_pk_bf16(v0[0] * fsigmoid(bflo(gb[0])), v0[1] * fsigmoid(bfhi(gb[0]))); w.y = cvt_pk_bf16(v0[2] * fsigmoid(bflo(gb[1])), v0[3] * fsigmoid(bfhi(gb[1])));
                    w.z = cvt_pk_bf16(v1[0] * fsigmoid(bflo(gb[2])), v1[1] * fsigmoid(bfhi(gb[2]))); w.w = cvt_pk_bf16(v1[2] * fsigmoid(bflo(gb[3])), v1[3] * fsigmoid(bfhi(gb[3])));
                    *(u32x4*)(Y + r * D + col0 + bj * HALF) = w; }
                asm volatile("" ::: "memory"); }
    }
};
struct EpiResF32 {
    static constexpr bool PERM = false, MIDK = false, F8 = false;
    const float* base; float* out;
    __device__ __forceinline__ void operator()(const f32x4 (&acc)[2][2][4][2], const Unit& u, int wr, int wc, int fr, int fq) const {
        const int row0 = u.pm * BM + wr * 64 + fr, col0 = u.pn * BM + wc * 32 + 4 * fq;
#pragma unroll
        for (int ai = 0; ai < 2; ++ai)
#pragma unroll
            for (int m = 0; m < 4; ++m) { const size_t off = (size_t)(row0 + ai * HALF + m * 16) * D + col0;
#pragma unroll
                for (int bj = 0; bj < 2; ++bj)
#pragma unroll
                    for (int n = 0; n < 2; ++n) *(f32x4*)(out + off + bj * HALF + n * 16) = *(const f32x4*)(base + off + bj * HALF + n * 16) + acc[ai][bj][m][n];
                asm volatile("" ::: "memory"); }
    }
};
struct EpiGlu {
    static constexpr bool PERM = true, MIDK = false, F8 = true;
    unsigned char* H; const float* rstd_s; const float* bg; const float* bu;
    __device__ __forceinline__ void operator()(const f32x4 (&acc)[2][2][4][2], const Unit& u, int wr, int wc, int fr, int fq) const {
        const int row0 = u.pm * BM + wr * 64 + fr; const int colo = u.pn * HALF + wc * 32 + 8 * fq;
        f32x4 g4[2], u4[2];
#pragma unroll
        for (int n = 0; n < 2; ++n) { g4[n] = *(const f32x4*)(bg + (size_t)u.e * FF + colo + 4 * n); u4[n] = *(const f32x4*)(bu + (size_t)u.e * FF + colo + 4 * n); }
#pragma unroll
        for (int ai = 0; ai < 2; ++ai)
#pragma unroll
            for (int m = 0; m < 4; ++m) { const int r = row0 + ai * HALF + m * 16; const float rs = rstd_s[r] * (1.0f / 32.0f);
                float o[8];
#pragma unroll
                for (int n = 0; n < 2; ++n)
#pragma unroll
                    for (int j = 0; j < 4; ++j) { float g = acc[ai][0][m][n][j] * rs + g4[n][j], up = acc[ai][1][m][n][j] * rs + u4[n][j];
                        g = fminf(g, 7.0f); up = fminf(fmaxf(up, -7.0f), 7.0f);
                        const float glu = g * fsigmoid(1.702f * g); o[n * 4 + j] = (up + 1.0f) * glu; }
                u32x2 w; w.x = pk4_fp8(o[0], o[1], o[2], o[3]); w.y = pk4_fp8(o[4], o[5], o[6], o[7]);
                *(u32x2*)(H + (size_t)r * FF + colo) = w; asm volatile("" ::: "memory"); }
    }
};
template <int ACT, bool HASBIAS, bool F8_ = false> struct EpiBf16 {
    static constexpr bool PERM = true, MIDK = false, F8 = F8_;
    bf16_t* O; int ldc; const float* bias; int bias_stride; float scale;
    __device__ __forceinline__ void operator()(const f32x4 (&acc)[2][2][4][2], const Unit& u, int wr, int wc, int fr, int fq) const {
        const int row0 = u.pm * BM + wr * 64 + fr; const int col0 = u.pn * BM + wc * 32 + 8 * fq;
        f32x4 bv[2][2];
#pragma unroll
        for (int bj = 0; bj < 2; ++bj)
#pragma unroll
            for (int n = 0; n < 2; ++n) bv[bj][n] = HASBIAS ? *(const f32x4*)(bias + (size_t)u.e * bias_stride + col0 + bj * HALF + 4 * n) : (f32x4){0.f, 0.f, 0.f, 0.f};
#pragma unroll
        for (int ai = 0; ai < 2; ++ai)
#pragma unroll
            for (int m = 0; m < 4; ++m) { bf16_t* rowp = O + (size_t)(row0 + ai * HALF + m * 16) * ldc + col0;
#pragma unroll
                for (int bj = 0; bj < 2; ++bj) { f32x4 v0 = acc[ai][bj][m][0] * scale + bv[bj][0], v1 = acc[ai][bj][m][1] * scale + bv[bj][1];
                    if (ACT == 1) {
#pragma unroll
                        for (int j = 0; j < 4; ++j) { v0[j] = fsigmoid(v0[j]); v1[j] = fsigmoid(v1[j]); } }
                    u32x4 w; w.x = cvt_pk_bf16(v0[0], v0[1]); w.y = cvt_pk_bf16(v0[2], v0[3]); w.z = cvt_pk_bf16(v1[0], v1[1]); w.w = cvt_pk_bf16(v1[2], v1[3]);
                    *(u32x4*)(rowp + bj * HALF) = w; }
                asm volatile("" ::: "memory"); }
    }
};
}
__device__ __forceinline__ void transpose_item(const float* __restrict__ W, int ldw, int k0, int n_src0, bf16_t* __restrict__ WT, int ldo, int n_dst0, int k_off, LAS float* scr, int lane) {
    { float t_[32]; const float* wp_ = W + (size_t)(k0 + (lane >> 5)) * ldw + n_src0 + (lane & 31);
#pragma unroll
    for (int i = 0; i < 32; ++i) t_[i] = wp_[(size_t)(2 * i) * ldw];
#pragma unroll
    for (int i = 0; i < 32; ++i) scr[(2 * i + (lane >> 5)) * 33 + (lane & 31)] = t_[i]; }
    LDS_WAIT(); asm volatile("" ::: "memory");
    const int c = lane & 7;
#pragma unroll
    for (int j = 0; j < 4; ++j) { const int n = (lane >> 3) + 8 * j; const LAS float* s = scr + (8 * c) * 33 + n;
        u32x4 o; o.x = cvt_pk_bf16(s[0 * 33], s[1 * 33]); o.y = cvt_pk_bf16(s[2 * 33], s[3 * 33]); o.z = cvt_pk_bf16(s[4 * 33], s[5 * 33]); o.w = cvt_pk_bf16(s[6 * 33], s[7 * 33]);
        *(u32x4*)(WT + (size_t)(n_dst0 + n) * ldo + k_off + k0 + 8 * c) = o; }
    LDS_WAIT(); asm volatile("" ::: "memory");
}
__device__ __forceinline__ void transpose_item_f8(const float* __restrict__ W, int ldw, int k0, int n_src0, unsigned char* __restrict__ WT, int ldo, int n_dst0, float sc, LAS float* scr, int lane) {
    { float t_[32]; const float* wp_ = W + (size_t)(k0 + (lane >> 5)) * ldw + n_src0 + (lane & 31);
#pragma unroll
    for (int i = 0; i < 32; ++i) t_[i] = wp_[(size_t)(2 * i) * ldw];
#pragma unroll
    for (int i = 0; i < 32; ++i) scr[(2 * i + (lane >> 5)) * 33 + (lane & 31)] = t_[i]; }
    LDS_WAIT(); asm volatile("" ::: "memory");
    const int c = lane & 7;
#pragma unroll
    for (int j = 0; j < 4; ++j) { const int n = (lane >> 3) + 8 * j; const LAS float* s = scr + (8 * c) * 33 + n;
        u32x2 o; o.x = pk4_fp8(s[0 * 33] * sc, s[1 * 33] * sc, s[2 * 33] * sc, s[3 * 33] * sc); o.y = pk4_fp8(s[4 * 33] * sc, s[5 * 33] * sc, s[6 * 33] * sc, s[7 * 33] * sc);
        *(u32x2*)(WT + (size_t)(n_dst0 + n) * ldo + k0 + 8 * c) = o; }
    LDS_WAIT(); asm volatile("" ::: "memory");
}
__device__ __forceinline__ void transpose_mat_item(const float* W, int ldw, int N, int n_src_base, bf16_t* WT, int ldo, int n_dst_base, int k_off, LAS float* scr, int item, int lane) {
    const int nblk = N / 32, kb = item / nblk, nb = item % nblk;
    transpose_item(W, ldw, 64 * kb, n_src_base + 32 * nb, WT, ldo, n_dst_base + 32 * nb, k_off, scr, lane);
}

struct P {
    const float* in[25]; float* out; unsigned char* ws;
};

__device__ __forceinline__ void p0_prologue(const P& a, LAS unsigned char* lds, int vcu, int G, int wave, int lane) {
    LAS float* scr = (LAS float*)(lds + wave * 16384);
    const int gw = vcu * NWAVES + wave, NGW = G * NWAVES;
    unsigned char* ws = a.ws;
    bf16_t* WinT = (bf16_t*)(ws + WS_WIN); bf16_t* WupT = (bf16_t*)(ws + WS_WUP); bf16_t* WoT = (bf16_t*)(ws + WS_WO); bf16_t* WpgT = (bf16_t*)(ws + WS_WPG); bf16_t* WppT = (bf16_t*)(ws + WS_WPP);
    constexpr int I_A = 16 * 96, I_B = 16 * 160, I_S = 16 * 32, I_P = 4 * 32;
    constexpr int NITEMS = I_A + I_B + 4 * I_S + I_P;
#ifndef P0_PARTS
#define P0_PARTS 63
#endif
    if (P0_PARTS & 1)
    for (int it = gw; it < NITEMS; it += NGW) {
        int r = it;
        if (r < I_A) { transpose_mat_item(a.in[4], D_IN, 3072, 0, WinT, D, 0, 0, scr, r, lane); continue; } r -= I_A;
        if (r < I_B) { transpose_mat_item(a.in[4], D_IN, 5120, 3088, WinT, D, 3072, 0, scr, r, lane); continue; } r -= I_B;
        if (r < I_S) { transpose_mat_item(a.in[8], D, D, 0, WupT, 2048, 0, 0, scr, r, lane); continue; } r -= I_S;
        if (r < I_S) { transpose_mat_item(a.in[9], D, D, 0, WupT, 2048, 0, 1024, scr, r, lane); continue; } r -= I_S;
        if (r < I_S) { transpose_mat_item(a.in[10], D, D, 0, WoT, D, 0, 0, scr, r, lane); continue; } r -= I_S;
        if (r < I_S) { transpose_mat_item(a.in[21], D, D, 0, WpgT, D, 0, 0, scr, r, lane); continue; } r -= I_S;
        transpose_mat_item(a.in[22], D, D, 0, WppT, 256, 0, 0, scr, r, lane);
    }
    if (P0_PARTS & 2) {
        const float* x = a.in[0]; const float* g = a.in[3]; bf16_t* H = (bf16_t*)(ws + WS_H);
        f32x4 gv[4];
#pragma unroll
        for (int j = 0; j < 4; ++j) gv[j] = *((const f32x4*)g + lane + 64 * j);
        for (int m = gw; m < T; m += NGW) {
            const f32x4* xr = (const f32x4*)(x + (size_t)m * D) + lane; f32x4 v[4]; float s = 0.f;
#pragma unroll
            for (int j = 0; j < 4; ++j) { v[j] = xr[64 * j]; s += (v[j].x * v[j].x + v[j].y * v[j].y) + (v[j].z * v[j].z + v[j].w * v[j].w); }
            const float rstd = 1.0f / sqrtf(wave_sum(s) * (1.0f / D) + EPS);
            u32x2* o8 = (u32x2*)(H + (size_t)m * D) + lane;
#pragma unroll
            for (int j = 0; j < 4; ++j) { const f32x4 y = v[j] * rstd * gv[j]; u32x2 w; w.x = cvt_pk_bf16(y.x, y.y); w.y = cvt_pk_bf16(y.z, y.w); o8[64 * j] = w; }
        }
    }
    if (P0_PARTS & 4) {
        const f32x4* p4 = (const f32x4*)a.in[1]; u32x2* pb = (u32x2*)(ws + WS_PB);
        const size_t n4 = (size_t)T * 256 / 4;
        for (size_t i = (size_t)gw * 64 + lane; i < n4; i += (size_t)NGW * 64) { const f32x4 v = p4[i]; u32x2 w; w.x = cvt_pk_bf16(v.x, v.y); w.y = cvt_pk_bf16(v.z, v.w); pb[i] = w; }
    }
    if (P0_PARTS & 8) {
        const int gt = (vcu * NWAVES + wave) * 64 + lane;
        if ((P0_PARTS & 16) && gt < 16 * 1024) { const int n = gt >> 10, k = gt & 1023; ((bf16_t*)(ws + WS_WALT))[n * 1024 + k] = (bf16_t)(cvt_pk_bf16(a.in[4][(size_t)k * D_IN + SRC_ALOW + n], 0.f) & 0xffffu); }
        if ((P0_PARTS & 32) && gt < 4096) { const int s = gt >> 6, l = gt & 63, e = l & 31, hh = l >> 5; const float* wr = a.in[12];
            float v[8], lo[8];
#pragma unroll
            for (int j = 0; j < 8; ++j) { v[j] = wr[(size_t)(16 * s + 8 * hh + j) * NE + e]; }
            u32x4 whi; whi.x = cvt_pk_bf16(v[0], v[1]); whi.y = cvt_pk_bf16(v[2], v[3]); whi.z = cvt_pk_bf16(v[4], v[5]); whi.w = cvt_pk_bf16(v[6], v[7]);
#pragma unroll
            for (int j = 0; j < 4; ++j) { lo[2 * j] = v[2 * j] - bflo(whi[j]); lo[2 * j + 1] = v[2 * j + 1] - bfhi(whi[j]); }
            u32x4 wlo; wlo.x = cvt_pk_bf16(lo[0], lo[1]); wlo.y = cvt_pk_bf16(lo[2], lo[3]); wlo.z = cvt_pk_bf16(lo[4], lo[5]); wlo.w = cvt_pk_bf16(lo[6], lo[7]);
            u32x4* f = (u32x4*)(ws + WS_WRF); f[gt] = whi; f[4096 + gt] = wlo; }
    }
}

struct CvtItem { const float* src; unsigned char* dst; int ldo; };
__device__ __forceinline__ CvtItem cvt_item(const P& a, int it, int lane) {
    constexpr int IPM = 16 * 32;
    const int e = it / (3 * IPM), r0 = it % (3 * IPM), which = r0 / IPM, r = r0 % IPM, kb = r / 32, nb = r % 32, n0 = 32 * nb;
    CvtItem c;
    if (which < 2) { c.src = a.in[which == 0 ? 14 : 16] + (size_t)e * D * FF + (size_t)(64 * kb + (lane >> 5)) * FF + n0 + (lane & 31);
        c.dst = a.ws + WS_W1T + ((size_t)e * 2048 + (n0 >> 7) * 256 + (n0 & 127) + which * 128) * D + 64 * kb; c.ldo = D; }
    else { c.src = a.in[18] + (size_t)e * FF * D + (size_t)(64 * kb + (lane >> 5)) * D + n0 + (lane & 31);
        c.dst = a.ws + WS_W2T + ((size_t)e * D + n0) * FF + 64 * kb; c.ldo = FF; }
    return c;
}
__device__ __forceinline__ void expert_convert(const P& a, LAS unsigned char* lds, int vcu, int G, int wave, int lane) {
    LAS float* scr = (LAS float*)(lds + wave * 16384);
    const int gw = vcu * NWAVES + wave, NGW = G * NWAVES;
    constexpr int NIT = NE * 3 * 16 * 32;
    int it = gw; if (it >= NIT) return;
    float t[32];
    CvtItem cur = cvt_item(a, it, lane);
#pragma unroll
    for (int i = 0; i < 32; ++i) t[i] = cur.src[(size_t)(2 * i) * 1024];
    for (;;) {
#pragma unroll
        for (int i = 0; i < 32; ++i) scr[(2 * i + (lane >> 5)) * 33 + (lane & 31)] = t[i];
        const int nx = it + NGW; const bool more = nx < NIT;
        const CvtItem nxt = cvt_item(a, more ? nx : it, lane);
        if (more) {
#pragma unroll
            for (int i = 0; i < 32; ++i) t[i] = nxt.src[(size_t)(2 * i) * 1024];
        }
        LDS_WAIT(); asm volatile("" ::: "memory");
        const int c = lane & 7;
#pragma unroll
        for (int j = 0; j < 4; ++j) { const int n = (lane >> 3) + 8 * j; const LAS float* s = scr + (8 * c) * 33 + n;
            u32x2 o; o.x = pk4_fp8(s[0 * 33] * 32.0f, s[1 * 33] * 32.0f, s[2 * 33] * 32.0f, s[3 * 33] * 32.0f); o.y = pk4_fp8(s[4 * 33] * 32.0f, s[5 * 33] * 32.0f, s[6 * 33] * 32.0f, s[7 * 33] * 32.0f);
            *(u32x2*)(cur.dst + (size_t)n * cur.ldo + 8 * c) = o; }
        LDS_WAIT(); asm volatile("" ::: "memory");
        if (!more) break;
        it = nx; cur = nxt;
    }
}

__device__ __forceinline__ float fexp_(float x) { return __builtin_amdgcn_exp2f(x * 1.4426950408889634f); }
__device__ __forceinline__ float logsigmoidf_(float x) { const float e = fexp_(-fabsf(x)); return fminf(x, 0.0f) - 0.6931471805599453f * __builtin_amdgcn_logf(1.0f + e); }
__device__ __forceinline__ void gla_prep_unit(const P& a, LAS unsigned char* lds, int unit) {
    int tid = threadIdx.x; asm volatile("" : "+v"(tid));     const int wave = __builtin_amdgcn_readfirstlane(tid >> 6), lane = tid & 63;
    const int b = unit >> 5, chunk = unit & 31, tok0 = b * SEQ + chunk * 64;
    const bf16_t* H = (const bf16_t*)(a.ws + WS_H); const bf16_t* WalT = (const bf16_t*)(a.ws + WS_WALT); const bf16_t* proj = (const bf16_t*)(a.ws + WS_PROJ);
    LAS float* part = (LAS float*)lds;
    LAS float* alow = (LAS float*)(lds + 8192);
    LAS float* seg = (LAS float*)(lds + 12288);
    constexpr int GP_KDT = 16384, GP_VT = 34816;
    {
        const int rg = wave & 3, kh = wave >> 2, r = lane & 15, q = lane >> 4;
        f32x4 acc = (f32x4){0.f, 0.f, 0.f, 0.f};
        const bf16_t* ap = H + (size_t)(tok0 + 16 * rg + r) * D + 512 * kh + 8 * q; const bf16_t* bp = WalT + (size_t)r * D + 512 * kh + 8 * q;
#pragma unroll 4
        for (int s = 0; s < 16; ++s) { const bf16x8 av = *(const bf16x8*)(ap + 32 * s), bv = *(const bf16x8*)(bp + 32 * s); acc = __builtin_amdgcn_mfma_f32_16x16x32_bf16(bv, av, acc, 0, 0, 0); }
        *(LAS f32x4*)(part + (kh * 64 + 16 * rg + r) * 16 + 4 * q) = acc;
    }
    __syncthreads();
    if (tid < 256) { *(LAS f32x4*)(alow + tid * 4) = *(LAS f32x4*)(part + tid * 4) + *(LAS f32x4*)(part + 1024 + tid * 4); }
    __syncthreads();
    const int dp = tid & 63, tq = wave;
    const float* w_a2 = a.in[5]; const float* b_a2 = a.in[6];
    for (int h = 0; h < 4; ++h) {
        const int dcol = h * 128 + 2 * dp;
        f32x2 w2[16];
#pragma unroll
        for (int r = 0; r < 16; ++r) w2[r] = *(const f32x2*)(w_a2 + r * 512 + dcol);
        const f32x2 b2 = *(const f32x2*)(b_a2 + dcol);
        unsigned qv[8], kv[8];
#pragma unroll
        for (int i = 0; i < 8; ++i) { const bf16_t* rp = proj + (size_t)(tok0 + 8 * tq + i) * NPROJ + dcol; qv[i] = *(const unsigned*)(rp + C_QA); kv[i] = *(const unsigned*)(rp + C_KA); }
        float G0[8], G1[8]; float r0 = 0.f, r1 = 0.f;
#pragma unroll
        for (int i = 0; i < 8; ++i) { const LAS f32x4* al4 = (const LAS f32x4*)(alow + (8 * tq + i) * 16); float x0 = b2.x, x1 = b2.y;
#pragma unroll
            for (int r4 = 0; r4 < 4; ++r4) { const f32x4 al = al4[r4];
#pragma unroll
                for (int j = 0; j < 4; ++j) { x0 += al[j] * w2[4 * r4 + j].x; x1 += al[j] * w2[4 * r4 + j].y; } }
            r0 += logsigmoidf_(x0) * (1.0f / 16.0f); r1 += logsigmoidf_(x1) * (1.0f / 16.0f); G0[i] = r0; G1[i] = r1; }
        *(LAS f32x2*)(seg + tq * 128 + 2 * dp) = (f32x2){r0, r1};
        __syncthreads();
        float off0 = 0.f, off1 = 0.f, tot0 = 0.f, tot1 = 0.f;
#pragma unroll
        for (int q = 0; q < 8; ++q) { const f32x2 s = *(LAS f32x2*)(seg + q * 128 + 2 * dp); tot0 += s.x; tot1 += s.y; if (q < tq) { off0 += s.x; off1 += s.y; } }
        const size_t tile = (size_t)((b * 4 + h) * 32 + chunk);
        bf16_t* Qg = (bf16_t*)(a.ws + WS_QG) + tile * 8192; bf16_t* Kg = (bf16_t*)(a.ws + WS_KG) + tile * 8192;
        float kd0[8], kd1[8];
#pragma unroll
        for (int i = 0; i < 8; ++i) { const float g0 = G0[i] + off0, g1 = G1[i] + off1; const float q0 = bflo(qv[i]), q1 = bfhi(qv[i]), k0 = bflo(kv[i]), k1 = bfhi(kv[i]);
            const float e0 = fexp_(g0), e1 = fexp_(g1);
            *(unsigned*)(Qg + (8 * tq + i) * 128 + 2 * dp) = cvt_pk_bf16(q0 * e0 * 0.08838834764831845f, q1 * e1 * 0.08838834764831845f);
            *(unsigned*)(Kg + (8 * tq + i) * 128 + 2 * dp) = cvt_pk_bf16(k0 * __builtin_amdgcn_rcpf(e0), k1 * __builtin_amdgcn_rcpf(e1));
            kd0[i] = k0 * fexp_(tot0 - g0); kd1[i] = k1 * fexp_(tot1 - g1); }
        u32x4 w0, w1; w0.x = cvt_pk_bf16(kd0[0], kd0[1]); w0.y = cvt_pk_bf16(kd0[2], kd0[3]); w0.z = cvt_pk_bf16(kd0[4], kd0[5]); w0.w = cvt_pk_bf16(kd0[6], kd0[7]);
        w1.x = cvt_pk_bf16(kd1[0], kd1[1]); w1.y = cvt_pk_bf16(kd1[2], kd1[3]); w1.z = cvt_pk_bf16(kd1[4], kd1[5]); w1.w = cvt_pk_bf16(kd1[6], kd1[7]);
        *(LAS u32x4*)(lds + GP_KDT + (2 * dp) * 144 + 16 * tq) = w0; *(LAS u32x4*)(lds + GP_KDT + (2 * dp + 1) * 144 + 16 * tq) = w1;
        if (tq == 0) *(f32x2*)((float*)(a.ws + WS_DEC) + tile * 128 + 2 * dp) = (f32x2){fexp_(tot0), fexp_(tot1)};
        {
            const int ep = tid & 127, sq4 = tid >> 7; unsigned sv[16];
            const bf16_t* v_ = proj + (size_t)(tok0 + 16 * sq4) * NPROJ + C_VA + h * 256 + 2 * ep;
#pragma unroll
            for (int i = 0; i < 16; ++i) sv[i] = *(const unsigned*)(v_ + (size_t)i * NPROJ);
            u32x4 lo0, lo1, hi0, hi1;
#pragma unroll
            for (int j = 0; j < 4; ++j) { lo0[j] = (sv[2 * j] & 0xffffu) | (sv[2 * j + 1] << 16); lo1[j] = (sv[8 + 2 * j] & 0xffffu) | (sv[8 + 2 * j + 1] << 16);
                hi0[j] = (sv[2 * j] >> 16) | (sv[2 * j + 1] & 0xffff0000u); hi1[j] = (sv[8 + 2 * j] >> 16) | (sv[8 + 2 * j + 1] & 0xffff0000u); }
            LAS unsigned char* v0 = lds + GP_VT + (2 * ep) * 144 + sq4 * 32;
            *(LAS u32x4*)(v0) = lo0; *(LAS u32x4*)(v0 + 16) = lo1; *(LAS u32x4*)(v0 + 144) = hi0; *(LAS u32x4*)(v0 + 144 + 16) = hi1;
        }
        __syncthreads();
        {
            const int c32 = lane & 31, hi = lane >> 5;
            bf16x8 vt[4];
#pragma unroll
            for (int ks = 0; ks < 4; ++ks) vt[ks] = *(const LAS bf16x8*)(lds + GP_VT + (32 * wave + c32) * 144 + (16 * ks + 8 * hi) * 2);
            u32x2* sl = (u32x2*)(a.ws + WS_SLOC) + tile * 8192;
#pragma unroll
            for (int tl = 0; tl < 4; ++tl) { f32x16 acc;
#pragma unroll
                for (int r = 0; r < 16; ++r) acc[r] = 0.f;
#pragma unroll
                for (int ks = 0; ks < 4; ++ks) { const bf16x8 av = *(const LAS bf16x8*)(lds + GP_KDT + (32 * tl + c32) * 144 + (16 * ks + 8 * hi) * 2); acc = __builtin_amdgcn_mfma_f32_32x32x16_bf16(av, vt[ks], acc, 0, 0, 0); }
#pragma unroll
                for (int g = 0; g < 4; ++g) { u32x2 w; w.x = cvt_pk_bf16(acc[4 * g], acc[4 * g + 1]); w.y = cvt_pk_bf16(acc[4 * g + 2], acc[4 * g + 3]); sl[((tl * 4 + g) * 2 + hi) * 256 + 32 * wave + c32] = w; } }
        }
        __syncthreads();
    }
}

__device__ __forceinline__ void gla_combine_unit(const P& a, int unit) {
    const int tid = threadIdx.x, bh = unit >> 4, i8 = (unit & 15) * 512 + tid;
    const int d0 = 32 * (i8 >> 11) + 8 * ((i8 >> 9) & 3) + 4 * ((i8 >> 8) & 1);
    u32x2* sl = (u32x2*)(a.ws + WS_SLOC) + (size_t)bh * 32 * 8192 + i8; const f32x4* dc = (const f32x4*)((const float*)(a.ws + WS_DEC) + (size_t)bh * 32 * 128 + d0);
    f32x4 s = (f32x4){0.f, 0.f, 0.f, 0.f};
    for (int cb = 0; cb < 32; cb += 8) {
        u32x2 loc[8]; f32x4 dv[8];
#pragma unroll
        for (int i = 0; i < 8; ++i) { loc[i] = sl[(size_t)(cb + i) * 8192]; dv[i] = dc[(cb + i) * 32]; }
#pragma unroll
        for (int i = 0; i < 8; ++i) { if (cb + i < 31) { s.x = dv[i].x * s.x + bflo(loc[i].x); s.y = dv[i].y * s.y + bfhi(loc[i].x); s.z = dv[i].z * s.z + bflo(loc[i].y); s.w = dv[i].w * s.w + bfhi(loc[i].y);
            u32x2 w; w.x = cvt_pk_bf16(s.x, s.y); w.y = cvt_pk_bf16(s.z, s.w); sl[(size_t)(cb + i) * 8192] = w; } }
    }
}

constexpr int GL_QG = 0, GL_KG = 17408, GL_VT = 53248, GL_AM = 90112, GL_OST = 0;
constexpr int GL_QS = 272, GL_TS = 144, GL_OS = 528;
__device__ __forceinline__ int crow(int r, int hi) { return (r & 3) + 8 * (r >> 2) + 4 * hi; }
__device__ __forceinline__ void gla_out_unit(const P& a, LAS unsigned char* lds, int unit) {
    int tid = threadIdx.x; asm volatile("" : "+v"(tid)); const int w = __builtin_amdgcn_readfirstlane(tid >> 6), lane = tid & 63, c32 = lane & 31, hi = lane >> 5;
    const int bh = unit >> 5, chunk = unit & 31, b = bh >> 2, h = bh & 3;
    const bf16_t* proj = (const bf16_t*)(a.ws + WS_PROJ); bf16_t* oab = (bf16_t*)(a.ws + WS_OAB); const float* ggo = a.in[7];
    const size_t tile = (size_t)bh * 32 + chunk;
    {
        const u32x4* q_ = (const u32x4*)((const bf16_t*)(a.ws + WS_QG) + tile * 8192); const u32x4* k_ = (const u32x4*)((const bf16_t*)(a.ws + WS_KG) + tile * 8192);
        u32x4 sq[2], sk[2]; unsigned sv[16];
        sq[0] = q_[tid]; sq[1] = q_[tid + 512]; sk[0] = k_[tid]; sk[1] = k_[tid + 512];
        const int ep = tid & 127, sq4 = tid >> 7;
        const bf16_t* v_ = proj + (size_t)(b * SEQ + chunk * 64 + 16 * sq4) * NPROJ + C_VA + h * 256 + 2 * ep;
#pragma unroll
        for (int i = 0; i < 16; ++i) sv[i] = *(const unsigned*)(v_ + (size_t)i * NPROJ);
#pragma unroll
        for (int i = 0; i < 2; ++i) { const int p = tid + 512 * i;
            *(LAS u32x4*)(lds + GL_QG + (p >> 4) * GL_QS + (p & 15) * 16) = sq[i]; *(LAS u32x4*)(lds + GL_KG + (p >> 4) * GL_QS + (p & 15) * 16) = sk[i]; }
        u32x4 lo0, lo1, hi0, hi1;
#pragma unroll
        for (int j = 0; j < 4; ++j) { lo0[j] = (sv[2 * j] & 0xffffu) | (sv[2 * j + 1] << 16); lo1[j] = (sv[8 + 2 * j] & 0xffffu) | (sv[8 + 2 * j + 1] << 16);
            hi0[j] = (sv[2 * j] >> 16) | (sv[2 * j + 1] & 0xffff0000u); hi1[j] = (sv[8 + 2 * j] >> 16) | (sv[8 + 2 * j + 1] & 0xffff0000u); }
        LAS unsigned char* v0 = lds + GL_VT + (2 * ep) * GL_TS + sq4 * 32;
        *(LAS u32x4*)(v0) = lo0; *(LAS u32x4*)(v0 + 16) = lo1; *(LAS u32x4*)(v0 + GL_TS) = hi0; *(LAS u32x4*)(v0 + GL_TS + 16) = hi1;
    }
    u32x2 sf[4][2][2];
    if (chunk > 0) { const u32x2* sl = (const u32x2*)(a.ws + WS_SLOC) + (tile - 1) * 8192;
#pragma unroll
        for (int tl = 0; tl < 4; ++tl)
#pragma unroll
            for (int s = 0; s < 2; ++s)
#pragma unroll
                for (int q = 0; q < 2; ++q) sf[tl][s][q] = sl[((tl * 4 + 2 * s + q) * 2 + hi) * 256 + 32 * w + c32]; }
    __syncthreads();
    if (w < 3) {
        const int ti = (w + 1) >> 1, si = w >> 1;
        f32x16 A;
#pragma unroll
        for (int r = 0; r < 16; ++r) A[r] = 0.f;
#pragma unroll
        for (int s = 0; s < 8; ++s) { const bf16x8 av = *(const LAS bf16x8*)(lds + GL_QG + (32 * ti + c32) * GL_QS + (16 * s + 8 * hi) * 2), bv = *(const LAS bf16x8*)(lds + GL_KG + (32 * si + c32) * GL_QS + (16 * s + 8 * hi) * 2);
            A = __builtin_amdgcn_mfma_f32_32x32x16_bf16(av, bv, A, 0, 0, 0); }
        const int sidx = 32 * si + c32;
#pragma unroll
        for (int r = 0; r < 16; ++r) { const int t = 32 * ti + crow(r, hi); const float v = (sidx <= t) ? A[r] : 0.f;
            *(LAS bf16_t*)(lds + GL_AM + t * GL_TS + sidx * 2) = (bf16_t)(cvt_pk_bf16(v, 0.f) & 0xffffu); }
    }
    __syncthreads();
    f32x16 o[2];
    {
        bf16x8 vt[4];
#pragma unroll
        for (int ks = 0; ks < 4; ++ks) vt[ks] = *(const LAS bf16x8*)(lds + GL_VT + (32 * w + c32) * GL_TS + (16 * ks + 8 * hi) * 2);
#pragma unroll
        for (int ti = 0; ti < 2; ++ti) {
#pragma unroll
            for (int r = 0; r < 16; ++r) o[ti][r] = 0.f;
            if (chunk > 0) {
#pragma unroll
                for (int tl = 0; tl < 4; ++tl)
#pragma unroll
                    for (int s = 0; s < 2; ++s) { const LAS unsigned char* qp = lds + GL_QG + (32 * ti + c32) * GL_QS + (32 * tl + 16 * s + 4 * hi) * 2;
                        const s16x4 lo = *(const LAS s16x4*)qp, hh = *(const LAS s16x4*)(qp + 16);
                        const bf16x8 aop = __builtin_shufflevector(lo, hh, 0, 1, 2, 3, 4, 5, 6, 7);
                        const u32x4 bw = {sf[tl][s][0].x, sf[tl][s][0].y, sf[tl][s][1].x, sf[tl][s][1].y};
                        o[ti] = __builtin_amdgcn_mfma_f32_32x32x16_bf16(aop, __builtin_bit_cast(bf16x8, bw), o[ti], 0, 0, 0); }
            }
#pragma unroll
            for (int ks = 0; ks < 4; ++ks) { if (ti == 0 && ks >= 2) continue;
                const bf16x8 av = *(const LAS bf16x8*)(lds + GL_AM + (32 * ti + c32) * GL_TS + (16 * ks + 8 * hi) * 2);
                o[ti] = __builtin_amdgcn_mfma_f32_32x32x16_bf16(av, vt[ks], o[ti], 0, 0, 0); }
        }
    }
    __syncthreads();
#pragma unroll
    for (int ti = 0; ti < 2; ++ti)
#pragma unroll
        for (int r = 0; r < 16; ++r) *(LAS bf16_t*)(lds + GL_OST + (32 * ti + crow(r, hi)) * GL_OS + (32 * w + c32) * 2) = (bf16_t)(cvt_pk_bf16(o[ti][r], 0.f) & 0xffffu);
    __syncthreads();
    {
        const int t = tid >> 3, sg = tid & 7; const size_t tok = (size_t)(b * SEQ + chunk * 64 + t);
        u32x4 ov[4]; float ss = 0.f;
#pragma unroll
        for (int j = 0; j < 4; ++j) { ov[j] = *(const LAS u32x4*)(lds + GL_OST + t * GL_OS + sg * 64 + j * 16);
#pragma unroll
            for (int i = 0; i < 4; ++i) { const float x0 = bflo(ov[j][i]), x1 = bfhi(ov[j][i]); ss += x0 * x0 + x1 * x1; } }
        ss += __shfl_xor(ss, 1); ss += __shfl_xor(ss, 2); ss += __shfl_xor(ss, 4);
        const float rstd = 1.0f / sqrtf(ss * (1.0f / 256.0f) + EPS);
        const bf16_t* rap = proj + tok * NPROJ + C_RA + h * 256 + sg * 32; bf16_t* op = oab + tok * 2048 + h * 256 + sg * 32; const float* gp = ggo + sg * 32;
#pragma unroll
        for (int j = 0; j < 4; ++j) { const u32x4 ra = *(const u32x4*)(rap + 8 * j); const f32x4 g0 = *(const f32x4*)(gp + 8 * j), g1 = *(const f32x4*)(gp + 8 * j + 4); u32x4 wv;
#pragma unroll
            for (int i = 0; i < 4; ++i) { const float r0 = bflo(ra[i]), r1 = bfhi(ra[i]); const float ga = (i < 2) ? g0[2 * i] : g1[2 * i - 4], gb = (i < 2) ? g0[2 * i + 1] : g1[2 * i - 3];
                wv[i] = cvt_pk_bf16(bflo(ov[j][i]) * rstd * ga * (r0 * fsigmoid(r0)), bfhi(ov[j][i]) * rstd * gb * (r1 * fsigmoid(r1))); }
            *(u32x4*)(op + 8 * j) = wv; }
    }
    __syncthreads();
}
namespace moba {
constexpr int HD = 128;
constexpr float SCALE = 0.08838834764831845f;
constexpr float THR = 8.f;
constexpr int NW = 8, QBLK = 32, KVBLK = 64, QB = NW * QBLK;
constexpr int SHM_V = KVBLK * HD * 2, SHM_K = KVBLK * HD * 2;
constexpr int OFF_WS = 2 * SHM_V + 2 * SHM_K;
constexpr int OFF_RTAB = OFF_WS + NW * 64 * 4;
constexpr int OFF_KM = OFF_RTAB + 2304 * 4;
constexpr int OFF_MISC = OFF_KM + 8 * 128 * 4;
constexpr int OFF_SEL = OFF_MISC + 64;
constexpr int LDS_BYTES = OFF_SEL + 2048;
constexpr int LDP = NPROJ, LDO = 2048;

#define KSWZ(row, colB) ((row) * 256 + ((colB) ^ (((row) & 7) << 4)))
#define SBAR() __builtin_amdgcn_sched_barrier(0)
__device__ __forceinline__ int v_st(int k, int c) { const int kk = (k & ~0xC) | ((k & 4) << 1) | ((k & 8) >> 1); return ((kk >> 3) * 4 + (c >> 5)) * 512 + ((kk & 7) * 32 + (c & 31)) * 2; }
__device__ __forceinline__ int v_rd_base(int lane) { return ((lane & 3) << 3) | (((lane >> 2) & 3) << 6) | (((lane >> 4) & 1) << 5) | (((lane >> 5) & 1) << 8); }
constexpr int v_rd_off(int d0, int ks, int half) { return d0 * 512 + ks * 4096 + half * 2048; }
__device__ __forceinline__ int crow(int r, int hi) { return (r & 3) + 8 * (r >> 2) + 4 * hi; }
__device__ __forceinline__ unsigned cvtpk(float lo, float hi) { unsigned r; asm volatile("v_cvt_pk_bf16_f32 %0, %1, %2" : "=v"(r) : "v"(lo), "v"(hi)); return r; }

__device__ __forceinline__ void mask_tile(f32x16& p0, f32x16& p1, int dq) {
    const float NEG = -__builtin_inff();
#pragma unroll
    for (int r = 0; r < 16; ++r) {
        const int c = (r & 3) + 8 * (r >> 2);
        if (dq - c < 0) p0[r] = NEG;
        if (dq - c - 32 < 0) p1[r] = NEG;
    }
}
__device__ __forceinline__ void bias_tile(f32x16& p0, f32x16& p1, const LAS float* rt) {
#pragma unroll
    for (int r = 0; r < 16; ++r) { const int c = (r & 3) + 8 * (r >> 2); p0[r] += rt[c]; p1[r] += rt[c + 32]; }
}
__device__ __forceinline__ void kill_tile(f32x16& p0, f32x16& p1) {
    const float NEG = -__builtin_inff();
#pragma unroll
    for (int r = 0; r < 16; ++r) { p0[r] = NEG; p1[r] = NEG; }
}
__device__ __forceinline__ void partialSM(f32x16& p0, f32x16& p1, float& m_reg, float& mn, float& alpha) {
    float pmax = p0[0];
#pragma unroll
    for (int r = 1; r < 16; ++r) pmax = fmaxf(pmax, p0[r]);
#pragma unroll
    for (int r = 0; r < 16; ++r) pmax = fmaxf(pmax, p1[r]);
    { auto rr = __builtin_amdgcn_permlane32_swap(__float_as_uint(pmax), __float_as_uint(pmax), false, false);
      pmax = fmaxf(__uint_as_float(rr[0]), __uint_as_float(rr[1])); }
    constexpr float C2 = 1.4426950408889634f * SCALE;
    if (__builtin_expect(__all((pmax - m_reg) * SCALE <= THR), 1)) { mn = m_reg; alpha = 1.f; }
    else { mn = fmaxf(m_reg, pmax); alpha = __builtin_amdgcn_exp2f((m_reg - mn) * C2); m_reg = mn; }
    const float mnL = -mn * C2;
#pragma unroll
    for (int r = 0; r < 16; ++r) p0[r] = fmaf(p0[r], C2, mnL);
#pragma unroll
    for (int r = 0; r < 16; ++r) p1[r] = fmaf(p1[r], C2, mnL);
#pragma unroll
    for (int r = 0; r < 16; ++r) p0[r] = __builtin_amdgcn_exp2f(p0[r]);
}
__device__ __forceinline__ void finishSM(f32x16& p0, f32x16& p1, float alpha, float& l_reg, bf16x8& pa0, bf16x8& pa1, bf16x8& pa2, bf16x8& pa3) {
#pragma unroll
    for (int r = 0; r < 16; ++r) p1[r] = __builtin_amdgcn_exp2f(p1[r]);
    float ps = 0;
#pragma unroll
    for (int r = 0; r < 16; ++r) ps += p0[r];
#pragma unroll
    for (int r = 0; r < 16; ++r) ps += p1[r];
    { auto rr = __builtin_amdgcn_permlane32_swap(__float_as_uint(ps), __float_as_uint(ps), false, false);
      ps = __uint_as_float(rr[0]) + __uint_as_float(rr[1]); }
    l_reg = l_reg * alpha + ps;
#define PK4(P, B_, OUT) do { unsigned a0 = cvtpk(P[B_+0], P[B_+1]), a1 = cvtpk(P[B_+2], P[B_+3]);                          \
        unsigned b0 = cvtpk(P[B_+4], P[B_+5]), b1 = cvtpk(P[B_+6], P[B_+7]);                                             \
        auto r0 = __builtin_amdgcn_permlane32_swap(a0, b0, false, false); auto r1 = __builtin_amdgcn_permlane32_swap(a1, b1, false, false); \
        u32x4 w = {r0[0], r1[0], r0[1], r1[1]}; OUT = __builtin_bit_cast(bf16x8, w); } while (0)
    PK4(p0, 0, pa0); PK4(p0, 8, pa1); PK4(p1, 0, pa2); PK4(p1, 8, pa3);
#undef PK4
}
template <int KB>
__device__ __forceinline__ void qkt(f32x16& p0, f32x16& p1, const char* K_lds, int r32, int hi, const bf16x8* qr) {
#pragma unroll
    for (int r = 0; r < 16; ++r) { p0[r] = 0.f; p1[r] = 0.f; }
    const char* kb[4];
#pragma unroll
    for (int dd = 0; dd < 4; ++dd) kb[dd] = K_lds + KB * SHM_K + KSWZ(r32, (dd * 16 + hi * 8) * 2);
#pragma unroll
    for (int d0 = 0; d0 < 8; ++d0) { const char* a = kb[d0 & 3] + (d0 >> 2) * 128;
        bf16x8 b0 = *reinterpret_cast<const bf16x8*>(a);
        bf16x8 b1 = *reinterpret_cast<const bf16x8*>(a + 32 * 256);
        p0 = __builtin_amdgcn_mfma_f32_32x32x16_bf16(b0, qr[d0], p0, 0, 0, 0);
        p1 = __builtin_amdgcn_mfma_f32_32x32x16_bf16(b1, qr[d0], p1, 0, 0, 0); }
}
template <int VB>
__device__ __forceinline__ void pv_tile(f32x16* o, int vb0, bf16x8 pa0, bf16x8 pa1, bf16x8 pa2, bf16x8 pa3) {
#define TRRD(dst, off) asm volatile("ds_read_b64_tr_b16 %0, %1 offset:%2" : "=&v"(dst) : "v"(vb0), "i"(off) : "memory")
#define PV_D0(d0) do { s16x4 l0, l1, l2, l3, h0, h1, h2, h3; constexpr int b_ = VB * SHM_V + v_rd_off(d0, 0, 0);   \
        TRRD(l0, b_); TRRD(h0, b_ + 2048); TRRD(l1, b_ + 4096); TRRD(h1, b_ + 6144); TRRD(l2, b_ + 8192); TRRD(h2, b_ + 10240); TRRD(l3, b_ + 12288); TRRD(h3, b_ + 14336); \
        asm volatile("s_waitcnt lgkmcnt(0)" ::: "memory"); SBAR();   \
        o[d0] = __builtin_amdgcn_mfma_f32_32x32x16_bf16(pa0, (bf16x8){l0[0], l0[1], l0[2], l0[3], h0[0], h0[1], h0[2], h0[3]}, o[d0], 0, 0, 0);   \
        o[d0] = __builtin_amdgcn_mfma_f32_32x32x16_bf16(pa1, (bf16x8){l1[0], l1[1], l1[2], l1[3], h1[0], h1[1], h1[2], h1[3]}, o[d0], 0, 0, 0);   \
        o[d0] = __builtin_amdgcn_mfma_f32_32x32x16_bf16(pa2, (bf16x8){l2[0], l2[1], l2[2], l2[3], h2[0], h2[1], h2[2], h2[3]}, o[d0], 0, 0, 0);   \
        o[d0] = __builtin_amdgcn_mfma_f32_32x32x16_bf16(pa3, (bf16x8){l3[0], l3[1], l3[2], l3[3], h3[0], h3[1], h3[2], h3[3]}, o[d0], 0, 0, 0); } while (0)
    PV_D0(0); PV_D0(1); PV_D0(2); PV_D0(3);
#undef PV_D0
#undef TRRD
}

struct BlockRef { const bf16_t* Q; const bf16_t* K; const bf16_t* V; bf16_t* O; int qb; int b, h; };
struct Seam { bf16x8 qr[8]; bf16x8 st_v0, st_v1, st_k0, st_k1; };
#define VMW() asm volatile("s_waitcnt vmcnt(0)" ::: "memory")
#define VMWN(n) asm volatile("s_waitcnt vmcnt(%0)" :: "i"(n) : "memory")
#define LD8(p) (*reinterpret_cast<const bf16x8*>(p))
#define SLOAD_H(Kp, Vp, k0) do { const char* kb__ = (const char*)(Kp) + (size_t)(k0) * (LDP * 2); \
        S.st_v0 = LD8(kb__ + 2048 + kvoff); S.st_v1 = LD8(kb__ + (32 * LDP * 2 + 2048) + kvoff); S.st_k0 = LD8(kb__ + kvoff); S.st_k1 = LD8(kb__ + 32 * LDP * 2 + kvoff); } while (0)
#define SWRITE_HK(bf) do { *(bf16x8*)(K_lds + (bf) * SHM_K + kws) = S.st_k0; *(bf16x8*)(K_lds + (bf) * SHM_K + kws + 32 * 256) = S.st_k1; } while (0)
#define SWRITE_HV(bf) do { *(bf16x8*)(V_lds + (bf) * SHM_V + vst0) = S.st_v0; *(bf16x8*)(V_lds + (bf) * SHM_V + vst1) = S.st_v1; } while (0)
#define SWRITE_H(bf) do { SWRITE_HV(bf); SWRITE_HK(bf); } while (0)

__device__ __forceinline__ void prime(const BlockRef& cur, char* lds, Seam& S) {
    int tid = threadIdx.x; asm volatile("" : "+v"(tid));     const int wid = __builtin_amdgcn_readfirstlane(tid >> 6), lane = tid & 63, r32 = lane & 31, hi = lane >> 5;
    const int sr = tid >> 4, sc = (tid & 15) * 8, kws = KSWZ(sr, sc * 2); char* K_lds = lds + 2 * SHM_V;
    const unsigned kvoff = (unsigned)(sr * LDP + sc) * 2u, qvoff = (unsigned)(r32 * LDP + hi * 8) * 2u;
    { const char* qb__ = (const char*)cur.Q + (size_t)(wid * QBLK) * (LDP * 2);
#pragma unroll
    for (int d0 = 0; d0 < 8; ++d0) S.qr[d0] = LD8(qb__ + qvoff + d0 * 32); }
    SLOAD_H(cur.K, cur.V, 0); VMW(); SWRITE_HK(0);
    __syncthreads();
}
__device__ __forceinline__ int rel_bucket(int n) {
    if (n < 16) return n;
    const float nf = (float)n;
    int large = 16 + (int)(logf(nf / 16.0f) / 5.545177444479562f * 16.0f);
    return large < 31 ? large : 31;
}
__device__ __forceinline__ void block(const BlockRef& cur, const BlockRef& nxt, const float* rel_bias, const float* kmp, char* lds, Seam& S) {
    int tid = threadIdx.x; asm volatile("" : "+v"(tid));     const int wid = __builtin_amdgcn_readfirstlane(tid >> 6), lane = tid & 63, r32 = lane & 31, hi = lane >> 5;
    const int qb = cur.qb, NT = 4 * (qb + 1);
    const int qlo = qb * QB + wid * QBLK, qrow = qlo + r32;
    char* V_lds = lds; char* K_lds = lds + 2 * SHM_V;
    float* ws = (float*)(lds + OFF_WS) + wid * 64; float* li_l = ws, * al_l = ws + 32;
    LAS float* rtab = (LAS float*)(LAS char*)(uintptr_t)(unsigned)(uintptr_t)(lds + OFF_RTAB);
    float* kmL = (float*)(lds + OFF_KM);
    for (int i = tid; i < 2304; i += NW * 64) { const int dist = 2047 - i; rtab[i] = dist >= 0 ? rel_bias[rel_bucket(dist) * 8 + cur.h] * (1.0f / SCALE) : 0.f; }
    for (int i = tid; i < qb * 128; i += NW * 64) { const int j = i >> 7, dd = i & 127; const size_t o = ((size_t)(cur.b * 8 + j)) * 1024 + cur.h * 128 + dd;
        kmL[i] = (kmp[o] + kmp[o + 64 * 1024]) * (1.0f / 256.0f); }
    __syncthreads();
    unsigned selmask = 0;
    {
        float sc7[7];
#pragma unroll
        for (int j = 0; j < 7; ++j) { sc7[j] = -__builtin_inff();
            if (j < qb) { float acc = 0.f;
#pragma unroll
                for (int d0 = 0; d0 < 8; ++d0) { const u32x4 q4 = __builtin_bit_cast(u32x4, S.qr[d0]); const f32x4 k0 = *(const f32x4*)(kmL + j * 128 + d0 * 16 + hi * 8), k1 = *(const f32x4*)(kmL + j * 128 + d0 * 16 + hi * 8 + 4);
                    acc += bflo(q4[0]) * k0[0] + bfhi(q4[0]) * k0[1] + bflo(q4[1]) * k0[2] + bfhi(q4[1]) * k0[3] + bflo(q4[2]) * k1[0] + bfhi(q4[2]) * k1[1] + bflo(q4[3]) * k1[2] + bfhi(q4[3]) * k1[3]; }
                acc += __shfl_xor(acc, 32); sc7[j] = acc; } }
#pragma unroll
        for (int j = 0; j < 7; ++j) { int rank = 0;
#pragma unroll
            for (int i = 0; i < 7; ++i) { if (i != j) rank += (sc7[i] > sc7[j] || (sc7[i] == sc7[j] && i < j)) ? 1 : 0; }
            if (j < qb && (qb <= 3 || rank < 3)) selmask |= 1u << j; }
    }
    LAS unsigned* selp = (LAS unsigned*)(LAS char*)(uintptr_t)(unsigned)(uintptr_t)(lds + OFF_SEL) + tid;
    *selp = selmask;
    float m_reg = -1e30f, l_reg = 0; f32x16 o[4];
#pragma unroll
    for (int d = 0; d < 4; ++d)
#pragma unroll
        for (int r = 0; r < 16; ++r) o[d][r] = 0.f;
    const int sr = tid >> 4, sc = (tid & 15) * 8, vst0 = v_st(sr, sc), vst1 = v_st(32 + sr, sc), kws = KSWZ(sr, sc * 2);
    const unsigned kvoff = (unsigned)(sr * LDP + sc) * 2u;
    const int vb0 = (int)(uintptr_t)V_lds + v_rd_base(lane);
    const bf16_t* Kh = cur.K; const bf16_t* Vh = cur.V;
#define RESC(a) do { if (__any((a) < 1.f)) { if (hi == 0) al_l[r32] = (a); asm volatile("s_waitcnt lgkmcnt(0)" ::: "memory");              \
                     for (int d_ = 0; d_ < 4; ++d_) for (int r = 0; r < 16; ++r) o[d_][r] *= al_l[crow(r, hi)]; } } while (0)
#define KBASE(t) ((t) * KVBLK)
#define MASKT(P0_, P1_, t) do { const int kb_ = KBASE(t); bias_tile(P0_, P1_, rtab + (kb_ + 4 * hi - qrow + 2047)); \
        if (((t) >> 2) != qb) { if (!((*selp >> ((t) >> 2)) & 1u)) kill_tile(P0_, P1_); } \
        else if (kb_ + KVBLK - 1 > qlo) mask_tile(P0_, P1_, qrow - 4 * hi - kb_); } while (0)
    constexpr int NQL = 8;
#define SEAM_K0() do { VMWN(NQL); SWRITE_HK(0); SBAR(); } while (0)
    f32x16 pA0, pA1, pB0, pB1; float mnA, mnB, alA, alB; bf16x8 pa0, pa1, pa2, pa3;
    SWRITE_HV(0); SBAR();
    if (NT > 1) { SLOAD_H(Kh, Vh, KBASE(1)); }
    SBAR(); qkt<0>(pA0, pA1, K_lds, r32, hi, S.qr);
    MASKT(pA0, pA1, 0); partialSM(pA0, pA1, m_reg, mnA, alA);
    if (NT > 1) { VMW(); SWRITE_H(1); }
    __syncthreads();
#define HALF_STEP(PX0, PX1, mnX, alX, PY0, PY1, alY, t, KB, VB, SB) do {                                                      \
        SBAR(); qkt<KB>(PX0, PX1, K_lds, r32, hi, S.qr);                                             \
        finishSM(PY0, PY1, alY, l_reg, pa0, pa1, pa2, pa3); SBAR();                                                           \
        if ((t) + 1 < NT) { SLOAD_H(Kh, Vh, KBASE((t) + 1)); SBAR(); }                                               \
        pv_tile<VB>(o, vb0, pa0, pa1, pa2, pa3); MASKT(PX0, PX1, (t)); partialSM(PX0, PX1, m_reg, mnX, alX);                                        \
        __syncthreads();                                                                                                      \
        if ((t) + 1 < NT) { VMW(); SWRITE_H(SB); }                                                                          \
        RESC(alX); __syncthreads(); } while (0)
    for (int t = 1; t + 1 < NT; t += 2) {
        HALF_STEP(pB0, pB1, mnB, alB, pA0, pA1, alA, t, 1, 0, 0);
        HALF_STEP(pA0, pA1, mnA, alA, pB0, pB1, alB, t + 1, 0, 1, 1);
    }
    { SBAR(); qkt<1>(pB0, pB1, K_lds, r32, hi, S.qr); SBAR(); }
    SLOAD_H(nxt.K, nxt.V, 0); SBAR();
    { const char* qb__ = (const char*)nxt.Q + (size_t)(wid * QBLK) * (LDP * 2); int l_ = lane; asm volatile("" : "+v"(l_));
      const unsigned qvoff = (unsigned)((l_ & 31) * LDP + (l_ >> 5) * 8) * 2u;
#pragma unroll
    for (int d0 = 0; d0 < 8; ++d0) S.qr[d0] = LD8(qb__ + qvoff + d0 * 32); }
    SBAR();
    finishSM(pA0, pA1, alA, l_reg, pa0, pa1, pa2, pa3); SBAR();
    pv_tile<0>(o, vb0, pa0, pa1, pa2, pa3);
    { MASKT(pB0, pB1, NT - 1); partialSM(pB0, pB1, m_reg, mnB, alB); __syncthreads(); RESC(alB);
      finishSM(pB0, pB1, alB, l_reg, pa0, pa1, pa2, pa3); SBAR(); pv_tile<1>(o, vb0, pa0, pa1, pa2, pa3); }
    SBAR(); SEAM_K0();
    if (hi == 0) li_l[r32] = l_reg; asm volatile("s_waitcnt lgkmcnt(0)" ::: "memory");
    float rli[16];
#pragma unroll
    for (int r = 0; r < 16; ++r) rli[r] = __builtin_amdgcn_rcpf(li_l[crow(r, hi)]);
    char* Ow = (char*)cur.O + (size_t)(wid * QBLK) * (LDO * 2); const unsigned ovoff = (unsigned)(4 * hi * LDO + r32) * 2u;
#pragma unroll
    for (int r = 0; r < 16; ++r) { const int orow0 = (r & 3) + 8 * (r >> 2);
#pragma unroll
        for (int d0 = 0; d0 < 4; ++d0) { const float v = o[d0][r] * rli[r];
            const float vn = __shfl_xor(v, 1);
            if ((r32 & 1) == 0) *(unsigned*)(Ow + (size_t)(orow0 * LDO * 2 + d0 * 64) + ovoff) = cvtpk(v, vn); } }
    __syncthreads();
#undef RESC
#undef KBASE
#undef MASKT
#undef SEAM_K0
#undef HALF_STEP
}
#undef ROWP
#undef VMW
#undef VMWN
#undef LD8
#undef SLOAD_H
#undef SWRITE_HK
#undef SWRITE_HV
#undef SWRITE_H

__device__ __forceinline__ BlockRef make_ref(const P& a, int item) {
    const int qb = 7 - (item >> 6), bh = item & 63, b = bh >> 3, h = bh & 7;
    const bf16_t* proj = (const bf16_t*)(a.ws + WS_PROJ);
    BlockRef r; r.b = b; r.h = h; r.qb = qb;
    r.Q = proj + (size_t)(b * SEQ + qb * QB) * LDP + C_QB + h * HD;
    r.K = proj + (size_t)(b * SEQ) * LDP + C_KB + h * HD;
    r.V = proj + (size_t)(b * SEQ) * LDP + C_VB + h * HD;
    r.O = (bf16_t*)(a.ws + WS_OAB) + (size_t)(b * SEQ + qb * QB) * LDO + 1024 + h * HD;
    return r;
}
}
__device__ __forceinline__ void router_unit(const P& a, LAS unsigned char* lds, int unit) {
    int tid = threadIdx.x; asm volatile("" : "+v"(tid)); const int wave = __builtin_amdgcn_readfirstlane(tid >> 6), lane = tid & 63, c32 = lane & 31, hi = lane >> 5;
    const int tg = wave & 1, kq = wave >> 1;
    const float* x1 = a.out; const float* g = a.in[11]; const float* br = a.in[13];
    unsigned char* A2 = a.ws + WS_H; const u32x4* frag = (const u32x4*)(a.ws + WS_WRF);
    LAS float* Lw = (LAS float*)(lds + wave * 4352);
    LAS float* ssp = (LAS float*)(lds + 8 * 4352);
    LAS unsigned* hist = (LAS unsigned*)(lds + 8 * 4352 + 2048);
    LAS unsigned* base = hist + 32;
    if (tid < 32) hist[tid] = 0u;
    const int tok = unit * 64 + tg * 32 + c32;
    f32x16 L;
#pragma unroll
    for (int r = 0; r < 16; ++r) L[r] = 0.f;
    float ss = 0.f;
    const float* xr = x1 + (size_t)tok * D + 8 * hi + 256 * kq; unsigned char* ar = A2 + (size_t)tok * D + 8 * hi + 256 * kq; const float* gr = g + 8 * hi + 256 * kq;
#pragma unroll 4
    for (int s = 0; s < 16; ++s) {
        const f32x4 xa = *(const f32x4*)(xr + 16 * s), xb = *(const f32x4*)(xr + 16 * s + 4), ga = *(const f32x4*)(gr + 16 * s), gb = *(const f32x4*)(gr + 16 * s + 4);
        ss += (xa.x * xa.x + xa.y * xa.y) + (xa.z * xa.z + xa.w * xa.w) + (xb.x * xb.x + xb.y * xb.y) + (xb.z * xb.z + xb.w * xb.w);
        const f32x4 va = xa * ga, vb = xb * gb;
        u32x4 wh; wh.x = cvt_pk_bf16(va.x, va.y); wh.y = cvt_pk_bf16(va.z, va.w); wh.z = cvt_pk_bf16(vb.x, vb.y); wh.w = cvt_pk_bf16(vb.z, vb.w);
        { u32x2 w8; w8.x = pk4_fp8(va.x, va.y, va.z, va.w); w8.y = pk4_fp8(vb.x, vb.y, vb.z, vb.w); *(u32x2*)(ar + 16 * s) = w8; }
        u32x4 wl; wl.x = cvt_pk_bf16(va.x - bflo(wh.x), va.y - bfhi(wh.x)); wl.y = cvt_pk_bf16(va.z - bflo(wh.y), va.w - bfhi(wh.y));
        wl.z = cvt_pk_bf16(vb.x - bflo(wh.z), vb.y - bfhi(wh.z)); wl.w = cvt_pk_bf16(vb.z - bflo(wh.w), vb.w - bfhi(wh.w));
        const bf16x8 ah = __builtin_bit_cast(bf16x8, wh), al = __builtin_bit_cast(bf16x8, wl);
        const bf16x8 bh = __builtin_bit_cast(bf16x8, frag[(16 * kq + s) * 64 + lane]), bl = __builtin_bit_cast(bf16x8, frag[4096 + (16 * kq + s) * 64 + lane]);
        L = __builtin_amdgcn_mfma_f32_32x32x16_bf16(ah, bh, L, 0, 0, 0);
        L = __builtin_amdgcn_mfma_f32_32x32x16_bf16(ah, bl, L, 0, 0, 0);
        L = __builtin_amdgcn_mfma_f32_32x32x16_bf16(al, bh, L, 0, 0, 0);
    }
#pragma unroll
    for (int r = 0; r < 16; ++r) Lw[((r & 3) + 8 * (r >> 2) + 4 * hi) * 33 + c32] = L[r];
    ssp[wave * 64 + lane] = ss;
    __syncthreads();
    int e4[4] = {0, 0, 0, 0}; float w4[4] = {0.f, 0.f, 0.f, 0.f}; unsigned loc[4] = {0u, 0u, 0u, 0u}; float rstd = 0.f;
    const bool sel = (wave < 2) && (hi == 0);
    if (sel) {
        float sst = 0.f;
#pragma unroll
        for (int q = 0; q < 4; ++q) sst += ssp[(wave + 2 * q) * 64 + c32] + ssp[(wave + 2 * q) * 64 + 32 + c32];
        rstd = 1.0f / sqrtf(sst * (1.0f / D) + EPS);
        float lg[32];
#pragma unroll
        for (int e = 0; e < 32; ++e) { const LAS float* lp = (const LAS float*)(lds + wave * 4352) + c32 * 33 + e; lg[e] = (lp[0] + lp[2 * 1088] + lp[4 * 1088] + lp[6 * 1088]) * rstd + br[e]; }
        unsigned used = 0u; float v4[4];
#pragma unroll
        for (int p = 0; p < 4; ++p) { float best = -__builtin_inff(); int bi = 0;
#pragma unroll
            for (int e = 0; e < 32; ++e) { const bool take = !((used >> e) & 1u) && lg[e] > best; best = take ? lg[e] : best; bi = take ? e : bi; }
            used |= 1u << bi; e4[p] = bi; v4[p] = best; }
        float sum = 0.f;
#pragma unroll
        for (int p = 0; p < 4; ++p) { w4[p] = expf(v4[p] - v4[0]); sum += w4[p]; }
        const float inv = 1.0f / sum;
#pragma unroll
        for (int p = 0; p < 4; ++p) { w4[p] *= inv; loc[p] = __hip_atomic_fetch_add(hist + e4[p], 1u, __ATOMIC_RELAXED, __HIP_MEMORY_SCOPE_WORKGROUP); }
    }
    __syncthreads();
    if (tid < 32) base[tid] = __hip_atomic_fetch_add((unsigned*)(a.ws + WS_CTL) + CW_COUNTS + tid, hist[tid], RLX_AGENT);
    __syncthreads();
    if (sel) {
        int* tope = (int*)(a.ws + WS_TOPE) + (size_t)tok * 4; float* wts = (float*)(a.ws + WS_WTS) + (size_t)tok * 4; int* slot = (int*)(a.ws + WS_SLOT) + (size_t)tok * 4;
#pragma unroll
        for (int p = 0; p < 4; ++p) { tope[p] = e4[p]; wts[p] = w4[p]; slot[p] = (int)(base[e4[p]] + loc[p]); }
        ((float*)(a.ws + WS_RSTD))[tok] = rstd;
    }
    __syncthreads();
}

__device__ __forceinline__ void moe_index(const P& a, LAS unsigned char* lds, int vcu, int G) {
    const int tid = threadIdx.x;
    LAS int* pstart = (LAS int*)lds;
    LAS int* cnt = pstart + 64;
    const unsigned* counts = (const unsigned*)(a.ws + WS_CTL) + CW_COUNTS;
    if (tid == 0) { int acc = 0; for (int e = 0; e < NE; ++e) { const int c = (int)counts[e]; cnt[e] = c; pstart[e] = acc; acc += ((c + 255) >> 8) << 8; } pstart[NE] = acc; }
    __syncthreads();
    int* rowtok = (int*)(a.ws + WS_ROWTOK); float* rstds = (float*)(a.ws + WS_RSTDS); int* dest = (int*)(a.ws + WS_DEST);
    const int* tope = (const int*)(a.ws + WS_TOPE); const int* slot = (const int*)(a.ws + WS_SLOT); const float* rstd = (const float*)(a.ws + WS_RSTD);
    const int gt = vcu * NTHREADS + tid, NGT = G * NTHREADS;
    for (int i = gt; i < T * 4; i += NGT) { const int e = tope[i], d = pstart[e] + slot[i]; dest[i] = d; rowtok[d] = i >> 2; rstds[d] = rstd[i >> 2]; }
    for (int i = gt; i < NE * 256; i += NGT) { const int e = i >> 8, r = pstart[e] + cnt[e] + (i & 255); if (r < pstart[e + 1]) { rowtok[r] = 0; rstds[r] = 0.f; } }
    if (vcu == 0) { int* tile_e = (int*)(a.ws + WS_TILEE);
        for (int t = tid; t < MAXTILES; t += NTHREADS) { int e = NE - 1; for (int q = 0; q < NE; ++q) { if (t * 256 >= pstart[q] && t * 256 < pstart[q + 1]) e = q; } tile_e[t] = e; }
        if (tid == 0) tile_e[MAXTILES] = pstart[NE] >> 8; }
    __syncthreads();
}

__device__ __forceinline__ void combine_rows(const P& a, int vcu, int G, int wave, int lane) {
    const int gw = vcu * NWAVES + wave, NGW = G * NWAVES;
    float* X = a.out; const bf16_t* Y = (const bf16_t*)(a.ws + WS_YROWS); bf16_t* A3 = (bf16_t*)(a.ws + WS_H);
    const int* dest = (const int*)(a.ws + WS_DEST); const float* wts = (const float*)(a.ws + WS_WTS); const float* g = a.in[20];
    f32x4 gv[4];
#pragma unroll
    for (int j = 0; j < 4; ++j) gv[j] = *((const f32x4*)g + lane + 64 * j);
    for (int m = gw; m < T; m += NGW) {
        f32x4* xr = (f32x4*)(X + (size_t)m * D) + lane; f32x4 v[4];
#pragma unroll
        for (int j = 0; j < 4; ++j) v[j] = xr[64 * j];
#pragma unroll
        for (int k = 0; k < 4; ++k) { const int d = __builtin_amdgcn_readfirstlane(dest[m * 4 + k]); const float w = __uint_as_float(__builtin_amdgcn_readfirstlane(__float_as_uint(wts[m * 4 + k])));
            const u32x2* yr = (const u32x2*)(Y + (size_t)d * D) + lane;
#pragma unroll
            for (int j = 0; j < 4; ++j) { const u32x2 y = yr[64 * j]; v[j].x += w * bflo(y.x); v[j].y += w * bfhi(y.x); v[j].z += w * bflo(y.y); v[j].w += w * bfhi(y.y); } }
        float s = 0.f;
#pragma unroll
        for (int j = 0; j < 4; ++j) s += (v[j].x * v[j].x + v[j].y * v[j].y) + (v[j].z * v[j].z + v[j].w * v[j].w);
        const float rstd = 1.0f / sqrtf(wave_sum(s) * (1.0f / D) + EPS);
        u32x2* o8 = (u32x2*)(A3 + (size_t)m * D) + lane;
#pragma unroll
        for (int j = 0; j < 4; ++j) { xr[64 * j] = v[j]; u32x2 w; w.x = cvt_pk_bf16(v[j].x * rstd * gv[j].x, v[j].y * rstd * gv[j].y); w.y = cvt_pk_bf16(v[j].z * rstd * gv[j].z, v[j].w * rstd * gv[j].w); o8[64 * j] = w; }
    }
}
__device__ __forceinline__ void final_rows(const P& a, int vcu, int G, int wave, int lane) {
    const int gw = vcu * NWAVES + wave, NGW = G * NWAVES;
    float* X = a.out; const bf16_t* PG = (const bf16_t*)(a.ws + WS_PGATE); const bf16_t* PP = (const bf16_t*)(a.ws + WS_PPROJ);
    f32x4 gp[4], gf[4];
#pragma unroll
    for (int j = 0; j < 4; ++j) { gp[j] = *((const f32x4*)a.in[23] + lane + 64 * j); gf[j] = *((const f32x4*)a.in[24] + lane + 64 * j); }
    for (int m = gw; m < T; m += NGW) {
        f32x4* xr = (f32x4*)(X + (size_t)m * D) + lane; const u32x2* pgr = (const u32x2*)(PG + (size_t)m * D) + lane; const u32x2* ppr = (const u32x2*)(PP + (size_t)m * D) + lane;
        f32x4 v[4], pp[4], pg[4]; float sp = 0.f;
#pragma unroll
        for (int j = 0; j < 4; ++j) { v[j] = xr[64 * j]; const u32x2 q = ppr[64 * j], gq = pgr[64 * j];
            pp[j] = (f32x4){bflo(q.x), bfhi(q.x), bflo(q.y), bfhi(q.y)}; pg[j] = (f32x4){bflo(gq.x), bfhi(gq.x), bflo(gq.y), bfhi(gq.y)};
            sp += (pp[j].x * pp[j].x + pp[j].y * pp[j].y) + (pp[j].z * pp[j].z + pp[j].w * pp[j].w); }
        const float rp = 1.0f / sqrtf(wave_sum(sp) * (1.0f / D) + EPS); float s = 0.f;
#pragma unroll
        for (int j = 0; j < 4; ++j) { v[j] = v[j] + pg[j] * (pp[j] * rp * gp[j]); s += (v[j].x * v[j].x + v[j].y * v[j].y) + (v[j].z * v[j].z + v[j].w * v[j].w); }
        const float rstd = 1.0f / sqrtf(wave_sum(s) * (1.0f / D) + EPS);
#pragma unroll
        for (int j = 0; j < 4; ++j) xr[64 * j] = v[j] * rstd * gf[j];
    }
}
struct Args { P p; };
template <int PH_LO, int PH_HI>
__global__ void __launch_bounds__(NTHREADS, 2) hybrid_fwd(Args args) {
    extern __shared__ __attribute__((aligned(16))) unsigned char lds_raw[];
    LAS unsigned char* lds = (LAS unsigned char*)lds_raw;
    const P& a = args.p;
    const int tid = threadIdx.x, lane = tid & 63, wave = __builtin_amdgcn_readfirstlane(tid >> 6);
    const int G = gridDim.x; const int bx = blockIdx.x; const int vcu = (G % 8 == 0) ? (bx % 8) * (G / 8) + bx / 8 : bx;
    unsigned* ctl = (unsigned*)(a.ws + WS_CTL);
    for (int u = tid; u < (LDS_BYTES - LDSCTL_OFF) / 4; u += NTHREADS) ((LAS unsigned*)(lds + LDSCTL_OFF))[u] = 0u;
    __syncthreads();
#if MK_PER_PHASE
#define GRID_BAR() do { } while (0)
#else
    XcdBarrier bar = xcd_barrier_post(ctl + CW_BAR, (volatile LAS unsigned*)(lds + MISC_OFF + 32));
#define GRID_BAR() xcd_barrier(bar)
#endif
    constexpr int lo = PH_LO, hi = PH_HI;
#define IN(k) (lo <= (k) && (k) < hi)
#define SEAM(k) do { if constexpr (IN(k) && IN((k) + 1)) GRID_BAR(); } while (0)
    unsigned char* ws = a.ws;

    if constexpr (IN(0)) { p0_prologue(a, lds, vcu, G, wave, lane); }
    SEAM(0);
    if constexpr (IN(1)) {
        pg8::DenseSched S; S.o.init(T / 256, NPROJ / 256, G, bx); S.Bt = (const char*)(ws + WS_WIN); S.K = D;
        pg8::EpiProj<false> E{(bf16_t*)(ws + WS_PROJ), (float*)(ws + WS_KMP)};
        pg8::gemm_phase(lds, (const char*)(ws + WS_H), D, D, D, S, E);
    }
    SEAM(1);
    if constexpr (IN(2)) { for (int u = vcu; u < NB * 32; u += G) gla_prep_unit(a, lds, u); }
    SEAM(2);
    if constexpr (IN(3)) { for (int u = vcu; u < 512; u += G) gla_combine_unit(a, u); }
    SEAM(3);
    if constexpr (IN(4)) {
        for (int u = vcu; u < 1024; u += G) gla_out_unit(a, lds, u);
        __syncthreads();
    }
    if constexpr (IN(5)) {
        for (int c = bx; c < 256; c += G) {
            moba::Seam S;
            moba::BlockRef cur = moba::make_ref(a, c); const moba::BlockRef second = moba::make_ref(a, 511 - c);
            moba::prime(cur, (char*)lds_raw, S);
            for (int pass = 0; pass < 2; ++pass) {
                moba::block(cur, second, a.in[2], (const float*)(ws + WS_KMP), (char*)lds_raw, S);
                cur = second;
            }
        }
    }
    SEAM(5);
    if constexpr (IN(6)) {
        pg8::ChainSched S; S.o.init(T / 256, D / 256, G, bx); S.Bt = (const char*)(ws + WS_WUP); S.K = 1024;
        pg8::EpiMerge E{(const bf16_t*)(ws + WS_PROJ), (bf16_t*)(ws + WS_Y)};
        pg8::gemm_phase(lds, (const char*)(ws + WS_OAB), 1024, 2048, 2048, S, E);
    }
    SEAM(6);
    if constexpr (IN(7)) {
        pg8::DenseSched S; S.o.init(T / 256, D / 256, G, bx); S.Bt = (const char*)(ws + WS_WO); S.K = D;
        pg8::EpiResF32 E{a.in[0], a.out};
        pg8::gemm_phase(lds, (const char*)(ws + WS_Y), D, D, D, S, E);
        __syncthreads();
        expert_convert(a, lds, vcu, G, wave, lane);
    }
    SEAM(7);
    if constexpr (IN(8)) { for (int u = vcu; u < T / 64; u += G) router_unit(a, lds, u); }
    SEAM(8);
    if constexpr (IN(9)) { moe_index(a, lds, vcu, G); }
    SEAM(9);
    if constexpr (IN(10)) {
        const int* tile_e = (const int*)(ws + WS_TILEE); const int ntile = __builtin_amdgcn_readfirstlane(tile_e[MAXTILES]);
        pg8::MoeSched<true> S; S.o.init(ntile, 8, G, bx); S.Bt = (const char*)(ws + WS_W1T); S.K = D; S.rows_per_e = 2048; S.tile_e = tile_e; S.row_tok = (const int*)(ws + WS_ROWTOK); S.es = 1;
        pg8::EpiGlu E{(unsigned char*)(ws + WS_HMID), (const float*)(ws + WS_RSTDS), a.in[15], a.in[17]};
        pg8::gemm_phase(lds, (const char*)(ws + WS_H), D, D, D, S, E);
    }
    SEAM(10);
    if constexpr (IN(11)) {
        const int* tile_e = (const int*)(ws + WS_TILEE); const int ntile = __builtin_amdgcn_readfirstlane(tile_e[MAXTILES]);
        pg8::MoeSched<false> S; S.o.init(ntile, 4, G, bx); S.Bt = (const char*)(ws + WS_W2T); S.K = FF; S.rows_per_e = 1024; S.tile_e = tile_e; S.row_tok = nullptr; S.es = 1;
        pg8::EpiBf16<0, true, true> E{(bf16_t*)(ws + WS_YROWS), D, a.in[19], D, 1.0f / 32.0f};
        pg8::gemm_phase(lds, (const char*)(ws + WS_HMID), FF, FF, FF, S, E);
    }
    SEAM(11);
    if constexpr (IN(12)) { combine_rows(a, vcu, G, wave, lane); }
    SEAM(12);
    if constexpr (IN(13)) {
        { pg8::DenseSched S; S.o.init(T / 256, D / 256, G, bx); S.Bt = (const char*)(ws + WS_WPG); S.K = D;
          pg8::EpiBf16<1, false> E{(bf16_t*)(ws + WS_PGATE), D, nullptr, 0, 1.0f};
          pg8::gemm_phase(lds, (const char*)(ws + WS_H), D, D, D, S, E); }
        __syncthreads();
        { pg8::DenseSched S; S.o.init(T / 256, D / 256, G, bx); S.Bt = (const char*)(ws + WS_WPP); S.K = 256;
          pg8::EpiBf16<0, false> E{(bf16_t*)(ws + WS_PPROJ), D, nullptr, 0, 1.0f};
          pg8::gemm_phase(lds, (const char*)(ws + WS_PB), 256, 256, 256, S, E); }
    }
    SEAM(13);
    if constexpr (IN(14)) { final_rows(a, vcu, G, wave, lane); }
#undef IN
#undef SEAM
#undef GRID_BAR
}

template <int LO, int HI> static void launch_range(const Args& a, int grid, hipStream_t stream) {
    static bool attr = false;
    if (!attr) { attr = true; if (hipFuncSetAttribute((const void*)hybrid_fwd<LO, HI>, hipFuncAttributeMaxDynamicSharedMemorySize, LDS_BYTES) != hipSuccess) fprintf(stderr, "kernel_launch: hipFuncSetAttribute failed\n"); }
    hipLaunchKernelGGL((hybrid_fwd<LO, HI>), dim3(grid), dim3(NTHREADS), LDS_BYTES, stream, a);
}
extern "C" void kernel_launch(void* const* d_in, const int* in_sizes, int n_in, void* d_out, int out_size, void* d_ws, size_t ws_size, hipStream_t stream) {
    static int grid = 0;
    if (grid == 0) {
        static const int expect[25] = {T * D, T * 256, 256, 1024, 1024 * D_IN, 16 * 512, 512, 256, 1048576, 1048576, 1048576, 1024, 32768, 32, 33554432, 32768, 33554432, 32768, 33554432, 32768, 1024, 1048576, 262144, 1024, 1024};
        bool okk = (n_in == 25);
        for (int i = 0; okk && i < 25; ++i) if (in_sizes[i] != expect[i]) { fprintf(stderr, "kernel_launch: input %d has %d elements, expected %d\n", i, in_sizes[i], expect[i]); okk = false; }
        if (!okk || out_size != T * D || ws_size < WS_END) { fprintf(stderr, "kernel_launch: unexpected shapes (n_in %d, in0 %d, out %d, ws %zu); nothing launched\n", n_in, n_in > 0 ? in_sizes[0] : -1, out_size, ws_size); grid = -1; return; }
        int dev = 0, cus = 0;
        if (hipGetDevice(&dev) != hipSuccess || hipDeviceGetAttribute(&cus, hipDeviceAttributeMultiprocessorCount, dev) != hipSuccess) { grid = -1; return; }
        grid = cus;
    }
    if (grid < 0) return;
    (void)hipMemsetAsync((char*)d_ws + WS_CTL, 0, CTL_ZERO_BYTES, stream);
    Args a{};
    for (int i = 0; i < 25; ++i) a.p.in[i] = (const float*)d_in[i];
    a.p.out = (float*)d_out; a.p.ws = (unsigned char*)d_ws;
#if MK_PER_PHASE
#ifndef MK_LAST
#define MK_LAST 14
#endif
#ifndef MK_REPEAT
#define MK_REPEAT 0
#endif
#define LR(k) do { if ((k) <= MK_LAST) for (int r_ = 0; r_ < 1 + ((MK_REPEAT >> (k)) & 1); ++r_) launch_range<(k), (k) + 1>(a, grid, stream); } while (0)
    LR(0); LR(1); LR(2); LR(3); LR(4); LR(5); LR(6); LR(7); LR(8); LR(9); LR(10); LR(11); LR(12); LR(13); LR(14);
#undef LR
#else
    launch_range<0, NPHASES>(a, grid, stream);
#endif
}
```

```cpp
#define MK_PER_PHASE 0
#define MK_REPEAT 0
#include <hip/hip_runtime.h>
#include <cstdio>
#include <cstdint>

#define LAS __attribute__((address_space(3)))
#define GAS __attribute__((address_space(1)))
typedef unsigned short bf16_t;
typedef short bf16x8 __attribute__((ext_vector_type(8)));
typedef short s16x4 __attribute__((ext_vector_type(4)));
typedef float f32x2 __attribute__((ext_vector_type(2)));
typedef float f32x4 __attribute__((ext_vector_type(4)));
typedef float f32x16 __attribute__((ext_vector_type(16)));
typedef unsigned u32x2 __attribute__((ext_vector_type(2)));
typedef unsigned u32x4 __attribute__((ext_vector_type(4)));
typedef int i32x4 __attribute__((ext_vector_type(4)));
typedef int i32x8 __attribute__((ext_vector_type(8)));
typedef GAS unsigned gu32;
#define RLX_AGENT __ATOMIC_RELAXED, __HIP_MEMORY_SCOPE_AGENT
#define LDS_WAIT() asm volatile("s_waitcnt lgkmcnt(0)" ::: "memory")
#define VM_WAIT() asm volatile("s_waitcnt vmcnt(0)" ::: "memory")

#ifndef MK_PER_PHASE
#define MK_PER_PHASE 0
#endif

constexpr int NB = 8, SEQ = 2048, T = NB * SEQ, D = 1024;
constexpr int NPROJ = 8192;
constexpr int C_QA = 0, C_KA = 512, C_VA = 1024, C_RA = 2048, C_QB = 3072, C_KB = 4096, C_VB = 5120, C_GA = 6144, C_GB = 7168;
constexpr int SRC_ALOW = 3072, D_IN = 8208;
constexpr int NE = 32, FF = 1024, MAXTILES = 288, MAXROWS = MAXTILES * 256;
constexpr float EPS = 1e-6f;
constexpr int NWAVES = 8, NTHREADS = 512;
constexpr int NPHASES = 15;

constexpr size_t MiB = 1u << 20;
constexpr size_t WS_CTL = 0, CTL_ZERO_BYTES = 1 * MiB;
constexpr size_t WS_SMALL = 1 * MiB;
constexpr size_t WS_KMP   = WS_SMALL;
constexpr size_t WS_DEC   = WS_KMP + 512 * 1024;
constexpr size_t WS_TOPE  = WS_DEC + 512 * 1024;
constexpr size_t WS_WTS   = WS_TOPE + 256 * 1024;
constexpr size_t WS_SLOT  = WS_WTS + 256 * 1024;
constexpr size_t WS_DEST  = WS_SLOT + 256 * 1024;
constexpr size_t WS_ROWTOK = WS_DEST + 256 * 1024;
constexpr size_t WS_RSTDS = WS_ROWTOK + 320 * 1024;
constexpr size_t WS_RSTD  = WS_RSTDS + 320 * 1024;
constexpr size_t WS_TILEE = WS_RSTD + 64 * 1024;
constexpr size_t WS_WALT  = WS_TILEE + 4 * 1024;
constexpr size_t WS_WRF   = WS_WALT + 32 * 1024;
static_assert(WS_WRF + 128 * 1024 <= 6 * MiB, "small map");
constexpr size_t WS_WO = 6 * MiB, WS_WPG = 8 * MiB, WS_WPP = 10 * MiB, WS_WUP = 12 * MiB, WS_WIN = 16 * MiB;
constexpr size_t WS_PB = 34 * MiB;
constexpr size_t WS_H  = 42 * MiB;
constexpr size_t WS_PROJ = 74 * MiB;
constexpr size_t WS_QG = 330 * MiB, WS_KG = 346 * MiB;
constexpr size_t WS_SLOC = 426 * MiB;
constexpr size_t WS_OAB = 362 * MiB;
constexpr size_t WS_H8 = 426 * MiB;
constexpr size_t WS_WIN8 = 442 * MiB;
constexpr size_t WS_Y = 330 * MiB;
constexpr size_t WS_W2T = 42 * MiB;
constexpr size_t WS_A2 = 330 * MiB;
constexpr size_t WS_HMID = 138 * MiB;
constexpr size_t WS_W1T = 426 * MiB;
constexpr size_t WS_YROWS = 282 * MiB;
constexpr size_t WS_PGATE = 74 * MiB, WS_PPROJ = 106 * MiB;
constexpr size_t WS_END = 506 * MiB;

constexpr int CW_BAR = 4096;
constexpr int CW_COUNTS = 16384;
constexpr int CW_QUEUE = 16384 + 64;

constexpr int RING_BYTES = 131072;
constexpr int LDSCTL_OFF = RING_BYTES, MISC_OFF = LDSCTL_OFF + 320;
constexpr int LDS_BYTES = 147456;

typedef __bf16 bf16v2_t __attribute__((ext_vector_type(2)));
__device__ __forceinline__ unsigned cvt_pk_bf16(float lo, float hi) { const f32x2 v = {lo, hi}; return __builtin_bit_cast(unsigned, __builtin_convertvector(v, bf16v2_t)); }
__device__ __forceinline__ unsigned pk4_fp8(float a, float b, float c, float d) { int w = 0; w = __builtin_amdgcn_cvt_pk_fp8_f32(a, b, w, false); w = __builtin_amdgcn_cvt_pk_fp8_f32(c, d, w, true); return (unsigned)w; }
__device__ __forceinline__ float bf2f(unsigned short s) { return __uint_as_float(((unsigned)s) << 16); }
__device__ __forceinline__ float bflo(unsigned w) { return __uint_as_float(w << 16); }
__device__ __forceinline__ float bfhi(unsigned w) { return __uint_as_float(w & 0xffff0000u); }
__device__ __forceinline__ float fsigmoid(float x) { return __builtin_amdgcn_rcpf(1.0f + __builtin_amdgcn_exp2f(-1.4426950408889634f * x)); }
__device__ __forceinline__ float wave_sum(float v) {
#pragma unroll
    for (int o = 1; o < 64; o <<= 1) v += __shfl_xor(v, o);
    return v;
}
__device__ __forceinline__ bf16x8 pack8(f32x4 a, f32x4 b) {
    u32x4 w = {cvt_pk_bf16(a[0], a[1]), cvt_pk_bf16(a[2], a[3]), cvt_pk_bf16(b[0], b[1]), cvt_pk_bf16(b[2], b[3])};
    return __builtin_bit_cast(bf16x8, w);
}

#define XB_TMO      128
#define XB_XCNT(j)  (256  + 64 * (j))
#define XB_XSUB(j)  (1280 + 64 * (j))
#define XB_XGEN(j)  (2304 + 64 * (j))
#define XB_TOP      3328
#define XB_TOPGEN   3392
#define XCD_BAR_WORDS 3456
#define XB_SPIN_CAP (1u << 18)

__device__ __forceinline__ unsigned xb_ld(unsigned* p)              { return __hip_atomic_load(p, __ATOMIC_RELAXED, __HIP_MEMORY_SCOPE_AGENT); }
__device__ __forceinline__ unsigned xb_add(unsigned* p, unsigned v) { return __hip_atomic_fetch_add(p, v, __ATOMIC_RELAXED, __HIP_MEMORY_SCOPE_AGENT); }
__device__ __forceinline__ unsigned xb_xcc_id() { return (unsigned)__builtin_amdgcn_s_getreg((3 << 11) | 20) & 0xFu; }
#define XB_SPIN(cond, bar) do { unsigned _sp = 0; while (cond) { __builtin_amdgcn_s_sleep(1); \
    if ((++_sp & 255u) == 0u) { if (xb_ld(&(bar)[XB_TMO])) break; if (_sp > XB_SPIN_CAP) { atomicAdd(&(bar)[XB_TMO], 1u); break; } } } } while (0)

struct XcdBarrier { unsigned* bar; unsigned x; volatile LAS unsigned* st; };

__device__ __forceinline__ XcdBarrier xcd_barrier_post(unsigned* bar, volatile LAS unsigned* st) {
    XcdBarrier b; b.bar = bar; b.x = xb_xcc_id(); b.st = st;
    if (threadIdx.x == 0) (void)xb_add(&bar[XB_XCNT(b.x)], 1u);
    return b;
}
__device__ __forceinline__ void xcd_barrier_complete(unsigned* bar, unsigned x, unsigned& nloc, unsigned& nx) {
    const unsigned G = gridDim.x * gridDim.y * gridDim.z;
    unsigned sum, cnt, mine, sp = 0u;
    for (;;) {
        sum = 0u; cnt = 0u; mine = 0u;
#pragma unroll
        for (unsigned j = 0; j < 16; ++j) { const unsigned c = xb_ld(&bar[XB_XCNT(j)]); sum += c; cnt += (c > 0u) ? 1u : 0u; mine = (j == x) ? c : mine; }
        if (sum == G) break;
        __builtin_amdgcn_s_sleep(1);
        if ((++sp & 255u) == 0u) { if (xb_ld(&bar[XB_TMO])) break; if (sp > XB_SPIN_CAP) { atomicAdd(&bar[XB_TMO], 1u); break; } }
    }
    nloc = mine > 0u ? mine : 1u; nx = cnt > 0u ? cnt : 1u;
}
__device__ __forceinline__ void xcd_barrier(const XcdBarrier& b) {
    asm volatile("s_waitcnt vmcnt(0)" ::: "memory");
    __syncthreads();
    if (threadIdx.x == 0) {
        unsigned* bar = b.bar;
        __builtin_amdgcn_s_waitcnt(0);
        unsigned nloc = b.st[0], nx = b.st[1];
        if (nloc == 0u) { xcd_barrier_complete(bar, b.x, nloc, nx); b.st[0] = nloc; b.st[1] = nx; }
        const unsigned old = xb_add(&bar[XB_XSUB(b.x)], 1u);
        const unsigned gen = old / nloc;
        if (old + 1u == (gen + 1u) * nloc) {
            __builtin_amdgcn_fence(__ATOMIC_RELEASE, "agent");
            asm volatile("s_waitcnt vmcnt(0)" ::: "memory");
            const unsigned og = xb_add(&bar[XB_TOP], 1u);
            const unsigned tg = og / nx;
            if (og + 1u == (tg + 1u) * nx) xb_add(&bar[XB_TOPGEN], 1u);
            else XB_SPIN(xb_ld(&bar[XB_TOPGEN]) == tg, bar);
            __builtin_amdgcn_fence(__ATOMIC_ACQUIRE, "agent");
            xb_add(&bar[XB_XGEN(b.x)], 1u);
            asm volatile("s_waitcnt vmcnt(0)" ::: "memory");
        } else {
            XB_SPIN(xb_ld(&bar[XB_XGEN(b.x)]) == gen, bar);
            __builtin_amdgcn_fence(__ATOMIC_ACQUIRE, "agent");
            asm volatile("s_waitcnt vmcnt(0)" ::: "memory");
        }
    }
    __syncthreads();
}
namespace pg8 {
constexpr int BM = 256, BK = 64, HALF = 128, HTB = HALF * BK * 2, STAGE_BYTES = 8 * HTB, NXCD = 8, WGM = 8;

__host__ __device__ __forceinline__ int lds_byte(int r, int c) { const int st = (r >> 4) * 2 + (c >> 5), rr = r & 15, cc = c & 31, ob = rr * 64 + cc * 2; return st * 1024 + (ob ^ (((ob >> 9) & 1) << 5)); }
__host__ __device__ __forceinline__ void stage_rc(int b, int& R, int& C) { const int st = b / 1024, sb = b % 1024, swz = sb ^ (((sb >> 9) & 1) << 5); R = (st >> 1) * 16 + swz / 64; C = (st & 1) * 32 + (swz % 64) / 2; }
__host__ __device__ __forceinline__ int perm32(int rho) { const int n = rho >> 4, i = rho & 15; return 8 * (i >> 2) + 4 * n + (i & 3); }

struct Unit { int pm, pn, e; };

struct TileOrder {
    int nM, nN, nwg, G, c;
    __device__ __forceinline__ void init(int nM_, int nN_, int G_, int c_) { nM = nM_; nN = nN_; nwg = nM * nN; G = G_; c = c_; }
    __device__ __forceinline__ bool next(int i, int& pm, int& pn) const {
        const long L = (long)i * G + c; if (L >= nwg) return false;
        int wgid = (int)L; { const int q = nwg / NXCD, r = nwg % NXCD, xcd = wgid % NXCD, off = wgid / NXCD; wgid = (xcd < r ? xcd * (q + 1) : r * (q + 1) + (xcd - r) * q) + off; }
        const int nig = WGM * nN, gid = wgid / nig, fm = gid * WGM, gsz = (nM - fm) < WGM ? (nM - fm) : WGM;
        pm = fm + ((wgid % nig) % gsz); pn = (wgid % nig) / gsz; return true;
    }
};
struct DenseSched {
    TileOrder o; const char* Bt; int K; int es = 2; int gap_at = 1 << 30, gap_by = 0, pn0 = 0; bool bt_out = true;
    __device__ __forceinline__ bool next(int i, Unit& u) const { int p; if (!o.next(i, u.pm, p)) return false; u.e = p; u.pn = p + (p >= gap_at ? gap_by : 0) + pn0; return true; }
    __device__ __forceinline__ unsigned a_row(const Unit& u, int r) const { return (unsigned)(u.pm * BM + r); }
    __device__ __forceinline__ unsigned a_koff(const Unit&) const { return 0u; }
    __device__ __forceinline__ const char* b_base(const Unit& u) const { return Bt + (size_t)(bt_out ? u.pn : u.e) * BM * K * es; }
};
struct ChainSched {
    TileOrder o; const char* Bt; int K;
    __device__ __forceinline__ bool next(int i, Unit& u) const { if (!o.next(i >> 1, u.pm, u.pn)) return false; u.e = i & 1; return true; }
    __device__ __forceinline__ unsigned a_row(const Unit& u, int r) const { return (unsigned)(u.pm * BM + r); }
    __device__ __forceinline__ unsigned a_koff(const Unit& u) const { return (unsigned)(u.e * K * 2); }
    __device__ __forceinline__ const char* b_base(const Unit& u) const { return Bt + (size_t)u.pn * BM * (2 * K) * 2 + (size_t)u.e * K * 2; }
};
template <bool GATHER> struct MoeSched {
    TileOrder o; const char* Bt; int K; int rows_per_e; const int* tile_e; const int* row_tok; int es;
    __device__ __forceinline__ bool next(int i, Unit& u) const { if (!o.next(i, u.pm, u.pn)) return false; u.e = __builtin_amdgcn_readfirstlane(tile_e[u.pm]); return true; }
    __device__ __forceinline__ unsigned a_row(const Unit& u, int r) const { if (GATHER) return (unsigned)row_tok[u.pm * BM + r]; else return (unsigned)(u.pm * BM + r); }
    __device__ __forceinline__ unsigned a_koff(const Unit&) const { return 0u; }
    __device__ __forceinline__ const char* b_base(const Unit& u) const { return Bt + ((size_t)u.e * rows_per_e + (size_t)u.pn * BM) * K * es; }
};

template <class Epi, class Sched>
__device__ __forceinline__ void gemm_phase(LAS unsigned char* lds, const char* gA, int K_, int lda, int ldb, const Sched& S, const Epi& E) {
    int K = K_; asm volatile("" : "+s"(K));
    int tid = threadIdx.x; asm volatile("" : "+v"(tid));     const int wid = __builtin_amdgcn_readfirstlane(tid >> 6), lane = tid & 63, wr = wid >> 2, wc = wid & 3, fr = lane & 15, fq = lane >> 4;
    constexpr int ES = Epi::F8 ? 1 : 2;
    const int nt = K * ES / 128;
    unsigned voffB[2];
#pragma unroll
    for (int i = 0; i < 2; ++i) { int R, C; stage_rc(tid * 16 + i * 8192, R, C); const int Rb = Epi::PERM ? ((R & ~31) + perm32(R & 31)) : R; voffB[i] = (unsigned)(Rb * ldb * ES + C * 2); }
    const unsigned kstep = (unsigned)(BK * 2);
    const size_t hstepB = (size_t)HALF * ldb * ES;
    const unsigned ldab = (unsigned)lda * ES;
    const unsigned ldsw = (unsigned)wid * 1024u;
    const int aoff = lds_byte(wr * 64 + fr, fq * 8), boff = lds_byte(wc * 32 + fr, fq * 8);
#define PG8_SA(b, h) (((b) * 2 + (h)) * HTB)
#define PG8_SB(b, h) ((4 + (b) * 2 + (h)) * HTB)
#define PG8_STAGE_B(bufoff, gbase) do { _Pragma("unroll") for (int _i = 0; _i < 2; ++_i) \
        __builtin_amdgcn_global_load_lds((const unsigned*)((const char*)(gbase) + voffB[_i]), (LAS unsigned*)(lds + (bufoff) + ldsw + _i * 8192), 16, 0, 0); } while (0)
#define PG8_STAGE_A(bufoff, o0, o1, kb) do { \
        const char* gk_ = gA + (kb);      \
        __builtin_amdgcn_global_load_lds((const unsigned*)(gk_ + (o0)), (LAS unsigned*)(lds + (bufoff) + ldsw), 16, 0, 0); \
        __builtin_amdgcn_global_load_lds((const unsigned*)(gk_ + (o1)), (LAS unsigned*)(lds + (bufoff) + ldsw + 8192), 16, 0, 0); } while (0)
#define PG8_LDA(dst, b, h) do { _Pragma("unroll") for (int m = 0; m < 4; ++m) _Pragma("unroll") for (int k = 0; k < 2; ++k) dst[m][k] = *(const LAS bf16x8*)(lds + PG8_SA(b, h) + aoff + m * 2048 + k * 1024); } while (0)
#define PG8_LDB(dst, b, h) do { _Pragma("unroll") for (int n = 0; n < 2; ++n) _Pragma("unroll") for (int k = 0; k < 2; ++k) dst[n][k] = *(const LAS bf16x8*)(lds + PG8_SB(b, h) + boff + n * 2048 + k * 1024); } while (0)
#define PG8_MMA(ai, bj, At, Bt) do { __builtin_amdgcn_s_setprio(1); \
        if constexpr (Epi::F8) { _Pragma("unroll") for (int m = 0; m < 4; ++m) _Pragma("unroll") for (int n = 0; n < 2; ++n) { \
            const i32x8 a8_ = __builtin_shufflevector(__builtin_bit_cast(i32x4, At[m][0]), __builtin_bit_cast(i32x4, At[m][1]), 0, 1, 2, 3, 4, 5, 6, 7); \
            const i32x8 b8_ = __builtin_shufflevector(__builtin_bit_cast(i32x4, Bt[n][0]), __builtin_bit_cast(i32x4, Bt[n][1]), 0, 1, 2, 3, 4, 5, 6, 7); \
            acc[ai][bj][m][n] = __builtin_amdgcn_mfma_scale_f32_16x16x128_f8f6f4(b8_, a8_, acc[ai][bj][m][n], 0, 0, 0, 0x7F7F7F7F, 0, 0x7F7F7F7F); } } \
        else { _Pragma("unroll") for (int m = 0; m < 4; ++m) _Pragma("unroll") for (int n = 0; n < 2; ++n) _Pragma("unroll") for (int k = 0; k < 2; ++k) \
            acc[ai][bj][m][n] = __builtin_amdgcn_mfma_f32_16x16x32_bf16(Bt[n][k], At[m][k], acc[ai][bj][m][n], 0, 0, 0); } \
        __builtin_amdgcn_s_setprio(0); } while (0)
#define PG8_WAIT_V(n) asm volatile("s_waitcnt vmcnt(" #n ")" ::: "memory")
#define PG8_WAIT_L(n) asm volatile("s_waitcnt lgkmcnt(" #n ")" ::: "memory")
#define PG8_BAR __builtin_amdgcn_s_barrier()
#define PG8_SCHED __builtin_amdgcn_sched_barrier(0)
#define PG8_AOFFS(dst, u) do { _Pragma("unroll") for (int _h = 0; _h < 2; ++_h) _Pragma("unroll") for (int _i = 0; _i < 2; ++_i) { int R_, C_; stage_rc(tid * 16 + _i * 8192, R_, C_); \
        dst[_h][_i] = S.a_row(u, _h * HALF + R_) * ldab + (unsigned)C_ * 2u + S.a_koff(u); } } while (0)
    Unit cur, nxt; int ui = 0;
    if (!S.next(0, cur)) return;
    f32x4 acc[2][2][4][2];
#pragma unroll
    for (int a = 0; a < 2; ++a)
#pragma unroll
        for (int b = 0; b < 2; ++b)
#pragma unroll
            for (int m = 0; m < 4; ++m)
#pragma unroll
                for (int n = 0; n < 2; ++n) acc[a][b][m][n] = (f32x4){0.f, 0.f, 0.f, 0.f};
    bf16x8 At[4][2], B0[2][2], B1[2][2];
    unsigned oc[2][2];
    LAS u32x4* nslot = (LAS u32x4*)(lds + LDSCTL_OFF + 2048) + tid;
    PG8_AOFFS(oc, cur);
    const char* cB = S.b_base(cur);
    PG8_STAGE_B(PG8_SB(0, 0), cB); PG8_STAGE_B(PG8_SB(0, 1), cB + hstepB); PG8_STAGE_A(PG8_SA(0, 0), oc[0][0], oc[0][1], 0u); PG8_STAGE_A(PG8_SA(0, 1), oc[1][0], oc[1][1], 0u);
    if (wr == 1) PG8_BAR;
    PG8_WAIT_V(2); PG8_BAR;
    PG8_STAGE_B(PG8_SB(1, 0), cB + kstep); PG8_STAGE_A(PG8_SA(1, 0), oc[0][0], oc[0][1], kstep); PG8_STAGE_B(PG8_SB(1, 1), cB + hstepB + kstep);
    PG8_WAIT_V(6); PG8_BAR;
    for (;;) {
        const bool has_next = S.next(ui + 1, nxt);
        const char* nB = has_next ? S.b_base(nxt) : cB;
        if (has_next) { unsigned on[2][2]; PG8_AOFFS(on, nxt); *nslot = (u32x4){on[0][0], on[0][1], on[1][0], on[1][1]}; }
        for (int t = 0; t < nt; t += 2) {
            const bool last = (t == nt - 2);
            const unsigned k1 = (unsigned)(t + 1) * kstep;
            const unsigned k2 = last ? 0u : (unsigned)(t + 2) * kstep, k3 = k2 + kstep;
            const char* b2 = last ? nB : cB + (size_t)(t + 2) * kstep; const char* b3 = b2 + kstep;
            PG8_LDB(B0, 0, 0); PG8_LDB(B1, 0, 1); PG8_SCHED; PG8_LDA(At, 0, 0); PG8_STAGE_A(PG8_SA(1, 1), oc[1][0], oc[1][1], k1);
            PG8_WAIT_V(8); PG8_WAIT_L(0); PG8_BAR; PG8_MMA(0, 0, At, B0); PG8_MMA(0, 1, At, B1); PG8_BAR; PG8_SCHED;
            if (last && has_next) { const u32x4 o_ = *nslot; oc[0][0] = o_.x; oc[0][1] = o_.y; oc[1][0] = o_.z; oc[1][1] = o_.w; }
            PG8_LDA(At, 0, 1); PG8_STAGE_B(PG8_SB(0, 0), b2); PG8_STAGE_B(PG8_SB(0, 1), b2 + hstepB); PG8_STAGE_A(PG8_SA(0, 0), oc[0][0], oc[0][1], k2);
            PG8_WAIT_V(8); PG8_WAIT_L(0); PG8_BAR; PG8_MMA(1, 0, At, B0); PG8_MMA(1, 1, At, B1); PG8_BAR; PG8_SCHED;
            PG8_LDB(B0, 1, 0); PG8_LDB(B1, 1, 1); PG8_SCHED; PG8_LDA(At, 1, 0); PG8_STAGE_A(PG8_SA(0, 1), oc[1][0], oc[1][1], k2);
            PG8_WAIT_V(8); PG8_WAIT_L(0); PG8_BAR; PG8_MMA(0, 0, At, B0); PG8_MMA(0, 1, At, B1); PG8_BAR; PG8_SCHED;
            PG8_LDA(At, 1, 1); PG8_STAGE_B(PG8_SB(1, 0), b3); PG8_STAGE_B(PG8_SB(1, 1), b3 + hstepB); PG8_STAGE_A(PG8_SA(1, 0), oc[0][0], oc[0][1], k3);
            PG8_WAIT_V(8); PG8_WAIT_L(0); PG8_BAR; PG8_MMA(1, 0, At, B0); PG8_MMA(1, 1, At, B1); PG8_BAR; PG8_SCHED;
        }
        if (wr == 0) PG8_BAR;
        bool carry = false;
        if constexpr (Epi::MIDK) { if (cur.e == 0) { E.mid(acc, cur, wr, wc, fr, fq); carry = true; } else E(acc, cur, wr, wc, fr, fq); } else E(acc, cur, wr, wc, fr, fq);
        if (!has_next) break;
        if (!carry)
#pragma unroll
        for (int a = 0; a < 2; ++a)
#pragma unroll
            for (int b = 0; b < 2; ++b)
#pragma unroll
                for (int m = 0; m < 4; ++m)
#pragma unroll
                    for (int n = 0; n < 2; ++n) acc[a][b][m][n] = (f32x4){0.f, 0.f, 0.f, 0.f};
        cur = nxt; cB = nB; ++ui;
        if (wr == 1) PG8_BAR;
    }
    PG8_WAIT_V(0);
    PG8_BAR;
#undef PG8_SA
#undef PG8_SB
#undef PG8_STAGE_A
#undef PG8_STAGE_B
#undef PG8_LDA
#undef PG8_LDB
#undef PG8_MMA
#undef PG8_WAIT_V
#undef PG8_WAIT_L
#undef PG8_BAR
#undef PG8_SCHED
#undef PG8_AOFFS
}

template <bool F8_> struct EpiProj {
    static constexpr bool PERM = true, MIDK = false, F8 = F8_;
    bf16_t* O; float* kmp;
    __device__ __forceinline__ void operator()(const f32x4 (&acc)[2][2][4][2], const Unit& u, int wr, int wc, int fr, int fq) const {
        const int row0 = u.pm * BM + wr * 64 + fr; const int col0 = u.pn * BM + wc * 32 + 8 * fq;
#pragma unroll
        for (int ai = 0; ai < 2; ++ai)
#pragma unroll
            for (int m = 0; m < 4; ++m) { bf16_t* rowp = O + (size_t)(row0 + ai * HALF + m * 16) * NPROJ + col0;
#pragma unroll
                for (int bj = 0; bj < 2; ++bj) { const float sc = F8 ? (1.0f / 32.0f) : 1.0f; const f32x4 v0 = acc[ai][bj][m][0] * sc, v1 = acc[ai][bj][m][1] * sc;
                    u32x4 w; w.x = cvt_pk_bf16(v0[0], v0[1]); w.y = cvt_pk_bf16(v0[2], v0[3]); w.z = cvt_pk_bf16(v1[0], v1[1]); w.w = cvt_pk_bf16(v1[2], v1[3]);
                    *(u32x4*)(rowp + bj * HALF) = w; } }
        if (u.pn >= C_KB / BM && u.pn < C_VB / BM) {
#pragma unroll
            for (int bj = 0; bj < 2; ++bj)
#pragma unroll
                for (int n = 0; n < 2; ++n) { f32x4 s = (f32x4){0.f, 0.f, 0.f, 0.f};
#pragma unroll
                    for (int ai = 0; ai < 2; ++ai)
#pragma unroll
                        for (int m = 0; m < 4; ++m) s += acc[ai][bj][m][n];
#pragma unroll
                    for (int o = 1; o < 16; o <<= 1) { s[0] += __shfl_xor(s[0], o); s[1] += __shfl_xor(s[1], o); s[2] += __shfl_xor(s[2], o); s[3] += __shfl_xor(s[3], o); }
                    if (fr == 0) *(f32x4*)(kmp + ((size_t)wr * 64 + u.pm) * 1024 + (u.pn - C_KB / BM) * BM + bj * HALF + wc * 32 + 8 * fq + 4 * n) = s * (F8 ? (1.0f / 32.0f) : 1.0f); }
        }
    }
};
struct EpiMerge {
    static constexpr bool PERM = true, MIDK = true, F8 = false;
    const bf16_t* proj; bf16_t* Y;
    __device__ __forceinline__ void mid(f32x4 (&acc)[2][2][4][2], const Unit& u, int wr, int wc, int fr, int fq) const {
        const int row0 = u.pm * BM + wr * 64 + fr; const int col0 = u.pn * BM + wc * 32 + 8 * fq;
#pragma unroll
        for (int ai = 0; ai < 2; ++ai)
#pragma unroll
            for (int m = 0; m < 4; ++m) { const bf16_t* rowp = proj + (size_t)(row0 + ai * HALF + m * 16) * NPROJ + col0;
#pragma unroll
                for (int bj = 0; bj < 2; ++bj) { const u32x4 ga = *(const u32x4*)(rowp + C_GA + bj * HALF), gb = *(const u32x4*)(rowp + C_GB + bj * HALF);
#pragma unroll
                    for (int j = 0; j < 4; ++j) { const float a0 = bflo(ga[j]), a1 = bfhi(ga[j]), b0 = bflo(gb[j]), b1 = bfhi(gb[j]);
                        const float r0 = (1.0f + __builtin_amdgcn_exp2f(-1.4426950408889634f * b0)) * __builtin_amdgcn_rcpf(1.0f + __builtin_amdgcn_exp2f(-1.4426950408889634f * a0));
                        const float r1 = (1.0f + __builtin_amdgcn_exp2f(-1.4426950408889634f * b1)) * __builtin_amdgcn_rcpf(1.0f + __builtin_amdgcn_exp2f(-1.4426950408889634f * a1));
                        acc[ai][bj][m][j >> 1][(j & 1) * 2] *= r0; acc[ai][bj][m][j >> 1][(j & 1) * 2 + 1] *= r1; } }
                asm volatile("" : "+v"(acc[ai][0][m][0]), "+v"(acc[ai][0][m][1]), "+v"(acc[ai][1][m][0]), "+v"(acc[ai][1][m][1]));
                asm volatile("" ::: "memory"); }
    }
    __device__ __forceinline__ void operator()(const f32x4 (&acc)[2][2][4][2], const Unit& u, int wr, int wc, int fr, int fq) const {
        const int row0 = u.pm * BM + wr * 64 + fr; const int col0 = u.pn * BM + wc * 32 + 8 * fq;
#pragma unroll
        for (int ai = 0; ai < 2; ++ai)
#pragma unroll
            for (int m = 0; m < 4; ++m) { const size_t r = (size_t)(row0 + ai * HALF + m * 16);
#pragma unroll
                for (int bj = 0; bj < 2; ++bj) { const u32x4 gb = *(const u32x4*)(proj + r * NPROJ + C_GB + col0 + bj * HALF);
                    const f32x4 v0 = acc[ai][bj][m][0], v1 = acc[ai][bj][m][1];
                    u32x4 w; w.x = cvt_pk_bf16(v0[0] * fsigmoid(bflo(gb[0])), v0[1] * fsigmoid(bfhi(gb[0]))); w.y = cvt_pk_bf16(v0[2] * fsigmoid(bflo(gb[1])), v0[3] * fsigmoid(bfhi(gb[1])));
                    w.z = cvt_pk_bf16(v1[0] * fsigmoid(bflo(gb[2])), v1[1] * fsigmoid(bfhi(gb[2]))); w.w = cvt_pk_bf16(v1[2] * fsigmoid(bflo(gb[3])), v1[3] * fsigmoid(bfhi(gb[3])));
                    *(u32x4*)(Y + r * D + col0 + bj * HALF) = w; }
                asm volatile("" ::: "memory"); }
    }
};
struct EpiResF32 {
    static constexpr bool PERM = false, MIDK = false, F8 = false;
    const float* base; float* out;
    __device__ __forceinline__ void operator()(const f32x4 (&acc)[2][2][4][2], const Unit& u, int wr, int wc, int fr, int fq) const {
        const int row0 = u.pm * BM + wr * 64 + fr, col0 = u.pn * BM + wc * 32 + 4 * fq;
#pragma unroll
        for (int ai = 0; ai < 2; ++ai)
#pragma unroll
            for (int m = 0; m < 4; ++m) { const size_t off = (size_t)(row0 + ai * HALF + m * 16) * D + col0;
#pragma unroll
                for (int bj = 0; bj < 2; ++bj)
#pragma unroll
                    for (int n = 0; n < 2; ++n) *(f32x4*)(out + off + bj * HALF + n * 16) = *(const f32x4*)(base + off + bj * HALF + n * 16) + acc[ai][bj][m][n];
                asm volatile("" ::: "memory"); }
    }
};
struct EpiGlu {
    static constexpr bool PERM = true, MIDK = false, F8 = true;
    unsigned char* H; const float* rstd_s; const float* bg; const float* bu;
    __device__ __forceinline__ void operator()(const f32x4 (&acc)[2][2][4][2], const Unit& u, int wr, int wc, int fr, int fq) const {
        const int row0 = u.pm * BM + wr * 64 + fr; const int colo = u.pn * HALF + wc * 32 + 8 * fq;
        f32x4 g4[2], u4[2];
#pragma unroll
        for (int n = 0; n < 2; ++n) { g4[n] = *(const f32x4*)(bg + (size_t)u.e * FF + colo + 4 * n); u4[n] = *(const f32x4*)(bu + (size_t)u.e * FF + colo + 4 * n); }
#pragma unroll
        for (int ai = 0; ai < 2; ++ai)
#pragma unroll
            for (int m = 0; m < 4; ++m) { const int r = row0 + ai * HALF + m * 16; const float rs = rstd_s[r] * (1.0f / 32.0f);
                float o[8];
#pragma unroll
                for (int n = 0; n < 2; ++n)
#pragma unroll
                    for (int j = 0; j < 4; ++j) { float g = acc[ai][0][m][n][j] * rs + g4[n][j], up = acc[ai][1][m][n][j] * rs + u4[n][j];
                        g = fminf(g, 7.0f); up = fminf(fmaxf(up, -7.0f), 7.0f);
                        const float glu = g * fsigmoid(1.702f * g); o[n * 4 + j] = (up + 1.0f) * glu; }
                u32x2 w; w.x = pk4_fp8(o[0], o[1], o[2], o[3]); w.y = pk4_fp8(o[4], o[5], o[6], o[7]);
                *(u32x2*)(H + (size_t)r * FF + colo) = w; asm volatile("" ::: "memory"); }
    }
};
template <int ACT, bool HASBIAS, bool F8_ = false> struct EpiBf16 {
    static constexpr bool PERM = true, MIDK = false, F8 = F8_;
    bf16_t* O; int ldc; const float* bias; int bias_stride; float scale;
    __device__ __forceinline__ void operator()(const f32x4 (&acc)[2][2][4][2], const Unit& u, int wr, int wc, int fr, int fq) const {
        const int row0 = u.pm * BM + wr * 64 + fr; const int col0 = u.pn * BM + wc * 32 + 8 * fq;
        f32x4 bv[2][2];
#pragma unroll
        for (int bj = 0; bj < 2; ++bj)
#pragma unroll
            for (int n = 0; n < 2; ++n) bv[bj][n] = HASBIAS ? *(const f32x4*)(bias + (size_t)u.e * bias_stride + col0 + bj * HALF + 4 * n) : (f32x4){0.f, 0.f, 0.f, 0.f};
#pragma unroll
        for (int ai = 0; ai < 2; ++ai)
#pragma unroll
            for (int m = 0; m < 4; ++m) { bf16_t* rowp = O + (size_t)(row0 + ai * HALF + m * 16) * ldc + col0;
#pragma unroll
                for (int bj = 0; bj < 2; ++bj) { f32x4 v0 = acc[ai][bj][m][0] * scale + bv[bj][0], v1 = acc[ai][bj][m][1] * scale + bv[bj][1];
                    if (ACT == 1) {
#pragma unroll
                        for (int j = 0; j < 4; ++j) { v0[j] = fsigmoid(v0[j]); v1[j] = fsigmoid(v1[j]); } }
                    u32x4 w; w.x = cvt_pk_bf16(v0[0], v0[1]); w.y = cvt_pk_bf16(v0[2], v0[3]); w.z = cvt_pk_bf16(v1[0], v1[1]); w.w = cvt_pk_bf16(v1[2], v1[3]);
                    *(u32x4*)(rowp + bj * HALF) = w; }
                asm volatile("" ::: "memory"); }
    }
};
}
__device__ __forceinline__ void transpose_item(const float* __restrict__ W, int ldw, int k0, int n_src0, bf16_t* __restrict__ WT, int ldo, int n_dst0, int k_off, LAS float* scr, int lane) {
    { float t_[32]; const float* wp_ = W + (size_t)(k0 + (lane >> 5)) * ldw + n_src0 + (lane & 31);
#pragma unroll
    for (int i = 0; i < 32; ++i) t_[i] = wp_[(size_t)(2 * i) * ldw];
#pragma unroll
    for (int i = 0; i < 32; ++i) scr[(2 * i + (lane >> 5)) * 33 + (lane & 31)] = t_[i]; }
    LDS_WAIT(); asm volatile("" ::: "memory");
    const int c = lane & 7;
#pragma unroll
    for (int j = 0; j < 4; ++j) { const int n = (lane >> 3) + 8 * j; const LAS float* s = scr + (8 * c) * 33 + n;
        u32x4 o; o.x = cvt_pk_bf16(s[0 * 33], s[1 * 33]); o.y = cvt_pk_bf16(s[2 * 33], s[3 * 33]); o.z = cvt_pk_bf16(s[4 * 33], s[5 * 33]); o.w = cvt_pk_bf16(s[6 * 33], s[7 * 33]);
        *(u32x4*)(WT + (size_t)(n_dst0 + n) * ldo + k_off + k0 + 8 * c) = o; }
    LDS_WAIT(); asm volatile("" ::: "memory");
}
__device__ __forceinline__ void transpose_item_f8(const float* __restrict__ W, int ldw, int k0, int n_src0, unsigned char* __restrict__ WT, int ldo, int n_dst0, float sc, LAS float* scr, int lane) {
    { float t_[32]; const float* wp_ = W + (size_t)(k0 + (lane >> 5)) * ldw + n_src0 + (lane & 31);
#pragma unroll
    for (int i = 0; i < 32; ++i) t_[i] = wp_[(size_t)(2 * i) * ldw];
#pragma unroll
    for (int i = 0; i < 32; ++i) scr[(2 * i + (lane >> 5)) * 33 + (lane & 31)] = t_[i]; }
    LDS_WAIT(); asm volatile("" ::: "memory");
    const int c = lane & 7;
#pragma unroll
    for (int j = 0; j < 4; ++j) { const int n = (lane >> 3) + 8 * j; const LAS float* s = scr + (8 * c) * 33 + n;
        u32x2 o; o.x = pk4_fp8(s[0 * 33] * sc, s[1 * 33] * sc, s[2 * 33] * sc, s[3 * 33] * sc); o.y = pk4_fp8(s[4 * 33] * sc, s[5 * 33] * sc, s[6 * 33] * sc, s[7 * 33] * sc);
        *(u32x2*)(WT + (size_t)(n_dst0 + n) * ldo + k0 + 8 * c) = o; }
    LDS_WAIT(); asm volatile("" ::: "memory");
}
__device__ __forceinline__ void transpose_mat_item(const float* W, int ldw, int N, int n_src_base, bf16_t* WT, int ldo, int n_dst_base, int k_off, LAS float* scr, int item, int lane) {
    const int nblk = N / 32, kb = item / nblk, nb = item % nblk;
    transpose_item(W, ldw, 64 * kb, n_src_base + 32 * nb, WT, ldo, n_dst_base + 32 * nb, k_off, scr, lane);
}

struct P {
    const float* in[25]; float* out; unsigned char* ws;
};

__device__ __forceinline__ void p0_prologue(const P& a, LAS unsigned char* lds, int vcu, int G, int wave, int lane) {
    LAS float* scr = (LAS float*)(lds + wave * 16384);
    const int gw = vcu * NWAVES + wave, NGW = G * NWAVES;
    unsigned char* ws = a.ws;
    bf16_t* WinT = (bf16_t*)(ws + WS_WIN); bf16_t* WupT = (bf16_t*)(ws + WS_WUP); bf16_t* WoT = (bf16_t*)(ws + WS_WO); bf16_t* WpgT = (bf16_t*)(ws + WS_WPG); bf16_t* WppT = (bf16_t*)(ws + WS_WPP);
    constexpr int I_A = 16 * 96, I_B = 16 * 160, I_S = 16 * 32, I_P = 4 * 32;
    constexpr int NITEMS = I_A + I_B + 4 * I_S + I_P;
#ifndef P0_PARTS
#define P0_PARTS 63
#endif
    if (P0_PARTS & 1)
    for (int it = gw; it < NITEMS; it += NGW) {
        int r = it;
        if (r < I_A) { transpose_mat_item(a.in[4], D_IN, 3072, 0, WinT, D, 0, 0, scr, r, lane); continue; } r -= I_A;
        if (r < I_B) { transpose_mat_item(a.in[4], D_IN, 5120, 3088, WinT, D, 3072, 0, scr, r, lane); continue; } r -= I_B;
        if (r < I_S) { transpose_mat_item(a.in[8], D, D, 0, WupT, 2048, 0, 0, scr, r, lane); continue; } r -= I_S;
        if (r < I_S) { transpose_mat_item(a.in[9], D, D, 0, WupT, 2048, 0, 1024, scr, r, lane); continue; } r -= I_S;
        if (r < I_S) { transpose_mat_item(a.in[10], D, D, 0, WoT, D, 0, 0, scr, r, lane); continue; } r -= I_S;
        if (r < I_S) { transpose_mat_item(a.in[21], D, D, 0, WpgT, D, 0, 0, scr, r, lane); continue; } r -= I_S;
        transpose_mat_item(a.in[22], D, D, 0, WppT, 256, 0, 0, scr, r, lane);
    }
    if (P0_PARTS & 2) {
        const float* x = a.in[0]; const float* g = a.in[3]; bf16_t* H = (bf16_t*)(ws + WS_H);
        f32x4 gv[4];
#pragma unroll
        for (int j = 0; j < 4; ++j) gv[j] = *((const f32x4*)g + lane + 64 * j);
        for (int m = gw; m < T; m += NGW) {
            const f32x4* xr = (const f32x4*)(x + (size_t)m * D) + lane; f32x4 v[4]; float s = 0.f;
#pragma unroll
            for (int j = 0; j < 4; ++j) { v[j] = xr[64 * j]; s += (v[j].x * v[j].x + v[j].y * v[j].y) + (v[j].z * v[j].z + v[j].w * v[j].w); }
            const float rstd = 1.0f / sqrtf(wave_sum(s) * (1.0f / D) + EPS);
            u32x2* o8 = (u32x2*)(H + (size_t)m * D) + lane;
#pragma unroll
            for (int j = 0; j < 4; ++j) { const f32x4 y = v[j] * rstd * gv[j]; u32x2 w; w.x = cvt_pk_bf16(y.x, y.y); w.y = cvt_pk_bf16(y.z, y.w); o8[64 * j] = w; }
        }
    }
    if (P0_PARTS & 4) {
        const f32x4* p4 = (const f32x4*)a.in[1]; u32x2* pb = (u32x2*)(ws + WS_PB);
        const size_t n4 = (size_t)T * 256 / 4;
        for (size_t i = (size_t)gw * 64 + lane; i < n4; i += (size_t)NGW * 64) { const f32x4 v = p4[i]; u32x2 w; w.x = cvt_pk_bf16(v.x, v.y); w.y = cvt_pk_bf16(v.z, v.w); pb[i] = w; }
    }
    if (P0_PARTS & 8) {
        const int gt = (vcu * NWAVES + wave) * 64 + lane;
        if ((P0_PARTS & 16) && gt < 16 * 1024) { const int n = gt >> 10, k = gt & 1023; ((bf16_t*)(ws + WS_WALT))[n * 1024 + k] = (bf16_t)(cvt_pk_bf16(a.in[4][(size_t)k * D_IN + SRC_ALOW + n], 0.f) & 0xffffu); }
        if ((P0_PARTS & 32) && gt < 4096) { const int s = gt >> 6, l = gt & 63, e = l & 31, hh = l >> 5; const float* wr = a.in[12];
            float v[8], lo[8];
#pragma unroll
            for (int j = 0; j < 8; ++j) { v[j] = wr[(size_t)(16 * s + 8 * hh + j) * NE + e]; }
            u32x4 whi; whi.x = cvt_pk_bf16(v[0], v[1]); whi.y = cvt_pk_bf16(v[2], v[3]); whi.z = cvt_pk_bf16(v[4], v[5]); whi.w = cvt_pk_bf16(v[6], v[7]);
#pragma unroll
            for (int j = 0; j < 4; ++j) { lo[2 * j] = v[2 * j] - bflo(whi[j]); lo[2 * j + 1] = v[2 * j + 1] - bfhi(whi[j]); }
            u32x4 wlo; wlo.x = cvt_pk_bf16(lo[0], lo[1]); wlo.y = cvt_pk_bf16(lo[2], lo[3]); wlo.z = cvt_pk_bf16(lo[4], lo[5]); wlo.w = cvt_pk_bf16(lo[6], lo[7]);
            u32x4* f = (u32x4*)(ws + WS_WRF); f[gt] = whi; f[4096 + gt] = wlo; }
    }
}

struct CvtItem { const float* src; unsigned char* dst; int ldo; };
__device__ __forceinline__ CvtItem cvt_item(const P& a, int it, int lane) {
    constexpr int IPM = 16 * 32;
    const int e = it / (3 * IPM), r0 = it % (3 * IPM), which = r0 / IPM, r = r0 % IPM, kb = r / 32, nb = r % 32, n0 = 32 * nb;
    CvtItem c;
    if (which < 2) { c.src = a.in[which == 0 ? 14 : 16] + (size_t)e * D * FF + (size_t)(64 * kb + (lane >> 5)) * FF + n0 + (lane & 31);
        c.dst = a.ws + WS_W1T + ((size_t)e * 2048 + (n0 >> 7) * 256 + (n0 & 127) + which * 128) * D + 64 * kb; c.ldo = D; }
    else { c.src = a.in[18] + (size_t)e * FF * D + (size_t)(64 * kb + (lane >> 5)) * D + n0 + (lane & 31);
        c.dst = a.ws + WS_W2T + ((size_t)e * D + n0) * FF + 64 * kb; c.ldo = FF; }
    return c;
}
__device__ __forceinline__ void expert_convert(const P& a, LAS unsigned char* lds, int vcu, int G, int wave, int lane) {
    LAS float* scr = (LAS float*)(lds + wave * 16384);
    const int gw = vcu * NWAVES + wave, NGW = G * NWAVES;
    constexpr int NIT = NE * 3 * 16 * 32;
    if (gw >= NIT) return;
    float tA[32], tB[32];
    CvtItem cA = cvt_item(a, gw, lane), cB = cvt_item(a, gw + NGW < NIT ? gw + NGW : gw, lane);
#pragma unroll
    for (int i = 0; i < 32; ++i) tA[i] = __builtin_nontemporal_load(cA.src + (size_t)(2 * i) * 1024);
#pragma unroll
    for (int i = 0; i < 32; ++i) tB[i] = __builtin_nontemporal_load(cB.src + (size_t)(2 * i) * 1024);
#define CVT_OUT(c_) do { LDS_WAIT(); asm volatile("" ::: "memory"); const int c = lane & 7; \
        _Pragma("unroll") for (int j = 0; j < 4; ++j) { const int n = (lane >> 3) + 8 * j; const LAS float* s = scr + (8 * c) * 33 + n; \
            u32x2 o; o.x = pk4_fp8(s[0 * 33] * 32.0f, s[1 * 33] * 32.0f, s[2 * 33] * 32.0f, s[3 * 33] * 32.0f); o.y = pk4_fp8(s[4 * 33] * 32.0f, s[5 * 33] * 32.0f, s[6 * 33] * 32.0f, s[7 * 33] * 32.0f); \
            __builtin_nontemporal_store(o, (u32x2*)((c_).dst + (size_t)n * (c_).ldo + 8 * c)); } \
        LDS_WAIT(); asm volatile("" ::: "memory"); } while (0)
    for (int it = gw; it < NIT; it += 2 * NGW) {
#pragma unroll
        for (int i = 0; i < 32; ++i) scr[(2 * i + (lane >> 5)) * 33 + (lane & 31)] = tA[i];
        const CvtItem dA = cA; const int n2 = it + 2 * NGW;
        if (n2 < NIT) { cA = cvt_item(a, n2, lane);
#pragma unroll
            for (int i = 0; i < 32; ++i) tA[i] = __builtin_nontemporal_load(cA.src + (size_t)(2 * i) * 1024); }
        CVT_OUT(dA);
        if (it + NGW >= NIT) break;
#pragma unroll
        for (int i = 0; i < 32; ++i) scr[(2 * i + (lane >> 5)) * 33 + (lane & 31)] = tB[i];
        const CvtItem dB = cB; const int n3 = it + 3 * NGW;
        if (n3 < NIT) { cB = cvt_item(a, n3, lane);
#pragma unroll
            for (int i = 0; i < 32; ++i) tB[i] = __builtin_nontemporal_load(cB.src + (size_t)(2 * i) * 1024); }
        CVT_OUT(dB);
    }
#undef CVT_OUT
}

__device__ __forceinline__ float fexp_(float x) { return __builtin_amdgcn_exp2f(x * 1.4426950408889634f); }
__device__ __forceinline__ float logsigmoidf_(float x) { const float e = fexp_(-fabsf(x)); return fminf(x, 0.0f) - 0.6931471805599453f * __builtin_amdgcn_logf(1.0f + e); }
__device__ __forceinline__ void gla_prep_unit(const P& a, LAS unsigned char* lds, int unit) {
    int tid = threadIdx.x; asm volatile("" : "+v"(tid));     const int wave = __builtin_amdgcn_readfirstlane(tid >> 6), lane = tid & 63;
    const int b = unit >> 5, chunk = unit & 31, tok0 = b * SEQ + chunk * 64;
    const bf16_t* H = (const bf16_t*)(a.ws + WS_H); const bf16_t* WalT = (const bf16_t*)(a.ws + WS_WALT); const bf16_t* proj = (const bf16_t*)(a.ws + WS_PROJ);
    LAS float* part = (LAS float*)lds;
    LAS float* alow = (LAS float*)(lds + 8192);
    LAS float* seg = (LAS float*)(lds + 12288);
    constexpr int GP_KDT = 16384, GP_VT = 34816;
    {
        const int rg = wave & 3, kh = wave >> 2, r = lane & 15, q = lane >> 4;
        f32x4 acc = (f32x4){0.f, 0.f, 0.f, 0.f};
        const bf16_t* ap = H + (size_t)(tok0 + 16 * rg + r) * D + 512 * kh + 8 * q; const bf16_t* bp = WalT + (size_t)r * D + 512 * kh + 8 * q;
#pragma unroll 4
        for (int s = 0; s < 16; ++s) { const bf16x8 av = *(const bf16x8*)(ap + 32 * s), bv = *(const bf16x8*)(bp + 32 * s); acc = __builtin_amdgcn_mfma_f32_16x16x32_bf16(bv, av, acc, 0, 0, 0); }
        *(LAS f32x4*)(part + (kh * 64 + 16 * rg + r) * 16 + 4 * q) = acc;
    }
    __syncthreads();
    if (tid < 256) { *(LAS f32x4*)(alow + tid * 4) = *(LAS f32x4*)(part + tid * 4) + *(LAS f32x4*)(part + 1024 + tid * 4); }
    __syncthreads();
    const int dp = tid & 63, tq = wave;
    const float* w_a2 = a.in[5]; const float* b_a2 = a.in[6];
    for (int h = 0; h < 4; ++h) {
        const int dcol = h * 128 + 2 * dp;
        f32x2 w2[16];
#pragma unroll
        for (int r = 0; r < 16; ++r) w2[r] = *(const f32x2*)(w_a2 + r * 512 + dcol);
        const f32x2 b2 = *(const f32x2*)(b_a2 + dcol);
        unsigned qv[8], kv[8];
#pragma unroll
        for (int i = 0; i < 8; ++i) { const bf16_t* rp = proj + (size_t)(tok0 + 8 * tq + i) * NPROJ + dcol; qv[i] = *(const unsigned*)(rp + C_QA); kv[i] = *(const unsigned*)(rp + C_KA); }
        float G0[8], G1[8]; float r0 = 0.f, r1 = 0.f;
#pragma unroll
        for (int i = 0; i < 8; ++i) { const LAS f32x4* al4 = (const LAS f32x4*)(alow + (8 * tq + i) * 16); float x0 = b2.x, x1 = b2.y;
#pragma unroll
            for (int r4 = 0; r4 < 4; ++r4) { const f32x4 al = al4[r4];
#pragma unroll
                for (int j = 0; j < 4; ++j) { x0 += al[j] * w2[4 * r4 + j].x; x1 += al[j] * w2[4 * r4 + j].y; } }
            r0 += logsigmoidf_(x0) * (1.0f / 16.0f); r1 += logsigmoidf_(x1) * (1.0f / 16.0f); G0[i] = r0; G1[i] = r1; }
        *(LAS f32x2*)(seg + tq * 128 + 2 * dp) = (f32x2){r0, r1};
        __syncthreads();
        float off0 = 0.f, off1 = 0.f, tot0 = 0.f, tot1 = 0.f;
#pragma unroll
        for (int q = 0; q < 8; ++q) { const f32x2 s = *(LAS f32x2*)(seg + q * 128 + 2 * dp); tot0 += s.x; tot1 += s.y; if (q < tq) { off0 += s.x; off1 += s.y; } }
        const size_t tile = (size_t)((b * 4 + h) * 32 + chunk);
        bf16_t* Qg = (bf16_t*)(a.ws + WS_QG) + tile * 8192; bf16_t* Kg = (bf16_t*)(a.ws + WS_KG) + tile * 8192;
        float kd0[8], kd1[8];
#pragma unroll
        for (int i = 0; i < 8; ++i) { const float g0 = G0[i] + off0, g1 = G1[i] + off1; const float q0 = bflo(qv[i]), q1 = bfhi(qv[i]), k0 = bflo(kv[i]), k1 = bfhi(kv[i]);
            const float e0 = fexp_(g0), e1 = fexp_(g1);
            *(unsigned*)(Qg + (8 * tq + i) * 128 + 2 * dp) = cvt_pk_bf16(q0 * e0 * 0.08838834764831845f, q1 * e1 * 0.08838834764831845f);
            *(unsigned*)(Kg + (8 * tq + i) * 128 + 2 * dp) = cvt_pk_bf16(k0 * __builtin_amdgcn_rcpf(e0), k1 * __builtin_amdgcn_rcpf(e1));
            kd0[i] = k0 * fexp_(tot0 - g0); kd1[i] = k1 * fexp_(tot1 - g1); }
        u32x4 w0, w1; w0.x = cvt_pk_bf16(kd0[0], kd0[1]); w0.y = cvt_pk_bf16(kd0[2], kd0[3]); w0.z = cvt_pk_bf16(kd0[4], kd0[5]); w0.w = cvt_pk_bf16(kd0[6], kd0[7]);
        w1.x = cvt_pk_bf16(kd1[0], kd1[1]); w1.y = cvt_pk_bf16(kd1[2], kd1[3]); w1.z = cvt_pk_bf16(kd1[4], kd1[5]); w1.w = cvt_pk_bf16(kd1[6], kd1[7]);
        *(LAS u32x4*)(lds + GP_KDT + (2 * dp) * 144 + 16 * tq) = w0; *(LAS u32x4*)(lds + GP_KDT + (2 * dp + 1) * 144 + 16 * tq) = w1;
        if (tq == 0) *(f32x2*)((float*)(a.ws + WS_DEC) + tile * 128 + 2 * dp) = (f32x2){fexp_(tot0), fexp_(tot1)};
        {
            const int ep = tid & 127, sq4 = tid >> 7; unsigned sv[16];
            const bf16_t* v_ = proj + (size_t)(tok0 + 16 * sq4) * NPROJ + C_VA + h * 256 + 2 * ep;
#pragma unroll
            for (int i = 0; i < 16; ++i) sv[i] = *(const unsigned*)(v_ + (size_t)i * NPROJ);
            u32x4 lo0, lo1, hi0, hi1;
#pragma unroll
            for (int j = 0; j < 4; ++j) { lo0[j] = (sv[2 * j] & 0xffffu) | (sv[2 * j + 1] << 16); lo1[j] = (sv[8 + 2 * j] & 0xffffu) | (sv[8 + 2 * j + 1] << 16);
                hi0[j] = (sv[2 * j] >> 16) | (sv[2 * j + 1] & 0xffff0000u); hi1[j] = (sv[8 + 2 * j] >> 16) | (sv[8 + 2 * j + 1] & 0xffff0000u); }
            LAS unsigned char* v0 = lds + GP_VT + (2 * ep) * 144 + sq4 * 32;
            *(LAS u32x4*)(v0) = lo0; *(LAS u32x4*)(v0 + 16) = lo1; *(LAS u32x4*)(v0 + 144) = hi0; *(LAS u32x4*)(v0 + 144 + 16) = hi1;
        }
        __syncthreads();
        {
            const int c32 = lane & 31, hi = lane >> 5;
            bf16x8 vt[4];
#pragma unroll
            for (int ks = 0; ks < 4; ++ks) vt[ks] = *(const LAS bf16x8*)(lds + GP_VT + (32 * wave + c32) * 144 + (16 * ks + 8 * hi) * 2);
            u32x2* sl = (u32x2*)(a.ws + WS_SLOC) + tile * 8192;
#pragma unroll
            for (int tl = 0; tl < 4; ++tl) { f32x16 acc;
#pragma unroll
                for (int r = 0; r < 16; ++r) acc[r] = 0.f;
#pragma unroll
                for (int ks = 0; ks < 4; ++ks) { const bf16x8 av = *(const LAS bf16x8*)(lds + GP_KDT + (32 * tl + c32) * 144 + (16 * ks + 8 * hi) * 2); acc = __builtin_amdgcn_mfma_f32_32x32x16_bf16(av, vt[ks], acc, 0, 0, 0); }
#pragma unroll
                for (int g = 0; g < 4; ++g) { u32x2 w; w.x = cvt_pk_bf16(acc[4 * g], acc[4 * g + 1]); w.y = cvt_pk_bf16(acc[4 * g + 2], acc[4 * g + 3]); sl[((tl * 4 + g) * 2 + hi) * 256 + 32 * wave + c32] = w; } }
        }
        __syncthreads();
    }
}

__device__ __forceinline__ void gla_combine_unit(const P& a, int unit) {
    const int tid = threadIdx.x, bh = unit >> 4, i8 = (unit & 15) * 512 + tid;
    const int d0 = 32 * (i8 >> 11) + 8 * ((i8 >> 9) & 3) + 4 * ((i8 >> 8) & 1);
    u32x2* sl = (u32x2*)(a.ws + WS_SLOC) + (size_t)bh * 32 * 8192 + i8; const f32x4* dc = (const f32x4*)((const float*)(a.ws + WS_DEC) + (size_t)bh * 32 * 128 + d0);
    f32x4 s = (f32x4){0.f, 0.f, 0.f, 0.f};
    for (int cb = 0; cb < 32; cb += 8) {
        u32x2 loc[8]; f32x4 dv[8];
#pragma unroll
        for (int i = 0; i < 8; ++i) { loc[i] = sl[(size_t)(cb + i) * 8192]; dv[i] = dc[(cb + i) * 32]; }
#pragma unroll
        for (int i = 0; i < 8; ++i) { if (cb + i < 31) { s.x = dv[i].x * s.x + bflo(loc[i].x); s.y = dv[i].y * s.y + bfhi(loc[i].x); s.z = dv[i].z * s.z + bflo(loc[i].y); s.w = dv[i].w * s.w + bfhi(loc[i].y);
            u32x2 w; w.x = cvt_pk_bf16(s.x, s.y); w.y = cvt_pk_bf16(s.z, s.w); sl[(size_t)(cb + i) * 8192] = w; } }
    }
}

constexpr int GL_QG = 0, GL_KG = 17408, GL_VT = 53248, GL_AM = 90112, GL_OST = 0;
constexpr int GL_QS = 272, GL_TS = 144, GL_OS = 528;
__device__ __forceinline__ int crow(int r, int hi) { return (r & 3) + 8 * (r >> 2) + 4 * hi; }
__device__ __forceinline__ void gla_out_unit(const P& a, LAS unsigned char* lds, int unit) {
    int tid = threadIdx.x; asm volatile("" : "+v"(tid)); const int w = __builtin_amdgcn_readfirstlane(tid >> 6), lane = tid & 63, c32 = lane & 31, hi = lane >> 5;
    const int bh = unit >> 5, chunk = unit & 31, b = bh >> 2, h = bh & 3;
    const bf16_t* proj = (const bf16_t*)(a.ws + WS_PROJ); bf16_t* oab = (bf16_t*)(a.ws + WS_OAB); const float* ggo = a.in[7];
    const size_t tile = (size_t)bh * 32 + chunk;
    {
        const u32x4* q_ = (const u32x4*)((const bf16_t*)(a.ws + WS_QG) + tile * 8192); const u32x4* k_ = (const u32x4*)((const bf16_t*)(a.ws + WS_KG) + tile * 8192);
        u32x4 sq[2], sk[2]; unsigned sv[16];
        sq[0] = q_[tid]; sq[1] = q_[tid + 512]; sk[0] = k_[tid]; sk[1] = k_[tid + 512];
        const int ep = tid & 127, sq4 = tid >> 7;
        const bf16_t* v_ = proj + (size_t)(b * SEQ + chunk * 64 + 16 * sq4) * NPROJ + C_VA + h * 256 + 2 * ep;
#pragma unroll
        for (int i = 0; i < 16; ++i) sv[i] = *(const unsigned*)(v_ + (size_t)i * NPROJ);
#pragma unroll
        for (int i = 0; i < 2; ++i) { const int p = tid + 512 * i;
            *(LAS u32x4*)(lds + GL_QG + (p >> 4) * GL_QS + (p & 15) * 16) = sq[i]; *(LAS u32x4*)(lds + GL_KG + (p >> 4) * GL_QS + (p & 15) * 16) = sk[i]; }
        u32x4 lo0, lo1, hi0, hi1;
#pragma unroll
        for (int j = 0; j < 4; ++j) { lo0[j] = (sv[2 * j] & 0xffffu) | (sv[2 * j + 1] << 16); lo1[j] = (sv[8 + 2 * j] & 0xffffu) | (sv[8 + 2 * j + 1] << 16);
            hi0[j] = (sv[2 * j] >> 16) | (sv[2 * j + 1] & 0xffff0000u); hi1[j] = (sv[8 + 2 * j] >> 16) | (sv[8 + 2 * j + 1] & 0xffff0000u); }
        LAS unsigned char* v0 = lds + GL_VT + (2 * ep) * GL_TS + sq4 * 32;
        *(LAS u32x4*)(v0) = lo0; *(LAS u32x4*)(v0 + 16) = lo1; *(LAS u32x4*)(v0 + GL_TS) = hi0; *(LAS u32x4*)(v0 + GL_TS + 16) = hi1;
    }
    u32x2 sf[4][2][2];
    if (chunk > 0) { const u32x2* sl = (const u32x2*)(a.ws + WS_SLOC) + (tile - 1) * 8192;
#pragma unroll
        for (int tl = 0; tl < 4; ++tl)
#pragma unroll
            for (int s = 0; s < 2; ++s)
#pragma unroll
                for (int q = 0; q < 2; ++q) sf[tl][s][q] = sl[((tl * 4 + 2 * s + q) * 2 + hi) * 256 + 32 * w + c32]; }
    __syncthreads();
    if (w < 3) {
        const int ti = (w + 1) >> 1, si = w >> 1;
        f32x16 A;
#pragma unroll
        for (int r = 0; r < 16; ++r) A[r] = 0.f;
#pragma unroll
        for (int s = 0; s < 8; ++s) { const bf16x8 av = *(const LAS bf16x8*)(lds + GL_QG + (32 * ti + c32) * GL_QS + (16 * s + 8 * hi) * 2), bv = *(const LAS bf16x8*)(lds + GL_KG + (32 * si + c32) * GL_QS + (16 * s + 8 * hi) * 2);
            A = __builtin_amdgcn_mfma_f32_32x32x16_bf16(av, bv, A, 0, 0, 0); }
        const int sidx = 32 * si + c32;
#pragma unroll
        for (int r = 0; r < 16; ++r) { const int t = 32 * ti + crow(r, hi); const float v = (sidx <= t) ? A[r] : 0.f;
            *(LAS bf16_t*)(lds + GL_AM + t * GL_TS + sidx * 2) = (bf16_t)(cvt_pk_bf16(v, 0.f) & 0xffffu); }
    }
    __syncthreads();
    f32x16 o[2];
    {
        bf16x8 vt[4];
#pragma unroll
        for (int ks = 0; ks < 4; ++ks) vt[ks] = *(const LAS bf16x8*)(lds + GL_VT + (32 * w + c32) * GL_TS + (16 * ks + 8 * hi) * 2);
#pragma unroll
        for (int ti = 0; ti < 2; ++ti) {
#pragma unroll
            for (int r = 0; r < 16; ++r) o[ti][r] = 0.f;
            if (chunk > 0) {
#pragma unroll
                for (int tl = 0; tl < 4; ++tl)
#pragma unroll
                    for (int s = 0; s < 2; ++s) { const LAS unsigned char* qp = lds + GL_QG + (32 * ti + c32) * GL_QS + (32 * tl + 16 * s + 4 * hi) * 2;
                        const s16x4 lo = *(const LAS s16x4*)qp, hh = *(const LAS s16x4*)(qp + 16);
                        const bf16x8 aop = __builtin_shufflevector(lo, hh, 0, 1, 2, 3, 4, 5, 6, 7);
                        const u32x4 bw = {sf[tl][s][0].x, sf[tl][s][0].y, sf[tl][s][1].x, sf[tl][s][1].y};
                        o[ti] = __builtin_amdgcn_mfma_f32_32x32x16_bf16(aop, __builtin_bit_cast(bf16x8, bw), o[ti], 0, 0, 0); }
            }
#pragma unroll
            for (int ks = 0; ks < 4; ++ks) { if (ti == 0 && ks >= 2) continue;
                const bf16x8 av = *(const LAS bf16x8*)(lds + GL_AM + (32 * ti + c32) * GL_TS + (16 * ks + 8 * hi) * 2);
                o[ti] = __builtin_amdgcn_mfma_f32_32x32x16_bf16(av, vt[ks], o[ti], 0, 0, 0); }
        }
    }
    __syncthreads();
#pragma unroll
    for (int ti = 0; ti < 2; ++ti)
#pragma unroll
        for (int r = 0; r < 16; ++r) *(LAS bf16_t*)(lds + GL_OST + (32 * ti + crow(r, hi)) * GL_OS + (32 * w + c32) * 2) = (bf16_t)(cvt_pk_bf16(o[ti][r], 0.f) & 0xffffu);
    __syncthreads();
    {
        const int t = tid >> 3, sg = tid & 7; const size_t tok = (size_t)(b * SEQ + chunk * 64 + t);
        u32x4 ov[4]; float ss = 0.f;
#pragma unroll
        for (int j = 0; j < 4; ++j) { ov[j] = *(const LAS u32x4*)(lds + GL_OST + t * GL_OS + sg * 64 + j * 16);
#pragma unroll
            for (int i = 0; i < 4; ++i) { const float x0 = bflo(ov[j][i]), x1 = bfhi(ov[j][i]); ss += x0 * x0 + x1 * x1; } }
        ss += __shfl_xor(ss, 1); ss += __shfl_xor(ss, 2); ss += __shfl_xor(ss, 4);
        const float rstd = 1.0f / sqrtf(ss * (1.0f / 256.0f) + EPS);
        const bf16_t* rap = proj + tok * NPROJ + C_RA + h * 256 + sg * 32; bf16_t* op = oab + tok * 2048 + h * 256 + sg * 32; const float* gp = ggo + sg * 32;
#pragma unroll
        for (int j = 0; j < 4; ++j) { const u32x4 ra = *(const u32x4*)(rap + 8 * j); const f32x4 g0 = *(const f32x4*)(gp + 8 * j), g1 = *(const f32x4*)(gp + 8 * j + 4); u32x4 wv;
#pragma unroll
            for (int i = 0; i < 4; ++i) { const float r0 = bflo(ra[i]), r1 = bfhi(ra[i]); const float ga = (i < 2) ? g0[2 * i] : g1[2 * i - 4], gb = (i < 2) ? g0[2 * i + 1] : g1[2 * i - 3];
                wv[i] = cvt_pk_bf16(bflo(ov[j][i]) * rstd * ga * (r0 * fsigmoid(r0)), bfhi(ov[j][i]) * rstd * gb * (r1 * fsigmoid(r1))); }
            *(u32x4*)(op + 8 * j) = wv; }
    }
    __syncthreads();
}
namespace moba {
constexpr int HD = 128;
constexpr float SCALE = 0.08838834764831845f;
constexpr float THR = 8.f;
constexpr int NW = 8, QBLK = 32, KVBLK = 64, QB = NW * QBLK;
constexpr int SHM_V = KVBLK * HD * 2, SHM_K = KVBLK * HD * 2;
constexpr int OFF_WS = 2 * SHM_V + 2 * SHM_K;
constexpr int OFF_RTAB = OFF_WS + NW * 64 * 4;
constexpr int OFF_KM = OFF_RTAB + 2304 * 4;
constexpr int OFF_MISC = OFF_KM + 8 * 128 * 4;
constexpr int OFF_SEL = OFF_MISC + 64;
constexpr int LDS_BYTES = OFF_SEL + 2048;
constexpr int LDP = NPROJ, LDO = 2048;

#define KSWZ(row, colB) ((row) * 256 + ((colB) ^ (((row) & 7) << 4)))
#define SBAR() __builtin_amdgcn_sched_barrier(0)
__device__ __forceinline__ int v_st(int k, int c) { const int kk = (k & ~0xC) | ((k & 4) << 1) | ((k & 8) >> 1); return ((kk >> 3) * 4 + (c >> 5)) * 512 + ((kk & 7) * 32 + (c & 31)) * 2; }
__device__ __forceinline__ int v_rd_base(int lane) { return ((lane & 3) << 3) | (((lane >> 2) & 3) << 6) | (((lane >> 4) & 1) << 5) | (((lane >> 5) & 1) << 8); }
constexpr int v_rd_off(int d0, int ks, int half) { return d0 * 512 + ks * 4096 + half * 2048; }
__device__ __forceinline__ int crow(int r, int hi) { return (r & 3) + 8 * (r >> 2) + 4 * hi; }
__device__ __forceinline__ unsigned cvtpk(float lo, float hi) { unsigned r; asm volatile("v_cvt_pk_bf16_f32 %0, %1, %2" : "=v"(r) : "v"(lo), "v"(hi)); return r; }

__device__ __forceinline__ void mask_tile(f32x16& p0, f32x16& p1, int dq) {
    const float NEG = -__builtin_inff();
#pragma unroll
    for (int r = 0; r < 16; ++r) {
        const int c = (r & 3) + 8 * (r >> 2);
        if (dq - c < 0) p0[r] = NEG;
        if (dq - c - 32 < 0) p1[r] = NEG;
    }
}
__device__ __forceinline__ void bias_tile(f32x16& p0, f32x16& p1, const LAS float* rt) {
#pragma unroll
    for (int r = 0; r < 16; ++r) { const int c = (r & 3) + 8 * (r >> 2); p0[r] += rt[c]; p1[r] += rt[c + 32]; }
}
__device__ __forceinline__ void kill_tile(f32x16& p0, f32x16& p1) {
    const float NEG = -__builtin_inff();
#pragma unroll
    for (int r = 0; r < 16; ++r) { p0[r] = NEG; p1[r] = NEG; }
}
__device__ __forceinline__ void partialSM(f32x16& p0, f32x16& p1, float& m_reg, float& mn, float& alpha) {
    float pmax = p0[0];
#pragma unroll
    for (int r = 1; r < 16; ++r) pmax = fmaxf(pmax, p0[r]);
#pragma unroll
    for (int r = 0; r < 16; ++r) pmax = fmaxf(pmax, p1[r]);
    { auto rr = __builtin_amdgcn_permlane32_swap(__float_as_uint(pmax), __float_as_uint(pmax), false, false);
      pmax = fmaxf(__uint_as_float(rr[0]), __uint_as_float(rr[1])); }
    constexpr float C2 = 1.4426950408889634f * SCALE;
    if (__builtin_expect(__all((pmax - m_reg) * SCALE <= THR), 1)) { mn = m_reg; alpha = 1.f; }
    else { mn = fmaxf(m_reg, pmax); alpha = __builtin_amdgcn_exp2f((m_reg - mn) * C2); m_reg = mn; }
    const float mnL = -mn * C2;
#pragma unroll
    for (int r = 0; r < 16; ++r) p0[r] = fmaf(p0[r], C2, mnL);
#pragma unroll
    for (int r = 0; r < 16; ++r) p1[r] = fmaf(p1[r], C2, mnL);
#pragma unroll
    for (int r = 0; r < 16; ++r) p0[r] = __builtin_amdgcn_exp2f(p0[r]);
}
__device__ __forceinline__ void finishSM(f32x16& p0, f32x16& p1, float alpha, float& l_reg, bf16x8& pa0, bf16x8& pa1, bf16x8& pa2, bf16x8& pa3) {
#pragma unroll
    for (int r = 0; r < 16; ++r) p1[r] = __builtin_amdgcn_exp2f(p1[r]);
    float ps = 0;
#pragma unroll
    for (int r = 0; r < 16; ++r) ps += p0[r];
#pragma unroll
    for (int r = 0; r < 16; ++r) ps += p1[r];
    { auto rr = __builtin_amdgcn_permlane32_swap(__float_as_uint(ps), __float_as_uint(ps), false, false);
      ps = __uint_as_float(rr[0]) + __uint_as_float(rr[1]); }
    l_reg = l_reg * alpha + ps;
#define PK4(P, B_, OUT) do { unsigned a0 = cvtpk(P[B_+0], P[B_+1]), a1 = cvtpk(P[B_+2], P[B_+3]);                          \
        unsigned b0 = cvtpk(P[B_+4], P[B_+5]), b1 = cvtpk(P[B_+6], P[B_+7]);                                             \
        auto r0 = __builtin_amdgcn_permlane32_swap(a0, b0, false, false); auto r1 = __builtin_amdgcn_permlane32_swap(a1, b1, false, false); \
        u32x4 w = {r0[0], r1[0], r0[1], r1[1]}; OUT = __builtin_bit_cast(bf16x8, w); } while (0)
    PK4(p0, 0, pa0); PK4(p0, 8, pa1); PK4(p1, 0, pa2); PK4(p1, 8, pa3);
#undef PK4
}
template <int KB>
__device__ __forceinline__ void qkt(f32x16& p0, f32x16& p1, const char* K_lds, int r32, int hi, const bf16x8* qr) {
#pragma unroll
    for (int r = 0; r < 16; ++r) { p0[r] = 0.f; p1[r] = 0.f; }
    const char* kb[4];
#pragma unroll
    for (int dd = 0; dd < 4; ++dd) kb[dd] = K_lds + KB * SHM_K + KSWZ(r32, (dd * 16 + hi * 8) * 2);
#pragma unroll
    for (int d0 = 0; d0 < 8; ++d0) { const char* a = kb[d0 & 3] + (d0 >> 2) * 128;
        bf16x8 b0 = *reinterpret_cast<const bf16x8*>(a);
        bf16x8 b1 = *reinterpret_cast<const bf16x8*>(a + 32 * 256);
        p0 = __builtin_amdgcn_mfma_f32_32x32x16_bf16(b0, qr[d0], p0, 0, 0, 0);
        p1 = __builtin_amdgcn_mfma_f32_32x32x16_bf16(b1, qr[d0], p1, 0, 0, 0); }
}
template <int VB>
__device__ __forceinline__ void pv_tile(f32x16* o, int vb0, bf16x8 pa0, bf16x8 pa1, bf16x8 pa2, bf16x8 pa3) {
#define TRRD(dst, off) asm volatile("ds_read_b64_tr_b16 %0, %1 offset:%2" : "=&v"(dst) : "v"(vb0), "i"(off) : "memory")
#define PV_D0(d0) do { s16x4 l0, l1, l2, l3, h0, h1, h2, h3; constexpr int b_ = VB * SHM_V + v_rd_off(d0, 0, 0);   \
        TRRD(l0, b_); TRRD(h0, b_ + 2048); TRRD(l1, b_ + 4096); TRRD(h1, b_ + 6144); TRRD(l2, b_ + 8192); TRRD(h2, b_ + 10240); TRRD(l3, b_ + 12288); TRRD(h3, b_ + 14336); \
        asm volatile("s_waitcnt lgkmcnt(0)" ::: "memory"); SBAR();   \
        o[d0] = __builtin_amdgcn_mfma_f32_32x32x16_bf16(pa0, (bf16x8){l0[0], l0[1], l0[2], l0[3], h0[0], h0[1], h0[2], h0[3]}, o[d0], 0, 0, 0);   \
        o[d0] = __builtin_amdgcn_mfma_f32_32x32x16_bf16(pa1, (bf16x8){l1[0], l1[1], l1[2], l1[3], h1[0], h1[1], h1[2], h1[3]}, o[d0], 0, 0, 0);   \
        o[d0] = __builtin_amdgcn_mfma_f32_32x32x16_bf16(pa2, (bf16x8){l2[0], l2[1], l2[2], l2[3], h2[0], h2[1], h2[2], h2[3]}, o[d0], 0, 0, 0);   \
        o[d0] = __builtin_amdgcn_mfma_f32_32x32x16_bf16(pa3, (bf16x8){l3[0], l3[1], l3[2], l3[3], h3[0], h3[1], h3[2], h3[3]}, o[d0], 0, 0, 0); } while (0)
    PV_D0(0); PV_D0(1); PV_D0(2); PV_D0(3);
#undef PV_D0
#undef TRRD
}

struct BlockRef { const bf16_t* Q; const bf16_t* K; const bf16_t* V; bf16_t* O; int qb; int b, h; };
struct Seam { bf16x8 qr[8]; bf16x8 st_v0, st_v1, st_k0, st_k1; };
#define VMW() asm volatile("s_waitcnt vmcnt(0)" ::: "memory")
#define VMWN(n) asm volatile("s_waitcnt vmcnt(%0)" :: "i"(n) : "memory")
#define LD8(p) (*reinterpret_cast<const bf16x8*>(p))
#define SLOAD_H(Kp, Vp, k0) do { const char* kb__ = (const char*)(Kp) + (size_t)(k0) * (LDP * 2); \
        S.st_v0 = LD8(kb__ + 2048 + kvoff); S.st_v1 = LD8(kb__ + (32 * LDP * 2 + 2048) + kvoff); S.st_k0 = LD8(kb__ + kvoff); S.st_k1 = LD8(kb__ + 32 * LDP * 2 + kvoff); } while (0)
#define SWRITE_HK(bf) do { *(bf16x8*)(K_lds + (bf) * SHM_K + kws) = S.st_k0; *(bf16x8*)(K_lds + (bf) * SHM_K + kws + 32 * 256) = S.st_k1; } while (0)
#define SWRITE_HV(bf) do { *(bf16x8*)(V_lds + (bf) * SHM_V + vst0) = S.st_v0; *(bf16x8*)(V_lds + (bf) * SHM_V + vst1) = S.st_v1; } while (0)
#define SWRITE_H(bf) do { SWRITE_HV(bf); SWRITE_HK(bf); } while (0)

__device__ __forceinline__ void prime(const BlockRef& cur, char* lds, Seam& S) {
    int tid = threadIdx.x; asm volatile("" : "+v"(tid));     const int wid = __builtin_amdgcn_readfirstlane(tid >> 6), lane = tid & 63, r32 = lane & 31, hi = lane >> 5;
    const int sr = tid >> 4, sc = (tid & 15) * 8, kws = KSWZ(sr, sc * 2); char* K_lds = lds + 2 * SHM_V;
    const unsigned kvoff = (unsigned)(sr * LDP + sc) * 2u, qvoff = (unsigned)(r32 * LDP + hi * 8) * 2u;
    { const char* qb__ = (const char*)cur.Q + (size_t)(wid * QBLK) * (LDP * 2);
#pragma unroll
    for (int d0 = 0; d0 < 8; ++d0) S.qr[d0] = LD8(qb__ + qvoff + d0 * 32); }
    SLOAD_H(cur.K, cur.V, 0); VMW(); SWRITE_HK(0);
    __syncthreads();
}
__device__ __forceinline__ int rel_bucket(int n) {
    if (n < 16) return n;
    const float nf = (float)n;
    int large = 16 + (int)(logf(nf / 16.0f) / 5.545177444479562f * 16.0f);
    return large < 31 ? large : 31;
}
__device__ __forceinline__ BlockRef make_ref(const P& a, int item);
__device__ __forceinline__ int block(const P& a, const BlockRef& cur, unsigned* queue, const float* rel_bias, const float* kmp, char* lds, Seam& S) {
    int tid = threadIdx.x; asm volatile("" : "+v"(tid));     const int wid = __builtin_amdgcn_readfirstlane(tid >> 6), lane = tid & 63, r32 = lane & 31, hi = lane >> 5;
    const int qb = cur.qb, NT = 4 * (qb + 1);
    const int qlo = qb * QB + wid * QBLK, qrow = qlo + r32;
    char* V_lds = lds; char* K_lds = lds + 2 * SHM_V;
    float* ws = (float*)(lds + OFF_WS) + wid * 64; float* li_l = ws, * al_l = ws + 32;
    LAS float* rtab = (LAS float*)(LAS char*)(uintptr_t)(unsigned)(uintptr_t)(lds + OFF_RTAB);
    float* kmL = (float*)(lds + OFF_KM);
    volatile int* misc = (volatile int*)(lds + OFF_MISC);
    if (tid == 0) misc[0] = (int)__hip_atomic_fetch_add(queue, 1u, __ATOMIC_RELAXED, __HIP_MEMORY_SCOPE_AGENT);
    for (int i = tid; i < 2304; i += NW * 64) { const int dist = 2047 - i; rtab[i] = dist >= 0 ? rel_bias[rel_bucket(dist) * 8 + cur.h] * (1.0f / SCALE) : 0.f; }
    for (int i = tid; i < qb * 128; i += NW * 64) { const int j = i >> 7, dd = i & 127; const size_t o = ((size_t)(cur.b * 8 + j)) * 1024 + cur.h * 128 + dd;
        kmL[i] = (kmp[o] + kmp[o + 64 * 1024]) * (1.0f / 256.0f); }
    __syncthreads();
    const int next_item = __builtin_amdgcn_readfirstlane(misc[0]);
    const BlockRef nxt = next_item < 512 ? make_ref(a, next_item) : cur;
    unsigned selmask = 0;
    {
        float sc7[7];
#pragma unroll
        for (int j = 0; j < 7; ++j) { sc7[j] = -__builtin_inff();
            if (j < qb) { float acc = 0.f;
#pragma unroll
                for (int d0 = 0; d0 < 8; ++d0) { const u32x4 q4 = __builtin_bit_cast(u32x4, S.qr[d0]); const f32x4 k0 = *(const f32x4*)(kmL + j * 128 + d0 * 16 + hi * 8), k1 = *(const f32x4*)(kmL + j * 128 + d0 * 16 + hi * 8 + 4);
                    acc += bflo(q4[0]) * k0[0] + bfhi(q4[0]) * k0[1] + bflo(q4[1]) * k0[2] + bfhi(q4[1]) * k0[3] + bflo(q4[2]) * k1[0] + bfhi(q4[2]) * k1[1] + bflo(q4[3]) * k1[2] + bfhi(q4[3]) * k1[3]; }
                acc += __shfl_xor(acc, 32); sc7[j] = acc; } }
#pragma unroll
        for (int j = 0; j < 7; ++j) { int rank = 0;
#pragma unroll
            for (int i = 0; i < 7; ++i) { if (i != j) rank += (sc7[i] > sc7[j] || (sc7[i] == sc7[j] && i < j)) ? 1 : 0; }
            if (j < qb && (qb <= 3 || rank < 3)) selmask |= 1u << j; }
    }
    LAS unsigned* selp = (LAS unsigned*)(LAS char*)(uintptr_t)(unsigned)(uintptr_t)(lds + OFF_SEL) + tid;
    *selp = selmask;
    float m_reg = -1e30f, l_reg = 0; f32x16 o[4];
#pragma unroll
    for (int d = 0; d < 4; ++d)
#pragma unroll
        for (int r = 0; r < 16; ++r) o[d][r] = 0.f;
    const int sr = tid >> 4, sc = (tid & 15) * 8, vst0 = v_st(sr, sc), vst1 = v_st(32 + sr, sc), kws = KSWZ(sr, sc * 2);
    const unsigned kvoff = (unsigned)(sr * LDP + sc) * 2u;
    const int vb0 = (int)(uintptr_t)V_lds + v_rd_base(lane);
    const bf16_t* Kh = cur.K; const bf16_t* Vh = cur.V;
#define RESC(a) do { if (__any((a) < 1.f)) { if (hi == 0) al_l[r32] = (a); asm volatile("s_waitcnt lgkmcnt(0)" ::: "memory");              \
                     for (int d_ = 0; d_ < 4; ++d_) for (int r = 0; r < 16; ++r) o[d_][r] *= al_l[crow(r, hi)]; } } while (0)
#define KBASE(t) ((t) * KVBLK)
#define MASKT(P0_, P1_, t) do { const int kb_ = KBASE(t); bias_tile(P0_, P1_, rtab + (kb_ + 4 * hi - qrow + 2047)); \
        if (((t) >> 2) != qb) { if (!((*selp >> ((t) >> 2)) & 1u)) kill_tile(P0_, P1_); } \
        else if (kb_ + KVBLK - 1 > qlo) mask_tile(P0_, P1_, qrow - 4 * hi - kb_); } while (0)
    constexpr int NQL = 8;
#define SEAM_K0() do { VMWN(NQL); SWRITE_HK(0); SBAR(); } while (0)
    f32x16 pA0, pA1, pB0, pB1; float mnA, mnB, alA, alB; bf16x8 pa0, pa1, pa2, pa3;
    SWRITE_HV(0); SBAR();
    if (NT > 1) { SLOAD_H(Kh, Vh, KBASE(1)); }
    SBAR(); qkt<0>(pA0, pA1, K_lds, r32, hi, S.qr);
    MASKT(pA0, pA1, 0); partialSM(pA0, pA1, m_reg, mnA, alA);
    if (NT > 1) { VMW(); SWRITE_H(1); }
    __syncthreads();
#define HALF_STEP(PX0, PX1, mnX, alX, PY0, PY1, alY, t, KB, VB, SB) do {                                                      \
        SBAR(); qkt<KB>(PX0, PX1, K_lds, r32, hi, S.qr);                                             \
        finishSM(PY0, PY1, alY, l_reg, pa0, pa1, pa2, pa3); SBAR();                                                           \
        if ((t) + 1 < NT) { SLOAD_H(Kh, Vh, KBASE((t) + 1)); SBAR(); }                                               \
        pv_tile<VB>(o, vb0, pa0, pa1, pa2, pa3); MASKT(PX0, PX1, (t)); partialSM(PX0, PX1, m_reg, mnX, alX);                                        \
        __syncthreads();                                                                                                      \
        if ((t) + 1 < NT) { VMW(); SWRITE_H(SB); }                                                                          \
        RESC(alX); __syncthreads(); } while (0)
    for (int t = 1; t + 1 < NT; t += 2) {
        HALF_STEP(pB0, pB1, mnB, alB, pA0, pA1, alA, t, 1, 0, 0);
        HALF_STEP(pA0, pA1, mnA, alA, pB0, pB1, alB, t + 1, 0, 1, 1);
    }
    { SBAR(); qkt<1>(pB0, pB1, K_lds, r32, hi, S.qr); SBAR(); }
    SLOAD_H(nxt.K, nxt.V, 0); SBAR();
    { const char* qb__ = (const char*)nxt.Q + (size_t)(wid * QBLK) * (LDP * 2); int l_ = lane; asm volatile("" : "+v"(l_));
      const unsigned qvoff = (unsigned)((l_ & 31) * LDP + (l_ >> 5) * 8) * 2u;
#pragma unroll
    for (int d0 = 0; d0 < 8; ++d0) S.qr[d0] = LD8(qb__ + qvoff + d0 * 32); }
    SBAR();
    finishSM(pA0, pA1, alA, l_reg, pa0, pa1, pa2, pa3); SBAR();
    pv_tile<0>(o, vb0, pa0, pa1, pa2, pa3);
    { MASKT(pB0, pB1, NT - 1); partialSM(pB0, pB1, m_reg, mnB, alB); __syncthreads(); RESC(alB);
      finishSM(pB0, pB1, alB, l_reg, pa0, pa1, pa2, pa3); SBAR(); pv_tile<1>(o, vb0, pa0, pa1, pa2, pa3); }
    SBAR(); SEAM_K0();
    if (hi == 0) li_l[r32] = l_reg; asm volatile("s_waitcnt lgkmcnt(0)" ::: "memory");
    float rli[16];
#pragma unroll
    for (int r = 0; r < 16; ++r) rli[r] = __builtin_amdgcn_rcpf(li_l[crow(r, hi)]);
    char* Ow = (char*)cur.O + (size_t)(wid * QBLK) * (LDO * 2); const unsigned ovoff = (unsigned)(4 * hi * LDO + r32) * 2u;
#pragma unroll
    for (int r = 0; r < 16; ++r) { const int orow0 = (r & 3) + 8 * (r >> 2);
#pragma unroll
        for (int d0 = 0; d0 < 4; ++d0) { const float v = o[d0][r] * rli[r];
            const float vn = __shfl_xor(v, 1);
            if ((r32 & 1) == 0) *(unsigned*)(Ow + (size_t)(orow0 * LDO * 2 + d0 * 64) + ovoff) = cvtpk(v, vn); } }
    __syncthreads();
    return next_item;
#undef RESC
#undef KBASE
#undef MASKT
#undef SEAM_K0
#undef HALF_STEP
}
#undef ROWP
#undef VMW
#undef VMWN
#undef LD8
#undef SLOAD_H
#undef SWRITE_HK
#undef SWRITE_HV
#undef SWRITE_H

__device__ __forceinline__ BlockRef make_ref(const P& a, int item) {
    const int qb = 7 - (item >> 6), bh = item & 63, b = bh >> 3, h = bh & 7;
    const bf16_t* proj = (const bf16_t*)(a.ws + WS_PROJ);
    BlockRef r; r.b = b; r.h = h; r.qb = qb;
    r.Q = proj + (size_t)(b * SEQ + qb * QB) * LDP + C_QB + h * HD;
    r.K = proj + (size_t)(b * SEQ) * LDP + C_KB + h * HD;
    r.V = proj + (size_t)(b * SEQ) * LDP + C_VB + h * HD;
    r.O = (bf16_t*)(a.ws + WS_OAB) + (size_t)(b * SEQ + qb * QB) * LDO + 1024 + h * HD;
    return r;
}
}
__device__ __forceinline__ void router_unit(const P& a, LAS unsigned char* lds, int unit) {
    int tid = threadIdx.x; asm volatile("" : "+v"(tid)); const int wave = __builtin_amdgcn_readfirstlane(tid >> 6), lane = tid & 63, c32 = lane & 31, hi = lane >> 5;
    const int tg = wave & 1, kq = wave >> 1;
    const float* x1 = a.out; const float* g = a.in[11]; const float* br = a.in[13];
    unsigned char* A2 = a.ws + WS_A2; const u32x4* frag = (const u32x4*)(a.ws + WS_WRF);
    LAS float* Lw = (LAS float*)(lds + wave * 4352);
    LAS float* ssp = (LAS float*)(lds + 8 * 4352);
    LAS unsigned* hist = (LAS unsigned*)(lds + 8 * 4352 + 2048);
    LAS unsigned* base = hist + 32;
    if (tid < 32) hist[tid] = 0u;
    const int tok = unit * 64 + tg * 32 + c32;
    f32x16 L;
#pragma unroll
    for (int r = 0; r < 16; ++r) L[r] = 0.f;
    float ss = 0.f;
    const float* xr = x1 + (size_t)tok * D + 8 * hi + 256 * kq; unsigned char* ar = A2 + (size_t)tok * D + 8 * hi + 256 * kq; const float* gr = g + 8 * hi + 256 * kq;
#pragma unroll 4
    for (int s = 0; s < 16; ++s) {
        const f32x4 xa = *(const f32x4*)(xr + 16 * s), xb = *(const f32x4*)(xr + 16 * s + 4), ga = *(const f32x4*)(gr + 16 * s), gb = *(const f32x4*)(gr + 16 * s + 4);
        ss += (xa.x * xa.x + xa.y * xa.y) + (xa.z * xa.z + xa.w * xa.w) + (xb.x * xb.x + xb.y * xb.y) + (xb.z * xb.z + xb.w * xb.w);
        const f32x4 va = xa * ga, vb = xb * gb;
        u32x4 wh; wh.x = cvt_pk_bf16(va.x, va.y); wh.y = cvt_pk_bf16(va.z, va.w); wh.z = cvt_pk_bf16(vb.x, vb.y); wh.w = cvt_pk_bf16(vb.z, vb.w);
        { u32x2 w8; w8.x = pk4_fp8(va.x, va.y, va.z, va.w); w8.y = pk4_fp8(vb.x, vb.y, vb.z, vb.w); *(u32x2*)(ar + 16 * s) = w8; }
        u32x4 wl; wl.x = cvt_pk_bf16(va.x - bflo(wh.x), va.y - bfhi(wh.x)); wl.y = cvt_pk_bf16(va.z - bflo(wh.y), va.w - bfhi(wh.y));
        wl.z = cvt_pk_bf16(vb.x - bflo(wh.z), vb.y - bfhi(wh.z)); wl.w = cvt_pk_bf16(vb.z - bflo(wh.w), vb.w - bfhi(wh.w));
        const bf16x8 ah = __builtin_bit_cast(bf16x8, wh), al = __builtin_bit_cast(bf16x8, wl);
        const bf16x8 bh = __builtin_bit_cast(bf16x8, frag[(16 * kq + s) * 64 + lane]), bl = __builtin_bit_cast(bf16x8, frag[4096 + (16 * kq + s) * 64 + lane]);
        L = __builtin_amdgcn_mfma_f32_32x32x16_bf16(ah, bh, L, 0, 0, 0);
        L = __builtin_amdgcn_mfma_f32_32x32x16_bf16(ah, bl, L, 0, 0, 0);
        L = __builtin_amdgcn_mfma_f32_32x32x16_bf16(al, bh, L, 0, 0, 0);
    }
#pragma unroll
    for (int r = 0; r < 16; ++r) Lw[((r & 3) + 8 * (r >> 2) + 4 * hi) * 33 + c32] = L[r];
    ssp[wave * 64 + lane] = ss;
    __syncthreads();
    int e4[4] = {0, 0, 0, 0}; float w4[4] = {0.f, 0.f, 0.f, 0.f}; unsigned loc[4] = {0u, 0u, 0u, 0u}; float rstd = 0.f;
    const bool sel = (wave < 2) && (hi == 0);
    if (sel) {
        float sst = 0.f;
#pragma unroll
        for (int q = 0; q < 4; ++q) sst += ssp[(wave + 2 * q) * 64 + c32] + ssp[(wave + 2 * q) * 64 + 32 + c32];
        rstd = 1.0f / sqrtf(sst * (1.0f / D) + EPS);
        float lg[32];
#pragma unroll
        for (int e = 0; e < 32; ++e) { const LAS float* lp = (const LAS float*)(lds + wave * 4352) + c32 * 33 + e; lg[e] = (lp[0] + lp[2 * 1088] + lp[4 * 1088] + lp[6 * 1088]) * rstd + br[e]; }
        unsigned used = 0u; float v4[4];
#pragma unroll
        for (int p = 0; p < 4; ++p) { float best = -__builtin_inff(); int bi = 0;
#pragma unroll
            for (int e = 0; e < 32; ++e) { const bool take = !((used >> e) & 1u) && lg[e] > best; best = take ? lg[e] : best; bi = take ? e : bi; }
            used |= 1u << bi; e4[p] = bi; v4[p] = best; }
        float sum = 0.f;
#pragma unroll
        for (int p = 0; p < 4; ++p) { w4[p] = expf(v4[p] - v4[0]); sum += w4[p]; }
        const float inv = 1.0f / sum;
#pragma unroll
        for (int p = 0; p < 4; ++p) { w4[p] *= inv; loc[p] = __hip_atomic_fetch_add(hist + e4[p], 1u, __ATOMIC_RELAXED, __HIP_MEMORY_SCOPE_WORKGROUP); }
    }
    __syncthreads();
    if (tid < 32) base[tid] = __hip_atomic_fetch_add((unsigned*)(a.ws + WS_CTL) + CW_COUNTS + tid, hist[tid], RLX_AGENT);
    __syncthreads();
    if (sel) {
        int* tope = (int*)(a.ws + WS_TOPE) + (size_t)tok * 4; float* wts = (float*)(a.ws + WS_WTS) + (size_t)tok * 4; int* slot = (int*)(a.ws + WS_SLOT) + (size_t)tok * 4;
#pragma unroll
        for (int p = 0; p < 4; ++p) { tope[p] = e4[p]; wts[p] = w4[p]; slot[p] = (int)(base[e4[p]] + loc[p]); }
        ((float*)(a.ws + WS_RSTD))[tok] = rstd;
    }
    __syncthreads();
}

__device__ __forceinline__ void moe_index(const P& a, LAS unsigned char* lds, int vcu, int G) {
    const int tid = threadIdx.x;
    LAS int* pstart = (LAS int*)lds;
    LAS int* cnt = pstart + 64;
    const unsigned* counts = (const unsigned*)(a.ws + WS_CTL) + CW_COUNTS;
    if (tid == 0) { int acc = 0; for (int e = 0; e < NE; ++e) { const int c = (int)counts[e]; cnt[e] = c; pstart[e] = acc; acc += ((c + 255) >> 8) << 8; } pstart[NE] = acc; }
    __syncthreads();
    int* rowtok = (int*)(a.ws + WS_ROWTOK); float* rstds = (float*)(a.ws + WS_RSTDS); int* dest = (int*)(a.ws + WS_DEST);
    const int* tope = (const int*)(a.ws + WS_TOPE); const int* slot = (const int*)(a.ws + WS_SLOT); const float* rstd = (const float*)(a.ws + WS_RSTD);
    const int gt = vcu * NTHREADS + tid, NGT = G * NTHREADS;
    for (int i = gt; i < T * 4; i += NGT) { const int e = tope[i], d = pstart[e] + slot[i]; dest[i] = d; rowtok[d] = i >> 2; rstds[d] = rstd[i >> 2]; }
    for (int i = gt; i < NE * 256; i += NGT) { const int e = i >> 8, r = pstart[e] + cnt[e] + (i & 255); if (r < pstart[e + 1]) { rowtok[r] = 0; rstds[r] = 0.f; } }
    if (vcu == 0) { int* tile_e = (int*)(a.ws + WS_TILEE);
        for (int t = tid; t < MAXTILES; t += NTHREADS) { int e = NE - 1; for (int q = 0; q < NE; ++q) { if (t * 256 >= pstart[q] && t * 256 < pstart[q + 1]) e = q; } tile_e[t] = e; }
        if (tid == 0) tile_e[MAXTILES] = pstart[NE] >> 8; }
    __syncthreads();
}

__device__ __forceinline__ void combine_rows(const P& a, int vcu, int G, int wave, int lane) {
    const int gw = vcu * NWAVES + wave, NGW = G * NWAVES;
    float* X = a.out; const bf16_t* Y = (const bf16_t*)(a.ws + WS_YROWS); bf16_t* A3 = (bf16_t*)(a.ws + WS_H);
    const int* dest = (const int*)(a.ws + WS_DEST); const float* wts = (const float*)(a.ws + WS_WTS); const float* g = a.in[20];
    f32x4 gv[4];
#pragma unroll
    for (int j = 0; j < 4; ++j) gv[j] = *((const f32x4*)g + lane + 64 * j);
    for (int m = gw; m < T; m += NGW) {
        f32x4* xr = (f32x4*)(X + (size_t)m * D) + lane; f32x4 v[4];
#pragma unroll
        for (int j = 0; j < 4; ++j) v[j] = xr[64 * j];
#pragma unroll
        for (int k = 0; k < 4; ++k) { const int d = __builtin_amdgcn_readfirstlane(dest[m * 4 + k]); const float w = __uint_as_float(__builtin_amdgcn_readfirstlane(__float_as_uint(wts[m * 4 + k])));
            const u32x2* yr = (const u32x2*)(Y + (size_t)d * D) + lane;
#pragma unroll
            for (int j = 0; j < 4; ++j) { const u32x2 y = yr[64 * j]; v[j].x += w * bflo(y.x); v[j].y += w * bfhi(y.x); v[j].z += w * bflo(y.y); v[j].w += w * bfhi(y.y); } }
        float s = 0.f;
#pragma unroll
        for (int j = 0; j < 4; ++j) s += (v[j].x * v[j].x + v[j].y * v[j].y) + (v[j].z * v[j].z + v[j].w * v[j].w);
        const float rstd = 1.0f / sqrtf(wave_sum(s) * (1.0f / D) + EPS);
        u32x2* o8 = (u32x2*)(A3 + (size_t)m * D) + lane;
#pragma unroll
        for (int j = 0; j < 4; ++j) { xr[64 * j] = v[j]; u32x2 w; w.x = cvt_pk_bf16(v[j].x * rstd * gv[j].x, v[j].y * rstd * gv[j].y); w.y = cvt_pk_bf16(v[j].z * rstd * gv[j].z, v[j].w * rstd * gv[j].w); o8[64 * j] = w; }
    }
}
__device__ __forceinline__ void final_rows(const P& a, int vcu, int G, int wave, int lane) {
    const int gw = vcu * NWAVES + wave, NGW = G * NWAVES;
    float* X = a.out; const bf16_t* PG = (const bf16_t*)(a.ws + WS_PGATE); const bf16_t* PP = (const bf16_t*)(a.ws + WS_PPROJ);
    f32x4 gp[4], gf[4];
#pragma unroll
    for (int j = 0; j < 4; ++j) { gp[j] = *((const f32x4*)a.in[23] + lane + 64 * j); gf[j] = *((const f32x4*)a.in[24] + lane + 64 * j); }
    for (int m = gw; m < T; m += NGW) {
        f32x4* xr = (f32x4*)(X + (size_t)m * D) + lane; const u32x2* pgr = (const u32x2*)(PG + (size_t)m * D) + lane; const u32x2* ppr = (const u32x2*)(PP + (size_t)m * D) + lane;
        f32x4 v[4], pp[4], pg[4]; float sp = 0.f;
#pragma unroll
        for (int j = 0; j < 4; ++j) { v[j] = xr[64 * j]; const u32x2 q = ppr[64 * j], gq = pgr[64 * j];
            pp[j] = (f32x4){bflo(q.x), bfhi(q.x), bflo(q.y), bfhi(q.y)}; pg[j] = (f32x4){bflo(gq.x), bfhi(gq.x), bflo(gq.y), bfhi(gq.y)};
            sp += (pp[j].x * pp[j].x + pp[j].y * pp[j].y) + (pp[j].z * pp[j].z + pp[j].w * pp[j].w); }
        const float rp = 1.0f / sqrtf(wave_sum(sp) * (1.0f / D) + EPS); float s = 0.f;
#pragma unroll
        for (int j = 0; j < 4; ++j) { v[j] = v[j] + pg[j] * (pp[j] * rp * gp[j]); s += (v[j].x * v[j].x + v[j].y * v[j].y) + (v[j].z * v[j].z + v[j].w * v[j].w); }
        const float rstd = 1.0f / sqrtf(wave_sum(s) * (1.0f / D) + EPS);
#pragma unroll
        for (int j = 0; j < 4; ++j) xr[64 * j] = v[j] * rstd * gf[j];
    }
}
struct Args { P p; };
template <int PH_LO, int PH_HI>
__global__ void __launch_bounds__(NTHREADS, 2) hybrid_fwd(Args args) {
    extern __shared__ __attribute__((aligned(16))) unsigned char lds_raw[];
    LAS unsigned char* lds = (LAS unsigned char*)lds_raw;
    const P& a = args.p;
    const int tid = threadIdx.x, lane = tid & 63, wave = __builtin_amdgcn_readfirstlane(tid >> 6);
    const int G = gridDim.x; const int bx = blockIdx.x; const int vcu = (G % 8 == 0) ? (bx % 8) * (G / 8) + bx / 8 : bx;
    unsigned* ctl = (unsigned*)(a.ws + WS_CTL);
    for (int u = tid; u < (LDS_BYTES - LDSCTL_OFF) / 4; u += NTHREADS) ((LAS unsigned*)(lds + LDSCTL_OFF))[u] = 0u;
    __syncthreads();
#if MK_PER_PHASE
#define GRID_BAR() do { } while (0)
#else
    XcdBarrier bar = xcd_barrier_post(ctl + CW_BAR, (volatile LAS unsigned*)(lds + MISC_OFF + 32));
#define GRID_BAR() xcd_barrier(bar)
#endif
    constexpr int lo = PH_LO, hi = PH_HI;
#define IN(k) (lo <= (k) && (k) < hi)
#define SEAM(k) do { if constexpr (IN(k) && IN((k) + 1)) GRID_BAR(); } while (0)
    unsigned char* ws = a.ws;

    if constexpr (IN(0)) { p0_prologue(a, lds, vcu, G, wave, lane); }
    SEAM(0);
    if constexpr (IN(1)) {
        pg8::DenseSched S; S.o.init(T / 256, NPROJ / 256, G, bx); S.Bt = (const char*)(ws + WS_WIN); S.K = D;
        pg8::EpiProj<false> E{(bf16_t*)(ws + WS_PROJ), (float*)(ws + WS_KMP)};
        pg8::gemm_phase(lds, (const char*)(ws + WS_H), D, D, D, S, E);
    }
    SEAM(1);
    if constexpr (IN(2)) { for (int u = vcu; u < NB * 32; u += G) gla_prep_unit(a, lds, u); }
    SEAM(2);
    if constexpr (IN(3)) { for (int u = vcu; u < 512; u += G) gla_combine_unit(a, u); }
    SEAM(3);
    if constexpr (IN(4)) {
        for (int u = vcu; u < 1024; u += G) gla_out_unit(a, lds, u);
        __syncthreads();
    }
    SEAM(4);
    if constexpr (IN(5)) {
        if ((vcu & 1) == 0) { expert_convert(a, lds, vcu >> 1, G >> 1, wave, lane); __syncthreads(); }
        unsigned* queue = ctl + CW_QUEUE;
        volatile LAS int* qslot = (volatile LAS int*)(lds + LDSCTL_OFF + 1024);
        if (tid == 0) qslot[0] = (int)__hip_atomic_fetch_add(queue, 1u, RLX_AGENT);
        __syncthreads();
        int item = __builtin_amdgcn_readfirstlane(qslot[0]);
        if (item < 512) {
            moba::Seam S;
            moba::BlockRef cur = moba::make_ref(a, item);
            moba::prime(cur, (char*)lds_raw, S);
            for (;;) {
                const int nitem = moba::block(a, cur, queue, a.in[2], (const float*)(ws + WS_KMP), (char*)lds_raw, S);
                if (nitem >= 512) break;
                cur = moba::make_ref(a, nitem);
            }
        }
    }
    SEAM(5);
    if constexpr (IN(6)) {
        pg8::ChainSched S; S.o.init(T / 256, D / 256, G, bx); S.Bt = (const char*)(ws + WS_WUP); S.K = 1024;
        pg8::EpiMerge E{(const bf16_t*)(ws + WS_PROJ), (bf16_t*)(ws + WS_Y)};
        pg8::gemm_phase(lds, (const char*)(ws + WS_OAB), 1024, 2048, 2048, S, E);
    }
    SEAM(6);
    if constexpr (IN(7)) {
        pg8::DenseSched S; S.o.init(T / 256, D / 256, G, bx); S.Bt = (const char*)(ws + WS_WO); S.K = D;
        pg8::EpiResF32 E{a.in[0], a.out};
        pg8::gemm_phase(lds, (const char*)(ws + WS_Y), D, D, D, S, E);
    }
    SEAM(7);
    if constexpr (IN(8)) { for (int u = vcu; u < T / 64; u += G) router_unit(a, lds, u); }
    SEAM(8);
    if constexpr (IN(9)) { moe_index(a, lds, vcu, G); }
    SEAM(9);
    if constexpr (IN(10)) {
        const int* tile_e = (const int*)(ws + WS_TILEE); const int ntile = __builtin_amdgcn_readfirstlane(tile_e[MAXTILES]);
        pg8::MoeSched<true> S; S.o.init(ntile, 8, G, bx); S.Bt = (const char*)(ws + WS_W1T); S.K = D; S.rows_per_e = 2048; S.tile_e = tile_e; S.row_tok = (const int*)(ws + WS_ROWTOK); S.es = 1;
        pg8::EpiGlu E{(unsigned char*)(ws + WS_HMID), (const float*)(ws + WS_RSTDS), a.in[15], a.in[17]};
        pg8::gemm_phase(lds, (const char*)(ws + WS_A2), D, D, D, S, E);
    }
    SEAM(10);
    if constexpr (IN(11)) {
        const int* tile_e = (const int*)(ws + WS_TILEE); const int ntile = __builtin_amdgcn_readfirstlane(tile_e[MAXTILES]);
        pg8::MoeSched<false> S; S.o.init(ntile, 4, G, bx); S.Bt = (const char*)(ws + WS_W2T); S.K = FF; S.rows_per_e = 1024; S.tile_e = tile_e; S.row_tok = nullptr; S.es = 1;
        pg8::EpiBf16<0, true, true> E{(bf16_t*)(ws + WS_YROWS), D, a.in[19], D, 1.0f / 32.0f};
        pg8::gemm_phase(lds, (const char*)(ws + WS_HMID), FF, FF, FF, S, E);
    }
    SEAM(11);
    if constexpr (IN(12)) { combine_rows(a, vcu, G, wave, lane); }
    SEAM(12);
    if constexpr (IN(13)) {
        { pg8::DenseSched S; S.o.init(T / 256, D / 256, G, bx); S.Bt = (const char*)(ws + WS_WPG); S.K = D;
          pg8::EpiBf16<1, false> E{(bf16_t*)(ws + WS_PGATE), D, nullptr, 0, 1.0f};
          pg8::gemm_phase(lds, (const char*)(ws + WS_H), D, D, D, S, E); }
        __syncthreads();
        { pg8::DenseSched S; S.o.init(T / 256, D / 256, G, bx); S.Bt = (const char*)(ws + WS_WPP); S.K = 256;
          pg8::EpiBf16<0, false> E{(bf16_t*)(ws + WS_PPROJ), D, nullptr, 0, 1.0f};
          pg8::gemm_phase(lds, (const char*)(ws + WS_PB), 256, 256, 256, S, E); }
    }
    SEAM(13);
    if constexpr (IN(14)) { final_rows(a, vcu, G, wave, lane); }
#undef IN
#undef SEAM
#undef GRID_BAR
}

template <int LO, int HI> static void launch_range(const Args& a, int grid, hipStream_t stream) {
    static bool attr = false;
    if (!attr) { attr = true; if (hipFuncSetAttribute((const void*)hybrid_fwd<LO, HI>, hipFuncAttributeMaxDynamicSharedMemorySize, LDS_BYTES) != hipSuccess) fprintf(stderr, "kernel_launch: hipFuncSetAttribute failed\n"); }
    hipLaunchKernelGGL((hybrid_fwd<LO, HI>), dim3(grid), dim3(NTHREADS), LDS_BYTES, stream, a);
}
extern "C" void kernel_launch(void* const* d_in, const int* in_sizes, int n_in, void* d_out, int out_size, void* d_ws, size_t ws_size, hipStream_t stream) {
    static int grid = 0;
    if (grid == 0) {
        static const int expect[25] = {T * D, T * 256, 256, 1024, 1024 * D_IN, 16 * 512, 512, 256, 1048576, 1048576, 1048576, 1024, 32768, 32, 33554432, 32768, 33554432, 32768, 33554432, 32768, 1024, 1048576, 262144, 1024, 1024};
        bool okk = (n_in == 25);
        for (int i = 0; okk && i < 25; ++i) if (in_sizes[i] != expect[i]) { fprintf(stderr, "kernel_launch: input %d has %d elements, expected %d\n", i, in_sizes[i], expect[i]); okk = false; }
        if (!okk || out_size != T * D || ws_size < WS_END) { fprintf(stderr, "kernel_launch: unexpected shapes (n_in %d, in0 %d, out %d, ws %zu); nothing launched\n", n_in, n_in > 0 ? in_sizes[0] : -1, out_size, ws_size); grid = -1; return; }
        int dev = 0, cus = 0;
        if (hipGetDevice(&dev) != hipSuccess || hipDeviceGetAttribute(&cus, hipDeviceAttributeMultiprocessorCount, dev) != hipSuccess) { grid = -1; return; }
        grid = cus;
    }
    if (grid < 0) return;
    (void)hipMemsetAsync((char*)d_ws + WS_CTL, 0, CTL_ZERO_BYTES, stream);
    Args a{};
    for (int i = 0; i < 25; ++i) a.p.in[i] = (const float*)d_in[i];
    a.p.out = (float*)d_out; a.p.ws = (unsigned char*)d_ws;
#if MK_PER_PHASE
#ifndef MK_LAST
#define MK_LAST 14
#endif
#ifndef MK_REPEAT
#define MK_REPEAT 0
#endif
#define LR(k) do { if ((k) <= MK_LAST) for (int r_ = 0; r_ < 1 + ((MK_REPEAT >> (k)) & 1); ++r_) launch_range<(k), (k) + 1>(a, grid, stream); } while (0)
    LR(0); LR(1); LR(2); LR(3); LR(4); LR(5); LR(6); LR(7); LR(8); LR(9); LR(10); LR(11); LR(12); LR(13); LR(14);
#undef LR
#else
    launch_range<0, NPHASES>(a, grid, stream);
#endif
}
```

```cpp
#include <hip/hip_runtime.h>
#include <cstdio>
#include <cstdint>

#define LAS __attribute__((address_space(3)))
#define GAS __attribute__((address_space(1)))
typedef unsigned short bf16_t;
typedef short bf16x8 __attribute__((ext_vector_type(8)));
typedef short s16x4 __attribute__((ext_vector_type(4)));
typedef float f32x2 __attribute__((ext_vector_type(2)));
typedef float f32x4 __attribute__((ext_vector_type(4)));
typedef float f32x16 __attribute__((ext_vector_type(16)));
typedef unsigned u32x2 __attribute__((ext_vector_type(2)));
typedef unsigned u32x4 __attribute__((ext_vector_type(4)));
typedef int i32x4 __attribute__((ext_vector_type(4)));
typedef int i32x8 __attribute__((ext_vector_type(8)));
typedef GAS unsigned gu32;
#define RLX_AGENT __ATOMIC_RELAXED, __HIP_MEMORY_SCOPE_AGENT
#define LDS_WAIT() asm volatile("s_waitcnt lgkmcnt(0)" ::: "memory")
#define VM_WAIT() asm volatile("s_waitcnt vmcnt(0)" ::: "memory")

#ifndef MK_PER_PHASE
#define MK_PER_PHASE 0
#endif

constexpr int NB = 8, SEQ = 2048, T = NB * SEQ, D = 1024;
constexpr int NPROJ = 8192;
constexpr int C_QA = 0, C_KA = 512, C_VA = 1024, C_RA = 2048, C_QB = 3072, C_KB = 4096, C_VB = 5120, C_GA = 6144, C_GB = 7168;
constexpr int SRC_ALOW = 3072, D_IN = 8208;
constexpr int NE = 32, FF = 1024, MAXTILES = 288, MAXROWS = MAXTILES * 256;
constexpr float EPS = 1e-6f;
constexpr int NWAVES = 8, NTHREADS = 512;
constexpr int NPHASES = 13;

constexpr size_t MiB = 1u << 20;
constexpr size_t WS_CTL = 0, CTL_ZERO_BYTES = 1 * MiB;
constexpr size_t WS_SMALL = 1 * MiB;
constexpr size_t WS_KMP   = WS_SMALL;
constexpr size_t WS_DEC   = WS_KMP + 512 * 1024;
constexpr size_t WS_TOPE  = WS_DEC + 512 * 1024;
constexpr size_t WS_WTS   = WS_TOPE + 256 * 1024;
constexpr size_t WS_SLOT  = WS_WTS + 256 * 1024;
constexpr size_t WS_DEST  = WS_SLOT + 256 * 1024;
constexpr size_t WS_ROWTOK = WS_DEST + 256 * 1024;
constexpr size_t WS_RSTDS = WS_ROWTOK + 320 * 1024;
constexpr size_t WS_RSTD  = WS_RSTDS + 320 * 1024;
constexpr size_t WS_TILEE = WS_RSTD + 64 * 1024;
constexpr size_t WS_WALT  = WS_TILEE + 4 * 1024;
constexpr size_t WS_WRF   = WS_WALT + 32 * 1024;
static_assert(WS_WRF + 128 * 1024 <= 6 * MiB, "small map");
constexpr size_t WS_WO = 6 * MiB, WS_WPG = 8 * MiB, WS_WPP = 10 * MiB, WS_WUP = 12 * MiB, WS_WIN = 16 * MiB;
constexpr size_t WS_PB = 34 * MiB;
constexpr size_t WS_H  = 42 * MiB;
constexpr size_t WS_PROJ = 74 * MiB;
constexpr size_t WS_QG = 330 * MiB, WS_KG = 346 * MiB;
constexpr size_t WS_SLOC = 426 * MiB;
constexpr size_t WS_OAB = 362 * MiB;
constexpr size_t WS_H8 = 426 * MiB;
constexpr size_t WS_WIN8 = 442 * MiB;
constexpr size_t WS_Y = 330 * MiB;
constexpr size_t WS_W2T = 42 * MiB;
constexpr size_t WS_A2 = 330 * MiB;
constexpr size_t WS_HMID = 138 * MiB;
constexpr size_t WS_X1 = 74 * MiB;
constexpr size_t WS_YROWS = 282 * MiB;
constexpr size_t WS_PGATE = 138 * MiB, WS_PPROJ = 226 * MiB;
constexpr size_t WS_ROWE = 490 * MiB;
constexpr size_t WS_RSTE = 492 * MiB;
constexpr size_t WS_END = 506 * MiB;

constexpr int CW_BAR = 4096;
constexpr int CW_COUNTS = 16384;
constexpr int CW_QUEUE = 16384 + 64;

constexpr int RING_BYTES = 131072;
constexpr int LDSCTL_OFF = RING_BYTES, MISC_OFF = LDSCTL_OFF + 320;
constexpr int LDS_MOE = LDSCTL_OFF + 10240;
constexpr int LDS_BYTES = 147456;

typedef __bf16 bf16v2_t __attribute__((ext_vector_type(2)));
__device__ __forceinline__ unsigned cvt_pk_bf16(float lo, float hi) { const f32x2 v = {lo, hi}; return __builtin_bit_cast(unsigned, __builtin_convertvector(v, bf16v2_t)); }
__device__ __forceinline__ unsigned pk4_fp8(float a, float b, float c, float d) { int w = 0; w = __builtin_amdgcn_cvt_pk_fp8_f32(a, b, w, false); w = __builtin_amdgcn_cvt_pk_fp8_f32(c, d, w, true); return (unsigned)w; }
__device__ __forceinline__ float bf2f(unsigned short s) { return __uint_as_float(((unsigned)s) << 16); }
__device__ __forceinline__ float bflo(unsigned w) { return __uint_as_float(w << 16); }
__device__ __forceinline__ float bfhi(unsigned w) { return __uint_as_float(w & 0xffff0000u); }
__device__ __forceinline__ float fsigmoid(float x) { return __builtin_amdgcn_rcpf(1.0f + __builtin_amdgcn_exp2f(-1.4426950408889634f * x)); }
__device__ __forceinline__ float wave_sum(float v) {
#pragma unroll
    for (int o = 1; o < 64; o <<= 1) v += __shfl_xor(v, o);
    return v;
}
__device__ __forceinline__ bf16x8 pack8(f32x4 a, f32x4 b) {
    u32x4 w = {cvt_pk_bf16(a[0], a[1]), cvt_pk_bf16(a[2], a[3]), cvt_pk_bf16(b[0], b[1]), cvt_pk_bf16(b[2], b[3])};
    return __builtin_bit_cast(bf16x8, w);
}

#define XB_TMO      128
#define XB_XCNT(j)  (256  + 64 * (j))
#define XB_XSUB(j)  (1280 + 64 * (j))
#define XB_XGEN(j)  (2304 + 64 * (j))
#define XB_TOP      3328
#define XB_TOPGEN   3392
#define XCD_BAR_WORDS 3456
#define XB_SPIN_CAP (1u << 18)

__device__ __forceinline__ unsigned xb_ld(unsigned* p)              { return __hip_atomic_load(p, __ATOMIC_RELAXED, __HIP_MEMORY_SCOPE_AGENT); }
__device__ __forceinline__ unsigned xb_add(unsigned* p, unsigned v) { return __hip_atomic_fetch_add(p, v, __ATOMIC_RELAXED, __HIP_MEMORY_SCOPE_AGENT); }
__device__ __forceinline__ unsigned xb_xcc_id() { return (unsigned)__builtin_amdgcn_s_getreg((3 << 11) | 20) & 0xFu; }
#define XB_SPIN(cond, bar) do { unsigned _sp = 0; while (cond) { __builtin_amdgcn_s_sleep(1); \
    if ((++_sp & 255u) == 0u) { if (xb_ld(&(bar)[XB_TMO])) break; if (_sp > XB_SPIN_CAP) { atomicAdd(&(bar)[XB_TMO], 1u); break; } } } } while (0)

struct XcdBarrier { unsigned* bar; unsigned x; volatile LAS unsigned* st; };

__device__ __forceinline__ XcdBarrier xcd_barrier_post(unsigned* bar, volatile LAS unsigned* st) {
    XcdBarrier b; b.bar = bar; b.x = xb_xcc_id(); b.st = st;
    if (threadIdx.x == 0) (void)xb_add(&bar[XB_XCNT(b.x)], 1u);
    return b;
}
__device__ __forceinline__ void xcd_barrier_complete(unsigned* bar, unsigned x, unsigned& nloc, unsigned& nx) {
    const unsigned G = gridDim.x * gridDim.y * gridDim.z;
    unsigned sum, cnt, mine, sp = 0u;
    for (;;) {
        sum = 0u; cnt = 0u; mine = 0u;
#pragma unroll
        for (unsigned j = 0; j < 16; ++j) { const unsigned c = xb_ld(&bar[XB_XCNT(j)]); sum += c; cnt += (c > 0u) ? 1u : 0u; mine = (j == x) ? c : mine; }
        if (sum == G) break;
        __builtin_amdgcn_s_sleep(1);
        if ((++sp & 255u) == 0u) { if (xb_ld(&bar[XB_TMO])) break; if (sp > XB_SPIN_CAP) { atomicAdd(&bar[XB_TMO], 1u); break; } }
    }
    nloc = mine > 0u ? mine : 1u; nx = cnt > 0u ? cnt : 1u;
}
__device__ __forceinline__ void xcd_barrier(const XcdBarrier& b) {
    asm volatile("s_waitcnt vmcnt(0)" ::: "memory");
    __syncthreads();
    if (threadIdx.x == 0) {
        unsigned* bar = b.bar;
        __builtin_amdgcn_s_waitcnt(0);
        unsigned nloc = b.st[0], nx = b.st[1];
        if (nloc == 0u) { xcd_barrier_complete(bar, b.x, nloc, nx); b.st[0] = nloc; b.st[1] = nx; }
        const unsigned old = xb_add(&bar[XB_XSUB(b.x)], 1u);
        const unsigned gen = old / nloc;
        if (old + 1u == (gen + 1u) * nloc) {
            __builtin_amdgcn_fence(__ATOMIC_RELEASE, "agent");
            asm volatile("s_waitcnt vmcnt(0)" ::: "memory");
            const unsigned og = xb_add(&bar[XB_TOP], 1u);
            const unsigned tg = og / nx;
            if (og + 1u == (tg + 1u) * nx) xb_add(&bar[XB_TOPGEN], 1u);
            else XB_SPIN(xb_ld(&bar[XB_TOPGEN]) == tg, bar);
            __builtin_amdgcn_fence(__ATOMIC_ACQUIRE, "agent");
            xb_add(&bar[XB_XGEN(b.x)], 1u);
            asm volatile("s_waitcnt vmcnt(0)" ::: "memory");
        } else {
            XB_SPIN(xb_ld(&bar[XB_XGEN(b.x)]) == gen, bar);
            __builtin_amdgcn_fence(__ATOMIC_ACQUIRE, "agent");
            asm volatile("s_waitcnt vmcnt(0)" ::: "memory");
        }
    }
    __syncthreads();
}
namespace pg8 {
constexpr int BM = 256, BK = 64, HALF = 128, HTB = HALF * BK * 2, STAGE_BYTES = 8 * HTB, NXCD = 8, WGM = 8;

__host__ __device__ __forceinline__ int lds_byte(int r, int c) { const int st = (r >> 4) * 2 + (c >> 5), rr = r & 15, cc = c & 31, ob = rr * 64 + cc * 2; return st * 1024 + (ob ^ (((ob >> 9) & 1) << 5)); }
__host__ __device__ __forceinline__ void stage_rc(int b, int& R, int& C) { const int st = b / 1024, sb = b % 1024, swz = sb ^ (((sb >> 9) & 1) << 5); R = (st >> 1) * 16 + swz / 64; C = (st & 1) * 32 + (swz % 64) / 2; }
__host__ __device__ __forceinline__ int perm32(int rho) { const int n = rho >> 4, i = rho & 15; return 8 * (i >> 2) + 4 * n + (i & 3); }

struct Unit { int pm, pn, e; };

struct TileOrder {
    int nM, nN, nwg, G, c;
    __device__ __forceinline__ void init(int nM_, int nN_, int G_, int c_) { nM = nM_; nN = nN_; nwg = nM * nN; G = G_; c = c_; }
    __device__ __forceinline__ bool next(int i, int& pm, int& pn) const {
        const long L = (long)i * G + c; if (L >= nwg) return false;
        int wgid = (int)L; { const int q = nwg / NXCD, r = nwg % NXCD, xcd = wgid % NXCD, off = wgid / NXCD; wgid = (xcd < r ? xcd * (q + 1) : r * (q + 1) + (xcd - r) * q) + off; }
        const int nig = WGM * nN, gid = wgid / nig, fm = gid * WGM, gsz = (nM - fm) < WGM ? (nM - fm) : WGM;
        pm = fm + ((wgid % nig) % gsz); pn = (wgid % nig) / gsz; return true;
    }
};
struct DenseSched {
    TileOrder o; const char* Bt; int K; int es = 2; int gap_at = 1 << 30, gap_by = 0, pn0 = 0; bool bt_out = true;
    __device__ __forceinline__ bool next(int i, Unit& u) const { int p; if (!o.next(i, u.pm, p)) return false; u.e = p; u.pn = p + (p >= gap_at ? gap_by : 0) + pn0; return true; }
    __device__ __forceinline__ unsigned a_row(const Unit& u, int r) const { return (unsigned)(u.pm * BM + r); }
    __device__ __forceinline__ unsigned a_koff(const Unit&) const { return 0u; }
    __device__ __forceinline__ const char* b_base(const Unit& u) const { return Bt + (size_t)(bt_out ? u.pn : u.e) * BM * K * es; }
};
struct ChainSched {
    TileOrder o; const char* Bt; int K;
    __device__ __forceinline__ bool next(int i, Unit& u) const { if (!o.next(i >> 1, u.pm, u.pn)) return false; u.e = i & 1; return true; }
    __device__ __forceinline__ unsigned a_row(const Unit& u, int r) const { return (unsigned)(u.pm * BM + r); }
    __device__ __forceinline__ unsigned a_koff(const Unit& u) const { return (unsigned)(u.e * K * 2); }
    __device__ __forceinline__ const char* b_base(const Unit& u) const { return Bt + (size_t)u.pn * BM * (2 * K) * 2 + (size_t)u.e * K * 2; }
};
template <bool GATHER> struct MoeSched {
    TileOrder o; const char* Bt; int K; int rows_per_e; const LAS int* tab; const int* row_e; int es;
    __device__ __forceinline__ bool next(int i, Unit& u) const { if (!o.next(i, u.pm, u.pn)) return false; u.e = __builtin_amdgcn_readfirstlane(tab[128 + u.pm]); return true; }
    __device__ __forceinline__ unsigned a_row(const Unit& u, int r) const {
        if (GATHER) { const int lr = u.pm * BM + r - tab[u.e]; return lr < tab[64 + u.e] ? (unsigned)row_e[(size_t)u.e * T + lr] : 0u; }
        else return (unsigned)(u.pm * BM + r); }
    __device__ __forceinline__ unsigned a_koff(const Unit&) const { return 0u; }
    __device__ __forceinline__ const char* b_base(const Unit& u) const { return Bt + ((size_t)u.e * rows_per_e + (size_t)u.pn * BM) * K * es; }
};

template <class Epi, class Sched>
__device__ __forceinline__ void gemm_phase(LAS unsigned char* lds, const char* gA, int K_, int lda, int ldb, const Sched& S, const Epi& E) {
    int K = K_; asm volatile("" : "+s"(K));
    int tid = threadIdx.x; asm volatile("" : "+v"(tid));     const int wid = __builtin_amdgcn_readfirstlane(tid >> 6), lane = tid & 63, wr = wid >> 2, wc = wid & 3, fr = lane & 15, fq = lane >> 4;
    constexpr int ES = Epi::F8 ? 1 : 2;
    const int nt = K * ES / 128;
    unsigned voffB[2];
#pragma unroll
    for (int i = 0; i < 2; ++i) { int R, C; stage_rc(tid * 16 + i * 8192, R, C); const int Rb = Epi::PERM ? ((R & ~31) + perm32(R & 31)) : R; voffB[i] = (unsigned)(Rb * ldb * ES + C * 2); }
    const unsigned kstep = (unsigned)(BK * 2);
    const size_t hstepB = (size_t)HALF * ldb * ES;
    const unsigned ldab = (unsigned)lda * ES;
    const unsigned ldsw = (unsigned)wid * 1024u;
    const int aoff = lds_byte(wr * 64 + fr, fq * 8), boff = lds_byte(wc * 32 + fr, fq * 8);
#define PG8_SA(b, h) (((b) * 2 + (h)) * HTB)
#define PG8_SB(b, h) ((4 + (b) * 2 + (h)) * HTB)
#define PG8_STAGE_B(bufoff, gbase) do { _Pragma("unroll") for (int _i = 0; _i < 2; ++_i) \
        __builtin_amdgcn_global_load_lds((const unsigned*)((const char*)(gbase) + voffB[_i]), (LAS unsigned*)(lds + (bufoff) + ldsw + _i * 8192), 16, 0, 0); } while (0)
#define PG8_STAGE_A(bufoff, o0, o1, kb) do { \
        const char* gk_ = gA + (kb);      \
        __builtin_amdgcn_global_load_lds((const unsigned*)(gk_ + (o0)), (LAS unsigned*)(lds + (bufoff) + ldsw), 16, 0, 0); \
        __builtin_amdgcn_global_load_lds((const unsigned*)(gk_ + (o1)), (LAS unsigned*)(lds + (bufoff) + ldsw + 8192), 16, 0, 0); } while (0)
#define PG8_LDA(dst, b, h) do { _Pragma("unroll") for (int m = 0; m < 4; ++m) _Pragma("unroll") for (int k = 0; k < 2; ++k) dst[m][k] = *(const LAS bf16x8*)(lds + PG8_SA(b, h) + aoff + m * 2048 + k * 1024); } while (0)
#define PG8_LDB(dst, b, h) do { _Pragma("unroll") for (int n = 0; n < 2; ++n) _Pragma("unroll") for (int k = 0; k < 2; ++k) dst[n][k] = *(const LAS bf16x8*)(lds + PG8_SB(b, h) + boff + n * 2048 + k * 1024); } while (0)
#define PG8_MMA(ai, bj, At, Bt) do { __builtin_amdgcn_s_setprio(1); \
        if constexpr (Epi::F8) { _Pragma("unroll") for (int m = 0; m < 4; ++m) _Pragma("unroll") for (int n = 0; n < 2; ++n) { \
            const i32x8 a8_ = __builtin_shufflevector(__builtin_bit_cast(i32x4, At[m][0]), __builtin_bit_cast(i32x4, At[m][1]), 0, 1, 2, 3, 4, 5, 6, 7); \
            const i32x8 b8_ = __builtin_shufflevector(__builtin_bit_cast(i32x4, Bt[n][0]), __builtin_bit_cast(i32x4, Bt[n][1]), 0, 1, 2, 3, 4, 5, 6, 7); \
            acc[ai][bj][m][n] = __builtin_amdgcn_mfma_scale_f32_16x16x128_f8f6f4(b8_, a8_, acc[ai][bj][m][n], 0, 0, 0, 0x7F7F7F7F, 0, 0x7F7F7F7F); } } \
        else { _Pragma("unroll") for (int m = 0; m < 4; ++m) _Pragma("unroll") for (int n = 0; n < 2; ++n) _Pragma("unroll") for (int k = 0; k < 2; ++k) \
            acc[ai][bj][m][n] = __builtin_amdgcn_mfma_f32_16x16x32_bf16(Bt[n][k], At[m][k], acc[ai][bj][m][n], 0, 0, 0); } \
        __builtin_amdgcn_s_setprio(0); } while (0)
#define PG8_WAIT_V(n) asm volatile("s_waitcnt vmcnt(" #n ")" ::: "memory")
#define PG8_WAIT_L(n) asm volatile("s_waitcnt lgkmcnt(" #n ")" ::: "memory")
#define PG8_BAR __builtin_amdgcn_s_barrier()
#define PG8_SCHED __builtin_amdgcn_sched_barrier(0)
#define PG8_AOFFS(dst, u) do { _Pragma("unroll") for (int _h = 0; _h < 2; ++_h) _Pragma("unroll") for (int _i = 0; _i < 2; ++_i) { int R_, C_; stage_rc(tid * 16 + _i * 8192, R_, C_); \
        dst[_h][_i] = S.a_row(u, _h * HALF + R_) * ldab + (unsigned)C_ * 2u + S.a_koff(u); } } while (0)
    Unit cur, nxt; int ui = 0;
    if (!S.next(0, cur)) return;
#ifdef MK_STAGGER
    if (S.o.nwg > 3 * S.o.G) {
        const unsigned long long t0_ = __builtin_amdgcn_s_memrealtime(); const unsigned long long d_ = (unsigned long long)((blockIdx.x >> 3) & 7) * MK_STAGGER;
        while (__builtin_amdgcn_s_memrealtime() - t0_ < d_) __builtin_amdgcn_s_sleep(4);
    }
#endif
    f32x4 acc[2][2][4][2];
#pragma unroll
    for (int a = 0; a < 2; ++a)
#pragma unroll
        for (int b = 0; b < 2; ++b)
#pragma unroll
            for (int m = 0; m < 4; ++m)
#pragma unroll
                for (int n = 0; n < 2; ++n) acc[a][b][m][n] = (f32x4){0.f, 0.f, 0.f, 0.f};
    bf16x8 At[4][2], B0[2][2], B1[2][2];
    unsigned oc[2][2];
    LAS u32x4* nslot = (LAS u32x4*)(lds + LDSCTL_OFF + 2048) + tid;
    PG8_AOFFS(oc, cur);
    const char* cB = S.b_base(cur);
    PG8_STAGE_B(PG8_SB(0, 0), cB); PG8_STAGE_B(PG8_SB(0, 1), cB + hstepB); PG8_STAGE_A(PG8_SA(0, 0), oc[0][0], oc[0][1], 0u); PG8_STAGE_A(PG8_SA(0, 1), oc[1][0], oc[1][1], 0u);
    if (wr == 1) PG8_BAR;
    PG8_WAIT_V(2); PG8_BAR;
    PG8_STAGE_B(PG8_SB(1, 0), cB + kstep); PG8_STAGE_A(PG8_SA(1, 0), oc[0][0], oc[0][1], kstep); PG8_STAGE_B(PG8_SB(1, 1), cB + hstepB + kstep);
    PG8_WAIT_V(6); PG8_BAR;
    for (;;) {
        const bool has_next = S.next(ui + 1, nxt);
        const char* nB = has_next ? S.b_base(nxt) : cB;
        if (has_next) { unsigned on[2][2]; PG8_AOFFS(on, nxt); *nslot = (u32x4){on[0][0], on[0][1], on[1][0], on[1][1]}; }
        for (int t = 0; t < nt; t += 2) {
            const bool last = (t == nt - 2);
            const unsigned k1 = (unsigned)(t + 1) * kstep;
            const unsigned k2 = last ? 0u : (unsigned)(t + 2) * kstep, k3 = k2 + kstep;
            const char* b2 = last ? nB : cB + (size_t)(t + 2) * kstep; const char* b3 = b2 + kstep;
            PG8_LDB(B0, 0, 0); PG8_LDB(B1, 0, 1); PG8_SCHED; PG8_LDA(At, 0, 0); PG8_STAGE_A(PG8_SA(1, 1), oc[1][0], oc[1][1], k1);
            PG8_WAIT_V(8); PG8_WAIT_L(0); PG8_BAR; PG8_MMA(0, 0, At, B0); PG8_MMA(0, 1, At, B1); PG8_BAR; PG8_SCHED;
            if (last && has_next) { const u32x4 o_ = *nslot; oc[0][0] = o_.x; oc[0][1] = o_.y; oc[1][0] = o_.z; oc[1][1] = o_.w; }
            PG8_LDA(At, 0, 1); PG8_STAGE_B(PG8_SB(0, 0), b2); PG8_STAGE_B(PG8_SB(0, 1), b2 + hstepB); PG8_STAGE_A(PG8_SA(0, 0), oc[0][0], oc[0][1], k2);
            PG8_WAIT_V(8); PG8_WAIT_L(0); PG8_BAR; PG8_MMA(1, 0, At, B0); PG8_MMA(1, 1, At, B1); PG8_BAR; PG8_SCHED;
            PG8_LDB(B0, 1, 0); PG8_LDB(B1, 1, 1); PG8_SCHED; PG8_LDA(At, 1, 0); PG8_STAGE_A(PG8_SA(0, 1), oc[1][0], oc[1][1], k2);
            PG8_WAIT_V(8); PG8_WAIT_L(0); PG8_BAR; PG8_MMA(0, 0, At, B0); PG8_MMA(0, 1, At, B1); PG8_BAR; PG8_SCHED;
            PG8_LDA(At, 1, 1); PG8_STAGE_B(PG8_SB(1, 0), b3); PG8_STAGE_B(PG8_SB(1, 1), b3 + hstepB); PG8_STAGE_A(PG8_SA(1, 0), oc[0][0], oc[0][1], k3);
            PG8_WAIT_V(8); PG8_WAIT_L(0); PG8_BAR; PG8_MMA(1, 0, At, B0); PG8_MMA(1, 1, At, B1); PG8_BAR; PG8_SCHED;
        }
        if (wr == 0) PG8_BAR;
        bool carry = false;
        if constexpr (Epi::MIDK) { if (cur.e == 0) { E.mid(acc, cur, wr, wc, fr, fq); carry = true; } else E(acc, cur, wr, wc, fr, fq); } else E(acc, cur, wr, wc, fr, fq);
        if (!has_next) break;
        if (!carry)
#pragma unroll
        for (int a = 0; a < 2; ++a)
#pragma unroll
            for (int b = 0; b < 2; ++b)
#pragma unroll
                for (int m = 0; m < 4; ++m)
#pragma unroll
                    for (int n = 0; n < 2; ++n) acc[a][b][m][n] = (f32x4){0.f, 0.f, 0.f, 0.f};
        cur = nxt; cB = nB; ++ui;
        if (wr == 1) PG8_BAR;
    }
    PG8_WAIT_V(0);
    PG8_BAR;
#undef PG8_SA
#undef PG8_SB
#undef PG8_STAGE_A
#undef PG8_STAGE_B
#undef PG8_LDA
#undef PG8_LDB
#undef PG8_MMA
#undef PG8_WAIT_V
#undef PG8_WAIT_L
#undef PG8_BAR
#undef PG8_SCHED
#undef PG8_AOFFS
}

template <bool F8_> struct EpiProj {
    static constexpr bool PERM = true, MIDK = false, F8 = F8_;
    bf16_t* O; float* kmp;
    __device__ __forceinline__ void operator()(const f32x4 (&acc)[2][2][4][2], const Unit& u, int wr, int wc, int fr, int fq) const {
        const int row0 = u.pm * BM + wr * 64 + fr; const int col0 = u.pn * BM + wc * 32 + 8 * fq;
#pragma unroll
        for (int ai = 0; ai < 2; ++ai)
#pragma unroll
            for (int m = 0; m < 4; ++m) { bf16_t* rowp = O + (size_t)(row0 + ai * HALF + m * 16) * NPROJ + col0;
#pragma unroll
                for (int bj = 0; bj < 2; ++bj) { const float sc = F8 ? (1.0f / 32.0f) : 1.0f; const f32x4 v0 = acc[ai][bj][m][0] * sc, v1 = acc[ai][bj][m][1] * sc;
                    u32x4 w; w.x = cvt_pk_bf16(v0[0], v0[1]); w.y = cvt_pk_bf16(v0[2], v0[3]); w.z = cvt_pk_bf16(v1[0], v1[1]); w.w = cvt_pk_bf16(v1[2], v1[3]);
                    __builtin_nontemporal_store(w, (u32x4*)(rowp + bj * HALF)); } }
        if (u.pn >= C_KB / BM && u.pn < C_VB / BM) {
#pragma unroll
            for (int bj = 0; bj < 2; ++bj)
#pragma unroll
                for (int n = 0; n < 2; ++n) { f32x4 s = (f32x4){0.f, 0.f, 0.f, 0.f};
#pragma unroll
                    for (int ai = 0; ai < 2; ++ai)
#pragma unroll
                        for (int m = 0; m < 4; ++m) s += acc[ai][bj][m][n];
#pragma unroll
                    for (int o = 1; o < 16; o <<= 1) { s[0] += __shfl_xor(s[0], o); s[1] += __shfl_xor(s[1], o); s[2] += __shfl_xor(s[2], o); s[3] += __shfl_xor(s[3], o); }
                    if (fr == 0) *(f32x4*)(kmp + ((size_t)wr * 64 + u.pm) * 1024 + (u.pn - C_KB / BM) * BM + bj * HALF + wc * 32 + 8 * fq + 4 * n) = s * (F8 ? (1.0f / 32.0f) : 1.0f); }
        }
    }
};
struct EpiMerge {
    static constexpr bool PERM = true, MIDK = true, F8 = false;
    const bf16_t* proj; bf16_t* Y;
    __device__ __forceinline__ void mid(f32x4 (&acc)[2][2][4][2], const Unit& u, int wr, int wc, int fr, int fq) const {
        const int row0 = u.pm * BM + wr * 64 + fr; const int col0 = u.pn * BM + wc * 32 + 8 * fq;
#pragma unroll
        for (int ai = 0; ai < 2; ++ai) {
            u32x4 ga[4][2], gb[4][2];
#pragma unroll
            for (int m = 0; m < 4; ++m) { const bf16_t* rowp = proj + (size_t)(row0 + ai * HALF + m * 16) * NPROJ + col0;
#pragma unroll
                for (int bj = 0; bj < 2; ++bj) { ga[m][bj] = *(const u32x4*)(rowp + C_GA + bj * HALF); gb[m][bj] = *(const u32x4*)(rowp + C_GB + bj * HALF); } }
#pragma unroll
            for (int m = 0; m < 4; ++m) {
#pragma unroll
                for (int bj = 0; bj < 2; ++bj) {
#pragma unroll
                    for (int j = 0; j < 4; ++j) { const float a0 = bflo(ga[m][bj][j]), a1 = bfhi(ga[m][bj][j]), b0 = bflo(gb[m][bj][j]), b1 = bfhi(gb[m][bj][j]);
                        const float r0 = (1.0f + __builtin_amdgcn_exp2f(-1.4426950408889634f * b0)) * __builtin_amdgcn_rcpf(1.0f + __builtin_amdgcn_exp2f(-1.4426950408889634f * a0));
                        const float r1 = (1.0f + __builtin_amdgcn_exp2f(-1.4426950408889634f * b1)) * __builtin_amdgcn_rcpf(1.0f + __builtin_amdgcn_exp2f(-1.4426950408889634f * a1));
                        acc[ai][bj][m][j >> 1][(j & 1) * 2] *= r0; acc[ai][bj][m][j >> 1][(j & 1) * 2 + 1] *= r1; } }
                asm volatile("" : "+v"(acc[ai][0][m][0]), "+v"(acc[ai][0][m][1]), "+v"(acc[ai][1][m][0]), "+v"(acc[ai][1][m][1])); }
            asm volatile("" ::: "memory"); }
    }
    __device__ __forceinline__ void operator()(const f32x4 (&acc)[2][2][4][2], const Unit& u, int wr, int wc, int fr, int fq) const {
        const int row0 = u.pm * BM + wr * 64 + fr; const int col0 = u.pn * BM + wc * 32 + 8 * fq;
#pragma unroll
        for (int ai = 0; ai < 2; ++ai) {
            u32x4 gb[4][2];
#pragma unroll
            for (int m = 0; m < 4; ++m)
#pragma unroll
                for (int bj = 0; bj < 2; ++bj) gb[m][bj] = *(const u32x4*)(proj + (size_t)(row0 + ai * HALF + m * 16) * NPROJ + C_GB + col0 + bj * HALF);
#pragma unroll
            for (int m = 0; m < 4; ++m) { const size_t r = (size_t)(row0 + ai * HALF + m * 16);
#pragma unroll
                for (int bj = 0; bj < 2; ++bj) { const u32x4 g = gb[m][bj];
                    const f32x4 v0 = acc[ai][bj][m][0], v1 = acc[ai][bj][m][1];
                    u32x4 w; w.x = cvt_pk_bf16(v0[0] * fsigmoid(bflo(g[0])), v0[1] * fsigmoid(bfhi(g[0]))); w.y = cvt_pk_bf16(v0[2] * fsigmoid(bflo(g[1])), v0[3] * fsigmoid(bfhi(g[1])));
                    w.z = cvt_pk_bf16(v1[0] * fsigmoid(bflo(g[2])), v1[1] * fsigmoid(bfhi(g[2]))); w.w = cvt_pk_bf16(v1[2] * fsigmoid(bflo(g[3])), v1[3] * fsigmoid(bfhi(g[3])));
                    *(u32x4*)(Y + r * D + col0 + bj * HALF) = w; } }
            asm volatile("" ::: "memory"); }
    }
};
struct EpiResF32 {
    static constexpr bool PERM = false, MIDK = false, F8 = false;
    const float* base; float* out;
    __device__ __forceinline__ void operator()(const f32x4 (&acc)[2][2][4][2], const Unit& u, int wr, int wc, int fr, int fq) const {
        const int row0 = u.pm * BM + wr * 64 + fr, col0 = u.pn * BM + wc * 32 + 4 * fq;
#pragma unroll
        for (int ai = 0; ai < 2; ++ai) {
            f32x4 bs[4][2][2];
#pragma unroll
            for (int m = 0; m < 4; ++m) { const size_t off = (size_t)(row0 + ai * HALF + m * 16) * D + col0;
#pragma unroll
                for (int bj = 0; bj < 2; ++bj)
#pragma unroll
                    for (int n = 0; n < 2; ++n) bs[m][bj][n] = __builtin_nontemporal_load((const f32x4*)(base + off + bj * HALF + n * 16)); }
#pragma unroll
            for (int m = 0; m < 4; ++m) { const size_t off = (size_t)(row0 + ai * HALF + m * 16) * D + col0;
#pragma unroll
                for (int bj = 0; bj < 2; ++bj)
#pragma unroll
                    for (int n = 0; n < 2; ++n) *(f32x4*)(out + off + bj * HALF + n * 16) = bs[m][bj][n] + acc[ai][bj][m][n]; }
            asm volatile("" ::: "memory"); }
    }
};
struct EpiGlu {
    static constexpr bool PERM = true, MIDK = false, F8 = true;
    unsigned char* H; const float* rstd_e; const LAS int* tab; const float* bg; const float* bu;
    __device__ __forceinline__ void operator()(const f32x4 (&acc)[2][2][4][2], const Unit& u, int wr, int wc, int fr, int fq) const {
        const int row0 = u.pm * BM + wr * 64 + fr; const int colo = u.pn * HALF + wc * 32 + 8 * fq;
        f32x4 g4[2], u4[2];
#pragma unroll
        for (int n = 0; n < 2; ++n) { g4[n] = *(const f32x4*)(bg + (size_t)u.e * FF + colo + 4 * n); u4[n] = *(const f32x4*)(bu + (size_t)u.e * FF + colo + 4 * n); }
        float rsv[2][4];
#pragma unroll
        for (int ai = 0; ai < 2; ++ai)
#pragma unroll
            for (int m = 0; m < 4; ++m) { const int lr = row0 + ai * HALF + m * 16 - tab[u.e]; rsv[ai][m] = lr < tab[64 + u.e] ? rstd_e[(size_t)u.e * T + lr] : 0.f; }
#pragma unroll
        for (int ai = 0; ai < 2; ++ai)
#pragma unroll
            for (int m = 0; m < 4; ++m) { const int r = row0 + ai * HALF + m * 16; const float rs = rsv[ai][m] * (1.0f / 32.0f);
                float o[8];
#pragma unroll
                for (int n = 0; n < 2; ++n)
#pragma unroll
                    for (int j = 0; j < 4; ++j) { float g = acc[ai][0][m][n][j] * rs + g4[n][j], up = acc[ai][1][m][n][j] * rs + u4[n][j];
                        g = fminf(g, 7.0f); up = fminf(fmaxf(up, -7.0f), 7.0f);
                        const float glu = g * fsigmoid(1.702f * g); o[n * 4 + j] = (up + 1.0f) * glu; }
                u32x2 w; w.x = pk4_fp8(o[0], o[1], o[2], o[3]); w.y = pk4_fp8(o[4], o[5], o[6], o[7]);
                *(u32x2*)(H + (size_t)r * FF + colo) = w; asm volatile("" ::: "memory"); }
    }
};
template <int ACT, bool HASBIAS, bool F8_ = false> struct EpiBf16 {
    static constexpr bool PERM = true, MIDK = false, F8 = F8_;
    bf16_t* O; int ldc; const float* bias; int bias_stride; float scale;
    __device__ __forceinline__ void operator()(const f32x4 (&acc)[2][2][4][2], const Unit& u, int wr, int wc, int fr, int fq) const {
        const int row0 = u.pm * BM + wr * 64 + fr; const int col0 = u.pn * BM + wc * 32 + 8 * fq;
        f32x4 bv[2][2];
#pragma unroll
        for (int bj = 0; bj < 2; ++bj)
#pragma unroll
            for (int n = 0; n < 2; ++n) bv[bj][n] = HASBIAS ? *(const f32x4*)(bias + (size_t)u.e * bias_stride + col0 + bj * HALF + 4 * n) : (f32x4){0.f, 0.f, 0.f, 0.f};
#pragma unroll
        for (int ai = 0; ai < 2; ++ai)
#pragma unroll
            for (int m = 0; m < 4; ++m) { bf16_t* rowp = O + (size_t)(row0 + ai * HALF + m * 16) * ldc + col0;
#pragma unroll
                for (int bj = 0; bj < 2; ++bj) { f32x4 v0 = acc[ai][bj][m][0] * scale + bv[bj][0], v1 = acc[ai][bj][m][1] * scale + bv[bj][1];
                    if (ACT == 1) {
#pragma unroll
                        for (int j = 0; j < 4; ++j) { v0[j] = fsigmoid(v0[j]); v1[j] = fsigmoid(v1[j]); } }
                    u32x4 w; w.x = cvt_pk_bf16(v0[0], v0[1]); w.y = cvt_pk_bf16(v0[2], v0[3]); w.z = cvt_pk_bf16(v1[0], v1[1]); w.w = cvt_pk_bf16(v1[2], v1[3]);
                    *(u32x4*)(rowp + bj * HALF) = w; }
                asm volatile("" ::: "memory"); }
    }
};
struct EpiDownF8 {
    static constexpr bool PERM = true, MIDK = false, F8 = true;
    unsigned char* O; const float* bias;
    __device__ __forceinline__ void operator()(const f32x4 (&acc)[2][2][4][2], const Unit& u, int wr, int wc, int fr, int fq) const {
        const int row0 = u.pm * BM + wr * 64 + fr; const int col0 = u.pn * BM + wc * 32 + 8 * fq;
        f32x4 bv[2][2];
#pragma unroll
        for (int bj = 0; bj < 2; ++bj)
#pragma unroll
            for (int n = 0; n < 2; ++n) bv[bj][n] = *(const f32x4*)(bias + (size_t)u.e * D + col0 + bj * HALF + 4 * n);
#pragma unroll
        for (int ai = 0; ai < 2; ++ai)
#pragma unroll
            for (int m = 0; m < 4; ++m) { unsigned char* rowp = O + (size_t)(row0 + ai * HALF + m * 16) * D + col0;
#pragma unroll
                for (int bj = 0; bj < 2; ++bj) { const f32x4 v0 = acc[ai][bj][m][0] * (1.0f / 32.0f) + bv[bj][0], v1 = acc[ai][bj][m][1] * (1.0f / 32.0f) + bv[bj][1];
                    u32x2 w; w.x = pk4_fp8(v0[0], v0[1], v0[2], v0[3]); w.y = pk4_fp8(v1[0], v1[1], v1[2], v1[3]);
                    *(u32x2*)(rowp + bj * HALF) = w; }
                asm volatile("" ::: "memory"); }
    }
};
}
__device__ __forceinline__ void transpose_item(const float* __restrict__ W, int ldw, int k0, int n_src0, bf16_t* __restrict__ WT, int ldo, int n_dst0, int k_off, LAS float* scr, int lane) {
    { float t_[32]; const float* wp_ = W + (size_t)(k0 + (lane >> 5)) * ldw + n_src0 + (lane & 31);
#pragma unroll
    for (int i = 0; i < 32; ++i) t_[i] = __builtin_nontemporal_load(wp_ + (size_t)(2 * i) * ldw);
#pragma unroll
    for (int i = 0; i < 32; ++i) scr[(2 * i + (lane >> 5)) * 33 + (lane & 31)] = t_[i]; }
    LDS_WAIT(); asm volatile("" ::: "memory");
    const int c = lane & 7;
#pragma unroll
    for (int j = 0; j < 4; ++j) { const int n = (lane >> 3) + 8 * j; const LAS float* s = scr + (8 * c) * 33 + n;
        u32x4 o; o.x = cvt_pk_bf16(s[0 * 33], s[1 * 33]); o.y = cvt_pk_bf16(s[2 * 33], s[3 * 33]); o.z = cvt_pk_bf16(s[4 * 33], s[5 * 33]); o.w = cvt_pk_bf16(s[6 * 33], s[7 * 33]);
        *(u32x4*)(WT + (size_t)(n_dst0 + n) * ldo + k_off + k0 + 8 * c) = o; }
    LDS_WAIT(); asm volatile("" ::: "memory");
}
__device__ __forceinline__ void transpose_item_f8(const float* __restrict__ W, int ldw, int k0, int n_src0, unsigned char* __restrict__ WT, int ldo, int n_dst0, float sc, LAS float* scr, int lane) {
    { float t_[32]; const float* wp_ = W + (size_t)(k0 + (lane >> 5)) * ldw + n_src0 + (lane & 31);
#pragma unroll
    for (int i = 0; i < 32; ++i) t_[i] = __builtin_nontemporal_load(wp_ + (size_t)(2 * i) * ldw);
#pragma unroll
    for (int i = 0; i < 32; ++i) scr[(2 * i + (lane >> 5)) * 33 + (lane & 31)] = t_[i]; }
    LDS_WAIT(); asm volatile("" ::: "memory");
    const int c = lane & 7;
#pragma unroll
    for (int j = 0; j < 4; ++j) { const int n = (lane >> 3) + 8 * j; const LAS float* s = scr + (8 * c) * 33 + n;
        u32x2 o; o.x = pk4_fp8(s[0 * 33] * sc, s[1 * 33] * sc, s[2 * 33] * sc, s[3 * 33] * sc); o.y = pk4_fp8(s[4 * 33] * sc, s[5 * 33] * sc, s[6 * 33] * sc, s[7 * 33] * sc);
        *(u32x2*)(WT + (size_t)(n_dst0 + n) * ldo + k0 + 8 * c) = o; }
    LDS_WAIT(); asm volatile("" ::: "memory");
}
__device__ __forceinline__ void transpose_mat_item(const float* W, int ldw, int N, int n_src_base, bf16_t* WT, int ldo, int n_dst_base, int k_off, LAS float* scr, int item, int lane) {
    const int nblk = N / 32, kb = item / nblk, nb = item % nblk;
    transpose_item(W, ldw, 64 * kb, n_src_base + 32 * nb, WT, ldo, n_dst_base + 32 * nb, k_off, scr, lane);
}

struct P {
    const float* in[25]; float* out; unsigned char* ws;
};

__device__ __forceinline__ void p0_prologue(const P& a, LAS unsigned char* lds, int vcu, int G, int wave, int lane) {
    LAS float* scr = (LAS float*)(lds + wave * 16384);
    const int gw = vcu * NWAVES + wave, NGW = G * NWAVES;
    unsigned char* ws = a.ws;
    bf16_t* WinT = (bf16_t*)(ws + WS_WIN); bf16_t* WupT = (bf16_t*)(ws + WS_WUP); bf16_t* WoT = (bf16_t*)(ws + WS_WO); bf16_t* WpgT = (bf16_t*)(ws + WS_WPG); bf16_t* WppT = (bf16_t*)(ws + WS_WPP);
    constexpr int I_A = 16 * 96, I_B = 16 * 160, I_S = 16 * 32, I_P = 4 * 32;
    constexpr int NITEMS = I_A + I_B + 4 * I_S + I_P;
#ifndef P0_PARTS
#define P0_PARTS 63
#endif
    if (P0_PARTS & 1)
    for (int it = gw; it < NITEMS; it += NGW) {
        int r = it;
        if (r < I_A) { transpose_mat_item(a.in[4], D_IN, 3072, 0, WinT, D, 0, 0, scr, r, lane); continue; } r -= I_A;
        if (r < I_B) { transpose_mat_item(a.in[4], D_IN, 5120, 3088, WinT, D, 3072, 0, scr, r, lane); continue; } r -= I_B;
        if (r < I_S) { transpose_mat_item(a.in[8], D, D, 0, WupT, 2048, 0, 0, scr, r, lane); continue; } r -= I_S;
        if (r < I_S) { transpose_mat_item(a.in[9], D, D, 0, WupT, 2048, 0, 1024, scr, r, lane); continue; } r -= I_S;
        if (r < I_S) { transpose_mat_item(a.in[10], D, D, 0, WoT, D, 0, 0, scr, r, lane); continue; } r -= I_S;
        if (r < I_S) { const int kb = r / 32, nb = r % 32; transpose_item_f8(a.in[21], D, 64 * kb, 32 * nb, (unsigned char*)WpgT, D, 32 * nb, 32.0f, scr, lane); continue; } r -= I_S;
        transpose_mat_item(a.in[22], D, D, 0, WppT, 256, 0, 0, scr, r, lane);
    }
    if (P0_PARTS & 2) {
        const float* x = a.in[0]; const float* g = a.in[3]; bf16_t* H = (bf16_t*)(ws + WS_H);
        f32x4 gv[4];
#pragma unroll
        for (int j = 0; j < 4; ++j) gv[j] = *((const f32x4*)g + lane + 64 * j);
        for (int m = gw; m < T; m += NGW) {
            const f32x4* xr = (const f32x4*)(x + (size_t)m * D) + lane; f32x4 v[4]; float s = 0.f;
#pragma unroll
            for (int j = 0; j < 4; ++j) { v[j] = __builtin_nontemporal_load(xr + 64 * j); s += (v[j].x * v[j].x + v[j].y * v[j].y) + (v[j].z * v[j].z + v[j].w * v[j].w); }
            const float rstd = 1.0f / sqrtf(wave_sum(s) * (1.0f / D) + EPS);
            u32x2* o8 = (u32x2*)(H + (size_t)m * D) + lane;
#pragma unroll
            for (int j = 0; j < 4; ++j) { const f32x4 y = v[j] * rstd * gv[j]; u32x2 w; w.x = cvt_pk_bf16(y.x, y.y); w.y = cvt_pk_bf16(y.z, y.w); o8[64 * j] = w; }
        }
    }
    if (P0_PARTS & 4) {
        const f32x4* p4 = (const f32x4*)a.in[1]; u32x2* pb = (u32x2*)(ws + WS_PB);
        const size_t n4 = (size_t)T * 256 / 4;
        for (size_t i = (size_t)gw * 64 + lane; i < n4; i += (size_t)NGW * 64) { const f32x4 v = __builtin_nontemporal_load(p4 + i); u32x2 w; w.x = cvt_pk_bf16(v.x, v.y); w.y = cvt_pk_bf16(v.z, v.w); pb[i] = w; }
    }
    if (P0_PARTS & 8) {
        const int gt = (vcu * NWAVES + wave) * 64 + lane;
        if ((P0_PARTS & 16) && gt < 16 * 1024) { const int n = gt >> 10, k = gt & 1023; ((bf16_t*)(ws + WS_WALT))[n * 1024 + k] = (bf16_t)(cvt_pk_bf16(a.in[4][(size_t)k * D_IN + SRC_ALOW + n], 0.f) & 0xffffu); }
        if ((P0_PARTS & 32) && gt < 4096) { const int s = gt >> 6, l = gt & 63, e = l & 31, hh = l >> 5; const float* wr = a.in[12];
            float v[8], lo[8];
#pragma unroll
            for (int j = 0; j < 8; ++j) { v[j] = wr[(size_t)(16 * s + 8 * hh + j) * NE + e]; }
            u32x4 whi; whi.x = cvt_pk_bf16(v[0], v[1]); whi.y = cvt_pk_bf16(v[2], v[3]); whi.z = cvt_pk_bf16(v[4], v[5]); whi.w = cvt_pk_bf16(v[6], v[7]);
#pragma unroll
            for (int j = 0; j < 4; ++j) { lo[2 * j] = v[2 * j] - bflo(whi[j]); lo[2 * j + 1] = v[2 * j + 1] - bfhi(whi[j]); }
            u32x4 wlo; wlo.x = cvt_pk_bf16(lo[0], lo[1]); wlo.y = cvt_pk_bf16(lo[2], lo[3]); wlo.z = cvt_pk_bf16(lo[4], lo[5]); wlo.w = cvt_pk_bf16(lo[6], lo[7]);
            u32x4* f = (u32x4*)(ws + WS_WRF); f[gt] = whi; f[4096 + gt] = wlo; }
    }
}

struct CvtItem { const float* src; unsigned char* dst; int ldo; };
__device__ __forceinline__ CvtItem cvt_item(const P& a, int it, int lane) {
    constexpr int IPM = 16 * 32;
    const int e = it / (3 * IPM), r0 = it % (3 * IPM), which = r0 / IPM, r = r0 % IPM, kb = r / 32, nb = r % 32, n0 = 32 * nb;
    CvtItem c;
    if (which < 2) { c.src = a.in[which == 0 ? 14 : 16] + (size_t)e * D * FF + (size_t)(64 * kb + (lane >> 5)) * FF + n0 + (lane & 31);
        c.dst = (unsigned char*)a.out + ((size_t)e * 2048 + (n0 >> 7) * 256 + (n0 & 127) + which * 128) * D + 64 * kb; c.ldo = D; }
    else { c.src = a.in[18] + (size_t)e * FF * D + (size_t)(64 * kb + (lane >> 5)) * D + n0 + (lane & 31);
        c.dst = a.ws + WS_W2T + ((size_t)e * D + n0) * FF + 64 * kb; c.ldo = FF; }
    return c;
}
__device__ __forceinline__ void expert_convert(const P& a, LAS unsigned char* lds, int vcu, int G, int wave, int lane) {
    LAS float* scr = (LAS float*)(lds + wave * 16384);
    const int gw = vcu * NWAVES + wave, NGW = G * NWAVES;
    constexpr int NIT = NE * 3 * 16 * 32;
    if (gw >= NIT) return;
    float tA[32], tB[32];
    CvtItem cA = cvt_item(a, gw, lane), cB = cvt_item(a, gw + NGW < NIT ? gw + NGW : gw, lane);
#pragma unroll
    for (int i = 0; i < 32; ++i) tA[i] = __builtin_nontemporal_load(cA.src + (size_t)(2 * i) * 1024);
#pragma unroll
    for (int i = 0; i < 32; ++i) tB[i] = __builtin_nontemporal_load(cB.src + (size_t)(2 * i) * 1024);
#define CVT_OUT(c_) do { LDS_WAIT(); asm volatile("" ::: "memory"); const int c = lane & 7; \
        _Pragma("unroll") for (int j = 0; j < 4; ++j) { const int n = (lane >> 3) + 8 * j; const LAS float* s = scr + (8 * c) * 33 + n; \
            u32x2 o; o.x = pk4_fp8(s[0 * 33] * 32.0f, s[1 * 33] * 32.0f, s[2 * 33] * 32.0f, s[3 * 33] * 32.0f); o.y = pk4_fp8(s[4 * 33] * 32.0f, s[5 * 33] * 32.0f, s[6 * 33] * 32.0f, s[7 * 33] * 32.0f); \
            __builtin_nontemporal_store(o, (u32x2*)((c_).dst + (size_t)n * (c_).ldo + 8 * c)); } \
        LDS_WAIT(); asm volatile("" ::: "memory"); } while (0)
    for (int it = gw; it < NIT; it += 2 * NGW) {
#pragma unroll
        for (int i = 0; i < 32; ++i) scr[(2 * i + (lane >> 5)) * 33 + (lane & 31)] = tA[i];
        const CvtItem dA = cA; const int n2 = it + 2 * NGW;
        if (n2 < NIT) { cA = cvt_item(a, n2, lane);
#pragma unroll
            for (int i = 0; i < 32; ++i) tA[i] = __builtin_nontemporal_load(cA.src + (size_t)(2 * i) * 1024); }
        CVT_OUT(dA);
        if (it + NGW >= NIT) break;
#pragma unroll
        for (int i = 0; i < 32; ++i) scr[(2 * i + (lane >> 5)) * 33 + (lane & 31)] = tB[i];
        const CvtItem dB = cB; const int n3 = it + 3 * NGW;
        if (n3 < NIT) { cB = cvt_item(a, n3, lane);
#pragma unroll
            for (int i = 0; i < 32; ++i) tB[i] = __builtin_nontemporal_load(cB.src + (size_t)(2 * i) * 1024); }
        CVT_OUT(dB);
    }
#undef CVT_OUT
}

__device__ __forceinline__ float fexp_(float x) { return __builtin_amdgcn_exp2f(x * 1.4426950408889634f); }
__device__ __forceinline__ float logsigmoidf_(float x) { const float e = fexp_(-fabsf(x)); return fminf(x, 0.0f) - 0.6931471805599453f * __builtin_amdgcn_logf(1.0f + e); }
__device__ __forceinline__ void gla_prep_unit(const P& a, LAS unsigned char* lds, int unit) {
    int tid = threadIdx.x; asm volatile("" : "+v"(tid));     const int wave = __builtin_amdgcn_readfirstlane(tid >> 6), lane = tid & 63;
    const int b = unit >> 5, chunk = unit & 31, tok0 = b * SEQ + chunk * 64;
    const bf16_t* H = (const bf16_t*)(a.ws + WS_H); const bf16_t* WalT = (const bf16_t*)(a.ws + WS_WALT); const bf16_t* proj = (const bf16_t*)(a.ws + WS_PROJ);
    LAS float* part = (LAS float*)lds;
    LAS float* alow = (LAS float*)(lds + 8192);
    LAS float* seg = (LAS float*)(lds + 12288);
    constexpr int GP_KDT = 16384, GP_VT = 34816;
    {
        const int rg = wave & 3, kh = wave >> 2, r = lane & 15, q = lane >> 4;
        f32x4 acc = (f32x4){0.f, 0.f, 0.f, 0.f};
        const bf16_t* ap = H + (size_t)(tok0 + 16 * rg + r) * D + 512 * kh + 8 * q; const bf16_t* bp = WalT + (size_t)r * D + 512 * kh + 8 * q;
#pragma unroll 8
        for (int s = 0; s < 16; ++s) { const bf16x8 av = *(const bf16x8*)(ap + 32 * s), bv = *(const bf16x8*)(bp + 32 * s); acc = __builtin_amdgcn_mfma_f32_16x16x32_bf16(bv, av, acc, 0, 0, 0); }
        *(LAS f32x4*)(part + (kh * 64 + 16 * rg + r) * 16 + 4 * q) = acc;
    }
    __syncthreads();
    if (tid < 256) { *(LAS f32x4*)(alow + tid * 4) = *(LAS f32x4*)(part + tid * 4) + *(LAS f32x4*)(part + 1024 + tid * 4); }
    __syncthreads();
    const int dp = tid & 63, tq = wave;
    const float* w_a2 = a.in[5]; const float* b_a2 = a.in[6];
    const int ep = tid & 127, sq4 = tid >> 7;
    f32x2 w2[16], w2n[16]; f32x2 b2, b2n; unsigned qv[8], kv[8], qvn[8], kvn[8], sv[16], svn[16];
#define GP_LOADS(h_, W2, B2, QV, KV, SV) do { const int dc_ = (h_) * 128 + 2 * dp; \
        _Pragma("unroll") for (int r = 0; r < 16; ++r) W2[r] = *(const f32x2*)(w_a2 + r * 512 + dc_); \
        B2 = *(const f32x2*)(b_a2 + dc_); \
        _Pragma("unroll") for (int i = 0; i < 8; ++i) { const bf16_t* rp = proj + (size_t)(tok0 + 8 * tq + i) * NPROJ + dc_; QV[i] = __builtin_nontemporal_load((const unsigned*)(rp + C_QA)); KV[i] = __builtin_nontemporal_load((const unsigned*)(rp + C_KA)); } \
        const bf16_t* v_ = proj + (size_t)(tok0 + 16 * sq4) * NPROJ + C_VA + (h_) * 256 + 2 * ep; \
        _Pragma("unroll") for (int i = 0; i < 16; ++i) SV[i] = __builtin_nontemporal_load((const unsigned*)(v_ + (size_t)i * NPROJ)); } while (0)
    GP_LOADS(0, w2, b2, qv, kv, sv);
    for (int h = 0; h < 4; ++h) {
        if (h + 1 < 4) GP_LOADS(h + 1, w2n, b2n, qvn, kvn, svn);
        float G0[8], G1[8]; float r0 = 0.f, r1 = 0.f;
#pragma unroll
        for (int i = 0; i < 8; ++i) { const LAS f32x4* al4 = (const LAS f32x4*)(alow + (8 * tq + i) * 16); float x0 = b2.x, x1 = b2.y;
#pragma unroll
            for (int r4 = 0; r4 < 4; ++r4) { const f32x4 al = al4[r4];
#pragma unroll
                for (int j = 0; j < 4; ++j) { x0 += al[j] * w2[4 * r4 + j].x; x1 += al[j] * w2[4 * r4 + j].y; } }
            r0 += logsigmoidf_(x0) * (1.0f / 16.0f); r1 += logsigmoidf_(x1) * (1.0f / 16.0f); G0[i] = r0; G1[i] = r1; }
        *(LAS f32x2*)(seg + tq * 128 + 2 * dp) = (f32x2){r0, r1};
        __syncthreads();
        float off0 = 0.f, off1 = 0.f, tot0 = 0.f, tot1 = 0.f;
#pragma unroll
        for (int q = 0; q < 8; ++q) { const f32x2 s = *(LAS f32x2*)(seg + q * 128 + 2 * dp); tot0 += s.x; tot1 += s.y; if (q < tq) { off0 += s.x; off1 += s.y; } }
        const size_t tile = (size_t)((b * 4 + h) * 32 + chunk);
        bf16_t* Qg = (bf16_t*)(a.ws + WS_QG) + tile * 8192; bf16_t* Kg = (bf16_t*)(a.ws + WS_KG) + tile * 8192;
        float kd0[8], kd1[8];
#pragma unroll
        for (int i = 0; i < 8; ++i) { const float g0 = G0[i] + off0, g1 = G1[i] + off1; const float q0 = bflo(qv[i]), q1 = bfhi(qv[i]), k0 = bflo(kv[i]), k1 = bfhi(kv[i]);
            const float e0 = fexp_(g0), e1 = fexp_(g1);
            *(unsigned*)(Qg + (8 * tq + i) * 128 + 2 * dp) = cvt_pk_bf16(q0 * e0 * 0.08838834764831845f, q1 * e1 * 0.08838834764831845f);
            *(unsigned*)(Kg + (8 * tq + i) * 128 + 2 * dp) = cvt_pk_bf16(k0 * __builtin_amdgcn_rcpf(e0), k1 * __builtin_amdgcn_rcpf(e1));
            kd0[i] = k0 * fexp_(tot0 - g0); kd1[i] = k1 * fexp_(tot1 - g1); }
        u32x4 w0, w1; w0.x = cvt_pk_bf16(kd0[0], kd0[1]); w0.y = cvt_pk_bf16(kd0[2], kd0[3]); w0.z = cvt_pk_bf16(kd0[4], kd0[5]); w0.w = cvt_pk_bf16(kd0[6], kd0[7]);
        w1.x = cvt_pk_bf16(kd1[0], kd1[1]); w1.y = cvt_pk_bf16(kd1[2], kd1[3]); w1.z = cvt_pk_bf16(kd1[4], kd1[5]); w1.w = cvt_pk_bf16(kd1[6], kd1[7]);
        *(LAS u32x4*)(lds + GP_KDT + (2 * dp) * 144 + 16 * tq) = w0; *(LAS u32x4*)(lds + GP_KDT + (2 * dp + 1) * 144 + 16 * tq) = w1;
        if (tq == 0) *(f32x2*)((float*)(a.ws + WS_DEC) + tile * 128 + 2 * dp) = (f32x2){fexp_(tot0), fexp_(tot1)};
        {
            u32x4 lo0, lo1, hi0, hi1;
#pragma unroll
            for (int j = 0; j < 4; ++j) { lo0[j] = (sv[2 * j] & 0xffffu) | (sv[2 * j + 1] << 16); lo1[j] = (sv[8 + 2 * j] & 0xffffu) | (sv[8 + 2 * j + 1] << 16);
                hi0[j] = (sv[2 * j] >> 16) | (sv[2 * j + 1] & 0xffff0000u); hi1[j] = (sv[8 + 2 * j] >> 16) | (sv[8 + 2 * j + 1] & 0xffff0000u); }
            LAS unsigned char* v0 = lds + GP_VT + (2 * ep) * 144 + sq4 * 32;
            *(LAS u32x4*)(v0) = lo0; *(LAS u32x4*)(v0 + 16) = lo1; *(LAS u32x4*)(v0 + 144) = hi0; *(LAS u32x4*)(v0 + 144 + 16) = hi1;
        }
        __syncthreads();
        {
            const int c32 = lane & 31, hi = lane >> 5;
            bf16x8 vt[4];
#pragma unroll
            for (int ks = 0; ks < 4; ++ks) vt[ks] = *(const LAS bf16x8*)(lds + GP_VT + (32 * wave + c32) * 144 + (16 * ks + 8 * hi) * 2);
            unsigned* sl = (unsigned*)(a.ws + WS_SLOC) + tile * 8192;
#pragma unroll
            for (int tl = 0; tl < 4; ++tl) { f32x16 acc;
#pragma unroll
                for (int r = 0; r < 16; ++r) acc[r] = 0.f;
#pragma unroll
                for (int ks = 0; ks < 4; ++ks) { const bf16x8 av = *(const LAS bf16x8*)(lds + GP_KDT + (32 * tl + c32) * 144 + (16 * ks + 8 * hi) * 2); acc = __builtin_amdgcn_mfma_f32_32x32x16_bf16(av, vt[ks], acc, 0, 0, 0); }
#pragma unroll
                for (int g = 0; g < 4; ++g) sl[((tl * 4 + g) * 2 + hi) * 256 + 32 * wave + c32] = pk4_fp8(acc[4 * g], acc[4 * g + 1], acc[4 * g + 2], acc[4 * g + 3]); }
        }
        __syncthreads();
#pragma unroll
        for (int r = 0; r < 16; ++r) { w2[r] = w2n[r]; sv[r] = svn[r]; }
#pragma unroll
        for (int i = 0; i < 8; ++i) { qv[i] = qvn[i]; kv[i] = kvn[i]; }
        b2 = b2n;
    }
#undef GP_LOADS
}

constexpr int GL_QG = 0, GL_KG = 17408, GL_VT = 53248, GL_AM = 90112, GL_OST = 0;
constexpr int GL_QS = 272, GL_TS = 144, GL_OS = 528;
__device__ __forceinline__ int crow(int r, int hi) { return (r & 3) + 8 * (r >> 2) + 4 * hi; }
__device__ __forceinline__ void gla_out_chunk(const P& a, LAS unsigned char* lds, int bh, int chunk, const float (&st)[16][4]) {
    int tid = threadIdx.x; asm volatile("" : "+v"(tid)); const int w = __builtin_amdgcn_readfirstlane(tid >> 6), lane = tid & 63, c32 = lane & 31, hi = lane >> 5;
    const int b = bh >> 2, h = bh & 3;
    const bf16_t* proj = (const bf16_t*)(a.ws + WS_PROJ); bf16_t* oab = (bf16_t*)(a.ws + WS_OAB); const float* ggo = a.in[7];
    const size_t tile = (size_t)bh * 32 + chunk;
    {
        const u32x4* q_ = (const u32x4*)((const bf16_t*)(a.ws + WS_QG) + tile * 8192); const u32x4* k_ = (const u32x4*)((const bf16_t*)(a.ws + WS_KG) + tile * 8192);
        u32x4 sq[2], sk[2]; unsigned sv[16];
        sq[0] = __builtin_nontemporal_load(q_ + tid); sq[1] = __builtin_nontemporal_load(q_ + tid + 512); sk[0] = __builtin_nontemporal_load(k_ + tid); sk[1] = __builtin_nontemporal_load(k_ + tid + 512);
        const int ep = tid & 127, sq4 = tid >> 7;
        const bf16_t* v_ = proj + (size_t)(b * SEQ + chunk * 64 + 16 * sq4) * NPROJ + C_VA + h * 256 + 2 * ep;
#pragma unroll
        for (int i = 0; i < 16; ++i) sv[i] = __builtin_nontemporal_load((const unsigned*)(v_ + (size_t)i * NPROJ));
#pragma unroll
        for (int i = 0; i < 2; ++i) { const int p = tid + 512 * i;
            *(LAS u32x4*)(lds + GL_QG + (p >> 4) * GL_QS + (p & 15) * 16) = sq[i]; *(LAS u32x4*)(lds + GL_KG + (p >> 4) * GL_QS + (p & 15) * 16) = sk[i]; }
        u32x4 lo0, lo1, hi0, hi1;
#pragma unroll
        for (int j = 0; j < 4; ++j) { lo0[j] = (sv[2 * j] & 0xffffu) | (sv[2 * j + 1] << 16); lo1[j] = (sv[8 + 2 * j] & 0xffffu) | (sv[8 + 2 * j + 1] << 16);
            hi0[j] = (sv[2 * j] >> 16) | (sv[2 * j + 1] & 0xffff0000u); hi1[j] = (sv[8 + 2 * j] >> 16) | (sv[8 + 2 * j + 1] & 0xffff0000u); }
        LAS unsigned char* v0 = lds + GL_VT + (2 * ep) * GL_TS + sq4 * 32;
        *(LAS u32x4*)(v0) = lo0; *(LAS u32x4*)(v0 + 16) = lo1; *(LAS u32x4*)(v0 + GL_TS) = hi0; *(LAS u32x4*)(v0 + GL_TS + 16) = hi1;
    }
    u32x2 sf[4][2][2];
#pragma unroll
    for (int tl = 0; tl < 4; ++tl)
#pragma unroll
        for (int s = 0; s < 2; ++s)
#pragma unroll
            for (int q = 0; q < 2; ++q) { const int i_ = tl * 4 + 2 * s + q; sf[tl][s][q].x = cvt_pk_bf16(st[i_][0], st[i_][1]); sf[tl][s][q].y = cvt_pk_bf16(st[i_][2], st[i_][3]); }
    __syncthreads();
    if (w < 3) {
        const int ti = (w + 1) >> 1, si = w >> 1;
        f32x16 A;
#pragma unroll
        for (int r = 0; r < 16; ++r) A[r] = 0.f;
#pragma unroll
        for (int s = 0; s < 8; ++s) { const bf16x8 av = *(const LAS bf16x8*)(lds + GL_QG + (32 * ti + c32) * GL_QS + (16 * s + 8 * hi) * 2), bv = *(const LAS bf16x8*)(lds + GL_KG + (32 * si + c32) * GL_QS + (16 * s + 8 * hi) * 2);
            A = __builtin_amdgcn_mfma_f32_32x32x16_bf16(av, bv, A, 0, 0, 0); }
        const int sidx = 32 * si + c32;
#pragma unroll
        for (int r = 0; r < 16; ++r) { const int t = 32 * ti + crow(r, hi); const float v = (sidx <= t) ? A[r] : 0.f;
            *(LAS bf16_t*)(lds + GL_AM + t * GL_TS + sidx * 2) = (bf16_t)(cvt_pk_bf16(v, 0.f) & 0xffffu); }
    }
    __syncthreads();
    f32x16 o[2];
    {
        bf16x8 vt[4];
#pragma unroll
        for (int ks = 0; ks < 4; ++ks) vt[ks] = *(const LAS bf16x8*)(lds + GL_VT + (32 * w + c32) * GL_TS + (16 * ks + 8 * hi) * 2);
#pragma unroll
        for (int ti = 0; ti < 2; ++ti) {
#pragma unroll
            for (int r = 0; r < 16; ++r) o[ti][r] = 0.f;
            if (chunk > 0) {
#pragma unroll
                for (int tl = 0; tl < 4; ++tl)
#pragma unroll
                    for (int s = 0; s < 2; ++s) { const LAS unsigned char* qp = lds + GL_QG + (32 * ti + c32) * GL_QS + (32 * tl + 16 * s + 4 * hi) * 2;
                        const s16x4 lo = *(const LAS s16x4*)qp, hh = *(const LAS s16x4*)(qp + 16);
                        const bf16x8 aop = __builtin_shufflevector(lo, hh, 0, 1, 2, 3, 4, 5, 6, 7);
                        const u32x4 bw = {sf[tl][s][0].x, sf[tl][s][0].y, sf[tl][s][1].x, sf[tl][s][1].y};
                        o[ti] = __builtin_amdgcn_mfma_f32_32x32x16_bf16(aop, __builtin_bit_cast(bf16x8, bw), o[ti], 0, 0, 0); }
            }
#pragma unroll
            for (int ks = 0; ks < 4; ++ks) { if (ti == 0 && ks >= 2) continue;
                const bf16x8 av = *(const LAS bf16x8*)(lds + GL_AM + (32 * ti + c32) * GL_TS + (16 * ks + 8 * hi) * 2);
                o[ti] = __builtin_amdgcn_mfma_f32_32x32x16_bf16(av, vt[ks], o[ti], 0, 0, 0); }
        }
    }
    __syncthreads();
#pragma unroll
    for (int ti = 0; ti < 2; ++ti)
#pragma unroll
        for (int r = 0; r < 16; ++r) *(LAS bf16_t*)(lds + GL_OST + (32 * ti + crow(r, hi)) * GL_OS + (32 * w + c32) * 2) = (bf16_t)(cvt_pk_bf16(o[ti][r], 0.f) & 0xffffu);
    __syncthreads();
    {
        const int t = tid >> 3, sg = tid & 7; const size_t tok = (size_t)(b * SEQ + chunk * 64 + t);
        u32x4 ov[4]; float ss = 0.f;
#pragma unroll
        for (int j = 0; j < 4; ++j) { ov[j] = *(const LAS u32x4*)(lds + GL_OST + t * GL_OS + sg * 64 + j * 16);
#pragma unroll
            for (int i = 0; i < 4; ++i) { const float x0 = bflo(ov[j][i]), x1 = bfhi(ov[j][i]); ss += x0 * x0 + x1 * x1; } }
        ss += __shfl_xor(ss, 1); ss += __shfl_xor(ss, 2); ss += __shfl_xor(ss, 4);
        const float rstd = 1.0f / sqrtf(ss * (1.0f / 256.0f) + EPS);
        const bf16_t* rap = proj + tok * NPROJ + C_RA + h * 256 + sg * 32; bf16_t* op = oab + tok * 2048 + h * 256 + sg * 32; const float* gp = ggo + sg * 32;
#pragma unroll
        for (int j = 0; j < 4; ++j) { const u32x4 ra = __builtin_nontemporal_load((const u32x4*)(rap + 8 * j)); const f32x4 g0 = *(const f32x4*)(gp + 8 * j), g1 = *(const f32x4*)(gp + 8 * j + 4); u32x4 wv;
#pragma unroll
            for (int i = 0; i < 4; ++i) { const float r0 = bflo(ra[i]), r1 = bfhi(ra[i]); const float ga = (i < 2) ? g0[2 * i] : g1[2 * i - 4], gb = (i < 2) ? g0[2 * i + 1] : g1[2 * i - 3];
                wv[i] = cvt_pk_bf16(bflo(ov[j][i]) * rstd * ga * (r0 * fsigmoid(r0)), bfhi(ov[j][i]) * rstd * gb * (r1 * fsigmoid(r1))); }
            *(u32x4*)(op + 8 * j) = wv; }
    }
    __syncthreads();
}

__device__ __forceinline__ void gla_out_group(const P& a, LAS unsigned char* lds, int unit) {
    const int tid = threadIdx.x, w = tid >> 6, lane = tid & 63, c32 = lane & 31, hi = lane >> 5;
    const int bh = unit >> 3, c0 = (unit & 7) * 4;
    float st[16][4];
#pragma unroll
    for (int i = 0; i < 16; ++i)
#pragma unroll
        for (int j = 0; j < 4; ++j) st[i][j] = 0.f;
    const unsigned* s8 = (const unsigned*)(a.ws + WS_SLOC) + (size_t)bh * 32 * 8192 + hi * 256 + 32 * w + c32;
    const f32x4* dcp = (const f32x4*)((const float*)(a.ws + WS_DEC) + (size_t)bh * 32 * 128 + 4 * hi);
#define GLA_ADV(c_) do { unsigned loc_[16]; f32x4 dv_[16]; \
        _Pragma("unroll") for (int i = 0; i < 16; ++i) { loc_[i] = __builtin_nontemporal_load(s8 + (size_t)(c_) * 8192 + i * 512); dv_[i] = dcp[(c_) * 32 + 8 * (i >> 2) + 2 * (i & 3)]; } \
        _Pragma("unroll") for (int i = 0; i < 16; ++i) { st[i][0] = dv_[i].x * st[i][0] + __builtin_amdgcn_cvt_f32_fp8((int)loc_[i], 0); st[i][1] = dv_[i].y * st[i][1] + __builtin_amdgcn_cvt_f32_fp8((int)loc_[i], 1); \
            st[i][2] = dv_[i].z * st[i][2] + __builtin_amdgcn_cvt_f32_fp8((int)loc_[i], 2); st[i][3] = dv_[i].w * st[i][3] + __builtin_amdgcn_cvt_f32_fp8((int)loc_[i], 3); } } while (0)
    for (int c = 0; c < c0; ++c) GLA_ADV(c);
    for (int k = 0; k < 4; ++k) {
        gla_out_chunk(a, lds, bh, c0 + k, st);
        if (c0 + k < 31) GLA_ADV(c0 + k);
    }
#undef GLA_ADV
}
namespace moba {
constexpr int HD = 128;
constexpr float SCALE = 0.08838834764831845f;
constexpr float THR = 8.f;
constexpr int NW = 8, QBLK = 32, KVBLK = 64, QB = NW * QBLK;
constexpr int SHM_V = KVBLK * HD * 2, SHM_K = KVBLK * HD * 2;
constexpr int OFF_WS = 2 * SHM_V + 2 * SHM_K;
constexpr int OFF_RTAB = OFF_WS + NW * 64 * 4;
constexpr int OFF_KM = OFF_RTAB + 2400 * 4;
constexpr int OFF_MISC = OFF_KM + 8 * 128 * 4;
constexpr int OFF_SEL = OFF_MISC + 64;
constexpr int LDS_BYTES = OFF_SEL + 2048;
constexpr int LDP = NPROJ, LDO = 2048;

#define KSWZ(row, colB) ((row) * 256 + ((colB) ^ (((row) & 7) << 4)))
#define SBAR() __builtin_amdgcn_sched_barrier(0)
__device__ __forceinline__ int v_st(int k, int c) { const int kk = (k & ~0xC) | ((k & 4) << 1) | ((k & 8) >> 1); return ((kk >> 3) * 4 + (c >> 5)) * 512 + ((kk & 7) * 32 + (c & 31)) * 2; }
__device__ __forceinline__ int v_rd_base(int lane) { return ((lane & 3) << 3) | (((lane >> 2) & 3) << 6) | (((lane >> 4) & 1) << 5) | (((lane >> 5) & 1) << 8); }
constexpr int v_rd_off(int d0, int ks, int half) { return d0 * 512 + ks * 4096 + half * 2048; }
__device__ __forceinline__ int crow(int r, int hi) { return (r & 3) + 8 * (r >> 2) + 4 * hi; }
__device__ __forceinline__ unsigned cvtpk(float lo, float hi) { unsigned r; asm volatile("v_cvt_pk_bf16_f32 %0, %1, %2" : "=v"(r) : "v"(lo), "v"(hi)); return r; }

__device__ __forceinline__ void mask_tile(f32x16& p0, f32x16& p1, int dq) {
    const float NEG = -__builtin_inff();
#pragma unroll
    for (int r = 0; r < 16; ++r) {
        const int c = (r & 3) + 8 * (r >> 2);
        if (dq - c < 0) p0[r] = NEG;
        if (dq - c - 32 < 0) p1[r] = NEG;
    }
}
__device__ __forceinline__ void bias_tile(f32x16& p0, f32x16& p1, const LAS float* rt) {
#pragma unroll
    for (int r = 0; r < 16; ++r) { const int c = (r & 3) + 8 * (r >> 2); p0[r] += rt[c]; p1[r] += rt[c + 32]; }
}
__device__ __forceinline__ void kill_tile(f32x16& p0, f32x16& p1) {
    const float NEG = -__builtin_inff();
#pragma unroll
    for (int r = 0; r < 16; ++r) { p0[r] = NEG; p1[r] = NEG; }
}
__device__ __forceinline__ void partialSM(f32x16& p0, f32x16& p1, float& m_reg, float& mn, float& alpha) {
    float pmax = p0[0];
#pragma unroll
    for (int r = 1; r < 16; ++r) pmax = fmaxf(pmax, p0[r]);
#pragma unroll
    for (int r = 0; r < 16; ++r) pmax = fmaxf(pmax, p1[r]);
    { auto rr = __builtin_amdgcn_permlane32_swap(__float_as_uint(pmax), __float_as_uint(pmax), false, false);
      pmax = fmaxf(__uint_as_float(rr[0]), __uint_as_float(rr[1])); }
    constexpr float C2 = 1.4426950408889634f * SCALE;
    if (__builtin_expect(__all((pmax - m_reg) * SCALE <= THR), 1)) { mn = m_reg; alpha = 1.f; }
    else { mn = fmaxf(m_reg, pmax); alpha = __builtin_amdgcn_exp2f((m_reg - mn) * C2); m_reg = mn; }
    const float mnL = -mn * C2;
#pragma unroll
    for (int r = 0; r < 16; ++r) p0[r] = fmaf(p0[r], C2, mnL);
#pragma unroll
    for (int r = 0; r < 16; ++r) p1[r] = fmaf(p1[r], C2, mnL);
#pragma unroll
    for (int r = 0; r < 16; ++r) p0[r] = __builtin_amdgcn_exp2f(p0[r]);
}
__device__ __forceinline__ void finishSM(f32x16& p0, f32x16& p1, float alpha, float& l_reg, bf16x8& pa0, bf16x8& pa1, bf16x8& pa2, bf16x8& pa3) {
#pragma unroll
    for (int r = 0; r < 16; ++r) p1[r] = __builtin_amdgcn_exp2f(p1[r]);
    float ps = 0;
#pragma unroll
    for (int r = 0; r < 16; ++r) ps += p0[r];
#pragma unroll
    for (int r = 0; r < 16; ++r) ps += p1[r];
    { auto rr = __builtin_amdgcn_permlane32_swap(__float_as_uint(ps), __float_as_uint(ps), false, false);
      ps = __uint_as_float(rr[0]) + __uint_as_float(rr[1]); }
    l_reg = l_reg * alpha + ps;
#define PK4(P, B_, OUT) do { unsigned a0 = cvtpk(P[B_+0], P[B_+1]), a1 = cvtpk(P[B_+2], P[B_+3]);                          \
        unsigned b0 = cvtpk(P[B_+4], P[B_+5]), b1 = cvtpk(P[B_+6], P[B_+7]);                                             \
        auto r0 = __builtin_amdgcn_permlane32_swap(a0, b0, false, false); auto r1 = __builtin_amdgcn_permlane32_swap(a1, b1, false, false); \
        u32x4 w = {r0[0], r1[0], r0[1], r1[1]}; OUT = __builtin_bit_cast(bf16x8, w); } while (0)
    PK4(p0, 0, pa0); PK4(p0, 8, pa1); PK4(p1, 0, pa2); PK4(p1, 8, pa3);
#undef PK4
}
template <int KB>
__device__ __forceinline__ void qkt(f32x16& p0, f32x16& p1, const char* K_lds, int r32, int hi, const bf16x8* qr) {
#pragma unroll
    for (int r = 0; r < 16; ++r) { p0[r] = 0.f; p1[r] = 0.f; }
    const char* kb[4];
#pragma unroll
    for (int dd = 0; dd < 4; ++dd) kb[dd] = K_lds + KB * SHM_K + KSWZ(r32, (dd * 16 + hi * 8) * 2);
#pragma unroll
    for (int d0 = 0; d0 < 8; ++d0) { const char* a = kb[d0 & 3] + (d0 >> 2) * 128;
        bf16x8 b0 = *reinterpret_cast<const bf16x8*>(a);
        bf16x8 b1 = *reinterpret_cast<const bf16x8*>(a + 32 * 256);
        p0 = __builtin_amdgcn_mfma_f32_32x32x16_bf16(b0, qr[d0], p0, 0, 0, 0);
        p1 = __builtin_amdgcn_mfma_f32_32x32x16_bf16(b1, qr[d0], p1, 0, 0, 0); }
}
template <int VB>
__device__ __forceinline__ void pv_tile(f32x16* o, int vb0, bf16x8 pa0, bf16x8 pa1, bf16x8 pa2, bf16x8 pa3) {
#define TRRD(dst, off) asm volatile("ds_read_b64_tr_b16 %0, %1 offset:%2" : "=&v"(dst) : "v"(vb0), "i"(off) : "memory")
#define PV_D0(d0) do { s16x4 l0, l1, l2, l3, h0, h1, h2, h3; constexpr int b_ = VB * SHM_V + v_rd_off(d0, 0, 0);   \
        TRRD(l0, b_); TRRD(h0, b_ + 2048); TRRD(l1, b_ + 4096); TRRD(h1, b_ + 6144); TRRD(l2, b_ + 8192); TRRD(h2, b_ + 10240); TRRD(l3, b_ + 12288); TRRD(h3, b_ + 14336); \
        asm volatile("s_waitcnt lgkmcnt(0)" ::: "memory"); SBAR();   \
        o[d0] = __builtin_amdgcn_mfma_f32_32x32x16_bf16(pa0, (bf16x8){l0[0], l0[1], l0[2], l0[3], h0[0], h0[1], h0[2], h0[3]}, o[d0], 0, 0, 0);   \
        o[d0] = __builtin_amdgcn_mfma_f32_32x32x16_bf16(pa1, (bf16x8){l1[0], l1[1], l1[2], l1[3], h1[0], h1[1], h1[2], h1[3]}, o[d0], 0, 0, 0);   \
        o[d0] = __builtin_amdgcn_mfma_f32_32x32x16_bf16(pa2, (bf16x8){l2[0], l2[1], l2[2], l2[3], h2[0], h2[1], h2[2], h2[3]}, o[d0], 0, 0, 0);   \
        o[d0] = __builtin_amdgcn_mfma_f32_32x32x16_bf16(pa3, (bf16x8){l3[0], l3[1], l3[2], l3[3], h3[0], h3[1], h3[2], h3[3]}, o[d0], 0, 0, 0); } while (0)
    PV_D0(0); PV_D0(1); PV_D0(2); PV_D0(3);
#undef PV_D0
#undef TRRD
}

struct BlockRef { const bf16_t* Q; const bf16_t* K; const bf16_t* V; bf16_t* O; int qb; int b, h; };
struct Seam { bf16x8 qr[8]; bf16x8 st_v0, st_v1, st_k0, st_k1; };
#define VMW() asm volatile("s_waitcnt vmcnt(0)" ::: "memory")
#define VMWN(n) asm volatile("s_waitcnt vmcnt(%0)" :: "i"(n) : "memory")
#define LD8(p) (*reinterpret_cast<const bf16x8*>(p))
#define SLOAD_H(Kp, Vp, k0) do { const char* kb__ = (const char*)(Kp) + (size_t)(k0) * (LDP * 2); \
        S.st_v0 = LD8(kb__ + 2048 + kvoff); S.st_v1 = LD8(kb__ + (32 * LDP * 2 + 2048) + kvoff); S.st_k0 = LD8(kb__ + kvoff); S.st_k1 = LD8(kb__ + 32 * LDP * 2 + kvoff); } while (0)
#define SWRITE_HK(bf) do { *(bf16x8*)(K_lds + (bf) * SHM_K + kws) = S.st_k0; *(bf16x8*)(K_lds + (bf) * SHM_K + kws + 32 * 256) = S.st_k1; } while (0)
#define SWRITE_HV(bf) do { *(bf16x8*)(V_lds + (bf) * SHM_V + vst0) = S.st_v0; *(bf16x8*)(V_lds + (bf) * SHM_V + vst1) = S.st_v1; } while (0)
#define SWRITE_H(bf) do { SWRITE_HV(bf); SWRITE_HK(bf); } while (0)

__device__ __forceinline__ void prime(const BlockRef& cur, char* lds, Seam& S) {
    int tid = threadIdx.x; asm volatile("" : "+v"(tid));     const int wid = __builtin_amdgcn_readfirstlane(tid >> 6), lane = tid & 63, r32 = lane & 31, hi = lane >> 5;
    const int sr = tid >> 4, sc = (tid & 15) * 8, kws = KSWZ(sr, sc * 2); char* K_lds = lds + 2 * SHM_V;
    const unsigned kvoff = (unsigned)(sr * LDP + sc) * 2u, qvoff = (unsigned)(r32 * LDP + hi * 8) * 2u;
    { const char* qb__ = (const char*)cur.Q + (size_t)(wid * QBLK) * (LDP * 2);
#pragma unroll
    for (int d0 = 0; d0 < 8; ++d0) S.qr[d0] = LD8(qb__ + qvoff + d0 * 32); }
    SLOAD_H(cur.K, cur.V, 0); VMW(); SWRITE_HK(0);
    __syncthreads();
}
__device__ __forceinline__ int rel_bucket(int n) {
    if (n < 16) return n;
    const float nf = (float)n;
    int large = 16 + (int)(logf(nf / 16.0f) / 5.545177444479562f * 16.0f);
    return large < 31 ? large : 31;
}
__device__ __forceinline__ BlockRef make_ref(const P& a, int item);
__device__ __forceinline__ int block(const P& a, const BlockRef& cur, unsigned* queue, const float* rel_bias, const float* kmp, char* lds, Seam& S) {
    int tid = threadIdx.x; asm volatile("" : "+v"(tid));     const int wid = __builtin_amdgcn_readfirstlane(tid >> 6), lane = tid & 63, r32 = lane & 31, hi = lane >> 5;
    const int qb = cur.qb, NT = 4 * (qb + 1);
    const int qlo = qb * QB + wid * QBLK, qrow = qlo + r32;
    char* V_lds = lds; char* K_lds = lds + 2 * SHM_V;
    float* ws = (float*)(lds + OFF_WS) + wid * 64; float* li_l = ws, * al_l = ws + 32;
    LAS float* rtab = (LAS float*)(LAS char*)(uintptr_t)(unsigned)(uintptr_t)(lds + OFF_RTAB);
    float* kmL = (float*)(lds + OFF_KM);
    volatile int* misc = (volatile int*)(lds + OFF_MISC);
    if (tid == 0) misc[0] = (int)__hip_atomic_fetch_add(queue, 1u, __ATOMIC_RELAXED, __HIP_MEMORY_SCOPE_AGENT);
    for (int i = tid; i < 2400; i += NW * 64) { const int dist = 2047 - i; rtab[i] = dist >= 0 ? rel_bias[rel_bucket(dist) * 8 + cur.h] * (1.0f / SCALE) : -__builtin_inff(); }
    for (int i = tid; i < qb * 128; i += NW * 64) { const int j = i >> 7, dd = i & 127; const size_t o = ((size_t)(cur.b * 8 + j)) * 1024 + cur.h * 128 + dd;
        kmL[i] = (kmp[o] + kmp[o + 64 * 1024]) * (1.0f / 256.0f); }
    __syncthreads();
    const int next_item = __builtin_amdgcn_readfirstlane(misc[0]);
    const BlockRef nxt = next_item < 512 ? make_ref(a, next_item) : cur;
    unsigned selmask = 0;
    {
        float sc7[7];
#pragma unroll
        for (int j = 0; j < 7; ++j) { sc7[j] = -__builtin_inff();
            if (j < qb) { float acc = 0.f;
#pragma unroll
                for (int d0 = 0; d0 < 8; ++d0) { const u32x4 q4 = __builtin_bit_cast(u32x4, S.qr[d0]); const f32x4 k0 = *(const f32x4*)(kmL + j * 128 + d0 * 16 + hi * 8), k1 = *(const f32x4*)(kmL + j * 128 + d0 * 16 + hi * 8 + 4);
                    acc += bflo(q4[0]) * k0[0] + bfhi(q4[0]) * k0[1] + bflo(q4[1]) * k0[2] + bfhi(q4[1]) * k0[3] + bflo(q4[2]) * k1[0] + bfhi(q4[2]) * k1[1] + bflo(q4[3]) * k1[2] + bfhi(q4[3]) * k1[3]; }
                acc += __shfl_xor(acc, 32); sc7[j] = acc; } }
#pragma unroll
        for (int j = 0; j < 7; ++j) { int rank = 0;
#pragma unroll
            for (int i = 0; i < 7; ++i) { if (i != j) rank += (sc7[i] > sc7[j] || (sc7[i] == sc7[j] && i < j)) ? 1 : 0; }
            if (j < qb && (qb <= 3 || rank < 3)) selmask |= 1u << j; }
    }
    LAS unsigned* selp = (LAS unsigned*)(LAS char*)(uintptr_t)(unsigned)(uintptr_t)(lds + OFF_SEL) + tid;
    *selp = selmask;
    float m_reg = -1e30f, l_reg = 0; f32x16 o[4];
#pragma unroll
    for (int d = 0; d < 4; ++d)
#pragma unroll
        for (int r = 0; r < 16; ++r) o[d][r] = 0.f;
    const int sr = tid >> 4, sc = (tid & 15) * 8, vst0 = v_st(sr, sc), vst1 = v_st(32 + sr, sc), kws = KSWZ(sr, sc * 2);
    const unsigned kvoff = (unsigned)(sr * LDP + sc) * 2u;
    const int vb0 = (int)(uintptr_t)V_lds + v_rd_base(lane);
    const bf16_t* Kh = cur.K; const bf16_t* Vh = cur.V;
#define RESC(a) do { if (__any((a) < 1.f)) { if (hi == 0) al_l[r32] = (a); asm volatile("s_waitcnt lgkmcnt(0)" ::: "memory");              \
                     for (int d_ = 0; d_ < 4; ++d_) for (int r = 0; r < 16; ++r) o[d_][r] *= al_l[crow(r, hi)]; } } while (0)
#define KBASE(t) ((t) * KVBLK)
#define MASKT(P0_, P1_, t) do { const int kb_ = KBASE(t); const int jb_ = (t) >> 2; \
        const bool on_ = (jb_ == qb) || ((*selp >> jb_) & 1u); \
        bias_tile(P0_, P1_, on_ ? rtab + (kb_ + 4 * hi - qrow + 2047) : rtab + 2304); } while (0)
    constexpr int NQL = 8;
#define SEAM_K0() do { VMWN(NQL); SWRITE_HK(0); SBAR(); } while (0)
    f32x16 pA0, pA1, pB0, pB1; float mnA, mnB, alA, alB; bf16x8 pa0, pa1, pa2, pa3;
    SWRITE_HV(0); SBAR();
    if (NT > 1) { SLOAD_H(Kh, Vh, KBASE(1)); }
    SBAR(); qkt<0>(pA0, pA1, K_lds, r32, hi, S.qr);
    MASKT(pA0, pA1, 0); partialSM(pA0, pA1, m_reg, mnA, alA);
    if (NT > 1) { VMW(); SWRITE_H(1); }
    __syncthreads();
#define HALF_STEP(PX0, PX1, mnX, alX, PY0, PY1, alY, t, KB, VB, SB) do {                                                      \
        SBAR(); qkt<KB>(PX0, PX1, K_lds, r32, hi, S.qr);                                             \
        finishSM(PY0, PY1, alY, l_reg, pa0, pa1, pa2, pa3); SBAR();                                                           \
        if ((t) + 1 < NT) { SLOAD_H(Kh, Vh, KBASE((t) + 1)); SBAR(); }                                               \
        pv_tile<VB>(o, vb0, pa0, pa1, pa2, pa3); MASKT(PX0, PX1, (t)); partialSM(PX0, PX1, m_reg, mnX, alX);                                        \
        __syncthreads();                                                                                                      \
        if ((t) + 1 < NT) { VMW(); SWRITE_H(SB); }                                                                          \
        RESC(alX); __syncthreads(); } while (0)
    for (int t = 1; t + 1 < NT; t += 2) {
        HALF_STEP(pB0, pB1, mnB, alB, pA0, pA1, alA, t, 1, 0, 0);
        HALF_STEP(pA0, pA1, mnA, alA, pB0, pB1, alB, t + 1, 0, 1, 1);
    }
    { SBAR(); qkt<1>(pB0, pB1, K_lds, r32, hi, S.qr); SBAR(); }
    SLOAD_H(nxt.K, nxt.V, 0); SBAR();
    { const char* qb__ = (const char*)nxt.Q + (size_t)(wid * QBLK) * (LDP * 2); int l_ = lane; asm volatile("" : "+v"(l_));
      const unsigned qvoff = (unsigned)((l_ & 31) * LDP + (l_ >> 5) * 8) * 2u;
#pragma unroll
    for (int d0 = 0; d0 < 8; ++d0) S.qr[d0] = LD8(qb__ + qvoff + d0 * 32); }
    SBAR();
    finishSM(pA0, pA1, alA, l_reg, pa0, pa1, pa2, pa3); SBAR();
    pv_tile<0>(o, vb0, pa0, pa1, pa2, pa3);
    { MASKT(pB0, pB1, NT - 1); partialSM(pB0, pB1, m_reg, mnB, alB); __syncthreads(); RESC(alB);
      finishSM(pB0, pB1, alB, l_reg, pa0, pa1, pa2, pa3); SBAR(); pv_tile<1>(o, vb0, pa0, pa1, pa2, pa3); }
    SBAR(); SEAM_K0();
    if (hi == 0) li_l[r32] = l_reg; asm volatile("s_waitcnt lgkmcnt(0)" ::: "memory");
    float rli[16];
#pragma unroll
    for (int r = 0; r < 16; ++r) rli[r] = __builtin_amdgcn_rcpf(li_l[crow(r, hi)]);
    char* Ow = (char*)cur.O + (size_t)(wid * QBLK) * (LDO * 2); const unsigned ovoff = (unsigned)(4 * hi * LDO + r32) * 2u;
#pragma unroll
    for (int r = 0; r < 16; ++r) { const int orow0 = (r & 3) + 8 * (r >> 2);
#pragma unroll
        for (int d0 = 0; d0 < 4; ++d0) { const float v = o[d0][r] * rli[r];
            const float vn = __shfl_xor(v, 1);
            if ((r32 & 1) == 0) *(unsigned*)(Ow + (size_t)(orow0 * LDO * 2 + d0 * 64) + ovoff) = cvtpk(v, vn); } }
    __syncthreads();
    return next_item;
#undef RESC
#undef KBASE
#undef MASKT
#undef SEAM_K0
#undef HALF_STEP
}
#undef ROWP
#undef VMW
#undef VMWN
#undef LD8
#undef SLOAD_H
#undef SWRITE_HK
#undef SWRITE_HV
#undef SWRITE_H

__device__ __forceinline__ BlockRef make_ref(const P& a, int item) {
    const int qb = 7 - (item >> 6), bh = item & 63, b = bh >> 3, h = bh & 7;
    const bf16_t* proj = (const bf16_t*)(a.ws + WS_PROJ);
    BlockRef r; r.b = b; r.h = h; r.qb = qb;
    r.Q = proj + (size_t)(b * SEQ + qb * QB) * LDP + C_QB + h * HD;
    r.K = proj + (size_t)(b * SEQ) * LDP + C_KB + h * HD;
    r.V = proj + (size_t)(b * SEQ) * LDP + C_VB + h * HD;
    r.O = (bf16_t*)(a.ws + WS_OAB) + (size_t)(b * SEQ + qb * QB) * LDO + 1024 + h * HD;
    return r;
}
}
__device__ __forceinline__ void router_unit(const P& a, LAS unsigned char* lds, int unit) {
    int tid = threadIdx.x; asm volatile("" : "+v"(tid)); const int wave = __builtin_amdgcn_readfirstlane(tid >> 6), lane = tid & 63, c32 = lane & 31, hi = lane >> 5;
    const int tg = wave & 1, kq = wave >> 1;
    const float* x1 = (const float*)(a.ws + WS_X1); const float* g = a.in[11]; const float* br = a.in[13];
    unsigned char* A2 = a.ws + WS_A2; const u32x4* frag = (const u32x4*)(a.ws + WS_WRF);
    LAS float* Lw = (LAS float*)(lds + wave * 4352);
    LAS float* ssp = (LAS float*)(lds + 8 * 4352);
    LAS unsigned* hist = (LAS unsigned*)(lds + 8 * 4352 + 2048);
    LAS unsigned* base = hist + 32;
    if (tid < 32) hist[tid] = 0u;
    const int tok = unit * 64 + tg * 32 + c32;
    f32x16 L;
#pragma unroll
    for (int r = 0; r < 16; ++r) L[r] = 0.f;
    float ss = 0.f;
    const float* xr = x1 + (size_t)tok * D + 8 * hi + 256 * kq; unsigned char* ar = A2 + (size_t)tok * D + 8 * hi + 256 * kq; const float* gr = g + 8 * hi + 256 * kq;
#pragma unroll 4
    for (int s = 0; s < 16; ++s) {
        const f32x4 xa = *(const f32x4*)(xr + 16 * s), xb = *(const f32x4*)(xr + 16 * s + 4), ga = *(const f32x4*)(gr + 16 * s), gb = *(const f32x4*)(gr + 16 * s + 4);
        ss += (xa.x * xa.x + xa.y * xa.y) + (xa.z * xa.z + xa.w * xa.w) + (xb.x * xb.x + xb.y * xb.y) + (xb.z * xb.z + xb.w * xb.w);
        const f32x4 va = xa * ga, vb = xb * gb;
        u32x4 wh; wh.x = cvt_pk_bf16(va.x, va.y); wh.y = cvt_pk_bf16(va.z, va.w); wh.z = cvt_pk_bf16(vb.x, vb.y); wh.w = cvt_pk_bf16(vb.z, vb.w);
        { u32x2 w8; w8.x = pk4_fp8(va.x, va.y, va.z, va.w); w8.y = pk4_fp8(vb.x, vb.y, vb.z, vb.w); *(u32x2*)(ar + 16 * s) = w8; }
        u32x4 wl; wl.x = cvt_pk_bf16(va.x - bflo(wh.x), va.y - bfhi(wh.x)); wl.y = cvt_pk_bf16(va.z - bflo(wh.y), va.w - bfhi(wh.y));
        wl.z = cvt_pk_bf16(vb.x - bflo(wh.z), vb.y - bfhi(wh.z)); wl.w = cvt_pk_bf16(vb.z - bflo(wh.w), vb.w - bfhi(wh.w));
        const bf16x8 ah = __builtin_bit_cast(bf16x8, wh), al = __builtin_bit_cast(bf16x8, wl);
        const bf16x8 bh = __builtin_bit_cast(bf16x8, frag[(16 * kq + s) * 64 + lane]), bl = __builtin_bit_cast(bf16x8, frag[4096 + (16 * kq + s) * 64 + lane]);
        L = __builtin_amdgcn_mfma_f32_32x32x16_bf16(ah, bh, L, 0, 0, 0);
        L = __builtin_amdgcn_mfma_f32_32x32x16_bf16(ah, bl, L, 0, 0, 0);
        L = __builtin_amdgcn_mfma_f32_32x32x16_bf16(al, bh, L, 0, 0, 0);
    }
#pragma unroll
    for (int r = 0; r < 16; ++r) Lw[((r & 3) + 8 * (r >> 2) + 4 * hi) * 33 + c32] = L[r];
    ssp[wave * 64 + lane] = ss;
    __syncthreads();
    int e4[4] = {0, 0, 0, 0}; float w4[4] = {0.f, 0.f, 0.f, 0.f}; unsigned loc[4] = {0u, 0u, 0u, 0u}; float rstd = 0.f;
    const bool sel = (wave < 2) && (hi == 0);
    if (sel) {
        float sst = 0.f;
#pragma unroll
        for (int q = 0; q < 4; ++q) sst += ssp[(wave + 2 * q) * 64 + c32] + ssp[(wave + 2 * q) * 64 + 32 + c32];
        rstd = 1.0f / sqrtf(sst * (1.0f / D) + EPS);
        float lg[32];
#pragma unroll
        for (int e = 0; e < 32; ++e) { const LAS float* lp = (const LAS float*)(lds + wave * 4352) + c32 * 33 + e; lg[e] = (lp[0] + lp[2 * 1088] + lp[4 * 1088] + lp[6 * 1088]) * rstd + br[e]; }
        unsigned used = 0u; float v4[4];
#pragma unroll
        for (int p = 0; p < 4; ++p) { float best = -__builtin_inff(); int bi = 0;
#pragma unroll
            for (int e = 0; e < 32; ++e) { const bool take = !((used >> e) & 1u) && lg[e] > best; best = take ? lg[e] : best; bi = take ? e : bi; }
            used |= 1u << bi; e4[p] = bi; v4[p] = best; }
        float sum = 0.f;
#pragma unroll
        for (int p = 0; p < 4; ++p) { w4[p] = expf(v4[p] - v4[0]); sum += w4[p]; }
        const float inv = 1.0f / sum;
#pragma unroll
        for (int p = 0; p < 4; ++p) { w4[p] *= inv; loc[p] = __hip_atomic_fetch_add(hist + e4[p], 1u, __ATOMIC_RELAXED, __HIP_MEMORY_SCOPE_WORKGROUP); }
    }
    __syncthreads();
    if (tid < 32) base[tid] = __hip_atomic_fetch_add((unsigned*)(a.ws + WS_CTL) + CW_COUNTS + tid, hist[tid], RLX_AGENT);
    __syncthreads();
    if (sel) {
        int* tope = (int*)(a.ws + WS_TOPE) + (size_t)tok * 4; float* wts = (float*)(a.ws + WS_WTS) + (size_t)tok * 4; int* slot = (int*)(a.ws + WS_SLOT) + (size_t)tok * 4;
#pragma unroll
        for (int p = 0; p < 4; ++p) { const int sl_ = (int)(base[e4[p]] + loc[p]); tope[p] = e4[p]; wts[p] = w4[p]; slot[p] = sl_;
            ((int*)(a.ws + WS_ROWE))[(size_t)e4[p] * T + sl_] = tok; ((float*)(a.ws + WS_RSTE))[(size_t)e4[p] * T + sl_] = rstd; }
    }
    __syncthreads();
}

__device__ __forceinline__ void moe_tables(const P& a, LAS unsigned char* lds) {
    int tid = threadIdx.x; asm volatile("" : "+v"(tid)); const int wave = tid >> 6, lane = tid & 63, e = lane & 31;
    LAS int* pstart = (LAS int*)(lds + LDS_MOE); LAS int* cnt = pstart + 64; LAS int* tile_e = pstart + 128;
    const unsigned* counts = (const unsigned*)(a.ws + WS_CTL) + CW_COUNTS;
    const int c = (int)counts[e]; const int p = ((c + 255) >> 8) << 8; int inc = p;
#pragma unroll
    for (int o = 1; o < 32; o <<= 1) { const int t = __shfl_up(inc, o, 32); if (e >= o) inc += t; }
    if (tid < 32) { cnt[e] = c; pstart[e] = inc - p; if (e == 31) { pstart[32] = inc; tile_e[MAXTILES] = inc >> 8; } }
    for (int t = wave * 36; t < wave * 36 + 36; ++t) { const unsigned long long m = __ballot(inc <= t * 256); const int ee = __builtin_popcount((unsigned)m); if (lane == 0) tile_e[t] = ee < NE ? ee : NE - 1; }
    __syncthreads();
}

__device__ __forceinline__ void combine_rows(const P& a, LAS unsigned char* lds, int vcu, int G, int wave, int lane) {
    const LAS int* pstart = (const LAS int*)(lds + LDS_MOE);
    const int gw = vcu * NWAVES + wave, NGW = G * NWAVES;
    float* X = (float*)(a.ws + WS_X1); const unsigned char* Y = a.ws + WS_YROWS; bf16_t* A3 = (bf16_t*)(a.ws + WS_H);
    const int* tope = (const int*)(a.ws + WS_TOPE); const int* slot = (const int*)(a.ws + WS_SLOT); const float* wts = (const float*)(a.ws + WS_WTS); const float* g = a.in[20];
    f32x4 gv[4];
#pragma unroll
    for (int j = 0; j < 4; ++j) gv[j] = *((const f32x4*)g + lane + 64 * j);
    for (int m = gw; m < T; m += NGW) {
        f32x4* xr = (f32x4*)(X + (size_t)m * D) + lane; f32x4 v[4];
#pragma unroll
        for (int j = 0; j < 4; ++j) v[j] = xr[64 * j];
#pragma unroll
        for (int k = 0; k < 4; ++k) { const int d = __builtin_amdgcn_readfirstlane(pstart[tope[m * 4 + k]] + slot[m * 4 + k]); const float w = __uint_as_float(__builtin_amdgcn_readfirstlane(__float_as_uint(wts[m * 4 + k])));
            const unsigned* yr = (const unsigned*)(Y + (size_t)d * D) + lane;
#pragma unroll
            for (int j = 0; j < 4; ++j) { const int y = (int)__builtin_nontemporal_load(yr + 64 * j);
                v[j].x += w * __builtin_amdgcn_cvt_f32_fp8(y, 0); v[j].y += w * __builtin_amdgcn_cvt_f32_fp8(y, 1); v[j].z += w * __builtin_amdgcn_cvt_f32_fp8(y, 2); v[j].w += w * __builtin_amdgcn_cvt_f32_fp8(y, 3); } }
        float s = 0.f;
#pragma unroll
        for (int j = 0; j < 4; ++j) s += (v[j].x * v[j].x + v[j].y * v[j].y) + (v[j].z * v[j].z + v[j].w * v[j].w);
        const float rstd = 1.0f / sqrtf(wave_sum(s) * (1.0f / D) + EPS);
        unsigned* o4 = (unsigned*)((unsigned char*)A3 + (size_t)m * D) + lane;
#pragma unroll
        for (int j = 0; j < 4; ++j) { xr[64 * j] = v[j]; o4[64 * j] = pk4_fp8(v[j].x * rstd * gv[j].x, v[j].y * rstd * gv[j].y, v[j].z * rstd * gv[j].z, v[j].w * rstd * gv[j].w); }
    }
}
__device__ __forceinline__ void final_rows(const P& a, int vcu, int G, int wave, int lane) {
    const int gw = vcu * NWAVES + wave, NGW = G * NWAVES;
    const float* X = (const float*)(a.ws + WS_X1); float* OUT = a.out; const bf16_t* PG = (const bf16_t*)(a.ws + WS_PGATE); const bf16_t* PP = (const bf16_t*)(a.ws + WS_PPROJ);
    f32x4 gp[4], gf[4];
#pragma unroll
    for (int j = 0; j < 4; ++j) { gp[j] = *((const f32x4*)a.in[23] + lane + 64 * j); gf[j] = *((const f32x4*)a.in[24] + lane + 64 * j); }
    for (int m = gw; m < T; m += NGW) {
        const f32x4* xr = (const f32x4*)(X + (size_t)m * D) + lane; f32x4* orow = (f32x4*)(OUT + (size_t)m * D) + lane; const u32x2* pgr = (const u32x2*)(PG + (size_t)m * D) + lane; const u32x2* ppr = (const u32x2*)(PP + (size_t)m * D) + lane;
        f32x4 v[4], pp[4], pg[4]; float sp = 0.f;
#pragma unroll
        for (int j = 0; j < 4; ++j) { v[j] = __builtin_nontemporal_load(xr + 64 * j); const u32x2 q = __builtin_nontemporal_load(ppr + 64 * j), gq = __builtin_nontemporal_load(pgr + 64 * j);
            pp[j] = (f32x4){bflo(q.x), bfhi(q.x), bflo(q.y), bfhi(q.y)}; pg[j] = (f32x4){bflo(gq.x), bfhi(gq.x), bflo(gq.y), bfhi(gq.y)};
            sp += (pp[j].x * pp[j].x + pp[j].y * pp[j].y) + (pp[j].z * pp[j].z + pp[j].w * pp[j].w); }
        const float rp = 1.0f / sqrtf(wave_sum(sp) * (1.0f / D) + EPS); float s = 0.f;
#pragma unroll
        for (int j = 0; j < 4; ++j) { v[j] = v[j] + pg[j] * (pp[j] * rp * gp[j]); s += (v[j].x * v[j].x + v[j].y * v[j].y) + (v[j].z * v[j].z + v[j].w * v[j].w); }
        const float rstd = 1.0f / sqrtf(wave_sum(s) * (1.0f / D) + EPS);
#pragma unroll
        for (int j = 0; j < 4; ++j) __builtin_nontemporal_store(v[j] * rstd * gf[j], orow + 64 * j);
    }
}
struct Args { P p; };
template <int PH_LO, int PH_HI>
__global__ void __launch_bounds__(NTHREADS, 2) hybrid_fwd(Args args) {
    extern __shared__ __attribute__((aligned(16))) unsigned char lds_raw[];
    LAS unsigned char* lds = (LAS unsigned char*)lds_raw;
    const P& a = args.p;
    const int tid = threadIdx.x, lane = tid & 63, wave = __builtin_amdgcn_readfirstlane(tid >> 6);
    const int G = gridDim.x; const int bx = blockIdx.x; const int vcu = (G % 8 == 0) ? (bx % 8) * (G / 8) + bx / 8 : bx;
    unsigned* ctl = (unsigned*)(a.ws + WS_CTL);
    for (int u = tid; u < (LDS_BYTES - LDSCTL_OFF) / 4; u += NTHREADS) ((LAS unsigned*)(lds + LDSCTL_OFF))[u] = 0u;
    __syncthreads();
#if MK_PER_PHASE
#define GRID_BAR() do { } while (0)
#else
    XcdBarrier bar = xcd_barrier_post(ctl + CW_BAR, (volatile LAS unsigned*)(lds + MISC_OFF + 32));
#define GRID_BAR() xcd_barrier(bar)
#endif
    constexpr int lo = PH_LO, hi = PH_HI;
#define IN(k) (lo <= (k) && (k) < hi)
#define SEAM(k) do { if constexpr (IN(k) && IN((k) + 1)) GRID_BAR(); } while (0)
    unsigned char* ws = a.ws;

    if constexpr (IN(0)) { p0_prologue(a, lds, vcu, G, wave, lane); }
    SEAM(0);
    if constexpr (IN(1)) {
        pg8::DenseSched S; S.o.init(T / 256, NPROJ / 256, G, bx); S.Bt = (const char*)(ws + WS_WIN); S.K = D;
        pg8::EpiProj<false> E{(bf16_t*)(ws + WS_PROJ), (float*)(ws + WS_KMP)};
        pg8::gemm_phase(lds, (const char*)(ws + WS_H), D, D, D, S, E);
    }
    SEAM(1);
    if constexpr (IN(2)) { for (int u = vcu; u < NB * 32; u += G) gla_prep_unit(a, lds, u); }
    SEAM(2);
    if constexpr (IN(3)) {
        for (int u = vcu; u < 256; u += G) gla_out_group(a, lds, u);
        __syncthreads();
    }
    if constexpr (IN(4)) {
        if ((vcu & 1) == 0) { expert_convert(a, lds, vcu >> 1, G >> 1, wave, lane); __syncthreads(); }
        unsigned* queue = ctl + CW_QUEUE;
        volatile LAS int* qslot = (volatile LAS int*)(lds + LDSCTL_OFF + 1024);
        if (tid == 0) qslot[0] = (int)__hip_atomic_fetch_add(queue, 1u, RLX_AGENT);
        __syncthreads();
        int item = __builtin_amdgcn_readfirstlane(qslot[0]);
        if (item < 512) {
            moba::Seam S;
            moba::BlockRef cur = moba::make_ref(a, item);
            moba::prime(cur, (char*)lds_raw, S);
            for (;;) {
                const int nitem = moba::block(a, cur, queue, a.in[2], (const float*)(ws + WS_KMP), (char*)lds_raw, S);
                if (nitem >= 512) break;
                cur = moba::make_ref(a, nitem);
            }
        }
    }
    SEAM(4);
    if constexpr (IN(5)) {
        pg8::ChainSched S; S.o.init(T / 256, D / 256, G, bx); S.Bt = (const char*)(ws + WS_WUP); S.K = 1024;
        pg8::EpiMerge E{(const bf16_t*)(ws + WS_PROJ), (bf16_t*)(ws + WS_Y)};
        pg8::gemm_phase(lds, (const char*)(ws + WS_OAB), 1024, 2048, 2048, S, E);
    }
    SEAM(5);
    if constexpr (IN(6)) {
        pg8::DenseSched S; S.o.init(T / 256, D / 256, G, bx); S.Bt = (const char*)(ws + WS_WO); S.K = D;
        pg8::EpiResF32 E{a.in[0], (float*)(ws + WS_X1)};
        pg8::gemm_phase(lds, (const char*)(ws + WS_Y), D, D, D, S, E);
    }
    SEAM(6);
    if constexpr (IN(7)) { for (int u = vcu; u < T / 64; u += G) router_unit(a, lds, u); }
    SEAM(7);
    if constexpr (IN(8)) {
        moe_tables(a, lds); const LAS int* tab = (const LAS int*)(lds + LDS_MOE); const int ntile = __builtin_amdgcn_readfirstlane(tab[128 + MAXTILES]);
        pg8::MoeSched<true> S; S.o.init(ntile, 8, G, bx); S.Bt = (const char*)a.out; S.K = D; S.rows_per_e = 2048; S.tab = tab; S.row_e = (const int*)(ws + WS_ROWE); S.es = 1;
        pg8::EpiGlu E{(unsigned char*)(ws + WS_HMID), (const float*)(ws + WS_RSTE), tab, a.in[15], a.in[17]};
        pg8::gemm_phase(lds, (const char*)(ws + WS_A2), D, D, D, S, E);
        const int extra = (ntile * 8) % G, nidle = G - extra;
        if (bx >= extra) { __syncthreads();
            pg8::DenseSched S2; S2.o.init(T / 256, D / 256, nidle, bx - extra); S2.Bt = (const char*)(ws + WS_WPP); S2.K = 256;
            pg8::EpiBf16<0, false> E2{(bf16_t*)(ws + WS_PPROJ), D, nullptr, 0, 1.0f};
            pg8::gemm_phase(lds, (const char*)(ws + WS_PB), 256, 256, 256, S2, E2); }
    }
    SEAM(8);
    if constexpr (IN(9)) {
        moe_tables(a, lds); const LAS int* tab = (const LAS int*)(lds + LDS_MOE); const int ntile = __builtin_amdgcn_readfirstlane(tab[128 + MAXTILES]);
        pg8::MoeSched<false> S; S.o.init(ntile, 4, G, bx); S.Bt = (const char*)(ws + WS_W2T); S.K = FF; S.rows_per_e = 1024; S.tab = tab; S.row_e = nullptr; S.es = 1;
        pg8::EpiDownF8 E{(unsigned char*)(ws + WS_YROWS), a.in[19]};
        pg8::gemm_phase(lds, (const char*)(ws + WS_HMID), FF, FF, FF, S, E);
    }
    SEAM(9);
    if constexpr (IN(10)) { moe_tables(a, lds); combine_rows(a, lds, vcu, G, wave, lane); }
    SEAM(10);
    if constexpr (IN(11)) {
        { pg8::DenseSched S; S.o.init(T / 256, D / 256, G, bx); S.Bt = (const char*)(ws + WS_WPG); S.K = D; S.es = 1;
          pg8::EpiBf16<1, false, true> E{(bf16_t*)(ws + WS_PGATE), D, nullptr, 0, 1.0f / 32.0f};
          pg8::gemm_phase(lds, (const char*)(ws + WS_H), D, D, D, S, E); }
    }
    SEAM(11);
    if constexpr (IN(12)) { final_rows(a, vcu, G, wave, lane); }
#undef IN
#undef SEAM
#undef GRID_BAR
}

template <int LO, int HI> static void launch_range(const Args& a, int grid, hipStream_t stream) {
    static bool attr = false;
    if (!attr) { attr = true; if (hipFuncSetAttribute((const void*)hybrid_fwd<LO, HI>, hipFuncAttributeMaxDynamicSharedMemorySize, LDS_BYTES) != hipSuccess) fprintf(stderr, "kernel_launch: hipFuncSetAttribute failed\n"); }
    hipLaunchKernelGGL((hybrid_fwd<LO, HI>), dim3(grid), dim3(NTHREADS), LDS_BYTES, stream, a);
}
extern "C" void kernel_launch(void* const* d_in, const int* in_sizes, int n_in, void* d_out, int out_size, void* d_ws, size_t ws_size, hipStream_t stream) {
    static int grid = 0;
    if (grid == 0) {
        static const int expect[25] = {T * D, T * 256, 256, 1024, 1024 * D_IN, 16 * 512, 512, 256, 1048576, 1048576, 1048576, 1024, 32768, 32, 33554432, 32768, 33554432, 32768, 33554432, 32768, 1024, 1048576, 262144, 1024, 1024};
        bool okk = (n_in == 25);
        for (int i = 0; okk && i < 25; ++i) if (in_sizes[i] != expect[i]) { fprintf(stderr, "kernel_launch: input %d has %d elements, expected %d\n", i, in_sizes[i], expect[i]); okk = false; }
        if (!okk || out_size != T * D || ws_size < WS_END) { fprintf(stderr, "kernel_launch: unexpected shapes (n_in %d, in0 %d, out %d, ws %zu); nothing launched\n", n_in, n_in > 0 ? in_sizes[0] : -1, out_size, ws_size); grid = -1; return; }
        int dev = 0, cus = 0;
        if (hipGetDevice(&dev) != hipSuccess || hipDeviceGetAttribute(&cus, hipDeviceAttributeMultiprocessorCount, dev) != hipSuccess) { grid = -1; return; }
        grid = cus;
    }
    if (grid < 0) return;
    (void)hipMemsetAsync((char*)d_ws + WS_CTL, 0, CTL_ZERO_BYTES, stream);
    Args a{};
    for (int i = 0; i < 25; ++i) a.p.in[i] = (const float*)d_in[i];
    a.p.out = (float*)d_out; a.p.ws = (unsigned char*)d_ws;
#if MK_PER_PHASE
#ifndef MK_LAST
#define MK_LAST 12
#endif
#ifndef MK_REPEAT
#define MK_REPEAT 0
#endif
#define LR(k) do { if ((k) <= MK_LAST) for (int r_ = 0; r_ < 1 + ((MK_REPEAT >> (k)) & 1); ++r_) launch_range<(k), (k) + 1>(a, grid, stream); } while (0)
    LR(0); LR(1); LR(2); LR(3); LR(4); LR(5); LR(6); LR(7); LR(8); LR(9); LR(10); LR(11); LR(12);
#undef LR
#else
    launch_range<0, NPHASES>(a, grid, stream);
#endif
}
```

```cpp
#include <hip/hip_runtime.h>
#include <cstdio>
#include <cstdint>

#define LAS __attribute__((address_space(3)))
#define GAS __attribute__((address_space(1)))
typedef unsigned short bf16_t;
typedef short bf16x8 __attribute__((ext_vector_type(8)));
typedef short s16x4 __attribute__((ext_vector_type(4)));
typedef float f32x2 __attribute__((ext_vector_type(2)));
typedef float f32x4 __attribute__((ext_vector_type(4)));
typedef float f32x16 __attribute__((ext_vector_type(16)));
typedef unsigned u32x2 __attribute__((ext_vector_type(2)));
typedef unsigned u32x4 __attribute__((ext_vector_type(4)));
typedef int i32x4 __attribute__((ext_vector_type(4)));
typedef int i32x8 __attribute__((ext_vector_type(8)));
typedef GAS unsigned gu32;
#define RLX_AGENT __ATOMIC_RELAXED, __HIP_MEMORY_SCOPE_AGENT
#define LDS_WAIT() asm volatile("s_waitcnt lgkmcnt(0)" ::: "memory")
#define VM_WAIT() asm volatile("s_waitcnt vmcnt(0)" ::: "memory")

#ifndef MK_PER_PHASE
#define MK_PER_PHASE 0
#endif

constexpr int NB = 8, SEQ = 2048, T = NB * SEQ, D = 1024;
constexpr int NPROJ = 8192;
constexpr int C_QA = 0, C_KA = 512, C_VA = 1024, C_RA = 2048, C_QB = 3072, C_KB = 4096, C_VB = 5120, C_GA = 6144, C_GB = 7168;
constexpr int SRC_ALOW = 3072, D_IN = 8208;
constexpr int NE = 32, FF = 1024, MAXTILES = 288, MAXROWS = MAXTILES * 256;
constexpr float EPS = 1e-6f;
constexpr int NWAVES = 8, NTHREADS = 512;
constexpr int NPHASES = 14;

constexpr size_t MiB = 1u << 20;
constexpr size_t WS_CTL = 0, CTL_ZERO_BYTES = 1 * MiB;
constexpr size_t WS_SMALL = 1 * MiB;
constexpr size_t WS_KMP   = WS_SMALL;
constexpr size_t WS_DEC   = WS_KMP + 512 * 1024;
constexpr size_t WS_TOPE  = WS_DEC + 512 * 1024;
constexpr size_t WS_WTS   = WS_TOPE + 256 * 1024;
constexpr size_t WS_SLOT  = WS_WTS + 256 * 1024;
constexpr size_t WS_DEST  = WS_SLOT + 256 * 1024;
constexpr size_t WS_ROWTOK = WS_DEST + 256 * 1024;
constexpr size_t WS_RSTDS = WS_ROWTOK + 320 * 1024;
constexpr size_t WS_RSTD  = WS_RSTDS + 320 * 1024;
constexpr size_t WS_TILEE = WS_RSTD + 64 * 1024;
constexpr size_t WS_WALT  = WS_TILEE + 4 * 1024;
constexpr size_t WS_WRF   = WS_WALT + 32 * 1024;
static_assert(WS_WRF + 128 * 1024 <= 6 * MiB, "small map");
constexpr size_t WS_WO = 6 * MiB, WS_WPG = 8 * MiB, WS_WPP = 10 * MiB, WS_WUP = 12 * MiB, WS_WIN = 16 * MiB;
constexpr size_t WS_PB = 34 * MiB;
constexpr size_t WS_H  = 42 * MiB;
constexpr size_t WS_PROJ = 74 * MiB;
constexpr size_t WS_QG = 330 * MiB, WS_KG = 346 * MiB;
constexpr size_t WS_SLOC = 426 * MiB;
constexpr size_t WS_OAB = 362 * MiB;
constexpr size_t WS_H8 = 426 * MiB;
constexpr size_t WS_WIN8 = 442 * MiB;
constexpr size_t WS_Y = 330 * MiB;
constexpr size_t WS_W2T = 42 * MiB;
constexpr size_t WS_A2 = 330 * MiB;
constexpr size_t WS_HMID = 138 * MiB;
constexpr size_t WS_X1 = 74 * MiB;
constexpr size_t WS_X2 = 138 * MiB;
constexpr size_t WS_YROWS = 282 * MiB;
constexpr size_t WS_PGATE = 330 * MiB, WS_PPROJ = 226 * MiB;
constexpr size_t WS_ROWE = 490 * MiB;
constexpr size_t WS_RSTE = 492 * MiB;
constexpr size_t WS_END = 506 * MiB;

constexpr int CW_BAR = 4096;
constexpr int CW_COUNTS = 16384;
constexpr int CW_QUEUE = 16384 + 64;

constexpr int RING_BYTES = 131072;
constexpr int LDSCTL_OFF = RING_BYTES, MISC_OFF = LDSCTL_OFF + 320;
constexpr int LDS_MOE = LDSCTL_OFF + 10240;
constexpr int LDS_BYTES = 147456;

typedef __bf16 bf16v2_t __attribute__((ext_vector_type(2)));
__device__ __forceinline__ unsigned cvt_pk_bf16(float lo, float hi) { const f32x2 v = {lo, hi}; return __builtin_bit_cast(unsigned, __builtin_convertvector(v, bf16v2_t)); }
__device__ __forceinline__ unsigned pk4_fp8(float a, float b, float c, float d) { int w = 0; w = __builtin_amdgcn_cvt_pk_fp8_f32(a, b, w, false); w = __builtin_amdgcn_cvt_pk_fp8_f32(c, d, w, true); return (unsigned)w; }
__device__ __forceinline__ float bf2f(unsigned short s) { return __uint_as_float(((unsigned)s) << 16); }
__device__ __forceinline__ float bflo(unsigned w) { return __uint_as_float(w << 16); }
__device__ __forceinline__ float bfhi(unsigned w) { return __uint_as_float(w & 0xffff0000u); }
__device__ __forceinline__ float fsigmoid(float x) { return __builtin_amdgcn_rcpf(1.0f + __builtin_amdgcn_exp2f(-1.4426950408889634f * x)); }
__device__ __forceinline__ float wave_sum(float v) {
#pragma unroll
    for (int o = 1; o < 64; o <<= 1) v += __shfl_xor(v, o);
    return v;
}
__device__ __forceinline__ bf16x8 pack8(f32x4 a, f32x4 b) {
    u32x4 w = {cvt_pk_bf16(a[0], a[1]), cvt_pk_bf16(a[2], a[3]), cvt_pk_bf16(b[0], b[1]), cvt_pk_bf16(b[2], b[3])};
    return __builtin_bit_cast(bf16x8, w);
}

#define XB_TMO      128
#define XB_XCNT(j)  (256  + 64 * (j))
#define XB_XSUB(j)  (1280 + 64 * (j))
#define XB_XGEN(j)  (2304 + 64 * (j))
#define XB_TOP      3328
#define XB_TOPGEN   3392
#define XCD_BAR_WORDS 3456
#define XB_SPIN_CAP (1u << 18)

__device__ __forceinline__ unsigned xb_ld(unsigned* p)              { return __hip_atomic_load(p, __ATOMIC_RELAXED, __HIP_MEMORY_SCOPE_AGENT); }
__device__ __forceinline__ unsigned xb_add(unsigned* p, unsigned v) { return __hip_atomic_fetch_add(p, v, __ATOMIC_RELAXED, __HIP_MEMORY_SCOPE_AGENT); }
__device__ __forceinline__ unsigned xb_xcc_id() { return (unsigned)__builtin_amdgcn_s_getreg((3 << 11) | 20) & 0xFu; }
#define XB_SPIN(cond, bar) do { unsigned _sp = 0; while (cond) { __builtin_amdgcn_s_sleep(1); \
    if ((++_sp & 255u) == 0u) { if (xb_ld(&(bar)[XB_TMO])) break; if (_sp > XB_SPIN_CAP) { atomicAdd(&(bar)[XB_TMO], 1u); break; } } } } while (0)

struct XcdBarrier { unsigned* bar; unsigned x; volatile LAS unsigned* st; };

__device__ __forceinline__ XcdBarrier xcd_barrier_post(unsigned* bar, volatile LAS unsigned* st) {
    XcdBarrier b; b.bar = bar; b.x = xb_xcc_id(); b.st = st;
    if (threadIdx.x == 0) (void)xb_add(&bar[XB_XCNT(b.x)], 1u);
    return b;
}
__device__ __forceinline__ void xcd_barrier_complete(unsigned* bar, unsigned x, unsigned& nloc, unsigned& nx) {
    const unsigned G = gridDim.x * gridDim.y * gridDim.z;
    unsigned sum, cnt, mine, sp = 0u;
    for (;;) {
        sum = 0u; cnt = 0u; mine = 0u;
#pragma unroll
        for (unsigned j = 0; j < 16; ++j) { const unsigned c = xb_ld(&bar[XB_XCNT(j)]); sum += c; cnt += (c > 0u) ? 1u : 0u; mine = (j == x) ? c : mine; }
        if (sum == G) break;
        __builtin_amdgcn_s_sleep(1);
        if ((++sp & 255u) == 0u) { if (xb_ld(&bar[XB_TMO])) break; if (sp > XB_SPIN_CAP) { atomicAdd(&bar[XB_TMO], 1u); break; } }
    }
    nloc = mine > 0u ? mine : 1u; nx = cnt > 0u ? cnt : 1u;
}
__device__ __forceinline__ void xcd_barrier(const XcdBarrier& b) {
    asm volatile("s_waitcnt vmcnt(0)" ::: "memory");
    __syncthreads();
    if (threadIdx.x == 0) {
        unsigned* bar = b.bar;
        __builtin_amdgcn_s_waitcnt(0);
        unsigned nloc = b.st[0], nx = b.st[1];
        if (nloc == 0u) { xcd_barrier_complete(bar, b.x, nloc, nx); b.st[0] = nloc; b.st[1] = nx; }
        const unsigned old = xb_add(&bar[XB_XSUB(b.x)], 1u);
        const unsigned gen = old / nloc;
        if (old + 1u == (gen + 1u) * nloc) {
            __builtin_amdgcn_fence(__ATOMIC_RELEASE, "agent");
            asm volatile("s_waitcnt vmcnt(0)" ::: "memory");
            const unsigned og = xb_add(&bar[XB_TOP], 1u);
            const unsigned tg = og / nx;
            if (og + 1u == (tg + 1u) * nx) xb_add(&bar[XB_TOPGEN], 1u);
            else XB_SPIN(xb_ld(&bar[XB_TOPGEN]) == tg, bar);
            __builtin_amdgcn_fence(__ATOMIC_ACQUIRE, "agent");
            xb_add(&bar[XB_XGEN(b.x)], 1u);
            asm volatile("s_waitcnt vmcnt(0)" ::: "memory");
        } else {
            XB_SPIN(xb_ld(&bar[XB_XGEN(b.x)]) == gen, bar);
            __builtin_amdgcn_fence(__ATOMIC_ACQUIRE, "agent");
            asm volatile("s_waitcnt vmcnt(0)" ::: "memory");
        }
    }
    __syncthreads();
}
namespace pg8 {
constexpr int BM = 256, BK = 64, HALF = 128, HTB = HALF * BK * 2, STAGE_BYTES = 8 * HTB, NXCD = 8, WGM = 8;

__host__ __device__ __forceinline__ int lds_byte(int r, int c) { const int st = (r >> 4) * 2 + (c >> 5), rr = r & 15, cc = c & 31, ob = rr * 64 + cc * 2; return st * 1024 + (ob ^ (((ob >> 9) & 1) << 5)); }
__host__ __device__ __forceinline__ void stage_rc(int b, int& R, int& C) { const int st = b / 1024, sb = b % 1024, swz = sb ^ (((sb >> 9) & 1) << 5); R = (st >> 1) * 16 + swz / 64; C = (st & 1) * 32 + (swz % 64) / 2; }
__host__ __device__ __forceinline__ int perm32(int rho) { const int n = rho >> 4, i = rho & 15; return 8 * (i >> 2) + 4 * n + (i & 3); }

struct Unit { int pm, pn, e; };

struct TileOrder {
    int nM, nN, nwg, G, c;
    __device__ __forceinline__ void init(int nM_, int nN_, int G_, int c_) { nM = nM_; nN = nN_; nwg = nM * nN; G = G_; c = c_; }
    __device__ __forceinline__ bool next(int i, int& pm, int& pn) const {
        const long L = (long)i * G + c; if (L >= nwg) return false;
        int wgid = (int)L; { const int q = nwg / NXCD, r = nwg % NXCD, xcd = wgid % NXCD, off = wgid / NXCD; wgid = (xcd < r ? xcd * (q + 1) : r * (q + 1) + (xcd - r) * q) + off; }
        const int nig = WGM * nN, gid = wgid / nig, fm = gid * WGM, gsz = (nM - fm) < WGM ? (nM - fm) : WGM;
        pm = fm + ((wgid % nig) % gsz); pn = (wgid % nig) / gsz; return true;
    }
};
struct DenseSched {
    TileOrder o; const char* Bt; int K; int es = 2; int gap_at = 1 << 30, gap_by = 0, pn0 = 0; bool bt_out = true;
    __device__ __forceinline__ bool next(int i, Unit& u) const { int p; if (!o.next(i, u.pm, p)) return false; u.e = p; u.pn = p + (p >= gap_at ? gap_by : 0) + pn0; return true; }
    __device__ __forceinline__ unsigned a_row(const Unit& u, int r) const { return (unsigned)(u.pm * BM + r); }
    __device__ __forceinline__ unsigned a_koff(const Unit&) const { return 0u; }
    __device__ __forceinline__ const char* b_base(const Unit& u) const { return Bt + (size_t)(bt_out ? u.pn : u.e) * BM * K * es; }
};
struct ChainSched {
    TileOrder o; const char* Bt; int K;
    __device__ __forceinline__ bool next(int i, Unit& u) const { if (!o.next(i >> 1, u.pm, u.pn)) return false; u.e = i & 1; return true; }
    __device__ __forceinline__ unsigned a_row(const Unit& u, int r) const { return (unsigned)(u.pm * BM + r); }
    __device__ __forceinline__ unsigned a_koff(const Unit& u) const { return (unsigned)(u.e * K * 2); }
    __device__ __forceinline__ const char* b_base(const Unit& u) const { return Bt + (size_t)u.pn * BM * (2 * K) * 2 + (size_t)u.e * K * 2; }
};
template <bool GATHER> struct MoeSched {
    TileOrder o; const char* Bt; int K; int rows_per_e; const LAS int* tab; const int* row_e; int es;
    __device__ __forceinline__ bool next(int i, Unit& u) const { if (!o.next(i, u.pm, u.pn)) return false; u.e = __builtin_amdgcn_readfirstlane(tab[128 + u.pm]); return true; }
    __device__ __forceinline__ unsigned a_row(const Unit& u, int r) const {
        if (GATHER) { const int lr = u.pm * BM + r - tab[u.e]; return lr < tab[64 + u.e] ? (unsigned)row_e[(size_t)u.e * T + lr] : 0u; }
        else return (unsigned)(u.pm * BM + r); }
    __device__ __forceinline__ unsigned a_koff(const Unit&) const { return 0u; }
    __device__ __forceinline__ const char* b_base(const Unit& u) const { return Bt + ((size_t)u.e * rows_per_e + (size_t)u.pn * BM) * K * es; }
};

template <class Epi, class Sched>
__device__ __forceinline__ void gemm_phase(LAS unsigned char* lds, const char* gA, int K_, int lda, int ldb, const Sched& S, const Epi& E) {
    int K = K_; asm volatile("" : "+s"(K));
    int tid = threadIdx.x; asm volatile("" : "+v"(tid));     const int wid = __builtin_amdgcn_readfirstlane(tid >> 6), lane = tid & 63, wr = wid >> 2, wc = wid & 3, fr = lane & 15, fq = lane >> 4;
    constexpr int ES = Epi::F8 ? 1 : 2;
    const int nt = K * ES / 128;
    unsigned voffB[2];
#pragma unroll
    for (int i = 0; i < 2; ++i) { int R, C; stage_rc(tid * 16 + i * 8192, R, C); const int Rb = Epi::PERM ? ((R & ~31) + perm32(R & 31)) : R; voffB[i] = (unsigned)(Rb * ldb * ES + C * 2); }
    const unsigned kstep = (unsigned)(BK * 2);
    const size_t hstepB = (size_t)HALF * ldb * ES;
    const unsigned ldab = (unsigned)lda * ES;
    const unsigned ldsw = (unsigned)wid * 1024u;
    const int aoff = lds_byte(wr * 64 + fr, fq * 8), boff = lds_byte(wc * 32 + fr, fq * 8);
#define PG8_SA(b, h) (((b) * 2 + (h)) * HTB)
#define PG8_SB(b, h) ((4 + (b) * 2 + (h)) * HTB)
#define PG8_STAGE_B(bufoff, gbase) do { _Pragma("unroll") for (int _i = 0; _i < 2; ++_i) \
        __builtin_amdgcn_global_load_lds((const unsigned*)((const char*)(gbase) + voffB[_i]), (LAS unsigned*)(lds + (bufoff) + ldsw + _i * 8192), 16, 0, 0); } while (0)
#define PG8_STAGE_A(bufoff, o0, o1, kb) do { \
        const char* gk_ = gA + (kb);      \
        __builtin_amdgcn_global_load_lds((const unsigned*)(gk_ + (o0)), (LAS unsigned*)(lds + (bufoff) + ldsw), 16, 0, 0); \
        __builtin_amdgcn_global_load_lds((const unsigned*)(gk_ + (o1)), (LAS unsigned*)(lds + (bufoff) + ldsw + 8192), 16, 0, 0); } while (0)
#define PG8_LDA(dst, b, h) do { _Pragma("unroll") for (int m = 0; m < 4; ++m) _Pragma("unroll") for (int k = 0; k < 2; ++k) dst[m][k] = *(const LAS bf16x8*)(lds + PG8_SA(b, h) + aoff + m * 2048 + k * 1024); } while (0)
#define PG8_LDB(dst, b, h) do { _Pragma("unroll") for (int n = 0; n < 2; ++n) _Pragma("unroll") for (int k = 0; k < 2; ++k) dst[n][k] = *(const LAS bf16x8*)(lds + PG8_SB(b, h) + boff + n * 2048 + k * 1024); } while (0)
#define PG8_MMA(ai, bj, At, Bt) do { __builtin_amdgcn_s_setprio(1); \
        if constexpr (Epi::F8) { _Pragma("unroll") for (int m = 0; m < 4; ++m) _Pragma("unroll") for (int n = 0; n < 2; ++n) { \
            const i32x8 a8_ = __builtin_shufflevector(__builtin_bit_cast(i32x4, At[m][0]), __builtin_bit_cast(i32x4, At[m][1]), 0, 1, 2, 3, 4, 5, 6, 7); \
            const i32x8 b8_ = __builtin_shufflevector(__builtin_bit_cast(i32x4, Bt[n][0]), __builtin_bit_cast(i32x4, Bt[n][1]), 0, 1, 2, 3, 4, 5, 6, 7); \
            acc[ai][bj][m][n] = __builtin_amdgcn_mfma_scale_f32_16x16x128_f8f6f4(b8_, a8_, acc[ai][bj][m][n], 0, 0, 0, 0x7F7F7F7F, 0, 0x7F7F7F7F); } } \
        else { _Pragma("unroll") for (int m = 0; m < 4; ++m) _Pragma("unroll") for (int n = 0; n < 2; ++n) _Pragma("unroll") for (int k = 0; k < 2; ++k) \
            acc[ai][bj][m][n] = __builtin_amdgcn_mfma_f32_16x16x32_bf16(Bt[n][k], At[m][k], acc[ai][bj][m][n], 0, 0, 0); } \
        __builtin_amdgcn_s_setprio(0); } while (0)
#define PG8_WAIT_V(n) asm volatile("s_waitcnt vmcnt(" #n ")" ::: "memory")
#define PG8_WAIT_L(n) asm volatile("s_waitcnt lgkmcnt(" #n ")" ::: "memory")
#define PG8_BAR __builtin_amdgcn_s_barrier()
#define PG8_SCHED __builtin_amdgcn_sched_barrier(0)
#define PG8_AOFFS(dst, u) do { _Pragma("unroll") for (int _h = 0; _h < 2; ++_h) _Pragma("unroll") for (int _i = 0; _i < 2; ++_i) { int R_, C_; stage_rc(tid * 16 + _i * 8192, R_, C_); \
        dst[_h][_i] = S.a_row(u, _h * HALF + R_) * ldab + (unsigned)C_ * 2u + S.a_koff(u); } } while (0)
    Unit cur, nxt; int ui = 0;
    if (!S.next(0, cur)) return;
#ifdef MK_STAGGER
    if (S.o.nwg > 3 * S.o.G) {
        const unsigned long long t0_ = __builtin_amdgcn_s_memrealtime(); const unsigned long long d_ = (unsigned long long)((blockIdx.x >> 3) & 7) * MK_STAGGER;
        while (__builtin_amdgcn_s_memrealtime() - t0_ < d_) __builtin_amdgcn_s_sleep(4);
    }
#endif
    f32x4 acc[2][2][4][2];
#pragma unroll
    for (int a = 0; a < 2; ++a)
#pragma unroll
        for (int b = 0; b < 2; ++b)
#pragma unroll
            for (int m = 0; m < 4; ++m)
#pragma unroll
                for (int n = 0; n < 2; ++n) acc[a][b][m][n] = (f32x4){0.f, 0.f, 0.f, 0.f};
    bf16x8 At[4][2], B0[2][2], B1[2][2];
    unsigned oc[2][2];
    LAS u32x4* nslot = (LAS u32x4*)(lds + LDSCTL_OFF + 2048) + tid;
    PG8_AOFFS(oc, cur);
    const char* cB = S.b_base(cur);
    PG8_STAGE_B(PG8_SB(0, 0), cB); PG8_STAGE_B(PG8_SB(0, 1), cB + hstepB); PG8_STAGE_A(PG8_SA(0, 0), oc[0][0], oc[0][1], 0u); PG8_STAGE_A(PG8_SA(0, 1), oc[1][0], oc[1][1], 0u);
    if (wr == 1) PG8_BAR;
    PG8_WAIT_V(2); PG8_BAR;
    PG8_STAGE_B(PG8_SB(1, 0), cB + kstep); PG8_STAGE_A(PG8_SA(1, 0), oc[0][0], oc[0][1], kstep); PG8_STAGE_B(PG8_SB(1, 1), cB + hstepB + kstep);
    PG8_WAIT_V(6); PG8_BAR;
    for (;;) {
        const bool has_next = S.next(ui + 1, nxt);
        const char* nB = has_next ? S.b_base(nxt) : cB;
        if (has_next) { unsigned on[2][2]; PG8_AOFFS(on, nxt); *nslot = (u32x4){on[0][0], on[0][1], on[1][0], on[1][1]}; }
        for (int t = 0; t < nt; t += 2) {
            const bool last = (t == nt - 2);
            const unsigned k1 = (unsigned)(t + 1) * kstep;
            const unsigned k2 = last ? 0u : (unsigned)(t + 2) * kstep, k3 = k2 + kstep;
            const char* b2 = last ? nB : cB + (size_t)(t + 2) * kstep; const char* b3 = b2 + kstep;
            PG8_LDB(B0, 0, 0); PG8_LDB(B1, 0, 1); PG8_SCHED; PG8_LDA(At, 0, 0); PG8_STAGE_A(PG8_SA(1, 1), oc[1][0], oc[1][1], k1);
            PG8_WAIT_V(8); PG8_WAIT_L(0); PG8_BAR; PG8_MMA(0, 0, At, B0); PG8_MMA(0, 1, At, B1); PG8_BAR; PG8_SCHED;
            if (last && has_next) { const u32x4 o_ = *nslot; oc[0][0] = o_.x; oc[0][1] = o_.y; oc[1][0] = o_.z; oc[1][1] = o_.w; }
            PG8_LDA(At, 0, 1); PG8_STAGE_B(PG8_SB(0, 0), b2); PG8_STAGE_B(PG8_SB(0, 1), b2 + hstepB); PG8_STAGE_A(PG8_SA(0, 0), oc[0][0], oc[0][1], k2);
            PG8_WAIT_V(8); PG8_WAIT_L(0); PG8_BAR; PG8_MMA(1, 0, At, B0); PG8_MMA(1, 1, At, B1); PG8_BAR; PG8_SCHED;
            PG8_LDB(B0, 1, 0); PG8_LDB(B1, 1, 1); PG8_SCHED; PG8_LDA(At, 1, 0); PG8_STAGE_A(PG8_SA(0, 1), oc[1][0], oc[1][1], k2);
            PG8_WAIT_V(8); PG8_WAIT_L(0); PG8_BAR; PG8_MMA(0, 0, At, B0); PG8_MMA(0, 1, At, B1); PG8_BAR; PG8_SCHED;
            PG8_LDA(At, 1, 1); PG8_STAGE_B(PG8_SB(1, 0), b3); PG8_STAGE_B(PG8_SB(1, 1), b3 + hstepB); PG8_STAGE_A(PG8_SA(1, 0), oc[0][0], oc[0][1], k3);
            PG8_WAIT_V(8); PG8_WAIT_L(0); PG8_BAR; PG8_MMA(1, 0, At, B0); PG8_MMA(1, 1, At, B1); PG8_BAR; PG8_SCHED;
        }
        if (wr == 0) PG8_BAR;
        bool carry = false;
        if constexpr (Epi::MIDK) { if (cur.e == 0) { E.mid(acc, cur, wr, wc, fr, fq); carry = true; } else E(acc, cur, wr, wc, fr, fq); } else E(acc, cur, wr, wc, fr, fq);
        if (!has_next) break;
        if (!carry)
#pragma unroll
        for (int a = 0; a < 2; ++a)
#pragma unroll
            for (int b = 0; b < 2; ++b)
#pragma unroll
                for (int m = 0; m < 4; ++m)
#pragma unroll
                    for (int n = 0; n < 2; ++n) acc[a][b][m][n] = (f32x4){0.f, 0.f, 0.f, 0.f};
        cur = nxt; cB = nB; ++ui;
        if (wr == 1) PG8_BAR;
    }
    PG8_WAIT_V(0);
    PG8_BAR;
#undef PG8_SA
#undef PG8_SB
#undef PG8_STAGE_A
#undef PG8_STAGE_B
#undef PG8_LDA
#undef PG8_LDB
#undef PG8_MMA
#undef PG8_WAIT_V
#undef PG8_WAIT_L
#undef PG8_BAR
#undef PG8_SCHED
#undef PG8_AOFFS
}

template <bool F8_> struct EpiProj {
    static constexpr bool PERM = true, MIDK = false, F8 = F8_;
    bf16_t* O; float* kmp;
    __device__ __forceinline__ void operator()(const f32x4 (&acc)[2][2][4][2], const Unit& u, int wr, int wc, int fr, int fq) const {
        const int row0 = u.pm * BM + wr * 64 + fr; const int col0 = u.pn * BM + wc * 32 + 8 * fq;
#pragma unroll
        for (int ai = 0; ai < 2; ++ai)
#pragma unroll
            for (int m = 0; m < 4; ++m) { bf16_t* rowp = O + (size_t)(row0 + ai * HALF + m * 16) * NPROJ + col0;
#pragma unroll
                for (int bj = 0; bj < 2; ++bj) { const float sc = F8 ? (1.0f / 32.0f) : 1.0f; const f32x4 v0 = acc[ai][bj][m][0] * sc, v1 = acc[ai][bj][m][1] * sc;
                    u32x4 w; w.x = cvt_pk_bf16(v0[0], v0[1]); w.y = cvt_pk_bf16(v0[2], v0[3]); w.z = cvt_pk_bf16(v1[0], v1[1]); w.w = cvt_pk_bf16(v1[2], v1[3]);
                    __builtin_nontemporal_store(w, (u32x4*)(rowp + bj * HALF)); } }
        if (u.pn >= C_KB / BM && u.pn < C_VB / BM) {
#pragma unroll
            for (int bj = 0; bj < 2; ++bj)
#pragma unroll
                for (int n = 0; n < 2; ++n) { f32x4 s = (f32x4){0.f, 0.f, 0.f, 0.f};
#pragma unroll
                    for (int ai = 0; ai < 2; ++ai)
#pragma unroll
                        for (int m = 0; m < 4; ++m) s += acc[ai][bj][m][n];
#pragma unroll
                    for (int o = 1; o < 16; o <<= 1) { s[0] += __shfl_xor(s[0], o); s[1] += __shfl_xor(s[1], o); s[2] += __shfl_xor(s[2], o); s[3] += __shfl_xor(s[3], o); }
                    if (fr == 0) *(f32x4*)(kmp + ((size_t)wr * 64 + u.pm) * 1024 + (u.pn - C_KB / BM) * BM + bj * HALF + wc * 32 + 8 * fq + 4 * n) = s * (F8 ? (1.0f / 32.0f) : 1.0f); }
        }
    }
};
struct EpiMerge {
    static constexpr bool PERM = true, MIDK = true, F8 = false;
    const bf16_t* proj; bf16_t* Y;
    __device__ __forceinline__ void mid(f32x4 (&acc)[2][2][4][2], const Unit& u, int wr, int wc, int fr, int fq) const {
        const int row0 = u.pm * BM + wr * 64 + fr; const int col0 = u.pn * BM + wc * 32 + 8 * fq;
#pragma unroll
        for (int ai = 0; ai < 2; ++ai) {
            u32x4 ga[4][2], gb[4][2];
#pragma unroll
            for (int m = 0; m < 4; ++m) { const bf16_t* rowp = proj + (size_t)(row0 + ai * HALF + m * 16) * NPROJ + col0;
#pragma unroll
                for (int bj = 0; bj < 2; ++bj) { ga[m][bj] = *(const u32x4*)(rowp + C_GA + bj * HALF); gb[m][bj] = *(const u32x4*)(rowp + C_GB + bj * HALF); } }
#pragma unroll
            for (int m = 0; m < 4; ++m) {
#pragma unroll
                for (int bj = 0; bj < 2; ++bj) {
#pragma unroll
                    for (int j = 0; j < 4; ++j) { const float a0 = bflo(ga[m][bj][j]), a1 = bfhi(ga[m][bj][j]), b0 = bflo(gb[m][bj][j]), b1 = bfhi(gb[m][bj][j]);
                        const float r0 = (1.0f + __builtin_amdgcn_exp2f(-1.4426950408889634f * b0)) * __builtin_amdgcn_rcpf(1.0f + __builtin_amdgcn_exp2f(-1.4426950408889634f * a0));
                        const float r1 = (1.0f + __builtin_amdgcn_exp2f(-1.4426950408889634f * b1)) * __builtin_amdgcn_rcpf(1.0f + __builtin_amdgcn_exp2f(-1.4426950408889634f * a1));
                        acc[ai][bj][m][j >> 1][(j & 1) * 2] *= r0; acc[ai][bj][m][j >> 1][(j & 1) * 2 + 1] *= r1; } }
                asm volatile("" : "+v"(acc[ai][0][m][0]), "+v"(acc[ai][0][m][1]), "+v"(acc[ai][1][m][0]), "+v"(acc[ai][1][m][1])); }
            asm volatile("" ::: "memory"); }
    }
    __device__ __forceinline__ void operator()(const f32x4 (&acc)[2][2][4][2], const Unit& u, int wr, int wc, int fr, int fq) const {
        const int row0 = u.pm * BM + wr * 64 + fr; const int col0 = u.pn * BM + wc * 32 + 8 * fq;
#pragma unroll
        for (int ai = 0; ai < 2; ++ai) {
            u32x4 gb[4][2];
#pragma unroll
            for (int m = 0; m < 4; ++m)
#pragma unroll
                for (int bj = 0; bj < 2; ++bj) gb[m][bj] = *(const u32x4*)(proj + (size_t)(row0 + ai * HALF + m * 16) * NPROJ + C_GB + col0 + bj * HALF);
#pragma unroll
            for (int m = 0; m < 4; ++m) { const size_t r = (size_t)(row0 + ai * HALF + m * 16);
#pragma unroll
                for (int bj = 0; bj < 2; ++bj) { const u32x4 g = gb[m][bj];
                    const f32x4 v0 = acc[ai][bj][m][0], v1 = acc[ai][bj][m][1];
                    u32x4 w; w.x = cvt_pk_bf16(v0[0] * fsigmoid(bflo(g[0])), v0[1] * fsigmoid(bfhi(g[0]))); w.y = cvt_pk_bf16(v0[2] * fsigmoid(bflo(g[1])), v0[3] * fsigmoid(bfhi(g[1])));
                    w.z = cvt_pk_bf16(v1[0] * fsigmoid(bflo(g[2])), v1[1] * fsigmoid(bfhi(g[2]))); w.w = cvt_pk_bf16(v1[2] * fsigmoid(bflo(g[3])), v1[3] * fsigmoid(bfhi(g[3])));
                    *(u32x4*)(Y + r * D + col0 + bj * HALF) = w; } }
            asm volatile("" ::: "memory"); }
    }
};
struct EpiResF32 {
    static constexpr bool PERM = false, MIDK = false, F8 = false;
    const float* base; bf16_t* out;
    __device__ __forceinline__ void operator()(const f32x4 (&acc)[2][2][4][2], const Unit& u, int wr, int wc, int fr, int fq) const {
        const int row0 = u.pm * BM + wr * 64 + fr, col0 = u.pn * BM + wc * 32 + 4 * fq;
#pragma unroll
        for (int ai = 0; ai < 2; ++ai) {
            f32x4 bs[4][2][2];
#pragma unroll
            for (int m = 0; m < 4; ++m) { const size_t off = (size_t)(row0 + ai * HALF + m * 16) * D + col0;
#pragma unroll
                for (int bj = 0; bj < 2; ++bj)
#pragma unroll
                    for (int n = 0; n < 2; ++n) bs[m][bj][n] = __builtin_nontemporal_load((const f32x4*)(base + off + bj * HALF + n * 16)); }
#pragma unroll
            for (int m = 0; m < 4; ++m) { const size_t off = (size_t)(row0 + ai * HALF + m * 16) * D + col0;
#pragma unroll
                for (int bj = 0; bj < 2; ++bj)
#pragma unroll
                    for (int n = 0; n < 2; ++n) { const f32x4 v = bs[m][bj][n] + acc[ai][bj][m][n]; u32x2 w; w.x = cvt_pk_bf16(v[0], v[1]); w.y = cvt_pk_bf16(v[2], v[3]); *(u32x2*)(out + off + bj * HALF + n * 16) = w; } }
            asm volatile("" ::: "memory"); }
    }
};
struct EpiGlu {
    static constexpr bool PERM = true, MIDK = false, F8 = true;
    unsigned char* H; const float* rstd_e; const LAS int* tab; const float* bg; const float* bu;
    __device__ __forceinline__ void operator()(const f32x4 (&acc)[2][2][4][2], const Unit& u, int wr, int wc, int fr, int fq) const {
        const int row0 = u.pm * BM + wr * 64 + fr; const int colo = u.pn * HALF + wc * 32 + 8 * fq;
        f32x4 g4[2], u4[2];
#pragma unroll
        for (int n = 0; n < 2; ++n) { g4[n] = *(const f32x4*)(bg + (size_t)u.e * FF + colo + 4 * n); u4[n] = *(const f32x4*)(bu + (size_t)u.e * FF + colo + 4 * n); }
        float rsv[2][4];
#pragma unroll
        for (int ai = 0; ai < 2; ++ai)
#pragma unroll
            for (int m = 0; m < 4; ++m) { const int lr = row0 + ai * HALF + m * 16 - tab[u.e]; rsv[ai][m] = lr < tab[64 + u.e] ? rstd_e[(size_t)u.e * T + lr] : 0.f; }
#pragma unroll
        for (int ai = 0; ai < 2; ++ai)
#pragma unroll
            for (int m = 0; m < 4; ++m) { const int r = row0 + ai * HALF + m * 16; const float rs = rsv[ai][m] * (1.0f / 32.0f);
                float o[8];
#pragma unroll
                for (int n = 0; n < 2; ++n)
#pragma unroll
                    for (int j = 0; j < 4; ++j) { float g = acc[ai][0][m][n][j] * rs + g4[n][j], up = acc[ai][1][m][n][j] * rs + u4[n][j];
                        g = fminf(g, 7.0f); up = fminf(fmaxf(up, -7.0f), 7.0f);
                        const float glu = g * fsigmoid(1.702f * g); o[n * 4 + j] = (up + 1.0f) * glu; }
                u32x2 w; w.x = pk4_fp8(o[0], o[1], o[2], o[3]); w.y = pk4_fp8(o[4], o[5], o[6], o[7]);
                *(u32x2*)(H + (size_t)r * FF + colo) = w; asm volatile("" ::: "memory"); }
    }
};
template <int ACT, bool HASBIAS, bool F8_ = false> struct EpiBf16 {
    static constexpr bool PERM = true, MIDK = false, F8 = F8_;
    bf16_t* O; int ldc; const float* bias; int bias_stride; float scale;
    __device__ __forceinline__ void operator()(const f32x4 (&acc)[2][2][4][2], const Unit& u, int wr, int wc, int fr, int fq) const {
        const int row0 = u.pm * BM + wr * 64 + fr; const int col0 = u.pn * BM + wc * 32 + 8 * fq;
        f32x4 bv[2][2];
#pragma unroll
        for (int bj = 0; bj < 2; ++bj)
#pragma unroll
            for (int n = 0; n < 2; ++n) bv[bj][n] = HASBIAS ? *(const f32x4*)(bias + (size_t)u.e * bias_stride + col0 + bj * HALF + 4 * n) : (f32x4){0.f, 0.f, 0.f, 0.f};
#pragma unroll
        for (int ai = 0; ai < 2; ++ai)
#pragma unroll
            for (int m = 0; m < 4; ++m) { bf16_t* rowp = O + (size_t)(row0 + ai * HALF + m * 16) * ldc + col0;
#pragma unroll
                for (int bj = 0; bj < 2; ++bj) { f32x4 v0 = acc[ai][bj][m][0] * scale + bv[bj][0], v1 = acc[ai][bj][m][1] * scale + bv[bj][1];
                    if (ACT == 1) {
#pragma unroll
                        for (int j = 0; j < 4; ++j) { v0[j] = fsigmoid(v0[j]); v1[j] = fsigmoid(v1[j]); } }
                    u32x4 w; w.x = cvt_pk_bf16(v0[0], v0[1]); w.y = cvt_pk_bf16(v0[2], v0[3]); w.z = cvt_pk_bf16(v1[0], v1[1]); w.w = cvt_pk_bf16(v1[2], v1[3]);
                    *(u32x4*)(rowp + bj * HALF) = w; }
                asm volatile("" ::: "memory"); }
    }
};
struct EpiDownF8 {
    static constexpr bool PERM = true, MIDK = false, F8 = true;
    unsigned char* O; const float* bias;
    __device__ __forceinline__ void operator()(const f32x4 (&acc)[2][2][4][2], const Unit& u, int wr, int wc, int fr, int fq) const {
        const int row0 = u.pm * BM + wr * 64 + fr; const int col0 = u.pn * BM + wc * 32 + 8 * fq;
        f32x4 bv[2][2];
#pragma unroll
        for (int bj = 0; bj < 2; ++bj)
#pragma unroll
            for (int n = 0; n < 2; ++n) bv[bj][n] = *(const f32x4*)(bias + (size_t)u.e * D + col0 + bj * HALF + 4 * n);
#pragma unroll
        for (int ai = 0; ai < 2; ++ai)
#pragma unroll
            for (int m = 0; m < 4; ++m) { unsigned char* rowp = O + (size_t)(row0 + ai * HALF + m * 16) * D + col0;
#pragma unroll
                for (int bj = 0; bj < 2; ++bj) { const f32x4 v0 = acc[ai][bj][m][0] * (1.0f / 32.0f) + bv[bj][0], v1 = acc[ai][bj][m][1] * (1.0f / 32.0f) + bv[bj][1];
                    u32x2 w; w.x = pk4_fp8(v0[0], v0[1], v0[2], v0[3]); w.y = pk4_fp8(v1[0], v1[1], v1[2], v1[3]);
                    *(u32x2*)(rowp + bj * HALF) = w; }
                asm volatile("" ::: "memory"); }
    }
};
}
__device__ __forceinline__ void transpose_item(const float* __restrict__ W, int ldw, int k0, int n_src0, bf16_t* __restrict__ WT, int ldo, int n_dst0, int k_off, LAS float* scr, int lane) {
    { float t_[32]; const float* wp_ = W + (size_t)(k0 + (lane >> 5)) * ldw + n_src0 + (lane & 31);
#pragma unroll
    for (int i = 0; i < 32; ++i) t_[i] = __builtin_nontemporal_load(wp_ + (size_t)(2 * i) * ldw);
#pragma unroll
    for (int i = 0; i < 32; ++i) scr[(2 * i + (lane >> 5)) * 33 + (lane & 31)] = t_[i]; }
    LDS_WAIT(); asm volatile("" ::: "memory");
    const int c = lane & 7;
#pragma unroll
    for (int j = 0; j < 4; ++j) { const int n = (lane >> 3) + 8 * j; const LAS float* s = scr + (8 * c) * 33 + n;
        u32x4 o; o.x = cvt_pk_bf16(s[0 * 33], s[1 * 33]); o.y = cvt_pk_bf16(s[2 * 33], s[3 * 33]); o.z = cvt_pk_bf16(s[4 * 33], s[5 * 33]); o.w = cvt_pk_bf16(s[6 * 33], s[7 * 33]);
        *(u32x4*)(WT + (size_t)(n_dst0 + n) * ldo + k_off + k0 + 8 * c) = o; }
    LDS_WAIT(); asm volatile("" ::: "memory");
}
__device__ __forceinline__ void transpose_item_f8(const float* __restrict__ W, int ldw, int k0, int n_src0, unsigned char* __restrict__ WT, int ldo, int n_dst0, float sc, LAS float* scr, int lane) {
    { float t_[32]; const float* wp_ = W + (size_t)(k0 + (lane >> 5)) * ldw + n_src0 + (lane & 31);
#pragma unroll
    for (int i = 0; i < 32; ++i) t_[i] = __builtin_nontemporal_load(wp_ + (size_t)(2 * i) * ldw);
#pragma unroll
    for (int i = 0; i < 32; ++i) scr[(2 * i + (lane >> 5)) * 33 + (lane & 31)] = t_[i]; }
    LDS_WAIT(); asm volatile("" ::: "memory");
    const int c = lane & 7;
#pragma unroll
    for (int j = 0; j < 4; ++j) { const int n = (lane >> 3) + 8 * j; const LAS float* s = scr + (8 * c) * 33 + n;
        u32x2 o; o.x = pk4_fp8(s[0 * 33] * sc, s[1 * 33] * sc, s[2 * 33] * sc, s[3 * 33] * sc); o.y = pk4_fp8(s[4 * 33] * sc, s[5 * 33] * sc, s[6 * 33] * sc, s[7 * 33] * sc);
        *(u32x2*)(WT + (size_t)(n_dst0 + n) * ldo + k0 + 8 * c) = o; }
    LDS_WAIT(); asm volatile("" ::: "memory");
}
__device__ __forceinline__ void transpose_mat_item(const float* W, int ldw, int N, int n_src_base, bf16_t* WT, int ldo, int n_dst_base, int k_off, LAS float* scr, int item, int lane) {
    const int nblk = N / 32, kb = item / nblk, nb = item % nblk;
    transpose_item(W, ldw, 64 * kb, n_src_base + 32 * nb, WT, ldo, n_dst_base + 32 * nb, k_off, scr, lane);
}

struct P {
    const float* in[25]; float* out; unsigned char* ws;
};

__device__ __forceinline__ void p0_prologue(const P& a, LAS unsigned char* lds, int vcu, int G, int wave, int lane) {
    LAS float* scr = (LAS float*)(lds + wave * 16384);
    const int gw = vcu * NWAVES + wave, NGW = G * NWAVES;
    unsigned char* ws = a.ws;
    bf16_t* WinT = (bf16_t*)(ws + WS_WIN); bf16_t* WupT = (bf16_t*)(ws + WS_WUP); bf16_t* WoT = (bf16_t*)(ws + WS_WO); bf16_t* WpgT = (bf16_t*)(ws + WS_WPG); bf16_t* WppT = (bf16_t*)(ws + WS_WPP);
    constexpr int I_A = 16 * 96, I_B = 16 * 160, I_S = 16 * 32, I_P = 4 * 32;
    constexpr int NITEMS = I_A + I_B + 4 * I_S + I_P;
#ifndef P0_PARTS
#define P0_PARTS 63
#endif
    if (P0_PARTS & 1)
    for (int it = gw; it < NITEMS; it += NGW) {
        int r = it;
        if (r < I_A) { transpose_mat_item(a.in[4], D_IN, 3072, 0, WinT, D, 0, 0, scr, r, lane); continue; } r -= I_A;
        if (r < I_B) { transpose_mat_item(a.in[4], D_IN, 5120, 3088, WinT, D, 3072, 0, scr, r, lane); continue; } r -= I_B;
        if (r < I_S) { transpose_mat_item(a.in[8], D, D, 0, WupT, 2048, 0, 0, scr, r, lane); continue; } r -= I_S;
        if (r < I_S) { transpose_mat_item(a.in[9], D, D, 0, WupT, 2048, 0, 1024, scr, r, lane); continue; } r -= I_S;
        if (r < I_S) { transpose_mat_item(a.in[10], D, D, 0, WoT, D, 0, 0, scr, r, lane); continue; } r -= I_S;
        if (r < I_S) { const int kb = r / 32, nb = r % 32; transpose_item_f8(a.in[21], D, 64 * kb, 32 * nb, (unsigned char*)WpgT, D, 32 * nb, 32.0f, scr, lane); continue; } r -= I_S;
        transpose_mat_item(a.in[22], D, D, 0, WppT, 256, 0, 0, scr, r, lane);
    }
    if (P0_PARTS & 2) {
        const float* x = a.in[0]; const float* g = a.in[3]; bf16_t* H = (bf16_t*)(ws + WS_H);
        f32x4 gv[4];
#pragma unroll
        for (int j = 0; j < 4; ++j) gv[j] = *((const f32x4*)g + lane + 64 * j);
        for (int m = gw; m < T; m += NGW) {
            const f32x4* xr = (const f32x4*)(x + (size_t)m * D) + lane; f32x4 v[4]; float s = 0.f;
#pragma unroll
            for (int j = 0; j < 4; ++j) { v[j] = __builtin_nontemporal_load(xr + 64 * j); s += (v[j].x * v[j].x + v[j].y * v[j].y) + (v[j].z * v[j].z + v[j].w * v[j].w); }
            const float rstd = 1.0f / sqrtf(wave_sum(s) * (1.0f / D) + EPS);
            u32x2* o8 = (u32x2*)(H + (size_t)m * D) + lane;
#pragma unroll
            for (int j = 0; j < 4; ++j) { const f32x4 y = v[j] * rstd * gv[j]; u32x2 w; w.x = cvt_pk_bf16(y.x, y.y); w.y = cvt_pk_bf16(y.z, y.w); o8[64 * j] = w; }
        }
    }
    if (P0_PARTS & 4) {
        const f32x4* p4 = (const f32x4*)a.in[1]; u32x2* pb = (u32x2*)(ws + WS_PB);
        const size_t n4 = (size_t)T * 256 / 4;
        for (size_t i = (size_t)gw * 64 + lane; i < n4; i += (size_t)NGW * 64) { const f32x4 v = __builtin_nontemporal_load(p4 + i); u32x2 w; w.x = cvt_pk_bf16(v.x, v.y); w.y = cvt_pk_bf16(v.z, v.w); pb[i] = w; }
    }
    if (P0_PARTS & 8) {
        const int gt = (vcu * NWAVES + wave) * 64 + lane;
        if ((P0_PARTS & 16) && gt < 16 * 1024) { const int n = gt >> 10, k = gt & 1023; ((bf16_t*)(ws + WS_WALT))[n * 1024 + k] = (bf16_t)(cvt_pk_bf16(a.in[4][(size_t)k * D_IN + SRC_ALOW + n], 0.f) & 0xffffu); }
        if ((P0_PARTS & 32) && gt < 4096) { const int s = gt >> 6, l = gt & 63, e = l & 31, hh = l >> 5; const float* wr = a.in[12];
            float v[8], lo[8];
#pragma unroll
            for (int j = 0; j < 8; ++j) { v[j] = wr[(size_t)(16 * s + 8 * hh + j) * NE + e]; }
            u32x4 whi; whi.x = cvt_pk_bf16(v[0], v[1]); whi.y = cvt_pk_bf16(v[2], v[3]); whi.z = cvt_pk_bf16(v[4], v[5]); whi.w = cvt_pk_bf16(v[6], v[7]);
#pragma unroll
            for (int j = 0; j < 4; ++j) { lo[2 * j] = v[2 * j] - bflo(whi[j]); lo[2 * j + 1] = v[2 * j + 1] - bfhi(whi[j]); }
            u32x4 wlo; wlo.x = cvt_pk_bf16(lo[0], lo[1]); wlo.y = cvt_pk_bf16(lo[2], lo[3]); wlo.z = cvt_pk_bf16(lo[4], lo[5]); wlo.w = cvt_pk_bf16(lo[6], lo[7]);
            u32x4* f = (u32x4*)(ws + WS_WRF); f[gt] = whi; f[4096 + gt] = wlo; }
    }
}

struct CvtItem { const float* src; unsigned char* dst; int ldo; };
__device__ __forceinline__ CvtItem cvt_item(const P& a, int it, int lane) {
    constexpr int IPM = 16 * 32;
    const int e = it / (3 * IPM), r0 = it % (3 * IPM), which = r0 / IPM, r = r0 % IPM, kb = r / 32, nb = r % 32, n0 = 32 * nb;
    CvtItem c;
    if (which < 2) { c.src = a.in[which == 0 ? 14 : 16] + (size_t)e * D * FF + (size_t)(64 * kb + (lane >> 5)) * FF + n0 + (lane & 31);
        c.dst = (unsigned char*)a.out + ((size_t)e * 2048 + (n0 >> 7) * 256 + (n0 & 127) + which * 128) * D + 64 * kb; c.ldo = D; }
    else { c.src = a.in[18] + (size_t)e * FF * D + (size_t)(64 * kb + (lane >> 5)) * D + n0 + (lane & 31);
        c.dst = a.ws + WS_W2T + ((size_t)e * D + n0) * FF + 64 * kb; c.ldo = FF; }
    return c;
}
__device__ __forceinline__ void expert_convert(const P& a, LAS unsigned char* lds, int vcu, int G, int wave, int lane) {
    LAS float* scr = (LAS float*)(lds + wave * 16384);
    const int gw = vcu * NWAVES + wave, NGW = G * NWAVES;
    constexpr int NIT = NE * 3 * 16 * 32;
    if (gw >= NIT) return;
    float tA[32], tB[32];
    CvtItem cA = cvt_item(a, gw, lane), cB = cvt_item(a, gw + NGW < NIT ? gw + NGW : gw, lane);
#pragma unroll
    for (int i = 0; i < 32; ++i) tA[i] = __builtin_nontemporal_load(cA.src + (size_t)(2 * i) * 1024);
#pragma unroll
    for (int i = 0; i < 32; ++i) tB[i] = __builtin_nontemporal_load(cB.src + (size_t)(2 * i) * 1024);
#define CVT_OUT(c_) do { LDS_WAIT(); asm volatile("" ::: "memory"); const int c = lane & 7; \
        _Pragma("unroll") for (int j = 0; j < 4; ++j) { const int n = (lane >> 3) + 8 * j; const LAS float* s = scr + (8 * c) * 33 + n; \
            u32x2 o; o.x = pk4_fp8(s[0 * 33] * 32.0f, s[1 * 33] * 32.0f, s[2 * 33] * 32.0f, s[3 * 33] * 32.0f); o.y = pk4_fp8(s[4 * 33] * 32.0f, s[5 * 33] * 32.0f, s[6 * 33] * 32.0f, s[7 * 33] * 32.0f); \
            __builtin_nontemporal_store(o, (u32x2*)((c_).dst + (size_t)n * (c_).ldo + 8 * c)); } \
        LDS_WAIT(); asm volatile("" ::: "memory"); } while (0)
    for (int it = gw; it < NIT; it += 2 * NGW) {
#pragma unroll
        for (int i = 0; i < 32; ++i) scr[(2 * i + (lane >> 5)) * 33 + (lane & 31)] = tA[i];
        const CvtItem dA = cA; const int n2 = it + 2 * NGW;
        if (n2 < NIT) { cA = cvt_item(a, n2, lane);
#pragma unroll
            for (int i = 0; i < 32; ++i) tA[i] = __builtin_nontemporal_load(cA.src + (size_t)(2 * i) * 1024); }
        CVT_OUT(dA);
        if (it + NGW >= NIT) break;
#pragma unroll
        for (int i = 0; i < 32; ++i) scr[(2 * i + (lane >> 5)) * 33 + (lane & 31)] = tB[i];
        const CvtItem dB = cB; const int n3 = it + 3 * NGW;
        if (n3 < NIT) { cB = cvt_item(a, n3, lane);
#pragma unroll
            for (int i = 0; i < 32; ++i) tB[i] = __builtin_nontemporal_load(cB.src + (size_t)(2 * i) * 1024); }
        CVT_OUT(dB);
    }
#undef CVT_OUT
}

__device__ __forceinline__ float fexp_(float x) { return __builtin_amdgcn_exp2f(x * 1.4426950408889634f); }
__device__ __forceinline__ float logsigmoidf_(float x) { const float e = fexp_(-fabsf(x)); return fminf(x, 0.0f) - 0.6931471805599453f * __builtin_amdgcn_logf(1.0f + e); }
__device__ __forceinline__ void gla_prep_unit(const P& a, LAS unsigned char* lds, int unit) {
    int tid = threadIdx.x; asm volatile("" : "+v"(tid));     const int wave = __builtin_amdgcn_readfirstlane(tid >> 6), lane = tid & 63;
    const int b = unit >> 5, chunk = unit & 31, tok0 = b * SEQ + chunk * 64;
    const bf16_t* H = (const bf16_t*)(a.ws + WS_H); const bf16_t* WalT = (const bf16_t*)(a.ws + WS_WALT); const bf16_t* proj = (const bf16_t*)(a.ws + WS_PROJ);
    LAS float* part = (LAS float*)lds;
    LAS float* alow = (LAS float*)(lds + 8192);
    LAS float* seg = (LAS float*)(lds + 12288);
    constexpr int GP_KDT = 16384, GP_VT = 34816;
    {
        const int rg = wave & 3, kh = wave >> 2, r = lane & 15, q = lane >> 4;
        f32x4 acc = (f32x4){0.f, 0.f, 0.f, 0.f};
        const bf16_t* ap = H + (size_t)(tok0 + 16 * rg + r) * D + 512 * kh + 8 * q; const bf16_t* bp = WalT + (size_t)r * D + 512 * kh + 8 * q;
#pragma unroll 8
        for (int s = 0; s < 16; ++s) { const bf16x8 av = *(const bf16x8*)(ap + 32 * s), bv = *(const bf16x8*)(bp + 32 * s); acc = __builtin_amdgcn_mfma_f32_16x16x32_bf16(bv, av, acc, 0, 0, 0); }
        *(LAS f32x4*)(part + (kh * 64 + 16 * rg + r) * 16 + 4 * q) = acc;
    }
    __syncthreads();
    if (tid < 256) { *(LAS f32x4*)(alow + tid * 4) = *(LAS f32x4*)(part + tid * 4) + *(LAS f32x4*)(part + 1024 + tid * 4); }
    __syncthreads();
    const int dp = tid & 63, tq = wave;
    const float* w_a2 = a.in[5]; const float* b_a2 = a.in[6];
    const int ep = tid & 127, sq4 = tid >> 7;
    f32x2 w2[16], w2n[16]; f32x2 b2, b2n; unsigned qv[8], kv[8], qvn[8], kvn[8], sv[16], svn[16];
#define GP_LOADS(h_, W2, B2, QV, KV, SV) do { const int dc_ = (h_) * 128 + 2 * dp; \
        _Pragma("unroll") for (int r = 0; r < 16; ++r) W2[r] = *(const f32x2*)(w_a2 + r * 512 + dc_); \
        B2 = *(const f32x2*)(b_a2 + dc_); \
        _Pragma("unroll") for (int i = 0; i < 8; ++i) { const bf16_t* rp = proj + (size_t)(tok0 + 8 * tq + i) * NPROJ + dc_; QV[i] = __builtin_nontemporal_load((const unsigned*)(rp + C_QA)); KV[i] = __builtin_nontemporal_load((const unsigned*)(rp + C_KA)); } \
        const bf16_t* v_ = proj + (size_t)(tok0 + 16 * sq4) * NPROJ + C_VA + (h_) * 256 + 2 * ep; \
        _Pragma("unroll") for (int i = 0; i < 16; ++i) SV[i] = __builtin_nontemporal_load((const unsigned*)(v_ + (size_t)i * NPROJ)); } while (0)
    GP_LOADS(0, w2, b2, qv, kv, sv);
    for (int h = 0; h < 4; ++h) {
        if (h + 1 < 4) GP_LOADS(h + 1, w2n, b2n, qvn, kvn, svn);
        float G0[8], G1[8]; float r0 = 0.f, r1 = 0.f;
#pragma unroll
        for (int i = 0; i < 8; ++i) { const LAS f32x4* al4 = (const LAS f32x4*)(alow + (8 * tq + i) * 16); float x0 = b2.x, x1 = b2.y;
#pragma unroll
            for (int r4 = 0; r4 < 4; ++r4) { const f32x4 al = al4[r4];
#pragma unroll
                for (int j = 0; j < 4; ++j) { x0 += al[j] * w2[4 * r4 + j].x; x1 += al[j] * w2[4 * r4 + j].y; } }
            r0 += logsigmoidf_(x0) * (1.0f / 16.0f); r1 += logsigmoidf_(x1) * (1.0f / 16.0f); G0[i] = r0; G1[i] = r1; }
        *(LAS f32x2*)(seg + tq * 128 + 2 * dp) = (f32x2){r0, r1};
        __syncthreads();
        float off0 = 0.f, off1 = 0.f, tot0 = 0.f, tot1 = 0.f;
#pragma unroll
        for (int q = 0; q < 8; ++q) { const f32x2 s = *(LAS f32x2*)(seg + q * 128 + 2 * dp); tot0 += s.x; tot1 += s.y; if (q < tq) { off0 += s.x; off1 += s.y; } }
        const size_t tile = (size_t)((b * 4 + h) * 32 + chunk);
        bf16_t* Qg = (bf16_t*)(a.ws + WS_QG) + tile * 8192; bf16_t* Kg = (bf16_t*)(a.ws + WS_KG) + tile * 8192;
        float kd0[8], kd1[8];
#pragma unroll
        for (int i = 0; i < 8; ++i) { const float g0 = G0[i] + off0, g1 = G1[i] + off1; const float q0 = bflo(qv[i]), q1 = bfhi(qv[i]), k0 = bflo(kv[i]), k1 = bfhi(kv[i]);
            const float e0 = fexp_(g0), e1 = fexp_(g1);
            *(unsigned*)(Qg + (8 * tq + i) * 128 + 2 * dp) = cvt_pk_bf16(q0 * e0 * 0.08838834764831845f, q1 * e1 * 0.08838834764831845f);
            *(unsigned*)(Kg + (8 * tq + i) * 128 + 2 * dp) = cvt_pk_bf16(k0 * __builtin_amdgcn_rcpf(e0), k1 * __builtin_amdgcn_rcpf(e1));
            kd0[i] = k0 * fexp_(tot0 - g0); kd1[i] = k1 * fexp_(tot1 - g1); }
        u32x4 w0, w1; w0.x = cvt_pk_bf16(kd0[0], kd0[1]); w0.y = cvt_pk_bf16(kd0[2], kd0[3]); w0.z = cvt_pk_bf16(kd0[4], kd0[5]); w0.w = cvt_pk_bf16(kd0[6], kd0[7]);
        w1.x = cvt_pk_bf16(kd1[0], kd1[1]); w1.y = cvt_pk_bf16(kd1[2], kd1[3]); w1.z = cvt_pk_bf16(kd1[4], kd1[5]); w1.w = cvt_pk_bf16(kd1[6], kd1[7]);
        *(LAS u32x4*)(lds + GP_KDT + (2 * dp) * 144 + 16 * tq) = w0; *(LAS u32x4*)(lds + GP_KDT + (2 * dp + 1) * 144 + 16 * tq) = w1;
        if (tq == 0) *(f32x2*)((float*)(a.ws + WS_DEC) + tile * 128 + 2 * dp) = (f32x2){fexp_(tot0), fexp_(tot1)};
        {
            u32x4 lo0, lo1, hi0, hi1;
#pragma unroll
            for (int j = 0; j < 4; ++j) { lo0[j] = (sv[2 * j] & 0xffffu) | (sv[2 * j + 1] << 16); lo1[j] = (sv[8 + 2 * j] & 0xffffu) | (sv[8 + 2 * j + 1] << 16);
                hi0[j] = (sv[2 * j] >> 16) | (sv[2 * j + 1] & 0xffff0000u); hi1[j] = (sv[8 + 2 * j] >> 16) | (sv[8 + 2 * j + 1] & 0xffff0000u); }
            LAS unsigned char* v0 = lds + GP_VT + (2 * ep) * 144 + sq4 * 32;
            *(LAS u32x4*)(v0) = lo0; *(LAS u32x4*)(v0 + 16) = lo1; *(LAS u32x4*)(v0 + 144) = hi0; *(LAS u32x4*)(v0 + 144 + 16) = hi1;
        }
        __syncthreads();
        {
            const int c32 = lane & 31, hi = lane >> 5;
            bf16x8 vt[4];
#pragma unroll
            for (int ks = 0; ks < 4; ++ks) vt[ks] = *(const LAS bf16x8*)(lds + GP_VT + (32 * wave + c32) * 144 + (16 * ks + 8 * hi) * 2);
            unsigned* sl = (unsigned*)a.out + tile * 8192;
#pragma unroll
            for (int tl = 0; tl < 4; ++tl) { f32x16 acc;
#pragma unroll
                for (int r = 0; r < 16; ++r) acc[r] = 0.f;
#pragma unroll
                for (int ks = 0; ks < 4; ++ks) { const bf16x8 av = *(const LAS bf16x8*)(lds + GP_KDT + (32 * tl + c32) * 144 + (16 * ks + 8 * hi) * 2); acc = __builtin_amdgcn_mfma_f32_32x32x16_bf16(av, vt[ks], acc, 0, 0, 0); }
#pragma unroll
                for (int g = 0; g < 4; ++g) sl[((tl * 4 + g) * 2 + hi) * 256 + 32 * wave + c32] = pk4_fp8(acc[4 * g], acc[4 * g + 1], acc[4 * g + 2], acc[4 * g + 3]); }
        }
        __syncthreads();
#pragma unroll
        for (int r = 0; r < 16; ++r) { w2[r] = w2n[r]; sv[r] = svn[r]; }
#pragma unroll
        for (int i = 0; i < 8; ++i) { qv[i] = qvn[i]; kv[i] = kvn[i]; }
        b2 = b2n;
    }
#undef GP_LOADS
}

__device__ __forceinline__ void gla_combine_unit(const P& a, int unit) {
    const int tid = threadIdx.x, bh = unit >> 4, i8 = (unit & 15) * 512 + tid;
    const int d0 = 32 * (i8 >> 11) + 8 * ((i8 >> 9) & 3) + 4 * ((i8 >> 8) & 1);
    const unsigned* sl8 = (const unsigned*)a.out + (size_t)bh * 32 * 8192 + i8; u32x2* sl = (u32x2*)(a.ws + WS_SLOC) + (size_t)bh * 32 * 8192 + i8;
    const f32x4* dc = (const f32x4*)((const float*)(a.ws + WS_DEC) + (size_t)bh * 32 * 128 + d0);
    f32x4 s = (f32x4){0.f, 0.f, 0.f, 0.f};
    for (int cb = 0; cb < 32; cb += 8) {
        unsigned loc[8]; f32x4 dv[8];
#pragma unroll
        for (int i = 0; i < 8; ++i) { loc[i] = __builtin_nontemporal_load(sl8 + (size_t)(cb + i) * 8192); dv[i] = dc[(cb + i) * 32]; }
#pragma unroll
        for (int i = 0; i < 8; ++i) { if (cb + i < 31) {
            s.x = dv[i].x * s.x + __builtin_amdgcn_cvt_f32_fp8((int)loc[i], 0); s.y = dv[i].y * s.y + __builtin_amdgcn_cvt_f32_fp8((int)loc[i], 1);
            s.z = dv[i].z * s.z + __builtin_amdgcn_cvt_f32_fp8((int)loc[i], 2); s.w = dv[i].w * s.w + __builtin_amdgcn_cvt_f32_fp8((int)loc[i], 3);
            u32x2 w; w.x = cvt_pk_bf16(s.x, s.y); w.y = cvt_pk_bf16(s.z, s.w); sl[(size_t)(cb + i) * 8192] = w; } }
    }
}

constexpr int GL_QG = 0, GL_KG = 17408, GL_VT = 53248, GL_AM = 90112, GL_OST = 0;
constexpr int GL_QS = 272, GL_TS = 144, GL_OS = 528;
__device__ __forceinline__ int crow(int r, int hi) { return (r & 3) + 8 * (r >> 2) + 4 * hi; }
__device__ __forceinline__ void gla_out_unit(const P& a, LAS unsigned char* lds, int unit) {
    int tid = threadIdx.x; asm volatile("" : "+v"(tid)); const int w = __builtin_amdgcn_readfirstlane(tid >> 6), lane = tid & 63, c32 = lane & 31, hi = lane >> 5;
    const int bh = unit >> 5, chunk = unit & 31, b = bh >> 2, h = bh & 3;
    const bf16_t* proj = (const bf16_t*)(a.ws + WS_PROJ); bf16_t* oab = (bf16_t*)(a.ws + WS_OAB); const float* ggo = a.in[7];
    const size_t tile = (size_t)bh * 32 + chunk;
    {
        const u32x4* q_ = (const u32x4*)((const bf16_t*)(a.ws + WS_QG) + tile * 8192); const u32x4* k_ = (const u32x4*)((const bf16_t*)(a.ws + WS_KG) + tile * 8192);
        u32x4 sq[2], sk[2]; unsigned sv[16];
        sq[0] = __builtin_nontemporal_load(q_ + tid); sq[1] = __builtin_nontemporal_load(q_ + tid + 512); sk[0] = __builtin_nontemporal_load(k_ + tid); sk[1] = __builtin_nontemporal_load(k_ + tid + 512);
        const int ep = tid & 127, sq4 = tid >> 7;
        const bf16_t* v_ = proj + (size_t)(b * SEQ + chunk * 64 + 16 * sq4) * NPROJ + C_VA + h * 256 + 2 * ep;
#pragma unroll
        for (int i = 0; i < 16; ++i) sv[i] = __builtin_nontemporal_load((const unsigned*)(v_ + (size_t)i * NPROJ));
#pragma unroll
        for (int i = 0; i < 2; ++i) { const int p = tid + 512 * i;
            *(LAS u32x4*)(lds + GL_QG + (p >> 4) * GL_QS + (p & 15) * 16) = sq[i]; *(LAS u32x4*)(lds + GL_KG + (p >> 4) * GL_QS + (p & 15) * 16) = sk[i]; }
        u32x4 lo0, lo1, hi0, hi1;
#pragma unroll
        for (int j = 0; j < 4; ++j) { lo0[j] = (sv[2 * j] & 0xffffu) | (sv[2 * j + 1] << 16); lo1[j] = (sv[8 + 2 * j] & 0xffffu) | (sv[8 + 2 * j + 1] << 16);
            hi0[j] = (sv[2 * j] >> 16) | (sv[2 * j + 1] & 0xffff0000u); hi1[j] = (sv[8 + 2 * j] >> 16) | (sv[8 + 2 * j + 1] & 0xffff0000u); }
        LAS unsigned char* v0 = lds + GL_VT + (2 * ep) * GL_TS + sq4 * 32;
        *(LAS u32x4*)(v0) = lo0; *(LAS u32x4*)(v0 + 16) = lo1; *(LAS u32x4*)(v0 + GL_TS) = hi0; *(LAS u32x4*)(v0 + GL_TS + 16) = hi1;
    }
    u32x2 sf[4][2][2];
    if (chunk > 0) { const u32x2* sl = (const u32x2*)(a.ws + WS_SLOC) + (tile - 1) * 8192;
#pragma unroll
        for (int tl = 0; tl < 4; ++tl)
#pragma unroll
            for (int s = 0; s < 2; ++s)
#pragma unroll
                for (int q = 0; q < 2; ++q) sf[tl][s][q] = __builtin_nontemporal_load(sl + ((tl * 4 + 2 * s + q) * 2 + hi) * 256 + 32 * w + c32); }
    __syncthreads();
    if (w < 3) {
        const int ti = (w + 1) >> 1, si = w >> 1;
        f32x16 A;
#pragma unroll
        for (int r = 0; r < 16; ++r) A[r] = 0.f;
#pragma unroll
        for (int s = 0; s < 8; ++s) { const bf16x8 av = *(const LAS bf16x8*)(lds + GL_QG + (32 * ti + c32) * GL_QS + (16 * s + 8 * hi) * 2), bv = *(const LAS bf16x8*)(lds + GL_KG + (32 * si + c32) * GL_QS + (16 * s + 8 * hi) * 2);
            A = __builtin_amdgcn_mfma_f32_32x32x16_bf16(av, bv, A, 0, 0, 0); }
        const int sidx = 32 * si + c32;
#pragma unroll
        for (int r = 0; r < 16; ++r) { const int t = 32 * ti + crow(r, hi); const float v = (sidx <= t) ? A[r] : 0.f;
            *(LAS bf16_t*)(lds + GL_AM + t * GL_TS + sidx * 2) = (bf16_t)(cvt_pk_bf16(v, 0.f) & 0xffffu); }
    }
    __syncthreads();
    f32x16 o[2];
    {
        bf16x8 vt[4];
#pragma unroll
        for (int ks = 0; ks < 4; ++ks) vt[ks] = *(const LAS bf16x8*)(lds + GL_VT + (32 * w + c32) * GL_TS + (16 * ks + 8 * hi) * 2);
#pragma unroll
        for (int ti = 0; ti < 2; ++ti) {
#pragma unroll
            for (int r = 0; r < 16; ++r) o[ti][r] = 0.f;
            if (chunk > 0) {
#pragma unroll
                for (int tl = 0; tl < 4; ++tl)
#pragma unroll
                    for (int s = 0; s < 2; ++s) { const LAS unsigned char* qp = lds + GL_QG + (32 * ti + c32) * GL_QS + (32 * tl + 16 * s + 4 * hi) * 2;
                        const s16x4 lo = *(const LAS s16x4*)qp, hh = *(const LAS s16x4*)(qp + 16);
                        const bf16x8 aop = __builtin_shufflevector(lo, hh, 0, 1, 2, 3, 4, 5, 6, 7);
                        const u32x4 bw = {sf[tl][s][0].x, sf[tl][s][0].y, sf[tl][s][1].x, sf[tl][s][1].y};
                        o[ti] = __builtin_amdgcn_mfma_f32_32x32x16_bf16(aop, __builtin_bit_cast(bf16x8, bw), o[ti], 0, 0, 0); }
            }
#pragma unroll
            for (int ks = 0; ks < 4; ++ks) { if (ti == 0 && ks >= 2) continue;
                const bf16x8 av = *(const LAS bf16x8*)(lds + GL_AM + (32 * ti + c32) * GL_TS + (16 * ks + 8 * hi) * 2);
                o[ti] = __builtin_amdgcn_mfma_f32_32x32x16_bf16(av, vt[ks], o[ti], 0, 0, 0); }
        }
    }
    __syncthreads();
#pragma unroll
    for (int ti = 0; ti < 2; ++ti)
#pragma unroll
        for (int r = 0; r < 16; ++r) *(LAS bf16_t*)(lds + GL_OST + (32 * ti + crow(r, hi)) * GL_OS + (32 * w + c32) * 2) = (bf16_t)(cvt_pk_bf16(o[ti][r], 0.f) & 0xffffu);
    __syncthreads();
    {
        const int t = tid >> 3, sg = tid & 7; const size_t tok = (size_t)(b * SEQ + chunk * 64 + t);
        u32x4 ov[4]; float ss = 0.f;
#pragma unroll
        for (int j = 0; j < 4; ++j) { ov[j] = *(const LAS u32x4*)(lds + GL_OST + t * GL_OS + sg * 64 + j * 16);
#pragma unroll
            for (int i = 0; i < 4; ++i) { const float x0 = bflo(ov[j][i]), x1 = bfhi(ov[j][i]); ss += x0 * x0 + x1 * x1; } }
        ss += __shfl_xor(ss, 1); ss += __shfl_xor(ss, 2); ss += __shfl_xor(ss, 4);
        const float rstd = 1.0f / sqrtf(ss * (1.0f / 256.0f) + EPS);
        const bf16_t* rap = proj + tok * NPROJ + C_RA + h * 256 + sg * 32; bf16_t* op = oab + tok * 2048 + h * 256 + sg * 32; const float* gp = ggo + sg * 32;
#pragma unroll
        for (int j = 0; j < 4; ++j) { const u32x4 ra = __builtin_nontemporal_load((const u32x4*)(rap + 8 * j)); const f32x4 g0 = *(const f32x4*)(gp + 8 * j), g1 = *(const f32x4*)(gp + 8 * j + 4); u32x4 wv;
#pragma unroll
            for (int i = 0; i < 4; ++i) { const float r0 = bflo(ra[i]), r1 = bfhi(ra[i]); const float ga = (i < 2) ? g0[2 * i] : g1[2 * i - 4], gb = (i < 2) ? g0[2 * i + 1] : g1[2 * i - 3];
                wv[i] = cvt_pk_bf16(bflo(ov[j][i]) * rstd * ga * (r0 * fsigmoid(r0)), bfhi(ov[j][i]) * rstd * gb * (r1 * fsigmoid(r1))); }
            *(u32x4*)(op + 8 * j) = wv; }
    }
    __syncthreads();
}
namespace moba {
constexpr int HD = 128;
constexpr float SCALE = 0.08838834764831845f;
constexpr float THR = 8.f;
constexpr int NW = 8, QBLK = 32, KVBLK = 64, QB = NW * QBLK;
constexpr int SHM_V = KVBLK * HD * 2, SHM_K = KVBLK * HD * 2;
constexpr int OFF_WS = 2 * SHM_V + 2 * SHM_K;
constexpr int OFF_RTAB = OFF_WS + NW * 64 * 4;
constexpr int OFF_KM = OFF_RTAB + 2400 * 4;
constexpr int OFF_MISC = OFF_KM + 8 * 128 * 4;
constexpr int OFF_SEL = OFF_MISC + 64;
constexpr int LDS_BYTES = OFF_SEL + 2048;
constexpr int LDP = NPROJ, LDO = 2048;

#define KSWZ(row, colB) ((row) * 256 + ((colB) ^ (((row) & 7) << 4)))
#define SBAR() __builtin_amdgcn_sched_barrier(0)
__device__ __forceinline__ int v_st(int k, int c) { const int kk = (k & ~0xC) | ((k & 4) << 1) | ((k & 8) >> 1); return ((kk >> 3) * 4 + (c >> 5)) * 512 + ((kk & 7) * 32 + (c & 31)) * 2; }
__device__ __forceinline__ int v_rd_base(int lane) { return ((lane & 3) << 3) | (((lane >> 2) & 3) << 6) | (((lane >> 4) & 1) << 5) | (((lane >> 5) & 1) << 8); }
constexpr int v_rd_off(int d0, int ks, int half) { return d0 * 512 + ks * 4096 + half * 2048; }
__device__ __forceinline__ int crow(int r, int hi) { return (r & 3) + 8 * (r >> 2) + 4 * hi; }
__device__ __forceinline__ unsigned cvtpk(float lo, float hi) { unsigned r; asm volatile("v_cvt_pk_bf16_f32 %0, %1, %2" : "=v"(r) : "v"(lo), "v"(hi)); return r; }

__device__ __forceinline__ void mask_tile(f32x16& p0, f32x16& p1, int dq) {
    const float NEG = -__builtin_inff();
#pragma unroll
    for (int r = 0; r < 16; ++r) {
        const int c = (r & 3) + 8 * (r >> 2);
        if (dq - c < 0) p0[r] = NEG;
        if (dq - c - 32 < 0) p1[r] = NEG;
    }
}
__device__ __forceinline__ void bias_tile(f32x16& p0, f32x16& p1, const LAS float* rt) {
#pragma unroll
    for (int r = 0; r < 16; ++r) { const int c = (r & 3) + 8 * (r >> 2); p0[r] += rt[c]; p1[r] += rt[c + 32]; }
}
__device__ __forceinline__ void kill_tile(f32x16& p0, f32x16& p1) {
    const float NEG = -__builtin_inff();
#pragma unroll
    for (int r = 0; r < 16; ++r) { p0[r] = NEG; p1[r] = NEG; }
}
__device__ __forceinline__ void partialSM(f32x16& p0, f32x16& p1, float& m_reg, float& mn, float& alpha) {
    float pmax = p0[0];
#pragma unroll
    for (int r = 1; r < 16; ++r) pmax = fmaxf(pmax, p0[r]);
#pragma unroll
    for (int r = 0; r < 16; ++r) pmax = fmaxf(pmax, p1[r]);
    { auto rr = __builtin_amdgcn_permlane32_swap(__float_as_uint(pmax), __float_as_uint(pmax), false, false);
      pmax = fmaxf(__uint_as_float(rr[0]), __uint_as_float(rr[1])); }
    constexpr float C2 = 1.4426950408889634f * SCALE;
    if (__builtin_expect(__all((pmax - m_reg) * SCALE <= THR), 1)) { mn = m_reg; alpha = 1.f; }
    else { mn = fmaxf(m_reg, pmax); alpha = __builtin_amdgcn_exp2f((m_reg - mn) * C2); m_reg = mn; }
    const float mnL = -mn * C2;
#pragma unroll
    for (int r = 0; r < 16; ++r) p0[r] = fmaf(p0[r], C2, mnL);
#pragma unroll
    for (int r = 0; r < 16; ++r) p1[r] = fmaf(p1[r], C2, mnL);
#pragma unroll
    for (int r = 0; r < 16; ++r) p0[r] = __builtin_amdgcn_exp2f(p0[r]);
}
__device__ __forceinline__ void finishSM(f32x16& p0, f32x16& p1, float alpha, float& l_reg, bf16x8& pa0, bf16x8& pa1, bf16x8& pa2, bf16x8& pa3) {
#pragma unroll
    for (int r = 0; r < 16; ++r) p1[r] = __builtin_amdgcn_exp2f(p1[r]);
    float ps = 0;
#pragma unroll
    for (int r = 0; r < 16; ++r) ps += p0[r];
#pragma unroll
    for (int r = 0; r < 16; ++r) ps += p1[r];
    { auto rr = __builtin_amdgcn_permlane32_swap(__float_as_uint(ps), __float_as_uint(ps), false, false);
      ps = __uint_as_float(rr[0]) + __uint_as_float(rr[1]); }
    l_reg = l_reg * alpha + ps;
#define PK4(P, B_, OUT) do { unsigned a0 = cvtpk(P[B_+0], P[B_+1]), a1 = cvtpk(P[B_+2], P[B_+3]);                          \
        unsigned b0 = cvtpk(P[B_+4], P[B_+5]), b1 = cvtpk(P[B_+6], P[B_+7]);                                             \
        auto r0 = __builtin_amdgcn_permlane32_swap(a0, b0, false, false); auto r1 = __builtin_amdgcn_permlane32_swap(a1, b1, false, false); \
        u32x4 w = {r0[0], r1[0], r0[1], r1[1]}; OUT = __builtin_bit_cast(bf16x8, w); } while (0)
    PK4(p0, 0, pa0); PK4(p0, 8, pa1); PK4(p1, 0, pa2); PK4(p1, 8, pa3);
#undef PK4
}
template <int KB>
__device__ __forceinline__ void qkt(f32x16& p0, f32x16& p1, const char* K_lds, int r32, int hi, const bf16x8* qr) {
#pragma unroll
    for (int r = 0; r < 16; ++r) { p0[r] = 0.f; p1[r] = 0.f; }
    const char* kb[4];
#pragma unroll
    for (int dd = 0; dd < 4; ++dd) kb[dd] = K_lds + KB * SHM_K + KSWZ(r32, (dd * 16 + hi * 8) * 2);
#pragma unroll
    for (int d0 = 0; d0 < 8; ++d0) { const char* a = kb[d0 & 3] + (d0 >> 2) * 128;
        bf16x8 b0 = *reinterpret_cast<const bf16x8*>(a);
        bf16x8 b1 = *reinterpret_cast<const bf16x8*>(a + 32 * 256);
        p0 = __builtin_amdgcn_mfma_f32_32x32x16_bf16(b0, qr[d0], p0, 0, 0, 0);
        p1 = __builtin_amdgcn_mfma_f32_32x32x16_bf16(b1, qr[d0], p1, 0, 0, 0); }
}
template <int VB>
__device__ __forceinline__ void pv_tile(f32x16* o, int vb0, bf16x8 pa0, bf16x8 pa1, bf16x8 pa2, bf16x8 pa3) {
#define TRRD(dst, off) asm volatile("ds_read_b64_tr_b16 %0, %1 offset:%2" : "=&v"(dst) : "v"(vb0), "i"(off) : "memory")
#define PV_D0(d0) do { s16x4 l0, l1, l2, l3, h0, h1, h2, h3; constexpr int b_ = VB * SHM_V + v_rd_off(d0, 0, 0);   \
        TRRD(l0, b_); TRRD(h0, b_ + 2048); TRRD(l1, b_ + 4096); TRRD(h1, b_ + 6144); TRRD(l2, b_ + 8192); TRRD(h2, b_ + 10240); TRRD(l3, b_ + 12288); TRRD(h3, b_ + 14336); \
        asm volatile("s_waitcnt lgkmcnt(0)" ::: "memory"); SBAR();   \
        o[d0] = __builtin_amdgcn_mfma_f32_32x32x16_bf16(pa0, (bf16x8){l0[0], l0[1], l0[2], l0[3], h0[0], h0[1], h0[2], h0[3]}, o[d0], 0, 0, 0);   \
        o[d0] = __builtin_amdgcn_mfma_f32_32x32x16_bf16(pa1, (bf16x8){l1[0], l1[1], l1[2], l1[3], h1[0], h1[1], h1[2], h1[3]}, o[d0], 0, 0, 0);   \
        o[d0] = __builtin_amdgcn_mfma_f32_32x32x16_bf16(pa2, (bf16x8){l2[0], l2[1], l2[2], l2[3], h2[0], h2[1], h2[2], h2[3]}, o[d0], 0, 0, 0);   \
        o[d0] = __builtin_amdgcn_mfma_f32_32x32x16_bf16(pa3, (bf16x8){l3[0], l3[1], l3[2], l3[3], h3[0], h3[1], h3[2], h3[3]}, o[d0], 0, 0, 0); } while (0)
    PV_D0(0); PV_D0(1); PV_D0(2); PV_D0(3);
#undef PV_D0
#undef TRRD
}

struct BlockRef { const bf16_t* Q; const bf16_t* K; const bf16_t* V; bf16_t* O; int qb; int b, h; };
struct Seam { bf16x8 qr[8]; bf16x8 st_v0, st_v1, st_k0, st_k1; };
#define VMW() asm volatile("s_waitcnt vmcnt(0)" ::: "memory")
#define VMWN(n) asm volatile("s_waitcnt vmcnt(%0)" :: "i"(n) : "memory")
#define LD8(p) (*reinterpret_cast<const bf16x8*>(p))
#define SLOAD_H(Kp, Vp, k0) do { const char* kb__ = (const char*)(Kp) + (size_t)(k0) * (LDP * 2); \
        S.st_v0 = LD8(kb__ + 2048 + kvoff); S.st_v1 = LD8(kb__ + (32 * LDP * 2 + 2048) + kvoff); S.st_k0 = LD8(kb__ + kvoff); S.st_k1 = LD8(kb__ + 32 * LDP * 2 + kvoff); } while (0)
#define SWRITE_HK(bf) do { *(bf16x8*)(K_lds + (bf) * SHM_K + kws) = S.st_k0; *(bf16x8*)(K_lds + (bf) * SHM_K + kws + 32 * 256) = S.st_k1; } while (0)
#define SWRITE_HV(bf) do { *(bf16x8*)(V_lds + (bf) * SHM_V + vst0) = S.st_v0; *(bf16x8*)(V_lds + (bf) * SHM_V + vst1) = S.st_v1; } while (0)
#define SWRITE_H(bf) do { SWRITE_HV(bf); SWRITE_HK(bf); } while (0)

__device__ __forceinline__ void prime(const BlockRef& cur, char* lds, Seam& S) {
    int tid = threadIdx.x; asm volatile("" : "+v"(tid));     const int wid = __builtin_amdgcn_readfirstlane(tid >> 6), lane = tid & 63, r32 = lane & 31, hi = lane >> 5;
    const int sr = tid >> 4, sc = (tid & 15) * 8, kws = KSWZ(sr, sc * 2); char* K_lds = lds + 2 * SHM_V;
    const unsigned kvoff = (unsigned)(sr * LDP + sc) * 2u, qvoff = (unsigned)(r32 * LDP + hi * 8) * 2u;
    { const char* qb__ = (const char*)cur.Q + (size_t)(wid * QBLK) * (LDP * 2);
#pragma unroll
    for (int d0 = 0; d0 < 8; ++d0) S.qr[d0] = LD8(qb__ + qvoff + d0 * 32); }
    SLOAD_H(cur.K, cur.V, 0); VMW(); SWRITE_HK(0);
    __syncthreads();
}
__device__ __forceinline__ int rel_bucket(int n) {
    if (n < 16) return n;
    const float nf = (float)n;
    int large = 16 + (int)(logf(nf / 16.0f) / 5.545177444479562f * 16.0f);
    return large < 31 ? large : 31;
}
__device__ __forceinline__ BlockRef make_ref(const P& a, int item);
__device__ __forceinline__ int block(const P& a, const BlockRef& cur, unsigned* queue, const float* rel_bias, const float* kmp, char* lds, Seam& S) {
    int tid = threadIdx.x; asm volatile("" : "+v"(tid));     const int wid = __builtin_amdgcn_readfirstlane(tid >> 6), lane = tid & 63, r32 = lane & 31, hi = lane >> 5;
    const int qb = cur.qb, NT = 4 * (qb + 1);
    const int qlo = qb * QB + wid * QBLK, qrow = qlo + r32;
    char* V_lds = lds; char* K_lds = lds + 2 * SHM_V;
    float* ws = (float*)(lds + OFF_WS) + wid * 64; float* li_l = ws, * al_l = ws + 32;
    LAS float* rtab = (LAS float*)(LAS char*)(uintptr_t)(unsigned)(uintptr_t)(lds + OFF_RTAB);
    float* kmL = (float*)(lds + OFF_KM);
    volatile int* misc = (volatile int*)(lds + OFF_MISC);
    if (tid == 0) misc[0] = (int)__hip_atomic_fetch_add(queue, 1u, __ATOMIC_RELAXED, __HIP_MEMORY_SCOPE_AGENT);
    for (int i = tid; i < 2400; i += NW * 64) { const int dist = 2047 - i; rtab[i] = dist >= 0 ? rel_bias[rel_bucket(dist) * 8 + cur.h] * (1.0f / SCALE) : -__builtin_inff(); }
    for (int i = tid; i < qb * 128; i += NW * 64) { const int j = i >> 7, dd = i & 127; const size_t o = ((size_t)(cur.b * 8 + j)) * 1024 + cur.h * 128 + dd;
        kmL[i] = (kmp[o] + kmp[o + 64 * 1024]) * (1.0f / 256.0f); }
    __syncthreads();
    const int next_item = __builtin_amdgcn_readfirstlane(misc[0]);
    const BlockRef nxt = next_item < 512 ? make_ref(a, next_item) : cur;
    unsigned selmask = 0;
    {
        float sc7[7];
#pragma unroll
        for (int j = 0; j < 7; ++j) { sc7[j] = -__builtin_inff();
            if (j < qb) { float acc = 0.f;
#pragma unroll
                for (int d0 = 0; d0 < 8; ++d0) { const u32x4 q4 = __builtin_bit_cast(u32x4, S.qr[d0]); const f32x4 k0 = *(const f32x4*)(kmL + j * 128 + d0 * 16 + hi * 8), k1 = *(const f32x4*)(kmL + j * 128 + d0 * 16 + hi * 8 + 4);
                    acc += bflo(q4[0]) * k0[0] + bfhi(q4[0]) * k0[1] + bflo(q4[1]) * k0[2] + bfhi(q4[1]) * k0[3] + bflo(q4[2]) * k1[0] + bfhi(q4[2]) * k1[1] + bflo(q4[3]) * k1[2] + bfhi(q4[3]) * k1[3]; }
                acc += __shfl_xor(acc, 32); sc7[j] = acc; } }
#pragma unroll
        for (int j = 0; j < 7; ++j) { int rank = 0;
#pragma unroll
            for (int i = 0; i < 7; ++i) { if (i != j) rank += (sc7[i] > sc7[j] || (sc7[i] == sc7[j] && i < j)) ? 1 : 0; }
            if (j < qb && (qb <= 3 || rank < 3)) selmask |= 1u << j; }
    }
    LAS unsigned* selp = (LAS unsigned*)(LAS char*)(uintptr_t)(unsigned)(uintptr_t)(lds + OFF_SEL) + tid;
    *selp = selmask;
    float m_reg = -1e30f, l_reg = 0; f32x16 o[4];
#pragma unroll
    for (int d = 0; d < 4; ++d)
#pragma unroll
        for (int r = 0; r < 16; ++r) o[d][r] = 0.f;
    const int sr = tid >> 4, sc = (tid & 15) * 8, vst0 = v_st(sr, sc), vst1 = v_st(32 + sr, sc), kws = KSWZ(sr, sc * 2);
    const unsigned kvoff = (unsigned)(sr * LDP + sc) * 2u;
    const int vb0 = (int)(uintptr_t)V_lds + v_rd_base(lane);
    const bf16_t* Kh = cur.K; const bf16_t* Vh = cur.V;
#define RESC(a) do { if (__any((a) < 1.f)) { if (hi == 0) al_l[r32] = (a); asm volatile("s_waitcnt lgkmcnt(0)" ::: "memory");              \
                     for (int d_ = 0; d_ < 4; ++d_) for (int r = 0; r < 16; ++r) o[d_][r] *= al_l[crow(r, hi)]; } } while (0)
#define KBASE(t) ((t) * KVBLK)
#define MASKT(P0_, P1_, t) do { const int kb_ = KBASE(t); const int jb_ = (t) >> 2; \
        const bool on_ = (jb_ == qb) || ((*selp >> jb_) & 1u); \
        bias_tile(P0_, P1_, on_ ? rtab + (kb_ + 4 * hi - qrow + 2047) : rtab + 2304); } while (0)
    constexpr int NQL = 8;
#define SEAM_K0() do { VMWN(NQL); SWRITE_HK(0); SBAR(); } while (0)
    f32x16 pA0, pA1, pB0, pB1; float mnA, mnB, alA, alB; bf16x8 pa0, pa1, pa2, pa3;
    SWRITE_HV(0); SBAR();
    if (NT > 1) { SLOAD_H(Kh, Vh, KBASE(1)); }
    SBAR(); qkt<0>(pA0, pA1, K_lds, r32, hi, S.qr);
    MASKT(pA0, pA1, 0); partialSM(pA0, pA1, m_reg, mnA, alA);
    if (NT > 1) { VMW(); SWRITE_H(1); }
    __syncthreads();
#define HALF_STEP(PX0, PX1, mnX, alX, PY0, PY1, alY, t, KB, VB, SB) do {                                                      \
        SBAR(); qkt<KB>(PX0, PX1, K_lds, r32, hi, S.qr);                                             \
        finishSM(PY0, PY1, alY, l_reg, pa0, pa1, pa2, pa3); SBAR();                                                           \
        if ((t) + 1 < NT) { SLOAD_H(Kh, Vh, KBASE((t) + 1)); SBAR(); }                                               \
        pv_tile<VB>(o, vb0, pa0, pa1, pa2, pa3); MASKT(PX0, PX1, (t)); partialSM(PX0, PX1, m_reg, mnX, alX);                                        \
        __syncthreads();                                                                                                      \
        if ((t) + 1 < NT) { VMW(); SWRITE_H(SB); }                                                                          \
        RESC(alX); __syncthreads(); } while (0)
    for (int t = 1; t + 1 < NT; t += 2) {
        HALF_STEP(pB0, pB1, mnB, alB, pA0, pA1, alA, t, 1, 0, 0);
        HALF_STEP(pA0, pA1, mnA, alA, pB0, pB1, alB, t + 1, 0, 1, 1);
    }
    { SBAR(); qkt<1>(pB0, pB1, K_lds, r32, hi, S.qr); SBAR(); }
    SLOAD_H(nxt.K, nxt.V, 0); SBAR();
    { const char* qb__ = (const char*)nxt.Q + (size_t)(wid * QBLK) * (LDP * 2); int l_ = lane; asm volatile("" : "+v"(l_));
      const unsigned qvoff = (unsigned)((l_ & 31) * LDP + (l_ >> 5) * 8) * 2u;
#pragma unroll
    for (int d0 = 0; d0 < 8; ++d0) S.qr[d0] = LD8(qb__ + qvoff + d0 * 32); }
    SBAR();
    finishSM(pA0, pA1, alA, l_reg, pa0, pa1, pa2, pa3); SBAR();
    pv_tile<0>(o, vb0, pa0, pa1, pa2, pa3);
    { MASKT(pB0, pB1, NT - 1); partialSM(pB0, pB1, m_reg, mnB, alB); __syncthreads(); RESC(alB);
      finishSM(pB0, pB1, alB, l_reg, pa0, pa1, pa2, pa3); SBAR(); pv_tile<1>(o, vb0, pa0, pa1, pa2, pa3); }
    SBAR(); SEAM_K0();
    if (hi == 0) li_l[r32] = l_reg; asm volatile("s_waitcnt lgkmcnt(0)" ::: "memory");
    float rli[16];
#pragma unroll
    for (int r = 0; r < 16; ++r) rli[r] = __builtin_amdgcn_rcpf(li_l[crow(r, hi)]);
    char* Ow = (char*)cur.O + (size_t)(wid * QBLK) * (LDO * 2); const unsigned ovoff = (unsigned)(4 * hi * LDO + r32) * 2u;
#pragma unroll
    for (int r = 0; r < 16; ++r) { const int orow0 = (r & 3) + 8 * (r >> 2);
#pragma unroll
        for (int d0 = 0; d0 < 4; ++d0) { const float v = o[d0][r] * rli[r];
            const float vn = __shfl_xor(v, 1);
            if ((r32 & 1) == 0) *(unsigned*)(Ow + (size_t)(orow0 * LDO * 2 + d0 * 64) + ovoff) = cvtpk(v, vn); } }
    __syncthreads();
    return next_item;
#undef RESC
#undef KBASE
#undef MASKT
#undef SEAM_K0
#undef HALF_STEP
}
#undef ROWP
#undef VMW
#undef VMWN
#undef LD8
#undef SLOAD_H
#undef SWRITE_HK
#undef SWRITE_HV
#undef SWRITE_H

__device__ __forceinline__ BlockRef make_ref(const P& a, int item) {
    const int qb = 7 - (item >> 6), bh = item & 63, b = bh >> 3, h = bh & 7;
    const bf16_t* proj = (const bf16_t*)(a.ws + WS_PROJ);
    BlockRef r; r.b = b; r.h = h; r.qb = qb;
    r.Q = proj + (size_t)(b * SEQ + qb * QB) * LDP + C_QB + h * HD;
    r.K = proj + (size_t)(b * SEQ) * LDP + C_KB + h * HD;
    r.V = proj + (size_t)(b * SEQ) * LDP + C_VB + h * HD;
    r.O = (bf16_t*)(a.ws + WS_OAB) + (size_t)(b * SEQ + qb * QB) * LDO + 1024 + h * HD;
    return r;
}
}
__device__ __forceinline__ void router_unit(const P& a, LAS unsigned char* lds, int unit) {
    int tid = threadIdx.x; asm volatile("" : "+v"(tid)); const int wave = __builtin_amdgcn_readfirstlane(tid >> 6), lane = tid & 63, c32 = lane & 31, hi = lane >> 5;
    const int tg = wave & 1, kq = wave >> 1;
    const bf16_t* x1 = (const bf16_t*)(a.ws + WS_X1); const float* g = a.in[11]; const float* br = a.in[13];
    unsigned char* A2 = a.ws + WS_A2; const u32x4* frag = (const u32x4*)(a.ws + WS_WRF);
    LAS float* Lw = (LAS float*)(lds + wave * 4352);
    LAS float* ssp = (LAS float*)(lds + 8 * 4352);
    LAS unsigned* hist = (LAS unsigned*)(lds + 8 * 4352 + 2048);
    LAS unsigned* base = hist + 32;
    if (tid < 32) hist[tid] = 0u;
    const int tok = unit * 64 + tg * 32 + c32;
    f32x16 L;
#pragma unroll
    for (int r = 0; r < 16; ++r) L[r] = 0.f;
    float ss = 0.f;
    const bf16_t* xr = x1 + (size_t)tok * D + 8 * hi + 256 * kq; unsigned char* ar = A2 + (size_t)tok * D + 8 * hi + 256 * kq; const float* gr = g + 8 * hi + 256 * kq;
#pragma unroll 4
    for (int s = 0; s < 16; ++s) {
        const u32x4 xw = *(const u32x4*)(xr + 16 * s); const f32x4 xa = {bflo(xw.x), bfhi(xw.x), bflo(xw.y), bfhi(xw.y)}, xb = {bflo(xw.z), bfhi(xw.z), bflo(xw.w), bfhi(xw.w)}, ga = *(const f32x4*)(gr + 16 * s), gb = *(const f32x4*)(gr + 16 * s + 4);
        ss += (xa.x * xa.x + xa.y * xa.y) + (xa.z * xa.z + xa.w * xa.w) + (xb.x * xb.x + xb.y * xb.y) + (xb.z * xb.z + xb.w * xb.w);
        const f32x4 va = xa * ga, vb = xb * gb;
        u32x4 wh; wh.x = cvt_pk_bf16(va.x, va.y); wh.y = cvt_pk_bf16(va.z, va.w); wh.z = cvt_pk_bf16(vb.x, vb.y); wh.w = cvt_pk_bf16(vb.z, vb.w);
        { u32x2 w8; w8.x = pk4_fp8(va.x, va.y, va.z, va.w); w8.y = pk4_fp8(vb.x, vb.y, vb.z, vb.w); *(u32x2*)(ar + 16 * s) = w8; }
        u32x4 wl; wl.x = cvt_pk_bf16(va.x - bflo(wh.x), va.y - bfhi(wh.x)); wl.y = cvt_pk_bf16(va.z - bflo(wh.y), va.w - bfhi(wh.y));
        wl.z = cvt_pk_bf16(vb.x - bflo(wh.z), vb.y - bfhi(wh.z)); wl.w = cvt_pk_bf16(vb.z - bflo(wh.w), vb.w - bfhi(wh.w));
        const bf16x8 ah = __builtin_bit_cast(bf16x8, wh), al = __builtin_bit_cast(bf16x8, wl);
        const bf16x8 bh = __builtin_bit_cast(bf16x8, frag[(16 * kq + s) * 64 + lane]), bl = __builtin_bit_cast(bf16x8, frag[4096 + (16 * kq + s) * 64 + lane]);
        L = __builtin_amdgcn_mfma_f32_32x32x16_bf16(ah, bh, L, 0, 0, 0);
        L = __builtin_amdgcn_mfma_f32_32x32x16_bf16(ah, bl, L, 0, 0, 0);
        L = __builtin_amdgcn_mfma_f32_32x32x16_bf16(al, bh, L, 0, 0, 0);
    }
#pragma unroll
    for (int r = 0; r < 16; ++r) Lw[((r & 3) + 8 * (r >> 2) + 4 * hi) * 33 + c32] = L[r];
    ssp[wave * 64 + lane] = ss;
    __syncthreads();
    int e4[4] = {0, 0, 0, 0}; float w4[4] = {0.f, 0.f, 0.f, 0.f}; unsigned loc[4] = {0u, 0u, 0u, 0u}; float rstd = 0.f;
    const bool sel = (wave < 2) && (hi == 0);
    if (sel) {
        float sst = 0.f;
#pragma unroll
        for (int q = 0; q < 4; ++q) sst += ssp[(wave + 2 * q) * 64 + c32] + ssp[(wave + 2 * q) * 64 + 32 + c32];
        rstd = 1.0f / sqrtf(sst * (1.0f / D) + EPS);
        float lg[32];
#pragma unroll
        for (int e = 0; e < 32; ++e) { const LAS float* lp = (const LAS float*)(lds + wave * 4352) + c32 * 33 + e; lg[e] = (lp[0] + lp[2 * 1088] + lp[4 * 1088] + lp[6 * 1088]) * rstd + br[e]; }
        unsigned used = 0u; float v4[4];
#pragma unroll
        for (int p = 0; p < 4; ++p) { float best = -__builtin_inff(); int bi = 0;
#pragma unroll
            for (int e = 0; e < 32; ++e) { const bool take = !((used >> e) & 1u) && lg[e] > best; best = take ? lg[e] : best; bi = take ? e : bi; }
            used |= 1u << bi; e4[p] = bi; v4[p] = best; }
        float sum = 0.f;
#pragma unroll
        for (int p = 0; p < 4; ++p) { w4[p] = expf(v4[p] - v4[0]); sum += w4[p]; }
        const float inv = 1.0f / sum;
#pragma unroll
        for (int p = 0; p < 4; ++p) { w4[p] *= inv; loc[p] = __hip_atomic_fetch_add(hist + e4[p], 1u, __ATOMIC_RELAXED, __HIP_MEMORY_SCOPE_WORKGROUP); }
    }
    __syncthreads();
    if (tid < 32) base[tid] = __hip_atomic_fetch_add((unsigned*)(a.ws + WS_CTL) + CW_COUNTS + tid, hist[tid], RLX_AGENT);
    __syncthreads();
    if (sel) {
        int* tope = (int*)(a.ws + WS_TOPE) + (size_t)tok * 4; float* wts = (float*)(a.ws + WS_WTS) + (size_t)tok * 4; int* slot = (int*)(a.ws + WS_SLOT) + (size_t)tok * 4;
#pragma unroll
        for (int p = 0; p < 4; ++p) { const int sl_ = (int)(base[e4[p]] + loc[p]); tope[p] = e4[p]; wts[p] = w4[p]; slot[p] = sl_;
            ((int*)(a.ws + WS_ROWE))[(size_t)e4[p] * T + sl_] = tok; ((float*)(a.ws + WS_RSTE))[(size_t)e4[p] * T + sl_] = rstd; }
    }
    __syncthreads();
}

__device__ __forceinline__ void moe_tables(const P& a, LAS unsigned char* lds) {
    int tid = threadIdx.x; asm volatile("" : "+v"(tid)); const int wave = tid >> 6, lane = tid & 63, e = lane & 31;
    LAS int* pstart = (LAS int*)(lds + LDS_MOE); LAS int* cnt = pstart + 64; LAS int* tile_e = pstart + 128;
    const unsigned* counts = (const unsigned*)(a.ws + WS_CTL) + CW_COUNTS;
    const int c = (int)counts[e]; const int p = ((c + 255) >> 8) << 8; int inc = p;
#pragma unroll
    for (int o = 1; o < 32; o <<= 1) { const int t = __shfl_up(inc, o, 32); if (e >= o) inc += t; }
    if (tid < 32) { cnt[e] = c; pstart[e] = inc - p; if (e == 31) { pstart[32] = inc; tile_e[MAXTILES] = inc >> 8; } }
    for (int t = wave * 36; t < wave * 36 + 36; ++t) { const unsigned long long m = __ballot(inc <= t * 256); const int ee = __builtin_popcount((unsigned)m); if (lane == 0) tile_e[t] = ee < NE ? ee : NE - 1; }
    __syncthreads();
}

__device__ __forceinline__ void combine_rows(const P& a, LAS unsigned char* lds, int vcu, int G, int wave, int lane) {
    const LAS int* pstart = (const LAS int*)(lds + LDS_MOE);
    const int gw = vcu * NWAVES + wave, NGW = G * NWAVES;
    const bf16_t* X1 = (const bf16_t*)(a.ws + WS_X1); float* X = (float*)(a.ws + WS_X2); const unsigned char* Y = a.ws + WS_YROWS; bf16_t* A3 = (bf16_t*)(a.ws + WS_H);
    const int* tope = (const int*)(a.ws + WS_TOPE); const int* slot = (const int*)(a.ws + WS_SLOT); const float* wts = (const float*)(a.ws + WS_WTS); const float* g = a.in[20];
    f32x4 gv[4];
#pragma unroll
    for (int j = 0; j < 4; ++j) gv[j] = *((const f32x4*)g + lane + 64 * j);
    for (int m = gw; m < T; m += NGW) {
        f32x4* xr = (f32x4*)(X + (size_t)m * D) + lane; const u32x2* x1r = (const u32x2*)(X1 + (size_t)m * D) + lane; f32x4 v[4];
#pragma unroll
        for (int j = 0; j < 4; ++j) { const u32x2 xq = __builtin_nontemporal_load(x1r + 64 * j); v[j] = (f32x4){bflo(xq.x), bfhi(xq.x), bflo(xq.y), bfhi(xq.y)}; }
#pragma unroll
        for (int k = 0; k < 4; ++k) { const int d = __builtin_amdgcn_readfirstlane(pstart[tope[m * 4 + k]] + slot[m * 4 + k]); const float w = __uint_as_float(__builtin_amdgcn_readfirstlane(__float_as_uint(wts[m * 4 + k])));
            const unsigned* yr = (const unsigned*)(Y + (size_t)d * D) + lane;
#pragma unroll
            for (int j = 0; j < 4; ++j) { const int y = (int)__builtin_nontemporal_load(yr + 64 * j);
                v[j].x += w * __builtin_amdgcn_cvt_f32_fp8(y, 0); v[j].y += w * __builtin_amdgcn_cvt_f32_fp8(y, 1); v[j].z += w * __builtin_amdgcn_cvt_f32_fp8(y, 2); v[j].w += w * __builtin_amdgcn_cvt_f32_fp8(y, 3); } }
        float s = 0.f;
#pragma unroll
        for (int j = 0; j < 4; ++j) s += (v[j].x * v[j].x + v[j].y * v[j].y) + (v[j].z * v[j].z + v[j].w * v[j].w);
        const float rstd = 1.0f / sqrtf(wave_sum(s) * (1.0f / D) + EPS);
        unsigned* o4 = (unsigned*)((unsigned char*)A3 + (size_t)m * D) + lane;
#pragma unroll
        for (int j = 0; j < 4; ++j) { xr[64 * j] = v[j]; o4[64 * j] = pk4_fp8(v[j].x * rstd * gv[j].x, v[j].y * rstd * gv[j].y, v[j].z * rstd * gv[j].z, v[j].w * rstd * gv[j].w); }
    }
}
__device__ __forceinline__ void final_rows(const P& a, int vcu, int G, int wave, int lane) {
    const int gw = vcu * NWAVES + wave, NGW = G * NWAVES;
    const float* X = (const float*)(a.ws + WS_X2); float* OUT = a.out; const bf16_t* PG = (const bf16_t*)(a.ws + WS_PGATE); const bf16_t* PP = (const bf16_t*)(a.ws + WS_PPROJ);
    f32x4 gp[4], gf[4];
#pragma unroll
    for (int j = 0; j < 4; ++j) { gp[j] = *((const f32x4*)a.in[23] + lane + 64 * j); gf[j] = *((const f32x4*)a.in[24] + lane + 64 * j); }
    for (int m = gw; m < T; m += NGW) {
        const f32x4* xr = (const f32x4*)(X + (size_t)m * D) + lane; f32x4* orow = (f32x4*)(OUT + (size_t)m * D) + lane; const u32x2* pgr = (const u32x2*)(PG + (size_t)m * D) + lane; const u32x2* ppr = (const u32x2*)(PP + (size_t)m * D) + lane;
        f32x4 v[4], pp[4], pg[4]; float sp = 0.f;
#pragma unroll
        for (int j = 0; j < 4; ++j) { v[j] = __builtin_nontemporal_load(xr + 64 * j); const u32x2 q = __builtin_nontemporal_load(ppr + 64 * j), gq = __builtin_nontemporal_load(pgr + 64 * j);
            pp[j] = (f32x4){bflo(q.x), bfhi(q.x), bflo(q.y), bfhi(q.y)}; pg[j] = (f32x4){bflo(gq.x), bfhi(gq.x), bflo(gq.y), bfhi(gq.y)};
            sp += (pp[j].x * pp[j].x + pp[j].y * pp[j].y) + (pp[j].z * pp[j].z + pp[j].w * pp[j].w); }
        const float rp = 1.0f / sqrtf(wave_sum(sp) * (1.0f / D) + EPS); float s = 0.f;
#pragma unroll
        for (int j = 0; j < 4; ++j) { v[j] = v[j] + pg[j] * (pp[j] * rp * gp[j]); s += (v[j].x * v[j].x + v[j].y * v[j].y) + (v[j].z * v[j].z + v[j].w * v[j].w); }
        const float rstd = 1.0f / sqrtf(wave_sum(s) * (1.0f / D) + EPS);
#pragma unroll
        for (int j = 0; j < 4; ++j) __builtin_nontemporal_store(v[j] * rstd * gf[j], orow + 64 * j);
    }
}
struct Args { P p; };
template <int PH_LO, int PH_HI>
__global__ void __launch_bounds__(NTHREADS, 2) hybrid_fwd(Args args) {
    extern __shared__ __attribute__((aligned(16))) unsigned char lds_raw[];
    LAS unsigned char* lds = (LAS unsigned char*)lds_raw;
    const P& a = args.p;
    const int tid = threadIdx.x, lane = tid & 63, wave = __builtin_amdgcn_readfirstlane(tid >> 6);
    const int G = gridDim.x; const int bx = blockIdx.x; const int vcu = (G % 8 == 0) ? (bx % 8) * (G / 8) + bx / 8 : bx;
    unsigned* ctl = (unsigned*)(a.ws + WS_CTL);
    for (int u = tid; u < (LDS_BYTES - LDSCTL_OFF) / 4; u += NTHREADS) ((LAS unsigned*)(lds + LDSCTL_OFF))[u] = 0u;
    __syncthreads();
#if MK_PER_PHASE
#define GRID_BAR() do { } while (0)
#else
    XcdBarrier bar = xcd_barrier_post(ctl + CW_BAR, (volatile LAS unsigned*)(lds + MISC_OFF + 32));
#define GRID_BAR() xcd_barrier(bar)
#endif
    constexpr int lo = PH_LO, hi = PH_HI;
#define IN(k) (lo <= (k) && (k) < hi)
#define SEAM(k) do { if constexpr (IN(k) && IN((k) + 1)) GRID_BAR(); } while (0)
    unsigned char* ws = a.ws;

    if constexpr (IN(0)) { p0_prologue(a, lds, vcu, G, wave, lane); }
    SEAM(0);
    if constexpr (IN(1)) {
        pg8::DenseSched S; S.o.init(T / 256, NPROJ / 256, G, bx); S.Bt = (const char*)(ws + WS_WIN); S.K = D;
        pg8::EpiProj<false> E{(bf16_t*)(ws + WS_PROJ), (float*)(ws + WS_KMP)};
        pg8::gemm_phase(lds, (const char*)(ws + WS_H), D, D, D, S, E);
    }
    SEAM(1);
    if constexpr (IN(2)) { for (int u = vcu; u < NB * 32; u += G) gla_prep_unit(a, lds, u); }
    SEAM(2);
    if constexpr (IN(3)) { for (int u = vcu; u < 512; u += G) gla_combine_unit(a, u); }
    SEAM(3);
    if constexpr (IN(4)) {
        for (int u = vcu; u < 1024; u += G) gla_out_unit(a, lds, u);
        __syncthreads();
    }
    if constexpr (IN(5)) {
        if ((vcu & 1) == 0) { expert_convert(a, lds, vcu >> 1, G >> 1, wave, lane); __syncthreads(); }
        unsigned* queue = ctl + CW_QUEUE;
        volatile LAS int* qslot = (volatile LAS int*)(lds + LDSCTL_OFF + 1024);
        if (tid == 0) qslot[0] = (int)__hip_atomic_fetch_add(queue, 1u, RLX_AGENT);
        __syncthreads();
        int item = __builtin_amdgcn_readfirstlane(qslot[0]);
        if (item < 512) {
            moba::Seam S;
            moba::BlockRef cur = moba::make_ref(a, item);
            moba::prime(cur, (char*)lds_raw, S);
            for (;;) {
                const int nitem = moba::block(a, cur, queue, a.in[2], (const float*)(ws + WS_KMP), (char*)lds_raw, S);
                if (nitem >= 512) break;
                cur = moba::make_ref(a, nitem);
            }
        }
    }
    SEAM(5);
    if constexpr (IN(6)) {
        pg8::ChainSched S; S.o.init(T / 256, D / 256, G, bx); S.Bt = (const char*)(ws + WS_WUP); S.K = 1024;
        pg8::EpiMerge E{(const bf16_t*)(ws + WS_PROJ), (bf16_t*)(ws + WS_Y)};
        pg8::gemm_phase(lds, (const char*)(ws + WS_OAB), 1024, 2048, 2048, S, E);
    }
    SEAM(6);
    if constexpr (IN(7)) {
        pg8::DenseSched S; S.o.init(T / 256, D / 256, G, bx); S.Bt = (const char*)(ws + WS_WO); S.K = D;
        pg8::EpiResF32 E{a.in[0], (bf16_t*)(ws + WS_X1)};
        pg8::gemm_phase(lds, (const char*)(ws + WS_Y), D, D, D, S, E);
    }
    SEAM(7);
    if constexpr (IN(8)) { for (int u = vcu; u < T / 64; u += G) router_unit(a, lds, u); }
    SEAM(8);
    if constexpr (IN(9)) {
        moe_tables(a, lds); const LAS int* tab = (const LAS int*)(lds + LDS_MOE); const int ntile = __builtin_amdgcn_readfirstlane(tab[128 + MAXTILES]);
        pg8::MoeSched<true> S; S.o.init(ntile, 8, G, bx); S.Bt = (const char*)a.out; S.K = D; S.rows_per_e = 2048; S.tab = tab; S.row_e = (const int*)(ws + WS_ROWE); S.es = 1;
        pg8::EpiGlu E{(unsigned char*)(ws + WS_HMID), (const float*)(ws + WS_RSTE), tab, a.in[15], a.in[17]};
        pg8::gemm_phase(lds, (const char*)(ws + WS_A2), D, D, D, S, E);
        const int extra = (ntile * 8) % G, nidle = G - extra;
        if (bx >= extra) { __syncthreads();
            pg8::DenseSched S2; S2.o.init(T / 256, D / 256, nidle, bx - extra); S2.Bt = (const char*)(ws + WS_WPP); S2.K = 256;
            pg8::EpiBf16<0, false> E2{(bf16_t*)(ws + WS_PPROJ), D, nullptr, 0, 1.0f};
            pg8::gemm_phase(lds, (const char*)(ws + WS_PB), 256, 256, 256, S2, E2); }
    }
    SEAM(9);
    if constexpr (IN(10)) {
        moe_tables(a, lds); const LAS int* tab = (const LAS int*)(lds + LDS_MOE); const int ntile = __builtin_amdgcn_readfirstlane(tab[128 + MAXTILES]);
        pg8::MoeSched<false> S; S.o.init(ntile, 4, G, bx); S.Bt = (const char*)(ws + WS_W2T); S.K = FF; S.rows_per_e = 1024; S.tab = tab; S.row_e = nullptr; S.es = 1;
        pg8::EpiDownF8 E{(unsigned char*)(ws + WS_YROWS), a.in[19]};
        pg8::gemm_phase(lds, (const char*)(ws + WS_HMID), FF, FF, FF, S, E);
    }
    SEAM(10);
    if constexpr (IN(11)) { moe_tables(a, lds); combine_rows(a, lds, vcu, G, wave, lane); }
    SEAM(11);
    if constexpr (IN(12)) {
        { pg8::DenseSched S; S.o.init(T / 256, D / 256, G, bx); S.Bt = (const char*)(ws + WS_WPG); S.K = D; S.es = 1;
          pg8::EpiBf16<1, false, true> E{(bf16_t*)(ws + WS_PGATE), D, nullptr, 0, 1.0f / 32.0f};
          pg8::gemm_phase(lds, (const char*)(ws + WS_H), D, D, D, S, E); }
    }
    SEAM(12);
    if constexpr (IN(13)) { final_rows(a, vcu, G, wave, lane); }
#undef IN
#undef SEAM
#undef GRID_BAR
}

template <int LO, int HI> static void launch_range(const Args& a, int grid, hipStream_t stream) {
    static bool attr = false;
    if (!attr) { attr = true; if (hipFuncSetAttribute((const void*)hybrid_fwd<LO, HI>, hipFuncAttributeMaxDynamicSharedMemorySize, LDS_BYTES) != hipSuccess) fprintf(stderr, "kernel_launch: hipFuncSetAttribute failed\n"); }
    hipLaunchKernelGGL((hybrid_fwd<LO, HI>), dim3(grid), dim3(NTHREADS), LDS_BYTES, stream, a);
}
extern "C" void kernel_launch(void* const* d_in, const int* in_sizes, int n_in, void* d_out, int out_size, void* d_ws, size_t ws_size, hipStream_t stream) {
    static int grid = 0;
    if (grid == 0) {
        static const int expect[25] = {T * D, T * 256, 256, 1024, 1024 * D_IN, 16 * 512, 512, 256, 1048576, 1048576, 1048576, 1024, 32768, 32, 33554432, 32768, 33554432, 32768, 33554432, 32768, 1024, 1048576, 262144, 1024, 1024};
        bool okk = (n_in == 25);
        for (int i = 0; okk && i < 25; ++i) if (in_sizes[i] != expect[i]) { fprintf(stderr, "kernel_launch: input %d has %d elements, expected %d\n", i, in_sizes[i], expect[i]); okk = false; }
        if (!okk || out_size != T * D || ws_size < WS_END) { fprintf(stderr, "kernel_launch: unexpected shapes (n_in %d, in0 %d, out %d, ws %zu); nothing launched\n", n_in, n_in > 0 ? in_sizes[0] : -1, out_size, ws_size); grid = -1; return; }
        int dev = 0, cus = 0;
        if (hipGetDevice(&dev) != hipSuccess || hipDeviceGetAttribute(&cus, hipDeviceAttributeMultiprocessorCount, dev) != hipSuccess) { grid = -1; return; }
        grid = cus;
    }
    if (grid < 0) return;
    (void)hipMemsetAsync((char*)d_ws + WS_CTL, 0, CTL_ZERO_BYTES, stream);
    Args a{};
    for (int i = 0; i < 25; ++i) a.p.in[i] = (const float*)d_in[i];
    a.p.out = (float*)d_out; a.p.ws = (unsigned char*)d_ws;
#if MK_PER_PHASE
#ifndef MK_LAST
#define MK_LAST 13
#endif
#ifndef MK_REPEAT
#define MK_REPEAT 0
#endif
#define LR(k) do { if ((k) <= MK_LAST) for (int r_ = 0; r_ < 1 + ((MK_REPEAT >> (k)) & 1); ++r_) launch_range<(k), (k) + 1>(a, grid, stream); } while (0)
    LR(0); LR(1); LR(2); LR(3); LR(4); LR(5); LR(6); LR(7); LR(8); LR(9); LR(10); LR(11); LR(12); LR(13);
#undef LR
#else
    launch_range<0, NPHASES>(a, grid, stream);
#endif
}
```

```cpp
#include <hip/hip_runtime.h>
#include <cstdio>
#include <cstdint>

#define LAS __attribute__((address_space(3)))
#define GAS __attribute__((address_space(1)))
typedef unsigned short bf16_t;
typedef short bf16x8 __attribute__((ext_vector_type(8)));
typedef short s16x4 __attribute__((ext_vector_type(4)));
typedef float f32x2 __attribute__((ext_vector_type(2)));
typedef float f32x4 __attribute__((ext_vector_type(4)));
typedef float f32x16 __attribute__((ext_vector_type(16)));
typedef unsigned u32x2 __attribute__((ext_vector_type(2)));
typedef unsigned u32x4 __attribute__((ext_vector_type(4)));
typedef int i32x4 __attribute__((ext_vector_type(4)));
typedef int i32x8 __attribute__((ext_vector_type(8)));
typedef GAS unsigned gu32;
#define RLX_AGENT __ATOMIC_RELAXED, __HIP_MEMORY_SCOPE_AGENT
#define LDS_WAIT() asm volatile("s_waitcnt lgkmcnt(0)" ::: "memory")
#define VM_WAIT() asm volatile("s_waitcnt vmcnt(0)" ::: "memory")

#ifndef MK_PER_PHASE
#define MK_PER_PHASE 0
#endif

constexpr int NB = 8, SEQ = 2048, T = NB * SEQ, D = 1024;
constexpr int NPROJ = 8192;
constexpr int C_QA = 0, C_KA = 512, C_VA = 1024, C_RA = 2048, C_QB = 3072, C_KB = 4096, C_VB = 5120, C_GA = 6144, C_GB = 7168;
constexpr int SRC_ALOW = 3072, D_IN = 8208;
constexpr int NE = 32, FF = 1024, MAXTILES = 288, MAXROWS = MAXTILES * 256;
constexpr float EPS = 1e-6f;
constexpr int NWAVES = 8, NTHREADS = 512;
constexpr int NPHASES = 14;

constexpr size_t MiB = 1u << 20;
constexpr size_t WS_CTL = 0, CTL_ZERO_BYTES = 1 * MiB;
constexpr size_t WS_SMALL = 1 * MiB;
constexpr size_t WS_KMP   = WS_SMALL;
constexpr size_t WS_DEC   = WS_KMP + 512 * 1024;
constexpr size_t WS_TOPE  = WS_DEC + 512 * 1024;
constexpr size_t WS_WTS   = WS_TOPE + 256 * 1024;
constexpr size_t WS_SLOT  = WS_WTS + 256 * 1024;
constexpr size_t WS_DEST  = WS_SLOT + 256 * 1024;
constexpr size_t WS_ROWTOK = WS_DEST + 256 * 1024;
constexpr size_t WS_RSTDS = WS_ROWTOK + 320 * 1024;
constexpr size_t WS_RSTD  = WS_RSTDS + 320 * 1024;
constexpr size_t WS_TILEE = WS_RSTD + 64 * 1024;
constexpr size_t WS_WALT  = WS_TILEE + 4 * 1024;
constexpr size_t WS_WRF   = WS_WALT + 32 * 1024;
static_assert(WS_WRF + 128 * 1024 <= 6 * MiB, "small map");
constexpr size_t WS_WO = 6 * MiB, WS_WPG = 8 * MiB, WS_WPP = 10 * MiB, WS_WUP = 12 * MiB, WS_WIN = 16 * MiB;
constexpr size_t WS_PB = 34 * MiB;
constexpr size_t WS_H  = 42 * MiB;
constexpr size_t WS_PROJ = 74 * MiB;
constexpr size_t WS_QG = 330 * MiB, WS_KG = 346 * MiB;
constexpr size_t WS_SLOC = 426 * MiB;
constexpr size_t WS_OAB = 362 * MiB;
constexpr size_t WS_H8 = 426 * MiB;
constexpr size_t WS_WIN8 = 442 * MiB;
constexpr size_t WS_Y = 330 * MiB;
constexpr size_t WS_W2T = 42 * MiB;
constexpr size_t WS_A2 = 330 * MiB;
constexpr size_t WS_HMID = 138 * MiB;
constexpr size_t WS_X1 = 74 * MiB;
constexpr size_t WS_X2 = 138 * MiB;
constexpr size_t WS_YROWS = 282 * MiB;
constexpr size_t WS_PGATE = 330 * MiB, WS_PPROJ = 226 * MiB;
constexpr size_t WS_ROWE = 490 * MiB;
constexpr size_t WS_RSTE = 492 * MiB;
constexpr size_t WS_END = 506 * MiB;

constexpr int CW_BAR = 4096;
constexpr int CW_COUNTS = 16384;
constexpr int CW_QUEUE = 16384 + 64;

constexpr int RING_BYTES = 131072;
constexpr int LDSCTL_OFF = RING_BYTES, MISC_OFF = LDSCTL_OFF + 320;
constexpr int LDS_MOE = LDSCTL_OFF + 10240;
constexpr int EPF_OFF = LDSCTL_OFF + 12288;
constexpr int LDS_BYTES = 151552;

typedef __bf16 bf16v2_t __attribute__((ext_vector_type(2)));
__device__ __forceinline__ unsigned cvt_pk_bf16(float lo, float hi) { const f32x2 v = {lo, hi}; return __builtin_bit_cast(unsigned, __builtin_convertvector(v, bf16v2_t)); }
__device__ __forceinline__ unsigned pk4_fp8(float a, float b, float c, float d) { int w = 0; w = __builtin_amdgcn_cvt_pk_fp8_f32(a, b, w, false); w = __builtin_amdgcn_cvt_pk_fp8_f32(c, d, w, true); return (unsigned)w; }
__device__ __forceinline__ float bf2f(unsigned short s) { return __uint_as_float(((unsigned)s) << 16); }
__device__ __forceinline__ float bflo(unsigned w) { return __uint_as_float(w << 16); }
__device__ __forceinline__ float bfhi(unsigned w) { return __uint_as_float(w & 0xffff0000u); }
__device__ __forceinline__ float fsigmoid(float x) { return __builtin_amdgcn_rcpf(1.0f + __builtin_amdgcn_exp2f(-1.4426950408889634f * x)); }
__device__ __forceinline__ float wave_sum(float v) {
#pragma unroll
    for (int o = 1; o < 64; o <<= 1) v += __shfl_xor(v, o);
    return v;
}
__device__ __forceinline__ bf16x8 pack8(f32x4 a, f32x4 b) {
    u32x4 w = {cvt_pk_bf16(a[0], a[1]), cvt_pk_bf16(a[2], a[3]), cvt_pk_bf16(b[0], b[1]), cvt_pk_bf16(b[2], b[3])};
    return __builtin_bit_cast(bf16x8, w);
}

#define XB_TMO      128
#define XB_XCNT(j)  (256  + 64 * (j))
#define XB_XSUB(j)  (1280 + 64 * (j))
#define XB_XGEN(j)  (2304 + 64 * (j))
#define XB_TOP      3328
#define XB_TOPGEN   3392
#define XCD_BAR_WORDS 3456
#define XB_SPIN_CAP (1u << 18)

__device__ __forceinline__ unsigned xb_ld(unsigned* p)              { return __hip_atomic_load(p, __ATOMIC_RELAXED, __HIP_MEMORY_SCOPE_AGENT); }
__device__ __forceinline__ unsigned xb_add(unsigned* p, unsigned v) { return __hip_atomic_fetch_add(p, v, __ATOMIC_RELAXED, __HIP_MEMORY_SCOPE_AGENT); }
__device__ __forceinline__ unsigned xb_xcc_id() { return (unsigned)__builtin_amdgcn_s_getreg((3 << 11) | 20) & 0xFu; }
#define XB_SPIN(cond, bar) do { unsigned _sp = 0; while (cond) { __builtin_amdgcn_s_sleep(1); \
    if ((++_sp & 255u) == 0u) { if (xb_ld(&(bar)[XB_TMO])) break; if (_sp > XB_SPIN_CAP) { atomicAdd(&(bar)[XB_TMO], 1u); break; } } } } while (0)

struct XcdBarrier { unsigned* bar; unsigned x; volatile LAS unsigned* st; };

__device__ __forceinline__ XcdBarrier xcd_barrier_post(unsigned* bar, volatile LAS unsigned* st) {
    XcdBarrier b; b.bar = bar; b.x = xb_xcc_id(); b.st = st;
    if (threadIdx.x == 0) (void)xb_add(&bar[XB_XCNT(b.x)], 1u);
    return b;
}
__device__ __forceinline__ void xcd_barrier_complete(unsigned* bar, unsigned x, unsigned& nloc, unsigned& nx) {
    const unsigned G = gridDim.x * gridDim.y * gridDim.z;
    unsigned sum, cnt, mine, sp = 0u;
    for (;;) {
        sum = 0u; cnt = 0u; mine = 0u;
#pragma unroll
        for (unsigned j = 0; j < 16; ++j) { const unsigned c = xb_ld(&bar[XB_XCNT(j)]); sum += c; cnt += (c > 0u) ? 1u : 0u; mine = (j == x) ? c : mine; }
        if (sum == G) break;
        __builtin_amdgcn_s_sleep(1);
        if ((++sp & 255u) == 0u) { if (xb_ld(&bar[XB_TMO])) break; if (sp > XB_SPIN_CAP) { atomicAdd(&bar[XB_TMO], 1u); break; } }
    }
    nloc = mine > 0u ? mine : 1u; nx = cnt > 0u ? cnt : 1u;
}
__device__ __forceinline__ void xcd_barrier(const XcdBarrier& b) {
    asm volatile("s_waitcnt vmcnt(0)" ::: "memory");
    __syncthreads();
    if (threadIdx.x == 0) {
        unsigned* bar = b.bar;
        __builtin_amdgcn_s_waitcnt(0);
        unsigned nloc = b.st[0], nx = b.st[1];
        if (nloc == 0u) { xcd_barrier_complete(bar, b.x, nloc, nx); b.st[0] = nloc; b.st[1] = nx; }
        const unsigned old = xb_add(&bar[XB_XSUB(b.x)], 1u);
        const unsigned gen = old / nloc;
        if (old + 1u == (gen + 1u) * nloc) {
            __builtin_amdgcn_fence(__ATOMIC_RELEASE, "agent");
            asm volatile("s_waitcnt vmcnt(0)" ::: "memory");
            const unsigned og = xb_add(&bar[XB_TOP], 1u);
            const unsigned tg = og / nx;
            if (og + 1u == (tg + 1u) * nx) xb_add(&bar[XB_TOPGEN], 1u);
            else XB_SPIN(xb_ld(&bar[XB_TOPGEN]) == tg, bar);
            __builtin_amdgcn_fence(__ATOMIC_ACQUIRE, "agent");
            xb_add(&bar[XB_XGEN(b.x)], 1u);
            asm volatile("s_waitcnt vmcnt(0)" ::: "memory");
        } else {
            XB_SPIN(xb_ld(&bar[XB_XGEN(b.x)]) == gen, bar);
            __builtin_amdgcn_fence(__ATOMIC_ACQUIRE, "agent");
            asm volatile("s_waitcnt vmcnt(0)" ::: "memory");
        }
    }
    __syncthreads();
}
#ifndef MK_SCL
#define MK_SCL 0
#endif
namespace pg8 {
constexpr int BM = 256, BK = 64, HALF = 128, HTB = HALF * BK * 2, STAGE_BYTES = 8 * HTB, NXCD = 8, WGM = 8;

__host__ __device__ __forceinline__ int lds_byte(int r, int c) { const int st = (r >> 4) * 2 + (c >> 5), rr = r & 15, cc = c & 31, ob = rr * 64 + cc * 2; return st * 1024 + (ob ^ (((ob >> 9) & 1) << 5)); }
__host__ __device__ __forceinline__ void stage_rc(int b, int& R, int& C) { const int st = b / 1024, sb = b % 1024, swz = sb ^ (((sb >> 9) & 1) << 5); R = (st >> 1) * 16 + swz / 64; C = (st & 1) * 32 + (swz % 64) / 2; }
__host__ __device__ __forceinline__ int perm32(int rho) { const int n = rho >> 4, i = rho & 15; return 8 * (i >> 2) + 4 * n + (i & 3); }

struct Unit { int pm, pn, e, s; };

struct TileOrder {
    int nM, nN, nwg, G, c;
    __device__ __forceinline__ void init(int nM_, int nN_, int G_, int c_) { nM = nM_; nN = nN_; nwg = nM * nN; G = G_; c = c_; }
    __device__ __forceinline__ bool next(int i, int& pm, int& pn) const {
        const unsigned L = (unsigned)i * (unsigned)G + (unsigned)c; if (L >= (unsigned)nwg) return false;
        int wgid = (int)L; { const int q = nwg / NXCD, r = nwg % NXCD, xcd = wgid % NXCD, off = wgid / NXCD; wgid = (xcd < r ? xcd * (q + 1) : r * (q + 1) + (xcd - r) * q) + off; }
        const int nig = WGM * nN, gid = wgid / nig, fm = gid * WGM, gsz = (nM - fm) < WGM ? (nM - fm) : WGM;
        pm = fm + ((wgid % nig) % gsz); pn = (wgid % nig) / gsz; return true;
    }
};
struct DenseSched {
    TileOrder o; const char* Bt; int K; int es = 2; int gap_at = 1 << 30, gap_by = 0, pn0 = 0; bool bt_out = true;
    __device__ __forceinline__ bool next(int i, Unit& u) const { int p; if (!o.next(i, u.pm, p)) return false; u.e = p; u.pn = p + (p >= gap_at ? gap_by : 0) + pn0; return true; }
    __device__ __forceinline__ unsigned a_row(const Unit& u, int r) const { return (unsigned)(u.pm * BM + r); }
    __device__ __forceinline__ unsigned a_koff(const Unit&) const { return 0u; }
    __device__ __forceinline__ const char* b_base(const Unit& u) const { return Bt + (size_t)(bt_out ? u.pn : u.e) * BM * K * es; }
};
struct ChainSched {
    TileOrder o; const char* Bt; int K;
    __device__ __forceinline__ bool next(int i, Unit& u) const { if (!o.next(i >> 1, u.pm, u.pn)) return false; u.e = i & 1; return true; }
    __device__ __forceinline__ unsigned a_row(const Unit& u, int r) const { return (unsigned)(u.pm * BM + r); }
    __device__ __forceinline__ unsigned a_koff(const Unit& u) const { return (unsigned)(u.e * K * 2); }
    __device__ __forceinline__ const char* b_base(const Unit& u) const { return Bt + (size_t)u.pn * BM * (2 * K) * 2 + (size_t)u.e * K * 2; }
};
template <bool GATHER> struct MoeSched {
    TileOrder o; const char* Bt; int K; int rows_per_e; const LAS int* tab; const int* row_e; int es;
    __device__ __forceinline__ bool next(int i, Unit& u) const { if (!o.next(i, u.pm, u.pn)) return false; u.e = __builtin_amdgcn_readfirstlane(tab[128 + u.pm]); return true; }
    __device__ __forceinline__ unsigned a_row(const Unit& u, int r) const {
        if (GATHER) { const int lr = u.pm * BM + r - tab[u.e]; return lr < tab[64 + u.e] ? (unsigned)row_e[(size_t)u.e * T + lr] : 0u; }
        else return (unsigned)(u.pm * BM + r); }
    __device__ __forceinline__ unsigned a_koff(const Unit&) const { return 0u; }
    __device__ __forceinline__ const char* b_base(const Unit& u) const { return Bt + ((size_t)u.e * rows_per_e + (size_t)u.pn * BM) * K * es; }
};

template <class Epi, class Sched>
__device__ __forceinline__ void gemm_phase(LAS unsigned char* lds, const char* gA, int K_, int lda, int ldb, const Sched& S, const Epi& E) {
    int K = K_; asm volatile("" : "+s"(K));
    int tid = threadIdx.x; asm volatile("" : "+v"(tid));     const int wid = __builtin_amdgcn_readfirstlane(tid >> 6), lane = tid & 63, wr = wid >> 2, wc = wid & 3, fr = lane & 15, fq = lane >> 4;
    constexpr int ES = Epi::F8 ? 1 : 2;
    const int nt = K * ES / 128;
    unsigned voffB[2];
#pragma unroll
    for (int i = 0; i < 2; ++i) { int R, C; stage_rc(tid * 16 + i * 8192, R, C); const int Rb = Epi::PERM ? ((R & ~31) + perm32(R & 31)) : R; voffB[i] = (unsigned)(Rb * ldb * ES + C * 2); }
    const unsigned kstep = (unsigned)(BK * 2);
    const size_t hstepB = (size_t)HALF * ldb * ES;
    const unsigned ldab = (unsigned)lda * ES;
    const unsigned ldsw = (unsigned)wid * 1024u;
    const int aoff = lds_byte(wr * 64 + fr, fq * 8), boff = lds_byte(wc * 32 + fr, fq * 8);
#define PG8_SA(b, h) (((b) * 2 + (h)) * HTB)
#define PG8_SB(b, h) ((4 + (b) * 2 + (h)) * HTB)
#define PG8_STAGE_B(bufoff, gbase) do { _Pragma("unroll") for (int _i = 0; _i < 2; ++_i) \
        __builtin_amdgcn_global_load_lds((const unsigned*)((const char*)(gbase) + voffB[_i]), (LAS unsigned*)(lds + (bufoff) + ldsw + _i * 8192), 16, 0, 0); } while (0)
#define PG8_STAGE_A(bufoff, o0, o1, kb) do { \
        const char* gk_ = gA + (kb);      \
        __builtin_amdgcn_global_load_lds((const unsigned*)(gk_ + (o0)), (LAS unsigned*)(lds + (bufoff) + ldsw), 16, 0, 0); \
        __builtin_amdgcn_global_load_lds((const unsigned*)(gk_ + (o1)), (LAS unsigned*)(lds + (bufoff) + ldsw + 8192), 16, 0, 0); } while (0)
#define PG8_LDA(dst, b, h) do { _Pragma("unroll") for (int m = 0; m < 4; ++m) _Pragma("unroll") for (int k = 0; k < 2; ++k) dst[m][k] = *(const LAS bf16x8*)(lds + PG8_SA(b, h) + aoff + m * 2048 + k * 1024); } while (0)
#define PG8_LDB(dst, b, h) do { _Pragma("unroll") for (int n = 0; n < 2; ++n) _Pragma("unroll") for (int k = 0; k < 2; ++k) dst[n][k] = *(const LAS bf16x8*)(lds + PG8_SB(b, h) + boff + n * 2048 + k * 1024); } while (0)
#define PG8_MMA(ai, bj, At, Bt) do { __builtin_amdgcn_s_setprio(1); \
        if constexpr (Epi::F8) { _Pragma("unroll") for (int m = 0; m < 4; ++m) _Pragma("unroll") for (int n = 0; n < 2; ++n) { \
            const i32x8 a8_ = __builtin_shufflevector(__builtin_bit_cast(i32x4, At[m][0]), __builtin_bit_cast(i32x4, At[m][1]), 0, 1, 2, 3, 4, 5, 6, 7); \
            const i32x8 b8_ = __builtin_shufflevector(__builtin_bit_cast(i32x4, Bt[n][0]), __builtin_bit_cast(i32x4, Bt[n][1]), 0, 1, 2, 3, 4, 5, 6, 7); \
            acc[ai][bj][m][n] = __builtin_amdgcn_mfma_scale_f32_16x16x128_f8f6f4(b8_, a8_, acc[ai][bj][m][n], 0, 0, 0, MK_SCL, 0, MK_SCL); } } \
        else { _Pragma("unroll") for (int m = 0; m < 4; ++m) _Pragma("unroll") for (int n = 0; n < 2; ++n) _Pragma("unroll") for (int k = 0; k < 2; ++k) \
            acc[ai][bj][m][n] = __builtin_amdgcn_mfma_f32_16x16x32_bf16(Bt[n][k], At[m][k], acc[ai][bj][m][n], 0, 0, 0); } \
        __builtin_amdgcn_s_setprio(0); } while (0)
#define PG8_WAIT_V(n) asm volatile("s_waitcnt vmcnt(" #n ")" ::: "memory")
#define PG8_WAIT_L(n) asm volatile("s_waitcnt lgkmcnt(" #n ")" ::: "memory")
#define PG8_BAR __builtin_amdgcn_s_barrier()
#define PG8_SCHED __builtin_amdgcn_sched_barrier(0)
#define PG8_AOFFS(dst, u) do { int t_ = threadIdx.x; asm volatile("" : "+v"(t_));     \
        _Pragma("unroll") for (int _h = 0; _h < 2; ++_h) _Pragma("unroll") for (int _i = 0; _i < 2; ++_i) { int R_, C_; stage_rc(t_ * 16 + _i * 8192, R_, C_); \
        dst[_h][_i] = S.a_row(u, _h * HALF + R_) * ldab + (unsigned)C_ * 2u + S.a_koff(u); } } while (0)
    Unit cur, nxt; int ui = 0;
    if (!S.next(0, cur)) return;
    cur.s = 0;
    if constexpr (Epi::PREF) E.prefetch(cur, 0);
#ifdef MK_STAGGER
    if (S.o.nwg > 3 * S.o.G) {
        const unsigned long long t0_ = __builtin_amdgcn_s_memrealtime(); const unsigned long long d_ = (unsigned long long)((blockIdx.x >> 3) & 7) * MK_STAGGER;
        while (__builtin_amdgcn_s_memrealtime() - t0_ < d_) __builtin_amdgcn_s_sleep(4);
    }
#endif
    f32x4 acc[2][2][4][2];
#pragma unroll
    for (int a = 0; a < 2; ++a)
#pragma unroll
        for (int b = 0; b < 2; ++b)
#pragma unroll
            for (int m = 0; m < 4; ++m)
#pragma unroll
                for (int n = 0; n < 2; ++n) acc[a][b][m][n] = (f32x4){0.f, 0.f, 0.f, 0.f};
    bf16x8 At[4][2], B0[2][2], B1[2][2];
    unsigned oc[2][2];
    LAS u32x4* nslot = (LAS u32x4*)(lds + LDSCTL_OFF + 2048) + tid;
    PG8_AOFFS(oc, cur);
    const char* cB = S.b_base(cur);
    PG8_STAGE_B(PG8_SB(0, 0), cB); PG8_STAGE_B(PG8_SB(0, 1), cB + hstepB); PG8_STAGE_A(PG8_SA(0, 0), oc[0][0], oc[0][1], 0u); PG8_STAGE_A(PG8_SA(0, 1), oc[1][0], oc[1][1], 0u);
    if (wr == 1) PG8_BAR;
    PG8_WAIT_V(2); PG8_BAR;
    PG8_STAGE_B(PG8_SB(1, 0), cB + kstep); PG8_STAGE_A(PG8_SA(1, 0), oc[0][0], oc[0][1], kstep); PG8_STAGE_B(PG8_SB(1, 1), cB + hstepB + kstep);
    PG8_WAIT_V(6); PG8_BAR;
    for (;;) {
        const bool has_next = S.next(ui + 1, nxt);
        const char* nB = has_next ? S.b_base(nxt) : cB;
        if (has_next) { unsigned on[2][2]; PG8_AOFFS(on, nxt); *nslot = (u32x4){on[0][0], on[0][1], on[1][0], on[1][1]}; nxt.s = cur.s == 2 ? 0 : cur.s + 1;
            if constexpr (Epi::PREF) E.prefetch(nxt, nxt.s); }
        for (int t = 0; t < nt; t += 2) {
            const bool last = (t == nt - 2);
            const unsigned k1 = (unsigned)(t + 1) * kstep;
            const unsigned k2 = last ? 0u : (unsigned)(t + 2) * kstep, k3 = k2 + kstep;
            const char* b2 = last ? nB : cB + (size_t)(t + 2) * kstep; const char* b3 = b2 + kstep;
            PG8_LDB(B0, 0, 0); PG8_LDB(B1, 0, 1); PG8_SCHED; PG8_LDA(At, 0, 0); PG8_STAGE_A(PG8_SA(1, 1), oc[1][0], oc[1][1], k1);
            PG8_WAIT_V(8); PG8_WAIT_L(0); PG8_BAR; PG8_MMA(0, 0, At, B0); PG8_MMA(0, 1, At, B1); PG8_BAR; PG8_SCHED;
            if (last && has_next) { const u32x4 o_ = *nslot; oc[0][0] = o_.x; oc[0][1] = o_.y; oc[1][0] = o_.z; oc[1][1] = o_.w; }
            PG8_LDA(At, 0, 1); PG8_STAGE_B(PG8_SB(0, 0), b2); PG8_STAGE_B(PG8_SB(0, 1), b2 + hstepB); PG8_STAGE_A(PG8_SA(0, 0), oc[0][0], oc[0][1], k2);
            PG8_WAIT_V(8); PG8_WAIT_L(0); PG8_BAR; PG8_MMA(1, 0, At, B0); PG8_MMA(1, 1, At, B1); PG8_BAR; PG8_SCHED;
            PG8_LDB(B0, 1, 0); PG8_LDB(B1, 1, 1); PG8_SCHED; PG8_LDA(At, 1, 0); PG8_STAGE_A(PG8_SA(0, 1), oc[1][0], oc[1][1], k2);
            PG8_WAIT_V(8); PG8_WAIT_L(0); PG8_BAR; PG8_MMA(0, 0, At, B0); PG8_MMA(0, 1, At, B1); PG8_BAR; PG8_SCHED;
            PG8_LDA(At, 1, 1); PG8_STAGE_B(PG8_SB(1, 0), b3); PG8_STAGE_B(PG8_SB(1, 1), b3 + hstepB); PG8_STAGE_A(PG8_SA(1, 0), oc[0][0], oc[0][1], k3);
            PG8_WAIT_V(8); PG8_WAIT_L(0); PG8_BAR; PG8_MMA(1, 0, At, B0); PG8_MMA(1, 1, At, B1); PG8_BAR; PG8_SCHED;
        }
        if (wr == 0) PG8_BAR;
        bool carry = false;
        if constexpr (Epi::MIDK) { if (cur.e == 0) { E.mid(acc, cur, wr, wc, fr, fq); carry = true; } else E(acc, cur, wr, wc, fr, fq); } else E(acc, cur, wr, wc, fr, fq);
        if (!has_next) break;
        if (!carry)
#pragma unroll
        for (int a = 0; a < 2; ++a)
#pragma unroll
            for (int b = 0; b < 2; ++b)
#pragma unroll
                for (int m = 0; m < 4; ++m)
#pragma unroll
                    for (int n = 0; n < 2; ++n) acc[a][b][m][n] = (f32x4){0.f, 0.f, 0.f, 0.f};
        cur = nxt; cB = nB; ++ui;
        if (wr == 1) PG8_BAR;
    }
    PG8_WAIT_V(0);
    PG8_BAR;
#undef PG8_SA
#undef PG8_SB
#undef PG8_STAGE_A
#undef PG8_STAGE_B
#undef PG8_LDA
#undef PG8_LDB
#undef PG8_MMA
#undef PG8_WAIT_V
#undef PG8_WAIT_L
#undef PG8_BAR
#undef PG8_SCHED
#undef PG8_AOFFS
}

template <bool F8_> struct EpiProj {
    static constexpr bool PREF = false, PERM = true, MIDK = false, F8 = F8_;
    bf16_t* O; float* kmp;
    __device__ __forceinline__ void operator()(const f32x4 (&acc)[2][2][4][2], const Unit& u, int wr, int wc, int fr, int fq) const {
        const int row0 = u.pm * BM + wr * 64 + fr; const int col0 = u.pn * BM + wc * 32 + 8 * fq;
#pragma unroll
        for (int ai = 0; ai < 2; ++ai)
#pragma unroll
            for (int m = 0; m < 4; ++m) { bf16_t* rowp = O + (size_t)(row0 + ai * HALF + m * 16) * NPROJ + col0;
#pragma unroll
                for (int bj = 0; bj < 2; ++bj) { const float sc = F8 ? (1.0f / 32.0f) : 1.0f; const f32x4 v0 = acc[ai][bj][m][0] * sc, v1 = acc[ai][bj][m][1] * sc;
                    u32x4 w; w.x = cvt_pk_bf16(v0[0], v0[1]); w.y = cvt_pk_bf16(v0[2], v0[3]); w.z = cvt_pk_bf16(v1[0], v1[1]); w.w = cvt_pk_bf16(v1[2], v1[3]);
                    __builtin_nontemporal_store(w, (u32x4*)(rowp + bj * HALF)); } }
        if (u.pn >= C_KB / BM && u.pn < C_VB / BM) {
#pragma unroll
            for (int bj = 0; bj < 2; ++bj)
#pragma unroll
                for (int n = 0; n < 2; ++n) { f32x4 s = (f32x4){0.f, 0.f, 0.f, 0.f};
#pragma unroll
                    for (int ai = 0; ai < 2; ++ai)
#pragma unroll
                        for (int m = 0; m < 4; ++m) s += acc[ai][bj][m][n];
#pragma unroll
                    for (int o = 1; o < 16; o <<= 1) { s[0] += __shfl_xor(s[0], o); s[1] += __shfl_xor(s[1], o); s[2] += __shfl_xor(s[2], o); s[3] += __shfl_xor(s[3], o); }
                    if (fr == 0) *(f32x4*)(kmp + ((size_t)wr * 64 + u.pm) * 1024 + (u.pn - C_KB / BM) * BM + bj * HALF + wc * 32 + 8 * fq + 4 * n) = s * (F8 ? (1.0f / 32.0f) : 1.0f); }
        }
    }
};
struct EpiMerge {
    static constexpr bool PREF = false, PERM = true, MIDK = true, F8 = false;
    const bf16_t* proj; bf16_t* Y;
    __device__ __forceinline__ void mid(f32x4 (&acc)[2][2][4][2], const Unit& u, int wr, int wc, int fr, int fq) const {
        const int row0 = u.pm * BM + wr * 64 + fr; const int col0 = u.pn * BM + wc * 32 + 8 * fq;
#pragma unroll
        for (int ai = 0; ai < 2; ++ai) {
            u32x4 ga[4][2], gb[4][2];
#pragma unroll
            for (int m = 0; m < 4; ++m) { const bf16_t* rowp = proj + (size_t)(row0 + ai * HALF + m * 16) * NPROJ + col0;
#pragma unroll
                for (int bj = 0; bj < 2; ++bj) { ga[m][bj] = *(const u32x4*)(rowp + C_GA + bj * HALF); gb[m][bj] = *(const u32x4*)(rowp + C_GB + bj * HALF); } }
#pragma unroll
            for (int m = 0; m < 4; ++m) {
#pragma unroll
                for (int bj = 0; bj < 2; ++bj) {
#pragma unroll
                    for (int j = 0; j < 4; ++j) { const float a0 = bflo(ga[m][bj][j]), a1 = bfhi(ga[m][bj][j]), b0 = bflo(gb[m][bj][j]), b1 = bfhi(gb[m][bj][j]);
                        const float r0 = (1.0f + __builtin_amdgcn_exp2f(-1.4426950408889634f * b0)) * __builtin_amdgcn_rcpf(1.0f + __builtin_amdgcn_exp2f(-1.4426950408889634f * a0));
                        const float r1 = (1.0f + __builtin_amdgcn_exp2f(-1.4426950408889634f * b1)) * __builtin_amdgcn_rcpf(1.0f + __builtin_amdgcn_exp2f(-1.4426950408889634f * a1));
                        acc[ai][bj][m][j >> 1][(j & 1) * 2] *= r0; acc[ai][bj][m][j >> 1][(j & 1) * 2 + 1] *= r1; } }
                asm volatile("" : "+v"(acc[ai][0][m][0]), "+v"(acc[ai][0][m][1]), "+v"(acc[ai][1][m][0]), "+v"(acc[ai][1][m][1])); }
            asm volatile("" ::: "memory"); }
    }
    __device__ __forceinline__ void operator()(const f32x4 (&acc)[2][2][4][2], const Unit& u, int wr, int wc, int fr, int fq) const {
        const int row0 = u.pm * BM + wr * 64 + fr; const int col0 = u.pn * BM + wc * 32 + 8 * fq;
#pragma unroll
        for (int ai = 0; ai < 2; ++ai) {
            u32x4 gb[4][2];
#pragma unroll
            for (int m = 0; m < 4; ++m)
#pragma unroll
                for (int bj = 0; bj < 2; ++bj) gb[m][bj] = *(const u32x4*)(proj + (size_t)(row0 + ai * HALF + m * 16) * NPROJ + C_GB + col0 + bj * HALF);
#pragma unroll
            for (int m = 0; m < 4; ++m) { const size_t r = (size_t)(row0 + ai * HALF + m * 16);
#pragma unroll
                for (int bj = 0; bj < 2; ++bj) { const u32x4 g = gb[m][bj];
                    const f32x4 v0 = acc[ai][bj][m][0], v1 = acc[ai][bj][m][1];
                    u32x4 w; w.x = cvt_pk_bf16(v0[0] * fsigmoid(bflo(g[0])), v0[1] * fsigmoid(bfhi(g[0]))); w.y = cvt_pk_bf16(v0[2] * fsigmoid(bflo(g[1])), v0[3] * fsigmoid(bfhi(g[1])));
                    w.z = cvt_pk_bf16(v1[0] * fsigmoid(bflo(g[2])), v1[1] * fsigmoid(bfhi(g[2]))); w.w = cvt_pk_bf16(v1[2] * fsigmoid(bflo(g[3])), v1[3] * fsigmoid(bfhi(g[3])));
                    *(u32x4*)(Y + r * D + col0 + bj * HALF) = w; } }
            asm volatile("" ::: "memory"); }
    }
};
struct EpiResF32 {
    static constexpr bool PREF = false, PERM = false, MIDK = false, F8 = false;
    const float* base; bf16_t* out;
    __device__ __forceinline__ void operator()(const f32x4 (&acc)[2][2][4][2], const Unit& u, int wr, int wc, int fr, int fq) const {
        const int row0 = u.pm * BM + wr * 64 + fr, col0 = u.pn * BM + wc * 32 + 4 * fq;
#pragma unroll
        for (int ai = 0; ai < 2; ++ai) {
            f32x4 bs[4][2][2];
#pragma unroll
            for (int m = 0; m < 4; ++m) { const size_t off = (size_t)(row0 + ai * HALF + m * 16) * D + col0;
#pragma unroll
                for (int bj = 0; bj < 2; ++bj)
#pragma unroll
                    for (int n = 0; n < 2; ++n) bs[m][bj][n] = __builtin_nontemporal_load((const f32x4*)(base + off + bj * HALF + n * 16)); }
#pragma unroll
            for (int m = 0; m < 4; ++m) { const size_t off = (size_t)(row0 + ai * HALF + m * 16) * D + col0;
#pragma unroll
                for (int bj = 0; bj < 2; ++bj)
#pragma unroll
                    for (int n = 0; n < 2; ++n) { const f32x4 v = bs[m][bj][n] + acc[ai][bj][m][n]; u32x2 w; w.x = cvt_pk_bf16(v[0], v[1]); w.y = cvt_pk_bf16(v[2], v[3]); *(u32x2*)(out + off + bj * HALF + n * 16) = w; } }
            asm volatile("" ::: "memory"); }
    }
};
struct EpiGlu {
    static constexpr bool PREF = true, PERM = true, MIDK = false, F8 = true;
    unsigned char* H; const float* rstd_e; const LAS int* tab; const float* bg; const float* bu; const float* zero; LAS unsigned char* lds;
    __device__ __forceinline__ void prefetch(const Unit& u, int slot) const {
        int tid = threadIdx.x; asm volatile("" : "+v"(tid)); const int wave = __builtin_amdgcn_readfirstlane(tid >> 6);
        const float* src;
        if (wave < 4) { const int lr = u.pm * BM + tid - tab[u.e]; src = lr < tab[64 + u.e] ? rstd_e + (size_t)u.e * T + lr : zero; }
        else { const int j = tid - 256; src = (j < 128 ? bg : bu) + (size_t)u.e * FF + u.pn * HALF + (j & 127); }
        __builtin_amdgcn_global_load_lds((const unsigned*)src, (LAS unsigned*)(lds + EPF_OFF + slot * 2048 + wave * 256), 4, 0, 0);
    }
    __device__ __forceinline__ void operator()(const f32x4 (&acc)[2][2][4][2], const Unit& u, int wr, int wc, int fr, int fq) const {
        const int row0 = u.pm * BM + wr * 64 + fr; const int colo = u.pn * HALF + wc * 32 + 8 * fq;
        const LAS float* ep = (const LAS float*)(lds + EPF_OFF + u.s * 2048);
        f32x4 g4[2], u4[2];
#pragma unroll
        for (int n = 0; n < 2; ++n) { g4[n] = *(const LAS f32x4*)(ep + 256 + wc * 32 + 8 * fq + 4 * n); u4[n] = *(const LAS f32x4*)(ep + 384 + wc * 32 + 8 * fq + 4 * n); }
        float rsv[2][4];
#pragma unroll
        for (int ai = 0; ai < 2; ++ai)
#pragma unroll
            for (int m = 0; m < 4; ++m) rsv[ai][m] = ep[wr * 64 + fr + ai * HALF + m * 16];
#pragma unroll
        for (int ai = 0; ai < 2; ++ai)
#pragma unroll
            for (int m = 0; m < 4; ++m) { const int r = row0 + ai * HALF + m * 16; const float rs = rsv[ai][m] * (1.0f / 32.0f);
                float o[8];
#pragma unroll
                for (int n = 0; n < 2; ++n)
#pragma unroll
                    for (int j = 0; j < 4; ++j) { float g = acc[ai][0][m][n][j] * rs + g4[n][j], up = acc[ai][1][m][n][j] * rs + u4[n][j];
                        g = fminf(g, 7.0f); up = fminf(fmaxf(up, -7.0f), 7.0f);
                        const float glu = g * fsigmoid(1.702f * g); o[n * 4 + j] = (up + 1.0f) * glu; }
                u32x2 w; w.x = pk4_fp8(o[0], o[1], o[2], o[3]); w.y = pk4_fp8(o[4], o[5], o[6], o[7]);
                *(u32x2*)(H + (size_t)r * FF + colo) = w; asm volatile("" ::: "memory"); }
    }
};
template <int ACT, bool HASBIAS, bool F8_ = false> struct EpiBf16 {
    static constexpr bool PREF = false, PERM = true, MIDK = false, F8 = F8_;
    bf16_t* O; int ldc; const float* bias; int bias_stride; float scale;
    __device__ __forceinline__ void operator()(const f32x4 (&acc)[2][2][4][2], const Unit& u, int wr, int wc, int fr, int fq) const {
        const int row0 = u.pm * BM + wr * 64 + fr; const int col0 = u.pn * BM + wc * 32 + 8 * fq;
        f32x4 bv[2][2];
#pragma unroll
        for (int bj = 0; bj < 2; ++bj)
#pragma unroll
            for (int n = 0; n < 2; ++n) bv[bj][n] = HASBIAS ? *(const f32x4*)(bias + (size_t)u.e * bias_stride + col0 + bj * HALF + 4 * n) : (f32x4){0.f, 0.f, 0.f, 0.f};
#pragma unroll
        for (int ai = 0; ai < 2; ++ai)
#pragma unroll
            for (int m = 0; m < 4; ++m) { bf16_t* rowp = O + (size_t)(row0 + ai * HALF + m * 16) * ldc + col0;
#pragma unroll
                for (int bj = 0; bj < 2; ++bj) { f32x4 v0 = acc[ai][bj][m][0] * scale + bv[bj][0], v1 = acc[ai][bj][m][1] * scale + bv[bj][1];
                    if (ACT == 1) {
#pragma unroll
                        for (int j = 0; j < 4; ++j) { v0[j] = fsigmoid(v0[j]); v1[j] = fsigmoid(v1[j]); } }
                    u32x4 w; w.x = cvt_pk_bf16(v0[0], v0[1]); w.y = cvt_pk_bf16(v0[2], v0[3]); w.z = cvt_pk_bf16(v1[0], v1[1]); w.w = cvt_pk_bf16(v1[2], v1[3]);
                    *(u32x4*)(rowp + bj * HALF) = w; }
                asm volatile("" ::: "memory"); }
    }
};
struct EpiDownF8 {
    static constexpr bool PREF = false, PERM = true, MIDK = false, F8 = true;
    unsigned char* O; const float* bias;
    __device__ __forceinline__ void operator()(const f32x4 (&acc)[2][2][4][2], const Unit& u, int wr, int wc, int fr, int fq) const {
        const int row0 = u.pm * BM + wr * 64 + fr; const int col0 = u.pn * BM + wc * 32 + 8 * fq;
        f32x4 bv[2][2];
#pragma unroll
        for (int bj = 0; bj < 2; ++bj)
#pragma unroll
            for (int n = 0; n < 2; ++n) bv[bj][n] = *(const f32x4*)(bias + (size_t)u.e * D + col0 + bj * HALF + 4 * n);
#pragma unroll
        for (int ai = 0; ai < 2; ++ai)
#pragma unroll
            for (int m = 0; m < 4; ++m) { unsigned char* rowp = O + (size_t)(row0 + ai * HALF + m * 16) * D + col0;
#pragma unroll
                for (int bj = 0; bj < 2; ++bj) { const f32x4 v0 = acc[ai][bj][m][0] * (1.0f / 32.0f) + bv[bj][0], v1 = acc[ai][bj][m][1] * (1.0f / 32.0f) + bv[bj][1];
                    u32x2 w; w.x = pk4_fp8(v0[0], v0[1], v0[2], v0[3]); w.y = pk4_fp8(v1[0], v1[1], v1[2], v1[3]);
                    *(u32x2*)(rowp + bj * HALF) = w; }
                asm volatile("" ::: "memory"); }
    }
};
}
__device__ __forceinline__ void transpose_item(const float* __restrict__ W, int ldw, int k0, int n_src0, bf16_t* __restrict__ WT, int ldo, int n_dst0, int k_off, LAS float* scr, int lane) {
    { float t_[32]; const float* wp_ = W + (size_t)(k0 + (lane >> 5)) * ldw + n_src0 + (lane & 31);
#pragma unroll
    for (int i = 0; i < 32; ++i) t_[i] = __builtin_nontemporal_load(wp_ + (size_t)(2 * i) * ldw);
#pragma unroll
    for (int i = 0; i < 32; ++i) scr[(2 * i + (lane >> 5)) * 33 + (lane & 31)] = t_[i]; }
    LDS_WAIT(); asm volatile("" ::: "memory");
    const int c = lane & 7;
#pragma unroll
    for (int j = 0; j < 4; ++j) { const int n = (lane >> 3) + 8 * j; const LAS float* s = scr + (8 * c) * 33 + n;
        u32x4 o; o.x = cvt_pk_bf16(s[0 * 33], s[1 * 33]); o.y = cvt_pk_bf16(s[2 * 33], s[3 * 33]); o.z = cvt_pk_bf16(s[4 * 33], s[5 * 33]); o.w = cvt_pk_bf16(s[6 * 33], s[7 * 33]);
        *(u32x4*)(WT + (size_t)(n_dst0 + n) * ldo + k_off + k0 + 8 * c) = o; }
    LDS_WAIT(); asm volatile("" ::: "memory");
}
__device__ __forceinline__ void transpose_item_f8(const float* __restrict__ W, int ldw, int k0, int n_src0, unsigned char* __restrict__ WT, int ldo, int n_dst0, float sc, LAS float* scr, int lane) {
    { float t_[32]; const float* wp_ = W + (size_t)(k0 + (lane >> 5)) * ldw + n_src0 + (lane & 31);
#pragma unroll
    for (int i = 0; i < 32; ++i) t_[i] = __builtin_nontemporal_load(wp_ + (size_t)(2 * i) * ldw);
#pragma unroll
    for (int i = 0; i < 32; ++i) scr[(2 * i + (lane >> 5)) * 33 + (lane & 31)] = t_[i]; }
    LDS_WAIT(); asm volatile("" ::: "memory");
    const int c = lane & 7;
#pragma unroll
    for (int j = 0; j < 4; ++j) { const int n = (lane >> 3) + 8 * j; const LAS float* s = scr + (8 * c) * 33 + n;
        u32x2 o; o.x = pk4_fp8(s[0 * 33] * sc, s[1 * 33] * sc, s[2 * 33] * sc, s[3 * 33] * sc); o.y = pk4_fp8(s[4 * 33] * sc, s[5 * 33] * sc, s[6 * 33] * sc, s[7 * 33] * sc);
        *(u32x2*)(WT + (size_t)(n_dst0 + n) * ldo + k0 + 8 * c) = o; }
    LDS_WAIT(); asm volatile("" ::: "memory");
}
__device__ __forceinline__ void transpose_mat_item(const float* W, int ldw, int N, int n_src_base, bf16_t* WT, int ldo, int n_dst_base, int k_off, LAS float* scr, int item, int lane) {
    const int nblk = N / 32, kb = item / nblk, nb = item % nblk;
    transpose_item(W, ldw, 64 * kb, n_src_base + 32 * nb, WT, ldo, n_dst_base + 32 * nb, k_off, scr, lane);
}

struct P {
    const float* in[25]; float* out; unsigned char* ws;
};

__device__ __forceinline__ void p0_prologue(const P& a, LAS unsigned char* lds, int vcu, int G, int wave, int lane) {
    LAS float* scr = (LAS float*)(lds + wave * 16384);
    const int gw = vcu * NWAVES + wave, NGW = G * NWAVES;
    unsigned char* ws = a.ws;
    bf16_t* WinT = (bf16_t*)(ws + WS_WIN); bf16_t* WupT = (bf16_t*)(ws + WS_WUP); bf16_t* WoT = (bf16_t*)(ws + WS_WO); bf16_t* WpgT = (bf16_t*)(ws + WS_WPG); bf16_t* WppT = (bf16_t*)(ws + WS_WPP);
    constexpr int I_A = 16 * 96, I_B = 16 * 160, I_S = 16 * 32, I_P = 4 * 32;
    constexpr int NITEMS = I_A + I_B + 4 * I_S + I_P;
#ifndef P0_PARTS
#define P0_PARTS 63
#endif
    if (P0_PARTS & 1)
    for (int it = gw; it < NITEMS; it += NGW) {
        int r = it;
        if (r < I_A) { transpose_mat_item(a.in[4], D_IN, 3072, 0, WinT, D, 0, 0, scr, r, lane); continue; } r -= I_A;
        if (r < I_B) { transpose_mat_item(a.in[4], D_IN, 5120, 3088, WinT, D, 3072, 0, scr, r, lane); continue; } r -= I_B;
        if (r < I_S) { transpose_mat_item(a.in[8], D, D, 0, WupT, 2048, 0, 0, scr, r, lane); continue; } r -= I_S;
        if (r < I_S) { transpose_mat_item(a.in[9], D, D, 0, WupT, 2048, 0, 1024, scr, r, lane); continue; } r -= I_S;
        if (r < I_S) { transpose_mat_item(a.in[10], D, D, 0, WoT, D, 0, 0, scr, r, lane); continue; } r -= I_S;
        if (r < I_S) { const int kb = r / 32, nb = r % 32; transpose_item_f8(a.in[21], D, 64 * kb, 32 * nb, (unsigned char*)WpgT, D, 32 * nb, 32.0f, scr, lane); continue; } r -= I_S;
        transpose_mat_item(a.in[22], D, D, 0, WppT, 256, 0, 0, scr, r, lane);
    }
    if (P0_PARTS & 2) {
        const float* x = a.in[0]; const float* g = a.in[3]; bf16_t* H = (bf16_t*)(ws + WS_H);
        f32x4 gv[4];
#pragma unroll
        for (int j = 0; j < 4; ++j) gv[j] = *((const f32x4*)g + lane + 64 * j);
        for (int m = gw; m < T; m += NGW) {
            const f32x4* xr = (const f32x4*)(x + (size_t)m * D) + lane; f32x4 v[4]; float s = 0.f;
#pragma unroll
            for (int j = 0; j < 4; ++j) { v[j] = __builtin_nontemporal_load(xr + 64 * j); s += (v[j].x * v[j].x + v[j].y * v[j].y) + (v[j].z * v[j].z + v[j].w * v[j].w); }
            const float rstd = 1.0f / sqrtf(wave_sum(s) * (1.0f / D) + EPS);
            u32x2* o8 = (u32x2*)(H + (size_t)m * D) + lane;
#pragma unroll
            for (int j = 0; j < 4; ++j) { const f32x4 y = v[j] * rstd * gv[j]; u32x2 w; w.x = cvt_pk_bf16(y.x, y.y); w.y = cvt_pk_bf16(y.z, y.w); o8[64 * j] = w; }
        }
    }
    if (P0_PARTS & 4) {
        const f32x4* p4 = (const f32x4*)a.in[1]; u32x2* pb = (u32x2*)(ws + WS_PB);
        const size_t n4 = (size_t)T * 256 / 4;
        for (size_t i = (size_t)gw * 64 + lane; i < n4; i += (size_t)NGW * 64) { const f32x4 v = __builtin_nontemporal_load(p4 + i); u32x2 w; w.x = cvt_pk_bf16(v.x, v.y); w.y = cvt_pk_bf16(v.z, v.w); pb[i] = w; }
    }
    if (P0_PARTS & 8) {
        const int gt = (vcu * NWAVES + wave) * 64 + lane;
        if ((P0_PARTS & 16) && gt < 16 * 1024) { const int n = gt >> 10, k = gt & 1023; ((bf16_t*)(ws + WS_WALT))[n * 1024 + k] = (bf16_t)(cvt_pk_bf16(a.in[4][(size_t)k * D_IN + SRC_ALOW + n], 0.f) & 0xffffu); }
        if ((P0_PARTS & 32) && gt < 4096) { const int s = gt >> 6, l = gt & 63, e = l & 31, hh = l >> 5; const float* wr = a.in[12];
            float v[8], lo[8];
#pragma unroll
            for (int j = 0; j < 8; ++j) { v[j] = wr[(size_t)(16 * s + 8 * hh + j) * NE + e]; }
            u32x4 whi; whi.x = cvt_pk_bf16(v[0], v[1]); whi.y = cvt_pk_bf16(v[2], v[3]); whi.z = cvt_pk_bf16(v[4], v[5]); whi.w = cvt_pk_bf16(v[6], v[7]);
#pragma unroll
            for (int j = 0; j < 4; ++j) { lo[2 * j] = v[2 * j] - bflo(whi[j]); lo[2 * j + 1] = v[2 * j + 1] - bfhi(whi[j]); }
            u32x4 wlo; wlo.x = cvt_pk_bf16(lo[0], lo[1]); wlo.y = cvt_pk_bf16(lo[2], lo[3]); wlo.z = cvt_pk_bf16(lo[4], lo[5]); wlo.w = cvt_pk_bf16(lo[6], lo[7]);
            u32x4* f = (u32x4*)(ws + WS_WRF); f[gt] = whi; f[4096 + gt] = wlo; }
    }
}

struct CvtItem { const float* src; unsigned char* dst; int ldo; };
__device__ __forceinline__ CvtItem cvt_item(const P& a, int it, int lane) {
    constexpr int IPM = 16 * 32;
    const int e = it / (3 * IPM), r0 = it % (3 * IPM), which = r0 / IPM, r = r0 % IPM, kb = r / 32, nb = r % 32, n0 = 32 * nb;
    CvtItem c;
    if (which < 2) { c.src = a.in[which == 0 ? 14 : 16] + (size_t)e * D * FF + (size_t)(64 * kb + (lane >> 5)) * FF + n0 + (lane & 31);
        c.dst = (unsigned char*)a.out + ((size_t)e * 2048 + (n0 >> 7) * 256 + (n0 & 127) + which * 128) * D + 64 * kb; c.ldo = D; }
    else { c.src = a.in[18] + (size_t)e * FF * D + (size_t)(64 * kb + (lane >> 5)) * D + n0 + (lane & 31);
        c.dst = a.ws + WS_W2T + ((size_t)e * D + n0) * FF + 64 * kb; c.ldo = FF; }
    return c;
}
__device__ __forceinline__ void expert_convert(const P& a, LAS unsigned char* lds, int vcu, int G, int wave, int lane) {
    LAS float* scr = (LAS float*)(lds + wave * 16384);
    const int gw = vcu * NWAVES + wave, NGW = G * NWAVES;
    constexpr int NIT = NE * 3 * 16 * 32;
    if (gw >= NIT) return;
    float tA[32], tB[32];
    CvtItem cA = cvt_item(a, gw, lane), cB = cvt_item(a, gw + NGW < NIT ? gw + NGW : gw, lane);
#pragma unroll
    for (int i = 0; i < 32; ++i) tA[i] = __builtin_nontemporal_load(cA.src + (size_t)(2 * i) * 1024);
#pragma unroll
    for (int i = 0; i < 32; ++i) tB[i] = __builtin_nontemporal_load(cB.src + (size_t)(2 * i) * 1024);
#define CVT_OUT(c_) do { LDS_WAIT(); asm volatile("" ::: "memory"); const int c = lane & 7; \
        _Pragma("unroll") for (int j = 0; j < 4; ++j) { const int n = (lane >> 3) + 8 * j; const LAS float* s = scr + (8 * c) * 33 + n; \
            u32x2 o; o.x = pk4_fp8(s[0 * 33] * 32.0f, s[1 * 33] * 32.0f, s[2 * 33] * 32.0f, s[3 * 33] * 32.0f); o.y = pk4_fp8(s[4 * 33] * 32.0f, s[5 * 33] * 32.0f, s[6 * 33] * 32.0f, s[7 * 33] * 32.0f); \
            __builtin_nontemporal_store(o, (u32x2*)((c_).dst + (size_t)n * (c_).ldo + 8 * c)); } \
        LDS_WAIT(); asm volatile("" ::: "memory"); } while (0)
    for (int it = gw; it < NIT; it += 2 * NGW) {
#pragma unroll
        for (int i = 0; i < 32; ++i) scr[(2 * i + (lane >> 5)) * 33 + (lane & 31)] = tA[i];
        const CvtItem dA = cA; const int n2 = it + 2 * NGW;
        if (n2 < NIT) { cA = cvt_item(a, n2, lane);
#pragma unroll
            for (int i = 0; i < 32; ++i) tA[i] = __builtin_nontemporal_load(cA.src + (size_t)(2 * i) * 1024); }
        CVT_OUT(dA);
        if (it + NGW >= NIT) break;
#pragma unroll
        for (int i = 0; i < 32; ++i) scr[(2 * i + (lane >> 5)) * 33 + (lane & 31)] = tB[i];
        const CvtItem dB = cB; const int n3 = it + 3 * NGW;
        if (n3 < NIT) { cB = cvt_item(a, n3, lane);
#pragma unroll
            for (int i = 0; i < 32; ++i) tB[i] = __builtin_nontemporal_load(cB.src + (size_t)(2 * i) * 1024); }
        CVT_OUT(dB);
    }
#undef CVT_OUT
}

__device__ __forceinline__ float fexp_(float x) { return __builtin_amdgcn_exp2f(x * 1.4426950408889634f); }
__device__ __forceinline__ float logsigmoidf_(float x) { const float e = fexp_(-fabsf(x)); return fminf(x, 0.0f) - 0.6931471805599453f * __builtin_amdgcn_logf(1.0f + e); }
__device__ __forceinline__ void gla_prep_unit(const P& a, LAS unsigned char* lds, int unit) {
    int tid = threadIdx.x; asm volatile("" : "+v"(tid));     const int wave = __builtin_amdgcn_readfirstlane(tid >> 6), lane = tid & 63;
    const int b = unit >> 5, chunk = unit & 31, tok0 = b * SEQ + chunk * 64;
    const bf16_t* H = (const bf16_t*)(a.ws + WS_H); const bf16_t* WalT = (const bf16_t*)(a.ws + WS_WALT); const bf16_t* proj = (const bf16_t*)(a.ws + WS_PROJ);
    LAS float* part = (LAS float*)lds;
    LAS float* alow = (LAS float*)(lds + 8192);
    LAS float* seg = (LAS float*)(lds + 12288);
    constexpr int GP_KDT = 16384, GP_VT = 34816;
    {
        const int rg = wave & 3, kh = wave >> 2, r = lane & 15, q = lane >> 4;
        f32x4 acc = (f32x4){0.f, 0.f, 0.f, 0.f};
        const bf16_t* ap = H + (size_t)(tok0 + 16 * rg + r) * D + 512 * kh + 8 * q; const bf16_t* bp = WalT + (size_t)r * D + 512 * kh + 8 * q;
#pragma unroll 8
        for (int s = 0; s < 16; ++s) { const bf16x8 av = *(const bf16x8*)(ap + 32 * s), bv = *(const bf16x8*)(bp + 32 * s); acc = __builtin_amdgcn_mfma_f32_16x16x32_bf16(bv, av, acc, 0, 0, 0); }
        *(LAS f32x4*)(part + (kh * 64 + 16 * rg + r) * 16 + 4 * q) = acc;
    }
    __syncthreads();
    if (tid < 256) { *(LAS f32x4*)(alow + tid * 4) = *(LAS f32x4*)(part + tid * 4) + *(LAS f32x4*)(part + 1024 + tid * 4); }
    __syncthreads();
    const int dp = tid & 63, tq = wave;
    const float* w_a2 = a.in[5]; const float* b_a2 = a.in[6];
    const int ep = tid & 127, sq4 = tid >> 7;
    f32x2 w2[16], w2n[16]; f32x2 b2, b2n; unsigned qv[8], kv[8], qvn[8], kvn[8], sv[16], svn[16];
#define GP_LOADS(h_, W2, B2, QV, KV, SV) do { const int dc_ = (h_) * 128 + 2 * dp; \
        _Pragma("unroll") for (int r = 0; r < 16; ++r) W2[r] = *(const f32x2*)(w_a2 + r * 512 + dc_); \
        B2 = *(const f32x2*)(b_a2 + dc_); \
        _Pragma("unroll") for (int i = 0; i < 8; ++i) { const bf16_t* rp = proj + (size_t)(tok0 + 8 * tq + i) * NPROJ + dc_; QV[i] = __builtin_nontemporal_load((const unsigned*)(rp + C_QA)); KV[i] = __builtin_nontemporal_load((const unsigned*)(rp + C_KA)); } \
        const bf16_t* v_ = proj + (size_t)(tok0 + 16 * sq4) * NPROJ + C_VA + (h_) * 256 + 2 * ep; \
        _Pragma("unroll") for (int i = 0; i < 16; ++i) SV[i] = __builtin_nontemporal_load((const unsigned*)(v_ + (size_t)i * NPROJ)); } while (0)
    GP_LOADS(0, w2, b2, qv, kv, sv);
    for (int h = 0; h < 4; ++h) {
        if (h + 1 < 4) GP_LOADS(h + 1, w2n, b2n, qvn, kvn, svn);
        float G0[8], G1[8]; float r0 = 0.f, r1 = 0.f;
#pragma unroll
        for (int i = 0; i < 8; ++i) { const LAS f32x4* al4 = (const LAS f32x4*)(alow + (8 * tq + i) * 16); float x0 = b2.x, x1 = b2.y;
#pragma unroll
            for (int r4 = 0; r4 < 4; ++r4) { const f32x4 al = al4[r4];
#pragma unroll
                for (int j = 0; j < 4; ++j) { x0 += al[j] * w2[4 * r4 + j].x; x1 += al[j] * w2[4 * r4 + j].y; } }
            r0 += logsigmoidf_(x0) * (1.0f / 16.0f); r1 += logsigmoidf_(x1) * (1.0f / 16.0f); G0[i] = r0; G1[i] = r1; }
        *(LAS f32x2*)(seg + tq * 128 + 2 * dp) = (f32x2){r0, r1};
        __syncthreads();
        float off0 = 0.f, off1 = 0.f, tot0 = 0.f, tot1 = 0.f;
#pragma unroll
        for (int q = 0; q < 8; ++q) { const f32x2 s = *(LAS f32x2*)(seg + q * 128 + 2 * dp); tot0 += s.x; tot1 += s.y; if (q < tq) { off0 += s.x; off1 += s.y; } }
        const size_t tile = (size_t)((b * 4 + h) * 32 + chunk);
        bf16_t* Qg = (bf16_t*)(a.ws + WS_QG) + tile * 8192; bf16_t* Kg = (bf16_t*)(a.ws + WS_KG) + tile * 8192;
        float kd0[8], kd1[8];
#pragma unroll
        for (int i = 0; i < 8; ++i) { const float g0 = G0[i] + off0, g1 = G1[i] + off1; const float q0 = bflo(qv[i]), q1 = bfhi(qv[i]), k0 = bflo(kv[i]), k1 = bfhi(kv[i]);
            const float e0 = fexp_(g0), e1 = fexp_(g1);
            *(unsigned*)(Qg + (8 * tq + i) * 128 + 2 * dp) = cvt_pk_bf16(q0 * e0 * 0.08838834764831845f, q1 * e1 * 0.08838834764831845f);
            *(unsigned*)(Kg + (8 * tq + i) * 128 + 2 * dp) = cvt_pk_bf16(k0 * __builtin_amdgcn_rcpf(e0), k1 * __builtin_amdgcn_rcpf(e1));
            kd0[i] = k0 * fexp_(tot0 - g0); kd1[i] = k1 * fexp_(tot1 - g1); }
        u32x4 w0, w1; w0.x = cvt_pk_bf16(kd0[0], kd0[1]); w0.y = cvt_pk_bf16(kd0[2], kd0[3]); w0.z = cvt_pk_bf16(kd0[4], kd0[5]); w0.w = cvt_pk_bf16(kd0[6], kd0[7]);
        w1.x = cvt_pk_bf16(kd1[0], kd1[1]); w1.y = cvt_pk_bf16(kd1[2], kd1[3]); w1.z = cvt_pk_bf16(kd1[4], kd1[5]); w1.w = cvt_pk_bf16(kd1[6], kd1[7]);
        *(LAS u32x4*)(lds + GP_KDT + (2 * dp) * 144 + 16 * tq) = w0; *(LAS u32x4*)(lds + GP_KDT + (2 * dp + 1) * 144 + 16 * tq) = w1;
        if (tq == 0) *(f32x2*)((float*)(a.ws + WS_DEC) + tile * 128 + 2 * dp) = (f32x2){fexp_(tot0), fexp_(tot1)};
        {
            u32x4 lo0, lo1, hi0, hi1;
#pragma unroll
            for (int j = 0; j < 4; ++j) { lo0[j] = (sv[2 * j] & 0xffffu) | (sv[2 * j + 1] << 16); lo1[j] = (sv[8 + 2 * j] & 0xffffu) | (sv[8 + 2 * j + 1] << 16);
                hi0[j] = (sv[2 * j] >> 16) | (sv[2 * j + 1] & 0xffff0000u); hi1[j] = (sv[8 + 2 * j] >> 16) | (sv[8 + 2 * j + 1] & 0xffff0000u); }
            LAS unsigned char* v0 = lds + GP_VT + (2 * ep) * 144 + sq4 * 32;
            *(LAS u32x4*)(v0) = lo0; *(LAS u32x4*)(v0 + 16) = lo1; *(LAS u32x4*)(v0 + 144) = hi0; *(LAS u32x4*)(v0 + 144 + 16) = hi1;
        }
        __syncthreads();
        {
            const int c32 = lane & 31, hi = lane >> 5;
            bf16x8 vt[4];
#pragma unroll
            for (int ks = 0; ks < 4; ++ks) vt[ks] = *(const LAS bf16x8*)(lds + GP_VT + (32 * wave + c32) * 144 + (16 * ks + 8 * hi) * 2);
            unsigned* sl = (unsigned*)a.out + tile * 8192;
#pragma unroll
            for (int tl = 0; tl < 4; ++tl) { f32x16 acc;
#pragma unroll
                for (int r = 0; r < 16; ++r) acc[r] = 0.f;
#pragma unroll
                for (int ks = 0; ks < 4; ++ks) { const bf16x8 av = *(const LAS bf16x8*)(lds + GP_KDT + (32 * tl + c32) * 144 + (16 * ks + 8 * hi) * 2); acc = __builtin_amdgcn_mfma_f32_32x32x16_bf16(av, vt[ks], acc, 0, 0, 0); }
#pragma unroll
                for (int g = 0; g < 4; ++g) sl[((tl * 4 + g) * 2 + hi) * 256 + 32 * wave + c32] = pk4_fp8(acc[4 * g], acc[4 * g + 1], acc[4 * g + 2], acc[4 * g + 3]); }
        }
        __syncthreads();
#pragma unroll
        for (int r = 0; r < 16; ++r) { w2[r] = w2n[r]; sv[r] = svn[r]; }
#pragma unroll
        for (int i = 0; i < 8; ++i) { qv[i] = qvn[i]; kv[i] = kvn[i]; }
        b2 = b2n;
    }
#undef GP_LOADS
}

__device__ __forceinline__ void gla_combine_unit(const P& a, int unit) {
    const int tid = threadIdx.x, bh = unit >> 4, i8 = (unit & 15) * 512 + tid;
    const int d0 = 32 * (i8 >> 11) + 8 * ((i8 >> 9) & 3) + 4 * ((i8 >> 8) & 1);
    const unsigned* sl8 = (const unsigned*)a.out + (size_t)bh * 32 * 8192 + i8; u32x2* sl = (u32x2*)(a.ws + WS_SLOC) + (size_t)bh * 32 * 8192 + i8;
    const f32x4* dc = (const f32x4*)((const float*)(a.ws + WS_DEC) + (size_t)bh * 32 * 128 + d0);
    f32x4 s = (f32x4){0.f, 0.f, 0.f, 0.f};
    for (int cb = 0; cb < 32; cb += 8) {
        unsigned loc[8]; f32x4 dv[8];
#pragma unroll
        for (int i = 0; i < 8; ++i) { loc[i] = __builtin_nontemporal_load(sl8 + (size_t)(cb + i) * 8192); dv[i] = dc[(cb + i) * 32]; }
#pragma unroll
        for (int i = 0; i < 8; ++i) { if (cb + i < 31) {
            s.x = dv[i].x * s.x + __builtin_amdgcn_cvt_f32_fp8((int)loc[i], 0); s.y = dv[i].y * s.y + __builtin_amdgcn_cvt_f32_fp8((int)loc[i], 1);
            s.z = dv[i].z * s.z + __builtin_amdgcn_cvt_f32_fp8((int)loc[i], 2); s.w = dv[i].w * s.w + __builtin_amdgcn_cvt_f32_fp8((int)loc[i], 3);
            u32x2 w; w.x = cvt_pk_bf16(s.x, s.y); w.y = cvt_pk_bf16(s.z, s.w); sl[(size_t)(cb + i) * 8192] = w; } }
    }
}

constexpr int GL_QG = 0, GL_KG = 17408, GL_VT = 53248, GL_AM = 90112, GL_OST = 0;
constexpr int GL_QS = 272, GL_TS = 144, GL_OS = 528;
__device__ __forceinline__ int crow(int r, int hi) { return (r & 3) + 8 * (r >> 2) + 4 * hi; }
__device__ __forceinline__ void gla_out_unit(const P& a, LAS unsigned char* lds, int unit) {
    int tid = threadIdx.x; asm volatile("" : "+v"(tid)); const int w = __builtin_amdgcn_readfirstlane(tid >> 6), lane = tid & 63, c32 = lane & 31, hi = lane >> 5;
    const int bh = unit >> 5, chunk = unit & 31, b = bh >> 2, h = bh & 3;
    const bf16_t* proj = (const bf16_t*)(a.ws + WS_PROJ); bf16_t* oab = (bf16_t*)(a.ws + WS_OAB); const float* ggo = a.in[7];
    const size_t tile = (size_t)bh * 32 + chunk;
    {
        const u32x4* q_ = (const u32x4*)((const bf16_t*)(a.ws + WS_QG) + tile * 8192); const u32x4* k_ = (const u32x4*)((const bf16_t*)(a.ws + WS_KG) + tile * 8192);
        u32x4 sq[2], sk[2]; unsigned sv[16];
        sq[0] = __builtin_nontemporal_load(q_ + tid); sq[1] = __builtin_nontemporal_load(q_ + tid + 512); sk[0] = __builtin_nontemporal_load(k_ + tid); sk[1] = __builtin_nontemporal_load(k_ + tid + 512);
        const int ep = tid & 127, sq4 = tid >> 7;
        const bf16_t* v_ = proj + (size_t)(b * SEQ + chunk * 64 + 16 * sq4) * NPROJ + C_VA + h * 256 + 2 * ep;
#pragma unroll
        for (int i = 0; i < 16; ++i) sv[i] = __builtin_nontemporal_load((const unsigned*)(v_ + (size_t)i * NPROJ));
#pragma unroll
        for (int i = 0; i < 2; ++i) { const int p = tid + 512 * i;
            *(LAS u32x4*)(lds + GL_QG + (p >> 4) * GL_QS + (p & 15) * 16) = sq[i]; *(LAS u32x4*)(lds + GL_KG + (p >> 4) * GL_QS + (p & 15) * 16) = sk[i]; }
        u32x4 lo0, lo1, hi0, hi1;
#pragma unroll
        for (int j = 0; j < 4; ++j) { lo0[j] = (sv[2 * j] & 0xffffu) | (sv[2 * j + 1] << 16); lo1[j] = (sv[8 + 2 * j] & 0xffffu) | (sv[8 + 2 * j + 1] << 16);
            hi0[j] = (sv[2 * j] >> 16) | (sv[2 * j + 1] & 0xffff0000u); hi1[j] = (sv[8 + 2 * j] >> 16) | (sv[8 + 2 * j + 1] & 0xffff0000u); }
        LAS unsigned char* v0 = lds + GL_VT + (2 * ep) * GL_TS + sq4 * 32;
        *(LAS u32x4*)(v0) = lo0; *(LAS u32x4*)(v0 + 16) = lo1; *(LAS u32x4*)(v0 + GL_TS) = hi0; *(LAS u32x4*)(v0 + GL_TS + 16) = hi1;
    }
    u32x2 sf[4][2][2];
    if (chunk > 0) { const u32x2* sl = (const u32x2*)(a.ws + WS_SLOC) + (tile - 1) * 8192;
#pragma unroll
        for (int tl = 0; tl < 4; ++tl)
#pragma unroll
            for (int s = 0; s < 2; ++s)
#pragma unroll
                for (int q = 0; q < 2; ++q) sf[tl][s][q] = __builtin_nontemporal_load(sl + ((tl * 4 + 2 * s + q) * 2 + hi) * 256 + 32 * w + c32); }
    __syncthreads();
    if (w < 3) {
        const int ti = (w + 1) >> 1, si = w >> 1;
        f32x16 A;
#pragma unroll
        for (int r = 0; r < 16; ++r) A[r] = 0.f;
#pragma unroll
        for (int s = 0; s < 8; ++s) { const bf16x8 av = *(const LAS bf16x8*)(lds + GL_QG + (32 * ti + c32) * GL_QS + (16 * s + 8 * hi) * 2), bv = *(const LAS bf16x8*)(lds + GL_KG + (32 * si + c32) * GL_QS + (16 * s + 8 * hi) * 2);
            A = __builtin_amdgcn_mfma_f32_32x32x16_bf16(av, bv, A, 0, 0, 0); }
        const int sidx = 32 * si + c32;
#pragma unroll
        for (int r = 0; r < 16; ++r) { const int t = 32 * ti + crow(r, hi); const float v = (sidx <= t) ? A[r] : 0.f;
            *(LAS bf16_t*)(lds + GL_AM + t * GL_TS + sidx * 2) = (bf16_t)(cvt_pk_bf16(v, 0.f) & 0xffffu); }
    }
    __syncthreads();
    f32x16 o[2];
    {
        bf16x8 vt[4];
#pragma unroll
        for (int ks = 0; ks < 4; ++ks) vt[ks] = *(const LAS bf16x8*)(lds + GL_VT + (32 * w + c32) * GL_TS + (16 * ks + 8 * hi) * 2);
#pragma unroll
        for (int ti = 0; ti < 2; ++ti) {
#pragma unroll
            for (int r = 0; r < 16; ++r) o[ti][r] = 0.f;
            if (chunk > 0) {
#pragma unroll
                for (int tl = 0; tl < 4; ++tl)
#pragma unroll
                    for (int s = 0; s < 2; ++s) { const LAS unsigned char* qp = lds + GL_QG + (32 * ti + c32) * GL_QS + (32 * tl + 16 * s + 4 * hi) * 2;
                        const s16x4 lo = *(const LAS s16x4*)qp, hh = *(const LAS s16x4*)(qp + 16);
                        const bf16x8 aop = __builtin_shufflevector(lo, hh, 0, 1, 2, 3, 4, 5, 6, 7);
                        const u32x4 bw = {sf[tl][s][0].x, sf[tl][s][0].y, sf[tl][s][1].x, sf[tl][s][1].y};
                        o[ti] = __builtin_amdgcn_mfma_f32_32x32x16_bf16(aop, __builtin_bit_cast(bf16x8, bw), o[ti], 0, 0, 0); }
            }
#pragma unroll
            for (int ks = 0; ks < 4; ++ks) { if (ti == 0 && ks >= 2) continue;
                const bf16x8 av = *(const LAS bf16x8*)(lds + GL_AM + (32 * ti + c32) * GL_TS + (16 * ks + 8 * hi) * 2);
                o[ti] = __builtin_amdgcn_mfma_f32_32x32x16_bf16(av, vt[ks], o[ti], 0, 0, 0); }
        }
    }
    __syncthreads();
#pragma unroll
    for (int ti = 0; ti < 2; ++ti)
#pragma unroll
        for (int r = 0; r < 16; ++r) *(LAS bf16_t*)(lds + GL_OST + (32 * ti + crow(r, hi)) * GL_OS + (32 * w + c32) * 2) = (bf16_t)(cvt_pk_bf16(o[ti][r], 0.f) & 0xffffu);
    __syncthreads();
    {
        const int t = tid >> 3, sg = tid & 7; const size_t tok = (size_t)(b * SEQ + chunk * 64 + t);
        u32x4 ov[4]; float ss = 0.f;
#pragma unroll
        for (int j = 0; j < 4; ++j) { ov[j] = *(const LAS u32x4*)(lds + GL_OST + t * GL_OS + sg * 64 + j * 16);
#pragma unroll
            for (int i = 0; i < 4; ++i) { const float x0 = bflo(ov[j][i]), x1 = bfhi(ov[j][i]); ss += x0 * x0 + x1 * x1; } }
        ss += __shfl_xor(ss, 1); ss += __shfl_xor(ss, 2); ss += __shfl_xor(ss, 4);
        const float rstd = 1.0f / sqrtf(ss * (1.0f / 256.0f) + EPS);
        const bf16_t* rap = proj + tok * NPROJ + C_RA + h * 256 + sg * 32; bf16_t* op = oab + tok * 2048 + h * 256 + sg * 32; const float* gp = ggo + sg * 32;
#pragma unroll
        for (int j = 0; j < 4; ++j) { const u32x4 ra = __builtin_nontemporal_load((const u32x4*)(rap + 8 * j)); const f32x4 g0 = *(const f32x4*)(gp + 8 * j), g1 = *(const f32x4*)(gp + 8 * j + 4); u32x4 wv;
#pragma unroll
            for (int i = 0; i < 4; ++i) { const float r0 = bflo(ra[i]), r1 = bfhi(ra[i]); const float ga = (i < 2) ? g0[2 * i] : g1[2 * i - 4], gb = (i < 2) ? g0[2 * i + 1] : g1[2 * i - 3];
                wv[i] = cvt_pk_bf16(bflo(ov[j][i]) * rstd * ga * (r0 * fsigmoid(r0)), bfhi(ov[j][i]) * rstd * gb * (r1 * fsigmoid(r1))); }
            *(u32x4*)(op + 8 * j) = wv; }
    }
    __syncthreads();
}
namespace moba {
constexpr int HD = 128;
constexpr float SCALE = 0.08838834764831845f;
constexpr float THR = 8.f;
constexpr int NW = 8, QBLK = 32, KVBLK = 64, QB = NW * QBLK;
constexpr int SHM_V = KVBLK * HD * 2, SHM_K = KVBLK * HD * 2;
constexpr int OFF_WS = 2 * SHM_V + 2 * SHM_K;
constexpr int OFF_RTAB = OFF_WS + NW * 64 * 4;
constexpr int OFF_KM = OFF_RTAB + 2400 * 4;
constexpr int OFF_MISC = OFF_KM + 8 * 128 * 4;
constexpr int OFF_SEL = OFF_MISC + 64;
constexpr int LDS_BYTES = OFF_SEL + 2048;
constexpr int LDP = NPROJ, LDO = 2048;

#define KSWZ(row, colB) ((row) * 256 + ((colB) ^ (((row) & 7) << 4)))
#define SBAR() __builtin_amdgcn_sched_barrier(0)
__device__ __forceinline__ int v_st(int k, int c) { const int kk = (k & ~0xC) | ((k & 4) << 1) | ((k & 8) >> 1); return ((kk >> 3) * 4 + (c >> 5)) * 512 + ((kk & 7) * 32 + (c & 31)) * 2; }
__device__ __forceinline__ int v_rd_base(int lane) { return ((lane & 3) << 3) | (((lane >> 2) & 3) << 6) | (((lane >> 4) & 1) << 5) | (((lane >> 5) & 1) << 8); }
constexpr int v_rd_off(int d0, int ks, int half) { return d0 * 512 + ks * 4096 + half * 2048; }
__device__ __forceinline__ int crow(int r, int hi) { return (r & 3) + 8 * (r >> 2) + 4 * hi; }
__device__ __forceinline__ unsigned cvtpk(float lo, float hi) { unsigned r; asm volatile("v_cvt_pk_bf16_f32 %0, %1, %2" : "=v"(r) : "v"(lo), "v"(hi)); return r; }

__device__ __forceinline__ void mask_tile(f32x16& p0, f32x16& p1, int dq) {
    const float NEG = -__builtin_inff();
#pragma unroll
    for (int r = 0; r < 16; ++r) {
        const int c = (r & 3) + 8 * (r >> 2);
        if (dq - c < 0) p0[r] = NEG;
        if (dq - c - 32 < 0) p1[r] = NEG;
    }
}
__device__ __forceinline__ void bias_tile(f32x16& p0, f32x16& p1, const LAS float* rt) {
#pragma unroll
    for (int r = 0; r < 16; ++r) { const int c = (r & 3) + 8 * (r >> 2); p0[r] += rt[c]; p1[r] += rt[c + 32]; }
}
__device__ __forceinline__ void kill_tile(f32x16& p0, f32x16& p1) {
    const float NEG = -__builtin_inff();
#pragma unroll
    for (int r = 0; r < 16; ++r) { p0[r] = NEG; p1[r] = NEG; }
}
__device__ __forceinline__ void partialSM(f32x16& p0, f32x16& p1, float& m_reg, float& mn, float& alpha) {
    float pmax = p0[0];
#pragma unroll
    for (int r = 1; r < 16; ++r) pmax = fmaxf(pmax, p0[r]);
#pragma unroll
    for (int r = 0; r < 16; ++r) pmax = fmaxf(pmax, p1[r]);
    { auto rr = __builtin_amdgcn_permlane32_swap(__float_as_uint(pmax), __float_as_uint(pmax), false, false);
      pmax = fmaxf(__uint_as_float(rr[0]), __uint_as_float(rr[1])); }
    constexpr float C2 = 1.4426950408889634f * SCALE;
    if (__builtin_expect(__all((pmax - m_reg) * SCALE <= THR), 1)) { mn = m_reg; alpha = 1.f; }
    else { mn = fmaxf(m_reg, pmax); alpha = __builtin_amdgcn_exp2f((m_reg - mn) * C2); m_reg = mn; }
    const float mnL = -mn * C2;
#pragma unroll
    for (int r = 0; r < 16; ++r) p0[r] = fmaf(p0[r], C2, mnL);
#pragma unroll
    for (int r = 0; r < 16; ++r) p1[r] = fmaf(p1[r], C2, mnL);
#pragma unroll
    for (int r = 0; r < 16; ++r) p0[r] = __builtin_amdgcn_exp2f(p0[r]);
}
__device__ __forceinline__ void finishSM(f32x16& p0, f32x16& p1, float alpha, float& l_reg, bf16x8& pa0, bf16x8& pa1, bf16x8& pa2, bf16x8& pa3) {
#pragma unroll
    for (int r = 0; r < 16; ++r) p1[r] = __builtin_amdgcn_exp2f(p1[r]);
    float ps = 0;
#pragma unroll
    for (int r = 0; r < 16; ++r) ps += p0[r];
#pragma unroll
    for (int r = 0; r < 16; ++r) ps += p1[r];
    { auto rr = __builtin_amdgcn_permlane32_swap(__float_as_uint(ps), __float_as_uint(ps), false, false);
      ps = __uint_as_float(rr[0]) + __uint_as_float(rr[1]); }
    l_reg = l_reg * alpha + ps;
#define PK4(P, B_, OUT) do { unsigned a0 = cvtpk(P[B_+0], P[B_+1]), a1 = cvtpk(P[B_+2], P[B_+3]);                          \
        unsigned b0 = cvtpk(P[B_+4], P[B_+5]), b1 = cvtpk(P[B_+6], P[B_+7]);                                             \
        auto r0 = __builtin_amdgcn_permlane32_swap(a0, b0, false, false); auto r1 = __builtin_amdgcn_permlane32_swap(a1, b1, false, false); \
        u32x4 w = {r0[0], r1[0], r0[1], r1[1]}; OUT = __builtin_bit_cast(bf16x8, w); } while (0)
    PK4(p0, 0, pa0); PK4(p0, 8, pa1); PK4(p1, 0, pa2); PK4(p1, 8, pa3);
#undef PK4
}
template <int KB>
__device__ __forceinline__ void qkt(f32x16& p0, f32x16& p1, const char* K_lds, int r32, int hi, const bf16x8* qr) {
#pragma unroll
    for (int r = 0; r < 16; ++r) { p0[r] = 0.f; p1[r] = 0.f; }
    const char* kb[4];
#pragma unroll
    for (int dd = 0; dd < 4; ++dd) kb[dd] = K_lds + KB * SHM_K + KSWZ(r32, (dd * 16 + hi * 8) * 2);
#pragma unroll
    for (int d0 = 0; d0 < 8; ++d0) { const char* a = kb[d0 & 3] + (d0 >> 2) * 128;
        bf16x8 b0 = *reinterpret_cast<const bf16x8*>(a);
        bf16x8 b1 = *reinterpret_cast<const bf16x8*>(a + 32 * 256);
        p0 = __builtin_amdgcn_mfma_f32_32x32x16_bf16(b0, qr[d0], p0, 0, 0, 0);
        p1 = __builtin_amdgcn_mfma_f32_32x32x16_bf16(b1, qr[d0], p1, 0, 0, 0); }
}
template <int VB>
__device__ __forceinline__ void pv_tile(f32x16* o, int vb0, bf16x8 pa0, bf16x8 pa1, bf16x8 pa2, bf16x8 pa3) {
#define TRRD(dst, off) asm volatile("ds_read_b64_tr_b16 %0, %1 offset:%2" : "=&v"(dst) : "v"(vb0), "i"(off) : "memory")
#define PV_D0(d0) do { s16x4 l0, l1, l2, l3, h0, h1, h2, h3; constexpr int b_ = VB * SHM_V + v_rd_off(d0, 0, 0);   \
        TRRD(l0, b_); TRRD(h0, b_ + 2048); TRRD(l1, b_ + 4096); TRRD(h1, b_ + 6144); TRRD(l2, b_ + 8192); TRRD(h2, b_ + 10240); TRRD(l3, b_ + 12288); TRRD(h3, b_ + 14336); \
        asm volatile("s_waitcnt lgkmcnt(0)" ::: "memory"); SBAR();   \
        o[d0] = __builtin_amdgcn_mfma_f32_32x32x16_bf16(pa0, (bf16x8){l0[0], l0[1], l0[2], l0[3], h0[0], h0[1], h0[2], h0[3]}, o[d0], 0, 0, 0);   \
        o[d0] = __builtin_amdgcn_mfma_f32_32x32x16_bf16(pa1, (bf16x8){l1[0], l1[1], l1[2], l1[3], h1[0], h1[1], h1[2], h1[3]}, o[d0], 0, 0, 0);   \
        o[d0] = __builtin_amdgcn_mfma_f32_32x32x16_bf16(pa2, (bf16x8){l2[0], l2[1], l2[2], l2[3], h2[0], h2[1], h2[2], h2[3]}, o[d0], 0, 0, 0);   \
        o[d0] = __builtin_amdgcn_mfma_f32_32x32x16_bf16(pa3, (bf16x8){l3[0], l3[1], l3[2], l3[3], h3[0], h3[1], h3[2], h3[3]}, o[d0], 0, 0, 0); } while (0)
    PV_D0(0); PV_D0(1); PV_D0(2); PV_D0(3);
#undef PV_D0
#undef TRRD
}

struct BlockRef { const bf16_t* Q; const bf16_t* K; const bf16_t* V; bf16_t* O; int qb; int b, h; };
struct Seam { bf16x8 qr[8]; bf16x8 st_v0, st_v1, st_k0, st_k1; };
#define VMW() asm volatile("s_waitcnt vmcnt(0)" ::: "memory")
#define VMWN(n) asm volatile("s_waitcnt vmcnt(%0)" :: "i"(n) : "memory")
#define LD8(p) (*reinterpret_cast<const bf16x8*>(p))
#define SLOAD_H(Kp, Vp, k0) do { const char* kb__ = (const char*)(Kp) + (size_t)(k0) * (LDP * 2); \
        S.st_v0 = LD8(kb__ + 2048 + kvoff); S.st_v1 = LD8(kb__ + (32 * LDP * 2 + 2048) + kvoff); S.st_k0 = LD8(kb__ + kvoff); S.st_k1 = LD8(kb__ + 32 * LDP * 2 + kvoff); } while (0)
#define SWRITE_HK(bf) do { *(bf16x8*)(K_lds + (bf) * SHM_K + kws) = S.st_k0; *(bf16x8*)(K_lds + (bf) * SHM_K + kws + 32 * 256) = S.st_k1; } while (0)
#define SWRITE_HV(bf) do { *(bf16x8*)(V_lds + (bf) * SHM_V + vst0) = S.st_v0; *(bf16x8*)(V_lds + (bf) * SHM_V + vst1) = S.st_v1; } while (0)
#define SWRITE_H(bf) do { SWRITE_HV(bf); SWRITE_HK(bf); } while (0)

__device__ __forceinline__ void prime(const BlockRef& cur, char* lds, Seam& S) {
    int tid = threadIdx.x; asm volatile("" : "+v"(tid));     const int wid = __builtin_amdgcn_readfirstlane(tid >> 6), lane = tid & 63, r32 = lane & 31, hi = lane >> 5;
    const int sr = tid >> 4, sc = (tid & 15) * 8, kws = KSWZ(sr, sc * 2); char* K_lds = lds + 2 * SHM_V;
    const unsigned kvoff = (unsigned)(sr * LDP + sc) * 2u, qvoff = (unsigned)(r32 * LDP + hi * 8) * 2u;
    { const char* qb__ = (const char*)cur.Q + (size_t)(wid * QBLK) * (LDP * 2);
#pragma unroll
    for (int d0 = 0; d0 < 8; ++d0) S.qr[d0] = LD8(qb__ + qvoff + d0 * 32); }
    SLOAD_H(cur.K, cur.V, 0); VMW(); SWRITE_HK(0);
    __syncthreads();
}
__device__ __forceinline__ int rel_bucket(int n) {
    if (n < 16) return n;
    const float nf = (float)n;
    int large = 16 + (int)(logf(nf / 16.0f) / 5.545177444479562f * 16.0f);
    return large < 31 ? large : 31;
}
__device__ __forceinline__ BlockRef make_ref(const P& a, int item);
__device__ __forceinline__ int block(const P& a, const BlockRef& cur, unsigned* queue, const float* rel_bias, const float* kmp, char* lds, Seam& S) {
    int tid = threadIdx.x; asm volatile("" : "+v"(tid));     const int wid = __builtin_amdgcn_readfirstlane(tid >> 6), lane = tid & 63, r32 = lane & 31, hi = lane >> 5;
    const int qb = cur.qb, NT = 4 * (qb + 1);
    const int qlo = qb * QB + wid * QBLK, qrow = qlo + r32;
    char* V_lds = lds; char* K_lds = lds + 2 * SHM_V;
    float* ws = (float*)(lds + OFF_WS) + wid * 64; float* li_l = ws, * al_l = ws + 32;
    LAS float* rtab = (LAS float*)(LAS char*)(uintptr_t)(unsigned)(uintptr_t)(lds + OFF_RTAB);
    float* kmL = (float*)(lds + OFF_KM);
    volatile int* misc = (volatile int*)(lds + OFF_MISC);
    if (tid == 0) misc[0] = (int)__hip_atomic_fetch_add(queue, 1u, __ATOMIC_RELAXED, __HIP_MEMORY_SCOPE_AGENT);
    for (int i = tid; i < 2400; i += NW * 64) { const int dist = 2047 - i; rtab[i] = dist >= 0 ? rel_bias[rel_bucket(dist) * 8 + cur.h] * (1.0f / SCALE) : -__builtin_inff(); }
    for (int i = tid; i < qb * 128; i += NW * 64) { const int j = i >> 7, dd = i & 127; const size_t o = ((size_t)(cur.b * 8 + j)) * 1024 + cur.h * 128 + dd;
        kmL[i] = (kmp[o] + kmp[o + 64 * 1024]) * (1.0f / 256.0f); }
    __syncthreads();
    const int next_item = __builtin_amdgcn_readfirstlane(misc[0]);
    const BlockRef nxt = next_item < 512 ? make_ref(a, next_item) : cur;
    unsigned selmask = 0;
    {
        float sc7[7];
#pragma unroll
        for (int j = 0; j < 7; ++j) { sc7[j] = -__builtin_inff();
            if (j < qb) { float acc = 0.f;
#pragma unroll
                for (int d0 = 0; d0 < 8; ++d0) { const u32x4 q4 = __builtin_bit_cast(u32x4, S.qr[d0]); const f32x4 k0 = *(const f32x4*)(kmL + j * 128 + d0 * 16 + hi * 8), k1 = *(const f32x4*)(kmL + j * 128 + d0 * 16 + hi * 8 + 4);
                    acc += bflo(q4[0]) * k0[0] + bfhi(q4[0]) * k0[1] + bflo(q4[1]) * k0[2] + bfhi(q4[1]) * k0[3] + bflo(q4[2]) * k1[0] + bfhi(q4[2]) * k1[1] + bflo(q4[3]) * k1[2] + bfhi(q4[3]) * k1[3]; }
                acc += __shfl_xor(acc, 32); sc7[j] = acc; } }
#pragma unroll
        for (int j = 0; j < 7; ++j) { int rank = 0;
#pragma unroll
            for (int i = 0; i < 7; ++i) { if (i != j) rank += (sc7[i] > sc7[j] || (sc7[i] == sc7[j] && i < j)) ? 1 : 0; }
            if (j < qb && (qb <= 3 || rank < 3)) selmask |= 1u << j; }
    }
    LAS unsigned* selp = (LAS unsigned*)(LAS char*)(uintptr_t)(unsigned)(uintptr_t)(lds + OFF_SEL) + tid;
    *selp = selmask;
    float m_reg = -1e30f, l_reg = 0; f32x16 o[4];
#pragma unroll
    for (int d = 0; d < 4; ++d)
#pragma unroll
        for (int r = 0; r < 16; ++r) o[d][r] = 0.f;
    const int sr = tid >> 4, sc = (tid & 15) * 8, vst0 = v_st(sr, sc), vst1 = v_st(32 + sr, sc), kws = KSWZ(sr, sc * 2);
    const unsigned kvoff = (unsigned)(sr * LDP + sc) * 2u;
    const int vb0 = (int)(uintptr_t)V_lds + v_rd_base(lane);
    const bf16_t* Kh = cur.K; const bf16_t* Vh = cur.V;
#define RESC(a) do { if (__any((a) < 1.f)) { if (hi == 0) al_l[r32] = (a); asm volatile("s_waitcnt lgkmcnt(0)" ::: "memory");              \
                     for (int d_ = 0; d_ < 4; ++d_) for (int r = 0; r < 16; ++r) o[d_][r] *= al_l[crow(r, hi)]; } } while (0)
#define KBASE(t) ((t) * KVBLK)
#define MASKT(P0_, P1_, t) do { const int kb_ = KBASE(t); const int jb_ = (t) >> 2; \
        const bool on_ = (jb_ == qb) || ((*selp >> jb_) & 1u); \
        bias_tile(P0_, P1_, on_ ? rtab + (kb_ + 4 * hi - qrow + 2047) : rtab + 2304); } while (0)
    constexpr int NQL = 8;
#define SEAM_K0() do { VMWN(NQL); SWRITE_HK(0); SBAR(); } while (0)
    f32x16 pA0, pA1, pB0, pB1; float mnA, mnB, alA, alB; bf16x8 pa0, pa1, pa2, pa3;
    SWRITE_HV(0); SBAR();
    if (NT > 1) { SLOAD_H(Kh, Vh, KBASE(1)); }
    SBAR(); qkt<0>(pA0, pA1, K_lds, r32, hi, S.qr);
    MASKT(pA0, pA1, 0); partialSM(pA0, pA1, m_reg, mnA, alA);
    if (NT > 1) { VMW(); SWRITE_H(1); }
    __syncthreads();
#define HALF_STEP(PX0, PX1, mnX, alX, PY0, PY1, alY, t, KB, VB, SB) do {                                                      \
        SBAR(); if ((t) + 1 < NT) { SLOAD_H(Kh, Vh, KBASE((t) + 1)); SBAR(); }      \
        qkt<KB>(PX0, PX1, K_lds, r32, hi, S.qr);                                             \
        finishSM(PY0, PY1, alY, l_reg, pa0, pa1, pa2, pa3); SBAR();                                                           \
        pv_tile<VB>(o, vb0, pa0, pa1, pa2, pa3); MASKT(PX0, PX1, (t)); partialSM(PX0, PX1, m_reg, mnX, alX);                                        \
        __syncthreads();                                                                                                      \
        if ((t) + 1 < NT) { VMW(); SWRITE_H(SB); }                                                                          \
        RESC(alX); __syncthreads(); } while (0)
    for (int t = 1; t + 1 < NT; t += 2) {
        HALF_STEP(pB0, pB1, mnB, alB, pA0, pA1, alA, t, 1, 0, 0);
        HALF_STEP(pA0, pA1, mnA, alA, pB0, pB1, alB, t + 1, 0, 1, 1);
    }
    { SBAR(); qkt<1>(pB0, pB1, K_lds, r32, hi, S.qr); SBAR(); }
    SLOAD_H(nxt.K, nxt.V, 0); SBAR();
    { const char* qb__ = (const char*)nxt.Q + (size_t)(wid * QBLK) * (LDP * 2); int l_ = lane; asm volatile("" : "+v"(l_));
      const unsigned qvoff = (unsigned)((l_ & 31) * LDP + (l_ >> 5) * 8) * 2u;
#pragma unroll
    for (int d0 = 0; d0 < 8; ++d0) S.qr[d0] = LD8(qb__ + qvoff + d0 * 32); }
    SBAR();
    finishSM(pA0, pA1, alA, l_reg, pa0, pa1, pa2, pa3); SBAR();
    pv_tile<0>(o, vb0, pa0, pa1, pa2, pa3);
    { MASKT(pB0, pB1, NT - 1); partialSM(pB0, pB1, m_reg, mnB, alB); __syncthreads(); RESC(alB);
      finishSM(pB0, pB1, alB, l_reg, pa0, pa1, pa2, pa3); SBAR(); pv_tile<1>(o, vb0, pa0, pa1, pa2, pa3); }
    SBAR(); SEAM_K0();
    if (hi == 0) li_l[r32] = l_reg; asm volatile("s_waitcnt lgkmcnt(0)" ::: "memory");
    float rli[16];
#pragma unroll
    for (int r = 0; r < 16; ++r) rli[r] = __builtin_amdgcn_rcpf(li_l[crow(r, hi)]);
    char* Ow = (char*)cur.O + (size_t)(wid * QBLK) * (LDO * 2); const unsigned ovoff = (unsigned)(4 * hi * LDO + r32) * 2u;
#pragma unroll
    for (int r = 0; r < 16; ++r) { const int orow0 = (r & 3) + 8 * (r >> 2);
#pragma unroll
        for (int d0 = 0; d0 < 4; ++d0) { const float v = o[d0][r] * rli[r];
            const float vn = __shfl_xor(v, 1);
            if ((r32 & 1) == 0) *(unsigned*)(Ow + (size_t)(orow0 * LDO * 2 + d0 * 64) + ovoff) = cvtpk(v, vn); } }
    __syncthreads();
    return next_item;
#undef RESC
#undef KBASE
#undef MASKT
#undef SEAM_K0
#undef HALF_STEP
}
#undef ROWP
#undef VMW
#undef VMWN
#undef LD8
#undef SLOAD_H
#undef SWRITE_HK
#undef SWRITE_HV
#undef SWRITE_H

__device__ __forceinline__ BlockRef make_ref(const P& a, int item) {
    const int qb = 7 - (item >> 6), bh = item & 63, b = bh >> 3, h = bh & 7;
    const bf16_t* proj = (const bf16_t*)(a.ws + WS_PROJ);
    BlockRef r; r.b = b; r.h = h; r.qb = qb;
    r.Q = proj + (size_t)(b * SEQ + qb * QB) * LDP + C_QB + h * HD;
    r.K = proj + (size_t)(b * SEQ) * LDP + C_KB + h * HD;
    r.V = proj + (size_t)(b * SEQ) * LDP + C_VB + h * HD;
    r.O = (bf16_t*)(a.ws + WS_OAB) + (size_t)(b * SEQ + qb * QB) * LDO + 1024 + h * HD;
    return r;
}
}
__device__ __forceinline__ void router_unit(const P& a, LAS unsigned char* lds, int unit) {
    int tid = threadIdx.x; asm volatile("" : "+v"(tid)); const int wave = __builtin_amdgcn_readfirstlane(tid >> 6), lane = tid & 63, c32 = lane & 31, hi = lane >> 5;
    const int tg = wave & 1, kq = wave >> 1;
    const bf16_t* x1 = (const bf16_t*)(a.ws + WS_X1); const float* g = a.in[11]; const float* br = a.in[13];
    unsigned char* A2 = a.ws + WS_A2; const u32x4* frag = (const u32x4*)(a.ws + WS_WRF);
    LAS float* Lw = (LAS float*)(lds + wave * 4352);
    LAS float* ssp = (LAS float*)(lds + 8 * 4352);
    LAS unsigned* hist = (LAS unsigned*)(lds + 8 * 4352 + 2048);
    LAS unsigned* base = hist + 32;
    if (tid < 32) hist[tid] = 0u;
    const int tok = unit * 64 + tg * 32 + c32;
    f32x16 L;
#pragma unroll
    for (int r = 0; r < 16; ++r) L[r] = 0.f;
    float ss = 0.f;
    const bf16_t* xr = x1 + (size_t)tok * D + 8 * hi + 256 * kq; unsigned char* ar = A2 + (size_t)tok * D + 8 * hi + 256 * kq; const float* gr = g + 8 * hi + 256 * kq;
#pragma unroll 4
    for (int s = 0; s < 16; ++s) {
        const u32x4 xw = *(const u32x4*)(xr + 16 * s); const f32x4 xa = {bflo(xw.x), bfhi(xw.x), bflo(xw.y), bfhi(xw.y)}, xb = {bflo(xw.z), bfhi(xw.z), bflo(xw.w), bfhi(xw.w)}, ga = *(const f32x4*)(gr + 16 * s), gb = *(const f32x4*)(gr + 16 * s + 4);
        ss += (xa.x * xa.x + xa.y * xa.y) + (xa.z * xa.z + xa.w * xa.w) + (xb.x * xb.x + xb.y * xb.y) + (xb.z * xb.z + xb.w * xb.w);
        const f32x4 va = xa * ga, vb = xb * gb;
        u32x4 wh; wh.x = cvt_pk_bf16(va.x, va.y); wh.y = cvt_pk_bf16(va.z, va.w); wh.z = cvt_pk_bf16(vb.x, vb.y); wh.w = cvt_pk_bf16(vb.z, vb.w);
        { u32x2 w8; w8.x = pk4_fp8(va.x, va.y, va.z, va.w); w8.y = pk4_fp8(vb.x, vb.y, vb.z, vb.w); *(u32x2*)(ar + 16 * s) = w8; }
        u32x4 wl; wl.x = cvt_pk_bf16(va.x - bflo(wh.x), va.y - bfhi(wh.x)); wl.y = cvt_pk_bf16(va.z - bflo(wh.y), va.w - bfhi(wh.y));
        wl.z = cvt_pk_bf16(vb.x - bflo(wh.z), vb.y - bfhi(wh.z)); wl.w = cvt_pk_bf16(vb.z - bflo(wh.w), vb.w - bfhi(wh.w));
        const bf16x8 ah = __builtin_bit_cast(bf16x8, wh), al = __builtin_bit_cast(bf16x8, wl);
        const bf16x8 bh = __builtin_bit_cast(bf16x8, frag[(16 * kq + s) * 64 + lane]), bl = __builtin_bit_cast(bf16x8, frag[4096 + (16 * kq + s) * 64 + lane]);
        L = __builtin_amdgcn_mfma_f32_32x32x16_bf16(ah, bh, L, 0, 0, 0);
        L = __builtin_amdgcn_mfma_f32_32x32x16_bf16(ah, bl, L, 0, 0, 0);
        L = __builtin_amdgcn_mfma_f32_32x32x16_bf16(al, bh, L, 0, 0, 0);
    }
#pragma unroll
    for (int r = 0; r < 16; ++r) Lw[((r & 3) + 8 * (r >> 2) + 4 * hi) * 33 + c32] = L[r];
    ssp[wave * 64 + lane] = ss;
    __syncthreads();
    int e4[4] = {0, 0, 0, 0}; float w4[4] = {0.f, 0.f, 0.f, 0.f}; unsigned loc[4] = {0u, 0u, 0u, 0u}; float rstd = 0.f;
    const bool sel = (wave < 2) && (hi == 0);
    if (sel) {
        float sst = 0.f;
#pragma unroll
        for (int q = 0; q < 4; ++q) sst += ssp[(wave + 2 * q) * 64 + c32] + ssp[(wave + 2 * q) * 64 + 32 + c32];
        rstd = 1.0f / sqrtf(sst * (1.0f / D) + EPS);
        float lg[32];
#pragma unroll
        for (int e = 0; e < 32; ++e) { const LAS float* lp = (const LAS float*)(lds + wave * 4352) + c32 * 33 + e; lg[e] = (lp[0] + lp[2 * 1088] + lp[4 * 1088] + lp[6 * 1088]) * rstd + br[e]; }
        unsigned used = 0u; float v4[4];
#pragma unroll
        for (int p = 0; p < 4; ++p) { float best = -__builtin_inff(); int bi = 0;
#pragma unroll
            for (int e = 0; e < 32; ++e) { const bool take = !((used >> e) & 1u) && lg[e] > best; best = take ? lg[e] : best; bi = take ? e : bi; }
            used |= 1u << bi; e4[p] = bi; v4[p] = best; }
        float sum = 0.f;
#pragma unroll
        for (int p = 0; p < 4; ++p) { w4[p] = expf(v4[p] - v4[0]); sum += w4[p]; }
        const float inv = 1.0f / sum;
#pragma unroll
        for (int p = 0; p < 4; ++p) { w4[p] *= inv; loc[p] = __hip_atomic_fetch_add(hist + e4[p], 1u, __ATOMIC_RELAXED, __HIP_MEMORY_SCOPE_WORKGROUP); }
    }
    __syncthreads();
    if (tid < 32) base[tid] = __hip_atomic_fetch_add((unsigned*)(a.ws + WS_CTL) + CW_COUNTS + tid, hist[tid], RLX_AGENT);
    __syncthreads();
    if (sel) {
        int* tope = (int*)(a.ws + WS_TOPE) + (size_t)tok * 4; float* wts = (float*)(a.ws + WS_WTS) + (size_t)tok * 4; int* slot = (int*)(a.ws + WS_SLOT) + (size_t)tok * 4;
#pragma unroll
        for (int p = 0; p < 4; ++p) { const int sl_ = (int)(base[e4[p]] + loc[p]); tope[p] = e4[p]; wts[p] = w4[p]; slot[p] = sl_;
            ((int*)(a.ws + WS_ROWE))[(size_t)e4[p] * T + sl_] = tok; ((float*)(a.ws + WS_RSTE))[(size_t)e4[p] * T + sl_] = rstd; }
    }
    __syncthreads();
}

__device__ __forceinline__ void moe_tables(const P& a, LAS unsigned char* lds) {
    int tid = threadIdx.x; asm volatile("" : "+v"(tid)); const int wave = tid >> 6, lane = tid & 63, e = lane & 31;
    LAS int* pstart = (LAS int*)(lds + LDS_MOE); LAS int* cnt = pstart + 64; LAS int* tile_e = pstart + 128;
    const unsigned* counts = (const unsigned*)(a.ws + WS_CTL) + CW_COUNTS;
    const int c = (int)counts[e]; const int p = ((c + 255) >> 8) << 8; int inc = p;
#pragma unroll
    for (int o = 1; o < 32; o <<= 1) { const int t = __builtin_amdgcn_ds_bpermute(((lane - o) & 63) << 2, inc); if (e >= o) inc += t; }
    if (tid < 32) { cnt[e] = c; pstart[e] = inc - p; if (e == 31) { pstart[32] = inc; tile_e[MAXTILES] = inc >> 8; } }
    for (int t = wave * 36; t < wave * 36 + 36; ++t) { const unsigned long long m = __ballot(inc <= t * 256); const int ee = __builtin_popcount((unsigned)m); if (lane == 0) tile_e[t] = ee < NE ? ee : NE - 1; }
    __syncthreads();
}

__device__ __forceinline__ void combine_rows(const P& a, LAS unsigned char* lds, int vcu, int G, int wave, int lane) {
    const LAS int* pstart = (const LAS int*)(lds + LDS_MOE);
    const int gw = vcu * NWAVES + wave, NGW = G * NWAVES;
    const bf16_t* X1 = (const bf16_t*)(a.ws + WS_X1); float* X = (float*)(a.ws + WS_X2); const unsigned char* Y = a.ws + WS_YROWS; bf16_t* A3 = (bf16_t*)(a.ws + WS_H);
    const int* tope = (const int*)(a.ws + WS_TOPE); const int* slot = (const int*)(a.ws + WS_SLOT); const float* wts = (const float*)(a.ws + WS_WTS); const float* g = a.in[20];
    f32x4 gv[4];
#pragma unroll
    for (int j = 0; j < 4; ++j) gv[j] = *((const f32x4*)g + lane + 64 * j);
    for (int m = gw; m < T; m += NGW) {
        f32x4* xr = (f32x4*)(X + (size_t)m * D) + lane; const u32x2* x1r = (const u32x2*)(X1 + (size_t)m * D) + lane; f32x4 v[4];
#pragma unroll
        for (int j = 0; j < 4; ++j) { const u32x2 xq = __builtin_nontemporal_load(x1r + 64 * j); v[j] = (f32x4){bflo(xq.x), bfhi(xq.x), bflo(xq.y), bfhi(xq.y)}; }
#pragma unroll
        for (int k = 0; k < 4; ++k) { const int d = __builtin_amdgcn_readfirstlane(pstart[tope[m * 4 + k]] + slot[m * 4 + k]); const float w = __uint_as_float(__builtin_amdgcn_readfirstlane(__float_as_uint(wts[m * 4 + k])));
            const unsigned* yr = (const unsigned*)(Y + (size_t)d * D) + lane;
#pragma unroll
            for (int j = 0; j < 4; ++j) { const int y = (int)__builtin_nontemporal_load(yr + 64 * j);
                v[j].x += w * __builtin_amdgcn_cvt_f32_fp8(y, 0); v[j].y += w * __builtin_amdgcn_cvt_f32_fp8(y, 1); v[j].z += w * __builtin_amdgcn_cvt_f32_fp8(y, 2); v[j].w += w * __builtin_amdgcn_cvt_f32_fp8(y, 3); } }
        float s = 0.f;
#pragma unroll
        for (int j = 0; j < 4; ++j) s += (v[j].x * v[j].x + v[j].y * v[j].y) + (v[j].z * v[j].z + v[j].w * v[j].w);
        const float rstd = 1.0f / sqrtf(wave_sum(s) * (1.0f / D) + EPS);
        unsigned* o4 = (unsigned*)((unsigned char*)A3 + (size_t)m * D) + lane;
#pragma unroll
        for (int j = 0; j < 4; ++j) { xr[64 * j] = v[j]; o4[64 * j] = pk4_fp8(v[j].x * rstd * gv[j].x, v[j].y * rstd * gv[j].y, v[j].z * rstd * gv[j].z, v[j].w * rstd * gv[j].w); }
    }
}
__device__ __forceinline__ void final_rows(const P& a, int vcu, int G, int wave, int lane) {
    const int gw = vcu * NWAVES + wave, NGW = G * NWAVES;
    const float* X = (const float*)(a.ws + WS_X2); float* OUT = a.out; const bf16_t* PG = (const bf16_t*)(a.ws + WS_PGATE); const bf16_t* PP = (const bf16_t*)(a.ws + WS_PPROJ);
    f32x4 gp[4], gf[4];
#pragma unroll
    for (int j = 0; j < 4; ++j) { gp[j] = *((const f32x4*)a.in[23] + lane + 64 * j); gf[j] = *((const f32x4*)a.in[24] + lane + 64 * j); }
    for (int m = gw; m < T; m += NGW) {
        const f32x4* xr = (const f32x4*)(X + (size_t)m * D) + lane; f32x4* orow = (f32x4*)(OUT + (size_t)m * D) + lane; const u32x2* pgr = (const u32x2*)(PG + (size_t)m * D) + lane; const u32x2* ppr = (const u32x2*)(PP + (size_t)m * D) + lane;
        f32x4 v[4], pp[4], pg[4]; float sp = 0.f;
#pragma unroll
        for (int j = 0; j < 4; ++j) { v[j] = __builtin_nontemporal_load(xr + 64 * j); const u32x2 q = __builtin_nontemporal_load(ppr + 64 * j), gq = __builtin_nontemporal_load(pgr + 64 * j);
            pp[j] = (f32x4){bflo(q.x), bfhi(q.x), bflo(q.y), bfhi(q.y)}; pg[j] = (f32x4){bflo(gq.x), bfhi(gq.x), bflo(gq.y), bfhi(gq.y)};
            sp += (pp[j].x * pp[j].x + pp[j].y * pp[j].y) + (pp[j].z * pp[j].z + pp[j].w * pp[j].w); }
        const float rp = 1.0f / sqrtf(wave_sum(sp) * (1.0f / D) + EPS); float s = 0.f;
#pragma unroll
        for (int j = 0; j < 4; ++j) { v[j] = v[j] + pg[j] * (pp[j] * rp * gp[j]); s += (v[j].x * v[j].x + v[j].y * v[j].y) + (v[j].z * v[j].z + v[j].w * v[j].w); }
        const float rstd = 1.0f / sqrtf(wave_sum(s) * (1.0f / D) + EPS);
#pragma unroll
        for (int j = 0; j < 4; ++j) __builtin_nontemporal_store(v[j] * rstd * gf[j], orow + 64 * j);
    }
}
struct Args { P p; };
template <int PH_LO, int PH_HI>
__global__ void __launch_bounds__(NTHREADS, 2) hybrid_fwd(Args args) {
    extern __shared__ __attribute__((aligned(16))) unsigned char lds_raw[];
    LAS unsigned char* lds = (LAS unsigned char*)lds_raw;
    const P& a = args.p;
    const int tid = threadIdx.x;
#define FRESH_WL() int t_ = threadIdx.x; asm volatile("" : "+v"(t_)); const int w_ = __builtin_amdgcn_readfirstlane(t_ >> 6), l_ = t_ & 63
    const int G = gridDim.x; const int bx = blockIdx.x; const int vcu = (G % 8 == 0) ? (bx % 8) * (G / 8) + bx / 8 : bx;
    unsigned* ctl = (unsigned*)(a.ws + WS_CTL);
    for (int u = tid; u < (LDS_BYTES - LDSCTL_OFF) / 4; u += NTHREADS) ((LAS unsigned*)(lds + LDSCTL_OFF))[u] = 0u;
    __syncthreads();
#if MK_PER_PHASE
#define GRID_BAR() do { } while (0)
#else
    XcdBarrier bar = xcd_barrier_post(ctl + CW_BAR, (volatile LAS unsigned*)(lds + MISC_OFF + 32));
#define GRID_BAR() xcd_barrier(bar)
#endif
    constexpr int lo = PH_LO, hi = PH_HI;
#define IN(k) (lo <= (k) && (k) < hi)
#define SEAM(k) do { if constexpr (IN(k) && IN((k) + 1)) GRID_BAR(); } while (0)
    unsigned char* ws = a.ws;

    if constexpr (IN(0)) { FRESH_WL(); p0_prologue(a, lds, vcu, G, w_, l_); }
    SEAM(0);
    if constexpr (IN(1)) {
        pg8::DenseSched S; S.o.init(T / 256, NPROJ / 256, G, bx); S.Bt = (const char*)(ws + WS_WIN); S.K = D;
        pg8::EpiProj<false> E{(bf16_t*)(ws + WS_PROJ), (float*)(ws + WS_KMP)};
        pg8::gemm_phase(lds, (const char*)(ws + WS_H), D, D, D, S, E);
    }
    SEAM(1);
    if constexpr (IN(2)) { for (int u = vcu; u < NB * 32; u += G) gla_prep_unit(a, lds, u); }
    SEAM(2);
    if constexpr (IN(3)) { for (int u = vcu; u < 512; u += G) gla_combine_unit(a, u); }
    SEAM(3);
    if constexpr (IN(4)) {
        for (int u = vcu; u < 1024; u += G) gla_out_unit(a, lds, u);
        __syncthreads();
    }
    if constexpr (IN(5)) {
        if ((vcu & 1) == 0) { FRESH_WL(); expert_convert(a, lds, vcu >> 1, G >> 1, w_, l_); __syncthreads(); }
        unsigned* queue = ctl + CW_QUEUE;
        volatile LAS int* qslot = (volatile LAS int*)(lds + LDSCTL_OFF + 1024);
        if (tid == 0) qslot[0] = (int)__hip_atomic_fetch_add(queue, 1u, RLX_AGENT);
        __syncthreads();
        int item = __builtin_amdgcn_readfirstlane(qslot[0]);
        if (item < 512) {
            moba::Seam S;
            moba::BlockRef cur = moba::make_ref(a, item);
            moba::prime(cur, (char*)lds_raw, S);
            for (;;) {
                const int nitem = moba::block(a, cur, queue, a.in[2], (const float*)(ws + WS_KMP), (char*)lds_raw, S);
                if (nitem >= 512) break;
                cur = moba::make_ref(a, nitem);
            }
        }
    }
    SEAM(5);
    if constexpr (IN(6)) {
        pg8::ChainSched S; S.o.init(T / 256, D / 256, G, bx); S.Bt = (const char*)(ws + WS_WUP); S.K = 1024;
        pg8::EpiMerge E{(const bf16_t*)(ws + WS_PROJ), (bf16_t*)(ws + WS_Y)};
        pg8::gemm_phase(lds, (const char*)(ws + WS_OAB), 1024, 2048, 2048, S, E);
    }
    SEAM(6);
    if constexpr (IN(7)) {
        pg8::DenseSched S; S.o.init(T / 256, D / 256, G, bx); S.Bt = (const char*)(ws + WS_WO); S.K = D;
        pg8::EpiResF32 E{a.in[0], (bf16_t*)(ws + WS_X1)};
        pg8::gemm_phase(lds, (const char*)(ws + WS_Y), D, D, D, S, E);
    }
    SEAM(7);
    if constexpr (IN(8)) { for (int u = vcu; u < T / 64; u += G) router_unit(a, lds, u); }
    SEAM(8);
    if constexpr (IN(9)) {
        moe_tables(a, lds); const LAS int* tab = (const LAS int*)(lds + LDS_MOE); const int ntile = __builtin_amdgcn_readfirstlane(tab[128 + MAXTILES]);
        pg8::MoeSched<true> S; S.o.init(ntile, 8, G, bx); S.Bt = (const char*)a.out; S.K = D; S.rows_per_e = 2048; S.tab = tab; S.row_e = (const int*)(ws + WS_ROWE); S.es = 1;
        pg8::EpiGlu E{(unsigned char*)(ws + WS_HMID), (const float*)(ws + WS_RSTE), tab, a.in[15], a.in[17], (const float*)(ws + WS_CTL) + 131072, lds};
        pg8::gemm_phase(lds, (const char*)(ws + WS_A2), D, D, D, S, E);
        const int extra = (ntile * 8) % G, nidle = G - extra;
        if (bx >= extra) { __syncthreads();
            pg8::DenseSched S2; S2.o.init(T / 256, D / 256, nidle, bx - extra); S2.Bt = (const char*)(ws + WS_WPP); S2.K = 256;
            pg8::EpiBf16<0, false> E2{(bf16_t*)(ws + WS_PPROJ), D, nullptr, 0, 1.0f};
            pg8::gemm_phase(lds, (const char*)(ws + WS_PB), 256, 256, 256, S2, E2); }
    }
    SEAM(9);
    if constexpr (IN(10)) {
        moe_tables(a, lds); const LAS int* tab = (const LAS int*)(lds + LDS_MOE); const int ntile = __builtin_amdgcn_readfirstlane(tab[128 + MAXTILES]);
        pg8::MoeSched<false> S; S.o.init(ntile, 4, G, bx); S.Bt = (const char*)(ws + WS_W2T); S.K = FF; S.rows_per_e = 1024; S.tab = tab; S.row_e = nullptr; S.es = 1;
        pg8::EpiDownF8 E{(unsigned char*)(ws + WS_YROWS), a.in[19]};
        pg8::gemm_phase(lds, (const char*)(ws + WS_HMID), FF, FF, FF, S, E);
    }
    SEAM(10);
    if constexpr (IN(11)) { moe_tables(a, lds); FRESH_WL(); combine_rows(a, lds, vcu, G, w_, l_); }
    SEAM(11);
    if constexpr (IN(12)) {
        { pg8::DenseSched S; S.o.init(T / 256, D / 256, G, bx); S.Bt = (const char*)(ws + WS_WPG); S.K = D; S.es = 1;
          pg8::EpiBf16<1, false, true> E{(bf16_t*)(ws + WS_PGATE), D, nullptr, 0, 1.0f / 32.0f};
          pg8::gemm_phase(lds, (const char*)(ws + WS_H), D, D, D, S, E); }
    }
    SEAM(12);
    if constexpr (IN(13)) { FRESH_WL(); final_rows(a, vcu, G, w_, l_); }
#undef FRESH_WL
#undef IN
#undef SEAM
#undef GRID_BAR
}

template <int LO, int HI> static void launch_range(const Args& a, int grid, hipStream_t stream) {
    static bool attr = false;
    if (!attr) { attr = true; if (hipFuncSetAttribute((const void*)hybrid_fwd<LO, HI>, hipFuncAttributeMaxDynamicSharedMemorySize, LDS_BYTES) != hipSuccess) fprintf(stderr, "kernel_launch: hipFuncSetAttribute failed\n"); }
    hipLaunchKernelGGL((hybrid_fwd<LO, HI>), dim3(grid), dim3(NTHREADS), LDS_BYTES, stream, a);
}
extern "C" void kernel_launch(void* const* d_in, const int* in_sizes, int n_in, void* d_out, int out_size, void* d_ws, size_t ws_size, hipStream_t stream) {
    static int grid = 0;
    if (grid == 0) {
        static const int expect[25] = {T * D, T * 256, 256, 1024, 1024 * D_IN, 16 * 512, 512, 256, 1048576, 1048576, 1048576, 1024, 32768, 32, 33554432, 32768, 33554432, 32768, 33554432, 32768, 1024, 1048576, 262144, 1024, 1024};
        bool okk = (n_in == 25);
        for (int i = 0; okk && i < 25; ++i) if (in_sizes[i] != expect[i]) { fprintf(stderr, "kernel_launch: input %d has %d elements, expected %d\n", i, in_sizes[i], expect[i]); okk = false; }
        if (!okk || out_size != T * D || ws_size < WS_END) { fprintf(stderr, "kernel_launch: unexpected shapes (n_in %d, in0 %d, out %d, ws %zu); nothing launched\n", n_in, n_in > 0 ? in_sizes[0] : -1, out_size, ws_size); grid = -1; return; }
        int dev = 0, cus = 0;
        if (hipGetDevice(&dev) != hipSuccess || hipDeviceGetAttribute(&cus, hipDeviceAttributeMultiprocessorCount, dev) != hipSuccess) { grid = -1; return; }
        grid = cus;
    }
    if (grid < 0) return;
    (void)hipMemsetAsync((char*)d_ws + WS_CTL, 0, CTL_ZERO_BYTES, stream);
    Args a{};
    for (int i = 0; i < 25; ++i) a.p.in[i] = (const float*)d_in[i];
    a.p.out = (float*)d_out; a.p.ws = (unsigned char*)d_ws;
#if MK_PER_PHASE
#ifndef MK_LAST
#define MK_LAST 13
#endif
#ifndef MK_REPEAT
#define MK_REPEAT 0
#endif
#define LR(k) do { if ((k) <= MK_LAST) for (int r_ = 0; r_ < 1 + ((MK_REPEAT >> (k)) & 1); ++r_) launch_range<(k), (k) + 1>(a, grid, stream); } while (0)
    LR(0); LR(1); LR(2); LR(3); LR(4); LR(5); LR(6); LR(7); LR(8); LR(9); LR(10); LR(11); LR(12); LR(13);
#undef LR
#else
    launch_range<0, NPHASES>(a, grid, stream);
#endif
}
```

```cpp
#include <hip/hip_runtime.h>
#include <cstdio>
#include <cstdint>

#define LAS __attribute__((address_space(3)))
#define GAS __attribute__((address_space(1)))
typedef unsigned short bf16_t;
typedef short bf16x8 __attribute__((ext_vector_type(8)));
typedef short s16x4 __attribute__((ext_vector_type(4)));
typedef float f32x2 __attribute__((ext_vector_type(2)));
typedef float f32x4 __attribute__((ext_vector_type(4)));
typedef float f32x16 __attribute__((ext_vector_type(16)));
typedef unsigned u32x2 __attribute__((ext_vector_type(2)));
typedef unsigned u32x4 __attribute__((ext_vector_type(4)));
typedef int i32x4 __attribute__((ext_vector_type(4)));
typedef int i32x8 __attribute__((ext_vector_type(8)));
typedef GAS unsigned gu32;
#define RLX_AGENT __ATOMIC_RELAXED, __HIP_MEMORY_SCOPE_AGENT
#define LDS_WAIT() asm volatile("s_waitcnt lgkmcnt(0)" ::: "memory")
#define VM_WAIT() asm volatile("s_waitcnt vmcnt(0)" ::: "memory")

#ifndef MK_PER_PHASE
#define MK_PER_PHASE 0
#endif

constexpr int NB = 8, SEQ = 2048, T = NB * SEQ, D = 1024;
constexpr int NPROJ = 8192;
constexpr int C_QA = 0, C_KA = 512, C_VA = 1024, C_RA = 2048, C_QB = 3072, C_KB = 4096, C_VB = 5120, C_GA = 6144, C_GB = 7168;
constexpr int SRC_ALOW = 3072, D_IN = 8208;
constexpr int NE = 32, FF = 1024, MAXTILES = 288, MAXROWS = MAXTILES * 256;
constexpr float EPS = 1e-6f;
constexpr int NWAVES = 8, NTHREADS = 512;
constexpr int NPHASES = 14;

constexpr size_t MiB = 1u << 20;
constexpr size_t WS_CTL = 0, CTL_ZERO_BYTES = 1 * MiB;
constexpr size_t WS_SMALL = 1 * MiB;
constexpr size_t WS_KMP   = WS_SMALL;
constexpr size_t WS_DEC   = WS_KMP + 512 * 1024;
constexpr size_t WS_TOPE  = WS_DEC + 512 * 1024;
constexpr size_t WS_WTS   = WS_TOPE + 256 * 1024;
constexpr size_t WS_SLOT  = WS_WTS + 256 * 1024;
constexpr size_t WS_DEST  = WS_SLOT + 256 * 1024;
constexpr size_t WS_ROWTOK = WS_DEST + 256 * 1024;
constexpr size_t WS_RSTDS = WS_ROWTOK + 320 * 1024;
constexpr size_t WS_RSTD  = WS_RSTDS + 320 * 1024;
constexpr size_t WS_TILEE = WS_RSTD + 64 * 1024;
constexpr size_t WS_WALT  = WS_TILEE + 4 * 1024;
constexpr size_t WS_WRF   = WS_WALT + 32 * 1024;
static_assert(WS_WRF + 128 * 1024 <= 6 * MiB, "small map");
constexpr size_t WS_WO = 6 * MiB, WS_WPG = 8 * MiB, WS_WPP = 10 * MiB, WS_WUP = 12 * MiB, WS_WIN = 16 * MiB;
constexpr size_t WS_PB = 34 * MiB;
constexpr size_t WS_H  = 42 * MiB;
constexpr size_t WS_PROJ = 74 * MiB;
constexpr size_t WS_QG = 330 * MiB, WS_KG = 346 * MiB;
constexpr size_t WS_SLOC = 426 * MiB;
constexpr size_t WS_OAB = 362 * MiB;
constexpr size_t WS_H8 = 426 * MiB;
constexpr size_t WS_WIN8 = 442 * MiB;
constexpr size_t WS_Y = 330 * MiB;
constexpr size_t WS_W2T = 42 * MiB;
constexpr size_t WS_A2 = 330 * MiB;
constexpr size_t WS_HMID = 138 * MiB;
constexpr size_t WS_X1 = 74 * MiB;
constexpr size_t WS_X2 = 138 * MiB;
constexpr size_t WS_YROWS = 282 * MiB;
constexpr size_t WS_PGATE = 330 * MiB, WS_PPROJ = 226 * MiB;
constexpr size_t WS_ROWE = 490 * MiB;
constexpr size_t WS_RSTE = 492 * MiB;
constexpr size_t WS_END = 506 * MiB;

constexpr int CW_BAR = 4096;
constexpr int CW_COUNTS = 16384;
constexpr int CW_QUEUE = 16384 + 64;

constexpr int RING_BYTES = 131072;
constexpr int LDSCTL_OFF = RING_BYTES, MISC_OFF = LDSCTL_OFF + 320;
constexpr int LDS_MOE = LDSCTL_OFF + 10240;
constexpr int EPF_OFF = LDSCTL_OFF + 12288;
constexpr int LDS_BYTES = 151552;

typedef __bf16 bf16v2_t __attribute__((ext_vector_type(2)));
__device__ __forceinline__ unsigned cvt_pk_bf16(float lo, float hi) { const f32x2 v = {lo, hi}; return __builtin_bit_cast(unsigned, __builtin_convertvector(v, bf16v2_t)); }
__device__ __forceinline__ unsigned pk4_fp8(float a, float b, float c, float d) { int w = 0; w = __builtin_amdgcn_cvt_pk_fp8_f32(a, b, w, false); w = __builtin_amdgcn_cvt_pk_fp8_f32(c, d, w, true); return (unsigned)w; }
__device__ __forceinline__ float bf2f(unsigned short s) { return __uint_as_float(((unsigned)s) << 16); }
__device__ __forceinline__ float bflo(unsigned w) { return __uint_as_float(w << 16); }
__device__ __forceinline__ float bfhi(unsigned w) { return __uint_as_float(w & 0xffff0000u); }
__device__ __forceinline__ float fsigmoid(float x) { return __builtin_amdgcn_rcpf(1.0f + __builtin_amdgcn_exp2f(-1.4426950408889634f * x)); }
__device__ __forceinline__ float wave_sum(float v) {
#pragma unroll
    for (int o = 1; o < 64; o <<= 1) v += __shfl_xor(v, o);
    return v;
}
__device__ __forceinline__ bf16x8 pack8(f32x4 a, f32x4 b) {
    u32x4 w = {cvt_pk_bf16(a[0], a[1]), cvt_pk_bf16(a[2], a[3]), cvt_pk_bf16(b[0], b[1]), cvt_pk_bf16(b[2], b[3])};
    return __builtin_bit_cast(bf16x8, w);
}

#define XB_TMO      128
#define XB_XCNT(j)  (256  + 64 * (j))
#define XB_XSUB(j)  (1280 + 64 * (j))
#define XB_XGEN(j)  (2304 + 64 * (j))
#define XB_TOP      3328
#define XB_TOPGEN   3392
#define XCD_BAR_WORDS 3456
#define XB_SPIN_CAP (1u << 18)

__device__ __forceinline__ unsigned xb_ld(unsigned* p)              { return __hip_atomic_load(p, __ATOMIC_RELAXED, __HIP_MEMORY_SCOPE_AGENT); }
__device__ __forceinline__ unsigned xb_add(unsigned* p, unsigned v) { return __hip_atomic_fetch_add(p, v, __ATOMIC_RELAXED, __HIP_MEMORY_SCOPE_AGENT); }
__device__ __forceinline__ unsigned xb_xcc_id() { return (unsigned)__builtin_amdgcn_s_getreg((3 << 11) | 20) & 0xFu; }
#define XB_SPIN(cond, bar) do { unsigned _sp = 0; while (cond) { __builtin_amdgcn_s_sleep(1); \
    if ((++_sp & 255u) == 0u) { if (xb_ld(&(bar)[XB_TMO])) break; if (_sp > XB_SPIN_CAP) { atomicAdd(&(bar)[XB_TMO], 1u); break; } } } } while (0)

struct XcdBarrier { unsigned* bar; unsigned x; volatile LAS unsigned* st; };

__device__ __forceinline__ XcdBarrier xcd_barrier_post(unsigned* bar, volatile LAS unsigned* st) {
    XcdBarrier b; b.bar = bar; b.x = xb_xcc_id(); b.st = st;
    if (threadIdx.x == 0) (void)xb_add(&bar[XB_XCNT(b.x)], 1u);
    return b;
}
__device__ __forceinline__ void xcd_barrier_complete(unsigned* bar, unsigned x, unsigned& nloc, unsigned& nx) {
    const unsigned G = gridDim.x * gridDim.y * gridDim.z;
    unsigned sum, cnt, mine, sp = 0u;
    for (;;) {
        sum = 0u; cnt = 0u; mine = 0u;
#pragma unroll
        for (unsigned j = 0; j < 16; ++j) { const unsigned c = xb_ld(&bar[XB_XCNT(j)]); sum += c; cnt += (c > 0u) ? 1u : 0u; mine = (j == x) ? c : mine; }
        if (sum == G) break;
        __builtin_amdgcn_s_sleep(1);
        if ((++sp & 255u) == 0u) { if (xb_ld(&bar[XB_TMO])) break; if (sp > XB_SPIN_CAP) { atomicAdd(&bar[XB_TMO], 1u); break; } }
    }
    nloc = mine > 0u ? mine : 1u; nx = cnt > 0u ? cnt : 1u;
}
__device__ __forceinline__ void xcd_barrier(const XcdBarrier& b) {
    asm volatile("s_waitcnt vmcnt(0)" ::: "memory");
    __syncthreads();
    if (threadIdx.x == 0) {
        unsigned* bar = b.bar;
        __builtin_amdgcn_s_waitcnt(0);
        unsigned nloc = b.st[0], nx = b.st[1];
        if (nloc == 0u) { xcd_barrier_complete(bar, b.x, nloc, nx); b.st[0] = nloc; b.st[1] = nx; }
        const unsigned old = xb_add(&bar[XB_XSUB(b.x)], 1u);
        const unsigned gen = old / nloc;
        if (old + 1u == (gen + 1u) * nloc) {
            __builtin_amdgcn_fence(__ATOMIC_RELEASE, "agent");
            asm volatile("s_waitcnt vmcnt(0)" ::: "memory");
            const unsigned og = xb_add(&bar[XB_TOP], 1u);
            const unsigned tg = og / nx;
            if (og + 1u == (tg + 1u) * nx) xb_add(&bar[XB_TOPGEN], 1u);
            else XB_SPIN(xb_ld(&bar[XB_TOPGEN]) == tg, bar);
            __builtin_amdgcn_fence(__ATOMIC_ACQUIRE, "agent");
            xb_add(&bar[XB_XGEN(b.x)], 1u);
            asm volatile("s_waitcnt vmcnt(0)" ::: "memory");
        } else {
            XB_SPIN(xb_ld(&bar[XB_XGEN(b.x)]) == gen, bar);
            __builtin_amdgcn_fence(__ATOMIC_ACQUIRE, "agent");
            asm volatile("s_waitcnt vmcnt(0)" ::: "memory");
        }
    }
    __syncthreads();
}
#ifndef MK_SCL
#define MK_SCL 0
#endif
namespace pg8 {
constexpr int BM = 256, BK = 64, HALF = 128, HTB = HALF * BK * 2, STAGE_BYTES = 8 * HTB, NXCD = 8, WGM = 8;

__host__ __device__ __forceinline__ int lds_byte(int r, int c) { const int st = (r >> 4) * 2 + (c >> 5), rr = r & 15, cc = c & 31, ob = rr * 64 + cc * 2; return st * 1024 + (ob ^ (((ob >> 9) & 1) << 5)); }
__host__ __device__ __forceinline__ void stage_rc(int b, int& R, int& C) { const int st = b / 1024, sb = b % 1024, swz = sb ^ (((sb >> 9) & 1) << 5); R = (st >> 1) * 16 + swz / 64; C = (st & 1) * 32 + (swz % 64) / 2; }
__host__ __device__ __forceinline__ int perm32(int rho) { const int n = rho >> 4, i = rho & 15; return 8 * (i >> 2) + 4 * n + (i & 3); }

struct Unit { int pm, pn, e, s; };

struct TileOrder {
    int nM, nN, nwg, G, c;
    __device__ __forceinline__ void init(int nM_, int nN_, int G_, int c_) { nM = nM_; nN = nN_; nwg = nM * nN; G = G_; c = c_; }
    __device__ __forceinline__ bool next(int i, int& pm, int& pn) const {
        const unsigned L = (unsigned)i * (unsigned)G + (unsigned)c; if (L >= (unsigned)nwg) return false;
        int wgid = (int)L; { const int q = nwg / NXCD, r = nwg % NXCD, xcd = wgid % NXCD, off = wgid / NXCD; wgid = (xcd < r ? xcd * (q + 1) : r * (q + 1) + (xcd - r) * q) + off; }
        const int nig = WGM * nN, gid = wgid / nig, fm = gid * WGM, gsz = (nM - fm) < WGM ? (nM - fm) : WGM;
        pm = fm + ((wgid % nig) % gsz); pn = (wgid % nig) / gsz; return true;
    }
};
struct DenseSched {
    TileOrder o; const char* Bt; int K; int es = 2; int gap_at = 1 << 30, gap_by = 0, pn0 = 0; bool bt_out = true;
    __device__ __forceinline__ bool next(int i, Unit& u) const { int p; if (!o.next(i, u.pm, p)) return false; u.e = p; u.pn = p + (p >= gap_at ? gap_by : 0) + pn0; return true; }
    __device__ __forceinline__ unsigned a_row(const Unit& u, int r) const { return (unsigned)(u.pm * BM + r); }
    __device__ __forceinline__ unsigned a_koff(const Unit&) const { return 0u; }
    __device__ __forceinline__ const char* b_base(const Unit& u) const { return Bt + (size_t)(bt_out ? u.pn : u.e) * BM * K * es; }
};
struct ChainSched {
    TileOrder o; const char* Bt; int K;
    __device__ __forceinline__ bool next(int i, Unit& u) const { if (!o.next(i >> 1, u.pm, u.pn)) return false; u.e = i & 1; return true; }
    __device__ __forceinline__ unsigned a_row(const Unit& u, int r) const { return (unsigned)(u.pm * BM + r); }
    __device__ __forceinline__ unsigned a_koff(const Unit& u) const { return (unsigned)(u.e * K * 2); }
    __device__ __forceinline__ const char* b_base(const Unit& u) const { return Bt + (size_t)u.pn * BM * (2 * K) * 2 + (size_t)u.e * K * 2; }
};
template <bool GATHER> struct MoeSched {
    TileOrder o; const char* Bt; int K; int rows_per_e; const LAS int* tab; const int* row_e; int es;
    __device__ __forceinline__ bool next(int i, Unit& u) const { if (!o.next(i, u.pm, u.pn)) return false; u.e = __builtin_amdgcn_readfirstlane(tab[128 + u.pm]); return true; }
    __device__ __forceinline__ unsigned a_row(const Unit& u, int r) const {
        if (GATHER) { const int lr = u.pm * BM + r - tab[u.e]; return lr < tab[64 + u.e] ? (unsigned)row_e[(size_t)u.e * T + lr] : 0u; }
        else return (unsigned)(u.pm * BM + r); }
    __device__ __forceinline__ unsigned a_koff(const Unit&) const { return 0u; }
    __device__ __forceinline__ const char* b_base(const Unit& u) const { return Bt + ((size_t)u.e * rows_per_e + (size_t)u.pn * BM) * K * es; }
};

template <class Epi, class Sched>
__device__ __forceinline__ void gemm_phase(LAS unsigned char* lds, const char* gA, int K_, int lda, int ldb, const Sched& S, const Epi& E) {
    int K = K_; asm volatile("" : "+s"(K));
    int tid = threadIdx.x; asm volatile("" : "+v"(tid));     const int wid = __builtin_amdgcn_readfirstlane(tid >> 6), lane = tid & 63, wr = wid >> 2, wc = wid & 3, fr = lane & 15, fq = lane >> 4;
    constexpr int ES = Epi::F8 ? 1 : 2;
    const int nt = K * ES / 128;
    unsigned voffB[2];
#pragma unroll
    for (int i = 0; i < 2; ++i) { int R, C; stage_rc(tid * 16 + i * 8192, R, C); const int Rb = Epi::PERM ? ((R & ~31) + perm32(R & 31)) : R; voffB[i] = (unsigned)(Rb * ldb * ES + C * 2); }
    const unsigned kstep = (unsigned)(BK * 2);
    const size_t hstepB = (size_t)HALF * ldb * ES;
    const unsigned ldab = (unsigned)lda * ES;
    const unsigned ldsw = (unsigned)wid * 1024u;
    const int aoff = lds_byte(wr * 64 + fr, fq * 8), boff = lds_byte(wc * 32 + fr, fq * 8);
#define PG8_SA(b, h) (((b) * 2 + (h)) * HTB)
#define PG8_SB(b, h) ((4 + (b) * 2 + (h)) * HTB)
#define PG8_STAGE_B(bufoff, gbase) do { _Pragma("unroll") for (int _i = 0; _i < 2; ++_i) \
        __builtin_amdgcn_global_load_lds((const unsigned*)((const char*)(gbase) + voffB[_i]), (LAS unsigned*)(lds + (bufoff) + ldsw + _i * 8192), 16, 0, 0); } while (0)
#define PG8_STAGE_A(bufoff, o0, o1, kb) do { \
        const char* gk_ = gA + (kb);      \
        __builtin_amdgcn_global_load_lds((const unsigned*)(gk_ + (o0)), (LAS unsigned*)(lds + (bufoff) + ldsw), 16, 0, 0); \
        __builtin_amdgcn_global_load_lds((const unsigned*)(gk_ + (o1)), (LAS unsigned*)(lds + (bufoff) + ldsw + 8192), 16, 0, 0); } while (0)
#define PG8_LDA(dst, b, h) do { _Pragma("unroll") for (int m = 0; m < 4; ++m) _Pragma("unroll") for (int k = 0; k < 2; ++k) dst[m][k] = *(const LAS bf16x8*)(lds + PG8_SA(b, h) + aoff + m * 2048 + k * 1024); } while (0)
#define PG8_LDB(dst, b, h) do { _Pragma("unroll") for (int n = 0; n < 2; ++n) _Pragma("unroll") for (int k = 0; k < 2; ++k) dst[n][k] = *(const LAS bf16x8*)(lds + PG8_SB(b, h) + boff + n * 2048 + k * 1024); } while (0)
#define PG8_MMA(ai, bj, At, Bt) do { __builtin_amdgcn_s_setprio(1); \
        if constexpr (Epi::F8) { _Pragma("unroll") for (int m = 0; m < 4; ++m) _Pragma("unroll") for (int n = 0; n < 2; ++n) { \
            const i32x8 a8_ = __builtin_shufflevector(__builtin_bit_cast(i32x4, At[m][0]), __builtin_bit_cast(i32x4, At[m][1]), 0, 1, 2, 3, 4, 5, 6, 7); \
            const i32x8 b8_ = __builtin_shufflevector(__builtin_bit_cast(i32x4, Bt[n][0]), __builtin_bit_cast(i32x4, Bt[n][1]), 0, 1, 2, 3, 4, 5, 6, 7); \
            acc[ai][bj][m][n] = __builtin_amdgcn_mfma_scale_f32_16x16x128_f8f6f4(b8_, a8_, acc[ai][bj][m][n], 0, 0, 0, MK_SCL, 0, MK_SCL); } } \
        else { _Pragma("unroll") for (int m = 0; m < 4; ++m) _Pragma("unroll") for (int n = 0; n < 2; ++n) _Pragma("unroll") for (int k = 0; k < 2; ++k) \
            acc[ai][bj][m][n] = __builtin_amdgcn_mfma_f32_16x16x32_bf16(Bt[n][k], At[m][k], acc[ai][bj][m][n], 0, 0, 0); } \
        __builtin_amdgcn_s_setprio(0); } while (0)
#define PG8_WAIT_V(n) asm volatile("s_waitcnt vmcnt(" #n ")" ::: "memory")
#define PG8_WAIT_L(n) asm volatile("s_waitcnt lgkmcnt(" #n ")" ::: "memory")
#define PG8_BAR __builtin_amdgcn_s_barrier()
#define PG8_SCHED __builtin_amdgcn_sched_barrier(0)
#define PG8_AOFFS(dst, u) do { int t_ = threadIdx.x; asm volatile("" : "+v"(t_));     \
        _Pragma("unroll") for (int _h = 0; _h < 2; ++_h) _Pragma("unroll") for (int _i = 0; _i < 2; ++_i) { int R_, C_; stage_rc(t_ * 16 + _i * 8192, R_, C_); \
        dst[_h][_i] = S.a_row(u, _h * HALF + R_) * ldab + (unsigned)C_ * 2u + S.a_koff(u); } } while (0)
    Unit cur, nxt; int ui = 0;
    if (!S.next(0, cur)) return;
    cur.s = 0;
    if constexpr (Epi::PREF) E.prefetch(cur, 0);
#ifdef MK_STAGGER
    if (S.o.nwg > 3 * S.o.G) {
        const unsigned long long t0_ = __builtin_amdgcn_s_memrealtime(); const unsigned long long d_ = (unsigned long long)((blockIdx.x >> 3) & 7) * MK_STAGGER;
        while (__builtin_amdgcn_s_memrealtime() - t0_ < d_) __builtin_amdgcn_s_sleep(4);
    }
#endif
    f32x4 acc[2][2][4][2];
#pragma unroll
    for (int a = 0; a < 2; ++a)
#pragma unroll
        for (int b = 0; b < 2; ++b)
#pragma unroll
            for (int m = 0; m < 4; ++m)
#pragma unroll
                for (int n = 0; n < 2; ++n) acc[a][b][m][n] = (f32x4){0.f, 0.f, 0.f, 0.f};
    bf16x8 At[4][2], B0[2][2], B1[2][2];
    unsigned oc[2][2];
    LAS u32x4* nslot = (LAS u32x4*)(lds + LDSCTL_OFF + 2048) + tid;
    PG8_AOFFS(oc, cur);
    const char* cB = S.b_base(cur);
    PG8_STAGE_B(PG8_SB(0, 0), cB); PG8_STAGE_B(PG8_SB(0, 1), cB + hstepB); PG8_STAGE_A(PG8_SA(0, 0), oc[0][0], oc[0][1], 0u); PG8_STAGE_A(PG8_SA(0, 1), oc[1][0], oc[1][1], 0u);
    if (wr == 1) PG8_BAR;
    PG8_WAIT_V(2); PG8_BAR;
    PG8_STAGE_B(PG8_SB(1, 0), cB + kstep); PG8_STAGE_A(PG8_SA(1, 0), oc[0][0], oc[0][1], kstep); PG8_STAGE_B(PG8_SB(1, 1), cB + hstepB + kstep);
    PG8_WAIT_V(6); PG8_BAR;
    for (;;) {
        const bool has_next = S.next(ui + 1, nxt);
        const char* nB = has_next ? S.b_base(nxt) : cB;
        if (has_next) { unsigned on[2][2]; PG8_AOFFS(on, nxt); *nslot = (u32x4){on[0][0], on[0][1], on[1][0], on[1][1]}; nxt.s = cur.s == 2 ? 0 : cur.s + 1;
            if constexpr (Epi::PREF) E.prefetch(nxt, nxt.s); }
        for (int t = 0; t < nt; t += 2) {
            const bool last = (t == nt - 2);
            const unsigned k1 = (unsigned)(t + 1) * kstep;
            const unsigned k2 = last ? 0u : (unsigned)(t + 2) * kstep, k3 = k2 + kstep;
            const char* b2 = last ? nB : cB + (size_t)(t + 2) * kstep; const char* b3 = b2 + kstep;
            PG8_LDB(B0, 0, 0); PG8_LDB(B1, 0, 1); PG8_SCHED; PG8_LDA(At, 0, 0); PG8_STAGE_A(PG8_SA(1, 1), oc[1][0], oc[1][1], k1);
            PG8_WAIT_V(8); PG8_WAIT_L(0); PG8_BAR; PG8_MMA(0, 0, At, B0); PG8_MMA(0, 1, At, B1); PG8_BAR; PG8_SCHED;
            if (last && has_next) { const u32x4 o_ = *nslot; oc[0][0] = o_.x; oc[0][1] = o_.y; oc[1][0] = o_.z; oc[1][1] = o_.w; }
            PG8_LDA(At, 0, 1); PG8_STAGE_B(PG8_SB(0, 0), b2); PG8_STAGE_B(PG8_SB(0, 1), b2 + hstepB); PG8_STAGE_A(PG8_SA(0, 0), oc[0][0], oc[0][1], k2);
            PG8_WAIT_V(8); PG8_WAIT_L(0); PG8_BAR; PG8_MMA(1, 0, At, B0); PG8_MMA(1, 1, At, B1); PG8_BAR; PG8_SCHED;
            PG8_LDB(B0, 1, 0); PG8_LDB(B1, 1, 1); PG8_SCHED; PG8_LDA(At, 1, 0); PG8_STAGE_A(PG8_SA(0, 1), oc[1][0], oc[1][1], k2);
            PG8_WAIT_V(8); PG8_WAIT_L(0); PG8_BAR; PG8_MMA(0, 0, At, B0); PG8_MMA(0, 1, At, B1); PG8_BAR; PG8_SCHED;
            PG8_LDA(At, 1, 1); PG8_STAGE_B(PG8_SB(1, 0), b3); PG8_STAGE_B(PG8_SB(1, 1), b3 + hstepB); PG8_STAGE_A(PG8_SA(1, 0), oc[0][0], oc[0][1], k3);
            PG8_WAIT_V(8); PG8_WAIT_L(0); PG8_BAR; PG8_MMA(1, 0, At, B0); PG8_MMA(1, 1, At, B1); PG8_BAR; PG8_SCHED;
        }
        if (wr == 0) PG8_BAR;
        bool carry = false;
        if constexpr (Epi::MIDK) { if (cur.e == 0) { E.mid(acc, cur, wr, wc, fr, fq); carry = true; } else E(acc, cur, wr, wc, fr, fq); } else E(acc, cur, wr, wc, fr, fq);
        if (!has_next) break;
        if (!carry)
#pragma unroll
        for (int a = 0; a < 2; ++a)
#pragma unroll
            for (int b = 0; b < 2; ++b)
#pragma unroll
                for (int m = 0; m < 4; ++m)
#pragma unroll
                    for (int n = 0; n < 2; ++n) acc[a][b][m][n] = (f32x4){0.f, 0.f, 0.f, 0.f};
        cur = nxt; cB = nB; ++ui;
        if (wr == 1) PG8_BAR;
    }
    PG8_WAIT_V(0);
    PG8_BAR;
#undef PG8_SA
#undef PG8_SB
#undef PG8_STAGE_A
#undef PG8_STAGE_B
#undef PG8_LDA
#undef PG8_LDB
#undef PG8_MMA
#undef PG8_WAIT_V
#undef PG8_WAIT_L
#undef PG8_BAR
#undef PG8_SCHED
#undef PG8_AOFFS
}

template <bool F8_> struct EpiProj {
    static constexpr bool PREF = false, PERM = true, MIDK = false, F8 = F8_;
    bf16_t* O; float* kmp;
    __device__ __forceinline__ void operator()(const f32x4 (&acc)[2][2][4][2], const Unit& u, int wr, int wc, int fr, int fq) const {
        const int row0 = u.pm * BM + wr * 64 + fr; const int col0 = u.pn * BM + wc * 32 + 8 * fq;
#pragma unroll
        for (int ai = 0; ai < 2; ++ai)
#pragma unroll
            for (int m = 0; m < 4; ++m) { bf16_t* rowp = O + (size_t)(row0 + ai * HALF + m * 16) * NPROJ + col0;
#pragma unroll
                for (int bj = 0; bj < 2; ++bj) { const float sc = F8 ? (1.0f / 32.0f) : 1.0f; const f32x4 v0 = acc[ai][bj][m][0] * sc, v1 = acc[ai][bj][m][1] * sc;
                    u32x4 w; w.x = cvt_pk_bf16(v0[0], v0[1]); w.y = cvt_pk_bf16(v0[2], v0[3]); w.z = cvt_pk_bf16(v1[0], v1[1]); w.w = cvt_pk_bf16(v1[2], v1[3]);
                    __builtin_nontemporal_store(w, (u32x4*)(rowp + bj * HALF)); } }
        if (u.pn >= C_KB / BM && u.pn < C_VB / BM) {
#pragma unroll
            for (int bj = 0; bj < 2; ++bj)
#pragma unroll
                for (int n = 0; n < 2; ++n) { f32x4 s = (f32x4){0.f, 0.f, 0.f, 0.f};
#pragma unroll
                    for (int ai = 0; ai < 2; ++ai)
#pragma unroll
                        for (int m = 0; m < 4; ++m) s += acc[ai][bj][m][n];
#pragma unroll
                    for (int o = 1; o < 16; o <<= 1) { s[0] += __shfl_xor(s[0], o); s[1] += __shfl_xor(s[1], o); s[2] += __shfl_xor(s[2], o); s[3] += __shfl_xor(s[3], o); }
                    if (fr == 0) *(f32x4*)(kmp + ((size_t)wr * 64 + u.pm) * 1024 + (u.pn - C_KB / BM) * BM + bj * HALF + wc * 32 + 8 * fq + 4 * n) = s * (F8 ? (1.0f / 32.0f) : 1.0f); }
        }
    }
};
struct EpiMerge {
    static constexpr bool PREF = false, PERM = true, MIDK = true, F8 = false;
    const bf16_t* proj; bf16_t* Y;
    __device__ __forceinline__ void mid(f32x4 (&acc)[2][2][4][2], const Unit& u, int wr, int wc, int fr, int fq) const {
        const int row0 = u.pm * BM + wr * 64 + fr; const int col0 = u.pn * BM + wc * 32 + 8 * fq;
#pragma unroll
        for (int ai = 0; ai < 2; ++ai) {
            u32x4 ga[4][2], gb[4][2];
#pragma unroll
            for (int m = 0; m < 4; ++m) { const bf16_t* rowp = proj + (size_t)(row0 + ai * HALF + m * 16) * NPROJ + col0;
#pragma unroll
                for (int bj = 0; bj < 2; ++bj) { ga[m][bj] = *(const u32x4*)(rowp + C_GA + bj * HALF); gb[m][bj] = *(const u32x4*)(rowp + C_GB + bj * HALF); } }
#pragma unroll
            for (int m = 0; m < 4; ++m) {
#pragma unroll
                for (int bj = 0; bj < 2; ++bj) {
#pragma unroll
                    for (int j = 0; j < 4; ++j) { const float a0 = bflo(ga[m][bj][j]), a1 = bfhi(ga[m][bj][j]), b0 = bflo(gb[m][bj][j]), b1 = bfhi(gb[m][bj][j]);
                        const float r0 = (1.0f + __builtin_amdgcn_exp2f(-1.4426950408889634f * b0)) * __builtin_amdgcn_rcpf(1.0f + __builtin_amdgcn_exp2f(-1.4426950408889634f * a0));
                        const float r1 = (1.0f + __builtin_amdgcn_exp2f(-1.4426950408889634f * b1)) * __builtin_amdgcn_rcpf(1.0f + __builtin_amdgcn_exp2f(-1.4426950408889634f * a1));
                        acc[ai][bj][m][j >> 1][(j & 1) * 2] *= r0; acc[ai][bj][m][j >> 1][(j & 1) * 2 + 1] *= r1; } }
                asm volatile("" : "+v"(acc[ai][0][m][0]), "+v"(acc[ai][0][m][1]), "+v"(acc[ai][1][m][0]), "+v"(acc[ai][1][m][1])); }
            asm volatile("" ::: "memory"); }
    }
    __device__ __forceinline__ void operator()(const f32x4 (&acc)[2][2][4][2], const Unit& u, int wr, int wc, int fr, int fq) const {
        const int row0 = u.pm * BM + wr * 64 + fr; const int col0 = u.pn * BM + wc * 32 + 8 * fq;
#pragma unroll
        for (int ai = 0; ai < 2; ++ai) {
            u32x4 gb[4][2];
#pragma unroll
            for (int m = 0; m < 4; ++m)
#pragma unroll
                for (int bj = 0; bj < 2; ++bj) gb[m][bj] = *(const u32x4*)(proj + (size_t)(row0 + ai * HALF + m * 16) * NPROJ + C_GB + col0 + bj * HALF);
#pragma unroll
            for (int m = 0; m < 4; ++m) { const size_t r = (size_t)(row0 + ai * HALF + m * 16);
#pragma unroll
                for (int bj = 0; bj < 2; ++bj) { const u32x4 g = gb[m][bj];
                    const f32x4 v0 = acc[ai][bj][m][0], v1 = acc[ai][bj][m][1];
                    u32x4 w; w.x = cvt_pk_bf16(v0[0] * fsigmoid(bflo(g[0])), v0[1] * fsigmoid(bfhi(g[0]))); w.y = cvt_pk_bf16(v0[2] * fsigmoid(bflo(g[1])), v0[3] * fsigmoid(bfhi(g[1])));
                    w.z = cvt_pk_bf16(v1[0] * fsigmoid(bflo(g[2])), v1[1] * fsigmoid(bfhi(g[2]))); w.w = cvt_pk_bf16(v1[2] * fsigmoid(bflo(g[3])), v1[3] * fsigmoid(bfhi(g[3])));
                    *(u32x4*)(Y + r * D + col0 + bj * HALF) = w; } }
            asm volatile("" ::: "memory"); }
    }
};
struct EpiResF32 {
    static constexpr bool PREF = false, PERM = false, MIDK = false, F8 = false;
    const float* base; bf16_t* out;
    __device__ __forceinline__ void operator()(const f32x4 (&acc)[2][2][4][2], const Unit& u, int wr, int wc, int fr, int fq) const {
        const int row0 = u.pm * BM + wr * 64 + fr, col0 = u.pn * BM + wc * 32 + 4 * fq;
#pragma unroll
        for (int ai = 0; ai < 2; ++ai) {
            f32x4 bs[4][2][2];
#pragma unroll
            for (int m = 0; m < 4; ++m) { const size_t off = (size_t)(row0 + ai * HALF + m * 16) * D + col0;
#pragma unroll
                for (int bj = 0; bj < 2; ++bj)
#pragma unroll
                    for (int n = 0; n < 2; ++n) bs[m][bj][n] = __builtin_nontemporal_load((const f32x4*)(base + off + bj * HALF + n * 16)); }
#pragma unroll
            for (int m = 0; m < 4; ++m) { const size_t off = (size_t)(row0 + ai * HALF + m * 16) * D + col0;
#pragma unroll
                for (int bj = 0; bj < 2; ++bj)
#pragma unroll
                    for (int n = 0; n < 2; ++n) { const f32x4 v = bs[m][bj][n] + acc[ai][bj][m][n]; u32x2 w; w.x = cvt_pk_bf16(v[0], v[1]); w.y = cvt_pk_bf16(v[2], v[3]); *(u32x2*)(out + off + bj * HALF + n * 16) = w; } }
            asm volatile("" ::: "memory"); }
    }
};
struct EpiGlu {
    static constexpr bool PREF = true, PERM = true, MIDK = false, F8 = true;
    unsigned char* H; const float* rstd_e; const LAS int* tab; const float* bg; const float* bu; const float* zero; LAS unsigned char* lds;
    __device__ __forceinline__ void prefetch(const Unit& u, int slot) const {
        int tid = threadIdx.x; asm volatile("" : "+v"(tid)); const int wave = __builtin_amdgcn_readfirstlane(tid >> 6);
        const float* src;
        if (wave < 4) { const int lr = u.pm * BM + tid - tab[u.e]; src = lr < tab[64 + u.e] ? rstd_e + (size_t)u.e * T + lr : zero; }
        else { const int j = tid - 256; src = (j < 128 ? bg : bu) + (size_t)u.e * FF + u.pn * HALF + (j & 127); }
        __builtin_amdgcn_global_load_lds((const unsigned*)src, (LAS unsigned*)(lds + EPF_OFF + slot * 2048 + wave * 256), 4, 0, 0);
    }
    __device__ __forceinline__ void operator()(const f32x4 (&acc)[2][2][4][2], const Unit& u, int wr, int wc, int fr, int fq) const {
        const int row0 = u.pm * BM + wr * 64 + fr; const int colo = u.pn * HALF + wc * 32 + 8 * fq;
        const LAS float* ep = (const LAS float*)(lds + EPF_OFF + u.s * 2048);
        f32x4 g4[2], u4[2];
#pragma unroll
        for (int n = 0; n < 2; ++n) { g4[n] = *(const LAS f32x4*)(ep + 256 + wc * 32 + 8 * fq + 4 * n); u4[n] = *(const LAS f32x4*)(ep + 384 + wc * 32 + 8 * fq + 4 * n); }
        float rsv[2][4];
#pragma unroll
        for (int ai = 0; ai < 2; ++ai)
#pragma unroll
            for (int m = 0; m < 4; ++m) rsv[ai][m] = ep[wr * 64 + fr + ai * HALF + m * 16];
#pragma unroll
        for (int ai = 0; ai < 2; ++ai)
#pragma unroll
            for (int m = 0; m < 4; ++m) { const int r = row0 + ai * HALF + m * 16; const float rs = rsv[ai][m] * (1.0f / 32.0f);
                float o[8];
#pragma unroll
                for (int n = 0; n < 2; ++n)
#pragma unroll
                    for (int j = 0; j < 4; ++j) { float g = acc[ai][0][m][n][j] * rs + g4[n][j], up = acc[ai][1][m][n][j] * rs + u4[n][j];
                        g = fminf(g, 7.0f); up = fminf(fmaxf(up, -7.0f), 7.0f);
                        const float glu = g * fsigmoid(1.702f * g); o[n * 4 + j] = (up + 1.0f) * glu; }
                u32x2 w; w.x = pk4_fp8(o[0], o[1], o[2], o[3]); w.y = pk4_fp8(o[4], o[5], o[6], o[7]);
                *(u32x2*)(H + (size_t)r * FF + colo) = w; asm volatile("" ::: "memory"); }
    }
};
template <int ACT, bool HASBIAS, bool F8_ = false> struct EpiBf16 {
    static constexpr bool PREF = false, PERM = true, MIDK = false, F8 = F8_;
    bf16_t* O; int ldc; const float* bias; int bias_stride; float scale;
    __device__ __forceinline__ void operator()(const f32x4 (&acc)[2][2][4][2], const Unit& u, int wr, int wc, int fr, int fq) const {
        const int row0 = u.pm * BM + wr * 64 + fr; const int col0 = u.pn * BM + wc * 32 + 8 * fq;
        f32x4 bv[2][2];
#pragma unroll
        for (int bj = 0; bj < 2; ++bj)
#pragma unroll
            for (int n = 0; n < 2; ++n) bv[bj][n] = HASBIAS ? *(const f32x4*)(bias + (size_t)u.e * bias_stride + col0 + bj * HALF + 4 * n) : (f32x4){0.f, 0.f, 0.f, 0.f};
#pragma unroll
        for (int ai = 0; ai < 2; ++ai)
#pragma unroll
            for (int m = 0; m < 4; ++m) { bf16_t* rowp = O + (size_t)(row0 + ai * HALF + m * 16) * ldc + col0;
#pragma unroll
                for (int bj = 0; bj < 2; ++bj) { f32x4 v0 = acc[ai][bj][m][0] * scale + bv[bj][0], v1 = acc[ai][bj][m][1] * scale + bv[bj][1];
                    if (ACT == 1) {
#pragma unroll
                        for (int j = 0; j < 4; ++j) { v0[j] = fsigmoid(v0[j]); v1[j] = fsigmoid(v1[j]); } }
                    u32x4 w; w.x = cvt_pk_bf16(v0[0], v0[1]); w.y = cvt_pk_bf16(v0[2], v0[3]); w.z = cvt_pk_bf16(v1[0], v1[1]); w.w = cvt_pk_bf16(v1[2], v1[3]);
                    *(u32x4*)(rowp + bj * HALF) = w; }
                asm volatile("" ::: "memory"); }
    }
};
struct EpiDownF8 {
    static constexpr bool PREF = false, PERM = true, MIDK = false, F8 = true;
    unsigned char* O; const float* bias;
    __device__ __forceinline__ void operator()(const f32x4 (&acc)[2][2][4][2], const Unit& u, int wr, int wc, int fr, int fq) const {
        const int row0 = u.pm * BM + wr * 64 + fr; const int col0 = u.pn * BM + wc * 32 + 8 * fq;
        f32x4 bv[2][2];
#pragma unroll
        for (int bj = 0; bj < 2; ++bj)
#pragma unroll
            for (int n = 0; n < 2; ++n) bv[bj][n] = *(const f32x4*)(bias + (size_t)u.e * D + col0 + bj * HALF + 4 * n);
#pragma unroll
        for (int ai = 0; ai < 2; ++ai)
#pragma unroll
            for (int m = 0; m < 4; ++m) { unsigned char* rowp = O + (size_t)(row0 + ai * HALF + m * 16) * D + col0;
#pragma unroll
                for (int bj = 0; bj < 2; ++bj) { const f32x4 v0 = acc[ai][bj][m][0] * (1.0f / 32.0f) + bv[bj][0], v1 = acc[ai][bj][m][1] * (1.0f / 32.0f) + bv[bj][1];
                    u32x2 w; w.x = pk4_fp8(v0[0], v0[1], v0[2], v0[3]); w.y = pk4_fp8(v1[0], v1[1], v1[2], v1[3]);
                    *(u32x2*)(rowp + bj * HALF) = w; }
                asm volatile("" ::: "memory"); }
    }
};
}
__device__ __forceinline__ void transpose_item(const float* __restrict__ W, int ldw, int k0, int n_src0, bf16_t* __restrict__ WT, int ldo, int n_dst0, int k_off, LAS float* scr, int lane) {
    { float t_[32]; const float* wp_ = W + (size_t)(k0 + (lane >> 5)) * ldw + n_src0 + (lane & 31);
#pragma unroll
    for (int i = 0; i < 32; ++i) t_[i] = __builtin_nontemporal_load(wp_ + (size_t)(2 * i) * ldw);
#pragma unroll
    for (int i = 0; i < 32; ++i) scr[(2 * i + (lane >> 5)) * 33 + (lane & 31)] = t_[i]; }
    LDS_WAIT(); asm volatile("" ::: "memory");
    const int c = lane & 7;
#pragma unroll
    for (int j = 0; j < 4; ++j) { const int n = (lane >> 3) + 8 * j; const LAS float* s = scr + (8 * c) * 33 + n;
        u32x4 o; o.x = cvt_pk_bf16(s[0 * 33], s[1 * 33]); o.y = cvt_pk_bf16(s[2 * 33], s[3 * 33]); o.z = cvt_pk_bf16(s[4 * 33], s[5 * 33]); o.w = cvt_pk_bf16(s[6 * 33], s[7 * 33]);
        *(u32x4*)(WT + (size_t)(n_dst0 + n) * ldo + k_off + k0 + 8 * c) = o; }
    LDS_WAIT(); asm volatile("" ::: "memory");
}
__device__ __forceinline__ void transpose_item_f8(const float* __restrict__ W, int ldw, int k0, int n_src0, unsigned char* __restrict__ WT, int ldo, int n_dst0, float sc, LAS float* scr, int lane) {
    { float t_[32]; const float* wp_ = W + (size_t)(k0 + (lane >> 5)) * ldw + n_src0 + (lane & 31);
#pragma unroll
    for (int i = 0; i < 32; ++i) t_[i] = __builtin_nontemporal_load(wp_ + (size_t)(2 * i) * ldw);
#pragma unroll
    for (int i = 0; i < 32; ++i) scr[(2 * i + (lane >> 5)) * 33 + (lane & 31)] = t_[i]; }
    LDS_WAIT(); asm volatile("" ::: "memory");
    const int c = lane & 7;
#pragma unroll
    for (int j = 0; j < 4; ++j) { const int n = (lane >> 3) + 8 * j; const LAS float* s = scr + (8 * c) * 33 + n;
        u32x2 o; o.x = pk4_fp8(s[0 * 33] * sc, s[1 * 33] * sc, s[2 * 33] * sc, s[3 * 33] * sc); o.y = pk4_fp8(s[4 * 33] * sc, s[5 * 33] * sc, s[6 * 33] * sc, s[7 * 33] * sc);
        *(u32x2*)(WT + (size_t)(n_dst0 + n) * ldo + k0 + 8 * c) = o; }
    LDS_WAIT(); asm volatile("" ::: "memory");
}
__device__ __forceinline__ void transpose_mat_item(const float* W, int ldw, int N, int n_src_base, bf16_t* WT, int ldo, int n_dst_base, int k_off, LAS float* scr, int item, int lane) {
    const int nblk = N / 32, kb = item / nblk, nb = item % nblk;
    transpose_item(W, ldw, 64 * kb, n_src_base + 32 * nb, WT, ldo, n_dst_base + 32 * nb, k_off, scr, lane);
}

struct P {
    const float* in[25]; float* out; unsigned char* ws;
};

__device__ __forceinline__ void p0_prologue(const P& a, LAS unsigned char* lds, int vcu, int G, int wave, int lane) {
    LAS float* scr = (LAS float*)(lds + wave * 16384);
    const int gw = vcu * NWAVES + wave, NGW = G * NWAVES;
    unsigned char* ws = a.ws;
    bf16_t* WinT = (bf16_t*)(ws + WS_WIN); bf16_t* WupT = (bf16_t*)(ws + WS_WUP); bf16_t* WoT = (bf16_t*)(ws + WS_WO); bf16_t* WpgT = (bf16_t*)(ws + WS_WPG); bf16_t* WppT = (bf16_t*)(ws + WS_WPP);
    constexpr int I_A = 16 * 96, I_B8 = 16 * 96, I_B = 16 * 64, I_S = 16 * 32, I_P = 4 * 32;
    constexpr int NITEMS = I_A + I_B8 + I_B + 4 * I_S + I_P;
#ifndef P0_PARTS
#define P0_PARTS 63
#endif
    if (P0_PARTS & 1)
    for (int it = gw; it < NITEMS; it += NGW) {
        int r = it;
        if (r < I_A) { transpose_mat_item(a.in[4], D_IN, 3072, 0, WinT, D, 0, 0, scr, r, lane); continue; } r -= I_A;
        if (r < I_B8) { const int kb = r / 96, nb = r % 96; transpose_item_f8(a.in[4], D_IN, 64 * kb, 3088 + 32 * nb, ws + WS_WIN8, D, 32 * nb, 32.0f, scr, lane); continue; } r -= I_B8;
        if (r < I_B) { transpose_mat_item(a.in[4], D_IN, 2048, 3088 + 3072, WinT, D, 6144, 0, scr, r, lane); continue; } r -= I_B;
        if (r < I_S) { transpose_mat_item(a.in[8], D, D, 0, WupT, 2048, 0, 0, scr, r, lane); continue; } r -= I_S;
        if (r < I_S) { transpose_mat_item(a.in[9], D, D, 0, WupT, 2048, 0, 1024, scr, r, lane); continue; } r -= I_S;
        if (r < I_S) { transpose_mat_item(a.in[10], D, D, 0, WoT, D, 0, 0, scr, r, lane); continue; } r -= I_S;
        if (r < I_S) { const int kb = r / 32, nb = r % 32; transpose_item_f8(a.in[21], D, 64 * kb, 32 * nb, (unsigned char*)WpgT, D, 32 * nb, 32.0f, scr, lane); continue; } r -= I_S;
        transpose_mat_item(a.in[22], D, D, 0, WppT, 256, 0, 0, scr, r, lane);
    }
    if (P0_PARTS & 2) {
        const float* x = a.in[0]; const float* g = a.in[3]; bf16_t* H = (bf16_t*)(ws + WS_H);
        f32x4 gv[4];
#pragma unroll
        for (int j = 0; j < 4; ++j) gv[j] = *((const f32x4*)g + lane + 64 * j);
        for (int m = gw; m < T; m += NGW) {
            const f32x4* xr = (const f32x4*)(x + (size_t)m * D) + lane; f32x4 v[4]; float s = 0.f;
#pragma unroll
            for (int j = 0; j < 4; ++j) { v[j] = __builtin_nontemporal_load(xr + 64 * j); s += (v[j].x * v[j].x + v[j].y * v[j].y) + (v[j].z * v[j].z + v[j].w * v[j].w); }
            const float rstd = 1.0f / sqrtf(wave_sum(s) * (1.0f / D) + EPS);
            u32x2* o8 = (u32x2*)(H + (size_t)m * D) + lane; unsigned* q8 = (unsigned*)(ws + WS_H8 + (size_t)m * D) + lane;
#pragma unroll
            for (int j = 0; j < 4; ++j) { const f32x4 y = v[j] * rstd * gv[j]; u32x2 w; w.x = cvt_pk_bf16(y.x, y.y); w.y = cvt_pk_bf16(y.z, y.w); o8[64 * j] = w; q8[64 * j] = pk4_fp8(y.x, y.y, y.z, y.w); }
        }
    }
    if (P0_PARTS & 4) {
        const f32x4* p4 = (const f32x4*)a.in[1]; u32x2* pb = (u32x2*)(ws + WS_PB);
        const size_t n4 = (size_t)T * 256 / 4;
        for (size_t i = (size_t)gw * 64 + lane; i < n4; i += (size_t)NGW * 64) { const f32x4 v = __builtin_nontemporal_load(p4 + i); u32x2 w; w.x = cvt_pk_bf16(v.x, v.y); w.y = cvt_pk_bf16(v.z, v.w); pb[i] = w; }
    }
    if (P0_PARTS & 8) {
        const int gt = (vcu * NWAVES + wave) * 64 + lane;
        if ((P0_PARTS & 16) && gt < 16 * 1024) { const int n = gt >> 10, k = gt & 1023; ((bf16_t*)(ws + WS_WALT))[n * 1024 + k] = (bf16_t)(cvt_pk_bf16(a.in[4][(size_t)k * D_IN + SRC_ALOW + n], 0.f) & 0xffffu); }
        if ((P0_PARTS & 32) && gt < 4096) { const int s = gt >> 6, l = gt & 63, e = l & 31, hh = l >> 5; const float* wr = a.in[12];
            float v[8], lo[8];
#pragma unroll
            for (int j = 0; j < 8; ++j) { v[j] = wr[(size_t)(16 * s + 8 * hh + j) * NE + e]; }
            u32x4 whi; whi.x = cvt_pk_bf16(v[0], v[1]); whi.y = cvt_pk_bf16(v[2], v[3]); whi.z = cvt_pk_bf16(v[4], v[5]); whi.w = cvt_pk_bf16(v[6], v[7]);
#pragma unroll
            for (int j = 0; j < 4; ++j) { lo[2 * j] = v[2 * j] - bflo(whi[j]); lo[2 * j + 1] = v[2 * j + 1] - bfhi(whi[j]); }
            u32x4 wlo; wlo.x = cvt_pk_bf16(lo[0], lo[1]); wlo.y = cvt_pk_bf16(lo[2], lo[3]); wlo.z = cvt_pk_bf16(lo[4], lo[5]); wlo.w = cvt_pk_bf16(lo[6], lo[7]);
            u32x4* f = (u32x4*)(ws + WS_WRF); f[gt] = whi; f[4096 + gt] = wlo; }
    }
}

struct CvtItem { const float* src; unsigned char* dst; int ldo; };
__device__ __forceinline__ CvtItem cvt_item(const P& a, int it, int lane) {
    constexpr int IPM = 16 * 32;
    const int e = it / (3 * IPM), r0 = it % (3 * IPM), which = r0 / IPM, r = r0 % IPM, kb = r / 32, nb = r % 32, n0 = 32 * nb;
    CvtItem c;
    if (which < 2) { c.src = a.in[which == 0 ? 14 : 16] + (size_t)e * D * FF + (size_t)(64 * kb + (lane >> 5)) * FF + n0 + (lane & 31);
        c.dst = (unsigned char*)a.out + ((size_t)e * 2048 + (n0 >> 7) * 256 + (n0 & 127) + which * 128) * D + 64 * kb; c.ldo = D; }
    else { c.src = a.in[18] + (size_t)e * FF * D + (size_t)(64 * kb + (lane >> 5)) * D + n0 + (lane & 31);
        c.dst = a.ws + WS_W2T + ((size_t)e * D + n0) * FF + 64 * kb; c.ldo = FF; }
    return c;
}
__device__ __forceinline__ void expert_convert(const P& a, LAS unsigned char* lds, int vcu, int G, int wave, int lane) {
    LAS float* scr = (LAS float*)(lds + wave * 16384);
    const int gw = vcu * NWAVES + wave, NGW = G * NWAVES;
    constexpr int NIT = NE * 3 * 16 * 32;
    if (gw >= NIT) return;
    float tA[32], tB[32];
    CvtItem cA = cvt_item(a, gw, lane), cB = cvt_item(a, gw + NGW < NIT ? gw + NGW : gw, lane);
#pragma unroll
    for (int i = 0; i < 32; ++i) tA[i] = __builtin_nontemporal_load(cA.src + (size_t)(2 * i) * 1024);
#pragma unroll
    for (int i = 0; i < 32; ++i) tB[i] = __builtin_nontemporal_load(cB.src + (size_t)(2 * i) * 1024);
#define CVT_OUT(c_) do { LDS_WAIT(); asm volatile("" ::: "memory"); const int c = lane & 7; \
        _Pragma("unroll") for (int j = 0; j < 4; ++j) { const int n = (lane >> 3) + 8 * j; const LAS float* s = scr + (8 * c) * 33 + n; \
            u32x2 o; o.x = pk4_fp8(s[0 * 33] * 32.0f, s[1 * 33] * 32.0f, s[2 * 33] * 32.0f, s[3 * 33] * 32.0f); o.y = pk4_fp8(s[4 * 33] * 32.0f, s[5 * 33] * 32.0f, s[6 * 33] * 32.0f, s[7 * 33] * 32.0f); \
            __builtin_nontemporal_store(o, (u32x2*)((c_).dst + (size_t)n * (c_).ldo + 8 * c)); } \
        LDS_WAIT(); asm volatile("" ::: "memory"); } while (0)
    for (int it = gw; it < NIT; it += 2 * NGW) {
#pragma unroll
        for (int i = 0; i < 32; ++i) scr[(2 * i + (lane >> 5)) * 33 + (lane & 31)] = tA[i];
        const CvtItem dA = cA; const int n2 = it + 2 * NGW;
        if (n2 < NIT) { cA = cvt_item(a, n2, lane);
#pragma unroll
            for (int i = 0; i < 32; ++i) tA[i] = __builtin_nontemporal_load(cA.src + (size_t)(2 * i) * 1024); }
        CVT_OUT(dA);
        if (it + NGW >= NIT) break;
#pragma unroll
        for (int i = 0; i < 32; ++i) scr[(2 * i + (lane >> 5)) * 33 + (lane & 31)] = tB[i];
        const CvtItem dB = cB; const int n3 = it + 3 * NGW;
        if (n3 < NIT) { cB = cvt_item(a, n3, lane);
#pragma unroll
            for (int i = 0; i < 32; ++i) tB[i] = __builtin_nontemporal_load(cB.src + (size_t)(2 * i) * 1024); }
        CVT_OUT(dB);
    }
#undef CVT_OUT
}

__device__ __forceinline__ float fexp_(float x) { return __builtin_amdgcn_exp2f(x * 1.4426950408889634f); }
__device__ __forceinline__ float logsigmoidf_(float x) { const float e = fexp_(-fabsf(x)); return fminf(x, 0.0f) - 0.6931471805599453f * __builtin_amdgcn_logf(1.0f + e); }
__device__ __forceinline__ void gla_prep_unit(const P& a, LAS unsigned char* lds, int unit) {
    int tid = threadIdx.x; asm volatile("" : "+v"(tid));     const int wave = __builtin_amdgcn_readfirstlane(tid >> 6), lane = tid & 63;
    const int b = unit >> 5, chunk = unit & 31, tok0 = b * SEQ + chunk * 64;
    const bf16_t* H = (const bf16_t*)(a.ws + WS_H); const bf16_t* WalT = (const bf16_t*)(a.ws + WS_WALT); const bf16_t* proj = (const bf16_t*)(a.ws + WS_PROJ);
    LAS float* part = (LAS float*)lds;
    LAS float* alow = (LAS float*)(lds + 8192);
    LAS float* seg = (LAS float*)(lds + 12288);
    constexpr int GP_KDT = 16384, GP_VT = 34816;
    {
        const int rg = wave & 3, kh = wave >> 2, r = lane & 15, q = lane >> 4;
        f32x4 acc = (f32x4){0.f, 0.f, 0.f, 0.f};
        const bf16_t* ap = H + (size_t)(tok0 + 16 * rg + r) * D + 512 * kh + 8 * q; const bf16_t* bp = WalT + (size_t)r * D + 512 * kh + 8 * q;
#pragma unroll 8
        for (int s = 0; s < 16; ++s) { const bf16x8 av = *(const bf16x8*)(ap + 32 * s), bv = *(const bf16x8*)(bp + 32 * s); acc = __builtin_amdgcn_mfma_f32_16x16x32_bf16(bv, av, acc, 0, 0, 0); }
        *(LAS f32x4*)(part + (kh * 64 + 16 * rg + r) * 16 + 4 * q) = acc;
    }
    __syncthreads();
    if (tid < 256) { *(LAS f32x4*)(alow + tid * 4) = *(LAS f32x4*)(part + tid * 4) + *(LAS f32x4*)(part + 1024 + tid * 4); }
    __syncthreads();
    const int dp = tid & 63, tq = wave;
    const float* w_a2 = a.in[5]; const float* b_a2 = a.in[6];
    const int ep = tid & 127, sq4 = tid >> 7;
    f32x2 w2[16], w2n[16]; f32x2 b2, b2n; unsigned qv[8], kv[8], qvn[8], kvn[8], sv[16], svn[16];
#define GP_LOADS(h_, W2, B2, QV, KV, SV) do { const int dc_ = (h_) * 128 + 2 * dp; \
        _Pragma("unroll") for (int r = 0; r < 16; ++r) W2[r] = *(const f32x2*)(w_a2 + r * 512 + dc_); \
        B2 = *(const f32x2*)(b_a2 + dc_); \
        _Pragma("unroll") for (int i = 0; i < 8; ++i) { const bf16_t* rp = proj + (size_t)(tok0 + 8 * tq + i) * NPROJ + dc_; QV[i] = __builtin_nontemporal_load((const unsigned*)(rp + C_QA)); KV[i] = __builtin_nontemporal_load((const unsigned*)(rp + C_KA)); } \
        const bf16_t* v_ = proj + (size_t)(tok0 + 16 * sq4) * NPROJ + C_VA + (h_) * 256 + 2 * ep; \
        _Pragma("unroll") for (int i = 0; i < 16; ++i) SV[i] = __builtin_nontemporal_load((const unsigned*)(v_ + (size_t)i * NPROJ)); } while (0)
    GP_LOADS(0, w2, b2, qv, kv, sv);
    for (int h = 0; h < 4; ++h) {
        if (h + 1 < 4) GP_LOADS(h + 1, w2n, b2n, qvn, kvn, svn);
        float G0[8], G1[8]; float r0 = 0.f, r1 = 0.f;
#pragma unroll
        for (int i = 0; i < 8; ++i) { const LAS f32x4* al4 = (const LAS f32x4*)(alow + (8 * tq + i) * 16); float x0 = b2.x, x1 = b2.y;
#pragma unroll
            for (int r4 = 0; r4 < 4; ++r4) { const f32x4 al = al4[r4];
#pragma unroll
                for (int j = 0; j < 4; ++j) { x0 += al[j] * w2[4 * r4 + j].x; x1 += al[j] * w2[4 * r4 + j].y; } }
            r0 += logsigmoidf_(x0) * (1.0f / 16.0f); r1 += logsigmoidf_(x1) * (1.0f / 16.0f); G0[i] = r0; G1[i] = r1; }
        *(LAS f32x2*)(seg + tq * 128 + 2 * dp) = (f32x2){r0, r1};
        __syncthreads();
        float off0 = 0.f, off1 = 0.f, tot0 = 0.f, tot1 = 0.f;
#pragma unroll
        for (int q = 0; q < 8; ++q) { const f32x2 s = *(LAS f32x2*)(seg + q * 128 + 2 * dp); tot0 += s.x; tot1 += s.y; if (q < tq) { off0 += s.x; off1 += s.y; } }
        const size_t tile = (size_t)((b * 4 + h) * 32 + chunk);
        bf16_t* Qg = (bf16_t*)(a.ws + WS_QG) + tile * 8192; bf16_t* Kg = (bf16_t*)(a.ws + WS_KG) + tile * 8192;
        float kd0[8], kd1[8];
#pragma unroll
        for (int i = 0; i < 8; ++i) { const float g0 = G0[i] + off0, g1 = G1[i] + off1; const float q0 = bflo(qv[i]), q1 = bfhi(qv[i]), k0 = bflo(kv[i]), k1 = bfhi(kv[i]);
            const float e0 = fexp_(g0), e1 = fexp_(g1);
            *(unsigned*)(Qg + (8 * tq + i) * 128 + 2 * dp) = cvt_pk_bf16(q0 * e0 * 0.08838834764831845f, q1 * e1 * 0.08838834764831845f);
            *(unsigned*)(Kg + (8 * tq + i) * 128 + 2 * dp) = cvt_pk_bf16(k0 * __builtin_amdgcn_rcpf(e0), k1 * __builtin_amdgcn_rcpf(e1));
            kd0[i] = k0 * fexp_(tot0 - g0); kd1[i] = k1 * fexp_(tot1 - g1); }
        u32x4 w0, w1; w0.x = cvt_pk_bf16(kd0[0], kd0[1]); w0.y = cvt_pk_bf16(kd0[2], kd0[3]); w0.z = cvt_pk_bf16(kd0[4], kd0[5]); w0.w = cvt_pk_bf16(kd0[6], kd0[7]);
        w1.x = cvt_pk_bf16(kd1[0], kd1[1]); w1.y = cvt_pk_bf16(kd1[2], kd1[3]); w1.z = cvt_pk_bf16(kd1[4], kd1[5]); w1.w = cvt_pk_bf16(kd1[6], kd1[7]);
        *(LAS u32x4*)(lds + GP_KDT + (2 * dp) * 144 + 16 * tq) = w0; *(LAS u32x4*)(lds + GP_KDT + (2 * dp + 1) * 144 + 16 * tq) = w1;
        if (tq == 0) *(f32x2*)((float*)(a.ws + WS_DEC) + tile * 128 + 2 * dp) = (f32x2){fexp_(tot0), fexp_(tot1)};
        {
            u32x4 lo0, lo1, hi0, hi1;
#pragma unroll
            for (int j = 0; j < 4; ++j) { lo0[j] = (sv[2 * j] & 0xffffu) | (sv[2 * j + 1] << 16); lo1[j] = (sv[8 + 2 * j] & 0xffffu) | (sv[8 + 2 * j + 1] << 16);
                hi0[j] = (sv[2 * j] >> 16) | (sv[2 * j + 1] & 0xffff0000u); hi1[j] = (sv[8 + 2 * j] >> 16) | (sv[8 + 2 * j + 1] & 0xffff0000u); }
            LAS unsigned char* v0 = lds + GP_VT + (2 * ep) * 144 + sq4 * 32;
            *(LAS u32x4*)(v0) = lo0; *(LAS u32x4*)(v0 + 16) = lo1; *(LAS u32x4*)(v0 + 144) = hi0; *(LAS u32x4*)(v0 + 144 + 16) = hi1;
        }
        __syncthreads();
        {
            const int c32 = lane & 31, hi = lane >> 5;
            bf16x8 vt[4];
#pragma unroll
            for (int ks = 0; ks < 4; ++ks) vt[ks] = *(const LAS bf16x8*)(lds + GP_VT + (32 * wave + c32) * 144 + (16 * ks + 8 * hi) * 2);
            unsigned* sl = (unsigned*)a.out + tile * 8192;
#pragma unroll
            for (int tl = 0; tl < 4; ++tl) { f32x16 acc;
#pragma unroll
                for (int r = 0; r < 16; ++r) acc[r] = 0.f;
#pragma unroll
                for (int ks = 0; ks < 4; ++ks) { const bf16x8 av = *(const LAS bf16x8*)(lds + GP_KDT + (32 * tl + c32) * 144 + (16 * ks + 8 * hi) * 2); acc = __builtin_amdgcn_mfma_f32_32x32x16_bf16(av, vt[ks], acc, 0, 0, 0); }
#pragma unroll
                for (int g = 0; g < 4; ++g) sl[((tl * 4 + g) * 2 + hi) * 256 + 32 * wave + c32] = pk4_fp8(acc[4 * g], acc[4 * g + 1], acc[4 * g + 2], acc[4 * g + 3]); }
        }
        __syncthreads();
#pragma unroll
        for (int r = 0; r < 16; ++r) { w2[r] = w2n[r]; sv[r] = svn[r]; }
#pragma unroll
        for (int i = 0; i < 8; ++i) { qv[i] = qvn[i]; kv[i] = kvn[i]; }
        b2 = b2n;
    }
#undef GP_LOADS
}

__device__ __forceinline__ void gla_combine_unit(const P& a, int unit) {
    const int tid = threadIdx.x, bh = unit >> 4, i8 = (unit & 15) * 512 + tid;
    const int d0 = 32 * (i8 >> 11) + 8 * ((i8 >> 9) & 3) + 4 * ((i8 >> 8) & 1);
    const unsigned* sl8 = (const unsigned*)a.out + (size_t)bh * 32 * 8192 + i8; u32x2* sl = (u32x2*)(a.ws + WS_SLOC) + (size_t)bh * 32 * 8192 + i8;
    const f32x4* dc = (const f32x4*)((const float*)(a.ws + WS_DEC) + (size_t)bh * 32 * 128 + d0);
    f32x4 s = (f32x4){0.f, 0.f, 0.f, 0.f};
    for (int cb = 0; cb < 32; cb += 8) {
        unsigned loc[8]; f32x4 dv[8];
#pragma unroll
        for (int i = 0; i < 8; ++i) { loc[i] = __builtin_nontemporal_load(sl8 + (size_t)(cb + i) * 8192); dv[i] = dc[(cb + i) * 32]; }
#pragma unroll
        for (int i = 0; i < 8; ++i) { if (cb + i < 31) {
            s.x = dv[i].x * s.x + __builtin_amdgcn_cvt_f32_fp8((int)loc[i], 0); s.y = dv[i].y * s.y + __builtin_amdgcn_cvt_f32_fp8((int)loc[i], 1);
            s.z = dv[i].z * s.z + __builtin_amdgcn_cvt_f32_fp8((int)loc[i], 2); s.w = dv[i].w * s.w + __builtin_amdgcn_cvt_f32_fp8((int)loc[i], 3);
            u32x2 w; w.x = cvt_pk_bf16(s.x, s.y); w.y = cvt_pk_bf16(s.z, s.w); sl[(size_t)(cb + i) * 8192] = w; } }
    }
}

constexpr int GL_QG = 0, GL_KG = 17408, GL_VT = 53248, GL_AM = 90112, GL_OST = 0;
constexpr int GL_QS = 272, GL_TS = 144, GL_OS = 528;
__device__ __forceinline__ int crow(int r, int hi) { return (r & 3) + 8 * (r >> 2) + 4 * hi; }
__device__ __forceinline__ void gla_out_unit(const P& a, LAS unsigned char* lds, int unit) {
    int tid = threadIdx.x; asm volatile("" : "+v"(tid)); const int w = __builtin_amdgcn_readfirstlane(tid >> 6), lane = tid & 63, c32 = lane & 31, hi = lane >> 5;
    const int bh = unit >> 5, chunk = unit & 31, b = bh >> 2, h = bh & 3;
    const bf16_t* proj = (const bf16_t*)(a.ws + WS_PROJ); bf16_t* oab = (bf16_t*)(a.ws + WS_OAB); const float* ggo = a.in[7];
    const size_t tile = (size_t)bh * 32 + chunk;
    {
        const u32x4* q_ = (const u32x4*)((const bf16_t*)(a.ws + WS_QG) + tile * 8192); const u32x4* k_ = (const u32x4*)((const bf16_t*)(a.ws + WS_KG) + tile * 8192);
        u32x4 sq[2], sk[2]; unsigned sv[16];
        sq[0] = __builtin_nontemporal_load(q_ + tid); sq[1] = __builtin_nontemporal_load(q_ + tid + 512); sk[0] = __builtin_nontemporal_load(k_ + tid); sk[1] = __builtin_nontemporal_load(k_ + tid + 512);
        const int ep = tid & 127, sq4 = tid >> 7;
        const bf16_t* v_ = proj + (size_t)(b * SEQ + chunk * 64 + 16 * sq4) * NPROJ + C_VA + h * 256 + 2 * ep;
#pragma unroll
        for (int i = 0; i < 16; ++i) sv[i] = __builtin_nontemporal_load((const unsigned*)(v_ + (size_t)i * NPROJ));
#pragma unroll
        for (int i = 0; i < 2; ++i) { const int p = tid + 512 * i;
            *(LAS u32x4*)(lds + GL_QG + (p >> 4) * GL_QS + (p & 15) * 16) = sq[i]; *(LAS u32x4*)(lds + GL_KG + (p >> 4) * GL_QS + (p & 15) * 16) = sk[i]; }
        u32x4 lo0, lo1, hi0, hi1;
#pragma unroll
        for (int j = 0; j < 4; ++j) { lo0[j] = (sv[2 * j] & 0xffffu) | (sv[2 * j + 1] << 16); lo1[j] = (sv[8 + 2 * j] & 0xffffu) | (sv[8 + 2 * j + 1] << 16);
            hi0[j] = (sv[2 * j] >> 16) | (sv[2 * j + 1] & 0xffff0000u); hi1[j] = (sv[8 + 2 * j] >> 16) | (sv[8 + 2 * j + 1] & 0xffff0000u); }
        LAS unsigned char* v0 = lds + GL_VT + (2 * ep) * GL_TS + sq4 * 32;
        *(LAS u32x4*)(v0) = lo0; *(LAS u32x4*)(v0 + 16) = lo1; *(LAS u32x4*)(v0 + GL_TS) = hi0; *(LAS u32x4*)(v0 + GL_TS + 16) = hi1;
    }
    u32x2 sf[4][2][2];
    if (chunk > 0) { const u32x2* sl = (const u32x2*)(a.ws + WS_SLOC) + (tile - 1) * 8192;
#pragma unroll
        for (int tl = 0; tl < 4; ++tl)
#pragma unroll
            for (int s = 0; s < 2; ++s)
#pragma unroll
                for (int q = 0; q < 2; ++q) sf[tl][s][q] = __builtin_nontemporal_load(sl + ((tl * 4 + 2 * s + q) * 2 + hi) * 256 + 32 * w + c32); }
    __syncthreads();
    if (w < 3) {
        const int ti = (w + 1) >> 1, si = w >> 1;
        f32x16 A;
#pragma unroll
        for (int r = 0; r < 16; ++r) A[r] = 0.f;
#pragma unroll
        for (int s = 0; s < 8; ++s) { const bf16x8 av = *(const LAS bf16x8*)(lds + GL_QG + (32 * ti + c32) * GL_QS + (16 * s + 8 * hi) * 2), bv = *(const LAS bf16x8*)(lds + GL_KG + (32 * si + c32) * GL_QS + (16 * s + 8 * hi) * 2);
            A = __builtin_amdgcn_mfma_f32_32x32x16_bf16(av, bv, A, 0, 0, 0); }
        const int sidx = 32 * si + c32;
#pragma unroll
        for (int r = 0; r < 16; ++r) { const int t = 32 * ti + crow(r, hi); const float v = (sidx <= t) ? A[r] : 0.f;
            *(LAS bf16_t*)(lds + GL_AM + t * GL_TS + sidx * 2) = (bf16_t)(cvt_pk_bf16(v, 0.f) & 0xffffu); }
    }
    __syncthreads();
    f32x16 o[2];
    {
        bf16x8 vt[4];
#pragma unroll
        for (int ks = 0; ks < 4; ++ks) vt[ks] = *(const LAS bf16x8*)(lds + GL_VT + (32 * w + c32) * GL_TS + (16 * ks + 8 * hi) * 2);
#pragma unroll
        for (int ti = 0; ti < 2; ++ti) {
#pragma unroll
            for (int r = 0; r < 16; ++r) o[ti][r] = 0.f;
            if (chunk > 0) {
#pragma unroll
                for (int tl = 0; tl < 4; ++tl)
#pragma unroll
                    for (int s = 0; s < 2; ++s) { const LAS unsigned char* qp = lds + GL_QG + (32 * ti + c32) * GL_QS + (32 * tl + 16 * s + 4 * hi) * 2;
                        const s16x4 lo = *(const LAS s16x4*)qp, hh = *(const LAS s16x4*)(qp + 16);
                        const bf16x8 aop = __builtin_shufflevector(lo, hh, 0, 1, 2, 3, 4, 5, 6, 7);
                        const u32x4 bw = {sf[tl][s][0].x, sf[tl][s][0].y, sf[tl][s][1].x, sf[tl][s][1].y};
                        o[ti] = __builtin_amdgcn_mfma_f32_32x32x16_bf16(aop, __builtin_bit_cast(bf16x8, bw), o[ti], 0, 0, 0); }
            }
#pragma unroll
            for (int ks = 0; ks < 4; ++ks) { if (ti == 0 && ks >= 2) continue;
                const bf16x8 av = *(const LAS bf16x8*)(lds + GL_AM + (32 * ti + c32) * GL_TS + (16 * ks + 8 * hi) * 2);
                o[ti] = __builtin_amdgcn_mfma_f32_32x32x16_bf16(av, vt[ks], o[ti], 0, 0, 0); }
        }
    }
    __syncthreads();
#pragma unroll
    for (int ti = 0; ti < 2; ++ti)
#pragma unroll
        for (int r = 0; r < 16; ++r) *(LAS bf16_t*)(lds + GL_OST + (32 * ti + crow(r, hi)) * GL_OS + (32 * w + c32) * 2) = (bf16_t)(cvt_pk_bf16(o[ti][r], 0.f) & 0xffffu);
    __syncthreads();
    {
        const int t = tid >> 3, sg = tid & 7; const size_t tok = (size_t)(b * SEQ + chunk * 64 + t);
        u32x4 ov[4]; float ss = 0.f;
#pragma unroll
        for (int j = 0; j < 4; ++j) { ov[j] = *(const LAS u32x4*)(lds + GL_OST + t * GL_OS + sg * 64 + j * 16);
#pragma unroll
            for (int i = 0; i < 4; ++i) { const float x0 = bflo(ov[j][i]), x1 = bfhi(ov[j][i]); ss += x0 * x0 + x1 * x1; } }
        ss += __shfl_xor(ss, 1); ss += __shfl_xor(ss, 2); ss += __shfl_xor(ss, 4);
        const float rstd = 1.0f / sqrtf(ss * (1.0f / 256.0f) + EPS);
        const bf16_t* rap = proj + tok * NPROJ + C_RA + h * 256 + sg * 32; bf16_t* op = oab + tok * 2048 + h * 256 + sg * 32; const float* gp = ggo + sg * 32;
#pragma unroll
        for (int j = 0; j < 4; ++j) { const u32x4 ra = __builtin_nontemporal_load((const u32x4*)(rap + 8 * j)); const f32x4 g0 = *(const f32x4*)(gp + 8 * j), g1 = *(const f32x4*)(gp + 8 * j + 4); u32x4 wv;
#pragma unroll
            for (int i = 0; i < 4; ++i) { const float r0 = bflo(ra[i]), r1 = bfhi(ra[i]); const float ga = (i < 2) ? g0[2 * i] : g1[2 * i - 4], gb = (i < 2) ? g0[2 * i + 1] : g1[2 * i - 3];
                wv[i] = cvt_pk_bf16(bflo(ov[j][i]) * rstd * ga * (r0 * fsigmoid(r0)), bfhi(ov[j][i]) * rstd * gb * (r1 * fsigmoid(r1))); }
            *(u32x4*)(op + 8 * j) = wv; }
    }
    __syncthreads();
}
namespace moba {
constexpr int HD = 128;
constexpr float SCALE = 0.08838834764831845f;
constexpr float THR = 8.f;
constexpr int NW = 8, QBLK = 32, KVBLK = 64, QB = NW * QBLK;
constexpr int SHM_V = KVBLK * HD * 2, SHM_K = KVBLK * HD * 2;
constexpr int OFF_WS = 2 * SHM_V + 2 * SHM_K;
constexpr int OFF_RTAB = OFF_WS + NW * 64 * 4;
constexpr int OFF_KM = OFF_RTAB + 2400 * 4;
constexpr int OFF_MISC = OFF_KM + 8 * 128 * 4;
constexpr int OFF_SEL = OFF_MISC + 64;
constexpr int LDS_BYTES = OFF_SEL + 2048;
constexpr int LDP = NPROJ, LDO = 2048;

#define KSWZ(row, colB) ((row) * 256 + ((colB) ^ (((row) & 7) << 4)))
#define SBAR() __builtin_amdgcn_sched_barrier(0)
__device__ __forceinline__ int v_st(int k, int c) { const int kk = (k & ~0xC) | ((k & 4) << 1) | ((k & 8) >> 1); return ((kk >> 3) * 4 + (c >> 5)) * 512 + ((kk & 7) * 32 + (c & 31)) * 2; }
__device__ __forceinline__ int v_rd_base(int lane) { return ((lane & 3) << 3) | (((lane >> 2) & 3) << 6) | (((lane >> 4) & 1) << 5) | (((lane >> 5) & 1) << 8); }
constexpr int v_rd_off(int d0, int ks, int half) { return d0 * 512 + ks * 4096 + half * 2048; }
__device__ __forceinline__ int crow(int r, int hi) { return (r & 3) + 8 * (r >> 2) + 4 * hi; }
__device__ __forceinline__ unsigned cvtpk(float lo, float hi) { unsigned r; asm volatile("v_cvt_pk_bf16_f32 %0, %1, %2" : "=v"(r) : "v"(lo), "v"(hi)); return r; }

__device__ __forceinline__ void mask_tile(f32x16& p0, f32x16& p1, int dq) {
    const float NEG = -__builtin_inff();
#pragma unroll
    for (int r = 0; r < 16; ++r) {
        const int c = (r & 3) + 8 * (r >> 2);
        if (dq - c < 0) p0[r] = NEG;
        if (dq - c - 32 < 0) p1[r] = NEG;
    }
}
__device__ __forceinline__ void bias_tile(f32x16& p0, f32x16& p1, const LAS float* rt) {
#pragma unroll
    for (int r = 0; r < 16; ++r) { const int c = (r & 3) + 8 * (r >> 2); p0[r] += rt[c]; p1[r] += rt[c + 32]; }
}
__device__ __forceinline__ void kill_tile(f32x16& p0, f32x16& p1) {
    const float NEG = -__builtin_inff();
#pragma unroll
    for (int r = 0; r < 16; ++r) { p0[r] = NEG; p1[r] = NEG; }
}
__device__ __forceinline__ void partialSM(f32x16& p0, f32x16& p1, float& m_reg, float& mn, float& alpha) {
    float pmax = p0[0];
#pragma unroll
    for (int r = 1; r < 16; ++r) pmax = fmaxf(pmax, p0[r]);
#pragma unroll
    for (int r = 0; r < 16; ++r) pmax = fmaxf(pmax, p1[r]);
    { auto rr = __builtin_amdgcn_permlane32_swap(__float_as_uint(pmax), __float_as_uint(pmax), false, false);
      pmax = fmaxf(__uint_as_float(rr[0]), __uint_as_float(rr[1])); }
    constexpr float C2 = 1.4426950408889634f * SCALE;
    if (__builtin_expect(__all((pmax - m_reg) * SCALE <= THR), 1)) { mn = m_reg; alpha = 1.f; }
    else { mn = fmaxf(m_reg, pmax); alpha = __builtin_amdgcn_exp2f((m_reg - mn) * C2); m_reg = mn; }
    const float mnL = -mn * C2;
#pragma unroll
    for (int r = 0; r < 16; ++r) p0[r] = fmaf(p0[r], C2, mnL);
#pragma unroll
    for (int r = 0; r < 16; ++r) p1[r] = fmaf(p1[r], C2, mnL);
#pragma unroll
    for (int r = 0; r < 16; ++r) p0[r] = __builtin_amdgcn_exp2f(p0[r]);
}
__device__ __forceinline__ void finishSM(f32x16& p0, f32x16& p1, float alpha, float& l_reg, bf16x8& pa0, bf16x8& pa1, bf16x8& pa2, bf16x8& pa3) {
#pragma unroll
    for (int r = 0; r < 16; ++r) p1[r] = __builtin_amdgcn_exp2f(p1[r]);
    float ps = 0;
#pragma unroll
    for (int r = 0; r < 16; ++r) ps += p0[r];
#pragma unroll
    for (int r = 0; r < 16; ++r) ps += p1[r];
    { auto rr = __builtin_amdgcn_permlane32_swap(__float_as_uint(ps), __float_as_uint(ps), false, false);
      ps = __uint_as_float(rr[0]) + __uint_as_float(rr[1]); }
    l_reg = l_reg * alpha + ps;
#define PK4(P, B_, OUT) do { unsigned a0 = cvtpk(P[B_+0], P[B_+1]), a1 = cvtpk(P[B_+2], P[B_+3]);                          \
        unsigned b0 = cvtpk(P[B_+4], P[B_+5]), b1 = cvtpk(P[B_+6], P[B_+7]);                                             \
        auto r0 = __builtin_amdgcn_permlane32_swap(a0, b0, false, false); auto r1 = __builtin_amdgcn_permlane32_swap(a1, b1, false, false); \
        u32x4 w = {r0[0], r1[0], r0[1], r1[1]}; OUT = __builtin_bit_cast(bf16x8, w); } while (0)
    PK4(p0, 0, pa0); PK4(p0, 8, pa1); PK4(p1, 0, pa2); PK4(p1, 8, pa3);
#undef PK4
}
template <int KB>
__device__ __forceinline__ void qkt(f32x16& p0, f32x16& p1, const char* K_lds, int r32, int hi, const bf16x8* qr) {
#pragma unroll
    for (int r = 0; r < 16; ++r) { p0[r] = 0.f; p1[r] = 0.f; }
    const char* kb[4];
#pragma unroll
    for (int dd = 0; dd < 4; ++dd) kb[dd] = K_lds + KB * SHM_K + KSWZ(r32, (dd * 16 + hi * 8) * 2);
#pragma unroll
    for (int d0 = 0; d0 < 8; ++d0) { const char* a = kb[d0 & 3] + (d0 >> 2) * 128;
        bf16x8 b0 = *reinterpret_cast<const bf16x8*>(a);
        bf16x8 b1 = *reinterpret_cast<const bf16x8*>(a + 32 * 256);
        p0 = __builtin_amdgcn_mfma_f32_32x32x16_bf16(b0, qr[d0], p0, 0, 0, 0);
        p1 = __builtin_amdgcn_mfma_f32_32x32x16_bf16(b1, qr[d0], p1, 0, 0, 0); }
}
template <int VB>
__device__ __forceinline__ void pv_tile(f32x16* o, int vb0, bf16x8 pa0, bf16x8 pa1, bf16x8 pa2, bf16x8 pa3) {
#define TRRD(dst, off) asm volatile("ds_read_b64_tr_b16 %0, %1 offset:%2" : "=&v"(dst) : "v"(vb0), "i"(off) : "memory")
#define PV_D0(d0) do { s16x4 l0, l1, l2, l3, h0, h1, h2, h3; constexpr int b_ = VB * SHM_V + v_rd_off(d0, 0, 0);   \
        TRRD(l0, b_); TRRD(h0, b_ + 2048); TRRD(l1, b_ + 4096); TRRD(h1, b_ + 6144); TRRD(l2, b_ + 8192); TRRD(h2, b_ + 10240); TRRD(l3, b_ + 12288); TRRD(h3, b_ + 14336); \
        asm volatile("s_waitcnt lgkmcnt(0)" ::: "memory"); SBAR();   \
        o[d0] = __builtin_amdgcn_mfma_f32_32x32x16_bf16(pa0, (bf16x8){l0[0], l0[1], l0[2], l0[3], h0[0], h0[1], h0[2], h0[3]}, o[d0], 0, 0, 0);   \
        o[d0] = __builtin_amdgcn_mfma_f32_32x32x16_bf16(pa1, (bf16x8){l1[0], l1[1], l1[2], l1[3], h1[0], h1[1], h1[2], h1[3]}, o[d0], 0, 0, 0);   \
        o[d0] = __builtin_amdgcn_mfma_f32_32x32x16_bf16(pa2, (bf16x8){l2[0], l2[1], l2[2], l2[3], h2[0], h2[1], h2[2], h2[3]}, o[d0], 0, 0, 0);   \
        o[d0] = __builtin_amdgcn_mfma_f32_32x32x16_bf16(pa3, (bf16x8){l3[0], l3[1], l3[2], l3[3], h3[0], h3[1], h3[2], h3[3]}, o[d0], 0, 0, 0); } while (0)
    PV_D0(0); PV_D0(1); PV_D0(2); PV_D0(3);
#undef PV_D0
#undef TRRD
}

struct BlockRef { const bf16_t* Q; const bf16_t* K; const bf16_t* V; bf16_t* O; int qb; int b, h; };
struct Seam { bf16x8 qr[8]; bf16x8 st_v0, st_v1, st_k0, st_k1; };
#define VMW() asm volatile("s_waitcnt vmcnt(0)" ::: "memory")
#define VMWN(n) asm volatile("s_waitcnt vmcnt(%0)" :: "i"(n) : "memory")
#define LD8(p) (*reinterpret_cast<const bf16x8*>(p))
#define SLOAD_H(Kp, Vp, k0) do { const char* kb__ = (const char*)(Kp) + (size_t)(k0) * (LDP * 2); \
        S.st_v0 = LD8(kb__ + 2048 + kvoff); S.st_v1 = LD8(kb__ + (32 * LDP * 2 + 2048) + kvoff); S.st_k0 = LD8(kb__ + kvoff); S.st_k1 = LD8(kb__ + 32 * LDP * 2 + kvoff); } while (0)
#define SWRITE_HK(bf) do { *(bf16x8*)(K_lds + (bf) * SHM_K + kws) = S.st_k0; *(bf16x8*)(K_lds + (bf) * SHM_K + kws + 32 * 256) = S.st_k1; } while (0)
#define SWRITE_HV(bf) do { *(bf16x8*)(V_lds + (bf) * SHM_V + vst0) = S.st_v0; *(bf16x8*)(V_lds + (bf) * SHM_V + vst1) = S.st_v1; } while (0)
#define SWRITE_H(bf) do { SWRITE_HV(bf); SWRITE_HK(bf); } while (0)

__device__ __forceinline__ void prime(const BlockRef& cur, char* lds, Seam& S) {
    int tid = threadIdx.x; asm volatile("" : "+v"(tid));     const int wid = __builtin_amdgcn_readfirstlane(tid >> 6), lane = tid & 63, r32 = lane & 31, hi = lane >> 5;
    const int sr = tid >> 4, sc = (tid & 15) * 8, kws = KSWZ(sr, sc * 2); char* K_lds = lds + 2 * SHM_V;
    const unsigned kvoff = (unsigned)(sr * LDP + sc) * 2u, qvoff = (unsigned)(r32 * LDP + hi * 8) * 2u;
    { const char* qb__ = (const char*)cur.Q + (size_t)(wid * QBLK) * (LDP * 2);
#pragma unroll
    for (int d0 = 0; d0 < 8; ++d0) S.qr[d0] = LD8(qb__ + qvoff + d0 * 32); }
    SLOAD_H(cur.K, cur.V, 0); VMW(); SWRITE_HK(0);
    __syncthreads();
}
__device__ __forceinline__ int rel_bucket(int n) {
    if (n < 16) return n;
    const float nf = (float)n;
    int large = 16 + (int)(logf(nf / 16.0f) / 5.545177444479562f * 16.0f);
    return large < 31 ? large : 31;
}
__device__ __forceinline__ BlockRef make_ref(const P& a, int item);
__device__ __forceinline__ int block(const P& a, const BlockRef& cur, unsigned* queue, const float* rel_bias, const float* kmp, char* lds, Seam& S) {
    int tid = threadIdx.x; asm volatile("" : "+v"(tid));     const int wid = __builtin_amdgcn_readfirstlane(tid >> 6), lane = tid & 63, r32 = lane & 31, hi = lane >> 5;
    const int qb = cur.qb, NT = 4 * (qb + 1);
    const int qlo = qb * QB + wid * QBLK, qrow = qlo + r32;
    char* V_lds = lds; char* K_lds = lds + 2 * SHM_V;
    float* ws = (float*)(lds + OFF_WS) + wid * 64; float* li_l = ws, * al_l = ws + 32;
    LAS float* rtab = (LAS float*)(LAS char*)(uintptr_t)(unsigned)(uintptr_t)(lds + OFF_RTAB);
    float* kmL = (float*)(lds + OFF_KM);
    volatile int* misc = (volatile int*)(lds + OFF_MISC);
    if (tid == 0) misc[0] = (int)__hip_atomic_fetch_add(queue, 1u, __ATOMIC_RELAXED, __HIP_MEMORY_SCOPE_AGENT);
    for (int i = tid; i < 2400; i += NW * 64) { const int dist = 2047 - i; rtab[i] = dist >= 0 ? rel_bias[rel_bucket(dist) * 8 + cur.h] * (1.0f / SCALE) : -__builtin_inff(); }
    for (int i = tid; i < qb * 128; i += NW * 64) { const int j = i >> 7, dd = i & 127; const size_t o = ((size_t)(cur.b * 8 + j)) * 1024 + cur.h * 128 + dd;
        kmL[i] = (kmp[o] + kmp[o + 64 * 1024]) * (1.0f / 256.0f); }
    __syncthreads();
    const int next_item = __builtin_amdgcn_readfirstlane(misc[0]);
    const BlockRef nxt = next_item < 512 ? make_ref(a, next_item) : cur;
    unsigned selmask = 0;
    {
        float sc7[7];
#pragma unroll
        for (int j = 0; j < 7; ++j) { sc7[j] = -__builtin_inff();
            if (j < qb) { float acc = 0.f;
#pragma unroll
                for (int d0 = 0; d0 < 8; ++d0) { const u32x4 q4 = __builtin_bit_cast(u32x4, S.qr[d0]); const f32x4 k0 = *(const f32x4*)(kmL + j * 128 + d0 * 16 + hi * 8), k1 = *(const f32x4*)(kmL + j * 128 + d0 * 16 + hi * 8 + 4);
                    acc += bflo(q4[0]) * k0[0] + bfhi(q4[0]) * k0[1] + bflo(q4[1]) * k0[2] + bfhi(q4[1]) * k0[3] + bflo(q4[2]) * k1[0] + bfhi(q4[2]) * k1[1] + bflo(q4[3]) * k1[2] + bfhi(q4[3]) * k1[3]; }
                acc += __shfl_xor(acc, 32); sc7[j] = acc; } }
#pragma unroll
        for (int j = 0; j < 7; ++j) { int rank = 0;
#pragma unroll
            for (int i = 0; i < 7; ++i) { if (i != j) rank += (sc7[i] > sc7[j] || (sc7[i] == sc7[j] && i < j)) ? 1 : 0; }
            if (j < qb && (qb <= 3 || rank < 3)) selmask |= 1u << j; }
    }
    LAS unsigned* selp = (LAS unsigned*)(LAS char*)(uintptr_t)(unsigned)(uintptr_t)(lds + OFF_SEL) + tid;
    *selp = selmask;
    float m_reg = -1e30f, l_reg = 0; f32x16 o[4];
#pragma unroll
    for (int d = 0; d < 4; ++d)
#pragma unroll
        for (int r = 0; r < 16; ++r) o[d][r] = 0.f;
    const int sr = tid >> 4, sc = (tid & 15) * 8, vst0 = v_st(sr, sc), vst1 = v_st(32 + sr, sc), kws = KSWZ(sr, sc * 2);
    const unsigned kvoff = (unsigned)(sr * LDP + sc) * 2u;
    const int vb0 = (int)(uintptr_t)V_lds + v_rd_base(lane);
    const bf16_t* Kh = cur.K; const bf16_t* Vh = cur.V;
#define RESC(a) do { if (__any((a) < 1.f)) { if (hi == 0) al_l[r32] = (a); asm volatile("s_waitcnt lgkmcnt(0)" ::: "memory");              \
                     for (int d_ = 0; d_ < 4; ++d_) for (int r = 0; r < 16; ++r) o[d_][r] *= al_l[crow(r, hi)]; } } while (0)
#define KBASE(t) ((t) * KVBLK)
#define MASKT(P0_, P1_, t) do { const int kb_ = KBASE(t); const int jb_ = (t) >> 2; \
        const bool on_ = (jb_ == qb) || ((*selp >> jb_) & 1u); \
        bias_tile(P0_, P1_, on_ ? rtab + (kb_ + 4 * hi - qrow + 2047) : rtab + 2304); } while (0)
    constexpr int NQL = 8;
#define SEAM_K0() do { VMWN(NQL); SWRITE_HK(0); SBAR(); } while (0)
    f32x16 pA0, pA1, pB0, pB1; float mnA, mnB, alA, alB; bf16x8 pa0, pa1, pa2, pa3;
    SWRITE_HV(0); SBAR();
    if (NT > 1) { SLOAD_H(Kh, Vh, KBASE(1)); }
    SBAR(); qkt<0>(pA0, pA1, K_lds, r32, hi, S.qr);
    MASKT(pA0, pA1, 0); partialSM(pA0, pA1, m_reg, mnA, alA);
    if (NT > 1) { VMW(); SWRITE_H(1); }
    __syncthreads();
#define HALF_STEP(PX0, PX1, mnX, alX, PY0, PY1, alY, t, KB, VB, SB) do {                                                      \
        SBAR(); if ((t) + 1 < NT) { SLOAD_H(Kh, Vh, KBASE((t) + 1)); SBAR(); }      \
        qkt<KB>(PX0, PX1, K_lds, r32, hi, S.qr);                                             \
        finishSM(PY0, PY1, alY, l_reg, pa0, pa1, pa2, pa3); SBAR();                                                           \
        pv_tile<VB>(o, vb0, pa0, pa1, pa2, pa3); MASKT(PX0, PX1, (t)); partialSM(PX0, PX1, m_reg, mnX, alX);                                        \
        __syncthreads();                                                                                                      \
        if ((t) + 1 < NT) { VMW(); SWRITE_H(SB); }                                                                          \
        RESC(alX); __syncthreads(); } while (0)
    for (int t = 1; t + 1 < NT; t += 2) {
        HALF_STEP(pB0, pB1, mnB, alB, pA0, pA1, alA, t, 1, 0, 0);
        HALF_STEP(pA0, pA1, mnA, alA, pB0, pB1, alB, t + 1, 0, 1, 1);
    }
    { SBAR(); qkt<1>(pB0, pB1, K_lds, r32, hi, S.qr); SBAR(); }
    SLOAD_H(nxt.K, nxt.V, 0); SBAR();
    { const char* qb__ = (const char*)nxt.Q + (size_t)(wid * QBLK) * (LDP * 2); int l_ = lane; asm volatile("" : "+v"(l_));
      const unsigned qvoff = (unsigned)((l_ & 31) * LDP + (l_ >> 5) * 8) * 2u;
#pragma unroll
    for (int d0 = 0; d0 < 8; ++d0) S.qr[d0] = LD8(qb__ + qvoff + d0 * 32); }
    SBAR();
    finishSM(pA0, pA1, alA, l_reg, pa0, pa1, pa2, pa3); SBAR();
    pv_tile<0>(o, vb0, pa0, pa1, pa2, pa3);
    { MASKT(pB0, pB1, NT - 1); partialSM(pB0, pB1, m_reg, mnB, alB); __syncthreads(); RESC(alB);
      finishSM(pB0, pB1, alB, l_reg, pa0, pa1, pa2, pa3); SBAR(); pv_tile<1>(o, vb0, pa0, pa1, pa2, pa3); }
    SBAR(); SEAM_K0();
    if (hi == 0) li_l[r32] = l_reg; asm volatile("s_waitcnt lgkmcnt(0)" ::: "memory");
    float rli[16];
#pragma unroll
    for (int r = 0; r < 16; ++r) rli[r] = __builtin_amdgcn_rcpf(li_l[crow(r, hi)]);
    char* Ow = (char*)cur.O + (size_t)(wid * QBLK) * (LDO * 2); const unsigned ovoff = (unsigned)(4 * hi * LDO + r32) * 2u;
#pragma unroll
    for (int r = 0; r < 16; ++r) { const int orow0 = (r & 3) + 8 * (r >> 2);
#pragma unroll
        for (int d0 = 0; d0 < 4; ++d0) { const float v = o[d0][r] * rli[r];
            const float vn = __shfl_xor(v, 1);
            if ((r32 & 1) == 0) *(unsigned*)(Ow + (size_t)(orow0 * LDO * 2 + d0 * 64) + ovoff) = cvtpk(v, vn); } }
    __syncthreads();
    return next_item;
#undef RESC
#undef KBASE
#undef MASKT
#undef SEAM_K0
#undef HALF_STEP
}
#undef ROWP
#undef VMW
#undef VMWN
#undef LD8
#undef SLOAD_H
#undef SWRITE_HK
#undef SWRITE_HV
#undef SWRITE_H

__device__ __forceinline__ BlockRef make_ref(const P& a, int item) {
    const int qb = 7 - (item >> 6), bh = item & 63, b = bh >> 3, h = bh & 7;
    const bf16_t* proj = (const bf16_t*)(a.ws + WS_PROJ);
    BlockRef r; r.b = b; r.h = h; r.qb = qb;
    r.Q = proj + (size_t)(b * SEQ + qb * QB) * LDP + C_QB + h * HD;
    r.K = proj + (size_t)(b * SEQ) * LDP + C_KB + h * HD;
    r.V = proj + (size_t)(b * SEQ) * LDP + C_VB + h * HD;
    r.O = (bf16_t*)(a.ws + WS_OAB) + (size_t)(b * SEQ + qb * QB) * LDO + 1024 + h * HD;
    return r;
}
}
__device__ __forceinline__ void router_unit(const P& a, LAS unsigned char* lds, int unit) {
    int tid = threadIdx.x; asm volatile("" : "+v"(tid)); const int wave = __builtin_amdgcn_readfirstlane(tid >> 6), lane = tid & 63, c32 = lane & 31, hi = lane >> 5;
    const int tg = wave & 1, kq = wave >> 1;
    const bf16_t* x1 = (const bf16_t*)(a.ws + WS_X1); const float* g = a.in[11]; const float* br = a.in[13];
    unsigned char* A2 = a.ws + WS_A2; const u32x4* frag = (const u32x4*)(a.ws + WS_WRF);
    LAS float* Lw = (LAS float*)(lds + wave * 4352);
    LAS float* ssp = (LAS float*)(lds + 8 * 4352);
    LAS unsigned* hist = (LAS unsigned*)(lds + 8 * 4352 + 2048);
    LAS unsigned* base = hist + 32;
    if (tid < 32) hist[tid] = 0u;
    const int tok = unit * 64 + tg * 32 + c32;
    f32x16 L;
#pragma unroll
    for (int r = 0; r < 16; ++r) L[r] = 0.f;
    float ss = 0.f;
    const bf16_t* xr = x1 + (size_t)tok * D + 8 * hi + 256 * kq; unsigned char* ar = A2 + (size_t)tok * D + 8 * hi + 256 * kq; const float* gr = g + 8 * hi + 256 * kq;
#pragma unroll 4
    for (int s = 0; s < 16; ++s) {
        const u32x4 xw = *(const u32x4*)(xr + 16 * s); const f32x4 xa = {bflo(xw.x), bfhi(xw.x), bflo(xw.y), bfhi(xw.y)}, xb = {bflo(xw.z), bfhi(xw.z), bflo(xw.w), bfhi(xw.w)}, ga = *(const f32x4*)(gr + 16 * s), gb = *(const f32x4*)(gr + 16 * s + 4);
        ss += (xa.x * xa.x + xa.y * xa.y) + (xa.z * xa.z + xa.w * xa.w) + (xb.x * xb.x + xb.y * xb.y) + (xb.z * xb.z + xb.w * xb.w);
        const f32x4 va = xa * ga, vb = xb * gb;
        u32x4 wh; wh.x = cvt_pk_bf16(va.x, va.y); wh.y = cvt_pk_bf16(va.z, va.w); wh.z = cvt_pk_bf16(vb.x, vb.y); wh.w = cvt_pk_bf16(vb.z, vb.w);
        { u32x2 w8; w8.x = pk4_fp8(va.x, va.y, va.z, va.w); w8.y = pk4_fp8(vb.x, vb.y, vb.z, vb.w); *(u32x2*)(ar + 16 * s) = w8; }
        u32x4 wl; wl.x = cvt_pk_bf16(va.x - bflo(wh.x), va.y - bfhi(wh.x)); wl.y = cvt_pk_bf16(va.z - bflo(wh.y), va.w - bfhi(wh.y));
        wl.z = cvt_pk_bf16(vb.x - bflo(wh.z), vb.y - bfhi(wh.z)); wl.w = cvt_pk_bf16(vb.z - bflo(wh.w), vb.w - bfhi(wh.w));
        const bf16x8 ah = __builtin_bit_cast(bf16x8, wh), al = __builtin_bit_cast(bf16x8, wl);
        const bf16x8 bh = __builtin_bit_cast(bf16x8, frag[(16 * kq + s) * 64 + lane]), bl = __builtin_bit_cast(bf16x8, frag[4096 + (16 * kq + s) * 64 + lane]);
        L = __builtin_amdgcn_mfma_f32_32x32x16_bf16(ah, bh, L, 0, 0, 0);
        L = __builtin_amdgcn_mfma_f32_32x32x16_bf16(ah, bl, L, 0, 0, 0);
        L = __builtin_amdgcn_mfma_f32_32x32x16_bf16(al, bh, L, 0, 0, 0);
    }
#pragma unroll
    for (int r = 0; r < 16; ++r) Lw[((r & 3) + 8 * (r >> 2) + 4 * hi) * 33 + c32] = L[r];
    ssp[wave * 64 + lane] = ss;
    __syncthreads();
    int e4[4] = {0, 0, 0, 0}; float w4[4] = {0.f, 0.f, 0.f, 0.f}; unsigned loc[4] = {0u, 0u, 0u, 0u}; float rstd = 0.f;
    const bool sel = (wave < 2) && (hi == 0);
    if (sel) {
        float sst = 0.f;
#pragma unroll
        for (int q = 0; q < 4; ++q) sst += ssp[(wave + 2 * q) * 64 + c32] + ssp[(wave + 2 * q) * 64 + 32 + c32];
        rstd = 1.0f / sqrtf(sst * (1.0f / D) + EPS);
        float lg[32];
#pragma unroll
        for (int e = 0; e < 32; ++e) { const LAS float* lp = (const LAS float*)(lds + wave * 4352) + c32 * 33 + e; lg[e] = (lp[0] + lp[2 * 1088] + lp[4 * 1088] + lp[6 * 1088]) * rstd + br[e]; }
        unsigned used = 0u; float v4[4];
#pragma unroll
        for (int p = 0; p < 4; ++p) { float best = -__builtin_inff(); int bi = 0;
#pragma unroll
            for (int e = 0; e < 32; ++e) { const bool take = !((used >> e) & 1u) && lg[e] > best; best = take ? lg[e] : best; bi = take ? e : bi; }
            used |= 1u << bi; e4[p] = bi; v4[p] = best; }
        float sum = 0.f;
#pragma unroll
        for (int p = 0; p < 4; ++p) { w4[p] = expf(v4[p] - v4[0]); sum += w4[p]; }
        const float inv = 1.0f / sum;
#pragma unroll
        for (int p = 0; p < 4; ++p) { w4[p] *= inv; loc[p] = __hip_atomic_fetch_add(hist + e4[p], 1u, __ATOMIC_RELAXED, __HIP_MEMORY_SCOPE_WORKGROUP); }
    }
    __syncthreads();
    if (tid < 32) base[tid] = __hip_atomic_fetch_add((unsigned*)(a.ws + WS_CTL) + CW_COUNTS + tid, hist[tid], RLX_AGENT);
    __syncthreads();
    if (sel) {
        int* tope = (int*)(a.ws + WS_TOPE) + (size_t)tok * 4; float* wts = (float*)(a.ws + WS_WTS) + (size_t)tok * 4; int* slot = (int*)(a.ws + WS_SLOT) + (size_t)tok * 4;
#pragma unroll
        for (int p = 0; p < 4; ++p) { const int sl_ = (int)(base[e4[p]] + loc[p]); tope[p] = e4[p]; wts[p] = w4[p]; slot[p] = sl_;
            ((int*)(a.ws + WS_ROWE))[(size_t)e4[p] * T + sl_] = tok; ((float*)(a.ws + WS_RSTE))[(size_t)e4[p] * T + sl_] = rstd; }
    }
    __syncthreads();
}

__device__ __forceinline__ void moe_tables(const P& a, LAS unsigned char* lds) {
    int tid = threadIdx.x; asm volatile("" : "+v"(tid)); const int wave = tid >> 6, lane = tid & 63, e = lane & 31;
    LAS int* pstart = (LAS int*)(lds + LDS_MOE); LAS int* cnt = pstart + 64; LAS int* tile_e = pstart + 128;
    const unsigned* counts = (const unsigned*)(a.ws + WS_CTL) + CW_COUNTS;
    const int c = (int)counts[e]; const int p = ((c + 255) >> 8) << 8; int inc = p;
#pragma unroll
    for (int o = 1; o < 32; o <<= 1) { const int t = __builtin_amdgcn_ds_bpermute(((lane - o) & 63) << 2, inc); if (e >= o) inc += t; }
    if (tid < 32) { cnt[e] = c; pstart[e] = inc - p; if (e == 31) { pstart[32] = inc; tile_e[MAXTILES] = inc >> 8; } }
    for (int t = wave * 36; t < wave * 36 + 36; ++t) { const unsigned long long m = __ballot(inc <= t * 256); const int ee = __builtin_popcount((unsigned)m); if (lane == 0) tile_e[t] = ee < NE ? ee : NE - 1; }
    __syncthreads();
}

__device__ __forceinline__ void combine_rows(const P& a, LAS unsigned char* lds, int vcu, int G, int wave, int lane) {
    const LAS int* pstart = (const LAS int*)(lds + LDS_MOE);
    const int gw = vcu * NWAVES + wave, NGW = G * NWAVES;
    const bf16_t* X1 = (const bf16_t*)(a.ws + WS_X1); float* X = (float*)(a.ws + WS_X2); const unsigned char* Y = a.ws + WS_YROWS; bf16_t* A3 = (bf16_t*)(a.ws + WS_H);
    const int* tope = (const int*)(a.ws + WS_TOPE); const int* slot = (const int*)(a.ws + WS_SLOT); const float* wts = (const float*)(a.ws + WS_WTS); const float* g = a.in[20];
    f32x4 gv[4];
#pragma unroll
    for (int j = 0; j < 4; ++j) gv[j] = *((const f32x4*)g + lane + 64 * j);
    for (int m = gw; m < T; m += NGW) {
        f32x4* xr = (f32x4*)(X + (size_t)m * D) + lane; const u32x2* x1r = (const u32x2*)(X1 + (size_t)m * D) + lane; f32x4 v[4];
#pragma unroll
        for (int j = 0; j < 4; ++j) { const u32x2 xq = __builtin_nontemporal_load(x1r + 64 * j); v[j] = (f32x4){bflo(xq.x), bfhi(xq.x), bflo(xq.y), bfhi(xq.y)}; }
#pragma unroll
        for (int k = 0; k < 4; ++k) { const int d = __builtin_amdgcn_readfirstlane(pstart[tope[m * 4 + k]] + slot[m * 4 + k]); const float w = __uint_as_float(__builtin_amdgcn_readfirstlane(__float_as_uint(wts[m * 4 + k])));
            const unsigned* yr = (const unsigned*)(Y + (size_t)d * D) + lane;
#pragma unroll
            for (int j = 0; j < 4; ++j) { const int y = (int)__builtin_nontemporal_load(yr + 64 * j);
                v[j].x += w * __builtin_amdgcn_cvt_f32_fp8(y, 0); v[j].y += w * __builtin_amdgcn_cvt_f32_fp8(y, 1); v[j].z += w * __builtin_amdgcn_cvt_f32_fp8(y, 2); v[j].w += w * __builtin_amdgcn_cvt_f32_fp8(y, 3); } }
        float s = 0.f;
#pragma unroll
        for (int j = 0; j < 4; ++j) s += (v[j].x * v[j].x + v[j].y * v[j].y) + (v[j].z * v[j].z + v[j].w * v[j].w);
        const float rstd = 1.0f / sqrtf(wave_sum(s) * (1.0f / D) + EPS);
        unsigned* o4 = (unsigned*)((unsigned char*)A3 + (size_t)m * D) + lane;
#pragma unroll
        for (int j = 0; j < 4; ++j) { xr[64 * j] = v[j]; o4[64 * j] = pk4_fp8(v[j].x * rstd * gv[j].x, v[j].y * rstd * gv[j].y, v[j].z * rstd * gv[j].z, v[j].w * rstd * gv[j].w); }
    }
}
__device__ __forceinline__ void final_rows(const P& a, int vcu, int G, int wave, int lane) {
    const int gw = vcu * NWAVES + wave, NGW = G * NWAVES;
    const float* X = (const float*)(a.ws + WS_X2); float* OUT = a.out; const bf16_t* PG = (const bf16_t*)(a.ws + WS_PGATE); const bf16_t* PP = (const bf16_t*)(a.ws + WS_PPROJ);
    f32x4 gp[4], gf[4];
#pragma unroll
    for (int j = 0; j < 4; ++j) { gp[j] = *((const f32x4*)a.in[23] + lane + 64 * j); gf[j] = *((const f32x4*)a.in[24] + lane + 64 * j); }
    for (int m = gw; m < T; m += NGW) {
        const f32x4* xr = (const f32x4*)(X + (size_t)m * D) + lane; f32x4* orow = (f32x4*)(OUT + (size_t)m * D) + lane; const u32x2* pgr = (const u32x2*)(PG + (size_t)m * D) + lane; const u32x2* ppr = (const u32x2*)(PP + (size_t)m * D) + lane;
        f32x4 v[4], pp[4], pg[4]; float sp = 0.f;
#pragma unroll
        for (int j = 0; j < 4; ++j) { v[j] = __builtin_nontemporal_load(xr + 64 * j); const u32x2 q = __builtin_nontemporal_load(ppr + 64 * j), gq = __builtin_nontemporal_load(pgr + 64 * j);
            pp[j] = (f32x4){bflo(q.x), bfhi(q.x), bflo(q.y), bfhi(q.y)}; pg[j] = (f32x4){bflo(gq.x), bfhi(gq.x), bflo(gq.y), bfhi(gq.y)};
            sp += (pp[j].x * pp[j].x + pp[j].y * pp[j].y) + (pp[j].z * pp[j].z + pp[j].w * pp[j].w); }
        const float rp = 1.0f / sqrtf(wave_sum(sp) * (1.0f / D) + EPS); float s = 0.f;
#pragma unroll
        for (int j = 0; j < 4; ++j) { v[j] = v[j] + pg[j] * (pp[j] * rp * gp[j]); s += (v[j].x * v[j].x + v[j].y * v[j].y) + (v[j].z * v[j].z + v[j].w * v[j].w); }
        const float rstd = 1.0f / sqrtf(wave_sum(s) * (1.0f / D) + EPS);
#pragma unroll
        for (int j = 0; j < 4; ++j) __builtin_nontemporal_store(v[j] * rstd * gf[j], orow + 64 * j);
    }
}
struct Args { P p; };
template <int PH_LO, int PH_HI>
__global__ void __launch_bounds__(NTHREADS, 2) hybrid_fwd(Args args) {
    extern __shared__ __attribute__((aligned(16))) unsigned char lds_raw[];
    LAS unsigned char* lds = (LAS unsigned char*)lds_raw;
    const P& a = args.p;
    const int tid = threadIdx.x;
#define FRESH_WL() int t_ = threadIdx.x; asm volatile("" : "+v"(t_)); const int w_ = __builtin_amdgcn_readfirstlane(t_ >> 6), l_ = t_ & 63
    const int G = gridDim.x; const int bx = blockIdx.x; const int vcu = (G % 8 == 0) ? (bx % 8) * (G / 8) + bx / 8 : bx;
    unsigned* ctl = (unsigned*)(a.ws + WS_CTL);
    for (int u = tid; u < (LDS_BYTES - LDSCTL_OFF) / 4; u += NTHREADS) ((LAS unsigned*)(lds + LDSCTL_OFF))[u] = 0u;
    __syncthreads();
#if MK_PER_PHASE
#define GRID_BAR() do { } while (0)
#else
    XcdBarrier bar = xcd_barrier_post(ctl + CW_BAR, (volatile LAS unsigned*)(lds + MISC_OFF + 32));
#define GRID_BAR() xcd_barrier(bar)
#endif
    constexpr int lo = PH_LO, hi = PH_HI;
#define IN(k) (lo <= (k) && (k) < hi)
#define SEAM(k) do { if constexpr (IN(k) && IN((k) + 1)) GRID_BAR(); } while (0)
    unsigned char* ws = a.ws;

    if constexpr (IN(0)) { FRESH_WL(); p0_prologue(a, lds, vcu, G, w_, l_); }
    SEAM(0);
    if constexpr (IN(1)) {
        { pg8::DenseSched S; S.o.init(T / 256, 20, G, bx); S.Bt = (const char*)(ws + WS_WIN); S.K = D; S.gap_at = 12; S.gap_by = 12;
          pg8::EpiProj<false> E{(bf16_t*)(ws + WS_PROJ), (float*)(ws + WS_KMP)};
          pg8::gemm_phase(lds, (const char*)(ws + WS_H), D, D, D, S, E); }
        { pg8::DenseSched S; S.o.init(T / 256, 12, G, bx); S.Bt = (const char*)(ws + WS_WIN8); S.K = D; S.es = 1; S.pn0 = 12; S.bt_out = false;
          pg8::EpiProj<true> E{(bf16_t*)(ws + WS_PROJ), (float*)(ws + WS_KMP)};
          pg8::gemm_phase(lds, (const char*)(ws + WS_H8), D, D, D, S, E); }
    }
    SEAM(1);
    if constexpr (IN(2)) { for (int u = vcu; u < NB * 32; u += G) gla_prep_unit(a, lds, u); }
    SEAM(2);
    if constexpr (IN(3)) { for (int u = vcu; u < 512; u += G) gla_combine_unit(a, u); }
    SEAM(3);
    if constexpr (IN(4)) {
        for (int u = vcu; u < 1024; u += G) gla_out_unit(a, lds, u);
        __syncthreads();
    }
    if constexpr (IN(5)) {
        if ((vcu & 1) == 0) { FRESH_WL(); expert_convert(a, lds, vcu >> 1, G >> 1, w_, l_); __syncthreads(); }
        unsigned* queue = ctl + CW_QUEUE;
        volatile LAS int* qslot = (volatile LAS int*)(lds + LDSCTL_OFF + 1024);
        if (tid == 0) qslot[0] = (int)__hip_atomic_fetch_add(queue, 1u, RLX_AGENT);
        __syncthreads();
        int item = __builtin_amdgcn_readfirstlane(qslot[0]);
        if (item < 512) {
            moba::Seam S;
            moba::BlockRef cur = moba::make_ref(a, item);
            moba::prime(cur, (char*)lds_raw, S);
            for (;;) {
                const int nitem = moba::block(a, cur, queue, a.in[2], (const float*)(ws + WS_KMP), (char*)lds_raw, S);
                if (nitem >= 512) break;
                cur = moba::make_ref(a, nitem);
            }
        }
    }
    SEAM(5);
    if constexpr (IN(6)) {
        pg8::ChainSched S; S.o.init(T / 256, D / 256, G, bx); S.Bt = (const char*)(ws + WS_WUP); S.K = 1024;
        pg8::EpiMerge E{(const bf16_t*)(ws + WS_PROJ), (bf16_t*)(ws + WS_Y)};
        pg8::gemm_phase(lds, (const char*)(ws + WS_OAB), 1024, 2048, 2048, S, E);
    }
    SEAM(6);
    if constexpr (IN(7)) {
        pg8::DenseSched S; S.o.init(T / 256, D / 256, G, bx); S.Bt = (const char*)(ws + WS_WO); S.K = D;
        pg8::EpiResF32 E{a.in[0], (bf16_t*)(ws + WS_X1)};
        pg8::gemm_phase(lds, (const char*)(ws + WS_Y), D, D, D, S, E);
    }
    SEAM(7);
    if constexpr (IN(8)) { for (int u = vcu; u < T / 64; u += G) router_unit(a, lds, u); }
    SEAM(8);
    if constexpr (IN(9)) {
        moe_tables(a, lds); const LAS int* tab = (const LAS int*)(lds + LDS_MOE); const int ntile = __builtin_amdgcn_readfirstlane(tab[128 + MAXTILES]);
        pg8::MoeSched<true> S; S.o.init(ntile, 8, G, bx); S.Bt = (const char*)a.out; S.K = D; S.rows_per_e = 2048; S.tab = tab; S.row_e = (const int*)(ws + WS_ROWE); S.es = 1;
        pg8::EpiGlu E{(unsigned char*)(ws + WS_HMID), (const float*)(ws + WS_RSTE), tab, a.in[15], a.in[17], (const float*)(ws + WS_CTL) + 131072, lds};
        pg8::gemm_phase(lds, (const char*)(ws + WS_A2), D, D, D, S, E);
        const int extra = (ntile * 8) % G, nidle = G - extra;
        if (bx >= extra) { __syncthreads();
            pg8::DenseSched S2; S2.o.init(T / 256, D / 256, nidle, bx - extra); S2.Bt = (const char*)(ws + WS_WPP); S2.K = 256;
            pg8::EpiBf16<0, false> E2{(bf16_t*)(ws + WS_PPROJ), D, nullptr, 0, 1.0f};
            pg8::gemm_phase(lds, (const char*)(ws + WS_PB), 256, 256, 256, S2, E2); }
    }
    SEAM(9);
    if constexpr (IN(10)) {
        moe_tables(a, lds); const LAS int* tab = (const LAS int*)(lds + LDS_MOE); const int ntile = __builtin_amdgcn_readfirstlane(tab[128 + MAXTILES]);
        pg8::MoeSched<false> S; S.o.init(ntile, 4, G, bx); S.Bt = (const char*)(ws + WS_W2T); S.K = FF; S.rows_per_e = 1024; S.tab = tab; S.row_e = nullptr; S.es = 1;
        pg8::EpiDownF8 E{(unsigned char*)(ws + WS_YROWS), a.in[19]};
        pg8::gemm_phase(lds, (const char*)(ws + WS_HMID), FF, FF, FF, S, E);
    }
    SEAM(10);
    if constexpr (IN(11)) { moe_tables(a, lds); FRESH_WL(); combine_rows(a, lds, vcu, G, w_, l_); }
    SEAM(11);
    if constexpr (IN(12)) {
        { pg8::DenseSched S; S.o.init(T / 256, D / 256, G, bx); S.Bt = (const char*)(ws + WS_WPG); S.K = D; S.es = 1;
          pg8::EpiBf16<1, false, true> E{(bf16_t*)(ws + WS_PGATE), D, nullptr, 0, 1.0f / 32.0f};
          pg8::gemm_phase(lds, (const char*)(ws + WS_H), D, D, D, S, E); }
    }
    SEAM(12);
    if constexpr (IN(13)) { FRESH_WL(); final_rows(a, vcu, G, w_, l_); }
#undef FRESH_WL
#undef IN
#undef SEAM
#undef GRID_BAR
}

template <int LO, int HI> static void launch_range(const Args& a, int grid, hipStream_t stream) {
    static bool attr = false;
    if (!attr) { attr = true; if (hipFuncSetAttribute((const void*)hybrid_fwd<LO, HI>, hipFuncAttributeMaxDynamicSharedMemorySize, LDS_BYTES) != hipSuccess) fprintf(stderr, "kernel_launch: hipFuncSetAttribute failed\n"); }
    hipLaunchKernelGGL((hybrid_fwd<LO, HI>), dim3(grid), dim3(NTHREADS), LDS_BYTES, stream, a);
}
extern "C" void kernel_launch(void* const* d_in, const int* in_sizes, int n_in, void* d_out, int out_size, void* d_ws, size_t ws_size, hipStream_t stream) {
    static int grid = 0;
    if (grid == 0) {
        static const int expect[25] = {T * D, T * 256, 256, 1024, 1024 * D_IN, 16 * 512, 512, 256, 1048576, 1048576, 1048576, 1024, 32768, 32, 33554432, 32768, 33554432, 32768, 33554432, 32768, 1024, 1048576, 262144, 1024, 1024};
        bool okk = (n_in == 25);
        for (int i = 0; okk && i < 25; ++i) if (in_sizes[i] != expect[i]) { fprintf(stderr, "kernel_launch: input %d has %d elements, expected %d\n", i, in_sizes[i], expect[i]); okk = false; }
        if (!okk || out_size != T * D || ws_size < WS_END) { fprintf(stderr, "kernel_launch: unexpected shapes (n_in %d, in0 %d, out %d, ws %zu); nothing launched\n", n_in, n_in > 0 ? in_sizes[0] : -1, out_size, ws_size); grid = -1; return; }
        int dev = 0, cus = 0;
        if (hipGetDevice(&dev) != hipSuccess || hipDeviceGetAttribute(&cus, hipDeviceAttributeMultiprocessorCount, dev) != hipSuccess) { grid = -1; return; }
        grid = cus;
    }
    if (grid < 0) return;
    (void)hipMemsetAsync((char*)d_ws + WS_CTL, 0, CTL_ZERO_BYTES, stream);
    Args a{};
    for (int i = 0; i < 25; ++i) a.p.in[i] = (const float*)d_in[i];
    a.p.out = (float*)d_out; a.p.ws = (unsigned char*)d_ws;
#if MK_PER_PHASE
#ifndef MK_LAST
#define MK_LAST 13
#endif
#ifndef MK_REPEAT
#define MK_REPEAT 0
#endif
#define LR(k) do { if ((k) <= MK_LAST) for (int r_ = 0; r_ < 1 + ((MK_REPEAT >> (k)) & 1); ++r_) launch_range<(k), (k) + 1>(a, grid, stream); } while (0)
    LR(0); LR(1); LR(2); LR(3); LR(4); LR(5); LR(6); LR(7); LR(8); LR(9); LR(10); LR(11); LR(12); LR(13);
#undef LR
#else
    launch_range<0, NPHASES>(a, grid, stream);
#endif
}
```

```cpp
#include <hip/hip_runtime.h>
#include <cstdio>
#include <cstdint>

#define LAS __attribute__((address_space(3)))
#define GAS __attribute__((address_space(1)))
typedef unsigned short bf16_t;
typedef short bf16x8 __attribute__((ext_vector_type(8)));
typedef short s16x4 __attribute__((ext_vector_type(4)));
typedef float f32x2 __attribute__((ext_vector_type(2)));
typedef float f32x4 __attribute__((ext_vector_type(4)));
typedef float f32x16 __attribute__((ext_vector_type(16)));
typedef unsigned u32x2 __attribute__((ext_vector_type(2)));
typedef unsigned u32x4 __attribute__((ext_vector_type(4)));
typedef int i32x4 __attribute__((ext_vector_type(4)));
typedef int i32x8 __attribute__((ext_vector_type(8)));
typedef GAS unsigned gu32;
#define RLX_AGENT __ATOMIC_RELAXED, __HIP_MEMORY_SCOPE_AGENT
#define LDS_WAIT() asm volatile("s_waitcnt lgkmcnt(0)" ::: "memory")
#define VM_WAIT() asm volatile("s_waitcnt vmcnt(0)" ::: "memory")

#ifndef MK_PER_PHASE
#define MK_PER_PHASE 0
#endif

constexpr int NB = 8, SEQ = 2048, T = NB * SEQ, D = 1024;
constexpr int NPROJ = 8192;
constexpr int C_QA = 0, C_KA = 512, C_VA = 1024, C_RA = 2048, C_QB = 3072, C_KB = 4096, C_VB = 5120, C_GA = 6144, C_GB = 7168;
constexpr int SRC_ALOW = 3072, D_IN = 8208;
constexpr int NE = 32, FF = 1024, MAXTILES = 288, MAXROWS = MAXTILES * 256;
constexpr float EPS = 1e-6f;
constexpr int NWAVES = 8, NTHREADS = 512;
constexpr int NPHASES = 14;

constexpr size_t MiB = 1u << 20;
constexpr size_t WS_CTL = 0, CTL_ZERO_BYTES = 1 * MiB;
constexpr size_t WS_SMALL = 1 * MiB;
constexpr size_t WS_KMP   = WS_SMALL;
constexpr size_t WS_DEC   = WS_KMP + 512 * 1024;
constexpr size_t WS_TOPE  = WS_DEC + 512 * 1024;
constexpr size_t WS_WTS   = WS_TOPE + 256 * 1024;
constexpr size_t WS_SLOT  = WS_WTS + 256 * 1024;
constexpr size_t WS_DEST  = WS_SLOT + 256 * 1024;
constexpr size_t WS_ROWTOK = WS_DEST + 256 * 1024;
constexpr size_t WS_RSTDS = WS_ROWTOK + 320 * 1024;
constexpr size_t WS_RSTD  = WS_RSTDS + 320 * 1024;
constexpr size_t WS_TILEE = WS_RSTD + 64 * 1024;
constexpr size_t WS_WALT  = WS_TILEE + 4 * 1024;
constexpr size_t WS_WRF   = WS_WALT + 32 * 1024;
static_assert(WS_WRF + 128 * 1024 <= 6 * MiB, "small map");
constexpr size_t WS_WO = 6 * MiB, WS_WPG = 8 * MiB, WS_WPP = 10 * MiB, WS_WUP = 12 * MiB, WS_WIN = 16 * MiB;
constexpr size_t WS_PB = 34 * MiB;
constexpr size_t WS_H  = 42 * MiB;
constexpr size_t WS_PROJ = 74 * MiB;
constexpr size_t WS_QG = 330 * MiB, WS_KG = 346 * MiB;
constexpr size_t WS_SLOC = 426 * MiB;
constexpr size_t WS_OAB = 362 * MiB;
constexpr size_t WS_H8 = 426 * MiB;
constexpr size_t WS_WIN8 = 442 * MiB;
constexpr size_t WS_Y = 330 * MiB;
constexpr size_t WS_W2T = 42 * MiB;
constexpr size_t WS_A2 = 330 * MiB;
constexpr size_t WS_HMID = 138 * MiB;
constexpr size_t WS_X1 = 74 * MiB;
constexpr size_t WS_X2 = 138 * MiB;
constexpr size_t WS_YROWS = 282 * MiB;
constexpr size_t WS_PGATE = 330 * MiB, WS_PPROJ = 226 * MiB;
constexpr size_t WS_ROWE = 490 * MiB;
constexpr size_t WS_RSTE = 492 * MiB;
constexpr size_t WS_END = 506 * MiB;

constexpr int CW_BAR = 4096;
constexpr int CW_COUNTS = 16384;
constexpr int CW_QUEUE = 16384 + 64;

constexpr int RING_BYTES = 131072;
constexpr int LDSCTL_OFF = RING_BYTES, MISC_OFF = LDSCTL_OFF + 320;
constexpr int LDS_MOE = LDSCTL_OFF + 10240;
constexpr int EPF_OFF = LDSCTL_OFF + 12288;
constexpr int LDS_BYTES = 151552;

typedef __bf16 bf16v2_t __attribute__((ext_vector_type(2)));
__device__ __forceinline__ unsigned cvt_pk_bf16(float lo, float hi) { const f32x2 v = {lo, hi}; return __builtin_bit_cast(unsigned, __builtin_convertvector(v, bf16v2_t)); }
__device__ __forceinline__ unsigned pk4_fp8(float a, float b, float c, float d) { int w = 0; w = __builtin_amdgcn_cvt_pk_fp8_f32(a, b, w, false); w = __builtin_amdgcn_cvt_pk_fp8_f32(c, d, w, true); return (unsigned)w; }
__device__ __forceinline__ float bf2f(unsigned short s) { return __uint_as_float(((unsigned)s) << 16); }
__device__ __forceinline__ float bflo(unsigned w) { return __uint_as_float(w << 16); }
__device__ __forceinline__ float bfhi(unsigned w) { return __uint_as_float(w & 0xffff0000u); }
__device__ __forceinline__ float fsigmoid(float x) { return __builtin_amdgcn_rcpf(1.0f + __builtin_amdgcn_exp2f(-1.4426950408889634f * x)); }
__device__ __forceinline__ float wave_sum(float v) {
#pragma unroll
    for (int o = 1; o < 64; o <<= 1) v += __shfl_xor(v, o);
    return v;
}
__device__ __forceinline__ bf16x8 pack8(f32x4 a, f32x4 b) {
    u32x4 w = {cvt_pk_bf16(a[0], a[1]), cvt_pk_bf16(a[2], a[3]), cvt_pk_bf16(b[0], b[1]), cvt_pk_bf16(b[2], b[3])};
    return __builtin_bit_cast(bf16x8, w);
}

#define XB_TMO      128
#define XB_XCNT(j)  (256  + 64 * (j))
#define XB_XSUB(j)  (1280 + 64 * (j))
#define XB_XGEN(j)  (2304 + 64 * (j))
#define XB_TOP      3328
#define XB_TOPGEN   3392
#define XCD_BAR_WORDS 3456
#define XB_SPIN_CAP (1u << 18)

__device__ __forceinline__ unsigned xb_ld(unsigned* p)              { return __hip_atomic_load(p, __ATOMIC_RELAXED, __HIP_MEMORY_SCOPE_AGENT); }
__device__ __forceinline__ unsigned xb_add(unsigned* p, unsigned v) { return __hip_atomic_fetch_add(p, v, __ATOMIC_RELAXED, __HIP_MEMORY_SCOPE_AGENT); }
__device__ __forceinline__ unsigned xb_xcc_id() { return (unsigned)__builtin_amdgcn_s_getreg((3 << 11) | 20) & 0xFu; }
#define XB_SPIN(cond, bar) do { unsigned _sp = 0; while (cond) { __builtin_amdgcn_s_sleep(1); \
    if ((++_sp & 255u) == 0u) { if (xb_ld(&(bar)[XB_TMO])) break; if (_sp > XB_SPIN_CAP) { atomicAdd(&(bar)[XB_TMO], 1u); break; } } } } while (0)

struct XcdBarrier { unsigned* bar; unsigned x; volatile LAS unsigned* st; };

__device__ __forceinline__ XcdBarrier xcd_barrier_post(unsigned* bar, volatile LAS unsigned* st) {
    XcdBarrier b; b.bar = bar; b.x = xb_xcc_id(); b.st = st;
    if (threadIdx.x == 0) (void)xb_add(&bar[XB_XCNT(b.x)], 1u);
    return b;
}
__device__ __forceinline__ void xcd_barrier_complete(unsigned* bar, unsigned x, unsigned& nloc, unsigned& nx) {
    const unsigned G = gridDim.x * gridDim.y * gridDim.z;
    unsigned sum, cnt, mine, sp = 0u;
    for (;;) {
        sum = 0u; cnt = 0u; mine = 0u;
#pragma unroll
        for (unsigned j = 0; j < 16; ++j) { const unsigned c = xb_ld(&bar[XB_XCNT(j)]); sum += c; cnt += (c > 0u) ? 1u : 0u; mine = (j == x) ? c : mine; }
        if (sum == G) break;
        __builtin_amdgcn_s_sleep(1);
        if ((++sp & 255u) == 0u) { if (xb_ld(&bar[XB_TMO])) break; if (sp > XB_SPIN_CAP) { atomicAdd(&bar[XB_TMO], 1u); break; } }
    }
    nloc = mine > 0u ? mine : 1u; nx = cnt > 0u ? cnt : 1u;
}
__device__ __forceinline__ void xcd_barrier(const XcdBarrier& b) {
    asm volatile("s_waitcnt vmcnt(0)" ::: "memory");
    __syncthreads();
    if (threadIdx.x == 0) {
        unsigned* bar = b.bar;
        __builtin_amdgcn_s_waitcnt(0);
        unsigned nloc = b.st[0], nx = b.st[1];
        if (nloc == 0u) { xcd_barrier_complete(bar, b.x, nloc, nx); b.st[0] = nloc; b.st[1] = nx; }
        const unsigned old = xb_add(&bar[XB_XSUB(b.x)], 1u);
        const unsigned gen = old / nloc;
        if (old + 1u == (gen + 1u) * nloc) {
            __builtin_amdgcn_fence(__ATOMIC_RELEASE, "agent");
            asm volatile("s_waitcnt vmcnt(0)" ::: "memory");
            const unsigned og = xb_add(&bar[XB_TOP], 1u);
            const unsigned tg = og / nx;
            if (og + 1u == (tg + 1u) * nx) xb_add(&bar[XB_TOPGEN], 1u);
            else XB_SPIN(xb_ld(&bar[XB_TOPGEN]) == tg, bar);
            __builtin_amdgcn_fence(__ATOMIC_ACQUIRE, "agent");
            xb_add(&bar[XB_XGEN(b.x)], 1u);
            asm volatile("s_waitcnt vmcnt(0)" ::: "memory");
        } else {
            XB_SPIN(xb_ld(&bar[XB_XGEN(b.x)]) == gen, bar);
            __builtin_amdgcn_fence(__ATOMIC_ACQUIRE, "agent");
            asm volatile("s_waitcnt vmcnt(0)" ::: "memory");
        }
    }
    __syncthreads();
}
#ifndef MK_SCL
#define MK_SCL 0
#endif
namespace pg8 {
constexpr int BM = 256, BK = 64, HALF = 128, HTB = HALF * BK * 2, STAGE_BYTES = 8 * HTB, NXCD = 8, WGM = 8;

__host__ __device__ __forceinline__ int lds_byte(int r, int c) { const int st = (r >> 4) * 2 + (c >> 5), rr = r & 15, cc = c & 31, ob = rr * 64 + cc * 2; return st * 1024 + (ob ^ (((ob >> 9) & 1) << 5)); }
__host__ __device__ __forceinline__ void stage_rc(int b, int& R, int& C) { const int st = b / 1024, sb = b % 1024, swz = sb ^ (((sb >> 9) & 1) << 5); R = (st >> 1) * 16 + swz / 64; C = (st & 1) * 32 + (swz % 64) / 2; }
__host__ __device__ __forceinline__ int perm32(int rho) { const int n = rho >> 4, i = rho & 15; return 8 * (i >> 2) + 4 * n + (i & 3); }

struct Unit { int pm, pn, e, s; };

struct TileOrder {
    int nM, nN, nwg, G, c;
    __device__ __forceinline__ void init(int nM_, int nN_, int G_, int c_) { nM = nM_; nN = nN_; nwg = nM * nN; G = G_; c = c_; }
    __device__ __forceinline__ bool next(int i, int& pm, int& pn) const {
        const unsigned L = (unsigned)i * (unsigned)G + (unsigned)c; if (L >= (unsigned)nwg) return false;
        int wgid = (int)L; { const int q = nwg / NXCD, r = nwg % NXCD, xcd = wgid % NXCD, off = wgid / NXCD; wgid = (xcd < r ? xcd * (q + 1) : r * (q + 1) + (xcd - r) * q) + off; }
        const int nig = WGM * nN, gid = wgid / nig, fm = gid * WGM, gsz = (nM - fm) < WGM ? (nM - fm) : WGM;
        pm = fm + ((wgid % nig) % gsz); pn = (wgid % nig) / gsz; return true;
    }
};
struct DenseSched {
    TileOrder o; const char* Bt; int K; int es = 2; int gap_at = 1 << 30, gap_by = 0, pn0 = 0; bool bt_out = true;
    __device__ __forceinline__ bool next(int i, Unit& u) const { int p; if (!o.next(i, u.pm, p)) return false; u.e = p; u.pn = p + (p >= gap_at ? gap_by : 0) + pn0; return true; }
    __device__ __forceinline__ unsigned a_row(const Unit& u, int r) const { return (unsigned)(u.pm * BM + r); }
    __device__ __forceinline__ unsigned a_koff(const Unit&) const { return 0u; }
    __device__ __forceinline__ const char* b_base(const Unit& u) const { return Bt + (size_t)(bt_out ? u.pn : u.e) * BM * K * es; }
};
struct ChainSched {
    TileOrder o; const char* Bt; int K;
    __device__ __forceinline__ bool next(int i, Unit& u) const { if (!o.next(i >> 1, u.pm, u.pn)) return false; u.e = i & 1; return true; }
    __device__ __forceinline__ unsigned a_row(const Unit& u, int r) const { return (unsigned)(u.pm * BM + r); }
    __device__ __forceinline__ unsigned a_koff(const Unit& u) const { return (unsigned)(u.e * K * 2); }
    __device__ __forceinline__ const char* b_base(const Unit& u) const { return Bt + (size_t)u.pn * BM * (2 * K) * 2 + (size_t)u.e * K * 2; }
};
template <bool GATHER> struct MoeSched {
    TileOrder o; const char* Bt; int K; int rows_per_e; const LAS int* tab; const int* row_e; int es;
    __device__ __forceinline__ bool next(int i, Unit& u) const { if (!o.next(i, u.pm, u.pn)) return false; u.e = __builtin_amdgcn_readfirstlane(tab[128 + u.pm]); return true; }
    __device__ __forceinline__ unsigned a_row(const Unit& u, int r) const {
        if (GATHER) { const int lr = u.pm * BM + r - tab[u.e]; return lr < tab[64 + u.e] ? (unsigned)row_e[(size_t)u.e * T + lr] : 0u; }
        else return (unsigned)(u.pm * BM + r); }
    __device__ __forceinline__ unsigned a_koff(const Unit&) const { return 0u; }
    __device__ __forceinline__ const char* b_base(const Unit& u) const { return Bt + ((size_t)u.e * rows_per_e + (size_t)u.pn * BM) * K * es; }
};

template <class Epi, class Sched>
__device__ __forceinline__ void gemm_phase(LAS unsigned char* lds, const char* gA, int K_, int lda, int ldb, const Sched& S, const Epi& E) {
    int K = K_; asm volatile("" : "+s"(K));
    int tid = threadIdx.x; asm volatile("" : "+v"(tid));     const int wid = __builtin_amdgcn_readfirstlane(tid >> 6), lane = tid & 63, wr = wid >> 2, wc = wid & 3, fr = lane & 15, fq = lane >> 4;
    constexpr int ES = Epi::F8 ? 1 : 2;
    const int nt = K * ES / 128;
    unsigned voffB[2];
#pragma unroll
    for (int i = 0; i < 2; ++i) { int R, C; stage_rc(tid * 16 + i * 8192, R, C); const int Rb = Epi::PERM ? ((R & ~31) + perm32(R & 31)) : R; voffB[i] = (unsigned)(Rb * ldb * ES + C * 2); }
    const unsigned kstep = (unsigned)(BK * 2);
    const size_t hstepB = (size_t)HALF * ldb * ES;
    const unsigned ldab = (unsigned)lda * ES;
    const unsigned ldsw = (unsigned)wid * 1024u;
    const int aoff = lds_byte(wr * 64 + fr, fq * 8), boff = lds_byte(wc * 32 + fr, fq * 8);
#define PG8_SA(b, h) (((b) * 2 + (h)) * HTB)
#define PG8_SB(b, h) ((4 + (b) * 2 + (h)) * HTB)
#define PG8_STAGE_B(bufoff, gbase) do { _Pragma("unroll") for (int _i = 0; _i < 2; ++_i) \
        __builtin_amdgcn_global_load_lds((const unsigned*)((const char*)(gbase) + voffB[_i]), (LAS unsigned*)(lds + (bufoff) + ldsw + _i * 8192), 16, 0, 0); } while (0)
#define PG8_STAGE_A(bufoff, o0, o1, kb) do { \
        const char* gk_ = gA + (kb);      \
        __builtin_amdgcn_global_load_lds((const unsigned*)(gk_ + (o0)), (LAS unsigned*)(lds + (bufoff) + ldsw), 16, 0, 0); \
        __builtin_amdgcn_global_load_lds((const unsigned*)(gk_ + (o1)), (LAS unsigned*)(lds + (bufoff) + ldsw + 8192), 16, 0, 0); } while (0)
#define PG8_LDA(dst, b, h) do { _Pragma("unroll") for (int m = 0; m < 4; ++m) _Pragma("unroll") for (int k = 0; k < 2; ++k) dst[m][k] = *(const LAS bf16x8*)(lds + PG8_SA(b, h) + aoff + m * 2048 + k * 1024); } while (0)
#define PG8_LDB(dst, b, h) do { _Pragma("unroll") for (int n = 0; n < 2; ++n) _Pragma("unroll") for (int k = 0; k < 2; ++k) dst[n][k] = *(const LAS bf16x8*)(lds + PG8_SB(b, h) + boff + n * 2048 + k * 1024); } while (0)
#define PG8_MMA(ai, bj, At, Bt) do { __builtin_amdgcn_s_setprio(1); \
        if constexpr (Epi::F8) { _Pragma("unroll") for (int m = 0; m < 4; ++m) _Pragma("unroll") for (int n = 0; n < 2; ++n) { \
            const i32x8 a8_ = __builtin_shufflevector(__builtin_bit_cast(i32x4, At[m][0]), __builtin_bit_cast(i32x4, At[m][1]), 0, 1, 2, 3, 4, 5, 6, 7); \
            const i32x8 b8_ = __builtin_shufflevector(__builtin_bit_cast(i32x4, Bt[n][0]), __builtin_bit_cast(i32x4, Bt[n][1]), 0, 1, 2, 3, 4, 5, 6, 7); \
            acc[ai][bj][m][n] = __builtin_amdgcn_mfma_scale_f32_16x16x128_f8f6f4(b8_, a8_, acc[ai][bj][m][n], 0, 0, 0, MK_SCL, 0, MK_SCL); } } \
        else { _Pragma("unroll") for (int m = 0; m < 4; ++m) _Pragma("unroll") for (int n = 0; n < 2; ++n) _Pragma("unroll") for (int k = 0; k < 2; ++k) \
            acc[ai][bj][m][n] = __builtin_amdgcn_mfma_f32_16x16x32_bf16(Bt[n][k], At[m][k], acc[ai][bj][m][n], 0, 0, 0); } \
        __builtin_amdgcn_s_setprio(0); } while (0)
#define PG8_WAIT_V(n) asm volatile("s_waitcnt vmcnt(" #n ")" ::: "memory")
#define PG8_WAIT_L(n) asm volatile("s_waitcnt lgkmcnt(" #n ")" ::: "memory")
#define PG8_BAR __builtin_amdgcn_s_barrier()
#define PG8_SCHED __builtin_amdgcn_sched_barrier(0)
#define PG8_AOFFS(dst, u) do { int t_ = threadIdx.x; asm volatile("" : "+v"(t_));     \
        _Pragma("unroll") for (int _h = 0; _h < 2; ++_h) _Pragma("unroll") for (int _i = 0; _i < 2; ++_i) { int R_, C_; stage_rc(t_ * 16 + _i * 8192, R_, C_); \
        dst[_h][_i] = S.a_row(u, _h * HALF + R_) * ldab + (unsigned)C_ * 2u + S.a_koff(u); } } while (0)
    Unit cur, nxt; int ui = 0;
    if (!S.next(0, cur)) return;
    cur.s = 0;
    if constexpr (Epi::PREF) E.prefetch(cur, 0);
#ifdef MK_STAGGER
    if (S.o.nwg > 3 * S.o.G) {
        const unsigned long long t0_ = __builtin_amdgcn_s_memrealtime(); const unsigned long long d_ = (unsigned long long)((blockIdx.x >> 3) & 7) * MK_STAGGER;
        while (__builtin_amdgcn_s_memrealtime() - t0_ < d_) __builtin_amdgcn_s_sleep(4);
    }
#endif
    f32x4 acc[2][2][4][2];
#pragma unroll
    for (int a = 0; a < 2; ++a)
#pragma unroll
        for (int b = 0; b < 2; ++b)
#pragma unroll
            for (int m = 0; m < 4; ++m)
#pragma unroll
                for (int n = 0; n < 2; ++n) acc[a][b][m][n] = (f32x4){0.f, 0.f, 0.f, 0.f};
    bf16x8 At[4][2], B0[2][2], B1[2][2];
    unsigned oc[2][2];
    LAS u32x4* nslot = (LAS u32x4*)(lds + LDSCTL_OFF + 2048) + tid;
    PG8_AOFFS(oc, cur);
    const char* cB = S.b_base(cur);
    PG8_STAGE_B(PG8_SB(0, 0), cB); PG8_STAGE_B(PG8_SB(0, 1), cB + hstepB); PG8_STAGE_A(PG8_SA(0, 0), oc[0][0], oc[0][1], 0u); PG8_STAGE_A(PG8_SA(0, 1), oc[1][0], oc[1][1], 0u);
    if (wr == 1) PG8_BAR;
    PG8_WAIT_V(2); PG8_BAR;
    PG8_STAGE_B(PG8_SB(1, 0), cB + kstep); PG8_STAGE_A(PG8_SA(1, 0), oc[0][0], oc[0][1], kstep); PG8_STAGE_B(PG8_SB(1, 1), cB + hstepB + kstep);
    PG8_WAIT_V(6); PG8_BAR;
    for (;;) {
        const bool has_next = S.next(ui + 1, nxt);
        const char* nB = has_next ? S.b_base(nxt) : cB;
        if (has_next) { unsigned on[2][2]; PG8_AOFFS(on, nxt); *nslot = (u32x4){on[0][0], on[0][1], on[1][0], on[1][1]}; nxt.s = cur.s == 2 ? 0 : cur.s + 1;
            if constexpr (Epi::PREF) E.prefetch(nxt, nxt.s); }
        for (int t = 0; t < nt; t += 2) {
            const bool last = (t == nt - 2);
            const unsigned k1 = (unsigned)(t + 1) * kstep;
            const unsigned k2 = last ? 0u : (unsigned)(t + 2) * kstep, k3 = k2 + kstep;
            const char* b2 = last ? nB : cB + (size_t)(t + 2) * kstep; const char* b3 = b2 + kstep;
            PG8_LDB(B0, 0, 0); PG8_LDB(B1, 0, 1); PG8_SCHED; PG8_LDA(At, 0, 0); PG8_STAGE_A(PG8_SA(1, 1), oc[1][0], oc[1][1], k1);
            PG8_WAIT_V(8); PG8_WAIT_L(0); PG8_BAR; PG8_MMA(0, 0, At, B0); PG8_MMA(0, 1, At, B1); PG8_BAR; PG8_SCHED;
            if (last && has_next) { const u32x4 o_ = *nslot; oc[0][0] = o_.x; oc[0][1] = o_.y; oc[1][0] = o_.z; oc[1][1] = o_.w; }
            PG8_LDA(At, 0, 1); PG8_STAGE_B(PG8_SB(0, 0), b2); PG8_STAGE_B(PG8_SB(0, 1), b2 + hstepB); PG8_STAGE_A(PG8_SA(0, 0), oc[0][0], oc[0][1], k2);
            PG8_WAIT_V(8); PG8_WAIT_L(0); PG8_BAR; PG8_MMA(1, 0, At, B0); PG8_MMA(1, 1, At, B1); PG8_BAR; PG8_SCHED;
            PG8_LDB(B0, 1, 0); PG8_LDB(B1, 1, 1); PG8_SCHED; PG8_LDA(At, 1, 0); PG8_STAGE_A(PG8_SA(0, 1), oc[1][0], oc[1][1], k2);
            PG8_WAIT_V(8); PG8_WAIT_L(0); PG8_BAR; PG8_MMA(0, 0, At, B0); PG8_MMA(0, 1, At, B1); PG8_BAR; PG8_SCHED;
            PG8_LDA(At, 1, 1); PG8_STAGE_B(PG8_SB(1, 0), b3); PG8_STAGE_B(PG8_SB(1, 1), b3 + hstepB); PG8_STAGE_A(PG8_SA(1, 0), oc[0][0], oc[0][1], k3);
            PG8_WAIT_V(8); PG8_WAIT_L(0); PG8_BAR; PG8_MMA(1, 0, At, B0); PG8_MMA(1, 1, At, B1); PG8_BAR; PG8_SCHED;
        }
        if (wr == 0) PG8_BAR;
        bool carry = false;
        if constexpr (Epi::MIDK) { if (cur.e == 0) { E.mid(acc, cur, wr, wc, fr, fq); carry = true; } else E(acc, cur, wr, wc, fr, fq); } else E(acc, cur, wr, wc, fr, fq);
        if (!has_next) break;
        if (!carry)
#pragma unroll
        for (int a = 0; a < 2; ++a)
#pragma unroll
            for (int b = 0; b < 2; ++b)
#pragma unroll
                for (int m = 0; m < 4; ++m)
#pragma unroll
                    for (int n = 0; n < 2; ++n) acc[a][b][m][n] = (f32x4){0.f, 0.f, 0.f, 0.f};
        cur = nxt; cB = nB; ++ui;
        if (wr == 1) PG8_BAR;
    }
    PG8_WAIT_V(0);
    PG8_BAR;
#undef PG8_SA
#undef PG8_SB
#undef PG8_STAGE_A
#undef PG8_STAGE_B
#undef PG8_LDA
#undef PG8_LDB
#undef PG8_MMA
#undef PG8_WAIT_V
#undef PG8_WAIT_L
#undef PG8_BAR
#undef PG8_SCHED
#undef PG8_AOFFS
}

template <bool F8_> struct EpiProj {
    static constexpr bool PREF = false, PERM = true, MIDK = false, F8 = F8_;
    bf16_t* O; float* kmp;
    __device__ __forceinline__ void operator()(const f32x4 (&acc)[2][2][4][2], const Unit& u, int wr, int wc, int fr, int fq) const {
        const int row0 = u.pm * BM + wr * 64 + fr; const int col0 = u.pn * BM + wc * 32 + 8 * fq;
#pragma unroll
        for (int ai = 0; ai < 2; ++ai)
#pragma unroll
            for (int m = 0; m < 4; ++m) { bf16_t* rowp = O + (size_t)(row0 + ai * HALF + m * 16) * NPROJ + col0;
#pragma unroll
                for (int bj = 0; bj < 2; ++bj) { const float sc = F8 ? (1.0f / 32.0f) : 1.0f; const f32x4 v0 = acc[ai][bj][m][0] * sc, v1 = acc[ai][bj][m][1] * sc;
                    u32x4 w; w.x = cvt_pk_bf16(v0[0], v0[1]); w.y = cvt_pk_bf16(v0[2], v0[3]); w.z = cvt_pk_bf16(v1[0], v1[1]); w.w = cvt_pk_bf16(v1[2], v1[3]);
                    __builtin_nontemporal_store(w, (u32x4*)(rowp + bj * HALF)); } }
        if (u.pn >= C_KB / BM && u.pn < C_VB / BM) {
#pragma unroll
            for (int bj = 0; bj < 2; ++bj)
#pragma unroll
                for (int n = 0; n < 2; ++n) { f32x4 s = (f32x4){0.f, 0.f, 0.f, 0.f};
#pragma unroll
                    for (int ai = 0; ai < 2; ++ai)
#pragma unroll
                        for (int m = 0; m < 4; ++m) s += acc[ai][bj][m][n];
#pragma unroll
                    for (int o = 1; o < 16; o <<= 1) { s[0] += __shfl_xor(s[0], o); s[1] += __shfl_xor(s[1], o); s[2] += __shfl_xor(s[2], o); s[3] += __shfl_xor(s[3], o); }
                    if (fr == 0) *(f32x4*)(kmp + ((size_t)wr * 64 + u.pm) * 1024 + (u.pn - C_KB / BM) * BM + bj * HALF + wc * 32 + 8 * fq + 4 * n) = s * (F8 ? (1.0f / 32.0f) : 1.0f); }
        }
    }
};
struct EpiMerge {
    static constexpr bool PREF = false, PERM = true, MIDK = true, F8 = false;
    const bf16_t* proj; bf16_t* Y;
    __device__ __forceinline__ void mid(f32x4 (&acc)[2][2][4][2], const Unit& u, int wr, int wc, int fr, int fq) const {
        const int row0 = u.pm * BM + wr * 64 + fr; const int col0 = u.pn * BM + wc * 32 + 8 * fq;
#pragma unroll
        for (int ai = 0; ai < 2; ++ai) {
            u32x4 ga[4][2], gb[4][2];
#pragma unroll
            for (int m = 0; m < 4; ++m) { const bf16_t* rowp = proj + (size_t)(row0 + ai * HALF + m * 16) * NPROJ + col0;
#pragma unroll
                for (int bj = 0; bj < 2; ++bj) { ga[m][bj] = *(const u32x4*)(rowp + C_GA + bj * HALF); gb[m][bj] = *(const u32x4*)(rowp + C_GB + bj * HALF); } }
#pragma unroll
            for (int m = 0; m < 4; ++m) {
#pragma unroll
                for (int bj = 0; bj < 2; ++bj) {
#pragma unroll
                    for (int j = 0; j < 4; ++j) { const float a0 = bflo(ga[m][bj][j]), a1 = bfhi(ga[m][bj][j]), b0 = bflo(gb[m][bj][j]), b1 = bfhi(gb[m][bj][j]);
                        const float r0 = (1.0f + __builtin_amdgcn_exp2f(-1.4426950408889634f * b0)) * __builtin_amdgcn_rcpf(1.0f + __builtin_amdgcn_exp2f(-1.4426950408889634f * a0));
                        const float r1 = (1.0f + __builtin_amdgcn_exp2f(-1.4426950408889634f * b1)) * __builtin_amdgcn_rcpf(1.0f + __builtin_amdgcn_exp2f(-1.4426950408889634f * a1));
                        acc[ai][bj][m][j >> 1][(j & 1) * 2] *= r0; acc[ai][bj][m][j >> 1][(j & 1) * 2 + 1] *= r1; } }
                asm volatile("" : "+v"(acc[ai][0][m][0]), "+v"(acc[ai][0][m][1]), "+v"(acc[ai][1][m][0]), "+v"(acc[ai][1][m][1])); }
            asm volatile("" ::: "memory"); }
    }
    __device__ __forceinline__ void operator()(const f32x4 (&acc)[2][2][4][2], const Unit& u, int wr, int wc, int fr, int fq) const {
        const int row0 = u.pm * BM + wr * 64 + fr; const int col0 = u.pn * BM + wc * 32 + 8 * fq;
#pragma unroll
        for (int ai = 0; ai < 2; ++ai) {
            u32x4 gb[4][2];
#pragma unroll
            for (int m = 0; m < 4; ++m)
#pragma unroll
                for (int bj = 0; bj < 2; ++bj) gb[m][bj] = *(const u32x4*)(proj + (size_t)(row0 + ai * HALF + m * 16) * NPROJ + C_GB + col0 + bj * HALF);
#pragma unroll
            for (int m = 0; m < 4; ++m) { const size_t r = (size_t)(row0 + ai * HALF + m * 16);
#pragma unroll
                for (int bj = 0; bj < 2; ++bj) { const u32x4 g = gb[m][bj];
                    const f32x4 v0 = acc[ai][bj][m][0], v1 = acc[ai][bj][m][1];
                    u32x4 w; w.x = cvt_pk_bf16(v0[0] * fsigmoid(bflo(g[0])), v0[1] * fsigmoid(bfhi(g[0]))); w.y = cvt_pk_bf16(v0[2] * fsigmoid(bflo(g[1])), v0[3] * fsigmoid(bfhi(g[1])));
                    w.z = cvt_pk_bf16(v1[0] * fsigmoid(bflo(g[2])), v1[1] * fsigmoid(bfhi(g[2]))); w.w = cvt_pk_bf16(v1[2] * fsigmoid(bflo(g[3])), v1[3] * fsigmoid(bfhi(g[3])));
                    *(u32x4*)(Y + r * D + col0 + bj * HALF) = w; } }
            asm volatile("" ::: "memory"); }
    }
};
struct EpiResF32 {
    static constexpr bool PREF = false, PERM = false, MIDK = false, F8 = false;
    const float* base; bf16_t* out;
    __device__ __forceinline__ void operator()(const f32x4 (&acc)[2][2][4][2], const Unit& u, int wr, int wc, int fr, int fq) const {
        const int row0 = u.pm * BM + wr * 64 + fr, col0 = u.pn * BM + wc * 32 + 4 * fq;
#pragma unroll
        for (int ai = 0; ai < 2; ++ai) {
            f32x4 bs[4][2][2];
#pragma unroll
            for (int m = 0; m < 4; ++m) { const size_t off = (size_t)(row0 + ai * HALF + m * 16) * D + col0;
#pragma unroll
                for (int bj = 0; bj < 2; ++bj)
#pragma unroll
                    for (int n = 0; n < 2; ++n) bs[m][bj][n] = __builtin_nontemporal_load((const f32x4*)(base + off + bj * HALF + n * 16)); }
#pragma unroll
            for (int m = 0; m < 4; ++m) { const size_t off = (size_t)(row0 + ai * HALF + m * 16) * D + col0;
#pragma unroll
                for (int bj = 0; bj < 2; ++bj)
#pragma unroll
                    for (int n = 0; n < 2; ++n) { const f32x4 v = bs[m][bj][n] + acc[ai][bj][m][n]; u32x2 w; w.x = cvt_pk_bf16(v[0], v[1]); w.y = cvt_pk_bf16(v[2], v[3]); *(u32x2*)(out + off + bj * HALF + n * 16) = w; } }
            asm volatile("" ::: "memory"); }
    }
};
struct EpiGlu {
    static constexpr bool PREF = true, PERM = true, MIDK = false, F8 = true;
    unsigned char* H; const float* rstd_e; const LAS int* tab; const float* bg; const float* bu; const float* zero; LAS unsigned char* lds;
    __device__ __forceinline__ void prefetch(const Unit& u, int slot) const {
        int tid = threadIdx.x; asm volatile("" : "+v"(tid)); const int wave = __builtin_amdgcn_readfirstlane(tid >> 6);
        const float* src;
        if (wave < 4) { const int lr = u.pm * BM + tid - tab[u.e]; src = lr < tab[64 + u.e] ? rstd_e + (size_t)u.e * T + lr : zero; }
        else { const int j = tid - 256; src = (j < 128 ? bg : bu) + (size_t)u.e * FF + u.pn * HALF + (j & 127); }
        __builtin_amdgcn_global_load_lds((const unsigned*)src, (LAS unsigned*)(lds + EPF_OFF + slot * 2048 + wave * 256), 4, 0, 0);
    }
    __device__ __forceinline__ void operator()(const f32x4 (&acc)[2][2][4][2], const Unit& u, int wr, int wc, int fr, int fq) const {
        const int row0 = u.pm * BM + wr * 64 + fr; const int colo = u.pn * HALF + wc * 32 + 8 * fq;
        const LAS float* ep = (const LAS float*)(lds + EPF_OFF + u.s * 2048);
        f32x4 g4[2], u4[2];
#pragma unroll
        for (int n = 0; n < 2; ++n) { g4[n] = *(const LAS f32x4*)(ep + 256 + wc * 32 + 8 * fq + 4 * n); u4[n] = *(const LAS f32x4*)(ep + 384 + wc * 32 + 8 * fq + 4 * n); }
        float rsv[2][4];
#pragma unroll
        for (int ai = 0; ai < 2; ++ai)
#pragma unroll
            for (int m = 0; m < 4; ++m) rsv[ai][m] = ep[wr * 64 + fr + ai * HALF + m * 16];
#pragma unroll
        for (int ai = 0; ai < 2; ++ai)
#pragma unroll
            for (int m = 0; m < 4; ++m) { const int r = row0 + ai * HALF + m * 16; const float rs = rsv[ai][m] * (1.0f / 32.0f);
                float o[8];
#pragma unroll
                for (int n = 0; n < 2; ++n)
#pragma unroll
                    for (int j = 0; j < 4; ++j) { float g = acc[ai][0][m][n][j] * rs + g4[n][j], up = acc[ai][1][m][n][j] * rs + u4[n][j];
                        g = fminf(g, 7.0f); up = fminf(fmaxf(up, -7.0f), 7.0f);
                        const float glu = g * fsigmoid(1.702f * g); o[n * 4 + j] = (up + 1.0f) * glu; }
                u32x2 w; w.x = pk4_fp8(o[0], o[1], o[2], o[3]); w.y = pk4_fp8(o[4], o[5], o[6], o[7]);
                *(u32x2*)(H + (size_t)r * FF + colo) = w; asm volatile("" ::: "memory"); }
    }
};
template <int ACT, bool HASBIAS, bool F8_ = false> struct EpiBf16 {
    static constexpr bool PREF = false, PERM = true, MIDK = false, F8 = F8_;
    bf16_t* O; int ldc; const float* bias; int bias_stride; float scale;
    __device__ __forceinline__ void operator()(const f32x4 (&acc)[2][2][4][2], const Unit& u, int wr, int wc, int fr, int fq) const {
        const int row0 = u.pm * BM + wr * 64 + fr; const int col0 = u.pn * BM + wc * 32 + 8 * fq;
        f32x4 bv[2][2];
#pragma unroll
        for (int bj = 0; bj < 2; ++bj)
#pragma unroll
            for (int n = 0; n < 2; ++n) bv[bj][n] = HASBIAS ? *(const f32x4*)(bias + (size_t)u.e * bias_stride + col0 + bj * HALF + 4 * n) : (f32x4){0.f, 0.f, 0.f, 0.f};
#pragma unroll
        for (int ai = 0; ai < 2; ++ai)
#pragma unroll
            for (int m = 0; m < 4; ++m) { bf16_t* rowp = O + (size_t)(row0 + ai * HALF + m * 16) * ldc + col0;
#pragma unroll
                for (int bj = 0; bj < 2; ++bj) { f32x4 v0 = acc[ai][bj][m][0] * scale + bv[bj][0], v1 = acc[ai][bj][m][1] * scale + bv[bj][1];
                    if (ACT == 1) {
#pragma unroll
                        for (int j = 0; j < 4; ++j) { v0[j] = fsigmoid(v0[j]); v1[j] = fsigmoid(v1[j]); } }
                    u32x4 w; w.x = cvt_pk_bf16(v0[0], v0[1]); w.y = cvt_pk_bf16(v0[2], v0[3]); w.z = cvt_pk_bf16(v1[0], v1[1]); w.w = cvt_pk_bf16(v1[2], v1[3]);
                    *(u32x4*)(rowp + bj * HALF) = w; }
                asm volatile("" ::: "memory"); }
    }
};
struct EpiDownF8 {
    static constexpr bool PREF = false, PERM = true, MIDK = false, F8 = true;
    unsigned char* O; const float* bias;
    __device__ __forceinline__ void operator()(const f32x4 (&acc)[2][2][4][2], const Unit& u, int wr, int wc, int fr, int fq) const {
        const int row0 = u.pm * BM + wr * 64 + fr; const int col0 = u.pn * BM + wc * 32 + 8 * fq;
        f32x4 bv[2][2];
#pragma unroll
        for (int bj = 0; bj < 2; ++bj)
#pragma unroll
            for (int n = 0; n < 2; ++n) bv[bj][n] = *(const f32x4*)(bias + (size_t)u.e * D + col0 + bj * HALF + 4 * n);
#pragma unroll
        for (int ai = 0; ai < 2; ++ai)
#pragma unroll
            for (int m = 0; m < 4; ++m) { unsigned char* rowp = O + (size_t)(row0 + ai * HALF + m * 16) * D + col0;
#pragma unroll
                for (int bj = 0; bj < 2; ++bj) { const f32x4 v0 = acc[ai][bj][m][0] * (1.0f / 32.0f) + bv[bj][0], v1 = acc[ai][bj][m][1] * (1.0f / 32.0f) + bv[bj][1];
                    u32x2 w; w.x = pk4_fp8(v0[0], v0[1], v0[2], v0[3]); w.y = pk4_fp8(v1[0], v1[1], v1[2], v1[3]);
                    *(u32x2*)(rowp + bj * HALF) = w; }
                asm volatile("" ::: "memory"); }
    }
};
}
__device__ __forceinline__ void transpose_item(const float* __restrict__ W, int ldw, int k0, int n_src0, bf16_t* __restrict__ WT, int ldo, int n_dst0, int k_off, LAS float* scr, int lane) {
    { float t_[32]; const float* wp_ = W + (size_t)(k0 + (lane >> 5)) * ldw + n_src0 + (lane & 31);
#pragma unroll
    for (int i = 0; i < 32; ++i) t_[i] = __builtin_nontemporal_load(wp_ + (size_t)(2 * i) * ldw);
#pragma unroll
    for (int i = 0; i < 32; ++i) scr[(2 * i + (lane >> 5)) * 33 + (lane & 31)] = t_[i]; }
    LDS_WAIT(); asm volatile("" ::: "memory");
    const int c = lane & 7;
#pragma unroll
    for (int j = 0; j < 4; ++j) { const int n = (lane >> 3) + 8 * j; const LAS float* s = scr + (8 * c) * 33 + n;
        u32x4 o; o.x = cvt_pk_bf16(s[0 * 33], s[1 * 33]); o.y = cvt_pk_bf16(s[2 * 33], s[3 * 33]); o.z = cvt_pk_bf16(s[4 * 33], s[5 * 33]); o.w = cvt_pk_bf16(s[6 * 33], s[7 * 33]);
        *(u32x4*)(WT + (size_t)(n_dst0 + n) * ldo + k_off + k0 + 8 * c) = o; }
    LDS_WAIT(); asm volatile("" ::: "memory");
}
__device__ __forceinline__ void transpose_item_f8(const float* __restrict__ W, int ldw, int k0, int n_src0, unsigned char* __restrict__ WT, int ldo, int n_dst0, float sc, LAS float* scr, int lane) {
    { float t_[32]; const float* wp_ = W + (size_t)(k0 + (lane >> 5)) * ldw + n_src0 + (lane & 31);
#pragma unroll
    for (int i = 0; i < 32; ++i) t_[i] = __builtin_nontemporal_load(wp_ + (size_t)(2 * i) * ldw);
#pragma unroll
    for (int i = 0; i < 32; ++i) scr[(2 * i + (lane >> 5)) * 33 + (lane & 31)] = t_[i]; }
    LDS_WAIT(); asm volatile("" ::: "memory");
    const int c = lane & 7;
#pragma unroll
    for (int j = 0; j < 4; ++j) { const int n = (lane >> 3) + 8 * j; const LAS float* s = scr + (8 * c) * 33 + n;
        u32x2 o; o.x = pk4_fp8(s[0 * 33] * sc, s[1 * 33] * sc, s[2 * 33] * sc, s[3 * 33] * sc); o.y = pk4_fp8(s[4 * 33] * sc, s[5 * 33] * sc, s[6 * 33] * sc, s[7 * 33] * sc);
        *(u32x2*)(WT + (size_t)(n_dst0 + n) * ldo + k0 + 8 * c) = o; }
    LDS_WAIT(); asm volatile("" ::: "memory");
}
__device__ __forceinline__ void transpose_mat_item(const float* W, int ldw, int N, int n_src_base, bf16_t* WT, int ldo, int n_dst_base, int k_off, LAS float* scr, int item, int lane) {
    const int nblk = N / 32, kb = item / nblk, nb = item % nblk;
    transpose_item(W, ldw, 64 * kb, n_src_base + 32 * nb, WT, ldo, n_dst_base + 32 * nb, k_off, scr, lane);
}

struct P {
    const float* in[25]; float* out; unsigned char* ws;
};

__device__ __forceinline__ void p0_prologue(const P& a, LAS unsigned char* lds, int vcu, int G, int wave, int lane) {
    LAS float* scr = (LAS float*)(lds + wave * 16384);
    const int gw = vcu * NWAVES + wave, NGW = G * NWAVES;
    unsigned char* ws = a.ws;
    bf16_t* WinT = (bf16_t*)(ws + WS_WIN); bf16_t* WupT = (bf16_t*)(ws + WS_WUP); bf16_t* WoT = (bf16_t*)(ws + WS_WO); bf16_t* WpgT = (bf16_t*)(ws + WS_WPG); bf16_t* WppT = (bf16_t*)(ws + WS_WPP);
    constexpr int I_A = 16 * 96, I_B8 = 16 * 160, I_B = 0, I_S = 16 * 32, I_P = 4 * 32;
    constexpr int NITEMS = I_A + I_B8 + I_B + 4 * I_S + I_P;
#ifndef P0_PARTS
#define P0_PARTS 63
#endif
    if (P0_PARTS & 1)
    for (int it = gw; it < NITEMS; it += NGW) {
        int r = it;
        if (r < I_A) { transpose_mat_item(a.in[4], D_IN, 3072, 0, WinT, D, 0, 0, scr, r, lane); continue; } r -= I_A;
        if (r < I_B8) { const int kb = r / 160, nb = r % 160; transpose_item_f8(a.in[4], D_IN, 64 * kb, 3088 + 32 * nb, ws + WS_WIN8, D, 32 * nb, 32.0f, scr, lane); continue; } r -= I_B8;
        if (r < I_S) { transpose_mat_item(a.in[8], D, D, 0, WupT, 2048, 0, 0, scr, r, lane); continue; } r -= I_S;
        if (r < I_S) { transpose_mat_item(a.in[9], D, D, 0, WupT, 2048, 0, 1024, scr, r, lane); continue; } r -= I_S;
        if (r < I_S) { transpose_mat_item(a.in[10], D, D, 0, WoT, D, 0, 0, scr, r, lane); continue; } r -= I_S;
        if (r < I_S) { const int kb = r / 32, nb = r % 32; transpose_item_f8(a.in[21], D, 64 * kb, 32 * nb, (unsigned char*)WpgT, D, 32 * nb, 32.0f, scr, lane); continue; } r -= I_S;
        transpose_mat_item(a.in[22], D, D, 0, WppT, 256, 0, 0, scr, r, lane);
    }
    if (P0_PARTS & 2) {
        const float* x = a.in[0]; const float* g = a.in[3]; bf16_t* H = (bf16_t*)(ws + WS_H);
        f32x4 gv[4];
#pragma unroll
        for (int j = 0; j < 4; ++j) gv[j] = *((const f32x4*)g + lane + 64 * j);
        for (int m = gw; m < T; m += NGW) {
            const f32x4* xr = (const f32x4*)(x + (size_t)m * D) + lane; f32x4 v[4]; float s = 0.f;
#pragma unroll
            for (int j = 0; j < 4; ++j) { v[j] = __builtin_nontemporal_load(xr + 64 * j); s += (v[j].x * v[j].x + v[j].y * v[j].y) + (v[j].z * v[j].z + v[j].w * v[j].w); }
            const float rstd = 1.0f / sqrtf(wave_sum(s) * (1.0f / D) + EPS);
            u32x2* o8 = (u32x2*)(H + (size_t)m * D) + lane; unsigned* q8 = (unsigned*)(ws + WS_H8 + (size_t)m * D) + lane;
#pragma unroll
            for (int j = 0; j < 4; ++j) { const f32x4 y = v[j] * rstd * gv[j]; u32x2 w; w.x = cvt_pk_bf16(y.x, y.y); w.y = cvt_pk_bf16(y.z, y.w); o8[64 * j] = w; q8[64 * j] = pk4_fp8(y.x, y.y, y.z, y.w); }
        }
    }
    if (P0_PARTS & 4) {
        const f32x4* p4 = (const f32x4*)a.in[1]; u32x2* pb = (u32x2*)(ws + WS_PB);
        const size_t n4 = (size_t)T * 256 / 4;
        for (size_t i = (size_t)gw * 64 + lane; i < n4; i += (size_t)NGW * 64) { const f32x4 v = __builtin_nontemporal_load(p4 + i); u32x2 w; w.x = cvt_pk_bf16(v.x, v.y); w.y = cvt_pk_bf16(v.z, v.w); pb[i] = w; }
    }
    if (P0_PARTS & 8) {
        const int gt = (vcu * NWAVES + wave) * 64 + lane;
        if ((P0_PARTS & 16) && gt < 16 * 1024) { const int n = gt >> 10, k = gt & 1023; ((bf16_t*)(ws + WS_WALT))[n * 1024 + k] = (bf16_t)(cvt_pk_bf16(a.in[4][(size_t)k * D_IN + SRC_ALOW + n], 0.f) & 0xffffu); }
        if ((P0_PARTS & 32) && gt < 4096) { const int s = gt >> 6, l = gt & 63, e = l & 31, hh = l >> 5; const float* wr = a.in[12];
            float v[8], lo[8];
#pragma unroll
            for (int j = 0; j < 8; ++j) { v[j] = wr[(size_t)(16 * s + 8 * hh + j) * NE + e]; }
            u32x4 whi; whi.x = cvt_pk_bf16(v[0], v[1]); whi.y = cvt_pk_bf16(v[2], v[3]); whi.z = cvt_pk_bf16(v[4], v[5]); whi.w = cvt_pk_bf16(v[6], v[7]);
#pragma unroll
            for (int j = 0; j < 4; ++j) { lo[2 * j] = v[2 * j] - bflo(whi[j]); lo[2 * j + 1] = v[2 * j + 1] - bfhi(whi[j]); }
            u32x4 wlo; wlo.x = cvt_pk_bf16(lo[0], lo[1]); wlo.y = cvt_pk_bf16(lo[2], lo[3]); wlo.z = cvt_pk_bf16(lo[4], lo[5]); wlo.w = cvt_pk_bf16(lo[6], lo[7]);
            u32x4* f = (u32x4*)(ws + WS_WRF); f[gt] = whi; f[4096 + gt] = wlo; }
    }
}

struct CvtItem { const float* src; unsigned char* dst; int ldo; };
__device__ __forceinline__ CvtItem cvt_item(const P& a, int it, int lane) {
    constexpr int IPM = 16 * 32;
    const int e = it / (3 * IPM), r0 = it % (3 * IPM), which = r0 / IPM, r = r0 % IPM, kb = r / 32, nb = r % 32, n0 = 32 * nb;
    CvtItem c;
    if (which < 2) { c.src = a.in[which == 0 ? 14 : 16] + (size_t)e * D * FF + (size_t)(64 * kb + (lane >> 5)) * FF + n0 + (lane & 31);
        c.dst = (unsigned char*)a.out + ((size_t)e * 2048 + (n0 >> 7) * 256 + (n0 & 127) + which * 128) * D + 64 * kb; c.ldo = D; }
    else { c.src = a.in[18] + (size_t)e * FF * D + (size_t)(64 * kb + (lane >> 5)) * D + n0 + (lane & 31);
        c.dst = a.ws + WS_W2T + ((size_t)e * D + n0) * FF + 64 * kb; c.ldo = FF; }
    return c;
}
__device__ __forceinline__ void expert_convert(const P& a, LAS unsigned char* lds, int vcu, int G, int wave, int lane) {
    LAS float* scr = (LAS float*)(lds + wave * 16384);
    const int gw = vcu * NWAVES + wave, NGW = G * NWAVES;
    constexpr int NIT = NE * 3 * 16 * 32;
    if (gw >= NIT) return;
    float tA[32], tB[32];
    CvtItem cA = cvt_item(a, gw, lane), cB = cvt_item(a, gw + NGW < NIT ? gw + NGW : gw, lane);
#pragma unroll
    for (int i = 0; i < 32; ++i) tA[i] = __builtin_nontemporal_load(cA.src + (size_t)(2 * i) * 1024);
#pragma unroll
    for (int i = 0; i < 32; ++i) tB[i] = __builtin_nontemporal_load(cB.src + (size_t)(2 * i) * 1024);
#define CVT_OUT(c_) do { LDS_WAIT(); asm volatile("" ::: "memory"); const int c = lane & 7; \
        _Pragma("unroll") for (int j = 0; j < 4; ++j) { const int n = (lane >> 3) + 8 * j; const LAS float* s = scr + (8 * c) * 33 + n; \
            u32x2 o; o.x = pk4_fp8(s[0 * 33] * 32.0f, s[1 * 33] * 32.0f, s[2 * 33] * 32.0f, s[3 * 33] * 32.0f); o.y = pk4_fp8(s[4 * 33] * 32.0f, s[5 * 33] * 32.0f, s[6 * 33] * 32.0f, s[7 * 33] * 32.0f); \
            __builtin_nontemporal_store(o, (u32x2*)((c_).dst + (size_t)n * (c_).ldo + 8 * c)); } \
        LDS_WAIT(); asm volatile("" ::: "memory"); } while (0)
    for (int it = gw; it < NIT; it += 2 * NGW) {
#pragma unroll
        for (int i = 0; i < 32; ++i) scr[(2 * i + (lane >> 5)) * 33 + (lane & 31)] = tA[i];
        const CvtItem dA = cA; const int n2 = it + 2 * NGW;
        if (n2 < NIT) { cA = cvt_item(a, n2, lane);
#pragma unroll
            for (int i = 0; i < 32; ++i) tA[i] = __builtin_nontemporal_load(cA.src + (size_t)(2 * i) * 1024); }
        CVT_OUT(dA);
        if (it + NGW >= NIT) break;
#pragma unroll
        for (int i = 0; i < 32; ++i) scr[(2 * i + (lane >> 5)) * 33 + (lane & 31)] = tB[i];
        const CvtItem dB = cB; const int n3 = it + 3 * NGW;
        if (n3 < NIT) { cB = cvt_item(a, n3, lane);
#pragma unroll
            for (int i = 0; i < 32; ++i) tB[i] = __builtin_nontemporal_load(cB.src + (size_t)(2 * i) * 1024); }
        CVT_OUT(dB);
    }
#undef CVT_OUT
}

__device__ __forceinline__ float fexp_(float x) { return __builtin_amdgcn_exp2f(x * 1.4426950408889634f); }
__device__ __forceinline__ float logsigmoidf_(float x) { const float e = fexp_(-fabsf(x)); return fminf(x, 0.0f) - 0.6931471805599453f * __builtin_amdgcn_logf(1.0f + e); }
__device__ __forceinline__ void gla_prep_unit(const P& a, LAS unsigned char* lds, int unit) {
    int tid = threadIdx.x; asm volatile("" : "+v"(tid));     const int wave = __builtin_amdgcn_readfirstlane(tid >> 6), lane = tid & 63;
    const int b = unit >> 5, chunk = unit & 31, tok0 = b * SEQ + chunk * 64;
    const bf16_t* H = (const bf16_t*)(a.ws + WS_H); const bf16_t* WalT = (const bf16_t*)(a.ws + WS_WALT); const bf16_t* proj = (const bf16_t*)(a.ws + WS_PROJ);
    LAS float* part = (LAS float*)lds;
    LAS float* alow = (LAS float*)(lds + 8192);
    LAS float* seg = (LAS float*)(lds + 12288);
    constexpr int GP_KDT = 16384, GP_VT = 34816;
    {
        const int rg = wave & 3, kh = wave >> 2, r = lane & 15, q = lane >> 4;
        f32x4 acc = (f32x4){0.f, 0.f, 0.f, 0.f};
        const bf16_t* ap = H + (size_t)(tok0 + 16 * rg + r) * D + 512 * kh + 8 * q; const bf16_t* bp = WalT + (size_t)r * D + 512 * kh + 8 * q;
#pragma unroll 8
        for (int s = 0; s < 16; ++s) { const bf16x8 av = *(const bf16x8*)(ap + 32 * s), bv = *(const bf16x8*)(bp + 32 * s); acc = __builtin_amdgcn_mfma_f32_16x16x32_bf16(bv, av, acc, 0, 0, 0); }
        *(LAS f32x4*)(part + (kh * 64 + 16 * rg + r) * 16 + 4 * q) = acc;
    }
    __syncthreads();
    if (tid < 256) { *(LAS f32x4*)(alow + tid * 4) = *(LAS f32x4*)(part + tid * 4) + *(LAS f32x4*)(part + 1024 + tid * 4); }
    __syncthreads();
    const int dp = tid & 63, tq = wave;
    const float* w_a2 = a.in[5]; const float* b_a2 = a.in[6];
    const int ep = tid & 127, sq4 = tid >> 7;
    f32x2 w2[16], w2n[16]; f32x2 b2, b2n; unsigned qv[8], kv[8], qvn[8], kvn[8], sv[16], svn[16];
#define GP_LOADS(h_, W2, B2, QV, KV, SV) do { const int dc_ = (h_) * 128 + 2 * dp; \
        _Pragma("unroll") for (int r = 0; r < 16; ++r) W2[r] = *(const f32x2*)(w_a2 + r * 512 + dc_); \
        B2 = *(const f32x2*)(b_a2 + dc_); \
        _Pragma("unroll") for (int i = 0; i < 8; ++i) { const bf16_t* rp = proj + (size_t)(tok0 + 8 * tq + i) * NPROJ + dc_; QV[i] = __builtin_nontemporal_load((const unsigned*)(rp + C_QA)); KV[i] = __builtin_nontemporal_load((const unsigned*)(rp + C_KA)); } \
        const bf16_t* v_ = proj + (size_t)(tok0 + 16 * sq4) * NPROJ + C_VA + (h_) * 256 + 2 * ep; \
        _Pragma("unroll") for (int i = 0; i < 16; ++i) SV[i] = __builtin_nontemporal_load((const unsigned*)(v_ + (size_t)i * NPROJ)); } while (0)
    GP_LOADS(0, w2, b2, qv, kv, sv);
    for (int h = 0; h < 4; ++h) {
        if (h + 1 < 4) GP_LOADS(h + 1, w2n, b2n, qvn, kvn, svn);
        float G0[8], G1[8]; float r0 = 0.f, r1 = 0.f;
#pragma unroll
        for (int i = 0; i < 8; ++i) { const LAS f32x4* al4 = (const LAS f32x4*)(alow + (8 * tq + i) * 16); float x0 = b2.x, x1 = b2.y;
#pragma unroll
            for (int r4 = 0; r4 < 4; ++r4) { const f32x4 al = al4[r4];
#pragma unroll
                for (int j = 0; j < 4; ++j) { x0 += al[j] * w2[4 * r4 + j].x; x1 += al[j] * w2[4 * r4 + j].y; } }
            r0 += logsigmoidf_(x0) * (1.0f / 16.0f); r1 += logsigmoidf_(x1) * (1.0f / 16.0f); G0[i] = r0; G1[i] = r1; }
        *(LAS f32x2*)(seg + tq * 128 + 2 * dp) = (f32x2){r0, r1};
        __syncthreads();
        float off0 = 0.f, off1 = 0.f, tot0 = 0.f, tot1 = 0.f;
#pragma unroll
        for (int q = 0; q < 8; ++q) { const f32x2 s = *(LAS f32x2*)(seg + q * 128 + 2 * dp); tot0 += s.x; tot1 += s.y; if (q < tq) { off0 += s.x; off1 += s.y; } }
        const size_t tile = (size_t)((b * 4 + h) * 32 + chunk);
        bf16_t* Qg = (bf16_t*)(a.ws + WS_QG) + tile * 8192; bf16_t* Kg = (bf16_t*)(a.ws + WS_KG) + tile * 8192;
        float kd0[8], kd1[8];
#pragma unroll
        for (int i = 0; i < 8; ++i) { const float g0 = G0[i] + off0, g1 = G1[i] + off1; const float q0 = bflo(qv[i]), q1 = bfhi(qv[i]), k0 = bflo(kv[i]), k1 = bfhi(kv[i]);
            const float e0 = fexp_(g0), e1 = fexp_(g1);
            *(unsigned*)(Qg + (8 * tq + i) * 128 + 2 * dp) = cvt_pk_bf16(q0 * e0 * 0.08838834764831845f, q1 * e1 * 0.08838834764831845f);
            *(unsigned*)(Kg + (8 * tq + i) * 128 + 2 * dp) = cvt_pk_bf16(k0 * __builtin_amdgcn_rcpf(e0), k1 * __builtin_amdgcn_rcpf(e1));
            kd0[i] = k0 * fexp_(tot0 - g0); kd1[i] = k1 * fexp_(tot1 - g1); }
        u32x4 w0, w1; w0.x = cvt_pk_bf16(kd0[0], kd0[1]); w0.y = cvt_pk_bf16(kd0[2], kd0[3]); w0.z = cvt_pk_bf16(kd0[4], kd0[5]); w0.w = cvt_pk_bf16(kd0[6], kd0[7]);
        w1.x = cvt_pk_bf16(kd1[0], kd1[1]); w1.y = cvt_pk_bf16(kd1[2], kd1[3]); w1.z = cvt_pk_bf16(kd1[4], kd1[5]); w1.w = cvt_pk_bf16(kd1[6], kd1[7]);
        *(LAS u32x4*)(lds + GP_KDT + (2 * dp) * 144 + 16 * tq) = w0; *(LAS u32x4*)(lds + GP_KDT + (2 * dp + 1) * 144 + 16 * tq) = w1;
        if (tq == 0) *(f32x2*)((float*)(a.ws + WS_DEC) + tile * 128 + 2 * dp) = (f32x2){fexp_(tot0), fexp_(tot1)};
        {
            u32x4 lo0, lo1, hi0, hi1;
#pragma unroll
            for (int j = 0; j < 4; ++j) { lo0[j] = (sv[2 * j] & 0xffffu) | (sv[2 * j + 1] << 16); lo1[j] = (sv[8 + 2 * j] & 0xffffu) | (sv[8 + 2 * j + 1] << 16);
                hi0[j] = (sv[2 * j] >> 16) | (sv[2 * j + 1] & 0xffff0000u); hi1[j] = (sv[8 + 2 * j] >> 16) | (sv[8 + 2 * j + 1] & 0xffff0000u); }
            LAS unsigned char* v0 = lds + GP_VT + (2 * ep) * 144 + sq4 * 32;
            *(LAS u32x4*)(v0) = lo0; *(LAS u32x4*)(v0 + 16) = lo1; *(LAS u32x4*)(v0 + 144) = hi0; *(LAS u32x4*)(v0 + 144 + 16) = hi1;
        }
        __syncthreads();
        {
            const int c32 = lane & 31, hi = lane >> 5;
            bf16x8 vt[4];
#pragma unroll
            for (int ks = 0; ks < 4; ++ks) vt[ks] = *(const LAS bf16x8*)(lds + GP_VT + (32 * wave + c32) * 144 + (16 * ks + 8 * hi) * 2);
            unsigned* sl = (unsigned*)a.out + tile * 8192;
#pragma unroll
            for (int tl = 0; tl < 4; ++tl) { f32x16 acc;
#pragma unroll
                for (int r = 0; r < 16; ++r) acc[r] = 0.f;
#pragma unroll
                for (int ks = 0; ks < 4; ++ks) { const bf16x8 av = *(const LAS bf16x8*)(lds + GP_KDT + (32 * tl + c32) * 144 + (16 * ks + 8 * hi) * 2); acc = __builtin_amdgcn_mfma_f32_32x32x16_bf16(av, vt[ks], acc, 0, 0, 0); }
#pragma unroll
                for (int g = 0; g < 4; ++g) sl[((tl * 4 + g) * 2 + hi) * 256 + 32 * wave + c32] = pk4_fp8(acc[4 * g], acc[4 * g + 1], acc[4 * g + 2], acc[4 * g + 3]); }
        }
        __syncthreads();
#pragma unroll
        for (int r = 0; r < 16; ++r) { w2[r] = w2n[r]; sv[r] = svn[r]; }
#pragma unroll
        for (int i = 0; i < 8; ++i) { qv[i] = qvn[i]; kv[i] = kvn[i]; }
        b2 = b2n;
    }
#undef GP_LOADS
}

__device__ __forceinline__ void gla_combine_unit(const P& a, int unit) {
    const int tid = threadIdx.x, bh = unit >> 4, i8 = (unit & 15) * 512 + tid;
    const int d0 = 32 * (i8 >> 11) + 8 * ((i8 >> 9) & 3) + 4 * ((i8 >> 8) & 1);
    const unsigned* sl8 = (const unsigned*)a.out + (size_t)bh * 32 * 8192 + i8; u32x2* sl = (u32x2*)(a.ws + WS_SLOC) + (size_t)bh * 32 * 8192 + i8;
    const f32x4* dc = (const f32x4*)((const float*)(a.ws + WS_DEC) + (size_t)bh * 32 * 128 + d0);
    f32x4 s = (f32x4){0.f, 0.f, 0.f, 0.f};
    for (int cb = 0; cb < 32; cb += 8) {
        unsigned loc[8]; f32x4 dv[8];
#pragma unroll
        for (int i = 0; i < 8; ++i) { loc[i] = __builtin_nontemporal_load(sl8 + (size_t)(cb + i) * 8192); dv[i] = dc[(cb + i) * 32]; }
#pragma unroll
        for (int i = 0; i < 8; ++i) { if (cb + i < 31) {
            s.x = dv[i].x * s.x + __builtin_amdgcn_cvt_f32_fp8((int)loc[i], 0); s.y = dv[i].y * s.y + __builtin_amdgcn_cvt_f32_fp8((int)loc[i], 1);
            s.z = dv[i].z * s.z + __builtin_amdgcn_cvt_f32_fp8((int)loc[i], 2); s.w = dv[i].w * s.w + __builtin_amdgcn_cvt_f32_fp8((int)loc[i], 3);
            u32x2 w; w.x = cvt_pk_bf16(s.x, s.y); w.y = cvt_pk_bf16(s.z, s.w); sl[(size_t)(cb + i) * 8192] = w; } }
    }
}

constexpr int GL_QG = 0, GL_KG = 17408, GL_VT = 53248, GL_AM = 90112, GL_OST = 0;
constexpr int GL_QS = 272, GL_TS = 144, GL_OS = 528;
__device__ __forceinline__ int crow(int r, int hi) { return (r & 3) + 8 * (r >> 2) + 4 * hi; }
__device__ __forceinline__ void gla_out_unit(const P& a, LAS unsigned char* lds, int unit) {
    int tid = threadIdx.x; asm volatile("" : "+v"(tid)); const int w = __builtin_amdgcn_readfirstlane(tid >> 6), lane = tid & 63, c32 = lane & 31, hi = lane >> 5;
    const int bh = unit >> 5, chunk = unit & 31, b = bh >> 2, h = bh & 3;
    const bf16_t* proj = (const bf16_t*)(a.ws + WS_PROJ); bf16_t* oab = (bf16_t*)(a.ws + WS_OAB); const float* ggo = a.in[7];
    const size_t tile = (size_t)bh * 32 + chunk;
    {
        const u32x4* q_ = (const u32x4*)((const bf16_t*)(a.ws + WS_QG) + tile * 8192); const u32x4* k_ = (const u32x4*)((const bf16_t*)(a.ws + WS_KG) + tile * 8192);
        u32x4 sq[2], sk[2]; unsigned sv[16];
        sq[0] = __builtin_nontemporal_load(q_ + tid); sq[1] = __builtin_nontemporal_load(q_ + tid + 512); sk[0] = __builtin_nontemporal_load(k_ + tid); sk[1] = __builtin_nontemporal_load(k_ + tid + 512);
        const int ep = tid & 127, sq4 = tid >> 7;
        const bf16_t* v_ = proj + (size_t)(b * SEQ + chunk * 64 + 16 * sq4) * NPROJ + C_VA + h * 256 + 2 * ep;
#pragma unroll
        for (int i = 0; i < 16; ++i) sv[i] = __builtin_nontemporal_load((const unsigned*)(v_ + (size_t)i * NPROJ));
#pragma unroll
        for (int i = 0; i < 2; ++i) { const int p = tid + 512 * i;
            *(LAS u32x4*)(lds + GL_QG + (p >> 4) * GL_QS + (p & 15) * 16) = sq[i]; *(LAS u32x4*)(lds + GL_KG + (p >> 4) * GL_QS + (p & 15) * 16) = sk[i]; }
        u32x4 lo0, lo1, hi0, hi1;
#pragma unroll
        for (int j = 0; j < 4; ++j) { lo0[j] = (sv[2 * j] & 0xffffu) | (sv[2 * j + 1] << 16); lo1[j] = (sv[8 + 2 * j] & 0xffffu) | (sv[8 + 2 * j + 1] << 16);
            hi0[j] = (sv[2 * j] >> 16) | (sv[2 * j + 1] & 0xffff0000u); hi1[j] = (sv[8 + 2 * j] >> 16) | (sv[8 + 2 * j + 1] & 0xffff0000u); }
        LAS unsigned char* v0 = lds + GL_VT + (2 * ep) * GL_TS + sq4 * 32;
        *(LAS u32x4*)(v0) = lo0; *(LAS u32x4*)(v0 + 16) = lo1; *(LAS u32x4*)(v0 + GL_TS) = hi0; *(LAS u32x4*)(v0 + GL_TS + 16) = hi1;
    }
    u32x2 sf[4][2][2];
    if (chunk > 0) { const u32x2* sl = (const u32x2*)(a.ws + WS_SLOC) + (tile - 1) * 8192;
#pragma unroll
        for (int tl = 0; tl < 4; ++tl)
#pragma unroll
            for (int s = 0; s < 2; ++s)
#pragma unroll
                for (int q = 0; q < 2; ++q) sf[tl][s][q] = __builtin_nontemporal_load(sl + ((tl * 4 + 2 * s + q) * 2 + hi) * 256 + 32 * w + c32); }
    __syncthreads();
    if (w < 3) {
        const int ti = (w + 1) >> 1, si = w >> 1;
        f32x16 A;
#pragma unroll
        for (int r = 0; r < 16; ++r) A[r] = 0.f;
#pragma unroll
        for (int s = 0; s < 8; ++s) { const bf16x8 av = *(const LAS bf16x8*)(lds + GL_QG + (32 * ti + c32) * GL_QS + (16 * s + 8 * hi) * 2), bv = *(const LAS bf16x8*)(lds + GL_KG + (32 * si + c32) * GL_QS + (16 * s + 8 * hi) * 2);
            A = __builtin_amdgcn_mfma_f32_32x32x16_bf16(av, bv, A, 0, 0, 0); }
        const int sidx = 32 * si + c32;
#pragma unroll
        for (int r = 0; r < 16; ++r) { const int t = 32 * ti + crow(r, hi); const float v = (sidx <= t) ? A[r] : 0.f;
            *(LAS bf16_t*)(lds + GL_AM + t * GL_TS + sidx * 2) = (bf16_t)(cvt_pk_bf16(v, 0.f) & 0xffffu); }
    }
    __syncthreads();
    f32x16 o[2];
    {
        bf16x8 vt[4];
#pragma unroll
        for (int ks = 0; ks < 4; ++ks) vt[ks] = *(const LAS bf16x8*)(lds + GL_VT + (32 * w + c32) * GL_TS + (16 * ks + 8 * hi) * 2);
#pragma unroll
        for (int ti = 0; ti < 2; ++ti) {
#pragma unroll
            for (int r = 0; r < 16; ++r) o[ti][r] = 0.f;
            if (chunk > 0) {
#pragma unroll
                for (int tl = 0; tl < 4; ++tl)
#pragma unroll
                    for (int s = 0; s < 2; ++s) { const LAS unsigned char* qp = lds + GL_QG + (32 * ti + c32) * GL_QS + (32 * tl + 16 * s + 4 * hi) * 2;
                        const s16x4 lo = *(const LAS s16x4*)qp, hh = *(const LAS s16x4*)(qp + 16);
                        const bf16x8 aop = __builtin_shufflevector(lo, hh, 0, 1, 2, 3, 4, 5, 6, 7);
                        const u32x4 bw = {sf[tl][s][0].x, sf[tl][s][0].y, sf[tl][s][1].x, sf[tl][s][1].y};
                        o[ti] = __builtin_amdgcn_mfma_f32_32x32x16_bf16(aop, __builtin_bit_cast(bf16x8, bw), o[ti], 0, 0, 0); }
            }
#pragma unroll
            for (int ks = 0; ks < 4; ++ks) { if (ti == 0 && ks >= 2) continue;
                const bf16x8 av = *(const LAS bf16x8*)(lds + GL_AM + (32 * ti + c32) * GL_TS + (16 * ks + 8 * hi) * 2);
                o[ti] = __builtin_amdgcn_mfma_f32_32x32x16_bf16(av, vt[ks], o[ti], 0, 0, 0); }
        }
    }
    __syncthreads();
#pragma unroll
    for (int ti = 0; ti < 2; ++ti)
#pragma unroll
        for (int r = 0; r < 16; ++r) *(LAS bf16_t*)(lds + GL_OST + (32 * ti + crow(r, hi)) * GL_OS + (32 * w + c32) * 2) = (bf16_t)(cvt_pk_bf16(o[ti][r], 0.f) & 0xffffu);
    __syncthreads();
    {
        const int t = tid >> 3, sg = tid & 7; const size_t tok = (size_t)(b * SEQ + chunk * 64 + t);
        u32x4 ov[4]; float ss = 0.f;
#pragma unroll
        for (int j = 0; j < 4; ++j) { ov[j] = *(const LAS u32x4*)(lds + GL_OST + t * GL_OS + sg * 64 + j * 16);
#pragma unroll
            for (int i = 0; i < 4; ++i) { const float x0 = bflo(ov[j][i]), x1 = bfhi(ov[j][i]); ss += x0 * x0 + x1 * x1; } }
        ss += __shfl_xor(ss, 1); ss += __shfl_xor(ss, 2); ss += __shfl_xor(ss, 4);
        const float rstd = 1.0f / sqrtf(ss * (1.0f / 256.0f) + EPS);
        const bf16_t* rap = proj + tok * NPROJ + C_RA + h * 256 + sg * 32; bf16_t* op = oab + tok * 2048 + h * 256 + sg * 32; const float* gp = ggo + sg * 32;
#pragma unroll
        for (int j = 0; j < 4; ++j) { const u32x4 ra = __builtin_nontemporal_load((const u32x4*)(rap + 8 * j)); const f32x4 g0 = *(const f32x4*)(gp + 8 * j), g1 = *(const f32x4*)(gp + 8 * j + 4); u32x4 wv;
#pragma unroll
            for (int i = 0; i < 4; ++i) { const float r0 = bflo(ra[i]), r1 = bfhi(ra[i]); const float ga = (i < 2) ? g0[2 * i] : g1[2 * i - 4], gb = (i < 2) ? g0[2 * i + 1] : g1[2 * i - 3];
                wv[i] = cvt_pk_bf16(bflo(ov[j][i]) * rstd * ga * (r0 * fsigmoid(r0)), bfhi(ov[j][i]) * rstd * gb * (r1 * fsigmoid(r1))); }
            *(u32x4*)(op + 8 * j) = wv; }
    }
    __syncthreads();
}
namespace moba {
constexpr int HD = 128;
constexpr float SCALE = 0.08838834764831845f;
constexpr float THR = 8.f;
constexpr int NW = 8, QBLK = 32, KVBLK = 64, QB = NW * QBLK;
constexpr int SHM_V = KVBLK * HD * 2, SHM_K = KVBLK * HD * 2;
constexpr int OFF_WS = 2 * SHM_V + 2 * SHM_K;
constexpr int OFF_RTAB = OFF_WS + NW * 64 * 4;
constexpr int OFF_KM = OFF_RTAB + 2400 * 4;
constexpr int OFF_MISC = OFF_KM + 8 * 128 * 4;
constexpr int OFF_SEL = OFF_MISC + 64;
constexpr int LDS_BYTES = OFF_SEL + 2048;
constexpr int LDP = NPROJ, LDO = 2048;

#define KSWZ(row, colB) ((row) * 256 + ((colB) ^ (((row) & 7) << 4)))
#define SBAR() __builtin_amdgcn_sched_barrier(0)
__device__ __forceinline__ int v_st(int k, int c) { const int kk = (k & ~0xC) | ((k & 4) << 1) | ((k & 8) >> 1); return ((kk >> 3) * 4 + (c >> 5)) * 512 + ((kk & 7) * 32 + (c & 31)) * 2; }
__device__ __forceinline__ int v_rd_base(int lane) { return ((lane & 3) << 3) | (((lane >> 2) & 3) << 6) | (((lane >> 4) & 1) << 5) | (((lane >> 5) & 1) << 8); }
constexpr int v_rd_off(int d0, int ks, int half) { return d0 * 512 + ks * 4096 + half * 2048; }
__device__ __forceinline__ int crow(int r, int hi) { return (r & 3) + 8 * (r >> 2) + 4 * hi; }
__device__ __forceinline__ unsigned cvtpk(float lo, float hi) { unsigned r; asm volatile("v_cvt_pk_bf16_f32 %0, %1, %2" : "=v"(r) : "v"(lo), "v"(hi)); return r; }

__device__ __forceinline__ void mask_tile(f32x16& p0, f32x16& p1, int dq) {
    const float NEG = -__builtin_inff();
#pragma unroll
    for (int r = 0; r < 16; ++r) {
        const int c = (r & 3) + 8 * (r >> 2);
        if (dq - c < 0) p0[r] = NEG;
        if (dq - c - 32 < 0) p1[r] = NEG;
    }
}
__device__ __forceinline__ void bias_tile(f32x16& p0, f32x16& p1, const LAS float* rt) {
#pragma unroll
    for (int r = 0; r < 16; ++r) { const int c = (r & 3) + 8 * (r >> 2); p0[r] += rt[c]; p1[r] += rt[c + 32]; }
}
__device__ __forceinline__ void kill_tile(f32x16& p0, f32x16& p1) {
    const float NEG = -__builtin_inff();
#pragma unroll
    for (int r = 0; r < 16; ++r) { p0[r] = NEG; p1[r] = NEG; }
}
__device__ __forceinline__ void partialSM(f32x16& p0, f32x16& p1, float& m_reg, float& mn, float& alpha) {
    float pmax = p0[0];
#pragma unroll
    for (int r = 1; r < 16; ++r) pmax = fmaxf(pmax, p0[r]);
#pragma unroll
    for (int r = 0; r < 16; ++r) pmax = fmaxf(pmax, p1[r]);
    { auto rr = __builtin_amdgcn_permlane32_swap(__float_as_uint(pmax), __float_as_uint(pmax), false, false);
      pmax = fmaxf(__uint_as_float(rr[0]), __uint_as_float(rr[1])); }
    constexpr float C2 = 1.4426950408889634f * SCALE;
    if (__builtin_expect(__all((pmax - m_reg) * SCALE <= THR), 1)) { mn = m_reg; alpha = 1.f; }
    else { mn = fmaxf(m_reg, pmax); alpha = __builtin_amdgcn_exp2f((m_reg - mn) * C2); m_reg = mn; }
    const float mnL = -mn * C2;
#pragma unroll
    for (int r = 0; r < 16; ++r) p0[r] = fmaf(p0[r], C2, mnL);
#pragma unroll
    for (int r = 0; r < 16; ++r) p1[r] = fmaf(p1[r], C2, mnL);
#pragma unroll
    for (int r = 0; r < 16; ++r) p0[r] = __builtin_amdgcn_exp2f(p0[r]);
}
__device__ __forceinline__ void finishSM(f32x16& p0, f32x16& p1, float alpha, float& l_reg, bf16x8& pa0, bf16x8& pa1, bf16x8& pa2, bf16x8& pa3) {
#pragma unroll
    for (int r = 0; r < 16; ++r) p1[r] = __builtin_amdgcn_exp2f(p1[r]);
    float ps = 0;
#pragma unroll
    for (int r = 0; r < 16; ++r) ps += p0[r];
#pragma unroll
    for (int r = 0; r < 16; ++r) ps += p1[r];
    { auto rr = __builtin_amdgcn_permlane32_swap(__float_as_uint(ps), __float_as_uint(ps), false, false);
      ps = __uint_as_float(rr[0]) + __uint_as_float(rr[1]); }
    l_reg = l_reg * alpha + ps;
#define PK4(P, B_, OUT) do { unsigned a0 = cvtpk(P[B_+0], P[B_+1]), a1 = cvtpk(P[B_+2], P[B_+3]);                          \
        unsigned b0 = cvtpk(P[B_+4], P[B_+5]), b1 = cvtpk(P[B_+6], P[B_+7]);                                             \
        auto r0 = __builtin_amdgcn_permlane32_swap(a0, b0, false, false); auto r1 = __builtin_amdgcn_permlane32_swap(a1, b1, false, false); \
        u32x4 w = {r0[0], r1[0], r0[1], r1[1]}; OUT = __builtin_bit_cast(bf16x8, w); } while (0)
    PK4(p0, 0, pa0); PK4(p0, 8, pa1); PK4(p1, 0, pa2); PK4(p1, 8, pa3);
#undef PK4
}
template <int KB>
__device__ __forceinline__ void qkt(f32x16& p0, f32x16& p1, const char* K_lds, int r32, int hi, const bf16x8* qr) {
#pragma unroll
    for (int r = 0; r < 16; ++r) { p0[r] = 0.f; p1[r] = 0.f; }
    const char* kb[4];
#pragma unroll
    for (int dd = 0; dd < 4; ++dd) kb[dd] = K_lds + KB * SHM_K + KSWZ(r32, (dd * 16 + hi * 8) * 2);
#pragma unroll
    for (int d0 = 0; d0 < 8; ++d0) { const char* a = kb[d0 & 3] + (d0 >> 2) * 128;
        bf16x8 b0 = *reinterpret_cast<const bf16x8*>(a);
        bf16x8 b1 = *reinterpret_cast<const bf16x8*>(a + 32 * 256);
        p0 = __builtin_amdgcn_mfma_f32_32x32x16_bf16(b0, qr[d0], p0, 0, 0, 0);
        p1 = __builtin_amdgcn_mfma_f32_32x32x16_bf16(b1, qr[d0], p1, 0, 0, 0); }
}
template <int VB>
__device__ __forceinline__ void pv_tile(f32x16* o, int vb0, bf16x8 pa0, bf16x8 pa1, bf16x8 pa2, bf16x8 pa3) {
#define TRRD(dst, off) asm volatile("ds_read_b64_tr_b16 %0, %1 offset:%2" : "=&v"(dst) : "v"(vb0), "i"(off) : "memory")
#define PV_D0(d0) do { s16x4 l0, l1, l2, l3, h0, h1, h2, h3; constexpr int b_ = VB * SHM_V + v_rd_off(d0, 0, 0);   \
        TRRD(l0, b_); TRRD(h0, b_ + 2048); TRRD(l1, b_ + 4096); TRRD(h1, b_ + 6144); TRRD(l2, b_ + 8192); TRRD(h2, b_ + 10240); TRRD(l3, b_ + 12288); TRRD(h3, b_ + 14336); \
        asm volatile("s_waitcnt lgkmcnt(0)" ::: "memory"); SBAR();   \
        o[d0] = __builtin_amdgcn_mfma_f32_32x32x16_bf16(pa0, (bf16x8){l0[0], l0[1], l0[2], l0[3], h0[0], h0[1], h0[2], h0[3]}, o[d0], 0, 0, 0);   \
        o[d0] = __builtin_amdgcn_mfma_f32_32x32x16_bf16(pa1, (bf16x8){l1[0], l1[1], l1[2], l1[3], h1[0], h1[1], h1[2], h1[3]}, o[d0], 0, 0, 0);   \
        o[d0] = __builtin_amdgcn_mfma_f32_32x32x16_bf16(pa2, (bf16x8){l2[0], l2[1], l2[2], l2[3], h2[0], h2[1], h2[2], h2[3]}, o[d0], 0, 0, 0);   \
        o[d0] = __builtin_amdgcn_mfma_f32_32x32x16_bf16(pa3, (bf16x8){l3[0], l3[1], l3[2], l3[3], h3[0], h3[1], h3[2], h3[3]}, o[d0], 0, 0, 0); } while (0)
    PV_D0(0); PV_D0(1); PV_D0(2); PV_D0(3);
#undef PV_D0
#undef TRRD
}

struct BlockRef { const bf16_t* Q; const bf16_t* K; const bf16_t* V; bf16_t* O; int qb; int b, h; };
struct Seam { bf16x8 qr[8]; bf16x8 st_v0, st_v1, st_k0, st_k1; };
#define VMW() asm volatile("s_waitcnt vmcnt(0)" ::: "memory")
#define VMWN(n) asm volatile("s_waitcnt vmcnt(%0)" :: "i"(n) : "memory")
#define LD8(p) (*reinterpret_cast<const bf16x8*>(p))
#define SLOAD_H(Kp, Vp, k0) do { const char* kb__ = (const char*)(Kp) + (size_t)(k0) * (LDP * 2); \
        S.st_v0 = LD8(kb__ + 2048 + kvoff); S.st_v1 = LD8(kb__ + (32 * LDP * 2 + 2048) + kvoff); S.st_k0 = LD8(kb__ + kvoff); S.st_k1 = LD8(kb__ + 32 * LDP * 2 + kvoff); } while (0)
#define SWRITE_HK(bf) do { *(bf16x8*)(K_lds + (bf) * SHM_K + kws) = S.st_k0; *(bf16x8*)(K_lds + (bf) * SHM_K + kws + 32 * 256) = S.st_k1; } while (0)
#define SWRITE_HV(bf) do { *(bf16x8*)(V_lds + (bf) * SHM_V + vst0) = S.st_v0; *(bf16x8*)(V_lds + (bf) * SHM_V + vst1) = S.st_v1; } while (0)
#define SWRITE_H(bf) do { SWRITE_HV(bf); SWRITE_HK(bf); } while (0)

__device__ __forceinline__ void prime(const BlockRef& cur, char* lds, Seam& S) {
    int tid = threadIdx.x; asm volatile("" : "+v"(tid));     const int wid = __builtin_amdgcn_readfirstlane(tid >> 6), lane = tid & 63, r32 = lane & 31, hi = lane >> 5;
    const int sr = tid >> 4, sc = (tid & 15) * 8, kws = KSWZ(sr, sc * 2); char* K_lds = lds + 2 * SHM_V;
    const unsigned kvoff = (unsigned)(sr * LDP + sc) * 2u, qvoff = (unsigned)(r32 * LDP + hi * 8) * 2u;
    { const char* qb__ = (const char*)cur.Q + (size_t)(wid * QBLK) * (LDP * 2);
#pragma unroll
    for (int d0 = 0; d0 < 8; ++d0) S.qr[d0] = LD8(qb__ + qvoff + d0 * 32); }
    SLOAD_H(cur.K, cur.V, 0); VMW(); SWRITE_HK(0);
    __syncthreads();
}
__device__ __forceinline__ int rel_bucket(int n) {
    if (n < 16) return n;
    const float nf = (float)n;
    int large = 16 + (int)(logf(nf / 16.0f) / 5.545177444479562f * 16.0f);
    return large < 31 ? large : 31;
}
__device__ __forceinline__ BlockRef make_ref(const P& a, int item);
__device__ __forceinline__ int block(const P& a, const BlockRef& cur, unsigned* queue, const float* rel_bias, const float* kmp, char* lds, Seam& S) {
    int tid = threadIdx.x; asm volatile("" : "+v"(tid));     const int wid = __builtin_amdgcn_readfirstlane(tid >> 6), lane = tid & 63, r32 = lane & 31, hi = lane >> 5;
    const int qb = cur.qb, NT = 4 * (qb + 1);
    const int qlo = qb * QB + wid * QBLK, qrow = qlo + r32;
    char* V_lds = lds; char* K_lds = lds + 2 * SHM_V;
    float* ws = (float*)(lds + OFF_WS) + wid * 64; float* li_l = ws, * al_l = ws + 32;
    LAS float* rtab = (LAS float*)(LAS char*)(uintptr_t)(unsigned)(uintptr_t)(lds + OFF_RTAB);
    float* kmL = (float*)(lds + OFF_KM);
    volatile int* misc = (volatile int*)(lds + OFF_MISC);
    if (tid == 0) misc[0] = (int)__hip_atomic_fetch_add(queue, 1u, __ATOMIC_RELAXED, __HIP_MEMORY_SCOPE_AGENT);
    for (int i = tid; i < 2400; i += NW * 64) { const int dist = 2047 - i; rtab[i] = dist >= 0 ? rel_bias[rel_bucket(dist) * 8 + cur.h] * (1.0f / SCALE) : -__builtin_inff(); }
    for (int i = tid; i < qb * 128; i += NW * 64) { const int j = i >> 7, dd = i & 127; const size_t o = ((size_t)(cur.b * 8 + j)) * 1024 + cur.h * 128 + dd;
        kmL[i] = (kmp[o] + kmp[o + 64 * 1024]) * (1.0f / 256.0f); }
    __syncthreads();
    const int next_item = __builtin_amdgcn_readfirstlane(misc[0]);
    const BlockRef nxt = next_item < 512 ? make_ref(a, next_item) : cur;
    unsigned selmask = 0;
    {
        float sc7[7];
#pragma unroll
        for (int j = 0; j < 7; ++j) { sc7[j] = -__builtin_inff();
            if (j < qb) { float acc = 0.f;
#pragma unroll
                for (int d0 = 0; d0 < 8; ++d0) { const u32x4 q4 = __builtin_bit_cast(u32x4, S.qr[d0]); const f32x4 k0 = *(const f32x4*)(kmL + j * 128 + d0 * 16 + hi * 8), k1 = *(const f32x4*)(kmL + j * 128 + d0 * 16 + hi * 8 + 4);
                    acc += bflo(q4[0]) * k0[0] + bfhi(q4[0]) * k0[1] + bflo(q4[1]) * k0[2] + bfhi(q4[1]) * k0[3] + bflo(q4[2]) * k1[0] + bfhi(q4[2]) * k1[1] + bflo(q4[3]) * k1[2] + bfhi(q4[3]) * k1[3]; }
                acc += __shfl_xor(acc, 32); sc7[j] = acc; } }
#pragma unroll
        for (int j = 0; j < 7; ++j) { int rank = 0;
#pragma unroll
            for (int i = 0; i < 7; ++i) { if (i != j) rank += (sc7[i] > sc7[j] || (sc7[i] == sc7[j] && i < j)) ? 1 : 0; }
            if (j < qb && (qb <= 3 || rank < 3)) selmask |= 1u << j; }
    }
    LAS unsigned* selp = (LAS unsigned*)(LAS char*)(uintptr_t)(unsigned)(uintptr_t)(lds + OFF_SEL) + tid;
    *selp = selmask;
    float m_reg = -1e30f, l_reg = 0; f32x16 o[4];
#pragma unroll
    for (int d = 0; d < 4; ++d)
#pragma unroll
        for (int r = 0; r < 16; ++r) o[d][r] = 0.f;
    const int sr = tid >> 4, sc = (tid & 15) * 8, vst0 = v_st(sr, sc), vst1 = v_st(32 + sr, sc), kws = KSWZ(sr, sc * 2);
    const unsigned kvoff = (unsigned)(sr * LDP + sc) * 2u;
    const int vb0 = (int)(uintptr_t)V_lds + v_rd_base(lane);
    const bf16_t* Kh = cur.K; const bf16_t* Vh = cur.V;
#define RESC(a) do { if (__any((a) < 1.f)) { if (hi == 0) al_l[r32] = (a); asm volatile("s_waitcnt lgkmcnt(0)" ::: "memory");              \
                     for (int d_ = 0; d_ < 4; ++d_) for (int r = 0; r < 16; ++r) o[d_][r] *= al_l[crow(r, hi)]; } } while (0)
#define KBASE(t) ((t) * KVBLK)
#define MASKT(P0_, P1_, t) do { const int kb_ = KBASE(t); const int jb_ = (t) >> 2; \
        const bool on_ = (jb_ == qb) || ((*selp >> jb_) & 1u); \
        bias_tile(P0_, P1_, on_ ? rtab + (kb_ + 4 * hi - qrow + 2047) : rtab + 2304); } while (0)
    constexpr int NQL = 8;
#define SEAM_K0() do { VMWN(NQL); SWRITE_HK(0); SBAR(); } while (0)
    f32x16 pA0, pA1, pB0, pB1; float mnA, mnB, alA, alB; bf16x8 pa0, pa1, pa2, pa3;
    SWRITE_HV(0); SBAR();
    if (NT > 1) { SLOAD_H(Kh, Vh, KBASE(1)); }
    SBAR(); qkt<0>(pA0, pA1, K_lds, r32, hi, S.qr);
    MASKT(pA0, pA1, 0); partialSM(pA0, pA1, m_reg, mnA, alA);
    if (NT > 1) { VMW(); SWRITE_H(1); }
    __syncthreads();
#define HALF_STEP(PX0, PX1, mnX, alX, PY0, PY1, alY, t, KB, VB, SB) do {                                                      \
        SBAR(); if ((t) + 1 < NT) { SLOAD_H(Kh, Vh, KBASE((t) + 1)); SBAR(); }      \
        qkt<KB>(PX0, PX1, K_lds, r32, hi, S.qr);                                             \
        finishSM(PY0, PY1, alY, l_reg, pa0, pa1, pa2, pa3); SBAR();                                                           \
        pv_tile<VB>(o, vb0, pa0, pa1, pa2, pa3); MASKT(PX0, PX1, (t)); partialSM(PX0, PX1, m_reg, mnX, alX);                                        \
        __syncthreads();                                                                                                      \
        if ((t) + 1 < NT) { VMW(); SWRITE_H(SB); }                                                                          \
        RESC(alX); __syncthreads(); } while (0)
    for (int t = 1; t + 1 < NT; t += 2) {
        HALF_STEP(pB0, pB1, mnB, alB, pA0, pA1, alA, t, 1, 0, 0);
        HALF_STEP(pA0, pA1, mnA, alA, pB0, pB1, alB, t + 1, 0, 1, 1);
    }
    { SBAR(); qkt<1>(pB0, pB1, K_lds, r32, hi, S.qr); SBAR(); }
    SLOAD_H(nxt.K, nxt.V, 0); SBAR();
    { const char* qb__ = (const char*)nxt.Q + (size_t)(wid * QBLK) * (LDP * 2); int l_ = lane; asm volatile("" : "+v"(l_));
      const unsigned qvoff = (unsigned)((l_ & 31) * LDP + (l_ >> 5) * 8) * 2u;
#pragma unroll
    for (int d0 = 0; d0 < 8; ++d0) S.qr[d0] = LD8(qb__ + qvoff + d0 * 32); }
    SBAR();
    finishSM(pA0, pA1, alA, l_reg, pa0, pa1, pa2, pa3); SBAR();
    pv_tile<0>(o, vb0, pa0, pa1, pa2, pa3);
    { MASKT(pB0, pB1, NT - 1); partialSM(pB0, pB1, m_reg, mnB, alB); __syncthreads(); RESC(alB);
      finishSM(pB0, pB1, alB, l_reg, pa0, pa1, pa2, pa3); SBAR(); pv_tile<1>(o, vb0, pa0, pa1, pa2, pa3); }
    SBAR(); SEAM_K0();
    if (hi == 0) li_l[r32] = l_reg; asm volatile("s_waitcnt lgkmcnt(0)" ::: "memory");
    float rli[16];
#pragma unroll
    for (int r = 0; r < 16; ++r) rli[r] = __builtin_amdgcn_rcpf(li_l[crow(r, hi)]);
    char* Ow = (char*)cur.O + (size_t)(wid * QBLK) * (LDO * 2); const unsigned ovoff = (unsigned)(4 * hi * LDO + r32) * 2u;
#pragma unroll
    for (int r = 0; r < 16; ++r) { const int orow0 = (r & 3) + 8 * (r >> 2);
#pragma unroll
        for (int d0 = 0; d0 < 4; ++d0) { const float v = o[d0][r] * rli[r];
            const float vn = __shfl_xor(v, 1);
            if ((r32 & 1) == 0) *(unsigned*)(Ow + (size_t)(orow0 * LDO * 2 + d0 * 64) + ovoff) = cvtpk(v, vn); } }
    __syncthreads();
    return next_item;
#undef RESC
#undef KBASE
#undef MASKT
#undef SEAM_K0
#undef HALF_STEP
}
#undef ROWP
#undef VMW
#undef VMWN
#undef LD8
#undef SLOAD_H
#undef SWRITE_HK
#undef SWRITE_HV
#undef SWRITE_H

__device__ __forceinline__ BlockRef make_ref(const P& a, int item) {
    const int qb = 7 - (item >> 6), bh = item & 63, b = bh >> 3, h = bh & 7;
    const bf16_t* proj = (const bf16_t*)(a.ws + WS_PROJ);
    BlockRef r; r.b = b; r.h = h; r.qb = qb;
    r.Q = proj + (size_t)(b * SEQ + qb * QB) * LDP + C_QB + h * HD;
    r.K = proj + (size_t)(b * SEQ) * LDP + C_KB + h * HD;
    r.V = proj + (size_t)(b * SEQ) * LDP + C_VB + h * HD;
    r.O = (bf16_t*)(a.ws + WS_OAB) + (size_t)(b * SEQ + qb * QB) * LDO + 1024 + h * HD;
    return r;
}
}
__device__ __forceinline__ void router_unit(const P& a, LAS unsigned char* lds, int unit) {
    int tid = threadIdx.x; asm volatile("" : "+v"(tid)); const int wave = __builtin_amdgcn_readfirstlane(tid >> 6), lane = tid & 63, c32 = lane & 31, hi = lane >> 5;
    const int tg = wave & 1, kq = wave >> 1;
    const bf16_t* x1 = (const bf16_t*)(a.ws + WS_X1); const float* g = a.in[11]; const float* br = a.in[13];
    unsigned char* A2 = a.ws + WS_A2; const u32x4* frag = (const u32x4*)(a.ws + WS_WRF);
    LAS float* Lw = (LAS float*)(lds + wave * 4352);
    LAS float* ssp = (LAS float*)(lds + 8 * 4352);
    LAS unsigned* hist = (LAS unsigned*)(lds + 8 * 4352 + 2048);
    LAS unsigned* base = hist + 32;
    if (tid < 32) hist[tid] = 0u;
    const int tok = unit * 64 + tg * 32 + c32;
    f32x16 L;
#pragma unroll
    for (int r = 0; r < 16; ++r) L[r] = 0.f;
    float ss = 0.f;
    const bf16_t* xr = x1 + (size_t)tok * D + 8 * hi + 256 * kq; unsigned char* ar = A2 + (size_t)tok * D + 8 * hi + 256 * kq; const float* gr = g + 8 * hi + 256 * kq;
#pragma unroll 4
    for (int s = 0; s < 16; ++s) {
        const u32x4 xw = *(const u32x4*)(xr + 16 * s); const f32x4 xa = {bflo(xw.x), bfhi(xw.x), bflo(xw.y), bfhi(xw.y)}, xb = {bflo(xw.z), bfhi(xw.z), bflo(xw.w), bfhi(xw.w)}, ga = *(const f32x4*)(gr + 16 * s), gb = *(const f32x4*)(gr + 16 * s + 4);
        ss += (xa.x * xa.x + xa.y * xa.y) + (xa.z * xa.z + xa.w * xa.w) + (xb.x * xb.x + xb.y * xb.y) + (xb.z * xb.z + xb.w * xb.w);
        const f32x4 va = xa * ga, vb = xb * gb;
        u32x4 wh; wh.x = cvt_pk_bf16(va.x, va.y); wh.y = cvt_pk_bf16(va.z, va.w); wh.z = cvt_pk_bf16(vb.x, vb.y); wh.w = cvt_pk_bf16(vb.z, vb.w);
        { u32x2 w8; w8.x = pk4_fp8(va.x, va.y, va.z, va.w); w8.y = pk4_fp8(vb.x, vb.y, vb.z, vb.w); *(u32x2*)(ar + 16 * s) = w8; }
        u32x4 wl; wl.x = cvt_pk_bf16(va.x - bflo(wh.x), va.y - bfhi(wh.x)); wl.y = cvt_pk_bf16(va.z - bflo(wh.y), va.w - bfhi(wh.y));
        wl.z = cvt_pk_bf16(vb.x - bflo(wh.z), vb.y - bfhi(wh.z)); wl.w = cvt_pk_bf16(vb.z - bflo(wh.w), vb.w - bfhi(wh.w));
        const bf16x8 ah = __builtin_bit_cast(bf16x8, wh), al = __builtin_bit_cast(bf16x8, wl);
        const bf16x8 bh = __builtin_bit_cast(bf16x8, frag[(16 * kq + s) * 64 + lane]), bl = __builtin_bit_cast(bf16x8, frag[4096 + (16 * kq + s) * 64 + lane]);
        L = __builtin_amdgcn_mfma_f32_32x32x16_bf16(ah, bh, L, 0, 0, 0);
        L = __builtin_amdgcn_mfma_f32_32x32x16_bf16(ah, bl, L, 0, 0, 0);
        L = __builtin_amdgcn_mfma_f32_32x32x16_bf16(al, bh, L, 0, 0, 0);
    }
#pragma unroll
    for (int r = 0; r < 16; ++r) Lw[((r & 3) + 8 * (r >> 2) + 4 * hi) * 33 + c32] = L[r];
    ssp[wave * 64 + lane] = ss;
    __syncthreads();
    int e4[4] = {0, 0, 0, 0}; float w4[4] = {0.f, 0.f, 0.f, 0.f}; unsigned loc[4] = {0u, 0u, 0u, 0u}; float rstd = 0.f;
    const bool sel = (wave < 2) && (hi == 0);
    if (sel) {
        float sst = 0.f;
#pragma unroll
        for (int q = 0; q < 4; ++q) sst += ssp[(wave + 2 * q) * 64 + c32] + ssp[(wave + 2 * q) * 64 + 32 + c32];
        rstd = 1.0f / sqrtf(sst * (1.0f / D) + EPS);
        float lg[32];
#pragma unroll
        for (int e = 0; e < 32; ++e) { const LAS float* lp = (const LAS float*)(lds + wave * 4352) + c32 * 33 + e; lg[e] = (lp[0] + lp[2 * 1088] + lp[4 * 1088] + lp[6 * 1088]) * rstd + br[e]; }
        unsigned used = 0u; float v4[4];
#pragma unroll
        for (int p = 0; p < 4; ++p) { float best = -__builtin_inff(); int bi = 0;
#pragma unroll
            for (int e = 0; e < 32; ++e) { const bool take = !((used >> e) & 1u) && lg[e] > best; best = take ? lg[e] : best; bi = take ? e : bi; }
            used |= 1u << bi; e4[p] = bi; v4[p] = best; }
        float sum = 0.f;
#pragma unroll
        for (int p = 0; p < 4; ++p) { w4[p] = expf(v4[p] - v4[0]); sum += w4[p]; }
        const float inv = 1.0f / sum;
#pragma unroll
        for (int p = 0; p < 4; ++p) { w4[p] *= inv; loc[p] = __hip_atomic_fetch_add(hist + e4[p], 1u, __ATOMIC_RELAXED, __HIP_MEMORY_SCOPE_WORKGROUP); }
    }
    __syncthreads();
    if (tid < 32) base[tid] = __hip_atomic_fetch_add((unsigned*)(a.ws + WS_CTL) + CW_COUNTS + tid, hist[tid], RLX_AGENT);
    __syncthreads();
    if (sel) {
        int* tope = (int*)(a.ws + WS_TOPE) + (size_t)tok * 4; float* wts = (float*)(a.ws + WS_WTS) + (size_t)tok * 4; int* slot = (int*)(a.ws + WS_SLOT) + (size_t)tok * 4;
#pragma unroll
        for (int p = 0; p < 4; ++p) { const int sl_ = (int)(base[e4[p]] + loc[p]); tope[p] = e4[p]; wts[p] = w4[p]; slot[p] = sl_;
            ((int*)(a.ws + WS_ROWE))[(size_t)e4[p] * T + sl_] = tok; ((float*)(a.ws + WS_RSTE))[(size_t)e4[p] * T + sl_] = rstd; }
    }
    __syncthreads();
}

__device__ __forceinline__ void moe_tables(const P& a, LAS unsigned char* lds) {
    int tid = threadIdx.x; asm volatile("" : "+v"(tid)); const int wave = tid >> 6, lane = tid & 63, e = lane & 31;
    LAS int* pstart = (LAS int*)(lds + LDS_MOE); LAS int* cnt = pstart + 64; LAS int* tile_e = pstart + 128;
    const unsigned* counts = (const unsigned*)(a.ws + WS_CTL) + CW_COUNTS;
    const int c = (int)counts[e]; const int p = ((c + 255) >> 8) << 8; int inc = p;
#pragma unroll
    for (int o = 1; o < 32; o <<= 1) { const int t = __builtin_amdgcn_ds_bpermute(((lane - o) & 63) << 2, inc); if (e >= o) inc += t; }
    if (tid < 32) { cnt[e] = c; pstart[e] = inc - p; if (e == 31) { pstart[32] = inc; tile_e[MAXTILES] = inc >> 8; } }
    for (int t = wave * 36; t < wave * 36 + 36; ++t) { const unsigned long long m = __ballot(inc <= t * 256); const int ee = __builtin_popcount((unsigned)m); if (lane == 0) tile_e[t] = ee < NE ? ee : NE - 1; }
    __syncthreads();
}

__device__ __forceinline__ void combine_rows(const P& a, LAS unsigned char* lds, int vcu, int G, int wave, int lane) {
    const LAS int* pstart = (const LAS int*)(lds + LDS_MOE);
    const int gw = vcu * NWAVES + wave, NGW = G * NWAVES;
    const bf16_t* X1 = (const bf16_t*)(a.ws + WS_X1); float* X = (float*)(a.ws + WS_X2); const unsigned char* Y = a.ws + WS_YROWS; bf16_t* A3 = (bf16_t*)(a.ws + WS_H);
    const int* tope = (const int*)(a.ws + WS_TOPE); const int* slot = (const int*)(a.ws + WS_SLOT); const float* wts = (const float*)(a.ws + WS_WTS); const float* g = a.in[20];
    f32x4 gv[4];
#pragma unroll
    for (int j = 0; j < 4; ++j) gv[j] = *((const f32x4*)g + lane + 64 * j);
    for (int m = gw; m < T; m += NGW) {
        f32x4* xr = (f32x4*)(X + (size_t)m * D) + lane; const u32x2* x1r = (const u32x2*)(X1 + (size_t)m * D) + lane; f32x4 v[4];
#pragma unroll
        for (int j = 0; j < 4; ++j) { const u32x2 xq = __builtin_nontemporal_load(x1r + 64 * j); v[j] = (f32x4){bflo(xq.x), bfhi(xq.x), bflo(xq.y), bfhi(xq.y)}; }
#pragma unroll
        for (int k = 0; k < 4; ++k) { const int d = __builtin_amdgcn_readfirstlane(pstart[tope[m * 4 + k]] + slot[m * 4 + k]); const float w = __uint_as_float(__builtin_amdgcn_readfirstlane(__float_as_uint(wts[m * 4 + k])));
            const unsigned* yr = (const unsigned*)(Y + (size_t)d * D) + lane;
#pragma unroll
            for (int j = 0; j < 4; ++j) { const int y = (int)__builtin_nontemporal_load(yr + 64 * j);
                v[j].x += w * __builtin_amdgcn_cvt_f32_fp8(y, 0); v[j].y += w * __builtin_amdgcn_cvt_f32_fp8(y, 1); v[j].z += w * __builtin_amdgcn_cvt_f32_fp8(y, 2); v[j].w += w * __builtin_amdgcn_cvt_f32_fp8(y, 3); } }
        float s = 0.f;
#pragma unroll
        for (int j = 0; j < 4; ++j) s += (v[j].x * v[j].x + v[j].y * v[j].y) + (v[j].z * v[j].z + v[j].w * v[j].w);
        const float rstd = 1.0f / sqrtf(wave_sum(s) * (1.0f / D) + EPS);
        unsigned* o4 = (unsigned*)((unsigned char*)A3 + (size_t)m * D) + lane;
#pragma unroll
        for (int j = 0; j < 4; ++j) { xr[64 * j] = v[j]; o4[64 * j] = pk4_fp8(v[j].x * rstd * gv[j].x, v[j].y * rstd * gv[j].y, v[j].z * rstd * gv[j].z, v[j].w * rstd * gv[j].w); }
    }
}
__device__ __forceinline__ void final_rows(const P& a, int vcu, int G, int wave, int lane) {
    const int gw = vcu * NWAVES + wave, NGW = G * NWAVES;
    const float* X = (const float*)(a.ws + WS_X2); float* OUT = a.out; const bf16_t* PG = (const bf16_t*)(a.ws + WS_PGATE); const bf16_t* PP = (const bf16_t*)(a.ws + WS_PPROJ);
    f32x4 gp[4], gf[4];
#pragma unroll
    for (int j = 0; j < 4; ++j) { gp[j] = *((const f32x4*)a.in[23] + lane + 64 * j); gf[j] = *((const f32x4*)a.in[24] + lane + 64 * j); }
    for (int m = gw; m < T; m += NGW) {
        const f32x4* xr = (const f32x4*)(X + (size_t)m * D) + lane; f32x4* orow = (f32x4*)(OUT + (size_t)m * D) + lane; const u32x2* pgr = (const u32x2*)(PG + (size_t)m * D) + lane; const u32x2* ppr = (const u32x2*)(PP + (size_t)m * D) + lane;
        f32x4 v[4], pp[4], pg[4]; float sp = 0.f;
#pragma unroll
        for (int j = 0; j < 4; ++j) { v[j] = __builtin_nontemporal_load(xr + 64 * j); const u32x2 q = __builtin_nontemporal_load(ppr + 64 * j), gq = __builtin_nontemporal_load(pgr + 64 * j);
            pp[j] = (f32x4){bflo(q.x), bfhi(q.x), bflo(q.y), bfhi(q.y)}; pg[j] = (f32x4){bflo(gq.x), bfhi(gq.x), bflo(gq.y), bfhi(gq.y)};
            sp += (pp[j].x * pp[j].x + pp[j].y * pp[j].y) + (pp[j].z * pp[j].z + pp[j].w * pp[j].w); }
        const float rp = 1.0f / sqrtf(wave_sum(sp) * (1.0f / D) + EPS); float s = 0.f;
#pragma unroll
        for (int j = 0; j < 4; ++j) { v[j] = v[j] + pg[j] * (pp[j] * rp * gp[j]); s += (v[j].x * v[j].x + v[j].y * v[j].y) + (v[j].z * v[j].z + v[j].w * v[j].w); }
        const float rstd = 1.0f / sqrtf(wave_sum(s) * (1.0f / D) + EPS);
#pragma unroll
        for (int j = 0; j < 4; ++j) __builtin_nontemporal_store(v[j] * rstd * gf[j], orow + 64 * j);
    }
}
struct Args { P p; };
template <int PH_LO, int PH_HI>
__global__ void __launch_bounds__(NTHREADS, 2) hybrid_fwd(Args args) {
    extern __shared__ __attribute__((aligned(16))) unsigned char lds_raw[];
    LAS unsigned char* lds = (LAS unsigned char*)lds_raw;
    const P& a = args.p;
    const int tid = threadIdx.x;
#define FRESH_WL() int t_ = threadIdx.x; asm volatile("" : "+v"(t_)); const int w_ = __builtin_amdgcn_readfirstlane(t_ >> 6), l_ = t_ & 63
    const int G = gridDim.x; const int bx = blockIdx.x; const int vcu = (G % 8 == 0) ? (bx % 8) * (G / 8) + bx / 8 : bx;
    unsigned* ctl = (unsigned*)(a.ws + WS_CTL);
    for (int u = tid; u < (LDS_BYTES - LDSCTL_OFF) / 4; u += NTHREADS) ((LAS unsigned*)(lds + LDSCTL_OFF))[u] = 0u;
    __syncthreads();
#if MK_PER_PHASE
#define GRID_BAR() do { } while (0)
#else
    XcdBarrier bar = xcd_barrier_post(ctl + CW_BAR, (volatile LAS unsigned*)(lds + MISC_OFF + 32));
#define GRID_BAR() xcd_barrier(bar)
#endif
    constexpr int lo = PH_LO, hi = PH_HI;
#define IN(k) (lo <= (k) && (k) < hi)
#define SEAM(k) do { if constexpr (IN(k) && IN((k) + 1)) GRID_BAR(); } while (0)
    unsigned char* ws = a.ws;

    if constexpr (IN(0)) { FRESH_WL(); p0_prologue(a, lds, vcu, G, w_, l_); }
    SEAM(0);
    if constexpr (IN(1)) {
        { pg8::DenseSched S; S.o.init(T / 256, 12, G, bx); S.Bt = (const char*)(ws + WS_WIN); S.K = D;
          pg8::EpiProj<false> E{(bf16_t*)(ws + WS_PROJ), (float*)(ws + WS_KMP)};
          pg8::gemm_phase(lds, (const char*)(ws + WS_H), D, D, D, S, E); }
        { pg8::DenseSched S; S.o.init(T / 256, 20, G, bx); S.Bt = (const char*)(ws + WS_WIN8); S.K = D; S.es = 1; S.pn0 = 12; S.bt_out = false;
          pg8::EpiProj<true> E{(bf16_t*)(ws + WS_PROJ), (float*)(ws + WS_KMP)};
          pg8::gemm_phase(lds, (const char*)(ws + WS_H8), D, D, D, S, E); }
    }
    SEAM(1);
    if constexpr (IN(2)) { for (int u = vcu; u < NB * 32; u += G) gla_prep_unit(a, lds, u); }
    SEAM(2);
    if constexpr (IN(3)) { for (int u = vcu; u < 512; u += G) gla_combine_unit(a, u); }
    SEAM(3);
    if constexpr (IN(4)) {
        for (int u = vcu; u < 1024; u += G) gla_out_unit(a, lds, u);
        __syncthreads();
    }
    if constexpr (IN(5)) {
        if ((vcu & 1) == 0) { FRESH_WL(); expert_convert(a, lds, vcu >> 1, G >> 1, w_, l_); __syncthreads(); }
        unsigned* queue = ctl + CW_QUEUE;
        volatile LAS int* qslot = (volatile LAS int*)(lds + LDSCTL_OFF + 1024);
        if (tid == 0) qslot[0] = (int)__hip_atomic_fetch_add(queue, 1u, RLX_AGENT);
        __syncthreads();
        int item = __builtin_amdgcn_readfirstlane(qslot[0]);
        if (item < 512) {
            moba::Seam S;
            moba::BlockRef cur = moba::make_ref(a, item);
            moba::prime(cur, (char*)lds_raw, S);
            for (;;) {
                const int nitem = moba::block(a, cur, queue, a.in[2], (const float*)(ws + WS_KMP), (char*)lds_raw, S);
                if (nitem >= 512) break;
                cur = moba::make_ref(a, nitem);
            }
        }
    }
    SEAM(5);
    if constexpr (IN(6)) {
        pg8::ChainSched S; S.o.init(T / 256, D / 256, G, bx); S.Bt = (const char*)(ws + WS_WUP); S.K = 1024;
        pg8::EpiMerge E{(const bf16_t*)(ws + WS_PROJ), (bf16_t*)(ws + WS_Y)};
        pg8::gemm_phase(lds, (const char*)(ws + WS_OAB), 1024, 2048, 2048, S, E);
    }
    SEAM(6);
    if constexpr (IN(7)) {
        pg8::DenseSched S; S.o.init(T / 256, D / 256, G, bx); S.Bt = (const char*)(ws + WS_WO); S.K = D;
        pg8::EpiResF32 E{a.in[0], (bf16_t*)(ws + WS_X1)};
        pg8::gemm_phase(lds, (const char*)(ws + WS_Y), D, D, D, S, E);
    }
    SEAM(7);
    if constexpr (IN(8)) { for (int u = vcu; u < T / 64; u += G) router_unit(a, lds, u); }
    SEAM(8);
    if constexpr (IN(9)) {
        moe_tables(a, lds); const LAS int* tab = (const LAS int*)(lds + LDS_MOE); const int ntile = __builtin_amdgcn_readfirstlane(tab[128 + MAXTILES]);
        pg8::MoeSched<true> S; S.o.init(ntile, 8, G, bx); S.Bt = (const char*)a.out; S.K = D; S.rows_per_e = 2048; S.tab = tab; S.row_e = (const int*)(ws + WS_ROWE); S.es = 1;
        pg8::EpiGlu E{(unsigned char*)(ws + WS_HMID), (const float*)(ws + WS_RSTE), tab, a.in[15], a.in[17], (const float*)(ws + WS_CTL) + 131072, lds};
        pg8::gemm_phase(lds, (const char*)(ws + WS_A2), D, D, D, S, E);
        const int extra = (ntile * 8) % G, nidle = G - extra;
        if (bx >= extra) { __syncthreads();
            pg8::DenseSched S2; S2.o.init(T / 256, D / 256, nidle, bx - extra); S2.Bt = (const char*)(ws + WS_WPP); S2.K = 256;
            pg8::EpiBf16<0, false> E2{(bf16_t*)(ws + WS_PPROJ), D, nullptr, 0, 1.0f};
            pg8::gemm_phase(lds, (const char*)(ws + WS_PB), 256, 256, 256, S2, E2); }
    }
    SEAM(9);
    if constexpr (IN(10)) {
        moe_tables(a, lds); const LAS int* tab = (const LAS int*)(lds + LDS_MOE); const int ntile = __builtin_amdgcn_readfirstlane(tab[128 + MAXTILES]);
        pg8::MoeSched<false> S; S.o.init(ntile, 4, G, bx); S.Bt = (const char*)(ws + WS_W2T); S.K = FF; S.rows_per_e = 1024; S.tab = tab; S.row_e = nullptr; S.es = 1;
        pg8::EpiDownF8 E{(unsigned char*)(ws + WS_YROWS), a.in[19]};
        pg8::gemm_phase(lds, (const char*)(ws + WS_HMID), FF, FF, FF, S, E);
    }
    SEAM(10);
    if constexpr (IN(11)) { moe_tables(a, lds); FRESH_WL(); combine_rows(a, lds, vcu, G, w_, l_); }
    SEAM(11);
    if constexpr (IN(12)) {
        { pg8::DenseSched S; S.o.init(T / 256, D / 256, G, bx); S.Bt = (const char*)(ws + WS_WPG); S.K = D; S.es = 1;
          pg8::EpiBf16<1, false, true> E{(bf16_t*)(ws + WS_PGATE), D, nullptr, 0, 1.0f / 32.0f};
          pg8::gemm_phase(lds, (const char*)(ws + WS_H), D, D, D, S, E); }
    }
    SEAM(12);
    if constexpr (IN(13)) { FRESH_WL(); final_rows(a, vcu, G, w_, l_); }
#undef FRESH_WL
#undef IN
#undef SEAM
#undef GRID_BAR
}

template <int LO, int HI> static void launch_range(const Args& a, int grid, hipStream_t stream) {
    static bool attr = false;
    if (!attr) { attr = true; if (hipFuncSetAttribute((const void*)hybrid_fwd<LO, HI>, hipFuncAttributeMaxDynamicSharedMemorySize, LDS_BYTES) != hipSuccess) fprintf(stderr, "kernel_launch: hipFuncSetAttribute failed\n"); }
    hipLaunchKernelGGL((hybrid_fwd<LO, HI>), dim3(grid), dim3(NTHREADS), LDS_BYTES, stream, a);
}
extern "C" void kernel_launch(void* const* d_in, const int* in_sizes, int n_in, void* d_out, int out_size, void* d_ws, size_t ws_size, hipStream_t stream) {
    static int grid = 0;
    if (grid == 0) {
        static const int expect[25] = {T * D, T * 256, 256, 1024, 1024 * D_IN, 16 * 512, 512, 256, 1048576, 1048576, 1048576, 1024, 32768, 32, 33554432, 32768, 33554432, 32768, 33554432, 32768, 1024, 1048576, 262144, 1024, 1024};
        bool okk = (n_in == 25);
        for (int i = 0; okk && i < 25; ++i) if (in_sizes[i] != expect[i]) { fprintf(stderr, "kernel_launch: input %d has %d elements, expected %d\n", i, in_sizes[i], expect[i]); okk = false; }
        if (!okk || out_size != T * D || ws_size < WS_END) { fprintf(stderr, "kernel_launch: unexpected shapes (n_in %d, in0 %d, out %d, ws %zu); nothing launched\n", n_in, n_in > 0 ? in_sizes[0] : -1, out_size, ws_size); grid = -1; return; }
        int dev = 0, cus = 0;
        if (hipGetDevice(&dev) != hipSuccess || hipDeviceGetAttribute(&cus, hipDeviceAttributeMultiprocessorCount, dev) != hipSuccess) { grid = -1; return; }
        grid = cus;
    }
    if (grid < 0) return;
    (void)hipMemsetAsync((char*)d_ws + WS_CTL, 0, CTL_ZERO_BYTES, stream);
    Args a{};
    for (int i = 0; i < 25; ++i) a.p.in[i] = (const float*)d_in[i];
    a.p.out = (float*)d_out; a.p.ws = (unsigned char*)d_ws;
#if MK_PER_PHASE
#ifndef MK_LAST
#define MK_LAST 13
#endif
#ifndef MK_REPEAT
#define MK_REPEAT 0
#endif
#define LR(k) do { if ((k) <= MK_LAST) for (int r_ = 0; r_ < 1 + ((MK_REPEAT >> (k)) & 1); ++r_) launch_range<(k), (k) + 1>(a, grid, stream); } while (0)
    LR(0); LR(1); LR(2); LR(3); LR(4); LR(5); LR(6); LR(7); LR(8); LR(9); LR(10); LR(11); LR(12); LR(13);
#undef LR
#else
    launch_range<0, NPHASES>(a, grid, stream);
#endif
}
```

```cpp
#include <hip/hip_runtime.h>
#include <cstdio>
#include <cstdint>

#define LAS __attribute__((address_space(3)))
#define GAS __attribute__((address_space(1)))
typedef unsigned short bf16_t;
typedef short bf16x8 __attribute__((ext_vector_type(8)));
typedef short s16x4 __attribute__((ext_vector_type(4)));
typedef float f32x2 __attribute__((ext_vector_type(2)));
typedef float f32x4 __attribute__((ext_vector_type(4)));
typedef float f32x16 __attribute__((ext_vector_type(16)));
typedef unsigned u32x2 __attribute__((ext_vector_type(2)));
typedef unsigned u32x4 __attribute__((ext_vector_type(4)));
typedef int i32x4 __attribute__((ext_vector_type(4)));
typedef int i32x8 __attribute__((ext_vector_type(8)));
typedef GAS unsigned gu32;
#define RLX_AGENT __ATOMIC_RELAXED, __HIP_MEMORY_SCOPE_AGENT
#define LDS_WAIT() asm volatile("s_waitcnt lgkmcnt(0)" ::: "memory")
#define VM_WAIT() asm volatile("s_waitcnt vmcnt(0)" ::: "memory")

#ifndef MK_PER_PHASE
#define MK_PER_PHASE 0
#endif

constexpr int NB = 8, SEQ = 2048, T = NB * SEQ, D = 1024;
constexpr int NPROJ = 8192;
constexpr int C_QA = 0, C_KA = 512, C_VA = 1024, C_RA = 2048, C_QB = 3072, C_KB = 4096, C_VB = 5120, C_GA = 6144, C_GB = 7168;
#define PROJ_BLK(cs) ((size_t)(cs) * T)
constexpr int SRC_ALOW = 3072, D_IN = 8208;
constexpr int NE = 32, FF = 1024, MAXTILES = 288, MAXROWS = MAXTILES * 256;
constexpr float EPS = 1e-6f;
constexpr int NWAVES = 8, NTHREADS = 512;
constexpr int NPHASES = 14;

constexpr size_t MiB = 1u << 20;
constexpr size_t WS_CTL = 0, CTL_ZERO_BYTES = 1 * MiB;
constexpr size_t WS_SMALL = 1 * MiB;
constexpr size_t WS_KMP   = WS_SMALL;
constexpr size_t WS_DEC   = WS_KMP + 512 * 1024;
constexpr size_t WS_TOPE  = WS_DEC + 512 * 1024;
constexpr size_t WS_WTS   = WS_TOPE + 256 * 1024;
constexpr size_t WS_SLOT  = WS_WTS + 256 * 1024;
constexpr size_t WS_DEST  = WS_SLOT + 256 * 1024;
constexpr size_t WS_ROWTOK = WS_DEST + 256 * 1024;
constexpr size_t WS_RSTDS = WS_ROWTOK + 320 * 1024;
constexpr size_t WS_RSTD  = WS_RSTDS + 320 * 1024;
constexpr size_t WS_TILEE = WS_RSTD + 64 * 1024;
constexpr size_t WS_WALT  = WS_TILEE + 4 * 1024;
constexpr size_t WS_WRF   = WS_WALT + 32 * 1024;
static_assert(WS_WRF + 128 * 1024 <= 6 * MiB, "small map");
constexpr size_t WS_WO = 6 * MiB, WS_WPG = 8 * MiB, WS_WPP = 10 * MiB, WS_WUP = 12 * MiB, WS_WIN = 16 * MiB;
constexpr size_t WS_PB = 34 * MiB;
constexpr size_t WS_H  = 42 * MiB;
constexpr size_t WS_PROJ = 74 * MiB;
constexpr size_t WS_QG = 330 * MiB, WS_KG = 346 * MiB;
constexpr size_t WS_SLOC = 426 * MiB;
constexpr size_t WS_OAB = 362 * MiB;
constexpr size_t WS_H8 = 426 * MiB;
constexpr size_t WS_WIN8 = 442 * MiB;
constexpr size_t WS_Y = 330 * MiB;
constexpr size_t WS_W2T = 42 * MiB;
constexpr size_t WS_A2 = 330 * MiB;
constexpr size_t WS_HMID = 138 * MiB;
constexpr size_t WS_X1 = 74 * MiB;
constexpr size_t WS_X2 = 138 * MiB;
constexpr size_t WS_YROWS = 282 * MiB;
constexpr size_t WS_PGATE = 330 * MiB, WS_PPROJ = 226 * MiB;
constexpr size_t WS_ROWE = 490 * MiB;
constexpr size_t WS_RSTE = 492 * MiB;
constexpr size_t WS_END = 506 * MiB;

constexpr int CW_BAR = 4096;
constexpr int CW_COUNTS = 16384;
constexpr int CW_QUEUE = 16384 + 64;

constexpr int RING_BYTES = 131072;
constexpr int LDSCTL_OFF = RING_BYTES, MISC_OFF = LDSCTL_OFF + 320;
constexpr int LDS_MOE = LDSCTL_OFF + 10240;
constexpr int EPF_OFF = LDSCTL_OFF + 12288;
constexpr int LDS_BYTES = 151552;

typedef __bf16 bf16v2_t __attribute__((ext_vector_type(2)));
__device__ __forceinline__ unsigned cvt_pk_bf16(float lo, float hi) { const f32x2 v = {lo, hi}; return __builtin_bit_cast(unsigned, __builtin_convertvector(v, bf16v2_t)); }
__device__ __forceinline__ unsigned pk4_fp8(float a, float b, float c, float d) { int w = 0; w = __builtin_amdgcn_cvt_pk_fp8_f32(a, b, w, false); w = __builtin_amdgcn_cvt_pk_fp8_f32(c, d, w, true); return (unsigned)w; }
__device__ __forceinline__ float bf2f(unsigned short s) { return __uint_as_float(((unsigned)s) << 16); }
__device__ __forceinline__ float bflo(unsigned w) { return __uint_as_float(w << 16); }
__device__ __forceinline__ float bfhi(unsigned w) { return __uint_as_float(w & 0xffff0000u); }
__device__ __forceinline__ float fsigmoid(float x) { return __builtin_amdgcn_rcpf(1.0f + __builtin_amdgcn_exp2f(-1.4426950408889634f * x)); }
__device__ __forceinline__ float wave_sum(float v) {
#pragma unroll
    for (int o = 1; o < 64; o <<= 1) v += __shfl_xor(v, o);
    return v;
}
__device__ __forceinline__ bf16x8 pack8(f32x4 a, f32x4 b) {
    u32x4 w = {cvt_pk_bf16(a[0], a[1]), cvt_pk_bf16(a[2], a[3]), cvt_pk_bf16(b[0], b[1]), cvt_pk_bf16(b[2], b[3])};
    return __builtin_bit_cast(bf16x8, w);
}

#define XB_TMO      128
#define XB_XCNT(j)  (256  + 64 * (j))
#define XB_XSUB(j)  (1280 + 64 * (j))
#define XB_XGEN(j)  (2304 + 64 * (j))
#define XB_TOP      3328
#define XB_TOPGEN   3392
#define XCD_BAR_WORDS 3456
#define XB_SPIN_CAP (1u << 18)

__device__ __forceinline__ unsigned xb_ld(unsigned* p)              { return __hip_atomic_load(p, __ATOMIC_RELAXED, __HIP_MEMORY_SCOPE_AGENT); }
__device__ __forceinline__ unsigned xb_add(unsigned* p, unsigned v) { return __hip_atomic_fetch_add(p, v, __ATOMIC_RELAXED, __HIP_MEMORY_SCOPE_AGENT); }
__device__ __forceinline__ unsigned xb_xcc_id() { return (unsigned)__builtin_amdgcn_s_getreg((3 << 11) | 20) & 0xFu; }
#define XB_SPIN(cond, bar) do { unsigned _sp = 0; while (cond) { __builtin_amdgcn_s_sleep(1); \
    if ((++_sp & 255u) == 0u) { if (xb_ld(&(bar)[XB_TMO])) break; if (_sp > XB_SPIN_CAP) { atomicAdd(&(bar)[XB_TMO], 1u); break; } } } } while (0)

struct XcdBarrier { unsigned* bar; unsigned x; volatile LAS unsigned* st; };

__device__ __forceinline__ XcdBarrier xcd_barrier_post(unsigned* bar, volatile LAS unsigned* st) {
    XcdBarrier b; b.bar = bar; b.x = xb_xcc_id(); b.st = st;
    if (threadIdx.x == 0) (void)xb_add(&bar[XB_XCNT(b.x)], 1u);
    return b;
}
__device__ __forceinline__ void xcd_barrier_complete(unsigned* bar, unsigned x, unsigned& nloc, unsigned& nx) {
    const unsigned G = gridDim.x * gridDim.y * gridDim.z;
    unsigned sum, cnt, mine, sp = 0u;
    for (;;) {
        sum = 0u; cnt = 0u; mine = 0u;
#pragma unroll
        for (unsigned j = 0; j < 16; ++j) { const unsigned c = xb_ld(&bar[XB_XCNT(j)]); sum += c; cnt += (c > 0u) ? 1u : 0u; mine = (j == x) ? c : mine; }
        if (sum == G) break;
        __builtin_amdgcn_s_sleep(1);
        if ((++sp & 255u) == 0u) { if (xb_ld(&bar[XB_TMO])) break; if (sp > XB_SPIN_CAP) { atomicAdd(&bar[XB_TMO], 1u); break; } }
    }
    nloc = mine > 0u ? mine : 1u; nx = cnt > 0u ? cnt : 1u;
}
__device__ __forceinline__ void xcd_barrier(const XcdBarrier& b) {
    asm volatile("s_waitcnt vmcnt(0)" ::: "memory");
    __syncthreads();
    if (threadIdx.x == 0) {
        unsigned* bar = b.bar;
        __builtin_amdgcn_s_waitcnt(0);
        unsigned nloc = b.st[0], nx = b.st[1];
        if (nloc == 0u) { xcd_barrier_complete(bar, b.x, nloc, nx); b.st[0] = nloc; b.st[1] = nx; }
        const unsigned old = xb_add(&bar[XB_XSUB(b.x)], 1u);
        const unsigned gen = old / nloc;
        if (old + 1u == (gen + 1u) * nloc) {
            __builtin_amdgcn_fence(__ATOMIC_RELEASE, "agent");
            asm volatile("s_waitcnt vmcnt(0)" ::: "memory");
            const unsigned og = xb_add(&bar[XB_TOP], 1u);
            const unsigned tg = og / nx;
            if (og + 1u == (tg + 1u) * nx) xb_add(&bar[XB_TOPGEN], 1u);
            else XB_SPIN(xb_ld(&bar[XB_TOPGEN]) == tg, bar);
            __builtin_amdgcn_fence(__ATOMIC_ACQUIRE, "agent");
            xb_add(&bar[XB_XGEN(b.x)], 1u);
            asm volatile("s_waitcnt vmcnt(0)" ::: "memory");
        } else {
            XB_SPIN(xb_ld(&bar[XB_XGEN(b.x)]) == gen, bar);
            __builtin_amdgcn_fence(__ATOMIC_ACQUIRE, "agent");
            asm volatile("s_waitcnt vmcnt(0)" ::: "memory");
        }
    }
    __syncthreads();
}
#ifndef MK_SCL
#define MK_SCL 0
#endif
namespace pg8 {
constexpr int BM = 256, BK = 64, HALF = 128, HTB = HALF * BK * 2, STAGE_BYTES = 8 * HTB, NXCD = 8, WGM = 8;

__host__ __device__ __forceinline__ int lds_byte(int r, int c) { const int st = (r >> 4) * 2 + (c >> 5), rr = r & 15, cc = c & 31, ob = rr * 64 + cc * 2; return st * 1024 + (ob ^ (((ob >> 9) & 1) << 5)); }
__host__ __device__ __forceinline__ void stage_rc(int b, int& R, int& C) { const int st = b / 1024, sb = b % 1024, swz = sb ^ (((sb >> 9) & 1) << 5); R = (st >> 1) * 16 + swz / 64; C = (st & 1) * 32 + (swz % 64) / 2; }
__host__ __device__ __forceinline__ int perm32(int rho) { const int n = rho >> 4, i = rho & 15; return 8 * (i >> 2) + 4 * n + (i & 3); }

struct Unit { int pm, pn, e, s; };

struct TileOrder {
    int nM, nN, nwg, G, c;
    __device__ __forceinline__ void init(int nM_, int nN_, int G_, int c_) { nM = nM_; nN = nN_; nwg = nM * nN; G = G_; c = c_; }
    __device__ __forceinline__ bool next(int i, int& pm, int& pn) const {
        const unsigned L = (unsigned)i * (unsigned)G + (unsigned)c; if (L >= (unsigned)nwg) return false;
        int wgid = (int)L; { const int q = nwg / NXCD, r = nwg % NXCD, xcd = wgid % NXCD, off = wgid / NXCD; wgid = (xcd < r ? xcd * (q + 1) : r * (q + 1) + (xcd - r) * q) + off; }
        const int nig = WGM * nN, gid = wgid / nig, fm = gid * WGM, gsz = (nM - fm) < WGM ? (nM - fm) : WGM;
        pm = fm + ((wgid % nig) % gsz); pn = (wgid % nig) / gsz; return true;
    }
};
struct DenseSched {
    TileOrder o; const char* Bt; int K; int es = 2; int gap_at = 1 << 30, gap_by = 0, pn0 = 0; bool bt_out = true;
    __device__ __forceinline__ bool next(int i, Unit& u) const { int p; if (!o.next(i, u.pm, p)) return false; u.e = p; u.pn = p + (p >= gap_at ? gap_by : 0) + pn0; return true; }
    __device__ __forceinline__ unsigned a_row(const Unit& u, int r) const { return (unsigned)(u.pm * BM + r); }
    __device__ __forceinline__ unsigned a_koff(const Unit&) const { return 0u; }
    __device__ __forceinline__ const char* b_base(const Unit& u) const { return Bt + (size_t)(bt_out ? u.pn : u.e) * BM * K * es; }
};
struct ChainSched {
    TileOrder o; const char* Bt; int K;
    __device__ __forceinline__ bool next(int i, Unit& u) const { if (!o.next(i >> 1, u.pm, u.pn)) return false; u.e = i & 1; return true; }
    __device__ __forceinline__ unsigned a_row(const Unit& u, int r) const { return (unsigned)(u.pm * BM + r); }
    __device__ __forceinline__ unsigned a_koff(const Unit& u) const { return (unsigned)(u.e * K * 2); }
    __device__ __forceinline__ const char* b_base(const Unit& u) const { return Bt + (size_t)u.pn * BM * (2 * K) * 2 + (size_t)u.e * K * 2; }
};
template <bool GATHER> struct MoeSched {
    TileOrder o; const char* Bt; int K; int rows_per_e; const LAS int* tab; const int* row_e; int es;
    __device__ __forceinline__ bool next(int i, Unit& u) const { if (!o.next(i, u.pm, u.pn)) return false; u.e = __builtin_amdgcn_readfirstlane(tab[128 + u.pm]); return true; }
    __device__ __forceinline__ unsigned a_row(const Unit& u, int r) const {
        if (GATHER) { const int lr = u.pm * BM + r - tab[u.e]; return lr < tab[64 + u.e] ? (unsigned)row_e[(size_t)u.e * T + lr] : 0u; }
        else return (unsigned)(u.pm * BM + r); }
    __device__ __forceinline__ unsigned a_koff(const Unit&) const { return 0u; }
    __device__ __forceinline__ const char* b_base(const Unit& u) const { return Bt + ((size_t)u.e * rows_per_e + (size_t)u.pn * BM) * K * es; }
};

template <class Epi, class Sched>
__device__ __forceinline__ void gemm_phase(LAS unsigned char* lds, const char* gA, int K_, int lda, int ldb, const Sched& S, const Epi& E) {
    int K = K_; asm volatile("" : "+s"(K));
    int tid = threadIdx.x; asm volatile("" : "+v"(tid));     const int wid = __builtin_amdgcn_readfirstlane(tid >> 6), lane = tid & 63, wr = wid >> 2, wc = wid & 3, fr = lane & 15, fq = lane >> 4;
    constexpr int ES = Epi::F8 ? 1 : 2;
    const int nt = K * ES / 128;
    unsigned voffB[2];
#pragma unroll
    for (int i = 0; i < 2; ++i) { int R, C; stage_rc(tid * 16 + i * 8192, R, C); const int Rb = Epi::PERM ? ((R & ~31) + perm32(R & 31)) : R; voffB[i] = (unsigned)(Rb * ldb * ES + C * 2); }
    const unsigned kstep = (unsigned)(BK * 2);
    const size_t hstepB = (size_t)HALF * ldb * ES;
    const unsigned ldab = (unsigned)lda * ES;
    const unsigned ldsw = (unsigned)wid * 1024u;
    const int aoff = lds_byte(wr * 64 + fr, fq * 8), boff = lds_byte(wc * 32 + fr, fq * 8);
#define PG8_SA(b, h) (((b) * 2 + (h)) * HTB)
#define PG8_SB(b, h) ((4 + (b) * 2 + (h)) * HTB)
#define PG8_STAGE_B(bufoff, gbase) do { _Pragma("unroll") for (int _i = 0; _i < 2; ++_i) \
        __builtin_amdgcn_global_load_lds((const unsigned*)((const char*)(gbase) + voffB[_i]), (LAS unsigned*)(lds + (bufoff) + ldsw + _i * 8192), 16, 0, 0); } while (0)
#define PG8_STAGE_A(bufoff, o0, o1, kb) do { \
        const char* gk_ = gA + (kb);      \
        __builtin_amdgcn_global_load_lds((const unsigned*)(gk_ + (o0)), (LAS unsigned*)(lds + (bufoff) + ldsw), 16, 0, 0); \
        __builtin_amdgcn_global_load_lds((const unsigned*)(gk_ + (o1)), (LAS unsigned*)(lds + (bufoff) + ldsw + 8192), 16, 0, 0); } while (0)
#define PG8_LDA(dst, b, h) do { _Pragma("unroll") for (int m = 0; m < 4; ++m) _Pragma("unroll") for (int k = 0; k < 2; ++k) dst[m][k] = *(const LAS bf16x8*)(lds + PG8_SA(b, h) + aoff + m * 2048 + k * 1024); } while (0)
#define PG8_LDB(dst, b, h) do { _Pragma("unroll") for (int n = 0; n < 2; ++n) _Pragma("unroll") for (int k = 0; k < 2; ++k) dst[n][k] = *(const LAS bf16x8*)(lds + PG8_SB(b, h) + boff + n * 2048 + k * 1024); } while (0)
#define PG8_MMA(ai, bj, At, Bt) do { __builtin_amdgcn_s_setprio(1); \
        if constexpr (Epi::F8) { _Pragma("unroll") for (int m = 0; m < 4; ++m) _Pragma("unroll") for (int n = 0; n < 2; ++n) { \
            const i32x8 a8_ = __builtin_shufflevector(__builtin_bit_cast(i32x4, At[m][0]), __builtin_bit_cast(i32x4, At[m][1]), 0, 1, 2, 3, 4, 5, 6, 7); \
            const i32x8 b8_ = __builtin_shufflevector(__builtin_bit_cast(i32x4, Bt[n][0]), __builtin_bit_cast(i32x4, Bt[n][1]), 0, 1, 2, 3, 4, 5, 6, 7); \
            acc[ai][bj][m][n] = __builtin_amdgcn_mfma_scale_f32_16x16x128_f8f6f4(b8_, a8_, acc[ai][bj][m][n], 0, 0, 0, MK_SCL, 0, MK_SCL); } } \
        else { _Pragma("unroll") for (int m = 0; m < 4; ++m) _Pragma("unroll") for (int n = 0; n < 2; ++n) _Pragma("unroll") for (int k = 0; k < 2; ++k) \
            acc[ai][bj][m][n] = __builtin_amdgcn_mfma_f32_16x16x32_bf16(Bt[n][k], At[m][k], acc[ai][bj][m][n], 0, 0, 0); } \
        __builtin_amdgcn_s_setprio(0); } while (0)
#define PG8_WAIT_V(n) asm volatile("s_waitcnt vmcnt(" #n ")" ::: "memory")
#define PG8_WAIT_L(n) asm volatile("s_waitcnt lgkmcnt(" #n ")" ::: "memory")
#define PG8_BAR __builtin_amdgcn_s_barrier()
#define PG8_SCHED __builtin_amdgcn_sched_barrier(0)
#define PG8_AOFFS(dst, u) do { int t_ = threadIdx.x; asm volatile("" : "+v"(t_));     \
        _Pragma("unroll") for (int _h = 0; _h < 2; ++_h) _Pragma("unroll") for (int _i = 0; _i < 2; ++_i) { int R_, C_; stage_rc(t_ * 16 + _i * 8192, R_, C_); \
        dst[_h][_i] = S.a_row(u, _h * HALF + R_) * ldab + (unsigned)C_ * 2u + S.a_koff(u); } } while (0)
    Unit cur, nxt; int ui = 0;
    if (!S.next(0, cur)) return;
    cur.s = 0;
    if constexpr (Epi::PREF) E.prefetch(cur, 0);
#ifdef MK_STAGGER
    if (S.o.nwg > 3 * S.o.G) {
        const unsigned long long t0_ = __builtin_amdgcn_s_memrealtime(); const unsigned long long d_ = (unsigned long long)((blockIdx.x >> 3) & 7) * MK_STAGGER;
        while (__builtin_amdgcn_s_memrealtime() - t0_ < d_) __builtin_amdgcn_s_sleep(4);
    }
#endif
    f32x4 acc[2][2][4][2];
#pragma unroll
    for (int a = 0; a < 2; ++a)
#pragma unroll
        for (int b = 0; b < 2; ++b)
#pragma unroll
            for (int m = 0; m < 4; ++m)
#pragma unroll
                for (int n = 0; n < 2; ++n) acc[a][b][m][n] = (f32x4){0.f, 0.f, 0.f, 0.f};
    bf16x8 At[4][2], B0[2][2], B1[2][2];
    unsigned oc[2][2];
    LAS u32x4* nslot = (LAS u32x4*)(lds + LDSCTL_OFF + 2048) + tid;
    PG8_AOFFS(oc, cur);
    const char* cB = S.b_base(cur);
    PG8_STAGE_B(PG8_SB(0, 0), cB); PG8_STAGE_B(PG8_SB(0, 1), cB + hstepB); PG8_STAGE_A(PG8_SA(0, 0), oc[0][0], oc[0][1], 0u); PG8_STAGE_A(PG8_SA(0, 1), oc[1][0], oc[1][1], 0u);
    if (wr == 1) PG8_BAR;
    PG8_WAIT_V(2); PG8_BAR;
    PG8_STAGE_B(PG8_SB(1, 0), cB + kstep); PG8_STAGE_A(PG8_SA(1, 0), oc[0][0], oc[0][1], kstep); PG8_STAGE_B(PG8_SB(1, 1), cB + hstepB + kstep);
    PG8_WAIT_V(6); PG8_BAR;
    for (;;) {
        const bool has_next = S.next(ui + 1, nxt);
        const char* nB = has_next ? S.b_base(nxt) : cB;
        if (has_next) { unsigned on[2][2]; PG8_AOFFS(on, nxt); *nslot = (u32x4){on[0][0], on[0][1], on[1][0], on[1][1]}; nxt.s = cur.s == 2 ? 0 : cur.s + 1;
            if constexpr (Epi::PREF) E.prefetch(nxt, nxt.s); }
        for (int t = 0; t < nt; t += 2) {
            const bool last = (t == nt - 2);
            const unsigned k1 = (unsigned)(t + 1) * kstep;
            const unsigned k2 = last ? 0u : (unsigned)(t + 2) * kstep, k3 = k2 + kstep;
            const char* b2 = last ? nB : cB + (size_t)(t + 2) * kstep; const char* b3 = b2 + kstep;
            PG8_LDB(B0, 0, 0); PG8_LDB(B1, 0, 1); PG8_SCHED; PG8_LDA(At, 0, 0); PG8_STAGE_A(PG8_SA(1, 1), oc[1][0], oc[1][1], k1);
            PG8_WAIT_V(8); PG8_WAIT_L(0); PG8_BAR; PG8_MMA(0, 0, At, B0); PG8_MMA(0, 1, At, B1); PG8_BAR; PG8_SCHED;
            if (last && has_next) { const u32x4 o_ = *nslot; oc[0][0] = o_.x; oc[0][1] = o_.y; oc[1][0] = o_.z; oc[1][1] = o_.w; }
            PG8_LDA(At, 0, 1); PG8_STAGE_B(PG8_SB(0, 0), b2); PG8_STAGE_B(PG8_SB(0, 1), b2 + hstepB); PG8_STAGE_A(PG8_SA(0, 0), oc[0][0], oc[0][1], k2);
            PG8_WAIT_V(8); PG8_WAIT_L(0); PG8_BAR; PG8_MMA(1, 0, At, B0); PG8_MMA(1, 1, At, B1); PG8_BAR; PG8_SCHED;
            PG8_LDB(B0, 1, 0); PG8_LDB(B1, 1, 1); PG8_SCHED; PG8_LDA(At, 1, 0); PG8_STAGE_A(PG8_SA(0, 1), oc[1][0], oc[1][1], k2);
            PG8_WAIT_V(8); PG8_WAIT_L(0); PG8_BAR; PG8_MMA(0, 0, At, B0); PG8_MMA(0, 1, At, B1); PG8_BAR; PG8_SCHED;
            PG8_LDA(At, 1, 1); PG8_STAGE_B(PG8_SB(1, 0), b3); PG8_STAGE_B(PG8_SB(1, 1), b3 + hstepB); PG8_STAGE_A(PG8_SA(1, 0), oc[0][0], oc[0][1], k3);
            PG8_WAIT_V(8); PG8_WAIT_L(0); PG8_BAR; PG8_MMA(1, 0, At, B0); PG8_MMA(1, 1, At, B1); PG8_BAR; PG8_SCHED;
        }
        if (wr == 0) PG8_BAR;
        bool carry = false;
        if constexpr (Epi::MIDK) { if (cur.e == 0) { E.mid(acc, cur, wr, wc, fr, fq); carry = true; } else E(acc, cur, wr, wc, fr, fq); } else E(acc, cur, wr, wc, fr, fq);
        if (!has_next) break;
        if (!carry)
#pragma unroll
        for (int a = 0; a < 2; ++a)
#pragma unroll
            for (int b = 0; b < 2; ++b)
#pragma unroll
                for (int m = 0; m < 4; ++m)
#pragma unroll
                    for (int n = 0; n < 2; ++n) acc[a][b][m][n] = (f32x4){0.f, 0.f, 0.f, 0.f};
        cur = nxt; cB = nB; ++ui;
        if (wr == 1) PG8_BAR;
    }
    PG8_WAIT_V(0);
    PG8_BAR;
#undef PG8_SA
#undef PG8_SB
#undef PG8_STAGE_A
#undef PG8_STAGE_B
#undef PG8_LDA
#undef PG8_LDB
#undef PG8_MMA
#undef PG8_WAIT_V
#undef PG8_WAIT_L
#undef PG8_BAR
#undef PG8_SCHED
#undef PG8_AOFFS
}

template <bool F8_> struct EpiProj {
    static constexpr bool PREF = false, PERM = true, MIDK = false, F8 = F8_;
    bf16_t* O; float* kmp;
    __device__ __forceinline__ void operator()(const f32x4 (&acc)[2][2][4][2], const Unit& u, int wr, int wc, int fr, int fq) const {
        const int row0 = u.pm * BM + wr * 64 + fr;
        const bool narrow = (u.pn < C_VA / BM) || (u.pn >= C_QB / BM && u.pn < C_GA / BM);
        const int hw = narrow ? 128 : 256; const size_t bjs = narrow ? (size_t)HALF * T : (size_t)HALF;
#pragma unroll
        for (int ai = 0; ai < 2; ++ai)
#pragma unroll
            for (int m = 0; m < 4; ++m) { bf16_t* rowp = O + PROJ_BLK(u.pn * BM) + (size_t)(row0 + ai * HALF + m * 16) * hw + wc * 32 + 8 * fq;
#pragma unroll
                for (int bj = 0; bj < 2; ++bj) { const float sc = F8 ? (1.0f / 32.0f) : 1.0f; const f32x4 v0 = acc[ai][bj][m][0] * sc, v1 = acc[ai][bj][m][1] * sc;
                    u32x4 w; w.x = cvt_pk_bf16(v0[0], v0[1]); w.y = cvt_pk_bf16(v0[2], v0[3]); w.z = cvt_pk_bf16(v1[0], v1[1]); w.w = cvt_pk_bf16(v1[2], v1[3]);
                    __builtin_nontemporal_store(w, (u32x4*)(rowp + bj * bjs)); } }
        if (u.pn >= C_KB / BM && u.pn < C_VB / BM) {
#pragma unroll
            for (int bj = 0; bj < 2; ++bj)
#pragma unroll
                for (int n = 0; n < 2; ++n) { f32x4 s = (f32x4){0.f, 0.f, 0.f, 0.f};
#pragma unroll
                    for (int ai = 0; ai < 2; ++ai)
#pragma unroll
                        for (int m = 0; m < 4; ++m) s += acc[ai][bj][m][n];
#pragma unroll
                    for (int o = 1; o < 16; o <<= 1) { s[0] += __shfl_xor(s[0], o); s[1] += __shfl_xor(s[1], o); s[2] += __shfl_xor(s[2], o); s[3] += __shfl_xor(s[3], o); }
                    if (fr == 0) *(f32x4*)(kmp + ((size_t)wr * 64 + u.pm) * 1024 + (u.pn - C_KB / BM) * BM + bj * HALF + wc * 32 + 8 * fq + 4 * n) = s * (F8 ? (1.0f / 32.0f) : 1.0f); }
        }
    }
};
struct EpiMerge {
    static constexpr bool PREF = false, PERM = true, MIDK = true, F8 = false;
    const bf16_t* proj; bf16_t* Y;
    __device__ __forceinline__ void mid(f32x4 (&acc)[2][2][4][2], const Unit& u, int wr, int wc, int fr, int fq) const {
        const int row0 = u.pm * BM + wr * 64 + fr; const int col0 = u.pn * BM + wc * 32 + 8 * fq;
#pragma unroll
        for (int ai = 0; ai < 2; ++ai) {
            u32x4 ga[4][2], gb[4][2];
#pragma unroll
            for (int m = 0; m < 4; ++m) { const bf16_t* rowp = proj + PROJ_BLK(u.pn * BM) + (size_t)(row0 + ai * HALF + m * 16) * 256 + wc * 32 + 8 * fq;
#pragma unroll
                for (int bj = 0; bj < 2; ++bj) { ga[m][bj] = *(const u32x4*)(rowp + PROJ_BLK(C_GA) + bj * HALF); gb[m][bj] = *(const u32x4*)(rowp + PROJ_BLK(C_GB) + bj * HALF); } }
#pragma unroll
            for (int m = 0; m < 4; ++m) {
#pragma unroll
                for (int bj = 0; bj < 2; ++bj) {
#pragma unroll
                    for (int j = 0; j < 4; ++j) { const float a0 = bflo(ga[m][bj][j]), a1 = bfhi(ga[m][bj][j]), b0 = bflo(gb[m][bj][j]), b1 = bfhi(gb[m][bj][j]);
                        const float r0 = (1.0f + __builtin_amdgcn_exp2f(-1.4426950408889634f * b0)) * __builtin_amdgcn_rcpf(1.0f + __builtin_amdgcn_exp2f(-1.4426950408889634f * a0));
                        const float r1 = (1.0f + __builtin_amdgcn_exp2f(-1.4426950408889634f * b1)) * __builtin_amdgcn_rcpf(1.0f + __builtin_amdgcn_exp2f(-1.4426950408889634f * a1));
                        acc[ai][bj][m][j >> 1][(j & 1) * 2] *= r0; acc[ai][bj][m][j >> 1][(j & 1) * 2 + 1] *= r1; } }
                asm volatile("" : "+v"(acc[ai][0][m][0]), "+v"(acc[ai][0][m][1]), "+v"(acc[ai][1][m][0]), "+v"(acc[ai][1][m][1])); }
            asm volatile("" ::: "memory"); }
    }
    __device__ __forceinline__ void operator()(const f32x4 (&acc)[2][2][4][2], const Unit& u, int wr, int wc, int fr, int fq) const {
        const int row0 = u.pm * BM + wr * 64 + fr; const int col0 = u.pn * BM + wc * 32 + 8 * fq;
#pragma unroll
        for (int ai = 0; ai < 2; ++ai) {
            u32x4 gb[4][2];
#pragma unroll
            for (int m = 0; m < 4; ++m)
#pragma unroll
                for (int bj = 0; bj < 2; ++bj) gb[m][bj] = *(const u32x4*)(proj + PROJ_BLK(C_GB + u.pn * BM) + (size_t)(row0 + ai * HALF + m * 16) * 256 + wc * 32 + 8 * fq + bj * HALF);
#pragma unroll
            for (int m = 0; m < 4; ++m) { const size_t r = (size_t)(row0 + ai * HALF + m * 16);
#pragma unroll
                for (int bj = 0; bj < 2; ++bj) { const u32x4 g = gb[m][bj];
                    const f32x4 v0 = acc[ai][bj][m][0], v1 = acc[ai][bj][m][1];
                    u32x4 w; w.x = cvt_pk_bf16(v0[0] * fsigmoid(bflo(g[0])), v0[1] * fsigmoid(bfhi(g[0]))); w.y = cvt_pk_bf16(v0[2] * fsigmoid(bflo(g[1])), v0[3] * fsigmoid(bfhi(g[1])));
                    w.z = cvt_pk_bf16(v1[0] * fsigmoid(bflo(g[2])), v1[1] * fsigmoid(bfhi(g[2]))); w.w = cvt_pk_bf16(v1[2] * fsigmoid(bflo(g[3])), v1[3] * fsigmoid(bfhi(g[3])));
                    *(u32x4*)(Y + r * D + col0 + bj * HALF) = w; } }
            asm volatile("" ::: "memory"); }
    }
};
struct EpiResF32 {
    static constexpr bool PREF = false, PERM = false, MIDK = false, F8 = false;
    const float* base; bf16_t* out;
    __device__ __forceinline__ void operator()(const f32x4 (&acc)[2][2][4][2], const Unit& u, int wr, int wc, int fr, int fq) const {
        const int row0 = u.pm * BM + wr * 64 + fr, col0 = u.pn * BM + wc * 32 + 4 * fq;
#pragma unroll
        for (int ai = 0; ai < 2; ++ai) {
            f32x4 bs[4][2][2];
#pragma unroll
            for (int m = 0; m < 4; ++m) { const size_t off = (size_t)(row0 + ai * HALF + m * 16) * D + col0;
#pragma unroll
                for (int bj = 0; bj < 2; ++bj)
#pragma unroll
                    for (int n = 0; n < 2; ++n) bs[m][bj][n] = __builtin_nontemporal_load((const f32x4*)(base + off + bj * HALF + n * 16)); }
#pragma unroll
            for (int m = 0; m < 4; ++m) { const size_t off = (size_t)(row0 + ai * HALF + m * 16) * D + col0;
#pragma unroll
                for (int bj = 0; bj < 2; ++bj)
#pragma unroll
                    for (int n = 0; n < 2; ++n) { const f32x4 v = bs[m][bj][n] + acc[ai][bj][m][n]; u32x2 w; w.x = cvt_pk_bf16(v[0], v[1]); w.y = cvt_pk_bf16(v[2], v[3]); *(u32x2*)(out + off + bj * HALF + n * 16) = w; } }
            asm volatile("" ::: "memory"); }
    }
};
struct EpiGlu {
    static constexpr bool PREF = true, PERM = true, MIDK = false, F8 = true;
    unsigned char* H; const float* rstd_e; const LAS int* tab; const float* bg; const float* bu; const float* zero; LAS unsigned char* lds;
    __device__ __forceinline__ void prefetch(const Unit& u, int slot) const {
        int tid = threadIdx.x; asm volatile("" : "+v"(tid)); const int wave = __builtin_amdgcn_readfirstlane(tid >> 6);
        const float* src;
        if (wave < 4) { const int lr = u.pm * BM + tid - tab[u.e]; src = lr < tab[64 + u.e] ? rstd_e + (size_t)u.e * T + lr : zero; }
        else { const int j = tid - 256; src = (j < 128 ? bg : bu) + (size_t)u.e * FF + u.pn * HALF + (j & 127); }
        __builtin_amdgcn_global_load_lds((const unsigned*)src, (LAS unsigned*)(lds + EPF_OFF + slot * 2048 + wave * 256), 4, 0, 0);
    }
    __device__ __forceinline__ void operator()(const f32x4 (&acc)[2][2][4][2], const Unit& u, int wr, int wc, int fr, int fq) const {
        const int row0 = u.pm * BM + wr * 64 + fr; const int colo = u.pn * HALF + wc * 32 + 8 * fq;
        const LAS float* ep = (const LAS float*)(lds + EPF_OFF + u.s * 2048);
        f32x4 g4[2], u4[2];
#pragma unroll
        for (int n = 0; n < 2; ++n) { g4[n] = *(const LAS f32x4*)(ep + 256 + wc * 32 + 8 * fq + 4 * n); u4[n] = *(const LAS f32x4*)(ep + 384 + wc * 32 + 8 * fq + 4 * n); }
        float rsv[2][4];
#pragma unroll
        for (int ai = 0; ai < 2; ++ai)
#pragma unroll
            for (int m = 0; m < 4; ++m) rsv[ai][m] = ep[wr * 64 + fr + ai * HALF + m * 16];
#pragma unroll
        for (int ai = 0; ai < 2; ++ai)
#pragma unroll
            for (int m = 0; m < 4; ++m) { const int r = row0 + ai * HALF + m * 16; const float rs = rsv[ai][m] * (1.0f / 32.0f);
                float o[8];
#pragma unroll
                for (int n = 0; n < 2; ++n)
#pragma unroll
                    for (int j = 0; j < 4; ++j) { float g = acc[ai][0][m][n][j] * rs + g4[n][j], up = acc[ai][1][m][n][j] * rs + u4[n][j];
                        g = fminf(g, 7.0f); up = fminf(fmaxf(up, -7.0f), 7.0f);
                        const float glu = g * fsigmoid(1.702f * g); o[n * 4 + j] = (up + 1.0f) * glu; }
                u32x2 w; w.x = pk4_fp8(o[0], o[1], o[2], o[3]); w.y = pk4_fp8(o[4], o[5], o[6], o[7]);
                *(u32x2*)(H + (size_t)r * FF + colo) = w; asm volatile("" ::: "memory"); }
    }
};
template <int ACT, bool HASBIAS, bool F8_ = false> struct EpiBf16 {
    static constexpr bool PREF = false, PERM = true, MIDK = false, F8 = F8_;
    bf16_t* O; int ldc; const float* bias; int bias_stride; float scale;
    __device__ __forceinline__ void operator()(const f32x4 (&acc)[2][2][4][2], const Unit& u, int wr, int wc, int fr, int fq) const {
        const int row0 = u.pm * BM + wr * 64 + fr; const int col0 = u.pn * BM + wc * 32 + 8 * fq;
        f32x4 bv[2][2];
#pragma unroll
        for (int bj = 0; bj < 2; ++bj)
#pragma unroll
            for (int n = 0; n < 2; ++n) bv[bj][n] = HASBIAS ? *(const f32x4*)(bias + (size_t)u.e * bias_stride + col0 + bj * HALF + 4 * n) : (f32x4){0.f, 0.f, 0.f, 0.f};
#pragma unroll
        for (int ai = 0; ai < 2; ++ai)
#pragma unroll
            for (int m = 0; m < 4; ++m) { bf16_t* rowp = O + (size_t)(row0 + ai * HALF + m * 16) * ldc + col0;
#pragma unroll
                for (int bj = 0; bj < 2; ++bj) { f32x4 v0 = acc[ai][bj][m][0] * scale + bv[bj][0], v1 = acc[ai][bj][m][1] * scale + bv[bj][1];
                    if (ACT == 1) {
#pragma unroll
                        for (int j = 0; j < 4; ++j) { v0[j] = fsigmoid(v0[j]); v1[j] = fsigmoid(v1[j]); } }
                    u32x4 w; w.x = cvt_pk_bf16(v0[0], v0[1]); w.y = cvt_pk_bf16(v0[2], v0[3]); w.z = cvt_pk_bf16(v1[0], v1[1]); w.w = cvt_pk_bf16(v1[2], v1[3]);
                    *(u32x4*)(rowp + bj * HALF) = w; }
                asm volatile("" ::: "memory"); }
    }
};
struct EpiDownF8 {
    static constexpr bool PREF = false, PERM = true, MIDK = false, F8 = true;
    unsigned char* O; const float* bias;
    __device__ __forceinline__ void operator()(const f32x4 (&acc)[2][2][4][2], const Unit& u, int wr, int wc, int fr, int fq) const {
        const int row0 = u.pm * BM + wr * 64 + fr; const int col0 = u.pn * BM + wc * 32 + 8 * fq;
        f32x4 bv[2][2];
#pragma unroll
        for (int bj = 0; bj < 2; ++bj)
#pragma unroll
            for (int n = 0; n < 2; ++n) bv[bj][n] = *(const f32x4*)(bias + (size_t)u.e * D + col0 + bj * HALF + 4 * n);
#pragma unroll
        for (int ai = 0; ai < 2; ++ai)
#pragma unroll
            for (int m = 0; m < 4; ++m) { unsigned char* rowp = O + (size_t)(row0 + ai * HALF + m * 16) * D + col0;
#pragma unroll
                for (int bj = 0; bj < 2; ++bj) { const f32x4 v0 = acc[ai][bj][m][0] * (1.0f / 32.0f) + bv[bj][0], v1 = acc[ai][bj][m][1] * (1.0f / 32.0f) + bv[bj][1];
                    u32x2 w; w.x = pk4_fp8(v0[0], v0[1], v0[2], v0[3]); w.y = pk4_fp8(v1[0], v1[1], v1[2], v1[3]);
                    *(u32x2*)(rowp + bj * HALF) = w; }
                asm volatile("" ::: "memory"); }
    }
};
}
__device__ __forceinline__ void transpose_item(const float* __restrict__ W, int ldw, int k0, int n_src0, bf16_t* __restrict__ WT, int ldo, int n_dst0, int k_off, LAS float* scr, int lane) {
    { float t_[32]; const float* wp_ = W + (size_t)(k0 + (lane >> 5)) * ldw + n_src0 + (lane & 31);
#pragma unroll
    for (int i = 0; i < 32; ++i) t_[i] = __builtin_nontemporal_load(wp_ + (size_t)(2 * i) * ldw);
#pragma unroll
    for (int i = 0; i < 32; ++i) scr[(2 * i + (lane >> 5)) * 33 + (lane & 31)] = t_[i]; }
    LDS_WAIT(); asm volatile("" ::: "memory");
    const int c = lane & 7;
#pragma unroll
    for (int j = 0; j < 4; ++j) { const int n = (lane >> 3) + 8 * j; const LAS float* s = scr + (8 * c) * 33 + n;
        u32x4 o; o.x = cvt_pk_bf16(s[0 * 33], s[1 * 33]); o.y = cvt_pk_bf16(s[2 * 33], s[3 * 33]); o.z = cvt_pk_bf16(s[4 * 33], s[5 * 33]); o.w = cvt_pk_bf16(s[6 * 33], s[7 * 33]);
        *(u32x4*)(WT + (size_t)(n_dst0 + n) * ldo + k_off + k0 + 8 * c) = o; }
    LDS_WAIT(); asm volatile("" ::: "memory");
}
__device__ __forceinline__ void transpose_item_f8(const float* __restrict__ W, int ldw, int k0, int n_src0, unsigned char* __restrict__ WT, int ldo, int n_dst0, float sc, LAS float* scr, int lane) {
    { float t_[32]; const float* wp_ = W + (size_t)(k0 + (lane >> 5)) * ldw + n_src0 + (lane & 31);
#pragma unroll
    for (int i = 0; i < 32; ++i) t_[i] = __builtin_nontemporal_load(wp_ + (size_t)(2 * i) * ldw);
#pragma unroll
    for (int i = 0; i < 32; ++i) scr[(2 * i + (lane >> 5)) * 33 + (lane & 31)] = t_[i]; }
    LDS_WAIT(); asm volatile("" ::: "memory");
    const int c = lane & 7;
#pragma unroll
    for (int j = 0; j < 4; ++j) { const int n = (lane >> 3) + 8 * j; const LAS float* s = scr + (8 * c) * 33 + n;
        u32x2 o; o.x = pk4_fp8(s[0 * 33] * sc, s[1 * 33] * sc, s[2 * 33] * sc, s[3 * 33] * sc); o.y = pk4_fp8(s[4 * 33] * sc, s[5 * 33] * sc, s[6 * 33] * sc, s[7 * 33] * sc);
        *(u32x2*)(WT + (size_t)(n_dst0 + n) * ldo + k0 + 8 * c) = o; }
    LDS_WAIT(); asm volatile("" ::: "memory");
}
__device__ __forceinline__ void transpose_mat_item(const float* W, int ldw, int N, int n_src_base, bf16_t* WT, int ldo, int n_dst_base, int k_off, LAS float* scr, int item, int lane) {
    const int nblk = N / 32, kb = item / nblk, nb = item % nblk;
    transpose_item(W, ldw, 64 * kb, n_src_base + 32 * nb, WT, ldo, n_dst_base + 32 * nb, k_off, scr, lane);
}

struct P {
    const float* in[25]; float* out; unsigned char* ws;
};

__device__ __forceinline__ void p0_prologue(const P& a, LAS unsigned char* lds, int vcu, int G, int wave, int lane) {
    LAS float* scr = (LAS float*)(lds + wave * 16384);
    const int gw = vcu * NWAVES + wave, NGW = G * NWAVES;
    unsigned char* ws = a.ws;
    bf16_t* WinT = (bf16_t*)(ws + WS_WIN); bf16_t* WupT = (bf16_t*)(ws + WS_WUP); bf16_t* WoT = (bf16_t*)(ws + WS_WO); bf16_t* WpgT = (bf16_t*)(ws + WS_WPG); bf16_t* WppT = (bf16_t*)(ws + WS_WPP);
    constexpr int I_A = 16 * 96, I_B8 = 16 * 160, I_B = 0, I_S = 16 * 32, I_P = 4 * 32;
    constexpr int NITEMS = I_A + I_B8 + I_B + 4 * I_S + I_P;
#ifndef P0_PARTS
#define P0_PARTS 63
#endif
    if (P0_PARTS & 1)
    for (int it = gw; it < NITEMS; it += NGW) {
        int r = it;
        if (r < I_A) { transpose_mat_item(a.in[4], D_IN, 3072, 0, WinT, D, 0, 0, scr, r, lane); continue; } r -= I_A;
        if (r < I_B8) { const int kb = r / 160, nb = r % 160; transpose_item_f8(a.in[4], D_IN, 64 * kb, 3088 + 32 * nb, ws + WS_WIN8, D, 32 * nb, 32.0f, scr, lane); continue; } r -= I_B8;
        if (r < I_S) { transpose_mat_item(a.in[8], D, D, 0, WupT, 2048, 0, 0, scr, r, lane); continue; } r -= I_S;
        if (r < I_S) { transpose_mat_item(a.in[9], D, D, 0, WupT, 2048, 0, 1024, scr, r, lane); continue; } r -= I_S;
        if (r < I_S) { transpose_mat_item(a.in[10], D, D, 0, WoT, D, 0, 0, scr, r, lane); continue; } r -= I_S;
        if (r < I_S) { const int kb = r / 32, nb = r % 32; transpose_item_f8(a.in[21], D, 64 * kb, 32 * nb, (unsigned char*)WpgT, D, 32 * nb, 32.0f, scr, lane); continue; } r -= I_S;
        transpose_mat_item(a.in[22], D, D, 0, WppT, 256, 0, 0, scr, r, lane);
    }
    if (P0_PARTS & 2) {
        const float* x = a.in[0]; const float* g = a.in[3]; bf16_t* H = (bf16_t*)(ws + WS_H);
        f32x4 gv[4];
#pragma unroll
        for (int j = 0; j < 4; ++j) gv[j] = *((const f32x4*)g + lane + 64 * j);
        for (int m = gw; m < T; m += NGW) {
            const f32x4* xr = (const f32x4*)(x + (size_t)m * D) + lane; f32x4 v[4]; float s = 0.f;
#pragma unroll
            for (int j = 0; j < 4; ++j) { v[j] = __builtin_nontemporal_load(xr + 64 * j); s += (v[j].x * v[j].x + v[j].y * v[j].y) + (v[j].z * v[j].z + v[j].w * v[j].w); }
            const float rstd = 1.0f / sqrtf(wave_sum(s) * (1.0f / D) + EPS);
            u32x2* o8 = (u32x2*)(H + (size_t)m * D) + lane; unsigned* q8 = (unsigned*)(ws + WS_H8 + (size_t)m * D) + lane;
#pragma unroll
            for (int j = 0; j < 4; ++j) { const f32x4 y = v[j] * rstd * gv[j]; u32x2 w; w.x = cvt_pk_bf16(y.x, y.y); w.y = cvt_pk_bf16(y.z, y.w); o8[64 * j] = w; q8[64 * j] = pk4_fp8(y.x, y.y, y.z, y.w); }
        }
    }
    if (P0_PARTS & 4) {
        const f32x4* p4 = (const f32x4*)a.in[1]; u32x2* pb = (u32x2*)(ws + WS_PB);
        const size_t n4 = (size_t)T * 256 / 4;
        for (size_t i = (size_t)gw * 64 + lane; i < n4; i += (size_t)NGW * 64) { const f32x4 v = __builtin_nontemporal_load(p4 + i); u32x2 w; w.x = cvt_pk_bf16(v.x, v.y); w.y = cvt_pk_bf16(v.z, v.w); pb[i] = w; }
    }
    if (P0_PARTS & 8) {
        const int gt = (vcu * NWAVES + wave) * 64 + lane;
        if ((P0_PARTS & 16) && gt < 16 * 1024) { const int n = gt >> 10, k = gt & 1023; ((bf16_t*)(ws + WS_WALT))[n * 1024 + k] = (bf16_t)(cvt_pk_bf16(a.in[4][(size_t)k * D_IN + SRC_ALOW + n], 0.f) & 0xffffu); }
        if ((P0_PARTS & 32) && gt < 4096) { const int s = gt >> 6, l = gt & 63, e = l & 31, hh = l >> 5; const float* wr = a.in[12];
            float v[8], lo[8];
#pragma unroll
            for (int j = 0; j < 8; ++j) { v[j] = wr[(size_t)(16 * s + 8 * hh + j) * NE + e]; }
            u32x4 whi; whi.x = cvt_pk_bf16(v[0], v[1]); whi.y = cvt_pk_bf16(v[2], v[3]); whi.z = cvt_pk_bf16(v[4], v[5]); whi.w = cvt_pk_bf16(v[6], v[7]);
#pragma unroll
            for (int j = 0; j < 4; ++j) { lo[2 * j] = v[2 * j] - bflo(whi[j]); lo[2 * j + 1] = v[2 * j + 1] - bfhi(whi[j]); }
            u32x4 wlo; wlo.x = cvt_pk_bf16(lo[0], lo[1]); wlo.y = cvt_pk_bf16(lo[2], lo[3]); wlo.z = cvt_pk_bf16(lo[4], lo[5]); wlo.w = cvt_pk_bf16(lo[6], lo[7]);
            u32x4* f = (u32x4*)(ws + WS_WRF); f[gt] = whi; f[4096 + gt] = wlo; }
    }
}

struct CvtItem { const float* src; unsigned char* dst; int ldo; };
__device__ __forceinline__ CvtItem cvt_item(const P& a, int it, int lane) {
    constexpr int IPM = 16 * 32;
    const int e = it / (3 * IPM), r0 = it % (3 * IPM), which = r0 / IPM, r = r0 % IPM, kb = r / 32, nb = r % 32, n0 = 32 * nb;
    CvtItem c;
    if (which < 2) { c.src = a.in[which == 0 ? 14 : 16] + (size_t)e * D * FF + (size_t)(64 * kb + (lane >> 5)) * FF + n0 + (lane & 31);
        c.dst = (unsigned char*)a.out + ((size_t)e * 2048 + (n0 >> 7) * 256 + (n0 & 127) + which * 128) * D + 64 * kb; c.ldo = D; }
    else { c.src = a.in[18] + (size_t)e * FF * D + (size_t)(64 * kb + (lane >> 5)) * D + n0 + (lane & 31);
        c.dst = a.ws + WS_W2T + ((size_t)e * D + n0) * FF + 64 * kb; c.ldo = FF; }
    return c;
}
__device__ __forceinline__ void expert_convert(const P& a, LAS unsigned char* lds, int vcu, int G, int wave, int lane) {
    LAS float* scr = (LAS float*)(lds + wave * 16384);
    const int gw = vcu * NWAVES + wave, NGW = G * NWAVES;
    constexpr int NIT = NE * 3 * 16 * 32;
    if (gw >= NIT) return;
    float tA[32], tB[32];
    CvtItem cA = cvt_item(a, gw, lane), cB = cvt_item(a, gw + NGW < NIT ? gw + NGW : gw, lane);
#pragma unroll
    for (int i = 0; i < 32; ++i) tA[i] = __builtin_nontemporal_load(cA.src + (size_t)(2 * i) * 1024);
#pragma unroll
    for (int i = 0; i < 32; ++i) tB[i] = __builtin_nontemporal_load(cB.src + (size_t)(2 * i) * 1024);
#define CVT_OUT(c_) do { LDS_WAIT(); asm volatile("" ::: "memory"); const int c = lane & 7; \
        _Pragma("unroll") for (int j = 0; j < 4; ++j) { const int n = (lane >> 3) + 8 * j; const LAS float* s = scr + (8 * c) * 33 + n; \
            u32x2 o; o.x = pk4_fp8(s[0 * 33] * 32.0f, s[1 * 33] * 32.0f, s[2 * 33] * 32.0f, s[3 * 33] * 32.0f); o.y = pk4_fp8(s[4 * 33] * 32.0f, s[5 * 33] * 32.0f, s[6 * 33] * 32.0f, s[7 * 33] * 32.0f); \
            __builtin_nontemporal_store(o, (u32x2*)((c_).dst + (size_t)n * (c_).ldo + 8 * c)); } \
        LDS_WAIT(); asm volatile("" ::: "memory"); } while (0)
    for (int it = gw; it < NIT; it += 2 * NGW) {
#pragma unroll
        for (int i = 0; i < 32; ++i) scr[(2 * i + (lane >> 5)) * 33 + (lane & 31)] = tA[i];
        const CvtItem dA = cA; const int n2 = it + 2 * NGW;
        if (n2 < NIT) { cA = cvt_item(a, n2, lane);
#pragma unroll
            for (int i = 0; i < 32; ++i) tA[i] = __builtin_nontemporal_load(cA.src + (size_t)(2 * i) * 1024); }
        CVT_OUT(dA);
        if (it + NGW >= NIT) break;
#pragma unroll
        for (int i = 0; i < 32; ++i) scr[(2 * i + (lane >> 5)) * 33 + (lane & 31)] = tB[i];
        const CvtItem dB = cB; const int n3 = it + 3 * NGW;
        if (n3 < NIT) { cB = cvt_item(a, n3, lane);
#pragma unroll
            for (int i = 0; i < 32; ++i) tB[i] = __builtin_nontemporal_load(cB.src + (size_t)(2 * i) * 1024); }
        CVT_OUT(dB);
    }
#undef CVT_OUT
}

__device__ __forceinline__ float fexp_(float x) { return __builtin_amdgcn_exp2f(x * 1.4426950408889634f); }
__device__ __forceinline__ float logsigmoidf_(float x) { const float e = fexp_(-fabsf(x)); return fminf(x, 0.0f) - 0.6931471805599453f * __builtin_amdgcn_logf(1.0f + e); }
__device__ __forceinline__ void gla_prep_unit(const P& a, LAS unsigned char* lds, int unit) {
    int tid = threadIdx.x; asm volatile("" : "+v"(tid));     const int wave = __builtin_amdgcn_readfirstlane(tid >> 6), lane = tid & 63;
    const int b = unit >> 5, chunk = unit & 31, tok0 = b * SEQ + chunk * 64;
    const bf16_t* H = (const bf16_t*)(a.ws + WS_H); const bf16_t* WalT = (const bf16_t*)(a.ws + WS_WALT); const bf16_t* proj = (const bf16_t*)(a.ws + WS_PROJ);
    LAS float* part = (LAS float*)lds;
    LAS float* alow = (LAS float*)(lds + 8192);
    LAS float* seg = (LAS float*)(lds + 12288);
    constexpr int GP_KDT = 16384, GP_VT = 34816;
    {
        const int rg = wave & 3, kh = wave >> 2, r = lane & 15, q = lane >> 4;
        f32x4 acc = (f32x4){0.f, 0.f, 0.f, 0.f};
        const bf16_t* ap = H + (size_t)(tok0 + 16 * rg + r) * D + 512 * kh + 8 * q; const bf16_t* bp = WalT + (size_t)r * D + 512 * kh + 8 * q;
#pragma unroll 8
        for (int s = 0; s < 16; ++s) { const bf16x8 av = *(const bf16x8*)(ap + 32 * s), bv = *(const bf16x8*)(bp + 32 * s); acc = __builtin_amdgcn_mfma_f32_16x16x32_bf16(bv, av, acc, 0, 0, 0); }
        *(LAS f32x4*)(part + (kh * 64 + 16 * rg + r) * 16 + 4 * q) = acc;
    }
    __syncthreads();
    if (tid < 256) { *(LAS f32x4*)(alow + tid * 4) = *(LAS f32x4*)(part + tid * 4) + *(LAS f32x4*)(part + 1024 + tid * 4); }
    __syncthreads();
    const int dp = tid & 63, tq = wave;
    const float* w_a2 = a.in[5]; const float* b_a2 = a.in[6];
    const int ep = tid & 127, sq4 = tid >> 7;
    f32x2 w2[16], w2n[16]; f32x2 b2, b2n; unsigned qv[8], kv[8], qvn[8], kvn[8], sv[16], svn[16];
#define GP_LOADS(h_, W2, B2, QV, KV, SV) do { const int dc_ = (h_) * 128 + 2 * dp; \
        _Pragma("unroll") for (int r = 0; r < 16; ++r) W2[r] = *(const f32x2*)(w_a2 + r * 512 + dc_); \
        B2 = *(const f32x2*)(b_a2 + dc_); \
        _Pragma("unroll") for (int i = 0; i < 8; ++i) { const bf16_t* rp = proj + PROJ_BLK((h_) * 128) + (size_t)(tok0 + 8 * tq + i) * 128 + 2 * dp; QV[i] = __builtin_nontemporal_load((const unsigned*)(rp + PROJ_BLK(C_QA))); KV[i] = __builtin_nontemporal_load((const unsigned*)(rp + PROJ_BLK(C_KA))); } \
        const bf16_t* v_ = proj + PROJ_BLK(C_VA + (h_) * 256) + (size_t)(tok0 + 16 * sq4) * 256 + 2 * ep; \
        _Pragma("unroll") for (int i = 0; i < 16; ++i) SV[i] = __builtin_nontemporal_load((const unsigned*)(v_ + (size_t)i * 256)); } while (0)
    GP_LOADS(0, w2, b2, qv, kv, sv);
    for (int h = 0; h < 4; ++h) {
        if (h + 1 < 4) GP_LOADS(h + 1, w2n, b2n, qvn, kvn, svn);
        float G0[8], G1[8]; float r0 = 0.f, r1 = 0.f;
#pragma unroll
        for (int i = 0; i < 8; ++i) { const LAS f32x4* al4 = (const LAS f32x4*)(alow + (8 * tq + i) * 16); float x0 = b2.x, x1 = b2.y;
#pragma unroll
            for (int r4 = 0; r4 < 4; ++r4) { const f32x4 al = al4[r4];
#pragma unroll
                for (int j = 0; j < 4; ++j) { x0 += al[j] * w2[4 * r4 + j].x; x1 += al[j] * w2[4 * r4 + j].y; } }
            r0 += logsigmoidf_(x0) * (1.0f / 16.0f); r1 += logsigmoidf_(x1) * (1.0f / 16.0f); G0[i] = r0; G1[i] = r1; }
        *(LAS f32x2*)(seg + tq * 128 + 2 * dp) = (f32x2){r0, r1};
        __syncthreads();
        float off0 = 0.f, off1 = 0.f, tot0 = 0.f, tot1 = 0.f;
#pragma unroll
        for (int q = 0; q < 8; ++q) { const f32x2 s = *(LAS f32x2*)(seg + q * 128 + 2 * dp); tot0 += s.x; tot1 += s.y; if (q < tq) { off0 += s.x; off1 += s.y; } }
        const size_t tile = (size_t)((b * 4 + h) * 32 + chunk);
        bf16_t* Qg = (bf16_t*)(a.ws + WS_QG) + tile * 8192; bf16_t* Kg = (bf16_t*)(a.ws + WS_KG) + tile * 8192;
        float kd0[8], kd1[8];
#pragma unroll
        for (int i = 0; i < 8; ++i) { const float g0 = G0[i] + off0, g1 = G1[i] + off1; const float q0 = bflo(qv[i]), q1 = bfhi(qv[i]), k0 = bflo(kv[i]), k1 = bfhi(kv[i]);
            const float e0 = fexp_(g0), e1 = fexp_(g1);
            *(unsigned*)(Qg + (8 * tq + i) * 128 + 2 * dp) = cvt_pk_bf16(q0 * e0 * 0.08838834764831845f, q1 * e1 * 0.08838834764831845f);
            *(unsigned*)(Kg + (8 * tq + i) * 128 + 2 * dp) = cvt_pk_bf16(k0 * __builtin_amdgcn_rcpf(e0), k1 * __builtin_amdgcn_rcpf(e1));
            kd0[i] = k0 * fexp_(tot0 - g0); kd1[i] = k1 * fexp_(tot1 - g1); }
        u32x4 w0, w1; w0.x = cvt_pk_bf16(kd0[0], kd0[1]); w0.y = cvt_pk_bf16(kd0[2], kd0[3]); w0.z = cvt_pk_bf16(kd0[4], kd0[5]); w0.w = cvt_pk_bf16(kd0[6], kd0[7]);
        w1.x = cvt_pk_bf16(kd1[0], kd1[1]); w1.y = cvt_pk_bf16(kd1[2], kd1[3]); w1.z = cvt_pk_bf16(kd1[4], kd1[5]); w1.w = cvt_pk_bf16(kd1[6], kd1[7]);
        *(LAS u32x4*)(lds + GP_KDT + (2 * dp) * 144 + 16 * tq) = w0; *(LAS u32x4*)(lds + GP_KDT + (2 * dp + 1) * 144 + 16 * tq) = w1;
        if (tq == 0) *(f32x2*)((float*)(a.ws + WS_DEC) + tile * 128 + 2 * dp) = (f32x2){fexp_(tot0), fexp_(tot1)};
        {
            u32x4 lo0, lo1, hi0, hi1;
#pragma unroll
            for (int j = 0; j < 4; ++j) { lo0[j] = (sv[2 * j] & 0xffffu) | (sv[2 * j + 1] << 16); lo1[j] = (sv[8 + 2 * j] & 0xffffu) | (sv[8 + 2 * j + 1] << 16);
                hi0[j] = (sv[2 * j] >> 16) | (sv[2 * j + 1] & 0xffff0000u); hi1[j] = (sv[8 + 2 * j] >> 16) | (sv[8 + 2 * j + 1] & 0xffff0000u); }
            LAS unsigned char* v0 = lds + GP_VT + (2 * ep) * 144 + sq4 * 32;
            *(LAS u32x4*)(v0) = lo0; *(LAS u32x4*)(v0 + 16) = lo1; *(LAS u32x4*)(v0 + 144) = hi0; *(LAS u32x4*)(v0 + 144 + 16) = hi1;
        }
        __syncthreads();
        {
            const int c32 = lane & 31, hi = lane >> 5;
            bf16x8 vt[4];
#pragma unroll
            for (int ks = 0; ks < 4; ++ks) vt[ks] = *(const LAS bf16x8*)(lds + GP_VT + (32 * wave + c32) * 144 + (16 * ks + 8 * hi) * 2);
            unsigned* sl = (unsigned*)a.out + tile * 8192;
#pragma unroll
            for (int tl = 0; tl < 4; ++tl) { f32x16 acc;
#pragma unroll
                for (int r = 0; r < 16; ++r) acc[r] = 0.f;
#pragma unroll
                for (int ks = 0; ks < 4; ++ks) { const bf16x8 av = *(const LAS bf16x8*)(lds + GP_KDT + (32 * tl + c32) * 144 + (16 * ks + 8 * hi) * 2); acc = __builtin_amdgcn_mfma_f32_32x32x16_bf16(av, vt[ks], acc, 0, 0, 0); }
#pragma unroll
                for (int g = 0; g < 4; ++g) sl[((tl * 4 + g) * 2 + hi) * 256 + 32 * wave + c32] = pk4_fp8(acc[4 * g], acc[4 * g + 1], acc[4 * g + 2], acc[4 * g + 3]); }
        }
        __syncthreads();
#pragma unroll
        for (int r = 0; r < 16; ++r) { w2[r] = w2n[r]; sv[r] = svn[r]; }
#pragma unroll
        for (int i = 0; i < 8; ++i) { qv[i] = qvn[i]; kv[i] = kvn[i]; }
        b2 = b2n;
    }
#undef GP_LOADS
}

__device__ __forceinline__ void gla_combine_unit(const P& a, int unit) {
    const int tid = threadIdx.x, bh = unit >> 4, i8 = (unit & 15) * 512 + tid;
    const int d0 = 32 * (i8 >> 11) + 8 * ((i8 >> 9) & 3) + 4 * ((i8 >> 8) & 1);
    const unsigned* sl8 = (const unsigned*)a.out + (size_t)bh * 32 * 8192 + i8; u32x2* sl = (u32x2*)(a.ws + WS_SLOC) + (size_t)bh * 32 * 8192 + i8;
    const f32x4* dc = (const f32x4*)((const float*)(a.ws + WS_DEC) + (size_t)bh * 32 * 128 + d0);
    f32x4 s = (f32x4){0.f, 0.f, 0.f, 0.f};
    for (int cb = 0; cb < 32; cb += 8) {
        unsigned loc[8]; f32x4 dv[8];
#pragma unroll
        for (int i = 0; i < 8; ++i) { loc[i] = __builtin_nontemporal_load(sl8 + (size_t)(cb + i) * 8192); dv[i] = dc[(cb + i) * 32]; }
#pragma unroll
        for (int i = 0; i < 8; ++i) { if (cb + i < 31) {
            s.x = dv[i].x * s.x + __builtin_amdgcn_cvt_f32_fp8((int)loc[i], 0); s.y = dv[i].y * s.y + __builtin_amdgcn_cvt_f32_fp8((int)loc[i], 1);
            s.z = dv[i].z * s.z + __builtin_amdgcn_cvt_f32_fp8((int)loc[i], 2); s.w = dv[i].w * s.w + __builtin_amdgcn_cvt_f32_fp8((int)loc[i], 3);
            u32x2 w; w.x = cvt_pk_bf16(s.x, s.y); w.y = cvt_pk_bf16(s.z, s.w); sl[(size_t)(cb + i) * 8192] = w; } }
    }
}

constexpr int GL_QG = 0, GL_KG = 17408, GL_VT = 53248, GL_AM = 90112, GL_OST = 0;
constexpr int GL_QS = 272, GL_TS = 144, GL_OS = 528;
__device__ __forceinline__ int crow(int r, int hi) { return (r & 3) + 8 * (r >> 2) + 4 * hi; }
__device__ __forceinline__ void gla_out_unit(const P& a, LAS unsigned char* lds, int unit) {
    int tid = threadIdx.x; asm volatile("" : "+v"(tid)); const int w = __builtin_amdgcn_readfirstlane(tid >> 6), lane = tid & 63, c32 = lane & 31, hi = lane >> 5;
    const int bh = unit >> 5, chunk = unit & 31, b = bh >> 2, h = bh & 3;
    const bf16_t* proj = (const bf16_t*)(a.ws + WS_PROJ); bf16_t* oab = (bf16_t*)(a.ws + WS_OAB); const float* ggo = a.in[7];
    const size_t tile = (size_t)bh * 32 + chunk;
    {
        const u32x4* q_ = (const u32x4*)((const bf16_t*)(a.ws + WS_QG) + tile * 8192); const u32x4* k_ = (const u32x4*)((const bf16_t*)(a.ws + WS_KG) + tile * 8192);
        u32x4 sq[2], sk[2]; unsigned sv[16];
        sq[0] = __builtin_nontemporal_load(q_ + tid); sq[1] = __builtin_nontemporal_load(q_ + tid + 512); sk[0] = __builtin_nontemporal_load(k_ + tid); sk[1] = __builtin_nontemporal_load(k_ + tid + 512);
        const int ep = tid & 127, sq4 = tid >> 7;
        const bf16_t* v_ = proj + PROJ_BLK(C_VA + h * 256) + (size_t)(b * SEQ + chunk * 64 + 16 * sq4) * 256 + 2 * ep;
#pragma unroll
        for (int i = 0; i < 16; ++i) sv[i] = __builtin_nontemporal_load((const unsigned*)(v_ + (size_t)i * 256));
#pragma unroll
        for (int i = 0; i < 2; ++i) { const int p = tid + 512 * i;
            *(LAS u32x4*)(lds + GL_QG + (p >> 4) * GL_QS + (p & 15) * 16) = sq[i]; *(LAS u32x4*)(lds + GL_KG + (p >> 4) * GL_QS + (p & 15) * 16) = sk[i]; }
        u32x4 lo0, lo1, hi0, hi1;
#pragma unroll
        for (int j = 0; j < 4; ++j) { lo0[j] = (sv[2 * j] & 0xffffu) | (sv[2 * j + 1] << 16); lo1[j] = (sv[8 + 2 * j] & 0xffffu) | (sv[8 + 2 * j + 1] << 16);
            hi0[j] = (sv[2 * j] >> 16) | (sv[2 * j + 1] & 0xffff0000u); hi1[j] = (sv[8 + 2 * j] >> 16) | (sv[8 + 2 * j + 1] & 0xffff0000u); }
        LAS unsigned char* v0 = lds + GL_VT + (2 * ep) * GL_TS + sq4 * 32;
        *(LAS u32x4*)(v0) = lo0; *(LAS u32x4*)(v0 + 16) = lo1; *(LAS u32x4*)(v0 + GL_TS) = hi0; *(LAS u32x4*)(v0 + GL_TS + 16) = hi1;
    }
    u32x2 sf[4][2][2];
    if (chunk > 0) { const u32x2* sl = (const u32x2*)(a.ws + WS_SLOC) + (tile - 1) * 8192;
#pragma unroll
        for (int tl = 0; tl < 4; ++tl)
#pragma unroll
            for (int s = 0; s < 2; ++s)
#pragma unroll
                for (int q = 0; q < 2; ++q) sf[tl][s][q] = __builtin_nontemporal_load(sl + ((tl * 4 + 2 * s + q) * 2 + hi) * 256 + 32 * w + c32); }
    __syncthreads();
    if (w < 3) {
        const int ti = (w + 1) >> 1, si = w >> 1;
        f32x16 A;
#pragma unroll
        for (int r = 0; r < 16; ++r) A[r] = 0.f;
#pragma unroll
        for (int s = 0; s < 8; ++s) { const bf16x8 av = *(const LAS bf16x8*)(lds + GL_QG + (32 * ti + c32) * GL_QS + (16 * s + 8 * hi) * 2), bv = *(const LAS bf16x8*)(lds + GL_KG + (32 * si + c32) * GL_QS + (16 * s + 8 * hi) * 2);
            A = __builtin_amdgcn_mfma_f32_32x32x16_bf16(av, bv, A, 0, 0, 0); }
        const int sidx = 32 * si + c32;
#pragma unroll
        for (int r = 0; r < 16; ++r) { const int t = 32 * ti + crow(r, hi); const float v = (sidx <= t) ? A[r] : 0.f;
            *(LAS bf16_t*)(lds + GL_AM + t * GL_TS + sidx * 2) = (bf16_t)(cvt_pk_bf16(v, 0.f) & 0xffffu); }
    }
    __syncthreads();
    f32x16 o[2];
    {
        bf16x8 vt[4];
#pragma unroll
        for (int ks = 0; ks < 4; ++ks) vt[ks] = *(const LAS bf16x8*)(lds + GL_VT + (32 * w + c32) * GL_TS + (16 * ks + 8 * hi) * 2);
#pragma unroll
        for (int ti = 0; ti < 2; ++ti) {
#pragma unroll
            for (int r = 0; r < 16; ++r) o[ti][r] = 0.f;
            if (chunk > 0) {
#pragma unroll
                for (int tl = 0; tl < 4; ++tl)
#pragma unroll
                    for (int s = 0; s < 2; ++s) { const LAS unsigned char* qp = lds + GL_QG + (32 * ti + c32) * GL_QS + (32 * tl + 16 * s + 4 * hi) * 2;
                        const s16x4 lo = *(const LAS s16x4*)qp, hh = *(const LAS s16x4*)(qp + 16);
                        const bf16x8 aop = __builtin_shufflevector(lo, hh, 0, 1, 2, 3, 4, 5, 6, 7);
                        const u32x4 bw = {sf[tl][s][0].x, sf[tl][s][0].y, sf[tl][s][1].x, sf[tl][s][1].y};
                        o[ti] = __builtin_amdgcn_mfma_f32_32x32x16_bf16(aop, __builtin_bit_cast(bf16x8, bw), o[ti], 0, 0, 0); }
            }
#pragma unroll
            for (int ks = 0; ks < 4; ++ks) { if (ti == 0 && ks >= 2) continue;
                const bf16x8 av = *(const LAS bf16x8*)(lds + GL_AM + (32 * ti + c32) * GL_TS + (16 * ks + 8 * hi) * 2);
                o[ti] = __builtin_amdgcn_mfma_f32_32x32x16_bf16(av, vt[ks], o[ti], 0, 0, 0); }
        }
    }
    __syncthreads();
#pragma unroll
    for (int ti = 0; ti < 2; ++ti)
#pragma unroll
        for (int r = 0; r < 16; ++r) *(LAS bf16_t*)(lds + GL_OST + (32 * ti + crow(r, hi)) * GL_OS + (32 * w + c32) * 2) = (bf16_t)(cvt_pk_bf16(o[ti][r], 0.f) & 0xffffu);
    __syncthreads();
    {
        const int t = tid >> 3, sg = tid & 7; const size_t tok = (size_t)(b * SEQ + chunk * 64 + t);
        u32x4 ov[4]; float ss = 0.f;
#pragma unroll
        for (int j = 0; j < 4; ++j) { ov[j] = *(const LAS u32x4*)(lds + GL_OST + t * GL_OS + sg * 64 + j * 16);
#pragma unroll
            for (int i = 0; i < 4; ++i) { const float x0 = bflo(ov[j][i]), x1 = bfhi(ov[j][i]); ss += x0 * x0 + x1 * x1; } }
        ss += __shfl_xor(ss, 1); ss += __shfl_xor(ss, 2); ss += __shfl_xor(ss, 4);
        const float rstd = 1.0f / sqrtf(ss * (1.0f / 256.0f) + EPS);
        const bf16_t* rap = proj + PROJ_BLK(C_RA + h * 256) + tok * 256 + sg * 32; bf16_t* op = oab + tok * 2048 + h * 256 + sg * 32; const float* gp = ggo + sg * 32;
#pragma unroll
        for (int j = 0; j < 4; ++j) { const u32x4 ra = __builtin_nontemporal_load((const u32x4*)(rap + 8 * j)); const f32x4 g0 = *(const f32x4*)(gp + 8 * j), g1 = *(const f32x4*)(gp + 8 * j + 4); u32x4 wv;
#pragma unroll
            for (int i = 0; i < 4; ++i) { const float r0 = bflo(ra[i]), r1 = bfhi(ra[i]); const float ga = (i < 2) ? g0[2 * i] : g1[2 * i - 4], gb = (i < 2) ? g0[2 * i + 1] : g1[2 * i - 3];
                wv[i] = cvt_pk_bf16(bflo(ov[j][i]) * rstd * ga * (r0 * fsigmoid(r0)), bfhi(ov[j][i]) * rstd * gb * (r1 * fsigmoid(r1))); }
            *(u32x4*)(op + 8 * j) = wv; }
    }
    __syncthreads();
}
namespace moba {
constexpr int HD = 128;
constexpr float SCALE = 0.08838834764831845f;
constexpr float THR = 8.f;
constexpr int NW = 8, QBLK = 32, KVBLK = 64, QB = NW * QBLK;
constexpr int SHM_V = KVBLK * HD * 2, SHM_K = KVBLK * HD * 2;
constexpr int OFF_WS = 2 * SHM_V + 2 * SHM_K;
constexpr int OFF_RTAB = OFF_WS + NW * 64 * 4;
constexpr int OFF_KM = OFF_RTAB + 2400 * 4;
constexpr int OFF_MISC = OFF_KM + 8 * 128 * 4;
constexpr int OFF_SEL = OFF_MISC + 64;
constexpr int LDS_BYTES = OFF_SEL + 2048;
constexpr int LDP = HD, LDO = 2048;

#define KSWZ(row, colB) ((row) * 256 + ((colB) ^ (((row) & 7) << 4)))
#define SBAR() __builtin_amdgcn_sched_barrier(0)
__device__ __forceinline__ int v_st(int k, int c) { const int kk = (k & ~0xC) | ((k & 4) << 1) | ((k & 8) >> 1); return ((kk >> 3) * 4 + (c >> 5)) * 512 + ((kk & 7) * 32 + (c & 31)) * 2; }
__device__ __forceinline__ int v_rd_base(int lane) { return ((lane & 3) << 3) | (((lane >> 2) & 3) << 6) | (((lane >> 4) & 1) << 5) | (((lane >> 5) & 1) << 8); }
constexpr int v_rd_off(int d0, int ks, int half) { return d0 * 512 + ks * 4096 + half * 2048; }
__device__ __forceinline__ int crow(int r, int hi) { return (r & 3) + 8 * (r >> 2) + 4 * hi; }
__device__ __forceinline__ unsigned cvtpk(float lo, float hi) { unsigned r; asm volatile("v_cvt_pk_bf16_f32 %0, %1, %2" : "=v"(r) : "v"(lo), "v"(hi)); return r; }

__device__ __forceinline__ void mask_tile(f32x16& p0, f32x16& p1, int dq) {
    const float NEG = -__builtin_inff();
#pragma unroll
    for (int r = 0; r < 16; ++r) {
        const int c = (r & 3) + 8 * (r >> 2);
        if (dq - c < 0) p0[r] = NEG;
        if (dq - c - 32 < 0) p1[r] = NEG;
    }
}
__device__ __forceinline__ void bias_tile(f32x16& p0, f32x16& p1, const LAS float* rt) {
#pragma unroll
    for (int r = 0; r < 16; ++r) { const int c = (r & 3) + 8 * (r >> 2); p0[r] += rt[c]; p1[r] += rt[c + 32]; }
}
__device__ __forceinline__ void kill_tile(f32x16& p0, f32x16& p1) {
    const float NEG = -__builtin_inff();
#pragma unroll
    for (int r = 0; r < 16; ++r) { p0[r] = NEG; p1[r] = NEG; }
}
__device__ __forceinline__ void partialSM(f32x16& p0, f32x16& p1, float& m_reg, float& mn, float& alpha) {
    float pmax = p0[0];
#pragma unroll
    for (int r = 1; r < 16; ++r) pmax = fmaxf(pmax, p0[r]);
#pragma unroll
    for (int r = 0; r < 16; ++r) pmax = fmaxf(pmax, p1[r]);
    { auto rr = __builtin_amdgcn_permlane32_swap(__float_as_uint(pmax), __float_as_uint(pmax), false, false);
      pmax = fmaxf(__uint_as_float(rr[0]), __uint_as_float(rr[1])); }
    constexpr float C2 = 1.4426950408889634f * SCALE;
    if (__builtin_expect(__all((pmax - m_reg) * SCALE <= THR), 1)) { mn = m_reg; alpha = 1.f; }
    else { mn = fmaxf(m_reg, pmax); alpha = __builtin_amdgcn_exp2f((m_reg - mn) * C2); m_reg = mn; }
    const float mnL = -mn * C2;
#pragma unroll
    for (int r = 0; r < 16; ++r) p0[r] = fmaf(p0[r], C2, mnL);
#pragma unroll
    for (int r = 0; r < 16; ++r) p1[r] = fmaf(p1[r], C2, mnL);
#pragma unroll
    for (int r = 0; r < 16; ++r) p0[r] = __builtin_amdgcn_exp2f(p0[r]);
}
__device__ __forceinline__ void finishSM(f32x16& p0, f32x16& p1, float alpha, float& l_reg, bf16x8& pa0, bf16x8& pa1, bf16x8& pa2, bf16x8& pa3) {
#pragma unroll
    for (int r = 0; r < 16; ++r) p1[r] = __builtin_amdgcn_exp2f(p1[r]);
    float ps = 0;
#pragma unroll
    for (int r = 0; r < 16; ++r) ps += p0[r];
#pragma unroll
    for (int r = 0; r < 16; ++r) ps += p1[r];
    { auto rr = __builtin_amdgcn_permlane32_swap(__float_as_uint(ps), __float_as_uint(ps), false, false);
      ps = __uint_as_float(rr[0]) + __uint_as_float(rr[1]); }
    l_reg = l_reg * alpha + ps;
#define PK4(P, B_, OUT) do { unsigned a0 = cvtpk(P[B_+0], P[B_+1]), a1 = cvtpk(P[B_+2], P[B_+3]);                          \
        unsigned b0 = cvtpk(P[B_+4], P[B_+5]), b1 = cvtpk(P[B_+6], P[B_+7]);                                             \
        auto r0 = __builtin_amdgcn_permlane32_swap(a0, b0, false, false); auto r1 = __builtin_amdgcn_permlane32_swap(a1, b1, false, false); \
        u32x4 w = {r0[0], r1[0], r0[1], r1[1]}; OUT = __builtin_bit_cast(bf16x8, w); } while (0)
    PK4(p0, 0, pa0); PK4(p0, 8, pa1); PK4(p1, 0, pa2); PK4(p1, 8, pa3);
#undef PK4
}
template <int KB>
__device__ __forceinline__ void qkt(f32x16& p0, f32x16& p1, const char* K_lds, int r32, int hi, const bf16x8* qr) {
#pragma unroll
    for (int r = 0; r < 16; ++r) { p0[r] = 0.f; p1[r] = 0.f; }
    const char* kb[4];
#pragma unroll
    for (int dd = 0; dd < 4; ++dd) kb[dd] = K_lds + KB * SHM_K + KSWZ(r32, (dd * 16 + hi * 8) * 2);
#pragma unroll
    for (int d0 = 0; d0 < 8; ++d0) { const char* a = kb[d0 & 3] + (d0 >> 2) * 128;
        bf16x8 b0 = *reinterpret_cast<const bf16x8*>(a);
        bf16x8 b1 = *reinterpret_cast<const bf16x8*>(a + 32 * 256);
        p0 = __builtin_amdgcn_mfma_f32_32x32x16_bf16(b0, qr[d0], p0, 0, 0, 0);
        p1 = __builtin_amdgcn_mfma_f32_32x32x16_bf16(b1, qr[d0], p1, 0, 0, 0); }
}
template <int VB>
__device__ __forceinline__ void pv_tile(f32x16* o, int vb0, bf16x8 pa0, bf16x8 pa1, bf16x8 pa2, bf16x8 pa3) {
#define TRRD(dst, off) asm volatile("ds_read_b64_tr_b16 %0, %1 offset:%2" : "=&v"(dst) : "v"(vb0), "i"(off) : "memory")
#define PV_D0(d0) do { s16x4 l0, l1, l2, l3, h0, h1, h2, h3; constexpr int b_ = VB * SHM_V + v_rd_off(d0, 0, 0);   \
        TRRD(l0, b_); TRRD(h0, b_ + 2048); TRRD(l1, b_ + 4096); TRRD(h1, b_ + 6144); TRRD(l2, b_ + 8192); TRRD(h2, b_ + 10240); TRRD(l3, b_ + 12288); TRRD(h3, b_ + 14336); \
        asm volatile("s_waitcnt lgkmcnt(0)" ::: "memory"); SBAR();   \
        o[d0] = __builtin_amdgcn_mfma_f32_32x32x16_bf16(pa0, (bf16x8){l0[0], l0[1], l0[2], l0[3], h0[0], h0[1], h0[2], h0[3]}, o[d0], 0, 0, 0);   \
        o[d0] = __builtin_amdgcn_mfma_f32_32x32x16_bf16(pa1, (bf16x8){l1[0], l1[1], l1[2], l1[3], h1[0], h1[1], h1[2], h1[3]}, o[d0], 0, 0, 0);   \
        o[d0] = __builtin_amdgcn_mfma_f32_32x32x16_bf16(pa2, (bf16x8){l2[0], l2[1], l2[2], l2[3], h2[0], h2[1], h2[2], h2[3]}, o[d0], 0, 0, 0);   \
        o[d0] = __builtin_amdgcn_mfma_f32_32x32x16_bf16(pa3, (bf16x8){l3[0], l3[1], l3[2], l3[3], h3[0], h3[1], h3[2], h3[3]}, o[d0], 0, 0, 0); } while (0)
    PV_D0(0); PV_D0(1); PV_D0(2); PV_D0(3);
#undef PV_D0
#undef TRRD
}

struct BlockRef { const bf16_t* Q; const bf16_t* K; const bf16_t* V; bf16_t* O; int qb; int b, h; };
struct Seam { bf16x8 qr[8]; bf16x8 st_v0, st_v1, st_k0, st_k1; };
#define VMW() asm volatile("s_waitcnt vmcnt(0)" ::: "memory")
#define VMWN(n) asm volatile("s_waitcnt vmcnt(%0)" :: "i"(n) : "memory")
#define LD8(p) (*reinterpret_cast<const bf16x8*>(p))
#define SLOAD_H(Kp, Vp, k0) do { const char* kb__ = (const char*)(Kp) + (size_t)(k0) * (LDP * 2); const char* vb__ = (const char*)(Vp) + (size_t)(k0) * (LDP * 2); \
        S.st_v0 = LD8(vb__ + kvoff); S.st_v1 = LD8(vb__ + 32 * LDP * 2 + kvoff); S.st_k0 = LD8(kb__ + kvoff); S.st_k1 = LD8(kb__ + 32 * LDP * 2 + kvoff); } while (0)
#define SWRITE_HK(bf) do { *(bf16x8*)(K_lds + (bf) * SHM_K + kws) = S.st_k0; *(bf16x8*)(K_lds + (bf) * SHM_K + kws + 32 * 256) = S.st_k1; } while (0)
#define SWRITE_HV(bf) do { *(bf16x8*)(V_lds + (bf) * SHM_V + vst0) = S.st_v0; *(bf16x8*)(V_lds + (bf) * SHM_V + vst1) = S.st_v1; } while (0)
#define SWRITE_H(bf) do { SWRITE_HV(bf); SWRITE_HK(bf); } while (0)

__device__ __forceinline__ void prime(const BlockRef& cur, char* lds, Seam& S) {
    int tid = threadIdx.x; asm volatile("" : "+v"(tid));     const int wid = __builtin_amdgcn_readfirstlane(tid >> 6), lane = tid & 63, r32 = lane & 31, hi = lane >> 5;
    const int sr = tid >> 4, sc = (tid & 15) * 8, kws = KSWZ(sr, sc * 2); char* K_lds = lds + 2 * SHM_V;
    const unsigned kvoff = (unsigned)(sr * LDP + sc) * 2u, qvoff = (unsigned)(r32 * LDP + hi * 8) * 2u;
    { const char* qb__ = (const char*)cur.Q + (size_t)(wid * QBLK) * (LDP * 2);
#pragma unroll
    for (int d0 = 0; d0 < 8; ++d0) S.qr[d0] = LD8(qb__ + qvoff + d0 * 32); }
    SLOAD_H(cur.K, cur.V, 0); VMW(); SWRITE_HK(0);
    __syncthreads();
}
__device__ __forceinline__ int rel_bucket(int n) {
    if (n < 16) return n;
    const float nf = (float)n;
    int large = 16 + (int)(logf(nf / 16.0f) / 5.545177444479562f * 16.0f);
    return large < 31 ? large : 31;
}
__device__ __forceinline__ BlockRef make_ref(const P& a, int item);
__device__ __forceinline__ int block(const P& a, const BlockRef& cur, unsigned* queue, const float* rel_bias, const float* kmp, char* lds, Seam& S) {
    int tid = threadIdx.x; asm volatile("" : "+v"(tid));     const int wid = __builtin_amdgcn_readfirstlane(tid >> 6), lane = tid & 63, r32 = lane & 31, hi = lane >> 5;
    const int qb = cur.qb, NT = 4 * (qb + 1);
    const int qlo = qb * QB + wid * QBLK, qrow = qlo + r32;
    char* V_lds = lds; char* K_lds = lds + 2 * SHM_V;
    float* ws = (float*)(lds + OFF_WS) + wid * 64; float* li_l = ws, * al_l = ws + 32;
    LAS float* rtab = (LAS float*)(LAS char*)(uintptr_t)(unsigned)(uintptr_t)(lds + OFF_RTAB);
    float* kmL = (float*)(lds + OFF_KM);
    volatile int* misc = (volatile int*)(lds + OFF_MISC);
    if (tid == 0) misc[0] = (int)__hip_atomic_fetch_add(queue, 1u, __ATOMIC_RELAXED, __HIP_MEMORY_SCOPE_AGENT);
    for (int i = tid; i < 2400; i += NW * 64) { const int dist = 2047 - i; rtab[i] = dist >= 0 ? rel_bias[rel_bucket(dist) * 8 + cur.h] * (1.0f / SCALE) : -__builtin_inff(); }
    for (int i = tid; i < qb * 128; i += NW * 64) { const int j = i >> 7, dd = i & 127; const size_t o = ((size_t)(cur.b * 8 + j)) * 1024 + cur.h * 128 + dd;
        kmL[i] = (kmp[o] + kmp[o + 64 * 1024]) * (1.0f / 256.0f); }
    __syncthreads();
    const int next_item = __builtin_amdgcn_readfirstlane(misc[0]);
    const BlockRef nxt = next_item < 512 ? make_ref(a, next_item) : cur;
    unsigned selmask = 0;
    {
        float sc7[7];
#pragma unroll
        for (int j = 0; j < 7; ++j) { sc7[j] = -__builtin_inff();
            if (j < qb) { float acc = 0.f;
#pragma unroll
                for (int d0 = 0; d0 < 8; ++d0) { const u32x4 q4 = __builtin_bit_cast(u32x4, S.qr[d0]); const f32x4 k0 = *(const f32x4*)(kmL + j * 128 + d0 * 16 + hi * 8), k1 = *(const f32x4*)(kmL + j * 128 + d0 * 16 + hi * 8 + 4);
                    acc += bflo(q4[0]) * k0[0] + bfhi(q4[0]) * k0[1] + bflo(q4[1]) * k0[2] + bfhi(q4[1]) * k0[3] + bflo(q4[2]) * k1[0] + bfhi(q4[2]) * k1[1] + bflo(q4[3]) * k1[2] + bfhi(q4[3]) * k1[3]; }
                acc += __shfl_xor(acc, 32); sc7[j] = acc; } }
#pragma unroll
        for (int j = 0; j < 7; ++j) { int rank = 0;
#pragma unroll
            for (int i = 0; i < 7; ++i) { if (i != j) rank += (sc7[i] > sc7[j] || (sc7[i] == sc7[j] && i < j)) ? 1 : 0; }
            if (j < qb && (qb <= 3 || rank < 3)) selmask |= 1u << j; }
    }
    LAS unsigned* selp = (LAS unsigned*)(LAS char*)(uintptr_t)(unsigned)(uintptr_t)(lds + OFF_SEL) + tid;
    *selp = selmask;
    float m_reg = -1e30f, l_reg = 0; f32x16 o[4];
#pragma unroll
    for (int d = 0; d < 4; ++d)
#pragma unroll
        for (int r = 0; r < 16; ++r) o[d][r] = 0.f;
    const int sr = tid >> 4, sc = (tid & 15) * 8, vst0 = v_st(sr, sc), vst1 = v_st(32 + sr, sc), kws = KSWZ(sr, sc * 2);
    const unsigned kvoff = (unsigned)(sr * LDP + sc) * 2u;
    const int vb0 = (int)(uintptr_t)V_lds + v_rd_base(lane);
    const bf16_t* Kh = cur.K; const bf16_t* Vh = cur.V;
#define RESC(a) do { if (__any((a) < 1.f)) { if (hi == 0) al_l[r32] = (a); asm volatile("s_waitcnt lgkmcnt(0)" ::: "memory");              \
                     for (int d_ = 0; d_ < 4; ++d_) for (int r = 0; r < 16; ++r) o[d_][r] *= al_l[crow(r, hi)]; } } while (0)
#define KBASE(t) ((t) * KVBLK)
#define MASKT(P0_, P1_, t) do { const int kb_ = KBASE(t); const int jb_ = (t) >> 2; \
        const bool on_ = (jb_ == qb) || ((*selp >> jb_) & 1u); \
        bias_tile(P0_, P1_, on_ ? rtab + (kb_ + 4 * hi - qrow + 2047) : rtab + 2304); } while (0)
    constexpr int NQL = 8;
#define SEAM_K0() do { VMWN(NQL); SWRITE_HK(0); SBAR(); } while (0)
    f32x16 pA0, pA1, pB0, pB1; float mnA, mnB, alA, alB; bf16x8 pa0, pa1, pa2, pa3;
    SWRITE_HV(0); SBAR();
    if (NT > 1) { SLOAD_H(Kh, Vh, KBASE(1)); }
    SBAR(); qkt<0>(pA0, pA1, K_lds, r32, hi, S.qr);
    MASKT(pA0, pA1, 0); partialSM(pA0, pA1, m_reg, mnA, alA);
    if (NT > 1) { VMW(); SWRITE_H(1); }
    __syncthreads();
#define HALF_STEP(PX0, PX1, mnX, alX, PY0, PY1, alY, t, KB, VB, SB) do {                                                      \
        SBAR(); if ((t) + 1 < NT) { SLOAD_H(Kh, Vh, KBASE((t) + 1)); SBAR(); }      \
        qkt<KB>(PX0, PX1, K_lds, r32, hi, S.qr);                                             \
        finishSM(PY0, PY1, alY, l_reg, pa0, pa1, pa2, pa3); SBAR();                                                           \
        pv_tile<VB>(o, vb0, pa0, pa1, pa2, pa3); MASKT(PX0, PX1, (t)); partialSM(PX0, PX1, m_reg, mnX, alX);                                        \
        __syncthreads();                                                                                                      \
        if ((t) + 1 < NT) { VMW(); SWRITE_H(SB); }                                                                          \
        RESC(alX); __syncthreads(); } while (0)
    for (int t = 1; t + 1 < NT; t += 2) {
        HALF_STEP(pB0, pB1, mnB, alB, pA0, pA1, alA, t, 1, 0, 0);
        HALF_STEP(pA0, pA1, mnA, alA, pB0, pB1, alB, t + 1, 0, 1, 1);
    }
    { SBAR(); qkt<1>(pB0, pB1, K_lds, r32, hi, S.qr); SBAR(); }
    SLOAD_H(nxt.K, nxt.V, 0); SBAR();
    { const char* qb__ = (const char*)nxt.Q + (size_t)(wid * QBLK) * (LDP * 2); int l_ = lane; asm volatile("" : "+v"(l_));
      const unsigned qvoff = (unsigned)((l_ & 31) * LDP + (l_ >> 5) * 8) * 2u;
#pragma unroll
    for (int d0 = 0; d0 < 8; ++d0) S.qr[d0] = LD8(qb__ + qvoff + d0 * 32); }
    SBAR();
    finishSM(pA0, pA1, alA, l_reg, pa0, pa1, pa2, pa3); SBAR();
    pv_tile<0>(o, vb0, pa0, pa1, pa2, pa3);
    { MASKT(pB0, pB1, NT - 1); partialSM(pB0, pB1, m_reg, mnB, alB); __syncthreads(); RESC(alB);
      finishSM(pB0, pB1, alB, l_reg, pa0, pa1, pa2, pa3); SBAR(); pv_tile<1>(o, vb0, pa0, pa1, pa2, pa3); }
    SBAR(); SEAM_K0();
    if (hi == 0) li_l[r32] = l_reg; asm volatile("s_waitcnt lgkmcnt(0)" ::: "memory");
    float rli[16];
#pragma unroll
    for (int r = 0; r < 16; ++r) rli[r] = __builtin_amdgcn_rcpf(li_l[crow(r, hi)]);
    char* Ow = (char*)cur.O + (size_t)(wid * QBLK) * (LDO * 2); const unsigned ovoff = (unsigned)(4 * hi * LDO + r32) * 2u;
#pragma unroll
    for (int r = 0; r < 16; ++r) { const int orow0 = (r & 3) + 8 * (r >> 2);
#pragma unroll
        for (int d0 = 0; d0 < 4; ++d0) { const float v = o[d0][r] * rli[r];
            const float vn = __shfl_xor(v, 1);
            if ((r32 & 1) == 0) *(unsigned*)(Ow + (size_t)(orow0 * LDO * 2 + d0 * 64) + ovoff) = cvtpk(v, vn); } }
    __syncthreads();
    return next_item;
#undef RESC
#undef KBASE
#undef MASKT
#undef SEAM_K0
#undef HALF_STEP
}
#undef ROWP
#undef VMW
#undef VMWN
#undef LD8
#undef SLOAD_H
#undef SWRITE_HK
#undef SWRITE_HV
#undef SWRITE_H

__device__ __forceinline__ BlockRef make_ref(const P& a, int item) {
    const int qb = 7 - (item >> 6), bh = item & 63, b = bh >> 3, h = bh & 7;
    const bf16_t* proj = (const bf16_t*)(a.ws + WS_PROJ);
    BlockRef r; r.b = b; r.h = h; r.qb = qb;
    r.Q = proj + PROJ_BLK(C_QB + h * HD) + (size_t)(b * SEQ + qb * QB) * LDP;
    r.K = proj + PROJ_BLK(C_KB + h * HD) + (size_t)(b * SEQ) * LDP;
    r.V = proj + PROJ_BLK(C_VB + h * HD) + (size_t)(b * SEQ) * LDP;
    r.O = (bf16_t*)(a.ws + WS_OAB) + (size_t)(b * SEQ + qb * QB) * LDO + 1024 + h * HD;
    return r;
}
}
__device__ __forceinline__ void router_unit(const P& a, LAS unsigned char* lds, int unit) {
    int tid = threadIdx.x; asm volatile("" : "+v"(tid)); const int wave = __builtin_amdgcn_readfirstlane(tid >> 6), lane = tid & 63, c32 = lane & 31, hi = lane >> 5;
    const int tg = wave & 1, kq = wave >> 1;
    const bf16_t* x1 = (const bf16_t*)(a.ws + WS_X1); const float* g = a.in[11]; const float* br = a.in[13];
    unsigned char* A2 = a.ws + WS_A2; const u32x4* frag = (const u32x4*)(a.ws + WS_WRF);
    LAS float* Lw = (LAS float*)(lds + wave * 4352);
    LAS float* ssp = (LAS float*)(lds + 8 * 4352);
    LAS unsigned* hist = (LAS unsigned*)(lds + 8 * 4352 + 2048);
    LAS unsigned* base = hist + 32;
    if (tid < 32) hist[tid] = 0u;
    const int tok = unit * 64 + tg * 32 + c32;
    f32x16 L;
#pragma unroll
    for (int r = 0; r < 16; ++r) L[r] = 0.f;
    float ss = 0.f;
    const bf16_t* xr = x1 + (size_t)tok * D + 8 * hi + 256 * kq; unsigned char* ar = A2 + (size_t)tok * D + 8 * hi + 256 * kq; const float* gr = g + 8 * hi + 256 * kq;
#pragma unroll 4
    for (int s = 0; s < 16; ++s) {
        const u32x4 xw = *(const u32x4*)(xr + 16 * s); const f32x4 xa = {bflo(xw.x), bfhi(xw.x), bflo(xw.y), bfhi(xw.y)}, xb = {bflo(xw.z), bfhi(xw.z), bflo(xw.w), bfhi(xw.w)}, ga = *(const f32x4*)(gr + 16 * s), gb = *(const f32x4*)(gr + 16 * s + 4);
        ss += (xa.x * xa.x + xa.y * xa.y) + (xa.z * xa.z + xa.w * xa.w) + (xb.x * xb.x + xb.y * xb.y) + (xb.z * xb.z + xb.w * xb.w);
        const f32x4 va = xa * ga, vb = xb * gb;
        u32x4 wh; wh.x = cvt_pk_bf16(va.x, va.y); wh.y = cvt_pk_bf16(va.z, va.w); wh.z = cvt_pk_bf16(vb.x, vb.y); wh.w = cvt_pk_bf16(vb.z, vb.w);
        { u32x2 w8; w8.x = pk4_fp8(va.x, va.y, va.z, va.w); w8.y = pk4_fp8(vb.x, vb.y, vb.z, vb.w); *(u32x2*)(ar + 16 * s) = w8; }
        u32x4 wl; wl.x = cvt_pk_bf16(va.x - bflo(wh.x), va.y - bfhi(wh.x)); wl.y = cvt_pk_bf16(va.z - bflo(wh.y), va.w - bfhi(wh.y));
        wl.z = cvt_pk_bf16(vb.x - bflo(wh.z), vb.y - bfhi(wh.z)); wl.w = cvt_pk_bf16(vb.z - bflo(wh.w), vb.w - bfhi(wh.w));
        const bf16x8 ah = __builtin_bit_cast(bf16x8, wh), al = __builtin_bit_cast(bf16x8, wl);
        const bf16x8 bh = __builtin_bit_cast(bf16x8, frag[(16 * kq + s) * 64 + lane]), bl = __builtin_bit_cast(bf16x8, frag[4096 + (16 * kq + s) * 64 + lane]);
        L = __builtin_amdgcn_mfma_f32_32x32x16_bf16(ah, bh, L, 0, 0, 0);
        L = __builtin_amdgcn_mfma_f32_32x32x16_bf16(ah, bl, L, 0, 0, 0);
        L = __builtin_amdgcn_mfma_f32_32x32x16_bf16(al, bh, L, 0, 0, 0);
    }
#pragma unroll
    for (int r = 0; r < 16; ++r) Lw[((r & 3) + 8 * (r >> 2) + 4 * hi) * 33 + c32] = L[r];
    ssp[wave * 64 + lane] = ss;
    __syncthreads();
    int e4[4] = {0, 0, 0, 0}; float w4[4] = {0.f, 0.f, 0.f, 0.f}; unsigned loc[4] = {0u, 0u, 0u, 0u}; float rstd = 0.f;
    const bool sel = (wave < 2) && (hi == 0);
    if (sel) {
        float sst = 0.f;
#pragma unroll
        for (int q = 0; q < 4; ++q) sst += ssp[(wave + 2 * q) * 64 + c32] + ssp[(wave + 2 * q) * 64 + 32 + c32];
        rstd = 1.0f / sqrtf(sst * (1.0f / D) + EPS);
        float lg[32];
#pragma unroll
        for (int e = 0; e < 32; ++e) { const LAS float* lp = (const LAS float*)(lds + wave * 4352) + c32 * 33 + e; lg[e] = (lp[0] + lp[2 * 1088] + lp[4 * 1088] + lp[6 * 1088]) * rstd + br[e]; }
        unsigned used = 0u; float v4[4];
#pragma unroll
        for (int p = 0; p < 4; ++p) { float best = -__builtin_inff(); int bi = 0;
#pragma unroll
            for (int e = 0; e < 32; ++e) { const bool take = !((used >> e) & 1u) && lg[e] > best; best = take ? lg[e] : best; bi = take ? e : bi; }
            used |= 1u << bi; e4[p] = bi; v4[p] = best; }
        float sum = 0.f;
#pragma unroll
        for (int p = 0; p < 4; ++p) { w4[p] = expf(v4[p] - v4[0]); sum += w4[p]; }
        const float inv = 1.0f / sum;
#pragma unroll
        for (int p = 0; p < 4; ++p) { w4[p] *= inv; loc[p] = __hip_atomic_fetch_add(hist + e4[p], 1u, __ATOMIC_RELAXED, __HIP_MEMORY_SCOPE_WORKGROUP); }
    }
    __syncthreads();
    if (tid < 32) base[tid] = __hip_atomic_fetch_add((unsigned*)(a.ws + WS_CTL) + CW_COUNTS + tid, hist[tid], RLX_AGENT);
    __syncthreads();
    if (sel) {
        int* tope = (int*)(a.ws + WS_TOPE) + (size_t)tok * 4; float* wts = (float*)(a.ws + WS_WTS) + (size_t)tok * 4; int* slot = (int*)(a.ws + WS_SLOT) + (size_t)tok * 4;
#pragma unroll
        for (int p = 0; p < 4; ++p) { const int sl_ = (int)(base[e4[p]] + loc[p]); tope[p] = e4[p]; wts[p] = w4[p]; slot[p] = sl_;
            ((int*)(a.ws + WS_ROWE))[(size_t)e4[p] * T + sl_] = tok; ((float*)(a.ws + WS_RSTE))[(size_t)e4[p] * T + sl_] = rstd; }
    }
    __syncthreads();
}

__device__ __forceinline__ void moe_tables(const P& a, LAS unsigned char* lds) {
    int tid = threadIdx.x; asm volatile("" : "+v"(tid)); const int wave = tid >> 6, lane = tid & 63, e = lane & 31;
    LAS int* pstart = (LAS int*)(lds + LDS_MOE); LAS int* cnt = pstart + 64; LAS int* tile_e = pstart + 128;
    const unsigned* counts = (const unsigned*)(a.ws + WS_CTL) + CW_COUNTS;
    const int c = (int)counts[e]; const int p = ((c + 255) >> 8) << 8; int inc = p;
#pragma unroll
    for (int o = 1; o < 32; o <<= 1) { const int t = __builtin_amdgcn_ds_bpermute(((lane - o) & 63) << 2, inc); if (e >= o) inc += t; }
    if (tid < 32) { cnt[e] = c; pstart[e] = inc - p; if (e == 31) { pstart[32] = inc; tile_e[MAXTILES] = inc >> 8; } }
    for (int t = wave * 36; t < wave * 36 + 36; ++t) { const unsigned long long m = __ballot(inc <= t * 256); const int ee = __builtin_popcount((unsigned)m); if (lane == 0) tile_e[t] = ee < NE ? ee : NE - 1; }
    __syncthreads();
}

__device__ __forceinline__ void combine_rows(const P& a, LAS unsigned char* lds, int vcu, int G, int wave, int lane) {
    const LAS int* pstart = (const LAS int*)(lds + LDS_MOE);
    const int gw = vcu * NWAVES + wave, NGW = G * NWAVES;
    const bf16_t* X1 = (const bf16_t*)(a.ws + WS_X1); float* X = (float*)(a.ws + WS_X2); const unsigned char* Y = a.ws + WS_YROWS; bf16_t* A3 = (bf16_t*)(a.ws + WS_H);
    const int* tope = (const int*)(a.ws + WS_TOPE); const int* slot = (const int*)(a.ws + WS_SLOT); const float* wts = (const float*)(a.ws + WS_WTS); const float* g = a.in[20];
    f32x4 gv[4];
#pragma unroll
    for (int j = 0; j < 4; ++j) gv[j] = *((const f32x4*)g + lane + 64 * j);
    for (int m = gw; m < T; m += NGW) {
        f32x4* xr = (f32x4*)(X + (size_t)m * D) + lane; const u32x2* x1r = (const u32x2*)(X1 + (size_t)m * D) + lane; f32x4 v[4];
#pragma unroll
        for (int j = 0; j < 4; ++j) { const u32x2 xq = __builtin_nontemporal_load(x1r + 64 * j); v[j] = (f32x4){bflo(xq.x), bfhi(xq.x), bflo(xq.y), bfhi(xq.y)}; }
#pragma unroll
        for (int k = 0; k < 4; ++k) { const int d = __builtin_amdgcn_readfirstlane(pstart[tope[m * 4 + k]] + slot[m * 4 + k]); const float w = __uint_as_float(__builtin_amdgcn_readfirstlane(__float_as_uint(wts[m * 4 + k])));
            const unsigned* yr = (const unsigned*)(Y + (size_t)d * D) + lane;
#pragma unroll
            for (int j = 0; j < 4; ++j) { const int y = (int)__builtin_nontemporal_load(yr + 64 * j);
                v[j].x += w * __builtin_amdgcn_cvt_f32_fp8(y, 0); v[j].y += w * __builtin_amdgcn_cvt_f32_fp8(y, 1); v[j].z += w * __builtin_amdgcn_cvt_f32_fp8(y, 2); v[j].w += w * __builtin_amdgcn_cvt_f32_fp8(y, 3); } }
        float s = 0.f;
#pragma unroll
        for (int j = 0; j < 4; ++j) s += (v[j].x * v[j].x + v[j].y * v[j].y) + (v[j].z * v[j].z + v[j].w * v[j].w);
        const float rstd = 1.0f / sqrtf(wave_sum(s) * (1.0f / D) + EPS);
        unsigned* o4 = (unsigned*)((unsigned char*)A3 + (size_t)m * D) + lane;
#pragma unroll
        for (int j = 0; j < 4; ++j) { xr[64 * j] = v[j]; o4[64 * j] = pk4_fp8(v[j].x * rstd * gv[j].x, v[j].y * rstd * gv[j].y, v[j].z * rstd * gv[j].z, v[j].w * rstd * gv[j].w); }
    }
}
__device__ __forceinline__ void final_rows(const P& a, int vcu, int G, int wave, int lane) {
    const int gw = vcu * NWAVES + wave, NGW = G * NWAVES;
    const float* X = (const float*)(a.ws + WS_X2); float* OUT = a.out; const bf16_t* PG = (const bf16_t*)(a.ws + WS_PGATE); const bf16_t* PP = (const bf16_t*)(a.ws + WS_PPROJ);
    f32x4 gp[4], gf[4];
#pragma unroll
    for (int j = 0; j < 4; ++j) { gp[j] = *((const f32x4*)a.in[23] + lane + 64 * j); gf[j] = *((const f32x4*)a.in[24] + lane + 64 * j); }
    for (int m = gw; m < T; m += NGW) {
        const f32x4* xr = (const f32x4*)(X + (size_t)m * D) + lane; f32x4* orow = (f32x4*)(OUT + (size_t)m * D) + lane; const u32x2* pgr = (const u32x2*)(PG + (size_t)m * D) + lane; const u32x2* ppr = (const u32x2*)(PP + (size_t)m * D) + lane;
        f32x4 v[4], pp[4], pg[4]; float sp = 0.f;
#pragma unroll
        for (int j = 0; j < 4; ++j) { v[j] = __builtin_nontemporal_load(xr + 64 * j); const u32x2 q = __builtin_nontemporal_load(ppr + 64 * j), gq = __builtin_nontemporal_load(pgr + 64 * j);
            pp[j] = (f32x4){bflo(q.x), bfhi(q.x), bflo(q.y), bfhi(q.y)}; pg[j] = (f32x4){bflo(gq.x), bfhi(gq.x), bflo(gq.y), bfhi(gq.y)};
            sp += (pp[j].x * pp[j].x + pp[j].y * pp[j].y) + (pp[j].z * pp[j].z + pp[j].w * pp[j].w); }
        const float rp = 1.0f / sqrtf(wave_sum(sp) * (1.0f / D) + EPS); float s = 0.f;
#pragma unroll
        for (int j = 0; j < 4; ++j) { v[j] = v[j] + pg[j] * (pp[j] * rp * gp[j]); s += (v[j].x * v[j].x + v[j].y * v[j].y) + (v[j].z * v[j].z + v[j].w * v[j].w); }
        const float rstd = 1.0f / sqrtf(wave_sum(s) * (1.0f / D) + EPS);
#pragma unroll
        for (int j = 0; j < 4; ++j) __builtin_nontemporal_store(v[j] * rstd * gf[j], orow + 64 * j);
    }
}
struct Args { P p; };
template <int PH_LO, int PH_HI>
__global__ void __launch_bounds__(NTHREADS, 2) hybrid_fwd(Args args) {
    extern __shared__ __attribute__((aligned(16))) unsigned char lds_raw[];
    LAS unsigned char* lds = (LAS unsigned char*)lds_raw;
    const P& a = args.p;
    const int tid = threadIdx.x;
#define FRESH_WL() int t_ = threadIdx.x; asm volatile("" : "+v"(t_)); const int w_ = __builtin_amdgcn_readfirstlane(t_ >> 6), l_ = t_ & 63
    const int G = gridDim.x; const int bx = blockIdx.x; const int vcu = (G % 8 == 0) ? (bx % 8) * (G / 8) + bx / 8 : bx;
    unsigned* ctl = (unsigned*)(a.ws + WS_CTL);
    for (int u = tid; u < (LDS_BYTES - LDSCTL_OFF) / 4; u += NTHREADS) ((LAS unsigned*)(lds + LDSCTL_OFF))[u] = 0u;
    __syncthreads();
#if MK_PER_PHASE
#define GRID_BAR() do { } while (0)
#else
    XcdBarrier bar = xcd_barrier_post(ctl + CW_BAR, (volatile LAS unsigned*)(lds + MISC_OFF + 32));
#define GRID_BAR() xcd_barrier(bar)
#endif
    constexpr int lo = PH_LO, hi = PH_HI;
#define IN(k) (lo <= (k) && (k) < hi)
#define SEAM(k) do { if constexpr (IN(k) && IN((k) + 1)) GRID_BAR(); } while (0)
    unsigned char* ws = a.ws;

    if constexpr (IN(0)) { FRESH_WL(); p0_prologue(a, lds, vcu, G, w_, l_); }
    SEAM(0);
    if constexpr (IN(1)) {
        { pg8::DenseSched S; S.o.init(T / 256, 12, G, bx); S.Bt = (const char*)(ws + WS_WIN); S.K = D;
          pg8::EpiProj<false> E{(bf16_t*)(ws + WS_PROJ), (float*)(ws + WS_KMP)};
          pg8::gemm_phase(lds, (const char*)(ws + WS_H), D, D, D, S, E); }
        { pg8::DenseSched S; S.o.init(T / 256, 20, G, bx); S.Bt = (const char*)(ws + WS_WIN8); S.K = D; S.es = 1; S.pn0 = 12; S.bt_out = false;
          pg8::EpiProj<true> E{(bf16_t*)(ws + WS_PROJ), (float*)(ws + WS_KMP)};
          pg8::gemm_phase(lds, (const char*)(ws + WS_H8), D, D, D, S, E); }
    }
    SEAM(1);
    if constexpr (IN(2)) { for (int u = vcu; u < NB * 32; u += G) gla_prep_unit(a, lds, u); }
    SEAM(2);
    if constexpr (IN(3)) { for (int u = vcu; u < 512; u += G) gla_combine_unit(a, u); }
    SEAM(3);
    if constexpr (IN(4)) {
        for (int u = vcu; u < 1024; u += G) gla_out_unit(a, lds, u);
        __syncthreads();
    }
    if constexpr (IN(5)) {
        if ((vcu & 1) == 0) { FRESH_WL(); expert_convert(a, lds, vcu >> 1, G >> 1, w_, l_); __syncthreads(); }
        unsigned* queue = ctl + CW_QUEUE;
        volatile LAS int* qslot = (volatile LAS int*)(lds + LDSCTL_OFF + 1024);
        if (tid == 0) qslot[0] = (int)__hip_atomic_fetch_add(queue, 1u, RLX_AGENT);
        __syncthreads();
        int item = __builtin_amdgcn_readfirstlane(qslot[0]);
        if (item < 512) {
            moba::Seam S;
            moba::BlockRef cur = moba::make_ref(a, item);
            moba::prime(cur, (char*)lds_raw, S);
            for (;;) {
                const int nitem = moba::block(a, cur, queue, a.in[2], (const float*)(ws + WS_KMP), (char*)lds_raw, S);
                if (nitem >= 512) break;
                cur = moba::make_ref(a, nitem);
            }
        }
    }
    SEAM(5);
    if constexpr (IN(6)) {
        pg8::ChainSched S; S.o.init(T / 256, D / 256, G, bx); S.Bt = (const char*)(ws + WS_WUP); S.K = 1024;
        pg8::EpiMerge E{(const bf16_t*)(ws + WS_PROJ), (bf16_t*)(ws + WS_Y)};
        pg8::gemm_phase(lds, (const char*)(ws + WS_OAB), 1024, 2048, 2048, S, E);
    }
    SEAM(6);
    if constexpr (IN(7)) {
        pg8::DenseSched S; S.o.init(T / 256, D / 256, G, bx); S.Bt = (const char*)(ws + WS_WO); S.K = D;
        pg8::EpiResF32 E{a.in[0], (bf16_t*)(ws + WS_X1)};
        pg8::gemm_phase(lds, (const char*)(ws + WS_Y), D, D, D, S, E);
    }
    SEAM(7);
    if constexpr (IN(8)) { for (int u = vcu; u < T / 64; u += G) router_unit(a, lds, u); }
    SEAM(8);
    if constexpr (IN(9)) {
        moe_tables(a, lds); const LAS int* tab = (const LAS int*)(lds + LDS_MOE); const int ntile = __builtin_amdgcn_readfirstlane(tab[128 + MAXTILES]);
        pg8::MoeSched<true> S; S.o.init(ntile, 8, G, bx); S.Bt = (const char*)a.out; S.K = D; S.rows_per_e = 2048; S.tab = tab; S.row_e = (const int*)(ws + WS_ROWE); S.es = 1;
        pg8::EpiGlu E{(unsigned char*)(ws + WS_HMID), (const float*)(ws + WS_RSTE), tab, a.in[15], a.in[17], (const float*)(ws + WS_CTL) + 131072, lds};
        pg8::gemm_phase(lds, (const char*)(ws + WS_A2), D, D, D, S, E);
        const int extra = (ntile * 8) % G, nidle = G - extra;
        if (bx >= extra) { __syncthreads();
            pg8::DenseSched S2; S2.o.init(T / 256, D / 256, nidle, bx - extra); S2.Bt = (const char*)(ws + WS_WPP); S2.K = 256;
            pg8::EpiBf16<0, false> E2{(bf16_t*)(ws + WS_PPROJ), D, nullptr, 0, 1.0f};
            pg8::gemm_phase(lds, (const char*)(ws + WS_PB), 256, 256, 256, S2, E2); }
    }
    SEAM(9);
    if constexpr (IN(10)) {
        moe_tables(a, lds); const LAS int* tab = (const LAS int*)(lds + LDS_MOE); const int ntile = __builtin_amdgcn_readfirstlane(tab[128 + MAXTILES]);
        pg8::MoeSched<false> S; S.o.init(ntile, 4, G, bx); S.Bt = (const char*)(ws + WS_W2T); S.K = FF; S.rows_per_e = 1024; S.tab = tab; S.row_e = nullptr; S.es = 1;
        pg8::EpiDownF8 E{(unsigned char*)(ws + WS_YROWS), a.in[19]};
        pg8::gemm_phase(lds, (const char*)(ws + WS_HMID), FF, FF, FF, S, E);
    }
    SEAM(10);
    if constexpr (IN(11)) { moe_tables(a, lds); FRESH_WL(); combine_rows(a, lds, vcu, G, w_, l_); }
    SEAM(11);
    if constexpr (IN(12)) {
        { pg8::DenseSched S; S.o.init(T / 256, D / 256, G, bx); S.Bt = (const char*)(ws + WS_WPG); S.K = D; S.es = 1;
          pg8::EpiBf16<1, false, true> E{(bf16_t*)(ws + WS_PGATE), D, nullptr, 0, 1.0f / 32.0f};
          pg8::gemm_phase(lds, (const char*)(ws + WS_H), D, D, D, S, E); }
    }
    SEAM(12);
    if constexpr (IN(13)) { FRESH_WL(); final_rows(a, vcu, G, w_, l_); }
#undef FRESH_WL
#undef IN
#undef SEAM
#undef GRID_BAR
}

template <int LO, int HI> static void launch_range(const Args& a, int grid, hipStream_t stream) {
    static bool attr = false;
    if (!attr) { attr = true; if (hipFuncSetAttribute((const void*)hybrid_fwd<LO, HI>, hipFuncAttributeMaxDynamicSharedMemorySize, LDS_BYTES) != hipSuccess) fprintf(stderr, "kernel_launch: hipFuncSetAttribute failed\n"); }
    hipLaunchKernelGGL((hybrid_fwd<LO, HI>), dim3(grid), dim3(NTHREADS), LDS_BYTES, stream, a);
}
extern "C" void kernel_launch(void* const* d_in, const int* in_sizes, int n_in, void* d_out, int out_size, void* d_ws, size_t ws_size, hipStream_t stream) {
    static int grid = 0;
    if (grid == 0) {
        static const int expect[25] = {T * D, T * 256, 256, 1024, 1024 * D_IN, 16 * 512, 512, 256, 1048576, 1048576, 1048576, 1024, 32768, 32, 33554432, 32768, 33554432, 32768, 33554432, 32768, 1024, 1048576, 262144, 1024, 1024};
        bool okk = (n_in == 25);
        for (int i = 0; okk && i < 25; ++i) if (in_sizes[i] != expect[i]) { fprintf(stderr, "kernel_launch: input %d has %d elements, expected %d\n", i, in_sizes[i], expect[i]); okk = false; }
        if (!okk || out_size != T * D || ws_size < WS_END) { fprintf(stderr, "kernel_launch: unexpected shapes (n_in %d, in0 %d, out %d, ws %zu); nothing launched\n", n_in, n_in > 0 ? in_sizes[0] : -1, out_size, ws_size); grid = -1; return; }
        int dev = 0, cus = 0;
        if (hipGetDevice(&dev) != hipSuccess || hipDeviceGetAttribute(&cus, hipDeviceAttributeMultiprocessorCount, dev) != hipSuccess) { grid = -1; return; }
        grid = cus;
    }
    if (grid < 0) return;
    (void)hipMemsetAsync((char*)d_ws + WS_CTL, 0, CTL_ZERO_BYTES, stream);
    Args a{};
    for (int i = 0; i < 25; ++i) a.p.in[i] = (const float*)d_in[i];
    a.p.out = (float*)d_out; a.p.ws = (unsigned char*)d_ws;
#if MK_PER_PHASE
#ifndef MK_LAST
#define MK_LAST 13
#endif
#ifndef MK_REPEAT
#define MK_REPEAT 0
#endif
#define LR(k) do { if ((k) <= MK_LAST) for (int r_ = 0; r_ < 1 + ((MK_REPEAT >> (k)) & 1); ++r_) launch_range<(k), (k) + 1>(a, grid, stream); } while (0)
    LR(0); LR(1); LR(2); LR(3); LR(4); LR(5); LR(6); LR(7); LR(8); LR(9); LR(10); LR(11); LR(12); LR(13);
#undef LR
#else
    launch_range<0, NPHASES>(a, grid, stream);
#endif
}
```

```cpp
#include <hip/hip_runtime.h>
#include <cstdio>
#include <cstdint>

#define LAS __attribute__((address_space(3)))
#define GAS __attribute__((address_space(1)))
typedef unsigned short bf16_t;
typedef short bf16x8 __attribute__((ext_vector_type(8)));
typedef short s16x4 __attribute__((ext_vector_type(4)));
typedef float f32x2 __attribute__((ext_vector_type(2)));
typedef float f32x4 __attribute__((ext_vector_type(4)));
typedef float f32x16 __attribute__((ext_vector_type(16)));
typedef unsigned u32x2 __attribute__((ext_vector_type(2)));
typedef unsigned u32x4 __attribute__((ext_vector_type(4)));
typedef int i32x4 __attribute__((ext_vector_type(4)));
typedef int i32x8 __attribute__((ext_vector_type(8)));
typedef GAS unsigned gu32;
#define RLX_AGENT __ATOMIC_RELAXED, __HIP_MEMORY_SCOPE_AGENT
#define LDS_WAIT() asm volatile("s_waitcnt lgkmcnt(0)" ::: "memory")
#define VM_WAIT() asm volatile("s_waitcnt vmcnt(0)" ::: "memory")

#ifndef MK_PER_PHASE
#define MK_PER_PHASE 0
#endif

constexpr int NB = 8, SEQ = 2048, T = NB * SEQ, D = 1024;
constexpr int NPROJ = 8192;
constexpr int C_QA = 0, C_KA = 512, C_VA = 1024, C_RA = 2048, C_QB = 3072, C_KB = 4096, C_VB = 5120, C_GA = 6144, C_GB = 7168;
#define PROJ_BLK(cs) ((size_t)(cs) * T)
constexpr int SRC_ALOW = 3072, D_IN = 8208;
constexpr int NE = 32, FF = 1024, MAXTILES = 288, MAXROWS = MAXTILES * 256;
constexpr float EPS = 1e-6f;
constexpr int NWAVES = 8, NTHREADS = 512;
constexpr int NPHASES = 14;

constexpr size_t MiB = 1u << 20;
constexpr size_t WS_CTL = 0, CTL_ZERO_BYTES = 1 * MiB;
constexpr size_t WS_SMALL = 1 * MiB;
constexpr size_t WS_KMP   = WS_SMALL;
constexpr size_t WS_DEC   = WS_KMP + 512 * 1024;
constexpr size_t WS_TOPE  = WS_DEC + 512 * 1024;
constexpr size_t WS_WTS   = WS_TOPE + 256 * 1024;
constexpr size_t WS_SLOT  = WS_WTS + 256 * 1024;
constexpr size_t WS_DEST  = WS_SLOT + 256 * 1024;
constexpr size_t WS_ROWTOK = WS_DEST + 256 * 1024;
constexpr size_t WS_RSTDS = WS_ROWTOK + 320 * 1024;
constexpr size_t WS_RSTD  = WS_RSTDS + 320 * 1024;
constexpr size_t WS_TILEE = WS_RSTD + 64 * 1024;
constexpr size_t WS_WALT  = WS_TILEE + 4 * 1024;
constexpr size_t WS_WRF   = WS_WALT + 32 * 1024;
static_assert(WS_WRF + 128 * 1024 <= 6 * MiB, "small map");
constexpr size_t WS_WO = 6 * MiB, WS_WPG = 8 * MiB, WS_WPP = 10 * MiB, WS_WUP = 12 * MiB, WS_WIN = 16 * MiB;
constexpr size_t WS_PB = 34 * MiB;
constexpr size_t WS_H  = 42 * MiB;
constexpr size_t WS_PROJ = 74 * MiB;
constexpr size_t WS_QG = 330 * MiB, WS_KG = 346 * MiB;
constexpr size_t WS_SLOC = 426 * MiB;
constexpr size_t WS_OAB = 362 * MiB;
constexpr size_t WS_H8 = 426 * MiB;
constexpr size_t WS_WIN8 = 442 * MiB;
constexpr size_t WS_Y = 330 * MiB;
constexpr size_t WS_W2T = 42 * MiB;
constexpr size_t WS_A2 = 330 * MiB;
constexpr size_t WS_HMID = 138 * MiB;
constexpr size_t WS_X1 = 74 * MiB;
constexpr size_t WS_X2 = 138 * MiB;
constexpr size_t WS_YROWS = 282 * MiB;
constexpr size_t WS_PGATE = 330 * MiB, WS_PPROJ = 226 * MiB;
constexpr size_t WS_ROWE = 490 * MiB;
constexpr size_t WS_RSTE = 492 * MiB;
constexpr size_t WS_END = 506 * MiB;

constexpr int CW_BAR = 4096;
constexpr int CW_COUNTS = 16384;
constexpr int CW_QUEUE = 16384 + 64;

constexpr int RING_BYTES = 131072;
constexpr int LDSCTL_OFF = RING_BYTES, MISC_OFF = LDSCTL_OFF + 320;
constexpr int LDS_MOE = LDSCTL_OFF + 10240;
constexpr int EPF_OFF = LDSCTL_OFF + 12288;
constexpr int LDS_BYTES = 151552;

typedef __bf16 bf16v2_t __attribute__((ext_vector_type(2)));
__device__ __forceinline__ unsigned cvt_pk_bf16(float lo, float hi) { const f32x2 v = {lo, hi}; return __builtin_bit_cast(unsigned, __builtin_convertvector(v, bf16v2_t)); }
__device__ __forceinline__ unsigned pk4_fp8(float a, float b, float c, float d) { int w = 0; w = __builtin_amdgcn_cvt_pk_fp8_f32(a, b, w, false); w = __builtin_amdgcn_cvt_pk_fp8_f32(c, d, w, true); return (unsigned)w; }
__device__ __forceinline__ float bf2f(unsigned short s) { return __uint_as_float(((unsigned)s) << 16); }
__device__ __forceinline__ float bflo(unsigned w) { return __uint_as_float(w << 16); }
__device__ __forceinline__ float bfhi(unsigned w) { return __uint_as_float(w & 0xffff0000u); }
__device__ __forceinline__ float fsigmoid(float x) { return __builtin_amdgcn_rcpf(1.0f + __builtin_amdgcn_exp2f(-1.4426950408889634f * x)); }
__device__ __forceinline__ float wave_sum(float v) {
#pragma unroll
    for (int o = 1; o < 64; o <<= 1) v += __shfl_xor(v, o);
    return v;
}
__device__ __forceinline__ bf16x8 pack8(f32x4 a, f32x4 b) {
    u32x4 w = {cvt_pk_bf16(a[0], a[1]), cvt_pk_bf16(a[2], a[3]), cvt_pk_bf16(b[0], b[1]), cvt_pk_bf16(b[2], b[3])};
    return __builtin_bit_cast(bf16x8, w);
}

#define XB_TMO      128
#define XB_XCNT(j)  (256  + 64 * (j))
#define XB_XSUB(j)  (1280 + 64 * (j))
#define XB_XGEN(j)  (2304 + 64 * (j))
#define XB_TOP      3328
#define XB_TOPGEN   3392
#define XCD_BAR_WORDS 3456
#define XB_SPIN_CAP (1u << 18)

__device__ __forceinline__ unsigned xb_ld(unsigned* p)              { return __hip_atomic_load(p, __ATOMIC_RELAXED, __HIP_MEMORY_SCOPE_AGENT); }
__device__ __forceinline__ unsigned xb_add(unsigned* p, unsigned v) { return __hip_atomic_fetch_add(p, v, __ATOMIC_RELAXED, __HIP_MEMORY_SCOPE_AGENT); }
__device__ __forceinline__ unsigned xb_xcc_id() { return (unsigned)__builtin_amdgcn_s_getreg((3 << 11) | 20) & 0xFu; }
#define XB_SPIN(cond, bar) do { unsigned _sp = 0; while (cond) { __builtin_amdgcn_s_sleep(1); \
    if ((++_sp & 255u) == 0u) { if (xb_ld(&(bar)[XB_TMO])) break; if (_sp > XB_SPIN_CAP) { atomicAdd(&(bar)[XB_TMO], 1u); break; } } } } while (0)

struct XcdBarrier { unsigned* bar; unsigned x; volatile LAS unsigned* st; };

__device__ __forceinline__ XcdBarrier xcd_barrier_post(unsigned* bar, volatile LAS unsigned* st) {
    XcdBarrier b; b.bar = bar; b.x = xb_xcc_id(); b.st = st;
    if (threadIdx.x == 0) (void)xb_add(&bar[XB_XCNT(b.x)], 1u);
    return b;
}
__device__ __forceinline__ void xcd_barrier_complete(unsigned* bar, unsigned x, unsigned& nloc, unsigned& nx) {
    const unsigned G = gridDim.x * gridDim.y * gridDim.z;
    unsigned sum, cnt, mine, sp = 0u;
    for (;;) {
        sum = 0u; cnt = 0u; mine = 0u;
#pragma unroll
        for (unsigned j = 0; j < 16; ++j) { const unsigned c = xb_ld(&bar[XB_XCNT(j)]); sum += c; cnt += (c > 0u) ? 1u : 0u; mine = (j == x) ? c : mine; }
        if (sum == G) break;
        __builtin_amdgcn_s_sleep(1);
        if ((++sp & 255u) == 0u) { if (xb_ld(&bar[XB_TMO])) break; if (sp > XB_SPIN_CAP) { atomicAdd(&bar[XB_TMO], 1u); break; } }
    }
    nloc = mine > 0u ? mine : 1u; nx = cnt > 0u ? cnt : 1u;
}
__device__ __forceinline__ void xcd_barrier(const XcdBarrier& b) {
    asm volatile("s_waitcnt vmcnt(0)" ::: "memory");
    __syncthreads();
    if (threadIdx.x == 0) {
        unsigned* bar = b.bar;
        __builtin_amdgcn_s_waitcnt(0);
        unsigned nloc = b.st[0], nx = b.st[1];
        if (nloc == 0u) { xcd_barrier_complete(bar, b.x, nloc, nx); b.st[0] = nloc; b.st[1] = nx; }
        const unsigned old = xb_add(&bar[XB_XSUB(b.x)], 1u);
        const unsigned gen = old / nloc;
        if (old + 1u == (gen + 1u) * nloc) {
            __builtin_amdgcn_fence(__ATOMIC_RELEASE, "agent");
            asm volatile("s_waitcnt vmcnt(0)" ::: "memory");
            const unsigned og = xb_add(&bar[XB_TOP], 1u);
            const unsigned tg = og / nx;
            if (og + 1u == (tg + 1u) * nx) xb_add(&bar[XB_TOPGEN], 1u);
            else XB_SPIN(xb_ld(&bar[XB_TOPGEN]) == tg, bar);
            __builtin_amdgcn_fence(__ATOMIC_ACQUIRE, "agent");
            xb_add(&bar[XB_XGEN(b.x)], 1u);
            asm volatile("s_waitcnt vmcnt(0)" ::: "memory");
        } else {
            XB_SPIN(xb_ld(&bar[XB_XGEN(b.x)]) == gen, bar);
            __builtin_amdgcn_fence(__ATOMIC_ACQUIRE, "agent");
            asm volatile("s_waitcnt vmcnt(0)" ::: "memory");
        }
    }
    __syncthreads();
}
#ifndef MK_SCL
#define MK_SCL 0
#endif
namespace pg8 {
constexpr int BM = 256, BK = 64, HALF = 128, HTB = HALF * BK * 2, STAGE_BYTES = 8 * HTB, NXCD = 8, WGM = 8;

__host__ __device__ __forceinline__ int lds_byte(int r, int c) { const int st = (r >> 4) * 2 + (c >> 5), rr = r & 15, cc = c & 31, ob = rr * 64 + cc * 2; return st * 1024 + (ob ^ (((ob >> 9) & 1) << 5)); }
__host__ __device__ __forceinline__ void stage_rc(int b, int& R, int& C) { const int st = b / 1024, sb = b % 1024, swz = sb ^ (((sb >> 9) & 1) << 5); R = (st >> 1) * 16 + swz / 64; C = (st & 1) * 32 + (swz % 64) / 2; }
__host__ __device__ __forceinline__ int perm32(int rho) { const int n = rho >> 4, i = rho & 15; return 8 * (i >> 2) + 4 * n + (i & 3); }

struct Unit { int pm, pn, e, s; };

struct TileOrder {
    int nM, nN, nwg, G, c;
    __device__ __forceinline__ void init(int nM_, int nN_, int G_, int c_) { nM = nM_; nN = nN_; nwg = nM * nN; G = G_; c = c_; }
    __device__ __forceinline__ bool next(int i, int& pm, int& pn) const {
        const unsigned L = (unsigned)i * (unsigned)G + (unsigned)c; if (L >= (unsigned)nwg) return false;
        int wgid = (int)L; { const int q = nwg / NXCD, r = nwg % NXCD, xcd = wgid % NXCD, off = wgid / NXCD; wgid = (xcd < r ? xcd * (q + 1) : r * (q + 1) + (xcd - r) * q) + off; }
        const int nig = WGM * nN, gid = wgid / nig, fm = gid * WGM, gsz = (nM - fm) < WGM ? (nM - fm) : WGM;
        pm = fm + ((wgid % nig) % gsz); pn = (wgid % nig) / gsz; return true;
    }
};
struct DenseSched {
    TileOrder o; const char* Bt; int K; int es = 2; int gap_at = 1 << 30, gap_by = 0, pn0 = 0; bool bt_out = true;
    __device__ __forceinline__ bool next(int i, Unit& u) const { int p; if (!o.next(i, u.pm, p)) return false; u.e = p; u.pn = p + (p >= gap_at ? gap_by : 0) + pn0; return true; }
    __device__ __forceinline__ unsigned a_row(const Unit& u, int r) const { return (unsigned)(u.pm * BM + r); }
    __device__ __forceinline__ unsigned a_koff(const Unit&) const { return 0u; }
    __device__ __forceinline__ const char* b_base(const Unit& u) const { return Bt + (size_t)(bt_out ? u.pn : u.e) * BM * K * es; }
};
struct ChainSched {
    TileOrder o; const char* Bt; int K;
    __device__ __forceinline__ bool next(int i, Unit& u) const { if (!o.next(i >> 1, u.pm, u.pn)) return false; u.e = i & 1; return true; }
    __device__ __forceinline__ unsigned a_row(const Unit& u, int r) const { return (unsigned)(u.pm * BM + r); }
    __device__ __forceinline__ unsigned a_koff(const Unit& u) const { return (unsigned)(u.e * K * 2); }
    __device__ __forceinline__ const char* b_base(const Unit& u) const { return Bt + (size_t)u.pn * BM * (2 * K) * 2 + (size_t)u.e * K * 2; }
};
template <bool GATHER> struct MoeSched {
    TileOrder o; const char* Bt; int K; int rows_per_e; const LAS int* tab; const int* row_e; int es;
    __device__ __forceinline__ bool next(int i, Unit& u) const { if (!o.next(i, u.pm, u.pn)) return false; u.e = __builtin_amdgcn_readfirstlane(tab[128 + u.pm]); return true; }
    __device__ __forceinline__ unsigned a_row(const Unit& u, int r) const {
        if (GATHER) { const int lr = u.pm * BM + r - tab[u.e]; return lr < tab[64 + u.e] ? (unsigned)row_e[(size_t)u.e * T + lr] : 0u; }
        else return (unsigned)(u.pm * BM + r); }
    __device__ __forceinline__ unsigned a_koff(const Unit&) const { return 0u; }
    __device__ __forceinline__ const char* b_base(const Unit& u) const { return Bt + ((size_t)u.e * rows_per_e + (size_t)u.pn * BM) * K * es; }
};

template <class Epi, class Sched>
__device__ __forceinline__ void gemm_phase(LAS unsigned char* lds, const char* gA, int K_, int lda, int ldb, const Sched& S, const Epi& E) {
    int K = K_; asm volatile("" : "+s"(K));
    int tid = threadIdx.x; asm volatile("" : "+v"(tid));     const int wid = __builtin_amdgcn_readfirstlane(tid >> 6), lane = tid & 63, wr = wid >> 2, wc = wid & 3, fr = lane & 15, fq = lane >> 4;
    constexpr int ES = Epi::F8 ? 1 : 2;
    const int nt = K * ES / 128;
    unsigned voffB[2];
#pragma unroll
    for (int i = 0; i < 2; ++i) { int R, C; stage_rc(tid * 16 + i * 8192, R, C); const int Rb = Epi::PERM ? ((R & ~31) + perm32(R & 31)) : R; voffB[i] = (unsigned)(Rb * ldb * ES + C * 2); }
    const unsigned kstep = (unsigned)(BK * 2);
    const size_t hstepB = (size_t)HALF * ldb * ES;
    const unsigned ldab = (unsigned)lda * ES;
    const unsigned ldsw = (unsigned)wid * 1024u;
    const int aoff = lds_byte(wr * 64 + fr, fq * 8), boff = lds_byte(wc * 32 + fr, fq * 8);
#define PG8_SA(b, h) (((b) * 2 + (h)) * HTB)
#define PG8_SB(b, h) ((4 + (b) * 2 + (h)) * HTB)
#define PG8_STAGE_B(bufoff, gbase) do { _Pragma("unroll") for (int _i = 0; _i < 2; ++_i) \
        __builtin_amdgcn_global_load_lds((const unsigned*)((const char*)(gbase) + voffB[_i]), (LAS unsigned*)(lds + (bufoff) + ldsw + _i * 8192), 16, 0, 0); } while (0)
#define PG8_STAGE_A(bufoff, o0, o1, kb) do { \
        const char* gk_ = gA + (kb);      \
        __builtin_amdgcn_global_load_lds((const unsigned*)(gk_ + (o0)), (LAS unsigned*)(lds + (bufoff) + ldsw), 16, 0, 0); \
        __builtin_amdgcn_global_load_lds((const unsigned*)(gk_ + (o1)), (LAS unsigned*)(lds + (bufoff) + ldsw + 8192), 16, 0, 0); } while (0)
#define PG8_LDA(dst, b, h) do { _Pragma("unroll") for (int m = 0; m < 4; ++m) _Pragma("unroll") for (int k = 0; k < 2; ++k) dst[m][k] = *(const LAS bf16x8*)(lds + PG8_SA(b, h) + aoff + m * 2048 + k * 1024); } while (0)
#define PG8_LDB(dst, b, h) do { _Pragma("unroll") for (int n = 0; n < 2; ++n) _Pragma("unroll") for (int k = 0; k < 2; ++k) dst[n][k] = *(const LAS bf16x8*)(lds + PG8_SB(b, h) + boff + n * 2048 + k * 1024); } while (0)
#define PG8_MMA(ai, bj, At, Bt) do { __builtin_amdgcn_s_setprio(1); \
        if constexpr (Epi::F8) { _Pragma("unroll") for (int m = 0; m < 4; ++m) _Pragma("unroll") for (int n = 0; n < 2; ++n) { \
            const i32x8 a8_ = __builtin_shufflevector(__builtin_bit_cast(i32x4, At[m][0]), __builtin_bit_cast(i32x4, At[m][1]), 0, 1, 2, 3, 4, 5, 6, 7); \
            const i32x8 b8_ = __builtin_shufflevector(__builtin_bit_cast(i32x4, Bt[n][0]), __builtin_bit_cast(i32x4, Bt[n][1]), 0, 1, 2, 3, 4, 5, 6, 7); \
            acc[ai][bj][m][n] = __builtin_amdgcn_mfma_scale_f32_16x16x128_f8f6f4(b8_, a8_, acc[ai][bj][m][n], 0, 0, 0, MK_SCL, 0, MK_SCL); } } \
        else { _Pragma("unroll") for (int m = 0; m < 4; ++m) _Pragma("unroll") for (int n = 0; n < 2; ++n) _Pragma("unroll") for (int k = 0; k < 2; ++k) \
            acc[ai][bj][m][n] = __builtin_amdgcn_mfma_f32_16x16x32_bf16(Bt[n][k], At[m][k], acc[ai][bj][m][n], 0, 0, 0); } \
        __builtin_amdgcn_s_setprio(0); } while (0)
#define PG8_WAIT_V(n) asm volatile("s_waitcnt vmcnt(" #n ")" ::: "memory")
#define PG8_WAIT_L(n) asm volatile("s_waitcnt lgkmcnt(" #n ")" ::: "memory")
#define PG8_BAR __builtin_amdgcn_s_barrier()
#define PG8_SCHED __builtin_amdgcn_sched_barrier(0)
#define PG8_AOFFS(dst, u) do { int t_ = threadIdx.x; asm volatile("" : "+v"(t_));     \
        _Pragma("unroll") for (int _h = 0; _h < 2; ++_h) _Pragma("unroll") for (int _i = 0; _i < 2; ++_i) { int R_, C_; stage_rc(t_ * 16 + _i * 8192, R_, C_); \
        dst[_h][_i] = S.a_row(u, _h * HALF + R_) * ldab + (unsigned)C_ * 2u + S.a_koff(u); } } while (0)
    Unit cur, nxt; int ui = 0;
    if (!S.next(0, cur)) return;
    cur.s = 0;
    if constexpr (Epi::PREF) E.prefetch(cur, 0);
#ifdef MK_STAGGER
    if (S.o.nwg > 3 * S.o.G) {
        const unsigned long long t0_ = __builtin_amdgcn_s_memrealtime(); const unsigned long long d_ = (unsigned long long)((blockIdx.x >> 3) & 7) * MK_STAGGER;
        while (__builtin_amdgcn_s_memrealtime() - t0_ < d_) __builtin_amdgcn_s_sleep(4);
    }
#endif
    f32x4 acc[2][2][4][2];
#pragma unroll
    for (int a = 0; a < 2; ++a)
#pragma unroll
        for (int b = 0; b < 2; ++b)
#pragma unroll
            for (int m = 0; m < 4; ++m)
#pragma unroll
                for (int n = 0; n < 2; ++n) acc[a][b][m][n] = (f32x4){0.f, 0.f, 0.f, 0.f};
    bf16x8 At[4][2], B0[2][2], B1[2][2];
    unsigned oc[2][2];
    LAS u32x4* nslot = (LAS u32x4*)(lds + LDSCTL_OFF + 2048) + tid;
    PG8_AOFFS(oc, cur);
    const char* cB = S.b_base(cur);
    PG8_STAGE_B(PG8_SB(0, 0), cB); PG8_STAGE_B(PG8_SB(0, 1), cB + hstepB); PG8_STAGE_A(PG8_SA(0, 0), oc[0][0], oc[0][1], 0u); PG8_STAGE_A(PG8_SA(0, 1), oc[1][0], oc[1][1], 0u);
    if (wr == 1) PG8_BAR;
    PG8_WAIT_V(2); PG8_BAR;
    PG8_STAGE_B(PG8_SB(1, 0), cB + kstep); PG8_STAGE_A(PG8_SA(1, 0), oc[0][0], oc[0][1], kstep); PG8_STAGE_B(PG8_SB(1, 1), cB + hstepB + kstep);
    PG8_WAIT_V(6); PG8_BAR;
    for (;;) {
        const bool has_next = S.next(ui + 1, nxt);
        const char* nB = has_next ? S.b_base(nxt) : cB;
        if (has_next) { unsigned on[2][2]; PG8_AOFFS(on, nxt); *nslot = (u32x4){on[0][0], on[0][1], on[1][0], on[1][1]}; nxt.s = cur.s == 2 ? 0 : cur.s + 1;
            if constexpr (Epi::PREF) E.prefetch(nxt, nxt.s); }
        for (int t = 0; t < nt; t += 2) {
            const bool last = (t == nt - 2);
            const unsigned k1 = (unsigned)(t + 1) * kstep;
            const unsigned k2 = last ? 0u : (unsigned)(t + 2) * kstep, k3 = k2 + kstep;
            const char* b2 = last ? nB : cB + (size_t)(t + 2) * kstep; const char* b3 = b2 + kstep;
            PG8_LDB(B0, 0, 0); PG8_LDB(B1, 0, 1); PG8_SCHED; PG8_LDA(At, 0, 0); PG8_STAGE_A(PG8_SA(1, 1), oc[1][0], oc[1][1], k1);
            PG8_WAIT_V(8); PG8_WAIT_L(0); PG8_BAR; PG8_MMA(0, 0, At, B0); PG8_MMA(0, 1, At, B1); PG8_BAR; PG8_SCHED;
            if (last && has_next) { const u32x4 o_ = *nslot; oc[0][0] = o_.x; oc[0][1] = o_.y; oc[1][0] = o_.z; oc[1][1] = o_.w; }
            PG8_LDA(At, 0, 1); PG8_STAGE_B(PG8_SB(0, 0), b2); PG8_STAGE_B(PG8_SB(0, 1), b2 + hstepB); PG8_STAGE_A(PG8_SA(0, 0), oc[0][0], oc[0][1], k2);
            PG8_WAIT_V(8); PG8_WAIT_L(0); PG8_BAR; PG8_MMA(1, 0, At, B0); PG8_MMA(1, 1, At, B1); PG8_BAR; PG8_SCHED;
            PG8_LDB(B0, 1, 0); PG8_LDB(B1, 1, 1); PG8_SCHED; PG8_LDA(At, 1, 0); PG8_STAGE_A(PG8_SA(0, 1), oc[1][0], oc[1][1], k2);
            PG8_WAIT_V(8); PG8_WAIT_L(0); PG8_BAR; PG8_MMA(0, 0, At, B0); PG8_MMA(0, 1, At, B1); PG8_BAR; PG8_SCHED;
            PG8_LDA(At, 1, 1); PG8_STAGE_B(PG8_SB(1, 0), b3); PG8_STAGE_B(PG8_SB(1, 1), b3 + hstepB); PG8_STAGE_A(PG8_SA(1, 0), oc[0][0], oc[0][1], k3);
            PG8_WAIT_V(8); PG8_WAIT_L(0); PG8_BAR; PG8_MMA(1, 0, At, B0); PG8_MMA(1, 1, At, B1); PG8_BAR; PG8_SCHED;
        }
        if (wr == 0) PG8_BAR;
        bool carry = false;
        if constexpr (Epi::MIDK) { if (cur.e == 0) { E.mid(acc, cur, wr, wc, fr, fq); carry = true; } else E(acc, cur, wr, wc, fr, fq); } else E(acc, cur, wr, wc, fr, fq);
        if (!has_next) break;
        if (!carry)
#pragma unroll
        for (int a = 0; a < 2; ++a)
#pragma unroll
            for (int b = 0; b < 2; ++b)
#pragma unroll
                for (int m = 0; m < 4; ++m)
#pragma unroll
                    for (int n = 0; n < 2; ++n) acc[a][b][m][n] = (f32x4){0.f, 0.f, 0.f, 0.f};
        cur = nxt; cB = nB; ++ui;
        if (wr == 1) PG8_BAR;
    }
    PG8_WAIT_V(0);
    PG8_BAR;
#undef PG8_SA
#undef PG8_SB
#undef PG8_STAGE_A
#undef PG8_STAGE_B
#undef PG8_LDA
#undef PG8_LDB
#undef PG8_MMA
#undef PG8_WAIT_V
#undef PG8_WAIT_L
#undef PG8_BAR
#undef PG8_SCHED
#undef PG8_AOFFS
}

template <bool F8_> struct EpiProj {
    static constexpr bool PREF = false, PERM = true, MIDK = false, F8 = F8_;
    bf16_t* O; float* kmp;
    __device__ __forceinline__ void operator()(const f32x4 (&acc)[2][2][4][2], const Unit& u, int wr, int wc, int fr, int fq) const {
        const int row0 = u.pm * BM + wr * 64 + fr;
        const bool narrow = (u.pn < C_VA / BM) || (u.pn >= C_QB / BM && u.pn < C_GA / BM);
        const bool gate = u.pn >= C_GA / BM;
        const int hw = narrow ? 128 : 256; const size_t bjs = narrow ? (size_t)HALF * T : (size_t)HALF;
#pragma unroll
        for (int ai = 0; ai < 2; ++ai)
#pragma unroll
            for (int m = 0; m < 4; ++m) { bf16_t* rowp = O + PROJ_BLK(u.pn * BM) + (size_t)(row0 + ai * HALF + m * 16) * hw + wc * 32 + 8 * fq;
#pragma unroll
                for (int bj = 0; bj < 2; ++bj) { const float sc = F8 ? (1.0f / 32.0f) : 1.0f; const f32x4 v0 = acc[ai][bj][m][0] * sc, v1 = acc[ai][bj][m][1] * sc;
                    if (F8 && gate) { u32x2 w8; w8.x = pk4_fp8(v0[0], v0[1], v0[2], v0[3]); w8.y = pk4_fp8(v1[0], v1[1], v1[2], v1[3]);
                        __builtin_nontemporal_store(w8, (u32x2*)((unsigned char*)(O + PROJ_BLK(u.pn * BM)) + (size_t)(row0 + ai * HALF + m * 16) * 256 + bj * HALF + wc * 32 + 8 * fq)); continue; }
                    u32x4 w; w.x = cvt_pk_bf16(v0[0], v0[1]); w.y = cvt_pk_bf16(v0[2], v0[3]); w.z = cvt_pk_bf16(v1[0], v1[1]); w.w = cvt_pk_bf16(v1[2], v1[3]);
                    __builtin_nontemporal_store(w, (u32x4*)(rowp + bj * bjs)); } }
        if (u.pn >= C_KB / BM && u.pn < C_VB / BM) {
#pragma unroll
            for (int bj = 0; bj < 2; ++bj)
#pragma unroll
                for (int n = 0; n < 2; ++n) { f32x4 s = (f32x4){0.f, 0.f, 0.f, 0.f};
#pragma unroll
                    for (int ai = 0; ai < 2; ++ai)
#pragma unroll
                        for (int m = 0; m < 4; ++m) s += acc[ai][bj][m][n];
#pragma unroll
                    for (int o = 1; o < 16; o <<= 1) { s[0] += __shfl_xor(s[0], o); s[1] += __shfl_xor(s[1], o); s[2] += __shfl_xor(s[2], o); s[3] += __shfl_xor(s[3], o); }
                    if (fr == 0) *(f32x4*)(kmp + ((size_t)wr * 64 + u.pm) * 1024 + (u.pn - C_KB / BM) * BM + bj * HALF + wc * 32 + 8 * fq + 4 * n) = s * (F8 ? (1.0f / 32.0f) : 1.0f); }
        }
    }
};
struct EpiMerge {
    static constexpr bool PREF = false, PERM = true, MIDK = true, F8 = false;
    const bf16_t* proj; bf16_t* Y;
    __device__ __forceinline__ void mid(f32x4 (&acc)[2][2][4][2], const Unit& u, int wr, int wc, int fr, int fq) const {
        const int row0 = u.pm * BM + wr * 64 + fr; const int col0 = u.pn * BM + wc * 32 + 8 * fq;
#pragma unroll
        for (int ai = 0; ai < 2; ++ai) {
            u32x2 ga[4][2], gb[4][2];
#pragma unroll
            for (int m = 0; m < 4; ++m) { const unsigned char* rowp = (const unsigned char*)(proj + PROJ_BLK(u.pn * BM)) + (size_t)(row0 + ai * HALF + m * 16) * 256 + wc * 32 + 8 * fq;
#pragma unroll
                for (int bj = 0; bj < 2; ++bj) { ga[m][bj] = *(const u32x2*)(rowp + 2 * PROJ_BLK(C_GA) + bj * HALF); gb[m][bj] = *(const u32x2*)(rowp + 2 * PROJ_BLK(C_GB) + bj * HALF); } }
#pragma unroll
            for (int m = 0; m < 4; ++m) {
#pragma unroll
                for (int bj = 0; bj < 2; ++bj) {
#pragma unroll
                    for (int n = 0; n < 2; ++n) {
#define MG_R(b_) ((1.0f + __builtin_amdgcn_exp2f(-1.4426950408889634f * __builtin_amdgcn_cvt_f32_fp8((int)gb[m][bj][n], b_))) * __builtin_amdgcn_rcpf(1.0f + __builtin_amdgcn_exp2f(-1.4426950408889634f * __builtin_amdgcn_cvt_f32_fp8((int)ga[m][bj][n], b_))))
                        acc[ai][bj][m][n][0] *= MG_R(0); acc[ai][bj][m][n][1] *= MG_R(1); acc[ai][bj][m][n][2] *= MG_R(2); acc[ai][bj][m][n][3] *= MG_R(3);
#undef MG_R
                    } }
                asm volatile("" : "+v"(acc[ai][0][m][0]), "+v"(acc[ai][0][m][1]), "+v"(acc[ai][1][m][0]), "+v"(acc[ai][1][m][1])); }
            asm volatile("" ::: "memory"); }
    }
    __device__ __forceinline__ void operator()(const f32x4 (&acc)[2][2][4][2], const Unit& u, int wr, int wc, int fr, int fq) const {
        const int row0 = u.pm * BM + wr * 64 + fr; const int col0 = u.pn * BM + wc * 32 + 8 * fq;
#pragma unroll
        for (int ai = 0; ai < 2; ++ai) {
            u32x2 gb[4][2];
#pragma unroll
            for (int m = 0; m < 4; ++m)
#pragma unroll
                for (int bj = 0; bj < 2; ++bj) gb[m][bj] = *(const u32x2*)((const unsigned char*)(proj + PROJ_BLK(C_GB + u.pn * BM)) + (size_t)(row0 + ai * HALF + m * 16) * 256 + wc * 32 + 8 * fq + bj * HALF);
#pragma unroll
            for (int m = 0; m < 4; ++m) { const size_t r = (size_t)(row0 + ai * HALF + m * 16);
#pragma unroll
                for (int bj = 0; bj < 2; ++bj) { const u32x2 g = gb[m][bj];
                    const f32x4 v0 = acc[ai][bj][m][0], v1 = acc[ai][bj][m][1];
#define MG_S(w_, b_) fsigmoid(__builtin_amdgcn_cvt_f32_fp8((int)(w_), b_))
                    u32x4 w; w.x = cvt_pk_bf16(v0[0] * MG_S(g.x, 0), v0[1] * MG_S(g.x, 1)); w.y = cvt_pk_bf16(v0[2] * MG_S(g.x, 2), v0[3] * MG_S(g.x, 3));
                    w.z = cvt_pk_bf16(v1[0] * MG_S(g.y, 0), v1[1] * MG_S(g.y, 1)); w.w = cvt_pk_bf16(v1[2] * MG_S(g.y, 2), v1[3] * MG_S(g.y, 3));
#undef MG_S
                    *(u32x4*)(Y + r * D + col0 + bj * HALF) = w; } }
            asm volatile("" ::: "memory"); }
    }
};
struct EpiResF32 {
    static constexpr bool PREF = false, PERM = false, MIDK = false, F8 = false;
    const float* base; bf16_t* out;
    __device__ __forceinline__ void operator()(const f32x4 (&acc)[2][2][4][2], const Unit& u, int wr, int wc, int fr, int fq) const {
        const int row0 = u.pm * BM + wr * 64 + fr, col0 = u.pn * BM + wc * 32 + 4 * fq;
#pragma unroll
        for (int ai = 0; ai < 2; ++ai) {
            f32x4 bs[4][2][2];
#pragma unroll
            for (int m = 0; m < 4; ++m) { const size_t off = (size_t)(row0 + ai * HALF + m * 16) * D + col0;
#pragma unroll
                for (int bj = 0; bj < 2; ++bj)
#pragma unroll
                    for (int n = 0; n < 2; ++n) bs[m][bj][n] = __builtin_nontemporal_load((const f32x4*)(base + off + bj * HALF + n * 16)); }
#pragma unroll
            for (int m = 0; m < 4; ++m) { const size_t off = (size_t)(row0 + ai * HALF + m * 16) * D + col0;
#pragma unroll
                for (int bj = 0; bj < 2; ++bj)
#pragma unroll
                    for (int n = 0; n < 2; ++n) { const f32x4 v = bs[m][bj][n] + acc[ai][bj][m][n]; u32x2 w; w.x = cvt_pk_bf16(v[0], v[1]); w.y = cvt_pk_bf16(v[2], v[3]); *(u32x2*)(out + off + bj * HALF + n * 16) = w; } }
            asm volatile("" ::: "memory"); }
    }
};
struct EpiGlu {
    static constexpr bool PREF = true, PERM = true, MIDK = false, F8 = true;
    unsigned char* H; const float* rstd_e; const LAS int* tab; const float* bg; const float* bu; const float* zero; LAS unsigned char* lds;
    __device__ __forceinline__ void prefetch(const Unit& u, int slot) const {
        int tid = threadIdx.x; asm volatile("" : "+v"(tid)); const int wave = __builtin_amdgcn_readfirstlane(tid >> 6);
        const float* src;
        if (wave < 4) { const int lr = u.pm * BM + tid - tab[u.e]; src = lr < tab[64 + u.e] ? rstd_e + (size_t)u.e * T + lr : zero; }
        else { const int j = tid - 256; src = (j < 128 ? bg : bu) + (size_t)u.e * FF + u.pn * HALF + (j & 127); }
        __builtin_amdgcn_global_load_lds((const unsigned*)src, (LAS unsigned*)(lds + EPF_OFF + slot * 2048 + wave * 256), 4, 0, 0);
    }
    __device__ __forceinline__ void operator()(const f32x4 (&acc)[2][2][4][2], const Unit& u, int wr, int wc, int fr, int fq) const {
        const int row0 = u.pm * BM + wr * 64 + fr; const int colo = u.pn * HALF + wc * 32 + 8 * fq;
        const LAS float* ep = (const LAS float*)(lds + EPF_OFF + u.s * 2048);
        f32x4 g4[2], u4[2];
#pragma unroll
        for (int n = 0; n < 2; ++n) { g4[n] = *(const LAS f32x4*)(ep + 256 + wc * 32 + 8 * fq + 4 * n); u4[n] = *(const LAS f32x4*)(ep + 384 + wc * 32 + 8 * fq + 4 * n); }
        float rsv[2][4];
#pragma unroll
        for (int ai = 0; ai < 2; ++ai)
#pragma unroll
            for (int m = 0; m < 4; ++m) rsv[ai][m] = ep[wr * 64 + fr + ai * HALF + m * 16];
#pragma unroll
        for (int ai = 0; ai < 2; ++ai)
#pragma unroll
            for (int m = 0; m < 4; ++m) { const int r = row0 + ai * HALF + m * 16; const float rs = rsv[ai][m] * (1.0f / 32.0f);
                float o[8];
#pragma unroll
                for (int n = 0; n < 2; ++n)
#pragma unroll
                    for (int j = 0; j < 4; ++j) { float g = acc[ai][0][m][n][j] * rs + g4[n][j], up = acc[ai][1][m][n][j] * rs + u4[n][j];
                        g = fminf(g, 7.0f); up = fminf(fmaxf(up, -7.0f), 7.0f);
                        const float glu = g * fsigmoid(1.702f * g); o[n * 4 + j] = (up + 1.0f) * glu; }
                u32x2 w; w.x = pk4_fp8(o[0], o[1], o[2], o[3]); w.y = pk4_fp8(o[4], o[5], o[6], o[7]);
                *(u32x2*)(H + (size_t)r * FF + colo) = w; asm volatile("" ::: "memory"); }
    }
};
template <int ACT, bool HASBIAS, bool F8_ = false> struct EpiBf16 {
    static constexpr bool PREF = false, PERM = true, MIDK = false, F8 = F8_;
    bf16_t* O; int ldc; const float* bias; int bias_stride; float scale;
    __device__ __forceinline__ void operator()(const f32x4 (&acc)[2][2][4][2], const Unit& u, int wr, int wc, int fr, int fq) const {
        const int row0 = u.pm * BM + wr * 64 + fr; const int col0 = u.pn * BM + wc * 32 + 8 * fq;
        f32x4 bv[2][2];
#pragma unroll
        for (int bj = 0; bj < 2; ++bj)
#pragma unroll
            for (int n = 0; n < 2; ++n) bv[bj][n] = HASBIAS ? *(const f32x4*)(bias + (size_t)u.e * bias_stride + col0 + bj * HALF + 4 * n) : (f32x4){0.f, 0.f, 0.f, 0.f};
#pragma unroll
        for (int ai = 0; ai < 2; ++ai)
#pragma unroll
            for (int m = 0; m < 4; ++m) { bf16_t* rowp = O + (size_t)(row0 + ai * HALF + m * 16) * ldc + col0;
#pragma unroll
                for (int bj = 0; bj < 2; ++bj) { f32x4 v0 = acc[ai][bj][m][0] * scale + bv[bj][0], v1 = acc[ai][bj][m][1] * scale + bv[bj][1];
                    if (ACT == 1) {
#pragma unroll
                        for (int j = 0; j < 4; ++j) { v0[j] = fsigmoid(v0[j]); v1[j] = fsigmoid(v1[j]); } }
                    u32x4 w; w.x = cvt_pk_bf16(v0[0], v0[1]); w.y = cvt_pk_bf16(v0[2], v0[3]); w.z = cvt_pk_bf16(v1[0], v1[1]); w.w = cvt_pk_bf16(v1[2], v1[3]);
                    *(u32x4*)(rowp + bj * HALF) = w; }
                asm volatile("" ::: "memory"); }
    }
};
struct EpiDownF8 {
    static constexpr bool PREF = false, PERM = true, MIDK = false, F8 = true;
    unsigned char* O; const float* bias;
    __device__ __forceinline__ void operator()(const f32x4 (&acc)[2][2][4][2], const Unit& u, int wr, int wc, int fr, int fq) const {
        const int row0 = u.pm * BM + wr * 64 + fr; const int col0 = u.pn * BM + wc * 32 + 8 * fq;
        f32x4 bv[2][2];
#pragma unroll
        for (int bj = 0; bj < 2; ++bj)
#pragma unroll
            for (int n = 0; n < 2; ++n) bv[bj][n] = *(const f32x4*)(bias + (size_t)u.e * D + col0 + bj * HALF + 4 * n);
#pragma unroll
        for (int ai = 0; ai < 2; ++ai)
#pragma unroll
            for (int m = 0; m < 4; ++m) { unsigned char* rowp = O + (size_t)(row0 + ai * HALF + m * 16) * D + col0;
#pragma unroll
                for (int bj = 0; bj < 2; ++bj) { const f32x4 v0 = acc[ai][bj][m][0] * (1.0f / 32.0f) + bv[bj][0], v1 = acc[ai][bj][m][1] * (1.0f / 32.0f) + bv[bj][1];
                    u32x2 w; w.x = pk4_fp8(v0[0], v0[1], v0[2], v0[3]); w.y = pk4_fp8(v1[0], v1[1], v1[2], v1[3]);
                    *(u32x2*)(rowp + bj * HALF) = w; }
                asm volatile("" ::: "memory"); }
    }
};
}
__device__ __forceinline__ void transpose_item(const float* __restrict__ W, int ldw, int k0, int n_src0, bf16_t* __restrict__ WT, int ldo, int n_dst0, int k_off, LAS float* scr, int lane) {
    { float t_[32]; const float* wp_ = W + (size_t)(k0 + (lane >> 5)) * ldw + n_src0 + (lane & 31);
#pragma unroll
    for (int i = 0; i < 32; ++i) t_[i] = __builtin_nontemporal_load(wp_ + (size_t)(2 * i) * ldw);
#pragma unroll
    for (int i = 0; i < 32; ++i) scr[(2 * i + (lane >> 5)) * 33 + (lane & 31)] = t_[i]; }
    LDS_WAIT(); asm volatile("" ::: "memory");
    const int c = lane & 7;
#pragma unroll
    for (int j = 0; j < 4; ++j) { const int n = (lane >> 3) + 8 * j; const LAS float* s = scr + (8 * c) * 33 + n;
        u32x4 o; o.x = cvt_pk_bf16(s[0 * 33], s[1 * 33]); o.y = cvt_pk_bf16(s[2 * 33], s[3 * 33]); o.z = cvt_pk_bf16(s[4 * 33], s[5 * 33]); o.w = cvt_pk_bf16(s[6 * 33], s[7 * 33]);
        *(u32x4*)(WT + (size_t)(n_dst0 + n) * ldo + k_off + k0 + 8 * c) = o; }
    LDS_WAIT(); asm volatile("" ::: "memory");
}
__device__ __forceinline__ void transpose_item_f8(const float* __restrict__ W, int ldw, int k0, int n_src0, unsigned char* __restrict__ WT, int ldo, int n_dst0, float sc, LAS float* scr, int lane) {
    { float t_[32]; const float* wp_ = W + (size_t)(k0 + (lane >> 5)) * ldw + n_src0 + (lane & 31);
#pragma unroll
    for (int i = 0; i < 32; ++i) t_[i] = __builtin_nontemporal_load(wp_ + (size_t)(2 * i) * ldw);
#pragma unroll
    for (int i = 0; i < 32; ++i) scr[(2 * i + (lane >> 5)) * 33 + (lane & 31)] = t_[i]; }
    LDS_WAIT(); asm volatile("" ::: "memory");
    const int c = lane & 7;
#pragma unroll
    for (int j = 0; j < 4; ++j) { const int n = (lane >> 3) + 8 * j; const LAS float* s = scr + (8 * c) * 33 + n;
        u32x2 o; o.x = pk4_fp8(s[0 * 33] * sc, s[1 * 33] * sc, s[2 * 33] * sc, s[3 * 33] * sc); o.y = pk4_fp8(s[4 * 33] * sc, s[5 * 33] * sc, s[6 * 33] * sc, s[7 * 33] * sc);
        *(u32x2*)(WT + (size_t)(n_dst0 + n) * ldo + k0 + 8 * c) = o; }
    LDS_WAIT(); asm volatile("" ::: "memory");
}
__device__ __forceinline__ void transpose_mat_item(const float* W, int ldw, int N, int n_src_base, bf16_t* WT, int ldo, int n_dst_base, int k_off, LAS float* scr, int item, int lane) {
    const int nblk = N / 32, kb = item / nblk, nb = item % nblk;
    transpose_item(W, ldw, 64 * kb, n_src_base + 32 * nb, WT, ldo, n_dst_base + 32 * nb, k_off, scr, lane);
}

struct P {
    const float* in[25]; float* out; unsigned char* ws;
};

__device__ __forceinline__ void p0_prologue(const P& a, LAS unsigned char* lds, int vcu, int G, int wave, int lane) {
    LAS float* scr = (LAS float*)(lds + wave * 16384);
    const int gw = vcu * NWAVES + wave, NGW = G * NWAVES;
    unsigned char* ws = a.ws;
    bf16_t* WinT = (bf16_t*)(ws + WS_WIN); bf16_t* WupT = (bf16_t*)(ws + WS_WUP); bf16_t* WoT = (bf16_t*)(ws + WS_WO); bf16_t* WpgT = (bf16_t*)(ws + WS_WPG); bf16_t* WppT = (bf16_t*)(ws + WS_WPP);
    constexpr int I_A = 16 * 96, I_B8 = 16 * 160, I_B = 0, I_S = 16 * 32, I_P = 4 * 32;
    constexpr int NITEMS = I_A + I_B8 + I_B + 4 * I_S + I_P;
#ifndef P0_PARTS
#define P0_PARTS 63
#endif
    if (P0_PARTS & 1)
    for (int it = gw; it < NITEMS; it += NGW) {
        int r = it;
        if (r < I_A) { transpose_mat_item(a.in[4], D_IN, 3072, 0, WinT, D, 0, 0, scr, r, lane); continue; } r -= I_A;
        if (r < I_B8) { const int kb = r / 160, nb = r % 160; transpose_item_f8(a.in[4], D_IN, 64 * kb, 3088 + 32 * nb, ws + WS_WIN8, D, 32 * nb, 32.0f, scr, lane); continue; } r -= I_B8;
        if (r < I_S) { transpose_mat_item(a.in[8], D, D, 0, WupT, 2048, 0, 0, scr, r, lane); continue; } r -= I_S;
        if (r < I_S) { transpose_mat_item(a.in[9], D, D, 0, WupT, 2048, 0, 1024, scr, r, lane); continue; } r -= I_S;
        if (r < I_S) { transpose_mat_item(a.in[10], D, D, 0, WoT, D, 0, 0, scr, r, lane); continue; } r -= I_S;
        if (r < I_S) { const int kb = r / 32, nb = r % 32; transpose_item_f8(a.in[21], D, 64 * kb, 32 * nb, (unsigned char*)WpgT, D, 32 * nb, 32.0f, scr, lane); continue; } r -= I_S;
        transpose_mat_item(a.in[22], D, D, 0, WppT, 256, 0, 0, scr, r, lane);
    }
    if (P0_PARTS & 2) {
        const float* x = a.in[0]; const float* g = a.in[3]; bf16_t* H = (bf16_t*)(ws + WS_H);
        f32x4 gv[4];
#pragma unroll
        for (int j = 0; j < 4; ++j) gv[j] = *((const f32x4*)g + lane + 64 * j);
        for (int m = gw; m < T; m += NGW) {
            const f32x4* xr = (const f32x4*)(x + (size_t)m * D) + lane; f32x4 v[4]; float s = 0.f;
#pragma unroll
            for (int j = 0; j < 4; ++j) { v[j] = __builtin_nontemporal_load(xr + 64 * j); s += (v[j].x * v[j].x + v[j].y * v[j].y) + (v[j].z * v[j].z + v[j].w * v[j].w); }
            const float rstd = 1.0f / sqrtf(wave_sum(s) * (1.0f / D) + EPS);
            u32x2* o8 = (u32x2*)(H + (size_t)m * D) + lane; unsigned* q8 = (unsigned*)(ws + WS_H8 + (size_t)m * D) + lane;
#pragma unroll
            for (int j = 0; j < 4; ++j) { const f32x4 y = v[j] * rstd * gv[j]; u32x2 w; w.x = cvt_pk_bf16(y.x, y.y); w.y = cvt_pk_bf16(y.z, y.w); o8[64 * j] = w; q8[64 * j] = pk4_fp8(y.x, y.y, y.z, y.w); }
        }
    }
    if (P0_PARTS & 4) {
        const f32x4* p4 = (const f32x4*)a.in[1]; u32x2* pb = (u32x2*)(ws + WS_PB);
        const size_t n4 = (size_t)T * 256 / 4;
        for (size_t i = (size_t)gw * 64 + lane; i < n4; i += (size_t)NGW * 64) { const f32x4 v = __builtin_nontemporal_load(p4 + i); u32x2 w; w.x = cvt_pk_bf16(v.x, v.y); w.y = cvt_pk_bf16(v.z, v.w); pb[i] = w; }
    }
    if (P0_PARTS & 8) {
        const int gt = (vcu * NWAVES + wave) * 64 + lane;
        if ((P0_PARTS & 16) && gt < 16 * 1024) { const int n = gt >> 10, k = gt & 1023; ((bf16_t*)(ws + WS_WALT))[n * 1024 + k] = (bf16_t)(cvt_pk_bf16(a.in[4][(size_t)k * D_IN + SRC_ALOW + n], 0.f) & 0xffffu); }
        if ((P0_PARTS & 32) && gt < 4096) { const int s = gt >> 6, l = gt & 63, e = l & 31, hh = l >> 5; const float* wr = a.in[12];
            float v[8], lo[8];
#pragma unroll
            for (int j = 0; j < 8; ++j) { v[j] = wr[(size_t)(16 * s + 8 * hh + j) * NE + e]; }
            u32x4 whi; whi.x = cvt_pk_bf16(v[0], v[1]); whi.y = cvt_pk_bf16(v[2], v[3]); whi.z = cvt_pk_bf16(v[4], v[5]); whi.w = cvt_pk_bf16(v[6], v[7]);
#pragma unroll
            for (int j = 0; j < 4; ++j) { lo[2 * j] = v[2 * j] - bflo(whi[j]); lo[2 * j + 1] = v[2 * j + 1] - bfhi(whi[j]); }
            u32x4 wlo; wlo.x = cvt_pk_bf16(lo[0], lo[1]); wlo.y = cvt_pk_bf16(lo[2], lo[3]); wlo.z = cvt_pk_bf16(lo[4], lo[5]); wlo.w = cvt_pk_bf16(lo[6], lo[7]);
            u32x4* f = (u32x4*)(ws + WS_WRF); f[gt] = whi; f[4096 + gt] = wlo; }
    }
}

struct CvtItem { const float* src; unsigned char* dst; int ldo; };
__device__ __forceinline__ CvtItem cvt_item(const P& a, int it, int lane) {
    constexpr int IPM = 16 * 32;
    const int e = it / (3 * IPM), r0 = it % (3 * IPM), which = r0 / IPM, r = r0 % IPM, kb = r / 32, nb = r % 32, n0 = 32 * nb;
    CvtItem c;
    if (which < 2) { c.src = a.in[which == 0 ? 14 : 16] + (size_t)e * D * FF + (size_t)(64 * kb + (lane >> 5)) * FF + n0 + (lane & 31);
        c.dst = (unsigned char*)a.out + ((size_t)e * 2048 + (n0 >> 7) * 256 + (n0 & 127) + which * 128) * D + 64 * kb; c.ldo = D; }
    else { c.src = a.in[18] + (size_t)e * FF * D + (size_t)(64 * kb + (lane >> 5)) * D + n0 + (lane & 31);
        c.dst = a.ws + WS_W2T + ((size_t)e * D + n0) * FF + 64 * kb; c.ldo = FF; }
    return c;
}
__device__ __forceinline__ void expert_convert(const P& a, LAS unsigned char* lds, int vcu, int G, int wave, int lane) {
    LAS float* scr = (LAS float*)(lds + wave * 16384);
    const int gw = vcu * NWAVES + wave, NGW = G * NWAVES;
    constexpr int NIT = NE * 3 * 16 * 32;
    if (gw >= NIT) return;
    float tA[32], tB[32];
    CvtItem cA = cvt_item(a, gw, lane), cB = cvt_item(a, gw + NGW < NIT ? gw + NGW : gw, lane);
#pragma unroll
    for (int i = 0; i < 32; ++i) tA[i] = __builtin_nontemporal_load(cA.src + (size_t)(2 * i) * 1024);
#pragma unroll
    for (int i = 0; i < 32; ++i) tB[i] = __builtin_nontemporal_load(cB.src + (size_t)(2 * i) * 1024);
#define CVT_OUT(c_) do { LDS_WAIT(); asm volatile("" ::: "memory"); const int c = lane & 7; \
        _Pragma("unroll") for (int j = 0; j < 4; ++j) { const int n = (lane >> 3) + 8 * j; const LAS float* s = scr + (8 * c) * 33 + n; \
            u32x2 o; o.x = pk4_fp8(s[0 * 33] * 32.0f, s[1 * 33] * 32.0f, s[2 * 33] * 32.0f, s[3 * 33] * 32.0f); o.y = pk4_fp8(s[4 * 33] * 32.0f, s[5 * 33] * 32.0f, s[6 * 33] * 32.0f, s[7 * 33] * 32.0f); \
            __builtin_nontemporal_store(o, (u32x2*)((c_).dst + (size_t)n * (c_).ldo + 8 * c)); } \
        LDS_WAIT(); asm volatile("" ::: "memory"); } while (0)
    for (int it = gw; it < NIT; it += 2 * NGW) {
#pragma unroll
        for (int i = 0; i < 32; ++i) scr[(2 * i + (lane >> 5)) * 33 + (lane & 31)] = tA[i];
        const CvtItem dA = cA; const int n2 = it + 2 * NGW;
        if (n2 < NIT) { cA = cvt_item(a, n2, lane);
#pragma unroll
            for (int i = 0; i < 32; ++i) tA[i] = __builtin_nontemporal_load(cA.src + (size_t)(2 * i) * 1024); }
        CVT_OUT(dA);
        if (it + NGW >= NIT) break;
#pragma unroll
        for (int i = 0; i < 32; ++i) scr[(2 * i + (lane >> 5)) * 33 + (lane & 31)] = tB[i];
        const CvtItem dB = cB; const int n3 = it + 3 * NGW;
        if (n3 < NIT) { cB = cvt_item(a, n3, lane);
#pragma unroll
            for (int i = 0; i < 32; ++i) tB[i] = __builtin_nontemporal_load(cB.src + (size_t)(2 * i) * 1024); }
        CVT_OUT(dB);
    }
#undef CVT_OUT
}

__device__ __forceinline__ float fexp_(float x) { return __builtin_amdgcn_exp2f(x * 1.4426950408889634f); }
__device__ __forceinline__ float logsigmoidf_(float x) { const float e = fexp_(-fabsf(x)); return fminf(x, 0.0f) - 0.6931471805599453f * __builtin_amdgcn_logf(1.0f + e); }
__device__ __forceinline__ void gla_prep_unit(const P& a, LAS unsigned char* lds, int unit) {
    int tid = threadIdx.x; asm volatile("" : "+v"(tid));     const int wave = __builtin_amdgcn_readfirstlane(tid >> 6), lane = tid & 63;
    const int b = unit >> 5, chunk = unit & 31, tok0 = b * SEQ + chunk * 64;
    const bf16_t* H = (const bf16_t*)(a.ws + WS_H); const bf16_t* WalT = (const bf16_t*)(a.ws + WS_WALT); const bf16_t* proj = (const bf16_t*)(a.ws + WS_PROJ);
    LAS float* part = (LAS float*)lds;
    LAS float* alow = (LAS float*)(lds + 8192);
    LAS float* seg = (LAS float*)(lds + 12288);
    constexpr int GP_KDT = 16384, GP_VT = 34816;
    {
        const int rg = wave & 3, kh = wave >> 2, r = lane & 15, q = lane >> 4;
        f32x4 acc = (f32x4){0.f, 0.f, 0.f, 0.f};
        const bf16_t* ap = H + (size_t)(tok0 + 16 * rg + r) * D + 512 * kh + 8 * q; const bf16_t* bp = WalT + (size_t)r * D + 512 * kh + 8 * q;
#pragma unroll 8
        for (int s = 0; s < 16; ++s) { const bf16x8 av = *(const bf16x8*)(ap + 32 * s), bv = *(const bf16x8*)(bp + 32 * s); acc = __builtin_amdgcn_mfma_f32_16x16x32_bf16(bv, av, acc, 0, 0, 0); }
        *(LAS f32x4*)(part + (kh * 64 + 16 * rg + r) * 16 + 4 * q) = acc;
    }
    __syncthreads();
    if (tid < 256) { *(LAS f32x4*)(alow + tid * 4) = *(LAS f32x4*)(part + tid * 4) + *(LAS f32x4*)(part + 1024 + tid * 4); }
    __syncthreads();
    const int dp = tid & 63, tq = wave;
    const float* w_a2 = a.in[5]; const float* b_a2 = a.in[6];
    const int ep = tid & 127, sq4 = tid >> 7;
    f32x2 w2[16], w2n[16]; f32x2 b2, b2n; unsigned qv[8], kv[8], qvn[8], kvn[8], sv[16], svn[16];
#define GP_LOADS(h_, W2, B2, QV, KV, SV) do { const int dc_ = (h_) * 128 + 2 * dp; \
        _Pragma("unroll") for (int r = 0; r < 16; ++r) W2[r] = *(const f32x2*)(w_a2 + r * 512 + dc_); \
        B2 = *(const f32x2*)(b_a2 + dc_); \
        _Pragma("unroll") for (int i = 0; i < 8; ++i) { const bf16_t* rp = proj + PROJ_BLK((h_) * 128) + (size_t)(tok0 + 8 * tq + i) * 128 + 2 * dp; QV[i] = __builtin_nontemporal_load((const unsigned*)(rp + PROJ_BLK(C_QA))); KV[i] = __builtin_nontemporal_load((const unsigned*)(rp + PROJ_BLK(C_KA))); } \
        const bf16_t* v_ = proj + PROJ_BLK(C_VA + (h_) * 256) + (size_t)(tok0 + 16 * sq4) * 256 + 2 * ep; \
        _Pragma("unroll") for (int i = 0; i < 16; ++i) SV[i] = __builtin_nontemporal_load((const unsigned*)(v_ + (size_t)i * 256)); } while (0)
    GP_LOADS(0, w2, b2, qv, kv, sv);
    for (int h = 0; h < 4; ++h) {
        if (h + 1 < 4) GP_LOADS(h + 1, w2n, b2n, qvn, kvn, svn);
        float G0[8], G1[8]; float r0 = 0.f, r1 = 0.f;
#pragma unroll
        for (int i = 0; i < 8; ++i) { const LAS f32x4* al4 = (const LAS f32x4*)(alow + (8 * tq + i) * 16); float x0 = b2.x, x1 = b2.y;
#pragma unroll
            for (int r4 = 0; r4 < 4; ++r4) { const f32x4 al = al4[r4];
#pragma unroll
                for (int j = 0; j < 4; ++j) { x0 += al[j] * w2[4 * r4 + j].x; x1 += al[j] * w2[4 * r4 + j].y; } }
            r0 += logsigmoidf_(x0) * (1.0f / 16.0f); r1 += logsigmoidf_(x1) * (1.0f / 16.0f); G0[i] = r0; G1[i] = r1; }
        *(LAS f32x2*)(seg + tq * 128 + 2 * dp) = (f32x2){r0, r1};
        __syncthreads();
        float off0 = 0.f, off1 = 0.f, tot0 = 0.f, tot1 = 0.f;
#pragma unroll
        for (int q = 0; q < 8; ++q) { const f32x2 s = *(LAS f32x2*)(seg + q * 128 + 2 * dp); tot0 += s.x; tot1 += s.y; if (q < tq) { off0 += s.x; off1 += s.y; } }
        const size_t tile = (size_t)((b * 4 + h) * 32 + chunk);
        bf16_t* Qg = (bf16_t*)(a.ws + WS_QG) + tile * 8192; bf16_t* Kg = (bf16_t*)(a.ws + WS_KG) + tile * 8192;
        float kd0[8], kd1[8];
#pragma unroll
        for (int i = 0; i < 8; ++i) { const float g0 = G0[i] + off0, g1 = G1[i] + off1; const float q0 = bflo(qv[i]), q1 = bfhi(qv[i]), k0 = bflo(kv[i]), k1 = bfhi(kv[i]);
            const float e0 = fexp_(g0), e1 = fexp_(g1);
            *(unsigned*)(Qg + (8 * tq + i) * 128 + 2 * dp) = cvt_pk_bf16(q0 * e0 * 0.08838834764831845f, q1 * e1 * 0.08838834764831845f);
            *(unsigned*)(Kg + (8 * tq + i) * 128 + 2 * dp) = cvt_pk_bf16(k0 * __builtin_amdgcn_rcpf(e0), k1 * __builtin_amdgcn_rcpf(e1));
            kd0[i] = k0 * fexp_(tot0 - g0); kd1[i] = k1 * fexp_(tot1 - g1); }
        u32x4 w0, w1; w0.x = cvt_pk_bf16(kd0[0], kd0[1]); w0.y = cvt_pk_bf16(kd0[2], kd0[3]); w0.z = cvt_pk_bf16(kd0[4], kd0[5]); w0.w = cvt_pk_bf16(kd0[6], kd0[7]);
        w1.x = cvt_pk_bf16(kd1[0], kd1[1]); w1.y = cvt_pk_bf16(kd1[2], kd1[3]); w1.z = cvt_pk_bf16(kd1[4], kd1[5]); w1.w = cvt_pk_bf16(kd1[6], kd1[7]);
        *(LAS u32x4*)(lds + GP_KDT + (2 * dp) * 144 + 16 * tq) = w0; *(LAS u32x4*)(lds + GP_KDT + (2 * dp + 1) * 144 + 16 * tq) = w1;
        if (tq == 0) *(f32x2*)((float*)(a.ws + WS_DEC) + tile * 128 + 2 * dp) = (f32x2){fexp_(tot0), fexp_(tot1)};
        {
            u32x4 lo0, lo1, hi0, hi1;
#pragma unroll
            for (int j = 0; j < 4; ++j) { lo0[j] = (sv[2 * j] & 0xffffu) | (sv[2 * j + 1] << 16); lo1[j] = (sv[8 + 2 * j] & 0xffffu) | (sv[8 + 2 * j + 1] << 16);
                hi0[j] = (sv[2 * j] >> 16) | (sv[2 * j + 1] & 0xffff0000u); hi1[j] = (sv[8 + 2 * j] >> 16) | (sv[8 + 2 * j + 1] & 0xffff0000u); }
            LAS unsigned char* v0 = lds + GP_VT + (2 * ep) * 144 + sq4 * 32;
            *(LAS u32x4*)(v0) = lo0; *(LAS u32x4*)(v0 + 16) = lo1; *(LAS u32x4*)(v0 + 144) = hi0; *(LAS u32x4*)(v0 + 144 + 16) = hi1;
        }
        __syncthreads();
        {
            const int c32 = lane & 31, hi = lane >> 5;
            bf16x8 vt[4];
#pragma unroll
            for (int ks = 0; ks < 4; ++ks) vt[ks] = *(const LAS bf16x8*)(lds + GP_VT + (32 * wave + c32) * 144 + (16 * ks + 8 * hi) * 2);
            unsigned* sl = (unsigned*)a.out + tile * 8192;
#pragma unroll
            for (int tl = 0; tl < 4; ++tl) { f32x16 acc;
#pragma unroll
                for (int r = 0; r < 16; ++r) acc[r] = 0.f;
#pragma unroll
                for (int ks = 0; ks < 4; ++ks) { const bf16x8 av = *(const LAS bf16x8*)(lds + GP_KDT + (32 * tl + c32) * 144 + (16 * ks + 8 * hi) * 2); acc = __builtin_amdgcn_mfma_f32_32x32x16_bf16(av, vt[ks], acc, 0, 0, 0); }
#pragma unroll
                for (int g = 0; g < 4; ++g) sl[((tl * 4 + g) * 2 + hi) * 256 + 32 * wave + c32] = pk4_fp8(acc[4 * g], acc[4 * g + 1], acc[4 * g + 2], acc[4 * g + 3]); }
        }
        __syncthreads();
#pragma unroll
        for (int r = 0; r < 16; ++r) { w2[r] = w2n[r]; sv[r] = svn[r]; }
#pragma unroll
        for (int i = 0; i < 8; ++i) { qv[i] = qvn[i]; kv[i] = kvn[i]; }
        b2 = b2n;
    }
#undef GP_LOADS
}

__device__ __forceinline__ void gla_combine_unit(const P& a, int unit) {
    const int tid = threadIdx.x, bh = unit >> 4, i8 = (unit & 15) * 512 + tid;
    const int d0 = 32 * (i8 >> 11) + 8 * ((i8 >> 9) & 3) + 4 * ((i8 >> 8) & 1);
    const unsigned* sl8 = (const unsigned*)a.out + (size_t)bh * 32 * 8192 + i8; u32x2* sl = (u32x2*)(a.ws + WS_SLOC) + (size_t)bh * 32 * 8192 + i8;
    const f32x4* dc = (const f32x4*)((const float*)(a.ws + WS_DEC) + (size_t)bh * 32 * 128 + d0);
    f32x4 s = (f32x4){0.f, 0.f, 0.f, 0.f};
    for (int cb = 0; cb < 32; cb += 8) {
        unsigned loc[8]; f32x4 dv[8];
#pragma unroll
        for (int i = 0; i < 8; ++i) { loc[i] = __builtin_nontemporal_load(sl8 + (size_t)(cb + i) * 8192); dv[i] = dc[(cb + i) * 32]; }
#pragma unroll
        for (int i = 0; i < 8; ++i) { if (cb + i < 31) {
            s.x = dv[i].x * s.x + __builtin_amdgcn_cvt_f32_fp8((int)loc[i], 0); s.y = dv[i].y * s.y + __builtin_amdgcn_cvt_f32_fp8((int)loc[i], 1);
            s.z = dv[i].z * s.z + __builtin_amdgcn_cvt_f32_fp8((int)loc[i], 2); s.w = dv[i].w * s.w + __builtin_amdgcn_cvt_f32_fp8((int)loc[i], 3);
            u32x2 w; w.x = cvt_pk_bf16(s.x, s.y); w.y = cvt_pk_bf16(s.z, s.w); sl[(size_t)(cb + i) * 8192] = w; } }
    }
}

constexpr int GL_QG = 0, GL_KG = 17408, GL_VT = 53248, GL_AM = 90112, GL_OST = 0;
constexpr int GL_QS = 272, GL_TS = 144, GL_OS = 528;
__device__ __forceinline__ int crow(int r, int hi) { return (r & 3) + 8 * (r >> 2) + 4 * hi; }
__device__ __forceinline__ void gla_out_unit(const P& a, LAS unsigned char* lds, int unit) {
    int tid = threadIdx.x; asm volatile("" : "+v"(tid)); const int w = __builtin_amdgcn_readfirstlane(tid >> 6), lane = tid & 63, c32 = lane & 31, hi = lane >> 5;
    const int bh = unit >> 5, chunk = unit & 31, b = bh >> 2, h = bh & 3;
    const bf16_t* proj = (const bf16_t*)(a.ws + WS_PROJ); bf16_t* oab = (bf16_t*)(a.ws + WS_OAB); const float* ggo = a.in[7];
    const size_t tile = (size_t)bh * 32 + chunk;
    {
        const u32x4* q_ = (const u32x4*)((const bf16_t*)(a.ws + WS_QG) + tile * 8192); const u32x4* k_ = (const u32x4*)((const bf16_t*)(a.ws + WS_KG) + tile * 8192);
        u32x4 sq[2], sk[2]; unsigned sv[16];
        sq[0] = __builtin_nontemporal_load(q_ + tid); sq[1] = __builtin_nontemporal_load(q_ + tid + 512); sk[0] = __builtin_nontemporal_load(k_ + tid); sk[1] = __builtin_nontemporal_load(k_ + tid + 512);
        const int ep = tid & 127, sq4 = tid >> 7;
        const bf16_t* v_ = proj + PROJ_BLK(C_VA + h * 256) + (size_t)(b * SEQ + chunk * 64 + 16 * sq4) * 256 + 2 * ep;
#pragma unroll
        for (int i = 0; i < 16; ++i) sv[i] = __builtin_nontemporal_load((const unsigned*)(v_ + (size_t)i * 256));
#pragma unroll
        for (int i = 0; i < 2; ++i) { const int p = tid + 512 * i;
            *(LAS u32x4*)(lds + GL_QG + (p >> 4) * GL_QS + (p & 15) * 16) = sq[i]; *(LAS u32x4*)(lds + GL_KG + (p >> 4) * GL_QS + (p & 15) * 16) = sk[i]; }
        u32x4 lo0, lo1, hi0, hi1;
#pragma unroll
        for (int j = 0; j < 4; ++j) { lo0[j] = (sv[2 * j] & 0xffffu) | (sv[2 * j + 1] << 16); lo1[j] = (sv[8 + 2 * j] & 0xffffu) | (sv[8 + 2 * j + 1] << 16);
            hi0[j] = (sv[2 * j] >> 16) | (sv[2 * j + 1] & 0xffff0000u); hi1[j] = (sv[8 + 2 * j] >> 16) | (sv[8 + 2 * j + 1] & 0xffff0000u); }
        LAS unsigned char* v0 = lds + GL_VT + (2 * ep) * GL_TS + sq4 * 32;
        *(LAS u32x4*)(v0) = lo0; *(LAS u32x4*)(v0 + 16) = lo1; *(LAS u32x4*)(v0 + GL_TS) = hi0; *(LAS u32x4*)(v0 + GL_TS + 16) = hi1;
    }
    u32x2 sf[4][2][2];
    if (chunk > 0) { const u32x2* sl = (const u32x2*)(a.ws + WS_SLOC) + (tile - 1) * 8192;
#pragma unroll
        for (int tl = 0; tl < 4; ++tl)
#pragma unroll
            for (int s = 0; s < 2; ++s)
#pragma unroll
                for (int q = 0; q < 2; ++q) sf[tl][s][q] = __builtin_nontemporal_load(sl + ((tl * 4 + 2 * s + q) * 2 + hi) * 256 + 32 * w + c32); }
    __syncthreads();
    if (w < 3) {
        const int ti = (w + 1) >> 1, si = w >> 1;
        f32x16 A;
#pragma unroll
        for (int r = 0; r < 16; ++r) A[r] = 0.f;
#pragma unroll
        for (int s = 0; s < 8; ++s) { const bf16x8 av = *(const LAS bf16x8*)(lds + GL_QG + (32 * ti + c32) * GL_QS + (16 * s + 8 * hi) * 2), bv = *(const LAS bf16x8*)(lds + GL_KG + (32 * si + c32) * GL_QS + (16 * s + 8 * hi) * 2);
            A = __builtin_amdgcn_mfma_f32_32x32x16_bf16(av, bv, A, 0, 0, 0); }
        const int sidx = 32 * si + c32;
#pragma unroll
        for (int r = 0; r < 16; ++r) { const int t = 32 * ti + crow(r, hi); const float v = (sidx <= t) ? A[r] : 0.f;
            *(LAS bf16_t*)(lds + GL_AM + t * GL_TS + sidx * 2) = (bf16_t)(cvt_pk_bf16(v, 0.f) & 0xffffu); }
    }
    __syncthreads();
    f32x16 o[2];
    {
        bf16x8 vt[4];
#pragma unroll
        for (int ks = 0; ks < 4; ++ks) vt[ks] = *(const LAS bf16x8*)(lds + GL_VT + (32 * w + c32) * GL_TS + (16 * ks + 8 * hi) * 2);
#pragma unroll
        for (int ti = 0; ti < 2; ++ti) {
#pragma unroll
            for (int r = 0; r < 16; ++r) o[ti][r] = 0.f;
            if (chunk > 0) {
#pragma unroll
                for (int tl = 0; tl < 4; ++tl)
#pragma unroll
                    for (int s = 0; s < 2; ++s) { const LAS unsigned char* qp = lds + GL_QG + (32 * ti + c32) * GL_QS + (32 * tl + 16 * s + 4 * hi) * 2;
                        const s16x4 lo = *(const LAS s16x4*)qp, hh = *(const LAS s16x4*)(qp + 16);
                        const bf16x8 aop = __builtin_shufflevector(lo, hh, 0, 1, 2, 3, 4, 5, 6, 7);
                        const u32x4 bw = {sf[tl][s][0].x, sf[tl][s][0].y, sf[tl][s][1].x, sf[tl][s][1].y};
                        o[ti] = __builtin_amdgcn_mfma_f32_32x32x16_bf16(aop, __builtin_bit_cast(bf16x8, bw), o[ti], 0, 0, 0); }
            }
#pragma unroll
            for (int ks = 0; ks < 4; ++ks) { if (ti == 0 && ks >= 2) continue;
                const bf16x8 av = *(const LAS bf16x8*)(lds + GL_AM + (32 * ti + c32) * GL_TS + (16 * ks + 8 * hi) * 2);
                o[ti] = __builtin_amdgcn_mfma_f32_32x32x16_bf16(av, vt[ks], o[ti], 0, 0, 0); }
        }
    }
    __syncthreads();
#pragma unroll
    for (int ti = 0; ti < 2; ++ti)
#pragma unroll
        for (int r = 0; r < 16; ++r) *(LAS bf16_t*)(lds + GL_OST + (32 * ti + crow(r, hi)) * GL_OS + (32 * w + c32) * 2) = (bf16_t)(cvt_pk_bf16(o[ti][r], 0.f) & 0xffffu);
    __syncthreads();
    {
        const int t = tid >> 3, sg = tid & 7; const size_t tok = (size_t)(b * SEQ + chunk * 64 + t);
        u32x4 ov[4]; float ss = 0.f;
#pragma unroll
        for (int j = 0; j < 4; ++j) { ov[j] = *(const LAS u32x4*)(lds + GL_OST + t * GL_OS + sg * 64 + j * 16);
#pragma unroll
            for (int i = 0; i < 4; ++i) { const float x0 = bflo(ov[j][i]), x1 = bfhi(ov[j][i]); ss += x0 * x0 + x1 * x1; } }
        ss += __shfl_xor(ss, 1); ss += __shfl_xor(ss, 2); ss += __shfl_xor(ss, 4);
        const float rstd = 1.0f / sqrtf(ss * (1.0f / 256.0f) + EPS);
        const bf16_t* rap = proj + PROJ_BLK(C_RA + h * 256) + tok * 256 + sg * 32; bf16_t* op = oab + tok * 2048 + h * 256 + sg * 32; const float* gp = ggo + sg * 32;
#pragma unroll
        for (int j = 0; j < 4; ++j) { const u32x4 ra = __builtin_nontemporal_load((const u32x4*)(rap + 8 * j)); const f32x4 g0 = *(const f32x4*)(gp + 8 * j), g1 = *(const f32x4*)(gp + 8 * j + 4); u32x4 wv;
#pragma unroll
            for (int i = 0; i < 4; ++i) { const float r0 = bflo(ra[i]), r1 = bfhi(ra[i]); const float ga = (i < 2) ? g0[2 * i] : g1[2 * i - 4], gb = (i < 2) ? g0[2 * i + 1] : g1[2 * i - 3];
                wv[i] = cvt_pk_bf16(bflo(ov[j][i]) * rstd * ga * (r0 * fsigmoid(r0)), bfhi(ov[j][i]) * rstd * gb * (r1 * fsigmoid(r1))); }
            *(u32x4*)(op + 8 * j) = wv; }
    }
    __syncthreads();
}
namespace moba {
constexpr int HD = 128;
constexpr float SCALE = 0.08838834764831845f;
constexpr float THR = 8.f;
constexpr int NW = 8, QBLK = 32, KVBLK = 64, QB = NW * QBLK;
constexpr int SHM_V = KVBLK * HD * 2, SHM_K = KVBLK * HD * 2;
constexpr int OFF_WS = 2 * SHM_V + 2 * SHM_K;
constexpr int OFF_RTAB = OFF_WS + NW * 64 * 4;
constexpr int OFF_KM = OFF_RTAB + 2400 * 4;
constexpr int OFF_MISC = OFF_KM + 8 * 128 * 4;
constexpr int OFF_SEL = OFF_MISC + 64;
constexpr int LDS_BYTES = OFF_SEL + 2048;
constexpr int LDP = HD, LDO = 2048;

#define KSWZ(row, colB) ((row) * 256 + ((colB) ^ (((row) & 7) << 4)))
#define SBAR() __builtin_amdgcn_sched_barrier(0)
__device__ __forceinline__ int v_st(int k, int c) { const int kk = (k & ~0xC) | ((k & 4) << 1) | ((k & 8) >> 1); return ((kk >> 3) * 4 + (c >> 5)) * 512 + ((kk & 7) * 32 + (c & 31)) * 2; }
__device__ __forceinline__ int v_rd_base(int lane) { return ((lane & 3) << 3) | (((lane >> 2) & 3) << 6) | (((lane >> 4) & 1) << 5) | (((lane >> 5) & 1) << 8); }
constexpr int v_rd_off(int d0, int ks, int half) { return d0 * 512 + ks * 4096 + half * 2048; }
__device__ __forceinline__ int crow(int r, int hi) { return (r & 3) + 8 * (r >> 2) + 4 * hi; }
__device__ __forceinline__ unsigned cvtpk(float lo, float hi) { unsigned r; asm volatile("v_cvt_pk_bf16_f32 %0, %1, %2" : "=v"(r) : "v"(lo), "v"(hi)); return r; }

__device__ __forceinline__ void mask_tile(f32x16& p0, f32x16& p1, int dq) {
    const float NEG = -__builtin_inff();
#pragma unroll
    for (int r = 0; r < 16; ++r) {
        const int c = (r & 3) + 8 * (r >> 2);
        if (dq - c < 0) p0[r] = NEG;
        if (dq - c - 32 < 0) p1[r] = NEG;
    }
}
__device__ __forceinline__ void bias_tile(f32x16& p0, f32x16& p1, const LAS float* rt) {
#pragma unroll
    for (int r = 0; r < 16; ++r) { const int c = (r & 3) + 8 * (r >> 2); p0[r] += rt[c]; p1[r] += rt[c + 32]; }
}
__device__ __forceinline__ void kill_tile(f32x16& p0, f32x16& p1) {
    const float NEG = -__builtin_inff();
#pragma unroll
    for (int r = 0; r < 16; ++r) { p0[r] = NEG; p1[r] = NEG; }
}
__device__ __forceinline__ void partialSM(f32x16& p0, f32x16& p1, float& m_reg, float& mn, float& alpha) {
    float pmax = p0[0];
#pragma unroll
    for (int r = 1; r < 16; ++r) pmax = fmaxf(pmax, p0[r]);
#pragma unroll
    for (int r = 0; r < 16; ++r) pmax = fmaxf(pmax, p1[r]);
    { auto rr = __builtin_amdgcn_permlane32_swap(__float_as_uint(pmax), __float_as_uint(pmax), false, false);
      pmax = fmaxf(__uint_as_float(rr[0]), __uint_as_float(rr[1])); }
    constexpr float C2 = 1.4426950408889634f * SCALE;
    if (__builtin_expect(__all((pmax - m_reg) * SCALE <= THR), 1)) { mn = m_reg; alpha = 1.f; }
    else { mn = fmaxf(m_reg, pmax); alpha = __builtin_amdgcn_exp2f((m_reg - mn) * C2); m_reg = mn; }
    const float mnL = -mn * C2;
#pragma unroll
    for (int r = 0; r < 16; ++r) p0[r] = fmaf(p0[r], C2, mnL);
#pragma unroll
    for (int r = 0; r < 16; ++r) p1[r] = fmaf(p1[r], C2, mnL);
#pragma unroll
    for (int r = 0; r < 16; ++r) p0[r] = __builtin_amdgcn_exp2f(p0[r]);
}
__device__ __forceinline__ void finishSM(f32x16& p0, f32x16& p1, float alpha, float& l_reg, bf16x8& pa0, bf16x8& pa1, bf16x8& pa2, bf16x8& pa3) {
#pragma unroll
    for (int r = 0; r < 16; ++r) p1[r] = __builtin_amdgcn_exp2f(p1[r]);
    float ps = 0;
#pragma unroll
    for (int r = 0; r < 16; ++r) ps += p0[r];
#pragma unroll
    for (int r = 0; r < 16; ++r) ps += p1[r];
    { auto rr = __builtin_amdgcn_permlane32_swap(__float_as_uint(ps), __float_as_uint(ps), false, false);
      ps = __uint_as_float(rr[0]) + __uint_as_float(rr[1]); }
    l_reg = l_reg * alpha + ps;
#define PK4(P, B_, OUT) do { unsigned a0 = cvtpk(P[B_+0], P[B_+1]), a1 = cvtpk(P[B_+2], P[B_+3]);                          \
        unsigned b0 = cvtpk(P[B_+4], P[B_+5]), b1 = cvtpk(P[B_+6], P[B_+7]);                                             \
        auto r0 = __builtin_amdgcn_permlane32_swap(a0, b0, false, false); auto r1 = __builtin_amdgcn_permlane32_swap(a1, b1, false, false); \
        u32x4 w = {r0[0], r1[0], r0[1], r1[1]}; OUT = __builtin_bit_cast(bf16x8, w); } while (0)
    PK4(p0, 0, pa0); PK4(p0, 8, pa1); PK4(p1, 0, pa2); PK4(p1, 8, pa3);
#undef PK4
}
template <int KB>
__device__ __forceinline__ void qkt(f32x16& p0, f32x16& p1, const char* K_lds, int r32, int hi, const bf16x8* qr) {
#pragma unroll
    for (int r = 0; r < 16; ++r) { p0[r] = 0.f; p1[r] = 0.f; }
    const char* kb[4];
#pragma unroll
    for (int dd = 0; dd < 4; ++dd) kb[dd] = K_lds + KB * SHM_K + KSWZ(r32, (dd * 16 + hi * 8) * 2);
#pragma unroll
    for (int d0 = 0; d0 < 8; ++d0) { const char* a = kb[d0 & 3] + (d0 >> 2) * 128;
        bf16x8 b0 = *reinterpret_cast<const bf16x8*>(a);
        bf16x8 b1 = *reinterpret_cast<const bf16x8*>(a + 32 * 256);
        p0 = __builtin_amdgcn_mfma_f32_32x32x16_bf16(b0, qr[d0], p0, 0, 0, 0);
        p1 = __builtin_amdgcn_mfma_f32_32x32x16_bf16(b1, qr[d0], p1, 0, 0, 0); }
}
template <int VB>
__device__ __forceinline__ void pv_tile(f32x16* o, int vb0, bf16x8 pa0, bf16x8 pa1, bf16x8 pa2, bf16x8 pa3) {
#define TRRD(dst, off) asm volatile("ds_read_b64_tr_b16 %0, %1 offset:%2" : "=&v"(dst) : "v"(vb0), "i"(off) : "memory")
#define PV_D0(d0) do { s16x4 l0, l1, l2, l3, h0, h1, h2, h3; constexpr int b_ = VB * SHM_V + v_rd_off(d0, 0, 0);   \
        TRRD(l0, b_); TRRD(h0, b_ + 2048); TRRD(l1, b_ + 4096); TRRD(h1, b_ + 6144); TRRD(l2, b_ + 8192); TRRD(h2, b_ + 10240); TRRD(l3, b_ + 12288); TRRD(h3, b_ + 14336); \
        asm volatile("s_waitcnt lgkmcnt(0)" ::: "memory"); SBAR();   \
        o[d0] = __builtin_amdgcn_mfma_f32_32x32x16_bf16(pa0, (bf16x8){l0[0], l0[1], l0[2], l0[3], h0[0], h0[1], h0[2], h0[3]}, o[d0], 0, 0, 0);   \
        o[d0] = __builtin_amdgcn_mfma_f32_32x32x16_bf16(pa1, (bf16x8){l1[0], l1[1], l1[2], l1[3], h1[0], h1[1], h1[2], h1[3]}, o[d0], 0, 0, 0);   \
        o[d0] = __builtin_amdgcn_mfma_f32_32x32x16_bf16(pa2, (bf16x8){l2[0], l2[1], l2[2], l2[3], h2[0], h2[1], h2[2], h2[3]}, o[d0], 0, 0, 0);   \
        o[d0] = __builtin_amdgcn_mfma_f32_32x32x16_bf16(pa3, (bf16x8){l3[0], l3[1], l3[2], l3[3], h3[0], h3[1], h3[2], h3[3]}, o[d0], 0, 0, 0); } while (0)
    PV_D0(0); PV_D0(1); PV_D0(2); PV_D0(3);
#undef PV_D0
#undef TRRD
}

struct BlockRef { const bf16_t* Q; const bf16_t* K; const bf16_t* V; bf16_t* O; int qb; int b, h; };
struct Seam { bf16x8 qr[8]; bf16x8 st_v0, st_v1, st_k0, st_k1; };
#define VMW() asm volatile("s_waitcnt vmcnt(0)" ::: "memory")
#define VMWN(n) asm volatile("s_waitcnt vmcnt(%0)" :: "i"(n) : "memory")
#define LD8(p) (*reinterpret_cast<const bf16x8*>(p))
#define SLOAD_H(Kp, Vp, k0) do { const char* kb__ = (const char*)(Kp) + (size_t)(k0) * (LDP * 2); const char* vb__ = (const char*)(Vp) + (size_t)(k0) * (LDP * 2); \
        S.st_v0 = LD8(vb__ + kvoff); S.st_v1 = LD8(vb__ + 32 * LDP * 2 + kvoff); S.st_k0 = LD8(kb__ + kvoff); S.st_k1 = LD8(kb__ + 32 * LDP * 2 + kvoff); } while (0)
#define SWRITE_HK(bf) do { *(bf16x8*)(K_lds + (bf) * SHM_K + kws) = S.st_k0; *(bf16x8*)(K_lds + (bf) * SHM_K + kws + 32 * 256) = S.st_k1; } while (0)
#define SWRITE_HV(bf) do { *(bf16x8*)(V_lds + (bf) * SHM_V + vst0) = S.st_v0; *(bf16x8*)(V_lds + (bf) * SHM_V + vst1) = S.st_v1; } while (0)
#define SWRITE_H(bf) do { SWRITE_HV(bf); SWRITE_HK(bf); } while (0)

__device__ __forceinline__ void prime(const BlockRef& cur, char* lds, Seam& S) {
    int tid = threadIdx.x; asm volatile("" : "+v"(tid));     const int wid = __builtin_amdgcn_readfirstlane(tid >> 6), lane = tid & 63, r32 = lane & 31, hi = lane >> 5;
    const int sr = tid >> 4, sc = (tid & 15) * 8, kws = KSWZ(sr, sc * 2); char* K_lds = lds + 2 * SHM_V;
    const unsigned kvoff = (unsigned)(sr * LDP + sc) * 2u, qvoff = (unsigned)(r32 * LDP + hi * 8) * 2u;
    { const char* qb__ = (const char*)cur.Q + (size_t)(wid * QBLK) * (LDP * 2);
#pragma unroll
    for (int d0 = 0; d0 < 8; ++d0) S.qr[d0] = LD8(qb__ + qvoff + d0 * 32); }
    SLOAD_H(cur.K, cur.V, 0); VMW(); SWRITE_HK(0);
    __syncthreads();
}
__device__ __forceinline__ int rel_bucket(int n) {
    if (n < 16) return n;
    const float nf = (float)n;
    int large = 16 + (int)(logf(nf / 16.0f) / 5.545177444479562f * 16.0f);
    return large < 31 ? large : 31;
}
__device__ __forceinline__ BlockRef make_ref(const P& a, int item);
__device__ __forceinline__ int block(const P& a, const BlockRef& cur, unsigned* queue, const float* rel_bias, const float* kmp, char* lds, Seam& S) {
    int tid = threadIdx.x; asm volatile("" : "+v"(tid));     const int wid = __builtin_amdgcn_readfirstlane(tid >> 6), lane = tid & 63, r32 = lane & 31, hi = lane >> 5;
    const int qb = cur.qb, NT = 4 * (qb + 1);
    const int qlo = qb * QB + wid * QBLK, qrow = qlo + r32;
    char* V_lds = lds; char* K_lds = lds + 2 * SHM_V;
    float* ws = (float*)(lds + OFF_WS) + wid * 64; float* li_l = ws, * al_l = ws + 32;
    LAS float* rtab = (LAS float*)(LAS char*)(uintptr_t)(unsigned)(uintptr_t)(lds + OFF_RTAB);
    float* kmL = (float*)(lds + OFF_KM);
    volatile int* misc = (volatile int*)(lds + OFF_MISC);
    if (tid == 0) misc[0] = (int)__hip_atomic_fetch_add(queue, 1u, __ATOMIC_RELAXED, __HIP_MEMORY_SCOPE_AGENT);
    for (int i = tid; i < 2400; i += NW * 64) { const int dist = 2047 - i; rtab[i] = dist >= 0 ? rel_bias[rel_bucket(dist) * 8 + cur.h] * (1.0f / SCALE) : -__builtin_inff(); }
    for (int i = tid; i < qb * 128; i += NW * 64) { const int j = i >> 7, dd = i & 127; const size_t o = ((size_t)(cur.b * 8 + j)) * 1024 + cur.h * 128 + dd;
        kmL[i] = (kmp[o] + kmp[o + 64 * 1024]) * (1.0f / 256.0f); }
    __syncthreads();
    const int next_item = __builtin_amdgcn_readfirstlane(misc[0]);
    const BlockRef nxt = next_item < 512 ? make_ref(a, next_item) : cur;
    unsigned selmask = 0;
    {
        float sc7[7];
#pragma unroll
        for (int j = 0; j < 7; ++j) { sc7[j] = -__builtin_inff();
            if (j < qb) { float acc = 0.f;
#pragma unroll
                for (int d0 = 0; d0 < 8; ++d0) { const u32x4 q4 = __builtin_bit_cast(u32x4, S.qr[d0]); const f32x4 k0 = *(const f32x4*)(kmL + j * 128 + d0 * 16 + hi * 8), k1 = *(const f32x4*)(kmL + j * 128 + d0 * 16 + hi * 8 + 4);
                    acc += bflo(q4[0]) * k0[0] + bfhi(q4[0]) * k0[1] + bflo(q4[1]) * k0[2] + bfhi(q4[1]) * k0[3] + bflo(q4[2]) * k1[0] + bfhi(q4[2]) * k1[1] + bflo(q4[3]) * k1[2] + bfhi(q4[3]) * k1[3]; }
                acc += __shfl_xor(acc, 32); sc7[j] = acc; } }
#pragma unroll
        for (int j = 0; j < 7; ++j) { int rank = 0;
#pragma unroll
            for (int i = 0; i < 7; ++i) { if (i != j) rank += (sc7[i] > sc7[j] || (sc7[i] == sc7[j] && i < j)) ? 1 : 0; }
            if (j < qb && (qb <= 3 || rank < 3)) selmask |= 1u << j; }
    }
    LAS unsigned* selp = (LAS unsigned*)(LAS char*)(uintptr_t)(unsigned)(uintptr_t)(lds + OFF_SEL) + tid;
    *selp = selmask;
    float m_reg = -1e30f, l_reg = 0; f32x16 o[4];
#pragma unroll
    for (int d = 0; d < 4; ++d)
#pragma unroll
        for (int r = 0; r < 16; ++r) o[d][r] = 0.f;
    const int sr = tid >> 4, sc = (tid & 15) * 8, vst0 = v_st(sr, sc), vst1 = v_st(32 + sr, sc), kws = KSWZ(sr, sc * 2);
    const unsigned kvoff = (unsigned)(sr * LDP + sc) * 2u;
    const int vb0 = (int)(uintptr_t)V_lds + v_rd_base(lane);
    const bf16_t* Kh = cur.K; const bf16_t* Vh = cur.V;
#define RESC(a) do { if (__any((a) < 1.f)) { if (hi == 0) al_l[r32] = (a); asm volatile("s_waitcnt lgkmcnt(0)" ::: "memory");              \
                     for (int d_ = 0; d_ < 4; ++d_) for (int r = 0; r < 16; ++r) o[d_][r] *= al_l[crow(r, hi)]; } } while (0)
#define KBASE(t) ((t) * KVBLK)
#define MASKT(P0_, P1_, t) do { const int kb_ = KBASE(t); const int jb_ = (t) >> 2; \
        const bool on_ = (jb_ == qb) || ((*selp >> jb_) & 1u); \
        bias_tile(P0_, P1_, on_ ? rtab + (kb_ + 4 * hi - qrow + 2047) : rtab + 2304); } while (0)
    constexpr int NQL = 8;
#define SEAM_K0() do { VMWN(NQL); SWRITE_HK(0); SBAR(); } while (0)
    f32x16 pA0, pA1, pB0, pB1; float mnA, mnB, alA, alB; bf16x8 pa0, pa1, pa2, pa3;
    SWRITE_HV(0); SBAR();
    if (NT > 1) { SLOAD_H(Kh, Vh, KBASE(1)); }
    SBAR(); qkt<0>(pA0, pA1, K_lds, r32, hi, S.qr);
    MASKT(pA0, pA1, 0); partialSM(pA0, pA1, m_reg, mnA, alA);
    if (NT > 1) { VMW(); SWRITE_H(1); }
    __syncthreads();
#define HALF_STEP(PX0, PX1, mnX, alX, PY0, PY1, alY, t, KB, VB, SB) do {                                                      \
        SBAR(); if ((t) + 1 < NT) { SLOAD_H(Kh, Vh, KBASE((t) + 1)); SBAR(); }      \
        qkt<KB>(PX0, PX1, K_lds, r32, hi, S.qr);                                             \
        finishSM(PY0, PY1, alY, l_reg, pa0, pa1, pa2, pa3); SBAR();                                                           \
        pv_tile<VB>(o, vb0, pa0, pa1, pa2, pa3); MASKT(PX0, PX1, (t)); partialSM(PX0, PX1, m_reg, mnX, alX);                                        \
        __syncthreads();                                                                                                      \
        if ((t) + 1 < NT) { VMW(); SWRITE_H(SB); }                                                                          \
        RESC(alX); __syncthreads(); } while (0)
    for (int t = 1; t + 1 < NT; t += 2) {
        HALF_STEP(pB0, pB1, mnB, alB, pA0, pA1, alA, t, 1, 0, 0);
        HALF_STEP(pA0, pA1, mnA, alA, pB0, pB1, alB, t + 1, 0, 1, 1);
    }
    { SBAR(); qkt<1>(pB0, pB1, K_lds, r32, hi, S.qr); SBAR(); }
    SLOAD_H(nxt.K, nxt.V, 0); SBAR();
    { const char* qb__ = (const char*)nxt.Q + (size_t)(wid * QBLK) * (LDP * 2); int l_ = lane; asm volatile("" : "+v"(l_));
      const unsigned qvoff = (unsigned)((l_ & 31) * LDP + (l_ >> 5) * 8) * 2u;
#pragma unroll
    for (int d0 = 0; d0 < 8; ++d0) S.qr[d0] = LD8(qb__ + qvoff + d0 * 32); }
    SBAR();
    finishSM(pA0, pA1, alA, l_reg, pa0, pa1, pa2, pa3); SBAR();
    pv_tile<0>(o, vb0, pa0, pa1, pa2, pa3);
    { MASKT(pB0, pB1, NT - 1); partialSM(pB0, pB1, m_reg, mnB, alB); __syncthreads(); RESC(alB);
      finishSM(pB0, pB1, alB, l_reg, pa0, pa1, pa2, pa3); SBAR(); pv_tile<1>(o, vb0, pa0, pa1, pa2, pa3); }
    SBAR(); SEAM_K0();
    if (hi == 0) li_l[r32] = l_reg; asm volatile("s_waitcnt lgkmcnt(0)" ::: "memory");
    float rli[16];
#pragma unroll
    for (int r = 0; r < 16; ++r) rli[r] = __builtin_amdgcn_rcpf(li_l[crow(r, hi)]);
    char* Ow = (char*)cur.O + (size_t)(wid * QBLK) * (LDO * 2); const unsigned ovoff = (unsigned)(4 * hi * LDO + r32) * 2u;
#pragma unroll
    for (int r = 0; r < 16; ++r) { const int orow0 = (r & 3) + 8 * (r >> 2);
#pragma unroll
        for (int d0 = 0; d0 < 4; ++d0) { const float v = o[d0][r] * rli[r];
            const float vn = __shfl_xor(v, 1);
            if ((r32 & 1) == 0) *(unsigned*)(Ow + (size_t)(orow0 * LDO * 2 + d0 * 64) + ovoff) = cvtpk(v, vn); } }
    __syncthreads();
    return next_item;
#undef RESC
#undef KBASE
#undef MASKT
#undef SEAM_K0
#undef HALF_STEP
}
#undef ROWP
#undef VMW
#undef VMWN
#undef LD8
#undef SLOAD_H
#undef SWRITE_HK
#undef SWRITE_HV
#undef SWRITE_H

__device__ __forceinline__ BlockRef make_ref(const P& a, int item) {
    const int qb = 7 - (item >> 6), bh = item & 63, b = bh >> 3, h = bh & 7;
    const bf16_t* proj = (const bf16_t*)(a.ws + WS_PROJ);
    BlockRef r; r.b = b; r.h = h; r.qb = qb;
    r.Q = proj + PROJ_BLK(C_QB + h * HD) + (size_t)(b * SEQ + qb * QB) * LDP;
    r.K = proj + PROJ_BLK(C_KB + h * HD) + (size_t)(b * SEQ) * LDP;
    r.V = proj + PROJ_BLK(C_VB + h * HD) + (size_t)(b * SEQ) * LDP;
    r.O = (bf16_t*)(a.ws + WS_OAB) + (size_t)(b * SEQ + qb * QB) * LDO + 1024 + h * HD;
    return r;
}
}
__device__ __forceinline__ void router_unit(const P& a, LAS unsigned char* lds, int unit) {
    int tid = threadIdx.x; asm volatile("" : "+v"(tid)); const int wave = __builtin_amdgcn_readfirstlane(tid >> 6), lane = tid & 63, c32 = lane & 31, hi = lane >> 5;
    const int tg = wave & 1, kq = wave >> 1;
    const bf16_t* x1 = (const bf16_t*)(a.ws + WS_X1); const float* g = a.in[11]; const float* br = a.in[13];
    unsigned char* A2 = a.ws + WS_A2; const u32x4* frag = (const u32x4*)(a.ws + WS_WRF);
    LAS float* Lw = (LAS float*)(lds + wave * 4352);
    LAS float* ssp = (LAS float*)(lds + 8 * 4352);
    LAS unsigned* hist = (LAS unsigned*)(lds + 8 * 4352 + 2048);
    LAS unsigned* base = hist + 32;
    if (tid < 32) hist[tid] = 0u;
    const int tok = unit * 64 + tg * 32 + c32;
    f32x16 L;
#pragma unroll
    for (int r = 0; r < 16; ++r) L[r] = 0.f;
    float ss = 0.f;
    const bf16_t* xr = x1 + (size_t)tok * D + 8 * hi + 256 * kq; unsigned char* ar = A2 + (size_t)tok * D + 8 * hi + 256 * kq; const float* gr = g + 8 * hi + 256 * kq;
#pragma unroll 4
    for (int s = 0; s < 16; ++s) {
        const u32x4 xw = *(const u32x4*)(xr + 16 * s); const f32x4 xa = {bflo(xw.x), bfhi(xw.x), bflo(xw.y), bfhi(xw.y)}, xb = {bflo(xw.z), bfhi(xw.z), bflo(xw.w), bfhi(xw.w)}, ga = *(const f32x4*)(gr + 16 * s), gb = *(const f32x4*)(gr + 16 * s + 4);
        ss += (xa.x * xa.x + xa.y * xa.y) + (xa.z * xa.z + xa.w * xa.w) + (xb.x * xb.x + xb.y * xb.y) + (xb.z * xb.z + xb.w * xb.w);
        const f32x4 va = xa * ga, vb = xb * gb;
        u32x4 wh; wh.x = cvt_pk_bf16(va.x, va.y); wh.y = cvt_pk_bf16(va.z, va.w); wh.z = cvt_pk_bf16(vb.x, vb.y); wh.w = cvt_pk_bf16(vb.z, vb.w);
        { u32x2 w8; w8.x = pk4_fp8(va.x, va.y, va.z, va.w); w8.y = pk4_fp8(vb.x, vb.y, vb.z, vb.w); *(u32x2*)(ar + 16 * s) = w8; }
        u32x4 wl; wl.x = cvt_pk_bf16(va.x - bflo(wh.x), va.y - bfhi(wh.x)); wl.y = cvt_pk_bf16(va.z - bflo(wh.y), va.w - bfhi(wh.y));
        wl.z = cvt_pk_bf16(vb.x - bflo(wh.z), vb.y - bfhi(wh.z)); wl.w = cvt_pk_bf16(vb.z - bflo(wh.w), vb.w - bfhi(wh.w));
        const bf16x8 ah = __builtin_bit_cast(bf16x8, wh), al = __builtin_bit_cast(bf16x8, wl);
        const bf16x8 bh = __builtin_bit_cast(bf16x8, frag[(16 * kq + s) * 64 + lane]), bl = __builtin_bit_cast(bf16x8, frag[4096 + (16 * kq + s) * 64 + lane]);
        L = __builtin_amdgcn_mfma_f32_32x32x16_bf16(ah, bh, L, 0, 0, 0);
        L = __builtin_amdgcn_mfma_f32_32x32x16_bf16(ah, bl, L, 0, 0, 0);
        L = __builtin_amdgcn_mfma_f32_32x32x16_bf16(al, bh, L, 0, 0, 0);
    }
#pragma unroll
    for (int r = 0; r < 16; ++r) Lw[((r & 3) + 8 * (r >> 2) + 4 * hi) * 33 + c32] = L[r];
    ssp[wave * 64 + lane] = ss;
    __syncthreads();
    int e4[4] = {0, 0, 0, 0}; float w4[4] = {0.f, 0.f, 0.f, 0.f}; unsigned loc[4] = {0u, 0u, 0u, 0u}; float rstd = 0.f;
    const bool sel = (wave < 2) && (hi == 0);
    if (sel) {
        float sst = 0.f;
#pragma unroll
        for (int q = 0; q < 4; ++q) sst += ssp[(wave + 2 * q) * 64 + c32] + ssp[(wave + 2 * q) * 64 + 32 + c32];
        rstd = 1.0f / sqrtf(sst * (1.0f / D) + EPS);
        float lg[32];
#pragma unroll
        for (int e = 0; e < 32; ++e) { const LAS float* lp = (const LAS float*)(lds + wave * 4352) + c32 * 33 + e; lg[e] = (lp[0] + lp[2 * 1088] + lp[4 * 1088] + lp[6 * 1088]) * rstd + br[e]; }
        unsigned used = 0u; float v4[4];
#pragma unroll
        for (int p = 0; p < 4; ++p) { float best = -__builtin_inff(); int bi = 0;
#pragma unroll
            for (int e = 0; e < 32; ++e) { const bool take = !((used >> e) & 1u) && lg[e] > best; best = take ? lg[e] : best; bi = take ? e : bi; }
            used |= 1u << bi; e4[p] = bi; v4[p] = best; }
        float sum = 0.f;
#pragma unroll
        for (int p = 0; p < 4; ++p) { w4[p] = expf(v4[p] - v4[0]); sum += w4[p]; }
        const float inv = 1.0f / sum;
#pragma unroll
        for (int p = 0; p < 4; ++p) { w4[p] *= inv; loc[p] = __hip_atomic_fetch_add(hist + e4[p], 1u, __ATOMIC_RELAXED, __HIP_MEMORY_SCOPE_WORKGROUP); }
    }
    __syncthreads();
    if (tid < 32) base[tid] = __hip_atomic_fetch_add((unsigned*)(a.ws + WS_CTL) + CW_COUNTS + tid, hist[tid], RLX_AGENT);
    __syncthreads();
    if (sel) {
        int* tope = (int*)(a.ws + WS_TOPE) + (size_t)tok * 4; float* wts = (float*)(a.ws + WS_WTS) + (size_t)tok * 4; int* slot = (int*)(a.ws + WS_SLOT) + (size_t)tok * 4;
#pragma unroll
        for (int p = 0; p < 4; ++p) { const int sl_ = (int)(base[e4[p]] + loc[p]); tope[p] = e4[p]; wts[p] = w4[p]; slot[p] = sl_;
            ((int*)(a.ws + WS_ROWE))[(size_t)e4[p] * T + sl_] = tok; ((float*)(a.ws + WS_RSTE))[(size_t)e4[p] * T + sl_] = rstd; }
    }
    __syncthreads();
}

__device__ __forceinline__ void moe_tables(const P& a, LAS unsigned char* lds) {
    int tid = threadIdx.x; asm volatile("" : "+v"(tid)); const int wave = tid >> 6, lane = tid & 63, e = lane & 31;
    LAS int* pstart = (LAS int*)(lds + LDS_MOE); LAS int* cnt = pstart + 64; LAS int* tile_e = pstart + 128;
    const unsigned* counts = (const unsigned*)(a.ws + WS_CTL) + CW_COUNTS;
    const int c = (int)counts[e]; const int p = ((c + 255) >> 8) << 8; int inc = p;
#pragma unroll
    for (int o = 1; o < 32; o <<= 1) { const int t = __builtin_amdgcn_ds_bpermute(((lane - o) & 63) << 2, inc); if (e >= o) inc += t; }
    if (tid < 32) { cnt[e] = c; pstart[e] = inc - p; if (e == 31) { pstart[32] = inc; tile_e[MAXTILES] = inc >> 8; } }
    for (int t = wave * 36; t < wave * 36 + 36; ++t) { const unsigned long long m = __ballot(inc <= t * 256); const int ee = __builtin_popcount((unsigned)m); if (lane == 0) tile_e[t] = ee < NE ? ee : NE - 1; }
    __syncthreads();
}

__device__ __forceinline__ void combine_rows(const P& a, LAS unsigned char* lds, int vcu, int G, int wave, int lane) {
    const LAS int* pstart = (const LAS int*)(lds + LDS_MOE);
    const int gw = vcu * NWAVES + wave, NGW = G * NWAVES;
    const bf16_t* X1 = (const bf16_t*)(a.ws + WS_X1); float* X = (float*)(a.ws + WS_X2); const unsigned char* Y = a.ws + WS_YROWS; bf16_t* A3 = (bf16_t*)(a.ws + WS_H);
    const int* tope = (const int*)(a.ws + WS_TOPE); const int* slot = (const int*)(a.ws + WS_SLOT); const float* wts = (const float*)(a.ws + WS_WTS); const float* g = a.in[20];
    f32x4 gv[4];
#pragma unroll
    for (int j = 0; j < 4; ++j) gv[j] = *((const f32x4*)g + lane + 64 * j);
    for (int m = gw; m < T; m += NGW) {
        f32x4* xr = (f32x4*)(X + (size_t)m * D) + lane; const u32x2* x1r = (const u32x2*)(X1 + (size_t)m * D) + lane; f32x4 v[4];
#pragma unroll
        for (int j = 0; j < 4; ++j) { const u32x2 xq = __builtin_nontemporal_load(x1r + 64 * j); v[j] = (f32x4){bflo(xq.x), bfhi(xq.x), bflo(xq.y), bfhi(xq.y)}; }
#pragma unroll
        for (int k = 0; k < 4; ++k) { const int d = __builtin_amdgcn_readfirstlane(pstart[tope[m * 4 + k]] + slot[m * 4 + k]); const float w = __uint_as_float(__builtin_amdgcn_readfirstlane(__float_as_uint(wts[m * 4 + k])));
            const unsigned* yr = (const unsigned*)(Y + (size_t)d * D) + lane;
#pragma unroll
            for (int j = 0; j < 4; ++j) { const int y = (int)__builtin_nontemporal_load(yr + 64 * j);
                v[j].x += w * __builtin_amdgcn_cvt_f32_fp8(y, 0); v[j].y += w * __builtin_amdgcn_cvt_f32_fp8(y, 1); v[j].z += w * __builtin_amdgcn_cvt_f32_fp8(y, 2); v[j].w += w * __builtin_amdgcn_cvt_f32_fp8(y, 3); } }
        float s = 0.f;
#pragma unroll
        for (int j = 0; j < 4; ++j) s += (v[j].x * v[j].x + v[j].y * v[j].y) + (v[j].z * v[j].z + v[j].w * v[j].w);
        const float rstd = 1.0f / sqrtf(wave_sum(s) * (1.0f / D) + EPS);
        unsigned* o4 = (unsigned*)((unsigned char*)A3 + (size_t)m * D) + lane;
#pragma unroll
        for (int j = 0; j < 4; ++j) { xr[64 * j] = v[j]; o4[64 * j] = pk4_fp8(v[j].x * rstd * gv[j].x, v[j].y * rstd * gv[j].y, v[j].z * rstd * gv[j].z, v[j].w * rstd * gv[j].w); }
    }
}
__device__ __forceinline__ void final_rows(const P& a, int vcu, int G, int wave, int lane) {
    const int gw = vcu * NWAVES + wave, NGW = G * NWAVES;
    const float* X = (const float*)(a.ws + WS_X2); float* OUT = a.out; const bf16_t* PG = (const bf16_t*)(a.ws + WS_PGATE); const bf16_t* PP = (const bf16_t*)(a.ws + WS_PPROJ);
    f32x4 gp[4], gf[4];
#pragma unroll
    for (int j = 0; j < 4; ++j) { gp[j] = *((const f32x4*)a.in[23] + lane + 64 * j); gf[j] = *((const f32x4*)a.in[24] + lane + 64 * j); }
    for (int m = gw; m < T; m += NGW) {
        const f32x4* xr = (const f32x4*)(X + (size_t)m * D) + lane; f32x4* orow = (f32x4*)(OUT + (size_t)m * D) + lane; const u32x2* pgr = (const u32x2*)(PG + (size_t)m * D) + lane; const u32x2* ppr = (const u32x2*)(PP + (size_t)m * D) + lane;
        f32x4 v[4], pp[4], pg[4]; float sp = 0.f;
#pragma unroll
        for (int j = 0; j < 4; ++j) { v[j] = __builtin_nontemporal_load(xr + 64 * j); const u32x2 q = __builtin_nontemporal_load(ppr + 64 * j), gq = __builtin_nontemporal_load(pgr + 64 * j);
            pp[j] = (f32x4){bflo(q.x), bfhi(q.x), bflo(q.y), bfhi(q.y)}; pg[j] = (f32x4){bflo(gq.x), bfhi(gq.x), bflo(gq.y), bfhi(gq.y)};
            sp += (pp[j].x * pp[j].x + pp[j].y * pp[j].y) + (pp[j].z * pp[j].z + pp[j].w * pp[j].w); }
        const float rp = 1.0f / sqrtf(wave_sum(sp) * (1.0f / D) + EPS); float s = 0.f;
#pragma unroll
        for (int j = 0; j < 4; ++j) { v[j] = v[j] + pg[j] * (pp[j] * rp * gp[j]); s += (v[j].x * v[j].x + v[j].y * v[j].y) + (v[j].z * v[j].z + v[j].w * v[j].w); }
        const float rstd = 1.0f / sqrtf(wave_sum(s) * (1.0f / D) + EPS);
#pragma unroll
        for (int j = 0; j < 4; ++j) __builtin_nontemporal_store(v[j] * rstd * gf[j], orow + 64 * j);
    }
}
struct Args { P p; };
template <int PH_LO, int PH_HI>
__global__ void __launch_bounds__(NTHREADS, 2) hybrid_fwd(Args args) {
    extern __shared__ __attribute__((aligned(16))) unsigned char lds_raw[];
    LAS unsigned char* lds = (LAS unsigned char*)lds_raw;
    const P& a = args.p;
    const int tid = threadIdx.x;
#define FRESH_WL() int t_ = threadIdx.x; asm volatile("" : "+v"(t_)); const int w_ = __builtin_amdgcn_readfirstlane(t_ >> 6), l_ = t_ & 63
    const int G = gridDim.x; const int bx = blockIdx.x; const int vcu = (G % 8 == 0) ? (bx % 8) * (G / 8) + bx / 8 : bx;
    unsigned* ctl = (unsigned*)(a.ws + WS_CTL);
    for (int u = tid; u < (LDS_BYTES - LDSCTL_OFF) / 4; u += NTHREADS) ((LAS unsigned*)(lds + LDSCTL_OFF))[u] = 0u;
    __syncthreads();
#if MK_PER_PHASE
#define GRID_BAR() do { } while (0)
#else
    XcdBarrier bar = xcd_barrier_post(ctl + CW_BAR, (volatile LAS unsigned*)(lds + MISC_OFF + 32));
#define GRID_BAR() xcd_barrier(bar)
#endif
    constexpr int lo = PH_LO, hi = PH_HI;
#define IN(k) (lo <= (k) && (k) < hi)
#define SEAM(k) do { if constexpr (IN(k) && IN((k) + 1)) GRID_BAR(); } while (0)
    unsigned char* ws = a.ws;

    if constexpr (IN(0)) { FRESH_WL(); p0_prologue(a, lds, vcu, G, w_, l_); }
    SEAM(0);
    if constexpr (IN(1)) {
        { pg8::DenseSched S; S.o.init(T / 256, 12, G, bx); S.Bt = (const char*)(ws + WS_WIN); S.K = D;
          pg8::EpiProj<false> E{(bf16_t*)(ws + WS_PROJ), (float*)(ws + WS_KMP)};
          pg8::gemm_phase(lds, (const char*)(ws + WS_H), D, D, D, S, E); }
        { pg8::DenseSched S; S.o.init(T / 256, 20, G, bx); S.Bt = (const char*)(ws + WS_WIN8); S.K = D; S.es = 1; S.pn0 = 12; S.bt_out = false;
          pg8::EpiProj<true> E{(bf16_t*)(ws + WS_PROJ), (float*)(ws + WS_KMP)};
          pg8::gemm_phase(lds, (const char*)(ws + WS_H8), D, D, D, S, E); }
    }
    SEAM(1);
    if constexpr (IN(2)) { for (int u = vcu; u < NB * 32; u += G) gla_prep_unit(a, lds, u); }
    SEAM(2);
    if constexpr (IN(3)) { for (int u = vcu; u < 512; u += G) gla_combine_unit(a, u); }
    SEAM(3);
    if constexpr (IN(4)) {
        for (int u = vcu; u < 1024; u += G) gla_out_unit(a, lds, u);
        __syncthreads();
    }
    if constexpr (IN(5)) {
        if ((vcu & 1) == 0) { FRESH_WL(); expert_convert(a, lds, vcu >> 1, G >> 1, w_, l_); __syncthreads(); }
        unsigned* queue = ctl + CW_QUEUE;
        volatile LAS int* qslot = (volatile LAS int*)(lds + LDSCTL_OFF + 1024);
        if (tid == 0) qslot[0] = (int)__hip_atomic_fetch_add(queue, 1u, RLX_AGENT);
        __syncthreads();
        int item = __builtin_amdgcn_readfirstlane(qslot[0]);
        if (item < 512) {
            moba::Seam S;
            moba::BlockRef cur = moba::make_ref(a, item);
            moba::prime(cur, (char*)lds_raw, S);
            for (;;) {
                const int nitem = moba::block(a, cur, queue, a.in[2], (const float*)(ws + WS_KMP), (char*)lds_raw, S);
                if (nitem >= 512) break;
                cur = moba::make_ref(a, nitem);
            }
        }
    }
    SEAM(5);
    if constexpr (IN(6)) {
        pg8::ChainSched S; S.o.init(T / 256, D / 256, G, bx); S.Bt = (const char*)(ws + WS_WUP); S.K = 1024;
        pg8::EpiMerge E{(const bf16_t*)(ws + WS_PROJ), (bf16_t*)(ws + WS_Y)};
        pg8::gemm_phase(lds, (const char*)(ws + WS_OAB), 1024, 2048, 2048, S, E);
    }
    SEAM(6);
    if constexpr (IN(7)) {
        pg8::DenseSched S; S.o.init(T / 256, D / 256, G, bx); S.Bt = (const char*)(ws + WS_WO); S.K = D;
        pg8::EpiResF32 E{a.in[0], (bf16_t*)(ws + WS_X1)};
        pg8::gemm_phase(lds, (const char*)(ws + WS_Y), D, D, D, S, E);
    }
    SEAM(7);
    if constexpr (IN(8)) { for (int u = vcu; u < T / 64; u += G) router_unit(a, lds, u); }
    SEAM(8);
    if constexpr (IN(9)) {
        moe_tables(a, lds); const LAS int* tab = (const LAS int*)(lds + LDS_MOE); const int ntile = __builtin_amdgcn_readfirstlane(tab[128 + MAXTILES]);
        pg8::MoeSched<true> S; S.o.init(ntile, 8, G, bx); S.Bt = (const char*)a.out; S.K = D; S.rows_per_e = 2048; S.tab = tab; S.row_e = (const int*)(ws + WS_ROWE); S.es = 1;
        pg8::EpiGlu E{(unsigned char*)(ws + WS_HMID), (const float*)(ws + WS_RSTE), tab, a.in[15], a.in[17], (const float*)(ws + WS_CTL) + 131072, lds};
        pg8::gemm_phase(lds, (const char*)(ws + WS_A2), D, D, D, S, E);
        const int extra = (ntile * 8) % G, nidle = G - extra;
        if (bx >= extra) { __syncthreads();
            pg8::DenseSched S2; S2.o.init(T / 256, D / 256, nidle, bx - extra); S2.Bt = (const char*)(ws + WS_WPP); S2.K = 256;
            pg8::EpiBf16<0, false> E2{(bf16_t*)(ws + WS_PPROJ), D, nullptr, 0, 1.0f};
            pg8::gemm_phase(lds, (const char*)(ws + WS_PB), 256, 256, 256, S2, E2); }
    }
    SEAM(9);
    if constexpr (IN(10)) {
        moe_tables(a, lds); const LAS int* tab = (const LAS int*)(lds + LDS_MOE); const int ntile = __builtin_amdgcn_readfirstlane(tab[128 + MAXTILES]);
        pg8::MoeSched<false> S; S.o.init(ntile, 4, G, bx); S.Bt = (const char*)(ws + WS_W2T); S.K = FF; S.rows_per_e = 1024; S.tab = tab; S.row_e = nullptr; S.es = 1;
        pg8::EpiDownF8 E{(unsigned char*)(ws + WS_YROWS), a.in[19]};
        pg8::gemm_phase(lds, (const char*)(ws + WS_HMID), FF, FF, FF, S, E);
    }
    SEAM(10);
    if constexpr (IN(11)) { moe_tables(a, lds); FRESH_WL(); combine_rows(a, lds, vcu, G, w_, l_); }
    SEAM(11);
    if constexpr (IN(12)) {
        { pg8::DenseSched S; S.o.init(T / 256, D / 256, G, bx); S.Bt = (const char*)(ws + WS_WPG); S.K = D; S.es = 1;
          pg8::EpiBf16<1, false, true> E{(bf16_t*)(ws + WS_PGATE), D, nullptr, 0, 1.0f / 32.0f};
          pg8::gemm_phase(lds, (const char*)(ws + WS_H), D, D, D, S, E); }
    }
    SEAM(12);
    if constexpr (IN(13)) { FRESH_WL(); final_rows(a, vcu, G, w_, l_); }
#undef FRESH_WL
#undef IN
#undef SEAM
#undef GRID_BAR
}

template <int LO, int HI> static void launch_range(const Args& a, int grid, hipStream_t stream) {
    static bool attr = false;
    if (!attr) { attr = true; if (hipFuncSetAttribute((const void*)hybrid_fwd<LO, HI>, hipFuncAttributeMaxDynamicSharedMemorySize, LDS_BYTES) != hipSuccess) fprintf(stderr, "kernel_launch: hipFuncSetAttribute failed\n"); }
    hipLaunchKernelGGL((hybrid_fwd<LO, HI>), dim3(grid), dim3(NTHREADS), LDS_BYTES, stream, a);
}
extern "C" void kernel_launch(void* const* d_in, const int* in_sizes, int n_in, void* d_out, int out_size, void* d_ws, size_t ws_size, hipStream_t stream) {
    static int grid = 0;
    if (grid == 0) {
        static const int expect[25] = {T * D, T * 256, 256, 1024, 1024 * D_IN, 16 * 512, 512, 256, 1048576, 1048576, 1048576, 1024, 32768, 32, 33554432, 32768, 33554432, 32768, 33554432, 32768, 1024, 1048576, 262144, 1024, 1024};
        bool okk = (n_in == 25);
        for (int i = 0; okk && i < 25; ++i) if (in_sizes[i] != expect[i]) { fprintf(stderr, "kernel_launch: input %d has %d elements, expected %d\n", i, in_sizes[i], expect[i]); okk = false; }
        if (!okk || out_size != T * D || ws_size < WS_END) { fprintf(stderr, "kernel_launch: unexpected shapes (n_in %d, in0 %d, out %d, ws %zu); nothing launched\n", n_in, n_in > 0 ? in_sizes[0] : -1, out_size, ws_size); grid = -1; return; }
        int dev = 0, cus = 0;
        if (hipGetDevice(&dev) != hipSuccess || hipDeviceGetAttribute(&cus, hipDeviceAttributeMultiprocessorCount, dev) != hipSuccess) { grid = -1; return; }
        grid = cus;
    }
    if (grid < 0) return;
    (void)hipMemsetAsync((char*)d_ws + WS_CTL, 0, CTL_ZERO_BYTES, stream);
    Args a{};
    for (int i = 0; i < 25; ++i) a.p.in[i] = (const float*)d_in[i];
    a.p.out = (float*)d_out; a.p.ws = (unsigned char*)d_ws;
#if MK_PER_PHASE
#ifndef MK_LAST
#define MK_LAST 13
#endif
#ifndef MK_REPEAT
#define MK_REPEAT 0
#endif
#define LR(k) do { if ((k) <= MK_LAST) for (int r_ = 0; r_ < 1 + ((MK_REPEAT >> (k)) & 1); ++r_) launch_range<(k), (k) + 1>(a, grid, stream); } while (0)
    LR(0); LR(1); LR(2); LR(3); LR(4); LR(5); LR(6); LR(7); LR(8); LR(9); LR(10); LR(11); LR(12); LR(13);
#undef LR
#else
    launch_range<0, NPHASES>(a, grid, stream);
#endif
}
```

```cpp
#include <hip/hip_runtime.h>
#include <cstdio>
#include <cstdint>

#define LAS __attribute__((address_space(3)))
#define GAS __attribute__((address_space(1)))
typedef unsigned short bf16_t;
typedef short bf16x8 __attribute__((ext_vector_type(8)));
typedef short s16x4 __attribute__((ext_vector_type(4)));
typedef float f32x2 __attribute__((ext_vector_type(2)));
typedef float f32x4 __attribute__((ext_vector_type(4)));
typedef float f32x16 __attribute__((ext_vector_type(16)));
typedef unsigned u32x2 __attribute__((ext_vector_type(2)));
typedef unsigned u32x4 __attribute__((ext_vector_type(4)));
typedef int i32x4 __attribute__((ext_vector_type(4)));
typedef int i32x8 __attribute__((ext_vector_type(8)));
typedef GAS unsigned gu32;
#define RLX_AGENT __ATOMIC_RELAXED, __HIP_MEMORY_SCOPE_AGENT
#define LDS_WAIT() asm volatile("s_waitcnt lgkmcnt(0)" ::: "memory")
#define VM_WAIT() asm volatile("s_waitcnt vmcnt(0)" ::: "memory")

#ifndef MK_PER_PHASE
#define MK_PER_PHASE 0
#endif

constexpr int NB = 8, SEQ = 2048, T = NB * SEQ, D = 1024;
constexpr int NPROJ = 8192;
constexpr int C_QA = 0, C_KA = 512, C_VA = 1024, C_RA = 2048, C_QB = 3072, C_KB = 4096, C_VB = 5120, C_GA = 6144, C_GB = 7168;
#define PROJ_BLK(cs) ((size_t)(cs) * T)
constexpr int SRC_ALOW = 3072, D_IN = 8208;
constexpr int NE = 32, FF = 1024, MAXTILES = 288, MAXROWS = MAXTILES * 256;
constexpr float EPS = 1e-6f;
constexpr int NWAVES = 8, NTHREADS = 512;
constexpr int NPHASES = 14;

constexpr size_t MiB = 1u << 20;
constexpr size_t WS_CTL = 0, CTL_ZERO_BYTES = 1 * MiB;
constexpr size_t WS_SMALL = 1 * MiB;
constexpr size_t WS_KMP   = WS_SMALL;
constexpr size_t WS_DEC   = WS_KMP + 512 * 1024;
constexpr size_t WS_TOPE  = WS_DEC + 512 * 1024;
constexpr size_t WS_WTS   = WS_TOPE + 256 * 1024;
constexpr size_t WS_SLOT  = WS_WTS + 256 * 1024;
constexpr size_t WS_DEST  = WS_SLOT + 256 * 1024;
constexpr size_t WS_ROWTOK = WS_DEST + 256 * 1024;
constexpr size_t WS_RSTDS = WS_ROWTOK + 320 * 1024;
constexpr size_t WS_RSTD  = WS_RSTDS + 320 * 1024;
constexpr size_t WS_TILEE = WS_RSTD + 64 * 1024;
constexpr size_t WS_WALT  = WS_TILEE + 4 * 1024;
constexpr size_t WS_WRF   = WS_WALT + 32 * 1024;
static_assert(WS_WRF + 128 * 1024 <= 6 * MiB, "small map");
constexpr size_t WS_WO = 6 * MiB, WS_WPG = 8 * MiB, WS_WPP = 10 * MiB, WS_WUP = 12 * MiB, WS_WIN = 16 * MiB;
constexpr size_t WS_PB = 34 * MiB;
constexpr size_t WS_H  = 42 * MiB;
constexpr size_t WS_PROJ = 74 * MiB;
constexpr size_t WS_QG = 330 * MiB, WS_KG = 346 * MiB;
constexpr size_t WS_SLOC = 426 * MiB;
constexpr size_t WS_OAB = 362 * MiB;
constexpr size_t WS_H8 = 426 * MiB;
constexpr size_t WS_WIN8 = 442 * MiB;
constexpr size_t WS_Y = 330 * MiB;
constexpr size_t WS_W2T = 42 * MiB;
constexpr size_t WS_A2 = 330 * MiB;
constexpr size_t WS_HMID = 138 * MiB;
constexpr size_t WS_X1 = 74 * MiB;
constexpr size_t WS_X2 = 138 * MiB;
constexpr size_t WS_YROWS = 282 * MiB;
constexpr size_t WS_PGATE = 330 * MiB, WS_PPROJ = 226 * MiB;
constexpr size_t WS_ROWE = 490 * MiB;
constexpr size_t WS_RSTE = 492 * MiB;
constexpr size_t WS_END = 506 * MiB;

constexpr int CW_BAR = 4096;
constexpr int CW_COUNTS = 16384;
constexpr int CW_QUEUE = 16384 + 64;

constexpr int RING_BYTES = 131072;
constexpr int LDSCTL_OFF = RING_BYTES, MISC_OFF = LDSCTL_OFF + 320;
constexpr int LDS_MOE = LDSCTL_OFF + 10240;
constexpr int EPF_OFF = LDSCTL_OFF + 12288;
constexpr int LDS_BYTES = 151552;

typedef __bf16 bf16v2_t __attribute__((ext_vector_type(2)));
__device__ __forceinline__ unsigned cvt_pk_bf16(float lo, float hi) { const f32x2 v = {lo, hi}; return __builtin_bit_cast(unsigned, __builtin_convertvector(v, bf16v2_t)); }
__device__ __forceinline__ unsigned pk4_fp8(float a, float b, float c, float d) { int w = 0; w = __builtin_amdgcn_cvt_pk_fp8_f32(a, b, w, false); w = __builtin_amdgcn_cvt_pk_fp8_f32(c, d, w, true); return (unsigned)w; }
__device__ __forceinline__ float bf2f(unsigned short s) { return __uint_as_float(((unsigned)s) << 16); }
__device__ __forceinline__ float bflo(unsigned w) { return __uint_as_float(w << 16); }
__device__ __forceinline__ float bfhi(unsigned w) { return __uint_as_float(w & 0xffff0000u); }
__device__ __forceinline__ float fsigmoid(float x) { return __builtin_amdgcn_rcpf(1.0f + __builtin_amdgcn_exp2f(-1.4426950408889634f * x)); }
__device__ __forceinline__ float wave_sum(float v) {
#pragma unroll
    for (int o = 1; o < 64; o <<= 1) v += __shfl_xor(v, o);
    return v;
}
__device__ __forceinline__ bf16x8 pack8(f32x4 a, f32x4 b) {
    u32x4 w = {cvt_pk_bf16(a[0], a[1]), cvt_pk_bf16(a[2], a[3]), cvt_pk_bf16(b[0], b[1]), cvt_pk_bf16(b[2], b[3])};
    return __builtin_bit_cast(bf16x8, w);
}

#define XB_TMO      128
#define XB_XCNT(j)  (256  + 64 * (j))
#define XB_XSUB(j)  (1280 + 64 * (j))
#define XB_XGEN(j)  (2304 + 64 * (j))
#define XB_TOP      3328
#define XB_TOPGEN   3392
#define XCD_BAR_WORDS 3456
#define XB_SPIN_CAP (1u << 18)

__device__ __forceinline__ unsigned xb_ld(unsigned* p)              { return __hip_atomic_load(p, __ATOMIC_RELAXED, __HIP_MEMORY_SCOPE_AGENT); }
__device__ __forceinline__ unsigned xb_add(unsigned* p, unsigned v) { return __hip_atomic_fetch_add(p, v, __ATOMIC_RELAXED, __HIP_MEMORY_SCOPE_AGENT); }
__device__ __forceinline__ unsigned xb_xcc_id() { return (unsigned)__builtin_amdgcn_s_getreg((3 << 11) | 20) & 0xFu; }
#define XB_SPIN(cond, bar) do { unsigned _sp = 0; while (cond) { __builtin_amdgcn_s_sleep(1); \
    if ((++_sp & 255u) == 0u) { if (xb_ld(&(bar)[XB_TMO])) break; if (_sp > XB_SPIN_CAP) { atomicAdd(&(bar)[XB_TMO], 1u); break; } } } } while (0)

struct XcdBarrier { unsigned* bar; unsigned x; volatile LAS unsigned* st; };

__device__ __forceinline__ XcdBarrier xcd_barrier_post(unsigned* bar, volatile LAS unsigned* st) {
    XcdBarrier b; b.bar = bar; b.x = xb_xcc_id(); b.st = st;
    if (threadIdx.x == 0) (void)xb_add(&bar[XB_XCNT(b.x)], 1u);
    return b;
}
__device__ __forceinline__ void xcd_barrier_complete(unsigned* bar, unsigned x, unsigned& nloc, unsigned& nx) {
    const unsigned G = gridDim.x * gridDim.y * gridDim.z;
    unsigned sum, cnt, mine, sp = 0u;
    for (;;) {
        sum = 0u; cnt = 0u; mine = 0u;
#pragma unroll
        for (unsigned j = 0; j < 16; ++j) { const unsigned c = xb_ld(&bar[XB_XCNT(j)]); sum += c; cnt += (c > 0u) ? 1u : 0u; mine = (j == x) ? c : mine; }
        if (sum == G) break;
        __builtin_amdgcn_s_sleep(1);
        if ((++sp & 255u) == 0u) { if (xb_ld(&bar[XB_TMO])) break; if (sp > XB_SPIN_CAP) { atomicAdd(&bar[XB_TMO], 1u); break; } }
    }
    nloc = mine > 0u ? mine : 1u; nx = cnt > 0u ? cnt : 1u;
}
__device__ __forceinline__ void xcd_barrier(const XcdBarrier& b) {
    asm volatile("s_waitcnt vmcnt(0)" ::: "memory");
    __syncthreads();
    if (threadIdx.x == 0) {
        unsigned* bar = b.bar;
        __builtin_amdgcn_s_waitcnt(0);
        unsigned nloc = b.st[0], nx = b.st[1];
        if (nloc == 0u) { xcd_barrier_complete(bar, b.x, nloc, nx); b.st[0] = nloc; b.st[1] = nx; }
        const unsigned old = xb_add(&bar[XB_XSUB(b.x)], 1u);
        const unsigned gen = old / nloc;
        if (old + 1u == (gen + 1u) * nloc) {
            __builtin_amdgcn_fence(__ATOMIC_RELEASE, "agent");
            asm volatile("s_waitcnt vmcnt(0)" ::: "memory");
            const unsigned og = xb_add(&bar[XB_TOP], 1u);
            const unsigned tg = og / nx;
            if (og + 1u == (tg + 1u) * nx) xb_add(&bar[XB_TOPGEN], 1u);
            else XB_SPIN(xb_ld(&bar[XB_TOPGEN]) == tg, bar);
            __builtin_amdgcn_fence(__ATOMIC_ACQUIRE, "agent");
            xb_add(&bar[XB_XGEN(b.x)], 1u);
            asm volatile("s_waitcnt vmcnt(0)" ::: "memory");
        } else {
            XB_SPIN(xb_ld(&bar[XB_XGEN(b.x)]) == gen, bar);
            __builtin_amdgcn_fence(__ATOMIC_ACQUIRE, "agent");
            asm volatile("s_waitcnt vmcnt(0)" ::: "memory");
        }
    }
    __syncthreads();
}
#ifndef MK_SCL
#define MK_SCL 0
#endif
namespace pg8 {
constexpr int BM = 256, BK = 64, HALF = 128, HTB = HALF * BK * 2, STAGE_BYTES = 8 * HTB, NXCD = 8, WGM = 8;

__host__ __device__ __forceinline__ int lds_byte(int r, int c) { const int st = (r >> 4) * 2 + (c >> 5), rr = r & 15, cc = c & 31, ob = rr * 64 + cc * 2; return st * 1024 + (ob ^ (((ob >> 9) & 1) << 5)); }
__host__ __device__ __forceinline__ void stage_rc(int b, int& R, int& C) { const int st = b / 1024, sb = b % 1024, swz = sb ^ (((sb >> 9) & 1) << 5); R = (st >> 1) * 16 + swz / 64; C = (st & 1) * 32 + (swz % 64) / 2; }
__host__ __device__ __forceinline__ int perm32(int rho) { const int n = rho >> 4, i = rho & 15; return 8 * (i >> 2) + 4 * n + (i & 3); }

struct Unit { int pm, pn, e, s; };

struct TileOrder {
    int nM, nN, nwg, G, c;
    __device__ __forceinline__ void init(int nM_, int nN_, int G_, int c_) { nM = nM_; nN = nN_; nwg = nM * nN; G = G_; c = c_; }
    __device__ __forceinline__ bool next(int i, int& pm, int& pn) const {
        const unsigned L = (unsigned)i * (unsigned)G + (unsigned)c; if (L >= (unsigned)nwg) return false;
        int wgid = (int)L; { const int q = nwg / NXCD, r = nwg % NXCD, xcd = wgid % NXCD, off = wgid / NXCD; wgid = (xcd < r ? xcd * (q + 1) : r * (q + 1) + (xcd - r) * q) + off; }
        const int nig = WGM * nN, gid = wgid / nig, fm = gid * WGM, gsz = (nM - fm) < WGM ? (nM - fm) : WGM;
        pm = fm + ((wgid % nig) % gsz); pn = (wgid % nig) / gsz; return true;
    }
};
struct DenseSched {
    TileOrder o; const char* Bt; int K; int es = 2; int gap_at = 1 << 30, gap_by = 0, pn0 = 0; bool bt_out = true;
    __device__ __forceinline__ bool next(int i, Unit& u) const { int p; if (!o.next(i, u.pm, p)) return false; u.e = p; u.pn = p + (p >= gap_at ? gap_by : 0) + pn0; return true; }
    __device__ __forceinline__ unsigned a_row(const Unit& u, int r) const { return (unsigned)(u.pm * BM + r); }
    __device__ __forceinline__ unsigned a_koff(const Unit&) const { return 0u; }
    __device__ __forceinline__ const char* b_base(const Unit& u) const { return Bt + (size_t)(bt_out ? u.pn : u.e) * BM * K * es; }
};
struct ChainSched {
    TileOrder o; const char* Bt; int K;
    __device__ __forceinline__ bool next(int i, Unit& u) const { if (!o.next(i >> 1, u.pm, u.pn)) return false; u.e = i & 1; return true; }
    __device__ __forceinline__ unsigned a_row(const Unit& u, int r) const { return (unsigned)(u.pm * BM + r); }
    __device__ __forceinline__ unsigned a_koff(const Unit& u) const { return (unsigned)(u.e * K * 2); }
    __device__ __forceinline__ const char* b_base(const Unit& u) const { return Bt + (size_t)u.pn * BM * (2 * K) * 2 + (size_t)u.e * K * 2; }
};
template <bool GATHER> struct MoeSched {
    TileOrder o; const char* Bt; int K; int rows_per_e; const LAS int* tab; const int* row_e; int es;
    __device__ __forceinline__ bool next(int i, Unit& u) const { if (!o.next(i, u.pm, u.pn)) return false; u.e = __builtin_amdgcn_readfirstlane(tab[128 + u.pm]); return true; }
    __device__ __forceinline__ unsigned a_row(const Unit& u, int r) const {
        if (GATHER) { const int lr = u.pm * BM + r - tab[u.e]; return lr < tab[64 + u.e] ? (unsigned)row_e[(size_t)u.e * T + lr] : 0u; }
        else return (unsigned)(u.pm * BM + r); }
    __device__ __forceinline__ unsigned a_koff(const Unit&) const { return 0u; }
    __device__ __forceinline__ const char* b_base(const Unit& u) const { return Bt + ((size_t)u.e * rows_per_e + (size_t)u.pn * BM) * K * es; }
};

template <class Epi, class Sched>
__device__ __forceinline__ void gemm_phase(LAS unsigned char* lds, const char* gA, int K_, int lda, int ldb, const Sched& S, const Epi& E) {
    int K = K_; asm volatile("" : "+s"(K));
    int tid = threadIdx.x; asm volatile("" : "+v"(tid));     const int wid = __builtin_amdgcn_readfirstlane(tid >> 6), lane = tid & 63, wr = wid >> 2, wc = wid & 3, fr = lane & 15, fq = lane >> 4;
    constexpr int ES = Epi::F8 ? 1 : 2;
    const int nt = K * ES / 128;
    unsigned voffB[2];
#pragma unroll
    for (int i = 0; i < 2; ++i) { int R, C; stage_rc(tid * 16 + i * 8192, R, C); const int Rb = Epi::PERM ? ((R & ~31) + perm32(R & 31)) : R; voffB[i] = (unsigned)(Rb * ldb * ES + C * 2); }
    const unsigned kstep = (unsigned)(BK * 2);
    const size_t hstepB = (size_t)HALF * ldb * ES;
    const unsigned ldab = (unsigned)lda * ES;
    const unsigned ldsw = (unsigned)wid * 1024u;
    const int aoff = lds_byte(wr * 64 + fr, fq * 8), boff = lds_byte(wc * 32 + fr, fq * 8);
#define PG8_SA(b, h) (((b) * 2 + (h)) * HTB)
#define PG8_SB(b, h) ((4 + (b) * 2 + (h)) * HTB)
#define PG8_STAGE_B(bufoff, gbase) do { _Pragma("unroll") for (int _i = 0; _i < 2; ++_i) \
        __builtin_amdgcn_global_load_lds((const unsigned*)((const char*)(gbase) + voffB[_i]), (LAS unsigned*)(lds + (bufoff) + ldsw + _i * 8192), 16, 0, 0); } while (0)
#define PG8_STAGE_A(bufoff, o0, o1, kb) do { \
        const char* gk_ = gA + (kb);      \
        __builtin_amdgcn_global_load_lds((const unsigned*)(gk_ + (o0)), (LAS unsigned*)(lds + (bufoff) + ldsw), 16, 0, 0); \
        __builtin_amdgcn_global_load_lds((const unsigned*)(gk_ + (o1)), (LAS unsigned*)(lds + (bufoff) + ldsw + 8192), 16, 0, 0); } while (0)
#define PG8_LDA(dst, b, h) do { _Pragma("unroll") for (int m = 0; m < 4; ++m) _Pragma("unroll") for (int k = 0; k < 2; ++k) dst[m][k] = *(const LAS bf16x8*)(lds + PG8_SA(b, h) + aoff + m * 2048 + k * 1024); } while (0)
#define PG8_LDB(dst, b, h) do { _Pragma("unroll") for (int n = 0; n < 2; ++n) _Pragma("unroll") for (int k = 0; k < 2; ++k) dst[n][k] = *(const LAS bf16x8*)(lds + PG8_SB(b, h) + boff + n * 2048 + k * 1024); } while (0)
#define PG8_MMA(ai, bj, At, Bt) do { __builtin_amdgcn_s_setprio(1); \
        if constexpr (Epi::F8) { _Pragma("unroll") for (int m = 0; m < 4; ++m) _Pragma("unroll") for (int n = 0; n < 2; ++n) { \
            const i32x8 a8_ = __builtin_shufflevector(__builtin_bit_cast(i32x4, At[m][0]), __builtin_bit_cast(i32x4, At[m][1]), 0, 1, 2, 3, 4, 5, 6, 7); \
            const i32x8 b8_ = __builtin_shufflevector(__builtin_bit_cast(i32x4, Bt[n][0]), __builtin_bit_cast(i32x4, Bt[n][1]), 0, 1, 2, 3, 4, 5, 6, 7); \
            acc[ai][bj][m][n] = __builtin_amdgcn_mfma_scale_f32_16x16x128_f8f6f4(b8_, a8_, acc[ai][bj][m][n], 0, 0, 0, MK_SCL, 0, MK_SCL); } } \
        else { _Pragma("unroll") for (int m = 0; m < 4; ++m) _Pragma("unroll") for (int n = 0; n < 2; ++n) _Pragma("unroll") for (int k = 0; k < 2; ++k) \
            acc[ai][bj][m][n] = __builtin_amdgcn_mfma_f32_16x16x32_bf16(Bt[n][k], At[m][k], acc[ai][bj][m][n], 0, 0, 0); } \
        __builtin_amdgcn_s_setprio(0); } while (0)
#define PG8_WAIT_V(n) asm volatile("s_waitcnt vmcnt(" #n ")" ::: "memory")
#define PG8_WAIT_L(n) asm volatile("s_waitcnt lgkmcnt(" #n ")" ::: "memory")
#define PG8_BAR __builtin_amdgcn_s_barrier()
#define PG8_SCHED __builtin_amdgcn_sched_barrier(0)
#define PG8_AOFFS(dst, u) do { int t_ = threadIdx.x; asm volatile("" : "+v"(t_));     \
        _Pragma("unroll") for (int _h = 0; _h < 2; ++_h) _Pragma("unroll") for (int _i = 0; _i < 2; ++_i) { int R_, C_; stage_rc(t_ * 16 + _i * 8192, R_, C_); \
        dst[_h][_i] = S.a_row(u, _h * HALF + R_) * ldab + (unsigned)C_ * 2u + S.a_koff(u); } } while (0)
    Unit cur, nxt; int ui = 0;
    if (!S.next(0, cur)) return;
    cur.s = 0;
    if constexpr (Epi::PREF) E.prefetch(cur, 0);
#ifdef MK_STAGGER
    if (S.o.nwg > 3 * S.o.G) {
        const unsigned long long t0_ = __builtin_amdgcn_s_memrealtime(); const unsigned long long d_ = (unsigned long long)((blockIdx.x >> 3) & 7) * MK_STAGGER;
        while (__builtin_amdgcn_s_memrealtime() - t0_ < d_) __builtin_amdgcn_s_sleep(4);
    }
#endif
    f32x4 acc[2][2][4][2];
#pragma unroll
    for (int a = 0; a < 2; ++a)
#pragma unroll
        for (int b = 0; b < 2; ++b)
#pragma unroll
            for (int m = 0; m < 4; ++m)
#pragma unroll
                for (int n = 0; n < 2; ++n) acc[a][b][m][n] = (f32x4){0.f, 0.f, 0.f, 0.f};
    bf16x8 At[4][2], B0[2][2], B1[2][2];
    unsigned oc[2][2];
    LAS u32x4* nslot = (LAS u32x4*)(lds + LDSCTL_OFF + 2048) + tid;
    PG8_AOFFS(oc, cur);
    const char* cB = S.b_base(cur);
    PG8_STAGE_B(PG8_SB(0, 0), cB); PG8_STAGE_B(PG8_SB(0, 1), cB + hstepB); PG8_STAGE_A(PG8_SA(0, 0), oc[0][0], oc[0][1], 0u); PG8_STAGE_A(PG8_SA(0, 1), oc[1][0], oc[1][1], 0u);
    if (wr == 1) PG8_BAR;
    PG8_WAIT_V(2); PG8_BAR;
    PG8_STAGE_B(PG8_SB(1, 0), cB + kstep); PG8_STAGE_A(PG8_SA(1, 0), oc[0][0], oc[0][1], kstep); PG8_STAGE_B(PG8_SB(1, 1), cB + hstepB + kstep);
    PG8_WAIT_V(6); PG8_BAR;
    for (;;) {
        const bool has_next = S.next(ui + 1, nxt);
        const char* nB = has_next ? S.b_base(nxt) : cB;
        if (has_next) { unsigned on[2][2]; PG8_AOFFS(on, nxt); *nslot = (u32x4){on[0][0], on[0][1], on[1][0], on[1][1]}; nxt.s = cur.s == 2 ? 0 : cur.s + 1;
            if constexpr (Epi::PREF) E.prefetch(nxt, nxt.s); }
        for (int t = 0; t < nt; t += 2) {
            const bool last = (t == nt - 2);
            const unsigned k1 = (unsigned)(t + 1) * kstep;
            const unsigned k2 = last ? 0u : (unsigned)(t + 2) * kstep, k3 = k2 + kstep;
            const char* b2 = last ? nB : cB + (size_t)(t + 2) * kstep; const char* b3 = b2 + kstep;
            PG8_LDB(B0, 0, 0); PG8_LDB(B1, 0, 1); PG8_SCHED; PG8_LDA(At, 0, 0); PG8_STAGE_A(PG8_SA(1, 1), oc[1][0], oc[1][1], k1);
            PG8_WAIT_V(8); PG8_WAIT_L(0); PG8_BAR; PG8_MMA(0, 0, At, B0); PG8_MMA(0, 1, At, B1); PG8_BAR; PG8_SCHED;
            if (last && has_next) { const u32x4 o_ = *nslot; oc[0][0] = o_.x; oc[0][1] = o_.y; oc[1][0] = o_.z; oc[1][1] = o_.w; }
            PG8_LDA(At, 0, 1); PG8_STAGE_B(PG8_SB(0, 0), b2); PG8_STAGE_B(PG8_SB(0, 1), b2 + hstepB); PG8_STAGE_A(PG8_SA(0, 0), oc[0][0], oc[0][1], k2);
            PG8_WAIT_V(8); PG8_WAIT_L(0); PG8_BAR; PG8_MMA(1, 0, At, B0); PG8_MMA(1, 1, At, B1); PG8_BAR; PG8_SCHED;
            PG8_LDB(B0, 1, 0); PG8_LDB(B1, 1, 1); PG8_SCHED; PG8_LDA(At, 1, 0); PG8_STAGE_A(PG8_SA(0, 1), oc[1][0], oc[1][1], k2);
            PG8_WAIT_V(8); PG8_WAIT_L(0); PG8_BAR; PG8_MMA(0, 0, At, B0); PG8_MMA(0, 1, At, B1); PG8_BAR; PG8_SCHED;
            PG8_LDA(At, 1, 1); PG8_STAGE_B(PG8_SB(1, 0), b3); PG8_STAGE_B(PG8_SB(1, 1), b3 + hstepB); PG8_STAGE_A(PG8_SA(1, 0), oc[0][0], oc[0][1], k3);
            PG8_WAIT_V(8); PG8_WAIT_L(0); PG8_BAR; PG8_MMA(1, 0, At, B0); PG8_MMA(1, 1, At, B1); PG8_BAR; PG8_SCHED;
        }
        if (wr == 0) PG8_BAR;
        bool carry = false;
        if constexpr (Epi::MIDK) { if (cur.e == 0) { E.mid(acc, cur, wr, wc, fr, fq); carry = true; } else E(acc, cur, wr, wc, fr, fq); } else E(acc, cur, wr, wc, fr, fq);
        if (!has_next) break;
        if (!carry)
#pragma unroll
        for (int a = 0; a < 2; ++a)
#pragma unroll
            for (int b = 0; b < 2; ++b)
#pragma unroll
                for (int m = 0; m < 4; ++m)
#pragma unroll
                    for (int n = 0; n < 2; ++n) acc[a][b][m][n] = (f32x4){0.f, 0.f, 0.f, 0.f};
        cur = nxt; cB = nB; ++ui;
        if (wr == 1) PG8_BAR;
    }
    PG8_WAIT_V(0);
    PG8_BAR;
#undef PG8_SA
#undef PG8_SB
#undef PG8_STAGE_A
#undef PG8_STAGE_B
#undef PG8_LDA
#undef PG8_LDB
#undef PG8_MMA
#undef PG8_WAIT_V
#undef PG8_WAIT_L
#undef PG8_BAR
#undef PG8_SCHED
#undef PG8_AOFFS
}

template <bool F8_> struct EpiProj {
    static constexpr bool PREF = false, PERM = true, MIDK = false, F8 = F8_;
    bf16_t* O; float* kmp;
    __device__ __forceinline__ void operator()(const f32x4 (&acc)[2][2][4][2], const Unit& u, int wr, int wc, int fr, int fq) const {
        const int row0 = u.pm * BM + wr * 64 + fr;
        const bool narrow = (u.pn < C_VA / BM) || (u.pn >= C_QB / BM && u.pn < C_GA / BM);
        const bool gate = u.pn >= C_GA / BM;
        const int hw = narrow ? 128 : 256; const size_t bjs = narrow ? (size_t)HALF * T : (size_t)HALF;
#pragma unroll
        for (int ai = 0; ai < 2; ++ai)
#pragma unroll
            for (int m = 0; m < 4; ++m) { bf16_t* rowp = O + PROJ_BLK(u.pn * BM) + (size_t)(row0 + ai * HALF + m * 16) * hw + wc * 32 + 8 * fq;
#pragma unroll
                for (int bj = 0; bj < 2; ++bj) { const float sc = F8 ? (1.0f / 32.0f) : 1.0f; const f32x4 v0 = acc[ai][bj][m][0] * sc, v1 = acc[ai][bj][m][1] * sc;
                    if (F8 && gate) { u32x2 w8; w8.x = pk4_fp8(v0[0], v0[1], v0[2], v0[3]); w8.y = pk4_fp8(v1[0], v1[1], v1[2], v1[3]);
                        __builtin_nontemporal_store(w8, (u32x2*)((unsigned char*)(O + PROJ_BLK(u.pn * BM)) + (size_t)(row0 + ai * HALF + m * 16) * 256 + bj * HALF + wc * 32 + 8 * fq)); continue; }
                    u32x4 w; w.x = cvt_pk_bf16(v0[0], v0[1]); w.y = cvt_pk_bf16(v0[2], v0[3]); w.z = cvt_pk_bf16(v1[0], v1[1]); w.w = cvt_pk_bf16(v1[2], v1[3]);
                    __builtin_nontemporal_store(w, (u32x4*)(rowp + bj * bjs)); } }
        if (u.pn >= C_KB / BM && u.pn < C_VB / BM) {
#pragma unroll
            for (int bj = 0; bj < 2; ++bj)
#pragma unroll
                for (int n = 0; n < 2; ++n) { f32x4 s = (f32x4){0.f, 0.f, 0.f, 0.f};
#pragma unroll
                    for (int ai = 0; ai < 2; ++ai)
#pragma unroll
                        for (int m = 0; m < 4; ++m) s += acc[ai][bj][m][n];
#pragma unroll
                    for (int o = 1; o < 16; o <<= 1) { s[0] += __shfl_xor(s[0], o); s[1] += __shfl_xor(s[1], o); s[2] += __shfl_xor(s[2], o); s[3] += __shfl_xor(s[3], o); }
                    if (fr == 0) *(f32x4*)(kmp + ((size_t)wr * 64 + u.pm) * 1024 + (u.pn - C_KB / BM) * BM + bj * HALF + wc * 32 + 8 * fq + 4 * n) = s * (F8 ? (1.0f / 32.0f) : 1.0f); }
        }
    }
};
struct EpiMerge {
    static constexpr bool PREF = false, PERM = true, MIDK = true, F8 = false;
    const bf16_t* proj; bf16_t* Y;
    __device__ __forceinline__ void mid(f32x4 (&acc)[2][2][4][2], const Unit& u, int wr, int wc, int fr, int fq) const {
        const int row0 = u.pm * BM + wr * 64 + fr; const int col0 = u.pn * BM + wc * 32 + 8 * fq;
#pragma unroll
        for (int ai = 0; ai < 2; ++ai) {
            u32x2 ga[4][2], gb[4][2];
#pragma unroll
            for (int m = 0; m < 4; ++m) { const unsigned char* rowp = (const unsigned char*)(proj + PROJ_BLK(u.pn * BM)) + (size_t)(row0 + ai * HALF + m * 16) * 256 + wc * 32 + 8 * fq;
#pragma unroll
                for (int bj = 0; bj < 2; ++bj) { ga[m][bj] = *(const u32x2*)(rowp + 2 * PROJ_BLK(C_GA) + bj * HALF); gb[m][bj] = *(const u32x2*)(rowp + 2 * PROJ_BLK(C_GB) + bj * HALF); } }
#pragma unroll
            for (int m = 0; m < 4; ++m) {
#pragma unroll
                for (int bj = 0; bj < 2; ++bj) {
#pragma unroll
                    for (int n = 0; n < 2; ++n) {
#define MG_R(b_) ((1.0f + __builtin_amdgcn_exp2f(-1.4426950408889634f * __builtin_amdgcn_cvt_f32_fp8((int)gb[m][bj][n], b_))) * __builtin_amdgcn_rcpf(1.0f + __builtin_amdgcn_exp2f(-1.4426950408889634f * __builtin_amdgcn_cvt_f32_fp8((int)ga[m][bj][n], b_))))
                        acc[ai][bj][m][n][0] *= MG_R(0); acc[ai][bj][m][n][1] *= MG_R(1); acc[ai][bj][m][n][2] *= MG_R(2); acc[ai][bj][m][n][3] *= MG_R(3);
#undef MG_R
                    } }
                asm volatile("" : "+v"(acc[ai][0][m][0]), "+v"(acc[ai][0][m][1]), "+v"(acc[ai][1][m][0]), "+v"(acc[ai][1][m][1])); }
            asm volatile("" ::: "memory"); }
    }
    __device__ __forceinline__ void operator()(const f32x4 (&acc)[2][2][4][2], const Unit& u, int wr, int wc, int fr, int fq) const {
        const int row0 = u.pm * BM + wr * 64 + fr; const int col0 = u.pn * BM + wc * 32 + 8 * fq;
#pragma unroll
        for (int ai = 0; ai < 2; ++ai) {
            u32x2 gb[4][2];
#pragma unroll
            for (int m = 0; m < 4; ++m)
#pragma unroll
                for (int bj = 0; bj < 2; ++bj) gb[m][bj] = *(const u32x2*)((const unsigned char*)(proj + PROJ_BLK(C_GB + u.pn * BM)) + (size_t)(row0 + ai * HALF + m * 16) * 256 + wc * 32 + 8 * fq + bj * HALF);
#pragma unroll
            for (int m = 0; m < 4; ++m) { const size_t r = (size_t)(row0 + ai * HALF + m * 16);
#pragma unroll
                for (int bj = 0; bj < 2; ++bj) { const u32x2 g = gb[m][bj];
                    const f32x4 v0 = acc[ai][bj][m][0], v1 = acc[ai][bj][m][1];
#define MG_S(w_, b_) fsigmoid(__builtin_amdgcn_cvt_f32_fp8((int)(w_), b_))
                    u32x4 w; w.x = cvt_pk_bf16(v0[0] * MG_S(g.x, 0), v0[1] * MG_S(g.x, 1)); w.y = cvt_pk_bf16(v0[2] * MG_S(g.x, 2), v0[3] * MG_S(g.x, 3));
                    w.z = cvt_pk_bf16(v1[0] * MG_S(g.y, 0), v1[1] * MG_S(g.y, 1)); w.w = cvt_pk_bf16(v1[2] * MG_S(g.y, 2), v1[3] * MG_S(g.y, 3));
#undef MG_S
                    *(u32x4*)(Y + r * D + col0 + bj * HALF) = w; } }
            asm volatile("" ::: "memory"); }
    }
};
struct EpiResF32 {
    static constexpr bool PREF = false, PERM = false, MIDK = false, F8 = false;
    const float* base; bf16_t* out;
    __device__ __forceinline__ void operator()(const f32x4 (&acc)[2][2][4][2], const Unit& u, int wr, int wc, int fr, int fq) const {
        const int row0 = u.pm * BM + wr * 64 + fr, col0 = u.pn * BM + wc * 32 + 4 * fq;
#pragma unroll
        for (int ai = 0; ai < 2; ++ai) {
            f32x4 bs[4][2][2];
#pragma unroll
            for (int m = 0; m < 4; ++m) { const size_t off = (size_t)(row0 + ai * HALF + m * 16) * D + col0;
#pragma unroll
                for (int bj = 0; bj < 2; ++bj)
#pragma unroll
                    for (int n = 0; n < 2; ++n) bs[m][bj][n] = __builtin_nontemporal_load((const f32x4*)(base + off + bj * HALF + n * 16)); }
#pragma unroll
            for (int m = 0; m < 4; ++m) { const size_t off = (size_t)(row0 + ai * HALF + m * 16) * D + col0;
#pragma unroll
                for (int bj = 0; bj < 2; ++bj)
#pragma unroll
                    for (int n = 0; n < 2; ++n) { const f32x4 v = bs[m][bj][n] + acc[ai][bj][m][n]; u32x2 w; w.x = cvt_pk_bf16(v[0], v[1]); w.y = cvt_pk_bf16(v[2], v[3]); *(u32x2*)(out + off + bj * HALF + n * 16) = w; } }
            asm volatile("" ::: "memory"); }
    }
};
struct EpiGlu {
    static constexpr bool PREF = true, PERM = true, MIDK = false, F8 = true;
    unsigned char* H; const float* rstd_e; const LAS int* tab; const float* bg; const float* bu; const float* zero; LAS unsigned char* lds;
    __device__ __forceinline__ void prefetch(const Unit& u, int slot) const {
        int tid = threadIdx.x; asm volatile("" : "+v"(tid)); const int wave = __builtin_amdgcn_readfirstlane(tid >> 6);
        const float* src;
        if (wave < 4) { const int lr = u.pm * BM + tid - tab[u.e]; src = lr < tab[64 + u.e] ? rstd_e + (size_t)u.e * T + lr : zero; }
        else { const int j = tid - 256; src = (j < 128 ? bg : bu) + (size_t)u.e * FF + u.pn * HALF + (j & 127); }
        __builtin_amdgcn_global_load_lds((const unsigned*)src, (LAS unsigned*)(lds + EPF_OFF + slot * 2048 + wave * 256), 4, 0, 0);
    }
    __device__ __forceinline__ void operator()(const f32x4 (&acc)[2][2][4][2], const Unit& u, int wr, int wc, int fr, int fq) const {
        const int row0 = u.pm * BM + wr * 64 + fr; const int colo = u.pn * HALF + wc * 32 + 8 * fq;
        const LAS float* ep = (const LAS float*)(lds + EPF_OFF + u.s * 2048);
        f32x4 g4[2], u4[2];
#pragma unroll
        for (int n = 0; n < 2; ++n) { g4[n] = *(const LAS f32x4*)(ep + 256 + wc * 32 + 8 * fq + 4 * n); u4[n] = *(const LAS f32x4*)(ep + 384 + wc * 32 + 8 * fq + 4 * n); }
        float rsv[2][4];
#pragma unroll
        for (int ai = 0; ai < 2; ++ai)
#pragma unroll
            for (int m = 0; m < 4; ++m) rsv[ai][m] = ep[wr * 64 + fr + ai * HALF + m * 16];
#pragma unroll
        for (int ai = 0; ai < 2; ++ai)
#pragma unroll
            for (int m = 0; m < 4; ++m) { const int r = row0 + ai * HALF + m * 16; const float rs = rsv[ai][m] * (1.0f / 32.0f);
                float o[8];
#pragma unroll
                for (int n = 0; n < 2; ++n)
#pragma unroll
                    for (int j = 0; j < 4; ++j) { float g = acc[ai][0][m][n][j] * rs + g4[n][j], up = acc[ai][1][m][n][j] * rs + u4[n][j];
                        g = fminf(g, 7.0f); up = fminf(fmaxf(up, -7.0f), 7.0f);
                        const float glu = g * fsigmoid(1.702f * g); o[n * 4 + j] = (up + 1.0f) * glu; }
                u32x2 w; w.x = pk4_fp8(o[0], o[1], o[2], o[3]); w.y = pk4_fp8(o[4], o[5], o[6], o[7]);
                *(u32x2*)(H + (size_t)r * FF + colo) = w; asm volatile("" ::: "memory"); }
    }
};
template <int ACT, bool HASBIAS, bool F8_ = false> struct EpiBf16 {
    static constexpr bool PREF = false, PERM = true, MIDK = false, F8 = F8_;
    bf16_t* O; int ldc; const float* bias; int bias_stride; float scale;
    __device__ __forceinline__ void operator()(const f32x4 (&acc)[2][2][4][2], const Unit& u, int wr, int wc, int fr, int fq) const {
        const int row0 = u.pm * BM + wr * 64 + fr; const int col0 = u.pn * BM + wc * 32 + 8 * fq;
        f32x4 bv[2][2];
#pragma unroll
        for (int bj = 0; bj < 2; ++bj)
#pragma unroll
            for (int n = 0; n < 2; ++n) bv[bj][n] = HASBIAS ? *(const f32x4*)(bias + (size_t)u.e * bias_stride + col0 + bj * HALF + 4 * n) : (f32x4){0.f, 0.f, 0.f, 0.f};
#pragma unroll
        for (int ai = 0; ai < 2; ++ai)
#pragma unroll
            for (int m = 0; m < 4; ++m) { bf16_t* rowp = O + (size_t)(row0 + ai * HALF + m * 16) * ldc + col0;
#pragma unroll
                for (int bj = 0; bj < 2; ++bj) { f32x4 v0 = acc[ai][bj][m][0] * scale + bv[bj][0], v1 = acc[ai][bj][m][1] * scale + bv[bj][1];
                    if (ACT == 1) {
#pragma unroll
                        for (int j = 0; j < 4; ++j) { v0[j] = fsigmoid(v0[j]); v1[j] = fsigmoid(v1[j]); } }
                    u32x4 w; w.x = cvt_pk_bf16(v0[0], v0[1]); w.y = cvt_pk_bf16(v0[2], v0[3]); w.z = cvt_pk_bf16(v1[0], v1[1]); w.w = cvt_pk_bf16(v1[2], v1[3]);
                    *(u32x4*)(rowp + bj * HALF) = w; }
                asm volatile("" ::: "memory"); }
    }
};
struct EpiDownF8 {
    static constexpr bool PREF = false, PERM = true, MIDK = false, F8 = true;
    unsigned char* O; const float* bias;
    __device__ __forceinline__ void operator()(const f32x4 (&acc)[2][2][4][2], const Unit& u, int wr, int wc, int fr, int fq) const {
        const int row0 = u.pm * BM + wr * 64 + fr; const int col0 = u.pn * BM + wc * 32 + 8 * fq;
        f32x4 bv[2][2];
#pragma unroll
        for (int bj = 0; bj < 2; ++bj)
#pragma unroll
            for (int n = 0; n < 2; ++n) bv[bj][n] = *(const f32x4*)(bias + (size_t)u.e * D + col0 + bj * HALF + 4 * n);
#pragma unroll
        for (int ai = 0; ai < 2; ++ai)
#pragma unroll
            for (int m = 0; m < 4; ++m) { unsigned char* rowp = O + (size_t)(row0 + ai * HALF + m * 16) * D + col0;
#pragma unroll
                for (int bj = 0; bj < 2; ++bj) { const f32x4 v0 = acc[ai][bj][m][0] * (1.0f / 32.0f) + bv[bj][0], v1 = acc[ai][bj][m][1] * (1.0f / 32.0f) + bv[bj][1];
                    u32x2 w; w.x = pk4_fp8(v0[0], v0[1], v0[2], v0[3]); w.y = pk4_fp8(v1[0], v1[1], v1[2], v1[3]);
                    *(u32x2*)(rowp + bj * HALF) = w; }
                asm volatile("" ::: "memory"); }
    }
};
}
__device__ __forceinline__ void transpose_item(const float* __restrict__ W, int ldw, int k0, int n_src0, bf16_t* __restrict__ WT, int ldo, int n_dst0, int k_off, LAS float* scr, int lane) {
    { float t_[32]; const float* wp_ = W + (size_t)(k0 + (lane >> 5)) * ldw + n_src0 + (lane & 31);
#pragma unroll
    for (int i = 0; i < 32; ++i) t_[i] = __builtin_nontemporal_load(wp_ + (size_t)(2 * i) * ldw);
#pragma unroll
    for (int i = 0; i < 32; ++i) scr[(2 * i + (lane >> 5)) * 33 + (lane & 31)] = t_[i]; }
    LDS_WAIT(); asm volatile("" ::: "memory");
    const int c = lane & 7;
#pragma unroll
    for (int j = 0; j < 4; ++j) { const int n = (lane >> 3) + 8 * j; const LAS float* s = scr + (8 * c) * 33 + n;
        u32x4 o; o.x = cvt_pk_bf16(s[0 * 33], s[1 * 33]); o.y = cvt_pk_bf16(s[2 * 33], s[3 * 33]); o.z = cvt_pk_bf16(s[4 * 33], s[5 * 33]); o.w = cvt_pk_bf16(s[6 * 33], s[7 * 33]);
        *(u32x4*)(WT + (size_t)(n_dst0 + n) * ldo + k_off + k0 + 8 * c) = o; }
    LDS_WAIT(); asm volatile("" ::: "memory");
}
__device__ __forceinline__ void transpose_item_f8(const float* __restrict__ W, int ldw, int k0, int n_src0, unsigned char* __restrict__ WT, int ldo, int n_dst0, float sc, LAS float* scr, int lane) {
    { float t_[32]; const float* wp_ = W + (size_t)(k0 + (lane >> 5)) * ldw + n_src0 + (lane & 31);
#pragma unroll
    for (int i = 0; i < 32; ++i) t_[i] = __builtin_nontemporal_load(wp_ + (size_t)(2 * i) * ldw);
#pragma unroll
    for (int i = 0; i < 32; ++i) scr[(2 * i + (lane >> 5)) * 33 + (lane & 31)] = t_[i]; }
    LDS_WAIT(); asm volatile("" ::: "memory");
    const int c = lane & 7;
#pragma unroll
    for (int j = 0; j < 4; ++j) { const int n = (lane >> 3) + 8 * j; const LAS float* s = scr + (8 * c) * 33 + n;
        u32x2 o; o.x = pk4_fp8(s[0 * 33] * sc, s[1 * 33] * sc, s[2 * 33] * sc, s[3 * 33] * sc); o.y = pk4_fp8(s[4 * 33] * sc, s[5 * 33] * sc, s[6 * 33] * sc, s[7 * 33] * sc);
        *(u32x2*)(WT + (size_t)(n_dst0 + n) * ldo + k0 + 8 * c) = o; }
    LDS_WAIT(); asm volatile("" ::: "memory");
}
__device__ __forceinline__ void transpose_mat_item(const float* W, int ldw, int N, int n_src_base, bf16_t* WT, int ldo, int n_dst_base, int k_off, LAS float* scr, int item, int lane) {
    const int nblk = N / 32, kb = item / nblk, nb = item % nblk;
    transpose_item(W, ldw, 64 * kb, n_src_base + 32 * nb, WT, ldo, n_dst_base + 32 * nb, k_off, scr, lane);
}

struct P {
    const float* in[25]; float* out; unsigned char* ws;
};

__device__ __forceinline__ void p0_prologue(const P& a, LAS unsigned char* lds, int vcu, int G, int wave, int lane) {
    LAS float* scr = (LAS float*)(lds + wave * 16384);
    const int gw = vcu * NWAVES + wave, NGW = G * NWAVES;
    unsigned char* ws = a.ws;
    bf16_t* WinT = (bf16_t*)(ws + WS_WIN); bf16_t* WupT = (bf16_t*)(ws + WS_WUP); bf16_t* WoT = (bf16_t*)(ws + WS_WO); bf16_t* WpgT = (bf16_t*)(ws + WS_WPG); bf16_t* WppT = (bf16_t*)(ws + WS_WPP);
    constexpr int I_A = 16 * 96, I_B8 = 16 * 160, I_B = 0, I_S = 16 * 32, I_P = 4 * 32;
    constexpr int NITEMS = I_A + I_B8 + I_B + 4 * I_S + I_P;
#ifndef P0_PARTS
#define P0_PARTS 63
#endif
    if (P0_PARTS & 1)
    for (int it = gw; it < NITEMS; it += NGW) {
        int r = it;
        if (r < I_A) { transpose_mat_item(a.in[4], D_IN, 3072, 0, WinT, D, 0, 0, scr, r, lane); continue; } r -= I_A;
        if (r < I_B8) { const int kb = r / 160, nb = r % 160; transpose_item_f8(a.in[4], D_IN, 64 * kb, 3088 + 32 * nb, ws + WS_WIN8, D, 32 * nb, 32.0f, scr, lane); continue; } r -= I_B8;
        if (r < I_S) { transpose_mat_item(a.in[8], D, D, 0, WupT, 2048, 0, 0, scr, r, lane); continue; } r -= I_S;
        if (r < I_S) { transpose_mat_item(a.in[9], D, D, 0, WupT, 2048, 0, 1024, scr, r, lane); continue; } r -= I_S;
        if (r < I_S) { transpose_mat_item(a.in[10], D, D, 0, WoT, D, 0, 0, scr, r, lane); continue; } r -= I_S;
        if (r < I_S) { const int kb = r / 32, nb = r % 32; transpose_item_f8(a.in[21], D, 64 * kb, 32 * nb, (unsigned char*)WpgT, D, 32 * nb, 32.0f, scr, lane); continue; } r -= I_S;
        transpose_mat_item(a.in[22], D, D, 0, WppT, 256, 0, 0, scr, r, lane);
    }
    if (P0_PARTS & 2) {
        const float* x = a.in[0]; const float* g = a.in[3]; bf16_t* H = (bf16_t*)(ws + WS_H);
        f32x4 gv[4];
#pragma unroll
        for (int j = 0; j < 4; ++j) gv[j] = *((const f32x4*)g + lane + 64 * j);
        f32x4 va[4], vb[4];
#define H_LOAD(m_, V) do { if ((m_) < T) { const f32x4* xr = (const f32x4*)(x + (size_t)(m_) * D) + lane; _Pragma("unroll") for (int j = 0; j < 4; ++j) V[j] = __builtin_nontemporal_load(xr + 64 * j); } } while (0)
#define H_DO(m_, V) do { if ((m_) < T) { float s_ = 0.f; \
            _Pragma("unroll") for (int j = 0; j < 4; ++j) s_ += (V[j].x * V[j].x + V[j].y * V[j].y) + (V[j].z * V[j].z + V[j].w * V[j].w); \
            const float rstd = 1.0f / sqrtf(wave_sum(s_) * (1.0f / D) + EPS); \
            u32x2* o8 = (u32x2*)(H + (size_t)(m_) * D) + lane; unsigned* q8 = (unsigned*)(ws + WS_H8 + (size_t)(m_) * D) + lane; \
            _Pragma("unroll") for (int j = 0; j < 4; ++j) { const f32x4 y = V[j] * rstd * gv[j]; u32x2 w; w.x = cvt_pk_bf16(y.x, y.y); w.y = cvt_pk_bf16(y.z, y.w); o8[64 * j] = w; q8[64 * j] = pk4_fp8(y.x, y.y, y.z, y.w); } } } while (0)
        H_LOAD(gw, va);
        for (int m = gw; m < T; m += 2 * NGW) { H_LOAD(m + NGW, vb); H_DO(m, va); H_LOAD(m + 2 * NGW, va); H_DO(m + NGW, vb); }
#undef H_LOAD
#undef H_DO
    }
    if (P0_PARTS & 4) {
        const f32x4* p4 = (const f32x4*)a.in[1]; u32x2* pb = (u32x2*)(ws + WS_PB);
        const size_t n4 = (size_t)T * 256 / 4;
        for (size_t i = (size_t)gw * 64 + lane; i < n4; i += (size_t)NGW * 64) { const f32x4 v = __builtin_nontemporal_load(p4 + i); u32x2 w; w.x = cvt_pk_bf16(v.x, v.y); w.y = cvt_pk_bf16(v.z, v.w); pb[i] = w; }
    }
    if (P0_PARTS & 8) {
        const int gt = (vcu * NWAVES + wave) * 64 + lane;
        if ((P0_PARTS & 16) && gt < 16 * 1024) { const int n = gt >> 10, k = gt & 1023; ((bf16_t*)(ws + WS_WALT))[n * 1024 + k] = (bf16_t)(cvt_pk_bf16(a.in[4][(size_t)k * D_IN + SRC_ALOW + n], 0.f) & 0xffffu); }
        if ((P0_PARTS & 32) && gt < 4096) { const int s = gt >> 6, l = gt & 63, e = l & 31, hh = l >> 5; const float* wr = a.in[12];
            float v[8], lo[8];
#pragma unroll
            for (int j = 0; j < 8; ++j) { v[j] = wr[(size_t)(16 * s + 8 * hh + j) * NE + e]; }
            u32x4 whi; whi.x = cvt_pk_bf16(v[0], v[1]); whi.y = cvt_pk_bf16(v[2], v[3]); whi.z = cvt_pk_bf16(v[4], v[5]); whi.w = cvt_pk_bf16(v[6], v[7]);
#pragma unroll
            for (int j = 0; j < 4; ++j) { lo[2 * j] = v[2 * j] - bflo(whi[j]); lo[2 * j + 1] = v[2 * j + 1] - bfhi(whi[j]); }
            u32x4 wlo; wlo.x = cvt_pk_bf16(lo[0], lo[1]); wlo.y = cvt_pk_bf16(lo[2], lo[3]); wlo.z = cvt_pk_bf16(lo[4], lo[5]); wlo.w = cvt_pk_bf16(lo[6], lo[7]);
            u32x4* f = (u32x4*)(ws + WS_WRF); f[gt] = whi; f[4096 + gt] = wlo; }
    }
}

struct CvtItem { const float* src; unsigned char* dst; int ldo; };
__device__ __forceinline__ CvtItem cvt_item(const P& a, int it, int lane) {
    constexpr int IPM = 16 * 32;
    const int e = it / (3 * IPM), r0 = it % (3 * IPM), which = r0 / IPM, r = r0 % IPM, kb = r / 32, nb = r % 32, n0 = 32 * nb;
    CvtItem c;
    if (which < 2) { c.src = a.in[which == 0 ? 14 : 16] + (size_t)e * D * FF + (size_t)(64 * kb + (lane >> 5)) * FF + n0 + (lane & 31);
        c.dst = (unsigned char*)a.out + ((size_t)e * 2048 + (n0 >> 7) * 256 + (n0 & 127) + which * 128) * D + 64 * kb; c.ldo = D; }
    else { c.src = a.in[18] + (size_t)e * FF * D + (size_t)(64 * kb + (lane >> 5)) * D + n0 + (lane & 31);
        c.dst = a.ws + WS_W2T + ((size_t)e * D + n0) * FF + 64 * kb; c.ldo = FF; }
    return c;
}
__device__ __forceinline__ void expert_convert(const P& a, LAS unsigned char* lds, int vcu, int G, int wave, int lane) {
    LAS float* scr = (LAS float*)(lds + wave * 16384);
    const int gw = vcu * NWAVES + wave, NGW = G * NWAVES;
    constexpr int NIT = NE * 3 * 16 * 32;
    if (gw >= NIT) return;
    float tA[32], tB[32];
    CvtItem cA = cvt_item(a, gw, lane), cB = cvt_item(a, gw + NGW < NIT ? gw + NGW : gw, lane);
#pragma unroll
    for (int i = 0; i < 32; ++i) tA[i] = __builtin_nontemporal_load(cA.src + (size_t)(2 * i) * 1024);
#pragma unroll
    for (int i = 0; i < 32; ++i) tB[i] = __builtin_nontemporal_load(cB.src + (size_t)(2 * i) * 1024);
#define CVT_OUT(c_) do { LDS_WAIT(); asm volatile("" ::: "memory"); const int c = lane & 7; \
        _Pragma("unroll") for (int j = 0; j < 4; ++j) { const int n = (lane >> 3) + 8 * j; const LAS float* s = scr + (8 * c) * 33 + n; \
            u32x2 o; o.x = pk4_fp8(s[0 * 33] * 32.0f, s[1 * 33] * 32.0f, s[2 * 33] * 32.0f, s[3 * 33] * 32.0f); o.y = pk4_fp8(s[4 * 33] * 32.0f, s[5 * 33] * 32.0f, s[6 * 33] * 32.0f, s[7 * 33] * 32.0f); \
            __builtin_nontemporal_store(o, (u32x2*)((c_).dst + (size_t)n * (c_).ldo + 8 * c)); } \
        LDS_WAIT(); asm volatile("" ::: "memory"); } while (0)
    for (int it = gw; it < NIT; it += 2 * NGW) {
#pragma unroll
        for (int i = 0; i < 32; ++i) scr[(2 * i + (lane >> 5)) * 33 + (lane & 31)] = tA[i];
        const CvtItem dA = cA; const int n2 = it + 2 * NGW;
        if (n2 < NIT) { cA = cvt_item(a, n2, lane);
#pragma unroll
            for (int i = 0; i < 32; ++i) tA[i] = __builtin_nontemporal_load(cA.src + (size_t)(2 * i) * 1024); }
        CVT_OUT(dA);
        if (it + NGW >= NIT) break;
#pragma unroll
        for (int i = 0; i < 32; ++i) scr[(2 * i + (lane >> 5)) * 33 + (lane & 31)] = tB[i];
        const CvtItem dB = cB; const int n3 = it + 3 * NGW;
        if (n3 < NIT) { cB = cvt_item(a, n3, lane);
#pragma unroll
            for (int i = 0; i < 32; ++i) tB[i] = __builtin_nontemporal_load(cB.src + (size_t)(2 * i) * 1024); }
        CVT_OUT(dB);
    }
#undef CVT_OUT
}

__device__ __forceinline__ float fexp_(float x) { return __builtin_amdgcn_exp2f(x * 1.4426950408889634f); }
__device__ __forceinline__ float logsigmoidf_(float x) { const float e = fexp_(-fabsf(x)); return fminf(x, 0.0f) - 0.6931471805599453f * __builtin_amdgcn_logf(1.0f + e); }
__device__ __forceinline__ void gla_prep_unit(const P& a, LAS unsigned char* lds, int unit) {
    int tid = threadIdx.x; asm volatile("" : "+v"(tid));     const int wave = __builtin_amdgcn_readfirstlane(tid >> 6), lane = tid & 63;
    const int b = unit >> 5, chunk = unit & 31, tok0 = b * SEQ + chunk * 64;
    const bf16_t* H = (const bf16_t*)(a.ws + WS_H); const bf16_t* WalT = (const bf16_t*)(a.ws + WS_WALT); const bf16_t* proj = (const bf16_t*)(a.ws + WS_PROJ);
    LAS float* part = (LAS float*)lds;
    LAS float* alow = (LAS float*)(lds + 8192);
    LAS float* seg = (LAS float*)(lds + 12288);
    constexpr int GP_KDT = 16384, GP_VT = 34816;
    {
        const int rg = wave & 3, kh = wave >> 2, r = lane & 15, q = lane >> 4;
        f32x4 acc = (f32x4){0.f, 0.f, 0.f, 0.f};
        const bf16_t* ap = H + (size_t)(tok0 + 16 * rg + r) * D + 512 * kh + 8 * q; const bf16_t* bp = WalT + (size_t)r * D + 512 * kh + 8 * q;
#pragma unroll 8
        for (int s = 0; s < 16; ++s) { const bf16x8 av = *(const bf16x8*)(ap + 32 * s), bv = *(const bf16x8*)(bp + 32 * s); acc = __builtin_amdgcn_mfma_f32_16x16x32_bf16(bv, av, acc, 0, 0, 0); }
        *(LAS f32x4*)(part + (kh * 64 + 16 * rg + r) * 16 + 4 * q) = acc;
    }
    __syncthreads();
    if (tid < 256) { *(LAS f32x4*)(alow + tid * 4) = *(LAS f32x4*)(part + tid * 4) + *(LAS f32x4*)(part + 1024 + tid * 4); }
    __syncthreads();
    const int dp = tid & 63, tq = wave;
    const float* w_a2 = a.in[5]; const float* b_a2 = a.in[6];
    const int ep = tid & 127, sq4 = tid >> 7;
    f32x2 w2[16], w2n[16]; f32x2 b2, b2n; unsigned qv[8], kv[8], qvn[8], kvn[8], sv[16], svn[16];
#define GP_LOADS(h_, W2, B2, QV, KV, SV) do { const int dc_ = (h_) * 128 + 2 * dp; \
        _Pragma("unroll") for (int r = 0; r < 16; ++r) W2[r] = *(const f32x2*)(w_a2 + r * 512 + dc_); \
        B2 = *(const f32x2*)(b_a2 + dc_); \
        _Pragma("unroll") for (int i = 0; i < 8; ++i) { const bf16_t* rp = proj + PROJ_BLK((h_) * 128) + (size_t)(tok0 + 8 * tq + i) * 128 + 2 * dp; QV[i] = __builtin_nontemporal_load((const unsigned*)(rp + PROJ_BLK(C_QA))); KV[i] = __builtin_nontemporal_load((const unsigned*)(rp + PROJ_BLK(C_KA))); } \
        const bf16_t* v_ = proj + PROJ_BLK(C_VA + (h_) * 256) + (size_t)(tok0 + 16 * sq4) * 256 + 2 * ep; \
        _Pragma("unroll") for (int i = 0; i < 16; ++i) SV[i] = __builtin_nontemporal_load((const unsigned*)(v_ + (size_t)i * 256)); } while (0)
    GP_LOADS(0, w2, b2, qv, kv, sv);
    for (int h = 0; h < 4; ++h) {
        if (h + 1 < 4) GP_LOADS(h + 1, w2n, b2n, qvn, kvn, svn);
        float G0[8], G1[8]; float r0 = 0.f, r1 = 0.f;
#pragma unroll
        for (int i = 0; i < 8; ++i) { const LAS f32x4* al4 = (const LAS f32x4*)(alow + (8 * tq + i) * 16); float x0 = b2.x, x1 = b2.y;
#pragma unroll
            for (int r4 = 0; r4 < 4; ++r4) { const f32x4 al = al4[r4];
#pragma unroll
                for (int j = 0; j < 4; ++j) { x0 += al[j] * w2[4 * r4 + j].x; x1 += al[j] * w2[4 * r4 + j].y; } }
            r0 += logsigmoidf_(x0) * (1.0f / 16.0f); r1 += logsigmoidf_(x1) * (1.0f / 16.0f); G0[i] = r0; G1[i] = r1; }
        *(LAS f32x2*)(seg + tq * 128 + 2 * dp) = (f32x2){r0, r1};
        __syncthreads();
        float off0 = 0.f, off1 = 0.f, tot0 = 0.f, tot1 = 0.f;
#pragma unroll
        for (int q = 0; q < 8; ++q) { const f32x2 s = *(LAS f32x2*)(seg + q * 128 + 2 * dp); tot0 += s.x; tot1 += s.y; if (q < tq) { off0 += s.x; off1 += s.y; } }
        const size_t tile = (size_t)((b * 4 + h) * 32 + chunk);
        bf16_t* Qg = (bf16_t*)(a.ws + WS_QG) + tile * 8192; bf16_t* Kg = (bf16_t*)(a.ws + WS_KG) + tile * 8192;
        float kd0[8], kd1[8];
#pragma unroll
        for (int i = 0; i < 8; ++i) { const float g0 = G0[i] + off0, g1 = G1[i] + off1; const float q0 = bflo(qv[i]), q1 = bfhi(qv[i]), k0 = bflo(kv[i]), k1 = bfhi(kv[i]);
            const float e0 = fexp_(g0), e1 = fexp_(g1);
            *(unsigned*)(Qg + (8 * tq + i) * 128 + 2 * dp) = cvt_pk_bf16(q0 * e0 * 0.08838834764831845f, q1 * e1 * 0.08838834764831845f);
            *(unsigned*)(Kg + (8 * tq + i) * 128 + 2 * dp) = cvt_pk_bf16(k0 * __builtin_amdgcn_rcpf(e0), k1 * __builtin_amdgcn_rcpf(e1));
            kd0[i] = k0 * fexp_(tot0 - g0); kd1[i] = k1 * fexp_(tot1 - g1); }
        u32x4 w0, w1; w0.x = cvt_pk_bf16(kd0[0], kd0[1]); w0.y = cvt_pk_bf16(kd0[2], kd0[3]); w0.z = cvt_pk_bf16(kd0[4], kd0[5]); w0.w = cvt_pk_bf16(kd0[6], kd0[7]);
        w1.x = cvt_pk_bf16(kd1[0], kd1[1]); w1.y = cvt_pk_bf16(kd1[2], kd1[3]); w1.z = cvt_pk_bf16(kd1[4], kd1[5]); w1.w = cvt_pk_bf16(kd1[6], kd1[7]);
        *(LAS u32x4*)(lds + GP_KDT + (2 * dp) * 144 + 16 * tq) = w0; *(LAS u32x4*)(lds + GP_KDT + (2 * dp + 1) * 144 + 16 * tq) = w1;
        if (tq == 0) *(f32x2*)((float*)(a.ws + WS_DEC) + tile * 128 + 2 * dp) = (f32x2){fexp_(tot0), fexp_(tot1)};
        {
            u32x4 lo0, lo1, hi0, hi1;
#pragma unroll
            for (int j = 0; j < 4; ++j) { lo0[j] = (sv[2 * j] & 0xffffu) | (sv[2 * j + 1] << 16); lo1[j] = (sv[8 + 2 * j] & 0xffffu) | (sv[8 + 2 * j + 1] << 16);
                hi0[j] = (sv[2 * j] >> 16) | (sv[2 * j + 1] & 0xffff0000u); hi1[j] = (sv[8 + 2 * j] >> 16) | (sv[8 + 2 * j + 1] & 0xffff0000u); }
            LAS unsigned char* v0 = lds + GP_VT + (2 * ep) * 144 + sq4 * 32;
            *(LAS u32x4*)(v0) = lo0; *(LAS u32x4*)(v0 + 16) = lo1; *(LAS u32x4*)(v0 + 144) = hi0; *(LAS u32x4*)(v0 + 144 + 16) = hi1;
        }
        __syncthreads();
        {
            const int c32 = lane & 31, hi = lane >> 5;
            bf16x8 vt[4];
#pragma unroll
            for (int ks = 0; ks < 4; ++ks) vt[ks] = *(const LAS bf16x8*)(lds + GP_VT + (32 * wave + c32) * 144 + (16 * ks + 8 * hi) * 2);
            unsigned* sl = (unsigned*)a.out + tile * 8192;
#pragma unroll
            for (int tl = 0; tl < 4; ++tl) { f32x16 acc;
#pragma unroll
                for (int r = 0; r < 16; ++r) acc[r] = 0.f;
#pragma unroll
                for (int ks = 0; ks < 4; ++ks) { const bf16x8 av = *(const LAS bf16x8*)(lds + GP_KDT + (32 * tl + c32) * 144 + (16 * ks + 8 * hi) * 2); acc = __builtin_amdgcn_mfma_f32_32x32x16_bf16(av, vt[ks], acc, 0, 0, 0); }
#pragma unroll
                for (int g = 0; g < 4; ++g) sl[((tl * 4 + g) * 2 + hi) * 256 + 32 * wave + c32] = pk4_fp8(acc[4 * g], acc[4 * g + 1], acc[4 * g + 2], acc[4 * g + 3]); }
        }
        __syncthreads();
#pragma unroll
        for (int r = 0; r < 16; ++r) { w2[r] = w2n[r]; sv[r] = svn[r]; }
#pragma unroll
        for (int i = 0; i < 8; ++i) { qv[i] = qvn[i]; kv[i] = kvn[i]; }
        b2 = b2n;
    }
#undef GP_LOADS
}

__device__ __forceinline__ void gla_combine_unit(const P& a, int unit) {
    const int tid = threadIdx.x, bh = unit >> 4, i8 = (unit & 15) * 512 + tid;
    const int d0 = 32 * (i8 >> 11) + 8 * ((i8 >> 9) & 3) + 4 * ((i8 >> 8) & 1);
    const unsigned* sl8 = (const unsigned*)a.out + (size_t)bh * 32 * 8192 + i8; u32x2* sl = (u32x2*)(a.ws + WS_SLOC) + (size_t)bh * 32 * 8192 + i8;
    const f32x4* dc = (const f32x4*)((const float*)(a.ws + WS_DEC) + (size_t)bh * 32 * 128 + d0);
    f32x4 s = (f32x4){0.f, 0.f, 0.f, 0.f};
    for (int cb = 0; cb < 32; cb += 8) {
        unsigned loc[8]; f32x4 dv[8];
#pragma unroll
        for (int i = 0; i < 8; ++i) { loc[i] = __builtin_nontemporal_load(sl8 + (size_t)(cb + i) * 8192); dv[i] = dc[(cb + i) * 32]; }
#pragma unroll
        for (int i = 0; i < 8; ++i) { if (cb + i < 31) {
            s.x = dv[i].x * s.x + __builtin_amdgcn_cvt_f32_fp8((int)loc[i], 0); s.y = dv[i].y * s.y + __builtin_amdgcn_cvt_f32_fp8((int)loc[i], 1);
            s.z = dv[i].z * s.z + __builtin_amdgcn_cvt_f32_fp8((int)loc[i], 2); s.w = dv[i].w * s.w + __builtin_amdgcn_cvt_f32_fp8((int)loc[i], 3);
            u32x2 w; w.x = cvt_pk_bf16(s.x, s.y); w.y = cvt_pk_bf16(s.z, s.w); sl[(size_t)(cb + i) * 8192] = w; } }
    }
}

constexpr int GL_QG = 0, GL_KG = 17408, GL_VT = 53248, GL_AM = 90112, GL_OST = 0;
constexpr int GL_QS = 272, GL_TS = 144, GL_OS = 528;
__device__ __forceinline__ int crow(int r, int hi) { return (r & 3) + 8 * (r >> 2) + 4 * hi; }
__device__ __forceinline__ void gla_out_unit(const P& a, LAS unsigned char* lds, int unit) {
    int tid = threadIdx.x; asm volatile("" : "+v"(tid)); const int w = __builtin_amdgcn_readfirstlane(tid >> 6), lane = tid & 63, c32 = lane & 31, hi = lane >> 5;
    const int bh = unit >> 5, chunk = unit & 31, b = bh >> 2, h = bh & 3;
    const bf16_t* proj = (const bf16_t*)(a.ws + WS_PROJ); bf16_t* oab = (bf16_t*)(a.ws + WS_OAB); const float* ggo = a.in[7];
    const size_t tile = (size_t)bh * 32 + chunk;
    {
        const u32x4* q_ = (const u32x4*)((const bf16_t*)(a.ws + WS_QG) + tile * 8192); const u32x4* k_ = (const u32x4*)((const bf16_t*)(a.ws + WS_KG) + tile * 8192);
        u32x4 sq[2], sk[2]; unsigned sv[16];
        sq[0] = __builtin_nontemporal_load(q_ + tid); sq[1] = __builtin_nontemporal_load(q_ + tid + 512); sk[0] = __builtin_nontemporal_load(k_ + tid); sk[1] = __builtin_nontemporal_load(k_ + tid + 512);
        const int ep = tid & 127, sq4 = tid >> 7;
        const bf16_t* v_ = proj + PROJ_BLK(C_VA + h * 256) + (size_t)(b * SEQ + chunk * 64 + 16 * sq4) * 256 + 2 * ep;
#pragma unroll
        for (int i = 0; i < 16; ++i) sv[i] = __builtin_nontemporal_load((const unsigned*)(v_ + (size_t)i * 256));
#pragma unroll
        for (int i = 0; i < 2; ++i) { const int p = tid + 512 * i;
            *(LAS u32x4*)(lds + GL_QG + (p >> 4) * GL_QS + (p & 15) * 16) = sq[i]; *(LAS u32x4*)(lds + GL_KG + (p >> 4) * GL_QS + (p & 15) * 16) = sk[i]; }
        u32x4 lo0, lo1, hi0, hi1;
#pragma unroll
        for (int j = 0; j < 4; ++j) { lo0[j] = (sv[2 * j] & 0xffffu) | (sv[2 * j + 1] << 16); lo1[j] = (sv[8 + 2 * j] & 0xffffu) | (sv[8 + 2 * j + 1] << 16);
            hi0[j] = (sv[2 * j] >> 16) | (sv[2 * j + 1] & 0xffff0000u); hi1[j] = (sv[8 + 2 * j] >> 16) | (sv[8 + 2 * j + 1] & 0xffff0000u); }
        LAS unsigned char* v0 = lds + GL_VT + (2 * ep) * GL_TS + sq4 * 32;
        *(LAS u32x4*)(v0) = lo0; *(LAS u32x4*)(v0 + 16) = lo1; *(LAS u32x4*)(v0 + GL_TS) = hi0; *(LAS u32x4*)(v0 + GL_TS + 16) = hi1;
    }
    u32x2 sf[4][2][2];
    if (chunk > 0) { const u32x2* sl = (const u32x2*)(a.ws + WS_SLOC) + (tile - 1) * 8192;
#pragma unroll
        for (int tl = 0; tl < 4; ++tl)
#pragma unroll
            for (int s = 0; s < 2; ++s)
#pragma unroll
                for (int q = 0; q < 2; ++q) sf[tl][s][q] = __builtin_nontemporal_load(sl + ((tl * 4 + 2 * s + q) * 2 + hi) * 256 + 32 * w + c32); }
    __syncthreads();
    if (w < 3) {
        const int ti = (w + 1) >> 1, si = w >> 1;
        f32x16 A;
#pragma unroll
        for (int r = 0; r < 16; ++r) A[r] = 0.f;
#pragma unroll
        for (int s = 0; s < 8; ++s) { const bf16x8 av = *(const LAS bf16x8*)(lds + GL_QG + (32 * ti + c32) * GL_QS + (16 * s + 8 * hi) * 2), bv = *(const LAS bf16x8*)(lds + GL_KG + (32 * si + c32) * GL_QS + (16 * s + 8 * hi) * 2);
            A = __builtin_amdgcn_mfma_f32_32x32x16_bf16(av, bv, A, 0, 0, 0); }
        const int sidx = 32 * si + c32;
#pragma unroll
        for (int r = 0; r < 16; ++r) { const int t = 32 * ti + crow(r, hi); const float v = (sidx <= t) ? A[r] : 0.f;
            *(LAS bf16_t*)(lds + GL_AM + t * GL_TS + sidx * 2) = (bf16_t)(cvt_pk_bf16(v, 0.f) & 0xffffu); }
    }
    __syncthreads();
    f32x16 o[2];
    {
        bf16x8 vt[4];
#pragma unroll
        for (int ks = 0; ks < 4; ++ks) vt[ks] = *(const LAS bf16x8*)(lds + GL_VT + (32 * w + c32) * GL_TS + (16 * ks + 8 * hi) * 2);
#pragma unroll
        for (int ti = 0; ti < 2; ++ti) {
#pragma unroll
            for (int r = 0; r < 16; ++r) o[ti][r] = 0.f;
            if (chunk > 0) {
#pragma unroll
                for (int tl = 0; tl < 4; ++tl)
#pragma unroll
                    for (int s = 0; s < 2; ++s) { const LAS unsigned char* qp = lds + GL_QG + (32 * ti + c32) * GL_QS + (32 * tl + 16 * s + 4 * hi) * 2;
                        const s16x4 lo = *(const LAS s16x4*)qp, hh = *(const LAS s16x4*)(qp + 16);
                        const bf16x8 aop = __builtin_shufflevector(lo, hh, 0, 1, 2, 3, 4, 5, 6, 7);
                        const u32x4 bw = {sf[tl][s][0].x, sf[tl][s][0].y, sf[tl][s][1].x, sf[tl][s][1].y};
                        o[ti] = __builtin_amdgcn_mfma_f32_32x32x16_bf16(aop, __builtin_bit_cast(bf16x8, bw), o[ti], 0, 0, 0); }
            }
#pragma unroll
            for (int ks = 0; ks < 4; ++ks) { if (ti == 0 && ks >= 2) continue;
                const bf16x8 av = *(const LAS bf16x8*)(lds + GL_AM + (32 * ti + c32) * GL_TS + (16 * ks + 8 * hi) * 2);
                o[ti] = __builtin_amdgcn_mfma_f32_32x32x16_bf16(av, vt[ks], o[ti], 0, 0, 0); }
        }
    }
    __syncthreads();
#pragma unroll
    for (int ti = 0; ti < 2; ++ti)
#pragma unroll
        for (int r = 0; r < 16; ++r) *(LAS bf16_t*)(lds + GL_OST + (32 * ti + crow(r, hi)) * GL_OS + (32 * w + c32) * 2) = (bf16_t)(cvt_pk_bf16(o[ti][r], 0.f) & 0xffffu);
    __syncthreads();
    {
        const int t = tid >> 3, sg = tid & 7; const size_t tok = (size_t)(b * SEQ + chunk * 64 + t);
        u32x4 ov[4]; float ss = 0.f;
#pragma unroll
        for (int j = 0; j < 4; ++j) { ov[j] = *(const LAS u32x4*)(lds + GL_OST + t * GL_OS + sg * 64 + j * 16);
#pragma unroll
            for (int i = 0; i < 4; ++i) { const float x0 = bflo(ov[j][i]), x1 = bfhi(ov[j][i]); ss += x0 * x0 + x1 * x1; } }
        ss += __shfl_xor(ss, 1); ss += __shfl_xor(ss, 2); ss += __shfl_xor(ss, 4);
        const float rstd = 1.0f / sqrtf(ss * (1.0f / 256.0f) + EPS);
        const bf16_t* rap = proj + PROJ_BLK(C_RA + h * 256) + tok * 256 + sg * 32; bf16_t* op = oab + tok * 2048 + h * 256 + sg * 32; const float* gp = ggo + sg * 32;
#pragma unroll
        for (int j = 0; j < 4; ++j) { const u32x4 ra = __builtin_nontemporal_load((const u32x4*)(rap + 8 * j)); const f32x4 g0 = *(const f32x4*)(gp + 8 * j), g1 = *(const f32x4*)(gp + 8 * j + 4); u32x4 wv;
#pragma unroll
            for (int i = 0; i < 4; ++i) { const float r0 = bflo(ra[i]), r1 = bfhi(ra[i]); const float ga = (i < 2) ? g0[2 * i] : g1[2 * i - 4], gb = (i < 2) ? g0[2 * i + 1] : g1[2 * i - 3];
                wv[i] = cvt_pk_bf16(bflo(ov[j][i]) * rstd * ga * (r0 * fsigmoid(r0)), bfhi(ov[j][i]) * rstd * gb * (r1 * fsigmoid(r1))); }
            *(u32x4*)(op + 8 * j) = wv; }
    }
    __syncthreads();
}
namespace moba {
constexpr int HD = 128;
constexpr float SCALE = 0.08838834764831845f;
constexpr float THR = 8.f;
constexpr int NW = 8, QBLK = 32, KVBLK = 64, QB = NW * QBLK;
constexpr int SHM_V = KVBLK * HD * 2, SHM_K = KVBLK * HD * 2;
constexpr int OFF_WS = 2 * SHM_V + 2 * SHM_K;
constexpr int OFF_RTAB = OFF_WS + NW * 64 * 4;
constexpr int OFF_KM = OFF_RTAB + 2400 * 4;
constexpr int OFF_MISC = OFF_KM + 8 * 128 * 4;
constexpr int OFF_SEL = OFF_MISC + 64;
constexpr int LDS_BYTES = OFF_SEL + 2048;
constexpr int LDP = HD, LDO = 2048;

#define KSWZ(row, colB) ((row) * 256 + ((colB) ^ (((row) & 7) << 4)))
#define SBAR() __builtin_amdgcn_sched_barrier(0)
__device__ __forceinline__ int v_st(int k, int c) { const int kk = (k & ~0xC) | ((k & 4) << 1) | ((k & 8) >> 1); return ((kk >> 3) * 4 + (c >> 5)) * 512 + ((kk & 7) * 32 + (c & 31)) * 2; }
__device__ __forceinline__ int v_rd_base(int lane) { return ((lane & 3) << 3) | (((lane >> 2) & 3) << 6) | (((lane >> 4) & 1) << 5) | (((lane >> 5) & 1) << 8); }
constexpr int v_rd_off(int d0, int ks, int half) { return d0 * 512 + ks * 4096 + half * 2048; }
__device__ __forceinline__ int crow(int r, int hi) { return (r & 3) + 8 * (r >> 2) + 4 * hi; }
__device__ __forceinline__ unsigned cvtpk(float lo, float hi) { unsigned r; asm volatile("v_cvt_pk_bf16_f32 %0, %1, %2" : "=v"(r) : "v"(lo), "v"(hi)); return r; }

__device__ __forceinline__ void mask_tile(f32x16& p0, f32x16& p1, int dq) {
    const float NEG = -__builtin_inff();
#pragma unroll
    for (int r = 0; r < 16; ++r) {
        const int c = (r & 3) + 8 * (r >> 2);
        if (dq - c < 0) p0[r] = NEG;
        if (dq - c - 32 < 0) p1[r] = NEG;
    }
}
__device__ __forceinline__ void bias_tile(f32x16& p0, f32x16& p1, const LAS float* rt) {
#pragma unroll
    for (int r = 0; r < 16; ++r) { const int c = (r & 3) + 8 * (r >> 2); p0[r] += rt[c]; p1[r] += rt[c + 32]; }
}
__device__ __forceinline__ void kill_tile(f32x16& p0, f32x16& p1) {
    const float NEG = -__builtin_inff();
#pragma unroll
    for (int r = 0; r < 16; ++r) { p0[r] = NEG; p1[r] = NEG; }
}
__device__ __forceinline__ void partialSM(f32x16& p0, f32x16& p1, float& m_reg, float& mn, float& alpha) {
    float pmax = p0[0];
#pragma unroll
    for (int r = 1; r < 16; ++r) pmax = fmaxf(pmax, p0[r]);
#pragma unroll
    for (int r = 0; r < 16; ++r) pmax = fmaxf(pmax, p1[r]);
    { auto rr = __builtin_amdgcn_permlane32_swap(__float_as_uint(pmax), __float_as_uint(pmax), false, false);
      pmax = fmaxf(__uint_as_float(rr[0]), __uint_as_float(rr[1])); }
    constexpr float C2 = 1.4426950408889634f * SCALE;
    if (__builtin_expect(__all((pmax - m_reg) * SCALE <= THR), 1)) { mn = m_reg; alpha = 1.f; }
    else { mn = fmaxf(m_reg, pmax); alpha = __builtin_amdgcn_exp2f((m_reg - mn) * C2); m_reg = mn; }
    const float mnL = -mn * C2;
#pragma unroll
    for (int r = 0; r < 16; ++r) p0[r] = fmaf(p0[r], C2, mnL);
#pragma unroll
    for (int r = 0; r < 16; ++r) p1[r] = fmaf(p1[r], C2, mnL);
#pragma unroll
    for (int r = 0; r < 16; ++r) p0[r] = __builtin_amdgcn_exp2f(p0[r]);
}
__device__ __forceinline__ void finishSM(f32x16& p0, f32x16& p1, float alpha, float& l_reg, bf16x8& pa0, bf16x8& pa1, bf16x8& pa2, bf16x8& pa3) {
#pragma unroll
    for (int r = 0; r < 16; ++r) p1[r] = __builtin_amdgcn_exp2f(p1[r]);
    float ps = 0;
#pragma unroll
    for (int r = 0; r < 16; ++r) ps += p0[r];
#pragma unroll
    for (int r = 0; r < 16; ++r) ps += p1[r];
    { auto rr = __builtin_amdgcn_permlane32_swap(__float_as_uint(ps), __float_as_uint(ps), false, false);
      ps = __uint_as_float(rr[0]) + __uint_as_float(rr[1]); }
    l_reg = l_reg * alpha + ps;
#define PK4(P, B_, OUT) do { unsigned a0 = cvtpk(P[B_+0], P[B_+1]), a1 = cvtpk(P[B_+2], P[B_+3]);                          \
        unsigned b0 = cvtpk(P[B_+4], P[B_+5]), b1 = cvtpk(P[B_+6], P[B_+7]);                                             \
        auto r0 = __builtin_amdgcn_permlane32_swap(a0, b0, false, false); auto r1 = __builtin_amdgcn_permlane32_swap(a1, b1, false, false); \
        u32x4 w = {r0[0], r1[0], r0[1], r1[1]}; OUT = __builtin_bit_cast(bf16x8, w); } while (0)
    PK4(p0, 0, pa0); PK4(p0, 8, pa1); PK4(p1, 0, pa2); PK4(p1, 8, pa3);
#undef PK4
}
template <int KB>
__device__ __forceinline__ void qkt(f32x16& p0, f32x16& p1, const char* K_lds, int r32, int hi, const bf16x8* qr) {
#pragma unroll
    for (int r = 0; r < 16; ++r) { p0[r] = 0.f; p1[r] = 0.f; }
    const char* kb[4];
#pragma unroll
    for (int dd = 0; dd < 4; ++dd) kb[dd] = K_lds + KB * SHM_K + KSWZ(r32, (dd * 16 + hi * 8) * 2);
#pragma unroll
    for (int d0 = 0; d0 < 8; ++d0) { const char* a = kb[d0 & 3] + (d0 >> 2) * 128;
        bf16x8 b0 = *reinterpret_cast<const bf16x8*>(a);
        bf16x8 b1 = *reinterpret_cast<const bf16x8*>(a + 32 * 256);
        p0 = __builtin_amdgcn_mfma_f32_32x32x16_bf16(b0, qr[d0], p0, 0, 0, 0);
        p1 = __builtin_amdgcn_mfma_f32_32x32x16_bf16(b1, qr[d0], p1, 0, 0, 0); }
}
template <int VB>
__device__ __forceinline__ void pv_tile(f32x16* o, int vb0, bf16x8 pa0, bf16x8 pa1, bf16x8 pa2, bf16x8 pa3) {
#define TRRD(dst, off) asm volatile("ds_read_b64_tr_b16 %0, %1 offset:%2" : "=&v"(dst) : "v"(vb0), "i"(off) : "memory")
#define PV_D0(d0) do { s16x4 l0, l1, l2, l3, h0, h1, h2, h3; constexpr int b_ = VB * SHM_V + v_rd_off(d0, 0, 0);   \
        TRRD(l0, b_); TRRD(h0, b_ + 2048); TRRD(l1, b_ + 4096); TRRD(h1, b_ + 6144); TRRD(l2, b_ + 8192); TRRD(h2, b_ + 10240); TRRD(l3, b_ + 12288); TRRD(h3, b_ + 14336); \
        asm volatile("s_waitcnt lgkmcnt(0)" ::: "memory"); SBAR();   \
        o[d0] = __builtin_amdgcn_mfma_f32_32x32x16_bf16(pa0, (bf16x8){l0[0], l0[1], l0[2], l0[3], h0[0], h0[1], h0[2], h0[3]}, o[d0], 0, 0, 0);   \
        o[d0] = __builtin_amdgcn_mfma_f32_32x32x16_bf16(pa1, (bf16x8){l1[0], l1[1], l1[2], l1[3], h1[0], h1[1], h1[2], h1[3]}, o[d0], 0, 0, 0);   \
        o[d0] = __builtin_amdgcn_mfma_f32_32x32x16_bf16(pa2, (bf16x8){l2[0], l2[1], l2[2], l2[3], h2[0], h2[1], h2[2], h2[3]}, o[d0], 0, 0, 0);   \
        o[d0] = __builtin_amdgcn_mfma_f32_32x32x16_bf16(pa3, (bf16x8){l3[0], l3[1], l3[2], l3[3], h3[0], h3[1], h3[2], h3[3]}, o[d0], 0, 0, 0); } while (0)
    PV_D0(0); PV_D0(1); PV_D0(2); PV_D0(3);
#undef PV_D0
#undef TRRD
}

struct BlockRef { const bf16_t* Q; const bf16_t* K; const bf16_t* V; bf16_t* O; int qb; int b, h; };
struct Seam { bf16x8 qr[8]; bf16x8 st_v0, st_v1, st_k0, st_k1; };
#define VMW() asm volatile("s_waitcnt vmcnt(0)" ::: "memory")
#define VMWN(n) asm volatile("s_waitcnt vmcnt(%0)" :: "i"(n) : "memory")
#define LD8(p) (*reinterpret_cast<const bf16x8*>(p))
#define SLOAD_H(Kp, Vp, k0) do { const char* kb__ = (const char*)(Kp) + (size_t)(k0) * (LDP * 2); const char* vb__ = (const char*)(Vp) + (size_t)(k0) * (LDP * 2); \
        S.st_v0 = LD8(vb__ + kvoff); S.st_v1 = LD8(vb__ + 32 * LDP * 2 + kvoff); S.st_k0 = LD8(kb__ + kvoff); S.st_k1 = LD8(kb__ + 32 * LDP * 2 + kvoff); } while (0)
#define SWRITE_HK(bf) do { *(bf16x8*)(K_lds + (bf) * SHM_K + kws) = S.st_k0; *(bf16x8*)(K_lds + (bf) * SHM_K + kws + 32 * 256) = S.st_k1; } while (0)
#define SWRITE_HV(bf) do { *(bf16x8*)(V_lds + (bf) * SHM_V + vst0) = S.st_v0; *(bf16x8*)(V_lds + (bf) * SHM_V + vst1) = S.st_v1; } while (0)
#define SWRITE_H(bf) do { SWRITE_HV(bf); SWRITE_HK(bf); } while (0)

__device__ __forceinline__ void prime(const BlockRef& cur, char* lds, Seam& S) {
    int tid = threadIdx.x; asm volatile("" : "+v"(tid));     const int wid = __builtin_amdgcn_readfirstlane(tid >> 6), lane = tid & 63, r32 = lane & 31, hi = lane >> 5;
    const int sr = tid >> 4, sc = (tid & 15) * 8, kws = KSWZ(sr, sc * 2); char* K_lds = lds + 2 * SHM_V;
    const unsigned kvoff = (unsigned)(sr * LDP + sc) * 2u, qvoff = (unsigned)(r32 * LDP + hi * 8) * 2u;
    { const char* qb__ = (const char*)cur.Q + (size_t)(wid * QBLK) * (LDP * 2);
#pragma unroll
    for (int d0 = 0; d0 < 8; ++d0) S.qr[d0] = LD8(qb__ + qvoff + d0 * 32); }
    SLOAD_H(cur.K, cur.V, 0); VMW(); SWRITE_HK(0);
    __syncthreads();
}
__device__ __forceinline__ int rel_bucket(int n) {
    if (n < 16) return n;
    const float nf = (float)n;
    int large = 16 + (int)(logf(nf / 16.0f) / 5.545177444479562f * 16.0f);
    return large < 31 ? large : 31;
}
__device__ __forceinline__ BlockRef make_ref(const P& a, int item);
__device__ __forceinline__ int block(const P& a, const BlockRef& cur, unsigned* queue, const float* rel_bias, const float* kmp, char* lds, Seam& S) {
    int tid = threadIdx.x; asm volatile("" : "+v"(tid));     const int wid = __builtin_amdgcn_readfirstlane(tid >> 6), lane = tid & 63, r32 = lane & 31, hi = lane >> 5;
    const int qb = cur.qb, NT = 4 * (qb + 1);
    const int qlo = qb * QB + wid * QBLK, qrow = qlo + r32;
    char* V_lds = lds; char* K_lds = lds + 2 * SHM_V;
    float* ws = (float*)(lds + OFF_WS) + wid * 64; float* li_l = ws, * al_l = ws + 32;
    LAS float* rtab = (LAS float*)(LAS char*)(uintptr_t)(unsigned)(uintptr_t)(lds + OFF_RTAB);
    float* kmL = (float*)(lds + OFF_KM);
    volatile int* misc = (volatile int*)(lds + OFF_MISC);
    if (tid == 0) misc[0] = (int)__hip_atomic_fetch_add(queue, 1u, __ATOMIC_RELAXED, __HIP_MEMORY_SCOPE_AGENT);
    for (int i = tid; i < 2400; i += NW * 64) { const int dist = 2047 - i; rtab[i] = dist >= 0 ? rel_bias[rel_bucket(dist) * 8 + cur.h] * (1.0f / SCALE) : -__builtin_inff(); }
    for (int i = tid; i < qb * 128; i += NW * 64) { const int j = i >> 7, dd = i & 127; const size_t o = ((size_t)(cur.b * 8 + j)) * 1024 + cur.h * 128 + dd;
        kmL[i] = (kmp[o] + kmp[o + 64 * 1024]) * (1.0f / 256.0f); }
    __syncthreads();
    const int next_item = __builtin_amdgcn_readfirstlane(misc[0]);
    const BlockRef nxt = next_item < 512 ? make_ref(a, next_item) : cur;
    unsigned selmask = 0;
    {
        float sc7[7];
#pragma unroll
        for (int j = 0; j < 7; ++j) { sc7[j] = -__builtin_inff();
            if (j < qb) { float acc = 0.f;
#pragma unroll
                for (int d0 = 0; d0 < 8; ++d0) { const u32x4 q4 = __builtin_bit_cast(u32x4, S.qr[d0]); const f32x4 k0 = *(const f32x4*)(kmL + j * 128 + d0 * 16 + hi * 8), k1 = *(const f32x4*)(kmL + j * 128 + d0 * 16 + hi * 8 + 4);
                    acc += bflo(q4[0]) * k0[0] + bfhi(q4[0]) * k0[1] + bflo(q4[1]) * k0[2] + bfhi(q4[1]) * k0[3] + bflo(q4[2]) * k1[0] + bfhi(q4[2]) * k1[1] + bflo(q4[3]) * k1[2] + bfhi(q4[3]) * k1[3]; }
                acc += __shfl_xor(acc, 32); sc7[j] = acc; } }
#pragma unroll
        for (int j = 0; j < 7; ++j) { int rank = 0;
#pragma unroll
            for (int i = 0; i < 7; ++i) { if (i != j) rank += (sc7[i] > sc7[j] || (sc7[i] == sc7[j] && i < j)) ? 1 : 0; }
            if (j < qb && (qb <= 3 || rank < 3)) selmask |= 1u << j; }
    }
    LAS unsigned* selp = (LAS unsigned*)(LAS char*)(uintptr_t)(unsigned)(uintptr_t)(lds + OFF_SEL) + tid;
    *selp = selmask;
    float m_reg = -1e30f, l_reg = 0; f32x16 o[4];
#pragma unroll
    for (int d = 0; d < 4; ++d)
#pragma unroll
        for (int r = 0; r < 16; ++r) o[d][r] = 0.f;
    const int sr = tid >> 4, sc = (tid & 15) * 8, vst0 = v_st(sr, sc), vst1 = v_st(32 + sr, sc), kws = KSWZ(sr, sc * 2);
    const unsigned kvoff = (unsigned)(sr * LDP + sc) * 2u;
    const int vb0 = (int)(uintptr_t)V_lds + v_rd_base(lane);
    const bf16_t* Kh = cur.K; const bf16_t* Vh = cur.V;
#define RESC(a) do { if (__any((a) < 1.f)) { if (hi == 0) al_l[r32] = (a); asm volatile("s_waitcnt lgkmcnt(0)" ::: "memory");              \
                     for (int d_ = 0; d_ < 4; ++d_) for (int r = 0; r < 16; ++r) o[d_][r] *= al_l[crow(r, hi)]; } } while (0)
#define KBASE(t) ((t) * KVBLK)
#define MASKT(P0_, P1_, t) do { const int kb_ = KBASE(t); const int jb_ = (t) >> 2; \
        const bool on_ = (jb_ == qb) || ((*selp >> jb_) & 1u); \
        bias_tile(P0_, P1_, on_ ? rtab + (kb_ + 4 * hi - qrow + 2047) : rtab + 2304); } while (0)
    constexpr int NQL = 8;
#define SEAM_K0() do { VMWN(NQL); SWRITE_HK(0); SBAR(); } while (0)
    f32x16 pA0, pA1, pB0, pB1; float mnA, mnB, alA, alB; bf16x8 pa0, pa1, pa2, pa3;
    SWRITE_HV(0); SBAR();
    if (NT > 1) { SLOAD_H(Kh, Vh, KBASE(1)); }
    SBAR(); qkt<0>(pA0, pA1, K_lds, r32, hi, S.qr);
    MASKT(pA0, pA1, 0); partialSM(pA0, pA1, m_reg, mnA, alA);
    if (NT > 1) { VMW(); SWRITE_H(1); }
    __syncthreads();
#define HALF_STEP(PX0, PX1, mnX, alX, PY0, PY1, alY, t, KB, VB, SB) do {                                                      \
        SBAR(); if ((t) + 1 < NT) { SLOAD_H(Kh, Vh, KBASE((t) + 1)); SBAR(); }      \
        qkt<KB>(PX0, PX1, K_lds, r32, hi, S.qr);                                             \
        finishSM(PY0, PY1, alY, l_reg, pa0, pa1, pa2, pa3); SBAR();                                                           \
        pv_tile<VB>(o, vb0, pa0, pa1, pa2, pa3); MASKT(PX0, PX1, (t)); partialSM(PX0, PX1, m_reg, mnX, alX);                                        \
        __syncthreads();                                                                                                      \
        if ((t) + 1 < NT) { VMW(); SWRITE_H(SB); }                                                                          \
        RESC(alX); __syncthreads(); } while (0)
    for (int t = 1; t + 1 < NT; t += 2) {
        HALF_STEP(pB0, pB1, mnB, alB, pA0, pA1, alA, t, 1, 0, 0);
        HALF_STEP(pA0, pA1, mnA, alA, pB0, pB1, alB, t + 1, 0, 1, 1);
    }
    { SBAR(); qkt<1>(pB0, pB1, K_lds, r32, hi, S.qr); SBAR(); }
    SLOAD_H(nxt.K, nxt.V, 0); SBAR();
    { const char* qb__ = (const char*)nxt.Q + (size_t)(wid * QBLK) * (LDP * 2); int l_ = lane; asm volatile("" : "+v"(l_));
      const unsigned qvoff = (unsigned)((l_ & 31) * LDP + (l_ >> 5) * 8) * 2u;
#pragma unroll
    for (int d0 = 0; d0 < 8; ++d0) S.qr[d0] = LD8(qb__ + qvoff + d0 * 32); }
    SBAR();
    finishSM(pA0, pA1, alA, l_reg, pa0, pa1, pa2, pa3); SBAR();
    pv_tile<0>(o, vb0, pa0, pa1, pa2, pa3);
    { MASKT(pB0, pB1, NT - 1); partialSM(pB0, pB1, m_reg, mnB, alB); __syncthreads(); RESC(alB);
      finishSM(pB0, pB1, alB, l_reg, pa0, pa1, pa2, pa3); SBAR(); pv_tile<1>(o, vb0, pa0, pa1, pa2, pa3); }
    SBAR(); SEAM_K0();
    if (hi == 0) li_l[r32] = l_reg; asm volatile("s_waitcnt lgkmcnt(0)" ::: "memory");
    float rli[16];
#pragma unroll
    for (int r = 0; r < 16; ++r) rli[r] = __builtin_amdgcn_rcpf(li_l[crow(r, hi)]);
    char* Ow = (char*)cur.O + (size_t)(wid * QBLK) * (LDO * 2); const unsigned ovoff = (unsigned)(4 * hi * LDO + r32) * 2u;
#pragma unroll
    for (int r = 0; r < 16; ++r) { const int orow0 = (r & 3) + 8 * (r >> 2);
#pragma unroll
        for (int d0 = 0; d0 < 4; ++d0) { const float v = o[d0][r] * rli[r];
            const float vn = __shfl_xor(v, 1);
            if ((r32 & 1) == 0) *(unsigned*)(Ow + (size_t)(orow0 * LDO * 2 + d0 * 64) + ovoff) = cvtpk(v, vn); } }
    __syncthreads();
    return next_item;
#undef RESC
#undef KBASE
#undef MASKT
#undef SEAM_K0
#undef HALF_STEP
}
#undef ROWP
#undef VMW
#undef VMWN
#undef LD8
#undef SLOAD_H
#undef SWRITE_HK
#undef SWRITE_HV
#undef SWRITE_H

__device__ __forceinline__ BlockRef make_ref(const P& a, int item) {
    const int qb = 7 - (item >> 6), bh = item & 63, b = bh >> 3, h = bh & 7;
    const bf16_t* proj = (const bf16_t*)(a.ws + WS_PROJ);
    BlockRef r; r.b = b; r.h = h; r.qb = qb;
    r.Q = proj + PROJ_BLK(C_QB + h * HD) + (size_t)(b * SEQ + qb * QB) * LDP;
    r.K = proj + PROJ_BLK(C_KB + h * HD) + (size_t)(b * SEQ) * LDP;
    r.V = proj + PROJ_BLK(C_VB + h * HD) + (size_t)(b * SEQ) * LDP;
    r.O = (bf16_t*)(a.ws + WS_OAB) + (size_t)(b * SEQ + qb * QB) * LDO + 1024 + h * HD;
    return r;
}
}
__device__ __forceinline__ void router_unit(const P& a, LAS unsigned char* lds, int unit) {
    int tid = threadIdx.x; asm volatile("" : "+v"(tid)); const int wave = __builtin_amdgcn_readfirstlane(tid >> 6), lane = tid & 63, c32 = lane & 31, hi = lane >> 5;
    const int tg = wave & 1, kq = wave >> 1;
    const bf16_t* x1 = (const bf16_t*)(a.ws + WS_X1); const float* g = a.in[11]; const float* br = a.in[13];
    unsigned char* A2 = a.ws + WS_A2; const u32x4* frag = (const u32x4*)(a.ws + WS_WRF);
    LAS float* Lw = (LAS float*)(lds + wave * 4352);
    LAS float* ssp = (LAS float*)(lds + 8 * 4352);
    LAS unsigned* hist = (LAS unsigned*)(lds + 8 * 4352 + 2048);
    LAS unsigned* base = hist + 32;
    if (tid < 32) hist[tid] = 0u;
    const int tok = unit * 64 + tg * 32 + c32;
    f32x16 L;
#pragma unroll
    for (int r = 0; r < 16; ++r) L[r] = 0.f;
    float ss = 0.f;
    const bf16_t* xr = x1 + (size_t)tok * D + 8 * hi + 256 * kq; unsigned char* ar = A2 + (size_t)tok * D + 8 * hi + 256 * kq; const float* gr = g + 8 * hi + 256 * kq;
#pragma unroll 4
    for (int s = 0; s < 16; ++s) {
        const u32x4 xw = *(const u32x4*)(xr + 16 * s); const f32x4 xa = {bflo(xw.x), bfhi(xw.x), bflo(xw.y), bfhi(xw.y)}, xb = {bflo(xw.z), bfhi(xw.z), bflo(xw.w), bfhi(xw.w)}, ga = *(const f32x4*)(gr + 16 * s), gb = *(const f32x4*)(gr + 16 * s + 4);
        ss += (xa.x * xa.x + xa.y * xa.y) + (xa.z * xa.z + xa.w * xa.w) + (xb.x * xb.x + xb.y * xb.y) + (xb.z * xb.z + xb.w * xb.w);
        const f32x4 va = xa * ga, vb = xb * gb;
        u32x4 wh; wh.x = cvt_pk_bf16(va.x, va.y); wh.y = cvt_pk_bf16(va.z, va.w); wh.z = cvt_pk_bf16(vb.x, vb.y); wh.w = cvt_pk_bf16(vb.z, vb.w);
        { u32x2 w8; w8.x = pk4_fp8(va.x, va.y, va.z, va.w); w8.y = pk4_fp8(vb.x, vb.y, vb.z, vb.w); *(u32x2*)(ar + 16 * s) = w8; }
        u32x4 wl; wl.x = cvt_pk_bf16(va.x - bflo(wh.x), va.y - bfhi(wh.x)); wl.y = cvt_pk_bf16(va.z - bflo(wh.y), va.w - bfhi(wh.y));
        wl.z = cvt_pk_bf16(vb.x - bflo(wh.z), vb.y - bfhi(wh.z)); wl.w = cvt_pk_bf16(vb.z - bflo(wh.w), vb.w - bfhi(wh.w));
        const bf16x8 ah = __builtin_bit_cast(bf16x8, wh), al = __builtin_bit_cast(bf16x8, wl);
        const bf16x8 bh = __builtin_bit_cast(bf16x8, frag[(16 * kq + s) * 64 + lane]), bl = __builtin_bit_cast(bf16x8, frag[4096 + (16 * kq + s) * 64 + lane]);
        L = __builtin_amdgcn_mfma_f32_32x32x16_bf16(ah, bh, L, 0, 0, 0);
        L = __builtin_amdgcn_mfma_f32_32x32x16_bf16(ah, bl, L, 0, 0, 0);
        L = __builtin_amdgcn_mfma_f32_32x32x16_bf16(al, bh, L, 0, 0, 0);
    }
#pragma unroll
    for (int r = 0; r < 16; ++r) Lw[((r & 3) + 8 * (r >> 2) + 4 * hi) * 33 + c32] = L[r];
    ssp[wave * 64 + lane] = ss;
    __syncthreads();
    int e4[4] = {0, 0, 0, 0}; float w4[4] = {0.f, 0.f, 0.f, 0.f}; unsigned loc[4] = {0u, 0u, 0u, 0u}; float rstd = 0.f;
    const bool sel = (wave < 2) && (hi == 0);
    if (sel) {
        float sst = 0.f;
#pragma unroll
        for (int q = 0; q < 4; ++q) sst += ssp[(wave + 2 * q) * 64 + c32] + ssp[(wave + 2 * q) * 64 + 32 + c32];
        rstd = 1.0f / sqrtf(sst * (1.0f / D) + EPS);
        float lg[32];
#pragma unroll
        for (int e = 0; e < 32; ++e) { const LAS float* lp = (const LAS float*)(lds + wave * 4352) + c32 * 33 + e; lg[e] = (lp[0] + lp[2 * 1088] + lp[4 * 1088] + lp[6 * 1088]) * rstd + br[e]; }
        unsigned used = 0u; float v4[4];
#pragma unroll
        for (int p = 0; p < 4; ++p) { float best = -__builtin_inff(); int bi = 0;
#pragma unroll
            for (int e = 0; e < 32; ++e) { const bool take = !((used >> e) & 1u) && lg[e] > best; best = take ? lg[e] : best; bi = take ? e : bi; }
            used |= 1u << bi; e4[p] = bi; v4[p] = best; }
        float sum = 0.f;
#pragma unroll
        for (int p = 0; p < 4; ++p) { w4[p] = expf(v4[p] - v4[0]); sum += w4[p]; }
        const float inv = 1.0f / sum;
#pragma unroll
        for (int p = 0; p < 4; ++p) { w4[p] *= inv; loc[p] = __hip_atomic_fetch_add(hist + e4[p], 1u, __ATOMIC_RELAXED, __HIP_MEMORY_SCOPE_WORKGROUP); }
    }
    __syncthreads();
    if (tid < 32) base[tid] = __hip_atomic_fetch_add((unsigned*)(a.ws + WS_CTL) + CW_COUNTS + tid, hist[tid], RLX_AGENT);
    __syncthreads();
    if (sel) {
        int* tope = (int*)(a.ws + WS_TOPE) + (size_t)tok * 4; float* wts = (float*)(a.ws + WS_WTS) + (size_t)tok * 4; int* slot = (int*)(a.ws + WS_SLOT) + (size_t)tok * 4;
#pragma unroll
        for (int p = 0; p < 4; ++p) { const int sl_ = (int)(base[e4[p]] + loc[p]); tope[p] = e4[p]; wts[p] = w4[p]; slot[p] = sl_;
            ((int*)(a.ws + WS_ROWE))[(size_t)e4[p] * T + sl_] = tok; ((float*)(a.ws + WS_RSTE))[(size_t)e4[p] * T + sl_] = rstd; }
    }
    __syncthreads();
}

__device__ __forceinline__ void moe_tables(const P& a, LAS unsigned char* lds) {
    int tid = threadIdx.x; asm volatile("" : "+v"(tid)); const int wave = tid >> 6, lane = tid & 63, e = lane & 31;
    LAS int* pstart = (LAS int*)(lds + LDS_MOE); LAS int* cnt = pstart + 64; LAS int* tile_e = pstart + 128;
    const unsigned* counts = (const unsigned*)(a.ws + WS_CTL) + CW_COUNTS;
    const int c = (int)counts[e]; const int p = ((c + 255) >> 8) << 8; int inc = p;
#pragma unroll
    for (int o = 1; o < 32; o <<= 1) { const int t = __builtin_amdgcn_ds_bpermute(((lane - o) & 63) << 2, inc); if (e >= o) inc += t; }
    if (tid < 32) { cnt[e] = c; pstart[e] = inc - p; if (e == 31) { pstart[32] = inc; tile_e[MAXTILES] = inc >> 8; } }
    for (int t = wave * 36; t < wave * 36 + 36; ++t) { const unsigned long long m = __ballot(inc <= t * 256); const int ee = __builtin_popcount((unsigned)m); if (lane == 0) tile_e[t] = ee < NE ? ee : NE - 1; }
    __syncthreads();
}

__device__ __forceinline__ void combine_rows(const P& a, LAS unsigned char* lds, int vcu, int G, int wave, int lane) {
    const LAS int* pstart = (const LAS int*)(lds + LDS_MOE);
    const int gw = vcu * NWAVES + wave, NGW = G * NWAVES;
    const bf16_t* X1 = (const bf16_t*)(a.ws + WS_X1); float* X = (float*)(a.ws + WS_X2); const unsigned char* Y = a.ws + WS_YROWS; bf16_t* A3 = (bf16_t*)(a.ws + WS_H);
    const int* tope = (const int*)(a.ws + WS_TOPE); const int* slot = (const int*)(a.ws + WS_SLOT); const float* wts = (const float*)(a.ws + WS_WTS); const float* g = a.in[20];
    f32x4 gv[4];
#pragma unroll
    for (int j = 0; j < 4; ++j) gv[j] = *((const f32x4*)g + lane + 64 * j);
    for (int m0 = gw; m0 < T; m0 += 8 * NGW) {
        int dl = 0; float wl = 0.f;
        { const int i = (lane >> 2) & 7, k = lane & 3; const int m = m0 + i * NGW; if (lane < 32 && m < T) { dl = pstart[tope[m * 4 + k]] + slot[m * 4 + k]; wl = wts[m * 4 + k]; } }
        u32x2 xa[4], xb[4]; unsigned ya[4][4], yb[4][4];
#define CR_LOAD(i_, XQ, YQ) do { const int m_ = m0 + (i_) * NGW; if (m_ < T) { const u32x2* x1r = (const u32x2*)(X1 + (size_t)m_ * D) + lane; \
            _Pragma("unroll") for (int j = 0; j < 4; ++j) XQ[j] = __builtin_nontemporal_load(x1r + 64 * j); \
            _Pragma("unroll") for (int k = 0; k < 4; ++k) { const int d = __builtin_amdgcn_readlane(dl, 4 * (i_) + k); const unsigned* yr = (const unsigned*)(Y + (size_t)d * D) + lane; \
                _Pragma("unroll") for (int j = 0; j < 4; ++j) YQ[k][j] = __builtin_nontemporal_load(yr + 64 * j); } } } while (0)
#define CR_DO(i_, XQ, YQ) do { const int m_ = m0 + (i_) * NGW; if (m_ < T) { f32x4 v[4]; \
            _Pragma("unroll") for (int j = 0; j < 4; ++j) v[j] = (f32x4){bflo(XQ[j].x), bfhi(XQ[j].x), bflo(XQ[j].y), bfhi(XQ[j].y)}; \
            _Pragma("unroll") for (int k = 0; k < 4; ++k) { const float w = __int_as_float(__builtin_amdgcn_readlane(__float_as_int(wl), 4 * (i_) + k)); \
                _Pragma("unroll") for (int j = 0; j < 4; ++j) { const int y = (int)YQ[k][j]; \
                    v[j].x += w * __builtin_amdgcn_cvt_f32_fp8(y, 0); v[j].y += w * __builtin_amdgcn_cvt_f32_fp8(y, 1); v[j].z += w * __builtin_amdgcn_cvt_f32_fp8(y, 2); v[j].w += w * __builtin_amdgcn_cvt_f32_fp8(y, 3); } } \
            float s = 0.f; \
            _Pragma("unroll") for (int j = 0; j < 4; ++j) s += (v[j].x * v[j].x + v[j].y * v[j].y) + (v[j].z * v[j].z + v[j].w * v[j].w); \
            const float rstd = 1.0f / sqrtf(wave_sum(s) * (1.0f / D) + EPS); \
            f32x4* xr = (f32x4*)(X + (size_t)m_ * D) + lane; unsigned* o4 = (unsigned*)((unsigned char*)A3 + (size_t)m_ * D) + lane;        \
            _Pragma("unroll") for (int j = 0; j < 4; ++j) { xr[64 * j] = v[j]; o4[64 * j] = pk4_fp8(v[j].x * rstd * gv[j].x, v[j].y * rstd * gv[j].y, v[j].z * rstd * gv[j].z, v[j].w * rstd * gv[j].w); } } } while (0)
        CR_LOAD(0, xa, ya);
#pragma unroll
        for (int i = 0; i < 8; i += 2) { CR_LOAD(i + 1, xb, yb); CR_DO(i, xa, ya); if (i + 2 < 8) CR_LOAD(i + 2, xa, ya); CR_DO(i + 1, xb, yb); }
#undef CR_LOAD
#undef CR_DO
    }
}
__device__ __forceinline__ void final_rows(const P& a, int vcu, int G, int wave, int lane) {
    const int gw = vcu * NWAVES + wave, NGW = G * NWAVES;
    const float* X = (const float*)(a.ws + WS_X2); float* OUT = a.out; const bf16_t* PG = (const bf16_t*)(a.ws + WS_PGATE); const bf16_t* PP = (const bf16_t*)(a.ws + WS_PPROJ);
    f32x4 gp[4], gf[4];
#pragma unroll
    for (int j = 0; j < 4; ++j) { gp[j] = *((const f32x4*)a.in[23] + lane + 64 * j); gf[j] = *((const f32x4*)a.in[24] + lane + 64 * j); }
    f32x4 va[4], vb[4]; u32x2 qa[4], qb[4], ga[4], gb[4];
#define FR_LOAD(m_, V, Q, GQ) do { if ((m_) < T) { const f32x4* xr = (const f32x4*)(X + (size_t)(m_) * D) + lane; const u32x2* pgr = (const u32x2*)(PG + (size_t)(m_) * D) + lane; const u32x2* ppr = (const u32x2*)(PP + (size_t)(m_) * D) + lane; \
        _Pragma("unroll") for (int j = 0; j < 4; ++j) { V[j] = __builtin_nontemporal_load(xr + 64 * j); Q[j] = __builtin_nontemporal_load(ppr + 64 * j); GQ[j] = __builtin_nontemporal_load(pgr + 64 * j); } } } while (0)
#define FR_DO(m_, V, Q, GQ) do { if ((m_) < T) { f32x4 v[4], pp[4], pg[4]; float sp = 0.f; \
        _Pragma("unroll") for (int j = 0; j < 4; ++j) { v[j] = V[j]; pp[j] = (f32x4){bflo(Q[j].x), bfhi(Q[j].x), bflo(Q[j].y), bfhi(Q[j].y)}; pg[j] = (f32x4){bflo(GQ[j].x), bfhi(GQ[j].x), bflo(GQ[j].y), bfhi(GQ[j].y)}; \
            sp += (pp[j].x * pp[j].x + pp[j].y * pp[j].y) + (pp[j].z * pp[j].z + pp[j].w * pp[j].w); } \
        const float rp = 1.0f / sqrtf(wave_sum(sp) * (1.0f / D) + EPS); float s_ = 0.f; \
        _Pragma("unroll") for (int j = 0; j < 4; ++j) { v[j] = v[j] + pg[j] * (pp[j] * rp * gp[j]); s_ += (v[j].x * v[j].x + v[j].y * v[j].y) + (v[j].z * v[j].z + v[j].w * v[j].w); } \
        const float rstd = 1.0f / sqrtf(wave_sum(s_) * (1.0f / D) + EPS); f32x4* orow = (f32x4*)(OUT + (size_t)(m_) * D) + lane; \
        _Pragma("unroll") for (int j = 0; j < 4; ++j) __builtin_nontemporal_store(v[j] * rstd * gf[j], orow + 64 * j); } } while (0)
    FR_LOAD(gw, va, qa, ga);
    for (int m = gw; m < T; m += 2 * NGW) { FR_LOAD(m + NGW, vb, qb, gb); FR_DO(m, va, qa, ga); FR_LOAD(m + 2 * NGW, va, qa, ga); FR_DO(m + NGW, vb, qb, gb); }
#undef FR_LOAD
#undef FR_DO
}
struct Args { P p; };
template <int PH_LO, int PH_HI>
__global__ void __launch_bounds__(NTHREADS, 2) hybrid_fwd(Args args) {
    extern __shared__ __attribute__((aligned(16))) unsigned char lds_raw[];
    LAS unsigned char* lds = (LAS unsigned char*)lds_raw;
    const P& a = args.p;
    const int tid = threadIdx.x;
#define FRESH_WL() int t_ = threadIdx.x; asm volatile("" : "+v"(t_)); const int w_ = __builtin_amdgcn_readfirstlane(t_ >> 6), l_ = t_ & 63
    const int G = gridDim.x; const int bx = blockIdx.x; const int vcu = (G % 8 == 0) ? (bx % 8) * (G / 8) + bx / 8 : bx;
    unsigned* ctl = (unsigned*)(a.ws + WS_CTL);
    for (int u = tid; u < (LDS_BYTES - LDSCTL_OFF) / 4; u += NTHREADS) ((LAS unsigned*)(lds + LDSCTL_OFF))[u] = 0u;
    __syncthreads();
#if MK_PER_PHASE
#define GRID_BAR() do { } while (0)
#else
    XcdBarrier bar = xcd_barrier_post(ctl + CW_BAR, (volatile LAS unsigned*)(lds + MISC_OFF + 32));
#define GRID_BAR() xcd_barrier(bar)
#endif
    constexpr int lo = PH_LO, hi = PH_HI;
#define IN(k) (lo <= (k) && (k) < hi)
#define SEAM(k) do { if constexpr (IN(k) && IN((k) + 1)) GRID_BAR(); } while (0)
    unsigned char* ws = a.ws;

    if constexpr (IN(0)) { FRESH_WL(); p0_prologue(a, lds, vcu, G, w_, l_); }
    SEAM(0);
    if constexpr (IN(1)) {
        { pg8::DenseSched S; S.o.init(T / 256, 12, G, bx); S.Bt = (const char*)(ws + WS_WIN); S.K = D;
          pg8::EpiProj<false> E{(bf16_t*)(ws + WS_PROJ), (float*)(ws + WS_KMP)};
          pg8::gemm_phase(lds, (const char*)(ws + WS_H), D, D, D, S, E); }
        { pg8::DenseSched S; S.o.init(T / 256, 20, G, bx); S.Bt = (const char*)(ws + WS_WIN8); S.K = D; S.es = 1; S.pn0 = 12; S.bt_out = false;
          pg8::EpiProj<true> E{(bf16_t*)(ws + WS_PROJ), (float*)(ws + WS_KMP)};
          pg8::gemm_phase(lds, (const char*)(ws + WS_H8), D, D, D, S, E); }
    }
    SEAM(1);
    if constexpr (IN(2)) { for (int u = vcu; u < NB * 32; u += G) gla_prep_unit(a, lds, u); }
    SEAM(2);
    if constexpr (IN(3)) { for (int u = vcu; u < 512; u += G) gla_combine_unit(a, u); }
    SEAM(3);
    if constexpr (IN(4)) {
        for (int u = vcu; u < 1024; u += G) gla_out_unit(a, lds, u);
        __syncthreads();
    }
    if constexpr (IN(5)) {
        if ((vcu & 1) == 0) { FRESH_WL(); expert_convert(a, lds, vcu >> 1, G >> 1, w_, l_); __syncthreads(); }
        unsigned* queue = ctl + CW_QUEUE;
        volatile LAS int* qslot = (volatile LAS int*)(lds + LDSCTL_OFF + 1024);
        if (tid == 0) qslot[0] = (int)__hip_atomic_fetch_add(queue, 1u, RLX_AGENT);
        __syncthreads();
        int item = __builtin_amdgcn_readfirstlane(qslot[0]);
        if (item < 512) {
            moba::Seam S;
            moba::BlockRef cur = moba::make_ref(a, item);
            moba::prime(cur, (char*)lds_raw, S);
            for (;;) {
                const int nitem = moba::block(a, cur, queue, a.in[2], (const float*)(ws + WS_KMP), (char*)lds_raw, S);
                if (nitem >= 512) break;
                cur = moba::make_ref(a, nitem);
            }
        }
    }
    SEAM(5);
    if constexpr (IN(6)) {
        pg8::ChainSched S; S.o.init(T / 256, D / 256, G, bx); S.Bt = (const char*)(ws + WS_WUP); S.K = 1024;
        pg8::EpiMerge E{(const bf16_t*)(ws + WS_PROJ), (bf16_t*)(ws + WS_Y)};
        pg8::gemm_phase(lds, (const char*)(ws + WS_OAB), 1024, 2048, 2048, S, E);
    }
    SEAM(6);
    if constexpr (IN(7)) {
        pg8::DenseSched S; S.o.init(T / 256, D / 256, G, bx); S.Bt = (const char*)(ws + WS_WO); S.K = D;
        pg8::EpiResF32 E{a.in[0], (bf16_t*)(ws + WS_X1)};
        pg8::gemm_phase(lds, (const char*)(ws + WS_Y), D, D, D, S, E);
    }
    SEAM(7);
    if constexpr (IN(8)) { for (int u = vcu; u < T / 64; u += G) router_unit(a, lds, u); }
    SEAM(8);
    if constexpr (IN(9)) {
        moe_tables(a, lds); const LAS int* tab = (const LAS int*)(lds + LDS_MOE); const int ntile = __builtin_amdgcn_readfirstlane(tab[128 + MAXTILES]);
        pg8::MoeSched<true> S; S.o.init(ntile, 8, G, bx); S.Bt = (const char*)a.out; S.K = D; S.rows_per_e = 2048; S.tab = tab; S.row_e = (const int*)(ws + WS_ROWE); S.es = 1;
        pg8::EpiGlu E{(unsigned char*)(ws + WS_HMID), (const float*)(ws + WS_RSTE), tab, a.in[15], a.in[17], (const float*)(ws + WS_CTL) + 131072, lds};
        pg8::gemm_phase(lds, (const char*)(ws + WS_A2), D, D, D, S, E);
        const int extra = (ntile * 8) % G, nidle = G - extra;
        if (bx >= extra) { __syncthreads();
            pg8::DenseSched S2; S2.o.init(T / 256, D / 256, nidle, bx - extra); S2.Bt = (const char*)(ws + WS_WPP); S2.K = 256;
            pg8::EpiBf16<0, false> E2{(bf16_t*)(ws + WS_PPROJ), D, nullptr, 0, 1.0f};
            pg8::gemm_phase(lds, (const char*)(ws + WS_PB), 256, 256, 256, S2, E2); }
    }
    SEAM(9);
    if constexpr (IN(10)) {
        moe_tables(a, lds); const LAS int* tab = (const LAS int*)(lds + LDS_MOE); const int ntile = __builtin_amdgcn_readfirstlane(tab[128 + MAXTILES]);
        pg8::MoeSched<false> S; S.o.init(ntile, 4, G, bx); S.Bt = (const char*)(ws + WS_W2T); S.K = FF; S.rows_per_e = 1024; S.tab = tab; S.row_e = nullptr; S.es = 1;
        pg8::EpiDownF8 E{(unsigned char*)(ws + WS_YROWS), a.in[19]};
        pg8::gemm_phase(lds, (const char*)(ws + WS_HMID), FF, FF, FF, S, E);
    }
    SEAM(10);
    if constexpr (IN(11)) { moe_tables(a, lds); FRESH_WL(); combine_rows(a, lds, vcu, G, w_, l_); }
    SEAM(11);
    if constexpr (IN(12)) {
        { pg8::DenseSched S; S.o.init(T / 256, D / 256, G, bx); S.Bt = (const char*)(ws + WS_WPG); S.K = D; S.es = 1;
          pg8::EpiBf16<1, false, true> E{(bf16_t*)(ws + WS_PGATE), D, nullptr, 0, 1.0f / 32.0f};
          pg8::gemm_phase(lds, (const char*)(ws + WS_H), D, D, D, S, E); }
    }
    SEAM(12);
    if constexpr (IN(13)) { FRESH_WL(); final_rows(a, vcu, G, w_, l_); }
#undef FRESH_WL
#undef IN
#undef SEAM
#undef GRID_BAR
}

template <int LO, int HI> static void launch_range(const Args& a, int grid, hipStream_t stream) {
    static bool attr = false;
    if (!attr) { attr = true; if (hipFuncSetAttribute((const void*)hybrid_fwd<LO, HI>, hipFuncAttributeMaxDynamicSharedMemorySize, LDS_BYTES) != hipSuccess) fprintf(stderr, "kernel_launch: hipFuncSetAttribute failed\n"); }
    hipLaunchKernelGGL((hybrid_fwd<LO, HI>), dim3(grid), dim3(NTHREADS), LDS_BYTES, stream, a);
}
extern "C" void kernel_launch(void* const* d_in, const int* in_sizes, int n_in, void* d_out, int out_size, void* d_ws, size_t ws_size, hipStream_t stream) {
    static int grid = 0;
    if (grid == 0) {
        static const int expect[25] = {T * D, T * 256, 256, 1024, 1024 * D_IN, 16 * 512, 512, 256, 1048576, 1048576, 1048576, 1024, 32768, 32, 33554432, 32768, 33554432, 32768, 33554432, 32768, 1024, 1048576, 262144, 1024, 1024};
        bool okk = (n_in == 25);
        for (int i = 0; okk && i < 25; ++i) if (in_sizes[i] != expect[i]) { fprintf(stderr, "kernel_launch: input %d has %d elements, expected %d\n", i, in_sizes[i], expect[i]); okk = false; }
        if (!okk || out_size != T * D || ws_size < WS_END) { fprintf(stderr, "kernel_launch: unexpected shapes (n_in %d, in0 %d, out %d, ws %zu); nothing launched\n", n_in, n_in > 0 ? in_sizes[0] : -1, out_size, ws_size); grid = -1; return; }
        int dev = 0, cus = 0;
        if (hipGetDevice(&dev) != hipSuccess || hipDeviceGetAttribute(&cus, hipDeviceAttributeMultiprocessorCount, dev) != hipSuccess) { grid = -1; return; }
        grid = cus;
    }
    if (grid < 0) return;
    (void)hipMemsetAsync((char*)d_ws + WS_CTL, 0, CTL_ZERO_BYTES, stream);
    Args a{};
    for (int i = 0; i < 25; ++i) a.p.in[i] = (const float*)d_in[i];
    a.p.out = (float*)d_out; a.p.ws = (unsigned char*)d_ws;
#if MK_PER_PHASE
#ifndef MK_LAST
#define MK_LAST 13
#endif
#ifndef MK_REPEAT
#define MK_REPEAT 0
#endif
#define LR(k) do { if ((k) <= MK_LAST) for (int r_ = 0; r_ < 1 + ((MK_REPEAT >> (k)) & 1); ++r_) launch_range<(k), (k) + 1>(a, grid, stream); } while (0)
    LR(0); LR(1); LR(2); LR(3); LR(4); LR(5); LR(6); LR(7); LR(8); LR(9); LR(10); LR(11); LR(12); LR(13);
#undef LR
#else
    launch_range<0, NPHASES>(a, grid, stream);
#endif
}
```

```cpp
#include <hip/hip_runtime.h>
#include <cstdio>
#include <cstdint>

#define LAS __attribute__((address_space(3)))
#define GAS __attribute__((address_space(1)))
typedef unsigned short bf16_t;
typedef short bf16x8 __attribute__((ext_vector_type(8)));
typedef short s16x4 __attribute__((ext_vector_type(4)));
typedef float f32x2 __attribute__((ext_vector_type(2)));
typedef float f32x4 __attribute__((ext_vector_type(4)));
typedef float f32x16 __attribute__((ext_vector_type(16)));
typedef unsigned u32x2 __attribute__((ext_vector_type(2)));
typedef unsigned u32x4 __attribute__((ext_vector_type(4)));
typedef int i32x4 __attribute__((ext_vector_type(4)));
typedef int i32x8 __attribute__((ext_vector_type(8)));
typedef GAS unsigned gu32;
#define RLX_AGENT __ATOMIC_RELAXED, __HIP_MEMORY_SCOPE_AGENT
#define LDS_WAIT() asm volatile("s_waitcnt lgkmcnt(0)" ::: "memory")
#define VM_WAIT() asm volatile("s_waitcnt vmcnt(0)" ::: "memory")

#ifndef MK_PER_PHASE
#define MK_PER_PHASE 0
#endif

constexpr int NB = 8, SEQ = 2048, T = NB * SEQ, D = 1024;
constexpr int NPROJ = 8192;
constexpr int C_QA = 0, C_KA = 512, C_VA = 1024, C_RA = 2048, C_QB = 3072, C_KB = 4096, C_VB = 5120, C_GA = 6144, C_GB = 7168;
#define PROJ_BLK(cs) ((size_t)(cs) * T)
constexpr int SRC_ALOW = 3072, D_IN = 8208;
constexpr int NE = 32, FF = 1024, MAXTILES = 288, MAXROWS = MAXTILES * 256;
constexpr float EPS = 1e-6f;
constexpr int NWAVES = 8, NTHREADS = 512;
constexpr int NPHASES = 14;

constexpr size_t MiB = 1u << 20;
constexpr size_t WS_CTL = 0, CTL_ZERO_BYTES = 1 * MiB;
constexpr size_t WS_SMALL = 1 * MiB;
constexpr size_t WS_KMP   = WS_SMALL;
constexpr size_t WS_DEC   = WS_KMP + 512 * 1024;
constexpr size_t WS_TOPE  = WS_DEC + 512 * 1024;
constexpr size_t WS_WTS   = WS_TOPE + 256 * 1024;
constexpr size_t WS_SLOT  = WS_WTS + 256 * 1024;
constexpr size_t WS_DEST  = WS_SLOT + 256 * 1024;
constexpr size_t WS_ROWTOK = WS_DEST + 256 * 1024;
constexpr size_t WS_RSTDS = WS_ROWTOK + 320 * 1024;
constexpr size_t WS_RSTD  = WS_RSTDS + 320 * 1024;
constexpr size_t WS_TILEE = WS_RSTD + 64 * 1024;
constexpr size_t WS_WALT  = WS_TILEE + 4 * 1024;
constexpr size_t WS_WRF   = WS_WALT + 32 * 1024;
static_assert(WS_WRF + 128 * 1024 <= 6 * MiB, "small map");
constexpr size_t WS_WO = 6 * MiB, WS_WPG = 8 * MiB, WS_WPP = 10 * MiB, WS_WUP = 12 * MiB, WS_WIN = 16 * MiB;
constexpr size_t WS_PB = 34 * MiB;
constexpr size_t WS_H  = 42 * MiB;
constexpr size_t WS_PROJ = 74 * MiB;
constexpr size_t WS_QG = 330 * MiB, WS_KG = 346 * MiB;
constexpr size_t WS_SLOC = 426 * MiB;
constexpr size_t WS_OAB = 362 * MiB;
constexpr size_t WS_H8 = 426 * MiB;
constexpr size_t WS_WIN8 = 442 * MiB;
constexpr size_t WS_Y = 330 * MiB;
constexpr size_t WS_W2T = 42 * MiB;
constexpr size_t WS_A2 = 330 * MiB;
constexpr size_t WS_HMID = 138 * MiB;
constexpr size_t WS_X1 = 74 * MiB;
constexpr size_t WS_X2 = 138 * MiB;
constexpr size_t WS_YROWS = 282 * MiB;
constexpr size_t WS_PGATE = 330 * MiB, WS_PPROJ = 226 * MiB;
constexpr size_t WS_ROWE = 490 * MiB;
constexpr size_t WS_RSTE = 492 * MiB;
constexpr size_t WS_END = 506 * MiB;

constexpr int CW_BAR = 4096;
constexpr int CW_COUNTS = 16384;
constexpr int CW_QUEUE = 16384 + 64;

constexpr int RING_BYTES = 131072;
constexpr int LDSCTL_OFF = RING_BYTES, MISC_OFF = LDSCTL_OFF + 320;
constexpr int LDS_MOE = LDSCTL_OFF + 10240;
constexpr int EPF_OFF = LDSCTL_OFF + 12288;
constexpr int LDS_BYTES = 151552;

typedef __bf16 bf16v2_t __attribute__((ext_vector_type(2)));
__device__ __forceinline__ unsigned cvt_pk_bf16(float lo, float hi) { const f32x2 v = {lo, hi}; return __builtin_bit_cast(unsigned, __builtin_convertvector(v, bf16v2_t)); }
__device__ __forceinline__ unsigned pk4_fp8(float a, float b, float c, float d) { int w = 0; w = __builtin_amdgcn_cvt_pk_fp8_f32(a, b, w, false); w = __builtin_amdgcn_cvt_pk_fp8_f32(c, d, w, true); return (unsigned)w; }
__device__ __forceinline__ float bf2f(unsigned short s) { return __uint_as_float(((unsigned)s) << 16); }
__device__ __forceinline__ float bflo(unsigned w) { return __uint_as_float(w << 16); }
__device__ __forceinline__ float bfhi(unsigned w) { return __uint_as_float(w & 0xffff0000u); }
__device__ __forceinline__ float fsigmoid(float x) { return __builtin_amdgcn_rcpf(1.0f + __builtin_amdgcn_exp2f(-1.4426950408889634f * x)); }
__device__ __forceinline__ float wave_sum(float v) {
#pragma unroll
    for (int o = 1; o < 64; o <<= 1) v += __shfl_xor(v, o);
    return v;
}
__device__ __forceinline__ bf16x8 pack8(f32x4 a, f32x4 b) {
    u32x4 w = {cvt_pk_bf16(a[0], a[1]), cvt_pk_bf16(a[2], a[3]), cvt_pk_bf16(b[0], b[1]), cvt_pk_bf16(b[2], b[3])};
    return __builtin_bit_cast(bf16x8, w);
}

#define XB_TMO      128
#define XB_XCNT(j)  (256  + 64 * (j))
#define XB_XSUB(j)  (1280 + 64 * (j))
#define XB_XGEN(j)  (2304 + 64 * (j))
#define XB_TOP      3328
#define XB_TOPGEN   3392
#define XCD_BAR_WORDS 3456
#define XB_SPIN_CAP (1u << 18)

__device__ __forceinline__ unsigned xb_ld(unsigned* p)              { return __hip_atomic_load(p, __ATOMIC_RELAXED, __HIP_MEMORY_SCOPE_AGENT); }
__device__ __forceinline__ unsigned xb_add(unsigned* p, unsigned v) { return __hip_atomic_fetch_add(p, v, __ATOMIC_RELAXED, __HIP_MEMORY_SCOPE_AGENT); }
__device__ __forceinline__ unsigned xb_xcc_id() { return (unsigned)__builtin_amdgcn_s_getreg((3 << 11) | 20) & 0xFu; }
#define XB_SPIN(cond, bar) do { unsigned _sp = 0; while (cond) { __builtin_amdgcn_s_sleep(1); \
    if ((++_sp & 255u) == 0u) { if (xb_ld(&(bar)[XB_TMO])) break; if (_sp > XB_SPIN_CAP) { atomicAdd(&(bar)[XB_TMO], 1u); break; } } } } while (0)

struct XcdBarrier { unsigned* bar; unsigned x; volatile LAS unsigned* st; };

__device__ __forceinline__ XcdBarrier xcd_barrier_post(unsigned* bar, volatile LAS unsigned* st) {
    XcdBarrier b; b.bar = bar; b.x = xb_xcc_id(); b.st = st;
    if (threadIdx.x == 0) (void)xb_add(&bar[XB_XCNT(b.x)], 1u);
    return b;
}
__device__ __forceinline__ void xcd_barrier_complete(unsigned* bar, unsigned x, unsigned& nloc, unsigned& nx) {
    const unsigned G = gridDim.x * gridDim.y * gridDim.z;
    unsigned sum, cnt, mine, sp = 0u;
    for (;;) {
        sum = 0u; cnt = 0u; mine = 0u;
#pragma unroll
        for (unsigned j = 0; j < 16; ++j) { const unsigned c = xb_ld(&bar[XB_XCNT(j)]); sum += c; cnt += (c > 0u) ? 1u : 0u; mine = (j == x) ? c : mine; }
        if (sum == G) break;
        __builtin_amdgcn_s_sleep(1);
        if ((++sp & 255u) == 0u) { if (xb_ld(&bar[XB_TMO])) break; if (sp > XB_SPIN_CAP) { atomicAdd(&bar[XB_TMO], 1u); break; } }
    }
    nloc = mine > 0u ? mine : 1u; nx = cnt > 0u ? cnt : 1u;
}
__device__ __forceinline__ void xcd_barrier(const XcdBarrier& b) {
    asm volatile("s_waitcnt vmcnt(0)" ::: "memory");
    __syncthreads();
    if (threadIdx.x == 0) {
        unsigned* bar = b.bar;
        __builtin_amdgcn_s_waitcnt(0);
        unsigned nloc = b.st[0], nx = b.st[1];
        if (nloc == 0u) { xcd_barrier_complete(bar, b.x, nloc, nx); b.st[0] = nloc; b.st[1] = nx; }
        const unsigned old = xb_add(&bar[XB_XSUB(b.x)], 1u);
        const unsigned gen = old / nloc;
        if (old + 1u == (gen + 1u) * nloc) {
            __builtin_amdgcn_fence(__ATOMIC_RELEASE, "agent");
            asm volatile("s_waitcnt vmcnt(0)" ::: "memory");
            const unsigned og = xb_add(&bar[XB_TOP], 1u);
            const unsigned tg = og / nx;
            if (og + 1u == (tg + 1u) * nx) xb_add(&bar[XB_TOPGEN], 1u);
            else XB_SPIN(xb_ld(&bar[XB_TOPGEN]) == tg, bar);
            __builtin_amdgcn_fence(__ATOMIC_ACQUIRE, "agent");
            xb_add(&bar[XB_XGEN(b.x)], 1u);
            asm volatile("s_waitcnt vmcnt(0)" ::: "memory");
        } else {
            XB_SPIN(xb_ld(&bar[XB_XGEN(b.x)]) == gen, bar);
            __builtin_amdgcn_fence(__ATOMIC_ACQUIRE, "agent");
            asm volatile("s_waitcnt vmcnt(0)" ::: "memory");
        }
    }
    __syncthreads();
}
#ifndef MK_SCL
#define MK_SCL 0
#endif
namespace pg8 {
constexpr int BM = 256, BK = 64, HALF = 128, HTB = HALF * BK * 2, STAGE_BYTES = 8 * HTB, NXCD = 8, WGM = 8;

__host__ __device__ __forceinline__ int lds_byte(int r, int c) { const int st = (r >> 4) * 2 + (c >> 5), rr = r & 15, cc = c & 31, ob = rr * 64 + cc * 2; return st * 1024 + (ob ^ (((ob >> 9) & 1) << 5)); }
__host__ __device__ __forceinline__ void stage_rc(int b, int& R, int& C) { const int st = b / 1024, sb = b % 1024, swz = sb ^ (((sb >> 9) & 1) << 5); R = (st >> 1) * 16 + swz / 64; C = (st & 1) * 32 + (swz % 64) / 2; }
__host__ __device__ __forceinline__ int perm32(int rho) { const int n = rho >> 4, i = rho & 15; return 8 * (i >> 2) + 4 * n + (i & 3); }

struct Unit { int pm, pn, e, s; };

struct TileOrder {
    int nM, nN, nwg, G, c;
    __device__ __forceinline__ void init(int nM_, int nN_, int G_, int c_) { nM = nM_; nN = nN_; nwg = nM * nN; G = G_; c = c_; }
    __device__ __forceinline__ bool next(int i, int& pm, int& pn) const {
        const unsigned L = (unsigned)i * (unsigned)G + (unsigned)c; if (L >= (unsigned)nwg) return false;
        int wgid = (int)L; { const int q = nwg / NXCD, r = nwg % NXCD, xcd = wgid % NXCD, off = wgid / NXCD; wgid = (xcd < r ? xcd * (q + 1) : r * (q + 1) + (xcd - r) * q) + off; }
        const int nig = WGM * nN, gid = wgid / nig, fm = gid * WGM, gsz = (nM - fm) < WGM ? (nM - fm) : WGM;
        pm = fm + ((wgid % nig) % gsz); pn = (wgid % nig) / gsz; return true;
    }
};
struct DenseSched {
    TileOrder o; const char* Bt; int K; int es = 2; int gap_at = 1 << 30, gap_by = 0, pn0 = 0; bool bt_out = true;
    __device__ __forceinline__ bool next(int i, Unit& u) const { int p; if (!o.next(i, u.pm, p)) return false; u.e = p; u.pn = p + (p >= gap_at ? gap_by : 0) + pn0; return true; }
    __device__ __forceinline__ unsigned a_row(const Unit& u, int r) const { return (unsigned)(u.pm * BM + r); }
    __device__ __forceinline__ unsigned a_koff(const Unit&) const { return 0u; }
    __device__ __forceinline__ const char* b_base(const Unit& u) const { return Bt + (size_t)(bt_out ? u.pn : u.e) * BM * K * es; }
};
struct ChainSched {
    TileOrder o; const char* Bt; int K;
    __device__ __forceinline__ bool next(int i, Unit& u) const { if (!o.next(i >> 1, u.pm, u.pn)) return false; u.e = i & 1; return true; }
    __device__ __forceinline__ unsigned a_row(const Unit& u, int r) const { return (unsigned)(u.pm * BM + r); }
    __device__ __forceinline__ unsigned a_koff(const Unit& u) const { return (unsigned)(u.e * K * 2); }
    __device__ __forceinline__ const char* b_base(const Unit& u) const { return Bt + (size_t)u.pn * BM * (2 * K) * 2 + (size_t)u.e * K * 2; }
};
template <bool GATHER> struct MoeSched {
    TileOrder o; const char* Bt; int K; int rows_per_e; const LAS int* tab; const int* row_e; int es;
    __device__ __forceinline__ bool next(int i, Unit& u) const { if (!o.next(i, u.pm, u.pn)) return false; u.e = __builtin_amdgcn_readfirstlane(tab[128 + u.pm]); return true; }
    __device__ __forceinline__ unsigned a_row(const Unit& u, int r) const {
        if (GATHER) { const int lr = u.pm * BM + r - tab[u.e]; return lr < tab[64 + u.e] ? (unsigned)row_e[(size_t)u.e * T + lr] : 0u; }
        else return (unsigned)(u.pm * BM + r); }
    __device__ __forceinline__ unsigned a_koff(const Unit&) const { return 0u; }
    __device__ __forceinline__ const char* b_base(const Unit& u) const { return Bt + ((size_t)u.e * rows_per_e + (size_t)u.pn * BM) * K * es; }
};

template <class Epi, class Sched>
__device__ __forceinline__ void gemm_phase(LAS unsigned char* lds, const char* gA, int K_, int lda, int ldb, const Sched& S, const Epi& E) {
    int K = K_; asm volatile("" : "+s"(K));
    int tid = threadIdx.x; asm volatile("" : "+v"(tid));     const int wid = __builtin_amdgcn_readfirstlane(tid >> 6), lane = tid & 63, wr = wid >> 2, wc = wid & 3, fr = lane & 15, fq = lane >> 4;
    constexpr int ES = Epi::F8 ? 1 : 2;
    const int nt = K * ES / 128;
    unsigned voffB[2];
#pragma unroll
    for (int i = 0; i < 2; ++i) { int R, C; stage_rc(tid * 16 + i * 8192, R, C); const int Rb = Epi::PERM ? ((R & ~31) + perm32(R & 31)) : R; voffB[i] = (unsigned)(Rb * ldb * ES + C * 2); }
    const unsigned kstep = (unsigned)(BK * 2);
    const size_t hstepB = (size_t)HALF * ldb * ES;
    const unsigned ldab = (unsigned)lda * ES;
    const unsigned ldsw = (unsigned)wid * 1024u;
    const int aoff = lds_byte(wr * 64 + fr, fq * 8), boff = lds_byte(wc * 32 + fr, fq * 8);
#define PG8_SA(b, h) (((b) * 2 + (h)) * HTB)
#define PG8_SB(b, h) ((4 + (b) * 2 + (h)) * HTB)
#define PG8_STAGE_B(bufoff, gbase) do { _Pragma("unroll") for (int _i = 0; _i < 2; ++_i) \
        __builtin_amdgcn_global_load_lds((const unsigned*)((const char*)(gbase) + voffB[_i]), (LAS unsigned*)(lds + (bufoff) + ldsw + _i * 8192), 16, 0, 0); } while (0)
#define PG8_STAGE_A(bufoff, o0, o1, kb) do { \
        const char* gk_ = gA + (kb);      \
        __builtin_amdgcn_global_load_lds((const unsigned*)(gk_ + (o0)), (LAS unsigned*)(lds + (bufoff) + ldsw), 16, 0, 0); \
        __builtin_amdgcn_global_load_lds((const unsigned*)(gk_ + (o1)), (LAS unsigned*)(lds + (bufoff) + ldsw + 8192), 16, 0, 0); } while (0)
#define PG8_LDA(dst, b, h) do { _Pragma("unroll") for (int m = 0; m < 4; ++m) _Pragma("unroll") for (int k = 0; k < 2; ++k) dst[m][k] = *(const LAS bf16x8*)(lds + PG8_SA(b, h) + aoff + m * 2048 + k * 1024); } while (0)
#define PG8_LDB(dst, b, h) do { _Pragma("unroll") for (int n = 0; n < 2; ++n) _Pragma("unroll") for (int k = 0; k < 2; ++k) dst[n][k] = *(const LAS bf16x8*)(lds + PG8_SB(b, h) + boff + n * 2048 + k * 1024); } while (0)
#define PG8_MMA(ai, bj, At, Bt) do { __builtin_amdgcn_s_setprio(1); \
        if constexpr (Epi::F8) { _Pragma("unroll") for (int m = 0; m < 4; ++m) _Pragma("unroll") for (int n = 0; n < 2; ++n) { \
            const i32x8 a8_ = __builtin_shufflevector(__builtin_bit_cast(i32x4, At[m][0]), __builtin_bit_cast(i32x4, At[m][1]), 0, 1, 2, 3, 4, 5, 6, 7); \
            const i32x8 b8_ = __builtin_shufflevector(__builtin_bit_cast(i32x4, Bt[n][0]), __builtin_bit_cast(i32x4, Bt[n][1]), 0, 1, 2, 3, 4, 5, 6, 7); \
            acc[ai][bj][m][n] = __builtin_amdgcn_mfma_scale_f32_16x16x128_f8f6f4(b8_, a8_, acc[ai][bj][m][n], 0, 0, 0, MK_SCL, 0, MK_SCL); } } \
        else { _Pragma("unroll") for (int m = 0; m < 4; ++m) _Pragma("unroll") for (int n = 0; n < 2; ++n) _Pragma("unroll") for (int k = 0; k < 2; ++k) \
            acc[ai][bj][m][n] = __builtin_amdgcn_mfma_f32_16x16x32_bf16(Bt[n][k], At[m][k], acc[ai][bj][m][n], 0, 0, 0); } \
        __builtin_amdgcn_s_setprio(0); } while (0)
#define PG8_WAIT_V(n) asm volatile("s_waitcnt vmcnt(" #n ")" ::: "memory")
#define PG8_WAIT_L(n) asm volatile("s_waitcnt lgkmcnt(" #n ")" ::: "memory")
#define PG8_BAR __builtin_amdgcn_s_barrier()
#define PG8_SCHED __builtin_amdgcn_sched_barrier(0)
#define PG8_AOFFS(dst, u) do { int t_ = threadIdx.x; asm volatile("" : "+v"(t_));     \
        _Pragma("unroll") for (int _h = 0; _h < 2; ++_h) _Pragma("unroll") for (int _i = 0; _i < 2; ++_i) { int R_, C_; stage_rc(t_ * 16 + _i * 8192, R_, C_); \
        dst[_h][_i] = S.a_row(u, _h * HALF + R_) * ldab + (unsigned)C_ * 2u + S.a_koff(u); } } while (0)
    Unit cur, nxt; int ui = 0;
    if (!S.next(0, cur)) return;
    cur.s = 0;
    if constexpr (Epi::PREF) E.prefetch(cur, 0);
#ifdef MK_STAGGER
    if (S.o.nwg > 3 * S.o.G) {
        const unsigned long long t0_ = __builtin_amdgcn_s_memrealtime(); const unsigned long long d_ = (unsigned long long)((blockIdx.x >> 3) & 7) * MK_STAGGER;
        while (__builtin_amdgcn_s_memrealtime() - t0_ < d_) __builtin_amdgcn_s_sleep(4);
    }
#endif
    f32x4 acc[2][2][4][2];
#pragma unroll
    for (int a = 0; a < 2; ++a)
#pragma unroll
        for (int b = 0; b < 2; ++b)
#pragma unroll
            for (int m = 0; m < 4; ++m)
#pragma unroll
                for (int n = 0; n < 2; ++n) acc[a][b][m][n] = (f32x4){0.f, 0.f, 0.f, 0.f};
    bf16x8 At[4][2], B0[2][2], B1[2][2];
    unsigned oc[2][2];
    LAS u32x4* nslot = (LAS u32x4*)(lds + LDSCTL_OFF + 2048) + tid;
    PG8_AOFFS(oc, cur);
    const char* cB = S.b_base(cur);
    PG8_STAGE_B(PG8_SB(0, 0), cB); PG8_STAGE_B(PG8_SB(0, 1), cB + hstepB); PG8_STAGE_A(PG8_SA(0, 0), oc[0][0], oc[0][1], 0u); PG8_STAGE_A(PG8_SA(0, 1), oc[1][0], oc[1][1], 0u);
    if (wr == 1) PG8_BAR;
    PG8_WAIT_V(2); PG8_BAR;
    PG8_STAGE_B(PG8_SB(1, 0), cB + kstep); PG8_STAGE_A(PG8_SA(1, 0), oc[0][0], oc[0][1], kstep); PG8_STAGE_B(PG8_SB(1, 1), cB + hstepB + kstep);
    PG8_WAIT_V(6); PG8_BAR;
    for (;;) {
        const bool has_next = S.next(ui + 1, nxt);
        const char* nB = has_next ? S.b_base(nxt) : cB;
        if (has_next) { unsigned on[2][2]; PG8_AOFFS(on, nxt); *nslot = (u32x4){on[0][0], on[0][1], on[1][0], on[1][1]}; nxt.s = cur.s == 2 ? 0 : cur.s + 1;
            if constexpr (Epi::PREF) E.prefetch(nxt, nxt.s); }
        for (int t = 0; t < nt; t += 2) {
            const bool last = (t == nt - 2);
            const unsigned k1 = (unsigned)(t + 1) * kstep;
            const unsigned k2 = last ? 0u : (unsigned)(t + 2) * kstep, k3 = k2 + kstep;
            const char* b2 = last ? nB : cB + (size_t)(t + 2) * kstep; const char* b3 = b2 + kstep;
            PG8_LDB(B0, 0, 0); PG8_LDB(B1, 0, 1); PG8_SCHED; PG8_LDA(At, 0, 0); PG8_STAGE_A(PG8_SA(1, 1), oc[1][0], oc[1][1], k1);
            PG8_WAIT_V(8); PG8_WAIT_L(0); PG8_BAR; PG8_MMA(0, 0, At, B0); PG8_MMA(0, 1, At, B1); PG8_BAR; PG8_SCHED;
            if (last && has_next) { const u32x4 o_ = *nslot; oc[0][0] = o_.x; oc[0][1] = o_.y; oc[1][0] = o_.z; oc[1][1] = o_.w; }
            PG8_LDA(At, 0, 1); PG8_STAGE_B(PG8_SB(0, 0), b2); PG8_STAGE_B(PG8_SB(0, 1), b2 + hstepB); PG8_STAGE_A(PG8_SA(0, 0), oc[0][0], oc[0][1], k2);
            PG8_WAIT_V(8); PG8_WAIT_L(0); PG8_BAR; PG8_MMA(1, 0, At, B0); PG8_MMA(1, 1, At, B1); PG8_BAR; PG8_SCHED;
            PG8_LDB(B0, 1, 0); PG8_LDB(B1, 1, 1); PG8_SCHED; PG8_LDA(At, 1, 0); PG8_STAGE_A(PG8_SA(0, 1), oc[1][0], oc[1][1], k2);
            PG8_WAIT_V(8); PG8_WAIT_L(0); PG8_BAR; PG8_MMA(0, 0, At, B0); PG8_MMA(0, 1, At, B1); PG8_BAR; PG8_SCHED;
            PG8_LDA(At, 1, 1); PG8_STAGE_B(PG8_SB(1, 0), b3); PG8_STAGE_B(PG8_SB(1, 1), b3 + hstepB); PG8_STAGE_A(PG8_SA(1, 0), oc[0][0], oc[0][1], k3);
            PG8_WAIT_V(8); PG8_WAIT_L(0); PG8_BAR; PG8_MMA(1, 0, At, B0); PG8_MMA(1, 1, At, B1); PG8_BAR; PG8_SCHED;
        }
        if (wr == 0) PG8_BAR;
        bool carry = false;
        if constexpr (Epi::MIDK) { if (cur.e == 0) { E.mid(acc, cur, wr, wc, fr, fq); carry = true; } else E(acc, cur, wr, wc, fr, fq); } else E(acc, cur, wr, wc, fr, fq);
        if (!has_next) break;
        if (!carry)
#pragma unroll
        for (int a = 0; a < 2; ++a)
#pragma unroll
            for (int b = 0; b < 2; ++b)
#pragma unroll
                for (int m = 0; m < 4; ++m)
#pragma unroll
                    for (int n = 0; n < 2; ++n) acc[a][b][m][n] = (f32x4){0.f, 0.f, 0.f, 0.f};
        cur = nxt; cB = nB; ++ui;
        if (wr == 1) PG8_BAR;
    }
    PG8_WAIT_V(0);
    PG8_BAR;
#undef PG8_SA
#undef PG8_SB
#undef PG8_STAGE_A
#undef PG8_STAGE_B
#undef PG8_LDA
#undef PG8_LDB
#undef PG8_MMA
#undef PG8_WAIT_V
#undef PG8_WAIT_L
#undef PG8_BAR
#undef PG8_SCHED
#undef PG8_AOFFS
}

template <bool F8_> struct EpiProj {
    static constexpr bool PREF = false, PERM = true, MIDK = false, F8 = F8_;
    bf16_t* O; float* kmp;
    __device__ __forceinline__ void operator()(const f32x4 (&acc)[2][2][4][2], const Unit& u, int wr, int wc, int fr, int fq) const {
        const int row0 = u.pm * BM + wr * 64 + fr;
        const bool narrow = (u.pn < C_VA / BM) || (u.pn >= C_QB / BM && u.pn < C_GA / BM);
        const bool gate = u.pn >= C_GA / BM;
        const int hw = narrow ? 128 : 256; const size_t bjs = narrow ? (size_t)HALF * T : (size_t)HALF;
#pragma unroll
        for (int ai = 0; ai < 2; ++ai)
#pragma unroll
            for (int m = 0; m < 4; ++m) { bf16_t* rowp = O + PROJ_BLK(u.pn * BM) + (size_t)(row0 + ai * HALF + m * 16) * hw + wc * 32 + 8 * fq;
#pragma unroll
                for (int bj = 0; bj < 2; ++bj) { const float sc = F8 ? (1.0f / 32.0f) : 1.0f; const f32x4 v0 = acc[ai][bj][m][0] * sc, v1 = acc[ai][bj][m][1] * sc;
                    if (F8 && gate) { u32x2 w8; w8.x = pk4_fp8(v0[0], v0[1], v0[2], v0[3]); w8.y = pk4_fp8(v1[0], v1[1], v1[2], v1[3]);
                        __builtin_nontemporal_store(w8, (u32x2*)((unsigned char*)(O + PROJ_BLK(u.pn * BM)) + (size_t)(row0 + ai * HALF + m * 16) * 256 + bj * HALF + wc * 32 + 8 * fq)); continue; }
                    u32x4 w; w.x = cvt_pk_bf16(v0[0], v0[1]); w.y = cvt_pk_bf16(v0[2], v0[3]); w.z = cvt_pk_bf16(v1[0], v1[1]); w.w = cvt_pk_bf16(v1[2], v1[3]);
                    __builtin_nontemporal_store(w, (u32x4*)(rowp + bj * bjs)); } }
        if (u.pn >= C_KB / BM && u.pn < C_VB / BM) {
#pragma unroll
            for (int bj = 0; bj < 2; ++bj)
#pragma unroll
                for (int n = 0; n < 2; ++n) { f32x4 s = (f32x4){0.f, 0.f, 0.f, 0.f};
#pragma unroll
                    for (int ai = 0; ai < 2; ++ai)
#pragma unroll
                        for (int m = 0; m < 4; ++m) s += acc[ai][bj][m][n];
#pragma unroll
                    for (int o = 1; o < 16; o <<= 1) { s[0] += __shfl_xor(s[0], o); s[1] += __shfl_xor(s[1], o); s[2] += __shfl_xor(s[2], o); s[3] += __shfl_xor(s[3], o); }
                    if (fr == 0) *(f32x4*)(kmp + ((size_t)wr * 64 + u.pm) * 1024 + (u.pn - C_KB / BM) * BM + bj * HALF + wc * 32 + 8 * fq + 4 * n) = s * (F8 ? (1.0f / 32.0f) : 1.0f); }
        }
    }
};
struct EpiMerge {
    static constexpr bool PREF = false, PERM = true, MIDK = true, F8 = false;
    const bf16_t* proj; bf16_t* Y;
    __device__ __forceinline__ void mid(f32x4 (&acc)[2][2][4][2], const Unit& u, int wr, int wc, int fr, int fq) const {
        const int row0 = u.pm * BM + wr * 64 + fr; const int col0 = u.pn * BM + wc * 32 + 8 * fq;
#pragma unroll
        for (int ai = 0; ai < 2; ++ai) {
            u32x2 ga[4][2], gb[4][2];
#pragma unroll
            for (int m = 0; m < 4; ++m) { const unsigned char* rowp = (const unsigned char*)(proj + PROJ_BLK(u.pn * BM)) + (size_t)(row0 + ai * HALF + m * 16) * 256 + wc * 32 + 8 * fq;
#pragma unroll
                for (int bj = 0; bj < 2; ++bj) { ga[m][bj] = *(const u32x2*)(rowp + 2 * PROJ_BLK(C_GA) + bj * HALF); gb[m][bj] = *(const u32x2*)(rowp + 2 * PROJ_BLK(C_GB) + bj * HALF); } }
#pragma unroll
            for (int m = 0; m < 4; ++m) {
#pragma unroll
                for (int bj = 0; bj < 2; ++bj) {
#pragma unroll
                    for (int n = 0; n < 2; ++n) {
#define MG_R(b_) ((1.0f + __builtin_amdgcn_exp2f(-1.4426950408889634f * __builtin_amdgcn_cvt_f32_fp8((int)gb[m][bj][n], b_))) * __builtin_amdgcn_rcpf(1.0f + __builtin_amdgcn_exp2f(-1.4426950408889634f * __builtin_amdgcn_cvt_f32_fp8((int)ga[m][bj][n], b_))))
                        acc[ai][bj][m][n][0] *= MG_R(0); acc[ai][bj][m][n][1] *= MG_R(1); acc[ai][bj][m][n][2] *= MG_R(2); acc[ai][bj][m][n][3] *= MG_R(3);
#undef MG_R
                    } }
                asm volatile("" : "+v"(acc[ai][0][m][0]), "+v"(acc[ai][0][m][1]), "+v"(acc[ai][1][m][0]), "+v"(acc[ai][1][m][1])); }
            asm volatile("" ::: "memory"); }
    }
    __device__ __forceinline__ void operator()(const f32x4 (&acc)[2][2][4][2], const Unit& u, int wr, int wc, int fr, int fq) const {
        const int row0 = u.pm * BM + wr * 64 + fr; const int col0 = u.pn * BM + wc * 32 + 8 * fq;
#pragma unroll
        for (int ai = 0; ai < 2; ++ai) {
            u32x2 gb[4][2];
#pragma unroll
            for (int m = 0; m < 4; ++m)
#pragma unroll
                for (int bj = 0; bj < 2; ++bj) gb[m][bj] = *(const u32x2*)((const unsigned char*)(proj + PROJ_BLK(C_GB + u.pn * BM)) + (size_t)(row0 + ai * HALF + m * 16) * 256 + wc * 32 + 8 * fq + bj * HALF);
#pragma unroll
            for (int m = 0; m < 4; ++m) { const size_t r = (size_t)(row0 + ai * HALF + m * 16);
#pragma unroll
                for (int bj = 0; bj < 2; ++bj) { const u32x2 g = gb[m][bj];
                    const f32x4 v0 = acc[ai][bj][m][0], v1 = acc[ai][bj][m][1];
#define MG_S(w_, b_) fsigmoid(__builtin_amdgcn_cvt_f32_fp8((int)(w_), b_))
                    u32x4 w; w.x = cvt_pk_bf16(v0[0] * MG_S(g.x, 0), v0[1] * MG_S(g.x, 1)); w.y = cvt_pk_bf16(v0[2] * MG_S(g.x, 2), v0[3] * MG_S(g.x, 3));
                    w.z = cvt_pk_bf16(v1[0] * MG_S(g.y, 0), v1[1] * MG_S(g.y, 1)); w.w = cvt_pk_bf16(v1[2] * MG_S(g.y, 2), v1[3] * MG_S(g.y, 3));
#undef MG_S
                    *(u32x4*)(Y + r * D + col0 + bj * HALF) = w; } }
            asm volatile("" ::: "memory"); }
    }
};
struct EpiResF32 {
    static constexpr bool PREF = false, PERM = false, MIDK = false, F8 = false;
    const float* base; bf16_t* out;
    __device__ __forceinline__ void operator()(const f32x4 (&acc)[2][2][4][2], const Unit& u, int wr, int wc, int fr, int fq) const {
        const int row0 = u.pm * BM + wr * 64 + fr, col0 = u.pn * BM + wc * 32 + 4 * fq;
#pragma unroll
        for (int ai = 0; ai < 2; ++ai) {
            f32x4 bs[4][2][2];
#pragma unroll
            for (int m = 0; m < 4; ++m) { const size_t off = (size_t)(row0 + ai * HALF + m * 16) * D + col0;
#pragma unroll
                for (int bj = 0; bj < 2; ++bj)
#pragma unroll
                    for (int n = 0; n < 2; ++n) bs[m][bj][n] = __builtin_nontemporal_load((const f32x4*)(base + off + bj * HALF + n * 16)); }
#pragma unroll
            for (int m = 0; m < 4; ++m) { const size_t off = (size_t)(row0 + ai * HALF + m * 16) * D + col0;
#pragma unroll
                for (int bj = 0; bj < 2; ++bj)
#pragma unroll
                    for (int n = 0; n < 2; ++n) { const f32x4 v = bs[m][bj][n] + acc[ai][bj][m][n]; u32x2 w; w.x = cvt_pk_bf16(v[0], v[1]); w.y = cvt_pk_bf16(v[2], v[3]); *(u32x2*)(out + off + bj * HALF + n * 16) = w; } }
            asm volatile("" ::: "memory"); }
    }
};
struct EpiGlu {
    static constexpr bool PREF = true, PERM = true, MIDK = false, F8 = true;
    unsigned char* H; const float* rstd_e; const LAS int* tab; const float* bg; const float* bu; const float* zero; LAS unsigned char* lds;
    __device__ __forceinline__ void prefetch(const Unit& u, int slot) const {
        int tid = threadIdx.x; asm volatile("" : "+v"(tid)); const int wave = __builtin_amdgcn_readfirstlane(tid >> 6);
        const float* src;
        if (wave < 4) { const int lr = u.pm * BM + tid - tab[u.e]; src = lr < tab[64 + u.e] ? rstd_e + (size_t)u.e * T + lr : zero; }
        else { const int j = tid - 256; src = (j < 128 ? bg : bu) + (size_t)u.e * FF + u.pn * HALF + (j & 127); }
        __builtin_amdgcn_global_load_lds((const unsigned*)src, (LAS unsigned*)(lds + EPF_OFF + slot * 2048 + wave * 256), 4, 0, 0);
    }
    __device__ __forceinline__ void operator()(const f32x4 (&acc)[2][2][4][2], const Unit& u, int wr, int wc, int fr, int fq) const {
        const int row0 = u.pm * BM + wr * 64 + fr; const int colo = u.pn * HALF + wc * 32 + 8 * fq;
        const LAS float* ep = (const LAS float*)(lds + EPF_OFF + u.s * 2048);
        f32x4 g4[2], u4[2];
#pragma unroll
        for (int n = 0; n < 2; ++n) { g4[n] = *(const LAS f32x4*)(ep + 256 + wc * 32 + 8 * fq + 4 * n); u4[n] = *(const LAS f32x4*)(ep + 384 + wc * 32 + 8 * fq + 4 * n); }
        float rsv[2][4];
#pragma unroll
        for (int ai = 0; ai < 2; ++ai)
#pragma unroll
            for (int m = 0; m < 4; ++m) rsv[ai][m] = ep[wr * 64 + fr + ai * HALF + m * 16];
#pragma unroll
        for (int ai = 0; ai < 2; ++ai)
#pragma unroll
            for (int m = 0; m < 4; ++m) { const int r = row0 + ai * HALF + m * 16; const float rs = rsv[ai][m] * (1.0f / 32.0f);
                float o[8];
#pragma unroll
                for (int n = 0; n < 2; ++n)
#pragma unroll
                    for (int j = 0; j < 4; ++j) { float g = acc[ai][0][m][n][j] * rs + g4[n][j], up = acc[ai][1][m][n][j] * rs + u4[n][j];
                        g = fminf(g, 7.0f); up = fminf(fmaxf(up, -7.0f), 7.0f);
                        const float glu = g * fsigmoid(1.702f * g); o[n * 4 + j] = (up + 1.0f) * glu; }
                u32x2 w; w.x = pk4_fp8(o[0], o[1], o[2], o[3]); w.y = pk4_fp8(o[4], o[5], o[6], o[7]);
                *(u32x2*)(H + (size_t)r * FF + colo) = w; asm volatile("" ::: "memory"); }
    }
};
template <int ACT, bool HASBIAS, bool F8_ = false> struct EpiBf16 {
    static constexpr bool PREF = false, PERM = true, MIDK = false, F8 = F8_;
    bf16_t* O; int ldc; const float* bias; int bias_stride; float scale;
    __device__ __forceinline__ void operator()(const f32x4 (&acc)[2][2][4][2], const Unit& u, int wr, int wc, int fr, int fq) const {
        const int row0 = u.pm * BM + wr * 64 + fr; const int col0 = u.pn * BM + wc * 32 + 8 * fq;
        f32x4 bv[2][2];
#pragma unroll
        for (int bj = 0; bj < 2; ++bj)
#pragma unroll
            for (int n = 0; n < 2; ++n) bv[bj][n] = HASBIAS ? *(const f32x4*)(bias + (size_t)u.e * bias_stride + col0 + bj * HALF + 4 * n) : (f32x4){0.f, 0.f, 0.f, 0.f};
#pragma unroll
        for (int ai = 0; ai < 2; ++ai)
#pragma unroll
            for (int m = 0; m < 4; ++m) { bf16_t* rowp = O + (size_t)(row0 + ai * HALF + m * 16) * ldc + col0;
#pragma unroll
                for (int bj = 0; bj < 2; ++bj) { f32x4 v0 = acc[ai][bj][m][0] * scale + bv[bj][0], v1 = acc[ai][bj][m][1] * scale + bv[bj][1];
                    if (ACT == 1) {
#pragma unroll
                        for (int j = 0; j < 4; ++j) { v0[j] = fsigmoid(v0[j]); v1[j] = fsigmoid(v1[j]); } }
                    u32x4 w; w.x = cvt_pk_bf16(v0[0], v0[1]); w.y = cvt_pk_bf16(v0[2], v0[3]); w.z = cvt_pk_bf16(v1[0], v1[1]); w.w = cvt_pk_bf16(v1[2], v1[3]);
                    *(u32x4*)(rowp + bj * HALF) = w; }
                asm volatile("" ::: "memory"); }
    }
};
struct EpiDownF8 {
    static constexpr bool PREF = false, PERM = true, MIDK = false, F8 = true;
    unsigned char* O; const float* bias;
    __device__ __forceinline__ void operator()(const f32x4 (&acc)[2][2][4][2], const Unit& u, int wr, int wc, int fr, int fq) const {
        const int row0 = u.pm * BM + wr * 64 + fr; const int col0 = u.pn * BM + wc * 32 + 8 * fq;
        f32x4 bv[2][2];
#pragma unroll
        for (int bj = 0; bj < 2; ++bj)
#pragma unroll
            for (int n = 0; n < 2; ++n) bv[bj][n] = *(const f32x4*)(bias + (size_t)u.e * D + col0 + bj * HALF + 4 * n);
#pragma unroll
        for (int ai = 0; ai < 2; ++ai)
#pragma unroll
            for (int m = 0; m < 4; ++m) { unsigned char* rowp = O + (size_t)(row0 + ai * HALF + m * 16) * D + col0;
#pragma unroll
                for (int bj = 0; bj < 2; ++bj) { const f32x4 v0 = acc[ai][bj][m][0] * (1.0f / 32.0f) + bv[bj][0], v1 = acc[ai][bj][m][1] * (1.0f / 32.0f) + bv[bj][1];
                    u32x2 w; w.x = pk4_fp8(v0[0], v0[1], v0[2], v0[3]); w.y = pk4_fp8(v1[0], v1[1], v1[2], v1[3]);
                    *(u32x2*)(rowp + bj * HALF) = w; }
                asm volatile("" ::: "memory"); }
    }
};
}
__device__ __forceinline__ void transpose_item(const float* __restrict__ W, int ldw, int k0, int n_src0, bf16_t* __restrict__ WT, int ldo, int n_dst0, int k_off, LAS float* scr, int lane) {
    { float t_[32]; const float* wp_ = W + (size_t)(k0 + (lane >> 5)) * ldw + n_src0 + (lane & 31);
#pragma unroll
    for (int i = 0; i < 32; ++i) t_[i] = __builtin_nontemporal_load(wp_ + (size_t)(2 * i) * ldw);
#pragma unroll
    for (int i = 0; i < 32; ++i) scr[(2 * i + (lane >> 5)) * 33 + (lane & 31)] = t_[i]; }
    LDS_WAIT(); asm volatile("" ::: "memory");
    const int c = lane & 7;
#pragma unroll
    for (int j = 0; j < 4; ++j) { const int n = (lane >> 3) + 8 * j; const LAS float* s = scr + (8 * c) * 33 + n;
        u32x4 o; o.x = cvt_pk_bf16(s[0 * 33], s[1 * 33]); o.y = cvt_pk_bf16(s[2 * 33], s[3 * 33]); o.z = cvt_pk_bf16(s[4 * 33], s[5 * 33]); o.w = cvt_pk_bf16(s[6 * 33], s[7 * 33]);
        *(u32x4*)(WT + (size_t)(n_dst0 + n) * ldo + k_off + k0 + 8 * c) = o; }
    LDS_WAIT(); asm volatile("" ::: "memory");
}
__device__ __forceinline__ void transpose_item_f8(const float* __restrict__ W, int ldw, int k0, int n_src0, unsigned char* __restrict__ WT, int ldo, int n_dst0, float sc, LAS float* scr, int lane) {
    { float t_[32]; const float* wp_ = W + (size_t)(k0 + (lane >> 5)) * ldw + n_src0 + (lane & 31);
#pragma unroll
    for (int i = 0; i < 32; ++i) t_[i] = __builtin_nontemporal_load(wp_ + (size_t)(2 * i) * ldw);
#pragma unroll
    for (int i = 0; i < 32; ++i) scr[(2 * i + (lane >> 5)) * 33 + (lane & 31)] = t_[i]; }
    LDS_WAIT(); asm volatile("" ::: "memory");
    const int c = lane & 7;
#pragma unroll
    for (int j = 0; j < 4; ++j) { const int n = (lane >> 3) + 8 * j; const LAS float* s = scr + (8 * c) * 33 + n;
        u32x2 o; o.x = pk4_fp8(s[0 * 33] * sc, s[1 * 33] * sc, s[2 * 33] * sc, s[3 * 33] * sc); o.y = pk4_fp8(s[4 * 33] * sc, s[5 * 33] * sc, s[6 * 33] * sc, s[7 * 33] * sc);
        *(u32x2*)(WT + (size_t)(n_dst0 + n) * ldo + k0 + 8 * c) = o; }
    LDS_WAIT(); asm volatile("" ::: "memory");
}
__device__ __forceinline__ void transpose_mat_item(const float* W, int ldw, int N, int n_src_base, bf16_t* WT, int ldo, int n_dst_base, int k_off, LAS float* scr, int item, int lane) {
    const int nblk = N / 32, kb = item / nblk, nb = item % nblk;
    transpose_item(W, ldw, 64 * kb, n_src_base + 32 * nb, WT, ldo, n_dst_base + 32 * nb, k_off, scr, lane);
}

struct P {
    const float* in[25]; float* out; unsigned char* ws;
};

__device__ __forceinline__ void p0_prologue(const P& a, LAS unsigned char* lds, int vcu, int G, int wave, int lane) {
    LAS float* scr = (LAS float*)(lds + wave * 16384);
    const int gw = vcu * NWAVES + wave, NGW = G * NWAVES;
    unsigned char* ws = a.ws;
    bf16_t* WinT = (bf16_t*)(ws + WS_WIN); bf16_t* WupT = (bf16_t*)(ws + WS_WUP); bf16_t* WoT = (bf16_t*)(ws + WS_WO); bf16_t* WpgT = (bf16_t*)(ws + WS_WPG); bf16_t* WppT = (bf16_t*)(ws + WS_WPP);
    constexpr int I_A = 16 * 96, I_B8 = 16 * 160, I_B = 0, I_S = 16 * 32, I_P = 4 * 32;
    constexpr int NITEMS = I_A + I_B8 + I_B + 4 * I_S + I_P;
#ifndef P0_PARTS
#define P0_PARTS 63
#endif
    if (P0_PARTS & 1)
    for (int it = gw; it < NITEMS; it += NGW) {
        int r = it;
        if (r < I_A) { transpose_mat_item(a.in[4], D_IN, 3072, 0, WinT, D, 0, 0, scr, r, lane); continue; } r -= I_A;
        if (r < I_B8) { const int kb = r / 160, nb = r % 160; transpose_item_f8(a.in[4], D_IN, 64 * kb, 3088 + 32 * nb, ws + WS_WIN8, D, 32 * nb, 32.0f, scr, lane); continue; } r -= I_B8;
        if (r < I_S) { transpose_mat_item(a.in[8], D, D, 0, WupT, 2048, 0, 0, scr, r, lane); continue; } r -= I_S;
        if (r < I_S) { transpose_mat_item(a.in[9], D, D, 0, WupT, 2048, 0, 1024, scr, r, lane); continue; } r -= I_S;
        if (r < I_S) { transpose_mat_item(a.in[10], D, D, 0, WoT, D, 0, 0, scr, r, lane); continue; } r -= I_S;
        if (r < I_S) { const int kb = r / 32, nb = r % 32; transpose_item_f8(a.in[21], D, 64 * kb, 32 * nb, (unsigned char*)WpgT, D, 32 * nb, 32.0f, scr, lane); continue; } r -= I_S;
        transpose_mat_item(a.in[22], D, D, 0, WppT, 256, 0, 0, scr, r, lane);
    }
    if (P0_PARTS & 2) {
        const float* x = a.in[0]; const float* g = a.in[3]; bf16_t* H = (bf16_t*)(ws + WS_H);
        f32x4 gv[4];
#pragma unroll
        for (int j = 0; j < 4; ++j) gv[j] = *((const f32x4*)g + lane + 64 * j);
        f32x4 va[4], vb[4];
#define H_LOAD(m_, V) do { if ((m_) < T) { const f32x4* xr = (const f32x4*)(x + (size_t)(m_) * D) + lane; _Pragma("unroll") for (int j = 0; j < 4; ++j) V[j] = __builtin_nontemporal_load(xr + 64 * j); } } while (0)
#define H_DO(m_, V) do { if ((m_) < T) { float s_ = 0.f; \
            _Pragma("unroll") for (int j = 0; j < 4; ++j) s_ += (V[j].x * V[j].x + V[j].y * V[j].y) + (V[j].z * V[j].z + V[j].w * V[j].w); \
            const float rstd = 1.0f / sqrtf(wave_sum(s_) * (1.0f / D) + EPS); \
            u32x2* o8 = (u32x2*)(H + (size_t)(m_) * D) + lane; unsigned* q8 = (unsigned*)(ws + WS_H8 + (size_t)(m_) * D) + lane; \
            _Pragma("unroll") for (int j = 0; j < 4; ++j) { const f32x4 y = V[j] * rstd * gv[j]; u32x2 w; w.x = cvt_pk_bf16(y.x, y.y); w.y = cvt_pk_bf16(y.z, y.w); o8[64 * j] = w; q8[64 * j] = pk4_fp8(y.x, y.y, y.z, y.w); } } } while (0)
        H_LOAD(gw, va);
        for (int m = gw; m < T; m += 2 * NGW) { H_LOAD(m + NGW, vb); H_DO(m, va); H_LOAD(m + 2 * NGW, va); H_DO(m + NGW, vb); }
#undef H_LOAD
#undef H_DO
    }
    if (P0_PARTS & 4) {
        const f32x4* p4 = (const f32x4*)a.in[1]; u32x2* pb = (u32x2*)(ws + WS_PB);
        const size_t n4 = (size_t)T * 256 / 4;
        for (size_t i = (size_t)gw * 64 + lane; i < n4; i += (size_t)NGW * 64) { const f32x4 v = __builtin_nontemporal_load(p4 + i); u32x2 w; w.x = cvt_pk_bf16(v.x, v.y); w.y = cvt_pk_bf16(v.z, v.w); pb[i] = w; }
    }
    if (P0_PARTS & 8) {
        const int gt = (vcu * NWAVES + wave) * 64 + lane;
        if ((P0_PARTS & 16) && gt < 16 * 1024) { const int n = gt >> 10, k = gt & 1023; ((bf16_t*)(ws + WS_WALT))[n * 1024 + k] = (bf16_t)(cvt_pk_bf16(a.in[4][(size_t)k * D_IN + SRC_ALOW + n], 0.f) & 0xffffu); }
        if ((P0_PARTS & 32) && gt < 4096) { const int s = gt >> 6, l = gt & 63, e = l & 31, hh = l >> 5; const float* wr = a.in[12];
            float v[8], lo[8];
#pragma unroll
            for (int j = 0; j < 8; ++j) { v[j] = wr[(size_t)(16 * s + 8 * hh + j) * NE + e]; }
            u32x4 whi; whi.x = cvt_pk_bf16(v[0], v[1]); whi.y = cvt_pk_bf16(v[2], v[3]); whi.z = cvt_pk_bf16(v[4], v[5]); whi.w = cvt_pk_bf16(v[6], v[7]);
#pragma unroll
            for (int j = 0; j < 4; ++j) { lo[2 * j] = v[2 * j] - bflo(whi[j]); lo[2 * j + 1] = v[2 * j + 1] - bfhi(whi[j]); }
            u32x4 wlo; wlo.x = cvt_pk_bf16(lo[0], lo[1]); wlo.y = cvt_pk_bf16(lo[2], lo[3]); wlo.z = cvt_pk_bf16(lo[4], lo[5]); wlo.w = cvt_pk_bf16(lo[6], lo[7]);
            u32x4* f = (u32x4*)(ws + WS_WRF); f[gt] = whi; f[4096 + gt] = wlo; }
    }
}

struct CvtItem { const float* src; unsigned char* dst; int ldo; };
__device__ __forceinline__ CvtItem cvt_item(const P& a, int it, int lane) {
    constexpr int IPM = 16 * 32;
    const int e = it / (3 * IPM), r0 = it % (3 * IPM), which = r0 / IPM, r = r0 % IPM, kb = r / 32, nb = r % 32, n0 = 32 * nb;
    CvtItem c;
    if (which < 2) { c.src = a.in[which == 0 ? 14 : 16] + (size_t)e * D * FF + (size_t)(64 * kb + (lane >> 5)) * FF + n0 + (lane & 31);
        c.dst = (unsigned char*)a.out + ((size_t)e * 2048 + (n0 >> 7) * 256 + (n0 & 127) + which * 128) * D + 64 * kb; c.ldo = D; }
    else { c.src = a.in[18] + (size_t)e * FF * D + (size_t)(64 * kb + (lane >> 5)) * D + n0 + (lane & 31);
        c.dst = a.ws + WS_W2T + ((size_t)e * D + n0) * FF + 64 * kb; c.ldo = FF; }
    return c;
}
__device__ __forceinline__ void expert_convert(const P& a, LAS unsigned char* lds, int vcu, int G, int wave, int lane) {
    LAS float* scr = (LAS float*)(lds + wave * 16384);
    const int gw = vcu * NWAVES + wave, NGW = G * NWAVES;
    constexpr int NIT = NE * 3 * 16 * 32;
    if (gw >= NIT) return;
    float tA[32], tB[32];
    CvtItem cA = cvt_item(a, gw, lane), cB = cvt_item(a, gw + NGW < NIT ? gw + NGW : gw, lane);
#pragma unroll
    for (int i = 0; i < 32; ++i) tA[i] = __builtin_nontemporal_load(cA.src + (size_t)(2 * i) * 1024);
#pragma unroll
    for (int i = 0; i < 32; ++i) tB[i] = __builtin_nontemporal_load(cB.src + (size_t)(2 * i) * 1024);
#define CVT_OUT(c_) do { LDS_WAIT(); asm volatile("" ::: "memory"); const int c = lane & 7; \
        _Pragma("unroll") for (int j = 0; j < 4; ++j) { const int n = (lane >> 3) + 8 * j; const LAS float* s = scr + (8 * c) * 33 + n; \
            u32x2 o; o.x = pk4_fp8(s[0 * 33] * 32.0f, s[1 * 33] * 32.0f, s[2 * 33] * 32.0f, s[3 * 33] * 32.0f); o.y = pk4_fp8(s[4 * 33] * 32.0f, s[5 * 33] * 32.0f, s[6 * 33] * 32.0f, s[7 * 33] * 32.0f); \
            __builtin_nontemporal_store(o, (u32x2*)((c_).dst + (size_t)n * (c_).ldo + 8 * c)); } \
        LDS_WAIT(); asm volatile("" ::: "memory"); } while (0)
    for (int it = gw; it < NIT; it += 2 * NGW) {
#pragma unroll
        for (int i = 0; i < 32; ++i) scr[(2 * i + (lane >> 5)) * 33 + (lane & 31)] = tA[i];
        const CvtItem dA = cA; const int n2 = it + 2 * NGW;
        if (n2 < NIT) { cA = cvt_item(a, n2, lane);
#pragma unroll
            for (int i = 0; i < 32; ++i) tA[i] = __builtin_nontemporal_load(cA.src + (size_t)(2 * i) * 1024); }
        CVT_OUT(dA);
        if (it + NGW >= NIT) break;
#pragma unroll
        for (int i = 0; i < 32; ++i) scr[(2 * i + (lane >> 5)) * 33 + (lane & 31)] = tB[i];
        const CvtItem dB = cB; const int n3 = it + 3 * NGW;
        if (n3 < NIT) { cB = cvt_item(a, n3, lane);
#pragma unroll
            for (int i = 0; i < 32; ++i) tB[i] = __builtin_nontemporal_load(cB.src + (size_t)(2 * i) * 1024); }
        CVT_OUT(dB);
    }
#undef CVT_OUT
}

__device__ __forceinline__ float fexp_(float x) { return __builtin_amdgcn_exp2f(x * 1.4426950408889634f); }
__device__ __forceinline__ float logsigmoidf_(float x) { const float e = fexp_(-fabsf(x)); return fminf(x, 0.0f) - 0.6931471805599453f * __builtin_amdgcn_logf(1.0f + e); }
__device__ __forceinline__ void gla_prep_unit(const P& a, LAS unsigned char* lds, int unit) {
    int tid = threadIdx.x; asm volatile("" : "+v"(tid));     const int wave = __builtin_amdgcn_readfirstlane(tid >> 6), lane = tid & 63;
    const int b = unit >> 5, chunk = unit & 31, tok0 = b * SEQ + chunk * 64;
    const bf16_t* H = (const bf16_t*)(a.ws + WS_H); const bf16_t* WalT = (const bf16_t*)(a.ws + WS_WALT); const bf16_t* proj = (const bf16_t*)(a.ws + WS_PROJ);
    LAS float* part = (LAS float*)lds;
    LAS float* alow = (LAS float*)(lds + 8192);
    LAS float* seg = (LAS float*)(lds + 12288);
    constexpr int GP_KDT = 16384, GP_VT = 34816;
    {
        const int rg = wave & 3, kh = wave >> 2, r = lane & 15, q = lane >> 4;
        f32x4 acc = (f32x4){0.f, 0.f, 0.f, 0.f};
        const bf16_t* ap = H + (size_t)(tok0 + 16 * rg + r) * D + 512 * kh + 8 * q; const bf16_t* bp = WalT + (size_t)r * D + 512 * kh + 8 * q;
#pragma unroll 8
        for (int s = 0; s < 16; ++s) { const bf16x8 av = *(const bf16x8*)(ap + 32 * s), bv = *(const bf16x8*)(bp + 32 * s); acc = __builtin_amdgcn_mfma_f32_16x16x32_bf16(bv, av, acc, 0, 0, 0); }
        *(LAS f32x4*)(part + (kh * 64 + 16 * rg + r) * 16 + 4 * q) = acc;
    }
    __syncthreads();
    if (tid < 256) { *(LAS f32x4*)(alow + tid * 4) = *(LAS f32x4*)(part + tid * 4) + *(LAS f32x4*)(part + 1024 + tid * 4); }
    __syncthreads();
    const int dp = tid & 63, tq = wave;
    const float* w_a2 = a.in[5]; const float* b_a2 = a.in[6];
    const int ep = tid & 127, sq4 = tid >> 7;
    f32x2 w2[16], w2n[16]; f32x2 b2, b2n; unsigned qv[8], kv[8], qvn[8], kvn[8], sv[16], svn[16];
#define GP_LOADS(h_, W2, B2, QV, KV, SV) do { const int dc_ = (h_) * 128 + 2 * dp; \
        _Pragma("unroll") for (int r = 0; r < 16; ++r) W2[r] = *(const f32x2*)(w_a2 + r * 512 + dc_); \
        B2 = *(const f32x2*)(b_a2 + dc_); \
        _Pragma("unroll") for (int i = 0; i < 8; ++i) { const bf16_t* rp = proj + PROJ_BLK((h_) * 128) + (size_t)(tok0 + 8 * tq + i) * 128 + 2 * dp; QV[i] = __builtin_nontemporal_load((const unsigned*)(rp + PROJ_BLK(C_QA))); KV[i] = __builtin_nontemporal_load((const unsigned*)(rp + PROJ_BLK(C_KA))); } \
        const bf16_t* v_ = proj + PROJ_BLK(C_VA + (h_) * 256) + (size_t)(tok0 + 16 * sq4) * 256 + 2 * ep; \
        _Pragma("unroll") for (int i = 0; i < 16; ++i) SV[i] = __builtin_nontemporal_load((const unsigned*)(v_ + (size_t)i * 256)); } while (0)
    GP_LOADS(0, w2, b2, qv, kv, sv);
    for (int h = 0; h < 4; ++h) {
        if (h + 1 < 4) GP_LOADS(h + 1, w2n, b2n, qvn, kvn, svn);
        float G0[8], G1[8]; float r0 = 0.f, r1 = 0.f;
#pragma unroll
        for (int i = 0; i < 8; ++i) { const LAS f32x4* al4 = (const LAS f32x4*)(alow + (8 * tq + i) * 16); float x0 = b2.x, x1 = b2.y;
#pragma unroll
            for (int r4 = 0; r4 < 4; ++r4) { const f32x4 al = al4[r4];
#pragma unroll
                for (int j = 0; j < 4; ++j) { x0 += al[j] * w2[4 * r4 + j].x; x1 += al[j] * w2[4 * r4 + j].y; } }
            r0 += logsigmoidf_(x0) * (1.0f / 16.0f); r1 += logsigmoidf_(x1) * (1.0f / 16.0f); G0[i] = r0; G1[i] = r1; }
        *(LAS f32x2*)(seg + tq * 128 + 2 * dp) = (f32x2){r0, r1};
        __syncthreads();
        float off0 = 0.f, off1 = 0.f, tot0 = 0.f, tot1 = 0.f;
#pragma unroll
        for (int q = 0; q < 8; ++q) { const f32x2 s = *(LAS f32x2*)(seg + q * 128 + 2 * dp); tot0 += s.x; tot1 += s.y; if (q < tq) { off0 += s.x; off1 += s.y; } }
        const size_t tile = (size_t)((b * 4 + h) * 32 + chunk);
        bf16_t* Qg = (bf16_t*)(a.ws + WS_QG) + tile * 8192; bf16_t* Kg = (bf16_t*)(a.ws + WS_KG) + tile * 8192;
        float kd0[8], kd1[8];
#pragma unroll
        for (int i = 0; i < 8; ++i) { const float g0 = G0[i] + off0, g1 = G1[i] + off1; const float q0 = bflo(qv[i]), q1 = bfhi(qv[i]), k0 = bflo(kv[i]), k1 = bfhi(kv[i]);
            const float e0 = fexp_(g0), e1 = fexp_(g1);
            *(unsigned*)(Qg + (8 * tq + i) * 128 + 2 * dp) = cvt_pk_bf16(q0 * e0 * 0.08838834764831845f, q1 * e1 * 0.08838834764831845f);
            *(unsigned*)(Kg + (8 * tq + i) * 128 + 2 * dp) = cvt_pk_bf16(k0 * __builtin_amdgcn_rcpf(e0), k1 * __builtin_amdgcn_rcpf(e1));
            kd0[i] = k0 * fexp_(tot0 - g0); kd1[i] = k1 * fexp_(tot1 - g1); }
        u32x4 w0, w1; w0.x = cvt_pk_bf16(kd0[0], kd0[1]); w0.y = cvt_pk_bf16(kd0[2], kd0[3]); w0.z = cvt_pk_bf16(kd0[4], kd0[5]); w0.w = cvt_pk_bf16(kd0[6], kd0[7]);
        w1.x = cvt_pk_bf16(kd1[0], kd1[1]); w1.y = cvt_pk_bf16(kd1[2], kd1[3]); w1.z = cvt_pk_bf16(kd1[4], kd1[5]); w1.w = cvt_pk_bf16(kd1[6], kd1[7]);
        *(LAS u32x4*)(lds + GP_KDT + (2 * dp) * 144 + 16 * tq) = w0; *(LAS u32x4*)(lds + GP_KDT + (2 * dp + 1) * 144 + 16 * tq) = w1;
        if (tq == 0) *(f32x2*)((float*)(a.ws + WS_DEC) + tile * 128 + 2 * dp) = (f32x2){fexp_(tot0), fexp_(tot1)};
        {
            u32x4 lo0, lo1, hi0, hi1;
#pragma unroll
            for (int j = 0; j < 4; ++j) { lo0[j] = (sv[2 * j] & 0xffffu) | (sv[2 * j + 1] << 16); lo1[j] = (sv[8 + 2 * j] & 0xffffu) | (sv[8 + 2 * j + 1] << 16);
                hi0[j] = (sv[2 * j] >> 16) | (sv[2 * j + 1] & 0xffff0000u); hi1[j] = (sv[8 + 2 * j] >> 16) | (sv[8 + 2 * j + 1] & 0xffff0000u); }
            LAS unsigned char* v0 = lds + GP_VT + (2 * ep) * 144 + sq4 * 32;
            *(LAS u32x4*)(v0) = lo0; *(LAS u32x4*)(v0 + 16) = lo1; *(LAS u32x4*)(v0 + 144) = hi0; *(LAS u32x4*)(v0 + 144 + 16) = hi1;
        }
        __syncthreads();
        {
            const int c32 = lane & 31, hi = lane >> 5;
            bf16x8 vt[4];
#pragma unroll
            for (int ks = 0; ks < 4; ++ks) vt[ks] = *(const LAS bf16x8*)(lds + GP_VT + (32 * wave + c32) * 144 + (16 * ks + 8 * hi) * 2);
            unsigned* sl = (unsigned*)a.out + tile * 8192;
#pragma unroll
            for (int tl = 0; tl < 4; ++tl) { f32x16 acc;
#pragma unroll
                for (int r = 0; r < 16; ++r) acc[r] = 0.f;
#pragma unroll
                for (int ks = 0; ks < 4; ++ks) { const bf16x8 av = *(const LAS bf16x8*)(lds + GP_KDT + (32 * tl + c32) * 144 + (16 * ks + 8 * hi) * 2); acc = __builtin_amdgcn_mfma_f32_32x32x16_bf16(av, vt[ks], acc, 0, 0, 0); }
#pragma unroll
                for (int g = 0; g < 4; ++g) sl[((tl * 4 + g) * 2 + hi) * 256 + 32 * wave + c32] = pk4_fp8(acc[4 * g], acc[4 * g + 1], acc[4 * g + 2], acc[4 * g + 3]); }
        }
        __syncthreads();
#pragma unroll
        for (int r = 0; r < 16; ++r) { w2[r] = w2n[r]; sv[r] = svn[r]; }
#pragma unroll
        for (int i = 0; i < 8; ++i) { qv[i] = qvn[i]; kv[i] = kvn[i]; }
        b2 = b2n;
    }
#undef GP_LOADS
}

__device__ __forceinline__ void gla_combine_unit(const P& a, int unit) {
    const int tid = threadIdx.x, bh = unit >> 4, i8 = (unit & 15) * 512 + tid;
    const int d0 = 32 * (i8 >> 11) + 8 * ((i8 >> 9) & 3) + 4 * ((i8 >> 8) & 1);
    const unsigned* sl8 = (const unsigned*)a.out + (size_t)bh * 32 * 8192 + i8; u32x2* sl = (u32x2*)(a.ws + WS_SLOC) + (size_t)bh * 32 * 8192 + i8;
    const f32x4* dc = (const f32x4*)((const float*)(a.ws + WS_DEC) + (size_t)bh * 32 * 128 + d0);
    f32x4 s = (f32x4){0.f, 0.f, 0.f, 0.f};
    for (int cb = 0; cb < 32; cb += 8) {
        unsigned loc[8]; f32x4 dv[8];
#pragma unroll
        for (int i = 0; i < 8; ++i) { loc[i] = __builtin_nontemporal_load(sl8 + (size_t)(cb + i) * 8192); dv[i] = dc[(cb + i) * 32]; }
#pragma unroll
        for (int i = 0; i < 8; ++i) { if (cb + i < 31) {
            s.x = dv[i].x * s.x + __builtin_amdgcn_cvt_f32_fp8((int)loc[i], 0); s.y = dv[i].y * s.y + __builtin_amdgcn_cvt_f32_fp8((int)loc[i], 1);
            s.z = dv[i].z * s.z + __builtin_amdgcn_cvt_f32_fp8((int)loc[i], 2); s.w = dv[i].w * s.w + __builtin_amdgcn_cvt_f32_fp8((int)loc[i], 3);
            u32x2 w; w.x = cvt_pk_bf16(s.x, s.y); w.y = cvt_pk_bf16(s.z, s.w); sl[(size_t)(cb + i) * 8192] = w; } }
    }
}

constexpr int GL_QG = 0, GL_KG = 17408, GL_VT = 53248, GL_AM = 90112, GL_OST = 0;
constexpr int GL_QS = 272, GL_TS = 144, GL_OS = 528;
__device__ __forceinline__ int crow(int r, int hi) { return (r & 3) + 8 * (r >> 2) + 4 * hi; }
__device__ __forceinline__ void gla_out_unit(const P& a, LAS unsigned char* lds, int unit) {
    int tid = threadIdx.x; asm volatile("" : "+v"(tid)); const int w = __builtin_amdgcn_readfirstlane(tid >> 6), lane = tid & 63, c32 = lane & 31, hi = lane >> 5;
    const int bh = unit >> 5, chunk = unit & 31, b = bh >> 2, h = bh & 3;
    const bf16_t* proj = (const bf16_t*)(a.ws + WS_PROJ); bf16_t* oab = (bf16_t*)(a.ws + WS_OAB); const float* ggo = a.in[7];
    const size_t tile = (size_t)bh * 32 + chunk;
    {
        const u32x4* q_ = (const u32x4*)((const bf16_t*)(a.ws + WS_QG) + tile * 8192); const u32x4* k_ = (const u32x4*)((const bf16_t*)(a.ws + WS_KG) + tile * 8192);
        u32x4 sq[2], sk[2]; unsigned sv[16];
        sq[0] = __builtin_nontemporal_load(q_ + tid); sq[1] = __builtin_nontemporal_load(q_ + tid + 512); sk[0] = __builtin_nontemporal_load(k_ + tid); sk[1] = __builtin_nontemporal_load(k_ + tid + 512);
        const int ep = tid & 127, sq4 = tid >> 7;
        const bf16_t* v_ = proj + PROJ_BLK(C_VA + h * 256) + (size_t)(b * SEQ + chunk * 64 + 16 * sq4) * 256 + 2 * ep;
#pragma unroll
        for (int i = 0; i < 16; ++i) sv[i] = __builtin_nontemporal_load((const unsigned*)(v_ + (size_t)i * 256));
#pragma unroll
        for (int i = 0; i < 2; ++i) { const int p = tid + 512 * i;
            *(LAS u32x4*)(lds + GL_QG + (p >> 4) * GL_QS + (p & 15) * 16) = sq[i]; *(LAS u32x4*)(lds + GL_KG + (p >> 4) * GL_QS + (p & 15) * 16) = sk[i]; }
        u32x4 lo0, lo1, hi0, hi1;
#pragma unroll
        for (int j = 0; j < 4; ++j) { lo0[j] = (sv[2 * j] & 0xffffu) | (sv[2 * j + 1] << 16); lo1[j] = (sv[8 + 2 * j] & 0xffffu) | (sv[8 + 2 * j + 1] << 16);
            hi0[j] = (sv[2 * j] >> 16) | (sv[2 * j + 1] & 0xffff0000u); hi1[j] = (sv[8 + 2 * j] >> 16) | (sv[8 + 2 * j + 1] & 0xffff0000u); }
        LAS unsigned char* v0 = lds + GL_VT + (2 * ep) * GL_TS + sq4 * 32;
        *(LAS u32x4*)(v0) = lo0; *(LAS u32x4*)(v0 + 16) = lo1; *(LAS u32x4*)(v0 + GL_TS) = hi0; *(LAS u32x4*)(v0 + GL_TS + 16) = hi1;
    }
    u32x2 sf[4][2][2];
    if (chunk > 0) { const u32x2* sl = (const u32x2*)(a.ws + WS_SLOC) + (tile - 1) * 8192;
#pragma unroll
        for (int tl = 0; tl < 4; ++tl)
#pragma unroll
            for (int s = 0; s < 2; ++s)
#pragma unroll
                for (int q = 0; q < 2; ++q) sf[tl][s][q] = __builtin_nontemporal_load(sl + ((tl * 4 + 2 * s + q) * 2 + hi) * 256 + 32 * w + c32); }
    __syncthreads();
    if (w < 3) {
        const int ti = (w + 1) >> 1, si = w >> 1;
        f32x16 A;
#pragma unroll
        for (int r = 0; r < 16; ++r) A[r] = 0.f;
#pragma unroll
        for (int s = 0; s < 8; ++s) { const bf16x8 av = *(const LAS bf16x8*)(lds + GL_QG + (32 * ti + c32) * GL_QS + (16 * s + 8 * hi) * 2), bv = *(const LAS bf16x8*)(lds + GL_KG + (32 * si + c32) * GL_QS + (16 * s + 8 * hi) * 2);
            A = __builtin_amdgcn_mfma_f32_32x32x16_bf16(av, bv, A, 0, 0, 0); }
        const int sidx = 32 * si + c32;
#pragma unroll
        for (int r = 0; r < 16; ++r) { const int t = 32 * ti + crow(r, hi); const float v = (sidx <= t) ? A[r] : 0.f;
            *(LAS bf16_t*)(lds + GL_AM + t * GL_TS + sidx * 2) = (bf16_t)(cvt_pk_bf16(v, 0.f) & 0xffffu); }
    }
    __syncthreads();
    f32x16 o[2];
    {
        bf16x8 vt[4];
#pragma unroll
        for (int ks = 0; ks < 4; ++ks) vt[ks] = *(const LAS bf16x8*)(lds + GL_VT + (32 * w + c32) * GL_TS + (16 * ks + 8 * hi) * 2);
#pragma unroll
        for (int ti = 0; ti < 2; ++ti) {
#pragma unroll
            for (int r = 0; r < 16; ++r) o[ti][r] = 0.f;
            if (chunk > 0) {
#pragma unroll
                for (int tl = 0; tl < 4; ++tl)
#pragma unroll
                    for (int s = 0; s < 2; ++s) { const LAS unsigned char* qp = lds + GL_QG + (32 * ti + c32) * GL_QS + (32 * tl + 16 * s + 4 * hi) * 2;
                        const s16x4 lo = *(const LAS s16x4*)qp, hh = *(const LAS s16x4*)(qp + 16);
                        const bf16x8 aop = __builtin_shufflevector(lo, hh, 0, 1, 2, 3, 4, 5, 6, 7);
                        const u32x4 bw = {sf[tl][s][0].x, sf[tl][s][0].y, sf[tl][s][1].x, sf[tl][s][1].y};
                        o[ti] = __builtin_amdgcn_mfma_f32_32x32x16_bf16(aop, __builtin_bit_cast(bf16x8, bw), o[ti], 0, 0, 0); }
            }
#pragma unroll
            for (int ks = 0; ks < 4; ++ks) { if (ti == 0 && ks >= 2) continue;
                const bf16x8 av = *(const LAS bf16x8*)(lds + GL_AM + (32 * ti + c32) * GL_TS + (16 * ks + 8 * hi) * 2);
                o[ti] = __builtin_amdgcn_mfma_f32_32x32x16_bf16(av, vt[ks], o[ti], 0, 0, 0); }
        }
    }
    __syncthreads();
#pragma unroll
    for (int ti = 0; ti < 2; ++ti)
#pragma unroll
        for (int r = 0; r < 16; ++r) *(LAS bf16_t*)(lds + GL_OST + (32 * ti + crow(r, hi)) * GL_OS + (32 * w + c32) * 2) = (bf16_t)(cvt_pk_bf16(o[ti][r], 0.f) & 0xffffu);
    __syncthreads();
    {
        const int t = tid >> 3, sg = tid & 7; const size_t tok = (size_t)(b * SEQ + chunk * 64 + t);
        u32x4 ov[4]; float ss = 0.f;
#pragma unroll
        for (int j = 0; j < 4; ++j) { ov[j] = *(const LAS u32x4*)(lds + GL_OST + t * GL_OS + sg * 64 + j * 16);
#pragma unroll
            for (int i = 0; i < 4; ++i) { const float x0 = bflo(ov[j][i]), x1 = bfhi(ov[j][i]); ss += x0 * x0 + x1 * x1; } }
        ss += __shfl_xor(ss, 1); ss += __shfl_xor(ss, 2); ss += __shfl_xor(ss, 4);
        const float rstd = 1.0f / sqrtf(ss * (1.0f / 256.0f) + EPS);
        const bf16_t* rap = proj + PROJ_BLK(C_RA + h * 256) + tok * 256 + sg * 32; bf16_t* op = oab + tok * 2048 + h * 256 + sg * 32; const float* gp = ggo + sg * 32;
#pragma unroll
        for (int j = 0; j < 4; ++j) { const u32x4 ra = __builtin_nontemporal_load((const u32x4*)(rap + 8 * j)); const f32x4 g0 = *(const f32x4*)(gp + 8 * j), g1 = *(const f32x4*)(gp + 8 * j + 4); u32x4 wv;
#pragma unroll
            for (int i = 0; i < 4; ++i) { const float r0 = bflo(ra[i]), r1 = bfhi(ra[i]); const float ga = (i < 2) ? g0[2 * i] : g1[2 * i - 4], gb = (i < 2) ? g0[2 * i + 1] : g1[2 * i - 3];
                wv[i] = cvt_pk_bf16(bflo(ov[j][i]) * rstd * ga * (r0 * fsigmoid(r0)), bfhi(ov[j][i]) * rstd * gb * (r1 * fsigmoid(r1))); }
            *(u32x4*)(op + 8 * j) = wv; }
    }
    __syncthreads();
}
namespace moba {
constexpr int HD = 128;
constexpr float SCALE = 0.08838834764831845f;
constexpr float THR = 8.f;
constexpr int NW = 8, QBLK = 32, KVBLK = 64, QB = NW * QBLK;
constexpr int SHM_V = KVBLK * HD * 2, SHM_K = KVBLK * HD * 2;
constexpr int OFF_WS = 2 * SHM_V + 2 * SHM_K;
constexpr int OFF_RTAB = OFF_WS + NW * 64 * 4;
constexpr int OFF_KM = OFF_RTAB + 2400 * 4;
constexpr int OFF_MISC = OFF_KM + 8 * 128 * 4;
constexpr int OFF_SEL = OFF_MISC + 64;
constexpr int LDS_BYTES = OFF_SEL + 2048;
constexpr int LDP = HD, LDO = 2048;

#define KSWZ(row, colB) ((row) * 256 + ((colB) ^ (((row) & 7) << 4)))
#define SBAR() __builtin_amdgcn_sched_barrier(0)
__device__ __forceinline__ int v_st(int k, int c) { const int kk = (k & ~0xC) | ((k & 4) << 1) | ((k & 8) >> 1); return ((kk >> 3) * 4 + (c >> 5)) * 512 + ((kk & 7) * 32 + (c & 31)) * 2; }
__device__ __forceinline__ int v_rd_base(int lane) { return ((lane & 3) << 3) | (((lane >> 2) & 3) << 6) | (((lane >> 4) & 1) << 5) | (((lane >> 5) & 1) << 8); }
constexpr int v_rd_off(int d0, int ks, int half) { return d0 * 512 + ks * 4096 + half * 2048; }
__device__ __forceinline__ int crow(int r, int hi) { return (r & 3) + 8 * (r >> 2) + 4 * hi; }
__device__ __forceinline__ unsigned cvtpk(float lo, float hi) { unsigned r; asm volatile("v_cvt_pk_bf16_f32 %0, %1, %2" : "=v"(r) : "v"(lo), "v"(hi)); return r; }

__device__ __forceinline__ void mask_tile(f32x16& p0, f32x16& p1, int dq) {
    const float NEG = -__builtin_inff();
#pragma unroll
    for (int r = 0; r < 16; ++r) {
        const int c = (r & 3) + 8 * (r >> 2);
        if (dq - c < 0) p0[r] = NEG;
        if (dq - c - 32 < 0) p1[r] = NEG;
    }
}
__device__ __forceinline__ void bias_tile(f32x16& p0, f32x16& p1, const LAS float* rt) {
#pragma unroll
    for (int r = 0; r < 16; ++r) { const int c = (r & 3) + 8 * (r >> 2); p0[r] += rt[c]; p1[r] += rt[c + 32]; }
}
__device__ __forceinline__ void kill_tile(f32x16& p0, f32x16& p1) {
    const float NEG = -__builtin_inff();
#pragma unroll
    for (int r = 0; r < 16; ++r) { p0[r] = NEG; p1[r] = NEG; }
}
__device__ __forceinline__ void partialSM(f32x16& p0, f32x16& p1, float& m_reg, float& mn, float& alpha) {
    float pmax = p0[0];
#pragma unroll
    for (int r = 1; r < 16; ++r) pmax = fmaxf(pmax, p0[r]);
#pragma unroll
    for (int r = 0; r < 16; ++r) pmax = fmaxf(pmax, p1[r]);
    { auto rr = __builtin_amdgcn_permlane32_swap(__float_as_uint(pmax), __float_as_uint(pmax), false, false);
      pmax = fmaxf(__uint_as_float(rr[0]), __uint_as_float(rr[1])); }
    constexpr float C2 = 1.4426950408889634f * SCALE;
    if (__builtin_expect(__all((pmax - m_reg) * SCALE <= THR), 1)) { mn = m_reg; alpha = 1.f; }
    else { mn = fmaxf(m_reg, pmax); alpha = __builtin_amdgcn_exp2f((m_reg - mn) * C2); m_reg = mn; }
    const float mnL = -mn * C2;
#pragma unroll
    for (int r = 0; r < 16; ++r) p0[r] = fmaf(p0[r], C2, mnL);
#pragma unroll
    for (int r = 0; r < 16; ++r) p1[r] = fmaf(p1[r], C2, mnL);
#pragma unroll
    for (int r = 0; r < 16; ++r) p0[r] = __builtin_amdgcn_exp2f(p0[r]);
}
__device__ __forceinline__ void finishSM(f32x16& p0, f32x16& p1, float alpha, float& l_reg, bf16x8& pa0, bf16x8& pa1, bf16x8& pa2, bf16x8& pa3) {
#pragma unroll
    for (int r = 0; r < 16; ++r) p1[r] = __builtin_amdgcn_exp2f(p1[r]);
    float ps = 0;
#pragma unroll
    for (int r = 0; r < 16; ++r) ps += p0[r];
#pragma unroll
    for (int r = 0; r < 16; ++r) ps += p1[r];
    { auto rr = __builtin_amdgcn_permlane32_swap(__float_as_uint(ps), __float_as_uint(ps), false, false);
      ps = __uint_as_float(rr[0]) + __uint_as_float(rr[1]); }
    l_reg = l_reg * alpha + ps;
#define PK4(P, B_, OUT) do { unsigned a0 = cvtpk(P[B_+0], P[B_+1]), a1 = cvtpk(P[B_+2], P[B_+3]);                          \
        unsigned b0 = cvtpk(P[B_+4], P[B_+5]), b1 = cvtpk(P[B_+6], P[B_+7]);                                             \
        auto r0 = __builtin_amdgcn_permlane32_swap(a0, b0, false, false); auto r1 = __builtin_amdgcn_permlane32_swap(a1, b1, false, false); \
        u32x4 w = {r0[0], r1[0], r0[1], r1[1]}; OUT = __builtin_bit_cast(bf16x8, w); } while (0)
    PK4(p0, 0, pa0); PK4(p0, 8, pa1); PK4(p1, 0, pa2); PK4(p1, 8, pa3);
#undef PK4
}
template <int KB>
__device__ __forceinline__ void qkt(f32x16& p0, f32x16& p1, const char* K_lds, int r32, int hi, const bf16x8* qr) {
#pragma unroll
    for (int r = 0; r < 16; ++r) { p0[r] = 0.f; p1[r] = 0.f; }
    const char* kb[4];
#pragma unroll
    for (int dd = 0; dd < 4; ++dd) kb[dd] = K_lds + KB * SHM_K + KSWZ(r32, (dd * 16 + hi * 8) * 2);
#pragma unroll
    for (int d0 = 0; d0 < 8; ++d0) { const char* a = kb[d0 & 3] + (d0 >> 2) * 128;
        bf16x8 b0 = *reinterpret_cast<const bf16x8*>(a);
        bf16x8 b1 = *reinterpret_cast<const bf16x8*>(a + 32 * 256);
        p0 = __builtin_amdgcn_mfma_f32_32x32x16_bf16(b0, qr[d0], p0, 0, 0, 0);
        p1 = __builtin_amdgcn_mfma_f32_32x32x16_bf16(b1, qr[d0], p1, 0, 0, 0); }
}
template <int VB>
__device__ __forceinline__ void pv_tile(f32x16* o, int vb0, bf16x8 pa0, bf16x8 pa1, bf16x8 pa2, bf16x8 pa3) {
#define TRRD(dst, off) asm volatile("ds_read_b64_tr_b16 %0, %1 offset:%2" : "=&v"(dst) : "v"(vb0), "i"(off) : "memory")
#define PV_D0(d0) do { s16x4 l0, l1, l2, l3, h0, h1, h2, h3; constexpr int b_ = VB * SHM_V + v_rd_off(d0, 0, 0);   \
        TRRD(l0, b_); TRRD(h0, b_ + 2048); TRRD(l1, b_ + 4096); TRRD(h1, b_ + 6144); TRRD(l2, b_ + 8192); TRRD(h2, b_ + 10240); TRRD(l3, b_ + 12288); TRRD(h3, b_ + 14336); \
        asm volatile("s_waitcnt lgkmcnt(0)" ::: "memory"); SBAR();   \
        o[d0] = __builtin_amdgcn_mfma_f32_32x32x16_bf16(pa0, (bf16x8){l0[0], l0[1], l0[2], l0[3], h0[0], h0[1], h0[2], h0[3]}, o[d0], 0, 0, 0);   \
        o[d0] = __builtin_amdgcn_mfma_f32_32x32x16_bf16(pa1, (bf16x8){l1[0], l1[1], l1[2], l1[3], h1[0], h1[1], h1[2], h1[3]}, o[d0], 0, 0, 0);   \
        o[d0] = __builtin_amdgcn_mfma_f32_32x32x16_bf16(pa2, (bf16x8){l2[0], l2[1], l2[2], l2[3], h2[0], h2[1], h2[2], h2[3]}, o[d0], 0, 0, 0);   \
        o[d0] = __builtin_amdgcn_mfma_f32_32x32x16_bf16(pa3, (bf16x8){l3[0], l3[1], l3[2], l3[3], h3[0], h3[1], h3[2], h3[3]}, o[d0], 0, 0, 0); } while (0)
    PV_D0(0); PV_D0(1); PV_D0(2); PV_D0(3);
#undef PV_D0
#undef TRRD
}

struct BlockRef { const bf16_t* Q; const bf16_t* K; const bf16_t* V; bf16_t* O; int qb; int b, h; };
struct Seam { bf16x8 qr[8]; bf16x8 st_v0, st_v1, st_k0, st_k1; };
#define VMW() asm volatile("s_waitcnt vmcnt(0)" ::: "memory")
#define VMWN(n) asm volatile("s_waitcnt vmcnt(%0)" :: "i"(n) : "memory")
#define LD8(p) (*reinterpret_cast<const bf16x8*>(p))
#define SLOAD_H(Kp, Vp, k0) do { const char* kb__ = (const char*)(Kp) + (size_t)(k0) * (LDP * 2); const char* vb__ = (const char*)(Vp) + (size_t)(k0) * (LDP * 2); \
        S.st_v0 = LD8(vb__ + kvoff); S.st_v1 = LD8(vb__ + 32 * LDP * 2 + kvoff); S.st_k0 = LD8(kb__ + kvoff); S.st_k1 = LD8(kb__ + 32 * LDP * 2 + kvoff); } while (0)
#define SWRITE_HK(bf) do { *(bf16x8*)(K_lds + (bf) * SHM_K + kws) = S.st_k0; *(bf16x8*)(K_lds + (bf) * SHM_K + kws + 32 * 256) = S.st_k1; } while (0)
#define SWRITE_HV(bf) do { *(bf16x8*)(V_lds + (bf) * SHM_V + vst0) = S.st_v0; *(bf16x8*)(V_lds + (bf) * SHM_V + vst1) = S.st_v1; } while (0)
#define SWRITE_H(bf) do { SWRITE_HV(bf); SWRITE_HK(bf); } while (0)

__device__ __forceinline__ void prime(const BlockRef& cur, char* lds, Seam& S) {
    int tid = threadIdx.x; asm volatile("" : "+v"(tid));     const int wid = __builtin_amdgcn_readfirstlane(tid >> 6), lane = tid & 63, r32 = lane & 31, hi = lane >> 5;
    const int sr = tid >> 4, sc = (tid & 15) * 8, kws = KSWZ(sr, sc * 2); char* K_lds = lds + 2 * SHM_V;
    const unsigned kvoff = (unsigned)(sr * LDP + sc) * 2u, qvoff = (unsigned)(r32 * LDP + hi * 8) * 2u;
    { const char* qb__ = (const char*)cur.Q + (size_t)(wid * QBLK) * (LDP * 2);
#pragma unroll
    for (int d0 = 0; d0 < 8; ++d0) S.qr[d0] = LD8(qb__ + qvoff + d0 * 32); }
    SLOAD_H(cur.K, cur.V, 0); VMW(); SWRITE_HK(0);
    __syncthreads();
}
__device__ __forceinline__ int rel_bucket(int n) {
    if (n < 16) return n;
    const float nf = (float)n;
    int large = 16 + (int)(logf(nf / 16.0f) / 5.545177444479562f * 16.0f);
    return large < 31 ? large : 31;
}
__device__ __forceinline__ BlockRef make_ref(const P& a, int item);
__device__ __forceinline__ int block(const P& a, const BlockRef& cur, unsigned* queue, const float* rel_bias, const float* kmp, char* lds, Seam& S) {
    int tid = threadIdx.x; asm volatile("" : "+v"(tid));     const int wid = __builtin_amdgcn_readfirstlane(tid >> 6), lane = tid & 63, r32 = lane & 31, hi = lane >> 5;
    const int qb = cur.qb, NT = 4 * (qb + 1);
    const int qlo = qb * QB + wid * QBLK, qrow = qlo + r32;
    char* V_lds = lds; char* K_lds = lds + 2 * SHM_V;
    float* ws = (float*)(lds + OFF_WS) + wid * 64; float* li_l = ws, * al_l = ws + 32;
    LAS float* rtab = (LAS float*)(LAS char*)(uintptr_t)(unsigned)(uintptr_t)(lds + OFF_RTAB);
    float* kmL = (float*)(lds + OFF_KM);
    volatile int* misc = (volatile int*)(lds + OFF_MISC);
    if (tid == 0) misc[0] = (int)__hip_atomic_fetch_add(queue, 1u, __ATOMIC_RELAXED, __HIP_MEMORY_SCOPE_AGENT);
    for (int i = tid; i < 2400; i += NW * 64) { const int dist = 2047 - i; rtab[i] = dist >= 0 ? rel_bias[rel_bucket(dist) * 8 + cur.h] * (1.0f / SCALE) : -__builtin_inff(); }
    for (int i = tid; i < qb * 128; i += NW * 64) { const int j = i >> 7, dd = i & 127; const size_t o = ((size_t)(cur.b * 8 + j)) * 1024 + cur.h * 128 + dd;
        kmL[i] = (kmp[o] + kmp[o + 64 * 1024]) * (1.0f / 256.0f); }
    __syncthreads();
    const int next_item = __builtin_amdgcn_readfirstlane(misc[0]);
    const BlockRef nxt = next_item < 512 ? make_ref(a, next_item) : cur;
    unsigned selmask = 0;
    {
        float sc7[7];
#pragma unroll
        for (int j = 0; j < 7; ++j) { sc7[j] = -__builtin_inff();
            if (j < qb) { float acc = 0.f;
#pragma unroll
                for (int d0 = 0; d0 < 8; ++d0) { const u32x4 q4 = __builtin_bit_cast(u32x4, S.qr[d0]); const f32x4 k0 = *(const f32x4*)(kmL + j * 128 + d0 * 16 + hi * 8), k1 = *(const f32x4*)(kmL + j * 128 + d0 * 16 + hi * 8 + 4);
                    acc += bflo(q4[0]) * k0[0] + bfhi(q4[0]) * k0[1] + bflo(q4[1]) * k0[2] + bfhi(q4[1]) * k0[3] + bflo(q4[2]) * k1[0] + bfhi(q4[2]) * k1[1] + bflo(q4[3]) * k1[2] + bfhi(q4[3]) * k1[3]; }
                acc += __shfl_xor(acc, 32); sc7[j] = acc; } }
#pragma unroll
        for (int j = 0; j < 7; ++j) { int rank = 0;
#pragma unroll
            for (int i = 0; i < 7; ++i) { if (i != j) rank += (sc7[i] > sc7[j] || (sc7[i] == sc7[j] && i < j)) ? 1 : 0; }
            if (j < qb && (qb <= 3 || rank < 3)) selmask |= 1u << j; }
    }
    LAS unsigned* selp = (LAS unsigned*)(LAS char*)(uintptr_t)(unsigned)(uintptr_t)(lds + OFF_SEL) + tid;
    *selp = selmask;
    float m_reg = -1e30f, l_reg = 0; f32x16 o[4];
#pragma unroll
    for (int d = 0; d < 4; ++d)
#pragma unroll
        for (int r = 0; r < 16; ++r) o[d][r] = 0.f;
    const int sr = tid >> 4, sc = (tid & 15) * 8, vst0 = v_st(sr, sc), vst1 = v_st(32 + sr, sc), kws = KSWZ(sr, sc * 2);
    const unsigned kvoff = (unsigned)(sr * LDP + sc) * 2u;
    const int vb0 = (int)(uintptr_t)V_lds + v_rd_base(lane);
    const bf16_t* Kh = cur.K; const bf16_t* Vh = cur.V;
#define RESC(a) do { if (__any((a) < 1.f)) { if (hi == 0) al_l[r32] = (a); asm volatile("s_waitcnt lgkmcnt(0)" ::: "memory");              \
                     for (int d_ = 0; d_ < 4; ++d_) for (int r = 0; r < 16; ++r) o[d_][r] *= al_l[crow(r, hi)]; } } while (0)
#define KBASE(t) ((t) * KVBLK)
#define MASKT(P0_, P1_, t) do { const int kb_ = KBASE(t); const int jb_ = (t) >> 2; \
        const bool on_ = (jb_ == qb) || ((*selp >> jb_) & 1u); \
        bias_tile(P0_, P1_, on_ ? rtab + (kb_ + 4 * hi - qrow + 2047) : rtab + 2304); } while (0)
    constexpr int NQL = 8;
#define SEAM_K0() do { VMWN(NQL); SWRITE_HK(0); SBAR(); } while (0)
    f32x16 pA0, pA1, pB0, pB1; float mnA, mnB, alA, alB; bf16x8 pa0, pa1, pa2, pa3;
    SWRITE_HV(0); SBAR();
    if (NT > 1) { SLOAD_H(Kh, Vh, KBASE(1)); }
    SBAR(); qkt<0>(pA0, pA1, K_lds, r32, hi, S.qr);
    MASKT(pA0, pA1, 0); partialSM(pA0, pA1, m_reg, mnA, alA);
    if (NT > 1) { VMW(); SWRITE_H(1); }
    __syncthreads();
#define HALF_STEP(PX0, PX1, mnX, alX, PY0, PY1, alY, t, KB, VB, SB) do {                                                      \
        SBAR(); if ((t) + 1 < NT) { SLOAD_H(Kh, Vh, KBASE((t) + 1)); SBAR(); }      \
        qkt<KB>(PX0, PX1, K_lds, r32, hi, S.qr);                                             \
        finishSM(PY0, PY1, alY, l_reg, pa0, pa1, pa2, pa3); SBAR();                                                           \
        pv_tile<VB>(o, vb0, pa0, pa1, pa2, pa3); MASKT(PX0, PX1, (t)); partialSM(PX0, PX1, m_reg, mnX, alX);                                        \
        __syncthreads();                                                                                                      \
        if ((t) + 1 < NT) { VMW(); SWRITE_H(SB); }                                                                          \
        RESC(alX); __syncthreads(); } while (0)
    for (int t = 1; t + 1 < NT; t += 2) {
        HALF_STEP(pB0, pB1, mnB, alB, pA0, pA1, alA, t, 1, 0, 0);
        HALF_STEP(pA0, pA1, mnA, alA, pB0, pB1, alB, t + 1, 0, 1, 1);
    }
    { SBAR(); qkt<1>(pB0, pB1, K_lds, r32, hi, S.qr); SBAR(); }
    SLOAD_H(nxt.K, nxt.V, 0); SBAR();
    { const char* qb__ = (const char*)nxt.Q + (size_t)(wid * QBLK) * (LDP * 2); int l_ = lane; asm volatile("" : "+v"(l_));
      const unsigned qvoff = (unsigned)((l_ & 31) * LDP + (l_ >> 5) * 8) * 2u;
#pragma unroll
    for (int d0 = 0; d0 < 8; ++d0) S.qr[d0] = LD8(qb__ + qvoff + d0 * 32); }
    SBAR();
    finishSM(pA0, pA1, alA, l_reg, pa0, pa1, pa2, pa3); SBAR();
    pv_tile<0>(o, vb0, pa0, pa1, pa2, pa3);
    { MASKT(pB0, pB1, NT - 1); partialSM(pB0, pB1, m_reg, mnB, alB); __syncthreads(); RESC(alB);
      finishSM(pB0, pB1, alB, l_reg, pa0, pa1, pa2, pa3); SBAR(); pv_tile<1>(o, vb0, pa0, pa1, pa2, pa3); }
    SBAR(); SEAM_K0();
    if (hi == 0) li_l[r32] = l_reg; asm volatile("s_waitcnt lgkmcnt(0)" ::: "memory");
    float rli[16];
#pragma unroll
    for (int r = 0; r < 16; ++r) rli[r] = __builtin_amdgcn_rcpf(li_l[crow(r, hi)]);
    char* Ow = (char*)cur.O + (size_t)(wid * QBLK) * (LDO * 2); const unsigned ovoff = (unsigned)(4 * hi * LDO + r32) * 2u;
#pragma unroll
    for (int r = 0; r < 16; ++r) { const int orow0 = (r & 3) + 8 * (r >> 2);
#pragma unroll
        for (int d0 = 0; d0 < 4; ++d0) { const float v = o[d0][r] * rli[r];
            const float vn = __shfl_xor(v, 1);
            if ((r32 & 1) == 0) *(unsigned*)(Ow + (size_t)(orow0 * LDO * 2 + d0 * 64) + ovoff) = cvtpk(v, vn); } }
    __syncthreads();
    return next_item;
#undef RESC
#undef KBASE
#undef MASKT
#undef SEAM_K0
#undef HALF_STEP
}
#undef ROWP
#undef VMW
#undef VMWN
#undef LD8
#undef SLOAD_H
#undef SWRITE_HK
#undef SWRITE_HV
#undef SWRITE_H

__device__ __forceinline__ BlockRef make_ref(const P& a, int item) {
    const int qb = 7 - (item >> 6), bh = item & 63, b = bh >> 3, h = bh & 7;
    const bf16_t* proj = (const bf16_t*)(a.ws + WS_PROJ);
    BlockRef r; r.b = b; r.h = h; r.qb = qb;
    r.Q = proj + PROJ_BLK(C_QB + h * HD) + (size_t)(b * SEQ + qb * QB) * LDP;
    r.K = proj + PROJ_BLK(C_KB + h * HD) + (size_t)(b * SEQ) * LDP;
    r.V = proj + PROJ_BLK(C_VB + h * HD) + (size_t)(b * SEQ) * LDP;
    r.O = (bf16_t*)(a.ws + WS_OAB) + (size_t)(b * SEQ + qb * QB) * LDO + 1024 + h * HD;
    return r;
}
}
__device__ __forceinline__ void router_unit(const P& a, LAS unsigned char* lds, int unit) {
    int tid = threadIdx.x; asm volatile("" : "+v"(tid)); const int wave = __builtin_amdgcn_readfirstlane(tid >> 6), lane = tid & 63, c32 = lane & 31, hi = lane >> 5;
    const int tg = wave & 1, kq = wave >> 1;
    const bf16_t* x1 = (const bf16_t*)(a.ws + WS_X1); const float* g = a.in[11]; const float* br = a.in[13];
    unsigned char* A2 = a.ws + WS_A2; const u32x4* frag = (const u32x4*)(a.ws + WS_WRF);
    LAS float* Lw = (LAS float*)(lds + wave * 4352);
    LAS float* ssp = (LAS float*)(lds + 8 * 4352);
    LAS unsigned* hist = (LAS unsigned*)(lds + 8 * 4352 + 2048);
    LAS unsigned* base = hist + 32;
    if (tid < 32) hist[tid] = 0u;
    const int tok = unit * 64 + tg * 32 + c32;
    f32x16 L;
#pragma unroll
    for (int r = 0; r < 16; ++r) L[r] = 0.f;
    float ss = 0.f;
    const bf16_t* xr = x1 + (size_t)tok * D + 8 * hi + 256 * kq; unsigned char* ar = A2 + (size_t)tok * D + 8 * hi + 256 * kq; const float* gr = g + 8 * hi + 256 * kq;
#pragma unroll 4
    for (int s = 0; s < 16; ++s) {
        const u32x4 xw = *(const u32x4*)(xr + 16 * s); const f32x4 xa = {bflo(xw.x), bfhi(xw.x), bflo(xw.y), bfhi(xw.y)}, xb = {bflo(xw.z), bfhi(xw.z), bflo(xw.w), bfhi(xw.w)}, ga = *(const f32x4*)(gr + 16 * s), gb = *(const f32x4*)(gr + 16 * s + 4);
        ss += (xa.x * xa.x + xa.y * xa.y) + (xa.z * xa.z + xa.w * xa.w) + (xb.x * xb.x + xb.y * xb.y) + (xb.z * xb.z + xb.w * xb.w);
        const f32x4 va = xa * ga, vb = xb * gb;
        u32x4 wh; wh.x = cvt_pk_bf16(va.x, va.y); wh.y = cvt_pk_bf16(va.z, va.w); wh.z = cvt_pk_bf16(vb.x, vb.y); wh.w = cvt_pk_bf16(vb.z, vb.w);
        { u32x2 w8; w8.x = pk4_fp8(va.x, va.y, va.z, va.w); w8.y = pk4_fp8(vb.x, vb.y, vb.z, vb.w); *(u32x2*)(ar + 16 * s) = w8; }
        u32x4 wl; wl.x = cvt_pk_bf16(va.x - bflo(wh.x), va.y - bfhi(wh.x)); wl.y = cvt_pk_bf16(va.z - bflo(wh.y), va.w - bfhi(wh.y));
        wl.z = cvt_pk_bf16(vb.x - bflo(wh.z), vb.y - bfhi(wh.z)); wl.w = cvt_pk_bf16(vb.z - bflo(wh.w), vb.w - bfhi(wh.w));
        const bf16x8 ah = __builtin_bit_cast(bf16x8, wh), al = __builtin_bit_cast(bf16x8, wl);
        const bf16x8 bh = __builtin_bit_cast(bf16x8, frag[(16 * kq + s) * 64 + lane]), bl = __builtin_bit_cast(bf16x8, frag[4096 + (16 * kq + s) * 64 + lane]);
        L = __builtin_amdgcn_mfma_f32_32x32x16_bf16(ah, bh, L, 0, 0, 0);
        L = __builtin_amdgcn_mfma_f32_32x32x16_bf16(ah, bl, L, 0, 0, 0);
        L = __builtin_amdgcn_mfma_f32_32x32x16_bf16(al, bh, L, 0, 0, 0);
    }
#pragma unroll
    for (int r = 0; r < 16; ++r) Lw[((r & 3) + 8 * (r >> 2) + 4 * hi) * 33 + c32] = L[r];
    ssp[wave * 64 + lane] = ss;
    __syncthreads();
    int e4[4] = {0, 0, 0, 0}; float w4[4] = {0.f, 0.f, 0.f, 0.f}; unsigned loc[4] = {0u, 0u, 0u, 0u}; float rstd = 0.f;
    const bool sel = (wave < 2) && (hi == 0);
    if (sel) {
        float sst = 0.f;
#pragma unroll
        for (int q = 0; q < 4; ++q) sst += ssp[(wave + 2 * q) * 64 + c32] + ssp[(wave + 2 * q) * 64 + 32 + c32];
        rstd = 1.0f / sqrtf(sst * (1.0f / D) + EPS);
        float lg[32];
#pragma unroll
        for (int e = 0; e < 32; ++e) { const LAS float* lp = (const LAS float*)(lds + wave * 4352) + c32 * 33 + e; lg[e] = (lp[0] + lp[2 * 1088] + lp[4 * 1088] + lp[6 * 1088]) * rstd + br[e]; }
        unsigned used = 0u; float v4[4];
#pragma unroll
        for (int p = 0; p < 4; ++p) { float best = -__builtin_inff(); int bi = 0;
#pragma unroll
            for (int e = 0; e < 32; ++e) { const bool take = !((used >> e) & 1u) && lg[e] > best; best = take ? lg[e] : best; bi = take ? e : bi; }
            used |= 1u << bi; e4[p] = bi; v4[p] = best; }
        float sum = 0.f;
#pragma unroll
        for (int p = 0; p < 4; ++p) { w4[p] = expf(v4[p] - v4[0]); sum += w4[p]; }
        const float inv = 1.0f / sum;
#pragma unroll
        for (int p = 0; p < 4; ++p) { w4[p] *= inv; loc[p] = __hip_atomic_fetch_add(hist + e4[p], 1u, __ATOMIC_RELAXED, __HIP_MEMORY_SCOPE_WORKGROUP); }
    }
    __syncthreads();
    if (tid < 32) base[tid] = __hip_atomic_fetch_add((unsigned*)(a.ws + WS_CTL) + CW_COUNTS + tid, hist[tid], RLX_AGENT);
    __syncthreads();
    if (sel) {
        int* tope = (int*)(a.ws + WS_TOPE) + (size_t)tok * 4; float* wts = (float*)(a.ws + WS_WTS) + (size_t)tok * 4; int* slot = (int*)(a.ws + WS_SLOT) + (size_t)tok * 4;
#pragma unroll
        for (int p = 0; p < 4; ++p) { const int sl_ = (int)(base[e4[p]] + loc[p]); tope[p] = e4[p]; wts[p] = w4[p]; slot[p] = sl_;
            ((int*)(a.ws + WS_ROWE))[(size_t)e4[p] * T + sl_] = tok; ((float*)(a.ws + WS_RSTE))[(size_t)e4[p] * T + sl_] = rstd; }
    }
    __syncthreads();
}

__device__ __forceinline__ void moe_tables(const P& a, LAS unsigned char* lds) {
    int tid = threadIdx.x; asm volatile("" : "+v"(tid)); const int wave = tid >> 6, lane = tid & 63, e = lane & 31;
    LAS int* pstart = (LAS int*)(lds + LDS_MOE); LAS int* cnt = pstart + 64; LAS int* tile_e = pstart + 128;
    const unsigned* counts = (const unsigned*)(a.ws + WS_CTL) + CW_COUNTS;
    const int c = (int)counts[e]; const int p = ((c + 255) >> 8) << 8; int inc = p;
#pragma unroll
    for (int o = 1; o < 32; o <<= 1) { const int t = __builtin_amdgcn_ds_bpermute(((lane - o) & 63) << 2, inc); if (e >= o) inc += t; }
    if (tid < 32) { cnt[e] = c; pstart[e] = inc - p; if (e == 31) { pstart[32] = inc; tile_e[MAXTILES] = inc >> 8; } }
    for (int t = wave * 36; t < wave * 36 + 36; ++t) { const unsigned long long m = __ballot(inc <= t * 256); const int ee = __builtin_popcount((unsigned)m); if (lane == 0) tile_e[t] = ee < NE ? ee : NE - 1; }
    __syncthreads();
}

__device__ __forceinline__ void combine_rows(const P& a, LAS unsigned char* lds, int vcu, int G, int wave, int lane) {
    const LAS int* pstart = (const LAS int*)(lds + LDS_MOE);
    const int gw = vcu * NWAVES + wave, NGW = G * NWAVES;
    const bf16_t* X1 = (const bf16_t*)(a.ws + WS_X1); float* X = (float*)(a.ws + WS_X2); const unsigned char* Y = a.ws + WS_YROWS; bf16_t* A3 = (bf16_t*)(a.ws + WS_H);
    const int* tope = (const int*)(a.ws + WS_TOPE); const int* slot = (const int*)(a.ws + WS_SLOT); const float* wts = (const float*)(a.ws + WS_WTS); const float* g = a.in[20];
    f32x4 gv[4];
#pragma unroll
    for (int j = 0; j < 4; ++j) gv[j] = *((const f32x4*)g + lane + 64 * j);
    for (int m0 = gw; m0 < T; m0 += 8 * NGW) {
        int dl = 0; float wl = 0.f;
        { const int i = (lane >> 2) & 7, k = lane & 3; const int m = m0 + i * NGW; if (lane < 32 && m < T) { dl = pstart[tope[m * 4 + k]] + slot[m * 4 + k]; wl = wts[m * 4 + k]; } }
        u32x2 xa[4], xb[4]; unsigned ya[4][4], yb[4][4];
#define CR_LOAD(i_, XQ, YQ) do { const int m_ = m0 + (i_) * NGW; if (m_ < T) { const u32x2* x1r = (const u32x2*)(X1 + (size_t)m_ * D) + lane; \
            _Pragma("unroll") for (int j = 0; j < 4; ++j) XQ[j] = __builtin_nontemporal_load(x1r + 64 * j); \
            _Pragma("unroll") for (int k = 0; k < 4; ++k) { const int d = __builtin_amdgcn_readlane(dl, 4 * (i_) + k); const unsigned* yr = (const unsigned*)(Y + (size_t)d * D) + lane; \
                _Pragma("unroll") for (int j = 0; j < 4; ++j) YQ[k][j] = __builtin_nontemporal_load(yr + 64 * j); } } } while (0)
#define CR_DO(i_, XQ, YQ) do { const int m_ = m0 + (i_) * NGW; if (m_ < T) { f32x4 v[4]; \
            _Pragma("unroll") for (int j = 0; j < 4; ++j) v[j] = (f32x4){bflo(XQ[j].x), bfhi(XQ[j].x), bflo(XQ[j].y), bfhi(XQ[j].y)}; \
            _Pragma("unroll") for (int k = 0; k < 4; ++k) { const float w = __int_as_float(__builtin_amdgcn_readlane(__float_as_int(wl), 4 * (i_) + k)); \
                _Pragma("unroll") for (int j = 0; j < 4; ++j) { const int y = (int)YQ[k][j]; \
                    v[j].x += w * __builtin_amdgcn_cvt_f32_fp8(y, 0); v[j].y += w * __builtin_amdgcn_cvt_f32_fp8(y, 1); v[j].z += w * __builtin_amdgcn_cvt_f32_fp8(y, 2); v[j].w += w * __builtin_amdgcn_cvt_f32_fp8(y, 3); } } \
            float s = 0.f; \
            _Pragma("unroll") for (int j = 0; j < 4; ++j) s += (v[j].x * v[j].x + v[j].y * v[j].y) + (v[j].z * v[j].z + v[j].w * v[j].w); \
            const float rstd = 1.0f / sqrtf(wave_sum(s) * (1.0f / D) + EPS); \
            f32x4* xr = (f32x4*)(X + (size_t)m_ * D) + lane; unsigned* o4 = (unsigned*)((unsigned char*)A3 + (size_t)m_ * D) + lane;        \
            _Pragma("unroll") for (int j = 0; j < 4; ++j) { xr[64 * j] = v[j]; o4[64 * j] = pk4_fp8(v[j].x * rstd * gv[j].x, v[j].y * rstd * gv[j].y, v[j].z * rstd * gv[j].z, v[j].w * rstd * gv[j].w); } } } while (0)
        CR_LOAD(0, xa, ya);
#pragma unroll
        for (int i = 0; i < 8; i += 2) { CR_LOAD(i + 1, xb, yb); CR_DO(i, xa, ya); if (i + 2 < 8) CR_LOAD(i + 2, xa, ya); CR_DO(i + 1, xb, yb); }
#undef CR_LOAD
#undef CR_DO
    }
}
__device__ __forceinline__ void final_rows(const P& a, int vcu, int G, int wave, int lane) {
    const int gw = vcu * NWAVES + wave, NGW = G * NWAVES;
    const float* X = (const float*)(a.ws + WS_X2); float* OUT = a.out; const bf16_t* PG = (const bf16_t*)(a.ws + WS_PGATE); const bf16_t* PP = (const bf16_t*)(a.ws + WS_PPROJ);
    f32x4 gp[4], gf[4];
#pragma unroll
    for (int j = 0; j < 4; ++j) { gp[j] = *((const f32x4*)a.in[23] + lane + 64 * j); gf[j] = *((const f32x4*)a.in[24] + lane + 64 * j); }
    f32x4 va[4], vb[4]; u32x2 qa[4], qb[4], ga[4], gb[4];
#define FR_LOAD(m_, V, Q, GQ) do { if ((m_) < T) { const f32x4* xr = (const f32x4*)(X + (size_t)(m_) * D) + lane; const u32x2* pgr = (const u32x2*)(PG + (size_t)(m_) * D) + lane; const u32x2* ppr = (const u32x2*)(PP + (size_t)(m_) * D) + lane; \
        _Pragma("unroll") for (int j = 0; j < 4; ++j) { V[j] = __builtin_nontemporal_load(xr + 64 * j); Q[j] = __builtin_nontemporal_load(ppr + 64 * j); GQ[j] = __builtin_nontemporal_load(pgr + 64 * j); } } } while (0)
#define FR_DO(m_, V, Q, GQ) do { if ((m_) < T) { f32x4 v[4], pp[4], pg[4]; float sp = 0.f; \
        _Pragma("unroll") for (int j = 0; j < 4; ++j) { v[j] = V[j]; pp[j] = (f32x4){bflo(Q[j].x), bfhi(Q[j].x), bflo(Q[j].y), bfhi(Q[j].y)}; pg[j] = (f32x4){bflo(GQ[j].x), bfhi(GQ[j].x), bflo(GQ[j].y), bfhi(GQ[j].y)}; \
            sp += (pp[j].x * pp[j].x + pp[j].y * pp[j].y) + (pp[j].z * pp[j].z + pp[j].w * pp[j].w); } \
        const float rp = 1.0f / sqrtf(wave_sum(sp) * (1.0f / D) + EPS); float s_ = 0.f; \
        _Pragma("unroll") for (int j = 0; j < 4; ++j) { v[j] = v[j] + pg[j] * (pp[j] * rp * gp[j]); s_ += (v[j].x * v[j].x + v[j].y * v[j].y) + (v[j].z * v[j].z + v[j].w * v[j].w); } \
        const float rstd = 1.0f / sqrtf(wave_sum(s_) * (1.0f / D) + EPS); f32x4* orow = (f32x4*)(OUT + (size_t)(m_) * D) + lane; \
        _Pragma("unroll") for (int j = 0; j < 4; ++j) __builtin_nontemporal_store(v[j] * rstd * gf[j], orow + 64 * j); } } while (0)
    FR_LOAD(gw, va, qa, ga);
    for (int m = gw; m < T; m += 2 * NGW) { FR_LOAD(m + NGW, vb, qb, gb); FR_DO(m, va, qa, ga); FR_LOAD(m + 2 * NGW, va, qa, ga); FR_DO(m + NGW, vb, qb, gb); }
#undef FR_LOAD
#undef FR_DO
}
#ifndef MK_CVP
#define MK_CVP 8
#define MK_CVQ 3
#endif
struct Args { P p; };
template <int PH_LO, int PH_HI>
__global__ void __launch_bounds__(NTHREADS, 2) hybrid_fwd(Args args) {
    extern __shared__ __attribute__((aligned(16))) unsigned char lds_raw[];
    LAS unsigned char* lds = (LAS unsigned char*)lds_raw;
    const P& a = args.p;
    const int tid = threadIdx.x;
#define FRESH_WL() int t_ = threadIdx.x; asm volatile("" : "+v"(t_)); const int w_ = __builtin_amdgcn_readfirstlane(t_ >> 6), l_ = t_ & 63
    const int G = gridDim.x; const int bx = blockIdx.x; const int vcu = (G % 8 == 0) ? (bx % 8) * (G / 8) + bx / 8 : bx;
    unsigned* ctl = (unsigned*)(a.ws + WS_CTL);
    for (int u = tid; u < (LDS_BYTES - LDSCTL_OFF) / 4; u += NTHREADS) ((LAS unsigned*)(lds + LDSCTL_OFF))[u] = 0u;
    __syncthreads();
#if MK_PER_PHASE
#define GRID_BAR() do { } while (0)
#else
    XcdBarrier bar = xcd_barrier_post(ctl + CW_BAR, (volatile LAS unsigned*)(lds + MISC_OFF + 32));
#define GRID_BAR() xcd_barrier(bar)
#endif
    constexpr int lo = PH_LO, hi = PH_HI;
#define IN(k) (lo <= (k) && (k) < hi)
#define SEAM(k) do { if constexpr (IN(k) && IN((k) + 1)) GRID_BAR(); } while (0)
    unsigned char* ws = a.ws;

    if constexpr (IN(0)) { FRESH_WL(); p0_prologue(a, lds, vcu, G, w_, l_); }
    SEAM(0);
    if constexpr (IN(1)) {
        { pg8::DenseSched S; S.o.init(T / 256, 12, G, bx); S.Bt = (const char*)(ws + WS_WIN); S.K = D;
          pg8::EpiProj<false> E{(bf16_t*)(ws + WS_PROJ), (float*)(ws + WS_KMP)};
          pg8::gemm_phase(lds, (const char*)(ws + WS_H), D, D, D, S, E); }
        { pg8::DenseSched S; S.o.init(T / 256, 20, G, bx); S.Bt = (const char*)(ws + WS_WIN8); S.K = D; S.es = 1; S.pn0 = 12; S.bt_out = false;
          pg8::EpiProj<true> E{(bf16_t*)(ws + WS_PROJ), (float*)(ws + WS_KMP)};
          pg8::gemm_phase(lds, (const char*)(ws + WS_H8), D, D, D, S, E); }
    }
    SEAM(1);
    if constexpr (IN(2)) { for (int u = vcu; u < NB * 32; u += G) gla_prep_unit(a, lds, u); }
    SEAM(2);
    if constexpr (IN(3)) { for (int u = vcu; u < 512; u += G) gla_combine_unit(a, u); }
    SEAM(3);
    if constexpr (IN(4)) {
        for (int u = vcu; u < 1024; u += G) gla_out_unit(a, lds, u);
        __syncthreads();
    }
    if constexpr (IN(5)) {
        if ((vcu % MK_CVP) < MK_CVQ) { FRESH_WL(); expert_convert(a, lds, (vcu / MK_CVP) * MK_CVQ + vcu % MK_CVP, (G / MK_CVP) * MK_CVQ + ((G % MK_CVP) < MK_CVQ ? (G % MK_CVP) : MK_CVQ), w_, l_); __syncthreads(); }
        unsigned* queue = ctl + CW_QUEUE;
        volatile LAS int* qslot = (volatile LAS int*)(lds + LDSCTL_OFF + 1024);
        if (tid == 0) qslot[0] = (int)__hip_atomic_fetch_add(queue, 1u, RLX_AGENT);
        __syncthreads();
        int item = __builtin_amdgcn_readfirstlane(qslot[0]);
        if (item < 512) {
            moba::Seam S;
            moba::BlockRef cur = moba::make_ref(a, item);
            moba::prime(cur, (char*)lds_raw, S);
            for (;;) {
                const int nitem = moba::block(a, cur, queue, a.in[2], (const float*)(ws + WS_KMP), (char*)lds_raw, S);
                if (nitem >= 512) break;
                cur = moba::make_ref(a, nitem);
            }
        }
    }
    SEAM(5);
    if constexpr (IN(6)) {
        pg8::ChainSched S; S.o.init(T / 256, D / 256, G, bx); S.Bt = (const char*)(ws + WS_WUP); S.K = 1024;
        pg8::EpiMerge E{(const bf16_t*)(ws + WS_PROJ), (bf16_t*)(ws + WS_Y)};
        pg8::gemm_phase(lds, (const char*)(ws + WS_OAB), 1024, 2048, 2048, S, E);
    }
    SEAM(6);
    if constexpr (IN(7)) {
        pg8::DenseSched S; S.o.init(T / 256, D / 256, G, bx); S.Bt = (const char*)(ws + WS_WO); S.K = D;
        pg8::EpiResF32 E{a.in[0], (bf16_t*)(ws + WS_X1)};
        pg8::gemm_phase(lds, (const char*)(ws + WS_Y), D, D, D, S, E);
    }
    SEAM(7);
    if constexpr (IN(8)) { for (int u = vcu; u < T / 64; u += G) router_unit(a, lds, u); }
    SEAM(8);
    if constexpr (IN(9)) {
        moe_tables(a, lds); const LAS int* tab = (const LAS int*)(lds + LDS_MOE); const int ntile = __builtin_amdgcn_readfirstlane(tab[128 + MAXTILES]);
        pg8::MoeSched<true> S; S.o.init(ntile, 8, G, bx); S.Bt = (const char*)a.out; S.K = D; S.rows_per_e = 2048; S.tab = tab; S.row_e = (const int*)(ws + WS_ROWE); S.es = 1;
        pg8::EpiGlu E{(unsigned char*)(ws + WS_HMID), (const float*)(ws + WS_RSTE), tab, a.in[15], a.in[17], (const float*)(ws + WS_CTL) + 131072, lds};
        pg8::gemm_phase(lds, (const char*)(ws + WS_A2), D, D, D, S, E);
        const int extra = (ntile * 8) % G, nidle = G - extra;
        if (bx >= extra) { __syncthreads();
            pg8::DenseSched S2; S2.o.init(T / 256, D / 256, nidle, bx - extra); S2.Bt = (const char*)(ws + WS_WPP); S2.K = 256;
            pg8::EpiBf16<0, false> E2{(bf16_t*)(ws + WS_PPROJ), D, nullptr, 0, 1.0f};
            pg8::gemm_phase(lds, (const char*)(ws + WS_PB), 256, 256, 256, S2, E2); }
    }
    SEAM(9);
    if constexpr (IN(10)) {
        moe_tables(a, lds); const LAS int* tab = (const LAS int*)(lds + LDS_MOE); const int ntile = __builtin_amdgcn_readfirstlane(tab[128 + MAXTILES]);
        pg8::MoeSched<false> S; S.o.init(ntile, 4, G, bx); S.Bt = (const char*)(ws + WS_W2T); S.K = FF; S.rows_per_e = 1024; S.tab = tab; S.row_e = nullptr; S.es = 1;
        pg8::EpiDownF8 E{(unsigned char*)(ws + WS_YROWS), a.in[19]};
        pg8::gemm_phase(lds, (const char*)(ws + WS_HMID), FF, FF, FF, S, E);
    }
    SEAM(10);
    if constexpr (IN(11)) { moe_tables(a, lds); FRESH_WL(); combine_rows(a, lds, vcu, G, w_, l_); }
    SEAM(11);
    if constexpr (IN(12)) {
        { pg8::DenseSched S; S.o.init(T / 256, D / 256, G, bx); S.Bt = (const char*)(ws + WS_WPG); S.K = D; S.es = 1;
          pg8::EpiBf16<1, false, true> E{(bf16_t*)(ws + WS_PGATE), D, nullptr, 0, 1.0f / 32.0f};
          pg8::gemm_phase(lds, (const char*)(ws + WS_H), D, D, D, S, E); }
    }
    SEAM(12);
    if constexpr (IN(13)) { FRESH_WL(); final_rows(a, vcu, G, w_, l_); }
#undef FRESH_WL
#undef IN
#undef SEAM
#undef GRID_BAR
}

template <int LO, int HI> static void launch_range(const Args& a, int grid, hipStream_t stream) {
    static bool attr = false;
    if (!attr) { attr = true; if (hipFuncSetAttribute((const void*)hybrid_fwd<LO, HI>, hipFuncAttributeMaxDynamicSharedMemorySize, LDS_BYTES) != hipSuccess) fprintf(stderr, "kernel_launch: hipFuncSetAttribute failed\n"); }
    hipLaunchKernelGGL((hybrid_fwd<LO, HI>), dim3(grid), dim3(NTHREADS), LDS_BYTES, stream, a);
}
extern "C" void kernel_launch(void* const* d_in, const int* in_sizes, int n_in, void* d_out, int out_size, void* d_ws, size_t ws_size, hipStream_t stream) {
    static int grid = 0;
    if (grid == 0) {
        static const int expect[25] = {T * D, T * 256, 256, 1024, 1024 * D_IN, 16 * 512, 512, 256, 1048576, 1048576, 1048576, 1024, 32768, 32, 33554432, 32768, 33554432, 32768, 33554432, 32768, 1024, 1048576, 262144, 1024, 1024};
        bool okk = (n_in == 25);
        for (int i = 0; okk && i < 25; ++i) if (in_sizes[i] != expect[i]) { fprintf(stderr, "kernel_launch: input %d has %d elements, expected %d\n", i, in_sizes[i], expect[i]); okk = false; }
        if (!okk || out_size != T * D || ws_size < WS_END) { fprintf(stderr, "kernel_launch: unexpected shapes (n_in %d, in0 %d, out %d, ws %zu); nothing launched\n", n_in, n_in > 0 ? in_sizes[0] : -1, out_size, ws_size); grid = -1; return; }
        int dev = 0, cus = 0;
        if (hipGetDevice(&dev) != hipSuccess || hipDeviceGetAttribute(&cus, hipDeviceAttributeMultiprocessorCount, dev) != hipSuccess) { grid = -1; return; }
        grid = cus;
    }
    if (grid < 0) return;
    (void)hipMemsetAsync((char*)d_ws + WS_CTL, 0, CTL_ZERO_BYTES, stream);
    Args a{};
    for (int i = 0; i < 25; ++i) a.p.in[i] = (const float*)d_in[i];
    a.p.out = (float*)d_out; a.p.ws = (unsigned char*)d_ws;
#if MK_PER_PHASE
#ifndef MK_LAST
#define MK_LAST 13
#endif
#ifndef MK_REPEAT
#define MK_REPEAT 0
#endif
#define LR(k) do { if ((k) <= MK_LAST) for (int r_ = 0; r_ < 1 + ((MK_REPEAT >> (k)) & 1); ++r_) launch_range<(k), (k) + 1>(a, grid, stream); } while (0)
    LR(0); LR(1); LR(2); LR(3); LR(4); LR(5); LR(6); LR(7); LR(8); LR(9); LR(10); LR(11); LR(12); LR(13);
#undef LR
#else
    launch_range<0, NPHASES>(a, grid, stream);
#endif
}
```

```cpp
#include <hip/hip_runtime.h>
#include <cstdio>
#include <cstdint>

#define LAS __attribute__((address_space(3)))
#define GAS __attribute__((address_space(1)))
typedef unsigned short bf16_t;
typedef short bf16x8 __attribute__((ext_vector_type(8)));
typedef short s16x4 __attribute__((ext_vector_type(4)));
typedef float f32x2 __attribute__((ext_vector_type(2)));
typedef float f32x4 __attribute__((ext_vector_type(4)));
typedef float f32x16 __attribute__((ext_vector_type(16)));
typedef unsigned u32x2 __attribute__((ext_vector_type(2)));
typedef unsigned u32x4 __attribute__((ext_vector_type(4)));
typedef int i32x4 __attribute__((ext_vector_type(4)));
typedef int i32x8 __attribute__((ext_vector_type(8)));
typedef GAS unsigned gu32;
#define RLX_AGENT __ATOMIC_RELAXED, __HIP_MEMORY_SCOPE_AGENT
#define LDS_WAIT() asm volatile("s_waitcnt lgkmcnt(0)" ::: "memory")
#define VM_WAIT() asm volatile("s_waitcnt vmcnt(0)" ::: "memory")

#ifndef MK_PER_PHASE
#define MK_PER_PHASE 0
#endif

constexpr int NB = 8, SEQ = 2048, T = NB * SEQ, D = 1024;
constexpr int NPROJ = 8192;
constexpr int C_QA = 0, C_KA = 512, C_VA = 1024, C_RA = 2048, C_QB = 3072, C_KB = 4096, C_VB = 5120, C_GA = 6144, C_GB = 7168;
#define PROJ_BLK(cs) ((size_t)(cs) * T)
constexpr int SRC_ALOW = 3072, D_IN = 8208;
constexpr int NE = 32, FF = 1024, MAXTILES = 288, MAXROWS = MAXTILES * 256;
constexpr float EPS = 1e-6f;
constexpr int NWAVES = 8, NTHREADS = 512;
constexpr int NPHASES = 14;

constexpr size_t MiB = 1u << 20;
constexpr size_t WS_CTL = 0, CTL_ZERO_BYTES = 1 * MiB;
constexpr size_t WS_SMALL = 1 * MiB;
constexpr size_t WS_KMP   = WS_SMALL;
constexpr size_t WS_DEC   = WS_KMP + 512 * 1024;
constexpr size_t WS_TOPE  = WS_DEC + 512 * 1024;
constexpr size_t WS_WTS   = WS_TOPE + 256 * 1024;
constexpr size_t WS_SLOT  = WS_WTS + 256 * 1024;
constexpr size_t WS_DEST  = WS_SLOT + 256 * 1024;
constexpr size_t WS_ROWTOK = WS_DEST + 256 * 1024;
constexpr size_t WS_RSTDS = WS_ROWTOK + 320 * 1024;
constexpr size_t WS_RSTD  = WS_RSTDS + 320 * 1024;
constexpr size_t WS_TILEE = WS_RSTD + 64 * 1024;
constexpr size_t WS_WALT  = WS_TILEE + 4 * 1024;
constexpr size_t WS_WRF   = WS_WALT + 32 * 1024;
static_assert(WS_WRF + 128 * 1024 <= 6 * MiB, "small map");
constexpr size_t WS_WO = 6 * MiB, WS_WPG = 8 * MiB, WS_WPP = 10 * MiB, WS_WUP = 12 * MiB, WS_WIN = 16 * MiB;
constexpr size_t WS_PB = 34 * MiB;
constexpr size_t WS_H  = 42 * MiB;
constexpr size_t WS_PROJ = 74 * MiB;
constexpr size_t WS_QG = 330 * MiB, WS_KG = 346 * MiB;
constexpr size_t WS_SLOC = 426 * MiB;
constexpr size_t WS_OAB = 362 * MiB;
constexpr size_t WS_H8 = 426 * MiB;
constexpr size_t WS_WIN8 = 442 * MiB;
constexpr size_t WS_Y = 330 * MiB;
constexpr size_t WS_W2T = 42 * MiB;
constexpr size_t WS_A2 = 330 * MiB;
constexpr size_t WS_HMID = 138 * MiB;
constexpr size_t WS_X1 = 74 * MiB;
constexpr size_t WS_X2 = 138 * MiB;
constexpr size_t WS_YROWS = 282 * MiB;
constexpr size_t WS_PGATE = 330 * MiB, WS_PPROJ = 226 * MiB;
constexpr size_t WS_ROWE = 490 * MiB;
constexpr size_t WS_RSTE = 492 * MiB;
constexpr size_t WS_END = 506 * MiB;

constexpr int CW_BAR = 4096;
constexpr int CW_COUNTS = 16384;
constexpr int CW_QUEUE = 16384 + 64;

constexpr int RING_BYTES = 131072;
constexpr int LDSCTL_OFF = RING_BYTES, MISC_OFF = LDSCTL_OFF + 320;
constexpr int LDS_MOE = LDSCTL_OFF + 10240;
constexpr int EPF_OFF = LDSCTL_OFF + 12288;
constexpr int LDS_BYTES = 151552;

typedef __bf16 bf16v2_t __attribute__((ext_vector_type(2)));
__device__ __forceinline__ unsigned cvt_pk_bf16(float lo, float hi) { const f32x2 v = {lo, hi}; return __builtin_bit_cast(unsigned, __builtin_convertvector(v, bf16v2_t)); }
__device__ __forceinline__ unsigned pk4_fp8(float a, float b, float c, float d) { int w = 0; w = __builtin_amdgcn_cvt_pk_fp8_f32(a, b, w, false); w = __builtin_amdgcn_cvt_pk_fp8_f32(c, d, w, true); return (unsigned)w; }
__device__ __forceinline__ float bf2f(unsigned short s) { return __uint_as_float(((unsigned)s) << 16); }
__device__ __forceinline__ float bflo(unsigned w) { return __uint_as_float(w << 16); }
__device__ __forceinline__ float bfhi(unsigned w) { return __uint_as_float(w & 0xffff0000u); }
__device__ __forceinline__ float fsigmoid(float x) { return __builtin_amdgcn_rcpf(1.0f + __builtin_amdgcn_exp2f(-1.4426950408889634f * x)); }
__device__ __forceinline__ float wave_sum(float v) {
#pragma unroll
    for (int o = 1; o < 64; o <<= 1) v += __shfl_xor(v, o);
    return v;
}
__device__ __forceinline__ bf16x8 pack8(f32x4 a, f32x4 b) {
    u32x4 w = {cvt_pk_bf16(a[0], a[1]), cvt_pk_bf16(a[2], a[3]), cvt_pk_bf16(b[0], b[1]), cvt_pk_bf16(b[2], b[3])};
    return __builtin_bit_cast(bf16x8, w);
}

#define XB_TMO      128
#define XB_XCNT(j)  (256  + 64 * (j))
#define XB_XSUB(j)  (1280 + 64 * (j))
#define XB_XGEN(j)  (2304 + 64 * (j))
#define XB_TOP      3328
#define XB_TOPGEN   3392
#define XCD_BAR_WORDS 3456
#define XB_SPIN_CAP (1u << 18)

__device__ __forceinline__ unsigned xb_ld(unsigned* p)              { return __hip_atomic_load(p, __ATOMIC_RELAXED, __HIP_MEMORY_SCOPE_AGENT); }
__device__ __forceinline__ unsigned xb_add(unsigned* p, unsigned v) { return __hip_atomic_fetch_add(p, v, __ATOMIC_RELAXED, __HIP_MEMORY_SCOPE_AGENT); }
__device__ __forceinline__ unsigned xb_xcc_id() { return (unsigned)__builtin_amdgcn_s_getreg((3 << 11) | 20) & 0xFu; }
#define XB_SPIN(cond, bar) do { unsigned _sp = 0; while (cond) { __builtin_amdgcn_s_sleep(1); \
    if ((++_sp & 255u) == 0u) { if (xb_ld(&(bar)[XB_TMO])) break; if (_sp > XB_SPIN_CAP) { atomicAdd(&(bar)[XB_TMO], 1u); break; } } } } while (0)

struct XcdBarrier { unsigned* bar; unsigned x; volatile LAS unsigned* st; };

__device__ __forceinline__ XcdBarrier xcd_barrier_post(unsigned* bar, volatile LAS unsigned* st) {
    XcdBarrier b; b.bar = bar; b.x = xb_xcc_id(); b.st = st;
    if (threadIdx.x == 0) (void)xb_add(&bar[XB_XCNT(b.x)], 1u);
    return b;
}
__device__ __forceinline__ void xcd_barrier_complete(unsigned* bar, unsigned x, unsigned& nloc, unsigned& nx) {
    const unsigned G = gridDim.x * gridDim.y * gridDim.z;
    unsigned sum, cnt, mine, sp = 0u;
    for (;;) {
        sum = 0u; cnt = 0u; mine = 0u;
#pragma unroll
        for (unsigned j = 0; j < 16; ++j) { const unsigned c = xb_ld(&bar[XB_XCNT(j)]); sum += c; cnt += (c > 0u) ? 1u : 0u; mine = (j == x) ? c : mine; }
        if (sum == G) break;
        __builtin_amdgcn_s_sleep(1);
        if ((++sp & 255u) == 0u) { if (xb_ld(&bar[XB_TMO])) break; if (sp > XB_SPIN_CAP) { atomicAdd(&bar[XB_TMO], 1u); break; } }
    }
    nloc = mine > 0u ? mine : 1u; nx = cnt > 0u ? cnt : 1u;
}
__device__ __forceinline__ void xcd_barrier(const XcdBarrier& b) {
    asm volatile("s_waitcnt vmcnt(0)" ::: "memory");
    __syncthreads();
    if (threadIdx.x == 0) {
        unsigned* bar = b.bar;
        __builtin_amdgcn_s_waitcnt(0);
        unsigned nloc = b.st[0], nx = b.st[1];
        if (nloc == 0u) { xcd_barrier_complete(bar, b.x, nloc, nx); b.st[0] = nloc; b.st[1] = nx; }
        const unsigned old = xb_add(&bar[XB_XSUB(b.x)], 1u);
        const unsigned gen = old / nloc;
        if (old + 1u == (gen + 1u) * nloc) {
            __builtin_amdgcn_fence(__ATOMIC_RELEASE, "agent");
            asm volatile("s_waitcnt vmcnt(0)" ::: "memory");
            const unsigned og = xb_add(&bar[XB_TOP], 1u);
            const unsigned tg = og / nx;
            if (og + 1u == (tg + 1u) * nx) xb_add(&bar[XB_TOPGEN], 1u);
            else XB_SPIN(xb_ld(&bar[XB_TOPGEN]) == tg, bar);
            __builtin_amdgcn_fence(__ATOMIC_ACQUIRE, "agent");
            xb_add(&bar[XB_XGEN(b.x)], 1u);
            asm volatile("s_waitcnt vmcnt(0)" ::: "memory");
        } else {
            XB_SPIN(xb_ld(&bar[XB_XGEN(b.x)]) == gen, bar);
            __builtin_amdgcn_fence(__ATOMIC_ACQUIRE, "agent");
            asm volatile("s_waitcnt vmcnt(0)" ::: "memory");
        }
    }
    __syncthreads();
}
#ifndef MK_SCL
#define MK_SCL 0
#endif
namespace pg8 {
constexpr int BM = 256, BK = 64, HALF = 128, HTB = HALF * BK * 2, STAGE_BYTES = 8 * HTB, NXCD = 8, WGM = 8;

__host__ __device__ __forceinline__ int lds_byte(int r, int c) { const int st = (r >> 4) * 2 + (c >> 5), rr = r & 15, cc = c & 31, ob = rr * 64 + cc * 2; return st * 1024 + (ob ^ (((ob >> 9) & 1) << 5)); }
__host__ __device__ __forceinline__ void stage_rc(int b, int& R, int& C) { const int st = b / 1024, sb = b % 1024, swz = sb ^ (((sb >> 9) & 1) << 5); R = (st >> 1) * 16 + swz / 64; C = (st & 1) * 32 + (swz % 64) / 2; }
__host__ __device__ __forceinline__ int perm32(int rho) { const int n = rho >> 4, i = rho & 15; return 8 * (i >> 2) + 4 * n + (i & 3); }

struct Unit { int pm, pn, e, s; };

struct TileOrder {
    int nM, nN, nwg, G, c;
    __device__ __forceinline__ void init(int nM_, int nN_, int G_, int c_) { nM = nM_; nN = nN_; nwg = nM * nN; G = G_; c = c_; }
    __device__ __forceinline__ bool next(int i, int& pm, int& pn) const {
        const unsigned L = (unsigned)i * (unsigned)G + (unsigned)c; if (L >= (unsigned)nwg) return false;
        int wgid = (int)L; { const int q = nwg / NXCD, r = nwg % NXCD, xcd = wgid % NXCD, off = wgid / NXCD; wgid = (xcd < r ? xcd * (q + 1) : r * (q + 1) + (xcd - r) * q) + off; }
        const int nig = WGM * nN, gid = wgid / nig, fm = gid * WGM, gsz = (nM - fm) < WGM ? (nM - fm) : WGM;
        pm = fm + ((wgid % nig) % gsz); pn = (wgid % nig) / gsz; return true;
    }
};
struct DenseSched {
    TileOrder o; const char* Bt; int K; int es = 2; int gap_at = 1 << 30, gap_by = 0, pn0 = 0; bool bt_out = true;
    __device__ __forceinline__ bool next(int i, Unit& u) const { int p; if (!o.next(i, u.pm, p)) return false; u.e = p; u.pn = p + (p >= gap_at ? gap_by : 0) + pn0; return true; }
    __device__ __forceinline__ unsigned a_row(const Unit& u, int r) const { return (unsigned)(u.pm * BM + r); }
    __device__ __forceinline__ unsigned a_koff(const Unit&) const { return 0u; }
    __device__ __forceinline__ const char* b_base(const Unit& u) const { return Bt + (size_t)(bt_out ? u.pn : u.e) * BM * K * es; }
};
struct ChainSched {
    TileOrder o; const char* Bt; int K;
    __device__ __forceinline__ bool next(int i, Unit& u) const { if (!o.next(i >> 1, u.pm, u.pn)) return false; u.e = i & 1; return true; }
    __device__ __forceinline__ unsigned a_row(const Unit& u, int r) const { return (unsigned)(u.pm * BM + r); }
    __device__ __forceinline__ unsigned a_koff(const Unit& u) const { return (unsigned)(u.e * K * 2); }
    __device__ __forceinline__ const char* b_base(const Unit& u) const { return Bt + (size_t)u.pn * BM * (2 * K) * 2 + (size_t)u.e * K * 2; }
};
template <bool GATHER> struct MoeSched {
    TileOrder o; const char* Bt; int K; int rows_per_e; const LAS int* tab; const int* row_e; int es;
    __device__ __forceinline__ bool next(int i, Unit& u) const { if (!o.next(i, u.pm, u.pn)) return false; u.e = __builtin_amdgcn_readfirstlane(tab[128 + u.pm]); return true; }
    __device__ __forceinline__ unsigned a_row(const Unit& u, int r) const {
        if (GATHER) { const int lr = u.pm * BM + r - tab[u.e]; return lr < tab[64 + u.e] ? (unsigned)row_e[(size_t)u.e * T + lr] : 0u; }
        else return (unsigned)(u.pm * BM + r); }
    __device__ __forceinline__ unsigned a_koff(const Unit&) const { return 0u; }
    __device__ __forceinline__ const char* b_base(const Unit& u) const { return Bt + ((size_t)u.e * rows_per_e + (size_t)u.pn * BM) * K * es; }
};

template <class Epi, class Sched>
__device__ __forceinline__ void gemm_phase(LAS unsigned char* lds, const char* gA, int K_, int lda, int ldb, const Sched& S, const Epi& E) {
    int K = K_; asm volatile("" : "+s"(K));
    int tid = threadIdx.x; asm volatile("" : "+v"(tid));     const int wid = __builtin_amdgcn_readfirstlane(tid >> 6), lane = tid & 63, wr = wid >> 2, wc = wid & 3, fr = lane & 15, fq = lane >> 4;
    constexpr int ES = Epi::F8 ? 1 : 2;
    const int nt = K * ES / 128;
    unsigned voffB[2];
#pragma unroll
    for (int i = 0; i < 2; ++i) { int R, C; stage_rc(tid * 16 + i * 8192, R, C); const int Rb = Epi::PERM ? ((R & ~31) + perm32(R & 31)) : R; voffB[i] = (unsigned)(Rb * ldb * ES + C * 2); }
    const unsigned kstep = (unsigned)(BK * 2);
    const size_t hstepB = (size_t)HALF * ldb * ES;
    const unsigned ldab = (unsigned)lda * ES;
    const unsigned ldsw = (unsigned)wid * 1024u;
    const int aoff = lds_byte(wr * 64 + fr, fq * 8), boff = lds_byte(wc * 32 + fr, fq * 8);
#define PG8_SA(b, h) (((b) * 2 + (h)) * HTB)
#define PG8_SB(b, h) ((4 + (b) * 2 + (h)) * HTB)
#define PG8_STAGE_B(bufoff, gbase) do { _Pragma("unroll") for (int _i = 0; _i < 2; ++_i) \
        __builtin_amdgcn_global_load_lds((const unsigned*)((const char*)(gbase) + voffB[_i]), (LAS unsigned*)(lds + (bufoff) + ldsw + _i * 8192), 16, 0, 0); } while (0)
#define PG8_STAGE_A(bufoff, o0, o1, kb) do { \
        const char* gk_ = gA + (kb);      \
        __builtin_amdgcn_global_load_lds((const unsigned*)(gk_ + (o0)), (LAS unsigned*)(lds + (bufoff) + ldsw), 16, 0, 0); \
        __builtin_amdgcn_global_load_lds((const unsigned*)(gk_ + (o1)), (LAS unsigned*)(lds + (bufoff) + ldsw + 8192), 16, 0, 0); } while (0)
#define PG8_LDA(dst, b, h) do { _Pragma("unroll") for (int m = 0; m < 4; ++m) _Pragma("unroll") for (int k = 0; k < 2; ++k) dst[m][k] = *(const LAS bf16x8*)(lds + PG8_SA(b, h) + aoff + m * 2048 + k * 1024); } while (0)
#define PG8_LDB(dst, b, h) do { _Pragma("unroll") for (int n = 0; n < 2; ++n) _Pragma("unroll") for (int k = 0; k < 2; ++k) dst[n][k] = *(const LAS bf16x8*)(lds + PG8_SB(b, h) + boff + n * 2048 + k * 1024); } while (0)
#define PG8_MMA(ai, bj, At, Bt) do { __builtin_amdgcn_s_setprio(1); \
        if constexpr (Epi::F8) { _Pragma("unroll") for (int m = 0; m < 4; ++m) _Pragma("unroll") for (int n = 0; n < 2; ++n) { \
            const i32x8 a8_ = __builtin_shufflevector(__builtin_bit_cast(i32x4, At[m][0]), __builtin_bit_cast(i32x4, At[m][1]), 0, 1, 2, 3, 4, 5, 6, 7); \
            const i32x8 b8_ = __builtin_shufflevector(__builtin_bit_cast(i32x4, Bt[n][0]), __builtin_bit_cast(i32x4, Bt[n][1]), 0, 1, 2, 3, 4, 5, 6, 7); \
            acc[ai][bj][m][n] = __builtin_amdgcn_mfma_scale_f32_16x16x128_f8f6f4(b8_, a8_, acc[ai][bj][m][n], 0, 0, 0, MK_SCL, 0, MK_SCL); } } \
        else { _Pragma("unroll") for (int m = 0; m < 4; ++m) _Pragma("unroll") for (int n = 0; n < 2; ++n) _Pragma("unroll") for (int k = 0; k < 2; ++k) \
            acc[ai][bj][m][n] = __builtin_amdgcn_mfma_f32_16x16x32_bf16(Bt[n][k], At[m][k], acc[ai][bj][m][n], 0, 0, 0); } \
        __builtin_amdgcn_s_setprio(0); } while (0)
#define PG8_WAIT_V(n) asm volatile("s_waitcnt vmcnt(" #n ")" ::: "memory")
#define PG8_WAIT_L(n) asm volatile("s_waitcnt lgkmcnt(" #n ")" ::: "memory")
#define PG8_BAR __builtin_amdgcn_s_barrier()
#define PG8_SCHED __builtin_amdgcn_sched_barrier(0)
#define PG8_AOFFS(dst, u) do { int t_ = threadIdx.x; asm volatile("" : "+v"(t_));     \
        _Pragma("unroll") for (int _h = 0; _h < 2; ++_h) _Pragma("unroll") for (int _i = 0; _i < 2; ++_i) { int R_, C_; stage_rc(t_ * 16 + _i * 8192, R_, C_); \
        dst[_h][_i] = S.a_row(u, _h * HALF + R_) * ldab + (unsigned)C_ * 2u + S.a_koff(u); } } while (0)
    Unit cur, nxt; int ui = 0;
    if (!S.next(0, cur)) return;
    cur.s = 0;
    if constexpr (Epi::PREF) E.prefetch(cur, 0);
#ifdef MK_STAGGER
    if (S.o.nwg > 3 * S.o.G) {
        const unsigned long long t0_ = __builtin_amdgcn_s_memrealtime(); const unsigned long long d_ = (unsigned long long)((blockIdx.x >> 3) & 7) * MK_STAGGER;
        while (__builtin_amdgcn_s_memrealtime() - t0_ < d_) __builtin_amdgcn_s_sleep(4);
    }
#endif
    f32x4 acc[2][2][4][2];
#pragma unroll
    for (int a = 0; a < 2; ++a)
#pragma unroll
        for (int b = 0; b < 2; ++b)
#pragma unroll
            for (int m = 0; m < 4; ++m)
#pragma unroll
                for (int n = 0; n < 2; ++n) acc[a][b][m][n] = (f32x4){0.f, 0.f, 0.f, 0.f};
    bf16x8 At[4][2], B0[2][2], B1[2][2];
    unsigned oc[2][2];
    LAS u32x4* nslot = (LAS u32x4*)(lds + LDSCTL_OFF + 2048) + tid;
    PG8_AOFFS(oc, cur);
    const char* cB = S.b_base(cur);
    PG8_STAGE_B(PG8_SB(0, 0), cB); PG8_STAGE_B(PG8_SB(0, 1), cB + hstepB); PG8_STAGE_A(PG8_SA(0, 0), oc[0][0], oc[0][1], 0u); PG8_STAGE_A(PG8_SA(0, 1), oc[1][0], oc[1][1], 0u);
    if (wr == 1) PG8_BAR;
    PG8_WAIT_V(2); PG8_BAR;
    PG8_STAGE_B(PG8_SB(1, 0), cB + kstep); PG8_STAGE_A(PG8_SA(1, 0), oc[0][0], oc[0][1], kstep); PG8_STAGE_B(PG8_SB(1, 1), cB + hstepB + kstep);
    PG8_WAIT_V(6); PG8_BAR;
    for (;;) {
        const bool has_next = S.next(ui + 1, nxt);
        const char* nB = has_next ? S.b_base(nxt) : cB;
        if (has_next) { unsigned on[2][2]; PG8_AOFFS(on, nxt); *nslot = (u32x4){on[0][0], on[0][1], on[1][0], on[1][1]}; nxt.s = cur.s == 2 ? 0 : cur.s + 1;
            if constexpr (Epi::PREF) E.prefetch(nxt, nxt.s); }
        for (int t = 0; t < nt; t += 2) {
            const bool last = (t == nt - 2);
            const unsigned k1 = (unsigned)(t + 1) * kstep;
            const unsigned k2 = last ? 0u : (unsigned)(t + 2) * kstep, k3 = k2 + kstep;
            const char* b2 = last ? nB : cB + (size_t)(t + 2) * kstep; const char* b3 = b2 + kstep;
            PG8_LDB(B0, 0, 0); PG8_LDB(B1, 0, 1); PG8_SCHED; PG8_LDA(At, 0, 0); PG8_STAGE_A(PG8_SA(1, 1), oc[1][0], oc[1][1], k1);
            PG8_WAIT_V(8); PG8_WAIT_L(0); PG8_BAR; PG8_MMA(0, 0, At, B0); PG8_MMA(0, 1, At, B1); PG8_BAR; PG8_SCHED;
            if (last && has_next) { const u32x4 o_ = *nslot; oc[0][0] = o_.x; oc[0][1] = o_.y; oc[1][0] = o_.z; oc[1][1] = o_.w; }
            PG8_LDA(At, 0, 1); PG8_STAGE_B(PG8_SB(0, 0), b2); PG8_STAGE_B(PG8_SB(0, 1), b2 + hstepB); PG8_STAGE_A(PG8_SA(0, 0), oc[0][0], oc[0][1], k2);
            PG8_WAIT_V(8); PG8_WAIT_L(0); PG8_BAR; PG8_MMA(1, 0, At, B0); PG8_MMA(1, 1, At, B1); PG8_BAR; PG8_SCHED;
            PG8_LDB(B0, 1, 0); PG8_LDB(B1, 1, 1); PG8_SCHED; PG8_LDA(At, 1, 0); PG8_STAGE_A(PG8_SA(0, 1), oc[1][0], oc[1][1], k2);
            PG8_WAIT_V(8); PG8_WAIT_L(0); PG8_BAR; PG8_MMA(0, 0, At, B0); PG8_MMA(0, 1, At, B1); PG8_BAR; PG8_SCHED;
            PG8_LDA(At, 1, 1); PG8_STAGE_B(PG8_SB(1, 0), b3); PG8_STAGE_B(PG8_SB(1, 1), b3 + hstepB); PG8_STAGE_A(PG8_SA(1, 0), oc[0][0], oc[0][1], k3);
            PG8_WAIT_V(8); PG8_WAIT_L(0); PG8_BAR; PG8_MMA(1, 0, At, B0); PG8_MMA(1, 1, At, B1); PG8_BAR; PG8_SCHED;
        }
        if (wr == 0) PG8_BAR;
        bool carry = false;
        if constexpr (Epi::MIDK) { if (cur.e == 0) { E.mid(acc, cur, wr, wc, fr, fq); carry = true; } else E(acc, cur, wr, wc, fr, fq); } else E(acc, cur, wr, wc, fr, fq);
        if (!has_next) break;
        if (!carry)
#pragma unroll
        for (int a = 0; a < 2; ++a)
#pragma unroll
            for (int b = 0; b < 2; ++b)
#pragma unroll
                for (int m = 0; m < 4; ++m)
#pragma unroll
                    for (int n = 0; n < 2; ++n) acc[a][b][m][n] = (f32x4){0.f, 0.f, 0.f, 0.f};
        cur = nxt; cB = nB; ++ui;
        if (wr == 1) PG8_BAR;
    }
    PG8_WAIT_V(0);
    PG8_BAR;
#undef PG8_SA
#undef PG8_SB
#undef PG8_STAGE_A
#undef PG8_STAGE_B
#undef PG8_LDA
#undef PG8_LDB
#undef PG8_MMA
#undef PG8_WAIT_V
#undef PG8_WAIT_L
#undef PG8_BAR
#undef PG8_SCHED
#undef PG8_AOFFS
}

template <bool F8_> struct EpiProj {
    static constexpr bool PREF = false, PERM = true, MIDK = false, F8 = F8_;
    bf16_t* O; float* kmp;
    __device__ __forceinline__ void operator()(const f32x4 (&acc)[2][2][4][2], const Unit& u, int wr, int wc, int fr, int fq) const {
        const int row0 = u.pm * BM + wr * 64 + fr;
        const bool narrow = (u.pn < C_VA / BM) || (u.pn >= C_QB / BM && u.pn < C_GA / BM);
        const bool gate = u.pn >= C_GA / BM;
        const int hw = narrow ? 128 : 256; const size_t bjs = narrow ? (size_t)HALF * T : (size_t)HALF;
#pragma unroll
        for (int ai = 0; ai < 2; ++ai)
#pragma unroll
            for (int m = 0; m < 4; ++m) { bf16_t* rowp = O + PROJ_BLK(u.pn * BM) + (size_t)(row0 + ai * HALF + m * 16) * hw + wc * 32 + 8 * fq;
#pragma unroll
                for (int bj = 0; bj < 2; ++bj) { const float sc = F8 ? (1.0f / 32.0f) : 1.0f; const f32x4 v0 = acc[ai][bj][m][0] * sc, v1 = acc[ai][bj][m][1] * sc;
                    if (F8 && gate) { u32x2 w8; w8.x = pk4_fp8(v0[0], v0[1], v0[2], v0[3]); w8.y = pk4_fp8(v1[0], v1[1], v1[2], v1[3]);
                        __builtin_nontemporal_store(w8, (u32x2*)((unsigned char*)(O + PROJ_BLK(u.pn * BM)) + (size_t)(row0 + ai * HALF + m * 16) * 256 + bj * HALF + wc * 32 + 8 * fq)); continue; }
                    u32x4 w; w.x = cvt_pk_bf16(v0[0], v0[1]); w.y = cvt_pk_bf16(v0[2], v0[3]); w.z = cvt_pk_bf16(v1[0], v1[1]); w.w = cvt_pk_bf16(v1[2], v1[3]);
                    __builtin_nontemporal_store(w, (u32x4*)(rowp + bj * bjs)); } }
        if (u.pn >= C_KB / BM && u.pn < C_VB / BM) {
#pragma unroll
            for (int bj = 0; bj < 2; ++bj)
#pragma unroll
                for (int n = 0; n < 2; ++n) { f32x4 s = (f32x4){0.f, 0.f, 0.f, 0.f};
#pragma unroll
                    for (int ai = 0; ai < 2; ++ai)
#pragma unroll
                        for (int m = 0; m < 4; ++m) s += acc[ai][bj][m][n];
#pragma unroll
                    for (int o = 1; o < 16; o <<= 1) { s[0] += __shfl_xor(s[0], o); s[1] += __shfl_xor(s[1], o); s[2] += __shfl_xor(s[2], o); s[3] += __shfl_xor(s[3], o); }
                    if (fr == 0) *(f32x4*)(kmp + ((size_t)wr * 64 + u.pm) * 1024 + (u.pn - C_KB / BM) * BM + bj * HALF + wc * 32 + 8 * fq + 4 * n) = s * (F8 ? (1.0f / 32.0f) : 1.0f); }
        }
    }
};
struct EpiMerge {
    static constexpr bool PREF = false, PERM = true, MIDK = true, F8 = false;
    const bf16_t* proj; bf16_t* Y;
    __device__ __forceinline__ void mid(f32x4 (&acc)[2][2][4][2], const Unit& u, int wr, int wc, int fr, int fq) const {
        const int row0 = u.pm * BM + wr * 64 + fr; const int col0 = u.pn * BM + wc * 32 + 8 * fq;
#pragma unroll
        for (int ai = 0; ai < 2; ++ai) {
            u32x2 ga[4][2], gb[4][2];
#pragma unroll
            for (int m = 0; m < 4; ++m) { const unsigned char* rowp = (const unsigned char*)(proj + PROJ_BLK(u.pn * BM)) + (size_t)(row0 + ai * HALF + m * 16) * 256 + wc * 32 + 8 * fq;
#pragma unroll
                for (int bj = 0; bj < 2; ++bj) { ga[m][bj] = *(const u32x2*)(rowp + 2 * PROJ_BLK(C_GA) + bj * HALF); gb[m][bj] = *(const u32x2*)(rowp + 2 * PROJ_BLK(C_GB) + bj * HALF); } }
#pragma unroll
            for (int m = 0; m < 4; ++m) {
#pragma unroll
                for (int bj = 0; bj < 2; ++bj) {
#pragma unroll
                    for (int n = 0; n < 2; ++n) {
#define MG_R(b_) ((1.0f + __builtin_amdgcn_exp2f(-1.4426950408889634f * __builtin_amdgcn_cvt_f32_fp8((int)gb[m][bj][n], b_))) * __builtin_amdgcn_rcpf(1.0f + __builtin_amdgcn_exp2f(-1.4426950408889634f * __builtin_amdgcn_cvt_f32_fp8((int)ga[m][bj][n], b_))))
                        acc[ai][bj][m][n][0] *= MG_R(0); acc[ai][bj][m][n][1] *= MG_R(1); acc[ai][bj][m][n][2] *= MG_R(2); acc[ai][bj][m][n][3] *= MG_R(3);
#undef MG_R
                    } }
                asm volatile("" : "+v"(acc[ai][0][m][0]), "+v"(acc[ai][0][m][1]), "+v"(acc[ai][1][m][0]), "+v"(acc[ai][1][m][1])); }
            asm volatile("" ::: "memory"); }
    }
    __device__ __forceinline__ void operator()(const f32x4 (&acc)[2][2][4][2], const Unit& u, int wr, int wc, int fr, int fq) const {
        const int row0 = u.pm * BM + wr * 64 + fr; const int col0 = u.pn * BM + wc * 32 + 8 * fq;
#pragma unroll
        for (int ai = 0; ai < 2; ++ai) {
            u32x2 gb[4][2];
#pragma unroll
            for (int m = 0; m < 4; ++m)
#pragma unroll
                for (int bj = 0; bj < 2; ++bj) gb[m][bj] = *(const u32x2*)((const unsigned char*)(proj + PROJ_BLK(C_GB + u.pn * BM)) + (size_t)(row0 + ai * HALF + m * 16) * 256 + wc * 32 + 8 * fq + bj * HALF);
#pragma unroll
            for (int m = 0; m < 4; ++m) { const size_t r = (size_t)(row0 + ai * HALF + m * 16);
#pragma unroll
                for (int bj = 0; bj < 2; ++bj) { const u32x2 g = gb[m][bj];
                    const f32x4 v0 = acc[ai][bj][m][0], v1 = acc[ai][bj][m][1];
#define MG_S(w_, b_) fsigmoid(__builtin_amdgcn_cvt_f32_fp8((int)(w_), b_))
                    u32x4 w; w.x = cvt_pk_bf16(v0[0] * MG_S(g.x, 0), v0[1] * MG_S(g.x, 1)); w.y = cvt_pk_bf16(v0[2] * MG_S(g.x, 2), v0[3] * MG_S(g.x, 3));
                    w.z = cvt_pk_bf16(v1[0] * MG_S(g.y, 0), v1[1] * MG_S(g.y, 1)); w.w = cvt_pk_bf16(v1[2] * MG_S(g.y, 2), v1[3] * MG_S(g.y, 3));
#undef MG_S
                    *(u32x4*)(Y + r * D + col0 + bj * HALF) = w; } }
            asm volatile("" ::: "memory"); }
    }
};
struct EpiResF32 {
    static constexpr bool PREF = false, PERM = false, MIDK = false, F8 = false;
    const float* base; bf16_t* out;
    __device__ __forceinline__ void operator()(const f32x4 (&acc)[2][2][4][2], const Unit& u, int wr, int wc, int fr, int fq) const {
        const int row0 = u.pm * BM + wr * 64 + fr, col0 = u.pn * BM + wc * 32 + 4 * fq;
#pragma unroll
        for (int ai = 0; ai < 2; ++ai) {
            f32x4 bs[4][2][2];
#pragma unroll
            for (int m = 0; m < 4; ++m) { const size_t off = (size_t)(row0 + ai * HALF + m * 16) * D + col0;
#pragma unroll
                for (int bj = 0; bj < 2; ++bj)
#pragma unroll
                    for (int n = 0; n < 2; ++n) bs[m][bj][n] = __builtin_nontemporal_load((const f32x4*)(base + off + bj * HALF + n * 16)); }
#pragma unroll
            for (int m = 0; m < 4; ++m) { const size_t off = (size_t)(row0 + ai * HALF + m * 16) * D + col0;
#pragma unroll
                for (int bj = 0; bj < 2; ++bj)
#pragma unroll
                    for (int n = 0; n < 2; ++n) { const f32x4 v = bs[m][bj][n] + acc[ai][bj][m][n]; u32x2 w; w.x = cvt_pk_bf16(v[0], v[1]); w.y = cvt_pk_bf16(v[2], v[3]); *(u32x2*)(out + off + bj * HALF + n * 16) = w; } }
            asm volatile("" ::: "memory"); }
    }
};
struct EpiGlu {
    static constexpr bool PREF = true, PERM = true, MIDK = false, F8 = true;
    unsigned char* H; const float* rstd_e; const LAS int* tab; const float* bg; const float* bu; const float* zero; LAS unsigned char* lds;
    __device__ __forceinline__ void prefetch(const Unit& u, int slot) const {
        int tid = threadIdx.x; asm volatile("" : "+v"(tid)); const int wave = __builtin_amdgcn_readfirstlane(tid >> 6);
        const float* src;
        if (wave < 4) { const int lr = u.pm * BM + tid - tab[u.e]; src = lr < tab[64 + u.e] ? rstd_e + (size_t)u.e * T + lr : zero; }
        else { const int j = tid - 256; src = (j < 128 ? bg : bu) + (size_t)u.e * FF + u.pn * HALF + (j & 127); }
        __builtin_amdgcn_global_load_lds((const unsigned*)src, (LAS unsigned*)(lds + EPF_OFF + slot * 2048 + wave * 256), 4, 0, 0);
    }
    __device__ __forceinline__ void operator()(const f32x4 (&acc)[2][2][4][2], const Unit& u, int wr, int wc, int fr, int fq) const {
        const int row0 = u.pm * BM + wr * 64 + fr; const int colo = u.pn * HALF + wc * 32 + 8 * fq;
        const LAS float* ep = (const LAS float*)(lds + EPF_OFF + u.s * 2048);
        f32x4 g4[2], u4[2];
#pragma unroll
        for (int n = 0; n < 2; ++n) { g4[n] = *(const LAS f32x4*)(ep + 256 + wc * 32 + 8 * fq + 4 * n); u4[n] = *(const LAS f32x4*)(ep + 384 + wc * 32 + 8 * fq + 4 * n); }
        float rsv[2][4];
#pragma unroll
        for (int ai = 0; ai < 2; ++ai)
#pragma unroll
            for (int m = 0; m < 4; ++m) rsv[ai][m] = ep[wr * 64 + fr + ai * HALF + m * 16];
#pragma unroll
        for (int ai = 0; ai < 2; ++ai)
#pragma unroll
            for (int m = 0; m < 4; ++m) { const int r = row0 + ai * HALF + m * 16; const float rs = rsv[ai][m] * (1.0f / 32.0f);
                float o[8];
#pragma unroll
                for (int n = 0; n < 2; ++n)
#pragma unroll
                    for (int j = 0; j < 4; ++j) { float g = acc[ai][0][m][n][j] * rs + g4[n][j], up = acc[ai][1][m][n][j] * rs + u4[n][j];
                        g = fminf(g, 7.0f); up = fminf(fmaxf(up, -7.0f), 7.0f);
                        const float glu = g * fsigmoid(1.702f * g); o[n * 4 + j] = (up + 1.0f) * glu; }
                u32x2 w; w.x = pk4_fp8(o[0], o[1], o[2], o[3]); w.y = pk4_fp8(o[4], o[5], o[6], o[7]);
                *(u32x2*)(H + (size_t)r * FF + colo) = w; asm volatile("" ::: "memory"); }
    }
};
template <int ACT, bool HASBIAS, bool F8_ = false> struct EpiBf16 {
    static constexpr bool PREF = false, PERM = true, MIDK = false, F8 = F8_;
    bf16_t* O; int ldc; const float* bias; int bias_stride; float scale;
    __device__ __forceinline__ void operator()(const f32x4 (&acc)[2][2][4][2], const Unit& u, int wr, int wc, int fr, int fq) const {
        const int row0 = u.pm * BM + wr * 64 + fr; const int col0 = u.pn * BM + wc * 32 + 8 * fq;
        f32x4 bv[2][2];
#pragma unroll
        for (int bj = 0; bj < 2; ++bj)
#pragma unroll
            for (int n = 0; n < 2; ++n) bv[bj][n] = HASBIAS ? *(const f32x4*)(bias + (size_t)u.e * bias_stride + col0 + bj * HALF + 4 * n) : (f32x4){0.f, 0.f, 0.f, 0.f};
#pragma unroll
        for (int ai = 0; ai < 2; ++ai)
#pragma unroll
            for (int m = 0; m < 4; ++m) { bf16_t* rowp = O + (size_t)(row0 + ai * HALF + m * 16) * ldc + col0;
#pragma unroll
                for (int bj = 0; bj < 2; ++bj) { f32x4 v0 = acc[ai][bj][m][0] * scale + bv[bj][0], v1 = acc[ai][bj][m][1] * scale + bv[bj][1];
                    if (ACT == 1) {
#pragma unroll
                        for (int j = 0; j < 4; ++j) { v0[j] = fsigmoid(v0[j]); v1[j] = fsigmoid(v1[j]); } }
                    u32x4 w; w.x = cvt_pk_bf16(v0[0], v0[1]); w.y = cvt_pk_bf16(v0[2], v0[3]); w.z = cvt_pk_bf16(v1[0], v1[1]); w.w = cvt_pk_bf16(v1[2], v1[3]);
                    *(u32x4*)(rowp + bj * HALF) = w; }
                asm volatile("" ::: "memory"); }
    }
};
struct EpiDownF8 {
    static constexpr bool PREF = false, PERM = true, MIDK = false, F8 = true;
    unsigned char* O; const float* bias;
    __device__ __forceinline__ void operator()(const f32x4 (&acc)[2][2][4][2], const Unit& u, int wr, int wc, int fr, int fq) const {
        const int row0 = u.pm * BM + wr * 64 + fr; const int col0 = u.pn * BM + wc * 32 + 8 * fq;
        f32x4 bv[2][2];
#pragma unroll
        for (int bj = 0; bj < 2; ++bj)
#pragma unroll
            for (int n = 0; n < 2; ++n) bv[bj][n] = *(const f32x4*)(bias + (size_t)u.e * D + col0 + bj * HALF + 4 * n);
#pragma unroll
        for (int ai = 0; ai < 2; ++ai)
#pragma unroll
            for (int m = 0; m < 4; ++m) { unsigned char* rowp = O + (size_t)(row0 + ai * HALF + m * 16) * D + col0;
#pragma unroll
                for (int bj = 0; bj < 2; ++bj) { const f32x4 v0 = acc[ai][bj][m][0] * (1.0f / 32.0f) + bv[bj][0], v1 = acc[ai][bj][m][1] * (1.0f / 32.0f) + bv[bj][1];
                    u32x2 w; w.x = pk4_fp8(v0[0], v0[1], v0[2], v0[3]); w.y = pk4_fp8(v1[0], v1[1], v1[2], v1[3]);
                    *(u32x2*)(rowp + bj * HALF) = w; }
                asm volatile("" ::: "memory"); }
    }
};
}
__device__ __forceinline__ void transpose_item(const float* __restrict__ W, int ldw, int k0, int n_src0, bf16_t* __restrict__ WT, int ldo, int n_dst0, int k_off, LAS float* scr, int lane) {
    { float t_[32]; const float* wp_ = W + (size_t)(k0 + (lane >> 5)) * ldw + n_src0 + (lane & 31);
#pragma unroll
    for (int i = 0; i < 32; ++i) t_[i] = __builtin_nontemporal_load(wp_ + (size_t)(2 * i) * ldw);
#pragma unroll
    for (int i = 0; i < 32; ++i) scr[(2 * i + (lane >> 5)) * 33 + (lane & 31)] = t_[i]; }
    LDS_WAIT(); asm volatile("" ::: "memory");
    const int c = lane & 7;
#pragma unroll
    for (int j = 0; j < 4; ++j) { const int n = (lane >> 3) + 8 * j; const LAS float* s = scr + (8 * c) * 33 + n;
        u32x4 o; o.x = cvt_pk_bf16(s[0 * 33], s[1 * 33]); o.y = cvt_pk_bf16(s[2 * 33], s[3 * 33]); o.z = cvt_pk_bf16(s[4 * 33], s[5 * 33]); o.w = cvt_pk_bf16(s[6 * 33], s[7 * 33]);
        *(u32x4*)(WT + (size_t)(n_dst0 + n) * ldo + k_off + k0 + 8 * c) = o; }
    LDS_WAIT(); asm volatile("" ::: "memory");
}
__device__ __forceinline__ void transpose_item_f8(const float* __restrict__ W, int ldw, int k0, int n_src0, unsigned char* __restrict__ WT, int ldo, int n_dst0, float sc, LAS float* scr, int lane) {
    { float t_[32]; const float* wp_ = W + (size_t)(k0 + (lane >> 5)) * ldw + n_src0 + (lane & 31);
#pragma unroll
    for (int i = 0; i < 32; ++i) t_[i] = __builtin_nontemporal_load(wp_ + (size_t)(2 * i) * ldw);
#pragma unroll
    for (int i = 0; i < 32; ++i) scr[(2 * i + (lane >> 5)) * 33 + (lane & 31)] = t_[i]; }
    LDS_WAIT(); asm volatile("" ::: "memory");
    const int c = lane & 7;
#pragma unroll
    for (int j = 0; j < 4; ++j) { const int n = (lane >> 3) + 8 * j; const LAS float* s = scr + (8 * c) * 33 + n;
        u32x2 o; o.x = pk4_fp8(s[0 * 33] * sc, s[1 * 33] * sc, s[2 * 33] * sc, s[3 * 33] * sc); o.y = pk4_fp8(s[4 * 33] * sc, s[5 * 33] * sc, s[6 * 33] * sc, s[7 * 33] * sc);
        *(u32x2*)(WT + (size_t)(n_dst0 + n) * ldo + k0 + 8 * c) = o; }
    LDS_WAIT(); asm volatile("" ::: "memory");
}
__device__ __forceinline__ void transpose_mat_item(const float* W, int ldw, int N, int n_src_base, bf16_t* WT, int ldo, int n_dst_base, int k_off, LAS float* scr, int item, int lane) {
    const int nblk = N / 32, kb = item / nblk, nb = item % nblk;
    transpose_item(W, ldw, 64 * kb, n_src_base + 32 * nb, WT, ldo, n_dst_base + 32 * nb, k_off, scr, lane);
}

struct P {
    const float* in[25]; float* out; unsigned char* ws;
};

__device__ __forceinline__ void p0_prologue(const P& a, LAS unsigned char* lds, int vcu, int G, int wave, int lane) {
    LAS float* scr = (LAS float*)(lds + wave * 16384);
    const int gw = vcu * NWAVES + wave, NGW = G * NWAVES;
    unsigned char* ws = a.ws;
    bf16_t* WinT = (bf16_t*)(ws + WS_WIN); bf16_t* WupT = (bf16_t*)(ws + WS_WUP); bf16_t* WoT = (bf16_t*)(ws + WS_WO); bf16_t* WpgT = (bf16_t*)(ws + WS_WPG); bf16_t* WppT = (bf16_t*)(ws + WS_WPP);
    constexpr int I_A = 16 * 96, I_B8 = 16 * 160, I_B = 0, I_S = 16 * 32, I_P = 4 * 32;
    constexpr int NITEMS = I_A + I_B8 + I_B + 4 * I_S + I_P;
#ifndef P0_PARTS
#define P0_PARTS 63
#endif
    if (P0_PARTS & 1)
    for (int it = gw; it < NITEMS; it += NGW) {
        int r = it;
        if (r < I_A) { transpose_mat_item(a.in[4], D_IN, 3072, 0, WinT, D, 0, 0, scr, r, lane); continue; } r -= I_A;
        if (r < I_B8) { const int kb = r / 160, nb = r % 160; transpose_item_f8(a.in[4], D_IN, 64 * kb, 3088 + 32 * nb, ws + WS_WIN8, D, 32 * nb, 32.0f, scr, lane); continue; } r -= I_B8;
        if (r < I_S) { transpose_mat_item(a.in[8], D, D, 0, WupT, 2048, 0, 0, scr, r, lane); continue; } r -= I_S;
        if (r < I_S) { transpose_mat_item(a.in[9], D, D, 0, WupT, 2048, 0, 1024, scr, r, lane); continue; } r -= I_S;
        if (r < I_S) { transpose_mat_item(a.in[10], D, D, 0, WoT, D, 0, 0, scr, r, lane); continue; } r -= I_S;
        if (r < I_S) { const int kb = r / 32, nb = r % 32; transpose_item_f8(a.in[21], D, 64 * kb, 32 * nb, (unsigned char*)WpgT, D, 32 * nb, 32.0f, scr, lane); continue; } r -= I_S;
        transpose_mat_item(a.in[22], D, D, 0, WppT, 256, 0, 0, scr, r, lane);
    }
    if (P0_PARTS & 2) {
        const float* x = a.in[0]; const float* g = a.in[3]; bf16_t* H = (bf16_t*)(ws + WS_H);
        f32x4 gv[4];
#pragma unroll
        for (int j = 0; j < 4; ++j) gv[j] = *((const f32x4*)g + lane + 64 * j);
        f32x4 va[4], vb[4];
#define H_LOAD(m_, V) do { if ((m_) < T) { const f32x4* xr = (const f32x4*)(x + (size_t)(m_) * D) + lane; _Pragma("unroll") for (int j = 0; j < 4; ++j) V[j] = __builtin_nontemporal_load(xr + 64 * j); } } while (0)
#define H_DO(m_, V) do { if ((m_) < T) { float s_ = 0.f; \
            _Pragma("unroll") for (int j = 0; j < 4; ++j) s_ += (V[j].x * V[j].x + V[j].y * V[j].y) + (V[j].z * V[j].z + V[j].w * V[j].w); \
            const float rstd = 1.0f / sqrtf(wave_sum(s_) * (1.0f / D) + EPS); \
            u32x2* o8 = (u32x2*)(H + (size_t)(m_) * D) + lane; unsigned* q8 = (unsigned*)(ws + WS_H8 + (size_t)(m_) * D) + lane; \
            _Pragma("unroll") for (int j = 0; j < 4; ++j) { const f32x4 y = V[j] * rstd * gv[j]; u32x2 w; w.x = cvt_pk_bf16(y.x, y.y); w.y = cvt_pk_bf16(y.z, y.w); o8[64 * j] = w; q8[64 * j] = pk4_fp8(y.x, y.y, y.z, y.w); } } } while (0)
        H_LOAD(gw, va);
        for (int m = gw; m < T; m += 2 * NGW) { H_LOAD(m + NGW, vb); H_DO(m, va); H_LOAD(m + 2 * NGW, va); H_DO(m + NGW, vb); }
#undef H_LOAD
#undef H_DO
    }
    if (P0_PARTS & 4) {
        const f32x4* p4 = (const f32x4*)a.in[1]; u32x2* pb = (u32x2*)(ws + WS_PB);
        const size_t n4 = (size_t)T * 256 / 4;
        for (size_t i = (size_t)gw * 64 + lane; i < n4; i += (size_t)NGW * 64) { const f32x4 v = __builtin_nontemporal_load(p4 + i); u32x2 w; w.x = cvt_pk_bf16(v.x, v.y); w.y = cvt_pk_bf16(v.z, v.w); pb[i] = w; }
    }
    if (P0_PARTS & 8) {
        const int gt = (vcu * NWAVES + wave) * 64 + lane;
        if ((P0_PARTS & 16) && gt < 16 * 1024) { const int n = gt >> 10, k = gt & 1023; ((bf16_t*)(ws + WS_WALT))[n * 1024 + k] = (bf16_t)(cvt_pk_bf16(a.in[4][(size_t)k * D_IN + SRC_ALOW + n], 0.f) & 0xffffu); }
        if ((P0_PARTS & 32) && gt < 4096) { const int s = gt >> 6, l = gt & 63, e = l & 31, hh = l >> 5; const float* wr = a.in[12];
            float v[8], lo[8];
#pragma unroll
            for (int j = 0; j < 8; ++j) { v[j] = wr[(size_t)(16 * s + 8 * hh + j) * NE + e]; }
            u32x4 whi; whi.x = cvt_pk_bf16(v[0], v[1]); whi.y = cvt_pk_bf16(v[2], v[3]); whi.z = cvt_pk_bf16(v[4], v[5]); whi.w = cvt_pk_bf16(v[6], v[7]);
#pragma unroll
            for (int j = 0; j < 4; ++j) { lo[2 * j] = v[2 * j] - bflo(whi[j]); lo[2 * j + 1] = v[2 * j + 1] - bfhi(whi[j]); }
            u32x4 wlo; wlo.x = cvt_pk_bf16(lo[0], lo[1]); wlo.y = cvt_pk_bf16(lo[2], lo[3]); wlo.z = cvt_pk_bf16(lo[4], lo[5]); wlo.w = cvt_pk_bf16(lo[6], lo[7]);
            u32x4* f = (u32x4*)(ws + WS_WRF); f[gt] = whi; f[4096 + gt] = wlo; }
    }
}

struct CvtItem { const float* src; unsigned char* dst; int ldo; };
__device__ __forceinline__ CvtItem cvt_item(const P& a, int it, int lane) {
    constexpr int IPM = 16 * 32;
    const int e = it / (3 * IPM), r0 = it % (3 * IPM), which = r0 / IPM, r = r0 % IPM, kb = r / 32, nb = r % 32, n0 = 32 * nb;
    CvtItem c;
    if (which < 2) { c.src = a.in[which == 0 ? 14 : 16] + (size_t)e * D * FF + (size_t)(64 * kb + (lane >> 5)) * FF + n0 + (lane & 31);
        c.dst = (unsigned char*)a.out + ((size_t)e * 2048 + (n0 >> 7) * 256 + (n0 & 127) + which * 128) * D + 64 * kb; c.ldo = D; }
    else { c.src = a.in[18] + (size_t)e * FF * D + (size_t)(64 * kb + (lane >> 5)) * D + n0 + (lane & 31);
        c.dst = a.ws + WS_W2T + ((size_t)e * D + n0) * FF + 64 * kb; c.ldo = FF; }
    return c;
}
__device__ __forceinline__ void expert_convert(const P& a, LAS unsigned char* lds, int vcu, int G, int wave, int lane) {
    LAS float* scr = (LAS float*)(lds + wave * 16384);
    const int gw = vcu * NWAVES + wave, NGW = G * NWAVES;
    constexpr int NIT = NE * 3 * 16 * 32;
    if (gw >= NIT) return;
    float tA[32], tB[32], tC[32];
    CvtItem cA = cvt_item(a, gw, lane), cB = cvt_item(a, gw + NGW < NIT ? gw + NGW : gw, lane), cC = cvt_item(a, gw + 2 * NGW < NIT ? gw + 2 * NGW : gw, lane);
#pragma unroll
    for (int i = 0; i < 32; ++i) tA[i] = __builtin_nontemporal_load(cA.src + (size_t)(2 * i) * 1024);
#pragma unroll
    for (int i = 0; i < 32; ++i) tB[i] = __builtin_nontemporal_load(cB.src + (size_t)(2 * i) * 1024);
#pragma unroll
    for (int i = 0; i < 32; ++i) tC[i] = __builtin_nontemporal_load(cC.src + (size_t)(2 * i) * 1024);
#define CVT_OUT(c_) do { LDS_WAIT(); asm volatile("" ::: "memory"); const int c = lane & 7; \
        _Pragma("unroll") for (int j = 0; j < 4; ++j) { const int n = (lane >> 3) + 8 * j; const LAS float* s = scr + (8 * c) * 33 + n; \
            u32x2 o; o.x = pk4_fp8(s[0 * 33] * 32.0f, s[1 * 33] * 32.0f, s[2 * 33] * 32.0f, s[3 * 33] * 32.0f); o.y = pk4_fp8(s[4 * 33] * 32.0f, s[5 * 33] * 32.0f, s[6 * 33] * 32.0f, s[7 * 33] * 32.0f); \
            __builtin_nontemporal_store(o, (u32x2*)((c_).dst + (size_t)n * (c_).ldo + 8 * c)); } \
        LDS_WAIT(); asm volatile("" ::: "memory"); } while (0)
#define CVT_STEP(TT, CC, cur) do { \
        _Pragma("unroll") for (int i = 0; i < 32; ++i) scr[(2 * i + (lane >> 5)) * 33 + (lane & 31)] = TT[i]; \
        const CvtItem d_ = CC; const int nx_ = (cur) + 3 * NGW; \
        if (nx_ < NIT) { CC = cvt_item(a, nx_, lane); _Pragma("unroll") for (int i = 0; i < 32; ++i) TT[i] = __builtin_nontemporal_load(CC.src + (size_t)(2 * i) * 1024); } \
        CVT_OUT(d_); } while (0)
    for (int it = gw; it < NIT; it += 3 * NGW) {
        CVT_STEP(tA, cA, it);
        if (it + NGW >= NIT) break;
        CVT_STEP(tB, cB, it + NGW);
        if (it + 2 * NGW >= NIT) break;
        CVT_STEP(tC, cC, it + 2 * NGW);
    }
#undef CVT_STEP
#undef CVT_OUT
}

__device__ __forceinline__ float fexp_(float x) { return __builtin_amdgcn_exp2f(x * 1.4426950408889634f); }
__device__ __forceinline__ float logsigmoidf_(float x) { const float e = fexp_(-fabsf(x)); return fminf(x, 0.0f) - 0.6931471805599453f * __builtin_amdgcn_logf(1.0f + e); }
__device__ __forceinline__ void gla_prep_unit(const P& a, LAS unsigned char* lds, int unit) {
    int tid = threadIdx.x; asm volatile("" : "+v"(tid));     const int wave = __builtin_amdgcn_readfirstlane(tid >> 6), lane = tid & 63;
    const int b = unit >> 5, chunk = unit & 31, tok0 = b * SEQ + chunk * 64;
    const bf16_t* H = (const bf16_t*)(a.ws + WS_H); const bf16_t* WalT = (const bf16_t*)(a.ws + WS_WALT); const bf16_t* proj = (const bf16_t*)(a.ws + WS_PROJ);
    LAS float* part = (LAS float*)lds;
    LAS float* alow = (LAS float*)(lds + 8192);
    LAS float* seg = (LAS float*)(lds + 12288);
    constexpr int GP_KDT = 16384, GP_VT = 34816;
    {
        const int rg = wave & 3, kh = wave >> 2, r = lane & 15, q = lane >> 4;
        f32x4 acc = (f32x4){0.f, 0.f, 0.f, 0.f};
        const bf16_t* ap = H + (size_t)(tok0 + 16 * rg + r) * D + 512 * kh + 8 * q; const bf16_t* bp = WalT + (size_t)r * D + 512 * kh + 8 * q;
#pragma unroll 8
        for (int s = 0; s < 16; ++s) { const bf16x8 av = *(const bf16x8*)(ap + 32 * s), bv = *(const bf16x8*)(bp + 32 * s); acc = __builtin_amdgcn_mfma_f32_16x16x32_bf16(bv, av, acc, 0, 0, 0); }
        *(LAS f32x4*)(part + (kh * 64 + 16 * rg + r) * 16 + 4 * q) = acc;
    }
    __syncthreads();
    if (tid < 256) { *(LAS f32x4*)(alow + tid * 4) = *(LAS f32x4*)(part + tid * 4) + *(LAS f32x4*)(part + 1024 + tid * 4); }
    __syncthreads();
    const int dp = tid & 63, tq = wave;
    const float* w_a2 = a.in[5]; const float* b_a2 = a.in[6];
    const int ep = tid & 127, sq4 = tid >> 7;
    f32x2 w2[16], w2n[16]; f32x2 b2, b2n; unsigned qv[8], kv[8], qvn[8], kvn[8], sv[16], svn[16];
#define GP_LOADS(h_, W2, B2, QV, KV, SV) do { const int dc_ = (h_) * 128 + 2 * dp; \
        _Pragma("unroll") for (int r = 0; r < 16; ++r) W2[r] = *(const f32x2*)(w_a2 + r * 512 + dc_); \
        B2 = *(const f32x2*)(b_a2 + dc_); \
        _Pragma("unroll") for (int i = 0; i < 8; ++i) { const bf16_t* rp = proj + PROJ_BLK((h_) * 128) + (size_t)(tok0 + 8 * tq + i) * 128 + 2 * dp; QV[i] = __builtin_nontemporal_load((const unsigned*)(rp + PROJ_BLK(C_QA))); KV[i] = __builtin_nontemporal_load((const unsigned*)(rp + PROJ_BLK(C_KA))); } \
        const bf16_t* v_ = proj + PROJ_BLK(C_VA + (h_) * 256) + (size_t)(tok0 + 16 * sq4) * 256 + 2 * ep; \
        _Pragma("unroll") for (int i = 0; i < 16; ++i) SV[i] = __builtin_nontemporal_load((const unsigned*)(v_ + (size_t)i * 256)); } while (0)
    GP_LOADS(0, w2, b2, qv, kv, sv);
    for (int h = 0; h < 4; ++h) {
        if (h + 1 < 4) GP_LOADS(h + 1, w2n, b2n, qvn, kvn, svn);
        float G0[8], G1[8]; float r0 = 0.f, r1 = 0.f;
#pragma unroll
        for (int i = 0; i < 8; ++i) { const LAS f32x4* al4 = (const LAS f32x4*)(alow + (8 * tq + i) * 16); float x0 = b2.x, x1 = b2.y;
#pragma unroll
            for (int r4 = 0; r4 < 4; ++r4) { const f32x4 al = al4[r4];
#pragma unroll
                for (int j = 0; j < 4; ++j) { x0 += al[j] * w2[4 * r4 + j].x; x1 += al[j] * w2[4 * r4 + j].y; } }
            r0 += logsigmoidf_(x0) * (1.0f / 16.0f); r1 += logsigmoidf_(x1) * (1.0f / 16.0f); G0[i] = r0; G1[i] = r1; }
        *(LAS f32x2*)(seg + tq * 128 + 2 * dp) = (f32x2){r0, r1};
        __syncthreads();
        float off0 = 0.f, off1 = 0.f, tot0 = 0.f, tot1 = 0.f;
#pragma unroll
        for (int q = 0; q < 8; ++q) { const f32x2 s = *(LAS f32x2*)(seg + q * 128 + 2 * dp); tot0 += s.x; tot1 += s.y; if (q < tq) { off0 += s.x; off1 += s.y; } }
        const size_t tile = (size_t)((b * 4 + h) * 32 + chunk);
        bf16_t* Qg = (bf16_t*)(a.ws + WS_QG) + tile * 8192; bf16_t* Kg = (bf16_t*)(a.ws + WS_KG) + tile * 8192;
        float kd0[8], kd1[8];
#pragma unroll
        for (int i = 0; i < 8; ++i) { const float g0 = G0[i] + off0, g1 = G1[i] + off1; const float q0 = bflo(qv[i]), q1 = bfhi(qv[i]), k0 = bflo(kv[i]), k1 = bfhi(kv[i]);
            const float e0 = fexp_(g0), e1 = fexp_(g1);
            *(unsigned*)(Qg + (8 * tq + i) * 128 + 2 * dp) = cvt_pk_bf16(q0 * e0 * 0.08838834764831845f, q1 * e1 * 0.08838834764831845f);
            *(unsigned*)(Kg + (8 * tq + i) * 128 + 2 * dp) = cvt_pk_bf16(k0 * __builtin_amdgcn_rcpf(e0), k1 * __builtin_amdgcn_rcpf(e1));
            kd0[i] = k0 * fexp_(tot0 - g0); kd1[i] = k1 * fexp_(tot1 - g1); }
        u32x4 w0, w1; w0.x = cvt_pk_bf16(kd0[0], kd0[1]); w0.y = cvt_pk_bf16(kd0[2], kd0[3]); w0.z = cvt_pk_bf16(kd0[4], kd0[5]); w0.w = cvt_pk_bf16(kd0[6], kd0[7]);
        w1.x = cvt_pk_bf16(kd1[0], kd1[1]); w1.y = cvt_pk_bf16(kd1[2], kd1[3]); w1.z = cvt_pk_bf16(kd1[4], kd1[5]); w1.w = cvt_pk_bf16(kd1[6], kd1[7]);
        *(LAS u32x4*)(lds + GP_KDT + (2 * dp) * 144 + 16 * tq) = w0; *(LAS u32x4*)(lds + GP_KDT + (2 * dp + 1) * 144 + 16 * tq) = w1;
        if (tq == 0) *(f32x2*)((float*)(a.ws + WS_DEC) + tile * 128 + 2 * dp) = (f32x2){fexp_(tot0), fexp_(tot1)};
        {
            u32x4 lo0, lo1, hi0, hi1;
#pragma unroll
            for (int j = 0; j < 4; ++j) { lo0[j] = (sv[2 * j] & 0xffffu) | (sv[2 * j + 1] << 16); lo1[j] = (sv[8 + 2 * j] & 0xffffu) | (sv[8 + 2 * j + 1] << 16);
                hi0[j] = (sv[2 * j] >> 16) | (sv[2 * j + 1] & 0xffff0000u); hi1[j] = (sv[8 + 2 * j] >> 16) | (sv[8 + 2 * j + 1] & 0xffff0000u); }
            LAS unsigned char* v0 = lds + GP_VT + (2 * ep) * 144 + sq4 * 32;
            *(LAS u32x4*)(v0) = lo0; *(LAS u32x4*)(v0 + 16) = lo1; *(LAS u32x4*)(v0 + 144) = hi0; *(LAS u32x4*)(v0 + 144 + 16) = hi1;
        }
        __syncthreads();
        {
            const int c32 = lane & 31, hi = lane >> 5;
            bf16x8 vt[4];
#pragma unroll
            for (int ks = 0; ks < 4; ++ks) vt[ks] = *(const LAS bf16x8*)(lds + GP_VT + (32 * wave + c32) * 144 + (16 * ks + 8 * hi) * 2);
            unsigned* sl = (unsigned*)a.out + tile * 8192;
#pragma unroll
            for (int tl = 0; tl < 4; ++tl) { f32x16 acc;
#pragma unroll
                for (int r = 0; r < 16; ++r) acc[r] = 0.f;
#pragma unroll
                for (int ks = 0; ks < 4; ++ks) { const bf16x8 av = *(const LAS bf16x8*)(lds + GP_KDT + (32 * tl + c32) * 144 + (16 * ks + 8 * hi) * 2); acc = __builtin_amdgcn_mfma_f32_32x32x16_bf16(av, vt[ks], acc, 0, 0, 0); }
#pragma unroll
                for (int g = 0; g < 4; ++g) sl[((tl * 4 + g) * 2 + hi) * 256 + 32 * wave + c32] = pk4_fp8(acc[4 * g], acc[4 * g + 1], acc[4 * g + 2], acc[4 * g + 3]); }
        }
        __syncthreads();
#pragma unroll
        for (int r = 0; r < 16; ++r) { w2[r] = w2n[r]; sv[r] = svn[r]; }
#pragma unroll
        for (int i = 0; i < 8; ++i) { qv[i] = qvn[i]; kv[i] = kvn[i]; }
        b2 = b2n;
    }
#undef GP_LOADS
}

__device__ __forceinline__ void gla_combine_unit(const P& a, int unit) {
    const int tid = threadIdx.x, bh = unit >> 4, i8 = (unit & 15) * 512 + tid;
    const int d0 = 32 * (i8 >> 11) + 8 * ((i8 >> 9) & 3) + 4 * ((i8 >> 8) & 1);
    const unsigned* sl8 = (const unsigned*)a.out + (size_t)bh * 32 * 8192 + i8; u32x2* sl = (u32x2*)(a.ws + WS_SLOC) + (size_t)bh * 32 * 8192 + i8;
    const f32x4* dc = (const f32x4*)((const float*)(a.ws + WS_DEC) + (size_t)bh * 32 * 128 + d0);
    f32x4 s = (f32x4){0.f, 0.f, 0.f, 0.f};
    for (int cb = 0; cb < 32; cb += 8) {
        unsigned loc[8]; f32x4 dv[8];
#pragma unroll
        for (int i = 0; i < 8; ++i) { loc[i] = __builtin_nontemporal_load(sl8 + (size_t)(cb + i) * 8192); dv[i] = dc[(cb + i) * 32]; }
#pragma unroll
        for (int i = 0; i < 8; ++i) { if (cb + i < 31) {
            s.x = dv[i].x * s.x + __builtin_amdgcn_cvt_f32_fp8((int)loc[i], 0); s.y = dv[i].y * s.y + __builtin_amdgcn_cvt_f32_fp8((int)loc[i], 1);
            s.z = dv[i].z * s.z + __builtin_amdgcn_cvt_f32_fp8((int)loc[i], 2); s.w = dv[i].w * s.w + __builtin_amdgcn_cvt_f32_fp8((int)loc[i], 3);
            u32x2 w; w.x = cvt_pk_bf16(s.x, s.y); w.y = cvt_pk_bf16(s.z, s.w); sl[(size_t)(cb + i) * 8192] = w; } }
    }
}

constexpr int GL_QG = 0, GL_KG = 17408, GL_VT = 53248, GL_AM = 90112, GL_OST = 0;
constexpr int GL_QS = 272, GL_TS = 144, GL_OS = 528;
__device__ __forceinline__ int crow(int r, int hi) { return (r & 3) + 8 * (r >> 2) + 4 * hi; }
__device__ __forceinline__ void gla_out_unit(const P& a, LAS unsigned char* lds, int unit) {
    int tid = threadIdx.x; asm volatile("" : "+v"(tid)); const int w = __builtin_amdgcn_readfirstlane(tid >> 6), lane = tid & 63, c32 = lane & 31, hi = lane >> 5;
    const int bh = unit >> 5, chunk = unit & 31, b = bh >> 2, h = bh & 3;
    const bf16_t* proj = (const bf16_t*)(a.ws + WS_PROJ); bf16_t* oab = (bf16_t*)(a.ws + WS_OAB); const float* ggo = a.in[7];
    const size_t tile = (size_t)bh * 32 + chunk;
    {
        const u32x4* q_ = (const u32x4*)((const bf16_t*)(a.ws + WS_QG) + tile * 8192); const u32x4* k_ = (const u32x4*)((const bf16_t*)(a.ws + WS_KG) + tile * 8192);
        u32x4 sq[2], sk[2]; unsigned sv[16];
        sq[0] = __builtin_nontemporal_load(q_ + tid); sq[1] = __builtin_nontemporal_load(q_ + tid + 512); sk[0] = __builtin_nontemporal_load(k_ + tid); sk[1] = __builtin_nontemporal_load(k_ + tid + 512);
        const int ep = tid & 127, sq4 = tid >> 7;
        const bf16_t* v_ = proj + PROJ_BLK(C_VA + h * 256) + (size_t)(b * SEQ + chunk * 64 + 16 * sq4) * 256 + 2 * ep;
#pragma unroll
        for (int i = 0; i < 16; ++i) sv[i] = __builtin_nontemporal_load((const unsigned*)(v_ + (size_t)i * 256));
#pragma unroll
        for (int i = 0; i < 2; ++i) { const int p = tid + 512 * i;
            *(LAS u32x4*)(lds + GL_QG + (p >> 4) * GL_QS + (p & 15) * 16) = sq[i]; *(LAS u32x4*)(lds + GL_KG + (p >> 4) * GL_QS + (p & 15) * 16) = sk[i]; }
        u32x4 lo0, lo1, hi0, hi1;
#pragma unroll
        for (int j = 0; j < 4; ++j) { lo0[j] = (sv[2 * j] & 0xffffu) | (sv[2 * j + 1] << 16); lo1[j] = (sv[8 + 2 * j] & 0xffffu) | (sv[8 + 2 * j + 1] << 16);
            hi0[j] = (sv[2 * j] >> 16) | (sv[2 * j + 1] & 0xffff0000u); hi1[j] = (sv[8 + 2 * j] >> 16) | (sv[8 + 2 * j + 1] & 0xffff0000u); }
        LAS unsigned char* v0 = lds + GL_VT + (2 * ep) * GL_TS + sq4 * 32;
        *(LAS u32x4*)(v0) = lo0; *(LAS u32x4*)(v0 + 16) = lo1; *(LAS u32x4*)(v0 + GL_TS) = hi0; *(LAS u32x4*)(v0 + GL_TS + 16) = hi1;
    }
    u32x2 sf[4][2][2];
    if (chunk > 0) { const u32x2* sl = (const u32x2*)(a.ws + WS_SLOC) + (tile - 1) * 8192;
#pragma unroll
        for (int tl = 0; tl < 4; ++tl)
#pragma unroll
            for (int s = 0; s < 2; ++s)
#pragma unroll
                for (int q = 0; q < 2; ++q) sf[tl][s][q] = __builtin_nontemporal_load(sl + ((tl * 4 + 2 * s + q) * 2 + hi) * 256 + 32 * w + c32); }
    __syncthreads();
    if (w < 3) {
        const int ti = (w + 1) >> 1, si = w >> 1;
        f32x16 A;
#pragma unroll
        for (int r = 0; r < 16; ++r) A[r] = 0.f;
#pragma unroll
        for (int s = 0; s < 8; ++s) { const bf16x8 av = *(const LAS bf16x8*)(lds + GL_QG + (32 * ti + c32) * GL_QS + (16 * s + 8 * hi) * 2), bv = *(const LAS bf16x8*)(lds + GL_KG + (32 * si + c32) * GL_QS + (16 * s + 8 * hi) * 2);
            A = __builtin_amdgcn_mfma_f32_32x32x16_bf16(av, bv, A, 0, 0, 0); }
        const int sidx = 32 * si + c32;
#pragma unroll
        for (int r = 0; r < 16; ++r) { const int t = 32 * ti + crow(r, hi); const float v = (sidx <= t) ? A[r] : 0.f;
            *(LAS bf16_t*)(lds + GL_AM + t * GL_TS + sidx * 2) = (bf16_t)(cvt_pk_bf16(v, 0.f) & 0xffffu); }
    }
    __syncthreads();
    f32x16 o[2];
    {
        bf16x8 vt[4];
#pragma unroll
        for (int ks = 0; ks < 4; ++ks) vt[ks] = *(const LAS bf16x8*)(lds + GL_VT + (32 * w + c32) * GL_TS + (16 * ks + 8 * hi) * 2);
#pragma unroll
        for (int ti = 0; ti < 2; ++ti) {
#pragma unroll
            for (int r = 0; r < 16; ++r) o[ti][r] = 0.f;
            if (chunk > 0) {
#pragma unroll
                for (int tl = 0; tl < 4; ++tl)
#pragma unroll
                    for (int s = 0; s < 2; ++s) { const LAS unsigned char* qp = lds + GL_QG + (32 * ti + c32) * GL_QS + (32 * tl + 16 * s + 4 * hi) * 2;
                        const s16x4 lo = *(const LAS s16x4*)qp, hh = *(const LAS s16x4*)(qp + 16);
                        const bf16x8 aop = __builtin_shufflevector(lo, hh, 0, 1, 2, 3, 4, 5, 6, 7);
                        const u32x4 bw = {sf[tl][s][0].x, sf[tl][s][0].y, sf[tl][s][1].x, sf[tl][s][1].y};
                        o[ti] = __builtin_amdgcn_mfma_f32_32x32x16_bf16(aop, __builtin_bit_cast(bf16x8, bw), o[ti], 0, 0, 0); }
            }
#pragma unroll
            for (int ks = 0; ks < 4; ++ks) { if (ti == 0 && ks >= 2) continue;
                const bf16x8 av = *(const LAS bf16x8*)(lds + GL_AM + (32 * ti + c32) * GL_TS + (16 * ks + 8 * hi) * 2);
                o[ti] = __builtin_amdgcn_mfma_f32_32x32x16_bf16(av, vt[ks], o[ti], 0, 0, 0); }
        }
    }
    __syncthreads();
#pragma unroll
    for (int ti = 0; ti < 2; ++ti)
#pragma unroll
        for (int r = 0; r < 16; ++r) *(LAS bf16_t*)(lds + GL_OST + (32 * ti + crow(r, hi)) * GL_OS + (32 * w + c32) * 2) = (bf16_t)(cvt_pk_bf16(o[ti][r], 0.f) & 0xffffu);
    __syncthreads();
    {
        const int t = tid >> 3, sg = tid & 7; const size_t tok = (size_t)(b * SEQ + chunk * 64 + t);
        u32x4 ov[4]; float ss = 0.f;
#pragma unroll
        for (int j = 0; j < 4; ++j) { ov[j] = *(const LAS u32x4*)(lds + GL_OST + t * GL_OS + sg * 64 + j * 16);
#pragma unroll
            for (int i = 0; i < 4; ++i) { const float x0 = bflo(ov[j][i]), x1 = bfhi(ov[j][i]); ss += x0 * x0 + x1 * x1; } }
        ss += __shfl_xor(ss, 1); ss += __shfl_xor(ss, 2); ss += __shfl_xor(ss, 4);
        const float rstd = 1.0f / sqrtf(ss * (1.0f / 256.0f) + EPS);
        const bf16_t* rap = proj + PROJ_BLK(C_RA + h * 256) + tok * 256 + sg * 32; bf16_t* op = oab + tok * 2048 + h * 256 + sg * 32; const float* gp = ggo + sg * 32;
#pragma unroll
        for (int j = 0; j < 4; ++j) { const u32x4 ra = __builtin_nontemporal_load((const u32x4*)(rap + 8 * j)); const f32x4 g0 = *(const f32x4*)(gp + 8 * j), g1 = *(const f32x4*)(gp + 8 * j + 4); u32x4 wv;
#pragma unroll
            for (int i = 0; i < 4; ++i) { const float r0 = bflo(ra[i]), r1 = bfhi(ra[i]); const float ga = (i < 2) ? g0[2 * i] : g1[2 * i - 4], gb = (i < 2) ? g0[2 * i + 1] : g1[2 * i - 3];
                wv[i] = cvt_pk_bf16(bflo(ov[j][i]) * rstd * ga * (r0 * fsigmoid(r0)), bfhi(ov[j][i]) * rstd * gb * (r1 * fsigmoid(r1))); }
            *(u32x4*)(op + 8 * j) = wv; }
    }
    __syncthreads();
}
namespace moba {
constexpr int HD = 128;
constexpr float SCALE = 0.08838834764831845f;
constexpr float THR = 8.f;
constexpr int NW = 8, QBLK = 32, KVBLK = 64, QB = NW * QBLK;
constexpr int SHM_V = KVBLK * HD * 2, SHM_K = KVBLK * HD * 2;
constexpr int OFF_WS = 2 * SHM_V + 2 * SHM_K;
constexpr int OFF_RTAB = OFF_WS + NW * 64 * 4;
constexpr int OFF_KM = OFF_RTAB + 2400 * 4;
constexpr int OFF_MISC = OFF_KM + 8 * 128 * 4;
constexpr int OFF_SEL = OFF_MISC + 64;
constexpr int LDS_BYTES = OFF_SEL + 2048;
constexpr int LDP = HD, LDO = 2048;

#define KSWZ(row, colB) ((row) * 256 + ((colB) ^ (((row) & 7) << 4)))
#define SBAR() __builtin_amdgcn_sched_barrier(0)
__device__ __forceinline__ int v_st(int k, int c) { const int kk = (k & ~0xC) | ((k & 4) << 1) | ((k & 8) >> 1); return ((kk >> 3) * 4 + (c >> 5)) * 512 + ((kk & 7) * 32 + (c & 31)) * 2; }
__device__ __forceinline__ int v_rd_base(int lane) { return ((lane & 3) << 3) | (((lane >> 2) & 3) << 6) | (((lane >> 4) & 1) << 5) | (((lane >> 5) & 1) << 8); }
constexpr int v_rd_off(int d0, int ks, int half) { return d0 * 512 + ks * 4096 + half * 2048; }
__device__ __forceinline__ int crow(int r, int hi) { return (r & 3) + 8 * (r >> 2) + 4 * hi; }
__device__ __forceinline__ unsigned cvtpk(float lo, float hi) { unsigned r; asm volatile("v_cvt_pk_bf16_f32 %0, %1, %2" : "=v"(r) : "v"(lo), "v"(hi)); return r; }

__device__ __forceinline__ void mask_tile(f32x16& p0, f32x16& p1, int dq) {
    const float NEG = -__builtin_inff();
#pragma unroll
    for (int r = 0; r < 16; ++r) {
        const int c = (r & 3) + 8 * (r >> 2);
        if (dq - c < 0) p0[r] = NEG;
        if (dq - c - 32 < 0) p1[r] = NEG;
    }
}
__device__ __forceinline__ void bias_tile(f32x16& p0, f32x16& p1, const LAS float* rt) {
#pragma unroll
    for (int r = 0; r < 16; ++r) { const int c = (r & 3) + 8 * (r >> 2); p0[r] += rt[c]; p1[r] += rt[c + 32]; }
}
__device__ __forceinline__ void kill_tile(f32x16& p0, f32x16& p1) {
    const float NEG = -__builtin_inff();
#pragma unroll
    for (int r = 0; r < 16; ++r) { p0[r] = NEG; p1[r] = NEG; }
}
__device__ __forceinline__ void partialSM(f32x16& p0, f32x16& p1, float& m_reg, float& mn, float& alpha) {
    float pmax = p0[0];
#pragma unroll
    for (int r = 1; r < 16; ++r) pmax = fmaxf(pmax, p0[r]);
#pragma unroll
    for (int r = 0; r < 16; ++r) pmax = fmaxf(pmax, p1[r]);
    { auto rr = __builtin_amdgcn_permlane32_swap(__float_as_uint(pmax), __float_as_uint(pmax), false, false);
      pmax = fmaxf(__uint_as_float(rr[0]), __uint_as_float(rr[1])); }
    constexpr float C2 = 1.4426950408889634f * SCALE;
    if (__builtin_expect(__all((pmax - m_reg) * SCALE <= THR), 1)) { mn = m_reg; alpha = 1.f; }
    else { mn = fmaxf(m_reg, pmax); alpha = __builtin_amdgcn_exp2f((m_reg - mn) * C2); m_reg = mn; }
    const float mnL = -mn * C2;
#pragma unroll
    for (int r = 0; r < 16; ++r) p0[r] = fmaf(p0[r], C2, mnL);
#pragma unroll
    for (int r = 0; r < 16; ++r) p1[r] = fmaf(p1[r], C2, mnL);
#pragma unroll
    for (int r = 0; r < 16; ++r) p0[r] = __builtin_amdgcn_exp2f(p0[r]);
}
__device__ __forceinline__ void finishSM(f32x16& p0, f32x16& p1, float alpha, float& l_reg, bf16x8& pa0, bf16x8& pa1, bf16x8& pa2, bf16x8& pa3) {
#pragma unroll
    for (int r = 0; r < 16; ++r) p1[r] = __builtin_amdgcn_exp2f(p1[r]);
    float ps = 0;
#pragma unroll
    for (int r = 0; r < 16; ++r) ps += p0[r];
#pragma unroll
    for (int r = 0; r < 16; ++r) ps += p1[r];
    { auto rr = __builtin_amdgcn_permlane32_swap(__float_as_uint(ps), __float_as_uint(ps), false, false);
      ps = __uint_as_float(rr[0]) + __uint_as_float(rr[1]); }
    l_reg = l_reg * alpha + ps;
#define PK4(P, B_, OUT) do { unsigned a0 = cvtpk(P[B_+0], P[B_+1]), a1 = cvtpk(P[B_+2], P[B_+3]);                          \
        unsigned b0 = cvtpk(P[B_+4], P[B_+5]), b1 = cvtpk(P[B_+6], P[B_+7]);                                             \
        auto r0 = __builtin_amdgcn_permlane32_swap(a0, b0, false, false); auto r1 = __builtin_amdgcn_permlane32_swap(a1, b1, false, false); \
        u32x4 w = {r0[0], r1[0], r0[1], r1[1]}; OUT = __builtin_bit_cast(bf16x8, w); } while (0)
    PK4(p0, 0, pa0); PK4(p0, 8, pa1); PK4(p1, 0, pa2); PK4(p1, 8, pa3);
#undef PK4
}
template <int KB>
__device__ __forceinline__ void qkt(f32x16& p0, f32x16& p1, const char* K_lds, int r32, int hi, const bf16x8* qr) {
#pragma unroll
    for (int r = 0; r < 16; ++r) { p0[r] = 0.f; p1[r] = 0.f; }
    const char* kb[4];
#pragma unroll
    for (int dd = 0; dd < 4; ++dd) kb[dd] = K_lds + KB * SHM_K + KSWZ(r32, (dd * 16 + hi * 8) * 2);
#pragma unroll
    for (int d0 = 0; d0 < 8; ++d0) { const char* a = kb[d0 & 3] + (d0 >> 2) * 128;
        bf16x8 b0 = *reinterpret_cast<const bf16x8*>(a);
        bf16x8 b1 = *reinterpret_cast<const bf16x8*>(a + 32 * 256);
        p0 = __builtin_amdgcn_mfma_f32_32x32x16_bf16(b0, qr[d0], p0, 0, 0, 0);
        p1 = __builtin_amdgcn_mfma_f32_32x32x16_bf16(b1, qr[d0], p1, 0, 0, 0); }
}
template <int VB>
__device__ __forceinline__ void pv_tile(f32x16* o, int vb0, bf16x8 pa0, bf16x8 pa1, bf16x8 pa2, bf16x8 pa3) {
#define TRRD(dst, off) asm volatile("ds_read_b64_tr_b16 %0, %1 offset:%2" : "=&v"(dst) : "v"(vb0), "i"(off) : "memory")
#define PV_D0(d0) do { s16x4 l0, l1, l2, l3, h0, h1, h2, h3; constexpr int b_ = VB * SHM_V + v_rd_off(d0, 0, 0);   \
        TRRD(l0, b_); TRRD(h0, b_ + 2048); TRRD(l1, b_ + 4096); TRRD(h1, b_ + 6144); TRRD(l2, b_ + 8192); TRRD(h2, b_ + 10240); TRRD(l3, b_ + 12288); TRRD(h3, b_ + 14336); \
        asm volatile("s_waitcnt lgkmcnt(0)" ::: "memory"); SBAR();   \
        o[d0] = __builtin_amdgcn_mfma_f32_32x32x16_bf16(pa0, (bf16x8){l0[0], l0[1], l0[2], l0[3], h0[0], h0[1], h0[2], h0[3]}, o[d0], 0, 0, 0);   \
        o[d0] = __builtin_amdgcn_mfma_f32_32x32x16_bf16(pa1, (bf16x8){l1[0], l1[1], l1[2], l1[3], h1[0], h1[1], h1[2], h1[3]}, o[d0], 0, 0, 0);   \
        o[d0] = __builtin_amdgcn_mfma_f32_32x32x16_bf16(pa2, (bf16x8){l2[0], l2[1], l2[2], l2[3], h2[0], h2[1], h2[2], h2[3]}, o[d0], 0, 0, 0);   \
        o[d0] = __builtin_amdgcn_mfma_f32_32x32x16_bf16(pa3, (bf16x8){l3[0], l3[1], l3[2], l3[3], h3[0], h3[1], h3[2], h3[3]}, o[d0], 0, 0, 0); } while (0)
    PV_D0(0); PV_D0(1); PV_D0(2); PV_D0(3);
#undef PV_D0
#undef TRRD
}

struct BlockRef { const bf16_t* Q; const bf16_t* K; const bf16_t* V; bf16_t* O; int qb; int b, h; };
struct Seam { bf16x8 qr[8]; bf16x8 st_v0, st_v1, st_k0, st_k1; };
#define VMW() asm volatile("s_waitcnt vmcnt(0)" ::: "memory")
#define VMWN(n) asm volatile("s_waitcnt vmcnt(%0)" :: "i"(n) : "memory")
#define LD8(p) (*reinterpret_cast<const bf16x8*>(p))
#define SLOAD_H(Kp, Vp, k0) do { const char* kb__ = (const char*)(Kp) + (size_t)(k0) * (LDP * 2); const char* vb__ = (const char*)(Vp) + (size_t)(k0) * (LDP * 2); \
        S.st_v0 = LD8(vb__ + kvoff); S.st_v1 = LD8(vb__ + 32 * LDP * 2 + kvoff); S.st_k0 = LD8(kb__ + kvoff); S.st_k1 = LD8(kb__ + 32 * LDP * 2 + kvoff); } while (0)
#define SWRITE_HK(bf) do { *(bf16x8*)(K_lds + (bf) * SHM_K + kws) = S.st_k0; *(bf16x8*)(K_lds + (bf) * SHM_K + kws + 32 * 256) = S.st_k1; } while (0)
#define SWRITE_HV(bf) do { *(bf16x8*)(V_lds + (bf) * SHM_V + vst0) = S.st_v0; *(bf16x8*)(V_lds + (bf) * SHM_V + vst1) = S.st_v1; } while (0)
#define SWRITE_H(bf) do { SWRITE_HV(bf); SWRITE_HK(bf); } while (0)

__device__ __forceinline__ void prime(const BlockRef& cur, char* lds, Seam& S) {
    int tid = threadIdx.x; asm volatile("" : "+v"(tid));     const int wid = __builtin_amdgcn_readfirstlane(tid >> 6), lane = tid & 63, r32 = lane & 31, hi = lane >> 5;
    const int sr = tid >> 4, sc = (tid & 15) * 8, kws = KSWZ(sr, sc * 2); char* K_lds = lds + 2 * SHM_V;
    const unsigned kvoff = (unsigned)(sr * LDP + sc) * 2u, qvoff = (unsigned)(r32 * LDP + hi * 8) * 2u;
    { const char* qb__ = (const char*)cur.Q + (size_t)(wid * QBLK) * (LDP * 2);
#pragma unroll
    for (int d0 = 0; d0 < 8; ++d0) S.qr[d0] = LD8(qb__ + qvoff + d0 * 32); }
    SLOAD_H(cur.K, cur.V, 0); VMW(); SWRITE_HK(0);
    __syncthreads();
}
__device__ __forceinline__ int rel_bucket(int n) {
    if (n < 16) return n;
    const float nf = (float)n;
    int large = 16 + (int)(logf(nf / 16.0f) / 5.545177444479562f * 16.0f);
    return large < 31 ? large : 31;
}
__device__ __forceinline__ BlockRef make_ref(const P& a, int item);
__device__ __forceinline__ int block(const P& a, const BlockRef& cur, unsigned* queue, const float* rel_bias, const float* kmp, char* lds, Seam& S) {
    int tid = threadIdx.x; asm volatile("" : "+v"(tid));     const int wid = __builtin_amdgcn_readfirstlane(tid >> 6), lane = tid & 63, r32 = lane & 31, hi = lane >> 5;
    const int qb = cur.qb, NT = 4 * (qb + 1);
    const int qlo = qb * QB + wid * QBLK, qrow = qlo + r32;
    char* V_lds = lds; char* K_lds = lds + 2 * SHM_V;
    float* ws = (float*)(lds + OFF_WS) + wid * 64; float* li_l = ws, * al_l = ws + 32;
    LAS float* rtab = (LAS float*)(LAS char*)(uintptr_t)(unsigned)(uintptr_t)(lds + OFF_RTAB);
    float* kmL = (float*)(lds + OFF_KM);
    volatile int* misc = (volatile int*)(lds + OFF_MISC);
    if (tid == 0) misc[0] = (int)__hip_atomic_fetch_add(queue, 1u, __ATOMIC_RELAXED, __HIP_MEMORY_SCOPE_AGENT);
    for (int i = tid; i < 2400; i += NW * 64) { const int dist = 2047 - i; rtab[i] = dist >= 0 ? rel_bias[rel_bucket(dist) * 8 + cur.h] * (1.0f / SCALE) : -__builtin_inff(); }
    for (int i = tid; i < qb * 128; i += NW * 64) { const int j = i >> 7, dd = i & 127; const size_t o = ((size_t)(cur.b * 8 + j)) * 1024 + cur.h * 128 + dd;
        kmL[i] = (kmp[o] + kmp[o + 64 * 1024]) * (1.0f / 256.0f); }
    __syncthreads();
    const int next_item = __builtin_amdgcn_readfirstlane(misc[0]);
    const BlockRef nxt = next_item < 512 ? make_ref(a, next_item) : cur;
    unsigned selmask = 0;
    {
        float sc7[7];
#pragma unroll
        for (int j = 0; j < 7; ++j) { sc7[j] = -__builtin_inff();
            if (j < qb) { float acc = 0.f;
#pragma unroll
                for (int d0 = 0; d0 < 8; ++d0) { const u32x4 q4 = __builtin_bit_cast(u32x4, S.qr[d0]); const f32x4 k0 = *(const f32x4*)(kmL + j * 128 + d0 * 16 + hi * 8), k1 = *(const f32x4*)(kmL + j * 128 + d0 * 16 + hi * 8 + 4);
                    acc += bflo(q4[0]) * k0[0] + bfhi(q4[0]) * k0[1] + bflo(q4[1]) * k0[2] + bfhi(q4[1]) * k0[3] + bflo(q4[2]) * k1[0] + bfhi(q4[2]) * k1[1] + bflo(q4[3]) * k1[2] + bfhi(q4[3]) * k1[3]; }
                acc += __shfl_xor(acc, 32); sc7[j] = acc; } }
#pragma unroll
        for (int j = 0; j < 7; ++j) { int rank = 0;
#pragma unroll
            for (int i = 0; i < 7; ++i) { if (i != j) rank += (sc7[i] > sc7[j] || (sc7[i] == sc7[j] && i < j)) ? 1 : 0; }
            if (j < qb && (qb <= 3 || rank < 3)) selmask |= 1u << j; }
    }
    LAS unsigned* selp = (LAS unsigned*)(LAS char*)(uintptr_t)(unsigned)(uintptr_t)(lds + OFF_SEL) + tid;
    *selp = selmask;
    float m_reg = -1e30f, l_reg = 0; f32x16 o[4];
#pragma unroll
    for (int d = 0; d < 4; ++d)
#pragma unroll
        for (int r = 0; r < 16; ++r) o[d][r] = 0.f;
    const int sr = tid >> 4, sc = (tid & 15) * 8, vst0 = v_st(sr, sc), vst1 = v_st(32 + sr, sc), kws = KSWZ(sr, sc * 2);
    const unsigned kvoff = (unsigned)(sr * LDP + sc) * 2u;
    const int vb0 = (int)(uintptr_t)V_lds + v_rd_base(lane);
    const bf16_t* Kh = cur.K; const bf16_t* Vh = cur.V;
#define RESC(a) do { if (__any((a) < 1.f)) { if (hi == 0) al_l[r32] = (a); asm volatile("s_waitcnt lgkmcnt(0)" ::: "memory");              \
                     for (int d_ = 0; d_ < 4; ++d_) for (int r = 0; r < 16; ++r) o[d_][r] *= al_l[crow(r, hi)]; } } while (0)
#define KBASE(t) ((t) * KVBLK)
#define MASKT(P0_, P1_, t) do { const int kb_ = KBASE(t); const int jb_ = (t) >> 2; \
        const bool on_ = (jb_ == qb) || ((*selp >> jb_) & 1u); \
        bias_tile(P0_, P1_, on_ ? rtab + (kb_ + 4 * hi - qrow + 2047) : rtab + 2304); } while (0)
    constexpr int NQL = 8;
#define SEAM_K0() do { VMWN(NQL); SWRITE_HK(0); SBAR(); } while (0)
    f32x16 pA0, pA1, pB0, pB1; float mnA, mnB, alA, alB; bf16x8 pa0, pa1, pa2, pa3;
    SWRITE_HV(0); SBAR();
    if (NT > 1) { SLOAD_H(Kh, Vh, KBASE(1)); }
    SBAR(); qkt<0>(pA0, pA1, K_lds, r32, hi, S.qr);
    MASKT(pA0, pA1, 0); partialSM(pA0, pA1, m_reg, mnA, alA);
    if (NT > 1) { VMW(); SWRITE_H(1); }
    __syncthreads();
#define HALF_STEP(PX0, PX1, mnX, alX, PY0, PY1, alY, t, KB, VB, SB) do {                                                      \
        SBAR(); if ((t) + 1 < NT) { SLOAD_H(Kh, Vh, KBASE((t) + 1)); SBAR(); }      \
        qkt<KB>(PX0, PX1, K_lds, r32, hi, S.qr);                                             \
        finishSM(PY0, PY1, alY, l_reg, pa0, pa1, pa2, pa3); SBAR();                                                           \
        pv_tile<VB>(o, vb0, pa0, pa1, pa2, pa3); MASKT(PX0, PX1, (t)); partialSM(PX0, PX1, m_reg, mnX, alX);                                        \
        __syncthreads();                                                                                                      \
        if ((t) + 1 < NT) { VMW(); SWRITE_H(SB); }                                                                          \
        RESC(alX); __syncthreads(); } while (0)
    for (int t = 1; t + 1 < NT; t += 2) {
        HALF_STEP(pB0, pB1, mnB, alB, pA0, pA1, alA, t, 1, 0, 0);
        HALF_STEP(pA0, pA1, mnA, alA, pB0, pB1, alB, t + 1, 0, 1, 1);
    }
    { SBAR(); qkt<1>(pB0, pB1, K_lds, r32, hi, S.qr); SBAR(); }
    SLOAD_H(nxt.K, nxt.V, 0); SBAR();
    { const char* qb__ = (const char*)nxt.Q + (size_t)(wid * QBLK) * (LDP * 2); int l_ = lane; asm volatile("" : "+v"(l_));
      const unsigned qvoff = (unsigned)((l_ & 31) * LDP + (l_ >> 5) * 8) * 2u;
#pragma unroll
    for (int d0 = 0; d0 < 8; ++d0) S.qr[d0] = LD8(qb__ + qvoff + d0 * 32); }
    SBAR();
    finishSM(pA0, pA1, alA, l_reg, pa0, pa1, pa2, pa3); SBAR();
    pv_tile<0>(o, vb0, pa0, pa1, pa2, pa3);
    { MASKT(pB0, pB1, NT - 1); partialSM(pB0, pB1, m_reg, mnB, alB); __syncthreads(); RESC(alB);
      finishSM(pB0, pB1, alB, l_reg, pa0, pa1, pa2, pa3); SBAR(); pv_tile<1>(o, vb0, pa0, pa1, pa2, pa3); }
    SBAR(); SEAM_K0();
    if (hi == 0) li_l[r32] = l_reg; asm volatile("s_waitcnt lgkmcnt(0)" ::: "memory");
    float rli[16];
#pragma unroll
    for (int r = 0; r < 16; ++r) rli[r] = __builtin_amdgcn_rcpf(li_l[crow(r, hi)]);
    char* Ow = (char*)cur.O + (size_t)(wid * QBLK) * (LDO * 2); const unsigned ovoff = (unsigned)(4 * hi * LDO + r32) * 2u;
#pragma unroll
    for (int r = 0; r < 16; ++r) { const int orow0 = (r & 3) + 8 * (r >> 2);
#pragma unroll
        for (int d0 = 0; d0 < 4; ++d0) { const float v = o[d0][r] * rli[r];
            const float vn = __shfl_xor(v, 1);
            if ((r32 & 1) == 0) *(unsigned*)(Ow + (size_t)(orow0 * LDO * 2 + d0 * 64) + ovoff) = cvtpk(v, vn); } }
    __syncthreads();
    return next_item;
#undef RESC
#undef KBASE
#undef MASKT
#undef SEAM_K0
#undef HALF_STEP
}
#undef ROWP
#undef VMW
#undef VMWN
#undef LD8
#undef SLOAD_H
#undef SWRITE_HK
#undef SWRITE_HV
#undef SWRITE_H

__device__ __forceinline__ BlockRef make_ref(const P& a, int item) {
    const int qb = 7 - (item >> 6), bh = item & 63, b = bh >> 3, h = bh & 7;
    const bf16_t* proj = (const bf16_t*)(a.ws + WS_PROJ);
    BlockRef r; r.b = b; r.h = h; r.qb = qb;
    r.Q = proj + PROJ_BLK(C_QB + h * HD) + (size_t)(b * SEQ + qb * QB) * LDP;
    r.K = proj + PROJ_BLK(C_KB + h * HD) + (size_t)(b * SEQ) * LDP;
    r.V = proj + PROJ_BLK(C_VB + h * HD) + (size_t)(b * SEQ) * LDP;
    r.O = (bf16_t*)(a.ws + WS_OAB) + (size_t)(b * SEQ + qb * QB) * LDO + 1024 + h * HD;
    return r;
}
}
__device__ __forceinline__ void router_unit(const P& a, LAS unsigned char* lds, int unit) {
    int tid = threadIdx.x; asm volatile("" : "+v"(tid)); const int wave = __builtin_amdgcn_readfirstlane(tid >> 6), lane = tid & 63, c32 = lane & 31, hi = lane >> 5;
    const int tg = wave & 1, kq = wave >> 1;
    const bf16_t* x1 = (const bf16_t*)(a.ws + WS_X1); const float* g = a.in[11]; const float* br = a.in[13];
    unsigned char* A2 = a.ws + WS_A2; const u32x4* frag = (const u32x4*)(a.ws + WS_WRF);
    LAS float* Lw = (LAS float*)(lds + wave * 4352);
    LAS float* ssp = (LAS float*)(lds + 8 * 4352);
    LAS unsigned* hist = (LAS unsigned*)(lds + 8 * 4352 + 2048);
    LAS unsigned* base = hist + 32;
    if (tid < 32) hist[tid] = 0u;
    const int tok = unit * 64 + tg * 32 + c32;
    f32x16 L;
#pragma unroll
    for (int r = 0; r < 16; ++r) L[r] = 0.f;
    float ss = 0.f;
    const bf16_t* xr = x1 + (size_t)tok * D + 8 * hi + 256 * kq; unsigned char* ar = A2 + (size_t)tok * D + 8 * hi + 256 * kq; const float* gr = g + 8 * hi + 256 * kq;
#pragma unroll 4
    for (int s = 0; s < 16; ++s) {
        const u32x4 xw = *(const u32x4*)(xr + 16 * s); const f32x4 xa = {bflo(xw.x), bfhi(xw.x), bflo(xw.y), bfhi(xw.y)}, xb = {bflo(xw.z), bfhi(xw.z), bflo(xw.w), bfhi(xw.w)}, ga = *(const f32x4*)(gr + 16 * s), gb = *(const f32x4*)(gr + 16 * s + 4);
        ss += (xa.x * xa.x + xa.y * xa.y) + (xa.z * xa.z + xa.w * xa.w) + (xb.x * xb.x + xb.y * xb.y) + (xb.z * xb.z + xb.w * xb.w);
        const f32x4 va = xa * ga, vb = xb * gb;
        u32x4 wh; wh.x = cvt_pk_bf16(va.x, va.y); wh.y = cvt_pk_bf16(va.z, va.w); wh.z = cvt_pk_bf16(vb.x, vb.y); wh.w = cvt_pk_bf16(vb.z, vb.w);
        { u32x2 w8; w8.x = pk4_fp8(va.x, va.y, va.z, va.w); w8.y = pk4_fp8(vb.x, vb.y, vb.z, vb.w); *(u32x2*)(ar + 16 * s) = w8; }
        u32x4 wl; wl.x = cvt_pk_bf16(va.x - bflo(wh.x), va.y - bfhi(wh.x)); wl.y = cvt_pk_bf16(va.z - bflo(wh.y), va.w - bfhi(wh.y));
        wl.z = cvt_pk_bf16(vb.x - bflo(wh.z), vb.y - bfhi(wh.z)); wl.w = cvt_pk_bf16(vb.z - bflo(wh.w), vb.w - bfhi(wh.w));
        const bf16x8 ah = __builtin_bit_cast(bf16x8, wh), al = __builtin_bit_cast(bf16x8, wl);
        const bf16x8 bh = __builtin_bit_cast(bf16x8, frag[(16 * kq + s) * 64 + lane]), bl = __builtin_bit_cast(bf16x8, frag[4096 + (16 * kq + s) * 64 + lane]);
        L = __builtin_amdgcn_mfma_f32_32x32x16_bf16(ah, bh, L, 0, 0, 0);
        L = __builtin_amdgcn_mfma_f32_32x32x16_bf16(ah, bl, L, 0, 0, 0);
        L = __builtin_amdgcn_mfma_f32_32x32x16_bf16(al, bh, L, 0, 0, 0);
    }
#pragma unroll
    for (int r = 0; r < 16; ++r) Lw[((r & 3) + 8 * (r >> 2) + 4 * hi) * 33 + c32] = L[r];
    ssp[wave * 64 + lane] = ss;
    __syncthreads();
    int e4[4] = {0, 0, 0, 0}; float w4[4] = {0.f, 0.f, 0.f, 0.f}; unsigned loc[4] = {0u, 0u, 0u, 0u}; float rstd = 0.f;
    const bool sel = (wave < 2) && (hi == 0);
    if (sel) {
        float sst = 0.f;
#pragma unroll
        for (int q = 0; q < 4; ++q) sst += ssp[(wave + 2 * q) * 64 + c32] + ssp[(wave + 2 * q) * 64 + 32 + c32];
        rstd = 1.0f / sqrtf(sst * (1.0f / D) + EPS);
        float lg[32];
#pragma unroll
        for (int e = 0; e < 32; ++e) { const LAS float* lp = (const LAS float*)(lds + wave * 4352) + c32 * 33 + e; lg[e] = (lp[0] + lp[2 * 1088] + lp[4 * 1088] + lp[6 * 1088]) * rstd + br[e]; }
        unsigned used = 0u; float v4[4];
#pragma unroll
        for (int p = 0; p < 4; ++p) { float best = -__builtin_inff(); int bi = 0;
#pragma unroll
            for (int e = 0; e < 32; ++e) { const bool take = !((used >> e) & 1u) && lg[e] > best; best = take ? lg[e] : best; bi = take ? e : bi; }
            used |= 1u << bi; e4[p] = bi; v4[p] = best; }
        float sum = 0.f;
#pragma unroll
        for (int p = 0; p < 4; ++p) { w4[p] = expf(v4[p] - v4[0]); sum += w4[p]; }
        const float inv = 1.0f / sum;
#pragma unroll
        for (int p = 0; p < 4; ++p) { w4[p] *= inv; loc[p] = __hip_atomic_fetch_add(hist + e4[p], 1u, __ATOMIC_RELAXED, __HIP_MEMORY_SCOPE_WORKGROUP); }
    }
    __syncthreads();
    if (tid < 32) base[tid] = __hip_atomic_fetch_add((unsigned*)(a.ws + WS_CTL) + CW_COUNTS + tid, hist[tid], RLX_AGENT);
    __syncthreads();
    if (sel) {
        int* tope = (int*)(a.ws + WS_TOPE) + (size_t)tok * 4; float* wts = (float*)(a.ws + WS_WTS) + (size_t)tok * 4; int* slot = (int*)(a.ws + WS_SLOT) + (size_t)tok * 4;
#pragma unroll
        for (int p = 0; p < 4; ++p) { const int sl_ = (int)(base[e4[p]] + loc[p]); tope[p] = e4[p]; wts[p] = w4[p]; slot[p] = sl_;
            ((int*)(a.ws + WS_ROWE))[(size_t)e4[p] * T + sl_] = tok; ((float*)(a.ws + WS_RSTE))[(size_t)e4[p] * T + sl_] = rstd; }
    }
    __syncthreads();
}

__device__ __forceinline__ void moe_tables(const P& a, LAS unsigned char* lds) {
    int tid = threadIdx.x; asm volatile("" : "+v"(tid)); const int wave = tid >> 6, lane = tid & 63, e = lane & 31;
    LAS int* pstart = (LAS int*)(lds + LDS_MOE); LAS int* cnt = pstart + 64; LAS int* tile_e = pstart + 128;
    const unsigned* counts = (const unsigned*)(a.ws + WS_CTL) + CW_COUNTS;
    const int c = (int)counts[e]; const int p = ((c + 255) >> 8) << 8; int inc = p;
#pragma unroll
    for (int o = 1; o < 32; o <<= 1) { const int t = __builtin_amdgcn_ds_bpermute(((lane - o) & 63) << 2, inc); if (e >= o) inc += t; }
    if (tid < 32) { cnt[e] = c; pstart[e] = inc - p; if (e == 31) { pstart[32] = inc; tile_e[MAXTILES] = inc >> 8; } }
    for (int t = wave * 36; t < wave * 36 + 36; ++t) { const unsigned long long m = __ballot(inc <= t * 256); const int ee = __builtin_popcount((unsigned)m); if (lane == 0) tile_e[t] = ee < NE ? ee : NE - 1; }
    __syncthreads();
}

__device__ __forceinline__ void combine_rows(const P& a, LAS unsigned char* lds, int vcu, int G, int wave, int lane) {
    const LAS int* pstart = (const LAS int*)(lds + LDS_MOE);
    const int gw = vcu * NWAVES + wave, NGW = G * NWAVES;
    const bf16_t* X1 = (const bf16_t*)(a.ws + WS_X1); float* X = (float*)(a.ws + WS_X2); const unsigned char* Y = a.ws + WS_YROWS; bf16_t* A3 = (bf16_t*)(a.ws + WS_H);
    const int* tope = (const int*)(a.ws + WS_TOPE); const int* slot = (const int*)(a.ws + WS_SLOT); const float* wts = (const float*)(a.ws + WS_WTS); const float* g = a.in[20];
    f32x4 gv[4];
#pragma unroll
    for (int j = 0; j < 4; ++j) gv[j] = *((const f32x4*)g + lane + 64 * j);
    for (int m0 = gw; m0 < T; m0 += 8 * NGW) {
        int dl = 0; float wl = 0.f;
        { const int i = (lane >> 2) & 7, k = lane & 3; const int m = m0 + i * NGW; if (lane < 32 && m < T) { dl = pstart[tope[m * 4 + k]] + slot[m * 4 + k]; wl = wts[m * 4 + k]; } }
        u32x2 xa[4], xb[4]; unsigned ya[4][4], yb[4][4];
#define CR_LOAD(i_, XQ, YQ) do { const int m_ = m0 + (i_) * NGW; if (m_ < T) { const u32x2* x1r = (const u32x2*)(X1 + (size_t)m_ * D) + lane; \
            _Pragma("unroll") for (int j = 0; j < 4; ++j) XQ[j] = __builtin_nontemporal_load(x1r + 64 * j); \
            _Pragma("unroll") for (int k = 0; k < 4; ++k) { const int d = __builtin_amdgcn_readlane(dl, 4 * (i_) + k); const unsigned* yr = (const unsigned*)(Y + (size_t)d * D) + lane; \
                _Pragma("unroll") for (int j = 0; j < 4; ++j) YQ[k][j] = __builtin_nontemporal_load(yr + 64 * j); } } } while (0)
#define CR_DO(i_, XQ, YQ) do { const int m_ = m0 + (i_) * NGW; if (m_ < T) { f32x4 v[4]; \
            _Pragma("unroll") for (int j = 0; j < 4; ++j) v[j] = (f32x4){bflo(XQ[j].x), bfhi(XQ[j].x), bflo(XQ[j].y), bfhi(XQ[j].y)}; \
            _Pragma("unroll") for (int k = 0; k < 4; ++k) { const float w = __int_as_float(__builtin_amdgcn_readlane(__float_as_int(wl), 4 * (i_) + k)); \
                _Pragma("unroll") for (int j = 0; j < 4; ++j) { const int y = (int)YQ[k][j]; \
                    v[j].x += w * __builtin_amdgcn_cvt_f32_fp8(y, 0); v[j].y += w * __builtin_amdgcn_cvt_f32_fp8(y, 1); v[j].z += w * __builtin_amdgcn_cvt_f32_fp8(y, 2); v[j].w += w * __builtin_amdgcn_cvt_f32_fp8(y, 3); } } \
            float s = 0.f; \
            _Pragma("unroll") for (int j = 0; j < 4; ++j) s += (v[j].x * v[j].x + v[j].y * v[j].y) + (v[j].z * v[j].z + v[j].w * v[j].w); \
            const float rstd = 1.0f / sqrtf(wave_sum(s) * (1.0f / D) + EPS); \
            f32x4* xr = (f32x4*)(X + (size_t)m_ * D) + lane; unsigned* o4 = (unsigned*)((unsigned char*)A3 + (size_t)m_ * D) + lane;        \
            _Pragma("unroll") for (int j = 0; j < 4; ++j) { xr[64 * j] = v[j]; o4[64 * j] = pk4_fp8(v[j].x * rstd * gv[j].x, v[j].y * rstd * gv[j].y, v[j].z * rstd * gv[j].z, v[j].w * rstd * gv[j].w); } } } while (0)
        CR_LOAD(0, xa, ya);
#pragma unroll
        for (int i = 0; i < 8; i += 2) { CR_LOAD(i + 1, xb, yb); CR_DO(i, xa, ya); if (i + 2 < 8) CR_LOAD(i + 2, xa, ya); CR_DO(i + 1, xb, yb); }
#undef CR_LOAD
#undef CR_DO
    }
}
__device__ __forceinline__ void final_rows(const P& a, int vcu, int G, int wave, int lane) {
    const int gw = vcu * NWAVES + wave, NGW = G * NWAVES;
    const float* X = (const float*)(a.ws + WS_X2); float* OUT = a.out; const bf16_t* PG = (const bf16_t*)(a.ws + WS_PGATE); const bf16_t* PP = (const bf16_t*)(a.ws + WS_PPROJ);
    f32x4 gp[4], gf[4];
#pragma unroll
    for (int j = 0; j < 4; ++j) { gp[j] = *((const f32x4*)a.in[23] + lane + 64 * j); gf[j] = *((const f32x4*)a.in[24] + lane + 64 * j); }
    f32x4 va[4], vb[4]; u32x2 qa[4], qb[4], ga[4], gb[4];
#define FR_LOAD(m_, V, Q, GQ) do { if ((m_) < T) { const f32x4* xr = (const f32x4*)(X + (size_t)(m_) * D) + lane; const u32x2* pgr = (const u32x2*)(PG + (size_t)(m_) * D) + lane; const u32x2* ppr = (const u32x2*)(PP + (size_t)(m_) * D) + lane; \
        _Pragma("unroll") for (int j = 0; j < 4; ++j) { V[j] = __builtin_nontemporal_load(xr + 64 * j); Q[j] = __builtin_nontemporal_load(ppr + 64 * j); GQ[j] = __builtin_nontemporal_load(pgr + 64 * j); } } } while (0)
#define FR_DO(m_, V, Q, GQ) do { if ((m_) < T) { f32x4 v[4], pp[4], pg[4]; float sp = 0.f; \
        _Pragma("unroll") for (int j = 0; j < 4; ++j) { v[j] = V[j]; pp[j] = (f32x4){bflo(Q[j].x), bfhi(Q[j].x), bflo(Q[j].y), bfhi(Q[j].y)}; pg[j] = (f32x4){bflo(GQ[j].x), bfhi(GQ[j].x), bflo(GQ[j].y), bfhi(GQ[j].y)}; \
            sp += (pp[j].x * pp[j].x + pp[j].y * pp[j].y) + (pp[j].z * pp[j].z + pp[j].w * pp[j].w); } \
        const float rp = 1.0f / sqrtf(wave_sum(sp) * (1.0f / D) + EPS); float s_ = 0.f; \
        _Pragma("unroll") for (int j = 0; j < 4; ++j) { v[j] = v[j] + pg[j] * (pp[j] * rp * gp[j]); s_ += (v[j].x * v[j].x + v[j].y * v[j].y) + (v[j].z * v[j].z + v[j].w * v[j].w); } \
        const float rstd = 1.0f / sqrtf(wave_sum(s_) * (1.0f / D) + EPS); f32x4* orow = (f32x4*)(OUT + (size_t)(m_) * D) + lane; \
        _Pragma("unroll") for (int j = 0; j < 4; ++j) __builtin_nontemporal_store(v[j] * rstd * gf[j], orow + 64 * j); } } while (0)
    FR_LOAD(gw, va, qa, ga);
    for (int m = gw; m < T; m += 2 * NGW) { FR_LOAD(m + NGW, vb, qb, gb); FR_DO(m, va, qa, ga); FR_LOAD(m + 2 * NGW, va, qa, ga); FR_DO(m + NGW, vb, qb, gb); }
#undef FR_LOAD
#undef FR_DO
}
#ifndef MK_CVP
#define MK_CVP 16
#define MK_CVQ 5
#endif
struct Args { P p; };
template <int PH_LO, int PH_HI>
__global__ void __launch_bounds__(NTHREADS, 2) hybrid_fwd(Args args) {
    extern __shared__ __attribute__((aligned(16))) unsigned char lds_raw[];
    LAS unsigned char* lds = (LAS unsigned char*)lds_raw;
    const P& a = args.p;
    const int tid = threadIdx.x;
#define FRESH_WL() int t_ = threadIdx.x; asm volatile("" : "+v"(t_)); const int w_ = __builtin_amdgcn_readfirstlane(t_ >> 6), l_ = t_ & 63
    const int G = gridDim.x; const int bx = blockIdx.x; const int vcu = (G % 8 == 0) ? (bx % 8) * (G / 8) + bx / 8 : bx;
    unsigned* ctl = (unsigned*)(a.ws + WS_CTL);
    for (int u = tid; u < (LDS_BYTES - LDSCTL_OFF) / 4; u += NTHREADS) ((LAS unsigned*)(lds + LDSCTL_OFF))[u] = 0u;
    __syncthreads();
#if MK_PER_PHASE
#define GRID_BAR() do { } while (0)
#else
    XcdBarrier bar = xcd_barrier_post(ctl + CW_BAR, (volatile LAS unsigned*)(lds + MISC_OFF + 32));
#define GRID_BAR() xcd_barrier(bar)
#endif
    constexpr int lo = PH_LO, hi = PH_HI;
#define IN(k) (lo <= (k) && (k) < hi)
#define SEAM(k) do { if constexpr (IN(k) && IN((k) + 1)) GRID_BAR(); } while (0)
    unsigned char* ws = a.ws;

    if constexpr (IN(0)) { FRESH_WL(); p0_prologue(a, lds, vcu, G, w_, l_); }
    SEAM(0);
    if constexpr (IN(1)) {
        { pg8::DenseSched S; S.o.init(T / 256, 12, G, bx); S.Bt = (const char*)(ws + WS_WIN); S.K = D;
          pg8::EpiProj<false> E{(bf16_t*)(ws + WS_PROJ), (float*)(ws + WS_KMP)};
          pg8::gemm_phase(lds, (const char*)(ws + WS_H), D, D, D, S, E); }
        { pg8::DenseSched S; S.o.init(T / 256, 20, G, bx); S.Bt = (const char*)(ws + WS_WIN8); S.K = D; S.es = 1; S.pn0 = 12; S.bt_out = false;
          pg8::EpiProj<true> E{(bf16_t*)(ws + WS_PROJ), (float*)(ws + WS_KMP)};
          pg8::gemm_phase(lds, (const char*)(ws + WS_H8), D, D, D, S, E); }
    }
    SEAM(1);
    if constexpr (IN(2)) { for (int u = vcu; u < NB * 32; u += G) gla_prep_unit(a, lds, u); }
    SEAM(2);
    if constexpr (IN(3)) { for (int u = vcu; u < 512; u += G) gla_combine_unit(a, u); }
    SEAM(3);
    if constexpr (IN(4)) {
        for (int u = vcu; u < 1024; u += G) gla_out_unit(a, lds, u);
        __syncthreads();
    }
    if constexpr (IN(5)) {
        if ((vcu % MK_CVP) < MK_CVQ) { FRESH_WL(); expert_convert(a, lds, (vcu / MK_CVP) * MK_CVQ + vcu % MK_CVP, (G / MK_CVP) * MK_CVQ + ((G % MK_CVP) < MK_CVQ ? (G % MK_CVP) : MK_CVQ), w_, l_); __syncthreads(); }
        unsigned* queue = ctl + CW_QUEUE;
        volatile LAS int* qslot = (volatile LAS int*)(lds + LDSCTL_OFF + 1024);
        if (tid == 0) qslot[0] = (int)__hip_atomic_fetch_add(queue, 1u, RLX_AGENT);
        __syncthreads();
        int item = __builtin_amdgcn_readfirstlane(qslot[0]);
        if (item < 512) {
            moba::Seam S;
            moba::BlockRef cur = moba::make_ref(a, item);
            moba::prime(cur, (char*)lds_raw, S);
            for (;;) {
                const int nitem = moba::block(a, cur, queue, a.in[2], (const float*)(ws + WS_KMP), (char*)lds_raw, S);
                if (nitem >= 512) break;
                cur = moba::make_ref(a, nitem);
            }
        }
    }
    SEAM(5);
    if constexpr (IN(6)) {
        pg8::ChainSched S; S.o.init(T / 256, D / 256, G, bx); S.Bt = (const char*)(ws + WS_WUP); S.K = 1024;
        pg8::EpiMerge E{(const bf16_t*)(ws + WS_PROJ), (bf16_t*)(ws + WS_Y)};
        pg8::gemm_phase(lds, (const char*)(ws + WS_OAB), 1024, 2048, 2048, S, E);
    }
    SEAM(6);
    if constexpr (IN(7)) {
        pg8::DenseSched S; S.o.init(T / 256, D / 256, G, bx); S.Bt = (const char*)(ws + WS_WO); S.K = D;
        pg8::EpiResF32 E{a.in[0], (bf16_t*)(ws + WS_X1)};
        pg8::gemm_phase(lds, (const char*)(ws + WS_Y), D, D, D, S, E);
    }
    SEAM(7);
    if constexpr (IN(8)) { for (int u = vcu; u < T / 64; u += G) router_unit(a, lds, u); }
    SEAM(8);
    if constexpr (IN(9)) {
        moe_tables(a, lds); const LAS int* tab = (const LAS int*)(lds + LDS_MOE); const int ntile = __builtin_amdgcn_readfirstlane(tab[128 + MAXTILES]);
        pg8::MoeSched<true> S; S.o.init(ntile, 8, G, bx); S.Bt = (const char*)a.out; S.K = D; S.rows_per_e = 2048; S.tab = tab; S.row_e = (const int*)(ws + WS_ROWE); S.es = 1;
        pg8::EpiGlu E{(unsigned char*)(ws + WS_HMID), (const float*)(ws + WS_RSTE), tab, a.in[15], a.in[17], (const float*)(ws + WS_CTL) + 131072, lds};
        pg8::gemm_phase(lds, (const char*)(ws + WS_A2), D, D, D, S, E);
        const int extra = (ntile * 8) % G, nidle = G - extra;
        if (bx >= extra) { __syncthreads();
            pg8::DenseSched S2; S2.o.init(T / 256, D / 256, nidle, bx - extra); S2.Bt = (const char*)(ws + WS_WPP); S2.K = 256;
            pg8::EpiBf16<0, false> E2{(bf16_t*)(ws + WS_PPROJ), D, nullptr, 0, 1.0f};
            pg8::gemm_phase(lds, (const char*)(ws + WS_PB), 256, 256, 256, S2, E2); }
    }
    SEAM(9);
    if constexpr (IN(10)) {
        moe_tables(a, lds); const LAS int* tab = (const LAS int*)(lds + LDS_MOE); const int ntile = __builtin_amdgcn_readfirstlane(tab[128 + MAXTILES]);
        pg8::MoeSched<false> S; S.o.init(ntile, 4, G, bx); S.Bt = (const char*)(ws + WS_W2T); S.K = FF; S.rows_per_e = 1024; S.tab = tab; S.row_e = nullptr; S.es = 1;
        pg8::EpiDownF8 E{(unsigned char*)(ws + WS_YROWS), a.in[19]};
        pg8::gemm_phase(lds, (const char*)(ws + WS_HMID), FF, FF, FF, S, E);
    }
    SEAM(10);
    if constexpr (IN(11)) { moe_tables(a, lds); FRESH_WL(); combine_rows(a, lds, vcu, G, w_, l_); }
    SEAM(11);
    if constexpr (IN(12)) {
        { pg8::DenseSched S; S.o.init(T / 256, D / 256, G, bx); S.Bt = (const char*)(ws + WS_WPG); S.K = D; S.es = 1;
          pg8::EpiBf16<1, false, true> E{(bf16_t*)(ws + WS_PGATE), D, nullptr, 0, 1.0f / 32.0f};
          pg8::gemm_phase(lds, (const char*)(ws + WS_H), D, D, D, S, E); }
    }
    SEAM(12);
    if constexpr (IN(13)) { FRESH_WL(); final_rows(a, vcu, G, w_, l_); }
#undef FRESH_WL
#undef IN
#undef SEAM
#undef GRID_BAR
}

template <int LO, int HI> static void launch_range(const Args& a, int grid, hipStream_t stream) {
    static bool attr = false;
    if (!attr) { attr = true; if (hipFuncSetAttribute((const void*)hybrid_fwd<LO, HI>, hipFuncAttributeMaxDynamicSharedMemorySize, LDS_BYTES) != hipSuccess) fprintf(stderr, "kernel_launch: hipFuncSetAttribute failed\n"); }
    hipLaunchKernelGGL((hybrid_fwd<LO, HI>), dim3(grid), dim3(NTHREADS), LDS_BYTES, stream, a);
}
extern "C" void kernel_launch(void* const* d_in, const int* in_sizes, int n_in, void* d_out, int out_size, void* d_ws, size_t ws_size, hipStream_t stream) {
    static int grid = 0;
    if (grid == 0) {
        static const int expect[25] = {T * D, T * 256, 256, 1024, 1024 * D_IN, 16 * 512, 512, 256, 1048576, 1048576, 1048576, 1024, 32768, 32, 33554432, 32768, 33554432, 32768, 33554432, 32768, 1024, 1048576, 262144, 1024, 1024};
        bool okk = (n_in == 25);
        for (int i = 0; okk && i < 25; ++i) if (in_sizes[i] != expect[i]) { fprintf(stderr, "kernel_launch: input %d has %d elements, expected %d\n", i, in_sizes[i], expect[i]); okk = false; }
        if (!okk || out_size != T * D || ws_size < WS_END) { fprintf(stderr, "kernel_launch: unexpected shapes (n_in %d, in0 %d, out %d, ws %zu); nothing launched\n", n_in, n_in > 0 ? in_sizes[0] : -1, out_size, ws_size); grid = -1; return; }
        int dev = 0, cus = 0;
        if (hipGetDevice(&dev) != hipSuccess || hipDeviceGetAttribute(&cus, hipDeviceAttributeMultiprocessorCount, dev) != hipSuccess) { grid = -1; return; }
        grid = cus;
    }
    if (grid < 0) return;
    (void)hipMemsetAsync((char*)d_ws + WS_CTL, 0, CTL_ZERO_BYTES, stream);
    Args a{};
    for (int i = 0; i < 25; ++i) a.p.in[i] = (const float*)d_in[i];
    a.p.out = (float*)d_out; a.p.ws = (unsigned char*)d_ws;
#if MK_PER_PHASE
#ifndef MK_LAST
#define MK_LAST 13
#endif
#ifndef MK_REPEAT
#define MK_REPEAT 0
#endif
#define LR(k) do { if ((k) <= MK_LAST) for (int r_ = 0; r_ < 1 + ((MK_REPEAT >> (k)) & 1); ++r_) launch_range<(k), (k) + 1>(a, grid, stream); } while (0)
    LR(0); LR(1); LR(2); LR(3); LR(4); LR(5); LR(6); LR(7); LR(8); LR(9); LR(10); LR(11); LR(12); LR(13);
#undef LR
#else
    launch_range<0, NPHASES>(a, grid, stream);
#endif
}
```

```cpp
#include <hip/hip_runtime.h>
#include <cstdio>
#include <cstdint>

#define LAS __attribute__((address_space(3)))
#define GAS __attribute__((address_space(1)))
typedef unsigned short bf16_t;
typedef short bf16x8 __attribute__((ext_vector_type(8)));
typedef short s16x4 __attribute__((ext_vector_type(4)));
typedef float f32x2 __attribute__((ext_vector_type(2)));
typedef float f32x4 __attribute__((ext_vector_type(4)));
typedef float f32x16 __attribute__((ext_vector_type(16)));
typedef unsigned u32x2 __attribute__((ext_vector_type(2)));
typedef unsigned u32x4 __attribute__((ext_vector_type(4)));
typedef int i32x4 __attribute__((ext_vector_type(4)));
typedef int i32x8 __attribute__((ext_vector_type(8)));
typedef GAS unsigned gu32;
#define RLX_AGENT __ATOMIC_RELAXED, __HIP_MEMORY_SCOPE_AGENT
#define LDS_WAIT() asm volatile("s_waitcnt lgkmcnt(0)" ::: "memory")
#define VM_WAIT() asm volatile("s_waitcnt vmcnt(0)" ::: "memory")

#ifndef MK_PER_PHASE
#define MK_PER_PHASE 0
#endif

constexpr int NB = 8, SEQ = 2048, T = NB * SEQ, D = 1024;
constexpr int NPROJ = 8192;
constexpr int C_QA = 0, C_KA = 512, C_VA = 1024, C_RA = 2048, C_QB = 3072, C_KB = 4096, C_VB = 5120, C_GA = 6144, C_GB = 7168;
#define PROJ_BLK(cs) ((size_t)(cs) * T)
constexpr int SRC_ALOW = 3072, D_IN = 8208;
constexpr int NE = 32, FF = 1024, MAXTILES = 288, MAXROWS = MAXTILES * 256;
constexpr float EPS = 1e-6f;
constexpr int NWAVES = 8, NTHREADS = 512;
constexpr int NPHASES = 14;

constexpr size_t MiB = 1u << 20;
constexpr size_t WS_CTL = 0, CTL_ZERO_BYTES = 1 * MiB;
constexpr size_t WS_SMALL = 1 * MiB;
constexpr size_t WS_KMP   = WS_SMALL;
constexpr size_t WS_DEC   = WS_KMP + 512 * 1024;
constexpr size_t WS_TOPE  = WS_DEC + 512 * 1024;
constexpr size_t WS_WTS   = WS_TOPE + 256 * 1024;
constexpr size_t WS_SLOT  = WS_WTS + 256 * 1024;
constexpr size_t WS_DEST  = WS_SLOT + 256 * 1024;
constexpr size_t WS_ROWTOK = WS_DEST + 256 * 1024;
constexpr size_t WS_RSTDS = WS_ROWTOK + 320 * 1024;
constexpr size_t WS_RSTD  = WS_RSTDS + 320 * 1024;
constexpr size_t WS_TILEE = WS_RSTD + 64 * 1024;
constexpr size_t WS_WALT  = WS_TILEE + 4 * 1024;
constexpr size_t WS_WRF   = WS_WALT + 32 * 1024;
static_assert(WS_WRF + 128 * 1024 <= 6 * MiB, "small map");
constexpr size_t WS_WO = 6 * MiB, WS_WPG = 8 * MiB, WS_WPP = 10 * MiB, WS_WUP = 12 * MiB, WS_WIN = 16 * MiB;
constexpr size_t WS_PB = 34 * MiB;
constexpr size_t WS_H  = 42 * MiB;
constexpr size_t WS_PROJ = 74 * MiB;
constexpr size_t WS_QG = 330 * MiB, WS_KG = 346 * MiB;
constexpr size_t WS_SLOC = 426 * MiB;
constexpr size_t WS_OAB = 362 * MiB;
constexpr size_t WS_H8 = 426 * MiB;
constexpr size_t WS_WIN8 = 442 * MiB;
constexpr size_t WS_Y = 330 * MiB;
constexpr size_t WS_W2T = 42 * MiB;
constexpr size_t WS_A2 = 330 * MiB;
constexpr size_t WS_HMID = 138 * MiB;
constexpr size_t WS_X1 = 74 * MiB;
constexpr size_t WS_X2 = 138 * MiB;
constexpr size_t WS_YROWS = 282 * MiB;
constexpr size_t WS_PGATE = 330 * MiB, WS_PPROJ = 226 * MiB;
constexpr size_t WS_ROWE = 490 * MiB;
constexpr size_t WS_RSTE = 492 * MiB;
constexpr size_t WS_END = 506 * MiB;

constexpr int CW_BAR = 4096;
constexpr int CW_COUNTS = 16384;
constexpr int CW_QUEUE = 16384 + 64;

constexpr int RING_BYTES = 131072;
constexpr int LDSCTL_OFF = RING_BYTES, MISC_OFF = LDSCTL_OFF + 320;
constexpr int LDS_MOE = LDSCTL_OFF + 10240;
constexpr int EPF_OFF = LDSCTL_OFF + 12288;
constexpr int LDS_BYTES = 151552;

typedef __bf16 bf16v2_t __attribute__((ext_vector_type(2)));
__device__ __forceinline__ unsigned cvt_pk_bf16(float lo, float hi) { const f32x2 v = {lo, hi}; return __builtin_bit_cast(unsigned, __builtin_convertvector(v, bf16v2_t)); }
__device__ __forceinline__ unsigned pk4_fp8(float a, float b, float c, float d) { int w = 0; w = __builtin_amdgcn_cvt_pk_fp8_f32(a, b, w, false); w = __builtin_amdgcn_cvt_pk_fp8_f32(c, d, w, true); return (unsigned)w; }
__device__ __forceinline__ float bf2f(unsigned short s) { return __uint_as_float(((unsigned)s) << 16); }
__device__ __forceinline__ float bflo(unsigned w) { return __uint_as_float(w << 16); }
__device__ __forceinline__ float bfhi(unsigned w) { return __uint_as_float(w & 0xffff0000u); }
__device__ __forceinline__ float fsigmoid(float x) { return __builtin_amdgcn_rcpf(1.0f + __builtin_amdgcn_exp2f(-1.4426950408889634f * x)); }
__device__ __forceinline__ float wave_sum(float v) {
#pragma unroll
    for (int o = 1; o < 64; o <<= 1) v += __shfl_xor(v, o);
    return v;
}
__device__ __forceinline__ bf16x8 pack8(f32x4 a, f32x4 b) {
    u32x4 w = {cvt_pk_bf16(a[0], a[1]), cvt_pk_bf16(a[2], a[3]), cvt_pk_bf16(b[0], b[1]), cvt_pk_bf16(b[2], b[3])};
    return __builtin_bit_cast(bf16x8, w);
}

#define XB_TMO      128
#define XB_XCNT(j)  (256  + 64 * (j))
#define XB_XSUB(j)  (1280 + 64 * (j))
#define XB_XGEN(j)  (2304 + 64 * (j))
#define XB_TOP      3328
#define XB_TOPGEN   3392
#define XCD_BAR_WORDS 3456
#define XB_SPIN_CAP (1u << 18)

__device__ __forceinline__ unsigned xb_ld(unsigned* p)              { return __hip_atomic_load(p, __ATOMIC_RELAXED, __HIP_MEMORY_SCOPE_AGENT); }
__device__ __forceinline__ unsigned xb_add(unsigned* p, unsigned v) { return __hip_atomic_fetch_add(p, v, __ATOMIC_RELAXED, __HIP_MEMORY_SCOPE_AGENT); }
__device__ __forceinline__ unsigned xb_xcc_id() { return (unsigned)__builtin_amdgcn_s_getreg((3 << 11) | 20) & 0xFu; }
#define XB_SPIN(cond, bar) do { unsigned _sp = 0; while (cond) { __builtin_amdgcn_s_sleep(1); \
    if ((++_sp & 255u) == 0u) { if (xb_ld(&(bar)[XB_TMO])) break; if (_sp > XB_SPIN_CAP) { atomicAdd(&(bar)[XB_TMO], 1u); break; } } } } while (0)

struct XcdBarrier { unsigned* bar; unsigned x; volatile LAS unsigned* st; };

__device__ __forceinline__ XcdBarrier xcd_barrier_post(unsigned* bar, volatile LAS unsigned* st) {
    XcdBarrier b; b.bar = bar; b.x = xb_xcc_id(); b.st = st;
    if (threadIdx.x == 0) (void)xb_add(&bar[XB_XCNT(b.x)], 1u);
    return b;
}
__device__ __forceinline__ void xcd_barrier_complete(unsigned* bar, unsigned x, unsigned& nloc, unsigned& nx) {
    const unsigned G = gridDim.x * gridDim.y * gridDim.z;
    unsigned sum, cnt, mine, sp = 0u;
    for (;;) {
        sum = 0u; cnt = 0u; mine = 0u;
#pragma unroll
        for (unsigned j = 0; j < 16; ++j) { const unsigned c = xb_ld(&bar[XB_XCNT(j)]); sum += c; cnt += (c > 0u) ? 1u : 0u; mine = (j == x) ? c : mine; }
        if (sum == G) break;
        __builtin_amdgcn_s_sleep(1);
        if ((++sp & 255u) == 0u) { if (xb_ld(&bar[XB_TMO])) break; if (sp > XB_SPIN_CAP) { atomicAdd(&bar[XB_TMO], 1u); break; } }
    }
    nloc = mine > 0u ? mine : 1u; nx = cnt > 0u ? cnt : 1u;
}
__device__ __forceinline__ void xcd_barrier(const XcdBarrier& b) {
    asm volatile("s_waitcnt vmcnt(0)" ::: "memory");
    __syncthreads();
    if (threadIdx.x == 0) {
        unsigned* bar = b.bar;
        __builtin_amdgcn_s_waitcnt(0);
        unsigned nloc = b.st[0], nx = b.st[1];
        if (nloc == 0u) { xcd_barrier_complete(bar, b.x, nloc, nx); b.st[0] = nloc; b.st[1] = nx; }
        const unsigned old = xb_add(&bar[XB_XSUB(b.x)], 1u);
        const unsigned gen = old / nloc;
        if (old + 1u == (gen + 1u) * nloc) {
            __builtin_amdgcn_fence(__ATOMIC_RELEASE, "agent");
            asm volatile("s_waitcnt vmcnt(0)" ::: "memory");
            const unsigned og = xb_add(&bar[XB_TOP], 1u);
            const unsigned tg = og / nx;
            if (og + 1u == (tg + 1u) * nx) xb_add(&bar[XB_TOPGEN], 1u);
            else XB_SPIN(xb_ld(&bar[XB_TOPGEN]) == tg, bar);
            __builtin_amdgcn_fence(__ATOMIC_ACQUIRE, "agent");
            xb_add(&bar[XB_XGEN(b.x)], 1u);
            asm volatile("s_waitcnt vmcnt(0)" ::: "memory");
        } else {
            XB_SPIN(xb_ld(&bar[XB_XGEN(b.x)]) == gen, bar);
            __builtin_amdgcn_fence(__ATOMIC_ACQUIRE, "agent");
            asm volatile("s_waitcnt vmcnt(0)" ::: "memory");
        }
    }
    __syncthreads();
}
#ifndef MK_SCL
#define MK_SCL 0
#endif
namespace pg8 {
constexpr int BM = 256, BK = 64, HALF = 128, HTB = HALF * BK * 2, STAGE_BYTES = 8 * HTB, NXCD = 8, WGM = 8;

__host__ __device__ __forceinline__ int lds_byte(int r, int c) { const int st = (r >> 4) * 2 + (c >> 5), rr = r & 15, cc = c & 31, ob = rr * 64 + cc * 2; return st * 1024 + (ob ^ (((ob >> 9) & 1) << 5)); }
__host__ __device__ __forceinline__ void stage_rc(int b, int& R, int& C) { const int st = b / 1024, sb = b % 1024, swz = sb ^ (((sb >> 9) & 1) << 5); R = (st >> 1) * 16 + swz / 64; C = (st & 1) * 32 + (swz % 64) / 2; }
__host__ __device__ __forceinline__ int perm32(int rho) { const int n = rho >> 4, i = rho & 15; return 8 * (i >> 2) + 4 * n + (i & 3); }

struct Unit { int pm, pn, e, s; };

struct TileOrder {
    int nM, nN, nwg, G, c;
    __device__ __forceinline__ void init(int nM_, int nN_, int G_, int c_) { nM = nM_; nN = nN_; nwg = nM * nN; G = G_; c = c_; }
    __device__ __forceinline__ bool next(int i, int& pm, int& pn) const {
        const unsigned L = (unsigned)i * (unsigned)G + (unsigned)c; if (L >= (unsigned)nwg) return false;
        int wgid = (int)L; { const int q = nwg / NXCD, r = nwg % NXCD, xcd = wgid % NXCD, off = wgid / NXCD; wgid = (xcd < r ? xcd * (q + 1) : r * (q + 1) + (xcd - r) * q) + off; }
        const int nig = WGM * nN, gid = wgid / nig, fm = gid * WGM, gsz = (nM - fm) < WGM ? (nM - fm) : WGM;
        pm = fm + ((wgid % nig) % gsz); pn = (wgid % nig) / gsz; return true;
    }
};
struct DenseSched {
    TileOrder o; const char* Bt; int K; int es = 2; int gap_at = 1 << 30, gap_by = 0, pn0 = 0; bool bt_out = true;
    __device__ __forceinline__ bool next(int i, Unit& u) const { int p; if (!o.next(i, u.pm, p)) return false; u.e = p; u.pn = p + (p >= gap_at ? gap_by : 0) + pn0; return true; }
    __device__ __forceinline__ unsigned a_row(const Unit& u, int r) const { return (unsigned)(u.pm * BM + r); }
    __device__ __forceinline__ unsigned a_koff(const Unit&) const { return 0u; }
    __device__ __forceinline__ const char* b_base(const Unit& u) const { return Bt + (size_t)(bt_out ? u.pn : u.e) * BM * K * es; }
};
struct ChainSched {
    TileOrder o; const char* Bt; int K;
    __device__ __forceinline__ bool next(int i, Unit& u) const { if (!o.next(i >> 1, u.pm, u.pn)) return false; u.e = i & 1; return true; }
    __device__ __forceinline__ unsigned a_row(const Unit& u, int r) const { return (unsigned)(u.pm * BM + r); }
    __device__ __forceinline__ unsigned a_koff(const Unit& u) const { return (unsigned)(u.e * K * 2); }
    __device__ __forceinline__ const char* b_base(const Unit& u) const { return Bt + (size_t)u.pn * BM * (2 * K) * 2 + (size_t)u.e * K * 2; }
};
template <bool GATHER> struct MoeSched {
    TileOrder o; const char* Bt; int K; int rows_per_e; const LAS int* tab; const int* row_e; int es;
    __device__ __forceinline__ bool next(int i, Unit& u) const { if (!o.next(i, u.pm, u.pn)) return false; u.e = __builtin_amdgcn_readfirstlane(tab[128 + u.pm]); return true; }
    __device__ __forceinline__ unsigned a_row(const Unit& u, int r) const {
        if (GATHER) { const int lr = u.pm * BM + r - tab[u.e]; return lr < tab[64 + u.e] ? (unsigned)row_e[(size_t)u.e * T + lr] : 0u; }
        else return (unsigned)(u.pm * BM + r); }
    __device__ __forceinline__ unsigned a_koff(const Unit&) const { return 0u; }
    __device__ __forceinline__ const char* b_base(const Unit& u) const { return Bt + ((size_t)u.e * rows_per_e + (size_t)u.pn * BM) * K * es; }
};

template <class Epi, class Sched>
__device__ __forceinline__ void gemm_phase(LAS unsigned char* lds, const char* gA, int K_, int lda, int ldb, const Sched& S, const Epi& E) {
    int K = K_; asm volatile("" : "+s"(K));
    int tid = threadIdx.x; asm volatile("" : "+v"(tid));     const int wid = __builtin_amdgcn_readfirstlane(tid >> 6), lane = tid & 63, wr = wid >> 2, wc = wid & 3, fr = lane & 15, fq = lane >> 4;
    constexpr int ES = Epi::F8 ? 1 : 2;
    const int nt = K * ES / 128;
    unsigned voffB[2];
#pragma unroll
    for (int i = 0; i < 2; ++i) { int R, C; stage_rc(tid * 16 + i * 8192, R, C); const int Rb = Epi::PERM ? ((R & ~31) + perm32(R & 31)) : R; voffB[i] = (unsigned)(Rb * ldb * ES + C * 2); }
    const unsigned kstep = (unsigned)(BK * 2);
    const size_t hstepB = (size_t)HALF * ldb * ES;
    const unsigned ldab = (unsigned)lda * ES;
    const unsigned ldsw = (unsigned)wid * 1024u;
    const int aoff = lds_byte(wr * 64 + fr, fq * 8), boff = lds_byte(wc * 32 + fr, fq * 8);
#define PG8_SA(b, h) (((b) * 2 + (h)) * HTB)
#define PG8_SB(b, h) ((4 + (b) * 2 + (h)) * HTB)
#define PG8_STAGE_B(bufoff, gbase) do { _Pragma("unroll") for (int _i = 0; _i < 2; ++_i) \
        __builtin_amdgcn_global_load_lds((const unsigned*)((const char*)(gbase) + voffB[_i]), (LAS unsigned*)(lds + (bufoff) + ldsw + _i * 8192), 16, 0, 0); } while (0)
#define PG8_STAGE_A(bufoff, o0, o1, kb) do { \
        const char* gk_ = gA + (kb);      \
        __builtin_amdgcn_global_load_lds((const unsigned*)(gk_ + (o0)), (LAS unsigned*)(lds + (bufoff) + ldsw), 16, 0, 0); \
        __builtin_amdgcn_global_load_lds((const unsigned*)(gk_ + (o1)), (LAS unsigned*)(lds + (bufoff) + ldsw + 8192), 16, 0, 0); } while (0)
#define PG8_LDA(dst, b, h) do { _Pragma("unroll") for (int m = 0; m < 4; ++m) _Pragma("unroll") for (int k = 0; k < 2; ++k) dst[m][k] = *(const LAS bf16x8*)(lds + PG8_SA(b, h) + aoff + m * 2048 + k * 1024); } while (0)
#define PG8_LDB(dst, b, h) do { _Pragma("unroll") for (int n = 0; n < 2; ++n) _Pragma("unroll") for (int k = 0; k < 2; ++k) dst[n][k] = *(const LAS bf16x8*)(lds + PG8_SB(b, h) + boff + n * 2048 + k * 1024); } while (0)
#define PG8_MMA(ai, bj, At, Bt) do { __builtin_amdgcn_s_setprio(1); \
        if constexpr (Epi::F8) { _Pragma("unroll") for (int m = 0; m < 4; ++m) _Pragma("unroll") for (int n = 0; n < 2; ++n) { \
            const i32x8 a8_ = __builtin_shufflevector(__builtin_bit_cast(i32x4, At[m][0]), __builtin_bit_cast(i32x4, At[m][1]), 0, 1, 2, 3, 4, 5, 6, 7); \
            const i32x8 b8_ = __builtin_shufflevector(__builtin_bit_cast(i32x4, Bt[n][0]), __builtin_bit_cast(i32x4, Bt[n][1]), 0, 1, 2, 3, 4, 5, 6, 7); \
            acc[ai][bj][m][n] = __builtin_amdgcn_mfma_scale_f32_16x16x128_f8f6f4(b8_, a8_, acc[ai][bj][m][n], 0, 0, 0, MK_SCL, 0, MK_SCL); } } \
        else { _Pragma("unroll") for (int m = 0; m < 4; ++m) _Pragma("unroll") for (int n = 0; n < 2; ++n) _Pragma("unroll") for (int k = 0; k < 2; ++k) \
            acc[ai][bj][m][n] = __builtin_amdgcn_mfma_f32_16x16x32_bf16(Bt[n][k], At[m][k], acc[ai][bj][m][n], 0, 0, 0); } \
        __builtin_amdgcn_s_setprio(0); } while (0)
#define PG8_WAIT_V(n) asm volatile("s_waitcnt vmcnt(" #n ")" ::: "memory")
#define PG8_WAIT_L(n) asm volatile("s_waitcnt lgkmcnt(" #n ")" ::: "memory")
#define PG8_BAR __builtin_amdgcn_s_barrier()
#define PG8_SCHED __builtin_amdgcn_sched_barrier(0)
#define PG8_AOFFS(dst, u) do { int t_ = threadIdx.x; asm volatile("" : "+v"(t_));     \
        _Pragma("unroll") for (int _h = 0; _h < 2; ++_h) _Pragma("unroll") for (int _i = 0; _i < 2; ++_i) { int R_, C_; stage_rc(t_ * 16 + _i * 8192, R_, C_); \
        dst[_h][_i] = S.a_row(u, _h * HALF + R_) * ldab + (unsigned)C_ * 2u + S.a_koff(u); } } while (0)
    Unit cur, nxt; int ui = 0;
    if (!S.next(0, cur)) return;
    cur.s = 0;
    if constexpr (Epi::PREF) E.prefetch(cur, 0);
#ifdef MK_STAGGER
    if (S.o.nwg > 3 * S.o.G) {
        const unsigned long long t0_ = __builtin_amdgcn_s_memrealtime(); const unsigned long long d_ = (unsigned long long)((blockIdx.x >> 3) & 7) * MK_STAGGER;
        while (__builtin_amdgcn_s_memrealtime() - t0_ < d_) __builtin_amdgcn_s_sleep(4);
    }
#endif
    f32x4 acc[2][2][4][2];
#pragma unroll
    for (int a = 0; a < 2; ++a)
#pragma unroll
        for (int b = 0; b < 2; ++b)
#pragma unroll
            for (int m = 0; m < 4; ++m)
#pragma unroll
                for (int n = 0; n < 2; ++n) acc[a][b][m][n] = (f32x4){0.f, 0.f, 0.f, 0.f};
    bf16x8 At[4][2], B0[2][2], B1[2][2];
    unsigned oc[2][2];
    LAS u32x4* nslot = (LAS u32x4*)(lds + LDSCTL_OFF + 2048) + tid;
    PG8_AOFFS(oc, cur);
    const char* cB = S.b_base(cur);
    PG8_STAGE_B(PG8_SB(0, 0), cB); PG8_STAGE_B(PG8_SB(0, 1), cB + hstepB); PG8_STAGE_A(PG8_SA(0, 0), oc[0][0], oc[0][1], 0u); PG8_STAGE_A(PG8_SA(0, 1), oc[1][0], oc[1][1], 0u);
    if (wr == 1) PG8_BAR;
    PG8_WAIT_V(2); PG8_BAR;
    PG8_STAGE_B(PG8_SB(1, 0), cB + kstep); PG8_STAGE_A(PG8_SA(1, 0), oc[0][0], oc[0][1], kstep); PG8_STAGE_B(PG8_SB(1, 1), cB + hstepB + kstep);
    PG8_WAIT_V(6); PG8_BAR;
    for (;;) {
        const bool has_next = S.next(ui + 1, nxt);
        const char* nB = has_next ? S.b_base(nxt) : cB;
        if (has_next) { unsigned on[2][2]; PG8_AOFFS(on, nxt); *nslot = (u32x4){on[0][0], on[0][1], on[1][0], on[1][1]}; nxt.s = cur.s == 2 ? 0 : cur.s + 1;
            if constexpr (Epi::PREF) E.prefetch(nxt, nxt.s); }
        for (int t = 0; t < nt; t += 2) {
            const bool last = (t == nt - 2);
            const unsigned k1 = (unsigned)(t + 1) * kstep;
            const unsigned k2 = last ? 0u : (unsigned)(t + 2) * kstep, k3 = k2 + kstep;
            const char* b2 = last ? nB : cB + (size_t)(t + 2) * kstep; const char* b3 = b2 + kstep;
            PG8_LDB(B0, 0, 0); PG8_LDB(B1, 0, 1); PG8_SCHED; PG8_LDA(At, 0, 0); PG8_STAGE_A(PG8_SA(1, 1), oc[1][0], oc[1][1], k1);
            PG8_WAIT_V(8); PG8_WAIT_L(0); PG8_BAR; PG8_MMA(0, 0, At, B0); PG8_MMA(0, 1, At, B1); PG8_BAR; PG8_SCHED;
            if (last && has_next) { const u32x4 o_ = *nslot; oc[0][0] = o_.x; oc[0][1] = o_.y; oc[1][0] = o_.z; oc[1][1] = o_.w; }
            PG8_LDA(At, 0, 1); PG8_STAGE_B(PG8_SB(0, 0), b2); PG8_STAGE_B(PG8_SB(0, 1), b2 + hstepB); PG8_STAGE_A(PG8_SA(0, 0), oc[0][0], oc[0][1], k2);
            PG8_WAIT_V(8); PG8_WAIT_L(0); PG8_BAR; PG8_MMA(1, 0, At, B0); PG8_MMA(1, 1, At, B1); PG8_BAR; PG8_SCHED;
            PG8_LDB(B0, 1, 0); PG8_LDB(B1, 1, 1); PG8_SCHED; PG8_LDA(At, 1, 0); PG8_STAGE_A(PG8_SA(0, 1), oc[1][0], oc[1][1], k2);
            PG8_WAIT_V(8); PG8_WAIT_L(0); PG8_BAR; PG8_MMA(0, 0, At, B0); PG8_MMA(0, 1, At, B1); PG8_BAR; PG8_SCHED;
            PG8_LDA(At, 1, 1); PG8_STAGE_B(PG8_SB(1, 0), b3); PG8_STAGE_B(PG8_SB(1, 1), b3 + hstepB); PG8_STAGE_A(PG8_SA(1, 0), oc[0][0], oc[0][1], k3);
            PG8_WAIT_V(8); PG8_WAIT_L(0); PG8_BAR; PG8_MMA(1, 0, At, B0); PG8_MMA(1, 1, At, B1); PG8_BAR; PG8_SCHED;
        }
        if (wr == 0) PG8_BAR;
        bool carry = false;
        if constexpr (Epi::MIDK) { if (cur.e == 0) { E.mid(acc, cur, wr, wc, fr, fq); carry = true; } else E(acc, cur, wr, wc, fr, fq); } else E(acc, cur, wr, wc, fr, fq);
        if (!has_next) break;
        if (!carry)
#pragma unroll
        for (int a = 0; a < 2; ++a)
#pragma unroll
            for (int b = 0; b < 2; ++b)
#pragma unroll
                for (int m = 0; m < 4; ++m)
#pragma unroll
                    for (int n = 0; n < 2; ++n) acc[a][b][m][n] = (f32x4){0.f, 0.f, 0.f, 0.f};
        cur = nxt; cB = nB; ++ui;
        if (wr == 1) PG8_BAR;
    }
    PG8_WAIT_V(0);
    PG8_BAR;
#undef PG8_SA
#undef PG8_SB
#undef PG8_STAGE_A
#undef PG8_STAGE_B
#undef PG8_LDA
#undef PG8_LDB
#undef PG8_MMA
#undef PG8_WAIT_V
#undef PG8_WAIT_L
#undef PG8_BAR
#undef PG8_SCHED
#undef PG8_AOFFS
}

template <bool F8_> struct EpiProj {
    static constexpr bool PREF = false, PERM = true, MIDK = false, F8 = F8_;
    bf16_t* O; float* kmp;
    __device__ __forceinline__ void operator()(const f32x4 (&acc)[2][2][4][2], const Unit& u, int wr, int wc, int fr, int fq) const {
        const int row0 = u.pm * BM + wr * 64 + fr;
        const bool narrow = (u.pn < C_VA / BM) || (u.pn >= C_QB / BM && u.pn < C_GA / BM);
        const bool gate = u.pn >= C_GA / BM;
        const int hw = narrow ? 128 : 256; const size_t bjs = narrow ? (size_t)HALF * T : (size_t)HALF;
#pragma unroll
        for (int ai = 0; ai < 2; ++ai)
#pragma unroll
            for (int m = 0; m < 4; ++m) { bf16_t* rowp = O + PROJ_BLK(u.pn * BM) + (size_t)(row0 + ai * HALF + m * 16) * hw + wc * 32 + 8 * fq;
#pragma unroll
                for (int bj = 0; bj < 2; ++bj) { const float sc = F8 ? (1.0f / 32.0f) : 1.0f; const f32x4 v0 = acc[ai][bj][m][0] * sc, v1 = acc[ai][bj][m][1] * sc;
                    if (F8 && gate) { u32x2 w8; w8.x = pk4_fp8(v0[0], v0[1], v0[2], v0[3]); w8.y = pk4_fp8(v1[0], v1[1], v1[2], v1[3]);
                        __builtin_nontemporal_store(w8, (u32x2*)((unsigned char*)(O + PROJ_BLK(u.pn * BM)) + (size_t)(row0 + ai * HALF + m * 16) * 256 + bj * HALF + wc * 32 + 8 * fq)); continue; }
                    u32x4 w; w.x = cvt_pk_bf16(v0[0], v0[1]); w.y = cvt_pk_bf16(v0[2], v0[3]); w.z = cvt_pk_bf16(v1[0], v1[1]); w.w = cvt_pk_bf16(v1[2], v1[3]);
                    __builtin_nontemporal_store(w, (u32x4*)(rowp + bj * bjs)); } }
        if (u.pn >= C_KB / BM && u.pn < C_VB / BM) {
#pragma unroll
            for (int bj = 0; bj < 2; ++bj)
#pragma unroll
                for (int n = 0; n < 2; ++n) { f32x4 s = (f32x4){0.f, 0.f, 0.f, 0.f};
#pragma unroll
                    for (int ai = 0; ai < 2; ++ai)
#pragma unroll
                        for (int m = 0; m < 4; ++m) s += acc[ai][bj][m][n];
#pragma unroll
                    for (int o = 1; o < 16; o <<= 1) { s[0] += __shfl_xor(s[0], o); s[1] += __shfl_xor(s[1], o); s[2] += __shfl_xor(s[2], o); s[3] += __shfl_xor(s[3], o); }
                    if (fr == 0) *(f32x4*)(kmp + ((size_t)wr * 64 + u.pm) * 1024 + (u.pn - C_KB / BM) * BM + bj * HALF + wc * 32 + 8 * fq + 4 * n) = s * (F8 ? (1.0f / 32.0f) : 1.0f); }
        }
    }
};
struct EpiMerge {
    static constexpr bool PREF = false, PERM = true, MIDK = true, F8 = false;
    const bf16_t* proj; bf16_t* Y;
    __device__ __forceinline__ void mid(f32x4 (&acc)[2][2][4][2], const Unit& u, int wr, int wc, int fr, int fq) const {
        const int row0 = u.pm * BM + wr * 64 + fr; const int col0 = u.pn * BM + wc * 32 + 8 * fq;
#pragma unroll
        for (int ai = 0; ai < 2; ++ai) {
            u32x2 ga[4][2], gb[4][2];
#pragma unroll
            for (int m = 0; m < 4; ++m) { const unsigned char* rowp = (const unsigned char*)(proj + PROJ_BLK(u.pn * BM)) + (size_t)(row0 + ai * HALF + m * 16) * 256 + wc * 32 + 8 * fq;
#pragma unroll
                for (int bj = 0; bj < 2; ++bj) { ga[m][bj] = *(const u32x2*)(rowp + 2 * PROJ_BLK(C_GA) + bj * HALF); gb[m][bj] = *(const u32x2*)(rowp + 2 * PROJ_BLK(C_GB) + bj * HALF); } }
#pragma unroll
            for (int m = 0; m < 4; ++m) {
#pragma unroll
                for (int bj = 0; bj < 2; ++bj) {
#pragma unroll
                    for (int n = 0; n < 2; ++n) {
#define MG_R(b_) ((1.0f + __builtin_amdgcn_exp2f(-1.4426950408889634f * __builtin_amdgcn_cvt_f32_fp8((int)gb[m][bj][n], b_))) * __builtin_amdgcn_rcpf(1.0f + __builtin_amdgcn_exp2f(-1.4426950408889634f * __builtin_amdgcn_cvt_f32_fp8((int)ga[m][bj][n], b_))))
                        acc[ai][bj][m][n][0] *= MG_R(0); acc[ai][bj][m][n][1] *= MG_R(1); acc[ai][bj][m][n][2] *= MG_R(2); acc[ai][bj][m][n][3] *= MG_R(3);
#undef MG_R
                    } }
                asm volatile("" : "+v"(acc[ai][0][m][0]), "+v"(acc[ai][0][m][1]), "+v"(acc[ai][1][m][0]), "+v"(acc[ai][1][m][1])); }
            asm volatile("" ::: "memory"); }
    }
    __device__ __forceinline__ void operator()(const f32x4 (&acc)[2][2][4][2], const Unit& u, int wr, int wc, int fr, int fq) const {
        const int row0 = u.pm * BM + wr * 64 + fr; const int col0 = u.pn * BM + wc * 32 + 8 * fq;
#pragma unroll
        for (int ai = 0; ai < 2; ++ai) {
            u32x2 gb[4][2];
#pragma unroll
            for (int m = 0; m < 4; ++m)
#pragma unroll
                for (int bj = 0; bj < 2; ++bj) gb[m][bj] = *(const u32x2*)((const unsigned char*)(proj + PROJ_BLK(C_GB + u.pn * BM)) + (size_t)(row0 + ai * HALF + m * 16) * 256 + wc * 32 + 8 * fq + bj * HALF);
#pragma unroll
            for (int m = 0; m < 4; ++m) { const size_t r = (size_t)(row0 + ai * HALF + m * 16);
#pragma unroll
                for (int bj = 0; bj < 2; ++bj) { const u32x2 g = gb[m][bj];
                    const f32x4 v0 = acc[ai][bj][m][0], v1 = acc[ai][bj][m][1];
#define MG_S(w_, b_) fsigmoid(__builtin_amdgcn_cvt_f32_fp8((int)(w_), b_))
                    u32x4 w; w.x = cvt_pk_bf16(v0[0] * MG_S(g.x, 0), v0[1] * MG_S(g.x, 1)); w.y = cvt_pk_bf16(v0[2] * MG_S(g.x, 2), v0[3] * MG_S(g.x, 3));
                    w.z = cvt_pk_bf16(v1[0] * MG_S(g.y, 0), v1[1] * MG_S(g.y, 1)); w.w = cvt_pk_bf16(v1[2] * MG_S(g.y, 2), v1[3] * MG_S(g.y, 3));
#undef MG_S
                    *(u32x4*)(Y + r * D + col0 + bj * HALF) = w; } }
            asm volatile("" ::: "memory"); }
    }
};
struct EpiResF32 {
    static constexpr bool PREF = false, PERM = false, MIDK = false, F8 = false;
    const float* base; bf16_t* out;
    __device__ __forceinline__ void operator()(const f32x4 (&acc)[2][2][4][2], const Unit& u, int wr, int wc, int fr, int fq) const {
        const int row0 = u.pm * BM + wr * 64 + fr, col0 = u.pn * BM + wc * 32 + 4 * fq;
#pragma unroll
        for (int ai = 0; ai < 2; ++ai) {
            f32x4 bs[4][2][2];
#pragma unroll
            for (int m = 0; m < 4; ++m) { const size_t off = (size_t)(row0 + ai * HALF + m * 16) * D + col0;
#pragma unroll
                for (int bj = 0; bj < 2; ++bj)
#pragma unroll
                    for (int n = 0; n < 2; ++n) bs[m][bj][n] = __builtin_nontemporal_load((const f32x4*)(base + off + bj * HALF + n * 16)); }
#pragma unroll
            for (int m = 0; m < 4; ++m) { const size_t off = (size_t)(row0 + ai * HALF + m * 16) * D + col0;
#pragma unroll
                for (int bj = 0; bj < 2; ++bj)
#pragma unroll
                    for (int n = 0; n < 2; ++n) { const f32x4 v = bs[m][bj][n] + acc[ai][bj][m][n]; u32x2 w; w.x = cvt_pk_bf16(v[0], v[1]); w.y = cvt_pk_bf16(v[2], v[3]); *(u32x2*)(out + off + bj * HALF + n * 16) = w; } }
            asm volatile("" ::: "memory"); }
    }
};
struct EpiGlu {
    static constexpr bool PREF = true, PERM = true, MIDK = false, F8 = true;
    unsigned char* H; const float* rstd_e; const LAS int* tab; const float* bg; const float* bu; const float* zero; LAS unsigned char* lds;
    __device__ __forceinline__ void prefetch(const Unit& u, int slot) const {
        int tid = threadIdx.x; asm volatile("" : "+v"(tid)); const int wave = __builtin_amdgcn_readfirstlane(tid >> 6);
        const float* src;
        if (wave < 4) { const int lr = u.pm * BM + tid - tab[u.e]; src = lr < tab[64 + u.e] ? rstd_e + (size_t)u.e * T + lr : zero; }
        else { const int j = tid - 256; src = (j < 128 ? bg : bu) + (size_t)u.e * FF + u.pn * HALF + (j & 127); }
        __builtin_amdgcn_global_load_lds((const unsigned*)src, (LAS unsigned*)(lds + EPF_OFF + slot * 2048 + wave * 256), 4, 0, 0);
    }
    __device__ __forceinline__ void operator()(const f32x4 (&acc)[2][2][4][2], const Unit& u, int wr, int wc, int fr, int fq) const {
        const int row0 = u.pm * BM + wr * 64 + fr; const int colo = u.pn * HALF + wc * 32 + 8 * fq;
        const LAS float* ep = (const LAS float*)(lds + EPF_OFF + u.s * 2048);
        f32x4 g4[2], u4[2];
#pragma unroll
        for (int n = 0; n < 2; ++n) { g4[n] = *(const LAS f32x4*)(ep + 256 + wc * 32 + 8 * fq + 4 * n); u4[n] = *(const LAS f32x4*)(ep + 384 + wc * 32 + 8 * fq + 4 * n); }
        float rsv[2][4];
#pragma unroll
        for (int ai = 0; ai < 2; ++ai)
#pragma unroll
            for (int m = 0; m < 4; ++m) rsv[ai][m] = ep[wr * 64 + fr + ai * HALF + m * 16];
#pragma unroll
        for (int ai = 0; ai < 2; ++ai)
#pragma unroll
            for (int m = 0; m < 4; ++m) { const int r = row0 + ai * HALF + m * 16; const float rs = rsv[ai][m] * (1.0f / 32.0f);
                float o[8];
#pragma unroll
                for (int n = 0; n < 2; ++n)
#pragma unroll
                    for (int j = 0; j < 4; ++j) { float g = acc[ai][0][m][n][j] * rs + g4[n][j], up = acc[ai][1][m][n][j] * rs + u4[n][j];
                        g = fminf(g, 7.0f); up = fminf(fmaxf(up, -7.0f), 7.0f);
                        const float glu = g * fsigmoid(1.702f * g); o[n * 4 + j] = (up + 1.0f) * glu; }
                u32x2 w; w.x = pk4_fp8(o[0], o[1], o[2], o[3]); w.y = pk4_fp8(o[4], o[5], o[6], o[7]);
                *(u32x2*)(H + (size_t)r * FF + colo) = w; asm volatile("" ::: "memory"); }
    }
};
template <int ACT, bool HASBIAS, bool F8_ = false> struct EpiBf16 {
    static constexpr bool PREF = false, PERM = true, MIDK = false, F8 = F8_;
    bf16_t* O; int ldc; const float* bias; int bias_stride; float scale;
    __device__ __forceinline__ void operator()(const f32x4 (&acc)[2][2][4][2], const Unit& u, int wr, int wc, int fr, int fq) const {
        const int row0 = u.pm * BM + wr * 64 + fr; const int col0 = u.pn * BM + wc * 32 + 8 * fq;
        f32x4 bv[2][2];
#pragma unroll
        for (int bj = 0; bj < 2; ++bj)
#pragma unroll
            for (int n = 0; n < 2; ++n) bv[bj][n] = HASBIAS ? *(const f32x4*)(bias + (size_t)u.e * bias_stride + col0 + bj * HALF + 4 * n) : (f32x4){0.f, 0.f, 0.f, 0.f};
#pragma unroll
        for (int ai = 0; ai < 2; ++ai)
#pragma unroll
            for (int m = 0; m < 4; ++m) { bf16_t* rowp = O + (size_t)(row0 + ai * HALF + m * 16) * ldc + col0;
#pragma unroll
                for (int bj = 0; bj < 2; ++bj) { f32x4 v0 = acc[ai][bj][m][0] * scale + bv[bj][0], v1 = acc[ai][bj][m][1] * scale + bv[bj][1];
                    if (ACT == 1) {
#pragma unroll
                        for (int j = 0; j < 4; ++j) { v0[j] = fsigmoid(v0[j]); v1[j] = fsigmoid(v1[j]); } }
                    u32x4 w; w.x = cvt_pk_bf16(v0[0], v0[1]); w.y = cvt_pk_bf16(v0[2], v0[3]); w.z = cvt_pk_bf16(v1[0], v1[1]); w.w = cvt_pk_bf16(v1[2], v1[3]);
                    *(u32x4*)(rowp + bj * HALF) = w; }
                asm volatile("" ::: "memory"); }
    }
};
struct EpiDownF8 {
    static constexpr bool PREF = false, PERM = true, MIDK = false, F8 = true;
    unsigned char* O; const float* bias;
    __device__ __forceinline__ void operator()(const f32x4 (&acc)[2][2][4][2], const Unit& u, int wr, int wc, int fr, int fq) const {
        const int row0 = u.pm * BM + wr * 64 + fr; const int col0 = u.pn * BM + wc * 32 + 8 * fq;
        f32x4 bv[2][2];
#pragma unroll
        for (int bj = 0; bj < 2; ++bj)
#pragma unroll
            for (int n = 0; n < 2; ++n) bv[bj][n] = *(const f32x4*)(bias + (size_t)u.e * D + col0 + bj * HALF + 4 * n);
#pragma unroll
        for (int ai = 0; ai < 2; ++ai)
#pragma unroll
            for (int m = 0; m < 4; ++m) { unsigned char* rowp = O + (size_t)(row0 + ai * HALF + m * 16) * D + col0;
#pragma unroll
                for (int bj = 0; bj < 2; ++bj) { const f32x4 v0 = acc[ai][bj][m][0] * (1.0f / 32.0f) + bv[bj][0], v1 = acc[ai][bj][m][1] * (1.0f / 32.0f) + bv[bj][1];
                    u32x2 w; w.x = pk4_fp8(v0[0], v0[1], v0[2], v0[3]); w.y = pk4_fp8(v1[0], v1[1], v1[2], v1[3]);
                    *(u32x2*)(rowp + bj * HALF) = w; }
                asm volatile("" ::: "memory"); }
    }
};
}
__device__ __forceinline__ void transpose_item(const float* __restrict__ W, int ldw, int k0, int n_src0, bf16_t* __restrict__ WT, int ldo, int n_dst0, int k_off, LAS float* scr, int lane) {
    { float t_[32]; const float* wp_ = W + (size_t)(k0 + (lane >> 5)) * ldw + n_src0 + (lane & 31);
#pragma unroll
    for (int i = 0; i < 32; ++i) t_[i] = __builtin_nontemporal_load(wp_ + (size_t)(2 * i) * ldw);
#pragma unroll
    for (int i = 0; i < 32; ++i) scr[(2 * i + (lane >> 5)) * 33 + (lane & 31)] = t_[i]; }
    LDS_WAIT(); asm volatile("" ::: "memory");
    const int c = lane & 7;
#pragma unroll
    for (int j = 0; j < 4; ++j) { const int n = (lane >> 3) + 8 * j; const LAS float* s = scr + (8 * c) * 33 + n;
        u32x4 o; o.x = cvt_pk_bf16(s[0 * 33], s[1 * 33]); o.y = cvt_pk_bf16(s[2 * 33], s[3 * 33]); o.z = cvt_pk_bf16(s[4 * 33], s[5 * 33]); o.w = cvt_pk_bf16(s[6 * 33], s[7 * 33]);
        *(u32x4*)(WT + (size_t)(n_dst0 + n) * ldo + k_off + k0 + 8 * c) = o; }
    LDS_WAIT(); asm volatile("" ::: "memory");
}
__device__ __forceinline__ void transpose_item_f8(const float* __restrict__ W, int ldw, int k0, int n_src0, unsigned char* __restrict__ WT, int ldo, int n_dst0, float sc, LAS float* scr, int lane) {
    { float t_[32]; const float* wp_ = W + (size_t)(k0 + (lane >> 5)) * ldw + n_src0 + (lane & 31);
#pragma unroll
    for (int i = 0; i < 32; ++i) t_[i] = __builtin_nontemporal_load(wp_ + (size_t)(2 * i) * ldw);
#pragma unroll
    for (int i = 0; i < 32; ++i) scr[(2 * i + (lane >> 5)) * 33 + (lane & 31)] = t_[i]; }
    LDS_WAIT(); asm volatile("" ::: "memory");
    const int c = lane & 7;
#pragma unroll
    for (int j = 0; j < 4; ++j) { const int n = (lane >> 3) + 8 * j; const LAS float* s = scr + (8 * c) * 33 + n;
        u32x2 o; o.x = pk4_fp8(s[0 * 33] * sc, s[1 * 33] * sc, s[2 * 33] * sc, s[3 * 33] * sc); o.y = pk4_fp8(s[4 * 33] * sc, s[5 * 33] * sc, s[6 * 33] * sc, s[7 * 33] * sc);
        *(u32x2*)(WT + (size_t)(n_dst0 + n) * ldo + k0 + 8 * c) = o; }
    LDS_WAIT(); asm volatile("" ::: "memory");
}
__device__ __forceinline__ void transpose_mat_item(const float* W, int ldw, int N, int n_src_base, bf16_t* WT, int ldo, int n_dst_base, int k_off, LAS float* scr, int item, int lane) {
    const int nblk = N / 32, kb = item / nblk, nb = item % nblk;
    transpose_item(W, ldw, 64 * kb, n_src_base + 32 * nb, WT, ldo, n_dst_base + 32 * nb, k_off, scr, lane);
}

struct P {
    const float* in[25]; float* out; unsigned char* ws;
};

__device__ __forceinline__ void p0_prologue(const P& a, LAS unsigned char* lds, int vcu, int G, int wave, int lane) {
    LAS float* scr = (LAS float*)(lds + wave * 16384);
    const int gw = vcu * NWAVES + wave, NGW = G * NWAVES;
    unsigned char* ws = a.ws;
    bf16_t* WinT = (bf16_t*)(ws + WS_WIN);
    constexpr int I_A = 16 * 96, I_B8 = 16 * 160, I_B = 0;
    constexpr int NITEMS = I_A + I_B8 + I_B;
#ifndef P0_PARTS
#define P0_PARTS 63
#endif
    if (P0_PARTS & 1)
    for (int it = gw; it < NITEMS; it += NGW) {
        int r = it;
        if (r < I_A) { transpose_mat_item(a.in[4], D_IN, 3072, 0, WinT, D, 0, 0, scr, r, lane); continue; } r -= I_A;
        if (r < I_B8) { const int kb = r / 160, nb = r % 160; transpose_item_f8(a.in[4], D_IN, 64 * kb, 3088 + 32 * nb, ws + WS_WIN8, D, 32 * nb, 32.0f, scr, lane); continue; } r -= I_B8;
    }
    if (P0_PARTS & 2) {
        const float* x = a.in[0]; const float* g = a.in[3]; bf16_t* H = (bf16_t*)(ws + WS_H);
        f32x4 gv[4];
#pragma unroll
        for (int j = 0; j < 4; ++j) gv[j] = *((const f32x4*)g + lane + 64 * j);
        f32x4 va[4], vb[4];
#define H_LOAD(m_, V) do { if ((m_) < T) { const f32x4* xr = (const f32x4*)(x + (size_t)(m_) * D) + lane; _Pragma("unroll") for (int j = 0; j < 4; ++j) V[j] = __builtin_nontemporal_load(xr + 64 * j); } } while (0)
#define H_DO(m_, V) do { if ((m_) < T) { float s_ = 0.f; \
            _Pragma("unroll") for (int j = 0; j < 4; ++j) s_ += (V[j].x * V[j].x + V[j].y * V[j].y) + (V[j].z * V[j].z + V[j].w * V[j].w); \
            const float rstd = 1.0f / sqrtf(wave_sum(s_) * (1.0f / D) + EPS); \
            u32x2* o8 = (u32x2*)(H + (size_t)(m_) * D) + lane; unsigned* q8 = (unsigned*)(ws + WS_H8 + (size_t)(m_) * D) + lane; \
            _Pragma("unroll") for (int j = 0; j < 4; ++j) { const f32x4 y = V[j] * rstd * gv[j]; u32x2 w; w.x = cvt_pk_bf16(y.x, y.y); w.y = cvt_pk_bf16(y.z, y.w); o8[64 * j] = w; q8[64 * j] = pk4_fp8(y.x, y.y, y.z, y.w); } } } while (0)
        H_LOAD(gw, va);
        for (int m = gw; m < T; m += 2 * NGW) { H_LOAD(m + NGW, vb); H_DO(m, va); H_LOAD(m + 2 * NGW, va); H_DO(m + NGW, vb); }
#undef H_LOAD
#undef H_DO
    }
    if (P0_PARTS & 8) {
        const int gt = (vcu * NWAVES + wave) * 64 + lane;
        if ((P0_PARTS & 16) && gt < 16 * 1024) { const int n = gt >> 10, k = gt & 1023; ((bf16_t*)(ws + WS_WALT))[n * 1024 + k] = (bf16_t)(cvt_pk_bf16(a.in[4][(size_t)k * D_IN + SRC_ALOW + n], 0.f) & 0xffffu); }
        if ((P0_PARTS & 32) && gt < 4096) { const int s = gt >> 6, l = gt & 63, e = l & 31, hh = l >> 5; const float* wr = a.in[12];
            float v[8], lo[8];
#pragma unroll
            for (int j = 0; j < 8; ++j) { v[j] = wr[(size_t)(16 * s + 8 * hh + j) * NE + e]; }
            u32x4 whi; whi.x = cvt_pk_bf16(v[0], v[1]); whi.y = cvt_pk_bf16(v[2], v[3]); whi.z = cvt_pk_bf16(v[4], v[5]); whi.w = cvt_pk_bf16(v[6], v[7]);
#pragma unroll
            for (int j = 0; j < 4; ++j) { lo[2 * j] = v[2 * j] - bflo(whi[j]); lo[2 * j + 1] = v[2 * j + 1] - bfhi(whi[j]); }
            u32x4 wlo; wlo.x = cvt_pk_bf16(lo[0], lo[1]); wlo.y = cvt_pk_bf16(lo[2], lo[3]); wlo.z = cvt_pk_bf16(lo[4], lo[5]); wlo.w = cvt_pk_bf16(lo[6], lo[7]);
            u32x4* f = (u32x4*)(ws + WS_WRF); f[gt] = whi; f[4096 + gt] = wlo; }
    }
}

__device__ __forceinline__ void late_prep(const P& a, LAS unsigned char* lds, int ci, int ncv, int wave, int lane) {
    LAS float* scr = (LAS float*)(lds + wave * 16384);
    const int gw = ci * NWAVES + wave, NGW = ncv * NWAVES;
    unsigned char* ws = a.ws;
    bf16_t* WupT = (bf16_t*)(ws + WS_WUP); bf16_t* WoT = (bf16_t*)(ws + WS_WO); bf16_t* WpgT = (bf16_t*)(ws + WS_WPG); bf16_t* WppT = (bf16_t*)(ws + WS_WPP);
    constexpr int I_S = 16 * 32, I_P = 4 * 32;
    for (int it = gw; it < 4 * I_S + I_P; it += NGW) {
        int r = it;
        if (r < I_S) { transpose_mat_item(a.in[8], D, D, 0, WupT, 2048, 0, 0, scr, r, lane); continue; } r -= I_S;
        if (r < I_S) { transpose_mat_item(a.in[9], D, D, 0, WupT, 2048, 0, 1024, scr, r, lane); continue; } r -= I_S;
        if (r < I_S) { transpose_mat_item(a.in[10], D, D, 0, WoT, D, 0, 0, scr, r, lane); continue; } r -= I_S;
        if (r < I_S) { const int kb = r / 32, nb = r % 32; transpose_item_f8(a.in[21], D, 64 * kb, 32 * nb, (unsigned char*)WpgT, D, 32 * nb, 32.0f, scr, lane); continue; } r -= I_S;
        transpose_mat_item(a.in[22], D, D, 0, WppT, 256, 0, 0, scr, r, lane);
    }
    const f32x4* p4 = (const f32x4*)a.in[1]; u32x2* pb = (u32x2*)(ws + WS_PB);
    const size_t n4 = (size_t)T * 256 / 4;
    for (size_t i = (size_t)gw * 64 + lane; i < n4; i += (size_t)NGW * 64) { const f32x4 v = __builtin_nontemporal_load(p4 + i); u32x2 w; w.x = cvt_pk_bf16(v.x, v.y); w.y = cvt_pk_bf16(v.z, v.w); pb[i] = w; }
}

struct CvtItem { const float* src; unsigned char* dst; int ldo; };
__device__ __forceinline__ CvtItem cvt_item(const P& a, int it, int lane) {
    constexpr int IPM = 16 * 32;
    const int e = it / (3 * IPM), r0 = it % (3 * IPM), which = r0 / IPM, r = r0 % IPM, kb = r / 32, nb = r % 32, n0 = 32 * nb;
    CvtItem c;
    if (which < 2) { c.src = a.in[which == 0 ? 14 : 16] + (size_t)e * D * FF + (size_t)(64 * kb + (lane >> 5)) * FF + n0 + (lane & 31);
        c.dst = (unsigned char*)a.out + ((size_t)e * 2048 + (n0 >> 7) * 256 + (n0 & 127) + which * 128) * D + 64 * kb; c.ldo = D; }
    else { c.src = a.in[18] + (size_t)e * FF * D + (size_t)(64 * kb + (lane >> 5)) * D + n0 + (lane & 31);
        c.dst = a.ws + WS_W2T + ((size_t)e * D + n0) * FF + 64 * kb; c.ldo = FF; }
    return c;
}
__device__ __forceinline__ void expert_convert(const P& a, LAS unsigned char* lds, int vcu, int G, int wave, int lane) {
    LAS float* scr = (LAS float*)(lds + wave * 16384);
    const int gw = vcu * NWAVES + wave, NGW = G * NWAVES;
    constexpr int NIT = NE * 3 * 16 * 32;
    if (gw >= NIT) return;
    float tA[32], tB[32];
    CvtItem cA = cvt_item(a, gw, lane), cB = cvt_item(a, gw + NGW < NIT ? gw + NGW : gw, lane);
#pragma unroll
    for (int i = 0; i < 32; ++i) tA[i] = __builtin_nontemporal_load(cA.src + (size_t)(2 * i) * 1024);
#pragma unroll
    for (int i = 0; i < 32; ++i) tB[i] = __builtin_nontemporal_load(cB.src + (size_t)(2 * i) * 1024);
#define CVT_OUT(c_) do { LDS_WAIT(); asm volatile("" ::: "memory"); const int c = lane & 7; \
        _Pragma("unroll") for (int j = 0; j < 4; ++j) { const int n = (lane >> 3) + 8 * j; const LAS float* s = scr + (8 * c) * 33 + n; \
            u32x2 o; o.x = pk4_fp8(s[0 * 33] * 32.0f, s[1 * 33] * 32.0f, s[2 * 33] * 32.0f, s[3 * 33] * 32.0f); o.y = pk4_fp8(s[4 * 33] * 32.0f, s[5 * 33] * 32.0f, s[6 * 33] * 32.0f, s[7 * 33] * 32.0f); \
            __builtin_nontemporal_store(o, (u32x2*)((c_).dst + (size_t)n * (c_).ldo + 8 * c)); } \
        LDS_WAIT(); asm volatile("" ::: "memory"); } while (0)
    for (int it = gw; it < NIT; it += 2 * NGW) {
#pragma unroll
        for (int i = 0; i < 32; ++i) scr[(2 * i + (lane >> 5)) * 33 + (lane & 31)] = tA[i];
        const CvtItem dA = cA; const int n2 = it + 2 * NGW;
        if (n2 < NIT) { cA = cvt_item(a, n2, lane);
#pragma unroll
            for (int i = 0; i < 32; ++i) tA[i] = __builtin_nontemporal_load(cA.src + (size_t)(2 * i) * 1024); }
        CVT_OUT(dA);
        if (it + NGW >= NIT) break;
#pragma unroll
        for (int i = 0; i < 32; ++i) scr[(2 * i + (lane >> 5)) * 33 + (lane & 31)] = tB[i];
        const CvtItem dB = cB; const int n3 = it + 3 * NGW;
        if (n3 < NIT) { cB = cvt_item(a, n3, lane);
#pragma unroll
            for (int i = 0; i < 32; ++i) tB[i] = __builtin_nontemporal_load(cB.src + (size_t)(2 * i) * 1024); }
        CVT_OUT(dB);
    }
#undef CVT_OUT
}

__device__ __forceinline__ float fexp_(float x) { return __builtin_amdgcn_exp2f(x * 1.4426950408889634f); }
__device__ __forceinline__ float logsigmoidf_(float x) { const float e = fexp_(-fabsf(x)); return fminf(x, 0.0f) - 0.6931471805599453f * __builtin_amdgcn_logf(1.0f + e); }
__device__ __forceinline__ void gla_prep_unit(const P& a, LAS unsigned char* lds, int unit) {
    int tid = threadIdx.x; asm volatile("" : "+v"(tid));     const int wave = __builtin_amdgcn_readfirstlane(tid >> 6), lane = tid & 63;
    const int b = unit >> 5, chunk = unit & 31, tok0 = b * SEQ + chunk * 64;
    const bf16_t* H = (const bf16_t*)(a.ws + WS_H); const bf16_t* WalT = (const bf16_t*)(a.ws + WS_WALT); const bf16_t* proj = (const bf16_t*)(a.ws + WS_PROJ);
    LAS float* part = (LAS float*)lds;
    LAS float* alow = (LAS float*)(lds + 8192);
    LAS float* seg = (LAS float*)(lds + 12288);
    constexpr int GP_KDT = 16384, GP_VT = 34816;
    {
        const int rg = wave & 3, kh = wave >> 2, r = lane & 15, q = lane >> 4;
        f32x4 acc = (f32x4){0.f, 0.f, 0.f, 0.f};
        const bf16_t* ap = H + (size_t)(tok0 + 16 * rg + r) * D + 512 * kh + 8 * q; const bf16_t* bp = WalT + (size_t)r * D + 512 * kh + 8 * q;
#pragma unroll 8
        for (int s = 0; s < 16; ++s) { const bf16x8 av = *(const bf16x8*)(ap + 32 * s), bv = *(const bf16x8*)(bp + 32 * s); acc = __builtin_amdgcn_mfma_f32_16x16x32_bf16(bv, av, acc, 0, 0, 0); }
        *(LAS f32x4*)(part + (kh * 64 + 16 * rg + r) * 16 + 4 * q) = acc;
    }
    __syncthreads();
    if (tid < 256) { *(LAS f32x4*)(alow + tid * 4) = *(LAS f32x4*)(part + tid * 4) + *(LAS f32x4*)(part + 1024 + tid * 4); }
    __syncthreads();
    const int dp = tid & 63, tq = wave;
    const float* w_a2 = a.in[5]; const float* b_a2 = a.in[6];
    const int ep = tid & 127, sq4 = tid >> 7;
    f32x2 w2[16], w2n[16]; f32x2 b2, b2n; unsigned qv[8], kv[8], qvn[8], kvn[8], sv[16], svn[16];
#define GP_LOADS(h_, W2, B2, QV, KV, SV) do { const int dc_ = (h_) * 128 + 2 * dp; \
        _Pragma("unroll") for (int r = 0; r < 16; ++r) W2[r] = *(const f32x2*)(w_a2 + r * 512 + dc_); \
        B2 = *(const f32x2*)(b_a2 + dc_); \
        _Pragma("unroll") for (int i = 0; i < 8; ++i) { const bf16_t* rp = proj + PROJ_BLK((h_) * 128) + (size_t)(tok0 + 8 * tq + i) * 128 + 2 * dp; QV[i] = __builtin_nontemporal_load((const unsigned*)(rp + PROJ_BLK(C_QA))); KV[i] = __builtin_nontemporal_load((const unsigned*)(rp + PROJ_BLK(C_KA))); } \
        const bf16_t* v_ = proj + PROJ_BLK(C_VA + (h_) * 256) + (size_t)(tok0 + 16 * sq4) * 256 + 2 * ep; \
        _Pragma("unroll") for (int i = 0; i < 16; ++i) SV[i] = __builtin_nontemporal_load((const unsigned*)(v_ + (size_t)i * 256)); } while (0)
    GP_LOADS(0, w2, b2, qv, kv, sv);
    for (int h = 0; h < 4; ++h) {
        if (h + 1 < 4) GP_LOADS(h + 1, w2n, b2n, qvn, kvn, svn);
        float G0[8], G1[8]; float r0 = 0.f, r1 = 0.f;
#pragma unroll
        for (int i = 0; i < 8; ++i) { const LAS f32x4* al4 = (const LAS f32x4*)(alow + (8 * tq + i) * 16); float x0 = b2.x, x1 = b2.y;
#pragma unroll
            for (int r4 = 0; r4 < 4; ++r4) { const f32x4 al = al4[r4];
#pragma unroll
                for (int j = 0; j < 4; ++j) { x0 += al[j] * w2[4 * r4 + j].x; x1 += al[j] * w2[4 * r4 + j].y; } }
            r0 += logsigmoidf_(x0) * (1.0f / 16.0f); r1 += logsigmoidf_(x1) * (1.0f / 16.0f); G0[i] = r0; G1[i] = r1; }
        *(LAS f32x2*)(seg + tq * 128 + 2 * dp) = (f32x2){r0, r1};
        __syncthreads();
        float off0 = 0.f, off1 = 0.f, tot0 = 0.f, tot1 = 0.f;
#pragma unroll
        for (int q = 0; q < 8; ++q) { const f32x2 s = *(LAS f32x2*)(seg + q * 128 + 2 * dp); tot0 += s.x; tot1 += s.y; if (q < tq) { off0 += s.x; off1 += s.y; } }
        const size_t tile = (size_t)((b * 4 + h) * 32 + chunk);
        bf16_t* Qg = (bf16_t*)(a.ws + WS_QG) + tile * 8192; bf16_t* Kg = (bf16_t*)(a.ws + WS_KG) + tile * 8192;
        float kd0[8], kd1[8];
#pragma unroll
        for (int i = 0; i < 8; ++i) { const float g0 = G0[i] + off0, g1 = G1[i] + off1; const float q0 = bflo(qv[i]), q1 = bfhi(qv[i]), k0 = bflo(kv[i]), k1 = bfhi(kv[i]);
            const float e0 = fexp_(g0), e1 = fexp_(g1);
            *(unsigned*)(Qg + (8 * tq + i) * 128 + 2 * dp) = cvt_pk_bf16(q0 * e0 * 0.08838834764831845f, q1 * e1 * 0.08838834764831845f);
            *(unsigned*)(Kg + (8 * tq + i) * 128 + 2 * dp) = cvt_pk_bf16(k0 * __builtin_amdgcn_rcpf(e0), k1 * __builtin_amdgcn_rcpf(e1));
            kd0[i] = k0 * fexp_(tot0 - g0); kd1[i] = k1 * fexp_(tot1 - g1); }
        u32x4 w0, w1; w0.x = cvt_pk_bf16(kd0[0], kd0[1]); w0.y = cvt_pk_bf16(kd0[2], kd0[3]); w0.z = cvt_pk_bf16(kd0[4], kd0[5]); w0.w = cvt_pk_bf16(kd0[6], kd0[7]);
        w1.x = cvt_pk_bf16(kd1[0], kd1[1]); w1.y = cvt_pk_bf16(kd1[2], kd1[3]); w1.z = cvt_pk_bf16(kd1[4], kd1[5]); w1.w = cvt_pk_bf16(kd1[6], kd1[7]);
        *(LAS u32x4*)(lds + GP_KDT + (2 * dp) * 144 + 16 * tq) = w0; *(LAS u32x4*)(lds + GP_KDT + (2 * dp + 1) * 144 + 16 * tq) = w1;
        if (tq == 0) *(f32x2*)((float*)(a.ws + WS_DEC) + tile * 128 + 2 * dp) = (f32x2){fexp_(tot0), fexp_(tot1)};
        {
            u32x4 lo0, lo1, hi0, hi1;
#pragma unroll
            for (int j = 0; j < 4; ++j) { lo0[j] = (sv[2 * j] & 0xffffu) | (sv[2 * j + 1] << 16); lo1[j] = (sv[8 + 2 * j] & 0xffffu) | (sv[8 + 2 * j + 1] << 16);
                hi0[j] = (sv[2 * j] >> 16) | (sv[2 * j + 1] & 0xffff0000u); hi1[j] = (sv[8 + 2 * j] >> 16) | (sv[8 + 2 * j + 1] & 0xffff0000u); }
            LAS unsigned char* v0 = lds + GP_VT + (2 * ep) * 144 + sq4 * 32;
            *(LAS u32x4*)(v0) = lo0; *(LAS u32x4*)(v0 + 16) = lo1; *(LAS u32x4*)(v0 + 144) = hi0; *(LAS u32x4*)(v0 + 144 + 16) = hi1;
        }
        __syncthreads();
        {
            const int c32 = lane & 31, hi = lane >> 5;
            bf16x8 vt[4];
#pragma unroll
            for (int ks = 0; ks < 4; ++ks) vt[ks] = *(const LAS bf16x8*)(lds + GP_VT + (32 * wave + c32) * 144 + (16 * ks + 8 * hi) * 2);
            unsigned* sl = (unsigned*)a.out + tile * 8192;
#pragma unroll
            for (int tl = 0; tl < 4; ++tl) { f32x16 acc;
#pragma unroll
                for (int r = 0; r < 16; ++r) acc[r] = 0.f;
#pragma unroll
                for (int ks = 0; ks < 4; ++ks) { const bf16x8 av = *(const LAS bf16x8*)(lds + GP_KDT + (32 * tl + c32) * 144 + (16 * ks + 8 * hi) * 2); acc = __builtin_amdgcn_mfma_f32_32x32x16_bf16(av, vt[ks], acc, 0, 0, 0); }
#pragma unroll
                for (int g = 0; g < 4; ++g) sl[((tl * 4 + g) * 2 + hi) * 256 + 32 * wave + c32] = pk4_fp8(acc[4 * g], acc[4 * g + 1], acc[4 * g + 2], acc[4 * g + 3]); }
        }
        __syncthreads();
#pragma unroll
        for (int r = 0; r < 16; ++r) { w2[r] = w2n[r]; sv[r] = svn[r]; }
#pragma unroll
        for (int i = 0; i < 8; ++i) { qv[i] = qvn[i]; kv[i] = kvn[i]; }
        b2 = b2n;
    }
#undef GP_LOADS
}

__device__ __forceinline__ void gla_combine_unit(const P& a, int unit) {
    const int tid = threadIdx.x, bh = unit >> 4, i8 = (unit & 15) * 512 + tid;
    const int d0 = 32 * (i8 >> 11) + 8 * ((i8 >> 9) & 3) + 4 * ((i8 >> 8) & 1);
    const unsigned* sl8 = (const unsigned*)a.out + (size_t)bh * 32 * 8192 + i8; u32x2* sl = (u32x2*)(a.ws + WS_SLOC) + (size_t)bh * 32 * 8192 + i8;
    const f32x4* dc = (const f32x4*)((const float*)(a.ws + WS_DEC) + (size_t)bh * 32 * 128 + d0);
    f32x4 s = (f32x4){0.f, 0.f, 0.f, 0.f};
    for (int cb = 0; cb < 32; cb += 8) {
        unsigned loc[8]; f32x4 dv[8];
#pragma unroll
        for (int i = 0; i < 8; ++i) { loc[i] = __builtin_nontemporal_load(sl8 + (size_t)(cb + i) * 8192); dv[i] = dc[(cb + i) * 32]; }
#pragma unroll
        for (int i = 0; i < 8; ++i) { if (cb + i < 31) {
            s.x = dv[i].x * s.x + __builtin_amdgcn_cvt_f32_fp8((int)loc[i], 0); s.y = dv[i].y * s.y + __builtin_amdgcn_cvt_f32_fp8((int)loc[i], 1);
            s.z = dv[i].z * s.z + __builtin_amdgcn_cvt_f32_fp8((int)loc[i], 2); s.w = dv[i].w * s.w + __builtin_amdgcn_cvt_f32_fp8((int)loc[i], 3);
            u32x2 w; w.x = cvt_pk_bf16(s.x, s.y); w.y = cvt_pk_bf16(s.z, s.w); sl[(size_t)(cb + i) * 8192] = w; } }
    }
}

constexpr int GL_QG = 0, GL_KG = 17408, GL_VT = 53248, GL_AM = 90112, GL_OST = 0;
constexpr int GL_QS = 272, GL_TS = 144, GL_OS = 528;
__device__ __forceinline__ int crow(int r, int hi) { return (r & 3) + 8 * (r >> 2) + 4 * hi; }
__device__ __forceinline__ void gla_out_unit(const P& a, LAS unsigned char* lds, int unit) {
    int tid = threadIdx.x; asm volatile("" : "+v"(tid)); const int w = __builtin_amdgcn_readfirstlane(tid >> 6), lane = tid & 63, c32 = lane & 31, hi = lane >> 5;
    const int bh = unit >> 5, chunk = unit & 31, b = bh >> 2, h = bh & 3;
    const bf16_t* proj = (const bf16_t*)(a.ws + WS_PROJ); bf16_t* oab = (bf16_t*)(a.ws + WS_OAB); const float* ggo = a.in[7];
    const size_t tile = (size_t)bh * 32 + chunk;
    {
        const u32x4* q_ = (const u32x4*)((const bf16_t*)(a.ws + WS_QG) + tile * 8192); const u32x4* k_ = (const u32x4*)((const bf16_t*)(a.ws + WS_KG) + tile * 8192);
        u32x4 sq[2], sk[2]; unsigned sv[16];
        sq[0] = __builtin_nontemporal_load(q_ + tid); sq[1] = __builtin_nontemporal_load(q_ + tid + 512); sk[0] = __builtin_nontemporal_load(k_ + tid); sk[1] = __builtin_nontemporal_load(k_ + tid + 512);
        const int ep = tid & 127, sq4 = tid >> 7;
        const bf16_t* v_ = proj + PROJ_BLK(C_VA + h * 256) + (size_t)(b * SEQ + chunk * 64 + 16 * sq4) * 256 + 2 * ep;
#pragma unroll
        for (int i = 0; i < 16; ++i) sv[i] = __builtin_nontemporal_load((const unsigned*)(v_ + (size_t)i * 256));
#pragma unroll
        for (int i = 0; i < 2; ++i) { const int p = tid + 512 * i;
            *(LAS u32x4*)(lds + GL_QG + (p >> 4) * GL_QS + (p & 15) * 16) = sq[i]; *(LAS u32x4*)(lds + GL_KG + (p >> 4) * GL_QS + (p & 15) * 16) = sk[i]; }
        u32x4 lo0, lo1, hi0, hi1;
#pragma unroll
        for (int j = 0; j < 4; ++j) { lo0[j] = (sv[2 * j] & 0xffffu) | (sv[2 * j + 1] << 16); lo1[j] = (sv[8 + 2 * j] & 0xffffu) | (sv[8 + 2 * j + 1] << 16);
            hi0[j] = (sv[2 * j] >> 16) | (sv[2 * j + 1] & 0xffff0000u); hi1[j] = (sv[8 + 2 * j] >> 16) | (sv[8 + 2 * j + 1] & 0xffff0000u); }
        LAS unsigned char* v0 = lds + GL_VT + (2 * ep) * GL_TS + sq4 * 32;
        *(LAS u32x4*)(v0) = lo0; *(LAS u32x4*)(v0 + 16) = lo1; *(LAS u32x4*)(v0 + GL_TS) = hi0; *(LAS u32x4*)(v0 + GL_TS + 16) = hi1;
    }
    u32x2 sf[4][2][2];
    if (chunk > 0) { const u32x2* sl = (const u32x2*)(a.ws + WS_SLOC) + (tile - 1) * 8192;
#pragma unroll
        for (int tl = 0; tl < 4; ++tl)
#pragma unroll
            for (int s = 0; s < 2; ++s)
#pragma unroll
                for (int q = 0; q < 2; ++q) sf[tl][s][q] = __builtin_nontemporal_load(sl + ((tl * 4 + 2 * s + q) * 2 + hi) * 256 + 32 * w + c32); }
    __syncthreads();
    if (w < 3) {
        const int ti = (w + 1) >> 1, si = w >> 1;
        f32x16 A;
#pragma unroll
        for (int r = 0; r < 16; ++r) A[r] = 0.f;
#pragma unroll
        for (int s = 0; s < 8; ++s) { const bf16x8 av = *(const LAS bf16x8*)(lds + GL_QG + (32 * ti + c32) * GL_QS + (16 * s + 8 * hi) * 2), bv = *(const LAS bf16x8*)(lds + GL_KG + (32 * si + c32) * GL_QS + (16 * s + 8 * hi) * 2);
            A = __builtin_amdgcn_mfma_f32_32x32x16_bf16(av, bv, A, 0, 0, 0); }
        const int sidx = 32 * si + c32;
#pragma unroll
        for (int r = 0; r < 16; ++r) { const int t = 32 * ti + crow(r, hi); const float v = (sidx <= t) ? A[r] : 0.f;
            *(LAS bf16_t*)(lds + GL_AM + t * GL_TS + sidx * 2) = (bf16_t)(cvt_pk_bf16(v, 0.f) & 0xffffu); }
    }
    __syncthreads();
    f32x16 o[2];
    {
        bf16x8 vt[4];
#pragma unroll
        for (int ks = 0; ks < 4; ++ks) vt[ks] = *(const LAS bf16x8*)(lds + GL_VT + (32 * w + c32) * GL_TS + (16 * ks + 8 * hi) * 2);
#pragma unroll
        for (int ti = 0; ti < 2; ++ti) {
#pragma unroll
            for (int r = 0; r < 16; ++r) o[ti][r] = 0.f;
            if (chunk > 0) {
#pragma unroll
                for (int tl = 0; tl < 4; ++tl)
#pragma unroll
                    for (int s = 0; s < 2; ++s) { const LAS unsigned char* qp = lds + GL_QG + (32 * ti + c32) * GL_QS + (32 * tl + 16 * s + 4 * hi) * 2;
                        const s16x4 lo = *(const LAS s16x4*)qp, hh = *(const LAS s16x4*)(qp + 16);
                        const bf16x8 aop = __builtin_shufflevector(lo, hh, 0, 1, 2, 3, 4, 5, 6, 7);
                        const u32x4 bw = {sf[tl][s][0].x, sf[tl][s][0].y, sf[tl][s][1].x, sf[tl][s][1].y};
                        o[ti] = __builtin_amdgcn_mfma_f32_32x32x16_bf16(aop, __builtin_bit_cast(bf16x8, bw), o[ti], 0, 0, 0); }
            }
#pragma unroll
            for (int ks = 0; ks < 4; ++ks) { if (ti == 0 && ks >= 2) continue;
                const bf16x8 av = *(const LAS bf16x8*)(lds + GL_AM + (32 * ti + c32) * GL_TS + (16 * ks + 8 * hi) * 2);
                o[ti] = __builtin_amdgcn_mfma_f32_32x32x16_bf16(av, vt[ks], o[ti], 0, 0, 0); }
        }
    }
    __syncthreads();
#pragma unroll
    for (int ti = 0; ti < 2; ++ti)
#pragma unroll
        for (int r = 0; r < 16; ++r) *(LAS bf16_t*)(lds + GL_OST + (32 * ti + crow(r, hi)) * GL_OS + (32 * w + c32) * 2) = (bf16_t)(cvt_pk_bf16(o[ti][r], 0.f) & 0xffffu);
    __syncthreads();
    {
        const int t = tid >> 3, sg = tid & 7; const size_t tok = (size_t)(b * SEQ + chunk * 64 + t);
        u32x4 ov[4]; float ss = 0.f;
#pragma unroll
        for (int j = 0; j < 4; ++j) { ov[j] = *(const LAS u32x4*)(lds + GL_OST + t * GL_OS + sg * 64 + j * 16);
#pragma unroll
            for (int i = 0; i < 4; ++i) { const float x0 = bflo(ov[j][i]), x1 = bfhi(ov[j][i]); ss += x0 * x0 + x1 * x1; } }
        ss += __shfl_xor(ss, 1); ss += __shfl_xor(ss, 2); ss += __shfl_xor(ss, 4);
        const float rstd = 1.0f / sqrtf(ss * (1.0f / 256.0f) + EPS);
        const bf16_t* rap = proj + PROJ_BLK(C_RA + h * 256) + tok * 256 + sg * 32; bf16_t* op = oab + tok * 2048 + h * 256 + sg * 32; const float* gp = ggo + sg * 32;
#pragma unroll
        for (int j = 0; j < 4; ++j) { const u32x4 ra = __builtin_nontemporal_load((const u32x4*)(rap + 8 * j)); const f32x4 g0 = *(const f32x4*)(gp + 8 * j), g1 = *(const f32x4*)(gp + 8 * j + 4); u32x4 wv;
#pragma unroll
            for (int i = 0; i < 4; ++i) { const float r0 = bflo(ra[i]), r1 = bfhi(ra[i]); const float ga = (i < 2) ? g0[2 * i] : g1[2 * i - 4], gb = (i < 2) ? g0[2 * i + 1] : g1[2 * i - 3];
                wv[i] = cvt_pk_bf16(bflo(ov[j][i]) * rstd * ga * (r0 * fsigmoid(r0)), bfhi(ov[j][i]) * rstd * gb * (r1 * fsigmoid(r1))); }
            *(u32x4*)(op + 8 * j) = wv; }
    }
    __syncthreads();
}
namespace moba {
constexpr int HD = 128;
constexpr float SCALE = 0.08838834764831845f;
constexpr float THR = 8.f;
constexpr int NW = 8, QBLK = 32, KVBLK = 64, QB = NW * QBLK;
constexpr int SHM_V = KVBLK * HD * 2, SHM_K = KVBLK * HD * 2;
constexpr int OFF_WS = 2 * SHM_V + 2 * SHM_K;
constexpr int OFF_RTAB = OFF_WS + NW * 64 * 4;
constexpr int OFF_KM = OFF_RTAB + 2400 * 4;
constexpr int OFF_MISC = OFF_KM + 8 * 128 * 4;
constexpr int OFF_SEL = OFF_MISC + 64;
constexpr int LDS_BYTES = OFF_SEL + 2048;
constexpr int LDP = HD, LDO = 2048;

#define KSWZ(row, colB) ((row) * 256 + ((colB) ^ (((row) & 7) << 4)))
#define SBAR() __builtin_amdgcn_sched_barrier(0)
__device__ __forceinline__ int v_st(int k, int c) { const int kk = (k & ~0xC) | ((k & 4) << 1) | ((k & 8) >> 1); return ((kk >> 3) * 4 + (c >> 5)) * 512 + ((kk & 7) * 32 + (c & 31)) * 2; }
__device__ __forceinline__ int v_rd_base(int lane) { return ((lane & 3) << 3) | (((lane >> 2) & 3) << 6) | (((lane >> 4) & 1) << 5) | (((lane >> 5) & 1) << 8); }
constexpr int v_rd_off(int d0, int ks, int half) { return d0 * 512 + ks * 4096 + half * 2048; }
__device__ __forceinline__ int crow(int r, int hi) { return (r & 3) + 8 * (r >> 2) + 4 * hi; }
__device__ __forceinline__ unsigned cvtpk(float lo, float hi) { unsigned r; asm volatile("v_cvt_pk_bf16_f32 %0, %1, %2" : "=v"(r) : "v"(lo), "v"(hi)); return r; }

__device__ __forceinline__ void mask_tile(f32x16& p0, f32x16& p1, int dq) {
    const float NEG = -__builtin_inff();
#pragma unroll
    for (int r = 0; r < 16; ++r) {
        const int c = (r & 3) + 8 * (r >> 2);
        if (dq - c < 0) p0[r] = NEG;
        if (dq - c - 32 < 0) p1[r] = NEG;
    }
}
__device__ __forceinline__ void bias_tile(f32x16& p0, f32x16& p1, const LAS float* rt) {
#pragma unroll
    for (int r = 0; r < 16; ++r) { const int c = (r & 3) + 8 * (r >> 2); p0[r] += rt[c]; p1[r] += rt[c + 32]; }
}
__device__ __forceinline__ void kill_tile(f32x16& p0, f32x16& p1) {
    const float NEG = -__builtin_inff();
#pragma unroll
    for (int r = 0; r < 16; ++r) { p0[r] = NEG; p1[r] = NEG; }
}
__device__ __forceinline__ void partialSM(f32x16& p0, f32x16& p1, float& m_reg, float& mn, float& alpha) {
    float pmax = p0[0];
#pragma unroll
    for (int r = 1; r < 16; ++r) pmax = fmaxf(pmax, p0[r]);
#pragma unroll
    for (int r = 0; r < 16; ++r) pmax = fmaxf(pmax, p1[r]);
    { auto rr = __builtin_amdgcn_permlane32_swap(__float_as_uint(pmax), __float_as_uint(pmax), false, false);
      pmax = fmaxf(__uint_as_float(rr[0]), __uint_as_float(rr[1])); }
    constexpr float C2 = 1.4426950408889634f * SCALE;
    if (__builtin_expect(__all((pmax - m_reg) * SCALE <= THR), 1)) { mn = m_reg; alpha = 1.f; }
    else { mn = fmaxf(m_reg, pmax); alpha = __builtin_amdgcn_exp2f((m_reg - mn) * C2); m_reg = mn; }
    const float mnL = -mn * C2;
#pragma unroll
    for (int r = 0; r < 16; ++r) p0[r] = fmaf(p0[r], C2, mnL);
#pragma unroll
    for (int r = 0; r < 16; ++r) p1[r] = fmaf(p1[r], C2, mnL);
#pragma unroll
    for (int r = 0; r < 16; ++r) p0[r] = __builtin_amdgcn_exp2f(p0[r]);
}
__device__ __forceinline__ void finishSM(f32x16& p0, f32x16& p1, float alpha, float& l_reg, bf16x8& pa0, bf16x8& pa1, bf16x8& pa2, bf16x8& pa3) {
#pragma unroll
    for (int r = 0; r < 16; ++r) p1[r] = __builtin_amdgcn_exp2f(p1[r]);
    float ps = 0;
#pragma unroll
    for (int r = 0; r < 16; ++r) ps += p0[r];
#pragma unroll
    for (int r = 0; r < 16; ++r) ps += p1[r];
    { auto rr = __builtin_amdgcn_permlane32_swap(__float_as_uint(ps), __float_as_uint(ps), false, false);
      ps = __uint_as_float(rr[0]) + __uint_as_float(rr[1]); }
    l_reg = l_reg * alpha + ps;
#define PK4(P, B_, OUT) do { unsigned a0 = cvtpk(P[B_+0], P[B_+1]), a1 = cvtpk(P[B_+2], P[B_+3]);                          \
        unsigned b0 = cvtpk(P[B_+4], P[B_+5]), b1 = cvtpk(P[B_+6], P[B_+7]);                                             \
        auto r0 = __builtin_amdgcn_permlane32_swap(a0, b0, false, false); auto r1 = __builtin_amdgcn_permlane32_swap(a1, b1, false, false); \
        u32x4 w = {r0[0], r1[0], r0[1], r1[1]}; OUT = __builtin_bit_cast(bf16x8, w); } while (0)
    PK4(p0, 0, pa0); PK4(p0, 8, pa1); PK4(p1, 0, pa2); PK4(p1, 8, pa3);
#undef PK4
}
template <int KB>
__device__ __forceinline__ void qkt(f32x16& p0, f32x16& p1, const char* K_lds, int r32, int hi, const bf16x8* qr) {
#pragma unroll
    for (int r = 0; r < 16; ++r) { p0[r] = 0.f; p1[r] = 0.f; }
    const char* kb[4];
#pragma unroll
    for (int dd = 0; dd < 4; ++dd) kb[dd] = K_lds + KB * SHM_K + KSWZ(r32, (dd * 16 + hi * 8) * 2);
#pragma unroll
    for (int d0 = 0; d0 < 8; ++d0) { const char* a = kb[d0 & 3] + (d0 >> 2) * 128;
        bf16x8 b0 = *reinterpret_cast<const bf16x8*>(a);
        bf16x8 b1 = *reinterpret_cast<const bf16x8*>(a + 32 * 256);
        p0 = __builtin_amdgcn_mfma_f32_32x32x16_bf16(b0, qr[d0], p0, 0, 0, 0);
        p1 = __builtin_amdgcn_mfma_f32_32x32x16_bf16(b1, qr[d0], p1, 0, 0, 0); }
}
template <int VB>
__device__ __forceinline__ void pv_tile(f32x16* o, int vb0, bf16x8 pa0, bf16x8 pa1, bf16x8 pa2, bf16x8 pa3) {
#define TRRD(dst, off) asm volatile("ds_read_b64_tr_b16 %0, %1 offset:%2" : "=&v"(dst) : "v"(vb0), "i"(off) : "memory")
#define PV_D0(d0) do { s16x4 l0, l1, l2, l3, h0, h1, h2, h3; constexpr int b_ = VB * SHM_V + v_rd_off(d0, 0, 0);   \
        TRRD(l0, b_); TRRD(h0, b_ + 2048); TRRD(l1, b_ + 4096); TRRD(h1, b_ + 6144); TRRD(l2, b_ + 8192); TRRD(h2, b_ + 10240); TRRD(l3, b_ + 12288); TRRD(h3, b_ + 14336); \
        asm volatile("s_waitcnt lgkmcnt(0)" ::: "memory"); SBAR();   \
        o[d0] = __builtin_amdgcn_mfma_f32_32x32x16_bf16(pa0, (bf16x8){l0[0], l0[1], l0[2], l0[3], h0[0], h0[1], h0[2], h0[3]}, o[d0], 0, 0, 0);   \
        o[d0] = __builtin_amdgcn_mfma_f32_32x32x16_bf16(pa1, (bf16x8){l1[0], l1[1], l1[2], l1[3], h1[0], h1[1], h1[2], h1[3]}, o[d0], 0, 0, 0);   \
        o[d0] = __builtin_amdgcn_mfma_f32_32x32x16_bf16(pa2, (bf16x8){l2[0], l2[1], l2[2], l2[3], h2[0], h2[1], h2[2], h2[3]}, o[d0], 0, 0, 0);   \
        o[d0] = __builtin_amdgcn_mfma_f32_32x32x16_bf16(pa3, (bf16x8){l3[0], l3[1], l3[2], l3[3], h3[0], h3[1], h3[2], h3[3]}, o[d0], 0, 0, 0); } while (0)
    PV_D0(0); PV_D0(1); PV_D0(2); PV_D0(3);
#undef PV_D0
#undef TRRD
}

struct BlockRef { const bf16_t* Q; const bf16_t* K; const bf16_t* V; bf16_t* O; int qb; int b, h; };
struct Seam { bf16x8 qr[8]; bf16x8 st_v0, st_v1, st_k0, st_k1; };
#define VMW() asm volatile("s_waitcnt vmcnt(0)" ::: "memory")
#define VMWN(n) asm volatile("s_waitcnt vmcnt(%0)" :: "i"(n) : "memory")
#define LD8(p) (*reinterpret_cast<const bf16x8*>(p))
#define SLOAD_H(Kp, Vp, k0) do { const char* kb__ = (const char*)(Kp) + (size_t)(k0) * (LDP * 2); const char* vb__ = (const char*)(Vp) + (size_t)(k0) * (LDP * 2); \
        S.st_v0 = LD8(vb__ + kvoff); S.st_v1 = LD8(vb__ + 32 * LDP * 2 + kvoff); S.st_k0 = LD8(kb__ + kvoff); S.st_k1 = LD8(kb__ + 32 * LDP * 2 + kvoff); } while (0)
#define SWRITE_HK(bf) do { *(bf16x8*)(K_lds + (bf) * SHM_K + kws) = S.st_k0; *(bf16x8*)(K_lds + (bf) * SHM_K + kws + 32 * 256) = S.st_k1; } while (0)
#define SWRITE_HV(bf) do { *(bf16x8*)(V_lds + (bf) * SHM_V + vst0) = S.st_v0; *(bf16x8*)(V_lds + (bf) * SHM_V + vst1) = S.st_v1; } while (0)
#define SWRITE_H(bf) do { SWRITE_HV(bf); SWRITE_HK(bf); } while (0)

__device__ __forceinline__ void prime(const BlockRef& cur, char* lds, Seam& S) {
    int tid = threadIdx.x; asm volatile("" : "+v"(tid));     const int wid = __builtin_amdgcn_readfirstlane(tid >> 6), lane = tid & 63, r32 = lane & 31, hi = lane >> 5;
    const int sr = tid >> 4, sc = (tid & 15) * 8, kws = KSWZ(sr, sc * 2); char* K_lds = lds + 2 * SHM_V;
    const unsigned kvoff = (unsigned)(sr * LDP + sc) * 2u, qvoff = (unsigned)(r32 * LDP + hi * 8) * 2u;
    { const char* qb__ = (const char*)cur.Q + (size_t)(wid * QBLK) * (LDP * 2);
#pragma unroll
    for (int d0 = 0; d0 < 8; ++d0) S.qr[d0] = LD8(qb__ + qvoff + d0 * 32); }
    SLOAD_H(cur.K, cur.V, 0); VMW(); SWRITE_HK(0);
    __syncthreads();
}
__device__ __forceinline__ int rel_bucket(int n) {
    if (n < 16) return n;
    const float nf = (float)n;
    int large = 16 + (int)(logf(nf / 16.0f) / 5.545177444479562f * 16.0f);
    return large < 31 ? large : 31;
}
__device__ __forceinline__ BlockRef make_ref(const P& a, int item);
__device__ __forceinline__ int block(const P& a, const BlockRef& cur, unsigned* queue, const float* rel_bias, const float* kmp, char* lds, Seam& S) {
    int tid = threadIdx.x; asm volatile("" : "+v"(tid));     const int wid = __builtin_amdgcn_readfirstlane(tid >> 6), lane = tid & 63, r32 = lane & 31, hi = lane >> 5;
    const int qb = cur.qb, NT = 4 * (qb + 1);
    const int qlo = qb * QB + wid * QBLK, qrow = qlo + r32;
    char* V_lds = lds; char* K_lds = lds + 2 * SHM_V;
    float* ws = (float*)(lds + OFF_WS) + wid * 64; float* li_l = ws, * al_l = ws + 32;
    LAS float* rtab = (LAS float*)(LAS char*)(uintptr_t)(unsigned)(uintptr_t)(lds + OFF_RTAB);
    float* kmL = (float*)(lds + OFF_KM);
    volatile int* misc = (volatile int*)(lds + OFF_MISC);
    if (tid == 0) misc[0] = (int)__hip_atomic_fetch_add(queue, 1u, __ATOMIC_RELAXED, __HIP_MEMORY_SCOPE_AGENT);
    for (int i = tid; i < 2400; i += NW * 64) { const int dist = 2047 - i; rtab[i] = dist >= 0 ? rel_bias[rel_bucket(dist) * 8 + cur.h] * (1.0f / SCALE) : -__builtin_inff(); }
    for (int i = tid; i < qb * 128; i += NW * 64) { const int j = i >> 7, dd = i & 127; const size_t o = ((size_t)(cur.b * 8 + j)) * 1024 + cur.h * 128 + dd;
        kmL[i] = (kmp[o] + kmp[o + 64 * 1024]) * (1.0f / 256.0f); }
    __syncthreads();
    const int next_item = __builtin_amdgcn_readfirstlane(misc[0]);
    const BlockRef nxt = next_item < 512 ? make_ref(a, next_item) : cur;
    unsigned selmask = 0;
    {
        float sc7[7];
#pragma unroll
        for (int j = 0; j < 7; ++j) { sc7[j] = -__builtin_inff();
            if (j < qb) { float acc = 0.f;
#pragma unroll
                for (int d0 = 0; d0 < 8; ++d0) { const u32x4 q4 = __builtin_bit_cast(u32x4, S.qr[d0]); const f32x4 k0 = *(const f32x4*)(kmL + j * 128 + d0 * 16 + hi * 8), k1 = *(const f32x4*)(kmL + j * 128 + d0 * 16 + hi * 8 + 4);
                    acc += bflo(q4[0]) * k0[0] + bfhi(q4[0]) * k0[1] + bflo(q4[1]) * k0[2] + bfhi(q4[1]) * k0[3] + bflo(q4[2]) * k1[0] + bfhi(q4[2]) * k1[1] + bflo(q4[3]) * k1[2] + bfhi(q4[3]) * k1[3]; }
                acc += __shfl_xor(acc, 32); sc7[j] = acc; } }
#pragma unroll
        for (int j = 0; j < 7; ++j) { int rank = 0;
#pragma unroll
            for (int i = 0; i < 7; ++i) { if (i != j) rank += (sc7[i] > sc7[j] || (sc7[i] == sc7[j] && i < j)) ? 1 : 0; }
            if (j < qb && (qb <= 3 || rank < 3)) selmask |= 1u << j; }
    }
    LAS unsigned* selp = (LAS unsigned*)(LAS char*)(uintptr_t)(unsigned)(uintptr_t)(lds + OFF_SEL) + tid;
    *selp = selmask;
    float m_reg = -1e30f, l_reg = 0; f32x16 o[4];
#pragma unroll
    for (int d = 0; d < 4; ++d)
#pragma unroll
        for (int r = 0; r < 16; ++r) o[d][r] = 0.f;
    const int sr = tid >> 4, sc = (tid & 15) * 8, vst0 = v_st(sr, sc), vst1 = v_st(32 + sr, sc), kws = KSWZ(sr, sc * 2);
    const unsigned kvoff = (unsigned)(sr * LDP + sc) * 2u;
    const int vb0 = (int)(uintptr_t)V_lds + v_rd_base(lane);
    const bf16_t* Kh = cur.K; const bf16_t* Vh = cur.V;
#define RESC(a) do { if (__any((a) < 1.f)) { if (hi == 0) al_l[r32] = (a); asm volatile("s_waitcnt lgkmcnt(0)" ::: "memory");              \
                     for (int d_ = 0; d_ < 4; ++d_) for (int r = 0; r < 16; ++r) o[d_][r] *= al_l[crow(r, hi)]; } } while (0)
#define KBASE(t) ((t) * KVBLK)
#define MASKT(P0_, P1_, t) do { const int kb_ = KBASE(t); const int jb_ = (t) >> 2; \
        const bool on_ = (jb_ == qb) || ((*selp >> jb_) & 1u); \
        bias_tile(P0_, P1_, on_ ? rtab + (kb_ + 4 * hi - qrow + 2047) : rtab + 2304); } while (0)
    constexpr int NQL = 8;
#define SEAM_K0() do { VMWN(NQL); SWRITE_HK(0); SBAR(); } while (0)
    f32x16 pA0, pA1, pB0, pB1; float mnA, mnB, alA, alB; bf16x8 pa0, pa1, pa2, pa3;
    SWRITE_HV(0); SBAR();
    if (NT > 1) { SLOAD_H(Kh, Vh, KBASE(1)); }
    SBAR(); qkt<0>(pA0, pA1, K_lds, r32, hi, S.qr);
    MASKT(pA0, pA1, 0); partialSM(pA0, pA1, m_reg, mnA, alA);
    if (NT > 1) { VMW(); SWRITE_H(1); }
    __syncthreads();
#define HALF_STEP(PX0, PX1, mnX, alX, PY0, PY1, alY, t, KB, VB, SB) do {                                                      \
        SBAR(); if ((t) + 1 < NT) { SLOAD_H(Kh, Vh, KBASE((t) + 1)); SBAR(); }      \
        qkt<KB>(PX0, PX1, K_lds, r32, hi, S.qr);                                             \
        finishSM(PY0, PY1, alY, l_reg, pa0, pa1, pa2, pa3); SBAR();                                                           \
        pv_tile<VB>(o, vb0, pa0, pa1, pa2, pa3); MASKT(PX0, PX1, (t)); partialSM(PX0, PX1, m_reg, mnX, alX);                                        \
        __syncthreads();                                                                                                      \
        if ((t) + 1 < NT) { VMW(); SWRITE_H(SB); }                                                                          \
        RESC(alX); __syncthreads(); } while (0)
    for (int t = 1; t + 1 < NT; t += 2) {
        HALF_STEP(pB0, pB1, mnB, alB, pA0, pA1, alA, t, 1, 0, 0);
        HALF_STEP(pA0, pA1, mnA, alA, pB0, pB1, alB, t + 1, 0, 1, 1);
    }
    { SBAR(); qkt<1>(pB0, pB1, K_lds, r32, hi, S.qr); SBAR(); }
    SLOAD_H(nxt.K, nxt.V, 0); SBAR();
    { const char* qb__ = (const char*)nxt.Q + (size_t)(wid * QBLK) * (LDP * 2); int l_ = lane; asm volatile("" : "+v"(l_));
      const unsigned qvoff = (unsigned)((l_ & 31) * LDP + (l_ >> 5) * 8) * 2u;
#pragma unroll
    for (int d0 = 0; d0 < 8; ++d0) S.qr[d0] = LD8(qb__ + qvoff + d0 * 32); }
    SBAR();
    finishSM(pA0, pA1, alA, l_reg, pa0, pa1, pa2, pa3); SBAR();
    pv_tile<0>(o, vb0, pa0, pa1, pa2, pa3);
    { MASKT(pB0, pB1, NT - 1); partialSM(pB0, pB1, m_reg, mnB, alB); __syncthreads(); RESC(alB);
      finishSM(pB0, pB1, alB, l_reg, pa0, pa1, pa2, pa3); SBAR(); pv_tile<1>(o, vb0, pa0, pa1, pa2, pa3); }
    SBAR(); SEAM_K0();
    if (hi == 0) li_l[r32] = l_reg; asm volatile("s_waitcnt lgkmcnt(0)" ::: "memory");
    float rli[16];
#pragma unroll
    for (int r = 0; r < 16; ++r) rli[r] = __builtin_amdgcn_rcpf(li_l[crow(r, hi)]);
    char* Ow = (char*)cur.O + (size_t)(wid * QBLK) * (LDO * 2); const unsigned ovoff = (unsigned)(4 * hi * LDO + r32) * 2u;
#pragma unroll
    for (int r = 0; r < 16; ++r) { const int orow0 = (r & 3) + 8 * (r >> 2);
#pragma unroll
        for (int d0 = 0; d0 < 4; ++d0) { const float v = o[d0][r] * rli[r];
            const float vn = __shfl_xor(v, 1);
            if ((r32 & 1) == 0) *(unsigned*)(Ow + (size_t)(orow0 * LDO * 2 + d0 * 64) + ovoff) = cvtpk(v, vn); } }
    __syncthreads();
    return next_item;
#undef RESC
#undef KBASE
#undef MASKT
#undef SEAM_K0
#undef HALF_STEP
}
#undef ROWP
#undef VMW
#undef VMWN
#undef LD8
#undef SLOAD_H
#undef SWRITE_HK
#undef SWRITE_HV
#undef SWRITE_H

__device__ __forceinline__ BlockRef make_ref(const P& a, int item) {
    const int qb = 7 - (item >> 6), bh = item & 63, b = bh >> 3, h = bh & 7;
    const bf16_t* proj = (const bf16_t*)(a.ws + WS_PROJ);
    BlockRef r; r.b = b; r.h = h; r.qb = qb;
    r.Q = proj + PROJ_BLK(C_QB + h * HD) + (size_t)(b * SEQ + qb * QB) * LDP;
    r.K = proj + PROJ_BLK(C_KB + h * HD) + (size_t)(b * SEQ) * LDP;
    r.V = proj + PROJ_BLK(C_VB + h * HD) + (size_t)(b * SEQ) * LDP;
    r.O = (bf16_t*)(a.ws + WS_OAB) + (size_t)(b * SEQ + qb * QB) * LDO + 1024 + h * HD;
    return r;
}
}
__device__ __forceinline__ void router_unit(const P& a, LAS unsigned char* lds, int unit) {
    int tid = threadIdx.x; asm volatile("" : "+v"(tid)); const int wave = __builtin_amdgcn_readfirstlane(tid >> 6), lane = tid & 63, c32 = lane & 31, hi = lane >> 5;
    const int tg = wave & 1, kq = wave >> 1;
    const bf16_t* x1 = (const bf16_t*)(a.ws + WS_X1); const float* g = a.in[11]; const float* br = a.in[13];
    unsigned char* A2 = a.ws + WS_A2; const u32x4* frag = (const u32x4*)(a.ws + WS_WRF);
    LAS float* Lw = (LAS float*)(lds + wave * 4352);
    LAS float* ssp = (LAS float*)(lds + 8 * 4352);
    LAS unsigned* hist = (LAS unsigned*)(lds + 8 * 4352 + 2048);
    LAS unsigned* base = hist + 32;
    if (tid < 32) hist[tid] = 0u;
    const int tok = unit * 64 + tg * 32 + c32;
    f32x16 L;
#pragma unroll
    for (int r = 0; r < 16; ++r) L[r] = 0.f;
    float ss = 0.f;
    const bf16_t* xr = x1 + (size_t)tok * D + 8 * hi + 256 * kq; unsigned char* ar = A2 + (size_t)tok * D + 8 * hi + 256 * kq; const float* gr = g + 8 * hi + 256 * kq;
#pragma unroll 4
    for (int s = 0; s < 16; ++s) {
        const u32x4 xw = *(const u32x4*)(xr + 16 * s); const f32x4 xa = {bflo(xw.x), bfhi(xw.x), bflo(xw.y), bfhi(xw.y)}, xb = {bflo(xw.z), bfhi(xw.z), bflo(xw.w), bfhi(xw.w)}, ga = *(const f32x4*)(gr + 16 * s), gb = *(const f32x4*)(gr + 16 * s + 4);
        ss += (xa.x * xa.x + xa.y * xa.y) + (xa.z * xa.z + xa.w * xa.w) + (xb.x * xb.x + xb.y * xb.y) + (xb.z * xb.z + xb.w * xb.w);
        const f32x4 va = xa * ga, vb = xb * gb;
        u32x4 wh; wh.x = cvt_pk_bf16(va.x, va.y); wh.y = cvt_pk_bf16(va.z, va.w); wh.z = cvt_pk_bf16(vb.x, vb.y); wh.w = cvt_pk_bf16(vb.z, vb.w);
        { u32x2 w8; w8.x = pk4_fp8(va.x, va.y, va.z, va.w); w8.y = pk4_fp8(vb.x, vb.y, vb.z, vb.w); *(u32x2*)(ar + 16 * s) = w8; }
        u32x4 wl; wl.x = cvt_pk_bf16(va.x - bflo(wh.x), va.y - bfhi(wh.x)); wl.y = cvt_pk_bf16(va.z - bflo(wh.y), va.w - bfhi(wh.y));
        wl.z = cvt_pk_bf16(vb.x - bflo(wh.z), vb.y - bfhi(wh.z)); wl.w = cvt_pk_bf16(vb.z - bflo(wh.w), vb.w - bfhi(wh.w));
        const bf16x8 ah = __builtin_bit_cast(bf16x8, wh), al = __builtin_bit_cast(bf16x8, wl);
        const bf16x8 bh = __builtin_bit_cast(bf16x8, frag[(16 * kq + s) * 64 + lane]), bl = __builtin_bit_cast(bf16x8, frag[4096 + (16 * kq + s) * 64 + lane]);
        L = __builtin_amdgcn_mfma_f32_32x32x16_bf16(ah, bh, L, 0, 0, 0);
        L = __builtin_amdgcn_mfma_f32_32x32x16_bf16(ah, bl, L, 0, 0, 0);
        L = __builtin_amdgcn_mfma_f32_32x32x16_bf16(al, bh, L, 0, 0, 0);
    }
#pragma unroll
    for (int r = 0; r < 16; ++r) Lw[((r & 3) + 8 * (r >> 2) + 4 * hi) * 33 + c32] = L[r];
    ssp[wave * 64 + lane] = ss;
    __syncthreads();
    int e4[4] = {0, 0, 0, 0}; float w4[4] = {0.f, 0.f, 0.f, 0.f}; unsigned loc[4] = {0u, 0u, 0u, 0u}; float rstd = 0.f;
    const bool sel = (wave < 2) && (hi == 0);
    if (sel) {
        float sst = 0.f;
#pragma unroll
        for (int q = 0; q < 4; ++q) sst += ssp[(wave + 2 * q) * 64 + c32] + ssp[(wave + 2 * q) * 64 + 32 + c32];
        rstd = 1.0f / sqrtf(sst * (1.0f / D) + EPS);
        float lg[32];
#pragma unroll
        for (int e = 0; e < 32; ++e) { const LAS float* lp = (const LAS float*)(lds + wave * 4352) + c32 * 33 + e; lg[e] = (lp[0] + lp[2 * 1088] + lp[4 * 1088] + lp[6 * 1088]) * rstd + br[e]; }
        unsigned used = 0u; float v4[4];
#pragma unroll
        for (int p = 0; p < 4; ++p) { float best = -__builtin_inff(); int bi = 0;
#pragma unroll
            for (int e = 0; e < 32; ++e) { const bool take = !((used >> e) & 1u) && lg[e] > best; best = take ? lg[e] : best; bi = take ? e : bi; }
            used |= 1u << bi; e4[p] = bi; v4[p] = best; }
        float sum = 0.f;
#pragma unroll
        for (int p = 0; p < 4; ++p) { w4[p] = expf(v4[p] - v4[0]); sum += w4[p]; }
        const float inv = 1.0f / sum;
#pragma unroll
        for (int p = 0; p < 4; ++p) { w4[p] *= inv; loc[p] = __hip_atomic_fetch_add(hist + e4[p], 1u, __ATOMIC_RELAXED, __HIP_MEMORY_SCOPE_WORKGROUP); }
    }
    __syncthreads();
    if (tid < 32) base[tid] = __hip_atomic_fetch_add((unsigned*)(a.ws + WS_CTL) + CW_COUNTS + tid, hist[tid], RLX_AGENT);
    __syncthreads();
    if (sel) {
        int* tope = (int*)(a.ws + WS_TOPE) + (size_t)tok * 4; float* wts = (float*)(a.ws + WS_WTS) + (size_t)tok * 4; int* slot = (int*)(a.ws + WS_SLOT) + (size_t)tok * 4;
#pragma unroll
        for (int p = 0; p < 4; ++p) { const int sl_ = (int)(base[e4[p]] + loc[p]); tope[p] = e4[p]; wts[p] = w4[p]; slot[p] = sl_;
            ((int*)(a.ws + WS_ROWE))[(size_t)e4[p] * T + sl_] = tok; ((float*)(a.ws + WS_RSTE))[(size_t)e4[p] * T + sl_] = rstd; }
    }
    __syncthreads();
}

__device__ __forceinline__ void moe_tables(const P& a, LAS unsigned char* lds) {
    int tid = threadIdx.x; asm volatile("" : "+v"(tid)); const int wave = tid >> 6, lane = tid & 63, e = lane & 31;
    LAS int* pstart = (LAS int*)(lds + LDS_MOE); LAS int* cnt = pstart + 64; LAS int* tile_e = pstart + 128;
    const unsigned* counts = (const unsigned*)(a.ws + WS_CTL) + CW_COUNTS;
    const int c = (int)counts[e]; const int p = ((c + 255) >> 8) << 8; int inc = p;
#pragma unroll
    for (int o = 1; o < 32; o <<= 1) { const int t = __builtin_amdgcn_ds_bpermute(((lane - o) & 63) << 2, inc); if (e >= o) inc += t; }
    if (tid < 32) { cnt[e] = c; pstart[e] = inc - p; if (e == 31) { pstart[32] = inc; tile_e[MAXTILES] = inc >> 8; } }
    for (int t = wave * 36; t < wave * 36 + 36; ++t) { const unsigned long long m = __ballot(inc <= t * 256); const int ee = __builtin_popcount((unsigned)m); if (lane == 0) tile_e[t] = ee < NE ? ee : NE - 1; }
    __syncthreads();
}

__device__ __forceinline__ void combine_rows(const P& a, LAS unsigned char* lds, int vcu, int G, int wave, int lane) {
    const LAS int* pstart = (const LAS int*)(lds + LDS_MOE);
    const int gw = vcu * NWAVES + wave, NGW = G * NWAVES;
    const bf16_t* X1 = (const bf16_t*)(a.ws + WS_X1); float* X = (float*)(a.ws + WS_X2); const unsigned char* Y = a.ws + WS_YROWS; bf16_t* A3 = (bf16_t*)(a.ws + WS_H);
    const int* tope = (const int*)(a.ws + WS_TOPE); const int* slot = (const int*)(a.ws + WS_SLOT); const float* wts = (const float*)(a.ws + WS_WTS); const float* g = a.in[20];
    f32x4 gv[4];
#pragma unroll
    for (int j = 0; j < 4; ++j) gv[j] = *((const f32x4*)g + lane + 64 * j);
    for (int m0 = gw; m0 < T; m0 += 8 * NGW) {
        int dl = 0; float wl = 0.f;
        { const int i = (lane >> 2) & 7, k = lane & 3; const int m = m0 + i * NGW; if (lane < 32 && m < T) { dl = pstart[tope[m * 4 + k]] + slot[m * 4 + k]; wl = wts[m * 4 + k]; } }
        u32x2 xa[4], xb[4]; unsigned ya[4][4], yb[4][4];
#define CR_LOAD(i_, XQ, YQ) do { const int m_ = m0 + (i_) * NGW; if (m_ < T) { const u32x2* x1r = (const u32x2*)(X1 + (size_t)m_ * D) + lane; \
            _Pragma("unroll") for (int j = 0; j < 4; ++j) XQ[j] = __builtin_nontemporal_load(x1r + 64 * j); \
            _Pragma("unroll") for (int k = 0; k < 4; ++k) { const int d = __builtin_amdgcn_readlane(dl, 4 * (i_) + k); const unsigned* yr = (const unsigned*)(Y + (size_t)d * D) + lane; \
                _Pragma("unroll") for (int j = 0; j < 4; ++j) YQ[k][j] = __builtin_nontemporal_load(yr + 64 * j); } } } while (0)
#define CR_DO(i_, XQ, YQ) do { const int m_ = m0 + (i_) * NGW; if (m_ < T) { f32x4 v[4]; \
            _Pragma("unroll") for (int j = 0; j < 4; ++j) v[j] = (f32x4){bflo(XQ[j].x), bfhi(XQ[j].x), bflo(XQ[j].y), bfhi(XQ[j].y)}; \
            _Pragma("unroll") for (int k = 0; k < 4; ++k) { const float w = __int_as_float(__builtin_amdgcn_readlane(__float_as_int(wl), 4 * (i_) + k)); \
                _Pragma("unroll") for (int j = 0; j < 4; ++j) { const int y = (int)YQ[k][j]; \
                    v[j].x += w * __builtin_amdgcn_cvt_f32_fp8(y, 0); v[j].y += w * __builtin_amdgcn_cvt_f32_fp8(y, 1); v[j].z += w * __builtin_amdgcn_cvt_f32_fp8(y, 2); v[j].w += w * __builtin_amdgcn_cvt_f32_fp8(y, 3); } } \
            float s = 0.f; \
            _Pragma("unroll") for (int j = 0; j < 4; ++j) s += (v[j].x * v[j].x + v[j].y * v[j].y) + (v[j].z * v[j].z + v[j].w * v[j].w); \
            const float rstd = 1.0f / sqrtf(wave_sum(s) * (1.0f / D) + EPS); \
            f32x4* xr = (f32x4*)(X + (size_t)m_ * D) + lane; unsigned* o4 = (unsigned*)((unsigned char*)A3 + (size_t)m_ * D) + lane;        \
            _Pragma("unroll") for (int j = 0; j < 4; ++j) { xr[64 * j] = v[j]; o4[64 * j] = pk4_fp8(v[j].x * rstd * gv[j].x, v[j].y * rstd * gv[j].y, v[j].z * rstd * gv[j].z, v[j].w * rstd * gv[j].w); } } } while (0)
        CR_LOAD(0, xa, ya);
#pragma unroll
        for (int i = 0; i < 8; i += 2) { CR_LOAD(i + 1, xb, yb); CR_DO(i, xa, ya); if (i + 2 < 8) CR_LOAD(i + 2, xa, ya); CR_DO(i + 1, xb, yb); }
#undef CR_LOAD
#undef CR_DO
    }
}
__device__ __forceinline__ void final_rows(const P& a, int vcu, int G, int wave, int lane) {
    const int gw = vcu * NWAVES + wave, NGW = G * NWAVES;
    const float* X = (const float*)(a.ws + WS_X2); float* OUT = a.out; const bf16_t* PG = (const bf16_t*)(a.ws + WS_PGATE); const bf16_t* PP = (const bf16_t*)(a.ws + WS_PPROJ);
    f32x4 gp[4], gf[4];
#pragma unroll
    for (int j = 0; j < 4; ++j) { gp[j] = *((const f32x4*)a.in[23] + lane + 64 * j); gf[j] = *((const f32x4*)a.in[24] + lane + 64 * j); }
    f32x4 va[4], vb[4]; u32x2 qa[4], qb[4], ga[4], gb[4];
#define FR_LOAD(m_, V, Q, GQ) do { if ((m_) < T) { const f32x4* xr = (const f32x4*)(X + (size_t)(m_) * D) + lane; const u32x2* pgr = (const u32x2*)(PG + (size_t)(m_) * D) + lane; const u32x2* ppr = (const u32x2*)(PP + (size_t)(m_) * D) + lane; \
        _Pragma("unroll") for (int j = 0; j < 4; ++j) { V[j] = __builtin_nontemporal_load(xr + 64 * j); Q[j] = __builtin_nontemporal_load(ppr + 64 * j); GQ[j] = __builtin_nontemporal_load(pgr + 64 * j); } } } while (0)
#define FR_DO(m_, V, Q, GQ) do { if ((m_) < T) { f32x4 v[4], pp[4], pg[4]; float sp = 0.f; \
        _Pragma("unroll") for (int j = 0; j < 4; ++j) { v[j] = V[j]; pp[j] = (f32x4){bflo(Q[j].x), bfhi(Q[j].x), bflo(Q[j].y), bfhi(Q[j].y)}; pg[j] = (f32x4){bflo(GQ[j].x), bfhi(GQ[j].x), bflo(GQ[j].y), bfhi(GQ[j].y)}; \
            sp += (pp[j].x * pp[j].x + pp[j].y * pp[j].y) + (pp[j].z * pp[j].z + pp[j].w * pp[j].w); } \
        const float rp = 1.0f / sqrtf(wave_sum(sp) * (1.0f / D) + EPS); float s_ = 0.f; \
        _Pragma("unroll") for (int j = 0; j < 4; ++j) { v[j] = v[j] + pg[j] * (pp[j] * rp * gp[j]); s_ += (v[j].x * v[j].x + v[j].y * v[j].y) + (v[j].z * v[j].z + v[j].w * v[j].w); } \
        const float rstd = 1.0f / sqrtf(wave_sum(s_) * (1.0f / D) + EPS); f32x4* orow = (f32x4*)(OUT + (size_t)(m_) * D) + lane; \
        _Pragma("unroll") for (int j = 0; j < 4; ++j) __builtin_nontemporal_store(v[j] * rstd * gf[j], orow + 64 * j); } } while (0)
    FR_LOAD(gw, va, qa, ga);
    for (int m = gw; m < T; m += 2 * NGW) { FR_LOAD(m + NGW, vb, qb, gb); FR_DO(m, va, qa, ga); FR_LOAD(m + 2 * NGW, va, qa, ga); FR_DO(m + NGW, vb, qb, gb); }
#undef FR_LOAD
#undef FR_DO
}
#ifndef MK_CVP
#define MK_CVP 8
#define MK_CVQ 3
#endif
struct Args { P p; };
template <int PH_LO, int PH_HI>
__global__ void __launch_bounds__(NTHREADS, 2) hybrid_fwd(Args args) {
    extern __shared__ __attribute__((aligned(16))) unsigned char lds_raw[];
    LAS unsigned char* lds = (LAS unsigned char*)lds_raw;
    const P& a = args.p;
    const int tid = threadIdx.x;
#define FRESH_WL() int t_ = threadIdx.x; asm volatile("" : "+v"(t_)); const int w_ = __builtin_amdgcn_readfirstlane(t_ >> 6), l_ = t_ & 63
    const int G = gridDim.x; const int bx = blockIdx.x; const int vcu = (G % 8 == 0) ? (bx % 8) * (G / 8) + bx / 8 : bx;
    unsigned* ctl = (unsigned*)(a.ws + WS_CTL);
    for (int u = tid; u < (LDS_BYTES - LDSCTL_OFF) / 4; u += NTHREADS) ((LAS unsigned*)(lds + LDSCTL_OFF))[u] = 0u;
    __syncthreads();
#if MK_PER_PHASE
#define GRID_BAR() do { } while (0)
#else
    XcdBarrier bar = xcd_barrier_post(ctl + CW_BAR, (volatile LAS unsigned*)(lds + MISC_OFF + 32));
#define GRID_BAR() xcd_barrier(bar)
#endif
    constexpr int lo = PH_LO, hi = PH_HI;
#define IN(k) (lo <= (k) && (k) < hi)
#define SEAM(k) do { if constexpr (IN(k) && IN((k) + 1)) GRID_BAR(); } while (0)
    unsigned char* ws = a.ws;

    if constexpr (IN(0)) { FRESH_WL(); p0_prologue(a, lds, vcu, G, w_, l_); }
    SEAM(0);
    if constexpr (IN(1)) {
        { pg8::DenseSched S; S.o.init(T / 256, 12, G, bx); S.Bt = (const char*)(ws + WS_WIN); S.K = D;
          pg8::EpiProj<false> E{(bf16_t*)(ws + WS_PROJ), (float*)(ws + WS_KMP)};
          pg8::gemm_phase(lds, (const char*)(ws + WS_H), D, D, D, S, E); }
        { pg8::DenseSched S; S.o.init(T / 256, 20, G, bx); S.Bt = (const char*)(ws + WS_WIN8); S.K = D; S.es = 1; S.pn0 = 12; S.bt_out = false;
          pg8::EpiProj<true> E{(bf16_t*)(ws + WS_PROJ), (float*)(ws + WS_KMP)};
          pg8::gemm_phase(lds, (const char*)(ws + WS_H8), D, D, D, S, E); }
    }
    SEAM(1);
    if constexpr (IN(2)) { for (int u = vcu; u < NB * 32; u += G) gla_prep_unit(a, lds, u); }
    SEAM(2);
    if constexpr (IN(3)) { for (int u = vcu; u < 512; u += G) gla_combine_unit(a, u); }
    SEAM(3);
    if constexpr (IN(4)) {
        for (int u = vcu; u < 1024; u += G) gla_out_unit(a, lds, u);
        __syncthreads();
    }
    if constexpr (IN(5)) {
        if ((vcu % MK_CVP) < MK_CVQ) { FRESH_WL(); const int ci_ = (vcu / MK_CVP) * MK_CVQ + vcu % MK_CVP, ncv_ = (G / MK_CVP) * MK_CVQ + ((G % MK_CVP) < MK_CVQ ? (G % MK_CVP) : MK_CVQ);
            late_prep(a, lds, ci_, ncv_, w_, l_); expert_convert(a, lds, ci_, ncv_, w_, l_); __syncthreads(); }
        unsigned* queue = ctl + CW_QUEUE;
        volatile LAS int* qslot = (volatile LAS int*)(lds + LDSCTL_OFF + 1024);
        if (tid == 0) qslot[0] = (int)__hip_atomic_fetch_add(queue, 1u, RLX_AGENT);
        __syncthreads();
        int item = __builtin_amdgcn_readfirstlane(qslot[0]);
        if (item < 512) {
            moba::Seam S;
            moba::BlockRef cur = moba::make_ref(a, item);
            moba::prime(cur, (char*)lds_raw, S);
            for (;;) {
                const int nitem = moba::block(a, cur, queue, a.in[2], (const float*)(ws + WS_KMP), (char*)lds_raw, S);
                if (nitem >= 512) break;
                cur = moba::make_ref(a, nitem);
            }
        }
    }
    SEAM(5);
    if constexpr (IN(6)) {
        pg8::ChainSched S; S.o.init(T / 256, D / 256, G, bx); S.Bt = (const char*)(ws + WS_WUP); S.K = 1024;
        pg8::EpiMerge E{(const bf16_t*)(ws + WS_PROJ), (bf16_t*)(ws + WS_Y)};
        pg8::gemm_phase(lds, (const char*)(ws + WS_OAB), 1024, 2048, 2048, S, E);
    }
    SEAM(6);
    if constexpr (IN(7)) {
        pg8::DenseSched S; S.o.init(T / 256, D / 256, G, bx); S.Bt = (const char*)(ws + WS_WO); S.K = D;
        pg8::EpiResF32 E{a.in[0], (bf16_t*)(ws + WS_X1)};
        pg8::gemm_phase(lds, (const char*)(ws + WS_Y), D, D, D, S, E);
    }
    SEAM(7);
    if constexpr (IN(8)) { for (int u = vcu; u < T / 64; u += G) router_unit(a, lds, u); }
    SEAM(8);
    if constexpr (IN(9)) {
        moe_tables(a, lds); const LAS int* tab = (const LAS int*)(lds + LDS_MOE); const int ntile = __builtin_amdgcn_readfirstlane(tab[128 + MAXTILES]);
        pg8::MoeSched<true> S; S.o.init(ntile, 8, G, bx); S.Bt = (const char*)a.out; S.K = D; S.rows_per_e = 2048; S.tab = tab; S.row_e = (const int*)(ws + WS_ROWE); S.es = 1;
        pg8::EpiGlu E{(unsigned char*)(ws + WS_HMID), (const float*)(ws + WS_RSTE), tab, a.in[15], a.in[17], (const float*)(ws + WS_CTL) + 131072, lds};
        pg8::gemm_phase(lds, (const char*)(ws + WS_A2), D, D, D, S, E);
        const int extra = (ntile * 8) % G, nidle = G - extra;
        if (bx >= extra) { __syncthreads();
            pg8::DenseSched S2; S2.o.init(T / 256, D / 256, nidle, bx - extra); S2.Bt = (const char*)(ws + WS_WPP); S2.K = 256;
            pg8::EpiBf16<0, false> E2{(bf16_t*)(ws + WS_PPROJ), D, nullptr, 0, 1.0f};
            pg8::gemm_phase(lds, (const char*)(ws + WS_PB), 256, 256, 256, S2, E2); }
    }
    SEAM(9);
    if constexpr (IN(10)) {
        moe_tables(a, lds); const LAS int* tab = (const LAS int*)(lds + LDS_MOE); const int ntile = __builtin_amdgcn_readfirstlane(tab[128 + MAXTILES]);
        pg8::MoeSched<false> S; S.o.init(ntile, 4, G, bx); S.Bt = (const char*)(ws + WS_W2T); S.K = FF; S.rows_per_e = 1024; S.tab = tab; S.row_e = nullptr; S.es = 1;
        pg8::EpiDownF8 E{(unsigned char*)(ws + WS_YROWS), a.in[19]};
        pg8::gemm_phase(lds, (const char*)(ws + WS_HMID), FF, FF, FF, S, E);
    }
    SEAM(10);
    if constexpr (IN(11)) { moe_tables(a, lds); FRESH_WL(); combine_rows(a, lds, vcu, G, w_, l_); }
    SEAM(11);
    if constexpr (IN(12)) {
        { pg8::DenseSched S; S.o.init(T / 256, D / 256, G, bx); S.Bt = (const char*)(ws + WS_WPG); S.K = D; S.es = 1;
          pg8::EpiBf16<1, false, true> E{(bf16_t*)(ws + WS_PGATE), D, nullptr, 0, 1.0f / 32.0f};
          pg8::gemm_phase(lds, (const char*)(ws + WS_H), D, D, D, S, E); }
    }
    SEAM(12);
    if constexpr (IN(13)) { FRESH_WL(); final_rows(a, vcu, G, w_, l_); }
#undef FRESH_WL
#undef IN
#undef SEAM
#undef GRID_BAR
}

template <int LO, int HI> static void launch_range(const Args& a, int grid, hipStream_t stream) {
    static bool attr = false;
    if (!attr) { attr = true; if (hipFuncSetAttribute((const void*)hybrid_fwd<LO, HI>, hipFuncAttributeMaxDynamicSharedMemorySize, LDS_BYTES) != hipSuccess) fprintf(stderr, "kernel_launch: hipFuncSetAttribute failed\n"); }
    hipLaunchKernelGGL((hybrid_fwd<LO, HI>), dim3(grid), dim3(NTHREADS), LDS_BYTES, stream, a);
}
extern "C" void kernel_launch(void* const* d_in, const int* in_sizes, int n_in, void* d_out, int out_size, void* d_ws, size_t ws_size, hipStream_t stream) {
    static int grid = 0;
    if (grid == 0) {
        static const int expect[25] = {T * D, T * 256, 256, 1024, 1024 * D_IN, 16 * 512, 512, 256, 1048576, 1048576, 1048576, 1024, 32768, 32, 33554432, 32768, 33554432, 32768, 33554432, 32768, 1024, 1048576, 262144, 1024, 1024};
        bool okk = (n_in == 25);
        for (int i = 0; okk && i < 25; ++i) if (in_sizes[i] != expect[i]) { fprintf(stderr, "kernel_launch: input %d has %d elements, expected %d\n", i, in_sizes[i], expect[i]); okk = false; }
        if (!okk || out_size != T * D || ws_size < WS_END) { fprintf(stderr, "kernel_launch: unexpected shapes (n_in %d, in0 %d, out %d, ws %zu); nothing launched\n", n_in, n_in > 0 ? in_sizes[0] : -1, out_size, ws_size); grid = -1; return; }
        int dev = 0, cus = 0;
        if (hipGetDevice(&dev) != hipSuccess || hipDeviceGetAttribute(&cus, hipDeviceAttributeMultiprocessorCount, dev) != hipSuccess) { grid = -1; return; }
        grid = cus;
    }
    if (grid < 0) return;
    (void)hipMemsetAsync((char*)d_ws + WS_CTL, 0, CTL_ZERO_BYTES, stream);
    Args a{};
    for (int i = 0; i < 25; ++i) a.p.in[i] = (const float*)d_in[i];
    a.p.out = (float*)d_out; a.p.ws = (unsigned char*)d_ws;
#if MK_PER_PHASE
#ifndef MK_LAST
#define MK_LAST 13
#endif
#ifndef MK_REPEAT
#define MK_REPEAT 0
#endif
#define LR(k) do { if ((k) <= MK_LAST) for (int r_ = 0; r_ < 1 + ((MK_REPEAT >> (k)) & 1); ++r_) launch_range<(k), (k) + 1>(a, grid, stream); } while (0)
    LR(0); LR(1); LR(2); LR(3); LR(4); LR(5); LR(6); LR(7); LR(8); LR(9); LR(10); LR(11); LR(12); LR(13);
#undef LR
#else
    launch_range<0, NPHASES>(a, grid, stream);
#endif
}
```

```cpp
#include <hip/hip_runtime.h>
#include <cstdio>
#include <cstdint>

#define LAS __attribute__((address_space(3)))
#define GAS __attribute__((address_space(1)))
typedef unsigned short bf16_t;
typedef short bf16x8 __attribute__((ext_vector_type(8)));
typedef short s16x4 __attribute__((ext_vector_type(4)));
typedef float f32x2 __attribute__((ext_vector_type(2)));
typedef float f32x4 __attribute__((ext_vector_type(4)));
typedef float f32x16 __attribute__((ext_vector_type(16)));
typedef unsigned u32x2 __attribute__((ext_vector_type(2)));
typedef unsigned u32x4 __attribute__((ext_vector_type(4)));
typedef int i32x4 __attribute__((ext_vector_type(4)));
typedef int i32x8 __attribute__((ext_vector_type(8)));
typedef GAS unsigned gu32;
#define RLX_AGENT __ATOMIC_RELAXED, __HIP_MEMORY_SCOPE_AGENT
#define LDS_WAIT() asm volatile("s_waitcnt lgkmcnt(0)" ::: "memory")
#define VM_WAIT() asm volatile("s_waitcnt vmcnt(0)" ::: "memory")

#ifndef MK_PER_PHASE
#define MK_PER_PHASE 0
#endif

constexpr int NB = 8, SEQ = 2048, T = NB * SEQ, D = 1024;
constexpr int NPROJ = 8192;
constexpr int C_QA = 0, C_KA = 512, C_VA = 1024, C_RA = 2048, C_QB = 3072, C_KB = 4096, C_VB = 5120, C_GA = 6144, C_GB = 7168;
#define PROJ_BLK(cs) ((size_t)(cs) * T)
constexpr int SRC_ALOW = 3072, D_IN = 8208;
constexpr int NE = 32, FF = 1024, MAXTILES = 288, MAXROWS = MAXTILES * 256;
constexpr float EPS = 1e-6f;
constexpr int NWAVES = 8, NTHREADS = 512;
constexpr int NPHASES = 14;

constexpr size_t MiB = 1u << 20;
constexpr size_t WS_CTL = 0, CTL_ZERO_BYTES = 1 * MiB;
constexpr size_t WS_SMALL = 1 * MiB;
constexpr size_t WS_KMP   = WS_SMALL;
constexpr size_t WS_DEC   = WS_KMP + 512 * 1024;
constexpr size_t WS_TOPE  = WS_DEC + 512 * 1024;
constexpr size_t WS_WTS   = WS_TOPE + 256 * 1024;
constexpr size_t WS_SLOT  = WS_WTS + 256 * 1024;
constexpr size_t WS_DEST  = WS_SLOT + 256 * 1024;
constexpr size_t WS_ROWTOK = WS_DEST + 256 * 1024;
constexpr size_t WS_RSTDS = WS_ROWTOK + 320 * 1024;
constexpr size_t WS_RSTD  = WS_RSTDS + 320 * 1024;
constexpr size_t WS_TILEE = WS_RSTD + 64 * 1024;
constexpr size_t WS_WALT  = WS_TILEE + 4 * 1024;
constexpr size_t WS_WRF   = WS_WALT + 32 * 1024;
static_assert(WS_WRF + 128 * 1024 <= 6 * MiB, "small map");
constexpr size_t WS_WO = 6 * MiB, WS_WPG = 8 * MiB, WS_WPP = 10 * MiB, WS_WUP = 12 * MiB, WS_WIN = 16 * MiB;
constexpr size_t WS_PB = 34 * MiB;
constexpr size_t WS_H  = 42 * MiB;
constexpr size_t WS_PROJ = 74 * MiB;
constexpr size_t WS_QG = 330 * MiB, WS_KG = 346 * MiB;
constexpr size_t WS_SLOC = 426 * MiB;
constexpr size_t WS_OAB = 362 * MiB;
constexpr size_t WS_H8 = 426 * MiB;
constexpr size_t WS_WIN8 = 442 * MiB;
constexpr size_t WS_Y = 330 * MiB;
constexpr size_t WS_W2T = 42 * MiB;
constexpr size_t WS_A2 = 330 * MiB;
constexpr size_t WS_HMID = 138 * MiB;
constexpr size_t WS_X1 = 74 * MiB;
constexpr size_t WS_X2 = 138 * MiB;
constexpr size_t WS_YROWS = 282 * MiB;
constexpr size_t WS_PGATE = 330 * MiB, WS_PPROJ = 226 * MiB;
constexpr size_t WS_ROWE = 490 * MiB;
constexpr size_t WS_RSTE = 492 * MiB;
constexpr size_t WS_END = 506 * MiB;

constexpr int CW_BAR = 4096;
constexpr int CW_COUNTS = 16384;
constexpr int CW_QUEUE = 16384 + 64;

constexpr int RING_BYTES = 131072;
constexpr int LDSCTL_OFF = RING_BYTES, MISC_OFF = LDSCTL_OFF + 320;
constexpr int LDS_MOE = LDSCTL_OFF + 10240;
constexpr int EPF_OFF = LDSCTL_OFF + 12288;
constexpr int LDS_BYTES = 151552;

typedef __bf16 bf16v2_t __attribute__((ext_vector_type(2)));
__device__ __forceinline__ unsigned cvt_pk_bf16(float lo, float hi) { const f32x2 v = {lo, hi}; return __builtin_bit_cast(unsigned, __builtin_convertvector(v, bf16v2_t)); }
__device__ __forceinline__ unsigned pk4_fp8(float a, float b, float c, float d) { int w = 0; w = __builtin_amdgcn_cvt_pk_fp8_f32(a, b, w, false); w = __builtin_amdgcn_cvt_pk_fp8_f32(c, d, w, true); return (unsigned)w; }
__device__ __forceinline__ float bf2f(unsigned short s) { return __uint_as_float(((unsigned)s) << 16); }
__device__ __forceinline__ float bflo(unsigned w) { return __uint_as_float(w << 16); }
__device__ __forceinline__ float bfhi(unsigned w) { return __uint_as_float(w & 0xffff0000u); }
__device__ __forceinline__ float fsigmoid(float x) { return __builtin_amdgcn_rcpf(1.0f + __builtin_amdgcn_exp2f(-1.4426950408889634f * x)); }
__device__ __forceinline__ float wave_sum(float v) {
#pragma unroll
    for (int o = 1; o < 64; o <<= 1) v += __shfl_xor(v, o);
    return v;
}
__device__ __forceinline__ bf16x8 pack8(f32x4 a, f32x4 b) {
    u32x4 w = {cvt_pk_bf16(a[0], a[1]), cvt_pk_bf16(a[2], a[3]), cvt_pk_bf16(b[0], b[1]), cvt_pk_bf16(b[2], b[3])};
    return __builtin_bit_cast(bf16x8, w);
}

#define XB_TMO      128
#define XB_XCNT(j)  (256  + 64 * (j))
#define XB_XSUB(j)  (1280 + 64 * (j))
#define XB_XGEN(j)  (2304 + 64 * (j))
#define XB_TOP      3328
#define XB_TOPGEN   3392
#define XCD_BAR_WORDS 3456
#define XB_SPIN_CAP (1u << 18)

__device__ __forceinline__ unsigned xb_ld(unsigned* p)              { return __hip_atomic_load(p, __ATOMIC_RELAXED, __HIP_MEMORY_SCOPE_AGENT); }
__device__ __forceinline__ unsigned xb_add(unsigned* p, unsigned v) { return __hip_atomic_fetch_add(p, v, __ATOMIC_RELAXED, __HIP_MEMORY_SCOPE_AGENT); }
__device__ __forceinline__ unsigned xb_xcc_id() { return (unsigned)__builtin_amdgcn_s_getreg((3 << 11) | 20) & 0xFu; }
#define XB_SPIN(cond, bar) do { unsigned _sp = 0; while (cond) { __builtin_amdgcn_s_sleep(1); \
    if ((++_sp & 255u) == 0u) { if (xb_ld(&(bar)[XB_TMO])) break; if (_sp > XB_SPIN_CAP) { atomicAdd(&(bar)[XB_TMO], 1u); break; } } } } while (0)

struct XcdBarrier { unsigned* bar; unsigned x; volatile LAS unsigned* st; };

__device__ __forceinline__ XcdBarrier xcd_barrier_post(unsigned* bar, volatile LAS unsigned* st) {
    XcdBarrier b; b.bar = bar; b.x = xb_xcc_id(); b.st = st;
    if (threadIdx.x == 0) (void)xb_add(&bar[XB_XCNT(b.x)], 1u);
    return b;
}
__device__ __forceinline__ void xcd_barrier_complete(unsigned* bar, unsigned x, unsigned& nloc, unsigned& nx) {
    const unsigned G = gridDim.x * gridDim.y * gridDim.z;
    unsigned sum, cnt, mine, sp = 0u;
    for (;;) {
        sum = 0u; cnt = 0u; mine = 0u;
#pragma unroll
        for (unsigned j = 0; j < 16; ++j) { const unsigned c = xb_ld(&bar[XB_XCNT(j)]); sum += c; cnt += (c > 0u) ? 1u : 0u; mine = (j == x) ? c : mine; }
        if (sum == G) break;
        __builtin_amdgcn_s_sleep(1);
        if ((++sp & 255u) == 0u) { if (xb_ld(&bar[XB_TMO])) break; if (sp > XB_SPIN_CAP) { atomicAdd(&bar[XB_TMO], 1u); break; } }
    }
    nloc = mine > 0u ? mine : 1u; nx = cnt > 0u ? cnt : 1u;
}
__device__ __forceinline__ void xcd_barrier(const XcdBarrier& b) {
    asm volatile("s_waitcnt vmcnt(0)" ::: "memory");
    __syncthreads();
    if (threadIdx.x == 0) {
        unsigned* bar = b.bar;
        __builtin_amdgcn_s_waitcnt(0);
        unsigned nloc = b.st[0], nx = b.st[1];
        if (nloc == 0u) { xcd_barrier_complete(bar, b.x, nloc, nx); b.st[0] = nloc; b.st[1] = nx; }
        const unsigned old = xb_add(&bar[XB_XSUB(b.x)], 1u);
        const unsigned gen = old / nloc;
        if (old + 1u == (gen + 1u) * nloc) {
            __builtin_amdgcn_fence(__ATOMIC_RELEASE, "agent");
            asm volatile("s_waitcnt vmcnt(0)" ::: "memory");
            const unsigned og = xb_add(&bar[XB_TOP], 1u);
            const unsigned tg = og / nx;
            if (og + 1u == (tg + 1u) * nx) xb_add(&bar[XB_TOPGEN], 1u);
            else XB_SPIN(xb_ld(&bar[XB_TOPGEN]) == tg, bar);
            __builtin_amdgcn_fence(__ATOMIC_ACQUIRE, "agent");
            xb_add(&bar[XB_XGEN(b.x)], 1u);
            asm volatile("s_waitcnt vmcnt(0)" ::: "memory");
        } else {
            XB_SPIN(xb_ld(&bar[XB_XGEN(b.x)]) == gen, bar);
            __builtin_amdgcn_fence(__ATOMIC_ACQUIRE, "agent");
            asm volatile("s_waitcnt vmcnt(0)" ::: "memory");
        }
    }
    __syncthreads();
}
#ifndef MK_SCL
#define MK_SCL 0
#endif
namespace pg8 {
constexpr int BM = 256, BK = 64, HALF = 128, HTB = HALF * BK * 2, STAGE_BYTES = 8 * HTB, NXCD = 8, WGM = 8;

__host__ __device__ __forceinline__ int lds_byte(int r, int c) { const int st = (r >> 4) * 2 + (c >> 5), rr = r & 15, cc = c & 31, ob = rr * 64 + cc * 2; return st * 1024 + (ob ^ (((ob >> 9) & 1) << 5)); }
__host__ __device__ __forceinline__ void stage_rc(int b, int& R, int& C) { const int st = b / 1024, sb = b % 1024, swz = sb ^ (((sb >> 9) & 1) << 5); R = (st >> 1) * 16 + swz / 64; C = (st & 1) * 32 + (swz % 64) / 2; }
__host__ __device__ __forceinline__ int perm32(int rho) { const int n = rho >> 4, i = rho & 15; return 8 * (i >> 2) + 4 * n + (i & 3); }

struct Unit { int pm, pn, e, s; };

struct TileOrder {
    int nM, nN, nwg, G, c;
    __device__ __forceinline__ void init(int nM_, int nN_, int G_, int c_) { nM = nM_; nN = nN_; nwg = nM * nN; G = G_; c = c_; }
    __device__ __forceinline__ bool next(int i, int& pm, int& pn) const {
        const unsigned L = (unsigned)i * (unsigned)G + (unsigned)c; if (L >= (unsigned)nwg) return false;
        int wgid = (int)L; { const int q = nwg / NXCD, r = nwg % NXCD, xcd = wgid % NXCD, off = wgid / NXCD; wgid = (xcd < r ? xcd * (q + 1) : r * (q + 1) + (xcd - r) * q) + off; }
        const int nig = WGM * nN, gid = wgid / nig, fm = gid * WGM, gsz = (nM - fm) < WGM ? (nM - fm) : WGM;
        pm = fm + ((wgid % nig) % gsz); pn = (wgid % nig) / gsz; return true;
    }
};
struct DenseSched {
    TileOrder o; const char* Bt; int K; int es = 2; int gap_at = 1 << 30, gap_by = 0, pn0 = 0; bool bt_out = true;
    __device__ __forceinline__ bool next(int i, Unit& u) const { int p; if (!o.next(i, u.pm, p)) return false; u.e = p; u.pn = p + (p >= gap_at ? gap_by : 0) + pn0; return true; }
    __device__ __forceinline__ unsigned a_row(const Unit& u, int r) const { return (unsigned)(u.pm * BM + r); }
    __device__ __forceinline__ unsigned a_koff(const Unit&) const { return 0u; }
    __device__ __forceinline__ const char* b_base(const Unit& u) const { return Bt + (size_t)(bt_out ? u.pn : u.e) * BM * K * es; }
};
struct ChainSched {
    TileOrder o; const char* Bt; int K;
    __device__ __forceinline__ bool next(int i, Unit& u) const { if (!o.next(i >> 1, u.pm, u.pn)) return false; u.e = i & 1; return true; }
    __device__ __forceinline__ unsigned a_row(const Unit& u, int r) const { return (unsigned)(u.pm * BM + r); }
    __device__ __forceinline__ unsigned a_koff(const Unit& u) const { return (unsigned)(u.e * K * 2); }
    __device__ __forceinline__ const char* b_base(const Unit& u) const { return Bt + (size_t)u.pn * BM * (2 * K) * 2 + (size_t)u.e * K * 2; }
};
template <bool GATHER> struct MoeSched {
    TileOrder o; const char* Bt; int K; int rows_per_e; const LAS int* tab; const int* row_e; int es;
    __device__ __forceinline__ bool next(int i, Unit& u) const { if (!o.next(i, u.pm, u.pn)) return false; u.e = __builtin_amdgcn_readfirstlane(tab[128 + u.pm]); return true; }
    __device__ __forceinline__ unsigned a_row(const Unit& u, int r) const {
        if (GATHER) { const int lr = u.pm * BM + r - tab[u.e]; return lr < tab[64 + u.e] ? (unsigned)row_e[(size_t)u.e * T + lr] : 0u; }
        else return (unsigned)(u.pm * BM + r); }
    __device__ __forceinline__ unsigned a_koff(const Unit&) const { return 0u; }
    __device__ __forceinline__ const char* b_base(const Unit& u) const { return Bt + ((size_t)u.e * rows_per_e + (size_t)u.pn * BM) * K * es; }
};

template <class Epi, class Sched>
__device__ __forceinline__ void gemm_phase(LAS unsigned char* lds, const char* gA, int K_, int lda, int ldb, const Sched& S, const Epi& E) {
    int K = K_; asm volatile("" : "+s"(K));
    int tid = threadIdx.x; asm volatile("" : "+v"(tid));     const int wid = __builtin_amdgcn_readfirstlane(tid >> 6), lane = tid & 63, wr = wid >> 2, wc = wid & 3, fr = lane & 15, fq = lane >> 4;
    constexpr int ES = Epi::F8 ? 1 : 2;
    const int nt = K * ES / 128;
    unsigned voffB[2];
#pragma unroll
    for (int i = 0; i < 2; ++i) { int R, C; stage_rc(tid * 16 + i * 8192, R, C); const int Rb = Epi::PERM ? ((R & ~31) + perm32(R & 31)) : R; voffB[i] = (unsigned)(Rb * ldb * ES + C * 2); }
    const unsigned kstep = (unsigned)(BK * 2);
    const size_t hstepB = (size_t)HALF * ldb * ES;
    const unsigned ldab = (unsigned)lda * ES;
    const unsigned ldsw = (unsigned)wid * 1024u;
    const int aoff = lds_byte(wr * 64 + fr, fq * 8), boff = lds_byte(wc * 32 + fr, fq * 8);
#define PG8_SA(b, h) (((b) * 2 + (h)) * HTB)
#define PG8_SB(b, h) ((4 + (b) * 2 + (h)) * HTB)
#define PG8_STAGE_B(bufoff, gbase) do { _Pragma("unroll") for (int _i = 0; _i < 2; ++_i) \
        __builtin_amdgcn_global_load_lds((const unsigned*)((const char*)(gbase) + voffB[_i]), (LAS unsigned*)(lds + (bufoff) + ldsw + _i * 8192), 16, 0, 0); } while (0)
#define PG8_STAGE_A(bufoff, o0, o1, kb) do { \
        const char* gk_ = gA + (kb);      \
        __builtin_amdgcn_global_load_lds((const unsigned*)(gk_ + (o0)), (LAS unsigned*)(lds + (bufoff) + ldsw), 16, 0, 0); \
        __builtin_amdgcn_global_load_lds((const unsigned*)(gk_ + (o1)), (LAS unsigned*)(lds + (bufoff) + ldsw + 8192), 16, 0, 0); } while (0)
#define PG8_LDA(dst, b, h) do { _Pragma("unroll") for (int m = 0; m < 4; ++m) _Pragma("unroll") for (int k = 0; k < 2; ++k) dst[m][k] = *(const LAS bf16x8*)(lds + PG8_SA(b, h) + aoff + m * 2048 + k * 1024); } while (0)
#define PG8_LDB(dst, b, h) do { _Pragma("unroll") for (int n = 0; n < 2; ++n) _Pragma("unroll") for (int k = 0; k < 2; ++k) dst[n][k] = *(const LAS bf16x8*)(lds + PG8_SB(b, h) + boff + n * 2048 + k * 1024); } while (0)
#define PG8_MMA(ai, bj, At, Bt) do { __builtin_amdgcn_s_setprio(1); \
        if constexpr (Epi::F8) { _Pragma("unroll") for (int m = 0; m < 4; ++m) _Pragma("unroll") for (int n = 0; n < 2; ++n) { \
            const i32x8 a8_ = __builtin_shufflevector(__builtin_bit_cast(i32x4, At[m][0]), __builtin_bit_cast(i32x4, At[m][1]), 0, 1, 2, 3, 4, 5, 6, 7); \
            const i32x8 b8_ = __builtin_shufflevector(__builtin_bit_cast(i32x4, Bt[n][0]), __builtin_bit_cast(i32x4, Bt[n][1]), 0, 1, 2, 3, 4, 5, 6, 7); \
            acc[ai][bj][m][n] = __builtin_amdgcn_mfma_scale_f32_16x16x128_f8f6f4(b8_, a8_, acc[ai][bj][m][n], 0, 0, 0, MK_SCL, 0, MK_SCL); } } \
        else { _Pragma("unroll") for (int m = 0; m < 4; ++m) _Pragma("unroll") for (int n = 0; n < 2; ++n) _Pragma("unroll") for (int k = 0; k < 2; ++k) \
            acc[ai][bj][m][n] = __builtin_amdgcn_mfma_f32_16x16x32_bf16(Bt[n][k], At[m][k], acc[ai][bj][m][n], 0, 0, 0); } \
        __builtin_amdgcn_s_setprio(0); } while (0)
#define PG8_WAIT_V(n) asm volatile("s_waitcnt vmcnt(" #n ")" ::: "memory")
#define PG8_WAIT_L(n) asm volatile("s_waitcnt lgkmcnt(" #n ")" ::: "memory")
#define PG8_BAR __builtin_amdgcn_s_barrier()
#define PG8_SCHED __builtin_amdgcn_sched_barrier(0)
#define PG8_AOFFS(dst, u) do { int t_ = threadIdx.x; asm volatile("" : "+v"(t_));     \
        _Pragma("unroll") for (int _h = 0; _h < 2; ++_h) _Pragma("unroll") for (int _i = 0; _i < 2; ++_i) { int R_, C_; stage_rc(t_ * 16 + _i * 8192, R_, C_); \
        dst[_h][_i] = S.a_row(u, _h * HALF + R_) * ldab + (unsigned)C_ * 2u + S.a_koff(u); } } while (0)
    Unit cur, nxt; int ui = 0;
    if (!S.next(0, cur)) return;
    cur.s = 0;
    if constexpr (Epi::PREF) E.prefetch(cur, 0);
#ifdef MK_STAGGER
    if (S.o.nwg > 3 * S.o.G) {
        const unsigned long long t0_ = __builtin_amdgcn_s_memrealtime(); const unsigned long long d_ = (unsigned long long)((blockIdx.x >> 3) & 7) * MK_STAGGER;
        while (__builtin_amdgcn_s_memrealtime() - t0_ < d_) __builtin_amdgcn_s_sleep(4);
    }
#endif
    f32x4 acc[2][2][4][2];
#pragma unroll
    for (int a = 0; a < 2; ++a)
#pragma unroll
        for (int b = 0; b < 2; ++b)
#pragma unroll
            for (int m = 0; m < 4; ++m)
#pragma unroll
                for (int n = 0; n < 2; ++n) acc[a][b][m][n] = (f32x4){0.f, 0.f, 0.f, 0.f};
    bf16x8 At[4][2], B0[2][2], B1[2][2];
    unsigned oc[2][2];
    LAS u32x4* nslot = (LAS u32x4*)(lds + LDSCTL_OFF + 2048) + tid;
    PG8_AOFFS(oc, cur);
    const char* cB = S.b_base(cur);
    PG8_STAGE_B(PG8_SB(0, 0), cB); PG8_STAGE_B(PG8_SB(0, 1), cB + hstepB); PG8_STAGE_A(PG8_SA(0, 0), oc[0][0], oc[0][1], 0u); PG8_STAGE_A(PG8_SA(0, 1), oc[1][0], oc[1][1], 0u);
    if (wr == 1) PG8_BAR;
    PG8_WAIT_V(2); PG8_BAR;
    PG8_STAGE_B(PG8_SB(1, 0), cB + kstep); PG8_STAGE_A(PG8_SA(1, 0), oc[0][0], oc[0][1], kstep); PG8_STAGE_B(PG8_SB(1, 1), cB + hstepB + kstep);
    PG8_WAIT_V(6); PG8_BAR;
    for (;;) {
        const bool has_next = S.next(ui + 1, nxt);
        const char* nB = has_next ? S.b_base(nxt) : cB;
        if (has_next) { unsigned on[2][2]; PG8_AOFFS(on, nxt); *nslot = (u32x4){on[0][0], on[0][1], on[1][0], on[1][1]}; nxt.s = cur.s == 2 ? 0 : cur.s + 1;
            if constexpr (Epi::PREF) E.prefetch(nxt, nxt.s); }
        for (int t = 0; t < nt; t += 2) {
            const bool last = (t == nt - 2);
            const unsigned k1 = (unsigned)(t + 1) * kstep;
            const unsigned k2 = last ? 0u : (unsigned)(t + 2) * kstep, k3 = k2 + kstep;
            const char* b2 = last ? nB : cB + (size_t)(t + 2) * kstep; const char* b3 = b2 + kstep;
            PG8_LDB(B0, 0, 0); PG8_LDB(B1, 0, 1); PG8_SCHED; PG8_LDA(At, 0, 0); PG8_STAGE_A(PG8_SA(1, 1), oc[1][0], oc[1][1], k1);
            PG8_WAIT_V(8); PG8_WAIT_L(0); PG8_BAR; PG8_MMA(0, 0, At, B0); PG8_MMA(0, 1, At, B1); PG8_BAR; PG8_SCHED;
            if (last && has_next) { const u32x4 o_ = *nslot; oc[0][0] = o_.x; oc[0][1] = o_.y; oc[1][0] = o_.z; oc[1][1] = o_.w; }
            PG8_LDA(At, 0, 1); PG8_STAGE_B(PG8_SB(0, 0), b2); PG8_STAGE_B(PG8_SB(0, 1), b2 + hstepB); PG8_STAGE_A(PG8_SA(0, 0), oc[0][0], oc[0][1], k2);
            PG8_WAIT_V(8); PG8_WAIT_L(0); PG8_BAR; PG8_MMA(1, 0, At, B0); PG8_MMA(1, 1, At, B1); PG8_BAR; PG8_SCHED;
            PG8_LDB(B0, 1, 0); PG8_LDB(B1, 1, 1); PG8_SCHED; PG8_LDA(At, 1, 0); PG8_STAGE_A(PG8_SA(0, 1), oc[1][0], oc[1][1], k2);
            PG8_WAIT_V(8); PG8_WAIT_L(0); PG8_BAR; PG8_MMA(0, 0, At, B0); PG8_MMA(0, 1, At, B1); PG8_BAR; PG8_SCHED;
            PG8_LDA(At, 1, 1); PG8_STAGE_B(PG8_SB(1, 0), b3); PG8_STAGE_B(PG8_SB(1, 1), b3 + hstepB); PG8_STAGE_A(PG8_SA(1, 0), oc[0][0], oc[0][1], k3);
            PG8_WAIT_V(8); PG8_WAIT_L(0); PG8_BAR; PG8_MMA(1, 0, At, B0); PG8_MMA(1, 1, At, B1); PG8_BAR; PG8_SCHED;
        }
        if (wr == 0) PG8_BAR;
        bool carry = false;
        if constexpr (Epi::MIDK) { if (cur.e == 0) { E.mid(acc, cur, wr, wc, fr, fq); carry = true; } else E(acc, cur, wr, wc, fr, fq); } else E(acc, cur, wr, wc, fr, fq);
        if (!has_next) break;
        if (!carry)
#pragma unroll
        for (int a = 0; a < 2; ++a)
#pragma unroll
            for (int b = 0; b < 2; ++b)
#pragma unroll
                for (int m = 0; m < 4; ++m)
#pragma unroll
                    for (int n = 0; n < 2; ++n) acc[a][b][m][n] = (f32x4){0.f, 0.f, 0.f, 0.f};
        cur = nxt; cB = nB; ++ui;
        if (wr == 1) PG8_BAR;
    }
    PG8_WAIT_V(0);
    PG8_BAR;
#undef PG8_SA
#undef PG8_SB
#undef PG8_STAGE_A
#undef PG8_STAGE_B
#undef PG8_LDA
#undef PG8_LDB
#undef PG8_MMA
#undef PG8_WAIT_V
#undef PG8_WAIT_L
#undef PG8_BAR
#undef PG8_SCHED
#undef PG8_AOFFS
}

template <bool F8_> struct EpiProj {
    static constexpr bool PREF = false, PERM = true, MIDK = false, F8 = F8_;
    bf16_t* O; float* kmp;
    __device__ __forceinline__ void operator()(const f32x4 (&acc)[2][2][4][2], const Unit& u, int wr, int wc, int fr, int fq) const {
        const int row0 = u.pm * BM + wr * 64 + fr;
        const bool narrow = (u.pn < C_VA / BM) || (u.pn >= C_QB / BM && u.pn < C_GA / BM);
        const bool gate = u.pn >= C_GA / BM;
        const int hw = narrow ? 128 : 256; const size_t bjs = narrow ? (size_t)HALF * T : (size_t)HALF;
#pragma unroll
        for (int ai = 0; ai < 2; ++ai)
#pragma unroll
            for (int m = 0; m < 4; ++m) { bf16_t* rowp = O + PROJ_BLK(u.pn * BM) + (size_t)(row0 + ai * HALF + m * 16) * hw + wc * 32 + 8 * fq;
#pragma unroll
                for (int bj = 0; bj < 2; ++bj) { const float sc = F8 ? (1.0f / 32.0f) : 1.0f; const f32x4 v0 = acc[ai][bj][m][0] * sc, v1 = acc[ai][bj][m][1] * sc;
                    if (F8 && gate) { u32x2 w8; w8.x = pk4_fp8(v0[0], v0[1], v0[2], v0[3]); w8.y = pk4_fp8(v1[0], v1[1], v1[2], v1[3]);
                        __builtin_nontemporal_store(w8, (u32x2*)((unsigned char*)(O + PROJ_BLK(u.pn * BM)) + (size_t)(row0 + ai * HALF + m * 16) * 256 + bj * HALF + wc * 32 + 8 * fq)); continue; }
                    u32x4 w; w.x = cvt_pk_bf16(v0[0], v0[1]); w.y = cvt_pk_bf16(v0[2], v0[3]); w.z = cvt_pk_bf16(v1[0], v1[1]); w.w = cvt_pk_bf16(v1[2], v1[3]);
                    __builtin_nontemporal_store(w, (u32x4*)(rowp + bj * bjs)); } }
        if (u.pn >= C_KB / BM && u.pn < C_VB / BM) {
#pragma unroll
            for (int bj = 0; bj < 2; ++bj)
#pragma unroll
                for (int n = 0; n < 2; ++n) { f32x4 s = (f32x4){0.f, 0.f, 0.f, 0.f};
#pragma unroll
                    for (int ai = 0; ai < 2; ++ai)
#pragma unroll
                        for (int m = 0; m < 4; ++m) s += acc[ai][bj][m][n];
#pragma unroll
                    for (int o = 1; o < 16; o <<= 1) { s[0] += __shfl_xor(s[0], o); s[1] += __shfl_xor(s[1], o); s[2] += __shfl_xor(s[2], o); s[3] += __shfl_xor(s[3], o); }
                    if (fr == 0) *(f32x4*)(kmp + ((size_t)wr * 64 + u.pm) * 1024 + (u.pn - C_KB / BM) * BM + bj * HALF + wc * 32 + 8 * fq + 4 * n) = s * (F8 ? (1.0f / 32.0f) : 1.0f); }
        }
    }
};
struct EpiMerge {
    static constexpr bool PREF = false, PERM = true, MIDK = true, F8 = false;
    const bf16_t* proj; bf16_t* Y;
    __device__ __forceinline__ void mid(f32x4 (&acc)[2][2][4][2], const Unit& u, int wr, int wc, int fr, int fq) const {
        const int row0 = u.pm * BM + wr * 64 + fr; const int col0 = u.pn * BM + wc * 32 + 8 * fq;
#pragma unroll
        for (int ai = 0; ai < 2; ++ai) {
            u32x2 ga[4][2], gb[4][2];
#pragma unroll
            for (int m = 0; m < 4; ++m) { const unsigned char* rowp = (const unsigned char*)(proj + PROJ_BLK(u.pn * BM)) + (size_t)(row0 + ai * HALF + m * 16) * 256 + wc * 32 + 8 * fq;
#pragma unroll
                for (int bj = 0; bj < 2; ++bj) { ga[m][bj] = *(const u32x2*)(rowp + 2 * PROJ_BLK(C_GA) + bj * HALF); gb[m][bj] = *(const u32x2*)(rowp + 2 * PROJ_BLK(C_GB) + bj * HALF); } }
#pragma unroll
            for (int m = 0; m < 4; ++m) {
#pragma unroll
                for (int bj = 0; bj < 2; ++bj) {
#pragma unroll
                    for (int n = 0; n < 2; ++n) {
#define MG_R(b_) ((1.0f + __builtin_amdgcn_exp2f(-1.4426950408889634f * __builtin_amdgcn_cvt_f32_fp8((int)gb[m][bj][n], b_))) * __builtin_amdgcn_rcpf(1.0f + __builtin_amdgcn_exp2f(-1.4426950408889634f * __builtin_amdgcn_cvt_f32_fp8((int)ga[m][bj][n], b_))))
                        acc[ai][bj][m][n][0] *= MG_R(0); acc[ai][bj][m][n][1] *= MG_R(1); acc[ai][bj][m][n][2] *= MG_R(2); acc[ai][bj][m][n][3] *= MG_R(3);
#undef MG_R
                    } }
                asm volatile("" : "+v"(acc[ai][0][m][0]), "+v"(acc[ai][0][m][1]), "+v"(acc[ai][1][m][0]), "+v"(acc[ai][1][m][1])); }
            asm volatile("" ::: "memory"); }
    }
    __device__ __forceinline__ void operator()(const f32x4 (&acc)[2][2][4][2], const Unit& u, int wr, int wc, int fr, int fq) const {
        const int row0 = u.pm * BM + wr * 64 + fr; const int col0 = u.pn * BM + wc * 32 + 8 * fq;
#pragma unroll
        for (int ai = 0; ai < 2; ++ai) {
            u32x2 gb[4][2];
#pragma unroll
            for (int m = 0; m < 4; ++m)
#pragma unroll
                for (int bj = 0; bj < 2; ++bj) gb[m][bj] = *(const u32x2*)((const unsigned char*)(proj + PROJ_BLK(C_GB + u.pn * BM)) + (size_t)(row0 + ai * HALF + m * 16) * 256 + wc * 32 + 8 * fq + bj * HALF);
#pragma unroll
            for (int m = 0; m < 4; ++m) { const size_t r = (size_t)(row0 + ai * HALF + m * 16);
#pragma unroll
                for (int bj = 0; bj < 2; ++bj) { const u32x2 g = gb[m][bj];
                    const f32x4 v0 = acc[ai][bj][m][0], v1 = acc[ai][bj][m][1];
#define MG_S(w_, b_) fsigmoid(__builtin_amdgcn_cvt_f32_fp8((int)(w_), b_))
                    u32x4 w; w.x = cvt_pk_bf16(v0[0] * MG_S(g.x, 0), v0[1] * MG_S(g.x, 1)); w.y = cvt_pk_bf16(v0[2] * MG_S(g.x, 2), v0[3] * MG_S(g.x, 3));
                    w.z = cvt_pk_bf16(v1[0] * MG_S(g.y, 0), v1[1] * MG_S(g.y, 1)); w.w = cvt_pk_bf16(v1[2] * MG_S(g.y, 2), v1[3] * MG_S(g.y, 3));
#undef MG_S
                    *(u32x4*)(Y + r * D + col0 + bj * HALF) = w; } }
            asm volatile("" ::: "memory"); }
    }
};
struct EpiResF32 {
    static constexpr bool PREF = false, PERM = false, MIDK = false, F8 = false;
    const float* base; bf16_t* out;
    __device__ __forceinline__ void operator()(const f32x4 (&acc)[2][2][4][2], const Unit& u, int wr, int wc, int fr, int fq) const {
        const int row0 = u.pm * BM + wr * 64 + fr, col0 = u.pn * BM + wc * 32 + 4 * fq;
#pragma unroll
        for (int ai = 0; ai < 2; ++ai) {
            f32x4 bs[4][2][2];
#pragma unroll
            for (int m = 0; m < 4; ++m) { const size_t off = (size_t)(row0 + ai * HALF + m * 16) * D + col0;
#pragma unroll
                for (int bj = 0; bj < 2; ++bj)
#pragma unroll
                    for (int n = 0; n < 2; ++n) bs[m][bj][n] = __builtin_nontemporal_load((const f32x4*)(base + off + bj * HALF + n * 16)); }
#pragma unroll
            for (int m = 0; m < 4; ++m) { const size_t off = (size_t)(row0 + ai * HALF + m * 16) * D + col0;
#pragma unroll
                for (int bj = 0; bj < 2; ++bj)
#pragma unroll
                    for (int n = 0; n < 2; ++n) { const f32x4 v = bs[m][bj][n] + acc[ai][bj][m][n]; u32x2 w; w.x = cvt_pk_bf16(v[0], v[1]); w.y = cvt_pk_bf16(v[2], v[3]); *(u32x2*)(out + off + bj * HALF + n * 16) = w; } }
            asm volatile("" ::: "memory"); }
    }
};
struct EpiGlu {
    static constexpr bool PREF = true, PERM = true, MIDK = false, F8 = true;
    unsigned char* H; const float* rstd_e; const LAS int* tab; const float* bg; const float* bu; const float* zero; LAS unsigned char* lds;
    __device__ __forceinline__ void prefetch(const Unit& u, int slot) const {
        int tid = threadIdx.x; asm volatile("" : "+v"(tid)); const int wave = __builtin_amdgcn_readfirstlane(tid >> 6);
        const float* src;
        if (wave < 4) { const int lr = u.pm * BM + tid - tab[u.e]; src = lr < tab[64 + u.e] ? rstd_e + (size_t)u.e * T + lr : zero; }
        else { const int j = tid - 256; src = (j < 128 ? bg : bu) + (size_t)u.e * FF + u.pn * HALF + (j & 127); }
        __builtin_amdgcn_global_load_lds((const unsigned*)src, (LAS unsigned*)(lds + EPF_OFF + slot * 2048 + wave * 256), 4, 0, 0);
    }
    __device__ __forceinline__ void operator()(const f32x4 (&acc)[2][2][4][2], const Unit& u, int wr, int wc, int fr, int fq) const {
        const int row0 = u.pm * BM + wr * 64 + fr; const int colo = u.pn * HALF + wc * 32 + 8 * fq;
        const LAS float* ep = (const LAS float*)(lds + EPF_OFF + u.s * 2048);
        f32x4 g4[2], u4[2];
#pragma unroll
        for (int n = 0; n < 2; ++n) { g4[n] = *(const LAS f32x4*)(ep + 256 + wc * 32 + 8 * fq + 4 * n); u4[n] = *(const LAS f32x4*)(ep + 384 + wc * 32 + 8 * fq + 4 * n); }
        float rsv[2][4];
#pragma unroll
        for (int ai = 0; ai < 2; ++ai)
#pragma unroll
            for (int m = 0; m < 4; ++m) rsv[ai][m] = ep[wr * 64 + fr + ai * HALF + m * 16];
#pragma unroll
        for (int ai = 0; ai < 2; ++ai)
#pragma unroll
            for (int m = 0; m < 4; ++m) { const int r = row0 + ai * HALF + m * 16; const float rs = rsv[ai][m] * (1.0f / 32.0f);
                float o[8];
#pragma unroll
                for (int n = 0; n < 2; ++n)
#pragma unroll
                    for (int j = 0; j < 4; ++j) { float g = acc[ai][0][m][n][j] * rs + g4[n][j], up = acc[ai][1][m][n][j] * rs + u4[n][j];
                        g = fminf(g, 7.0f); up = fminf(fmaxf(up, -7.0f), 7.0f);
                        const float glu = g * fsigmoid(1.702f * g); o[n * 4 + j] = (up + 1.0f) * glu; }
                u32x2 w; w.x = pk4_fp8(o[0], o[1], o[2], o[3]); w.y = pk4_fp8(o[4], o[5], o[6], o[7]);
                *(u32x2*)(H + (size_t)r * FF + colo) = w; asm volatile("" ::: "memory"); }
    }
};
template <int ACT, bool HASBIAS, bool F8_ = false> struct EpiBf16 {
    static constexpr bool PREF = false, PERM = true, MIDK = false, F8 = F8_;
    bf16_t* O; int ldc; const float* bias; int bias_stride; float scale;
    __device__ __forceinline__ void operator()(const f32x4 (&acc)[2][2][4][2], const Unit& u, int wr, int wc, int fr, int fq) const {
        const int row0 = u.pm * BM + wr * 64 + fr; const int col0 = u.pn * BM + wc * 32 + 8 * fq;
        f32x4 bv[2][2];
#pragma unroll
        for (int bj = 0; bj < 2; ++bj)
#pragma unroll
            for (int n = 0; n < 2; ++n) bv[bj][n] = HASBIAS ? *(const f32x4*)(bias + (size_t)u.e * bias_stride + col0 + bj * HALF + 4 * n) : (f32x4){0.f, 0.f, 0.f, 0.f};
#pragma unroll
        for (int ai = 0; ai < 2; ++ai)
#pragma unroll
            for (int m = 0; m < 4; ++m) { bf16_t* rowp = O + (size_t)(row0 + ai * HALF + m * 16) * ldc + col0;
#pragma unroll
                for (int bj = 0; bj < 2; ++bj) { f32x4 v0 = acc[ai][bj][m][0] * scale + bv[bj][0], v1 = acc[ai][bj][m][1] * scale + bv[bj][1];
                    if (ACT == 1) {
#pragma unroll
                        for (int j = 0; j < 4; ++j) { v0[j] = fsigmoid(v0[j]); v1[j] = fsigmoid(v1[j]); } }
                    u32x4 w; w.x = cvt_pk_bf16(v0[0], v0[1]); w.y = cvt_pk_bf16(v0[2], v0[3]); w.z = cvt_pk_bf16(v1[0], v1[1]); w.w = cvt_pk_bf16(v1[2], v1[3]);
                    *(u32x4*)(rowp + bj * HALF) = w; }
                asm volatile("" ::: "memory"); }
    }
};
struct EpiDownF8 {
    static constexpr bool PREF = false, PERM = true, MIDK = false, F8 = true;
    unsigned char* O; const float* bias;
    __device__ __forceinline__ void operator()(const f32x4 (&acc)[2][2][4][2], const Unit& u, int wr, int wc, int fr, int fq) const {
        const int row0 = u.pm * BM + wr * 64 + fr; const int col0 = u.pn * BM + wc * 32 + 8 * fq;
        f32x4 bv[2][2];
#pragma unroll
        for (int bj = 0; bj < 2; ++bj)
#pragma unroll
            for (int n = 0; n < 2; ++n) bv[bj][n] = *(const f32x4*)(bias + (size_t)u.e * D + col0 + bj * HALF + 4 * n);
#pragma unroll
        for (int ai = 0; ai < 2; ++ai)
#pragma unroll
            for (int m = 0; m < 4; ++m) { unsigned char* rowp = O + (size_t)(row0 + ai * HALF + m * 16) * D + col0;
#pragma unroll
                for (int bj = 0; bj < 2; ++bj) { const f32x4 v0 = acc[ai][bj][m][0] * (1.0f / 32.0f) + bv[bj][0], v1 = acc[ai][bj][m][1] * (1.0f / 32.0f) + bv[bj][1];
                    u32x2 w; w.x = pk4_fp8(v0[0], v0[1], v0[2], v0[3]); w.y = pk4_fp8(v1[0], v1[1], v1[2], v1[3]);
                    *(u32x2*)(rowp + bj * HALF) = w; }
                asm volatile("" ::: "memory"); }
    }
};
}
__device__ __forceinline__ void transpose_item(const float* __restrict__ W, int ldw, int k0, int n_src0, bf16_t* __restrict__ WT, int ldo, int n_dst0, int k_off, LAS float* scr, int lane) {
    { float t_[32]; const float* wp_ = W + (size_t)(k0 + (lane >> 5)) * ldw + n_src0 + (lane & 31);
#pragma unroll
    for (int i = 0; i < 32; ++i) t_[i] = __builtin_nontemporal_load(wp_ + (size_t)(2 * i) * ldw);
#pragma unroll
    for (int i = 0; i < 32; ++i) scr[(2 * i + (lane >> 5)) * 33 + (lane & 31)] = t_[i]; }
    LDS_WAIT(); asm volatile("" ::: "memory");
    const int c = lane & 7;
#pragma unroll
    for (int j = 0; j < 4; ++j) { const int n = (lane >> 3) + 8 * j; const LAS float* s = scr + (8 * c) * 33 + n;
        u32x4 o; o.x = cvt_pk_bf16(s[0 * 33], s[1 * 33]); o.y = cvt_pk_bf16(s[2 * 33], s[3 * 33]); o.z = cvt_pk_bf16(s[4 * 33], s[5 * 33]); o.w = cvt_pk_bf16(s[6 * 33], s[7 * 33]);
        *(u32x4*)(WT + (size_t)(n_dst0 + n) * ldo + k_off + k0 + 8 * c) = o; }
    LDS_WAIT(); asm volatile("" ::: "memory");
}
__device__ __forceinline__ void transpose_item_f8(const float* __restrict__ W, int ldw, int k0, int n_src0, unsigned char* __restrict__ WT, int ldo, int n_dst0, float sc, LAS float* scr, int lane) {
    { float t_[32]; const float* wp_ = W + (size_t)(k0 + (lane >> 5)) * ldw + n_src0 + (lane & 31);
#pragma unroll
    for (int i = 0; i < 32; ++i) t_[i] = __builtin_nontemporal_load(wp_ + (size_t)(2 * i) * ldw);
#pragma unroll
    for (int i = 0; i < 32; ++i) scr[(2 * i + (lane >> 5)) * 33 + (lane & 31)] = t_[i]; }
    LDS_WAIT(); asm volatile("" ::: "memory");
    const int c = lane & 7;
#pragma unroll
    for (int j = 0; j < 4; ++j) { const int n = (lane >> 3) + 8 * j; const LAS float* s = scr + (8 * c) * 33 + n;
        u32x2 o; o.x = pk4_fp8(s[0 * 33] * sc, s[1 * 33] * sc, s[2 * 33] * sc, s[3 * 33] * sc); o.y = pk4_fp8(s[4 * 33] * sc, s[5 * 33] * sc, s[6 * 33] * sc, s[7 * 33] * sc);
        *(u32x2*)(WT + (size_t)(n_dst0 + n) * ldo + k0 + 8 * c) = o; }
    LDS_WAIT(); asm volatile("" ::: "memory");
}
__device__ __forceinline__ void transpose_mat_item(const float* W, int ldw, int N, int n_src_base, bf16_t* WT, int ldo, int n_dst_base, int k_off, LAS float* scr, int item, int lane) {
    const int nblk = N / 32, kb = item / nblk, nb = item % nblk;
    transpose_item(W, ldw, 64 * kb, n_src_base + 32 * nb, WT, ldo, n_dst_base + 32 * nb, k_off, scr, lane);
}

struct P {
    const float* in[25]; float* out; unsigned char* ws;
};

__device__ __forceinline__ void p0_prologue(const P& a, LAS unsigned char* lds, int vcu, int G, int wave, int lane) {
    LAS float* scr = (LAS float*)(lds + wave * 16384);
    const int gw = vcu * NWAVES + wave, NGW = G * NWAVES;
    unsigned char* ws = a.ws;
    bf16_t* WinT = (bf16_t*)(ws + WS_WIN);
    constexpr int I_A = 16 * 96, I_B8 = 16 * 160, I_B = 0;
    constexpr int NITEMS = I_A + I_B8 + I_B;
#ifndef P0_PARTS
#define P0_PARTS 63
#endif
    if (P0_PARTS & 1)
    for (int it = gw; it < NITEMS; it += NGW) {
        int r = it;
        if (r < I_A) { transpose_mat_item(a.in[4], D_IN, 3072, 0, WinT, D, 0, 0, scr, r, lane); continue; } r -= I_A;
        if (r < I_B8) { const int kb = r / 160, nb = r % 160; transpose_item_f8(a.in[4], D_IN, 64 * kb, 3088 + 32 * nb, ws + WS_WIN8, D, 32 * nb, 32.0f, scr, lane); continue; } r -= I_B8;
    }
    if (P0_PARTS & 2) {
        const float* x = a.in[0]; const float* g = a.in[3]; bf16_t* H = (bf16_t*)(ws + WS_H);
        f32x4 gv[4];
#pragma unroll
        for (int j = 0; j < 4; ++j) gv[j] = *((const f32x4*)g + lane + 64 * j);
        f32x4 va[4], vb[4];
#define H_LOAD(m_, V) do { if ((m_) < T) { const f32x4* xr = (const f32x4*)(x + (size_t)(m_) * D) + lane; _Pragma("unroll") for (int j = 0; j < 4; ++j) V[j] = __builtin_nontemporal_load(xr + 64 * j); } } while (0)
#define H_DO(m_, V) do { if ((m_) < T) { float s_ = 0.f; \
            _Pragma("unroll") for (int j = 0; j < 4; ++j) s_ += (V[j].x * V[j].x + V[j].y * V[j].y) + (V[j].z * V[j].z + V[j].w * V[j].w); \
            const float rstd = 1.0f / sqrtf(wave_sum(s_) * (1.0f / D) + EPS); \
            u32x2* o8 = (u32x2*)(H + (size_t)(m_) * D) + lane; unsigned* q8 = (unsigned*)(ws + WS_H8 + (size_t)(m_) * D) + lane; \
            _Pragma("unroll") for (int j = 0; j < 4; ++j) { const f32x4 y = V[j] * rstd * gv[j]; u32x2 w; w.x = cvt_pk_bf16(y.x, y.y); w.y = cvt_pk_bf16(y.z, y.w); o8[64 * j] = w; q8[64 * j] = pk4_fp8(y.x, y.y, y.z, y.w); } } } while (0)
        H_LOAD(gw, va);
        for (int m = gw; m < T; m += 2 * NGW) { H_LOAD(m + NGW, vb); H_DO(m, va); H_LOAD(m + 2 * NGW, va); H_DO(m + NGW, vb); }
#undef H_LOAD
#undef H_DO
    }
    if (P0_PARTS & 8) {
        const int gt = (vcu * NWAVES + wave) * 64 + lane;
        if ((P0_PARTS & 16) && gt < 16 * 1024) { const int n = gt >> 10, k = gt & 1023; ((bf16_t*)(ws + WS_WALT))[n * 1024 + k] = (bf16_t)(cvt_pk_bf16(a.in[4][(size_t)k * D_IN + SRC_ALOW + n], 0.f) & 0xffffu); }
        if ((P0_PARTS & 32) && gt < 4096) { const int s = gt >> 6, l = gt & 63, e = l & 31, hh = l >> 5; const float* wr = a.in[12];
            float v[8], lo[8];
#pragma unroll
            for (int j = 0; j < 8; ++j) { v[j] = wr[(size_t)(16 * s + 8 * hh + j) * NE + e]; }
            u32x4 whi; whi.x = cvt_pk_bf16(v[0], v[1]); whi.y = cvt_pk_bf16(v[2], v[3]); whi.z = cvt_pk_bf16(v[4], v[5]); whi.w = cvt_pk_bf16(v[6], v[7]);
#pragma unroll
            for (int j = 0; j < 4; ++j) { lo[2 * j] = v[2 * j] - bflo(whi[j]); lo[2 * j + 1] = v[2 * j + 1] - bfhi(whi[j]); }
            u32x4 wlo; wlo.x = cvt_pk_bf16(lo[0], lo[1]); wlo.y = cvt_pk_bf16(lo[2], lo[3]); wlo.z = cvt_pk_bf16(lo[4], lo[5]); wlo.w = cvt_pk_bf16(lo[6], lo[7]);
            u32x4* f = (u32x4*)(ws + WS_WRF); f[gt] = whi; f[4096 + gt] = wlo; }
    }
}

__device__ __forceinline__ void late_prep(const P& a, LAS unsigned char* lds, int ci, int ncv, int wave, int lane) {
    LAS float* scr = (LAS float*)(lds + wave * 16384);
    const int gw = ci * NWAVES + wave, NGW = ncv * NWAVES;
    unsigned char* ws = a.ws;
    bf16_t* WupT = (bf16_t*)(ws + WS_WUP); bf16_t* WoT = (bf16_t*)(ws + WS_WO); bf16_t* WpgT = (bf16_t*)(ws + WS_WPG); bf16_t* WppT = (bf16_t*)(ws + WS_WPP);
    constexpr int I_S = 16 * 32, I_P = 4 * 32;
    for (int it = gw; it < 4 * I_S + I_P; it += NGW) {
        int r = it;
        if (r < I_S) { transpose_mat_item(a.in[8], D, D, 0, WupT, 2048, 0, 0, scr, r, lane); continue; } r -= I_S;
        if (r < I_S) { transpose_mat_item(a.in[9], D, D, 0, WupT, 2048, 0, 1024, scr, r, lane); continue; } r -= I_S;
        if (r < I_S) { transpose_mat_item(a.in[10], D, D, 0, WoT, D, 0, 0, scr, r, lane); continue; } r -= I_S;
        if (r < I_S) { const int kb = r / 32, nb = r % 32; transpose_item_f8(a.in[21], D, 64 * kb, 32 * nb, (unsigned char*)WpgT, D, 32 * nb, 32.0f, scr, lane); continue; } r -= I_S;
        transpose_mat_item(a.in[22], D, D, 0, WppT, 256, 0, 0, scr, r, lane);
    }
    const f32x4* p4 = (const f32x4*)a.in[1]; u32x2* pb = (u32x2*)(ws + WS_PB);
    const size_t n4 = (size_t)T * 256 / 4;
    for (size_t i = (size_t)gw * 64 + lane; i < n4; i += (size_t)NGW * 64) { const f32x4 v = __builtin_nontemporal_load(p4 + i); u32x2 w; w.x = cvt_pk_bf16(v.x, v.y); w.y = cvt_pk_bf16(v.z, v.w); pb[i] = w; }
}

struct CvtItem { const float* src; unsigned char* dst; int ldo; };
__device__ __forceinline__ CvtItem cvt_item(const P& a, int it, int lane) {
    constexpr int IPM = 16 * 32;
    const int e = it / (3 * IPM), r0 = it % (3 * IPM), which = r0 / IPM, r = r0 % IPM, kb = r / 32, nb = r % 32, n0 = 32 * nb;
    CvtItem c;
    if (which < 2) { c.src = a.in[which == 0 ? 14 : 16] + (size_t)e * D * FF + (size_t)(64 * kb + (lane >> 5)) * FF + n0 + (lane & 31);
        c.dst = (unsigned char*)a.out + ((size_t)e * 2048 + (n0 >> 7) * 256 + (n0 & 127) + which * 128) * D + 64 * kb; c.ldo = D; }
    else { c.src = a.in[18] + (size_t)e * FF * D + (size_t)(64 * kb + (lane >> 5)) * D + n0 + (lane & 31);
        c.dst = a.ws + WS_W2T + ((size_t)e * D + n0) * FF + 64 * kb; c.ldo = FF; }
    return c;
}
__device__ __forceinline__ void expert_convert(const P& a, LAS unsigned char* lds, int vcu, int G, int wave, int lane) {
    LAS float* scr = (LAS float*)(lds + wave * 16384);
    const int gw = vcu * NWAVES + wave, NGW = G * NWAVES;
    constexpr int NIT = NE * 3 * 16 * 32;
    if (gw >= NIT) return;
    float tA[32], tB[32];
    CvtItem cA = cvt_item(a, gw, lane), cB = cvt_item(a, gw + NGW < NIT ? gw + NGW : gw, lane);
#pragma unroll
    for (int i = 0; i < 32; ++i) tA[i] = __builtin_nontemporal_load(cA.src + (size_t)(2 * i) * 1024);
#pragma unroll
    for (int i = 0; i < 32; ++i) tB[i] = __builtin_nontemporal_load(cB.src + (size_t)(2 * i) * 1024);
#define CVT_OUT(c_) do { LDS_WAIT(); asm volatile("" ::: "memory"); const int c = lane & 7; \
        _Pragma("unroll") for (int j = 0; j < 4; ++j) { const int n = (lane >> 3) + 8 * j; const LAS float* s = scr + (8 * c) * 33 + n; \
            u32x2 o; o.x = pk4_fp8(s[0 * 33] * 32.0f, s[1 * 33] * 32.0f, s[2 * 33] * 32.0f, s[3 * 33] * 32.0f); o.y = pk4_fp8(s[4 * 33] * 32.0f, s[5 * 33] * 32.0f, s[6 * 33] * 32.0f, s[7 * 33] * 32.0f); \
            __builtin_nontemporal_store(o, (u32x2*)((c_).dst + (size_t)n * (c_).ldo + 8 * c)); } \
        LDS_WAIT(); asm volatile("" ::: "memory"); } while (0)
    for (int it = gw; it < NIT; it += 2 * NGW) {
#pragma unroll
        for (int i = 0; i < 32; ++i) scr[(2 * i + (lane >> 5)) * 33 + (lane & 31)] = tA[i];
        const CvtItem dA = cA; const int n2 = it + 2 * NGW;
        if (n2 < NIT) { cA = cvt_item(a, n2, lane);
#pragma unroll
            for (int i = 0; i < 32; ++i) tA[i] = __builtin_nontemporal_load(cA.src + (size_t)(2 * i) * 1024); }
        CVT_OUT(dA);
        if (it + NGW >= NIT) break;
#pragma unroll
        for (int i = 0; i < 32; ++i) scr[(2 * i + (lane >> 5)) * 33 + (lane & 31)] = tB[i];
        const CvtItem dB = cB; const int n3 = it + 3 * NGW;
        if (n3 < NIT) { cB = cvt_item(a, n3, lane);
#pragma unroll
            for (int i = 0; i < 32; ++i) tB[i] = __builtin_nontemporal_load(cB.src + (size_t)(2 * i) * 1024); }
        CVT_OUT(dB);
    }
#undef CVT_OUT
}

__device__ __forceinline__ float fexp_(float x) { return __builtin_amdgcn_exp2f(x * 1.4426950408889634f); }
__device__ __forceinline__ float logsigmoidf_(float x) { const float e = fexp_(-fabsf(x)); return fminf(x, 0.0f) - 0.6931471805599453f * __builtin_amdgcn_logf(1.0f + e); }
__device__ __forceinline__ void gla_prep_unit(const P& a, LAS unsigned char* lds, int unit) {
    int tid = threadIdx.x; asm volatile("" : "+v"(tid));     const int wave = __builtin_amdgcn_readfirstlane(tid >> 6), lane = tid & 63;
    const int b = unit >> 5, chunk = unit & 31, tok0 = b * SEQ + chunk * 64;
    const bf16_t* H = (const bf16_t*)(a.ws + WS_H); const bf16_t* WalT = (const bf16_t*)(a.ws + WS_WALT); const bf16_t* proj = (const bf16_t*)(a.ws + WS_PROJ);
    LAS float* part = (LAS float*)lds;
    LAS float* alow = (LAS float*)(lds + 8192);
    LAS float* seg = (LAS float*)(lds + 12288);
    constexpr int GP_KDT = 16384, GP_VT = 34816;
    {
        const int rg = wave & 3, kh = wave >> 2, r = lane & 15, q = lane >> 4;
        f32x4 acc = (f32x4){0.f, 0.f, 0.f, 0.f};
        const bf16_t* ap = H + (size_t)(tok0 + 16 * rg + r) * D + 512 * kh + 8 * q; const bf16_t* bp = WalT + (size_t)r * D + 512 * kh + 8 * q;
#pragma unroll 8
        for (int s = 0; s < 16; ++s) { const bf16x8 av = *(const bf16x8*)(ap + 32 * s), bv = *(const bf16x8*)(bp + 32 * s); acc = __builtin_amdgcn_mfma_f32_16x16x32_bf16(bv, av, acc, 0, 0, 0); }
        *(LAS f32x4*)(part + (kh * 64 + 16 * rg + r) * 16 + 4 * q) = acc;
    }
    __syncthreads();
    if (tid < 256) { *(LAS f32x4*)(alow + tid * 4) = *(LAS f32x4*)(part + tid * 4) + *(LAS f32x4*)(part + 1024 + tid * 4); }
    __syncthreads();
    const int dp = tid & 63, tq = wave;
    const float* w_a2 = a.in[5]; const float* b_a2 = a.in[6];
    const int ep = tid & 127, sq4 = tid >> 7;
    f32x2 w2[16], w2n[16]; f32x2 b2, b2n; unsigned qv[8], kv[8], qvn[8], kvn[8], sv[16], svn[16];
#define GP_LOADS(h_, W2, B2, QV, KV, SV) do { const int dc_ = (h_) * 128 + 2 * dp; \
        _Pragma("unroll") for (int r = 0; r < 16; ++r) W2[r] = *(const f32x2*)(w_a2 + r * 512 + dc_); \
        B2 = *(const f32x2*)(b_a2 + dc_); \
        _Pragma("unroll") for (int i = 0; i < 8; ++i) { const bf16_t* rp = proj + PROJ_BLK((h_) * 128) + (size_t)(tok0 + 8 * tq + i) * 128 + 2 * dp; QV[i] = __builtin_nontemporal_load((const unsigned*)(rp + PROJ_BLK(C_QA))); KV[i] = __builtin_nontemporal_load((const unsigned*)(rp + PROJ_BLK(C_KA))); } \
        const bf16_t* v_ = proj + PROJ_BLK(C_VA + (h_) * 256) + (size_t)(tok0 + 16 * sq4) * 256 + 2 * ep; \
        _Pragma("unroll") for (int i = 0; i < 16; ++i) SV[i] = __builtin_nontemporal_load((const unsigned*)(v_ + (size_t)i * 256)); } while (0)
    GP_LOADS(0, w2, b2, qv, kv, sv);
    for (int h = 0; h < 4; ++h) {
        if (h + 1 < 4) GP_LOADS(h + 1, w2n, b2n, qvn, kvn, svn);
        float G0[8], G1[8]; float r0 = 0.f, r1 = 0.f;
#pragma unroll
        for (int i = 0; i < 8; ++i) { const LAS f32x4* al4 = (const LAS f32x4*)(alow + (8 * tq + i) * 16); float x0 = b2.x, x1 = b2.y;
#pragma unroll
            for (int r4 = 0; r4 < 4; ++r4) { const f32x4 al = al4[r4];
#pragma unroll
                for (int j = 0; j < 4; ++j) { x0 += al[j] * w2[4 * r4 + j].x; x1 += al[j] * w2[4 * r4 + j].y; } }
            r0 += logsigmoidf_(x0) * (1.0f / 16.0f); r1 += logsigmoidf_(x1) * (1.0f / 16.0f); G0[i] = r0; G1[i] = r1; }
        *(LAS f32x2*)(seg + tq * 128 + 2 * dp) = (f32x2){r0, r1};
        __syncthreads();
        float off0 = 0.f, off1 = 0.f, tot0 = 0.f, tot1 = 0.f;
#pragma unroll
        for (int q = 0; q < 8; ++q) { const f32x2 s = *(LAS f32x2*)(seg + q * 128 + 2 * dp); tot0 += s.x; tot1 += s.y; if (q < tq) { off0 += s.x; off1 += s.y; } }
        const size_t tile = (size_t)((b * 4 + h) * 32 + chunk);
        bf16_t* Qg = (bf16_t*)(a.ws + WS_QG) + tile * 8192; bf16_t* Kg = (bf16_t*)(a.ws + WS_KG) + tile * 8192;
        float kd0[8], kd1[8];
#pragma unroll
        for (int i = 0; i < 8; ++i) { const float g0 = G0[i] + off0, g1 = G1[i] + off1; const float q0 = bflo(qv[i]), q1 = bfhi(qv[i]), k0 = bflo(kv[i]), k1 = bfhi(kv[i]);
            const float e0 = fexp_(g0), e1 = fexp_(g1);
            *(unsigned*)(Qg + (8 * tq + i) * 128 + 2 * dp) = cvt_pk_bf16(q0 * e0 * 0.08838834764831845f, q1 * e1 * 0.08838834764831845f);
            *(unsigned*)(Kg + (8 * tq + i) * 128 + 2 * dp) = cvt_pk_bf16(k0 * __builtin_amdgcn_rcpf(e0), k1 * __builtin_amdgcn_rcpf(e1));
            kd0[i] = k0 * fexp_(tot0 - g0); kd1[i] = k1 * fexp_(tot1 - g1); }
        u32x4 w0, w1; w0.x = cvt_pk_bf16(kd0[0], kd0[1]); w0.y = cvt_pk_bf16(kd0[2], kd0[3]); w0.z = cvt_pk_bf16(kd0[4], kd0[5]); w0.w = cvt_pk_bf16(kd0[6], kd0[7]);
        w1.x = cvt_pk_bf16(kd1[0], kd1[1]); w1.y = cvt_pk_bf16(kd1[2], kd1[3]); w1.z = cvt_pk_bf16(kd1[4], kd1[5]); w1.w = cvt_pk_bf16(kd1[6], kd1[7]);
        *(LAS u32x4*)(lds + GP_KDT + (2 * dp) * 144 + 16 * tq) = w0; *(LAS u32x4*)(lds + GP_KDT + (2 * dp + 1) * 144 + 16 * tq) = w1;
        if (tq == 0) *(f32x2*)((float*)(a.ws + WS_DEC) + tile * 128 + 2 * dp) = (f32x2){fexp_(tot0), fexp_(tot1)};
        {
            u32x4 lo0, lo1, hi0, hi1;
#pragma unroll
            for (int j = 0; j < 4; ++j) { lo0[j] = (sv[2 * j] & 0xffffu) | (sv[2 * j + 1] << 16); lo1[j] = (sv[8 + 2 * j] & 0xffffu) | (sv[8 + 2 * j + 1] << 16);
                hi0[j] = (sv[2 * j] >> 16) | (sv[2 * j + 1] & 0xffff0000u); hi1[j] = (sv[8 + 2 * j] >> 16) | (sv[8 + 2 * j + 1] & 0xffff0000u); }
            LAS unsigned char* v0 = lds + GP_VT + (2 * ep) * 144 + sq4 * 32;
            *(LAS u32x4*)(v0) = lo0; *(LAS u32x4*)(v0 + 16) = lo1; *(LAS u32x4*)(v0 + 144) = hi0; *(LAS u32x4*)(v0 + 144 + 16) = hi1;
        }
        __syncthreads();
        {
            const int c32 = lane & 31, hi = lane >> 5;
            bf16x8 vt[4];
#pragma unroll
            for (int ks = 0; ks < 4; ++ks) vt[ks] = *(const LAS bf16x8*)(lds + GP_VT + (32 * wave + c32) * 144 + (16 * ks + 8 * hi) * 2);
            unsigned* sl = (unsigned*)a.out + tile * 8192;
#pragma unroll
            for (int tl = 0; tl < 4; ++tl) { f32x16 acc;
#pragma unroll
                for (int r = 0; r < 16; ++r) acc[r] = 0.f;
#pragma unroll
                for (int ks = 0; ks < 4; ++ks) { const bf16x8 av = *(const LAS bf16x8*)(lds + GP_KDT + (32 * tl + c32) * 144 + (16 * ks + 8 * hi) * 2); acc = __builtin_amdgcn_mfma_f32_32x32x16_bf16(av, vt[ks], acc, 0, 0, 0); }
#pragma unroll
                for (int g = 0; g < 4; ++g) sl[((tl * 4 + g) * 2 + hi) * 256 + 32 * wave + c32] = pk4_fp8(acc[4 * g], acc[4 * g + 1], acc[4 * g + 2], acc[4 * g + 3]); }
        }
        __syncthreads();
#pragma unroll
        for (int r = 0; r < 16; ++r) { w2[r] = w2n[r]; sv[r] = svn[r]; }
#pragma unroll
        for (int i = 0; i < 8; ++i) { qv[i] = qvn[i]; kv[i] = kvn[i]; }
        b2 = b2n;
    }
#undef GP_LOADS
}

__device__ __forceinline__ void gla_combine_unit(const P& a, int unit) {
    const int tid = threadIdx.x, bh = unit >> 4, i8 = (unit & 15) * 512 + tid;
    const int d0 = 32 * (i8 >> 11) + 8 * ((i8 >> 9) & 3) + 4 * ((i8 >> 8) & 1);
    const unsigned* sl8 = (const unsigned*)a.out + (size_t)bh * 32 * 8192 + i8; u32x2* sl = (u32x2*)(a.ws + WS_SLOC) + (size_t)bh * 32 * 8192 + i8;
    const f32x4* dc = (const f32x4*)((const float*)(a.ws + WS_DEC) + (size_t)bh * 32 * 128 + d0);
    f32x4 s = (f32x4){0.f, 0.f, 0.f, 0.f};
    for (int cb = 0; cb < 32; cb += 8) {
        unsigned loc[8]; f32x4 dv[8];
#pragma unroll
        for (int i = 0; i < 8; ++i) { loc[i] = __builtin_nontemporal_load(sl8 + (size_t)(cb + i) * 8192); dv[i] = dc[(cb + i) * 32]; }
#pragma unroll
        for (int i = 0; i < 8; ++i) { if (cb + i < 31) {
            s.x = dv[i].x * s.x + __builtin_amdgcn_cvt_f32_fp8((int)loc[i], 0); s.y = dv[i].y * s.y + __builtin_amdgcn_cvt_f32_fp8((int)loc[i], 1);
            s.z = dv[i].z * s.z + __builtin_amdgcn_cvt_f32_fp8((int)loc[i], 2); s.w = dv[i].w * s.w + __builtin_amdgcn_cvt_f32_fp8((int)loc[i], 3);
            u32x2 w; w.x = cvt_pk_bf16(s.x, s.y); w.y = cvt_pk_bf16(s.z, s.w); sl[(size_t)(cb + i) * 8192] = w; } }
    }
}

constexpr int GL_QG = 0, GL_KG = 17408, GL_VT = 53248, GL_AM = 90112, GL_OST = 0;
constexpr int GL_QS = 272, GL_TS = 144, GL_OS = 528;
__device__ __forceinline__ int crow(int r, int hi) { return (r & 3) + 8 * (r >> 2) + 4 * hi; }
__device__ __forceinline__ void gla_out_unit(const P& a, LAS unsigned char* lds, int unit) {
    int tid = threadIdx.x; asm volatile("" : "+v"(tid)); const int w = __builtin_amdgcn_readfirstlane(tid >> 6), lane = tid & 63, c32 = lane & 31, hi = lane >> 5;
    const int bh = unit >> 5, chunk = unit & 31, b = bh >> 2, h = bh & 3;
    const bf16_t* proj = (const bf16_t*)(a.ws + WS_PROJ); bf16_t* oab = (bf16_t*)(a.ws + WS_OAB); const float* ggo = a.in[7];
    const size_t tile = (size_t)bh * 32 + chunk;
    {
        const u32x4* q_ = (const u32x4*)((const bf16_t*)(a.ws + WS_QG) + tile * 8192); const u32x4* k_ = (const u32x4*)((const bf16_t*)(a.ws + WS_KG) + tile * 8192);
        u32x4 sq[2], sk[2]; unsigned sv[16];
        sq[0] = __builtin_nontemporal_load(q_ + tid); sq[1] = __builtin_nontemporal_load(q_ + tid + 512); sk[0] = __builtin_nontemporal_load(k_ + tid); sk[1] = __builtin_nontemporal_load(k_ + tid + 512);
        const int ep = tid & 127, sq4 = tid >> 7;
        const bf16_t* v_ = proj + PROJ_BLK(C_VA + h * 256) + (size_t)(b * SEQ + chunk * 64 + 16 * sq4) * 256 + 2 * ep;
#pragma unroll
        for (int i = 0; i < 16; ++i) sv[i] = __builtin_nontemporal_load((const unsigned*)(v_ + (size_t)i * 256));
#pragma unroll
        for (int i = 0; i < 2; ++i) { const int p = tid + 512 * i;
            *(LAS u32x4*)(lds + GL_QG + (p >> 4) * GL_QS + (p & 15) * 16) = sq[i]; *(LAS u32x4*)(lds + GL_KG + (p >> 4) * GL_QS + (p & 15) * 16) = sk[i]; }
        u32x4 lo0, lo1, hi0, hi1;
#pragma unroll
        for (int j = 0; j < 4; ++j) { lo0[j] = (sv[2 * j] & 0xffffu) | (sv[2 * j + 1] << 16); lo1[j] = (sv[8 + 2 * j] & 0xffffu) | (sv[8 + 2 * j + 1] << 16);
            hi0[j] = (sv[2 * j] >> 16) | (sv[2 * j + 1] & 0xffff0000u); hi1[j] = (sv[8 + 2 * j] >> 16) | (sv[8 + 2 * j + 1] & 0xffff0000u); }
        LAS unsigned char* v0 = lds + GL_VT + (2 * ep) * GL_TS + sq4 * 32;
        *(LAS u32x4*)(v0) = lo0; *(LAS u32x4*)(v0 + 16) = lo1; *(LAS u32x4*)(v0 + GL_TS) = hi0; *(LAS u32x4*)(v0 + GL_TS + 16) = hi1;
    }
    u32x2 sf[4][2][2];
    if (chunk > 0) { const u32x2* sl = (const u32x2*)(a.ws + WS_SLOC) + (tile - 1) * 8192;
#pragma unroll
        for (int tl = 0; tl < 4; ++tl)
#pragma unroll
            for (int s = 0; s < 2; ++s)
#pragma unroll
                for (int q = 0; q < 2; ++q) sf[tl][s][q] = __builtin_nontemporal_load(sl + ((tl * 4 + 2 * s + q) * 2 + hi) * 256 + 32 * w + c32); }
    __syncthreads();
    if (w < 3) {
        const int ti = (w + 1) >> 1, si = w >> 1;
        f32x16 A;
#pragma unroll
        for (int r = 0; r < 16; ++r) A[r] = 0.f;
#pragma unroll
        for (int s = 0; s < 8; ++s) { const bf16x8 av = *(const LAS bf16x8*)(lds + GL_QG + (32 * ti + c32) * GL_QS + (16 * s + 8 * hi) * 2), bv = *(const LAS bf16x8*)(lds + GL_KG + (32 * si + c32) * GL_QS + (16 * s + 8 * hi) * 2);
            A = __builtin_amdgcn_mfma_f32_32x32x16_bf16(av, bv, A, 0, 0, 0); }
        const int sidx = 32 * si + c32;
#pragma unroll
        for (int r = 0; r < 16; ++r) { const int t = 32 * ti + crow(r, hi); const float v = (sidx <= t) ? A[r] : 0.f;
            *(LAS bf16_t*)(lds + GL_AM + t * GL_TS + sidx * 2) = (bf16_t)(cvt_pk_bf16(v, 0.f) & 0xffffu); }
    }
    __syncthreads();
    f32x16 o[2];
    {
        bf16x8 vt[4];
#pragma unroll
        for (int ks = 0; ks < 4; ++ks) vt[ks] = *(const LAS bf16x8*)(lds + GL_VT + (32 * w + c32) * GL_TS + (16 * ks + 8 * hi) * 2);
#pragma unroll
        for (int ti = 0; ti < 2; ++ti) {
#pragma unroll
            for (int r = 0; r < 16; ++r) o[ti][r] = 0.f;
            if (chunk > 0) {
#pragma unroll
                for (int tl = 0; tl < 4; ++tl)
#pragma unroll
                    for (int s = 0; s < 2; ++s) { const LAS unsigned char* qp = lds + GL_QG + (32 * ti + c32) * GL_QS + (32 * tl + 16 * s + 4 * hi) * 2;
                        const s16x4 lo = *(const LAS s16x4*)qp, hh = *(const LAS s16x4*)(qp + 16);
                        const bf16x8 aop = __builtin_shufflevector(lo, hh, 0, 1, 2, 3, 4, 5, 6, 7);
                        const u32x4 bw = {sf[tl][s][0].x, sf[tl][s][0].y, sf[tl][s][1].x, sf[tl][s][1].y};
                        o[ti] = __builtin_amdgcn_mfma_f32_32x32x16_bf16(aop, __builtin_bit_cast(bf16x8, bw), o[ti], 0, 0, 0); }
            }
#pragma unroll
            for (int ks = 0; ks < 4; ++ks) { if (ti == 0 && ks >= 2) continue;
                const bf16x8 av = *(const LAS bf16x8*)(lds + GL_AM + (32 * ti + c32) * GL_TS + (16 * ks + 8 * hi) * 2);
                o[ti] = __builtin_amdgcn_mfma_f32_32x32x16_bf16(av, vt[ks], o[ti], 0, 0, 0); }
        }
    }
    __syncthreads();
#pragma unroll
    for (int ti = 0; ti < 2; ++ti)
#pragma unroll
        for (int r = 0; r < 16; ++r) *(LAS bf16_t*)(lds + GL_OST + (32 * ti + crow(r, hi)) * GL_OS + (32 * w + c32) * 2) = (bf16_t)(cvt_pk_bf16(o[ti][r], 0.f) & 0xffffu);
    __syncthreads();
    {
        const int t = tid >> 3, sg = tid & 7; const size_t tok = (size_t)(b * SEQ + chunk * 64 + t);
        u32x4 ov[4]; float ss = 0.f;
#pragma unroll
        for (int j = 0; j < 4; ++j) { ov[j] = *(const LAS u32x4*)(lds + GL_OST + t * GL_OS + sg * 64 + j * 16);
#pragma unroll
            for (int i = 0; i < 4; ++i) { const float x0 = bflo(ov[j][i]), x1 = bfhi(ov[j][i]); ss += x0 * x0 + x1 * x1; } }
        ss += __shfl_xor(ss, 1); ss += __shfl_xor(ss, 2); ss += __shfl_xor(ss, 4);
        const float rstd = 1.0f / sqrtf(ss * (1.0f / 256.0f) + EPS);
        const bf16_t* rap = proj + PROJ_BLK(C_RA + h * 256) + tok * 256 + sg * 32; bf16_t* op = oab + tok * 2048 + h * 256 + sg * 32; const float* gp = ggo + sg * 32;
#pragma unroll
        for (int j = 0; j < 4; ++j) { const u32x4 ra = __builtin_nontemporal_load((const u32x4*)(rap + 8 * j)); const f32x4 g0 = *(const f32x4*)(gp + 8 * j), g1 = *(const f32x4*)(gp + 8 * j + 4); u32x4 wv;
#pragma unroll
            for (int i = 0; i < 4; ++i) { const float r0 = bflo(ra[i]), r1 = bfhi(ra[i]); const float ga = (i < 2) ? g0[2 * i] : g1[2 * i - 4], gb = (i < 2) ? g0[2 * i + 1] : g1[2 * i - 3];
                wv[i] = cvt_pk_bf16(bflo(ov[j][i]) * rstd * ga * (r0 * fsigmoid(r0)), bfhi(ov[j][i]) * rstd * gb * (r1 * fsigmoid(r1))); }
            *(u32x4*)(op + 8 * j) = wv; }
    }
    __syncthreads();
}
namespace moba {
constexpr int HD = 128;
constexpr float SCALE = 0.08838834764831845f;
constexpr float THR = 8.f;
constexpr int NW = 8, QBLK = 32, KVBLK = 64, QB = NW * QBLK;
constexpr int SHM_V = KVBLK * HD * 2, SHM_K = KVBLK * HD * 2;
constexpr int OFF_WS = 2 * SHM_V + 2 * SHM_K;
constexpr int OFF_RTAB = OFF_WS + NW * 64 * 4;
constexpr int OFF_KM = OFF_RTAB + 2400 * 4;
constexpr int OFF_MISC = OFF_KM + 8 * 128 * 4;
constexpr int OFF_SEL = OFF_MISC + 64;
constexpr int LDS_BYTES = OFF_SEL + 2048;
constexpr int LDP = HD, LDO = 2048;

#define KSWZ(row, colB) ((row) * 256 + ((colB) ^ (((row) & 7) << 4)))
#define SBAR() __builtin_amdgcn_sched_barrier(0)
__device__ __forceinline__ int v_st(int k, int c) { const int kk = (k & ~0xC) | ((k & 4) << 1) | ((k & 8) >> 1); return ((kk >> 3) * 4 + (c >> 5)) * 512 + ((kk & 7) * 32 + (c & 31)) * 2; }
__device__ __forceinline__ int v_rd_base(int lane) { return ((lane & 3) << 3) | (((lane >> 2) & 3) << 6) | (((lane >> 4) & 1) << 5) | (((lane >> 5) & 1) << 8); }
constexpr int v_rd_off(int d0, int ks, int half) { return d0 * 512 + ks * 4096 + half * 2048; }
__device__ __forceinline__ int crow(int r, int hi) { return (r & 3) + 8 * (r >> 2) + 4 * hi; }
__device__ __forceinline__ unsigned cvtpk(float lo, float hi) { unsigned r; asm volatile("v_cvt_pk_bf16_f32 %0, %1, %2" : "=v"(r) : "v"(lo), "v"(hi)); return r; }

__device__ __forceinline__ void mask_tile(f32x16& p0, f32x16& p1, int dq) {
    const float NEG = -__builtin_inff();
#pragma unroll
    for (int r = 0; r < 16; ++r) {
        const int c = (r & 3) + 8 * (r >> 2);
        if (dq - c < 0) p0[r] = NEG;
        if (dq - c - 32 < 0) p1[r] = NEG;
    }
}
__device__ __forceinline__ void bias_tile(f32x16& p0, f32x16& p1, const LAS float* rt) {
#pragma unroll
    for (int r = 0; r < 16; ++r) { const int c = (r & 3) + 8 * (r >> 2); p0[r] += rt[c]; p1[r] += rt[c + 32]; }
}
__device__ __forceinline__ void kill_tile(f32x16& p0, f32x16& p1) {
    const float NEG = -__builtin_inff();
#pragma unroll
    for (int r = 0; r < 16; ++r) { p0[r] = NEG; p1[r] = NEG; }
}
__device__ __forceinline__ void partialSM(f32x16& p0, f32x16& p1, float& m_reg, float& mn, float& alpha) {
    float pmax = p0[0];
#pragma unroll
    for (int r = 1; r < 16; ++r) pmax = fmaxf(pmax, p0[r]);
#pragma unroll
    for (int r = 0; r < 16; ++r) pmax = fmaxf(pmax, p1[r]);
    { auto rr = __builtin_amdgcn_permlane32_swap(__float_as_uint(pmax), __float_as_uint(pmax), false, false);
      pmax = fmaxf(__uint_as_float(rr[0]), __uint_as_float(rr[1])); }
    constexpr float C2 = 1.4426950408889634f * SCALE;
    if (__builtin_expect(__all((pmax - m_reg) * SCALE <= THR), 1)) { mn = m_reg; alpha = 1.f; }
    else { mn = fmaxf(m_reg, pmax); alpha = __builtin_amdgcn_exp2f((m_reg - mn) * C2); m_reg = mn; }
    const float mnL = -mn * C2;
#pragma unroll
    for (int r = 0; r < 16; ++r) p0[r] = fmaf(p0[r], C2, mnL);
#pragma unroll
    for (int r = 0; r < 16; ++r) p1[r] = fmaf(p1[r], C2, mnL);
#pragma unroll
    for (int r = 0; r < 16; ++r) p0[r] = __builtin_amdgcn_exp2f(p0[r]);
}
__device__ __forceinline__ void finishSM(f32x16& p0, f32x16& p1, float alpha, float& l_reg, bf16x8& pa0, bf16x8& pa1, bf16x8& pa2, bf16x8& pa3) {
#pragma unroll
    for (int r = 0; r < 16; ++r) p1[r] = __builtin_amdgcn_exp2f(p1[r]);
    float ps = 0;
#pragma unroll
    for (int r = 0; r < 16; ++r) ps += p0[r];
#pragma unroll
    for (int r = 0; r < 16; ++r) ps += p1[r];
    { auto rr = __builtin_amdgcn_permlane32_swap(__float_as_uint(ps), __float_as_uint(ps), false, false);
      ps = __uint_as_float(rr[0]) + __uint_as_float(rr[1]); }
    l_reg = l_reg * alpha + ps;
#define PK4(P, B_, OUT) do { unsigned a0 = cvtpk(P[B_+0], P[B_+1]), a1 = cvtpk(P[B_+2], P[B_+3]);                          \
        unsigned b0 = cvtpk(P[B_+4], P[B_+5]), b1 = cvtpk(P[B_+6], P[B_+7]);                                             \
        auto r0 = __builtin_amdgcn_permlane32_swap(a0, b0, false, false); auto r1 = __builtin_amdgcn_permlane32_swap(a1, b1, false, false); \
        u32x4 w = {r0[0], r1[0], r0[1], r1[1]}; OUT = __builtin_bit_cast(bf16x8, w); } while (0)
    PK4(p0, 0, pa0); PK4(p0, 8, pa1); PK4(p1, 0, pa2); PK4(p1, 8, pa3);
#undef PK4
}
template <int KB>
__device__ __forceinline__ void qkt(f32x16& p0, f32x16& p1, const char* K_lds, int r32, int hi, const bf16x8* qr) {
#pragma unroll
    for (int r = 0; r < 16; ++r) { p0[r] = 0.f; p1[r] = 0.f; }
    const char* kb[4];
#pragma unroll
    for (int dd = 0; dd < 4; ++dd) kb[dd] = K_lds + KB * SHM_K + KSWZ(r32, (dd * 16 + hi * 8) * 2);
#pragma unroll
    for (int d0 = 0; d0 < 8; ++d0) { const char* a = kb[d0 & 3] + (d0 >> 2) * 128;
        bf16x8 b0 = *reinterpret_cast<const bf16x8*>(a);
        bf16x8 b1 = *reinterpret_cast<const bf16x8*>(a + 32 * 256);
        p0 = __builtin_amdgcn_mfma_f32_32x32x16_bf16(b0, qr[d0], p0, 0, 0, 0);
        p1 = __builtin_amdgcn_mfma_f32_32x32x16_bf16(b1, qr[d0], p1, 0, 0, 0); }
}
template <int VB>
__device__ __forceinline__ void pv_tile(f32x16* o, int vb0, bf16x8 pa0, bf16x8 pa1, bf16x8 pa2, bf16x8 pa3) {
#define TRRD(dst, off) asm volatile("ds_read_b64_tr_b16 %0, %1 offset:%2" : "=&v"(dst) : "v"(vb0), "i"(off) : "memory")
#define PV_D0(d0) do { s16x4 l0, l1, l2, l3, h0, h1, h2, h3; constexpr int b_ = VB * SHM_V + v_rd_off(d0, 0, 0);   \
        TRRD(l0, b_); TRRD(h0, b_ + 2048); TRRD(l1, b_ + 4096); TRRD(h1, b_ + 6144); TRRD(l2, b_ + 8192); TRRD(h2, b_ + 10240); TRRD(l3, b_ + 12288); TRRD(h3, b_ + 14336); \
        asm volatile("s_waitcnt lgkmcnt(0)" ::: "memory"); SBAR();   \
        o[d0] = __builtin_amdgcn_mfma_f32_32x32x16_bf16(pa0, (bf16x8){l0[0], l0[1], l0[2], l0[3], h0[0], h0[1], h0[2], h0[3]}, o[d0], 0, 0, 0);   \
        o[d0] = __builtin_amdgcn_mfma_f32_32x32x16_bf16(pa1, (bf16x8){l1[0], l1[1], l1[2], l1[3], h1[0], h1[1], h1[2], h1[3]}, o[d0], 0, 0, 0);   \
        o[d0] = __builtin_amdgcn_mfma_f32_32x32x16_bf16(pa2, (bf16x8){l2[0], l2[1], l2[2], l2[3], h2[0], h2[1], h2[2], h2[3]}, o[d0], 0, 0, 0);   \
        o[d0] = __builtin_amdgcn_mfma_f32_32x32x16_bf16(pa3, (bf16x8){l3[0], l3[1], l3[2], l3[3], h3[0], h3[1], h3[2], h3[3]}, o[d0], 0, 0, 0); } while (0)
    PV_D0(0); PV_D0(1); PV_D0(2); PV_D0(3);
#undef PV_D0
#undef TRRD
}

struct BlockRef { const bf16_t* Q; const bf16_t* K; const bf16_t* V; bf16_t* O; int qb; int b, h; };
struct Seam { bf16x8 qr[8]; bf16x8 st_v0, st_v1, st_k0, st_k1; };
#define VMW() asm volatile("s_waitcnt vmcnt(0)" ::: "memory")
#define VMWN(n) asm volatile("s_waitcnt vmcnt(%0)" :: "i"(n) : "memory")
#define LD8(p) (*reinterpret_cast<const bf16x8*>(p))
#define SLOAD_H(Kp, Vp, k0) do { const char* kb__ = (const char*)(Kp) + (size_t)(k0) * (LDP * 2); const char* vb__ = (const char*)(Vp) + (size_t)(k0) * (LDP * 2); \
        S.st_v0 = LD8(vb__ + kvoff); S.st_v1 = LD8(vb__ + 32 * LDP * 2 + kvoff); S.st_k0 = LD8(kb__ + kvoff); S.st_k1 = LD8(kb__ + 32 * LDP * 2 + kvoff); } while (0)
#define SWRITE_HK(bf) do { *(bf16x8*)(K_lds + (bf) * SHM_K + kws) = S.st_k0; *(bf16x8*)(K_lds + (bf) * SHM_K + kws + 32 * 256) = S.st_k1; } while (0)
#define SWRITE_HV(bf) do { *(bf16x8*)(V_lds + (bf) * SHM_V + vst0) = S.st_v0; *(bf16x8*)(V_lds + (bf) * SHM_V + vst1) = S.st_v1; } while (0)
#define SWRITE_H(bf) do { SWRITE_HV(bf); SWRITE_HK(bf); } while (0)

__device__ __forceinline__ void prime(const BlockRef& cur, char* lds, Seam& S) {
    int tid = threadIdx.x; asm volatile("" : "+v"(tid));     const int wid = __builtin_amdgcn_readfirstlane(tid >> 6), lane = tid & 63, r32 = lane & 31, hi = lane >> 5;
    const int sr = tid >> 4, sc = (tid & 15) * 8, kws = KSWZ(sr, sc * 2); char* K_lds = lds + 2 * SHM_V;
    const unsigned kvoff = (unsigned)(sr * LDP + sc) * 2u, qvoff = (unsigned)(r32 * LDP + hi * 8) * 2u;
    { const char* qb__ = (const char*)cur.Q + (size_t)(wid * QBLK) * (LDP * 2);
#pragma unroll
    for (int d0 = 0; d0 < 8; ++d0) S.qr[d0] = LD8(qb__ + qvoff + d0 * 32); }
    SLOAD_H(cur.K, cur.V, 0); VMW(); SWRITE_HK(0);
    __syncthreads();
}
__device__ __forceinline__ int rel_bucket(int n) {
    if (n < 16) return n;
    const float nf = (float)n;
    int large = 16 + (int)(logf(nf / 16.0f) / 5.545177444479562f * 16.0f);
    return large < 31 ? large : 31;
}
__device__ __forceinline__ BlockRef make_ref(const P& a, int item);
__device__ __forceinline__ int block(const P& a, const BlockRef& cur, unsigned* queue, const float* rel_bias, const float* kmp, char* lds, Seam& S) {
    int tid = threadIdx.x; asm volatile("" : "+v"(tid));     const int wid = __builtin_amdgcn_readfirstlane(tid >> 6), lane = tid & 63, r32 = lane & 31, hi = lane >> 5;
    const int qb = cur.qb, NT = 4 * (qb + 1);
    const int qlo = qb * QB + wid * QBLK, qrow = qlo + r32;
    char* V_lds = lds; char* K_lds = lds + 2 * SHM_V;
    float* ws = (float*)(lds + OFF_WS) + wid * 64; float* li_l = ws, * al_l = ws + 32;
    LAS float* rtab = (LAS float*)(LAS char*)(uintptr_t)(unsigned)(uintptr_t)(lds + OFF_RTAB);
    float* kmL = (float*)(lds + OFF_KM);
    volatile int* misc = (volatile int*)(lds + OFF_MISC);
    if (tid == 0) misc[0] = (int)__hip_atomic_fetch_add(queue, 1u, __ATOMIC_RELAXED, __HIP_MEMORY_SCOPE_AGENT);
    for (int i = tid; i < 2400; i += NW * 64) { const int dist = 2047 - i; rtab[i] = dist >= 0 ? rel_bias[rel_bucket(dist) * 8 + cur.h] * (1.0f / SCALE) : -__builtin_inff(); }
    for (int i = tid; i < qb * 128; i += NW * 64) { const int j = i >> 7, dd = i & 127; const size_t o = ((size_t)(cur.b * 8 + j)) * 1024 + cur.h * 128 + dd;
        kmL[i] = (kmp[o] + kmp[o + 64 * 1024]) * (1.0f / 256.0f); }
    __syncthreads();
    const int next_item = __builtin_amdgcn_readfirstlane(misc[0]);
    const BlockRef nxt = next_item < 512 ? make_ref(a, next_item) : cur;
    unsigned selmask = 0;
    {
        float sc7[7];
#pragma unroll
        for (int j = 0; j < 7; ++j) { sc7[j] = -__builtin_inff();
            if (j < qb) { float acc = 0.f;
#pragma unroll
                for (int d0 = 0; d0 < 8; ++d0) { const u32x4 q4 = __builtin_bit_cast(u32x4, S.qr[d0]); const f32x4 k0 = *(const f32x4*)(kmL + j * 128 + d0 * 16 + hi * 8), k1 = *(const f32x4*)(kmL + j * 128 + d0 * 16 + hi * 8 + 4);
                    acc += bflo(q4[0]) * k0[0] + bfhi(q4[0]) * k0[1] + bflo(q4[1]) * k0[2] + bfhi(q4[1]) * k0[3] + bflo(q4[2]) * k1[0] + bfhi(q4[2]) * k1[1] + bflo(q4[3]) * k1[2] + bfhi(q4[3]) * k1[3]; }
                acc += __shfl_xor(acc, 32); sc7[j] = acc; } }
#pragma unroll
        for (int j = 0; j < 7; ++j) { int rank = 0;
#pragma unroll
            for (int i = 0; i < 7; ++i) { if (i != j) rank += (sc7[i] > sc7[j] || (sc7[i] == sc7[j] && i < j)) ? 1 : 0; }
            if (j < qb && (qb <= 3 || rank < 3)) selmask |= 1u << j; }
    }
    LAS unsigned* selp = (LAS unsigned*)(LAS char*)(uintptr_t)(unsigned)(uintptr_t)(lds + OFF_SEL) + tid;
    *selp = selmask;
    float m_reg = -1e30f, l_reg = 0; f32x16 o[4];
#pragma unroll
    for (int d = 0; d < 4; ++d)
#pragma unroll
        for (int r = 0; r < 16; ++r) o[d][r] = 0.f;
    const int sr = tid >> 4, sc = (tid & 15) * 8, vst0 = v_st(sr, sc), vst1 = v_st(32 + sr, sc), kws = KSWZ(sr, sc * 2);
    const unsigned kvoff = (unsigned)(sr * LDP + sc) * 2u;
    const int vb0 = (int)(uintptr_t)V_lds + v_rd_base(lane);
    const bf16_t* Kh = cur.K; const bf16_t* Vh = cur.V;
#define RESC(a) do { if (__any((a) < 1.f)) { if (hi == 0) al_l[r32] = (a); asm volatile("s_waitcnt lgkmcnt(0)" ::: "memory");              \
                     for (int d_ = 0; d_ < 4; ++d_) for (int r = 0; r < 16; ++r) o[d_][r] *= al_l[crow(r, hi)]; } } while (0)
#define KBASE(t) ((t) * KVBLK)
#define MASKT(P0_, P1_, t) do { const int kb_ = KBASE(t); const int jb_ = (t) >> 2; \
        const bool on_ = (jb_ == qb) || ((*selp >> jb_) & 1u); \
        bias_tile(P0_, P1_, on_ ? rtab + (kb_ + 4 * hi - qrow + 2047) : rtab + 2304); } while (0)
    constexpr int NQL = 8;
#define SEAM_K0() do { VMWN(NQL); SWRITE_HK(0); SBAR(); } while (0)
    f32x16 pA0, pA1, pB0, pB1; float mnA, mnB, alA, alB; bf16x8 pa0, pa1, pa2, pa3;
    SWRITE_HV(0); SBAR();
    if (NT > 1) { SLOAD_H(Kh, Vh, KBASE(1)); }
    SBAR(); qkt<0>(pA0, pA1, K_lds, r32, hi, S.qr);
    MASKT(pA0, pA1, 0); partialSM(pA0, pA1, m_reg, mnA, alA);
    if (NT > 1) { VMW(); SWRITE_H(1); }
    __syncthreads();
#define HALF_STEP(PX0, PX1, mnX, alX, PY0, PY1, alY, t, KB, VB, SB) do {                                                      \
        SBAR(); if ((t) + 1 < NT) { SLOAD_H(Kh, Vh, KBASE((t) + 1)); SBAR(); }      \
        qkt<KB>(PX0, PX1, K_lds, r32, hi, S.qr);                                             \
        finishSM(PY0, PY1, alY, l_reg, pa0, pa1, pa2, pa3); SBAR();                                                           \
        pv_tile<VB>(o, vb0, pa0, pa1, pa2, pa3); MASKT(PX0, PX1, (t)); partialSM(PX0, PX1, m_reg, mnX, alX);                                        \
        __syncthreads();                                                                                                      \
        if ((t) + 1 < NT) { VMW(); SWRITE_H(SB); }                                                                          \
        RESC(alX); __syncthreads(); } while (0)
    for (int t = 1; t + 1 < NT; t += 2) {
        HALF_STEP(pB0, pB1, mnB, alB, pA0, pA1, alA, t, 1, 0, 0);
        HALF_STEP(pA0, pA1, mnA, alA, pB0, pB1, alB, t + 1, 0, 1, 1);
    }
    { SBAR(); qkt<1>(pB0, pB1, K_lds, r32, hi, S.qr); SBAR(); }
    SLOAD_H(nxt.K, nxt.V, 0); SBAR();
    { const char* qb__ = (const char*)nxt.Q + (size_t)(wid * QBLK) * (LDP * 2); int l_ = lane; asm volatile("" : "+v"(l_));
      const unsigned qvoff = (unsigned)((l_ & 31) * LDP + (l_ >> 5) * 8) * 2u;
#pragma unroll
    for (int d0 = 0; d0 < 8; ++d0) S.qr[d0] = LD8(qb__ + qvoff + d0 * 32); }
    SBAR();
    finishSM(pA0, pA1, alA, l_reg, pa0, pa1, pa2, pa3); SBAR();
    pv_tile<0>(o, vb0, pa0, pa1, pa2, pa3);
    { MASKT(pB0, pB1, NT - 1); partialSM(pB0, pB1, m_reg, mnB, alB); __syncthreads(); RESC(alB);
      finishSM(pB0, pB1, alB, l_reg, pa0, pa1, pa2, pa3); SBAR(); pv_tile<1>(o, vb0, pa0, pa1, pa2, pa3); }
    SBAR(); SEAM_K0();
    if (hi == 0) li_l[r32] = l_reg; asm volatile("s_waitcnt lgkmcnt(0)" ::: "memory");
    float rli[16];
#pragma unroll
    for (int r = 0; r < 16; ++r) rli[r] = __builtin_amdgcn_rcpf(li_l[crow(r, hi)]);
    char* Ow = (char*)cur.O + (size_t)(wid * QBLK) * (LDO * 2); const unsigned ovoff = (unsigned)(4 * hi * LDO + r32) * 2u;
#pragma unroll
    for (int r = 0; r < 16; ++r) { const int orow0 = (r & 3) + 8 * (r >> 2);
#pragma unroll
        for (int d0 = 0; d0 < 4; ++d0) { const float v = o[d0][r] * rli[r];
            const float vn = __shfl_xor(v, 1);
            if ((r32 & 1) == 0) *(unsigned*)(Ow + (size_t)(orow0 * LDO * 2 + d0 * 64) + ovoff) = cvtpk(v, vn); } }
    __syncthreads();
    return next_item;
#undef RESC
#undef KBASE
#undef MASKT
#undef SEAM_K0
#undef HALF_STEP
}
#undef ROWP
#undef VMW
#undef VMWN
#undef LD8
#undef SLOAD_H
#undef SWRITE_HK
#undef SWRITE_HV
#undef SWRITE_H

__device__ __forceinline__ BlockRef make_ref(const P& a, int item) {
    const int qb = 7 - (item >> 6), bh = item & 63, b = bh >> 3, h = bh & 7;
    const bf16_t* proj = (const bf16_t*)(a.ws + WS_PROJ);
    BlockRef r; r.b = b; r.h = h; r.qb = qb;
    r.Q = proj + PROJ_BLK(C_QB + h * HD) + (size_t)(b * SEQ + qb * QB) * LDP;
    r.K = proj + PROJ_BLK(C_KB + h * HD) + (size_t)(b * SEQ) * LDP;
    r.V = proj + PROJ_BLK(C_VB + h * HD) + (size_t)(b * SEQ) * LDP;
    r.O = (bf16_t*)(a.ws + WS_OAB) + (size_t)(b * SEQ + qb * QB) * LDO + 1024 + h * HD;
    return r;
}
}
__device__ __forceinline__ void router_unit(const P& a, LAS unsigned char* lds, int unit) {
    int tid = threadIdx.x; asm volatile("" : "+v"(tid)); const int wave = __builtin_amdgcn_readfirstlane(tid >> 6), lane = tid & 63, c32 = lane & 31, hi = lane >> 5;
    const int tg = wave & 1, kq = wave >> 1;
    const bf16_t* x1 = (const bf16_t*)(a.ws + WS_X1); const float* g = a.in[11]; const float* br = a.in[13];
    unsigned char* A2 = a.ws + WS_A2; const u32x4* frag = (const u32x4*)(a.ws + WS_WRF);
    LAS float* Lw = (LAS float*)(lds + wave * 4352);
    LAS float* ssp = (LAS float*)(lds + 8 * 4352);
    LAS unsigned* hist = (LAS unsigned*)(lds + 8 * 4352 + 2048);
    LAS unsigned* base = hist + 32;
    if (tid < 32) hist[tid] = 0u;
    const int tok = unit * 64 + tg * 32 + c32;
    f32x16 L;
#pragma unroll
    for (int r = 0; r < 16; ++r) L[r] = 0.f;
    float ss = 0.f;
    const bf16_t* xr = x1 + (size_t)tok * D + 8 * hi + 256 * kq; unsigned char* ar = A2 + (size_t)tok * D + 8 * hi + 256 * kq; const float* gr = g + 8 * hi + 256 * kq;
#pragma unroll 4
    for (int s = 0; s < 16; ++s) {
        const u32x4 xw = *(const u32x4*)(xr + 16 * s); const f32x4 xa = {bflo(xw.x), bfhi(xw.x), bflo(xw.y), bfhi(xw.y)}, xb = {bflo(xw.z), bfhi(xw.z), bflo(xw.w), bfhi(xw.w)}, ga = *(const f32x4*)(gr + 16 * s), gb = *(const f32x4*)(gr + 16 * s + 4);
        ss += (xa.x * xa.x + xa.y * xa.y) + (xa.z * xa.z + xa.w * xa.w) + (xb.x * xb.x + xb.y * xb.y) + (xb.z * xb.z + xb.w * xb.w);
        const f32x4 va = xa * ga, vb = xb * gb;
        u32x4 wh; wh.x = cvt_pk_bf16(va.x, va.y); wh.y = cvt_pk_bf16(va.z, va.w); wh.z = cvt_pk_bf16(vb.x, vb.y); wh.w = cvt_pk_bf16(vb.z, vb.w);
        { u32x2 w8; w8.x = pk4_fp8(va.x, va.y, va.z, va.w); w8.y = pk4_fp8(vb.x, vb.y, vb.z, vb.w); *(u32x2*)(ar + 16 * s) = w8; }
        u32x4 wl; wl.x = cvt_pk_bf16(va.x - bflo(wh.x), va.y - bfhi(wh.x)); wl.y = cvt_pk_bf16(va.z - bflo(wh.y), va.w - bfhi(wh.y));
        wl.z = cvt_pk_bf16(vb.x - bflo(wh.z), vb.y - bfhi(wh.z)); wl.w = cvt_pk_bf16(vb.z - bflo(wh.w), vb.w - bfhi(wh.w));
        const bf16x8 ah = __builtin_bit_cast(bf16x8, wh), al = __builtin_bit_cast(bf16x8, wl);
        const bf16x8 bh = __builtin_bit_cast(bf16x8, frag[(16 * kq + s) * 64 + lane]), bl = __builtin_bit_cast(bf16x8, frag[4096 + (16 * kq + s) * 64 + lane]);
        L = __builtin_amdgcn_mfma_f32_32x32x16_bf16(ah, bh, L, 0, 0, 0);
        L = __builtin_amdgcn_mfma_f32_32x32x16_bf16(ah, bl, L, 0, 0, 0);
        L = __builtin_amdgcn_mfma_f32_32x32x16_bf16(al, bh, L, 0, 0, 0);
    }
#pragma unroll
    for (int r = 0; r < 16; ++r) Lw[((r & 3) + 8 * (r >> 2) + 4 * hi) * 33 + c32] = L[r];
    ssp[wave * 64 + lane] = ss;
    __syncthreads();
    int e4[4] = {0, 0, 0, 0}; float w4[4] = {0.f, 0.f, 0.f, 0.f}; unsigned loc[4] = {0u, 0u, 0u, 0u}; float rstd = 0.f;
    const bool sel = (wave < 2) && (hi == 0);
    if (sel) {
        float sst = 0.f;
#pragma unroll
        for (int q = 0; q < 4; ++q) sst += ssp[(wave + 2 * q) * 64 + c32] + ssp[(wave + 2 * q) * 64 + 32 + c32];
        rstd = 1.0f / sqrtf(sst * (1.0f / D) + EPS);
        float lg[32];
#pragma unroll
        for (int e = 0; e < 32; ++e) { const LAS float* lp = (const LAS float*)(lds + wave * 4352) + c32 * 33 + e; lg[e] = (lp[0] + lp[2 * 1088] + lp[4 * 1088] + lp[6 * 1088]) * rstd + br[e]; }
        unsigned used = 0u; float v4[4];
#pragma unroll
        for (int p = 0; p < 4; ++p) { float best = -__builtin_inff(); int bi = 0;
#pragma unroll
            for (int e = 0; e < 32; ++e) { const bool take = !((used >> e) & 1u) && lg[e] > best; best = take ? lg[e] : best; bi = take ? e : bi; }
            used |= 1u << bi; e4[p] = bi; v4[p] = best; }
        float sum = 0.f;
#pragma unroll
        for (int p = 0; p < 4; ++p) { w4[p] = expf(v4[p] - v4[0]); sum += w4[p]; }
        const float inv = 1.0f / sum;
#pragma unroll
        for (int p = 0; p < 4; ++p) { w4[p] *= inv; loc[p] = __hip_atomic_fetch_add(hist + e4[p], 1u, __ATOMIC_RELAXED, __HIP_MEMORY_SCOPE_WORKGROUP); }
    }
    __syncthreads();
    if (tid < 32) base[tid] = __hip_atomic_fetch_add((unsigned*)(a.ws + WS_CTL) + CW_COUNTS + tid, hist[tid], RLX_AGENT);
    __syncthreads();
    if (sel) {
        int* tope = (int*)(a.ws + WS_TOPE) + (size_t)tok * 4; float* wts = (float*)(a.ws + WS_WTS) + (size_t)tok * 4; int* slot = (int*)(a.ws + WS_SLOT) + (size_t)tok * 4;
#pragma unroll
        for (int p = 0; p < 4; ++p) { const int sl_ = (int)(base[e4[p]] + loc[p]); tope[p] = e4[p]; wts[p] = w4[p]; slot[p] = sl_;
            ((int*)(a.ws + WS_ROWE))[(size_t)e4[p] * T + sl_] = tok; ((float*)(a.ws + WS_RSTE))[(size_t)e4[p] * T + sl_] = rstd; }
    }
    __syncthreads();
}

__device__ __forceinline__ void moe_tables(const P& a, LAS unsigned char* lds) {
    int tid = threadIdx.x; asm volatile("" : "+v"(tid)); const int wave = tid >> 6, lane = tid & 63, e = lane & 31;
    LAS int* pstart = (LAS int*)(lds + LDS_MOE); LAS int* cnt = pstart + 64; LAS int* tile_e = pstart + 128;
    const unsigned* counts = (const unsigned*)(a.ws + WS_CTL) + CW_COUNTS;
    const int c = (int)counts[e]; const int p = ((c + 255) >> 8) << 8; int inc = p;
#pragma unroll
    for (int o = 1; o < 32; o <<= 1) { const int t = __builtin_amdgcn_ds_bpermute(((lane - o) & 63) << 2, inc); if (e >= o) inc += t; }
    if (tid < 32) { cnt[e] = c; pstart[e] = inc - p; if (e == 31) { pstart[32] = inc; tile_e[MAXTILES] = inc >> 8; } }
    for (int t = wave * 36; t < wave * 36 + 36; ++t) { const unsigned long long m = __ballot(inc <= t * 256); const int ee = __builtin_popcount((unsigned)m); if (lane == 0) tile_e[t] = ee < NE ? ee : NE - 1; }
    __syncthreads();
}

__device__ __forceinline__ void combine_rows(const P& a, LAS unsigned char* lds, int vcu, int G, int wave, int lane) {
    const LAS int* pstart = (const LAS int*)(lds + LDS_MOE);
    const int gw = vcu * NWAVES + wave, NGW = G * NWAVES;
    const bf16_t* X1 = (const bf16_t*)(a.ws + WS_X1); float* X = (float*)(a.ws + WS_X2); const unsigned char* Y = a.ws + WS_YROWS; bf16_t* A3 = (bf16_t*)(a.ws + WS_H);
    const int* tope = (const int*)(a.ws + WS_TOPE); const int* slot = (const int*)(a.ws + WS_SLOT); const float* wts = (const float*)(a.ws + WS_WTS); const float* g = a.in[20];
    f32x4 gv[4];
#pragma unroll
    for (int j = 0; j < 4; ++j) gv[j] = *((const f32x4*)g + lane + 64 * j);
    for (int m0 = gw; m0 < T; m0 += 8 * NGW) {
        int dl = 0; float wl = 0.f;
        { const int i = (lane >> 2) & 7, k = lane & 3; const int m = m0 + i * NGW; if (lane < 32 && m < T) { dl = pstart[tope[m * 4 + k]] + slot[m * 4 + k]; wl = wts[m * 4 + k]; } }
        u32x2 xa[4], xb[4]; unsigned ya[4][4], yb[4][4];
#define CR_LOAD(i_, XQ, YQ) do { const int m_ = m0 + (i_) * NGW; if (m_ < T) { const u32x2* x1r = (const u32x2*)(X1 + (size_t)m_ * D) + lane; \
            _Pragma("unroll") for (int j = 0; j < 4; ++j) XQ[j] = __builtin_nontemporal_load(x1r + 64 * j); \
            _Pragma("unroll") for (int k = 0; k < 4; ++k) { const int d = __builtin_amdgcn_readlane(dl, 4 * (i_) + k); const unsigned* yr = (const unsigned*)(Y + (size_t)d * D) + lane; \
                _Pragma("unroll") for (int j = 0; j < 4; ++j) YQ[k][j] = __builtin_nontemporal_load(yr + 64 * j); } } } while (0)
#define CR_DO(i_, XQ, YQ) do { const int m_ = m0 + (i_) * NGW; if (m_ < T) { f32x4 v[4]; \
            _Pragma("unroll") for (int j = 0; j < 4; ++j) v[j] = (f32x4){bflo(XQ[j].x), bfhi(XQ[j].x), bflo(XQ[j].y), bfhi(XQ[j].y)}; \
            _Pragma("unroll") for (int k = 0; k < 4; ++k) { const float w = __int_as_float(__builtin_amdgcn_readlane(__float_as_int(wl), 4 * (i_) + k)); \
                _Pragma("unroll") for (int j = 0; j < 4; ++j) { const int y = (int)YQ[k][j]; \
                    v[j].x += w * __builtin_amdgcn_cvt_f32_fp8(y, 0); v[j].y += w * __builtin_amdgcn_cvt_f32_fp8(y, 1); v[j].z += w * __builtin_amdgcn_cvt_f32_fp8(y, 2); v[j].w += w * __builtin_amdgcn_cvt_f32_fp8(y, 3); } } \
            float s = 0.f; \
            _Pragma("unroll") for (int j = 0; j < 4; ++j) s += (v[j].x * v[j].x + v[j].y * v[j].y) + (v[j].z * v[j].z + v[j].w * v[j].w); \
            const float rstd = 1.0f / sqrtf(wave_sum(s) * (1.0f / D) + EPS); \
            u32x2* xr = (u32x2*)((bf16_t*)X + (size_t)m_ * D) + lane; unsigned* o4 = (unsigned*)((unsigned char*)A3 + (size_t)m_ * D) + lane;        \
            _Pragma("unroll") for (int j = 0; j < 4; ++j) { u32x2 xw_; xw_.x = cvt_pk_bf16(v[j].x, v[j].y); xw_.y = cvt_pk_bf16(v[j].z, v[j].w); xr[64 * j] = xw_; o4[64 * j] = pk4_fp8(v[j].x * rstd * gv[j].x, v[j].y * rstd * gv[j].y, v[j].z * rstd * gv[j].z, v[j].w * rstd * gv[j].w); } } } while (0)
        CR_LOAD(0, xa, ya);
#pragma unroll
        for (int i = 0; i < 8; i += 2) { CR_LOAD(i + 1, xb, yb); CR_DO(i, xa, ya); if (i + 2 < 8) CR_LOAD(i + 2, xa, ya); CR_DO(i + 1, xb, yb); }
#undef CR_LOAD
#undef CR_DO
    }
}
__device__ __forceinline__ void final_rows(const P& a, int vcu, int G, int wave, int lane) {
    const int gw = vcu * NWAVES + wave, NGW = G * NWAVES;
    const float* X = (const float*)(a.ws + WS_X2); float* OUT = a.out; const bf16_t* PG = (const bf16_t*)(a.ws + WS_PGATE); const bf16_t* PP = (const bf16_t*)(a.ws + WS_PPROJ);
    f32x4 gp[4], gf[4];
#pragma unroll
    for (int j = 0; j < 4; ++j) { gp[j] = *((const f32x4*)a.in[23] + lane + 64 * j); gf[j] = *((const f32x4*)a.in[24] + lane + 64 * j); }
    u32x2 va[4], vb[4]; u32x2 qa[4], qb[4], ga[4], gb[4];
#define FR_LOAD(m_, V, Q, GQ) do { if ((m_) < T) { const u32x2* xr = (const u32x2*)((const bf16_t*)X + (size_t)(m_) * D) + lane; const u32x2* pgr = (const u32x2*)(PG + (size_t)(m_) * D) + lane; const u32x2* ppr = (const u32x2*)(PP + (size_t)(m_) * D) + lane; \
        _Pragma("unroll") for (int j = 0; j < 4; ++j) { V[j] = __builtin_nontemporal_load(xr + 64 * j); Q[j] = __builtin_nontemporal_load(ppr + 64 * j); GQ[j] = __builtin_nontemporal_load(pgr + 64 * j); } } } while (0)
#define FR_DO(m_, V, Q, GQ) do { if ((m_) < T) { f32x4 v[4], pp[4], pg[4]; float sp = 0.f; \
        _Pragma("unroll") for (int j = 0; j < 4; ++j) { v[j] = (f32x4){bflo(V[j].x), bfhi(V[j].x), bflo(V[j].y), bfhi(V[j].y)}; pp[j] = (f32x4){bflo(Q[j].x), bfhi(Q[j].x), bflo(Q[j].y), bfhi(Q[j].y)}; pg[j] = (f32x4){bflo(GQ[j].x), bfhi(GQ[j].x), bflo(GQ[j].y), bfhi(GQ[j].y)}; \
            sp += (pp[j].x * pp[j].x + pp[j].y * pp[j].y) + (pp[j].z * pp[j].z + pp[j].w * pp[j].w); } \
        const float rp = 1.0f / sqrtf(wave_sum(sp) * (1.0f / D) + EPS); float s_ = 0.f; \
        _Pragma("unroll") for (int j = 0; j < 4; ++j) { v[j] = v[j] + pg[j] * (pp[j] * rp * gp[j]); s_ += (v[j].x * v[j].x + v[j].y * v[j].y) + (v[j].z * v[j].z + v[j].w * v[j].w); } \
        const float rstd = 1.0f / sqrtf(wave_sum(s_) * (1.0f / D) + EPS); f32x4* orow = (f32x4*)(OUT + (size_t)(m_) * D) + lane; \
        _Pragma("unroll") for (int j = 0; j < 4; ++j) __builtin_nontemporal_store(v[j] * rstd * gf[j], orow + 64 * j); } } while (0)
    FR_LOAD(gw, va, qa, ga);
    for (int m = gw; m < T; m += 2 * NGW) { FR_LOAD(m + NGW, vb, qb, gb); FR_DO(m, va, qa, ga); FR_LOAD(m + 2 * NGW, va, qa, ga); FR_DO(m + NGW, vb, qb, gb); }
#undef FR_LOAD
#undef FR_DO
}
#ifndef MK_CVP
#define MK_CVP 8
#define MK_CVQ 3
#endif
struct Args { P p; };
template <int PH_LO, int PH_HI>
__global__ void __launch_bounds__(NTHREADS, 2) hybrid_fwd(Args args) {
    extern __shared__ __attribute__((aligned(16))) unsigned char lds_raw[];
    LAS unsigned char* lds = (LAS unsigned char*)lds_raw;
    const P& a = args.p;
    const int tid = threadIdx.x;
#define FRESH_WL() int t_ = threadIdx.x; asm volatile("" : "+v"(t_)); const int w_ = __builtin_amdgcn_readfirstlane(t_ >> 6), l_ = t_ & 63
    const int G = gridDim.x; const int bx = blockIdx.x; const int vcu = (G % 8 == 0) ? (bx % 8) * (G / 8) + bx / 8 : bx;
    unsigned* ctl = (unsigned*)(a.ws + WS_CTL);
    for (int u = tid; u < (LDS_BYTES - LDSCTL_OFF) / 4; u += NTHREADS) ((LAS unsigned*)(lds + LDSCTL_OFF))[u] = 0u;
    __syncthreads();
#if MK_PER_PHASE
#define GRID_BAR() do { } while (0)
#else
    XcdBarrier bar = xcd_barrier_post(ctl + CW_BAR, (volatile LAS unsigned*)(lds + MISC_OFF + 32));
#define GRID_BAR() xcd_barrier(bar)
#endif
    constexpr int lo = PH_LO, hi = PH_HI;
#define IN(k) (lo <= (k) && (k) < hi)
#define SEAM(k) do { if constexpr (IN(k) && IN((k) + 1)) GRID_BAR(); } while (0)
    unsigned char* ws = a.ws;

    if constexpr (IN(0)) { FRESH_WL(); p0_prologue(a, lds, vcu, G, w_, l_); }
    SEAM(0);
    if constexpr (IN(1)) {
        { pg8::DenseSched S; S.o.init(T / 256, 12, G, bx); S.Bt = (const char*)(ws + WS_WIN); S.K = D;
          pg8::EpiProj<false> E{(bf16_t*)(ws + WS_PROJ), (float*)(ws + WS_KMP)};
          pg8::gemm_phase(lds, (const char*)(ws + WS_H), D, D, D, S, E); }
        { pg8::DenseSched S; S.o.init(T / 256, 20, G, bx); S.Bt = (const char*)(ws + WS_WIN8); S.K = D; S.es = 1; S.pn0 = 12; S.bt_out = false;
          pg8::EpiProj<true> E{(bf16_t*)(ws + WS_PROJ), (float*)(ws + WS_KMP)};
          pg8::gemm_phase(lds, (const char*)(ws + WS_H8), D, D, D, S, E); }
    }
    SEAM(1);
    if constexpr (IN(2)) { for (int u = vcu; u < NB * 32; u += G) gla_prep_unit(a, lds, u); }
    SEAM(2);
    if constexpr (IN(3)) { for (int u = vcu; u < 512; u += G) gla_combine_unit(a, u); }
    SEAM(3);
    if constexpr (IN(4)) {
        for (int u = vcu; u < 1024; u += G) gla_out_unit(a, lds, u);
        __syncthreads();
    }
    if constexpr (IN(5)) {
        if ((vcu % MK_CVP) < MK_CVQ) { FRESH_WL(); const int ci_ = (vcu / MK_CVP) * MK_CVQ + vcu % MK_CVP, ncv_ = (G / MK_CVP) * MK_CVQ + ((G % MK_CVP) < MK_CVQ ? (G % MK_CVP) : MK_CVQ);
            late_prep(a, lds, ci_, ncv_, w_, l_); expert_convert(a, lds, ci_, ncv_, w_, l_); __syncthreads(); }
        unsigned* queue = ctl + CW_QUEUE;
        volatile LAS int* qslot = (volatile LAS int*)(lds + LDSCTL_OFF + 1024);
        if (tid == 0) qslot[0] = (int)__hip_atomic_fetch_add(queue, 1u, RLX_AGENT);
        __syncthreads();
        int item = __builtin_amdgcn_readfirstlane(qslot[0]);
        if (item < 512) {
            moba::Seam S;
            moba::BlockRef cur = moba::make_ref(a, item);
            moba::prime(cur, (char*)lds_raw, S);
            for (;;) {
                const int nitem = moba::block(a, cur, queue, a.in[2], (const float*)(ws + WS_KMP), (char*)lds_raw, S);
                if (nitem >= 512) break;
                cur = moba::make_ref(a, nitem);
            }
        }
    }
    SEAM(5);
    if constexpr (IN(6)) {
        pg8::ChainSched S; S.o.init(T / 256, D / 256, G, bx); S.Bt = (const char*)(ws + WS_WUP); S.K = 1024;
        pg8::EpiMerge E{(const bf16_t*)(ws + WS_PROJ), (bf16_t*)(ws + WS_Y)};
        pg8::gemm_phase(lds, (const char*)(ws + WS_OAB), 1024, 2048, 2048, S, E);
    }
    SEAM(6);
    if constexpr (IN(7)) {
        pg8::DenseSched S; S.o.init(T / 256, D / 256, G, bx); S.Bt = (const char*)(ws + WS_WO); S.K = D;
        pg8::EpiResF32 E{a.in[0], (bf16_t*)(ws + WS_X1)};
        pg8::gemm_phase(lds, (const char*)(ws + WS_Y), D, D, D, S, E);
    }
    SEAM(7);
    if constexpr (IN(8)) { for (int u = vcu; u < T / 64; u += G) router_unit(a, lds, u); }
    SEAM(8);
    if constexpr (IN(9)) {
        moe_tables(a, lds); const LAS int* tab = (const LAS int*)(lds + LDS_MOE); const int ntile = __builtin_amdgcn_readfirstlane(tab[128 + MAXTILES]);
        pg8::MoeSched<true> S; S.o.init(ntile, 8, G, bx); S.Bt = (const char*)a.out; S.K = D; S.rows_per_e = 2048; S.tab = tab; S.row_e = (const int*)(ws + WS_ROWE); S.es = 1;
        pg8::EpiGlu E{(unsigned char*)(ws + WS_HMID), (const float*)(ws + WS_RSTE), tab, a.in[15], a.in[17], (const float*)(ws + WS_CTL) + 131072, lds};
        pg8::gemm_phase(lds, (const char*)(ws + WS_A2), D, D, D, S, E);
        const int extra = (ntile * 8) % G, nidle = G - extra;
        if (bx >= extra) { __syncthreads();
            pg8::DenseSched S2; S2.o.init(T / 256, D / 256, nidle, bx - extra); S2.Bt = (const char*)(ws + WS_WPP); S2.K = 256;
            pg8::EpiBf16<0, false> E2{(bf16_t*)(ws + WS_PPROJ), D, nullptr, 0, 1.0f};
            pg8::gemm_phase(lds, (const char*)(ws + WS_PB), 256, 256, 256, S2, E2); }
    }
    SEAM(9);
    if constexpr (IN(10)) {
        moe_tables(a, lds); const LAS int* tab = (const LAS int*)(lds + LDS_MOE); const int ntile = __builtin_amdgcn_readfirstlane(tab[128 + MAXTILES]);
        pg8::MoeSched<false> S; S.o.init(ntile, 4, G, bx); S.Bt = (const char*)(ws + WS_W2T); S.K = FF; S.rows_per_e = 1024; S.tab = tab; S.row_e = nullptr; S.es = 1;
        pg8::EpiDownF8 E{(unsigned char*)(ws + WS_YROWS), a.in[19]};
        pg8::gemm_phase(lds, (const char*)(ws + WS_HMID), FF, FF, FF, S, E);
    }
    SEAM(10);
    if constexpr (IN(11)) { moe_tables(a, lds); FRESH_WL(); combine_rows(a, lds, vcu, G, w_, l_); }
    SEAM(11);
    if constexpr (IN(12)) {
        { pg8::DenseSched S; S.o.init(T / 256, D / 256, G, bx); S.Bt = (const char*)(ws + WS_WPG); S.K = D; S.es = 1;
          pg8::EpiBf16<1, false, true> E{(bf16_t*)(ws + WS_PGATE), D, nullptr, 0, 1.0f / 32.0f};
          pg8::gemm_phase(lds, (const char*)(ws + WS_H), D, D, D, S, E); }
    }
    SEAM(12);
    if constexpr (IN(13)) { FRESH_WL(); final_rows(a, vcu, G, w_, l_); }
#undef FRESH_WL
#undef IN
#undef SEAM
#undef GRID_BAR
}

template <int LO, int HI> static void launch_range(const Args& a, int grid, hipStream_t stream) {
    static bool attr = false;
    if (!attr) { attr = true; if (hipFuncSetAttribute((const void*)hybrid_fwd<LO, HI>, hipFuncAttributeMaxDynamicSharedMemorySize, LDS_BYTES) != hipSuccess) fprintf(stderr, "kernel_launch: hipFuncSetAttribute failed\n"); }
    hipLaunchKernelGGL((hybrid_fwd<LO, HI>), dim3(grid), dim3(NTHREADS), LDS_BYTES, stream, a);
}
extern "C" void kernel_launch(void* const* d_in, const int* in_sizes, int n_in, void* d_out, int out_size, void* d_ws, size_t ws_size, hipStream_t stream) {
    static int grid = 0;
    if (grid == 0) {
        static const int expect[25] = {T * D, T * 256, 256, 1024, 1024 * D_IN, 16 * 512, 512, 256, 1048576, 1048576, 1048576, 1024, 32768, 32, 33554432, 32768, 33554432, 32768, 33554432, 32768, 1024, 1048576, 262144, 1024, 1024};
        bool okk = (n_in == 25);
        for (int i = 0; okk && i < 25; ++i) if (in_sizes[i] != expect[i]) { fprintf(stderr, "kernel_launch: input %d has %d elements, expected %d\n", i, in_sizes[i], expect[i]); okk = false; }
        if (!okk || out_size != T * D || ws_size < WS_END) { fprintf(stderr, "kernel_launch: unexpected shapes (n_in %d, in0 %d, out %d, ws %zu); nothing launched\n", n_in, n_in > 0 ? in_sizes[0] : -1, out_size, ws_size); grid = -1; return; }
        int dev = 0, cus = 0;
        if (hipGetDevice(&dev) != hipSuccess || hipDeviceGetAttribute(&cus, hipDeviceAttributeMultiprocessorCount, dev) != hipSuccess) { grid = -1; return; }
        grid = cus;
    }
    if (grid < 0) return;
    (void)hipMemsetAsync((char*)d_ws + WS_CTL, 0, CTL_ZERO_BYTES, stream);
    Args a{};
    for (int i = 0; i < 25; ++i) a.p.in[i] = (const float*)d_in[i];
    a.p.out = (float*)d_out; a.p.ws = (unsigned char*)d_ws;
#if MK_PER_PHASE
#ifndef MK_LAST
#define MK_LAST 13
#endif
#ifndef MK_REPEAT
#define MK_REPEAT 0
#endif
#define LR(k) do { if ((k) <= MK_LAST) for (int r_ = 0; r_ < 1 + ((MK_REPEAT >> (k)) & 1); ++r_) launch_range<(k), (k) + 1>(a, grid, stream); } while (0)
    LR(0); LR(1); LR(2); LR(3); LR(4); LR(5); LR(6); LR(7); LR(8); LR(9); LR(10); LR(11); LR(12); LR(13);
#undef LR
#else
    launch_range<0, NPHASES>(a, grid, stream);
#endif
}
```

```cpp
#include <hip/hip_runtime.h>
#include <cstdio>
#include <cstdint>

#define LAS __attribute__((address_space(3)))
#define GAS __attribute__((address_space(1)))
typedef unsigned short bf16_t;
typedef short bf16x8 __attribute__((ext_vector_type(8)));
typedef short s16x4 __attribute__((ext_vector_type(4)));
typedef float f32x2 __attribute__((ext_vector_type(2)));
typedef float f32x4 __attribute__((ext_vector_type(4)));
typedef float f32x16 __attribute__((ext_vector_type(16)));
typedef unsigned u32x2 __attribute__((ext_vector_type(2)));
typedef unsigned u32x4 __attribute__((ext_vector_type(4)));
typedef int i32x4 __attribute__((ext_vector_type(4)));
typedef int i32x8 __attribute__((ext_vector_type(8)));
typedef GAS unsigned gu32;
#define RLX_AGENT __ATOMIC_RELAXED, __HIP_MEMORY_SCOPE_AGENT
#define LDS_WAIT() asm volatile("s_waitcnt lgkmcnt(0)" ::: "memory")
#define VM_WAIT() asm volatile("s_waitcnt vmcnt(0)" ::: "memory")

#ifndef MK_PER_PHASE
#define MK_PER_PHASE 0
#endif

constexpr int NB = 8, SEQ = 2048, T = NB * SEQ, D = 1024;
constexpr int NPROJ = 8192;
constexpr int C_QA = 0, C_KA = 512, C_VA = 1024, C_RA = 2048, C_QB = 3072, C_KB = 4096, C_VB = 5120, C_GA = 6144, C_GB = 7168;
#define PROJ_BLK(cs) ((size_t)(cs) * T)
constexpr int SRC_ALOW = 3072, D_IN = 8208;
constexpr int NE = 32, FF = 1024, MAXTILES = 288, MAXROWS = MAXTILES * 256;
constexpr float EPS = 1e-6f;
constexpr int NWAVES = 8, NTHREADS = 512;
constexpr int NPHASES = 14;

constexpr size_t MiB = 1u << 20;
constexpr size_t WS_CTL = 0, CTL_ZERO_BYTES = 1 * MiB;
constexpr size_t WS_SMALL = 1 * MiB;
constexpr size_t WS_KMP   = WS_SMALL;
constexpr size_t WS_DEC   = WS_KMP + 512 * 1024;
constexpr size_t WS_TOPE  = WS_DEC + 512 * 1024;
constexpr size_t WS_WTS   = WS_TOPE + 256 * 1024;
constexpr size_t WS_SLOT  = WS_WTS + 256 * 1024;
constexpr size_t WS_DEST  = WS_SLOT + 256 * 1024;
constexpr size_t WS_ROWTOK = WS_DEST + 256 * 1024;
constexpr size_t WS_RSTDS = WS_ROWTOK + 320 * 1024;
constexpr size_t WS_RSTD  = WS_RSTDS + 320 * 1024;
constexpr size_t WS_TILEE = WS_RSTD + 64 * 1024;
constexpr size_t WS_WALT  = WS_TILEE + 4 * 1024;
constexpr size_t WS_WRF   = WS_WALT + 32 * 1024;
static_assert(WS_WRF + 128 * 1024 <= 6 * MiB, "small map");
constexpr size_t WS_WO = 6 * MiB, WS_WPG = 8 * MiB, WS_WPP = 10 * MiB, WS_WUP = 12 * MiB, WS_WIN = 16 * MiB;
constexpr size_t WS_PB = 34 * MiB;
constexpr size_t WS_H  = 42 * MiB;
constexpr size_t WS_PROJ = 74 * MiB;
constexpr size_t WS_QG = 330 * MiB, WS_KG = 346 * MiB;
constexpr size_t WS_SLOC = 426 * MiB;
constexpr size_t WS_OAB = 362 * MiB;
constexpr size_t WS_H8 = 426 * MiB;
constexpr size_t WS_WIN8 = 442 * MiB;
constexpr size_t WS_Y = 330 * MiB;
constexpr size_t WS_W2T = 42 * MiB;
constexpr size_t WS_A2 = 330 * MiB;
constexpr size_t WS_HMID = 138 * MiB;
constexpr size_t WS_X1 = 74 * MiB;
constexpr size_t WS_X2 = 138 * MiB;
constexpr size_t WS_YROWS = 282 * MiB;
constexpr size_t WS_PGATE = 330 * MiB, WS_PPROJ = 226 * MiB;
constexpr size_t WS_ROWE = 490 * MiB;
constexpr size_t WS_RSTE = 492 * MiB;
constexpr size_t WS_END = 506 * MiB;

constexpr int CW_BAR = 4096;
constexpr int CW_COUNTS = 16384;
constexpr int CW_QUEUE = 16384 + 64;

constexpr int RING_BYTES = 131072;
constexpr int LDSCTL_OFF = RING_BYTES, MISC_OFF = LDSCTL_OFF + 320;
constexpr int LDS_MOE = LDSCTL_OFF + 10240;
constexpr int EPF_OFF = LDSCTL_OFF + 12288;
constexpr int LDS_BYTES = 151552;

typedef __bf16 bf16v2_t __attribute__((ext_vector_type(2)));
__device__ __forceinline__ unsigned cvt_pk_bf16(float lo, float hi) { const f32x2 v = {lo, hi}; return __builtin_bit_cast(unsigned, __builtin_convertvector(v, bf16v2_t)); }
__device__ __forceinline__ unsigned pk4_fp8(float a, float b, float c, float d) { int w = 0; w = __builtin_amdgcn_cvt_pk_fp8_f32(a, b, w, false); w = __builtin_amdgcn_cvt_pk_fp8_f32(c, d, w, true); return (unsigned)w; }
__device__ __forceinline__ float bf2f(unsigned short s) { return __uint_as_float(((unsigned)s) << 16); }
__device__ __forceinline__ float bflo(unsigned w) { return __uint_as_float(w << 16); }
__device__ __forceinline__ float bfhi(unsigned w) { return __uint_as_float(w & 0xffff0000u); }
__device__ __forceinline__ float fsigmoid(float x) { return __builtin_amdgcn_rcpf(1.0f + __builtin_amdgcn_exp2f(-1.4426950408889634f * x)); }
__device__ __forceinline__ float wave_sum(float v) {
#pragma unroll
    for (int o = 1; o < 64; o <<= 1) v += __shfl_xor(v, o);
    return v;
}
__device__ __forceinline__ bf16x8 pack8(f32x4 a, f32x4 b) {
    u32x4 w = {cvt_pk_bf16(a[0], a[1]), cvt_pk_bf16(a[2], a[3]), cvt_pk_bf16(b[0], b[1]), cvt_pk_bf16(b[2], b[3])};
    return __builtin_bit_cast(bf16x8, w);
}

#define XB_TMO      128
#define XB_XCNT(j)  (256  + 64 * (j))
#define XB_XSUB(j)  (1280 + 64 * (j))
#define XB_XGEN(j)  (2304 + 64 * (j))
#define XB_TOP      3328
#define XB_TOPGEN   3392
#define XCD_BAR_WORDS 3456
#define XB_SPIN_CAP (1u << 18)

__device__ __forceinline__ unsigned xb_ld(unsigned* p)              { return __hip_atomic_load(p, __ATOMIC_RELAXED, __HIP_MEMORY_SCOPE_AGENT); }
__device__ __forceinline__ unsigned xb_add(unsigned* p, unsigned v) { return __hip_atomic_fetch_add(p, v, __ATOMIC_RELAXED, __HIP_MEMORY_SCOPE_AGENT); }
__device__ __forceinline__ unsigned xb_xcc_id() { return (unsigned)__builtin_amdgcn_s_getreg((3 << 11) | 20) & 0xFu; }
#define XB_SPIN(cond, bar) do { unsigned _sp = 0; while (cond) { __builtin_amdgcn_s_sleep(1); \
    if ((++_sp & 255u) == 0u) { if (xb_ld(&(bar)[XB_TMO])) break; if (_sp > XB_SPIN_CAP) { atomicAdd(&(bar)[XB_TMO], 1u); break; } } } } while (0)

struct XcdBarrier { unsigned* bar; unsigned x; volatile LAS unsigned* st; };

__device__ __forceinline__ XcdBarrier xcd_barrier_post(unsigned* bar, volatile LAS unsigned* st) {
    XcdBarrier b; b.bar = bar; b.x = xb_xcc_id(); b.st = st;
    if (threadIdx.x == 0) (void)xb_add(&bar[XB_XCNT(b.x)], 1u);
    return b;
}
__device__ __forceinline__ void xcd_barrier_complete(unsigned* bar, unsigned x, unsigned& nloc, unsigned& nx) {
    const unsigned G = gridDim.x * gridDim.y * gridDim.z;
    unsigned sum, cnt, mine, sp = 0u;
    for (;;) {
        sum = 0u; cnt = 0u; mine = 0u;
#pragma unroll
        for (unsigned j = 0; j < 16; ++j) { const unsigned c = xb_ld(&bar[XB_XCNT(j)]); sum += c; cnt += (c > 0u) ? 1u : 0u; mine = (j == x) ? c : mine; }
        if (sum == G) break;
        __builtin_amdgcn_s_sleep(1);
        if ((++sp & 255u) == 0u) { if (xb_ld(&bar[XB_TMO])) break; if (sp > XB_SPIN_CAP) { atomicAdd(&bar[XB_TMO], 1u); break; } }
    }
    nloc = mine > 0u ? mine : 1u; nx = cnt > 0u ? cnt : 1u;
}
__device__ __forceinline__ void xcd_barrier(const XcdBarrier& b) {
    asm volatile("s_waitcnt vmcnt(0)" ::: "memory");
    __syncthreads();
    if (threadIdx.x == 0) {
        unsigned* bar = b.bar;
        __builtin_amdgcn_s_waitcnt(0);
        unsigned nloc = b.st[0], nx = b.st[1];
        if (nloc == 0u) { xcd_barrier_complete(bar, b.x, nloc, nx); b.st[0] = nloc; b.st[1] = nx; }
        const unsigned old = xb_add(&bar[XB_XSUB(b.x)], 1u);
        const unsigned gen = old / nloc;
        if (old + 1u == (gen + 1u) * nloc) {
            __builtin_amdgcn_fence(__ATOMIC_RELEASE, "agent");
            asm volatile("s_waitcnt vmcnt(0)" ::: "memory");
            const unsigned og = xb_add(&bar[XB_TOP], 1u);
            const unsigned tg = og / nx;
            if (og + 1u == (tg + 1u) * nx) xb_add(&bar[XB_TOPGEN], 1u);
            else XB_SPIN(xb_ld(&bar[XB_TOPGEN]) == tg, bar);
            __builtin_amdgcn_fence(__ATOMIC_ACQUIRE, "agent");
            xb_add(&bar[XB_XGEN(b.x)], 1u);
            asm volatile("s_waitcnt vmcnt(0)" ::: "memory");
        } else {
            XB_SPIN(xb_ld(&bar[XB_XGEN(b.x)]) == gen, bar);
            __builtin_amdgcn_fence(__ATOMIC_ACQUIRE, "agent");
            asm volatile("s_waitcnt vmcnt(0)" ::: "memory");
        }
    }
    __syncthreads();
}
#ifndef MK_SCL
#define MK_SCL 0
#endif
namespace pg8 {
constexpr int BM = 256, BK = 64, HALF = 128, HTB = HALF * BK * 2, STAGE_BYTES = 8 * HTB, NXCD = 8, WGM = 8;

__host__ __device__ __forceinline__ int lds_byte(int r, int c) { const int st = (r >> 4) * 2 + (c >> 5), rr = r & 15, cc = c & 31, ob = rr * 64 + cc * 2; return st * 1024 + (ob ^ (((ob >> 9) & 1) << 5)); }
__host__ __device__ __forceinline__ void stage_rc(int b, int& R, int& C) { const int st = b / 1024, sb = b % 1024, swz = sb ^ (((sb >> 9) & 1) << 5); R = (st >> 1) * 16 + swz / 64; C = (st & 1) * 32 + (swz % 64) / 2; }
__host__ __device__ __forceinline__ int perm32(int rho) { const int n = rho >> 4, i = rho & 15; return 8 * (i >> 2) + 4 * n + (i & 3); }

struct Unit { int pm, pn, e, s; };

struct TileOrder {
    int nM, nN, nwg, G, c;
    __device__ __forceinline__ void init(int nM_, int nN_, int G_, int c_) { nM = nM_; nN = nN_; nwg = nM * nN; G = G_; c = c_; }
    __device__ __forceinline__ bool next(int i, int& pm, int& pn) const {
        const unsigned L = (unsigned)i * (unsigned)G + (unsigned)c; if (L >= (unsigned)nwg) return false;
        int wgid = (int)L; { const int q = nwg / NXCD, r = nwg % NXCD, xcd = wgid % NXCD, off = wgid / NXCD; wgid = (xcd < r ? xcd * (q + 1) : r * (q + 1) + (xcd - r) * q) + off; }
        const int nig = WGM * nN, gid = wgid / nig, fm = gid * WGM, gsz = (nM - fm) < WGM ? (nM - fm) : WGM;
        pm = fm + ((wgid % nig) % gsz); pn = (wgid % nig) / gsz; return true;
    }
};
struct DenseSched {
    TileOrder o; const char* Bt; int K; int es = 2; int gap_at = 1 << 30, gap_by = 0, pn0 = 0; bool bt_out = true;
    __device__ __forceinline__ bool next(int i, Unit& u) const { int p; if (!o.next(i, u.pm, p)) return false; u.e = p; u.pn = p + (p >= gap_at ? gap_by : 0) + pn0; return true; }
    __device__ __forceinline__ unsigned a_row(const Unit& u, int r) const { return (unsigned)(u.pm * BM + r); }
    __device__ __forceinline__ unsigned a_koff(const Unit&) const { return 0u; }
    __device__ __forceinline__ const char* b_base(const Unit& u) const { return Bt + (size_t)(bt_out ? u.pn : u.e) * BM * K * es; }
};
struct ChainSched {
    TileOrder o; const char* Bt; int K;
    __device__ __forceinline__ bool next(int i, Unit& u) const { if (!o.next(i >> 1, u.pm, u.pn)) return false; u.e = i & 1; return true; }
    __device__ __forceinline__ unsigned a_row(const Unit& u, int r) const { return (unsigned)(u.pm * BM + r); }
    __device__ __forceinline__ unsigned a_koff(const Unit& u) const { return (unsigned)(u.e * K * 2); }
    __device__ __forceinline__ const char* b_base(const Unit& u) const { return Bt + (size_t)u.pn * BM * (2 * K) * 2 + (size_t)u.e * K * 2; }
};
template <bool GATHER> struct MoeSched {
    TileOrder o; const char* Bt; int K; int rows_per_e; const LAS int* tab; const int* row_e; int es;
    __device__ __forceinline__ bool next(int i, Unit& u) const { if (!o.next(i, u.pm, u.pn)) return false; u.e = __builtin_amdgcn_readfirstlane(tab[128 + u.pm]); return true; }
    __device__ __forceinline__ unsigned a_row(const Unit& u, int r) const {
        if (GATHER) { const int lr = u.pm * BM + r - tab[u.e]; return lr < tab[64 + u.e] ? (unsigned)row_e[(size_t)u.e * T + lr] : 0u; }
        else return (unsigned)(u.pm * BM + r); }
    __device__ __forceinline__ unsigned a_koff(const Unit&) const { return 0u; }
    __device__ __forceinline__ const char* b_base(const Unit& u) const { return Bt + ((size_t)u.e * rows_per_e + (size_t)u.pn * BM) * K * es; }
};

template <class Epi, class Sched>
__device__ __forceinline__ void gemm_phase(LAS unsigned char* lds, const char* gA, int K_, int lda, int ldb, const Sched& S, const Epi& E) {
    int K = K_; asm volatile("" : "+s"(K));
    int tid = threadIdx.x; asm volatile("" : "+v"(tid));     const int wid = __builtin_amdgcn_readfirstlane(tid >> 6), lane = tid & 63, wr = wid >> 2, wc = wid & 3, fr = lane & 15, fq = lane >> 4;
    constexpr int ES = Epi::F8 ? 1 : 2;
    const int nt = K * ES / 128;
    unsigned voffB[2];
#pragma unroll
    for (int i = 0; i < 2; ++i) { int R, C; stage_rc(tid * 16 + i * 8192, R, C); const int Rb = Epi::PERM ? ((R & ~31) + perm32(R & 31)) : R; voffB[i] = (unsigned)(Rb * ldb * ES + C * 2); }
    const unsigned kstep = (unsigned)(BK * 2);
    const size_t hstepB = (size_t)HALF * ldb * ES;
    const unsigned ldab = (unsigned)lda * ES;
    const unsigned ldsw = (unsigned)wid * 1024u;
    const int aoff = lds_byte(wr * 64 + fr, fq * 8), boff = lds_byte(wc * 32 + fr, fq * 8);
#define PG8_SA(b, h) (((b) * 2 + (h)) * HTB)
#define PG8_SB(b, h) ((4 + (b) * 2 + (h)) * HTB)
#define PG8_STAGE_B(bufoff, gbase) do { _Pragma("unroll") for (int _i = 0; _i < 2; ++_i) \
        __builtin_amdgcn_global_load_lds((const unsigned*)((const char*)(gbase) + voffB[_i]), (LAS unsigned*)(lds + (bufoff) + ldsw + _i * 8192), 16, 0, 0); } while (0)
#define PG8_STAGE_A(bufoff, o0, o1, kb) do { \
        const char* gk_ = gA + (kb);      \
        __builtin_amdgcn_global_load_lds((const unsigned*)(gk_ + (o0)), (LAS unsigned*)(lds + (bufoff) + ldsw), 16, 0, 0); \
        __builtin_amdgcn_global_load_lds((const unsigned*)(gk_ + (o1)), (LAS unsigned*)(lds + (bufoff) + ldsw + 8192), 16, 0, 0); } while (0)
#define PG8_LDA(dst, b, h) do { _Pragma("unroll") for (int m = 0; m < 4; ++m) _Pragma("unroll") for (int k = 0; k < 2; ++k) dst[m][k] = *(const LAS bf16x8*)(lds + PG8_SA(b, h) + aoff + m * 2048 + k * 1024); } while (0)
#define PG8_LDB(dst, b, h) do { _Pragma("unroll") for (int n = 0; n < 2; ++n) _Pragma("unroll") for (int k = 0; k < 2; ++k) dst[n][k] = *(const LAS bf16x8*)(lds + PG8_SB(b, h) + boff + n * 2048 + k * 1024); } while (0)
#define PG8_MMA(ai, bj, At, Bt) do { __builtin_amdgcn_s_setprio(1); \
        if constexpr (Epi::F8) { _Pragma("unroll") for (int m = 0; m < 4; ++m) _Pragma("unroll") for (int n = 0; n < 2; ++n) { \
            const i32x8 a8_ = __builtin_shufflevector(__builtin_bit_cast(i32x4, At[m][0]), __builtin_bit_cast(i32x4, At[m][1]), 0, 1, 2, 3, 4, 5, 6, 7); \
            const i32x8 b8_ = __builtin_shufflevector(__builtin_bit_cast(i32x4, Bt[n][0]), __builtin_bit_cast(i32x4, Bt[n][1]), 0, 1, 2, 3, 4, 5, 6, 7); \
            acc[ai][bj][m][n] = __builtin_amdgcn_mfma_scale_f32_16x16x128_f8f6f4(b8_, a8_, acc[ai][bj][m][n], 0, 0, 0, MK_SCL, 0, MK_SCL); } } \
        else { _Pragma("unroll") for (int m = 0; m < 4; ++m) _Pragma("unroll") for (int n = 0; n < 2; ++n) _Pragma("unroll") for (int k = 0; k < 2; ++k) \
            acc[ai][bj][m][n] = __builtin_amdgcn_mfma_f32_16x16x32_bf16(Bt[n][k], At[m][k], acc[ai][bj][m][n], 0, 0, 0); } \
        __builtin_amdgcn_s_setprio(0); } while (0)
#define PG8_WAIT_V(n) asm volatile("s_waitcnt vmcnt(" #n ")" ::: "memory")
#define PG8_WAIT_L(n) asm volatile("s_waitcnt lgkmcnt(" #n ")" ::: "memory")
#define PG8_BAR __builtin_amdgcn_s_barrier()
#define PG8_SCHED __builtin_amdgcn_sched_barrier(0)
#define PG8_AOFFS(dst, u) do { int t_ = threadIdx.x; asm volatile("" : "+v"(t_));     \
        _Pragma("unroll") for (int _h = 0; _h < 2; ++_h) _Pragma("unroll") for (int _i = 0; _i < 2; ++_i) { int R_, C_; stage_rc(t_ * 16 + _i * 8192, R_, C_); \
        dst[_h][_i] = S.a_row(u, _h * HALF + R_) * ldab + (unsigned)C_ * 2u + S.a_koff(u); } } while (0)
    Unit cur, nxt; int ui = 0;
    if (!S.next(0, cur)) return;
    cur.s = 0;
    if constexpr (Epi::PREF) E.prefetch(cur, 0);
#ifdef MK_STAGGER
    if (S.o.nwg > 3 * S.o.G) {
        const unsigned long long t0_ = __builtin_amdgcn_s_memrealtime(); const unsigned long long d_ = (unsigned long long)((blockIdx.x >> 3) & 7) * MK_STAGGER;
        while (__builtin_amdgcn_s_memrealtime() - t0_ < d_) __builtin_amdgcn_s_sleep(4);
    }
#endif
    f32x4 acc[2][2][4][2];
#pragma unroll
    for (int a = 0; a < 2; ++a)
#pragma unroll
        for (int b = 0; b < 2; ++b)
#pragma unroll
            for (int m = 0; m < 4; ++m)
#pragma unroll
                for (int n = 0; n < 2; ++n) acc[a][b][m][n] = (f32x4){0.f, 0.f, 0.f, 0.f};
    bf16x8 At[4][2], B0[2][2], B1[2][2];
    unsigned oc[2][2];
    LAS u32x4* nslot = (LAS u32x4*)(lds + LDSCTL_OFF + 2048) + tid;
    PG8_AOFFS(oc, cur);
    const char* cB = S.b_base(cur);
    PG8_STAGE_B(PG8_SB(0, 0), cB); PG8_STAGE_B(PG8_SB(0, 1), cB + hstepB); PG8_STAGE_A(PG8_SA(0, 0), oc[0][0], oc[0][1], 0u); PG8_STAGE_A(PG8_SA(0, 1), oc[1][0], oc[1][1], 0u);
    if (wr == 1) PG8_BAR;
    PG8_WAIT_V(2); PG8_BAR;
    PG8_STAGE_B(PG8_SB(1, 0), cB + kstep); PG8_STAGE_A(PG8_SA(1, 0), oc[0][0], oc[0][1], kstep); PG8_STAGE_B(PG8_SB(1, 1), cB + hstepB + kstep);
    PG8_WAIT_V(6); PG8_BAR;
    for (;;) {
        const bool has_next = S.next(ui + 1, nxt);
        const char* nB = has_next ? S.b_base(nxt) : cB;
        if (has_next) { unsigned on[2][2]; PG8_AOFFS(on, nxt); *nslot = (u32x4){on[0][0], on[0][1], on[1][0], on[1][1]}; nxt.s = cur.s == 2 ? 0 : cur.s + 1;
            if constexpr (Epi::PREF) E.prefetch(nxt, nxt.s); }
        for (int t = 0; t < nt; t += 2) {
            const bool last = (t == nt - 2);
            const unsigned k1 = (unsigned)(t + 1) * kstep;
            const unsigned k2 = last ? 0u : (unsigned)(t + 2) * kstep, k3 = k2 + kstep;
            const char* b2 = last ? nB : cB + (size_t)(t + 2) * kstep; const char* b3 = b2 + kstep;
            PG8_LDB(B0, 0, 0); PG8_LDB(B1, 0, 1); PG8_SCHED; PG8_LDA(At, 0, 0); PG8_STAGE_A(PG8_SA(1, 1), oc[1][0], oc[1][1], k1);
            PG8_WAIT_V(8); PG8_WAIT_L(0); PG8_BAR; PG8_MMA(0, 0, At, B0); PG8_MMA(0, 1, At, B1); PG8_BAR; PG8_SCHED;
            if (last && has_next) { const u32x4 o_ = *nslot; oc[0][0] = o_.x; oc[0][1] = o_.y; oc[1][0] = o_.z; oc[1][1] = o_.w; }
            PG8_LDA(At, 0, 1); PG8_STAGE_B(PG8_SB(0, 0), b2); PG8_STAGE_B(PG8_SB(0, 1), b2 + hstepB); PG8_STAGE_A(PG8_SA(0, 0), oc[0][0], oc[0][1], k2);
            PG8_WAIT_V(8); PG8_WAIT_L(0); PG8_BAR; PG8_MMA(1, 0, At, B0); PG8_MMA(1, 1, At, B1); PG8_BAR; PG8_SCHED;
            PG8_LDB(B0, 1, 0); PG8_LDB(B1, 1, 1); PG8_SCHED; PG8_LDA(At, 1, 0); PG8_STAGE_A(PG8_SA(0, 1), oc[1][0], oc[1][1], k2);
            PG8_WAIT_V(8); PG8_WAIT_L(0); PG8_BAR; PG8_MMA(0, 0, At, B0); PG8_MMA(0, 1, At, B1); PG8_BAR; PG8_SCHED;
            PG8_LDA(At, 1, 1); PG8_STAGE_B(PG8_SB(1, 0), b3); PG8_STAGE_B(PG8_SB(1, 1), b3 + hstepB); PG8_STAGE_A(PG8_SA(1, 0), oc[0][0], oc[0][1], k3);
            PG8_WAIT_V(8); PG8_WAIT_L(0); PG8_BAR; PG8_MMA(1, 0, At, B0); PG8_MMA(1, 1, At, B1); PG8_BAR; PG8_SCHED;
        }
        if (wr == 0) PG8_BAR;
        bool carry = false;
        if constexpr (Epi::MIDK) { if (cur.e == 0) { E.mid(acc, cur, wr, wc, fr, fq); carry = true; } else E(acc, cur, wr, wc, fr, fq); } else E(acc, cur, wr, wc, fr, fq);
        if (!has_next) break;
        if (!carry)
#pragma unroll
        for (int a = 0; a < 2; ++a)
#pragma unroll
            for (int b = 0; b < 2; ++b)
#pragma unroll
                for (int m = 0; m < 4; ++m)
#pragma unroll
                    for (int n = 0; n < 2; ++n) acc[a][b][m][n] = (f32x4){0.f, 0.f, 0.f, 0.f};
        cur = nxt; cB = nB; ++ui;
        if (wr == 1) PG8_BAR;
    }
    PG8_WAIT_V(0);
    PG8_BAR;
#undef PG8_SA
#undef PG8_SB
#undef PG8_STAGE_A
#undef PG8_STAGE_B
#undef PG8_LDA
#undef PG8_LDB
#undef PG8_MMA
#undef PG8_WAIT_V
#undef PG8_WAIT_L
#undef PG8_BAR
#undef PG8_SCHED
#undef PG8_AOFFS
}

template <bool F8_> struct EpiProj {
    static constexpr bool PREF = false, PERM = true, MIDK = false, F8 = F8_;
    bf16_t* O; float* kmp;
    __device__ __forceinline__ void operator()(const f32x4 (&acc)[2][2][4][2], const Unit& u, int wr, int wc, int fr, int fq) const {
        const int row0 = u.pm * BM + wr * 64 + fr;
        const bool narrow = (u.pn < C_VA / BM) || (u.pn >= C_QB / BM && u.pn < C_GA / BM);
        const bool gate = u.pn >= C_GA / BM;
        const int hw = narrow ? 128 : 256; const size_t bjs = narrow ? (size_t)HALF * T : (size_t)HALF;
#pragma unroll
        for (int ai = 0; ai < 2; ++ai)
#pragma unroll
            for (int m = 0; m < 4; ++m) { bf16_t* rowp = O + PROJ_BLK(u.pn * BM) + (size_t)(row0 + ai * HALF + m * 16) * hw + wc * 32 + 8 * fq;
#pragma unroll
                for (int bj = 0; bj < 2; ++bj) { const float sc = F8 ? (1.0f / 32.0f) : 1.0f; const f32x4 v0 = acc[ai][bj][m][0] * sc, v1 = acc[ai][bj][m][1] * sc;
                    if (F8 && gate) { u32x2 w8; w8.x = pk4_fp8(v0[0], v0[1], v0[2], v0[3]); w8.y = pk4_fp8(v1[0], v1[1], v1[2], v1[3]);
                        __builtin_nontemporal_store(w8, (u32x2*)((unsigned char*)(O + PROJ_BLK(u.pn * BM)) + (size_t)(row0 + ai * HALF + m * 16) * 256 + bj * HALF + wc * 32 + 8 * fq)); continue; }
                    u32x4 w; w.x = cvt_pk_bf16(v0[0], v0[1]); w.y = cvt_pk_bf16(v0[2], v0[3]); w.z = cvt_pk_bf16(v1[0], v1[1]); w.w = cvt_pk_bf16(v1[2], v1[3]);
                    __builtin_nontemporal_store(w, (u32x4*)(rowp + bj * bjs)); } }
        if (u.pn >= C_KB / BM && u.pn < C_VB / BM) {
#pragma unroll
            for (int bj = 0; bj < 2; ++bj)
#pragma unroll
                for (int n = 0; n < 2; ++n) { f32x4 s = (f32x4){0.f, 0.f, 0.f, 0.f};
#pragma unroll
                    for (int ai = 0; ai < 2; ++ai)
#pragma unroll
                        for (int m = 0; m < 4; ++m) s += acc[ai][bj][m][n];
#pragma unroll
                    for (int o = 1; o < 16; o <<= 1) { s[0] += __shfl_xor(s[0], o); s[1] += __shfl_xor(s[1], o); s[2] += __shfl_xor(s[2], o); s[3] += __shfl_xor(s[3], o); }
                    if (fr == 0) *(f32x4*)(kmp + ((size_t)wr * 64 + u.pm) * 1024 + (u.pn - C_KB / BM) * BM + bj * HALF + wc * 32 + 8 * fq + 4 * n) = s * (F8 ? (1.0f / 32.0f) : 1.0f); }
        }
    }
};
struct EpiMerge {
    static constexpr bool PREF = false, PERM = true, MIDK = true, F8 = false;
    const bf16_t* proj; bf16_t* Y;
    __device__ __forceinline__ void mid(f32x4 (&acc)[2][2][4][2], const Unit& u, int wr, int wc, int fr, int fq) const {
        const int row0 = u.pm * BM + wr * 64 + fr; const int col0 = u.pn * BM + wc * 32 + 8 * fq;
#pragma unroll
        for (int ai = 0; ai < 2; ++ai) {
            u32x2 ga[4][2], gb[4][2];
#pragma unroll
            for (int m = 0; m < 4; ++m) { const unsigned char* rowp = (const unsigned char*)(proj + PROJ_BLK(u.pn * BM)) + (size_t)(row0 + ai * HALF + m * 16) * 256 + wc * 32 + 8 * fq;
#pragma unroll
                for (int bj = 0; bj < 2; ++bj) { ga[m][bj] = *(const u32x2*)(rowp + 2 * PROJ_BLK(C_GA) + bj * HALF); gb[m][bj] = *(const u32x2*)(rowp + 2 * PROJ_BLK(C_GB) + bj * HALF); } }
#pragma unroll
            for (int m = 0; m < 4; ++m) {
#pragma unroll
                for (int bj = 0; bj < 2; ++bj) {
#pragma unroll
                    for (int n = 0; n < 2; ++n) {
#define MG_R(b_) ((1.0f + __builtin_amdgcn_exp2f(-1.4426950408889634f * __builtin_amdgcn_cvt_f32_fp8((int)gb[m][bj][n], b_))) * __builtin_amdgcn_rcpf(1.0f + __builtin_amdgcn_exp2f(-1.4426950408889634f * __builtin_amdgcn_cvt_f32_fp8((int)ga[m][bj][n], b_))))
                        acc[ai][bj][m][n][0] *= MG_R(0); acc[ai][bj][m][n][1] *= MG_R(1); acc[ai][bj][m][n][2] *= MG_R(2); acc[ai][bj][m][n][3] *= MG_R(3);
#undef MG_R
                    } }
                asm volatile("" : "+v"(acc[ai][0][m][0]), "+v"(acc[ai][0][m][1]), "+v"(acc[ai][1][m][0]), "+v"(acc[ai][1][m][1])); }
            asm volatile("" ::: "memory"); }
    }
    __device__ __forceinline__ void operator()(const f32x4 (&acc)[2][2][4][2], const Unit& u, int wr, int wc, int fr, int fq) const {
        const int row0 = u.pm * BM + wr * 64 + fr; const int col0 = u.pn * BM + wc * 32 + 8 * fq;
#pragma unroll
        for (int ai = 0; ai < 2; ++ai) {
            u32x2 gb[4][2];
#pragma unroll
            for (int m = 0; m < 4; ++m)
#pragma unroll
                for (int bj = 0; bj < 2; ++bj) gb[m][bj] = *(const u32x2*)((const unsigned char*)(proj + PROJ_BLK(C_GB + u.pn * BM)) + (size_t)(row0 + ai * HALF + m * 16) * 256 + wc * 32 + 8 * fq + bj * HALF);
#pragma unroll
            for (int m = 0; m < 4; ++m) { const size_t r = (size_t)(row0 + ai * HALF + m * 16);
#pragma unroll
                for (int bj = 0; bj < 2; ++bj) { const u32x2 g = gb[m][bj];
                    const f32x4 v0 = acc[ai][bj][m][0], v1 = acc[ai][bj][m][1];
#define MG_S(w_, b_) fsigmoid(__builtin_amdgcn_cvt_f32_fp8((int)(w_), b_))
                    u32x4 w; w.x = cvt_pk_bf16(v0[0] * MG_S(g.x, 0), v0[1] * MG_S(g.x, 1)); w.y = cvt_pk_bf16(v0[2] * MG_S(g.x, 2), v0[3] * MG_S(g.x, 3));
                    w.z = cvt_pk_bf16(v1[0] * MG_S(g.y, 0), v1[1] * MG_S(g.y, 1)); w.w = cvt_pk_bf16(v1[2] * MG_S(g.y, 2), v1[3] * MG_S(g.y, 3));
#undef MG_S
                    *(u32x4*)(Y + r * D + col0 + bj * HALF) = w; } }
            asm volatile("" ::: "memory"); }
    }
};
struct EpiResF32 {
    static constexpr bool PREF = false, PERM = true, MIDK = false, F8 = false;
    const float* base; bf16_t* out;
    __device__ __forceinline__ void operator()(const f32x4 (&acc)[2][2][4][2], const Unit& u, int wr, int wc, int fr, int fq) const {
        const int row0 = u.pm * BM + wr * 64 + fr, col0 = u.pn * BM + wc * 32 + 8 * fq;
#pragma unroll
        for (int ai = 0; ai < 2; ++ai) {
            f32x4 bs[4][2][2];
#pragma unroll
            for (int m = 0; m < 4; ++m) { const size_t off = (size_t)(row0 + ai * HALF + m * 16) * D + col0;
#pragma unroll
                for (int bj = 0; bj < 2; ++bj)
#pragma unroll
                    for (int n = 0; n < 2; ++n) bs[m][bj][n] = __builtin_nontemporal_load((const f32x4*)(base + off + bj * HALF + n * 4)); }
#pragma unroll
            for (int m = 0; m < 4; ++m) { const size_t off = (size_t)(row0 + ai * HALF + m * 16) * D + col0;
#pragma unroll
                for (int bj = 0; bj < 2; ++bj) { const f32x4 v0 = bs[m][bj][0] + acc[ai][bj][m][0], v1 = bs[m][bj][1] + acc[ai][bj][m][1];
                    u32x4 w; w.x = cvt_pk_bf16(v0[0], v0[1]); w.y = cvt_pk_bf16(v0[2], v0[3]); w.z = cvt_pk_bf16(v1[0], v1[1]); w.w = cvt_pk_bf16(v1[2], v1[3]);
                    *(u32x4*)(out + off + bj * HALF) = w; } }
            asm volatile("" ::: "memory"); }
    }
};
struct EpiGlu {
    static constexpr bool PREF = true, PERM = true, MIDK = false, F8 = true;
    unsigned char* H; const float* rstd_e; const LAS int* tab; const float* bg; const float* bu; const float* zero; LAS unsigned char* lds;
    __device__ __forceinline__ void prefetch(const Unit& u, int slot) const {
        int tid = threadIdx.x; asm volatile("" : "+v"(tid)); const int wave = __builtin_amdgcn_readfirstlane(tid >> 6);
        const float* src;
        if (wave < 4) { const int lr = u.pm * BM + tid - tab[u.e]; src = lr < tab[64 + u.e] ? rstd_e + (size_t)u.e * T + lr : zero; }
        else { const int j = tid - 256; src = (j < 128 ? bg : bu) + (size_t)u.e * FF + u.pn * HALF + (j & 127); }
        __builtin_amdgcn_global_load_lds((const unsigned*)src, (LAS unsigned*)(lds + EPF_OFF + slot * 2048 + wave * 256), 4, 0, 0);
    }
    __device__ __forceinline__ void operator()(const f32x4 (&acc)[2][2][4][2], const Unit& u, int wr, int wc, int fr, int fq) const {
        const int row0 = u.pm * BM + wr * 64 + fr; const int colo = u.pn * HALF + wc * 32 + 8 * fq;
        const LAS float* ep = (const LAS float*)(lds + EPF_OFF + u.s * 2048);
        f32x4 g4[2], u4[2];
#pragma unroll
        for (int n = 0; n < 2; ++n) { g4[n] = *(const LAS f32x4*)(ep + 256 + wc * 32 + 8 * fq + 4 * n); u4[n] = *(const LAS f32x4*)(ep + 384 + wc * 32 + 8 * fq + 4 * n); }
        float rsv[2][4];
#pragma unroll
        for (int ai = 0; ai < 2; ++ai)
#pragma unroll
            for (int m = 0; m < 4; ++m) rsv[ai][m] = ep[wr * 64 + fr + ai * HALF + m * 16];
#pragma unroll
        for (int ai = 0; ai < 2; ++ai)
#pragma unroll
            for (int m = 0; m < 4; ++m) { const int r = row0 + ai * HALF + m * 16; const float rs = rsv[ai][m] * (1.0f / 32.0f);
                float o[8];
#pragma unroll
                for (int n = 0; n < 2; ++n)
#pragma unroll
                    for (int jp = 0; jp < 2; ++jp) {
                        const f32x2 ga = {acc[ai][0][m][n][2 * jp], acc[ai][0][m][n][2 * jp + 1]}, ua = {acc[ai][1][m][n][2 * jp], acc[ai][1][m][n][2 * jp + 1]};
                        const f32x2 rs2 = {rs, rs}, gb2 = {g4[n][2 * jp], g4[n][2 * jp + 1]}, ub2 = {u4[n][2 * jp], u4[n][2 * jp + 1]};
                        f32x2 g = __builtin_elementwise_fma(ga, rs2, gb2), up = __builtin_elementwise_fma(ua, rs2, ub2);
                        g.x = fminf(g.x, 7.0f); g.y = fminf(g.y, 7.0f); up.x = __builtin_amdgcn_fmed3f(up.x, -7.0f, 7.0f); up.y = __builtin_amdgcn_fmed3f(up.y, -7.0f, 7.0f);
                        const f32x2 t = g * (f32x2){-1.702f * 1.4426950408889634f, -1.702f * 1.4426950408889634f};
                        f32x2 d = {__builtin_amdgcn_exp2f(t.x), __builtin_amdgcn_exp2f(t.y)}; d = d + (f32x2){1.0f, 1.0f};
                        const f32x2 rr = {__builtin_amdgcn_rcpf(d.x), __builtin_amdgcn_rcpf(d.y)};
                        const f32x2 glu = g * rr, ov = __builtin_elementwise_fma(up, glu, glu);
                        o[n * 4 + 2 * jp] = ov.x; o[n * 4 + 2 * jp + 1] = ov.y; }
                u32x2 w; w.x = pk4_fp8(o[0], o[1], o[2], o[3]); w.y = pk4_fp8(o[4], o[5], o[6], o[7]);
                *(u32x2*)(H + (size_t)r * FF + colo) = w; asm volatile("" ::: "memory"); }
    }
};
template <int ACT, bool HASBIAS, bool F8_ = false> struct EpiBf16 {
    static constexpr bool PREF = false, PERM = true, MIDK = false, F8 = F8_;
    bf16_t* O; int ldc; const float* bias; int bias_stride; float scale;
    __device__ __forceinline__ void operator()(const f32x4 (&acc)[2][2][4][2], const Unit& u, int wr, int wc, int fr, int fq) const {
        const int row0 = u.pm * BM + wr * 64 + fr; const int col0 = u.pn * BM + wc * 32 + 8 * fq;
        f32x4 bv[2][2];
#pragma unroll
        for (int bj = 0; bj < 2; ++bj)
#pragma unroll
            for (int n = 0; n < 2; ++n) bv[bj][n] = HASBIAS ? *(const f32x4*)(bias + (size_t)u.e * bias_stride + col0 + bj * HALF + 4 * n) : (f32x4){0.f, 0.f, 0.f, 0.f};
#pragma unroll
        for (int ai = 0; ai < 2; ++ai)
#pragma unroll
            for (int m = 0; m < 4; ++m) { bf16_t* rowp = O + (size_t)(row0 + ai * HALF + m * 16) * ldc + col0;
#pragma unroll
                for (int bj = 0; bj < 2; ++bj) { f32x4 v0 = acc[ai][bj][m][0] * scale + bv[bj][0], v1 = acc[ai][bj][m][1] * scale + bv[bj][1];
                    if (ACT == 1) {
#pragma unroll
                        for (int j = 0; j < 4; ++j) { v0[j] = fsigmoid(v0[j]); v1[j] = fsigmoid(v1[j]); } }
                    u32x4 w; w.x = cvt_pk_bf16(v0[0], v0[1]); w.y = cvt_pk_bf16(v0[2], v0[3]); w.z = cvt_pk_bf16(v1[0], v1[1]); w.w = cvt_pk_bf16(v1[2], v1[3]);
                    *(u32x4*)(rowp + bj * HALF) = w; }
                asm volatile("" ::: "memory"); }
    }
};
struct EpiDownF8 {
    static constexpr bool PREF = false, PERM = true, MIDK = false, F8 = true;
    unsigned char* O; const float* bias;
    __device__ __forceinline__ void operator()(const f32x4 (&acc)[2][2][4][2], const Unit& u, int wr, int wc, int fr, int fq) const {
        const int row0 = u.pm * BM + wr * 64 + fr; const int col0 = u.pn * BM + wc * 32 + 8 * fq;
        f32x4 bv[2][2];
#pragma unroll
        for (int bj = 0; bj < 2; ++bj)
#pragma unroll
            for (int n = 0; n < 2; ++n) bv[bj][n] = *(const f32x4*)(bias + (size_t)u.e * D + col0 + bj * HALF + 4 * n);
#pragma unroll
        for (int ai = 0; ai < 2; ++ai)
#pragma unroll
            for (int m = 0; m < 4; ++m) { unsigned char* rowp = O + (size_t)(row0 + ai * HALF + m * 16) * D + col0;
#pragma unroll
                for (int bj = 0; bj < 2; ++bj) { const f32x4 v0 = acc[ai][bj][m][0] * (1.0f / 32.0f) + bv[bj][0], v1 = acc[ai][bj][m][1] * (1.0f / 32.0f) + bv[bj][1];
                    u32x2 w; w.x = pk4_fp8(v0[0], v0[1], v0[2], v0[3]); w.y = pk4_fp8(v1[0], v1[1], v1[2], v1[3]);
                    *(u32x2*)(rowp + bj * HALF) = w; }
                asm volatile("" ::: "memory"); }
    }
};
}
__device__ __forceinline__ void transpose_item(const float* __restrict__ W, int ldw, int k0, int n_src0, bf16_t* __restrict__ WT, int ldo, int n_dst0, int k_off, LAS float* scr, int lane) {
    { float t_[32]; const float* wp_ = W + (size_t)(k0 + (lane >> 5)) * ldw + n_src0 + (lane & 31);
#pragma unroll
    for (int i = 0; i < 32; ++i) t_[i] = __builtin_nontemporal_load(wp_ + (size_t)(2 * i) * ldw);
#pragma unroll
    for (int i = 0; i < 32; ++i) scr[(2 * i + (lane >> 5)) * 33 + (lane & 31)] = t_[i]; }
    LDS_WAIT(); asm volatile("" ::: "memory");
    const int c = lane & 7;
#pragma unroll
    for (int j = 0; j < 4; ++j) { const int n = (lane >> 3) + 8 * j; const LAS float* s = scr + (8 * c) * 33 + n;
        u32x4 o; o.x = cvt_pk_bf16(s[0 * 33], s[1 * 33]); o.y = cvt_pk_bf16(s[2 * 33], s[3 * 33]); o.z = cvt_pk_bf16(s[4 * 33], s[5 * 33]); o.w = cvt_pk_bf16(s[6 * 33], s[7 * 33]);
        *(u32x4*)(WT + (size_t)(n_dst0 + n) * ldo + k_off + k0 + 8 * c) = o; }
    LDS_WAIT(); asm volatile("" ::: "memory");
}
__device__ __forceinline__ void transpose_item_f8(const float* __restrict__ W, int ldw, int k0, int n_src0, unsigned char* __restrict__ WT, int ldo, int n_dst0, float sc, LAS float* scr, int lane) {
    { float t_[32]; const float* wp_ = W + (size_t)(k0 + (lane >> 5)) * ldw + n_src0 + (lane & 31);
#pragma unroll
    for (int i = 0; i < 32; ++i) t_[i] = __builtin_nontemporal_load(wp_ + (size_t)(2 * i) * ldw);
#pragma unroll
    for (int i = 0; i < 32; ++i) scr[(2 * i + (lane >> 5)) * 33 + (lane & 31)] = t_[i]; }
    LDS_WAIT(); asm volatile("" ::: "memory");
    const int c = lane & 7;
#pragma unroll
    for (int j = 0; j < 4; ++j) { const int n = (lane >> 3) + 8 * j; const LAS float* s = scr + (8 * c) * 33 + n;
        u32x2 o; o.x = pk4_fp8(s[0 * 33] * sc, s[1 * 33] * sc, s[2 * 33] * sc, s[3 * 33] * sc); o.y = pk4_fp8(s[4 * 33] * sc, s[5 * 33] * sc, s[6 * 33] * sc, s[7 * 33] * sc);
        *(u32x2*)(WT + (size_t)(n_dst0 + n) * ldo + k0 + 8 * c) = o; }
    LDS_WAIT(); asm volatile("" ::: "memory");
}
__device__ __forceinline__ void transpose_mat_item(const float* W, int ldw, int N, int n_src_base, bf16_t* WT, int ldo, int n_dst_base, int k_off, LAS float* scr, int item, int lane) {
    const int nblk = N / 32, kb = item / nblk, nb = item % nblk;
    transpose_item(W, ldw, 64 * kb, n_src_base + 32 * nb, WT, ldo, n_dst_base + 32 * nb, k_off, scr, lane);
}

struct P {
    const float* in[25]; float* out; unsigned char* ws;
};

__device__ __forceinline__ void p0_prologue(const P& a, LAS unsigned char* lds, int vcu, int G, int wave, int lane) {
    LAS float* scr = (LAS float*)(lds + wave * 16384);
    const int gw = vcu * NWAVES + wave, NGW = G * NWAVES;
    unsigned char* ws = a.ws;
    bf16_t* WinT = (bf16_t*)(ws + WS_WIN);
    constexpr int I_A = 16 * 96, I_B8 = 16 * 160, I_B = 0;
    constexpr int NITEMS = I_A + I_B8 + I_B;
#ifndef P0_PARTS
#define P0_PARTS 63
#endif
    if (P0_PARTS & 1)
    for (int it = gw; it < NITEMS; it += NGW) {
        int r = it;
        if (r < I_A) { transpose_mat_item(a.in[4], D_IN, 3072, 0, WinT, D, 0, 0, scr, r, lane); continue; } r -= I_A;
        if (r < I_B8) { const int kb = r / 160, nb = r % 160; transpose_item_f8(a.in[4], D_IN, 64 * kb, 3088 + 32 * nb, ws + WS_WIN8, D, 32 * nb, 32.0f, scr, lane); continue; } r -= I_B8;
    }
    if (P0_PARTS & 2) {
        const float* x = a.in[0]; const float* g = a.in[3]; bf16_t* H = (bf16_t*)(ws + WS_H);
        f32x4 gv[4];
#pragma unroll
        for (int j = 0; j < 4; ++j) gv[j] = *((const f32x4*)g + lane + 64 * j);
        f32x4 va[4], vb[4];
#define H_LOAD(m_, V) do { if ((m_) < T) { const f32x4* xr = (const f32x4*)(x + (size_t)(m_) * D) + lane; _Pragma("unroll") for (int j = 0; j < 4; ++j) V[j] = __builtin_nontemporal_load(xr + 64 * j); } } while (0)
#define H_DO(m_, V) do { if ((m_) < T) { float s_ = 0.f; \
            _Pragma("unroll") for (int j = 0; j < 4; ++j) s_ += (V[j].x * V[j].x + V[j].y * V[j].y) + (V[j].z * V[j].z + V[j].w * V[j].w); \
            const float rstd = 1.0f / sqrtf(wave_sum(s_) * (1.0f / D) + EPS); \
            u32x2* o8 = (u32x2*)(H + (size_t)(m_) * D) + lane; unsigned* q8 = (unsigned*)(ws + WS_H8 + (size_t)(m_) * D) + lane; \
            _Pragma("unroll") for (int j = 0; j < 4; ++j) { const f32x4 y = V[j] * rstd * gv[j]; u32x2 w; w.x = cvt_pk_bf16(y.x, y.y); w.y = cvt_pk_bf16(y.z, y.w); o8[64 * j] = w; q8[64 * j] = pk4_fp8(y.x, y.y, y.z, y.w); } } } while (0)
        H_LOAD(gw, va);
        for (int m = gw; m < T; m += 2 * NGW) { H_LOAD(m + NGW, vb); H_DO(m, va); H_LOAD(m + 2 * NGW, va); H_DO(m + NGW, vb); }
#undef H_LOAD
#undef H_DO
    }
    if (P0_PARTS & 8) {
        const int gt = (vcu * NWAVES + wave) * 64 + lane;
        if ((P0_PARTS & 16) && gt < 16 * 1024) { const int n = gt >> 10, k = gt & 1023; ((bf16_t*)(ws + WS_WALT))[n * 1024 + k] = (bf16_t)(cvt_pk_bf16(a.in[4][(size_t)k * D_IN + SRC_ALOW + n], 0.f) & 0xffffu); }
        if ((P0_PARTS & 32) && gt < 4096) { const int s = gt >> 6, l = gt & 63, e = l & 31, hh = l >> 5; const float* wr = a.in[12];
            float v[8], lo[8];
#pragma unroll
            for (int j = 0; j < 8; ++j) { v[j] = wr[(size_t)(16 * s + 8 * hh + j) * NE + e] * a.in[11][16 * s + 8 * hh + j]; }
            u32x4 whi; whi.x = cvt_pk_bf16(v[0], v[1]); whi.y = cvt_pk_bf16(v[2], v[3]); whi.z = cvt_pk_bf16(v[4], v[5]); whi.w = cvt_pk_bf16(v[6], v[7]);
#pragma unroll
            for (int j = 0; j < 4; ++j) { lo[2 * j] = v[2 * j] - bflo(whi[j]); lo[2 * j + 1] = v[2 * j + 1] - bfhi(whi[j]); }
            u32x4 wlo; wlo.x = cvt_pk_bf16(lo[0], lo[1]); wlo.y = cvt_pk_bf16(lo[2], lo[3]); wlo.z = cvt_pk_bf16(lo[4], lo[5]); wlo.w = cvt_pk_bf16(lo[6], lo[7]);
            u32x4* f = (u32x4*)(ws + WS_WRF); f[gt] = whi; f[4096 + gt] = wlo; }
    }
}

__device__ __forceinline__ void late_prep(const P& a, LAS unsigned char* lds, int ci, int ncv, int wave, int lane) {
    LAS float* scr = (LAS float*)(lds + wave * 16384);
    const int gw = ci * NWAVES + wave, NGW = ncv * NWAVES;
    unsigned char* ws = a.ws;
    bf16_t* WupT = (bf16_t*)(ws + WS_WUP); bf16_t* WoT = (bf16_t*)(ws + WS_WO); bf16_t* WpgT = (bf16_t*)(ws + WS_WPG); bf16_t* WppT = (bf16_t*)(ws + WS_WPP);
    constexpr int I_S = 16 * 32, I_P = 4 * 32;
    for (int it = gw; it < 4 * I_S + I_P; it += NGW) {
        int r = it;
        if (r < I_S) { transpose_mat_item(a.in[8], D, D, 0, WupT, 2048, 0, 0, scr, r, lane); continue; } r -= I_S;
        if (r < I_S) { transpose_mat_item(a.in[9], D, D, 0, WupT, 2048, 0, 1024, scr, r, lane); continue; } r -= I_S;
        if (r < I_S) { transpose_mat_item(a.in[10], D, D, 0, WoT, D, 0, 0, scr, r, lane); continue; } r -= I_S;
        if (r < I_S) { const int kb = r / 32, nb = r % 32; transpose_item_f8(a.in[21], D, 64 * kb, 32 * nb, (unsigned char*)WpgT, D, 32 * nb, 32.0f, scr, lane); continue; } r -= I_S;
        transpose_mat_item(a.in[22], D, D, 0, WppT, 256, 0, 0, scr, r, lane);
    }
    const f32x4* p4 = (const f32x4*)a.in[1]; u32x2* pb = (u32x2*)(ws + WS_PB);
    const size_t n4 = (size_t)T * 256 / 4;
    for (size_t i = (size_t)gw * 64 + lane; i < n4; i += (size_t)NGW * 64) { const f32x4 v = __builtin_nontemporal_load(p4 + i); u32x2 w; w.x = cvt_pk_bf16(v.x, v.y); w.y = cvt_pk_bf16(v.z, v.w); pb[i] = w; }
}

struct CvtItem { const float* src; unsigned char* dst; int ldo; const float* gs; };
__device__ __forceinline__ CvtItem cvt_item(const P& a, int it, int lane) {
    constexpr int IPM = 16 * 32;
    const int e = it / (3 * IPM), r0 = it % (3 * IPM), which = r0 / IPM, r = r0 % IPM, kb = r / 32, nb = r % 32, n0 = 32 * nb;
    CvtItem c;
    if (which < 2) { c.src = a.in[which == 0 ? 14 : 16] + (size_t)e * D * FF + (size_t)(64 * kb + (lane >> 5)) * FF + n0 + (lane & 31);
        c.dst = (unsigned char*)a.out + ((size_t)e * 2048 + (n0 >> 7) * 256 + (n0 & 127) + which * 128) * D + 64 * kb; c.ldo = D; c.gs = a.in[11] + 64 * kb; }
    else { c.src = a.in[18] + (size_t)e * FF * D + (size_t)(64 * kb + (lane >> 5)) * D + n0 + (lane & 31);
        c.dst = a.ws + WS_W2T + ((size_t)e * D + n0) * FF + 64 * kb; c.ldo = FF; c.gs = nullptr; }
    return c;
}
__device__ __forceinline__ void expert_convert(const P& a, LAS unsigned char* lds, int vcu, int G, int wave, int lane) {
    LAS float* scr = (LAS float*)(lds + wave * 16384);
    const int gw = vcu * NWAVES + wave, NGW = G * NWAVES;
    constexpr int NIT = NE * 3 * 16 * 32;
    if (gw >= NIT) return;
    float tA[32], tB[32];
    CvtItem cA = cvt_item(a, gw, lane), cB = cvt_item(a, gw + NGW < NIT ? gw + NGW : gw, lane);
    f32x4 gA0, gA1, gB0, gB1;
#define CVT_G(c_, G0, G1) do { G0 = (f32x4){1.0f, 1.0f, 1.0f, 1.0f}; G1 = G0; if ((c_).gs) { G0 = *(const f32x4*)((c_).gs + 8 * (lane & 7)); G1 = *(const f32x4*)((c_).gs + 8 * (lane & 7) + 4); } } while (0)
    CVT_G(cA, gA0, gA1); CVT_G(cB, gB0, gB1);
#pragma unroll
    for (int i = 0; i < 32; ++i) tA[i] = __builtin_nontemporal_load(cA.src + (size_t)(2 * i) * 1024);
#pragma unroll
    for (int i = 0; i < 32; ++i) tB[i] = __builtin_nontemporal_load(cB.src + (size_t)(2 * i) * 1024);
#define CVT_OUT(c_, H0, H1) do { LDS_WAIT(); asm volatile("" ::: "memory"); const int c = lane & 7; const f32x4 ga_ = (H0) * 32.0f, gb_ = (H1) * 32.0f; \
        _Pragma("unroll") for (int j = 0; j < 4; ++j) { const int n = (lane >> 3) + 8 * j; const LAS float* s = scr + (8 * c) * 33 + n; \
            u32x2 o; o.x = pk4_fp8(s[0 * 33] * ga_[0], s[1 * 33] * ga_[1], s[2 * 33] * ga_[2], s[3 * 33] * ga_[3]); o.y = pk4_fp8(s[4 * 33] * gb_[0], s[5 * 33] * gb_[1], s[6 * 33] * gb_[2], s[7 * 33] * gb_[3]); \
            __builtin_nontemporal_store(o, (u32x2*)((c_).dst + (size_t)n * (c_).ldo + 8 * c)); } \
        LDS_WAIT(); asm volatile("" ::: "memory"); } while (0)
    for (int it = gw; it < NIT; it += 2 * NGW) {
#pragma unroll
        for (int i = 0; i < 32; ++i) scr[(2 * i + (lane >> 5)) * 33 + (lane & 31)] = tA[i];
        const CvtItem dA = cA; const f32x4 hA0 = gA0, hA1 = gA1; const int n2 = it + 2 * NGW;
        if (n2 < NIT) { cA = cvt_item(a, n2, lane);
#pragma unroll
            for (int i = 0; i < 32; ++i) tA[i] = __builtin_nontemporal_load(cA.src + (size_t)(2 * i) * 1024);
            CVT_G(cA, gA0, gA1); }
        CVT_OUT(dA, hA0, hA1);
        if (it + NGW >= NIT) break;
#pragma unroll
        for (int i = 0; i < 32; ++i) scr[(2 * i + (lane >> 5)) * 33 + (lane & 31)] = tB[i];
        const CvtItem dB = cB; const f32x4 hB0 = gB0, hB1 = gB1; const int n3 = it + 3 * NGW;
        if (n3 < NIT) { cB = cvt_item(a, n3, lane);
#pragma unroll
            for (int i = 0; i < 32; ++i) tB[i] = __builtin_nontemporal_load(cB.src + (size_t)(2 * i) * 1024);
            CVT_G(cB, gB0, gB1); }
        CVT_OUT(dB, hB0, hB1);
    }
#undef CVT_OUT
#undef CVT_G
}

__device__ __forceinline__ float fexp_(float x) { return __builtin_amdgcn_exp2f(x * 1.4426950408889634f); }
__device__ __forceinline__ float logsigmoidf_(float x) { const float e = fexp_(-fabsf(x)); return fminf(x, 0.0f) - 0.6931471805599453f * __builtin_amdgcn_logf(1.0f + e); }
__device__ __forceinline__ void gla_prep_unit(const P& a, LAS unsigned char* lds, int unit) {
    int tid = threadIdx.x; asm volatile("" : "+v"(tid));     const int wave = __builtin_amdgcn_readfirstlane(tid >> 6), lane = tid & 63;
    const int b = unit >> 5, chunk = unit & 31, tok0 = b * SEQ + chunk * 64;
    const bf16_t* H = (const bf16_t*)(a.ws + WS_H); const bf16_t* WalT = (const bf16_t*)(a.ws + WS_WALT); const bf16_t* proj = (const bf16_t*)(a.ws + WS_PROJ);
    LAS float* part = (LAS float*)lds;
    LAS float* alow = (LAS float*)(lds + 8192);
    LAS float* seg = (LAS float*)(lds + 12288);
    constexpr int GP_KDT = 16384, GP_VT = 34816;
    {
        const int rg = wave & 3, kh = wave >> 2, r = lane & 15, q = lane >> 4;
        f32x4 acc = (f32x4){0.f, 0.f, 0.f, 0.f};
        const bf16_t* ap = H + (size_t)(tok0 + 16 * rg + r) * D + 512 * kh + 8 * q; const bf16_t* bp = WalT + (size_t)r * D + 512 * kh + 8 * q;
#pragma unroll 8
        for (int s = 0; s < 16; ++s) { const bf16x8 av = *(const bf16x8*)(ap + 32 * s), bv = *(const bf16x8*)(bp + 32 * s); acc = __builtin_amdgcn_mfma_f32_16x16x32_bf16(bv, av, acc, 0, 0, 0); }
        *(LAS f32x4*)(part + (kh * 64 + 16 * rg + r) * 16 + 4 * q) = acc;
    }
    __syncthreads();
    if (tid < 256) { *(LAS f32x4*)(alow + tid * 4) = *(LAS f32x4*)(part + tid * 4) + *(LAS f32x4*)(part + 1024 + tid * 4); }
    __syncthreads();
    const int dp = tid & 63, tq = wave;
    const float* w_a2 = a.in[5]; const float* b_a2 = a.in[6];
    const int ep = tid & 127, sq4 = tid >> 7;
    f32x2 w2[16], w2n[16]; f32x2 b2, b2n; unsigned qv[8], kv[8], qvn[8], kvn[8], sv[16], svn[16];
#define GP_LOADS(h_, W2, B2, QV, KV, SV) do { const int dc_ = (h_) * 128 + 2 * dp; \
        _Pragma("unroll") for (int r = 0; r < 16; ++r) W2[r] = *(const f32x2*)(w_a2 + r * 512 + dc_); \
        B2 = *(const f32x2*)(b_a2 + dc_); \
        _Pragma("unroll") for (int i = 0; i < 8; ++i) { const bf16_t* rp = proj + PROJ_BLK((h_) * 128) + (size_t)(tok0 + 8 * tq + i) * 128 + 2 * dp; QV[i] = __builtin_nontemporal_load((const unsigned*)(rp + PROJ_BLK(C_QA))); KV[i] = __builtin_nontemporal_load((const unsigned*)(rp + PROJ_BLK(C_KA))); } \
        const bf16_t* v_ = proj + PROJ_BLK(C_VA + (h_) * 256) + (size_t)(tok0 + 16 * sq4) * 256 + 2 * ep; \
        _Pragma("unroll") for (int i = 0; i < 16; ++i) SV[i] = __builtin_nontemporal_load((const unsigned*)(v_ + (size_t)i * 256)); } while (0)
    GP_LOADS(0, w2, b2, qv, kv, sv);
    for (int h = 0; h < 4; ++h) {
        if (h + 1 < 4) GP_LOADS(h + 1, w2n, b2n, qvn, kvn, svn);
        float G0[8], G1[8]; float r0 = 0.f, r1 = 0.f;
#pragma unroll
        for (int i = 0; i < 8; ++i) { const LAS f32x4* al4 = (const LAS f32x4*)(alow + (8 * tq + i) * 16); float x0 = b2.x, x1 = b2.y;
#pragma unroll
            for (int r4 = 0; r4 < 4; ++r4) { const f32x4 al = al4[r4];
#pragma unroll
                for (int j = 0; j < 4; ++j) { x0 += al[j] * w2[4 * r4 + j].x; x1 += al[j] * w2[4 * r4 + j].y; } }
            r0 += logsigmoidf_(x0) * (1.0f / 16.0f); r1 += logsigmoidf_(x1) * (1.0f / 16.0f); G0[i] = r0; G1[i] = r1; }
        *(LAS f32x2*)(seg + tq * 128 + 2 * dp) = (f32x2){r0, r1};
        __syncthreads();
        float off0 = 0.f, off1 = 0.f, tot0 = 0.f, tot1 = 0.f;
#pragma unroll
        for (int q = 0; q < 8; ++q) { const f32x2 s = *(LAS f32x2*)(seg + q * 128 + 2 * dp); tot0 += s.x; tot1 += s.y; if (q < tq) { off0 += s.x; off1 += s.y; } }
        const size_t tile = (size_t)((b * 4 + h) * 32 + chunk);
        bf16_t* Qg = (bf16_t*)(a.ws + WS_QG) + tile * 8192; bf16_t* Kg = (bf16_t*)(a.ws + WS_KG) + tile * 8192;
        float kd0[8], kd1[8];
#pragma unroll
        for (int i = 0; i < 8; ++i) { const float g0 = G0[i] + off0, g1 = G1[i] + off1; const float q0 = bflo(qv[i]), q1 = bfhi(qv[i]), k0 = bflo(kv[i]), k1 = bfhi(kv[i]);
            const float e0 = fexp_(g0), e1 = fexp_(g1);
            *(unsigned*)(Qg + (8 * tq + i) * 128 + 2 * dp) = cvt_pk_bf16(q0 * e0 * 0.08838834764831845f, q1 * e1 * 0.08838834764831845f);
            *(unsigned*)(Kg + (8 * tq + i) * 128 + 2 * dp) = cvt_pk_bf16(k0 * __builtin_amdgcn_rcpf(e0), k1 * __builtin_amdgcn_rcpf(e1));
            kd0[i] = k0 * fexp_(tot0 - g0); kd1[i] = k1 * fexp_(tot1 - g1); }
        u32x4 w0, w1; w0.x = cvt_pk_bf16(kd0[0], kd0[1]); w0.y = cvt_pk_bf16(kd0[2], kd0[3]); w0.z = cvt_pk_bf16(kd0[4], kd0[5]); w0.w = cvt_pk_bf16(kd0[6], kd0[7]);
        w1.x = cvt_pk_bf16(kd1[0], kd1[1]); w1.y = cvt_pk_bf16(kd1[2], kd1[3]); w1.z = cvt_pk_bf16(kd1[4], kd1[5]); w1.w = cvt_pk_bf16(kd1[6], kd1[7]);
        *(LAS u32x4*)(lds + GP_KDT + (2 * dp) * 144 + 16 * tq) = w0; *(LAS u32x4*)(lds + GP_KDT + (2 * dp + 1) * 144 + 16 * tq) = w1;
        if (tq == 0) *(f32x2*)((float*)(a.ws + WS_DEC) + tile * 128 + 2 * dp) = (f32x2){fexp_(tot0), fexp_(tot1)};
        {
            u32x4 lo0, lo1, hi0, hi1;
#pragma unroll
            for (int j = 0; j < 4; ++j) { lo0[j] = (sv[2 * j] & 0xffffu) | (sv[2 * j + 1] << 16); lo1[j] = (sv[8 + 2 * j] & 0xffffu) | (sv[8 + 2 * j + 1] << 16);
                hi0[j] = (sv[2 * j] >> 16) | (sv[2 * j + 1] & 0xffff0000u); hi1[j] = (sv[8 + 2 * j] >> 16) | (sv[8 + 2 * j + 1] & 0xffff0000u); }
            LAS unsigned char* v0 = lds + GP_VT + (2 * ep) * 144 + sq4 * 32;
            *(LAS u32x4*)(v0) = lo0; *(LAS u32x4*)(v0 + 16) = lo1; *(LAS u32x4*)(v0 + 144) = hi0; *(LAS u32x4*)(v0 + 144 + 16) = hi1;
        }
        __syncthreads();
        {
            const int c32 = lane & 31, hi = lane >> 5;
            bf16x8 vt[4];
#pragma unroll
            for (int ks = 0; ks < 4; ++ks) vt[ks] = *(const LAS bf16x8*)(lds + GP_VT + (32 * wave + c32) * 144 + (16 * ks + 8 * hi) * 2);
            unsigned* sl = (unsigned*)a.out + tile * 8192;
#pragma unroll
            for (int tl = 0; tl < 4; ++tl) { f32x16 acc;
#pragma unroll
                for (int r = 0; r < 16; ++r) acc[r] = 0.f;
#pragma unroll
                for (int ks = 0; ks < 4; ++ks) { const bf16x8 av = *(const LAS bf16x8*)(lds + GP_KDT + (32 * tl + c32) * 144 + (16 * ks + 8 * hi) * 2); acc = __builtin_amdgcn_mfma_f32_32x32x16_bf16(av, vt[ks], acc, 0, 0, 0); }
#pragma unroll
                for (int g = 0; g < 4; ++g) sl[((tl * 4 + g) * 2 + hi) * 256 + 32 * wave + c32] = pk4_fp8(acc[4 * g], acc[4 * g + 1], acc[4 * g + 2], acc[4 * g + 3]); }
        }
        __syncthreads();
#pragma unroll
        for (int r = 0; r < 16; ++r) { w2[r] = w2n[r]; sv[r] = svn[r]; }
#pragma unroll
        for (int i = 0; i < 8; ++i) { qv[i] = qvn[i]; kv[i] = kvn[i]; }
        b2 = b2n;
    }
#undef GP_LOADS
}

__device__ __forceinline__ void gla_combine_unit(const P& a, int unit) {
    const int tid = threadIdx.x, bh = unit >> 4, i8 = (unit & 15) * 512 + tid;
    const int d0 = 32 * (i8 >> 11) + 8 * ((i8 >> 9) & 3) + 4 * ((i8 >> 8) & 1);
    const unsigned* sl8 = (const unsigned*)a.out + (size_t)bh * 32 * 8192 + i8; u32x2* sl = (u32x2*)(a.ws + WS_SLOC) + (size_t)bh * 32 * 8192 + i8;
    const f32x4* dc = (const f32x4*)((const float*)(a.ws + WS_DEC) + (size_t)bh * 32 * 128 + d0);
    f32x4 s = (f32x4){0.f, 0.f, 0.f, 0.f};
    for (int cb = 0; cb < 32; cb += 8) {
        unsigned loc[8]; f32x4 dv[8];
#pragma unroll
        for (int i = 0; i < 8; ++i) { loc[i] = __builtin_nontemporal_load(sl8 + (size_t)(cb + i) * 8192); dv[i] = dc[(cb + i) * 32]; }
#pragma unroll
        for (int i = 0; i < 8; ++i) { if (cb + i < 31) {
            s.x = dv[i].x * s.x + __builtin_amdgcn_cvt_f32_fp8((int)loc[i], 0); s.y = dv[i].y * s.y + __builtin_amdgcn_cvt_f32_fp8((int)loc[i], 1);
            s.z = dv[i].z * s.z + __builtin_amdgcn_cvt_f32_fp8((int)loc[i], 2); s.w = dv[i].w * s.w + __builtin_amdgcn_cvt_f32_fp8((int)loc[i], 3);
            u32x2 w; w.x = cvt_pk_bf16(s.x, s.y); w.y = cvt_pk_bf16(s.z, s.w); sl[(size_t)(cb + i) * 8192] = w; } }
    }
}

constexpr int GL_QG = 0, GL_KG = 17408, GL_VT = 53248, GL_AM = 90112, GL_OST = 0;
constexpr int GL_QS = 272, GL_TS = 144, GL_OS = 528;
__device__ __forceinline__ int crow(int r, int hi) { return (r & 3) + 8 * (r >> 2) + 4 * hi; }
struct GlaIn { u32x4 sq[2], sk[2]; unsigned sv[16]; u32x2 sf[4][2][2]; u32x4 ra[4]; };
__device__ __forceinline__ void gla_out_load(const P& a, int unit, GlaIn& R) {
    int tid = threadIdx.x; asm volatile("" : "+v"(tid)); const int w = __builtin_amdgcn_readfirstlane(tid >> 6), lane = tid & 63, c32 = lane & 31, hi = lane >> 5;
    const int bh = unit >> 5, chunk = unit & 31, b = bh >> 2, h = bh & 3;
    const bf16_t* proj = (const bf16_t*)(a.ws + WS_PROJ);
    const size_t tile = (size_t)bh * 32 + chunk;
    const u32x4* q_ = (const u32x4*)((const bf16_t*)(a.ws + WS_QG) + tile * 8192); const u32x4* k_ = (const u32x4*)((const bf16_t*)(a.ws + WS_KG) + tile * 8192);
    R.sq[0] = __builtin_nontemporal_load(q_ + tid); R.sq[1] = __builtin_nontemporal_load(q_ + tid + 512); R.sk[0] = __builtin_nontemporal_load(k_ + tid); R.sk[1] = __builtin_nontemporal_load(k_ + tid + 512);
    const int ep = tid & 127, sq4 = tid >> 7;
    const bf16_t* v_ = proj + PROJ_BLK(C_VA + h * 256) + (size_t)(b * SEQ + chunk * 64 + 16 * sq4) * 256 + 2 * ep;
#pragma unroll
    for (int i = 0; i < 16; ++i) R.sv[i] = __builtin_nontemporal_load((const unsigned*)(v_ + (size_t)i * 256));
    if (chunk > 0) { const u32x2* sl = (const u32x2*)(a.ws + WS_SLOC) + (tile - 1) * 8192;
#pragma unroll
        for (int tl = 0; tl < 4; ++tl)
#pragma unroll
            for (int s = 0; s < 2; ++s)
#pragma unroll
                for (int q = 0; q < 2; ++q) R.sf[tl][s][q] = __builtin_nontemporal_load(sl + ((tl * 4 + 2 * s + q) * 2 + hi) * 256 + 32 * w + c32); }
    const bf16_t* rap = proj + PROJ_BLK(C_RA + h * 256) + (size_t)(b * SEQ + chunk * 64 + (tid >> 3)) * 256 + (tid & 7) * 32;
#pragma unroll
    for (int j = 0; j < 4; ++j) R.ra[j] = __builtin_nontemporal_load((const u32x4*)(rap + 8 * j));
}
__device__ __forceinline__ void gla_out_unit(const P& a, LAS unsigned char* lds, int unit, const GlaIn& R) {
    int tid = threadIdx.x; asm volatile("" : "+v"(tid)); const int w = __builtin_amdgcn_readfirstlane(tid >> 6), lane = tid & 63, c32 = lane & 31, hi = lane >> 5;
    const int bh = unit >> 5, chunk = unit & 31, b = bh >> 2, h = bh & 3;
    const bf16_t* proj = (const bf16_t*)(a.ws + WS_PROJ); bf16_t* oab = (bf16_t*)(a.ws + WS_OAB); const float* ggo = a.in[7];
    const size_t tile = (size_t)bh * 32 + chunk;
    {
        const u32x4* sq = R.sq; const u32x4* sk = R.sk; const unsigned* sv = R.sv;
        const int ep = tid & 127, sq4 = tid >> 7;
#pragma unroll
        for (int i = 0; i < 2; ++i) { const int p = tid + 512 * i;
            *(LAS u32x4*)(lds + GL_QG + (p >> 4) * GL_QS + (p & 15) * 16) = sq[i]; *(LAS u32x4*)(lds + GL_KG + (p >> 4) * GL_QS + (p & 15) * 16) = sk[i]; }
        u32x4 lo0, lo1, hi0, hi1;
#pragma unroll
        for (int j = 0; j < 4; ++j) { lo0[j] = (sv[2 * j] & 0xffffu) | (sv[2 * j + 1] << 16); lo1[j] = (sv[8 + 2 * j] & 0xffffu) | (sv[8 + 2 * j + 1] << 16);
            hi0[j] = (sv[2 * j] >> 16) | (sv[2 * j + 1] & 0xffff0000u); hi1[j] = (sv[8 + 2 * j] >> 16) | (sv[8 + 2 * j + 1] & 0xffff0000u); }
        LAS unsigned char* v0 = lds + GL_VT + (2 * ep) * GL_TS + sq4 * 32;
        *(LAS u32x4*)(v0) = lo0; *(LAS u32x4*)(v0 + 16) = lo1; *(LAS u32x4*)(v0 + GL_TS) = hi0; *(LAS u32x4*)(v0 + GL_TS + 16) = hi1;
    }
    __syncthreads();
    if (w < 3) {
        const int ti = (w + 1) >> 1, si = w >> 1;
        f32x16 A;
#pragma unroll
        for (int r = 0; r < 16; ++r) A[r] = 0.f;
#pragma unroll
        for (int s = 0; s < 8; ++s) { const bf16x8 av = *(const LAS bf16x8*)(lds + GL_QG + (32 * ti + c32) * GL_QS + (16 * s + 8 * hi) * 2), bv = *(const LAS bf16x8*)(lds + GL_KG + (32 * si + c32) * GL_QS + (16 * s + 8 * hi) * 2);
            A = __builtin_amdgcn_mfma_f32_32x32x16_bf16(av, bv, A, 0, 0, 0); }
        const int sidx = 32 * si + c32;
#pragma unroll
        for (int r = 0; r < 16; ++r) { const int t = 32 * ti + crow(r, hi); const float v = (sidx <= t) ? A[r] : 0.f;
            *(LAS bf16_t*)(lds + GL_AM + t * GL_TS + sidx * 2) = (bf16_t)(cvt_pk_bf16(v, 0.f) & 0xffffu); }
    }
    __syncthreads();
    f32x16 o[2];
    {
        bf16x8 vt[4];
#pragma unroll
        for (int ks = 0; ks < 4; ++ks) vt[ks] = *(const LAS bf16x8*)(lds + GL_VT + (32 * w + c32) * GL_TS + (16 * ks + 8 * hi) * 2);
#pragma unroll
        for (int ti = 0; ti < 2; ++ti) {
#pragma unroll
            for (int r = 0; r < 16; ++r) o[ti][r] = 0.f;
            if (chunk > 0) {
#pragma unroll
                for (int tl = 0; tl < 4; ++tl)
#pragma unroll
                    for (int s = 0; s < 2; ++s) { const LAS unsigned char* qp = lds + GL_QG + (32 * ti + c32) * GL_QS + (32 * tl + 16 * s + 4 * hi) * 2;
                        const s16x4 lo = *(const LAS s16x4*)qp, hh = *(const LAS s16x4*)(qp + 16);
                        const bf16x8 aop = __builtin_shufflevector(lo, hh, 0, 1, 2, 3, 4, 5, 6, 7);
                        const u32x4 bw = {R.sf[tl][s][0].x, R.sf[tl][s][0].y, R.sf[tl][s][1].x, R.sf[tl][s][1].y};
                        o[ti] = __builtin_amdgcn_mfma_f32_32x32x16_bf16(aop, __builtin_bit_cast(bf16x8, bw), o[ti], 0, 0, 0); }
            }
#pragma unroll
            for (int ks = 0; ks < 4; ++ks) { if (ti == 0 && ks >= 2) continue;
                const bf16x8 av = *(const LAS bf16x8*)(lds + GL_AM + (32 * ti + c32) * GL_TS + (16 * ks + 8 * hi) * 2);
                o[ti] = __builtin_amdgcn_mfma_f32_32x32x16_bf16(av, vt[ks], o[ti], 0, 0, 0); }
        }
    }
    __syncthreads();
#pragma unroll
    for (int ti = 0; ti < 2; ++ti)
#pragma unroll
        for (int r = 0; r < 16; ++r) *(LAS bf16_t*)(lds + GL_OST + (32 * ti + crow(r, hi)) * GL_OS + (32 * w + c32) * 2) = (bf16_t)(cvt_pk_bf16(o[ti][r], 0.f) & 0xffffu);
    __syncthreads();
    {
        const int t = tid >> 3, sg = tid & 7; const size_t tok = (size_t)(b * SEQ + chunk * 64 + t);
        u32x4 ov[4]; float ss = 0.f;
#pragma unroll
        for (int j = 0; j < 4; ++j) { ov[j] = *(const LAS u32x4*)(lds + GL_OST + t * GL_OS + sg * 64 + j * 16);
#pragma unroll
            for (int i = 0; i < 4; ++i) { const float x0 = bflo(ov[j][i]), x1 = bfhi(ov[j][i]); ss += x0 * x0 + x1 * x1; } }
        ss += __shfl_xor(ss, 1); ss += __shfl_xor(ss, 2); ss += __shfl_xor(ss, 4);
        const float rstd = 1.0f / sqrtf(ss * (1.0f / 256.0f) + EPS);
        bf16_t* op = oab + tok * 2048 + h * 256 + sg * 32; const float* gp = ggo + sg * 32;
#pragma unroll
        for (int j = 0; j < 4; ++j) { const u32x4 ra = R.ra[j]; const f32x4 g0 = *(const f32x4*)(gp + 8 * j), g1 = *(const f32x4*)(gp + 8 * j + 4); u32x4 wv;
#pragma unroll
            for (int i = 0; i < 4; ++i) { const float r0 = bflo(ra[i]), r1 = bfhi(ra[i]); const float ga = (i < 2) ? g0[2 * i] : g1[2 * i - 4], gb = (i < 2) ? g0[2 * i + 1] : g1[2 * i - 3];
                wv[i] = cvt_pk_bf16(bflo(ov[j][i]) * rstd * ga * (r0 * fsigmoid(r0)), bfhi(ov[j][i]) * rstd * gb * (r1 * fsigmoid(r1))); }
            *(u32x4*)(op + 8 * j) = wv; }
    }
    __syncthreads();
}
namespace moba {
constexpr int HD = 128;
constexpr float SCALE = 0.08838834764831845f;
constexpr float THR = 8.f;
constexpr int NW = 8, QBLK = 32, KVBLK = 64, QB = NW * QBLK;
constexpr int SHM_V = KVBLK * HD * 2, SHM_K = KVBLK * HD * 2;
constexpr int OFF_WS = 2 * SHM_V + 2 * SHM_K;
constexpr int OFF_RTAB = OFF_WS + NW * 64 * 4;
constexpr int OFF_KM = OFF_RTAB + 2400 * 4;
constexpr int OFF_MISC = OFF_KM + 8 * 128 * 4;
constexpr int OFF_SEL = OFF_MISC + 64;
constexpr int OFF_B32 = OFF_SEL + 2048;
constexpr int LDS_BYTES = OFF_B32 + 128;
constexpr int LDP = HD, LDO = 2048;

#define KSWZ(row, colB) ((row) * 256 + ((colB) ^ (((row) & 7) << 4)))
#define SBAR() __builtin_amdgcn_sched_barrier(0)
__device__ __forceinline__ int v_st(int k, int c) { const int kk = (k & ~0xC) | ((k & 4) << 1) | ((k & 8) >> 1); return ((kk >> 3) * 4 + (c >> 5)) * 512 + ((kk & 7) * 32 + (c & 31)) * 2; }
__device__ __forceinline__ int v_rd_base(int lane) { return ((lane & 3) << 3) | (((lane >> 2) & 3) << 6) | (((lane >> 4) & 1) << 5) | (((lane >> 5) & 1) << 8); }
constexpr int v_rd_off(int d0, int ks, int half) { return d0 * 512 + ks * 4096 + half * 2048; }
__device__ __forceinline__ int crow(int r, int hi) { return (r & 3) + 8 * (r >> 2) + 4 * hi; }
__device__ __forceinline__ unsigned cvtpk(float lo, float hi) { unsigned r; asm volatile("v_cvt_pk_bf16_f32 %0, %1, %2" : "=v"(r) : "v"(lo), "v"(hi)); return r; }

__device__ __forceinline__ void mask_tile(f32x16& p0, f32x16& p1, int dq) {
    const float NEG = -__builtin_inff();
#pragma unroll
    for (int r = 0; r < 16; ++r) {
        const int c = (r & 3) + 8 * (r >> 2);
        if (dq - c < 0) p0[r] = NEG;
        if (dq - c - 32 < 0) p1[r] = NEG;
    }
}
__device__ __forceinline__ void bias_tile(f32x16& p0, f32x16& p1, const LAS float* rt) {
#pragma unroll
    for (int r = 0; r < 16; ++r) { const int c = (r & 3) + 8 * (r >> 2); p0[r] += rt[c]; p1[r] += rt[c + 32]; }
}
__device__ __forceinline__ void kill_tile(f32x16& p0, f32x16& p1) {
    const float NEG = -__builtin_inff();
#pragma unroll
    for (int r = 0; r < 16; ++r) { p0[r] = NEG; p1[r] = NEG; }
}
__device__ __forceinline__ void partialSM(f32x16& p0, f32x16& p1, float& m_reg, float& mn, float& alpha) {
    float pmax = p0[0];
#pragma unroll
    for (int r = 1; r < 16; ++r) pmax = fmaxf(pmax, p0[r]);
#pragma unroll
    for (int r = 0; r < 16; ++r) pmax = fmaxf(pmax, p1[r]);
    { auto rr = __builtin_amdgcn_permlane32_swap(__float_as_uint(pmax), __float_as_uint(pmax), false, false);
      pmax = fmaxf(__uint_as_float(rr[0]), __uint_as_float(rr[1])); }
    constexpr float C2 = 1.4426950408889634f * SCALE;
    if (__builtin_expect(__all((pmax - m_reg) * SCALE <= THR), 1)) { mn = m_reg; alpha = 1.f; }
    else { mn = fmaxf(m_reg, pmax); alpha = __builtin_amdgcn_exp2f((m_reg - mn) * C2); m_reg = mn; }
    const float mnL = -mn * C2;
#pragma unroll
    for (int r = 0; r < 16; ++r) p0[r] = fmaf(p0[r], C2, mnL);
#pragma unroll
    for (int r = 0; r < 16; ++r) p1[r] = fmaf(p1[r], C2, mnL);
#pragma unroll
    for (int r = 0; r < 16; ++r) p0[r] = __builtin_amdgcn_exp2f(p0[r]);
}
__device__ __forceinline__ void finishSM(f32x16& p0, f32x16& p1, float alpha, float& l_reg, bf16x8& pa0, bf16x8& pa1, bf16x8& pa2, bf16x8& pa3) {
#pragma unroll
    for (int r = 0; r < 16; ++r) p1[r] = __builtin_amdgcn_exp2f(p1[r]);
    float ps = 0;
#pragma unroll
    for (int r = 0; r < 16; ++r) ps += p0[r];
#pragma unroll
    for (int r = 0; r < 16; ++r) ps += p1[r];
    { auto rr = __builtin_amdgcn_permlane32_swap(__float_as_uint(ps), __float_as_uint(ps), false, false);
      ps = __uint_as_float(rr[0]) + __uint_as_float(rr[1]); }
    l_reg = l_reg * alpha + ps;
#define PK4(P, B_, OUT) do { unsigned a0 = cvtpk(P[B_+0], P[B_+1]), a1 = cvtpk(P[B_+2], P[B_+3]);                          \
        unsigned b0 = cvtpk(P[B_+4], P[B_+5]), b1 = cvtpk(P[B_+6], P[B_+7]);                                             \
        auto r0 = __builtin_amdgcn_permlane32_swap(a0, b0, false, false); auto r1 = __builtin_amdgcn_permlane32_swap(a1, b1, false, false); \
        u32x4 w = {r0[0], r1[0], r0[1], r1[1]}; OUT = __builtin_bit_cast(bf16x8, w); } while (0)
    PK4(p0, 0, pa0); PK4(p0, 8, pa1); PK4(p1, 0, pa2); PK4(p1, 8, pa3);
#undef PK4
}
template <int KB>
__device__ __forceinline__ void qkt(f32x16& p0, f32x16& p1, const char* K_lds, int r32, int hi, const bf16x8* qr) {
#pragma unroll
    for (int r = 0; r < 16; ++r) { p0[r] = 0.f; p1[r] = 0.f; }
    const char* kb[4];
#pragma unroll
    for (int dd = 0; dd < 4; ++dd) kb[dd] = K_lds + KB * SHM_K + KSWZ(r32, (dd * 16 + hi * 8) * 2);
#pragma unroll
    for (int d0 = 0; d0 < 8; ++d0) { const char* a = kb[d0 & 3] + (d0 >> 2) * 128;
        bf16x8 b0 = *reinterpret_cast<const bf16x8*>(a);
        bf16x8 b1 = *reinterpret_cast<const bf16x8*>(a + 32 * 256);
        p0 = __builtin_amdgcn_mfma_f32_32x32x16_bf16(b0, qr[d0], p0, 0, 0, 0);
        p1 = __builtin_amdgcn_mfma_f32_32x32x16_bf16(b1, qr[d0], p1, 0, 0, 0); }
}
template <int VB>
__device__ __forceinline__ void pv_tile(f32x16* o, int vb0, bf16x8 pa0, bf16x8 pa1, bf16x8 pa2, bf16x8 pa3) {
#define TRRD(dst, off) asm volatile("ds_read_b64_tr_b16 %0, %1 offset:%2" : "=&v"(dst) : "v"(vb0), "i"(off) : "memory")
#define PV_D0(d0) do { s16x4 l0, l1, l2, l3, h0, h1, h2, h3; constexpr int b_ = VB * SHM_V + v_rd_off(d0, 0, 0);   \
        TRRD(l0, b_); TRRD(h0, b_ + 2048); TRRD(l1, b_ + 4096); TRRD(h1, b_ + 6144); TRRD(l2, b_ + 8192); TRRD(h2, b_ + 10240); TRRD(l3, b_ + 12288); TRRD(h3, b_ + 14336); \
        asm volatile("s_waitcnt lgkmcnt(0)" ::: "memory"); SBAR();   \
        o[d0] = __builtin_amdgcn_mfma_f32_32x32x16_bf16(pa0, (bf16x8){l0[0], l0[1], l0[2], l0[3], h0[0], h0[1], h0[2], h0[3]}, o[d0], 0, 0, 0);   \
        o[d0] = __builtin_amdgcn_mfma_f32_32x32x16_bf16(pa1, (bf16x8){l1[0], l1[1], l1[2], l1[3], h1[0], h1[1], h1[2], h1[3]}, o[d0], 0, 0, 0);   \
        o[d0] = __builtin_amdgcn_mfma_f32_32x32x16_bf16(pa2, (bf16x8){l2[0], l2[1], l2[2], l2[3], h2[0], h2[1], h2[2], h2[3]}, o[d0], 0, 0, 0);   \
        o[d0] = __builtin_amdgcn_mfma_f32_32x32x16_bf16(pa3, (bf16x8){l3[0], l3[1], l3[2], l3[3], h3[0], h3[1], h3[2], h3[3]}, o[d0], 0, 0, 0); } while (0)
    PV_D0(0); PV_D0(1); PV_D0(2); PV_D0(3);
#undef PV_D0
#undef TRRD
}

struct BlockRef { const bf16_t* Q; const bf16_t* K; const bf16_t* V; bf16_t* O; int qb; int b, h; };
struct Seam { bf16x8 qr[8]; bf16x8 st_v0, st_v1, st_k0, st_k1; unsigned bk5; };
#define VMW() asm volatile("s_waitcnt vmcnt(0)" ::: "memory")
#define VMWN(n) asm volatile("s_waitcnt vmcnt(%0)" :: "i"(n) : "memory")
#define LD8(p) (*reinterpret_cast<const bf16x8*>(p))
#define SLOAD_H(Kp, Vp, k0) do { const char* kb__ = (const char*)(Kp) + (size_t)(k0) * (LDP * 2); const char* vb__ = (const char*)(Vp) + (size_t)(k0) * (LDP * 2); \
        S.st_v0 = LD8(vb__ + kvoff); S.st_v1 = LD8(vb__ + 32 * LDP * 2 + kvoff); S.st_k0 = LD8(kb__ + kvoff); S.st_k1 = LD8(kb__ + 32 * LDP * 2 + kvoff); } while (0)
#define SWRITE_HK(bf) do { *(bf16x8*)(K_lds + (bf) * SHM_K + kws) = S.st_k0; *(bf16x8*)(K_lds + (bf) * SHM_K + kws + 32 * 256) = S.st_k1; } while (0)
#define SWRITE_HV(bf) do { *(bf16x8*)(V_lds + (bf) * SHM_V + vst0) = S.st_v0; *(bf16x8*)(V_lds + (bf) * SHM_V + vst1) = S.st_v1; } while (0)
#define SWRITE_H(bf) do { SWRITE_HV(bf); SWRITE_HK(bf); } while (0)

__device__ __forceinline__ int rel_bucket(int n) {
    if (n < 16) return n;
    const float nf = (float)n;
    int large = 16 + (int)(logf(nf / 16.0f) / 5.545177444479562f * 16.0f);
    return large < 31 ? large : 31;
}
#define TAB_LOAD(R) do { _Pragma("unroll") for (int q = 0; q < 4; ++q) tb[q] = rel_bias[((S.bk5 >> (5 * q)) & 31u) * 8 + (R).h]; \
        _Pragma("unroll") for (int q = 0; q < 2; ++q) { const int i = tid + q * 512; km0[q] = 0.f; km1[q] = 0.f; \
            if (i < (R).qb * 128) { const int j = i >> 7, dd = i & 127; const size_t o = ((size_t)((R).b * 8 + j)) * 1024 + (R).h * 128 + dd; km0[q] = kmp[o]; km1[q] = kmp[o + 64 * 1024]; } } } while (0)
#define TAB_WRITE(R) do { _Pragma("unroll") for (int q = 0; q < 4; ++q) rtab[tid + q * 512] = tb[q] * (1.0f / SCALE); \
        _Pragma("unroll") for (int q = 0; q < 2; ++q) { const int i = tid + q * 512; if (i < (R).qb * 128) kmL[i] = (km0[q] + km1[q]) * (1.0f / 256.0f); } } while (0)
__device__ __forceinline__ void prime(const BlockRef& cur, const float* rel_bias, const float* kmp, char* lds, Seam& S) {
    int tid = threadIdx.x; asm volatile("" : "+v"(tid));     const int wid = __builtin_amdgcn_readfirstlane(tid >> 6), lane = tid & 63, r32 = lane & 31, hi = lane >> 5;
    const int sr = tid >> 4, sc = (tid & 15) * 8, kws = KSWZ(sr, sc * 2); char* K_lds = lds + 2 * SHM_V;
    const unsigned kvoff = (unsigned)(sr * LDP + sc) * 2u, qvoff = (unsigned)(r32 * LDP + hi * 8) * 2u;
    { const char* qb__ = (const char*)cur.Q + (size_t)(wid * QBLK) * (LDP * 2);
#pragma unroll
    for (int d0 = 0; d0 < 8; ++d0) S.qr[d0] = LD8(qb__ + qvoff + d0 * 32); }
    {
        LAS float* rtab = (LAS float*)(LAS char*)(uintptr_t)(unsigned)(uintptr_t)(lds + OFF_RTAB); float* kmL = (float*)(lds + OFF_KM);
        unsigned bk = 0;
#pragma unroll
        for (int q = 0; q < 4; ++q) bk |= (unsigned)rel_bucket(2047 - (tid + q * 512)) << (5 * q);
        S.bk5 = bk;
        if (tid < 352) rtab[2048 + tid] = -__builtin_inff();
        float tb[4], km0[2], km1[2];
        TAB_LOAD(cur); TAB_WRITE(cur);
    }
    SLOAD_H(cur.K, cur.V, 0); VMW(); SWRITE_HK(0);
    __syncthreads();
}
__device__ __forceinline__ BlockRef make_ref(const P& a, int item);
__device__ __forceinline__ int block(const P& a, const BlockRef& cur, unsigned* queue, const float* rel_bias, const float* kmp, char* lds, Seam& S) {
    int tid = threadIdx.x; asm volatile("" : "+v"(tid));     const int wid = __builtin_amdgcn_readfirstlane(tid >> 6), lane = tid & 63, r32 = lane & 31, hi = lane >> 5;
    const int qb = cur.qb, NT = 4 * (qb + 1);
    const int qlo = qb * QB + wid * QBLK, qrow = qlo + r32;
    char* V_lds = lds; char* K_lds = lds + 2 * SHM_V;
    float* ws = (float*)(lds + OFF_WS) + wid * 64; float* li_l = ws, * al_l = ws + 32;
    LAS float* rtab = (LAS float*)(LAS char*)(uintptr_t)(unsigned)(uintptr_t)(lds + OFF_RTAB);
    float* kmL = (float*)(lds + OFF_KM);
    volatile int* misc = (volatile int*)(lds + OFF_MISC);
    int nx_v = 0;
    unsigned selmask = 0;
    {
        float sc7[7];
        int qbs = qb > 3 ? qb : 0; asm volatile("" : "+s"(qbs));

#pragma unroll
        for (int j = 0; j < 7; ++j) sc7[j] = 0.f;
#pragma unroll
        for (int d0 = 0; d0 < 8; ++d0) { const u32x4 q4 = __builtin_bit_cast(u32x4, S.qr[d0]);
            const float q0 = bflo(q4[0]), q1 = bfhi(q4[0]), q2 = bflo(q4[1]), q3 = bfhi(q4[1]), q5 = bflo(q4[2]), q6 = bfhi(q4[2]), q7 = bflo(q4[3]), q8 = bfhi(q4[3]);
#pragma unroll
            for (int j = 0; j < 7; ++j) if (j < qbs) { const f32x4 k0 = *(const f32x4*)(kmL + j * 128 + d0 * 16 + hi * 8), k1 = *(const f32x4*)(kmL + j * 128 + d0 * 16 + hi * 8 + 4);
                sc7[j] += q0 * k0[0] + q1 * k0[1] + q2 * k0[2] + q3 * k0[3] + q5 * k1[0] + q6 * k1[1] + q7 * k1[2] + q8 * k1[3]; } }
#pragma unroll
        for (int j = 0; j < 7; ++j) { if (j < qb) sc7[j] += __shfl_xor(sc7[j], 32); else sc7[j] = -__builtin_inff(); }
#pragma unroll
        for (int j = 0; j < 7; ++j) { int rank = 0;
#pragma unroll
            for (int i = 0; i < 7; ++i) { if (i != j) rank += (sc7[i] > sc7[j] || (sc7[i] == sc7[j] && i < j)) ? 1 : 0; }
            if (j < qb && (qb <= 3 || rank < 3)) selmask |= 1u << j; }
    }
    LAS unsigned* selp = (LAS unsigned*)(LAS char*)(uintptr_t)(unsigned)(uintptr_t)(lds + OFF_SEL) + tid;
    *selp = selmask;
    float m_reg = -1e30f, l_reg = 0; f32x16 o[4];
#pragma unroll
    for (int d = 0; d < 4; ++d)
#pragma unroll
        for (int r = 0; r < 16; ++r) o[d][r] = 0.f;
    const int sr = tid >> 4, sc = (tid & 15) * 8, vst0 = v_st(sr, sc), vst1 = v_st(32 + sr, sc), kws = KSWZ(sr, sc * 2);
    const unsigned kvoff = (unsigned)(sr * LDP + sc) * 2u;
    const int vb0 = (int)(uintptr_t)V_lds + v_rd_base(lane);
    const bf16_t* Kh = cur.K; const bf16_t* Vh = cur.V;
#define RESC(a) do { if (__any((a) < 1.f)) { if (hi == 0) al_l[r32] = (a); asm volatile("s_waitcnt lgkmcnt(0)" ::: "memory");              \
                     for (int d_ = 0; d_ < 4; ++d_) for (int r = 0; r < 16; ++r) o[d_][r] *= al_l[crow(r, hi)]; } } while (0)
#define KBASE(t) ((t) * KVBLK)
#define MASKT(P0_, P1_, t) do { const int kb_ = KBASE(t); const int jb_ = (t) >> 2; \
        const bool on_ = (jb_ == qb) || ((*selp >> jb_) & 1u); \
        bias_tile(P0_, P1_, on_ ? rtab + (kb_ + 4 * hi - qrow + 2047) : rtab + 2304); } while (0)
    constexpr int NQL = 8;
#define SEAM_K0() do { VMWN(NQL); SWRITE_HK(0); SBAR(); } while (0)
    f32x16 pA0, pA1, pB0, pB1; float mnA, mnB, alA, alB; bf16x8 pa0, pa1, pa2, pa3;
    SWRITE_HV(0); SBAR();
    if (NT > 1) { SLOAD_H(Kh, Vh, KBASE(1)); }
    SBAR(); qkt<0>(pA0, pA1, K_lds, r32, hi, S.qr);
    MASKT(pA0, pA1, 0); partialSM(pA0, pA1, m_reg, mnA, alA);
    if (NT > 1) { VMW(); SWRITE_H(1); }
    __syncthreads();
#define HALF_STEP(PX0, PX1, mnX, alX, PY0, PY1, alY, t, KB, VB, SB) do {                                                      \
        SBAR(); if ((t) + 1 < NT) { SLOAD_H(Kh, Vh, KBASE((t) + 1)); SBAR(); }      \
        qkt<KB>(PX0, PX1, K_lds, r32, hi, S.qr);                                             \
        finishSM(PY0, PY1, alY, l_reg, pa0, pa1, pa2, pa3); SBAR();                                                           \
        pv_tile<VB>(o, vb0, pa0, pa1, pa2, pa3); MASKT(PX0, PX1, (t)); partialSM(PX0, PX1, m_reg, mnX, alX);                                        \
        __syncthreads();                                                                                                      \
        if ((t) + 1 < NT) { VMW(); SWRITE_H(SB); }                                                                          \
        RESC(alX); __syncthreads(); } while (0)
    for (int t = 1; t + 1 < NT; t += 2) {
        const bool last_ = t + 3 >= NT;
        if (last_ && tid == 0) nx_v = (int)__hip_atomic_fetch_add(queue, 1u, __ATOMIC_RELAXED, __HIP_MEMORY_SCOPE_AGENT);
        HALF_STEP(pB0, pB1, mnB, alB, pA0, pA1, alA, t, 1, 0, 0);
        if (last_ && tid == 0) misc[0] = nx_v;
        HALF_STEP(pA0, pA1, mnA, alA, pB0, pB1, alB, t + 1, 0, 1, 1);
    }
    const int next_item = __builtin_amdgcn_readfirstlane(misc[0]);
    const BlockRef nxt = next_item < 512 ? make_ref(a, next_item) : cur;
    { SBAR(); qkt<1>(pB0, pB1, K_lds, r32, hi, S.qr); SBAR(); }
    float tb[4], km0[2], km1[2];
    TAB_LOAD(nxt); SBAR();
    SLOAD_H(nxt.K, nxt.V, 0); SBAR();
    { const char* qb__ = (const char*)nxt.Q + (size_t)(wid * QBLK) * (LDP * 2); int l_ = lane; asm volatile("" : "+v"(l_));
      const unsigned qvoff = (unsigned)((l_ & 31) * LDP + (l_ >> 5) * 8) * 2u;
#pragma unroll
    for (int d0 = 0; d0 < 8; ++d0) S.qr[d0] = LD8(qb__ + qvoff + d0 * 32); }
    SBAR();
    finishSM(pA0, pA1, alA, l_reg, pa0, pa1, pa2, pa3); SBAR();
    pv_tile<0>(o, vb0, pa0, pa1, pa2, pa3);
    { MASKT(pB0, pB1, NT - 1); partialSM(pB0, pB1, m_reg, mnB, alB); __syncthreads(); RESC(alB);
      finishSM(pB0, pB1, alB, l_reg, pa0, pa1, pa2, pa3); SBAR(); pv_tile<1>(o, vb0, pa0, pa1, pa2, pa3); }
    SBAR(); SEAM_K0();
    TAB_WRITE(nxt);
    if (hi == 0) li_l[r32] = l_reg; asm volatile("s_waitcnt lgkmcnt(0)" ::: "memory");
    float rli[16];
#pragma unroll
    for (int r = 0; r < 16; ++r) rli[r] = __builtin_amdgcn_rcpf(li_l[crow(r, hi)]);
    char* Ow = (char*)cur.O + (size_t)(wid * QBLK) * (LDO * 2);
    unsigned ow[16][4];
#pragma unroll
    for (int r = 0; r < 16; ++r)
#pragma unroll
        for (int d0 = 0; d0 < 4; ++d0) { const float v = o[d0][r] * rli[r];
            const float vn = __int_as_float(__builtin_amdgcn_update_dpp(0, __float_as_int(v), 0xB1, 0xF, 0xF, true));
            ow[r][d0] = cvtpk(v, vn); }
    {
        char* stg = lds + (wid < 2 ? wid * 8192 : (wid < 4 ? 49152 + (wid - 2) * 8192 : 86016 + (wid - 4) * 8192));
        if ((r32 & 1) == 0) {
#pragma unroll
            for (int r = 0; r < 16; ++r)
#pragma unroll
                for (int d0 = 0; d0 < 4; ++d0) *(unsigned*)(stg + crow(r, hi) * 256 + d0 * 64 + r32 * 2) = ow[r][d0]; }
        asm volatile("s_waitcnt lgkmcnt(0)" ::: "memory");
#pragma unroll
        for (int q = 0; q < 8; ++q) { const int row = 4 * q + (lane >> 4); const u32x4 v4_ = *(const u32x4*)(stg + row * 256 + (lane & 15) * 16); *(u32x4*)(Ow + (size_t)row * (LDO * 2) + (lane & 15) * 16) = v4_; }
    }
    __syncthreads();
    return next_item;
#undef RESC
#undef KBASE
#undef MASKT
#undef SEAM_K0
#undef HALF_STEP
}
#undef ROWP
#undef TAB_LOAD
#undef TAB_WRITE
#undef VMW
#undef VMWN
#undef LD8
#undef SLOAD_H
#undef SWRITE_HK
#undef SWRITE_HV
#undef SWRITE_H

__device__ __forceinline__ BlockRef make_ref(const P& a, int item) {
    const int qb = 7 - (item >> 6), bh = item & 63, b = bh >> 3, h = bh & 7;
    const bf16_t* proj = (const bf16_t*)(a.ws + WS_PROJ);
    BlockRef r; r.b = b; r.h = h; r.qb = qb;
    r.Q = proj + PROJ_BLK(C_QB + h * HD) + (size_t)(b * SEQ + qb * QB) * LDP;
    r.K = proj + PROJ_BLK(C_KB + h * HD) + (size_t)(b * SEQ) * LDP;
    r.V = proj + PROJ_BLK(C_VB + h * HD) + (size_t)(b * SEQ) * LDP;
    r.O = (bf16_t*)(a.ws + WS_OAB) + (size_t)(b * SEQ + qb * QB) * LDO + 1024 + h * HD;
    return r;
}
}
__device__ __forceinline__ void router_unit(const P& a, LAS unsigned char* lds, int unit) {
    int tid = threadIdx.x; asm volatile("" : "+v"(tid)); const int wave = __builtin_amdgcn_readfirstlane(tid >> 6), lane = tid & 63, c32 = lane & 31, hi = lane >> 5;
    const int tg = wave & 1, kq = wave >> 1;
    const bf16_t* x1 = (const bf16_t*)(a.ws + WS_X1); const float* g = a.in[11]; const float* br = a.in[13];
    unsigned char* A2 = a.ws + WS_A2; const u32x4* frag = (const u32x4*)(a.ws + WS_WRF);
    LAS float* Lw = (LAS float*)(lds + wave * 4352);
    LAS float* ssp = (LAS float*)(lds + 8 * 4352);
    LAS unsigned* hist = (LAS unsigned*)(lds + 8 * 4352 + 2048);
    LAS unsigned* base = hist + 32;
    if (tid < 32) hist[tid] = 0u;
    const int tok = unit * 64 + tg * 32 + c32;
    f32x16 L;
#pragma unroll
    for (int r = 0; r < 16; ++r) L[r] = 0.f;
    float ss = 0.f;
    const bf16_t* xr = x1 + (size_t)tok * D + 8 * hi + 256 * kq; unsigned char* ar = A2 + (size_t)tok * D + 8 * hi + 256 * kq;
    LAS float* brl = (LAS float*)(lds + 40960);
    if (tid < 32) brl[tid] = br[tid];
    u32x4 xw[16];
#pragma unroll
    for (int s = 0; s < 16; ++s) xw[s] = *(const u32x4*)(xr + 16 * s);
    u32x4 fhA[4], flA[4], fhB[4], flB[4];
    LAS unsigned char* a2l = lds + 49152 + (tg * 32 + c32) * 1032 + 8 * hi + 256 * kq;
#define RF_LOAD(FH, FL, b_) do { _Pragma("unroll") for (int j = 0; j < 4; ++j) { FH[j] = frag[(16 * kq + 4 * (b_) + j) * 64 + lane]; FL[j] = frag[4096 + (16 * kq + 4 * (b_) + j) * 64 + lane]; } } while (0)
#define RF_DO(FH, FL, b_) do { _Pragma("unroll") for (int j = 0; j < 4; ++j) { const int s = 4 * (b_) + j; const u32x4 xq = xw[s]; \
        const f32x4 xa = {bflo(xq.x), bfhi(xq.x), bflo(xq.y), bfhi(xq.y)}, xb = {bflo(xq.z), bfhi(xq.z), bflo(xq.w), bfhi(xq.w)}; \
        ss += (xa.x * xa.x + xa.y * xa.y) + (xa.z * xa.z + xa.w * xa.w) + (xb.x * xb.x + xb.y * xb.y) + (xb.z * xb.z + xb.w * xb.w); \
        { u32x2 w8_; w8_.x = pk4_fp8(xa.x, xa.y, xa.z, xa.w); w8_.y = pk4_fp8(xb.x, xb.y, xb.z, xb.w); *(LAS u32x2*)(a2l + 16 * s) = w8_; }       \
        const bf16x8 ah = __builtin_bit_cast(bf16x8, xq), bh = __builtin_bit_cast(bf16x8, FH[j]), bl = __builtin_bit_cast(bf16x8, FL[j]); \
        L = __builtin_amdgcn_mfma_f32_32x32x16_bf16(ah, bh, L, 0, 0, 0); \
        L = __builtin_amdgcn_mfma_f32_32x32x16_bf16(ah, bl, L, 0, 0, 0); } } while (0)
    RF_LOAD(fhA, flA, 0); RF_LOAD(fhB, flB, 1);
    RF_DO(fhA, flA, 0); RF_LOAD(fhA, flA, 2); RF_DO(fhB, flB, 1); RF_LOAD(fhB, flB, 3); RF_DO(fhA, flA, 2); RF_DO(fhB, flB, 3);
#undef RF_LOAD
#undef RF_DO
#pragma unroll
    for (int r = 0; r < 16; ++r) Lw[((r & 3) + 8 * (r >> 2) + 4 * hi) * 33 + c32] = L[r];
    ssp[wave * 64 + lane] = ss;
    __syncthreads();
    { const int row_ = tid >> 3, seg_ = tid & 7; const LAS unsigned char* src_ = lds + 49152 + row_ * 1032 + seg_ * 128; unsigned char* dst_ = A2 + (size_t)(unit * 64 + row_) * D + seg_ * 128;
#pragma unroll
      for (int q = 0; q < 8; ++q) { const u32x2 lo_ = *(const LAS u32x2*)(src_ + 16 * q), hi_ = *(const LAS u32x2*)(src_ + 16 * q + 8); *(u32x4*)(dst_ + 16 * q) = (u32x4){lo_.x, lo_.y, hi_.x, hi_.y}; } }
    int e4[4] = {0, 0, 0, 0}; float w4[4] = {0.f, 0.f, 0.f, 0.f}; unsigned loc[4] = {0u, 0u, 0u, 0u}; float rstd = 0.f;
    const bool sel = (wave < 2) && (hi == 0);
    if (sel) {
        float sst = 0.f;
#pragma unroll
        for (int q = 0; q < 4; ++q) sst += ssp[(wave + 2 * q) * 64 + c32] + ssp[(wave + 2 * q) * 64 + 32 + c32];
        rstd = 1.0f / sqrtf(sst * (1.0f / D) + EPS);
        float lg[32];
#pragma unroll
        for (int e = 0; e < 32; ++e) { const LAS float* lp = (const LAS float*)(lds + wave * 4352) + c32 * 33 + e; lg[e] = (lp[0] + lp[2 * 1088] + lp[4 * 1088] + lp[6 * 1088]) * rstd + brl[e]; }
        unsigned used = 0u; float v4[4];
#pragma unroll
        for (int p = 0; p < 4; ++p) { float best = -__builtin_inff(); int bi = 0;
#pragma unroll
            for (int e = 0; e < 32; ++e) { const bool take = !((used >> e) & 1u) && lg[e] > best; best = take ? lg[e] : best; bi = take ? e : bi; }
            used |= 1u << bi; e4[p] = bi; v4[p] = best; }
        float sum = 0.f;
#pragma unroll
        for (int p = 0; p < 4; ++p) { w4[p] = __builtin_amdgcn_exp2f((v4[p] - v4[0]) * 1.4426950408889634f); sum += w4[p]; }
        const float inv = 1.0f / sum;
#pragma unroll
        for (int p = 0; p < 4; ++p) { w4[p] *= inv; loc[p] = __hip_atomic_fetch_add(hist + e4[p], 1u, __ATOMIC_RELAXED, __HIP_MEMORY_SCOPE_WORKGROUP); }
    }
    __syncthreads();
    if (tid < 32) base[tid] = __hip_atomic_fetch_add((unsigned*)(a.ws + WS_CTL) + CW_COUNTS + tid, hist[tid], RLX_AGENT);
    __syncthreads();
    if (sel) {
        int* tope = (int*)(a.ws + WS_TOPE) + (size_t)tok * 4; float* wts = (float*)(a.ws + WS_WTS) + (size_t)tok * 4; int* slot = (int*)(a.ws + WS_SLOT) + (size_t)tok * 4;
#pragma unroll
        for (int p = 0; p < 4; ++p) { const int sl_ = (int)(base[e4[p]] + loc[p]); tope[p] = e4[p]; wts[p] = w4[p]; slot[p] = sl_;
            ((int*)(a.ws + WS_ROWE))[(size_t)e4[p] * T + sl_] = tok; ((float*)(a.ws + WS_RSTE))[(size_t)e4[p] * T + sl_] = rstd; }
    }
    __syncthreads();
}

__device__ __forceinline__ void moe_tables(const P& a, LAS unsigned char* lds) {
    int tid = threadIdx.x; asm volatile("" : "+v"(tid)); const int wave = tid >> 6, lane = tid & 63, e = lane & 31;
    LAS int* pstart = (LAS int*)(lds + LDS_MOE); LAS int* cnt = pstart + 64; LAS int* tile_e = pstart + 128;
    const unsigned* counts = (const unsigned*)(a.ws + WS_CTL) + CW_COUNTS;
    const int c = (int)counts[e]; const int p = ((c + 255) >> 8) << 8; int inc = p;
#pragma unroll
    for (int o = 1; o < 32; o <<= 1) { const int t = __builtin_amdgcn_ds_bpermute(((lane - o) & 63) << 2, inc); if (e >= o) inc += t; }
    if (tid < 32) { cnt[e] = c; pstart[e] = inc - p; if (e == 31) { pstart[32] = inc; tile_e[MAXTILES] = inc >> 8; } }
    for (int t = wave * 36; t < wave * 36 + 36; ++t) { const unsigned long long m = __ballot(inc <= t * 256); const int ee = __builtin_popcount((unsigned)m); if (lane == 0) tile_e[t] = ee < NE ? ee : NE - 1; }
    __syncthreads();
}

__device__ __forceinline__ void combine_rows(const P& a, LAS unsigned char* lds, int vcu, int G, int wave, int lane) {
    const LAS int* pstart = (const LAS int*)(lds + LDS_MOE);
    const int gw = vcu * NWAVES + wave, NGW = G * NWAVES;
    const bf16_t* X1 = (const bf16_t*)(a.ws + WS_X1); float* X = (float*)(a.ws + WS_X2); const unsigned char* Y = a.ws + WS_YROWS; bf16_t* A3 = (bf16_t*)(a.ws + WS_H);
    const int* tope = (const int*)(a.ws + WS_TOPE); const int* slot = (const int*)(a.ws + WS_SLOT); const float* wts = (const float*)(a.ws + WS_WTS); const float* g = a.in[20];
    f32x4 gv[4];
#pragma unroll
    for (int j = 0; j < 4; ++j) gv[j] = *((const f32x4*)g + lane + 64 * j);
    for (int m0 = gw; m0 < T; m0 += 8 * NGW) {
        int dl = 0; float wl = 0.f;
        { const int i = (lane >> 2) & 7, k = lane & 3; const int m = m0 + i * NGW; if (lane < 32 && m < T) { dl = pstart[tope[m * 4 + k]] + slot[m * 4 + k]; wl = wts[m * 4 + k]; } }
        u32x2 xa[4], xb[4]; unsigned ya[4][4], yb[4][4];
#define CR_LOAD(i_, XQ, YQ) do { const int m_ = m0 + (i_) * NGW; if (m_ < T) { const u32x2* x1r = (const u32x2*)(X1 + (size_t)m_ * D) + lane; \
            _Pragma("unroll") for (int j = 0; j < 4; ++j) XQ[j] = __builtin_nontemporal_load(x1r + 64 * j); \
            _Pragma("unroll") for (int k = 0; k < 4; ++k) { const int d = __builtin_amdgcn_readlane(dl, 4 * (i_) + k); const unsigned* yr = (const unsigned*)(Y + (size_t)d * D) + lane; \
                _Pragma("unroll") for (int j = 0; j < 4; ++j) YQ[k][j] = __builtin_nontemporal_load(yr + 64 * j); } } } while (0)
#define CR_DO(i_, XQ, YQ) do { const int m_ = m0 + (i_) * NGW; if (m_ < T) { f32x4 v[4]; \
            _Pragma("unroll") for (int j = 0; j < 4; ++j) v[j] = (f32x4){bflo(XQ[j].x), bfhi(XQ[j].x), bflo(XQ[j].y), bfhi(XQ[j].y)}; \
            _Pragma("unroll") for (int k = 0; k < 4; ++k) { const float w = __int_as_float(__builtin_amdgcn_readlane(__float_as_int(wl), 4 * (i_) + k)); \
                _Pragma("unroll") for (int j = 0; j < 4; ++j) { const int y = (int)YQ[k][j]; \
                    v[j].x += w * __builtin_amdgcn_cvt_f32_fp8(y, 0); v[j].y += w * __builtin_amdgcn_cvt_f32_fp8(y, 1); v[j].z += w * __builtin_amdgcn_cvt_f32_fp8(y, 2); v[j].w += w * __builtin_amdgcn_cvt_f32_fp8(y, 3); } } \
            float s = 0.f; \
            _Pragma("unroll") for (int j = 0; j < 4; ++j) s += (v[j].x * v[j].x + v[j].y * v[j].y) + (v[j].z * v[j].z + v[j].w * v[j].w); \
            const float rstd = 1.0f / sqrtf(wave_sum(s) * (1.0f / D) + EPS); \
            u32x2* xr = (u32x2*)((bf16_t*)X + (size_t)m_ * D) + lane; unsigned* o4 = (unsigned*)((unsigned char*)A3 + (size_t)m_ * D) + lane;        \
            _Pragma("unroll") for (int j = 0; j < 4; ++j) { u32x2 xw_; xw_.x = cvt_pk_bf16(v[j].x, v[j].y); xw_.y = cvt_pk_bf16(v[j].z, v[j].w); xr[64 * j] = xw_; o4[64 * j] = pk4_fp8(v[j].x * rstd * gv[j].x, v[j].y * rstd * gv[j].y, v[j].z * rstd * gv[j].z, v[j].w * rstd * gv[j].w); } } } while (0)
        CR_LOAD(0, xa, ya);
#pragma unroll
        for (int i = 0; i < 8; i += 2) { CR_LOAD(i + 1, xb, yb); CR_DO(i, xa, ya); if (i + 2 < 8) CR_LOAD(i + 2, xa, ya); CR_DO(i + 1, xb, yb); }
#undef CR_LOAD
#undef CR_DO
    }
}
__device__ __forceinline__ void final_rows(const P& a, int vcu, int G, int wave, int lane) {
    const int gw = vcu * NWAVES + wave, NGW = G * NWAVES;
    const float* X = (const float*)(a.ws + WS_X2); float* OUT = a.out; const bf16_t* PG = (const bf16_t*)(a.ws + WS_PGATE); const bf16_t* PP = (const bf16_t*)(a.ws + WS_PPROJ);
    f32x4 gp[4], gf[4];
#pragma unroll
    for (int j = 0; j < 4; ++j) { gp[j] = *((const f32x4*)a.in[23] + lane + 64 * j); gf[j] = *((const f32x4*)a.in[24] + lane + 64 * j); }
    u32x2 va[4], vb[4]; u32x2 qa[4], qb[4], ga[4], gb[4];
#define FR_LOAD(m_, V, Q, GQ) do { if ((m_) < T) { const u32x2* xr = (const u32x2*)((const bf16_t*)X + (size_t)(m_) * D) + lane; const u32x2* pgr = (const u32x2*)(PG + (size_t)(m_) * D) + lane; const u32x2* ppr = (const u32x2*)(PP + (size_t)(m_) * D) + lane; \
        _Pragma("unroll") for (int j = 0; j < 4; ++j) { V[j] = __builtin_nontemporal_load(xr + 64 * j); Q[j] = __builtin_nontemporal_load(ppr + 64 * j); GQ[j] = __builtin_nontemporal_load(pgr + 64 * j); } } } while (0)
#define FR_DO(m_, V, Q, GQ) do { if ((m_) < T) { f32x4 v[4], pp[4], pg[4]; float sp = 0.f; \
        _Pragma("unroll") for (int j = 0; j < 4; ++j) { v[j] = (f32x4){bflo(V[j].x), bfhi(V[j].x), bflo(V[j].y), bfhi(V[j].y)}; pp[j] = (f32x4){bflo(Q[j].x), bfhi(Q[j].x), bflo(Q[j].y), bfhi(Q[j].y)}; pg[j] = (f32x4){bflo(GQ[j].x), bfhi(GQ[j].x), bflo(GQ[j].y), bfhi(GQ[j].y)}; \
            sp += (pp[j].x * pp[j].x + pp[j].y * pp[j].y) + (pp[j].z * pp[j].z + pp[j].w * pp[j].w); } \
        const float rp = 1.0f / sqrtf(wave_sum(sp) * (1.0f / D) + EPS); float s_ = 0.f; \
        _Pragma("unroll") for (int j = 0; j < 4; ++j) { v[j] = v[j] + pg[j] * (pp[j] * rp * gp[j]); s_ += (v[j].x * v[j].x + v[j].y * v[j].y) + (v[j].z * v[j].z + v[j].w * v[j].w); } \
        const float rstd = 1.0f / sqrtf(wave_sum(s_) * (1.0f / D) + EPS); f32x4* orow = (f32x4*)(OUT + (size_t)(m_) * D) + lane; \
        _Pragma("unroll") for (int j = 0; j < 4; ++j) __builtin_nontemporal_store(v[j] * rstd * gf[j], orow + 64 * j); } } while (0)
    FR_LOAD(gw, va, qa, ga);
    for (int m = gw; m < T; m += 2 * NGW) { FR_LOAD(m + NGW, vb, qb, gb); FR_DO(m, va, qa, ga); FR_LOAD(m + 2 * NGW, va, qa, ga); FR_DO(m + NGW, vb, qb, gb); }
#undef FR_LOAD
#undef FR_DO
}
#ifndef MK_CVP
#define MK_CVP 16
#define MK_CVQ 7
#endif
struct Args { P p; };
template <int PH_LO, int PH_HI>
__global__ void __launch_bounds__(NTHREADS, 2) hybrid_fwd(Args args) {
    extern __shared__ __attribute__((aligned(16))) unsigned char lds_raw[];
    LAS unsigned char* lds = (LAS unsigned char*)lds_raw;
    const P& a = args.p;
    const int tid = threadIdx.x;
#define FRESH_WL() int t_ = threadIdx.x; asm volatile("" : "+v"(t_)); const int w_ = __builtin_amdgcn_readfirstlane(t_ >> 6), l_ = t_ & 63
    const int G = gridDim.x; const int bx = blockIdx.x; const int vcu = (G % 8 == 0) ? (bx % 8) * (G / 8) + bx / 8 : bx;
    unsigned* ctl = (unsigned*)(a.ws + WS_CTL);
    for (int u = tid; u < (LDS_BYTES - LDSCTL_OFF) / 4; u += NTHREADS) ((LAS unsigned*)(lds + LDSCTL_OFF))[u] = 0u;
    __syncthreads();
#if MK_PER_PHASE
#define GRID_BAR() do { } while (0)
#else
    XcdBarrier bar = xcd_barrier_post(ctl + CW_BAR, (volatile LAS unsigned*)(lds + MISC_OFF + 32));
#define GRID_BAR() xcd_barrier(bar)
#endif
    constexpr int lo = PH_LO, hi = PH_HI;
#define IN(k) (lo <= (k) && (k) < hi)
#define SEAM(k) do { if constexpr (IN(k) && IN((k) + 1)) GRID_BAR(); } while (0)
    unsigned char* ws = a.ws;

    if constexpr (IN(0)) { FRESH_WL(); p0_prologue(a, lds, vcu, G, w_, l_); }
    SEAM(0);
    if constexpr (IN(1)) {
#define P1_BF16() do { pg8::DenseSched S; S.o.init(T / 256, 12, G, bx); S.Bt = (const char*)(ws + WS_WIN); S.K = D; \
          pg8::EpiProj<false> E{(bf16_t*)(ws + WS_PROJ), (float*)(ws + WS_KMP)}; \
          pg8::gemm_phase(lds, (const char*)(ws + WS_H), D, D, D, S, E); } while (0)
#define P1_FP8() do { pg8::DenseSched S; S.o.init(T / 256, 20, G, bx); S.Bt = (const char*)(ws + WS_WIN8); S.K = D; S.es = 1; S.pn0 = 12; S.bt_out = false; \
          pg8::EpiProj<true> E{(bf16_t*)(ws + WS_PROJ), (float*)(ws + WS_KMP)}; \
          pg8::gemm_phase(lds, (const char*)(ws + WS_H8), D, D, D, S, E); } while (0)
        if ((bx & 7) < 4) { P1_BF16(); P1_FP8(); } else { P1_FP8(); P1_BF16(); }
#undef P1_BF16
#undef P1_FP8
    }
    SEAM(1);
    if constexpr (IN(2)) { for (int u = vcu; u < NB * 32; u += G) gla_prep_unit(a, lds, u); }
    SEAM(2);
    if constexpr (IN(3)) { for (int u = vcu; u < 512; u += G) gla_combine_unit(a, u); }
    SEAM(3);
    if constexpr (IN(4)) {
        {
            GlaIn ga_, gb_; int u = vcu;
            if (u < 1024) gla_out_load(a, u, ga_);
            for (; u < 1024; u += 2 * G) {
                if (u + G < 1024) gla_out_load(a, u + G, gb_);
                gla_out_unit(a, lds, u, ga_);
                if (u + G < 1024) { if (u + 2 * G < 1024) gla_out_load(a, u + 2 * G, ga_); gla_out_unit(a, lds, u + G, gb_); }
            }
        }
        __syncthreads();
    }
    if constexpr (IN(5)) {
        if ((vcu % MK_CVP) < MK_CVQ) { FRESH_WL(); const int ci_ = (vcu / MK_CVP) * MK_CVQ + vcu % MK_CVP, ncv_ = (G / MK_CVP) * MK_CVQ + ((G % MK_CVP) < MK_CVQ ? (G % MK_CVP) : MK_CVQ);
            late_prep(a, lds, ci_, ncv_, w_, l_); expert_convert(a, lds, ci_, ncv_, w_, l_); __syncthreads(); }
        unsigned* queue = ctl + CW_QUEUE;
        volatile LAS int* qslot = (volatile LAS int*)(lds + LDSCTL_OFF + 1024);
        if (tid == 0) qslot[0] = (int)__hip_atomic_fetch_add(queue, 1u, RLX_AGENT);
        __syncthreads();
        int item = __builtin_amdgcn_readfirstlane(qslot[0]);
        if (item < 512) {
            moba::Seam S;
            moba::BlockRef cur = moba::make_ref(a, item);
            moba::prime(cur, a.in[2], (const float*)(ws + WS_KMP), (char*)lds_raw, S);
            for (;;) {
                const int nitem = moba::block(a, cur, queue, a.in[2], (const float*)(ws + WS_KMP), (char*)lds_raw, S);
                if (nitem >= 512) break;
                cur = moba::make_ref(a, nitem);
            }
        }
    }
    SEAM(5);
    if constexpr (IN(6)) {
        pg8::ChainSched S; S.o.init(T / 256, D / 256, G, bx); S.Bt = (const char*)(ws + WS_WUP); S.K = 1024;
        pg8::EpiMerge E{(const bf16_t*)(ws + WS_PROJ), (bf16_t*)(ws + WS_Y)};
        pg8::gemm_phase(lds, (const char*)(ws + WS_OAB), 1024, 2048, 2048, S, E);
    }
    SEAM(6);
    if constexpr (IN(7)) {
        pg8::DenseSched S; S.o.init(T / 256, D / 256, G, bx); S.Bt = (const char*)(ws + WS_WO); S.K = D;
        pg8::EpiResF32 E{a.in[0], (bf16_t*)(ws + WS_X1)};
        pg8::gemm_phase(lds, (const char*)(ws + WS_Y), D, D, D, S, E);
    }
    SEAM(7);
    if constexpr (IN(8)) { for (int u = vcu; u < T / 64; u += G) router_unit(a, lds, u); }
    SEAM(8);
    if constexpr (IN(9)) {
        moe_tables(a, lds); const LAS int* tab = (const LAS int*)(lds + LDS_MOE); const int ntile = __builtin_amdgcn_readfirstlane(tab[128 + MAXTILES]);
        pg8::MoeSched<true> S; S.o.init(ntile, 8, G, bx); S.Bt = (const char*)a.out; S.K = D; S.rows_per_e = 2048; S.tab = tab; S.row_e = (const int*)(ws + WS_ROWE); S.es = 1;
        pg8::EpiGlu E{(unsigned char*)(ws + WS_HMID), (const float*)(ws + WS_RSTE), tab, a.in[15], a.in[17], (const float*)(ws + WS_CTL) + 131072, lds};
        pg8::gemm_phase(lds, (const char*)(ws + WS_A2), D, D, D, S, E);
        const int extra = (ntile * 8) % G, nidle = G - extra;
        if (bx >= extra) { __syncthreads();
            pg8::DenseSched S2; S2.o.init(T / 256, D / 256, nidle, bx - extra); S2.Bt = (const char*)(ws + WS_WPP); S2.K = 256;
            pg8::EpiBf16<0, false> E2{(bf16_t*)(ws + WS_PPROJ), D, nullptr, 0, 1.0f};
            pg8::gemm_phase(lds, (const char*)(ws + WS_PB), 256, 256, 256, S2, E2); }
    }
    SEAM(9);
    if constexpr (IN(10)) {
        moe_tables(a, lds); const LAS int* tab = (const LAS int*)(lds + LDS_MOE); const int ntile = __builtin_amdgcn_readfirstlane(tab[128 + MAXTILES]);
        pg8::MoeSched<false> S; S.o.init(ntile, 4, G, bx); S.Bt = (const char*)(ws + WS_W2T); S.K = FF; S.rows_per_e = 1024; S.tab = tab; S.row_e = nullptr; S.es = 1;
        pg8::EpiDownF8 E{(unsigned char*)(ws + WS_YROWS), a.in[19]};
        pg8::gemm_phase(lds, (const char*)(ws + WS_HMID), FF, FF, FF, S, E);
    }
    SEAM(10);
    if constexpr (IN(11)) { moe_tables(a, lds); FRESH_WL(); combine_rows(a, lds, vcu, G, w_, l_); }
    SEAM(11);
    if constexpr (IN(12)) {
        { pg8::DenseSched S; S.o.init(T / 256, D / 256, G, bx); S.Bt = (const char*)(ws + WS_WPG); S.K = D; S.es = 1;
          pg8::EpiBf16<1, false, true> E{(bf16_t*)(ws + WS_PGATE), D, nullptr, 0, 1.0f / 32.0f};
          pg8::gemm_phase(lds, (const char*)(ws + WS_H), D, D, D, S, E); }
    }
    SEAM(12);
    if constexpr (IN(13)) { FRESH_WL(); final_rows(a, vcu, G, w_, l_); }
#undef FRESH_WL
#undef IN
#undef SEAM
#undef GRID_BAR
}

template <int LO, int HI> static void launch_range(const Args& a, int grid, hipStream_t stream) {
    static bool attr = false;
    if (!attr) { attr = true; if (hipFuncSetAttribute((const void*)hybrid_fwd<LO, HI>, hipFuncAttributeMaxDynamicSharedMemorySize, LDS_BYTES) != hipSuccess) fprintf(stderr, "kernel_launch: hipFuncSetAttribute failed\n"); }
    hipLaunchKernelGGL((hybrid_fwd<LO, HI>), dim3(grid), dim3(NTHREADS), LDS_BYTES, stream, a);
}
extern "C" void kernel_launch(void* const* d_in, const int* in_sizes, int n_in, void* d_out, int out_size, void* d_ws, size_t ws_size, hipStream_t stream) {
    static int grid = 0;
    if (grid == 0) {
        static const int expect[25] = {T * D, T * 256, 256, 1024, 1024 * D_IN, 16 * 512, 512, 256, 1048576, 1048576, 1048576, 1024, 32768, 32, 33554432, 32768, 33554432, 32768, 33554432, 32768, 1024, 1048576, 262144, 1024, 1024};
        bool okk = (n_in == 25);
        for (int i = 0; okk && i < 25; ++i) if (in_sizes[i] != expect[i]) { fprintf(stderr, "kernel_launch: input %d has %d elements, expected %d\n", i, in_sizes[i], expect[i]); okk = false; }
        if (!okk || out_size != T * D || ws_size < WS_END) { fprintf(stderr, "kernel_launch: unexpected shapes (n_in %d, in0 %d, out %d, ws %zu); nothing launched\n", n_in, n_in > 0 ? in_sizes[0] : -1, out_size, ws_size); grid = -1; return; }
        int dev = 0, cus = 0;
        if (hipGetDevice(&dev) != hipSuccess || hipDeviceGetAttribute(&cus, hipDeviceAttributeMultiprocessorCount, dev) != hipSuccess) { grid = -1; return; }
        grid = cus;
    }
    if (grid < 0) return;
    (void)hipMemsetAsync((char*)d_ws + WS_CTL, 0, CTL_ZERO_BYTES, stream);
    Args a{};
    for (int i = 0; i < 25; ++i) a.p.in[i] = (const float*)d_in[i];
    a.p.out = (float*)d_out; a.p.ws = (unsigned char*)d_ws;
#if MK_PER_PHASE
#ifndef MK_LAST
#define MK_LAST 13
#endif
#ifndef MK_REPEAT
#define MK_REPEAT 0
#endif
#define LR(k) do { if ((k) <= MK_LAST) for (int r_ = 0; r_ < 1 + ((MK_REPEAT >> (k)) & 1); ++r_) launch_range<(k), (k) + 1>(a, grid, stream); } while (0)
    LR(0); LR(1); LR(2); LR(3); LR(4); LR(5); LR(6); LR(7); LR(8); LR(9); LR(10); LR(11); LR(12); LR(13);
#undef LR
#else
    launch_range<0, NPHASES>(a, grid, stream);
#endif
}
```
